# Optimizing an MI355X kernel written in HIP

```python
import jax, jax.numpy as jnp
from jax import lax
import numpy as np

D_MODEL = 1024
BATCH = 32
SEQ = 2048
DEPTH = 1

H_R = 8
N_R = 64
C_R = H_R * N_R
DECAY_LORA = 64
AAA_LORA = 64
GATE_LORA = 128
RW_SIZES = (C_R, C_R, C_R, DECAY_LORA, AAA_LORA, GATE_LORA)
RW_COLS = sum(RW_SIZES)
LNX_EPS = 64e-5

H_M = 4
DK_M = 64
DV_M = 128
C_MQK = H_M * DK_M
C_MV = H_M * DV_M
ML_SIZES = (C_MQK, C_MQK, C_MV, C_MV, H_M, H_M)
ML_COLS = sum(ML_SIZES)
QK_CONV = 4
CHUNK = 64
GATE_CAP = 15.0

N_IN = RW_COLS + ML_COLS
D_MIX = C_R + C_MV

D_FF = 2816
FFN_CONV = 3
NORM_EPS = 1e-6

kernel_name = "hymba_rwkv7_mlstm_convffn"


def _split(t, sizes):
    idx = np.cumsum(sizes)[:-1].tolist()
    return jnp.split(t, idx, axis=-1)


def rmsnorm(x, g):
    xf = x.astype(jnp.float32)
    y = xf * lax.rsqrt(jnp.mean(xf * xf, axis=-1, keepdims=True) + NORM_EPS)
    return y.astype(x.dtype) * g


def head_layernorm(y, eps):
    yf = y.astype(jnp.float32)
    mu = jnp.mean(yf, axis=-1, keepdims=True)
    var = jnp.mean(jnp.square(yf - mu), axis=-1, keepdims=True)
    return (yf - mu) * lax.rsqrt(var + eps)


def head_rmsnorm(y):
    yf = y.astype(jnp.float32)
    return yf * lax.rsqrt(jnp.mean(yf * yf, axis=-1, keepdims=True) + NORM_EPS)


def token_shift(t):
    return jnp.pad(t, ((0, 0), (1, 0), (0, 0)))[:, :-1]


def causal_dwconv(t, w, b):
    K = w.shape[0]
    T = t.shape[1]
    tp = jnp.pad(t, ((0, 0), (K - 1, 0), (0, 0)))
    out = b + tp[:, 0:T] * w[0]
    for j in range(1, K):
        out = out + tp[:, j:j + T] * w[j]
    return out


def softcap(t):
    return GATE_CAP * jnp.tanh(t / GATE_CAP)


def rwkv7_scan(r, w, k, v, a, b):
    Bn, T, H, N = r.shape

    def step(S, inp):
        r_t, w_t, k_t, v_t, a_t, b_t = inp
        sa = jnp.einsum('bhij,bhj->bhi', S, a_t)
        S = S * w_t[:, :, None, :] + sa[..., None] * b_t[:, :, None, :] + v_t[..., :, None] * k_t[..., None, :]
        y = jnp.einsum('bhij,bhj->bhi', S, r_t)
        return S, y

    S0 = jnp.zeros((Bn, H, N, N), jnp.float32)
    xs = tuple(jnp.moveaxis(t, 1, 0) for t in (r, w, k, v, a, b))
    _, y = lax.scan(step, S0, xs)
    return jnp.moveaxis(y, 0, 1)


def rwkv7_group(p, mu, w0, w_up_decay, a0, w_up_a, w_up_g, k_k, k_a, r_k, lnx_w, lnx_b):
    Bn, T, _ = p.shape
    p = p + (token_shift(p) - p) * mu
    r, k, v, w_lo, a_lo, g_lo = _split(p, RW_SIZES)
    log_w = -jax.nn.softplus(-(w0 + jnp.tanh(w_lo) @ w_up_decay)) - 0.5
    decay = jnp.exp(-jnp.exp(log_w.astype(jnp.float32)))
    a = jax.nn.sigmoid(a0 + a_lo @ w_up_a)
    g = jax.nn.sigmoid(g_lo) @ w_up_g
    heads = lambda t: t.reshape(Bn, T, H_R, N_R)
    kk = heads(k * k_k).astype(jnp.float32)
    kk = kk / jnp.maximum(jnp.sqrt(jnp.sum(kk * kk, axis=-1, keepdims=True)), 1e-12)
    k = k * (1 + (a - 1) * k_a)
    r_h, k_h, v_h, a_h = heads(r), heads(k), heads(v), heads(a)
    y = rwkv7_scan(r_h, heads(decay), k_h, v_h, -kk, kk * a_h)
    y = head_layernorm(y, LNX_EPS).reshape(Bn, T, C_R) * lnx_w + lnx_b
    bonus = jnp.sum(r_h * k_h * r_k, axis=-1, keepdims=True) * v_h
    return ((y + bonus.reshape(Bn, T, C_R)) * g).astype(p.dtype)


def mlstm_chunkwise(q, k, v, ig, logf):
    Bn, T, H, _ = q.shape
    nc = T // CHUNK

    def to_chunks(t):
        t = t.reshape(Bn, nc, CHUNK, H, *t.shape[3:])
        return jnp.moveaxis(t, (1, 3), (0, 2))

    causal = jnp.tril(jnp.ones((CHUNK, CHUNK), dtype=bool))

    def step(carry, inp):
        C, n, m = carry
        qc, kc, vc, ic, fc = inp
        b = jnp.cumsum(fc, axis=-1)
        log_d = jnp.where(causal, b[..., :, None] - b[..., None, :] + ic[..., None, :], -jnp.inf)
        m_inter = b + m[..., None]
        m_t = jnp.maximum(jnp.max(log_d, axis=-1), m_inter)
        d = jnp.exp(log_d - m_t[..., None])
        s = jnp.einsum('bhtd,bhsd->bhts', qc, kc) * d
        sc = jnp.exp(m_inter - m_t)
        num = jnp.einsum('bhts,bhsv->bhtv', s, vc) + sc[..., None] * jnp.einsum('bhtd,bhdv->bhtv', qc, C)
        den = jnp.sum(s, axis=-1) + sc * jnp.einsum('bhtd,bhd->bht', qc, n)
        h = num / jnp.maximum(jnp.abs(den), jnp.exp(-m_t))[..., None]
        b_last = b[..., -1]
        a_w = b_last[..., None] - b + ic
        m_new = jnp.maximum(b_last + m, jnp.max(a_w, axis=-1))
        w_s = jnp.exp(a_w - m_new[..., None])
        dec = jnp.exp(b_last + m - m_new)
        C = dec[..., None, None] * C + jnp.einsum('bhs,bhsd,bhsv->bhdv', w_s, kc, vc)
        n = dec[..., None] * n + jnp.einsum('bhs,bhsd->bhd', w_s, kc)
        return (C, n, m_new), h

    carry0 = (jnp.zeros((Bn, H, q.shape[-1], v.shape[-1]), jnp.float32),
              jnp.zeros((Bn, H, q.shape[-1]), jnp.float32),
              jnp.zeros((Bn, H), jnp.float32))
    xs = tuple(to_chunks(t) for t in (q, k, v, ig, logf))
    _, h = lax.scan(step, carry0, xs)
    h = jnp.moveaxis(h, (0, 2), (1, 3))
    return h.reshape(Bn, T, H, v.shape[-1])


def mlstm_group(p, qk_conv_w, qk_conv_b, i_bias, f_bias, mh_norm_g):
    Bn, T, _ = p.shape
    q, k, v, o, ig, fg = _split(p, ML_SIZES)
    qk = jax.nn.silu(causal_dwconv(jnp.concatenate([q, k], axis=-1), qk_conv_w, qk_conv_b))
    q, k = qk[..., :C_MQK], qk[..., C_MQK:]
    ig = softcap((ig + i_bias).astype(jnp.float32))
    logf = jax.nn.log_sigmoid(softcap((fg + f_bias).astype(jnp.float32)))
    h = mlstm_chunkwise(q.reshape(Bn, T, H_M, DK_M) * (DK_M ** -0.5),
                        k.reshape(Bn, T, H_M, DK_M),
                        v.reshape(Bn, T, H_M, DV_M), ig, logf)
    h = head_rmsnorm(h).reshape(Bn, T, C_MV) * mh_norm_g * jax.nn.sigmoid(o)
    return h.astype(p.dtype)


def setup_inputs(seed: int = 0) -> dict:
    key = jax.random.key(seed)
    ks = jax.random.split(key, 26)
    f32 = jnp.float32
    nrm = lambda k, s, sc: jax.random.normal(k, s, f32) * sc
    gain = lambda k, s: 1.0 + 0.02 * jax.random.normal(k, s, f32)
    L = DEPTH
    return {
        "x": jax.random.normal(ks[0], (BATCH, SEQ, D_MODEL), f32),
        "norm1_g": gain(ks[1], (L, D_MODEL)),
        "w_in": nrm(ks[2], (L, D_MODEL, N_IN), D_MODEL ** -0.5),
        "rw_mu": jax.random.uniform(ks[3], (L, RW_COLS), f32),
        "w0": jax.random.uniform(ks[4], (L, C_R), f32, -6.0, 0.0),
        "w_up_decay": nrm(ks[5], (L, DECAY_LORA, C_R), 0.1 * DECAY_LORA ** -0.5),
        "a0": nrm(ks[6], (L, C_R), 0.1),
        "w_up_a": nrm(ks[7], (L, AAA_LORA, C_R), 0.1 * AAA_LORA ** -0.5),
        "w_up_g": nrm(ks[8], (L, GATE_LORA, C_R), GATE_LORA ** -0.5),
        "k_k": 0.85 + 0.02 * jax.random.normal(ks[9], (L, C_R), f32),
        "k_a": gain(ks[10], (L, C_R)),
        "r_k": nrm(ks[11], (L, H_R, N_R), 0.1),
        "lnx_w": gain(ks[12], (L, C_R)),
        "lnx_b": nrm(ks[13], (L, C_R), 0.02),
        "qk_conv_w": nrm(ks[14], (L, QK_CONV, 2 * C_MQK), QK_CONV ** -0.5),
        "qk_conv_b": nrm(ks[15], (L, 2 * C_MQK), 0.02),
        "i_bias": nrm(ks[16], (L, H_M), 0.1),
        "f_bias": jax.random.uniform(ks[17], (L, H_M), f32, 3.0, 6.0),
        "mh_norm_g": gain(ks[18], (L, C_MV)),
        "w_out": nrm(ks[19], (L, D_MIX, D_MODEL), D_MIX ** -0.5),
        "norm2_g": gain(ks[20], (L, D_MODEL)),
        "w_ffn_up": nrm(ks[21], (L, D_MODEL, 2 * D_FF), D_MODEL ** -0.5),
        "ffn_conv_w": nrm(ks[22], (L, FFN_CONV, D_FF), FFN_CONV ** -0.5),
        "ffn_conv_b": nrm(ks[23], (L, D_FF), 0.02),
        "w_ffn_down": nrm(ks[24], (L, D_FF, D_MODEL), D_FF ** -0.5),
        "norm_f_g": gain(ks[25], (D_MODEL,)),
    }


def reference(x, norm1_g, w_in, rw_mu, w0, w_up_decay, a0, w_up_a, w_up_g, k_k, k_a, r_k,
              lnx_w, lnx_b, qk_conv_w, qk_conv_b, i_bias, f_bias, mh_norm_g, w_out,
              norm2_g, w_ffn_up, ffn_conv_w, ffn_conv_b, w_ffn_down, norm_f_g):
    for l in range(DEPTH):
        h = rmsnorm(x, norm1_g[l])
        proj = h @ w_in[l]
        p_rw, p_ml = proj[..., :RW_COLS], proj[..., RW_COLS:]
        y_rw = rwkv7_group(p_rw, rw_mu[l], w0[l], w_up_decay[l], a0[l], w_up_a[l], w_up_g[l],
                           k_k[l], k_a[l], r_k[l], lnx_w[l], lnx_b[l])
        y_ml = mlstm_group(p_ml, qk_conv_w[l], qk_conv_b[l], i_bias[l], f_bias[l],
                           mh_norm_g[l])
        x = x + jnp.concatenate([y_rw, y_ml], axis=-1) @ w_out[l]
        h = rmsnorm(x, norm2_g[l])
        u = h @ w_ffn_up[l]
        a, b = u[..., :D_FF], u[..., D_FF:]
        a = causal_dwconv(a, ffn_conv_w[l], ffn_conv_b[l])
        x = x + (jax.nn.silu(a) * b) @ w_ffn_down[l]
    return rmsnorm(x, norm_f_g)
```

```cpp
#include <hip/hip_runtime.h>
#include <cstdio>
#include <cstdint>
namespace pg8 {
#define PG8_LAS __attribute__((address_space(3)))
typedef unsigned short bf16_t;
typedef short bf16x8 __attribute__((ext_vector_type(8)));
typedef float f32x4 __attribute__((ext_vector_type(4)));
typedef unsigned u32x4 __attribute__((ext_vector_type(4)));
constexpr int BM = 256, BK = 64, HALF = 128, HTB = HALF * BK * 2  , STAGE_BYTES = 8 * HTB, NXCD = 8, WGM = 8;

__host__ __device__ __forceinline__ int lds_byte(int r, int c) { const int st = (r >> 4) * 2 + (c >> 5), rr = r & 15, cc = c & 31, ob = rr * 64 + cc * 2; return st * 1024 + (ob ^ (((ob >> 9) & 1) << 5)); }
__host__ __device__ __forceinline__ void stage_rc(int b, int& R, int& C) { const int st = b / 1024, sb = b % 1024, swz = sb ^ (((sb >> 9) & 1) << 5); R = (st >> 1) * 16 + swz / 64; C = (st & 1) * 32 + (swz % 64) / 2; }
__host__ __device__ __forceinline__ int perm32(int rho) { const int n = rho >> 4, i = rho & 15; return 8 * (i >> 2) + 4 * n + (i & 3); }

struct Unit { int pm, pn; };
struct Gemm { const bf16_t* A; const bf16_t* Bt; int M, N, K; };

struct StaticOrder {
    int nM, nN, nwg, G, c;
    __host__ __device__ void init(int M, int N, int G_, int c_) { nM = M / BM; nN = N / BM; nwg = nM * nN; G = G_; c = c_; }
    __host__ __device__ bool next(int i, Unit& u) const {
        const long L = (long)i * G + c; if (L >= nwg) return false;
        int wgid = (int)L; { const int q = nwg / NXCD, r = nwg % NXCD, xcd = wgid % NXCD, off = wgid / NXCD; wgid = (xcd < r ? xcd * (q + 1) : r * (q + 1) + (xcd - r) * q) + off; }
        const int nig = WGM * nN, gid = wgid / nig, fm = gid * WGM, gsz = (nM - fm) < WGM ? (nM - fm) : WGM;
        u.pm = fm + ((wgid % nig) % gsz); u.pn = (wgid % nig) / gsz; return true;
    }
    __device__ __forceinline__ void a_ready(const Unit&) const {}
    __device__ __forceinline__ void done(const Unit&) const {}
};

__device__ __forceinline__ unsigned cvt_pk_bf16(float lo, float hi) { unsigned r; asm volatile("v_cvt_pk_bf16_f32 %0, %1, %2" : "=v"(r) : "v"(lo), "v"(hi)); return r; }
typedef float f32x2 __attribute__((ext_vector_type(2)));
__device__ __forceinline__ f32x2 gelu_pk(f32x2 v) {
    const f32x2 av = __builtin_elementwise_abs(v), d = av * 0.2316418882f + 1.0f;
    f32x2 t; t.x = __builtin_amdgcn_rcpf(d.x); t.y = __builtin_amdgcn_rcpf(d.y);
    f32x2 q = t * 0.5307027145f + (-0.7265760135f); q = q * t + 0.7107068705f; q = q * t + (-0.142248368f); q = q * t + 0.127414796f; q = q * t;
    const f32x2 s = (v * v) * (-0.72134752044f);
    f32x2 e; e.x = __builtin_amdgcn_exp2f(s.x); e.y = __builtin_amdgcn_exp2f(s.y);
    const f32x2 m = v * (q * e), r = v - m;
    f32x2 o; o.x = v.x < 0.f ? m.x : r.x; o.y = v.y < 0.f ? m.y : r.y; return o;
}

template <int ACT  > struct EpiBf16 {
    static constexpr bool PERM = true, AFTER_DRAIN = false; static_assert(ACT == 0 || ACT == 1, "EpiBf16: ACT is 0 (none) or 1 (gelu_pk)");
    bf16_t* O; int ldc; const float* bias; int split_cols; size_t split_stride; float scale0;
    __device__ __forceinline__ void operator()(const f32x4 (&acc)[2][2][4][2], const Unit& u, int wr, int wc, int fr, int fq) const {
        const int row0 = u.pm * BM + wr * 64 + fr; int colt = u.pn * BM; bf16_t* base = O;
        float sc = 1.f; if (split_cols) { const int t = colt / split_cols; base += (size_t)t * split_stride; colt -= t * split_cols; if (t == 0) sc = scale0; }
        const int col0 = colt + wc * 32 + 8 * fq, bcol0 = u.pn * BM + wc * 32 + 8 * fq;
        f32x4 bv[2][2];
#pragma unroll
        for (int bj = 0; bj < 2; ++bj)
#pragma unroll
            for (int n = 0; n < 2; ++n) bv[bj][n] = bias ? *(const f32x4*)(bias + bcol0 + bj * HALF + 4 * n) : (f32x4){0.f, 0.f, 0.f, 0.f};
#pragma unroll
        for (int ai = 0; ai < 2; ++ai)
#pragma unroll
            for (int m = 0; m < 4; ++m) { bf16_t* rowp = base + (size_t)(row0 + ai * HALF + m * 16) * ldc + col0;
#pragma unroll
                for (int bj = 0; bj < 2; ++bj) { f32x4 v0 = acc[ai][bj][m][0] + bv[bj][0], v1 = acc[ai][bj][m][1] + bv[bj][1];
                    if (ACT == 1) { f32x2 a = gelu_pk((f32x2){v0[0], v0[1]}), b = gelu_pk((f32x2){v0[2], v0[3]}), c = gelu_pk((f32x2){v1[0], v1[1]}), d = gelu_pk((f32x2){v1[2], v1[3]});
                        v0 = (f32x4){a.x, a.y, b.x, b.y}; v1 = (f32x4){c.x, c.y, d.x, d.y}; }
                    v0 = v0 * sc; v1 = v1 * sc; u32x4 w; w.x = cvt_pk_bf16(v0[0], v0[1]); w.y = cvt_pk_bf16(v0[2], v0[3]); w.z = cvt_pk_bf16(v1[0], v1[1]); w.w = cvt_pk_bf16(v1[2], v1[3]);
                    *(u32x4*)(rowp + bj * HALF) = w; } }
    }
};
template <class Epi, class Sched, bool ALIGN_EPI = false, bool SP2 = false>
__device__ __forceinline__ void gemm_phase(PG8_LAS unsigned char* lds, const Gemm g, const Sched& S, const Epi& E) {
    const int tid = threadIdx.x, wid = __builtin_amdgcn_readfirstlane(tid >> 6), lane = tid & 63, wr = wid >> 2, wc = wid & 3, fr = lane & 15, fq = lane >> 4;
    const int K = g.K, nt = K / BK;
    unsigned voffA[2], voffB[2];
#pragma unroll
    for (int i = 0; i < 2; ++i) { int R, C; stage_rc(tid * 16 + i * 8192, R, C); const int Rb = Epi::PERM ? ((R & ~31) + perm32(R & 31)) : R;
        voffA[i] = (unsigned)(R * K + C) * 2u; voffB[i] = (unsigned)(Rb * K + C) * 2u; }
    const size_t kstep = (size_t)(BK * 2);
    const size_t hstep = (size_t)HALF * K * 2;
    const size_t tstep = 2 * hstep;
    const unsigned ldsw = (unsigned)wid * 1024u;
    const int aoff = lds_byte(wr * 64 + fr, fq * 8), boff = lds_byte(wc * 32 + fr, fq * 8);
#define PG8_SA(b, h) (((b) * 2 + (h)) * HTB)
#define PG8_SB(b, h) ((4 + (b) * 2 + (h)) * HTB)
#define PG8_STAGE(bufoff, gbase, voff) do { _Pragma("unroll") for (int _i = 0; _i < 2; ++_i) \
        __builtin_amdgcn_global_load_lds((const unsigned*)((const char*)(gbase) + (voff)[_i]), (PG8_LAS unsigned*)(lds + (bufoff) + ldsw + _i * 8192), 16, 0, 0); } while (0)
#define PG8_LDA(dst, b, h) do { _Pragma("unroll") for (int m = 0; m < 4; ++m) _Pragma("unroll") for (int k = 0; k < 2; ++k) dst[m][k] = *(const PG8_LAS bf16x8*)(lds + PG8_SA(b, h) + aoff + m * 2048 + k * 1024); } while (0)
#define PG8_LDB(dst, b, h) do { _Pragma("unroll") for (int n = 0; n < 2; ++n) _Pragma("unroll") for (int k = 0; k < 2; ++k) dst[n][k] = *(const PG8_LAS bf16x8*)(lds + PG8_SB(b, h) + boff + n * 2048 + k * 1024); } while (0)
#define PG8_MMA(ai, bj, At, Bt) do { __builtin_amdgcn_s_setprio(1); _Pragma("unroll") for (int m = 0; m < 4; ++m) _Pragma("unroll") for (int n = 0; n < 2; ++n) _Pragma("unroll") for (int k = 0; k < 2; ++k) \
        acc[ai][bj][m][n] = __builtin_amdgcn_mfma_f32_16x16x32_bf16(Bt[n][k], At[m][k], acc[ai][bj][m][n], 0, 0, 0); __builtin_amdgcn_s_setprio(0); } while (0)
#define PG8_WAIT_V(n) asm volatile("s_waitcnt vmcnt(" #n ")" ::: "memory")
#define PG8_WAIT_L(n) asm volatile("s_waitcnt lgkmcnt(" #n ")" ::: "memory")
#define PG8_BAR __builtin_amdgcn_s_barrier()
#define PG8_SCHED __builtin_amdgcn_sched_barrier(0)
    Unit cur, nxt; int ui = 0;
    if (!S.next(0, cur)) return;
    f32x4 acc[2][2][4][2];
#pragma unroll
    for (int a = 0; a < 2; ++a)
#pragma unroll
        for (int b = 0; b < 2; ++b)
#pragma unroll
            for (int m = 0; m < 4; ++m)
#pragma unroll
                for (int n = 0; n < 2; ++n) acc[a][b][m][n] = (f32x4){0.f, 0.f, 0.f, 0.f};
    bf16x8 At[4][2], B0[2][2], B1[2][2];
    const char* cA = (const char*)g.A + (size_t)cur.pm * tstep; const char* cB = (const char*)g.Bt + (size_t)cur.pn * tstep;
    S.a_ready(cur);
    if constexpr (SP2) {
        PG8_STAGE(PG8_SB(0, 0), cB, voffB); PG8_STAGE(PG8_SB(0, 1), cB + hstep, voffB); PG8_STAGE(PG8_SA(0, 0), cA, voffA); PG8_STAGE(PG8_SA(0, 1), cA + hstep, voffA);
        if (wr == 1) PG8_BAR;
        PG8_WAIT_V(2); PG8_BAR;
        PG8_STAGE(PG8_SB(1, 0), cB + kstep, voffB); PG8_STAGE(PG8_SA(1, 0), cA + kstep, voffA); PG8_STAGE(PG8_SB(1, 1), cB + hstep + kstep, voffB);
        PG8_WAIT_V(6); PG8_BAR;
    } else {
        PG8_STAGE(PG8_SB(0, 0), cB, voffB); PG8_STAGE(PG8_SA(0, 0), cA, voffA); PG8_STAGE(PG8_SB(0, 1), cB + hstep, voffB); PG8_STAGE(PG8_SA(0, 1), cA + hstep, voffA);
        if (wr == 1) PG8_BAR;
        PG8_WAIT_V(4); PG8_BAR;
        PG8_STAGE(PG8_SB(1, 0), cB + kstep, voffB); PG8_STAGE(PG8_SA(1, 0), cA + kstep, voffA); PG8_STAGE(PG8_SB(1, 1), cB + hstep + kstep, voffB);
        PG8_WAIT_V(6); PG8_BAR;
    }
    for (;;) {
        const bool has_next = S.next(ui + 1, nxt);
        const char* nA = has_next ? (const char*)g.A + (size_t)nxt.pm * tstep : cA; const char* nB = has_next ? (const char*)g.Bt + (size_t)nxt.pn * tstep : cB;
        for (int t = 0; t < nt; t += 2) {
            const bool last = (t == nt - 2);
            const char* a1 = cA + (size_t)(t + 1) * kstep;
            const char* a2 = last ? nA : cA + (size_t)(t + 2) * kstep; const char* b2 = last ? nB : cB + (size_t)(t + 2) * kstep;
            const char* a3 = a2 + kstep; const char* b3 = b2 + kstep;
            if (last && has_next) S.a_ready(nxt);
            if constexpr (SP2) {
            PG8_LDB(B0, 0, 0); PG8_LDB(B1, 0, 1); PG8_SCHED; PG8_LDA(At, 0, 0); PG8_STAGE(PG8_SA(1, 1), a1 + hstep, voffA);
            PG8_WAIT_V(8); PG8_WAIT_L(0); PG8_BAR; PG8_MMA(0, 0, At, B0); PG8_MMA(0, 1, At, B1); PG8_BAR; PG8_SCHED;
            PG8_LDA(At, 0, 1); PG8_STAGE(PG8_SB(0, 0), b2, voffB); PG8_STAGE(PG8_SB(0, 1), b2 + hstep, voffB); PG8_STAGE(PG8_SA(0, 0), a2, voffA);
            PG8_WAIT_V(8); PG8_WAIT_L(0); PG8_BAR; PG8_MMA(1, 0, At, B0); PG8_MMA(1, 1, At, B1); PG8_BAR; PG8_SCHED;
            PG8_LDB(B0, 1, 0); PG8_LDB(B1, 1, 1); PG8_SCHED; PG8_LDA(At, 1, 0); PG8_STAGE(PG8_SA(0, 1), a2 + hstep, voffA);
            PG8_WAIT_V(8); PG8_WAIT_L(0); PG8_BAR; PG8_MMA(0, 0, At, B0); PG8_MMA(0, 1, At, B1); PG8_BAR; PG8_SCHED;
            PG8_LDA(At, 1, 1); PG8_STAGE(PG8_SB(1, 0), b3, voffB); PG8_STAGE(PG8_SB(1, 1), b3 + hstep, voffB); PG8_STAGE(PG8_SA(1, 0), a3, voffA);
            PG8_WAIT_V(8); PG8_WAIT_L(0); PG8_BAR; PG8_MMA(1, 0, At, B0); PG8_MMA(1, 1, At, B1); PG8_BAR; PG8_SCHED;
            } else {
            PG8_LDB(B0, 0, 0); PG8_SCHED; PG8_LDA(At, 0, 0); PG8_STAGE(PG8_SA(1, 1), a1 + hstep, voffA);
            PG8_WAIT_L(8); PG8_BAR; PG8_WAIT_L(0); PG8_MMA(0, 0, At, B0); PG8_BAR; PG8_SCHED;
            PG8_LDB(B1, 0, 1); PG8_STAGE(PG8_SB(0, 0), b2, voffB);
            PG8_BAR; PG8_WAIT_L(0); PG8_MMA(0, 1, At, B1); PG8_BAR;
            PG8_LDA(At, 0, 1); PG8_STAGE(PG8_SA(0, 0), a2, voffA);
            PG8_BAR; PG8_WAIT_L(0); PG8_MMA(1, 0, At, B0); PG8_BAR; PG8_SCHED;
            PG8_STAGE(PG8_SB(0, 1), b2 + hstep, voffB);
            PG8_WAIT_V(6); PG8_BAR; PG8_MMA(1, 1, At, B1); PG8_BAR;
            PG8_LDB(B0, 1, 0); PG8_SCHED; PG8_LDA(At, 1, 0); PG8_STAGE(PG8_SA(0, 1), a2 + hstep, voffA);
            PG8_WAIT_L(8); PG8_BAR; PG8_WAIT_L(0); PG8_MMA(0, 0, At, B0); PG8_BAR; PG8_SCHED;
            PG8_LDB(B1, 1, 1); PG8_STAGE(PG8_SB(1, 0), b3, voffB);
            PG8_BAR; PG8_WAIT_L(0); PG8_MMA(0, 1, At, B1); PG8_BAR;
            PG8_LDA(At, 1, 1); PG8_STAGE(PG8_SA(1, 0), a3, voffA);
            PG8_BAR; PG8_WAIT_L(0); PG8_MMA(1, 0, At, B0); PG8_BAR; PG8_SCHED;
            PG8_STAGE(PG8_SB(1, 1), b3 + hstep, voffB);
            PG8_WAIT_V(6); PG8_BAR; PG8_MMA(1, 1, At, B1); PG8_BAR;
            }
        }
        if constexpr (ALIGN_EPI) { if (wr == 0) PG8_BAR; }
        if constexpr (!Epi::AFTER_DRAIN) { E(acc, cur, wr, wc, fr, fq); S.done(cur); }
        if (!has_next) break;
#pragma unroll
        for (int a = 0; a < 2; ++a)
#pragma unroll
            for (int b = 0; b < 2; ++b)
#pragma unroll
                for (int m = 0; m < 4; ++m)
#pragma unroll
                    for (int n = 0; n < 2; ++n) acc[a][b][m][n] = (f32x4){0.f, 0.f, 0.f, 0.f};
        cur = nxt; cA = nA; cB = nB; ++ui;
        if constexpr (ALIGN_EPI) { if (wr == 1) PG8_BAR; }
    }
    PG8_WAIT_V(0);
    if constexpr (!ALIGN_EPI) { if (wr == 0) PG8_BAR; }
    PG8_BAR;
    if constexpr (Epi::AFTER_DRAIN) { E.fused(acc, cur, wr, wc, fr, fq, lds, wid, lane); S.done(cur); }
#undef PG8_SA
#undef PG8_SB
#undef PG8_STAGE
#undef PG8_LDA
#undef PG8_LDB
#undef PG8_MMA
#undef PG8_WAIT_V
#undef PG8_WAIT_L
#undef PG8_BAR
#undef PG8_SCHED
}
}

#ifndef MK_SINGLE
#define MK_SINGLE 0
#endif
constexpr int BATCH = 32, SEQ = 2048, DM = 1024, M = BATCH * SEQ;
constexpr int NIN = 3336, NPROJ = 3328;
constexpr int DFF = 2816, NUP = 2 * DFF;
constexpr int C_Q = 1792, C_K = 2048, C_V = 2304, C_O = 2816;
constexpr int NLORA = 1536, KLORA = 256;
constexpr int MH = M / 2;
constexpr float NORM_EPS = 1e-6f, LNX_EPS = 64e-5f;

constexpr size_t MiB = 1u << 20;
constexpr size_t WS_CTL = 0, CTL_ZERO_BYTES = 1 * MiB;
constexpr size_t WS_WT_IN = 2 * MiB, WS_WT_OUT = 9 * MiB, WS_WT_UP = 11 * MiB, WS_WT_DN = 22 * MiB, WS_WT_LORA = 28 * MiB;
constexpr size_t WS_RS2 = 29 * MiB, WS_SSQP = 30 * MiB, WS_GATES = 34 * MiB;
constexpr size_t WS_XN = 40 * MiB;
constexpr size_t WS_PROJ = 168 * MiB;
constexpr size_t WS_LBUF = 584 * MiB;
constexpr size_t WS_DAG = 616 * MiB;
constexpr size_t WS_MIX = 808 * MiB;
constexpr size_t WS_UH = 168 * MiB;
constexpr size_t WS_GB = 520 * MiB;
constexpr size_t WS_END = 936 * MiB;

constexpr int LDS_BYTES = 147456;
constexpr int MISC_OFF = 131072 + 320;

#define GAS __attribute__((address_space(1)))
#define LAS __attribute__((address_space(3)))
typedef unsigned short bf16;
typedef unsigned v4u __attribute__((ext_vector_type(4)));
typedef unsigned v2u __attribute__((ext_vector_type(2)));
typedef float f32x4 __attribute__((ext_vector_type(4)));
typedef float f32x2 __attribute__((ext_vector_type(2)));
typedef short bf16x8 __attribute__((ext_vector_type(8)));
typedef GAS unsigned gu32;

__device__ __forceinline__ unsigned f2bf(float f) { unsigned u = __builtin_bit_cast(unsigned, f); return (u + 0x7fffu + ((u >> 16) & 1u)) >> 16; }
__device__ __forceinline__ unsigned pk2(float lo, float hi) { return f2bf(lo) | (f2bf(hi) << 16); }
__device__ __forceinline__ float bf2f(unsigned short u) { return __builtin_bit_cast(float, (unsigned)u << 16); }
__device__ __forceinline__ float bflo(unsigned w) { return __builtin_bit_cast(float, w << 16); }
__device__ __forceinline__ float bfhi(unsigned w) { return __builtin_bit_cast(float, w & 0xffff0000u); }
__device__ __forceinline__ void unpack8(const v4u w, float (&o)[8]) { o[0] = bflo(w.x); o[1] = bfhi(w.x); o[2] = bflo(w.y); o[3] = bfhi(w.y); o[4] = bflo(w.z); o[5] = bfhi(w.z); o[6] = bflo(w.w); o[7] = bfhi(w.w); }
__device__ __forceinline__ v4u pack8(const float (&o)[8]) { v4u w; w.x = pk2(o[0], o[1]); w.y = pk2(o[2], o[3]); w.z = pk2(o[4], o[5]); w.w = pk2(o[6], o[7]); return w; }
__device__ __forceinline__ float sigmoidf_(float x) { return 1.0f / (1.0f + __expf(-x)); }
__device__ __forceinline__ float tanhf_(float x) { return 1.0f - 2.0f / (__expf(2.0f * x) + 1.0f); }
__device__ __forceinline__ float softplusf_(float x) { return fmaxf(x, 0.f) + log1pf(__expf(-fabsf(x))); }
__device__ __forceinline__ float wave_sum(float v) {
#pragma unroll
    for (int o = 1; o < 64; o <<= 1) v += __shfl_xor(v, o);
    return v;
}
template <int CTRL> __device__ __forceinline__ float dppmov(float v) { return __builtin_bit_cast(float, __builtin_amdgcn_update_dpp(0, __builtin_bit_cast(int, v), CTRL, 0xF, 0xF, true)); }
__device__ __forceinline__ float red8(float v) { v += dppmov<0xB1>(v); v += dppmov<0x4E>(v); v += dppmov<0x141>(v); return v; }
__device__ __forceinline__ float red16(float v) { v += dppmov<0xB1>(v); v += dppmov<0x4E>(v); v += dppmov<0x141>(v); v += dppmov<0x140>(v); return v; }

#define XB_TMO      128
#define XB_XCNT(j)  (256  + 64 * (j))
#define XB_XSUB(j)  (1280 + 64 * (j))
#define XB_XGEN(j)  (2304 + 64 * (j))
#define XB_TOP      3328
#define XB_TOPGEN   3392
#define XCD_BAR_WORDS 3456
#define XB_SPIN_CAP (1u << 22)
__device__ __forceinline__ unsigned xb_ld(unsigned* p)              { return __hip_atomic_load(p, __ATOMIC_RELAXED, __HIP_MEMORY_SCOPE_AGENT); }
__device__ __forceinline__ unsigned xb_add(unsigned* p, unsigned v) { return __hip_atomic_fetch_add(p, v, __ATOMIC_RELAXED, __HIP_MEMORY_SCOPE_AGENT); }
__device__ __forceinline__ unsigned xb_xcc_id() { return (unsigned)__builtin_amdgcn_s_getreg((3 << 11) | 20) & 0xFu; }
#define XB_SPIN(cond, bar) do { unsigned _sp = 0; while (cond) { __builtin_amdgcn_s_sleep(1); \
    if ((++_sp & 255u) == 0u) { if (xb_ld(&(bar)[XB_TMO])) break; if (_sp > XB_SPIN_CAP) { atomicAdd(&(bar)[XB_TMO], 1u); break; } } } } while (0)
struct XcdBarrier { unsigned* bar; unsigned x; volatile LAS unsigned* st; };
__device__ __forceinline__ XcdBarrier xcd_barrier_post(unsigned* bar, volatile LAS unsigned* st) {
    XcdBarrier b; b.bar = bar; b.x = xb_xcc_id(); b.st = st;
    if (threadIdx.x == 0) (void)xb_add(&bar[XB_XCNT(b.x)], 1u);
    return b;
}
__device__ __forceinline__ void xcd_barrier_complete(unsigned* bar, unsigned x, unsigned& nloc, unsigned& nx) {
    const unsigned G = gridDim.x * gridDim.y * gridDim.z;
    unsigned sum, cnt, mine, sp = 0u;
    for (;;) {
        sum = 0u; cnt = 0u; mine = 0u;
#pragma unroll
        for (unsigned j = 0; j < 16; ++j) { const unsigned c = xb_ld(&bar[XB_XCNT(j)]); sum += c; cnt += (c > 0u) ? 1u : 0u; mine = (j == x) ? c : mine; }
        if (sum == G) break;
        __builtin_amdgcn_s_sleep(1);
        if ((++sp & 255u) == 0u) { if (xb_ld(&bar[XB_TMO])) break; if (sp > XB_SPIN_CAP) { atomicAdd(&bar[XB_TMO], 1u); break; } }
    }
    nloc = mine > 0u ? mine : 1u; nx = cnt > 0u ? cnt : 1u;
}
__device__ __forceinline__ void xcd_barrier(const XcdBarrier& b) {
    asm volatile("s_waitcnt vmcnt(0)" ::: "memory");
    __syncthreads();
    if (threadIdx.x == 0) {
        unsigned* bar = b.bar;
        __builtin_amdgcn_s_waitcnt(0);
        unsigned nloc = b.st[0], nx = b.st[1];
        if (nloc == 0u) { xcd_barrier_complete(bar, b.x, nloc, nx); b.st[0] = nloc; b.st[1] = nx; }
        const unsigned old = xb_add(&bar[XB_XSUB(b.x)], 1u);
        const unsigned gen = old / nloc;
        if (old + 1u == (gen + 1u) * nloc) {
            __builtin_amdgcn_fence(__ATOMIC_RELEASE, "agent");
            asm volatile("s_waitcnt vmcnt(0)" ::: "memory");
            const unsigned og = xb_add(&bar[XB_TOP], 1u);
            const unsigned tg = og / nx;
            if (og + 1u == (tg + 1u) * nx) xb_add(&bar[XB_TOPGEN], 1u);
            else XB_SPIN(xb_ld(&bar[XB_TOPGEN]) == tg, bar);
            __builtin_amdgcn_fence(__ATOMIC_ACQUIRE, "agent");
            xb_add(&bar[XB_XGEN(b.x)], 1u);
            asm volatile("s_waitcnt vmcnt(0)" ::: "memory");
        } else {
            XB_SPIN(xb_ld(&bar[XB_XGEN(b.x)]) == gen, bar);
            __builtin_amdgcn_fence(__ATOMIC_ACQUIRE, "agent");
            asm volatile("s_waitcnt vmcnt(0)" ::: "memory");
        }
    }
    __syncthreads();
}

struct Args { const float* in[26]; float* out; unsigned char* ws; int ph_lo, ph_hi; };

namespace pg8 {
struct PanelOrder {
    int c;
    __device__ bool next(int i, Unit& u) const { if (i >= 4) return false; u.pm = c; u.pn = i; return true; }
    __device__ __forceinline__ void a_ready(const Unit&) const {}
    __device__ __forceinline__ void done(const Unit&) const {}
};
struct EpiResid {
    static constexpr bool PERM = true, AFTER_DRAIN = false;
    const float* X; float* X2; bf16_t* XB; float* ssqp;
    __device__ __forceinline__ void operator()(const f32x4 (&acc)[2][2][4][2], const Unit& u, int wr, int wc, int fr, int fq) const {
        const int row0 = u.pm * BM + wr * 64 + fr, col0 = u.pn * BM + wc * 32 + 8 * fq;
#pragma unroll
        for (int ai = 0; ai < 2; ++ai)
#pragma unroll
            for (int m = 0; m < 4; ++m) { const int row = row0 + ai * HALF + m * 16; float ss = 0.f;
#pragma unroll
                for (int bj = 0; bj < 2; ++bj) { const size_t off = (size_t)row * DM + col0 + bj * HALF;
                    const f32x4 x0 = *(const f32x4*)(X + off), x1 = *(const f32x4*)(X + off + 4);
                    const f32x4 v0 = acc[ai][bj][m][0] + x0, v1 = acc[ai][bj][m][1] + x1;
                    *(f32x4*)(X2 + off) = v0; *(f32x4*)(X2 + off + 4) = v1;
                    ss += (v0[0] * v0[0] + v0[1] * v0[1]) + (v0[2] * v0[2] + v0[3] * v0[3]) + (v1[0] * v1[0] + v1[1] * v1[1]) + (v1[2] * v1[2] + v1[3] * v1[3]);
                    if (XB) { u32x4 w; w.x = pk2(v0[0], v0[1]); w.y = pk2(v0[2], v0[3]); w.z = pk2(v1[0], v1[1]); w.w = pk2(v1[2], v1[3]); *(u32x4*)(XB + off) = w; } }
                ss += __shfl_xor(ss, 16); ss += __shfl_xor(ss, 32);
                if (fq == 0) ssqp[(size_t)row * 16 + u.pn * 4 + wc] = ss; }
    }
};
struct EpiScale {
    static constexpr bool PERM = true, AFTER_DRAIN = false;
    bf16_t* O; int ldc; const float* rs; int row_off;
    __device__ __forceinline__ void operator()(const f32x4 (&acc)[2][2][4][2], const Unit& u, int wr, int wc, int fr, int fq) const {
        const int row0 = u.pm * BM + wr * 64 + fr, col0 = u.pn * BM + wc * 32 + 8 * fq;
#pragma unroll
        for (int ai = 0; ai < 2; ++ai)
#pragma unroll
            for (int m = 0; m < 4; ++m) { const int row = row0 + ai * HALF + m * 16; const float s = rs[row_off + row]; bf16_t* rowp = O + (size_t)row * ldc + col0;
#pragma unroll
                for (int bj = 0; bj < 2; ++bj) { const f32x4 v0 = acc[ai][bj][m][0] * s, v1 = acc[ai][bj][m][1] * s;
                    u32x4 w; w.x = pk2(v0[0], v0[1]); w.y = pk2(v0[2], v0[3]); w.z = pk2(v1[0], v1[1]); w.w = pk2(v1[2], v1[3]); *(u32x4*)(rowp + bj * HALF) = w; } }
    }
};
}

__device__ __forceinline__ void transpose_item(const float* W, int ldw, int K, bf16* WT, const float* kscale, LAS float* scr, int item, int nblk, int lane) {
    const int kb = item / nblk, nb = item % nblk, k0 = 64 * kb, n0 = 32 * nb;
#pragma unroll 8
    for (int i = 0; i < 32; ++i) { const int kk = 2 * i + (lane >> 5); const float s = kscale ? kscale[k0 + kk] : 1.0f; scr[kk * 33 + (lane & 31)] = W[(size_t)(k0 + kk) * ldw + n0 + (lane & 31)] * s; }
    asm volatile("s_waitcnt lgkmcnt(0)" ::: "memory");
    const int c = lane & 7;
#pragma unroll
    for (int j = 0; j < 4; ++j) { const int n = (lane >> 3) + 8 * j; const LAS float* s = scr + (8 * c) * 33 + n;
        v4u o; o.x = pk2(s[0 * 33], s[1 * 33]); o.y = pk2(s[2 * 33], s[3 * 33]); o.z = pk2(s[4 * 33], s[5 * 33]); o.w = pk2(s[6 * 33], s[7 * 33]);
        *(v4u*)(WT + (size_t)(n0 + n) * K + k0 + 8 * c) = o; }
    asm volatile("s_waitcnt lgkmcnt(0)" ::: "memory");
}

__device__ __forceinline__ void phase_prep(const Args& a, LAS unsigned char* lds, int tid, int lane, int wave) {
    unsigned char* ws = a.ws;
    LAS float* scr = (LAS float*)(lds + wave * 16384);
    const int gw = blockIdx.x * 8 + wave, NGW = gridDim.x * 8;
    constexpr int I_IN = 16 * 104, I_OUT = 16 * 32, I_UP = 16 * 176, I_DN = 44 * 32;
    for (int it = gw; it < I_IN + I_OUT + I_UP + I_DN; it += NGW) {
        int r = it;
        if (r < I_IN) { transpose_item(a.in[2], NIN, DM, (bf16*)(ws + WS_WT_IN), a.in[1], scr, r, 104, lane); continue; } r -= I_IN;
        if (r < I_OUT) { transpose_item(a.in[19], DM, DM, (bf16*)(ws + WS_WT_OUT), nullptr, scr, r, 32, lane); continue; } r -= I_OUT;
        if (r < I_UP) { transpose_item(a.in[21], NUP, DM, (bf16*)(ws + WS_WT_UP), a.in[20], scr, r, 176, lane); continue; } r -= I_UP;
        transpose_item(a.in[24], DM, DFF, (bf16*)(ws + WS_WT_DN), nullptr, scr, r, 32, lane);
    }
    {
        const float* wd = a.in[5]; const float* wa = a.in[7]; const float* wg = a.in[8]; bf16* WL = (bf16*)(ws + WS_WT_LORA);
        for (int idx = blockIdx.x * 512 + tid; idx < NLORA * KLORA; idx += gridDim.x * 512) {
            const int n = idx >> 8, k = idx & 255; float v = 0.f;
            if (n < 512) { if (k < 64) v = wd[k * 512 + n]; }
            else if (n < 1024) { if (k >= 64 && k < 128) v = wa[(k - 64) * 512 + (n - 512)]; }
            else { if (k >= 128) v = wg[(k - 128) * 512 + (n - 1024)]; }
            WL[idx] = (bf16)f2bf(v);
        }
    }
    {
        const float* x = a.in[0]; const float* g1 = a.in[1]; const float* w_in = a.in[2];
        bf16* XN = (bf16*)(ws + WS_XN); float* gates = (float*)(ws + WS_GATES);
        float wgt[16][8];
#pragma unroll
        for (int j = 0; j < 4; ++j)
#pragma unroll
            for (int e = 0; e < 4; ++e) { const int k = 4 * lane + 256 * j + e; const float g = g1[k];
                const f32x4 w0 = *(const f32x4*)(w_in + (size_t)k * NIN + 3328), w1 = *(const f32x4*)(w_in + (size_t)k * NIN + 3332);
                wgt[j * 4 + e][0] = w0[0] * g; wgt[j * 4 + e][1] = w0[1] * g; wgt[j * 4 + e][2] = w0[2] * g; wgt[j * 4 + e][3] = w0[3] * g;
                wgt[j * 4 + e][4] = w1[0] * g; wgt[j * 4 + e][5] = w1[1] * g; wgt[j * 4 + e][6] = w1[2] * g; wgt[j * 4 + e][7] = w1[3] * g; }
        for (int row = gw; row < M; row += NGW) {
            const f32x4* xr = (const f32x4*)(x + (size_t)row * DM) + lane;
            f32x4 v[4]; float ss = 0.f;
#pragma unroll
            for (int j = 0; j < 4; ++j) { v[j] = xr[64 * j]; ss += (v[j][0] * v[j][0] + v[j][1] * v[j][1]) + (v[j][2] * v[j][2] + v[j][3] * v[j][3]); }
            ss = wave_sum(ss);
            const float rs = rsqrtf(ss * (1.0f / DM) + NORM_EPS);
            unsigned long long* o8 = (unsigned long long*)(XN + (size_t)row * DM) + lane;
#pragma unroll
            for (int j = 0; j < 4; ++j) o8[64 * j] = (unsigned long long)pk2(v[j][0] * rs, v[j][1] * rs) | ((unsigned long long)pk2(v[j][2] * rs, v[j][3] * rs) << 32);
            float gs[8];
#pragma unroll
            for (int jg = 0; jg < 8; ++jg) { float s = 0.f;
#pragma unroll
                for (int j = 0; j < 4; ++j)
#pragma unroll
                    for (int e = 0; e < 4; ++e) s += v[j][e] * wgt[j * 4 + e][jg];
                gs[jg] = wave_sum(s); }
            if (lane < 8) { float s = gs[0];
#pragma unroll
                for (int jg = 1; jg < 8; ++jg) s = (lane == jg) ? gs[jg] : s;
                gates[(size_t)row * 8 + lane] = s * rs; }
        }
    }
}

__device__ __forceinline__ void phase_lmat(const Args& a, int tid) {
    unsigned char* ws = a.ws; const bf16* PROJ = (const bf16*)(ws + WS_PROJ); bf16* L = (bf16*)(ws + WS_LBUF); const float* mu = a.in[3];
    const int NT = gridDim.x * 512;
    for (int it = blockIdx.x * 512 + tid; it < M * 32; it += NT) {
        const int row = it >> 5, grp = it & 31, c0 = 1536 + 8 * grp;
        const v4u cur = *(const v4u*)(PROJ + (size_t)row * NPROJ + c0);
        v4u prv = {0u, 0u, 0u, 0u}; if ((row & (SEQ - 1)) != 0) prv = *(const v4u*)(PROJ + (size_t)(row - 1) * NPROJ + c0);
        const f32x4 m0 = *(const f32x4*)(mu + c0), m1 = *(const f32x4*)(mu + c0 + 4);
        float c[8], p[8], o[8]; unpack8(cur, c); unpack8(prv, p);
#pragma unroll
        for (int e = 0; e < 8; ++e) { const float mm = e < 4 ? m0[e & 3] : m1[e & 3]; const float xv = c[e] + (p[e] - c[e]) * mm;
            o[e] = grp < 8 ? tanhf_(xv) : (grp < 16 ? xv : sigmoidf_(xv)); }
        *(v4u*)(L + (size_t)row * KLORA + 8 * grp) = pack8(o);
    }
}

__device__ __forceinline__ void rwkv_unit(const Args& a, LAS unsigned char* lds, int unit, int tid) {
    unsigned char* ws = a.ws; const bf16* PROJ = (const bf16*)(ws + WS_PROJ); const bf16* DAG = (const bf16*)(ws + WS_DAG); bf16* MIX = (bf16*)(ws + WS_MIX);
    const float* mu = a.in[3]; const float* k_k = a.in[9]; const float* k_a = a.in[10]; const float* r_k = a.in[11]; const float* lnx_w = a.in[12]; const float* lnx_b = a.in[13]; const float* w0p = a.in[4]; const float* a0p = a.in[6];
    const int b = unit >> 3, h = unit & 7;
    LAS float* Ra = (LAS float*)lds; LAS float* Wa = Ra + 4096; LAS float* Ka = Wa + 4096; LAS float* Va = Ka + 4096; LAS float* Aa = Va + 4096; LAS float* Ba = Aa + 4096; LAS float* Ya = Ba + 4096; LAS float* bon = Ya + 4096;
    const int cg = tid & 15, rp = tid >> 4;
    const int tt_s = tid >> 3, c8 = tid & 7, j0 = h * 64 + 8 * c8;
    float S0[4] = {0.f, 0.f, 0.f, 0.f}, S1[4] = {0.f, 0.f, 0.f, 0.f};
    for (int blk = 0; blk < SEQ / 64; ++blk) {
        const int t0 = b * SEQ + blk * 64;
        {
            const int t = t0 + tt_s; const bf16* pr = PROJ + (size_t)t * NPROJ;
            const bool first = (blk == 0 && tt_s == 0);
            float rc[8], kc[8], vc[8], rp_[8], kp[8], vp[8], av[8], ldv[8];
            unpack8(*(const v4u*)(pr + j0), rc); unpack8(*(const v4u*)(pr + 512 + j0), kc); unpack8(*(const v4u*)(pr + 1024 + j0), vc);
            if (!first) { unpack8(*(const v4u*)(pr - NPROJ + j0), rp_); unpack8(*(const v4u*)(pr - NPROJ + 512 + j0), kp); unpack8(*(const v4u*)(pr - NPROJ + 1024 + j0), vp); }
            else {
#pragma unroll
                for (int e = 0; e < 8; ++e) { rp_[e] = 0.f; kp[e] = 0.f; vp[e] = 0.f; } }
            unpack8(*(const v4u*)(DAG + (size_t)t * NLORA + j0), ldv); unpack8(*(const v4u*)(DAG + (size_t)t * NLORA + 512 + j0), av);
            float ss = 0.f, bonus = 0.f, kkr[8], rr[8], km[8], vv[8];
#pragma unroll
            for (int e = 0; e < 8; ++e) {
                const float r = rc[e] + (rp_[e] - rc[e]) * mu[j0 + e];
                const float k = kc[e] + (kp[e] - kc[e]) * mu[512 + j0 + e];
                const float v = vc[e] + (vp[e] - vc[e]) * mu[1024 + j0 + e];
                kkr[e] = k * k_k[j0 + e]; ss += kkr[e] * kkr[e];
                av[e] = sigmoidf_(a0p[j0 + e] + av[e]);
                ldv[e] = __expf(-0.6065306597f * sigmoidf_(w0p[j0 + e] + ldv[e]));
                km[e] = k * (1.0f + (av[e] - 1.0f) * k_a[j0 + e]);
                bonus += r * km[e] * r_k[j0 + e];
                rr[e] = r; vv[e] = v;
            }
            ss = red8(ss); bonus = red8(bonus);
            const float inv = 1.0f / fmaxf(sqrtf(ss), 1e-12f);
            const int o = tt_s * 64 + 8 * c8;
#pragma unroll
            for (int e = 0; e < 8; ++e) { const float kk = kkr[e] * inv;
                Ra[o + e] = rr[e]; Wa[o + e] = ldv[e]; Ka[o + e] = km[e]; Va[o + e] = vv[e]; Aa[o + e] = -kk; Ba[o + e] = kk * av[e]; }
            if (c8 == 0) bon[tt_s] = bonus;
        }
        __syncthreads();
#pragma unroll 2
        for (int tt = 0; tt < 64; ++tt) {
            const f32x4 a4 = *(const LAS f32x4*)(Aa + tt * 64 + 4 * cg), w4 = *(const LAS f32x4*)(Wa + tt * 64 + 4 * cg), b4 = *(const LAS f32x4*)(Ba + tt * 64 + 4 * cg);
            const f32x4 k4 = *(const LAS f32x4*)(Ka + tt * 64 + 4 * cg), r4 = *(const LAS f32x4*)(Ra + tt * 64 + 4 * cg);
            const f32x2 v2 = *(const LAS f32x2*)(Va + tt * 64 + 2 * rp);
            float sa0 = (S0[0] * a4[0] + S0[1] * a4[1]) + (S0[2] * a4[2] + S0[3] * a4[3]);
            float sa1 = (S1[0] * a4[0] + S1[1] * a4[1]) + (S1[2] * a4[2] + S1[3] * a4[3]);
            sa0 = red16(sa0); sa1 = red16(sa1);
#pragma unroll
            for (int c = 0; c < 4; ++c) { S0[c] = S0[c] * w4[c] + (sa0 * b4[c] + v2[0] * k4[c]); S1[c] = S1[c] * w4[c] + (sa1 * b4[c] + v2[1] * k4[c]); }
            float y0 = (S0[0] * r4[0] + S0[1] * r4[1]) + (S0[2] * r4[2] + S0[3] * r4[3]);
            float y1 = (S1[0] * r4[0] + S1[1] * r4[1]) + (S1[2] * r4[2] + S1[3] * r4[3]);
            y0 = red16(y0); y1 = red16(y1);
            if (cg == 0) *(LAS f32x2*)(Ya + tt * 64 + 2 * rp) = (f32x2){y0, y1};
        }
        __syncthreads();
        {
            const int t = t0 + tt_s; const int o = tt_s * 64 + 8 * c8;
            float y[8], gv[8]; float s1 = 0.f;
#pragma unroll
            for (int e = 0; e < 8; ++e) { y[e] = Ya[o + e]; s1 += y[e]; }
            s1 = red8(s1); const float mean = s1 * (1.0f / 64.0f); float s2 = 0.f;
#pragma unroll
            for (int e = 0; e < 8; ++e) { const float d = y[e] - mean; s2 += d * d; }
            s2 = red8(s2); const float rstd = rsqrtf(s2 * (1.0f / 64.0f) + LNX_EPS);
            unpack8(*(const v4u*)(DAG + (size_t)t * NLORA + 1024 + j0), gv);
            const float bonus = bon[tt_s]; float ov[8];
#pragma unroll
            for (int e = 0; e < 8; ++e) { const float yn = (y[e] - mean) * rstd * lnx_w[j0 + e] + lnx_b[j0 + e]; ov[e] = (yn + bonus * Va[o + e]) * gv[e]; }
            *(v4u*)(MIX + (size_t)t * DM + j0) = pack8(ov);
        }
        __syncthreads();
    }
}

__device__ __forceinline__ f32x4 mfma16(const bf16x8 a, const bf16x8 b, const f32x4 c) { return __builtin_amdgcn_mfma_f32_16x16x32_bf16(a, b, c, 0, 0, 0); }
__device__ __forceinline__ void mlstm_unit(const Args& a, LAS unsigned char* lds, int unit, int tid, int lane, int wave) {
    unsigned char* ws = a.ws; const bf16* PROJ = (const bf16*)(ws + WS_PROJ); const float* gates = (const float*)(ws + WS_GATES); bf16* MIX = (bf16*)(ws + WS_MIX);
    const float* cw = a.in[14]; const float* cbias = a.in[15]; const float* i_bias = a.in[16]; const float* f_bias = a.in[17]; const float* mhg = a.in[18];
    const int b = unit >> 2, hm = unit & 3;
    constexpr int LD = 72;
    LAS bf16* Ql = (LAS bf16*)lds; LAS bf16* Kl = Ql + 64 * LD; LAS bf16* Kwt = Kl + 64 * LD; LAS bf16* Vt = Kwt + 64 * LD; LAS bf16* Sm = Vt + 128 * LD; LAS bf16* Ct = Sm + 64 * LD;
    LAS float* Hl = (LAS float*)(Ct + 128 * LD);
    LAS float* e_s = Hl + 64 * 132; LAS float* Mx = e_s + 64; LAS float* sc = Mx + 64; LAS float* em = sc + 64; LAS float* wsv = em + 64; LAS float* den = wsv + 64; LAS float* nvec = den + 64; LAS float* scal = nvec + 64;
    for (int i = tid; i < 128 * LD / 2; i += 512) ((LAS unsigned*)Ct)[i] = 0u;
    if (tid < 64) nvec[tid] = 0.f;
    if (tid == 0) { scal[0] = 1.f; scal[1] = 0.f; }
    f32x4 cacc[4];
#pragma unroll
    for (int i = 0; i < 4; ++i) cacc[i] = (f32x4){0.f, 0.f, 0.f, 0.f};
    const int l15 = lane & 15, l4 = lane >> 4;
    const int tt = tid >> 3, p8 = tid & 7;
    __syncthreads();
    for (int c = 0; c < SEQ / 64; ++c) {
        const int t0 = b * SEQ + c * 64;
        if (wave == 0) {
            const int t = t0 + lane;
            const float gi = gates[(size_t)t * 8 + hm] + i_bias[hm], gf = gates[(size_t)t * 8 + 4 + hm] + f_bias[hm];
            const float ig = 15.0f * tanhf_(gi * (1.0f / 15.0f)), fx = 15.0f * tanhf_(gf * (1.0f / 15.0f));
            const float logf = -softplusf_(-fx);
            float bc = logf;
#pragma unroll
            for (int o = 1; o < 64; o <<= 1) { const float t_ = __shfl_up(bc, o); if (lane >= o) bc += t_; }
            const float e = ig - bc; float P = e;
#pragma unroll
            for (int o = 1; o < 64; o <<= 1) { const float t_ = __shfl_up(P, o); if (lane >= o) P = fmaxf(P, t_); }
            const float m = scal[1];
            const float mx = fmaxf(P, m); const float mxL = __shfl(mx, 63), bL = __shfl(bc, 63);
            e_s[lane] = e; Mx[lane] = mx; sc[lane] = __expf(m - mx); em[lane] = __expf(-(bc + mx)); wsv[lane] = __expf(e - mxL);
            if (lane == 0) { scal[0] = __expf(m - mxL); scal[1] = bL + mxL; }
        }
        __syncthreads();
        {
            const int t = t0 + tt, tpos = c * 64 + tt, d0 = 8 * p8, cq = hm * 64 + d0, ck = 256 + hm * 64 + d0;
            float aq[8], ak[8];
#pragma unroll
            for (int e = 0; e < 8; ++e) { aq[e] = cbias[cq + e]; ak[e] = cbias[ck + e]; }
#pragma unroll
            for (int j = 0; j < 4; ++j) { if (tpos - 3 + j >= 0) { const bf16* pr = PROJ + (size_t)(t - 3 + j) * NPROJ; float pq[8], pk[8];
                    unpack8(*(const v4u*)(pr + C_Q + hm * 64 + d0), pq); unpack8(*(const v4u*)(pr + C_K + hm * 64 + d0), pk);
#pragma unroll
                    for (int e = 0; e < 8; ++e) { aq[e] += cw[j * 512 + cq + e] * pq[e]; ak[e] += cw[j * 512 + ck + e] * pk[e]; } } }
            const float w = wsv[tt];
#pragma unroll
            for (int e = 0; e < 8; ++e) { aq[e] = aq[e] * sigmoidf_(aq[e]) * 0.125f; ak[e] = ak[e] * sigmoidf_(ak[e]); }
            *(LAS v4u*)(Ql + tt * LD + d0) = pack8(aq); *(LAS v4u*)(Kl + tt * LD + d0) = pack8(ak);
#pragma unroll
            for (int e = 0; e < 8; ++e) Kwt[(d0 + e) * LD + tt] = (bf16)f2bf(w * ak[e]);
            const bf16* pv = PROJ + (size_t)t * NPROJ + C_V + hm * 128 + 16 * p8;
            const v4u va = *(const v4u*)pv, vb = *(const v4u*)(pv + 8);
            const unsigned wv[8] = {va.x, va.y, va.z, va.w, vb.x, vb.y, vb.z, vb.w};
#pragma unroll
            for (int e = 0; e < 8; ++e) { Vt[(16 * p8 + 2 * e) * LD + tt] = (bf16)(wv[e] & 0xffffu); Vt[(16 * p8 + 2 * e + 1) * LD + tt] = (bf16)(wv[e] >> 16); }
        }
        __syncthreads();
        {
            const int rb = wave >> 1;
#pragma unroll
            for (int ci = 0; ci < 2; ++ci) { const int cb = 2 * (wave & 1) + ci; f32x4 acc = {0.f, 0.f, 0.f, 0.f};
#pragma unroll
                for (int kk = 0; kk < 2; ++kk) { const bf16x8 A = *(const LAS bf16x8*)(Ql + (16 * rb + l15) * LD + 32 * kk + 8 * l4), B = *(const LAS bf16x8*)(Kl + (16 * cb + l15) * LD + 32 * kk + 8 * l4); acc = mfma16(A, B, acc); }
                const int s = 16 * cb + l15; const float es = e_s[s];
#pragma unroll
                for (int r = 0; r < 4; ++r) { const int t = 16 * rb + 4 * l4 + r; const float v = (s <= t) ? acc[r] * __expf(es - Mx[t]) : 0.f; Sm[t * LD + s] = (bf16)f2bf(v); } }
        }
        __syncthreads();
        f32x4 num[4];
        {
            float part = 0.f, qn = 0.f; float sv[8], qv[8];
            unpack8(*(const LAS v4u*)(Sm + tt * LD + 8 * p8), sv); unpack8(*(const LAS v4u*)(Ql + tt * LD + 8 * p8), qv);
#pragma unroll
            for (int e = 0; e < 8; ++e) { part += sv[e]; qn += qv[e] * nvec[8 * p8 + e]; }
            float tot = part + sc[tt] * qn; tot = red8(tot);
            if (p8 == 0) den[tt] = tot;
            const int rb = wave >> 1;
            bf16x8 As[2], Aq[2];
#pragma unroll
            for (int kk = 0; kk < 2; ++kk) { As[kk] = *(const LAS bf16x8*)(Sm + (16 * rb + l15) * LD + 32 * kk + 8 * l4); Aq[kk] = *(const LAS bf16x8*)(Ql + (16 * rb + l15) * LD + 32 * kk + 8 * l4); }
            float scr_[4];
#pragma unroll
            for (int r = 0; r < 4; ++r) scr_[r] = sc[16 * rb + 4 * l4 + r];
#pragma unroll
            for (int vi = 0; vi < 4; ++vi) { const int vb = 4 * (wave & 1) + vi; f32x4 a1 = {0.f, 0.f, 0.f, 0.f}, a2 = {0.f, 0.f, 0.f, 0.f};
#pragma unroll
                for (int kk = 0; kk < 2; ++kk) { const bf16x8 B1 = *(const LAS bf16x8*)(Vt + (16 * vb + l15) * LD + 32 * kk + 8 * l4), B2 = *(const LAS bf16x8*)(Ct + (16 * vb + l15) * LD + 32 * kk + 8 * l4);
                    a1 = mfma16(As[kk], B1, a1); a2 = mfma16(Aq[kk], B2, a2); }
#pragma unroll
                for (int r = 0; r < 4; ++r) num[vi][r] = a1[r] + scr_[r] * a2[r]; }
        }
        __syncthreads();
        {
            const int rb = wave >> 1;
#pragma unroll
            for (int r = 0; r < 4; ++r) { const int t = 16 * rb + 4 * l4 + r; const float dn = 1.0f / fmaxf(fabsf(den[t]), em[t]);
#pragma unroll
                for (int vi = 0; vi < 4; ++vi) Hl[t * 132 + 16 * (4 * (wave & 1) + vi) + l15] = num[vi][r] * dn; }
            const float dec = scal[0];
            bf16x8 Av[2];
#pragma unroll
            for (int kk = 0; kk < 2; ++kk) Av[kk] = *(const LAS bf16x8*)(Vt + (16 * wave + l15) * LD + 32 * kk + 8 * l4);
#pragma unroll
            for (int db = 0; db < 4; ++db) { cacc[db] = cacc[db] * dec;
#pragma unroll
                for (int kk = 0; kk < 2; ++kk) { const bf16x8 B = *(const LAS bf16x8*)(Kwt + (16 * db + l15) * LD + 32 * kk + 8 * l4); cacc[db] = mfma16(Av[kk], B, cacc[db]); }
#pragma unroll
                for (int r = 0; r < 4; ++r) Ct[(16 * wave + 4 * l4 + r) * LD + 16 * db + l15] = (bf16)f2bf(cacc[db][r]); }
            float kv[8]; unpack8(*(const LAS v4u*)(Kwt + tt * LD + 8 * p8), kv); float s = 0.f;
#pragma unroll
            for (int e = 0; e < 8; ++e) s += kv[e];
            s = red8(s);
            if (p8 == 0) nvec[tt] = dec * nvec[tt] + s;
        }
        __syncthreads();
        {
            const int t = t0 + tt, v0 = 16 * p8; float hv[16]; float ss = 0.f;
#pragma unroll
            for (int q = 0; q < 4; ++q) { const f32x4 x = *(const LAS f32x4*)(Hl + tt * 132 + v0 + 4 * q); hv[4 * q] = x[0]; hv[4 * q + 1] = x[1]; hv[4 * q + 2] = x[2]; hv[4 * q + 3] = x[3]; ss += (x[0] * x[0] + x[1] * x[1]) + (x[2] * x[2] + x[3] * x[3]); }
            ss = red8(ss); const float rn = rsqrtf(ss * (1.0f / 128.0f) + NORM_EPS);
            const bf16* po = PROJ + (size_t)t * NPROJ + C_O + hm * 128 + v0; float o0[8], o1[8]; unpack8(*(const v4u*)po, o0); unpack8(*(const v4u*)(po + 8), o1);
            float r0[8], r1[8];
#pragma unroll
            for (int e = 0; e < 8; ++e) { r0[e] = hv[e] * rn * mhg[hm * 128 + v0 + e] * sigmoidf_(o0[e]); r1[e] = hv[8 + e] * rn * mhg[hm * 128 + v0 + 8 + e] * sigmoidf_(o1[e]); }
            bf16* dst = MIX + (size_t)t * DM + 512 + hm * 128 + v0; *(v4u*)dst = pack8(r0); *(v4u*)(dst + 8) = pack8(r1);
        }
        __syncthreads();
    }
}

__device__ __forceinline__ void phase_conv(const Args& a, int half, int tid) {
    unsigned char* ws = a.ws; const bf16* UH = (const bf16*)(ws + WS_UH); bf16* GB = (bf16*)(ws + WS_GB); const float* cw = a.in[22]; const float* cb = a.in[23];
    const int NT = gridDim.x * 512;
    for (int it = blockIdx.x * 512 + tid; it < MH * (DFF / 8); it += NT) {
        const int rl = it / (DFF / 8), grp = it % (DFF / 8), f0 = 8 * grp, row = half * MH + rl, tpos = row & (SEQ - 1);
        const bf16* ur = UH + (size_t)rl * NUP + f0;
        float a0[8], a1[8], a2[8], bv[8];
        unpack8(*(const v4u*)ur, a0); unpack8(*(const v4u*)(ur + DFF), bv);
        if (tpos >= 1) unpack8(*(const v4u*)(ur - NUP), a1); else {
#pragma unroll
            for (int e = 0; e < 8; ++e) a1[e] = 0.f; }
        if (tpos >= 2) unpack8(*(const v4u*)(ur - 2 * NUP), a2); else {
#pragma unroll
            for (int e = 0; e < 8; ++e) a2[e] = 0.f; }
        float o[8];
#pragma unroll
        for (int e = 0; e < 8; ++e) { const float z = cb[f0 + e] + cw[f0 + e] * a2[e] + cw[DFF + f0 + e] * a1[e] + cw[2 * DFF + f0 + e] * a0[e]; o[e] = z * sigmoidf_(z) * bv[e]; }
        *(v4u*)(GB + (size_t)row * DFF + f0) = pack8(o);
    }
}

constexpr int N_PHASES = 11;
__global__ void __launch_bounds__(512, 2) mega(Args args) {
    extern __shared__ __attribute__((aligned(16))) unsigned char lds_raw[];
    LAS unsigned char* lds = (LAS unsigned char*)lds_raw;
    const int tid0 = threadIdx.x;
    unsigned char* ws = args.ws;
#define PHASE_IDS int tid = tid0; asm volatile("" : "+v"(tid)); const int lane = tid & 63, wave = __builtin_amdgcn_readfirstlane(tid >> 6); (void)lane; (void)wave
    volatile LAS unsigned* MISC = (volatile LAS unsigned*)(lds + MISC_OFF);
    { PHASE_IDS; for (int u = tid; u < (LDS_BYTES - 131072) / 4; u += 512) ((LAS unsigned*)(lds + 131072))[u] = 0u; }
    __syncthreads();
    XcdBarrier bar; bar.bar = (unsigned*)(ws + WS_CTL) + 4096; bar.x = 0; bar.st = nullptr;
    if (MK_SINGLE) bar = xcd_barrier_post((unsigned*)(ws + WS_CTL) + 4096, MISC + 8);
    const int lo = args.ph_lo, hi = args.ph_hi;
#ifndef PH_MASK
#define PH_MASK 0xFFFF
#endif
#define IN(k) ((((PH_MASK) >> (k)) & 1) && lo <= (k) && (k) < hi)
#define SEAM(k) do { if (IN(k) && IN((k) + 1)) xcd_barrier(bar); } while (0)

    if (IN(0)) { PHASE_IDS; phase_prep(args, lds, tid, lane, wave); } SEAM(0);
    if (IN(1)) {
        pg8::Gemm g{(const bf16*)(ws + WS_XN), (const bf16*)(ws + WS_WT_IN), M, NPROJ, DM}; pg8::StaticOrder S; S.init(M, NPROJ, gridDim.x, (int)blockIdx.x);
        pg8::EpiBf16<0> E{(bf16*)(ws + WS_PROJ), NPROJ, nullptr, 0, 0, 1.f};
        pg8::gemm_phase<pg8::EpiBf16<0>, pg8::StaticOrder, true, true>(lds, g, S, E);
    } SEAM(1);
    if (IN(2)) { PHASE_IDS; phase_lmat(args, tid); } SEAM(2);
    if (IN(3)) {
        pg8::Gemm g{(const bf16*)(ws + WS_LBUF), (const bf16*)(ws + WS_WT_LORA), M, NLORA, KLORA}; pg8::StaticOrder S; S.init(M, NLORA, gridDim.x, (int)blockIdx.x);
        pg8::EpiBf16<0> E{(bf16*)(ws + WS_DAG), NLORA, nullptr, 0, 0, 1.f};
        pg8::gemm_phase<pg8::EpiBf16<0>, pg8::StaticOrder, true, true>(lds, g, S, E);
    } SEAM(3);
    if (IN(4)) {
        PHASE_IDS;
        for (int u = blockIdx.x; u < BATCH * 8; u += gridDim.x) rwkv_unit(args, lds, u, tid);
        __syncthreads();
        for (int u = blockIdx.x; u < BATCH * 4; u += gridDim.x) mlstm_unit(args, lds, u, tid, lane, wave);
    } SEAM(4);
    if (IN(5)) {
        pg8::Gemm g{(const bf16*)(ws + WS_MIX), (const bf16*)(ws + WS_WT_OUT), M, DM, DM}; pg8::PanelOrder S{(int)blockIdx.x};
        pg8::EpiResid E{args.in[0], args.out, (bf16*)(ws + WS_XN), (float*)(ws + WS_SSQP)};
        pg8::gemm_phase<pg8::EpiResid, pg8::PanelOrder, true, true>(lds, g, S, E);
        __syncthreads();
        PHASE_IDS;
        if (tid < 256) { const int row = blockIdx.x * 256 + tid; const f32x4* p = (const f32x4*)((const float*)(ws + WS_SSQP) + (size_t)row * 16);
            const f32x4 s0 = p[0], s1 = p[1], s2 = p[2], s3 = p[3];
            const float ss = ((s0[0] + s0[1]) + (s0[2] + s0[3])) + ((s1[0] + s1[1]) + (s1[2] + s1[3])) + ((s2[0] + s2[1]) + (s2[2] + s2[3])) + ((s3[0] + s3[1]) + (s3[2] + s3[3]));
            ((float*)(ws + WS_RS2))[row] = rsqrtf(ss * (1.0f / DM) + NORM_EPS); }
    } SEAM(5);
#pragma unroll 1
    for (int half = 0; half < 2; ++half) {
        if (IN(6 + 2 * half)) {
            pg8::Gemm g{(const bf16*)(ws + WS_XN) + (size_t)half * MH * DM, (const bf16*)(ws + WS_WT_UP), MH, NUP, DM}; pg8::StaticOrder S; S.init(MH, NUP, gridDim.x, (int)blockIdx.x);
            pg8::EpiScale E{(bf16*)(ws + WS_UH), NUP, (const float*)(ws + WS_RS2), half * MH};
            pg8::gemm_phase<pg8::EpiScale, pg8::StaticOrder, true, true>(lds, g, S, E);
        } SEAM(6 + 2 * half);
        if (IN(7 + 2 * half)) { PHASE_IDS; phase_conv(args, half, tid); } SEAM(7 + 2 * half);
    }
    if (IN(10)) {
        pg8::Gemm g{(const bf16*)(ws + WS_GB), (const bf16*)(ws + WS_WT_DN), M, DM, DFF}; pg8::PanelOrder S{(int)blockIdx.x};
        pg8::EpiResid E{args.out, args.out, nullptr, (float*)(ws + WS_SSQP)};
        pg8::gemm_phase<pg8::EpiResid, pg8::PanelOrder, true, true>(lds, g, S, E);
        __builtin_amdgcn_fence(__ATOMIC_ACQUIRE, "agent");
        asm volatile("s_waitcnt vmcnt(0)" ::: "memory");
        __syncthreads();
        PHASE_IDS;
        LAS float* rsl = (LAS float*)lds;
        if (tid < 256) { const int row = blockIdx.x * 256 + tid; const f32x4* p = (const f32x4*)((const float*)(ws + WS_SSQP) + (size_t)row * 16);
            const f32x4 s0 = p[0], s1 = p[1], s2 = p[2], s3 = p[3];
            const float ss = ((s0[0] + s0[1]) + (s0[2] + s0[3])) + ((s1[0] + s1[1]) + (s1[2] + s1[3])) + ((s2[0] + s2[1]) + (s2[2] + s2[3])) + ((s3[0] + s3[1]) + (s3[2] + s3[3]));
            rsl[tid] = rsqrtf(ss * (1.0f / DM) + NORM_EPS); }
        __syncthreads();
        const float* gf = args.in[25];
        f32x4 gv[4];
#pragma unroll
        for (int j = 0; j < 4; ++j) gv[j] = *((const f32x4*)gf + lane + 64 * j);
        for (int r = wave; r < 256; r += 8) { const float rs = rsl[r]; f32x4* xr = (f32x4*)(args.out + (size_t)(blockIdx.x * 256 + r) * DM) + lane;
#pragma unroll
            for (int j = 0; j < 4; ++j) { const f32x4 v = xr[64 * j]; xr[64 * j] = v * rs * gv[j]; } }
    }
#undef IN
#undef SEAM
}

extern "C" void kernel_launch(void* const* d_in, const int* in_sizes, int n_in, void* d_out, int out_size, void* d_ws, size_t ws_size, hipStream_t stream) {
    static int grid = 0;
    if (grid == 0) {
        if (n_in != 26 || in_sizes[0] != M * DM || out_size != M * DM || ws_size < WS_END) { fprintf(stderr, "kernel_launch: unexpected shapes (n_in %d, in0 %d, out %d, ws %zu)\n", n_in, n_in > 0 ? in_sizes[0] : -1, out_size, ws_size); grid = -1; return; }
        int dev = 0, cus = 0, per_cu = 0;
        if (hipGetDevice(&dev) != hipSuccess || hipDeviceGetAttribute(&cus, hipDeviceAttributeMultiprocessorCount, dev) != hipSuccess) { grid = -1; return; }
        if (hipFuncSetAttribute((const void*)mega, hipFuncAttributeMaxDynamicSharedMemorySize, LDS_BYTES) != hipSuccess) { fprintf(stderr, "kernel_launch: hipFuncSetAttribute failed\n"); grid = -1; return; }
        if (hipOccupancyMaxActiveBlocksPerMultiprocessor(&per_cu, (const void*)mega, 512, LDS_BYTES) != hipSuccess || per_cu < 1) { fprintf(stderr, "kernel_launch: occupancy query says %d blocks per CU\n", per_cu); }
        (void)hipGetLastError();
        grid = cus;
        if (grid != 256) fprintf(stderr, "kernel_launch: %d CUs; this kernel is laid out for 256\n", grid);
    }
    if (grid < 0) return;
    (void)hipMemsetAsync((char*)d_ws + WS_CTL, 0, CTL_ZERO_BYTES, stream);
    Args a{};
    for (int i = 0; i < 26; ++i) a.in[i] = (const float*)d_in[i];
    a.out = (float*)d_out; a.ws = (unsigned char*)d_ws;
#if MK_SINGLE
    a.ph_lo = 0; a.ph_hi = N_PHASES;
    hipLaunchKernelGGL(mega, dim3(grid), dim3(512), LDS_BYTES, stream, a);
#else
    for (int p = 0; p < N_PHASES; ++p) { a.ph_lo = p; a.ph_hi = p + 1; hipLaunchKernelGGL(mega, dim3(grid), dim3(512), LDS_BYTES, stream, a); }
#endif
}
```

```cpp
#include <hip/hip_runtime.h>
#include <cstdio>
#include <cstdint>
namespace pg8 {
#define PG8_LAS __attribute__((address_space(3)))
typedef unsigned short bf16_t;
typedef short bf16x8 __attribute__((ext_vector_type(8)));
typedef float f32x4 __attribute__((ext_vector_type(4)));
typedef unsigned u32x4 __attribute__((ext_vector_type(4)));
constexpr int BM = 256, BK = 64, HALF = 128, HTB = HALF * BK * 2  , STAGE_BYTES = 8 * HTB, NXCD = 8, WGM = 8;

__host__ __device__ __forceinline__ int lds_byte(int r, int c) { const int st = (r >> 4) * 2 + (c >> 5), rr = r & 15, cc = c & 31, ob = rr * 64 + cc * 2; return st * 1024 + (ob ^ (((ob >> 9) & 1) << 5)); }
__host__ __device__ __forceinline__ void stage_rc(int b, int& R, int& C) { const int st = b / 1024, sb = b % 1024, swz = sb ^ (((sb >> 9) & 1) << 5); R = (st >> 1) * 16 + swz / 64; C = (st & 1) * 32 + (swz % 64) / 2; }
__host__ __device__ __forceinline__ int perm32(int rho) { const int n = rho >> 4, i = rho & 15; return 8 * (i >> 2) + 4 * n + (i & 3); }

struct Unit { int pm, pn; };
struct Gemm { const bf16_t* A; const bf16_t* Bt; int M, N, K; };

struct StaticOrder {
    int nM, nN, nwg, G, c;
    __host__ __device__ void init(int M, int N, int G_, int c_) { nM = M / BM; nN = N / BM; nwg = nM * nN; G = G_; c = c_; }
    __host__ __device__ bool next(int i, Unit& u) const {
        const long L = (long)i * G + c; if (L >= nwg) return false;
        int wgid = (int)L; { const int q = nwg / NXCD, r = nwg % NXCD, xcd = wgid % NXCD, off = wgid / NXCD; wgid = (xcd < r ? xcd * (q + 1) : r * (q + 1) + (xcd - r) * q) + off; }
        const int nig = WGM * nN, gid = wgid / nig, fm = gid * WGM, gsz = (nM - fm) < WGM ? (nM - fm) : WGM;
        u.pm = fm + ((wgid % nig) % gsz); u.pn = (wgid % nig) / gsz; return true;
    }
    __device__ __forceinline__ void a_ready(const Unit&) const {}
    __device__ __forceinline__ void done(const Unit&) const {}
};

__device__ __forceinline__ unsigned cvt_pk_bf16(float lo, float hi) { unsigned r; asm volatile("v_cvt_pk_bf16_f32 %0, %1, %2" : "=v"(r) : "v"(lo), "v"(hi)); return r; }
typedef float f32x2 __attribute__((ext_vector_type(2)));
__device__ __forceinline__ f32x2 gelu_pk(f32x2 v) {
    const f32x2 av = __builtin_elementwise_abs(v), d = av * 0.2316418882f + 1.0f;
    f32x2 t; t.x = __builtin_amdgcn_rcpf(d.x); t.y = __builtin_amdgcn_rcpf(d.y);
    f32x2 q = t * 0.5307027145f + (-0.7265760135f); q = q * t + 0.7107068705f; q = q * t + (-0.142248368f); q = q * t + 0.127414796f; q = q * t;
    const f32x2 s = (v * v) * (-0.72134752044f);
    f32x2 e; e.x = __builtin_amdgcn_exp2f(s.x); e.y = __builtin_amdgcn_exp2f(s.y);
    const f32x2 m = v * (q * e), r = v - m;
    f32x2 o; o.x = v.x < 0.f ? m.x : r.x; o.y = v.y < 0.f ? m.y : r.y; return o;
}

template <int ACT  > struct EpiBf16 {
    static constexpr bool PERM = true, AFTER_DRAIN = false; static_assert(ACT == 0 || ACT == 1, "EpiBf16: ACT is 0 (none) or 1 (gelu_pk)");
    bf16_t* O; int ldc; const float* bias; int split_cols; size_t split_stride; float scale0;
    __device__ __forceinline__ void operator()(const f32x4 (&acc)[2][2][4][2], const Unit& u, int wr, int wc, int fr, int fq) const {
        const int row0 = u.pm * BM + wr * 64 + fr; int colt = u.pn * BM; bf16_t* base = O;
        float sc = 1.f; if (split_cols) { const int t = colt / split_cols; base += (size_t)t * split_stride; colt -= t * split_cols; if (t == 0) sc = scale0; }
        const int col0 = colt + wc * 32 + 8 * fq, bcol0 = u.pn * BM + wc * 32 + 8 * fq;
        f32x4 bv[2][2];
#pragma unroll
        for (int bj = 0; bj < 2; ++bj)
#pragma unroll
            for (int n = 0; n < 2; ++n) bv[bj][n] = bias ? *(const f32x4*)(bias + bcol0 + bj * HALF + 4 * n) : (f32x4){0.f, 0.f, 0.f, 0.f};
#pragma unroll
        for (int ai = 0; ai < 2; ++ai)
#pragma unroll
            for (int m = 0; m < 4; ++m) { bf16_t* rowp = base + (size_t)(row0 + ai * HALF + m * 16) * ldc + col0;
#pragma unroll
                for (int bj = 0; bj < 2; ++bj) { f32x4 v0 = acc[ai][bj][m][0] + bv[bj][0], v1 = acc[ai][bj][m][1] + bv[bj][1];
                    if (ACT == 1) { f32x2 a = gelu_pk((f32x2){v0[0], v0[1]}), b = gelu_pk((f32x2){v0[2], v0[3]}), c = gelu_pk((f32x2){v1[0], v1[1]}), d = gelu_pk((f32x2){v1[2], v1[3]});
                        v0 = (f32x4){a.x, a.y, b.x, b.y}; v1 = (f32x4){c.x, c.y, d.x, d.y}; }
                    v0 = v0 * sc; v1 = v1 * sc; u32x4 w; w.x = cvt_pk_bf16(v0[0], v0[1]); w.y = cvt_pk_bf16(v0[2], v0[3]); w.z = cvt_pk_bf16(v1[0], v1[1]); w.w = cvt_pk_bf16(v1[2], v1[3]);
                    *(u32x4*)(rowp + bj * HALF) = w; } }
    }
};
template <class Epi, class Sched, bool ALIGN_EPI = false, bool SP2 = false>
__device__ __forceinline__ void gemm_phase(PG8_LAS unsigned char* lds, const Gemm g, const Sched& S, const Epi& E) {
    const int tid = threadIdx.x, wid = __builtin_amdgcn_readfirstlane(tid >> 6), lane = tid & 63, wr = wid >> 2, wc = wid & 3, fr = lane & 15, fq = lane >> 4;
    const int K = g.K, nt = K / BK;
    unsigned voffA[2], voffB[2];
#pragma unroll
    for (int i = 0; i < 2; ++i) { int R, C; stage_rc(tid * 16 + i * 8192, R, C); const int Rb = Epi::PERM ? ((R & ~31) + perm32(R & 31)) : R;
        voffA[i] = (unsigned)(R * K + C) * 2u; voffB[i] = (unsigned)(Rb * K + C) * 2u; }
    const size_t kstep = (size_t)(BK * 2);
    const size_t hstep = (size_t)HALF * K * 2;
    const size_t tstep = 2 * hstep;
    const unsigned ldsw = (unsigned)wid * 1024u;
    const int aoff = lds_byte(wr * 64 + fr, fq * 8), boff = lds_byte(wc * 32 + fr, fq * 8);
#define PG8_SA(b, h) (((b) * 2 + (h)) * HTB)
#define PG8_SB(b, h) ((4 + (b) * 2 + (h)) * HTB)
#define PG8_STAGE(bufoff, gbase, voff) do { _Pragma("unroll") for (int _i = 0; _i < 2; ++_i) \
        __builtin_amdgcn_global_load_lds((const unsigned*)((const char*)(gbase) + (voff)[_i]), (PG8_LAS unsigned*)(lds + (bufoff) + ldsw + _i * 8192), 16, 0, 0); } while (0)
#define PG8_LDA(dst, b, h) do { _Pragma("unroll") for (int m = 0; m < 4; ++m) _Pragma("unroll") for (int k = 0; k < 2; ++k) dst[m][k] = *(const PG8_LAS bf16x8*)(lds + PG8_SA(b, h) + aoff + m * 2048 + k * 1024); } while (0)
#define PG8_LDB(dst, b, h) do { _Pragma("unroll") for (int n = 0; n < 2; ++n) _Pragma("unroll") for (int k = 0; k < 2; ++k) dst[n][k] = *(const PG8_LAS bf16x8*)(lds + PG8_SB(b, h) + boff + n * 2048 + k * 1024); } while (0)
#define PG8_MMA(ai, bj, At, Bt) do { __builtin_amdgcn_s_setprio(1); _Pragma("unroll") for (int m = 0; m < 4; ++m) _Pragma("unroll") for (int n = 0; n < 2; ++n) _Pragma("unroll") for (int k = 0; k < 2; ++k) \
        acc[ai][bj][m][n] = __builtin_amdgcn_mfma_f32_16x16x32_bf16(Bt[n][k], At[m][k], acc[ai][bj][m][n], 0, 0, 0); __builtin_amdgcn_s_setprio(0); } while (0)
#define PG8_WAIT_V(n) asm volatile("s_waitcnt vmcnt(" #n ")" ::: "memory")
#define PG8_WAIT_L(n) asm volatile("s_waitcnt lgkmcnt(" #n ")" ::: "memory")
#define PG8_BAR __builtin_amdgcn_s_barrier()
#define PG8_SCHED __builtin_amdgcn_sched_barrier(0)
    Unit cur, nxt; int ui = 0;
    if (!S.next(0, cur)) return;
    f32x4 acc[2][2][4][2];
#pragma unroll
    for (int a = 0; a < 2; ++a)
#pragma unroll
        for (int b = 0; b < 2; ++b)
#pragma unroll
            for (int m = 0; m < 4; ++m)
#pragma unroll
                for (int n = 0; n < 2; ++n) acc[a][b][m][n] = (f32x4){0.f, 0.f, 0.f, 0.f};
    bf16x8 At[4][2], B0[2][2], B1[2][2];
    const char* cA = (const char*)g.A + (size_t)cur.pm * tstep; const char* cB = (const char*)g.Bt + (size_t)cur.pn * tstep;
    S.a_ready(cur);
    if constexpr (SP2) {
        PG8_STAGE(PG8_SB(0, 0), cB, voffB); PG8_STAGE(PG8_SB(0, 1), cB + hstep, voffB); PG8_STAGE(PG8_SA(0, 0), cA, voffA); PG8_STAGE(PG8_SA(0, 1), cA + hstep, voffA);
        if (wr == 1) PG8_BAR;
        PG8_WAIT_V(2); PG8_BAR;
        PG8_STAGE(PG8_SB(1, 0), cB + kstep, voffB); PG8_STAGE(PG8_SA(1, 0), cA + kstep, voffA); PG8_STAGE(PG8_SB(1, 1), cB + hstep + kstep, voffB);
        PG8_WAIT_V(6); PG8_BAR;
    } else {
        PG8_STAGE(PG8_SB(0, 0), cB, voffB); PG8_STAGE(PG8_SA(0, 0), cA, voffA); PG8_STAGE(PG8_SB(0, 1), cB + hstep, voffB); PG8_STAGE(PG8_SA(0, 1), cA + hstep, voffA);
        if (wr == 1) PG8_BAR;
        PG8_WAIT_V(4); PG8_BAR;
        PG8_STAGE(PG8_SB(1, 0), cB + kstep, voffB); PG8_STAGE(PG8_SA(1, 0), cA + kstep, voffA); PG8_STAGE(PG8_SB(1, 1), cB + hstep + kstep, voffB);
        PG8_WAIT_V(6); PG8_BAR;
    }
    for (;;) {
        const bool has_next = S.next(ui + 1, nxt);
        const char* nA = has_next ? (const char*)g.A + (size_t)nxt.pm * tstep : cA; const char* nB = has_next ? (const char*)g.Bt + (size_t)nxt.pn * tstep : cB;
        for (int t = 0; t < nt; t += 2) {
            const bool last = (t == nt - 2);
            const char* a1 = cA + (size_t)(t + 1) * kstep;
            const char* a2 = last ? nA : cA + (size_t)(t + 2) * kstep; const char* b2 = last ? nB : cB + (size_t)(t + 2) * kstep;
            const char* a3 = a2 + kstep; const char* b3 = b2 + kstep;
            if (last && has_next) S.a_ready(nxt);
            if constexpr (SP2) {
            PG8_LDB(B0, 0, 0); PG8_LDB(B1, 0, 1); PG8_SCHED; PG8_LDA(At, 0, 0); PG8_STAGE(PG8_SA(1, 1), a1 + hstep, voffA);
            PG8_WAIT_V(8); PG8_WAIT_L(0); PG8_BAR; PG8_MMA(0, 0, At, B0); PG8_MMA(0, 1, At, B1); PG8_BAR; PG8_SCHED;
            PG8_LDA(At, 0, 1); PG8_STAGE(PG8_SB(0, 0), b2, voffB); PG8_STAGE(PG8_SB(0, 1), b2 + hstep, voffB); PG8_STAGE(PG8_SA(0, 0), a2, voffA);
            PG8_WAIT_V(8); PG8_WAIT_L(0); PG8_BAR; PG8_MMA(1, 0, At, B0); PG8_MMA(1, 1, At, B1); PG8_BAR; PG8_SCHED;
            PG8_LDB(B0, 1, 0); PG8_LDB(B1, 1, 1); PG8_SCHED; PG8_LDA(At, 1, 0); PG8_STAGE(PG8_SA(0, 1), a2 + hstep, voffA);
            PG8_WAIT_V(8); PG8_WAIT_L(0); PG8_BAR; PG8_MMA(0, 0, At, B0); PG8_MMA(0, 1, At, B1); PG8_BAR; PG8_SCHED;
            PG8_LDA(At, 1, 1); PG8_STAGE(PG8_SB(1, 0), b3, voffB); PG8_STAGE(PG8_SB(1, 1), b3 + hstep, voffB); PG8_STAGE(PG8_SA(1, 0), a3, voffA);
            PG8_WAIT_V(8); PG8_WAIT_L(0); PG8_BAR; PG8_MMA(1, 0, At, B0); PG8_MMA(1, 1, At, B1); PG8_BAR; PG8_SCHED;
            } else {
            PG8_LDB(B0, 0, 0); PG8_SCHED; PG8_LDA(At, 0, 0); PG8_STAGE(PG8_SA(1, 1), a1 + hstep, voffA);
            PG8_WAIT_L(8); PG8_BAR; PG8_WAIT_L(0); PG8_MMA(0, 0, At, B0); PG8_BAR; PG8_SCHED;
            PG8_LDB(B1, 0, 1); PG8_STAGE(PG8_SB(0, 0), b2, voffB);
            PG8_BAR; PG8_WAIT_L(0); PG8_MMA(0, 1, At, B1); PG8_BAR;
            PG8_LDA(At, 0, 1); PG8_STAGE(PG8_SA(0, 0), a2, voffA);
            PG8_BAR; PG8_WAIT_L(0); PG8_MMA(1, 0, At, B0); PG8_BAR; PG8_SCHED;
            PG8_STAGE(PG8_SB(0, 1), b2 + hstep, voffB);
            PG8_WAIT_V(6); PG8_BAR; PG8_MMA(1, 1, At, B1); PG8_BAR;
            PG8_LDB(B0, 1, 0); PG8_SCHED; PG8_LDA(At, 1, 0); PG8_STAGE(PG8_SA(0, 1), a2 + hstep, voffA);
            PG8_WAIT_L(8); PG8_BAR; PG8_WAIT_L(0); PG8_MMA(0, 0, At, B0); PG8_BAR; PG8_SCHED;
            PG8_LDB(B1, 1, 1); PG8_STAGE(PG8_SB(1, 0), b3, voffB);
            PG8_BAR; PG8_WAIT_L(0); PG8_MMA(0, 1, At, B1); PG8_BAR;
            PG8_LDA(At, 1, 1); PG8_STAGE(PG8_SA(1, 0), a3, voffA);
            PG8_BAR; PG8_WAIT_L(0); PG8_MMA(1, 0, At, B0); PG8_BAR; PG8_SCHED;
            PG8_STAGE(PG8_SB(1, 1), b3 + hstep, voffB);
            PG8_WAIT_V(6); PG8_BAR; PG8_MMA(1, 1, At, B1); PG8_BAR;
            }
        }
        if constexpr (ALIGN_EPI) { if (wr == 0) PG8_BAR; }
        if constexpr (!Epi::AFTER_DRAIN) { E(acc, cur, wr, wc, fr, fq); S.done(cur); }
        if (!has_next) break;
#pragma unroll
        for (int a = 0; a < 2; ++a)
#pragma unroll
            for (int b = 0; b < 2; ++b)
#pragma unroll
                for (int m = 0; m < 4; ++m)
#pragma unroll
                    for (int n = 0; n < 2; ++n) acc[a][b][m][n] = (f32x4){0.f, 0.f, 0.f, 0.f};
        cur = nxt; cA = nA; cB = nB; ++ui;
        if constexpr (ALIGN_EPI) { if (wr == 1) PG8_BAR; }
    }
    PG8_WAIT_V(0);
    if constexpr (!ALIGN_EPI) { if (wr == 0) PG8_BAR; }
    PG8_BAR;
    if constexpr (Epi::AFTER_DRAIN) { E.fused(acc, cur, wr, wc, fr, fq, lds, wid, lane); S.done(cur); }
#undef PG8_SA
#undef PG8_SB
#undef PG8_STAGE
#undef PG8_LDA
#undef PG8_LDB
#undef PG8_MMA
#undef PG8_WAIT_V
#undef PG8_WAIT_L
#undef PG8_BAR
#undef PG8_SCHED
}
}

#ifndef MK_SINGLE
#define MK_SINGLE 1
#endif
constexpr int BATCH = 32, SEQ = 2048, DM = 1024, M = BATCH * SEQ;
constexpr int NIN = 3336, NPROJ = 3328;
constexpr int DFF = 2816, NUP = 2 * DFF;
constexpr int C_Q = 1792, C_K = 2048, C_V = 2304, C_O = 2816;
constexpr int NLORA = 1536, KLORA = 256;
constexpr int MH = M / 2;
constexpr float NORM_EPS = 1e-6f, LNX_EPS = 64e-5f;

constexpr size_t MiB = 1u << 20;
constexpr size_t WS_CTL = 0, CTL_ZERO_BYTES = 1 * MiB;
constexpr size_t WS_WT_IN = 2 * MiB, WS_WT_OUT = 9 * MiB, WS_WT_UP = 11 * MiB, WS_WT_DN = 22 * MiB, WS_WT_LORA = 28 * MiB;
constexpr size_t WS_RS2 = 29 * MiB, WS_SSQP = 30 * MiB, WS_GATES = 34 * MiB;
constexpr size_t WS_XN = 40 * MiB;
constexpr size_t WS_PROJ = 168 * MiB;
constexpr size_t WS_LBUF = 584 * MiB;
constexpr size_t WS_DAG = 616 * MiB;
constexpr size_t WS_MIX = 808 * MiB;
constexpr size_t WS_UH = 168 * MiB;
constexpr size_t WS_GB = 520 * MiB;
constexpr size_t WS_END = 936 * MiB;

constexpr int LDS_BYTES = 147456;
constexpr int MISC_OFF = 131072 + 320;

#define GAS __attribute__((address_space(1)))
#define LAS __attribute__((address_space(3)))
typedef unsigned short bf16;
typedef unsigned v4u __attribute__((ext_vector_type(4)));
typedef unsigned v2u __attribute__((ext_vector_type(2)));
typedef float f32x4 __attribute__((ext_vector_type(4)));
typedef float f32x2 __attribute__((ext_vector_type(2)));
typedef short bf16x8 __attribute__((ext_vector_type(8)));
typedef GAS unsigned gu32;

__device__ __forceinline__ unsigned f2bf(float f) { unsigned u = __builtin_bit_cast(unsigned, f); return (u + 0x7fffu + ((u >> 16) & 1u)) >> 16; }
__device__ __forceinline__ unsigned pk2(float lo, float hi) { return f2bf(lo) | (f2bf(hi) << 16); }
__device__ __forceinline__ float bf2f(unsigned short u) { return __builtin_bit_cast(float, (unsigned)u << 16); }
__device__ __forceinline__ float bflo(unsigned w) { return __builtin_bit_cast(float, w << 16); }
__device__ __forceinline__ float bfhi(unsigned w) { return __builtin_bit_cast(float, w & 0xffff0000u); }
__device__ __forceinline__ void unpack8(const v4u w, float (&o)[8]) { o[0] = bflo(w.x); o[1] = bfhi(w.x); o[2] = bflo(w.y); o[3] = bfhi(w.y); o[4] = bflo(w.z); o[5] = bfhi(w.z); o[6] = bflo(w.w); o[7] = bfhi(w.w); }
__device__ __forceinline__ v4u pack8(const float (&o)[8]) { v4u w; w.x = pk2(o[0], o[1]); w.y = pk2(o[2], o[3]); w.z = pk2(o[4], o[5]); w.w = pk2(o[6], o[7]); return w; }
__device__ __forceinline__ float sigmoidf_(float x) { return 1.0f / (1.0f + __expf(-x)); }
__device__ __forceinline__ float tanhf_(float x) { return 1.0f - 2.0f / (__expf(2.0f * x) + 1.0f); }
__device__ __forceinline__ float softplusf_(float x) { return fmaxf(x, 0.f) + log1pf(__expf(-fabsf(x))); }
__device__ __forceinline__ float wave_sum(float v) {
#pragma unroll
    for (int o = 1; o < 64; o <<= 1) v += __shfl_xor(v, o);
    return v;
}
template <int CTRL> __device__ __forceinline__ float dppmov(float v) { return __builtin_bit_cast(float, __builtin_amdgcn_update_dpp(0, __builtin_bit_cast(int, v), CTRL, 0xF, 0xF, true)); }
__device__ __forceinline__ float red8(float v) { v += dppmov<0xB1>(v); v += dppmov<0x4E>(v); v += dppmov<0x141>(v); return v; }
__device__ __forceinline__ float red16(float v) { v += dppmov<0xB1>(v); v += dppmov<0x4E>(v); v += dppmov<0x141>(v); v += dppmov<0x140>(v); return v; }

#define XB_TMO      128
#define XB_XCNT(j)  (256  + 64 * (j))
#define XB_XSUB(j)  (1280 + 64 * (j))
#define XB_XGEN(j)  (2304 + 64 * (j))
#define XB_TOP      3328
#define XB_TOPGEN   3392
#define XCD_BAR_WORDS 3456
#define XB_SPIN_CAP (1u << 22)
__device__ __forceinline__ unsigned xb_ld(unsigned* p)              { return __hip_atomic_load(p, __ATOMIC_RELAXED, __HIP_MEMORY_SCOPE_AGENT); }
__device__ __forceinline__ unsigned xb_add(unsigned* p, unsigned v) { return __hip_atomic_fetch_add(p, v, __ATOMIC_RELAXED, __HIP_MEMORY_SCOPE_AGENT); }
__device__ __forceinline__ unsigned xb_xcc_id() { return (unsigned)__builtin_amdgcn_s_getreg((3 << 11) | 20) & 0xFu; }
#define XB_SPIN(cond, bar) do { unsigned _sp = 0; while (cond) { __builtin_amdgcn_s_sleep(1); \
    if ((++_sp & 255u) == 0u) { if (xb_ld(&(bar)[XB_TMO])) break; if (_sp > XB_SPIN_CAP) { atomicAdd(&(bar)[XB_TMO], 1u); break; } } } } while (0)
struct XcdBarrier { unsigned* bar; unsigned x; volatile LAS unsigned* st; };
__device__ __forceinline__ XcdBarrier xcd_barrier_post(unsigned* bar, volatile LAS unsigned* st) {
    XcdBarrier b; b.bar = bar; b.x = xb_xcc_id(); b.st = st;
    if (threadIdx.x == 0) (void)xb_add(&bar[XB_XCNT(b.x)], 1u);
    return b;
}
__device__ __forceinline__ void xcd_barrier_complete(unsigned* bar, unsigned x, unsigned& nloc, unsigned& nx) {
    const unsigned G = gridDim.x * gridDim.y * gridDim.z;
    unsigned sum, cnt, mine, sp = 0u;
    for (;;) {
        sum = 0u; cnt = 0u; mine = 0u;
#pragma unroll
        for (unsigned j = 0; j < 16; ++j) { const unsigned c = xb_ld(&bar[XB_XCNT(j)]); sum += c; cnt += (c > 0u) ? 1u : 0u; mine = (j == x) ? c : mine; }
        if (sum == G) break;
        __builtin_amdgcn_s_sleep(1);
        if ((++sp & 255u) == 0u) { if (xb_ld(&bar[XB_TMO])) break; if (sp > XB_SPIN_CAP) { atomicAdd(&bar[XB_TMO], 1u); break; } }
    }
    nloc = mine > 0u ? mine : 1u; nx = cnt > 0u ? cnt : 1u;
}
__device__ __forceinline__ void xcd_barrier(const XcdBarrier& b) {
    asm volatile("s_waitcnt vmcnt(0)" ::: "memory");
    __syncthreads();
    if (threadIdx.x == 0) {
        unsigned* bar = b.bar;
        __builtin_amdgcn_s_waitcnt(0);
        unsigned nloc = b.st[0], nx = b.st[1];
        if (nloc == 0u) { xcd_barrier_complete(bar, b.x, nloc, nx); b.st[0] = nloc; b.st[1] = nx; }
        const unsigned old = xb_add(&bar[XB_XSUB(b.x)], 1u);
        const unsigned gen = old / nloc;
        if (old + 1u == (gen + 1u) * nloc) {
            __builtin_amdgcn_fence(__ATOMIC_RELEASE, "agent");
            asm volatile("s_waitcnt vmcnt(0)" ::: "memory");
            const unsigned og = xb_add(&bar[XB_TOP], 1u);
            const unsigned tg = og / nx;
            if (og + 1u == (tg + 1u) * nx) xb_add(&bar[XB_TOPGEN], 1u);
            else XB_SPIN(xb_ld(&bar[XB_TOPGEN]) == tg, bar);
            __builtin_amdgcn_fence(__ATOMIC_ACQUIRE, "agent");
            xb_add(&bar[XB_XGEN(b.x)], 1u);
            asm volatile("s_waitcnt vmcnt(0)" ::: "memory");
        } else {
            XB_SPIN(xb_ld(&bar[XB_XGEN(b.x)]) == gen, bar);
            __builtin_amdgcn_fence(__ATOMIC_ACQUIRE, "agent");
            asm volatile("s_waitcnt vmcnt(0)" ::: "memory");
        }
    }
    __syncthreads();
}

__device__ __forceinline__ int opaque_i(int v) { asm volatile("" : "+s"(v)); return v; }
struct Args { const float* in[26]; float* out; unsigned char* ws; int ph_lo, ph_hi; };

namespace pg8 {
struct PanelOrder {
    int c;
    __device__ bool next(int i, Unit& u) const { if (i >= 4) return false; u.pm = c; u.pn = i; return true; }
    __device__ __forceinline__ void a_ready(const Unit&) const {}
    __device__ __forceinline__ void done(const Unit&) const {}
};
struct EpiResid {
    static constexpr bool PERM = true, AFTER_DRAIN = false;
    const float* X; float* X2; bf16_t* XB; float* ssqp;
    __device__ __forceinline__ void operator()(const f32x4 (&acc)[2][2][4][2], const Unit& u, int wr, int wc, int fr, int fq) const {
        int pm_ = u.pm; asm volatile("" : "+s"(pm_));
        const int row0 = pm_ * BM + wr * 64 + fr, col0 = u.pn * BM + wc * 32 + 8 * fq;
#pragma unroll
        for (int ai = 0; ai < 2; ++ai)
#pragma unroll
            for (int m = 0; m < 4; ++m) { const int row = row0 + ai * HALF + m * 16; float ss = 0.f;
#pragma unroll
                for (int bj = 0; bj < 2; ++bj) { const size_t off = (size_t)row * DM + col0 + bj * HALF;
                    const f32x4 x0 = *(const f32x4*)(X + off), x1 = *(const f32x4*)(X + off + 4);
                    const f32x4 v0 = acc[ai][bj][m][0] + x0, v1 = acc[ai][bj][m][1] + x1;
                    *(f32x4*)(X2 + off) = v0; *(f32x4*)(X2 + off + 4) = v1;
                    ss += (v0[0] * v0[0] + v0[1] * v0[1]) + (v0[2] * v0[2] + v0[3] * v0[3]) + (v1[0] * v1[0] + v1[1] * v1[1]) + (v1[2] * v1[2] + v1[3] * v1[3]);
                    if (XB) { u32x4 w; w.x = pk2(v0[0], v0[1]); w.y = pk2(v0[2], v0[3]); w.z = pk2(v1[0], v1[1]); w.w = pk2(v1[2], v1[3]); *(u32x4*)(XB + off) = w; } }
                ss += __shfl_xor(ss, 16); ss += __shfl_xor(ss, 32);
                if (fq == 0) ssqp[(size_t)row * 16 + u.pn * 4 + wc] = ss; }
    }
};
struct EpiScale {
    static constexpr bool PERM = true, AFTER_DRAIN = false;
    bf16_t* O; int ldc; const float* rs; int row_off;
    __device__ __forceinline__ void operator()(const f32x4 (&acc)[2][2][4][2], const Unit& u, int wr, int wc, int fr, int fq) const {
        const int row0 = u.pm * BM + wr * 64 + fr, col0 = u.pn * BM + wc * 32 + 8 * fq;
#pragma unroll
        for (int ai = 0; ai < 2; ++ai)
#pragma unroll
            for (int m = 0; m < 4; ++m) { const int row = row0 + ai * HALF + m * 16; const float s = rs[row_off + row]; bf16_t* rowp = O + (size_t)row * ldc + col0;
#pragma unroll
                for (int bj = 0; bj < 2; ++bj) { const f32x4 v0 = acc[ai][bj][m][0] * s, v1 = acc[ai][bj][m][1] * s;
                    u32x4 w; w.x = pk2(v0[0], v0[1]); w.y = pk2(v0[2], v0[3]); w.z = pk2(v1[0], v1[1]); w.w = pk2(v1[2], v1[3]); *(u32x4*)(rowp + bj * HALF) = w; } }
    }
};
}

__device__ __forceinline__ void transpose_item(const float* W, int ldw, int K, bf16* WT, const float* kscale, LAS float* scr, int item, int nblk, int lane) {
    const int kb = item / nblk, nb = item % nblk, k0 = 64 * kb, n0 = 32 * nb;
#pragma unroll 8
    for (int i = 0; i < 32; ++i) { const int kk = 2 * i + (lane >> 5); const float s = kscale ? kscale[k0 + kk] : 1.0f; scr[kk * 33 + (lane & 31)] = W[(size_t)(k0 + kk) * ldw + n0 + (lane & 31)] * s; }
    asm volatile("s_waitcnt lgkmcnt(0)" ::: "memory");
    const int c = lane & 7;
#pragma unroll
    for (int j = 0; j < 4; ++j) { const int n = (lane >> 3) + 8 * j; const LAS float* s = scr + (8 * c) * 33 + n;
        v4u o; o.x = pk2(s[0 * 33], s[1 * 33]); o.y = pk2(s[2 * 33], s[3 * 33]); o.z = pk2(s[4 * 33], s[5 * 33]); o.w = pk2(s[6 * 33], s[7 * 33]);
        *(v4u*)(WT + (size_t)(n0 + n) * K + k0 + 8 * c) = o; }
    asm volatile("s_waitcnt lgkmcnt(0)" ::: "memory");
}

__device__ __forceinline__ void phase_prep(const Args& a, LAS unsigned char* lds, int tid, int lane, int wave) {
    unsigned char* ws = a.ws;
    LAS float* scr = (LAS float*)(lds + wave * 16384);
    const int gw = blockIdx.x * 8 + wave, NGW = gridDim.x * 8;
    constexpr int I_IN = 16 * 104, I_OUT = 16 * 32, I_UP = 16 * 176, I_DN = 44 * 32;
    for (int it = gw; it < I_IN + I_OUT + I_UP + I_DN; it += NGW) {
        int r = it;
        if (r < I_IN) { transpose_item(a.in[2], NIN, DM, (bf16*)(ws + WS_WT_IN), a.in[1], scr, r, 104, lane); continue; } r -= I_IN;
        if (r < I_OUT) { transpose_item(a.in[19], DM, DM, (bf16*)(ws + WS_WT_OUT), nullptr, scr, r, 32, lane); continue; } r -= I_OUT;
        if (r < I_UP) { transpose_item(a.in[21], NUP, DM, (bf16*)(ws + WS_WT_UP), a.in[20], scr, r, 176, lane); continue; } r -= I_UP;
        transpose_item(a.in[24], DM, DFF, (bf16*)(ws + WS_WT_DN), nullptr, scr, r, 32, lane);
    }
    {
        const float* wd = a.in[5]; const float* wa = a.in[7]; const float* wg = a.in[8]; bf16* WL = (bf16*)(ws + WS_WT_LORA);
        for (int idx = blockIdx.x * 512 + tid; idx < NLORA * KLORA; idx += gridDim.x * 512) {
            const int n = idx >> 8, k = idx & 255; float v = 0.f;
            if (n < 512) { if (k < 64) v = wd[k * 512 + n]; }
            else if (n < 1024) { if (k >= 64 && k < 128) v = wa[(k - 64) * 512 + (n - 512)]; }
            else { if (k >= 128) v = wg[(k - 128) * 512 + (n - 1024)]; }
            WL[idx] = (bf16)f2bf(v);
        }
    }
    {
        const float* x = a.in[0]; const float* g1 = a.in[1]; const float* w_in = a.in[2];
        bf16* XN = (bf16*)(ws + WS_XN); float* gates = (float*)(ws + WS_GATES);
        float wgt[16][8];
#pragma unroll
        for (int j = 0; j < 4; ++j)
#pragma unroll
            for (int e = 0; e < 4; ++e) { const int k = 4 * lane + 256 * j + e; const float g = g1[k];
                const f32x4 w0 = *(const f32x4*)(w_in + (size_t)k * NIN + 3328), w1 = *(const f32x4*)(w_in + (size_t)k * NIN + 3332);
                wgt[j * 4 + e][0] = w0[0] * g; wgt[j * 4 + e][1] = w0[1] * g; wgt[j * 4 + e][2] = w0[2] * g; wgt[j * 4 + e][3] = w0[3] * g;
                wgt[j * 4 + e][4] = w1[0] * g; wgt[j * 4 + e][5] = w1[1] * g; wgt[j * 4 + e][6] = w1[2] * g; wgt[j * 4 + e][7] = w1[3] * g; }
        for (int row = gw; row < M; row += NGW) {
            const f32x4* xr = (const f32x4*)(x + (size_t)row * DM) + lane;
            f32x4 v[4]; float ss = 0.f;
#pragma unroll
            for (int j = 0; j < 4; ++j) { v[j] = xr[64 * j]; ss += (v[j][0] * v[j][0] + v[j][1] * v[j][1]) + (v[j][2] * v[j][2] + v[j][3] * v[j][3]); }
            ss = wave_sum(ss);
            const float rs = rsqrtf(ss * (1.0f / DM) + NORM_EPS);
            unsigned long long* o8 = (unsigned long long*)(XN + (size_t)row * DM) + lane;
#pragma unroll
            for (int j = 0; j < 4; ++j) o8[64 * j] = (unsigned long long)pk2(v[j][0] * rs, v[j][1] * rs) | ((unsigned long long)pk2(v[j][2] * rs, v[j][3] * rs) << 32);
            float gs[8];
#pragma unroll
            for (int jg = 0; jg < 8; ++jg) { float s = 0.f;
#pragma unroll
                for (int j = 0; j < 4; ++j)
#pragma unroll
                    for (int e = 0; e < 4; ++e) s += v[j][e] * wgt[j * 4 + e][jg];
                gs[jg] = wave_sum(s); }
            if (lane < 8) { float s = gs[0];
#pragma unroll
                for (int jg = 1; jg < 8; ++jg) s = (lane == jg) ? gs[jg] : s;
                gates[(size_t)row * 8 + lane] = s * rs; }
        }
    }
}

__device__ __forceinline__ void phase_lmat(const Args& a, int tid) {
    unsigned char* ws = a.ws; const bf16* PROJ = (const bf16*)(ws + WS_PROJ); bf16* L = (bf16*)(ws + WS_LBUF); const float* mu = a.in[3];
    const int NT = gridDim.x * 512;
    for (int it = blockIdx.x * 512 + tid; it < M * 32; it += NT) {
        const int row = it >> 5, grp = it & 31, c0 = 1536 + 8 * grp;
        const v4u cur = *(const v4u*)(PROJ + (size_t)row * NPROJ + c0);
        v4u prv = {0u, 0u, 0u, 0u}; if ((row & (SEQ - 1)) != 0) prv = *(const v4u*)(PROJ + (size_t)(row - 1) * NPROJ + c0);
        const f32x4 m0 = *(const f32x4*)(mu + c0), m1 = *(const f32x4*)(mu + c0 + 4);
        float c[8], p[8], o[8]; unpack8(cur, c); unpack8(prv, p);
#pragma unroll
        for (int e = 0; e < 8; ++e) { const float mm = e < 4 ? m0[e & 3] : m1[e & 3]; const float xv = c[e] + (p[e] - c[e]) * mm;
            o[e] = grp < 8 ? tanhf_(xv) : (grp < 16 ? xv : sigmoidf_(xv)); }
        *(v4u*)(L + (size_t)row * KLORA + 8 * grp) = pack8(o);
    }
}

__device__ __forceinline__ void rwkv_unit(const Args& a, LAS unsigned char* lds, int unit, int tid) {
    unsigned char* ws = a.ws; const bf16* PROJ = (const bf16*)(ws + WS_PROJ); const bf16* DAG = (const bf16*)(ws + WS_DAG); bf16* MIX = (bf16*)(ws + WS_MIX);
    const float* mu = a.in[3]; const float* k_k = a.in[9]; const float* k_a = a.in[10]; const float* r_k = a.in[11]; const float* lnx_w = a.in[12]; const float* lnx_b = a.in[13]; const float* w0p = a.in[4]; const float* a0p = a.in[6];
    const int b = unit >> 3, h = unit & 7;
    LAS float* Ra = (LAS float*)lds; LAS float* Wa = Ra + 4096; LAS float* Ka = Wa + 4096; LAS float* Va = Ka + 4096; LAS float* Aa = Va + 4096; LAS float* Ba = Aa + 4096; LAS float* Ya = Ba + 4096; LAS float* bon = Ya + 4096;
    const int cg = tid & 15, rp = tid >> 4;
    const int tt_s = tid >> 3, c8 = tid & 7, j0 = h * 64 + 8 * c8;
    float S0[4] = {0.f, 0.f, 0.f, 0.f}, S1[4] = {0.f, 0.f, 0.f, 0.f};
    for (int blk = 0; blk < SEQ / 64; ++blk) {
        const int t0 = b * SEQ + blk * 64;
        {
            const int t = t0 + tt_s; const bf16* pr = PROJ + (size_t)t * NPROJ;
            const bool first = (blk == 0 && tt_s == 0);
            float rc[8], kc[8], vc[8], rp_[8], kp[8], vp[8], av[8], ldv[8];
            unpack8(*(const v4u*)(pr + j0), rc); unpack8(*(const v4u*)(pr + 512 + j0), kc); unpack8(*(const v4u*)(pr + 1024 + j0), vc);
            if (!first) { unpack8(*(const v4u*)(pr - NPROJ + j0), rp_); unpack8(*(const v4u*)(pr - NPROJ + 512 + j0), kp); unpack8(*(const v4u*)(pr - NPROJ + 1024 + j0), vp); }
            else {
#pragma unroll
                for (int e = 0; e < 8; ++e) { rp_[e] = 0.f; kp[e] = 0.f; vp[e] = 0.f; } }
            unpack8(*(const v4u*)(DAG + (size_t)t * NLORA + j0), ldv); unpack8(*(const v4u*)(DAG + (size_t)t * NLORA + 512 + j0), av);
            float ss = 0.f, bonus = 0.f, kkr[8], rr[8], km[8], vv[8];
#pragma unroll
            for (int e = 0; e < 8; ++e) {
                const float r = rc[e] + (rp_[e] - rc[e]) * mu[j0 + e];
                const float k = kc[e] + (kp[e] - kc[e]) * mu[512 + j0 + e];
                const float v = vc[e] + (vp[e] - vc[e]) * mu[1024 + j0 + e];
                kkr[e] = k * k_k[j0 + e]; ss += kkr[e] * kkr[e];
                av[e] = sigmoidf_(a0p[j0 + e] + av[e]);
                ldv[e] = __expf(-0.6065306597f * sigmoidf_(w0p[j0 + e] + ldv[e]));
                km[e] = k * (1.0f + (av[e] - 1.0f) * k_a[j0 + e]);
                bonus += r * km[e] * r_k[j0 + e];
                rr[e] = r; vv[e] = v;
            }
            ss = red8(ss); bonus = red8(bonus);
            const float inv = 1.0f / fmaxf(sqrtf(ss), 1e-12f);
            const int o = tt_s * 64 + 8 * c8;
#pragma unroll
            for (int e = 0; e < 8; ++e) { const float kk = kkr[e] * inv;
                Ra[o + e] = rr[e]; Wa[o + e] = ldv[e]; Ka[o + e] = km[e]; Va[o + e] = vv[e]; Aa[o + e] = -kk; Ba[o + e] = kk * av[e]; }
            if (c8 == 0) bon[tt_s] = bonus;
        }
        __syncthreads();
#pragma unroll 2
        for (int tt = 0; tt < 64; ++tt) {
            const f32x4 a4 = *(const LAS f32x4*)(Aa + tt * 64 + 4 * cg), w4 = *(const LAS f32x4*)(Wa + tt * 64 + 4 * cg), b4 = *(const LAS f32x4*)(Ba + tt * 64 + 4 * cg);
            const f32x4 k4 = *(const LAS f32x4*)(Ka + tt * 64 + 4 * cg), r4 = *(const LAS f32x4*)(Ra + tt * 64 + 4 * cg);
            const f32x2 v2 = *(const LAS f32x2*)(Va + tt * 64 + 2 * rp);
            float sa0 = (S0[0] * a4[0] + S0[1] * a4[1]) + (S0[2] * a4[2] + S0[3] * a4[3]);
            float sa1 = (S1[0] * a4[0] + S1[1] * a4[1]) + (S1[2] * a4[2] + S1[3] * a4[3]);
            sa0 = red16(sa0); sa1 = red16(sa1);
#pragma unroll
            for (int c = 0; c < 4; ++c) { S0[c] = S0[c] * w4[c] + (sa0 * b4[c] + v2[0] * k4[c]); S1[c] = S1[c] * w4[c] + (sa1 * b4[c] + v2[1] * k4[c]); }
            float y0 = (S0[0] * r4[0] + S0[1] * r4[1]) + (S0[2] * r4[2] + S0[3] * r4[3]);
            float y1 = (S1[0] * r4[0] + S1[1] * r4[1]) + (S1[2] * r4[2] + S1[3] * r4[3]);
            y0 = red16(y0); y1 = red16(y1);
            if (cg == 0) *(LAS f32x2*)(Ya + tt * 64 + 2 * rp) = (f32x2){y0, y1};
        }
        __syncthreads();
        {
            const int t = t0 + tt_s; const int o = tt_s * 64 + 8 * c8;
            float y[8], gv[8]; float s1 = 0.f;
#pragma unroll
            for (int e = 0; e < 8; ++e) { y[e] = Ya[o + e]; s1 += y[e]; }
            s1 = red8(s1); const float mean = s1 * (1.0f / 64.0f); float s2 = 0.f;
#pragma unroll
            for (int e = 0; e < 8; ++e) { const float d = y[e] - mean; s2 += d * d; }
            s2 = red8(s2); const float rstd = rsqrtf(s2 * (1.0f / 64.0f) + LNX_EPS);
            unpack8(*(const v4u*)(DAG + (size_t)t * NLORA + 1024 + j0), gv);
            const float bonus = bon[tt_s]; float ov[8];
#pragma unroll
            for (int e = 0; e < 8; ++e) { const float yn = (y[e] - mean) * rstd * lnx_w[j0 + e] + lnx_b[j0 + e]; ov[e] = (yn + bonus * Va[o + e]) * gv[e]; }
            *(v4u*)(MIX + (size_t)t * DM + j0) = pack8(ov);
        }
        __syncthreads();
    }
}

__device__ __forceinline__ f32x4 mfma16(const bf16x8 a, const bf16x8 b, const f32x4 c) { return __builtin_amdgcn_mfma_f32_16x16x32_bf16(a, b, c, 0, 0, 0); }
__device__ __forceinline__ void mlstm_unit(const Args& a, LAS unsigned char* lds, int unit, int tid, int lane, int wave) {
    unsigned char* ws = a.ws; const bf16* PROJ = (const bf16*)(ws + WS_PROJ); const float* gates = (const float*)(ws + WS_GATES); bf16* MIX = (bf16*)(ws + WS_MIX);
    const float* cw = a.in[14]; const float* cbias = a.in[15]; const float* i_bias = a.in[16]; const float* f_bias = a.in[17]; const float* mhg = a.in[18];
    const int b = unit >> 2, hm = unit & 3;
    constexpr int LD = 72;
    LAS bf16* Ql = (LAS bf16*)lds; LAS bf16* Kl = Ql + 64 * LD; LAS bf16* Kwt = Kl + 64 * LD; LAS bf16* Vt = Kwt + 64 * LD; LAS bf16* Sm = Vt + 128 * LD; LAS bf16* Ct = Sm + 64 * LD;
    LAS float* Hl = (LAS float*)(Ct + 128 * LD);
    LAS float* e_s = Hl + 64 * 132; LAS float* Mx = e_s + 64; LAS float* sc = Mx + 64; LAS float* em = sc + 64; LAS float* wsv = em + 64; LAS float* den = wsv + 64; LAS float* nvec = den + 64; LAS float* scal = nvec + 64;
    for (int i = tid; i < 128 * LD / 2; i += 512) ((LAS unsigned*)Ct)[i] = 0u;
    if (tid < 64) nvec[tid] = 0.f;
    if (tid == 0) { scal[0] = 1.f; scal[1] = 0.f; }
    f32x4 cacc[4];
#pragma unroll
    for (int i = 0; i < 4; ++i) cacc[i] = (f32x4){0.f, 0.f, 0.f, 0.f};
    const int l15 = lane & 15, l4 = lane >> 4;
    const int tt = tid >> 3, p8 = tid & 7;
    __syncthreads();
    for (int c = 0; c < SEQ / 64; ++c) {
        const int t0 = b * SEQ + c * 64;
        if (wave == 0) {
            const int t = t0 + lane;
            const float gi = gates[(size_t)t * 8 + hm] + i_bias[hm], gf = gates[(size_t)t * 8 + 4 + hm] + f_bias[hm];
            const float ig = 15.0f * tanhf_(gi * (1.0f / 15.0f)), fx = 15.0f * tanhf_(gf * (1.0f / 15.0f));
            const float logf = -softplusf_(-fx);
            float bc = logf;
#pragma unroll
            for (int o = 1; o < 64; o <<= 1) { const float t_ = __shfl_up(bc, o); if (lane >= o) bc += t_; }
            const float e = ig - bc; float P = e;
#pragma unroll
            for (int o = 1; o < 64; o <<= 1) { const float t_ = __shfl_up(P, o); if (lane >= o) P = fmaxf(P, t_); }
            const float m = scal[1];
            const float mx = fmaxf(P, m); const float mxL = __shfl(mx, 63), bL = __shfl(bc, 63);
            e_s[lane] = e; Mx[lane] = mx; sc[lane] = __expf(m - mx); em[lane] = __expf(-(bc + mx)); wsv[lane] = __expf(e - mxL);
            if (lane == 0) { scal[0] = __expf(m - mxL); scal[1] = bL + mxL; }
        }
        __syncthreads();
        {
            const int t = t0 + tt, tpos = c * 64 + tt, d0 = 8 * p8, cq = hm * 64 + d0, ck = 256 + hm * 64 + d0;
            float aq[8], ak[8];
#pragma unroll
            for (int e = 0; e < 8; ++e) { aq[e] = cbias[cq + e]; ak[e] = cbias[ck + e]; }
#pragma unroll
            for (int j = 0; j < 4; ++j) { if (tpos - 3 + j >= 0) { const bf16* pr = PROJ + (size_t)(t - 3 + j) * NPROJ; float pq[8], pk[8];
                    unpack8(*(const v4u*)(pr + C_Q + hm * 64 + d0), pq); unpack8(*(const v4u*)(pr + C_K + hm * 64 + d0), pk);
#pragma unroll
                    for (int e = 0; e < 8; ++e) { aq[e] += cw[j * 512 + cq + e] * pq[e]; ak[e] += cw[j * 512 + ck + e] * pk[e]; } } }
            const float w = wsv[tt];
#pragma unroll
            for (int e = 0; e < 8; ++e) { aq[e] = aq[e] * sigmoidf_(aq[e]) * 0.125f; ak[e] = ak[e] * sigmoidf_(ak[e]); }
            *(LAS v4u*)(Ql + tt * LD + d0) = pack8(aq); *(LAS v4u*)(Kl + tt * LD + d0) = pack8(ak);
#pragma unroll
            for (int e = 0; e < 8; ++e) Kwt[(d0 + e) * LD + tt] = (bf16)f2bf(w * ak[e]);
            const bf16* pv = PROJ + (size_t)t * NPROJ + C_V + hm * 128 + 16 * p8;
            const v4u va = *(const v4u*)pv, vb = *(const v4u*)(pv + 8);
            const unsigned wv[8] = {va.x, va.y, va.z, va.w, vb.x, vb.y, vb.z, vb.w};
#pragma unroll
            for (int e = 0; e < 8; ++e) { Vt[(16 * p8 + 2 * e) * LD + tt] = (bf16)(wv[e] & 0xffffu); Vt[(16 * p8 + 2 * e + 1) * LD + tt] = (bf16)(wv[e] >> 16); }
        }
        __syncthreads();
        {
            const int rb = wave >> 1;
#pragma unroll
            for (int ci = 0; ci < 2; ++ci) { const int cb = 2 * (wave & 1) + ci; f32x4 acc = {0.f, 0.f, 0.f, 0.f};
#pragma unroll
                for (int kk = 0; kk < 2; ++kk) { const bf16x8 A = *(const LAS bf16x8*)(Ql + (16 * rb + l15) * LD + 32 * kk + 8 * l4), B = *(const LAS bf16x8*)(Kl + (16 * cb + l15) * LD + 32 * kk + 8 * l4); acc = mfma16(A, B, acc); }
                const int s = 16 * cb + l15; const float es = e_s[s];
#pragma unroll
                for (int r = 0; r < 4; ++r) { const int t = 16 * rb + 4 * l4 + r; const float v = (s <= t) ? acc[r] * __expf(es - Mx[t]) : 0.f; Sm[t * LD + s] = (bf16)f2bf(v); } }
        }
        __syncthreads();
        f32x4 num[4];
        {
            float part = 0.f, qn = 0.f; float sv[8], qv[8];
            unpack8(*(const LAS v4u*)(Sm + tt * LD + 8 * p8), sv); unpack8(*(const LAS v4u*)(Ql + tt * LD + 8 * p8), qv);
#pragma unroll
            for (int e = 0; e < 8; ++e) { part += sv[e]; qn += qv[e] * nvec[8 * p8 + e]; }
            float tot = part + sc[tt] * qn; tot = red8(tot);
            if (p8 == 0) den[tt] = tot;
            const int rb = wave >> 1;
            bf16x8 As[2], Aq[2];
#pragma unroll
            for (int kk = 0; kk < 2; ++kk) { As[kk] = *(const LAS bf16x8*)(Sm + (16 * rb + l15) * LD + 32 * kk + 8 * l4); Aq[kk] = *(const LAS bf16x8*)(Ql + (16 * rb + l15) * LD + 32 * kk + 8 * l4); }
            float scr_[4];
#pragma unroll
            for (int r = 0; r < 4; ++r) scr_[r] = sc[16 * rb + 4 * l4 + r];
#pragma unroll
            for (int vi = 0; vi < 4; ++vi) { const int vb = 4 * (wave & 1) + vi; f32x4 a1 = {0.f, 0.f, 0.f, 0.f}, a2 = {0.f, 0.f, 0.f, 0.f};
#pragma unroll
                for (int kk = 0; kk < 2; ++kk) { const bf16x8 B1 = *(const LAS bf16x8*)(Vt + (16 * vb + l15) * LD + 32 * kk + 8 * l4), B2 = *(const LAS bf16x8*)(Ct + (16 * vb + l15) * LD + 32 * kk + 8 * l4);
                    a1 = mfma16(As[kk], B1, a1); a2 = mfma16(Aq[kk], B2, a2); }
#pragma unroll
                for (int r = 0; r < 4; ++r) num[vi][r] = a1[r] + scr_[r] * a2[r]; }
        }
        __syncthreads();
        {
            const int rb = wave >> 1;
#pragma unroll
            for (int r = 0; r < 4; ++r) { const int t = 16 * rb + 4 * l4 + r; const float dn = 1.0f / fmaxf(fabsf(den[t]), em[t]);
#pragma unroll
                for (int vi = 0; vi < 4; ++vi) Hl[t * 132 + 16 * (4 * (wave & 1) + vi) + l15] = num[vi][r] * dn; }
            const float dec = scal[0];
            bf16x8 Av[2];
#pragma unroll
            for (int kk = 0; kk < 2; ++kk) Av[kk] = *(const LAS bf16x8*)(Vt + (16 * wave + l15) * LD + 32 * kk + 8 * l4);
#pragma unroll
            for (int db = 0; db < 4; ++db) { cacc[db] = cacc[db] * dec;
#pragma unroll
                for (int kk = 0; kk < 2; ++kk) { const bf16x8 B = *(const LAS bf16x8*)(Kwt + (16 * db + l15) * LD + 32 * kk + 8 * l4); cacc[db] = mfma16(Av[kk], B, cacc[db]); }
#pragma unroll
                for (int r = 0; r < 4; ++r) Ct[(16 * wave + 4 * l4 + r) * LD + 16 * db + l15] = (bf16)f2bf(cacc[db][r]); }
            float kv[8]; unpack8(*(const LAS v4u*)(Kwt + tt * LD + 8 * p8), kv); float s = 0.f;
#pragma unroll
            for (int e = 0; e < 8; ++e) s += kv[e];
            s = red8(s);
            if (p8 == 0) nvec[tt] = dec * nvec[tt] + s;
        }
        __syncthreads();
        {
            const int t = t0 + tt, v0 = 16 * p8; float hv[16]; float ss = 0.f;
#pragma unroll
            for (int q = 0; q < 4; ++q) { const f32x4 x = *(const LAS f32x4*)(Hl + tt * 132 + v0 + 4 * q); hv[4 * q] = x[0]; hv[4 * q + 1] = x[1]; hv[4 * q + 2] = x[2]; hv[4 * q + 3] = x[3]; ss += (x[0] * x[0] + x[1] * x[1]) + (x[2] * x[2] + x[3] * x[3]); }
            ss = red8(ss); const float rn = rsqrtf(ss * (1.0f / 128.0f) + NORM_EPS);
            const bf16* po = PROJ + (size_t)t * NPROJ + C_O + hm * 128 + v0; float o0[8], o1[8]; unpack8(*(const v4u*)po, o0); unpack8(*(const v4u*)(po + 8), o1);
            float r0[8], r1[8];
#pragma unroll
            for (int e = 0; e < 8; ++e) { r0[e] = hv[e] * rn * mhg[hm * 128 + v0 + e] * sigmoidf_(o0[e]); r1[e] = hv[8 + e] * rn * mhg[hm * 128 + v0 + 8 + e] * sigmoidf_(o1[e]); }
            bf16* dst = MIX + (size_t)t * DM + 512 + hm * 128 + v0; *(v4u*)dst = pack8(r0); *(v4u*)(dst + 8) = pack8(r1);
        }
        __syncthreads();
    }
}

__device__ __forceinline__ void phase_conv(const Args& a, int half, int tid) {
    unsigned char* ws = a.ws; const bf16* UH = (const bf16*)(ws + WS_UH); bf16* GB = (bf16*)(ws + WS_GB); const float* cw = a.in[22]; const float* cb = a.in[23];
    const int NT = gridDim.x * 512;
    for (int it = blockIdx.x * 512 + tid; it < MH * (DFF / 8); it += NT) {
        const int rl = it / (DFF / 8), grp = it % (DFF / 8), f0 = 8 * grp, row = half * MH + rl, tpos = row & (SEQ - 1);
        const bf16* ur = UH + (size_t)rl * NUP + f0;
        float a0[8], a1[8], a2[8], bv[8];
        unpack8(*(const v4u*)ur, a0); unpack8(*(const v4u*)(ur + DFF), bv);
        if (tpos >= 1) unpack8(*(const v4u*)(ur - NUP), a1); else {
#pragma unroll
            for (int e = 0; e < 8; ++e) a1[e] = 0.f; }
        if (tpos >= 2) unpack8(*(const v4u*)(ur - 2 * NUP), a2); else {
#pragma unroll
            for (int e = 0; e < 8; ++e) a2[e] = 0.f; }
        float o[8];
#pragma unroll
        for (int e = 0; e < 8; ++e) { const float z = cb[f0 + e] + cw[f0 + e] * a2[e] + cw[DFF + f0 + e] * a1[e] + cw[2 * DFF + f0 + e] * a0[e]; o[e] = z * sigmoidf_(z) * bv[e]; }
        *(v4u*)(GB + (size_t)row * DFF + f0) = pack8(o);
    }
}

constexpr int N_PHASES = 11;
__global__ void __launch_bounds__(512, 2) mega(Args args) {
    extern __shared__ __attribute__((aligned(16))) unsigned char lds_raw[];
    LAS unsigned char* lds = (LAS unsigned char*)lds_raw;
    const int tid0 = threadIdx.x;
    unsigned char* ws = args.ws;
#define PHASE_IDS int tid = tid0; asm volatile("" : "+v"(tid)); const int lane = tid & 63, wave = __builtin_amdgcn_readfirstlane(tid >> 6); (void)lane; (void)wave
    volatile LAS unsigned* MISC = (volatile LAS unsigned*)(lds + MISC_OFF);
    { PHASE_IDS; for (int u = tid; u < (LDS_BYTES - 131072) / 4; u += 512) ((LAS unsigned*)(lds + 131072))[u] = 0u; }
    __syncthreads();
    XcdBarrier bar; bar.bar = (unsigned*)(ws + WS_CTL) + 4096; bar.x = 0; bar.st = nullptr;
    if (MK_SINGLE) bar = xcd_barrier_post((unsigned*)(ws + WS_CTL) + 4096, MISC + 8);
    const int lo = args.ph_lo, hi = args.ph_hi;
#ifndef PH_MASK
#define PH_MASK 0xFFFF
#endif
#define IN(k) ((((PH_MASK) >> (k)) & 1) && lo <= (k) && (k) < hi)
#define SEAM(k) do { if (IN(k) && IN((k) + 1)) xcd_barrier(bar); } while (0)

    if (IN(0)) { PHASE_IDS; phase_prep(args, lds, tid, lane, wave); } SEAM(0);
    if (IN(1)) {
        pg8::Gemm g{(const bf16*)(ws + WS_XN), (const bf16*)(ws + WS_WT_IN), M, NPROJ, opaque_i(DM)}; pg8::StaticOrder S; S.init(M, NPROJ, gridDim.x, (int)blockIdx.x);
        pg8::EpiBf16<0> E{(bf16*)(ws + WS_PROJ), NPROJ, nullptr, 0, 0, 1.f};
        pg8::gemm_phase<pg8::EpiBf16<0>, pg8::StaticOrder, true, true>(lds, g, S, E);
    } SEAM(1);
    if (IN(2)) { PHASE_IDS; phase_lmat(args, tid); } SEAM(2);
    if (IN(3)) {
        pg8::Gemm g{(const bf16*)(ws + WS_LBUF), (const bf16*)(ws + WS_WT_LORA), M, NLORA, opaque_i(KLORA)}; pg8::StaticOrder S; S.init(M, NLORA, gridDim.x, (int)blockIdx.x);
        pg8::EpiBf16<0> E{(bf16*)(ws + WS_DAG), NLORA, nullptr, 0, 0, 1.f};
        pg8::gemm_phase<pg8::EpiBf16<0>, pg8::StaticOrder, true, true>(lds, g, S, E);
    } SEAM(3);
    if (IN(4)) {
        PHASE_IDS;
        for (int u = blockIdx.x; u < BATCH * 8; u += gridDim.x) rwkv_unit(args, lds, u, tid);
        __syncthreads();
        for (int u = blockIdx.x; u < BATCH * 4; u += gridDim.x) mlstm_unit(args, lds, u, tid, lane, wave);
    } SEAM(4);
    if (IN(5)) {
        pg8::Gemm g{(const bf16*)(ws + WS_MIX), (const bf16*)(ws + WS_WT_OUT), M, DM, opaque_i(DM)}; pg8::PanelOrder S{(int)blockIdx.x};
        pg8::EpiResid E{args.in[0], args.out, (bf16*)(ws + WS_XN), (float*)(ws + WS_SSQP)};
        pg8::gemm_phase<pg8::EpiResid, pg8::PanelOrder, true, true>(lds, g, S, E);
        __syncthreads();
        PHASE_IDS;
        if (tid < 256) { const int row = blockIdx.x * 256 + tid; const f32x4* p = (const f32x4*)((const float*)(ws + WS_SSQP) + (size_t)row * 16);
            const f32x4 s0 = p[0], s1 = p[1], s2 = p[2], s3 = p[3];
            const float ss = ((s0[0] + s0[1]) + (s0[2] + s0[3])) + ((s1[0] + s1[1]) + (s1[2] + s1[3])) + ((s2[0] + s2[1]) + (s2[2] + s2[3])) + ((s3[0] + s3[1]) + (s3[2] + s3[3]));
            ((float*)(ws + WS_RS2))[row] = rsqrtf(ss * (1.0f / DM) + NORM_EPS); }
    } SEAM(5);
#pragma unroll 1
    for (int half = 0; half < 2; ++half) {
        if (IN(6 + 2 * half)) {
            pg8::Gemm g{(const bf16*)(ws + WS_XN) + (size_t)half * MH * DM, (const bf16*)(ws + WS_WT_UP), MH, NUP, opaque_i(DM)}; pg8::StaticOrder S; S.init(MH, NUP, gridDim.x, (int)blockIdx.x);
            pg8::EpiScale E{(bf16*)(ws + WS_UH), NUP, (const float*)(ws + WS_RS2), half * MH};
            pg8::gemm_phase<pg8::EpiScale, pg8::StaticOrder, true, true>(lds, g, S, E);
        } SEAM(6 + 2 * half);
        if (IN(7 + 2 * half)) { PHASE_IDS; phase_conv(args, half, tid); } SEAM(7 + 2 * half);
    }
    if (IN(10)) {
        pg8::Gemm g{(const bf16*)(ws + WS_GB), (const bf16*)(ws + WS_WT_DN), M, DM, opaque_i(DFF)}; pg8::PanelOrder S{(int)blockIdx.x};
        pg8::EpiResid E{args.out, args.out, nullptr, (float*)(ws + WS_SSQP)};
        pg8::gemm_phase<pg8::EpiResid, pg8::PanelOrder, true, true>(lds, g, S, E);
        __builtin_amdgcn_fence(__ATOMIC_ACQUIRE, "agent");
        asm volatile("s_waitcnt vmcnt(0)" ::: "memory");
        __syncthreads();
        PHASE_IDS;
        LAS float* rsl = (LAS float*)lds;
        if (tid < 256) { const int row = blockIdx.x * 256 + tid; const f32x4* p = (const f32x4*)((const float*)(ws + WS_SSQP) + (size_t)row * 16);
            const f32x4 s0 = p[0], s1 = p[1], s2 = p[2], s3 = p[3];
            const float ss = ((s0[0] + s0[1]) + (s0[2] + s0[3])) + ((s1[0] + s1[1]) + (s1[2] + s1[3])) + ((s2[0] + s2[1]) + (s2[2] + s2[3])) + ((s3[0] + s3[1]) + (s3[2] + s3[3]));
            rsl[tid] = rsqrtf(ss * (1.0f / DM) + NORM_EPS); }
        __syncthreads();
        const float* gf = args.in[25];
        f32x4 gv[4];
#pragma unroll
        for (int j = 0; j < 4; ++j) gv[j] = *((const f32x4*)gf + lane + 64 * j);
        for (int r = wave; r < 256; r += 8) { const float rs = rsl[r]; f32x4* xr = (f32x4*)(args.out + (size_t)(blockIdx.x * 256 + r) * DM) + lane;
#pragma unroll
            for (int j = 0; j < 4; ++j) { const f32x4 v = xr[64 * j]; xr[64 * j] = v * rs * gv[j]; } }
    }
#undef IN
#undef SEAM
}

extern "C" void kernel_launch(void* const* d_in, const int* in_sizes, int n_in, void* d_out, int out_size, void* d_ws, size_t ws_size, hipStream_t stream) {
    static int grid = 0;
    if (grid == 0) {
        if (n_in != 26 || in_sizes[0] != M * DM || out_size != M * DM || ws_size < WS_END) { fprintf(stderr, "kernel_launch: unexpected shapes (n_in %d, in0 %d, out %d, ws %zu)\n", n_in, n_in > 0 ? in_sizes[0] : -1, out_size, ws_size); grid = -1; return; }
        int dev = 0, cus = 0, per_cu = 0;
        if (hipGetDevice(&dev) != hipSuccess || hipDeviceGetAttribute(&cus, hipDeviceAttributeMultiprocessorCount, dev) != hipSuccess) { grid = -1; return; }
        if (hipFuncSetAttribute((const void*)mega, hipFuncAttributeMaxDynamicSharedMemorySize, LDS_BYTES) != hipSuccess) { fprintf(stderr, "kernel_launch: hipFuncSetAttribute failed\n"); grid = -1; return; }
        if (hipOccupancyMaxActiveBlocksPerMultiprocessor(&per_cu, (const void*)mega, 512, LDS_BYTES) != hipSuccess || per_cu < 1) { fprintf(stderr, "kernel_launch: occupancy query says %d blocks per CU\n", per_cu); }
        (void)hipGetLastError();
        grid = cus;
        if (grid != 256) fprintf(stderr, "kernel_launch: %d CUs; this kernel is laid out for 256\n", grid);
    }
    if (grid < 0) return;
    (void)hipMemsetAsync((char*)d_ws + WS_CTL, 0, CTL_ZERO_BYTES, stream);
    Args a{};
    for (int i = 0; i < 26; ++i) a.in[i] = (const float*)d_in[i];
    a.out = (float*)d_out; a.ws = (unsigned char*)d_ws;
#if MK_SINGLE
    a.ph_lo = 0; a.ph_hi = N_PHASES;
    hipLaunchKernelGGL(mega, dim3(grid), dim3(512), LDS_BYTES, stream, a);
#else
    for (int p = 0; p < N_PHASES; ++p) { a.ph_lo = p; a.ph_hi = p + 1; hipLaunchKernelGGL(mega, dim3(grid), dim3(512), LDS_BYTES, stream, a); }
#endif
}
```

```cpp
#include <hip/hip_runtime.h>
#include <cstdio>
#include <cstdint>
namespace pg8 {
#define PG8_LAS __attribute__((address_space(3)))
typedef unsigned short bf16_t;
typedef short bf16x8 __attribute__((ext_vector_type(8)));
typedef float f32x4 __attribute__((ext_vector_type(4)));
typedef unsigned u32x4 __attribute__((ext_vector_type(4)));
constexpr int BM = 256, BK = 64, HALF = 128, HTB = HALF * BK * 2  , STAGE_BYTES = 8 * HTB, NXCD = 8, WGM = 8;

__host__ __device__ __forceinline__ int lds_byte(int r, int c) { const int st = (r >> 4) * 2 + (c >> 5), rr = r & 15, cc = c & 31, ob = rr * 64 + cc * 2; return st * 1024 + (ob ^ (((ob >> 9) & 1) << 5)); }
__host__ __device__ __forceinline__ void stage_rc(int b, int& R, int& C) { const int st = b / 1024, sb = b % 1024, swz = sb ^ (((sb >> 9) & 1) << 5); R = (st >> 1) * 16 + swz / 64; C = (st & 1) * 32 + (swz % 64) / 2; }
__host__ __device__ __forceinline__ int perm32(int rho) { const int n = rho >> 4, i = rho & 15; return 8 * (i >> 2) + 4 * n + (i & 3); }

struct Unit { int pm, pn; };
struct Gemm { const bf16_t* A; const bf16_t* Bt; int M, N, K; };

struct StaticOrder {
    int nM, nN, nwg, G, c;
    __host__ __device__ void init(int M, int N, int G_, int c_) { nM = M / BM; nN = N / BM; nwg = nM * nN; G = G_; c = c_; }
    __host__ __device__ bool next(int i, Unit& u) const {
        const long L = (long)i * G + c; if (L >= nwg) return false;
        int wgid = (int)L; { const int q = nwg / NXCD, r = nwg % NXCD, xcd = wgid % NXCD, off = wgid / NXCD; wgid = (xcd < r ? xcd * (q + 1) : r * (q + 1) + (xcd - r) * q) + off; }
        const int nig = WGM * nN, gid = wgid / nig, fm = gid * WGM, gsz = (nM - fm) < WGM ? (nM - fm) : WGM;
        u.pm = fm + ((wgid % nig) % gsz); u.pn = (wgid % nig) / gsz; return true;
    }
    __device__ __forceinline__ void a_ready(const Unit&) const {}
    __device__ __forceinline__ void done(const Unit&) const {}
};

__device__ __forceinline__ unsigned cvt_pk_bf16(float lo, float hi) { unsigned r; asm volatile("v_cvt_pk_bf16_f32 %0, %1, %2" : "=v"(r) : "v"(lo), "v"(hi)); return r; }
typedef float f32x2 __attribute__((ext_vector_type(2)));
__device__ __forceinline__ f32x2 gelu_pk(f32x2 v) {
    const f32x2 av = __builtin_elementwise_abs(v), d = av * 0.2316418882f + 1.0f;
    f32x2 t; t.x = __builtin_amdgcn_rcpf(d.x); t.y = __builtin_amdgcn_rcpf(d.y);
    f32x2 q = t * 0.5307027145f + (-0.7265760135f); q = q * t + 0.7107068705f; q = q * t + (-0.142248368f); q = q * t + 0.127414796f; q = q * t;
    const f32x2 s = (v * v) * (-0.72134752044f);
    f32x2 e; e.x = __builtin_amdgcn_exp2f(s.x); e.y = __builtin_amdgcn_exp2f(s.y);
    const f32x2 m = v * (q * e), r = v - m;
    f32x2 o; o.x = v.x < 0.f ? m.x : r.x; o.y = v.y < 0.f ? m.y : r.y; return o;
}

template <int ACT  > struct EpiBf16 {
    static constexpr bool PERM = true, AFTER_DRAIN = false; static_assert(ACT == 0 || ACT == 1, "EpiBf16: ACT is 0 (none) or 1 (gelu_pk)");
    bf16_t* O; int ldc; const float* bias; int split_cols; size_t split_stride; float scale0;
    __device__ __forceinline__ void operator()(const f32x4 (&acc)[2][2][4][2], const Unit& u, int wr, int wc, int fr, int fq) const {
        const int row0 = u.pm * BM + wr * 64 + fr; int colt = u.pn * BM; bf16_t* base = O;
        float sc = 1.f; if (split_cols) { const int t = colt / split_cols; base += (size_t)t * split_stride; colt -= t * split_cols; if (t == 0) sc = scale0; }
        const int col0 = colt + wc * 32 + 8 * fq, bcol0 = u.pn * BM + wc * 32 + 8 * fq;
        f32x4 bv[2][2];
#pragma unroll
        for (int bj = 0; bj < 2; ++bj)
#pragma unroll
            for (int n = 0; n < 2; ++n) bv[bj][n] = bias ? *(const f32x4*)(bias + bcol0 + bj * HALF + 4 * n) : (f32x4){0.f, 0.f, 0.f, 0.f};
#pragma unroll
        for (int ai = 0; ai < 2; ++ai)
#pragma unroll
            for (int m = 0; m < 4; ++m) { bf16_t* rowp = base + (size_t)(row0 + ai * HALF + m * 16) * ldc + col0;
#pragma unroll
                for (int bj = 0; bj < 2; ++bj) { f32x4 v0 = acc[ai][bj][m][0] + bv[bj][0], v1 = acc[ai][bj][m][1] + bv[bj][1];
                    if (ACT == 1) { f32x2 a = gelu_pk((f32x2){v0[0], v0[1]}), b = gelu_pk((f32x2){v0[2], v0[3]}), c = gelu_pk((f32x2){v1[0], v1[1]}), d = gelu_pk((f32x2){v1[2], v1[3]});
                        v0 = (f32x4){a.x, a.y, b.x, b.y}; v1 = (f32x4){c.x, c.y, d.x, d.y}; }
                    v0 = v0 * sc; v1 = v1 * sc; u32x4 w; w.x = cvt_pk_bf16(v0[0], v0[1]); w.y = cvt_pk_bf16(v0[2], v0[3]); w.z = cvt_pk_bf16(v1[0], v1[1]); w.w = cvt_pk_bf16(v1[2], v1[3]);
                    *(u32x4*)(rowp + bj * HALF) = w; } }
    }
};
template <class Epi, class Sched, bool ALIGN_EPI = false, bool SP2 = false>
__device__ __forceinline__ void gemm_phase(PG8_LAS unsigned char* lds, const Gemm g, const Sched& S, const Epi& E) {
    const int tid = threadIdx.x, wid = __builtin_amdgcn_readfirstlane(tid >> 6), lane = tid & 63, wr = wid >> 2, wc = wid & 3, fr = lane & 15, fq = lane >> 4;
    const int K = g.K, nt = K / BK;
    unsigned voffA[2], voffB[2];
#pragma unroll
    for (int i = 0; i < 2; ++i) { int R, C; stage_rc(tid * 16 + i * 8192, R, C); const int Rb = Epi::PERM ? ((R & ~31) + perm32(R & 31)) : R;
        voffA[i] = (unsigned)(R * K + C) * 2u; voffB[i] = (unsigned)(Rb * K + C) * 2u; }
    const size_t kstep = (size_t)(BK * 2);
    const size_t hstep = (size_t)HALF * K * 2;
    const size_t tstep = 2 * hstep;
    const unsigned ldsw = (unsigned)wid * 1024u;
    const int aoff = lds_byte(wr * 64 + fr, fq * 8), boff = lds_byte(wc * 32 + fr, fq * 8);
#define PG8_SA(b, h) (((b) * 2 + (h)) * HTB)
#define PG8_SB(b, h) ((4 + (b) * 2 + (h)) * HTB)
#define PG8_STAGE(bufoff, gbase, voff) do { _Pragma("unroll") for (int _i = 0; _i < 2; ++_i) \
        __builtin_amdgcn_global_load_lds((const unsigned*)((const char*)(gbase) + (voff)[_i]), (PG8_LAS unsigned*)(lds + (bufoff) + ldsw + _i * 8192), 16, 0, 0); } while (0)
#define PG8_LDA(dst, b, h) do { _Pragma("unroll") for (int m = 0; m < 4; ++m) _Pragma("unroll") for (int k = 0; k < 2; ++k) dst[m][k] = *(const PG8_LAS bf16x8*)(lds + PG8_SA(b, h) + aoff + m * 2048 + k * 1024); } while (0)
#define PG8_LDB(dst, b, h) do { _Pragma("unroll") for (int n = 0; n < 2; ++n) _Pragma("unroll") for (int k = 0; k < 2; ++k) dst[n][k] = *(const PG8_LAS bf16x8*)(lds + PG8_SB(b, h) + boff + n * 2048 + k * 1024); } while (0)
#define PG8_MMA(ai, bj, At, Bt) do { __builtin_amdgcn_s_setprio(1); _Pragma("unroll") for (int m = 0; m < 4; ++m) _Pragma("unroll") for (int n = 0; n < 2; ++n) _Pragma("unroll") for (int k = 0; k < 2; ++k) \
        acc[ai][bj][m][n] = __builtin_amdgcn_mfma_f32_16x16x32_bf16(Bt[n][k], At[m][k], acc[ai][bj][m][n], 0, 0, 0); __builtin_amdgcn_s_setprio(0); } while (0)
#define PG8_WAIT_V(n) asm volatile("s_waitcnt vmcnt(" #n ")" ::: "memory")
#define PG8_WAIT_L(n) asm volatile("s_waitcnt lgkmcnt(" #n ")" ::: "memory")
#define PG8_BAR __builtin_amdgcn_s_barrier()
#define PG8_SCHED __builtin_amdgcn_sched_barrier(0)
    Unit cur, nxt; int ui = 0;
    if (!S.next(0, cur)) return;
    f32x4 acc[2][2][4][2];
#pragma unroll
    for (int a = 0; a < 2; ++a)
#pragma unroll
        for (int b = 0; b < 2; ++b)
#pragma unroll
            for (int m = 0; m < 4; ++m)
#pragma unroll
                for (int n = 0; n < 2; ++n) acc[a][b][m][n] = (f32x4){0.f, 0.f, 0.f, 0.f};
    bf16x8 At[4][2], B0[2][2], B1[2][2];
    const char* cA = (const char*)g.A + (size_t)cur.pm * tstep; const char* cB = (const char*)g.Bt + (size_t)cur.pn * tstep;
    S.a_ready(cur);
    if constexpr (SP2) {
        PG8_STAGE(PG8_SB(0, 0), cB, voffB); PG8_STAGE(PG8_SB(0, 1), cB + hstep, voffB); PG8_STAGE(PG8_SA(0, 0), cA, voffA); PG8_STAGE(PG8_SA(0, 1), cA + hstep, voffA);
        if (wr == 1) PG8_BAR;
        PG8_WAIT_V(2); PG8_BAR;
        PG8_STAGE(PG8_SB(1, 0), cB + kstep, voffB); PG8_STAGE(PG8_SA(1, 0), cA + kstep, voffA); PG8_STAGE(PG8_SB(1, 1), cB + hstep + kstep, voffB);
        PG8_WAIT_V(6); PG8_BAR;
    } else {
        PG8_STAGE(PG8_SB(0, 0), cB, voffB); PG8_STAGE(PG8_SA(0, 0), cA, voffA); PG8_STAGE(PG8_SB(0, 1), cB + hstep, voffB); PG8_STAGE(PG8_SA(0, 1), cA + hstep, voffA);
        if (wr == 1) PG8_BAR;
        PG8_WAIT_V(4); PG8_BAR;
        PG8_STAGE(PG8_SB(1, 0), cB + kstep, voffB); PG8_STAGE(PG8_SA(1, 0), cA + kstep, voffA); PG8_STAGE(PG8_SB(1, 1), cB + hstep + kstep, voffB);
        PG8_WAIT_V(6); PG8_BAR;
    }
    for (;;) {
        const bool has_next = S.next(ui + 1, nxt);
        const char* nA = has_next ? (const char*)g.A + (size_t)nxt.pm * tstep : cA; const char* nB = has_next ? (const char*)g.Bt + (size_t)nxt.pn * tstep : cB;
        for (int t = 0; t < nt; t += 2) {
            const bool last = (t == nt - 2);
            const char* a1 = cA + (size_t)(t + 1) * kstep;
            const char* a2 = last ? nA : cA + (size_t)(t + 2) * kstep; const char* b2 = last ? nB : cB + (size_t)(t + 2) * kstep;
            const char* a3 = a2 + kstep; const char* b3 = b2 + kstep;
            if (last && has_next) S.a_ready(nxt);
            if constexpr (SP2) {
            PG8_LDB(B0, 0, 0); PG8_LDB(B1, 0, 1); PG8_SCHED; PG8_LDA(At, 0, 0); PG8_STAGE(PG8_SA(1, 1), a1 + hstep, voffA);
            PG8_WAIT_V(8); PG8_WAIT_L(0); PG8_BAR; PG8_MMA(0, 0, At, B0); PG8_MMA(0, 1, At, B1); PG8_BAR; PG8_SCHED;
            PG8_LDA(At, 0, 1); PG8_STAGE(PG8_SB(0, 0), b2, voffB); PG8_STAGE(PG8_SB(0, 1), b2 + hstep, voffB); PG8_STAGE(PG8_SA(0, 0), a2, voffA);
            PG8_WAIT_V(8); PG8_WAIT_L(0); PG8_BAR; PG8_MMA(1, 0, At, B0); PG8_MMA(1, 1, At, B1); PG8_BAR; PG8_SCHED;
            PG8_LDB(B0, 1, 0); PG8_LDB(B1, 1, 1); PG8_SCHED; PG8_LDA(At, 1, 0); PG8_STAGE(PG8_SA(0, 1), a2 + hstep, voffA);
            PG8_WAIT_V(8); PG8_WAIT_L(0); PG8_BAR; PG8_MMA(0, 0, At, B0); PG8_MMA(0, 1, At, B1); PG8_BAR; PG8_SCHED;
            PG8_LDA(At, 1, 1); PG8_STAGE(PG8_SB(1, 0), b3, voffB); PG8_STAGE(PG8_SB(1, 1), b3 + hstep, voffB); PG8_STAGE(PG8_SA(1, 0), a3, voffA);
            PG8_WAIT_V(8); PG8_WAIT_L(0); PG8_BAR; PG8_MMA(1, 0, At, B0); PG8_MMA(1, 1, At, B1); PG8_BAR; PG8_SCHED;
            } else {
            PG8_LDB(B0, 0, 0); PG8_SCHED; PG8_LDA(At, 0, 0); PG8_STAGE(PG8_SA(1, 1), a1 + hstep, voffA);
            PG8_WAIT_L(8); PG8_BAR; PG8_WAIT_L(0); PG8_MMA(0, 0, At, B0); PG8_BAR; PG8_SCHED;
            PG8_LDB(B1, 0, 1); PG8_STAGE(PG8_SB(0, 0), b2, voffB);
            PG8_BAR; PG8_WAIT_L(0); PG8_MMA(0, 1, At, B1); PG8_BAR;
            PG8_LDA(At, 0, 1); PG8_STAGE(PG8_SA(0, 0), a2, voffA);
            PG8_BAR; PG8_WAIT_L(0); PG8_MMA(1, 0, At, B0); PG8_BAR; PG8_SCHED;
            PG8_STAGE(PG8_SB(0, 1), b2 + hstep, voffB);
            PG8_WAIT_V(6); PG8_BAR; PG8_MMA(1, 1, At, B1); PG8_BAR;
            PG8_LDB(B0, 1, 0); PG8_SCHED; PG8_LDA(At, 1, 0); PG8_STAGE(PG8_SA(0, 1), a2 + hstep, voffA);
            PG8_WAIT_L(8); PG8_BAR; PG8_WAIT_L(0); PG8_MMA(0, 0, At, B0); PG8_BAR; PG8_SCHED;
            PG8_LDB(B1, 1, 1); PG8_STAGE(PG8_SB(1, 0), b3, voffB);
            PG8_BAR; PG8_WAIT_L(0); PG8_MMA(0, 1, At, B1); PG8_BAR;
            PG8_LDA(At, 1, 1); PG8_STAGE(PG8_SA(1, 0), a3, voffA);
            PG8_BAR; PG8_WAIT_L(0); PG8_MMA(1, 0, At, B0); PG8_BAR; PG8_SCHED;
            PG8_STAGE(PG8_SB(1, 1), b3 + hstep, voffB);
            PG8_WAIT_V(6); PG8_BAR; PG8_MMA(1, 1, At, B1); PG8_BAR;
            }
        }
        if constexpr (ALIGN_EPI) { if (wr == 0) PG8_BAR; }
        if constexpr (!Epi::AFTER_DRAIN) { E(acc, cur, wr, wc, fr, fq); S.done(cur); }
        if (!has_next) break;
#pragma unroll
        for (int a = 0; a < 2; ++a)
#pragma unroll
            for (int b = 0; b < 2; ++b)
#pragma unroll
                for (int m = 0; m < 4; ++m)
#pragma unroll
                    for (int n = 0; n < 2; ++n) acc[a][b][m][n] = (f32x4){0.f, 0.f, 0.f, 0.f};
        cur = nxt; cA = nA; cB = nB; ++ui;
        if constexpr (ALIGN_EPI) { if (wr == 1) PG8_BAR; }
    }
    PG8_WAIT_V(0);
    if constexpr (!ALIGN_EPI) { if (wr == 0) PG8_BAR; }
    PG8_BAR;
    if constexpr (Epi::AFTER_DRAIN) { E.fused(acc, cur, wr, wc, fr, fq, lds, wid, lane); S.done(cur); }
#undef PG8_SA
#undef PG8_SB
#undef PG8_STAGE
#undef PG8_LDA
#undef PG8_LDB
#undef PG8_MMA
#undef PG8_WAIT_V
#undef PG8_WAIT_L
#undef PG8_BAR
#undef PG8_SCHED
}
}

#ifndef MK_SINGLE
#define MK_SINGLE 1
#endif
constexpr int BATCH = 32, SEQ = 2048, DM = 1024, M = BATCH * SEQ;
constexpr int NIN = 3336, NPROJ = 3328;
constexpr int DFF = 2816, NUP = 2 * DFF;
constexpr int C_Q = 1792, C_K = 2048, C_V = 2304, C_O = 2816;
constexpr int NLORA = 1536, KLORA = 256;
constexpr int MH = M / 2;
constexpr float NORM_EPS = 1e-6f, LNX_EPS = 64e-5f;

constexpr size_t MiB = 1u << 20;
constexpr size_t WS_CTL = 0, CTL_ZERO_BYTES = 1 * MiB;
constexpr size_t WS_WT_IN = 2 * MiB, WS_WT_OUT = 9 * MiB, WS_WT_UP = 11 * MiB, WS_WT_DN = 22 * MiB, WS_WT_LORA = 28 * MiB;
constexpr size_t WS_RS2 = 29 * MiB, WS_SSQP = 30 * MiB, WS_GATES = 34 * MiB;
constexpr size_t WS_XN = 40 * MiB;
constexpr size_t WS_PROJ = 168 * MiB;
constexpr size_t WS_LBUF = 584 * MiB;
constexpr size_t WS_DAG = 616 * MiB;
constexpr size_t WS_MIX = 808 * MiB;
constexpr size_t WS_SIDE = 168 * MiB;
constexpr int SIDE_ELEMS = 256 * 22 * 2 * 128;
constexpr size_t WS_GB = 520 * MiB;
constexpr size_t WS_END = 936 * MiB;

constexpr int LDS_BYTES = 147456;
constexpr int MISC_OFF = 131072 + 320;

#define GAS __attribute__((address_space(1)))
#define LAS __attribute__((address_space(3)))
typedef unsigned short bf16;
typedef unsigned v4u __attribute__((ext_vector_type(4)));
typedef unsigned v2u __attribute__((ext_vector_type(2)));
typedef float f32x4 __attribute__((ext_vector_type(4)));
typedef float f32x2 __attribute__((ext_vector_type(2)));
typedef short bf16x8 __attribute__((ext_vector_type(8)));
typedef GAS unsigned gu32;

__device__ __forceinline__ unsigned f2bf(float f) { unsigned u = __builtin_bit_cast(unsigned, f); return (u + 0x7fffu + ((u >> 16) & 1u)) >> 16; }
__device__ __forceinline__ unsigned pk2(float lo, float hi) { return f2bf(lo) | (f2bf(hi) << 16); }
__device__ __forceinline__ float bf2f(unsigned short u) { return __builtin_bit_cast(float, (unsigned)u << 16); }
__device__ __forceinline__ float bflo(unsigned w) { return __builtin_bit_cast(float, w << 16); }
__device__ __forceinline__ float bfhi(unsigned w) { return __builtin_bit_cast(float, w & 0xffff0000u); }
__device__ __forceinline__ void unpack8(const v4u w, float (&o)[8]) { o[0] = bflo(w.x); o[1] = bfhi(w.x); o[2] = bflo(w.y); o[3] = bfhi(w.y); o[4] = bflo(w.z); o[5] = bfhi(w.z); o[6] = bflo(w.w); o[7] = bfhi(w.w); }
__device__ __forceinline__ v4u pack8(const float (&o)[8]) { v4u w; w.x = pk2(o[0], o[1]); w.y = pk2(o[2], o[3]); w.z = pk2(o[4], o[5]); w.w = pk2(o[6], o[7]); return w; }
__device__ __forceinline__ float sigmoidf_(float x) { return 1.0f / (1.0f + __expf(-x)); }
__device__ __forceinline__ float tanhf_(float x) { return 1.0f - 2.0f / (__expf(2.0f * x) + 1.0f); }
__device__ __forceinline__ float softplusf_(float x) { return fmaxf(x, 0.f) + log1pf(__expf(-fabsf(x))); }
__device__ __forceinline__ float wave_sum(float v) {
#pragma unroll
    for (int o = 1; o < 64; o <<= 1) v += __shfl_xor(v, o);
    return v;
}
template <int CTRL> __device__ __forceinline__ float dppmov(float v) { return __builtin_bit_cast(float, __builtin_amdgcn_update_dpp(0, __builtin_bit_cast(int, v), CTRL, 0xF, 0xF, true)); }
__device__ __forceinline__ float red8(float v) { v += dppmov<0xB1>(v); v += dppmov<0x4E>(v); v += dppmov<0x141>(v); return v; }
__device__ __forceinline__ float red16(float v) { v += dppmov<0xB1>(v); v += dppmov<0x4E>(v); v += dppmov<0x141>(v); v += dppmov<0x140>(v); return v; }

#define XB_TMO      128
#define XB_XCNT(j)  (256  + 64 * (j))
#define XB_XSUB(j)  (1280 + 64 * (j))
#define XB_XGEN(j)  (2304 + 64 * (j))
#define XB_TOP      3328
#define XB_TOPGEN   3392
#define XCD_BAR_WORDS 3456
#define XB_SPIN_CAP (1u << 22)
__device__ __forceinline__ unsigned xb_ld(unsigned* p)              { return __hip_atomic_load(p, __ATOMIC_RELAXED, __HIP_MEMORY_SCOPE_AGENT); }
__device__ __forceinline__ unsigned xb_add(unsigned* p, unsigned v) { return __hip_atomic_fetch_add(p, v, __ATOMIC_RELAXED, __HIP_MEMORY_SCOPE_AGENT); }
__device__ __forceinline__ unsigned xb_xcc_id() { return (unsigned)__builtin_amdgcn_s_getreg((3 << 11) | 20) & 0xFu; }
#define XB_SPIN(cond, bar) do { unsigned _sp = 0; while (cond) { __builtin_amdgcn_s_sleep(1); \
    if ((++_sp & 255u) == 0u) { if (xb_ld(&(bar)[XB_TMO])) break; if (_sp > XB_SPIN_CAP) { atomicAdd(&(bar)[XB_TMO], 1u); break; } } } } while (0)
struct XcdBarrier { unsigned* bar; unsigned x; volatile LAS unsigned* st; };
__device__ __forceinline__ XcdBarrier xcd_barrier_post(unsigned* bar, volatile LAS unsigned* st) {
    XcdBarrier b; b.bar = bar; b.x = xb_xcc_id(); b.st = st;
    if (threadIdx.x == 0) (void)xb_add(&bar[XB_XCNT(b.x)], 1u);
    return b;
}
__device__ __forceinline__ void xcd_barrier_complete(unsigned* bar, unsigned x, unsigned& nloc, unsigned& nx) {
    const unsigned G = gridDim.x * gridDim.y * gridDim.z;
    unsigned sum, cnt, mine, sp = 0u;
    for (;;) {
        sum = 0u; cnt = 0u; mine = 0u;
#pragma unroll
        for (unsigned j = 0; j < 16; ++j) { const unsigned c = xb_ld(&bar[XB_XCNT(j)]); sum += c; cnt += (c > 0u) ? 1u : 0u; mine = (j == x) ? c : mine; }
        if (sum == G) break;
        __builtin_amdgcn_s_sleep(1);
        if ((++sp & 255u) == 0u) { if (xb_ld(&bar[XB_TMO])) break; if (sp > XB_SPIN_CAP) { atomicAdd(&bar[XB_TMO], 1u); break; } }
    }
    nloc = mine > 0u ? mine : 1u; nx = cnt > 0u ? cnt : 1u;
}
__device__ __forceinline__ void xcd_barrier(const XcdBarrier& b) {
    asm volatile("s_waitcnt vmcnt(0)" ::: "memory");
    __syncthreads();
    if (threadIdx.x == 0) {
        unsigned* bar = b.bar;
        __builtin_amdgcn_s_waitcnt(0);
        unsigned nloc = b.st[0], nx = b.st[1];
        if (nloc == 0u) { xcd_barrier_complete(bar, b.x, nloc, nx); b.st[0] = nloc; b.st[1] = nx; }
        const unsigned old = xb_add(&bar[XB_XSUB(b.x)], 1u);
        const unsigned gen = old / nloc;
        if (old + 1u == (gen + 1u) * nloc) {
            __builtin_amdgcn_fence(__ATOMIC_RELEASE, "agent");
            asm volatile("s_waitcnt vmcnt(0)" ::: "memory");
            const unsigned og = xb_add(&bar[XB_TOP], 1u);
            const unsigned tg = og / nx;
            if (og + 1u == (tg + 1u) * nx) xb_add(&bar[XB_TOPGEN], 1u);
            else XB_SPIN(xb_ld(&bar[XB_TOPGEN]) == tg, bar);
            __builtin_amdgcn_fence(__ATOMIC_ACQUIRE, "agent");
            xb_add(&bar[XB_XGEN(b.x)], 1u);
            asm volatile("s_waitcnt vmcnt(0)" ::: "memory");
        } else {
            XB_SPIN(xb_ld(&bar[XB_XGEN(b.x)]) == gen, bar);
            __builtin_amdgcn_fence(__ATOMIC_ACQUIRE, "agent");
            asm volatile("s_waitcnt vmcnt(0)" ::: "memory");
        }
    }
    __syncthreads();
}

__device__ __forceinline__ int opaque_i(int v) { asm volatile("" : "+s"(v)); return v; }
struct Args { const float* in[26]; float* out; unsigned char* ws; int ph_lo, ph_hi; };

namespace pg8 {
struct PanelOrder {
    int c;
    __device__ bool next(int i, Unit& u) const { if (i >= 4) return false; u.pm = c; u.pn = i; return true; }
    __device__ __forceinline__ void a_ready(const Unit&) const {}
    __device__ __forceinline__ void done(const Unit&) const {}
};
struct EpiResid {
    static constexpr bool PERM = true, AFTER_DRAIN = false;
    const float* X; float* X2; bf16_t* XB; float* ssqp;
    __device__ __forceinline__ void operator()(const f32x4 (&acc)[2][2][4][2], const Unit& u, int wr, int wc, int fr, int fq) const {
        int pm_ = u.pm; asm volatile("" : "+s"(pm_));
        const int row0 = pm_ * BM + wr * 64 + fr, col0 = u.pn * BM + wc * 32 + 8 * fq;
#pragma unroll
        for (int ai = 0; ai < 2; ++ai)
#pragma unroll
            for (int m = 0; m < 4; ++m) { const int row = row0 + ai * HALF + m * 16; float ss = 0.f;
#pragma unroll
                for (int bj = 0; bj < 2; ++bj) { const size_t off = (size_t)row * DM + col0 + bj * HALF;
                    const f32x4 x0 = *(const f32x4*)(X + off), x1 = *(const f32x4*)(X + off + 4);
                    const f32x4 v0 = acc[ai][bj][m][0] + x0, v1 = acc[ai][bj][m][1] + x1;
                    *(f32x4*)(X2 + off) = v0; *(f32x4*)(X2 + off + 4) = v1;
                    ss += (v0[0] * v0[0] + v0[1] * v0[1]) + (v0[2] * v0[2] + v0[3] * v0[3]) + (v1[0] * v1[0] + v1[1] * v1[1]) + (v1[2] * v1[2] + v1[3] * v1[3]);
                    if (XB) { u32x4 w; w.x = pk2(v0[0], v0[1]); w.y = pk2(v0[2], v0[3]); w.z = pk2(v1[0], v1[1]); w.w = pk2(v1[2], v1[3]); *(u32x4*)(XB + off) = w; } }
                ss += __shfl_xor(ss, 16); ss += __shfl_xor(ss, 32);
                if (fq == 0) ssqp[(size_t)row * 16 + u.pn * 4 + wc] = ss; }
    }
};
struct EpiScale {
    static constexpr bool PERM = true, AFTER_DRAIN = false;
    bf16_t* O; int ldc; const float* rs; int row_off;
    __device__ __forceinline__ void operator()(const f32x4 (&acc)[2][2][4][2], const Unit& u, int wr, int wc, int fr, int fq) const {
        const int row0 = u.pm * BM + wr * 64 + fr, col0 = u.pn * BM + wc * 32 + 8 * fq;
#pragma unroll
        for (int ai = 0; ai < 2; ++ai)
#pragma unroll
            for (int m = 0; m < 4; ++m) { const int row = row0 + ai * HALF + m * 16; const float s = rs[row_off + row]; bf16_t* rowp = O + (size_t)row * ldc + col0;
#pragma unroll
                for (int bj = 0; bj < 2; ++bj) { const f32x4 v0 = acc[ai][bj][m][0] * s, v1 = acc[ai][bj][m][1] * s;
                    u32x4 w; w.x = pk2(v0[0], v0[1]); w.y = pk2(v0[2], v0[3]); w.z = pk2(v1[0], v1[1]); w.w = pk2(v1[2], v1[3]); *(u32x4*)(rowp + bj * HALF) = w; } }
    }
};
struct EpiFfn {
    static constexpr bool PERM = true, AFTER_DRAIN = false;
    bf16_t* G; const float* rs; const float* cw; const float* cb; float* SA; float* SB; float* SL; LAS float* hal;
    __device__ __forceinline__ void operator()(const f32x4 (&acc)[2][2][4][2], const Unit& u, int wr, int wc, int fr, int fq) const {
        int chl = wc * 32 + 8 * fq; asm volatile("" : "+v"(chl));
        const int f0 = u.pn * 128 + chl, rowt = wr * 64 + fr;
        float rsv[2][4];
#pragma unroll
        for (int ai = 0; ai < 2; ++ai)
#pragma unroll
            for (int m = 0; m < 4; ++m) rsv[ai][m] = rs[u.pm * BM + ai * HALF + m * 16 + rowt];
        const size_t sbase = ((size_t)(u.pm * 22 + u.pn) * 2) * 128 + chl;
        if (fr >= 14) {
#pragma unroll
            for (int ai = 0; ai < 2; ++ai) { const float r_ = rsv[ai][3]; const f32x4 v0 = acc[ai][0][3][0] * r_, v1 = acc[ai][0][3][1] * r_;
                LAS float* hp = hal + ((ai * 2 + wr) * 2 + (fr - 14)) * 128 + chl; *(LAS f32x4*)hp = v0; *(LAS f32x4*)(hp + 4) = v1;
                if (ai == 1 && wr == 1) { float* gp = SL + sbase + (fr - 14) * 128; *(f32x4*)gp = v0; *(f32x4*)(gp + 4) = v1; } }
        }
        if (wr == 0 && fr < 2) { const float r_ = rsv[0][0]; float* ga = SA + sbase + fr * 128; float* gb = SB + sbase + fr * 128;
            *(f32x4*)ga = acc[0][0][0][0] * r_; *(f32x4*)(ga + 4) = acc[0][0][0][1] * r_; *(f32x4*)gb = acc[0][1][0][0] * r_; *(f32x4*)(gb + 4) = acc[0][1][0][1] * r_; }
        asm volatile("s_waitcnt lgkmcnt(0)" ::: "memory"); __builtin_amdgcn_s_barrier(); asm volatile("" ::: "memory");
        float w0[8], w1[8], w2[8], bz[8];
        { const f32x4 a0 = *(const f32x4*)(cw + f0), a1 = *(const f32x4*)(cw + f0 + 4), b0 = *(const f32x4*)(cw + DFF + f0), b1 = *(const f32x4*)(cw + DFF + f0 + 4);
          const f32x4 c0 = *(const f32x4*)(cw + 2 * DFF + f0), c1 = *(const f32x4*)(cw + 2 * DFF + f0 + 4), d0 = *(const f32x4*)(cb + f0), d1 = *(const f32x4*)(cb + f0 + 4);
#pragma unroll
          for (int j = 0; j < 4; ++j) { w0[j] = a0[j]; w0[4 + j] = a1[j]; w1[j] = b0[j]; w1[4 + j] = b1[j]; w2[j] = c0[j]; w2[4 + j] = c1[j]; bz[j] = d0[j]; bz[4 + j] = d1[j]; } }
        const bool fr0 = (fr == 0), frl2 = (fr < 2);
#pragma unroll
        for (int ai = 0; ai < 2; ++ai) {
            float ap[8];
            const int pb = ai * 2 + wr - 1;
#pragma unroll
            for (int m = 0; m < 4; ++m) {
                float av[8], bv[8], y1[8], y2[8];
                const float r_ = rsv[ai][m];
#pragma unroll
                for (int j = 0; j < 4; ++j) { av[j] = acc[ai][0][m][0][j] * r_; av[4 + j] = acc[ai][0][m][1][j] * r_; bv[j] = acc[ai][1][m][0][j] * r_; bv[4 + j] = acc[ai][1][m][1][j] * r_; }
                if (m == 0) {
                    if (pb >= 0) { const LAS float* h0 = hal + (pb * 2) * 128 + chl; const f32x4 h00 = *(const LAS f32x4*)h0, h01 = *(const LAS f32x4*)(h0 + 4), h10 = *(const LAS f32x4*)(h0 + 128), h11 = *(const LAS f32x4*)(h0 + 132);
#pragma unroll
                        for (int j = 0; j < 4; ++j) { y1[j] = h10[j]; y1[4 + j] = h11[j]; y2[j] = fr0 ? h00[j] : h10[j]; y2[4 + j] = fr0 ? h01[j] : h11[j]; } }
                    else {
#pragma unroll
                        for (int j = 0; j < 8; ++j) { y1[j] = 0.f; y2[j] = 0.f; } }
                } else {
#pragma unroll
                    for (int j = 0; j < 8; ++j) { y1[j] = dppmov<0x121>(ap[j]); y2[j] = dppmov<0x122>(ap[j]); }
                }
                float o[8];
#pragma unroll
                for (int j = 0; j < 8; ++j) { const float x1 = dppmov<0x121>(av[j]), x2 = dppmov<0x122>(av[j]);
                    const float am1 = fr0 ? y1[j] : x1, am2 = frl2 ? y2[j] : x2;
                    const float z = bz[j] + w0[j] * am2 + w1[j] * am1 + w2[j] * av[j];
                    o[j] = z * sigmoidf_(z) * bv[j]; ap[j] = av[j]; }
                if (!(ai == 0 && m == 0 && wr == 0 && frl2)) *(u32x4*)(G + (size_t)(u.pm * BM + ai * HALF + m * 16 + rowt) * DFF + f0) = pack8(o);
            }
        }
    }
};
}

template <bool FFN_UP = false>
__device__ __forceinline__ void transpose_item(const float* W, int ldw, int K, bf16* WT, const float* kscale, LAS float* scr, int item, int nblk, int lane) {
    const int kb = item / nblk, nb = item % nblk, k0 = 64 * kb, n0 = 32 * nb;
    const int d0 = !FFN_UP ? n0 : (n0 < DFF ? ((n0 >> 7) * 256 + (n0 & 127)) : ((((n0 - DFF) >> 7) * 256) + 128 + ((n0 - DFF) & 127)));
#pragma unroll 8
    for (int i = 0; i < 32; ++i) { const int kk = 2 * i + (lane >> 5); const float s = kscale ? kscale[k0 + kk] : 1.0f; scr[kk * 33 + (lane & 31)] = W[(size_t)(k0 + kk) * ldw + n0 + (lane & 31)] * s; }
    asm volatile("s_waitcnt lgkmcnt(0)" ::: "memory");
    const int c = lane & 7;
#pragma unroll
    for (int j = 0; j < 4; ++j) { const int n = (lane >> 3) + 8 * j; const LAS float* s = scr + (8 * c) * 33 + n;
        v4u o; o.x = pk2(s[0 * 33], s[1 * 33]); o.y = pk2(s[2 * 33], s[3 * 33]); o.z = pk2(s[4 * 33], s[5 * 33]); o.w = pk2(s[6 * 33], s[7 * 33]);
        *(v4u*)(WT + (size_t)(d0 + n) * K + k0 + 8 * c) = o; }
    asm volatile("s_waitcnt lgkmcnt(0)" ::: "memory");
}

__device__ __forceinline__ void phase_prep(const Args& a, LAS unsigned char* lds, int tid, int lane, int wave) {
    unsigned char* ws = a.ws;
    LAS float* scr = (LAS float*)(lds + wave * 16384);
    const int gw = blockIdx.x * 8 + wave, NGW = gridDim.x * 8;
    constexpr int I_IN = 16 * 104, I_OUT = 16 * 32, I_UP = 16 * 176, I_DN = 44 * 32;
    for (int it = gw; it < I_IN + I_OUT + I_UP + I_DN; it += NGW) {
        int r = it;
        if (r < I_IN) { transpose_item(a.in[2], NIN, DM, (bf16*)(ws + WS_WT_IN), a.in[1], scr, r, 104, lane); continue; } r -= I_IN;
        if (r < I_OUT) { transpose_item(a.in[19], DM, DM, (bf16*)(ws + WS_WT_OUT), nullptr, scr, r, 32, lane); continue; } r -= I_OUT;
        if (r < I_UP) { transpose_item<true>(a.in[21], NUP, DM, (bf16*)(ws + WS_WT_UP), a.in[20], scr, r, 176, lane); continue; } r -= I_UP;
        transpose_item(a.in[24], DM, DFF, (bf16*)(ws + WS_WT_DN), nullptr, scr, r, 32, lane);
    }
    {
        const float* wd = a.in[5]; const float* wa = a.in[7]; const float* wg = a.in[8]; bf16* WL = (bf16*)(ws + WS_WT_LORA);
        for (int idx = blockIdx.x * 512 + tid; idx < NLORA * KLORA; idx += gridDim.x * 512) {
            const int n = idx >> 8, k = idx & 255; float v = 0.f;
            if (n < 512) { if (k < 64) v = wd[k * 512 + n]; }
            else if (n < 1024) { if (k >= 64 && k < 128) v = wa[(k - 64) * 512 + (n - 512)]; }
            else { if (k >= 128) v = wg[(k - 128) * 512 + (n - 1024)]; }
            WL[idx] = (bf16)f2bf(v);
        }
    }
    {
        const float* x = a.in[0]; const float* g1 = a.in[1]; const float* w_in = a.in[2];
        bf16* XN = (bf16*)(ws + WS_XN); float* gates = (float*)(ws + WS_GATES);
        float wgt[16][8];
#pragma unroll
        for (int j = 0; j < 4; ++j)
#pragma unroll
            for (int e = 0; e < 4; ++e) { const int k = 4 * lane + 256 * j + e; const float g = g1[k];
                const f32x4 w0 = *(const f32x4*)(w_in + (size_t)k * NIN + 3328), w1 = *(const f32x4*)(w_in + (size_t)k * NIN + 3332);
                wgt[j * 4 + e][0] = w0[0] * g; wgt[j * 4 + e][1] = w0[1] * g; wgt[j * 4 + e][2] = w0[2] * g; wgt[j * 4 + e][3] = w0[3] * g;
                wgt[j * 4 + e][4] = w1[0] * g; wgt[j * 4 + e][5] = w1[1] * g; wgt[j * 4 + e][6] = w1[2] * g; wgt[j * 4 + e][7] = w1[3] * g; }
        for (int row = gw; row < M; row += NGW) {
            const f32x4* xr = (const f32x4*)(x + (size_t)row * DM) + lane;
            f32x4 v[4]; float ss = 0.f;
#pragma unroll
            for (int j = 0; j < 4; ++j) { v[j] = xr[64 * j]; ss += (v[j][0] * v[j][0] + v[j][1] * v[j][1]) + (v[j][2] * v[j][2] + v[j][3] * v[j][3]); }
            ss = wave_sum(ss);
            const float rs = rsqrtf(ss * (1.0f / DM) + NORM_EPS);
            unsigned long long* o8 = (unsigned long long*)(XN + (size_t)row * DM) + lane;
#pragma unroll
            for (int j = 0; j < 4; ++j) o8[64 * j] = (unsigned long long)pk2(v[j][0] * rs, v[j][1] * rs) | ((unsigned long long)pk2(v[j][2] * rs, v[j][3] * rs) << 32);
            float gs[8];
#pragma unroll
            for (int jg = 0; jg < 8; ++jg) { float s = 0.f;
#pragma unroll
                for (int j = 0; j < 4; ++j)
#pragma unroll
                    for (int e = 0; e < 4; ++e) s += v[j][e] * wgt[j * 4 + e][jg];
                gs[jg] = wave_sum(s); }
            if (lane < 8) { float s = gs[0];
#pragma unroll
                for (int jg = 1; jg < 8; ++jg) s = (lane == jg) ? gs[jg] : s;
                gates[(size_t)row * 8 + lane] = s * rs; }
        }
    }
}

__device__ __forceinline__ void phase_lmat(const Args& a, int tid) {
    unsigned char* ws = a.ws; const bf16* PROJ = (const bf16*)(ws + WS_PROJ); bf16* L = (bf16*)(ws + WS_LBUF); const float* mu = a.in[3];
    const int NT = gridDim.x * 512;
    for (int it = blockIdx.x * 512 + tid; it < M * 32; it += NT) {
        const int row = it >> 5, grp = it & 31, c0 = 1536 + 8 * grp;
        const v4u cur = *(const v4u*)(PROJ + (size_t)row * NPROJ + c0);
        v4u prv = {0u, 0u, 0u, 0u}; if ((row & (SEQ - 1)) != 0) prv = *(const v4u*)(PROJ + (size_t)(row - 1) * NPROJ + c0);
        const f32x4 m0 = *(const f32x4*)(mu + c0), m1 = *(const f32x4*)(mu + c0 + 4);
        float c[8], p[8], o[8]; unpack8(cur, c); unpack8(prv, p);
#pragma unroll
        for (int e = 0; e < 8; ++e) { const float mm = e < 4 ? m0[e & 3] : m1[e & 3]; const float xv = c[e] + (p[e] - c[e]) * mm;
            o[e] = grp < 8 ? tanhf_(xv) : (grp < 16 ? xv : sigmoidf_(xv)); }
        *(v4u*)(L + (size_t)row * KLORA + 8 * grp) = pack8(o);
    }
}

__device__ __forceinline__ void red16x4(float& a, float& b, float& c, float& d) {
    asm volatile(
        "s_nop 1\n\t"
        "v_add_f32_dpp %0, %0, %0 quad_perm:[1,0,3,2] row_mask:0xf bank_mask:0xf\n\t"
        "v_add_f32_dpp %1, %1, %1 quad_perm:[1,0,3,2] row_mask:0xf bank_mask:0xf\n\t"
        "v_add_f32_dpp %2, %2, %2 quad_perm:[1,0,3,2] row_mask:0xf bank_mask:0xf\n\t"
        "v_add_f32_dpp %3, %3, %3 quad_perm:[1,0,3,2] row_mask:0xf bank_mask:0xf\n\t"
        "v_add_f32_dpp %0, %0, %0 quad_perm:[2,3,0,1] row_mask:0xf bank_mask:0xf\n\t"
        "v_add_f32_dpp %1, %1, %1 quad_perm:[2,3,0,1] row_mask:0xf bank_mask:0xf\n\t"
        "v_add_f32_dpp %2, %2, %2 quad_perm:[2,3,0,1] row_mask:0xf bank_mask:0xf\n\t"
        "v_add_f32_dpp %3, %3, %3 quad_perm:[2,3,0,1] row_mask:0xf bank_mask:0xf\n\t"
        "v_add_f32_dpp %0, %0, %0 row_half_mirror row_mask:0xf bank_mask:0xf\n\t"
        "v_add_f32_dpp %1, %1, %1 row_half_mirror row_mask:0xf bank_mask:0xf\n\t"
        "v_add_f32_dpp %2, %2, %2 row_half_mirror row_mask:0xf bank_mask:0xf\n\t"
        "v_add_f32_dpp %3, %3, %3 row_half_mirror row_mask:0xf bank_mask:0xf\n\t"
        "v_add_f32_dpp %0, %0, %0 row_mirror row_mask:0xf bank_mask:0xf\n\t"
        "v_add_f32_dpp %1, %1, %1 row_mirror row_mask:0xf bank_mask:0xf\n\t"
        "v_add_f32_dpp %2, %2, %2 row_mirror row_mask:0xf bank_mask:0xf\n\t"
        "v_add_f32_dpp %3, %3, %3 row_mirror row_mask:0xf bank_mask:0xf\n\t"
        "s_nop 0"
        : "+v"(a), "+v"(b), "+v"(c), "+v"(d));
}
__device__ __forceinline__ void rwkv_unit(const Args& a, LAS unsigned char* lds, int unit, int tid) {
    unsigned char* ws = a.ws; const bf16* PROJ = (const bf16*)(ws + WS_PROJ); const bf16* DAG = (const bf16*)(ws + WS_DAG); bf16* MIX = (bf16*)(ws + WS_MIX);
    const int b = unit >> 3, h = unit & 7;
    LAS float* Qa = (LAS float*)lds; LAS float* Wa = Qa + 4096; LAS float* Ka = Wa + 4096; LAS float* Va = Ka + 4096; LAS float* Aa = Va + 4096; LAS float* Ba = Aa + 4096; LAS float* Ya = Ba + 4096;
    LAS float* sc2 = Ya + 4096; LAS float* bon = sc2 + 128;
    const int cg = tid & 15, rp = tid >> 4;
    const int tt_s = tid >> 3, c8 = tid & 7, j0 = h * 64 + 8 * c8;
    float mur[8], muk[8], muv[8], kkc[8], kac[8], rkc[8], w0c[8], a0c[8], lwc[8], lbc[8];
#pragma unroll
    for (int e = 0; e < 8; ++e) { mur[e] = a.in[3][j0 + e]; muk[e] = a.in[3][512 + j0 + e]; muv[e] = a.in[3][1024 + j0 + e]; kkc[e] = a.in[9][j0 + e]; kac[e] = a.in[10][j0 + e]; rkc[e] = a.in[11][j0 + e];
        w0c[e] = a.in[4][j0 + e]; a0c[e] = a.in[6][j0 + e]; lwc[e] = a.in[12][j0 + e]; lbc[e] = a.in[13][j0 + e]; }
    float S0[4] = {0.f, 0.f, 0.f, 0.f}, S1[4] = {0.f, 0.f, 0.f, 0.f};
    v4u g_rc, g_kc, g_vc, g_rp, g_kp, g_vp, g_ld, g_a, g_g;
#define RW_LOADBLK(blk_) do { const int t_ = b * SEQ + (blk_) * 64 + tt_s; const bf16* pr_ = PROJ + (size_t)t_ * NPROJ; \
        g_rc = *(const v4u*)(pr_ + j0); g_kc = *(const v4u*)(pr_ + 512 + j0); g_vc = *(const v4u*)(pr_ + 1024 + j0); \
        if ((blk_) == 0 && tt_s == 0) { g_rp = (v4u){0u, 0u, 0u, 0u}; g_kp = g_rp; g_vp = g_rp; } \
        else { g_rp = *(const v4u*)(pr_ - NPROJ + j0); g_kp = *(const v4u*)(pr_ - NPROJ + 512 + j0); g_vp = *(const v4u*)(pr_ - NPROJ + 1024 + j0); } \
        g_ld = *(const v4u*)(DAG + (size_t)t_ * NLORA + j0); g_a = *(const v4u*)(DAG + (size_t)t_ * NLORA + 512 + j0); g_g = *(const v4u*)(DAG + (size_t)t_ * NLORA + 1024 + j0); } while (0)
    RW_LOADBLK(0);
    for (int blk = 0; blk < SEQ / 64; ++blk) {
        const int t0 = b * SEQ + blk * 64;
        {
            float rc[8], kc[8], vc[8], rp_[8], kp[8], vp[8], av[8], ldv[8];
            unpack8(g_rc, rc); unpack8(g_kc, kc); unpack8(g_vc, vc); unpack8(g_rp, rp_); unpack8(g_kp, kp); unpack8(g_vp, vp); unpack8(g_ld, ldv); unpack8(g_a, av);
            float ss = 0.f, bonus = 0.f, brs = 0.f, krs = 0.f, kkr[8], rr[8], km[8], vv[8], wv[8];
#pragma unroll
            for (int e = 0; e < 8; ++e) {
                const float r = rc[e] + (rp_[e] - rc[e]) * mur[e];
                const float k = kc[e] + (kp[e] - kc[e]) * muk[e];
                const float v = vc[e] + (vp[e] - vc[e]) * muv[e];
                kkr[e] = k * kkc[e]; ss += kkr[e] * kkr[e];
                av[e] = sigmoidf_(a0c[e] + av[e]);
                wv[e] = __expf(-0.6065306597f * sigmoidf_(w0c[e] + ldv[e]));
                km[e] = k * (1.0f + (av[e] - 1.0f) * kac[e]);
                bonus += r * km[e] * rkc[e]; krs += r * km[e];
                rr[e] = r; vv[e] = v;
            }
            ss = red8(ss);
            const float inv = 1.0f / fmaxf(sqrtf(ss), 1e-12f);
            const int o = tt_s * 64 + 8 * c8;
#pragma unroll
            for (int e = 0; e < 8; ++e) { const float kk = kkr[e] * inv; const float bb = kk * av[e]; brs += bb * rr[e];
                Qa[o + e] = wv[e] * rr[e]; Wa[o + e] = wv[e]; Ka[o + e] = km[e]; Va[o + e] = vv[e]; Aa[o + e] = -kk; Ba[o + e] = bb; }
            bonus = red8(bonus); krs = red8(krs); brs = red8(brs);
            if (c8 == 0) { bon[tt_s] = bonus; sc2[2 * tt_s] = brs; sc2[2 * tt_s + 1] = krs; }
        }
        const v4u gcur = g_g;
        __syncthreads();
        if (blk + 1 < SEQ / 64) RW_LOADBLK(blk + 1);
        f32x4 A0, Q0, W0, B0, K0, A1, Q1, W1, B1, K1; f32x2 V0, C0, V1, C1;
#define RW_LD(tt_, A, Q, W, B, K, V, C) do { const int o_ = (tt_) * 64 + 4 * cg; A = *(const LAS f32x4*)(Aa + o_); Q = *(const LAS f32x4*)(Qa + o_); W = *(const LAS f32x4*)(Wa + o_); B = *(const LAS f32x4*)(Ba + o_); \
        K = *(const LAS f32x4*)(Ka + o_); V = *(const LAS f32x2*)(Va + (tt_) * 64 + 2 * rp); C = *(const LAS f32x2*)(sc2 + 2 * (tt_)); } while (0)
#define RW_STEP(tt_, A, Q, W, B, K, V, C) do { \
        float p0 = (S0[0] * A[0] + S0[1] * A[1]) + (S0[2] * A[2] + S0[3] * A[3]), p1 = (S1[0] * A[0] + S1[1] * A[1]) + (S1[2] * A[2] + S1[3] * A[3]); \
        float q0 = (S0[0] * Q[0] + S0[1] * Q[1]) + (S0[2] * Q[2] + S0[3] * Q[3]), q1 = (S1[0] * Q[0] + S1[1] * Q[1]) + (S1[2] * Q[2] + S1[3] * Q[3]); \
        red16x4(p0, p1, q0, q1); \
        const float y0 = q0 + (p0 * C[0] + V[0] * C[1]), y1 = q1 + (p1 * C[0] + V[1] * C[1]); \
        _Pragma("unroll") for (int c = 0; c < 4; ++c) { S0[c] = S0[c] * W[c] + (p0 * B[c] + V[0] * K[c]); S1[c] = S1[c] * W[c] + (p1 * B[c] + V[1] * K[c]); } \
        if (cg == 0) *(LAS f32x2*)(Ya + (tt_) * 64 + 2 * rp) = (f32x2){y0, y1}; } while (0)
        RW_LD(0, A0, Q0, W0, B0, K0, V0, C0);
#pragma unroll 1
        for (int tt = 0; tt < 64; tt += 2) {
            RW_LD(tt + 1, A1, Q1, W1, B1, K1, V1, C1);
            RW_STEP(tt, A0, Q0, W0, B0, K0, V0, C0);
            RW_LD((tt + 2) & 63, A0, Q0, W0, B0, K0, V0, C0);
            RW_STEP(tt + 1, A1, Q1, W1, B1, K1, V1, C1);
        }
        __syncthreads();
        {
            const int t = t0 + tt_s; const int o = tt_s * 64 + 8 * c8;
            float y[8], gv[8]; float s1 = 0.f;
#pragma unroll
            for (int e = 0; e < 8; ++e) { y[e] = Ya[o + e]; s1 += y[e]; }
            s1 = red8(s1); const float mean = s1 * (1.0f / 64.0f); float s2 = 0.f;
#pragma unroll
            for (int e = 0; e < 8; ++e) { const float d = y[e] - mean; s2 += d * d; }
            s2 = red8(s2); const float rstd = rsqrtf(s2 * (1.0f / 64.0f) + LNX_EPS);
            unpack8(gcur, gv);
            const float bonus = bon[tt_s]; float ov[8];
#pragma unroll
            for (int e = 0; e < 8; ++e) { const float yn = (y[e] - mean) * rstd * lwc[e] + lbc[e]; ov[e] = (yn + bonus * Va[o + e]) * gv[e]; }
            *(v4u*)(MIX + (size_t)t * DM + j0) = pack8(ov);
        }
        __syncthreads();
    }
#undef RW_LOADBLK
#undef RW_LD
#undef RW_STEP
}

__device__ __forceinline__ f32x4 mfma16(const bf16x8 a, const bf16x8 b, const f32x4 c) { return __builtin_amdgcn_mfma_f32_16x16x32_bf16(a, b, c, 0, 0, 0); }
__device__ __forceinline__ void mlstm_unit(const Args& a, LAS unsigned char* lds, int unit, int tid, int lane, int wave) {
    unsigned char* ws = a.ws; const bf16* PROJ = (const bf16*)(ws + WS_PROJ); const float* gates = (const float*)(ws + WS_GATES); bf16* MIX = (bf16*)(ws + WS_MIX);
    const float* cw = a.in[14]; const float* cbias = a.in[15]; const float* i_bias = a.in[16]; const float* f_bias = a.in[17]; const float* mhg = a.in[18];
    const int b = unit >> 2, hm = unit & 3;
    constexpr int LD = 72;
    LAS bf16* Ql = (LAS bf16*)lds; LAS bf16* Kl = Ql + 64 * LD; LAS bf16* Kwt = Kl + 64 * LD; LAS bf16* Vt = Kwt + 64 * LD; LAS bf16* Sm = Vt + 128 * LD; LAS bf16* Ct = Sm + 64 * LD;
    LAS float* Hl = (LAS float*)(Ct + 128 * LD);
    LAS float* e_s = Hl + 64 * 132; LAS float* Mx = e_s + 64; LAS float* sc = Mx + 64; LAS float* em = sc + 64; LAS float* wsv = em + 64; LAS float* den = wsv + 64; LAS float* nvec = den + 64; LAS float* scal = nvec + 64;
    for (int i = tid; i < 128 * LD / 2; i += 512) ((LAS unsigned*)Ct)[i] = 0u;
    if (tid < 64) nvec[tid] = 0.f;
    if (tid == 0) { scal[0] = 1.f; scal[1] = 0.f; }
    f32x4 cacc[4];
#pragma unroll
    for (int i = 0; i < 4; ++i) cacc[i] = (f32x4){0.f, 0.f, 0.f, 0.f};
    const int l15 = lane & 15, l4 = lane >> 4;
    const int tt = tid >> 3, p8 = tid & 7;
    __syncthreads();
    for (int c = 0; c < SEQ / 64; ++c) {
        const int t0 = b * SEQ + c * 64;
        if (wave == 0) {
            const int t = t0 + lane;
            const float gi = gates[(size_t)t * 8 + hm] + i_bias[hm], gf = gates[(size_t)t * 8 + 4 + hm] + f_bias[hm];
            const float ig = 15.0f * tanhf_(gi * (1.0f / 15.0f)), fx = 15.0f * tanhf_(gf * (1.0f / 15.0f));
            const float logf = -softplusf_(-fx);
            float bc = logf;
#pragma unroll
            for (int o = 1; o < 64; o <<= 1) { const float t_ = __shfl_up(bc, o); if (lane >= o) bc += t_; }
            const float e = ig - bc; float P = e;
#pragma unroll
            for (int o = 1; o < 64; o <<= 1) { const float t_ = __shfl_up(P, o); if (lane >= o) P = fmaxf(P, t_); }
            const float m = scal[1];
            const float mx = fmaxf(P, m); const float mxL = __shfl(mx, 63), bL = __shfl(bc, 63);
            e_s[lane] = e; Mx[lane] = mx; sc[lane] = __expf(m - mx); em[lane] = __expf(-(bc + mx)); wsv[lane] = __expf(e - mxL);
            if (lane == 0) { scal[0] = __expf(m - mxL); scal[1] = bL + mxL; }
        }
        __syncthreads();
        {
            const int t = t0 + tt, tpos = c * 64 + tt, d0 = 8 * p8, cq = hm * 64 + d0, ck = 256 + hm * 64 + d0;
            float aq[8], ak[8];
#pragma unroll
            for (int e = 0; e < 8; ++e) { aq[e] = cbias[cq + e]; ak[e] = cbias[ck + e]; }
#pragma unroll
            for (int j = 0; j < 4; ++j) { if (tpos - 3 + j >= 0) { const bf16* pr = PROJ + (size_t)(t - 3 + j) * NPROJ; float pq[8], pk[8];
                    unpack8(*(const v4u*)(pr + C_Q + hm * 64 + d0), pq); unpack8(*(const v4u*)(pr + C_K + hm * 64 + d0), pk);
#pragma unroll
                    for (int e = 0; e < 8; ++e) { aq[e] += cw[j * 512 + cq + e] * pq[e]; ak[e] += cw[j * 512 + ck + e] * pk[e]; } } }
            const float w = wsv[tt];
#pragma unroll
            for (int e = 0; e < 8; ++e) { aq[e] = aq[e] * sigmoidf_(aq[e]) * 0.125f; ak[e] = ak[e] * sigmoidf_(ak[e]); }
            *(LAS v4u*)(Ql + tt * LD + d0) = pack8(aq); *(LAS v4u*)(Kl + tt * LD + d0) = pack8(ak);
#pragma unroll
            for (int e = 0; e < 8; ++e) Kwt[(d0 + e) * LD + tt] = (bf16)f2bf(w * ak[e]);
            const bf16* pv = PROJ + (size_t)t * NPROJ + C_V + hm * 128 + 16 * p8;
            const v4u va = *(const v4u*)pv, vb = *(const v4u*)(pv + 8);
            const unsigned wv[8] = {va.x, va.y, va.z, va.w, vb.x, vb.y, vb.z, vb.w};
#pragma unroll
            for (int e = 0; e < 8; ++e) { Vt[(16 * p8 + 2 * e) * LD + tt] = (bf16)(wv[e] & 0xffffu); Vt[(16 * p8 + 2 * e + 1) * LD + tt] = (bf16)(wv[e] >> 16); }
        }
        __syncthreads();
        {
            const int rb = wave >> 1;
#pragma unroll
            for (int ci = 0; ci < 2; ++ci) { const int cb = 2 * (wave & 1) + ci; f32x4 acc = {0.f, 0.f, 0.f, 0.f};
#pragma unroll
                for (int kk = 0; kk < 2; ++kk) { const bf16x8 A = *(const LAS bf16x8*)(Ql + (16 * rb + l15) * LD + 32 * kk + 8 * l4), B = *(const LAS bf16x8*)(Kl + (16 * cb + l15) * LD + 32 * kk + 8 * l4); acc = mfma16(A, B, acc); }
                const int s = 16 * cb + l15; const float es = e_s[s];
#pragma unroll
                for (int r = 0; r < 4; ++r) { const int t = 16 * rb + 4 * l4 + r; const float v = (s <= t) ? acc[r] * __expf(es - Mx[t]) : 0.f; Sm[t * LD + s] = (bf16)f2bf(v); } }
        }
        __syncthreads();
        f32x4 num[4];
        {
            float part = 0.f, qn = 0.f; float sv[8], qv[8];
            unpack8(*(const LAS v4u*)(Sm + tt * LD + 8 * p8), sv); unpack8(*(const LAS v4u*)(Ql + tt * LD + 8 * p8), qv);
#pragma unroll
            for (int e = 0; e < 8; ++e) { part += sv[e]; qn += qv[e] * nvec[8 * p8 + e]; }
            float tot = part + sc[tt] * qn; tot = red8(tot);
            if (p8 == 0) den[tt] = tot;
            const int rb = wave >> 1;
            bf16x8 As[2], Aq[2];
#pragma unroll
            for (int kk = 0; kk < 2; ++kk) { As[kk] = *(const LAS bf16x8*)(Sm + (16 * rb + l15) * LD + 32 * kk + 8 * l4); Aq[kk] = *(const LAS bf16x8*)(Ql + (16 * rb + l15) * LD + 32 * kk + 8 * l4); }
            float scr_[4];
#pragma unroll
            for (int r = 0; r < 4; ++r) scr_[r] = sc[16 * rb + 4 * l4 + r];
#pragma unroll
            for (int vi = 0; vi < 4; ++vi) { const int vb = 4 * (wave & 1) + vi; f32x4 a1 = {0.f, 0.f, 0.f, 0.f}, a2 = {0.f, 0.f, 0.f, 0.f};
#pragma unroll
                for (int kk = 0; kk < 2; ++kk) { const bf16x8 B1 = *(const LAS bf16x8*)(Vt + (16 * vb + l15) * LD + 32 * kk + 8 * l4), B2 = *(const LAS bf16x8*)(Ct + (16 * vb + l15) * LD + 32 * kk + 8 * l4);
                    a1 = mfma16(As[kk], B1, a1); a2 = mfma16(Aq[kk], B2, a2); }
#pragma unroll
                for (int r = 0; r < 4; ++r) num[vi][r] = a1[r] + scr_[r] * a2[r]; }
        }
        __syncthreads();
        {
            const int rb = wave >> 1;
#pragma unroll
            for (int r = 0; r < 4; ++r) { const int t = 16 * rb + 4 * l4 + r; const float dn = 1.0f / fmaxf(fabsf(den[t]), em[t]);
#pragma unroll
                for (int vi = 0; vi < 4; ++vi) Hl[t * 132 + 16 * (4 * (wave & 1) + vi) + l15] = num[vi][r] * dn; }
            const float dec = scal[0];
            bf16x8 Av[2];
#pragma unroll
            for (int kk = 0; kk < 2; ++kk) Av[kk] = *(const LAS bf16x8*)(Vt + (16 * wave + l15) * LD + 32 * kk + 8 * l4);
#pragma unroll
            for (int db = 0; db < 4; ++db) { cacc[db] = cacc[db] * dec;
#pragma unroll
                for (int kk = 0; kk < 2; ++kk) { const bf16x8 B = *(const LAS bf16x8*)(Kwt + (16 * db + l15) * LD + 32 * kk + 8 * l4); cacc[db] = mfma16(Av[kk], B, cacc[db]); }
#pragma unroll
                for (int r = 0; r < 4; ++r) Ct[(16 * wave + 4 * l4 + r) * LD + 16 * db + l15] = (bf16)f2bf(cacc[db][r]); }
            float kv[8]; unpack8(*(const LAS v4u*)(Kwt + tt * LD + 8 * p8), kv); float s = 0.f;
#pragma unroll
            for (int e = 0; e < 8; ++e) s += kv[e];
            s = red8(s);
            if (p8 == 0) nvec[tt] = dec * nvec[tt] + s;
        }
        __syncthreads();
        {
            const int t = t0 + tt, v0 = 16 * p8; float hv[16]; float ss = 0.f;
#pragma unroll
            for (int q = 0; q < 4; ++q) { const f32x4 x = *(const LAS f32x4*)(Hl + tt * 132 + v0 + 4 * q); hv[4 * q] = x[0]; hv[4 * q + 1] = x[1]; hv[4 * q + 2] = x[2]; hv[4 * q + 3] = x[3]; ss += (x[0] * x[0] + x[1] * x[1]) + (x[2] * x[2] + x[3] * x[3]); }
            ss = red8(ss); const float rn = rsqrtf(ss * (1.0f / 128.0f) + NORM_EPS);
            const bf16* po = PROJ + (size_t)t * NPROJ + C_O + hm * 128 + v0; float o0[8], o1[8]; unpack8(*(const v4u*)po, o0); unpack8(*(const v4u*)(po + 8), o1);
            float r0[8], r1[8];
#pragma unroll
            for (int e = 0; e < 8; ++e) { r0[e] = hv[e] * rn * mhg[hm * 128 + v0 + e] * sigmoidf_(o0[e]); r1[e] = hv[8 + e] * rn * mhg[hm * 128 + v0 + 8 + e] * sigmoidf_(o1[e]); }
            bf16* dst = MIX + (size_t)t * DM + 512 + hm * 128 + v0; *(v4u*)dst = pack8(r0); *(v4u*)(dst + 8) = pack8(r1);
        }
        __syncthreads();
    }
}

__device__ __forceinline__ void phase_ffn_fix(const Args& a, int tid) {
    unsigned char* ws = a.ws; const float* SA = (const float*)(ws + WS_SIDE); const float* SB = SA + SIDE_ELEMS; const float* SL = SB + SIDE_ELEMS; bf16* GB = (bf16*)(ws + WS_GB);
    const float* cw = a.in[22]; const float* cb = a.in[23];
    const int NT = gridDim.x * 512;
    for (int it = blockIdx.x * 512 + tid; it < SIDE_ELEMS; it += NT) {
        const int ch = it & 127, r = (it >> 7) & 1, tile = it >> 8, pm = tile / 22, pn = tile % 22;
        const int base = tile * 256;
        float l0 = 0.f, l1 = 0.f;
        if ((pm & 7) != 0) { const int lb = (tile - 22) * 256; l0 = SL[lb + ch]; l1 = SL[lb + 128 + ch]; }
        const float a_r = SA[base + r * 128 + ch], b_r = SB[base + r * 128 + ch];
        const float am1 = r == 0 ? l1 : SA[base + ch], am2 = r == 0 ? l0 : l1;
        const int f = pn * 128 + ch;
        const float z = cb[f] + cw[f] * am2 + cw[DFF + f] * am1 + cw[2 * DFF + f] * a_r;
        GB[(size_t)(pm * 256 + r) * DFF + f] = (bf16)f2bf(z * sigmoidf_(z) * b_r);
    }
}
__device__ __forceinline__ void phase_final(const Args& a, int lane, int wave) {
    const float* ssqp = (const float*)(a.ws + WS_SSQP); const float* gf = a.in[25];
    f32x4 gv[4];
#pragma unroll
    for (int j = 0; j < 4; ++j) gv[j] = *((const f32x4*)gf + lane + 64 * j);
    const int NGW = gridDim.x * 8;
    for (int row = blockIdx.x * 8 + wave; row < M; row += NGW) {
        const f32x4* p = (const f32x4*)(ssqp + (size_t)row * 16); const f32x4 s0 = p[0], s1 = p[1], s2 = p[2], s3 = p[3];
        const float ss = ((s0[0] + s0[1]) + (s0[2] + s0[3])) + ((s1[0] + s1[1]) + (s1[2] + s1[3])) + ((s2[0] + s2[1]) + (s2[2] + s2[3])) + ((s3[0] + s3[1]) + (s3[2] + s3[3]));
        const float rs = rsqrtf(ss * (1.0f / DM) + NORM_EPS);
        f32x4* xr = (f32x4*)(a.out + (size_t)row * DM) + lane;
#pragma unroll
        for (int j = 0; j < 4; ++j) { const f32x4 v = xr[64 * j]; xr[64 * j] = v * rs * gv[j]; }
    }
}

constexpr int N_PHASES = 10;
__global__ void __launch_bounds__(512, 2) mega(Args args) {
    extern __shared__ __attribute__((aligned(16))) unsigned char lds_raw[];
    LAS unsigned char* lds = (LAS unsigned char*)lds_raw;
    const int tid0 = threadIdx.x;
    unsigned char* ws = args.ws;
#define PHASE_IDS int tid = tid0; asm volatile("" : "+v"(tid)); const int lane = tid & 63, wave = __builtin_amdgcn_readfirstlane(tid >> 6); (void)lane; (void)wave
    volatile LAS unsigned* MISC = (volatile LAS unsigned*)(lds + MISC_OFF);
    { PHASE_IDS; for (int u = tid; u < (LDS_BYTES - 131072) / 4; u += 512) ((LAS unsigned*)(lds + 131072))[u] = 0u; }
    __syncthreads();
    XcdBarrier bar; bar.bar = (unsigned*)(ws + WS_CTL) + 4096; bar.x = 0; bar.st = nullptr;
    if (MK_SINGLE) bar = xcd_barrier_post((unsigned*)(ws + WS_CTL) + 4096, MISC + 8);
    const int lo = args.ph_lo, hi = args.ph_hi;
#ifndef PH_MASK
#define PH_MASK 0xFFFF
#endif
#define IN(k) ((((PH_MASK) >> (k)) & 1) && lo <= (k) && (k) < hi)
#ifdef PROBE
    unsigned long long* const tstamps = (unsigned long long*)(ws + WS_CTL + 512 * 1024);
#define STAMP(k) do { if (blockIdx.x == 0 && tid0 == 0) tstamps[(k)] = __builtin_amdgcn_s_memrealtime(); } while (0)
#else
#define STAMP(k) do { } while (0)
#endif
    STAMP(0);
#define SEAM(k) do { if (IN(k) && IN((k) + 1)) xcd_barrier(bar); STAMP((k) + 1); } while (0)

    if (IN(0)) { PHASE_IDS; phase_prep(args, lds, tid, lane, wave); } SEAM(0);
    if (IN(1)) {
        pg8::Gemm g{(const bf16*)(ws + WS_XN), (const bf16*)(ws + WS_WT_IN), M, NPROJ, opaque_i(DM)}; pg8::StaticOrder S; S.init(M, NPROJ, gridDim.x, (int)blockIdx.x);
        pg8::EpiBf16<0> E{(bf16*)(ws + WS_PROJ), NPROJ, nullptr, 0, 0, 1.f};
        pg8::gemm_phase<pg8::EpiBf16<0>, pg8::StaticOrder, true, true>(lds, g, S, E);
    } SEAM(1);
    if (IN(2)) { PHASE_IDS; phase_lmat(args, tid); } SEAM(2);
    if (IN(3)) {
        pg8::Gemm g{(const bf16*)(ws + WS_LBUF), (const bf16*)(ws + WS_WT_LORA), M, NLORA, opaque_i(KLORA)}; pg8::StaticOrder S; S.init(M, NLORA, gridDim.x, (int)blockIdx.x);
        pg8::EpiBf16<0> E{(bf16*)(ws + WS_DAG), NLORA, nullptr, 0, 0, 1.f};
        pg8::gemm_phase<pg8::EpiBf16<0>, pg8::StaticOrder, true, true>(lds, g, S, E);
    } SEAM(3);
    if (IN(4)) {
        PHASE_IDS;
        for (int u = blockIdx.x; u < BATCH * 8; u += gridDim.x) rwkv_unit(args, lds, u, tid);
        __syncthreads();
        STAMP(12);
        for (int u = blockIdx.x; u < BATCH * 4; u += gridDim.x) mlstm_unit(args, lds, u, tid, lane, wave);
    } SEAM(4);
    if (IN(5)) {
        pg8::Gemm g{(const bf16*)(ws + WS_MIX), (const bf16*)(ws + WS_WT_OUT), M, DM, opaque_i(DM)}; pg8::StaticOrder S; S.init(M, DM, gridDim.x, (int)blockIdx.x);
        pg8::EpiResid E{args.in[0], args.out, (bf16*)(ws + WS_XN), (float*)(ws + WS_SSQP)};
        pg8::gemm_phase<pg8::EpiResid, pg8::StaticOrder, true, true>(lds, g, S, E);
    } SEAM(5);
    if (IN(6)) {
        pg8::Gemm g{(const bf16*)(ws + WS_XN), (const bf16*)(ws + WS_WT_UP), M, NUP, opaque_i(DM)}; pg8::StaticOrder S; S.init(M, NUP, gridDim.x, (int)blockIdx.x);
        float* side = (float*)(ws + WS_SIDE); float* rs2 = (float*)(ws + WS_RS2);
        {
            PHASE_IDS; pg8::Unit u;
            for (int i = 0; S.next(i, u); ++i) if (tid < 256) { const int row = u.pm * 256 + tid; const f32x4* p = (const f32x4*)((const float*)(ws + WS_SSQP) + (size_t)row * 16); const f32x4 s0 = p[0], s1 = p[1], s2 = p[2], s3 = p[3];
                const float ss = ((s0[0] + s0[1]) + (s0[2] + s0[3])) + ((s1[0] + s1[1]) + (s1[2] + s1[3])) + ((s2[0] + s2[1]) + (s2[2] + s2[3])) + ((s3[0] + s3[1]) + (s3[2] + s3[3]));
                rs2[row] = rsqrtf(ss * (1.0f / DM) + NORM_EPS); }
            asm volatile("s_waitcnt vmcnt(0)" ::: "memory"); __syncthreads();
        }
        pg8::EpiFfn E{(bf16*)(ws + WS_GB), rs2, args.in[22], args.in[23], side, side + SIDE_ELEMS, side + 2 * SIDE_ELEMS, (LAS float*)(lds + 131072 + 1024)};
        pg8::gemm_phase<pg8::EpiFfn, pg8::StaticOrder, true, true>(lds, g, S, E);
    } SEAM(6);
    if (IN(7)) { PHASE_IDS; phase_ffn_fix(args, tid); } SEAM(7);
    if (IN(8)) {
        pg8::Gemm g{(const bf16*)(ws + WS_GB), (const bf16*)(ws + WS_WT_DN), M, DM, opaque_i(DFF)}; pg8::StaticOrder S; S.init(M, DM, gridDim.x, (int)blockIdx.x);
        pg8::EpiResid E{args.out, args.out, nullptr, (float*)(ws + WS_SSQP)};
        pg8::gemm_phase<pg8::EpiResid, pg8::StaticOrder, true, true>(lds, g, S, E);
    } SEAM(8);
    if (IN(9)) { PHASE_IDS; phase_final(args, lane, wave); }
#undef IN
#undef SEAM
}

extern "C" void kernel_launch(void* const* d_in, const int* in_sizes, int n_in, void* d_out, int out_size, void* d_ws, size_t ws_size, hipStream_t stream) {
    static int grid = 0;
    if (grid == 0) {
        if (n_in != 26 || in_sizes[0] != M * DM || out_size != M * DM || ws_size < WS_END) { fprintf(stderr, "kernel_launch: unexpected shapes (n_in %d, in0 %d, out %d, ws %zu)\n", n_in, n_in > 0 ? in_sizes[0] : -1, out_size, ws_size); grid = -1; return; }
        int dev = 0, cus = 0, per_cu = 0;
        if (hipGetDevice(&dev) != hipSuccess || hipDeviceGetAttribute(&cus, hipDeviceAttributeMultiprocessorCount, dev) != hipSuccess) { grid = -1; return; }
        if (hipFuncSetAttribute((const void*)mega, hipFuncAttributeMaxDynamicSharedMemorySize, LDS_BYTES) != hipSuccess) { fprintf(stderr, "kernel_launch: hipFuncSetAttribute failed\n"); grid = -1; return; }
        if (hipOccupancyMaxActiveBlocksPerMultiprocessor(&per_cu, (const void*)mega, 512, LDS_BYTES) != hipSuccess || per_cu < 1) { fprintf(stderr, "kernel_launch: occupancy query says %d blocks per CU\n", per_cu); }
        (void)hipGetLastError();
        grid = cus;
        if (grid != 256) fprintf(stderr, "kernel_launch: %d CUs; this kernel is laid out for 256\n", grid);
    }
    if (grid < 0) return;
    (void)hipMemsetAsync((char*)d_ws + WS_CTL, 0, CTL_ZERO_BYTES, stream);
    Args a{};
    for (int i = 0; i < 26; ++i) a.in[i] = (const float*)d_in[i];
    a.out = (float*)d_out; a.ws = (unsigned char*)d_ws;
#if MK_SINGLE
    a.ph_lo = 0; a.ph_hi = N_PHASES;
    hipLaunchKernelGGL(mega, dim3(grid), dim3(512), LDS_BYTES, stream, a);
#else
    for (int p = 0; p < N_PHASES; ++p) { a.ph_lo = p; a.ph_hi = p + 1; hipLaunchKernelGGL(mega, dim3(grid), dim3(512), LDS_BYTES, stream, a); }
#endif
}
```

```cpp
#include <hip/hip_runtime.h>
#include <cstdio>
#include <cstdint>
namespace pg8 {
#define PG8_LAS __attribute__((address_space(3)))
typedef unsigned short bf16_t;
typedef short bf16x8 __attribute__((ext_vector_type(8)));
typedef float f32x4 __attribute__((ext_vector_type(4)));
typedef unsigned u32x4 __attribute__((ext_vector_type(4)));
constexpr int BM = 256, BK = 64, HALF = 128, HTB = HALF * BK * 2  , STAGE_BYTES = 8 * HTB, NXCD = 8, WGM = 8;

__host__ __device__ __forceinline__ int lds_byte(int r, int c) { const int st = (r >> 4) * 2 + (c >> 5), rr = r & 15, cc = c & 31, ob = rr * 64 + cc * 2; return st * 1024 + (ob ^ (((ob >> 9) & 1) << 5)); }
__host__ __device__ __forceinline__ void stage_rc(int b, int& R, int& C) { const int st = b / 1024, sb = b % 1024, swz = sb ^ (((sb >> 9) & 1) << 5); R = (st >> 1) * 16 + swz / 64; C = (st & 1) * 32 + (swz % 64) / 2; }
__host__ __device__ __forceinline__ int perm32(int rho) { const int n = rho >> 4, i = rho & 15; return 8 * (i >> 2) + 4 * n + (i & 3); }

struct Unit { int pm, pn; };
struct Gemm { const bf16_t* A; const bf16_t* Bt; int M, N, K; };

struct StaticOrder {
    int nM, nN, nwg, G, c;
    __host__ __device__ void init(int M, int N, int G_, int c_) { nM = M / BM; nN = N / BM; nwg = nM * nN; G = G_; c = c_; }
    __host__ __device__ bool next(int i, Unit& u) const {
        const long L = (long)i * G + c; if (L >= nwg) return false;
        int wgid = (int)L; { const int q = nwg / NXCD, r = nwg % NXCD, xcd = wgid % NXCD, off = wgid / NXCD; wgid = (xcd < r ? xcd * (q + 1) : r * (q + 1) + (xcd - r) * q) + off; }
        const int nig = WGM * nN, gid = wgid / nig, fm = gid * WGM, gsz = (nM - fm) < WGM ? (nM - fm) : WGM;
        u.pm = fm + ((wgid % nig) % gsz); u.pn = (wgid % nig) / gsz; return true;
    }
    __device__ __forceinline__ void a_ready(const Unit&) const {}
    __device__ __forceinline__ void done(const Unit&) const {}
};

__device__ __forceinline__ unsigned cvt_pk_bf16(float lo, float hi) { unsigned r; asm volatile("v_cvt_pk_bf16_f32 %0, %1, %2" : "=v"(r) : "v"(lo), "v"(hi)); return r; }
typedef float f32x2 __attribute__((ext_vector_type(2)));
__device__ __forceinline__ f32x2 gelu_pk(f32x2 v) {
    const f32x2 av = __builtin_elementwise_abs(v), d = av * 0.2316418882f + 1.0f;
    f32x2 t; t.x = __builtin_amdgcn_rcpf(d.x); t.y = __builtin_amdgcn_rcpf(d.y);
    f32x2 q = t * 0.5307027145f + (-0.7265760135f); q = q * t + 0.7107068705f; q = q * t + (-0.142248368f); q = q * t + 0.127414796f; q = q * t;
    const f32x2 s = (v * v) * (-0.72134752044f);
    f32x2 e; e.x = __builtin_amdgcn_exp2f(s.x); e.y = __builtin_amdgcn_exp2f(s.y);
    const f32x2 m = v * (q * e), r = v - m;
    f32x2 o; o.x = v.x < 0.f ? m.x : r.x; o.y = v.y < 0.f ? m.y : r.y; return o;
}

template <int ACT  > struct EpiBf16 {
    static constexpr bool PERM = true, AFTER_DRAIN = false; static_assert(ACT == 0 || ACT == 1, "EpiBf16: ACT is 0 (none) or 1 (gelu_pk)");
    bf16_t* O; int ldc; const float* bias; int split_cols; size_t split_stride; float scale0;
    __device__ __forceinline__ void operator()(const f32x4 (&acc)[2][2][4][2], const Unit& u, int wr, int wc, int fr, int fq) const {
        const int row0 = u.pm * BM + wr * 64 + fr; int colt = u.pn * BM; bf16_t* base = O;
        float sc = 1.f; if (split_cols) { const int t = colt / split_cols; base += (size_t)t * split_stride; colt -= t * split_cols; if (t == 0) sc = scale0; }
        const int col0 = colt + wc * 32 + 8 * fq, bcol0 = u.pn * BM + wc * 32 + 8 * fq;
        f32x4 bv[2][2];
#pragma unroll
        for (int bj = 0; bj < 2; ++bj)
#pragma unroll
            for (int n = 0; n < 2; ++n) bv[bj][n] = bias ? *(const f32x4*)(bias + bcol0 + bj * HALF + 4 * n) : (f32x4){0.f, 0.f, 0.f, 0.f};
#pragma unroll
        for (int ai = 0; ai < 2; ++ai)
#pragma unroll
            for (int m = 0; m < 4; ++m) { bf16_t* rowp = base + (size_t)(row0 + ai * HALF + m * 16) * ldc + col0;
#pragma unroll
                for (int bj = 0; bj < 2; ++bj) { f32x4 v0 = acc[ai][bj][m][0] + bv[bj][0], v1 = acc[ai][bj][m][1] + bv[bj][1];
                    if (ACT == 1) { f32x2 a = gelu_pk((f32x2){v0[0], v0[1]}), b = gelu_pk((f32x2){v0[2], v0[3]}), c = gelu_pk((f32x2){v1[0], v1[1]}), d = gelu_pk((f32x2){v1[2], v1[3]});
                        v0 = (f32x4){a.x, a.y, b.x, b.y}; v1 = (f32x4){c.x, c.y, d.x, d.y}; }
                    v0 = v0 * sc; v1 = v1 * sc; u32x4 w; w.x = cvt_pk_bf16(v0[0], v0[1]); w.y = cvt_pk_bf16(v0[2], v0[3]); w.z = cvt_pk_bf16(v1[0], v1[1]); w.w = cvt_pk_bf16(v1[2], v1[3]);
                    *(u32x4*)(rowp + bj * HALF) = w; } }
    }
};
template <class Epi, class Sched, bool ALIGN_EPI = false, bool SP2 = false>
__device__ __forceinline__ void gemm_phase(PG8_LAS unsigned char* lds, const Gemm g, const Sched& S, const Epi& E) {
    const int tid = threadIdx.x, wid = __builtin_amdgcn_readfirstlane(tid >> 6), lane = tid & 63, wr = wid >> 2, wc = wid & 3, fr = lane & 15, fq = lane >> 4;
    const int K = g.K, nt = K / BK;
    unsigned voffA[2], voffB[2];
#pragma unroll
    for (int i = 0; i < 2; ++i) { int R, C; stage_rc(tid * 16 + i * 8192, R, C); const int Rb = Epi::PERM ? ((R & ~31) + perm32(R & 31)) : R;
        voffA[i] = (unsigned)(R * K + C) * 2u; voffB[i] = (unsigned)(Rb * K + C) * 2u; }
    const size_t kstep = (size_t)(BK * 2);
    const size_t hstep = (size_t)HALF * K * 2;
    const size_t tstep = 2 * hstep;
    const unsigned ldsw = (unsigned)wid * 1024u;
    const int aoff = lds_byte(wr * 64 + fr, fq * 8), boff = lds_byte(wc * 32 + fr, fq * 8);
#define PG8_SA(b, h) (((b) * 2 + (h)) * HTB)
#define PG8_SB(b, h) ((4 + (b) * 2 + (h)) * HTB)
#define PG8_STAGE(bufoff, gbase, voff) do { _Pragma("unroll") for (int _i = 0; _i < 2; ++_i) \
        __builtin_amdgcn_global_load_lds((const unsigned*)((const char*)(gbase) + (voff)[_i]), (PG8_LAS unsigned*)(lds + (bufoff) + ldsw + _i * 8192), 16, 0, 0); } while (0)
#define PG8_LDA(dst, b, h) do { _Pragma("unroll") for (int m = 0; m < 4; ++m) _Pragma("unroll") for (int k = 0; k < 2; ++k) dst[m][k] = *(const PG8_LAS bf16x8*)(lds + PG8_SA(b, h) + aoff + m * 2048 + k * 1024); } while (0)
#define PG8_LDB(dst, b, h) do { _Pragma("unroll") for (int n = 0; n < 2; ++n) _Pragma("unroll") for (int k = 0; k < 2; ++k) dst[n][k] = *(const PG8_LAS bf16x8*)(lds + PG8_SB(b, h) + boff + n * 2048 + k * 1024); } while (0)
#define PG8_MMA(ai, bj, At, Bt) do { __builtin_amdgcn_s_setprio(1); _Pragma("unroll") for (int m = 0; m < 4; ++m) _Pragma("unroll") for (int n = 0; n < 2; ++n) _Pragma("unroll") for (int k = 0; k < 2; ++k) \
        acc[ai][bj][m][n] = __builtin_amdgcn_mfma_f32_16x16x32_bf16(Bt[n][k], At[m][k], acc[ai][bj][m][n], 0, 0, 0); __builtin_amdgcn_s_setprio(0); } while (0)
#define PG8_WAIT_V(n) asm volatile("s_waitcnt vmcnt(" #n ")" ::: "memory")
#define PG8_WAIT_L(n) asm volatile("s_waitcnt lgkmcnt(" #n ")" ::: "memory")
#define PG8_BAR __builtin_amdgcn_s_barrier()
#define PG8_SCHED __builtin_amdgcn_sched_barrier(0)
    Unit cur, nxt; int ui = 0;
    if (!S.next(0, cur)) return;
    f32x4 acc[2][2][4][2];
#pragma unroll
    for (int a = 0; a < 2; ++a)
#pragma unroll
        for (int b = 0; b < 2; ++b)
#pragma unroll
            for (int m = 0; m < 4; ++m)
#pragma unroll
                for (int n = 0; n < 2; ++n) acc[a][b][m][n] = (f32x4){0.f, 0.f, 0.f, 0.f};
    bf16x8 At[4][2], B0[2][2], B1[2][2];
    const char* cA = (const char*)g.A + (size_t)cur.pm * tstep; const char* cB = (const char*)g.Bt + (size_t)cur.pn * tstep;
    S.a_ready(cur);
    if constexpr (SP2) {
        PG8_STAGE(PG8_SB(0, 0), cB, voffB); PG8_STAGE(PG8_SB(0, 1), cB + hstep, voffB); PG8_STAGE(PG8_SA(0, 0), cA, voffA); PG8_STAGE(PG8_SA(0, 1), cA + hstep, voffA);
        if (wr == 1) PG8_BAR;
        PG8_WAIT_V(2); PG8_BAR;
        PG8_STAGE(PG8_SB(1, 0), cB + kstep, voffB); PG8_STAGE(PG8_SA(1, 0), cA + kstep, voffA); PG8_STAGE(PG8_SB(1, 1), cB + hstep + kstep, voffB);
        PG8_WAIT_V(6); PG8_BAR;
    } else {
        PG8_STAGE(PG8_SB(0, 0), cB, voffB); PG8_STAGE(PG8_SA(0, 0), cA, voffA); PG8_STAGE(PG8_SB(0, 1), cB + hstep, voffB); PG8_STAGE(PG8_SA(0, 1), cA + hstep, voffA);
        if (wr == 1) PG8_BAR;
        PG8_WAIT_V(4); PG8_BAR;
        PG8_STAGE(PG8_SB(1, 0), cB + kstep, voffB); PG8_STAGE(PG8_SA(1, 0), cA + kstep, voffA); PG8_STAGE(PG8_SB(1, 1), cB + hstep + kstep, voffB);
        PG8_WAIT_V(6); PG8_BAR;
    }
    for (;;) {
        const bool has_next = S.next(ui + 1, nxt);
        const char* nA = has_next ? (const char*)g.A + (size_t)nxt.pm * tstep : cA; const char* nB = has_next ? (const char*)g.Bt + (size_t)nxt.pn * tstep : cB;
        for (int t = 0; t < nt; t += 2) {
            const bool last = (t == nt - 2);
            const char* a1 = cA + (size_t)(t + 1) * kstep;
            const char* a2 = last ? nA : cA + (size_t)(t + 2) * kstep; const char* b2 = last ? nB : cB + (size_t)(t + 2) * kstep;
            const char* a3 = a2 + kstep; const char* b3 = b2 + kstep;
            if (last && has_next) S.a_ready(nxt);
            if constexpr (SP2) {
            PG8_LDB(B0, 0, 0); PG8_LDB(B1, 0, 1); PG8_SCHED; PG8_LDA(At, 0, 0); PG8_STAGE(PG8_SA(1, 1), a1 + hstep, voffA);
            PG8_WAIT_V(8); PG8_WAIT_L(0); PG8_BAR; PG8_MMA(0, 0, At, B0); PG8_MMA(0, 1, At, B1); PG8_BAR; PG8_SCHED;
            PG8_LDA(At, 0, 1); PG8_STAGE(PG8_SB(0, 0), b2, voffB); PG8_STAGE(PG8_SB(0, 1), b2 + hstep, voffB); PG8_STAGE(PG8_SA(0, 0), a2, voffA);
            PG8_WAIT_V(8); PG8_WAIT_L(0); PG8_BAR; PG8_MMA(1, 0, At, B0); PG8_MMA(1, 1, At, B1); PG8_BAR; PG8_SCHED;
            PG8_LDB(B0, 1, 0); PG8_LDB(B1, 1, 1); PG8_SCHED; PG8_LDA(At, 1, 0); PG8_STAGE(PG8_SA(0, 1), a2 + hstep, voffA);
            PG8_WAIT_V(8); PG8_WAIT_L(0); PG8_BAR; PG8_MMA(0, 0, At, B0); PG8_MMA(0, 1, At, B1); PG8_BAR; PG8_SCHED;
            PG8_LDA(At, 1, 1); PG8_STAGE(PG8_SB(1, 0), b3, voffB); PG8_STAGE(PG8_SB(1, 1), b3 + hstep, voffB); PG8_STAGE(PG8_SA(1, 0), a3, voffA);
            PG8_WAIT_V(8); PG8_WAIT_L(0); PG8_BAR; PG8_MMA(1, 0, At, B0); PG8_MMA(1, 1, At, B1); PG8_BAR; PG8_SCHED;
            } else {
            PG8_LDB(B0, 0, 0); PG8_SCHED; PG8_LDA(At, 0, 0); PG8_STAGE(PG8_SA(1, 1), a1 + hstep, voffA);
            PG8_WAIT_L(8); PG8_BAR; PG8_WAIT_L(0); PG8_MMA(0, 0, At, B0); PG8_BAR; PG8_SCHED;
            PG8_LDB(B1, 0, 1); PG8_STAGE(PG8_SB(0, 0), b2, voffB);
            PG8_BAR; PG8_WAIT_L(0); PG8_MMA(0, 1, At, B1); PG8_BAR;
            PG8_LDA(At, 0, 1); PG8_STAGE(PG8_SA(0, 0), a2, voffA);
            PG8_BAR; PG8_WAIT_L(0); PG8_MMA(1, 0, At, B0); PG8_BAR; PG8_SCHED;
            PG8_STAGE(PG8_SB(0, 1), b2 + hstep, voffB);
            PG8_WAIT_V(6); PG8_BAR; PG8_MMA(1, 1, At, B1); PG8_BAR;
            PG8_LDB(B0, 1, 0); PG8_SCHED; PG8_LDA(At, 1, 0); PG8_STAGE(PG8_SA(0, 1), a2 + hstep, voffA);
            PG8_WAIT_L(8); PG8_BAR; PG8_WAIT_L(0); PG8_MMA(0, 0, At, B0); PG8_BAR; PG8_SCHED;
            PG8_LDB(B1, 1, 1); PG8_STAGE(PG8_SB(1, 0), b3, voffB);
            PG8_BAR; PG8_WAIT_L(0); PG8_MMA(0, 1, At, B1); PG8_BAR;
            PG8_LDA(At, 1, 1); PG8_STAGE(PG8_SA(1, 0), a3, voffA);
            PG8_BAR; PG8_WAIT_L(0); PG8_MMA(1, 0, At, B0); PG8_BAR; PG8_SCHED;
            PG8_STAGE(PG8_SB(1, 1), b3 + hstep, voffB);
            PG8_WAIT_V(6); PG8_BAR; PG8_MMA(1, 1, At, B1); PG8_BAR;
            }
        }
        if constexpr (ALIGN_EPI) { if (wr == 0) PG8_BAR; }
        if constexpr (!Epi::AFTER_DRAIN) { E(acc, cur, wr, wc, fr, fq); S.done(cur); }
        if (!has_next) break;
#pragma unroll
        for (int a = 0; a < 2; ++a)
#pragma unroll
            for (int b = 0; b < 2; ++b)
#pragma unroll
                for (int m = 0; m < 4; ++m)
#pragma unroll
                    for (int n = 0; n < 2; ++n) acc[a][b][m][n] = (f32x4){0.f, 0.f, 0.f, 0.f};
        cur = nxt; cA = nA; cB = nB; ++ui;
        if constexpr (ALIGN_EPI) { if (wr == 1) PG8_BAR; }
    }
    PG8_WAIT_V(0);
    if constexpr (!ALIGN_EPI) { if (wr == 0) PG8_BAR; }
    PG8_BAR;
    if constexpr (Epi::AFTER_DRAIN) { E.fused(acc, cur, wr, wc, fr, fq, lds, wid, lane); S.done(cur); }
#undef PG8_SA
#undef PG8_SB
#undef PG8_STAGE
#undef PG8_LDA
#undef PG8_LDB
#undef PG8_MMA
#undef PG8_WAIT_V
#undef PG8_WAIT_L
#undef PG8_BAR
#undef PG8_SCHED
}
}

#ifndef MK_SINGLE
#define MK_SINGLE 1
#endif
constexpr int BATCH = 32, SEQ = 2048, DM = 1024, M = BATCH * SEQ;
constexpr int NIN = 3336, NPROJ = 3328;
constexpr int DFF = 2816, NUP = 2 * DFF;
constexpr int C_Q = 1792, C_K = 2048, C_V = 2304, C_O = 2816;
constexpr int NLORA = 1536, KLORA = 256;
constexpr int MH = M / 2;
constexpr float NORM_EPS = 1e-6f, LNX_EPS = 64e-5f;

constexpr size_t MiB = 1u << 20;
constexpr size_t WS_CTL = 0, CTL_ZERO_BYTES = 1 * MiB;
constexpr size_t WS_WT_IN = 2 * MiB, WS_WT_OUT = 9 * MiB, WS_WT_UP = 11 * MiB, WS_WT_DN = 22 * MiB, WS_WT_LORA = 28 * MiB;
constexpr size_t WS_RS2 = 29 * MiB, WS_SSQP = 30 * MiB, WS_GATES = 34 * MiB;
constexpr size_t WS_XN = 40 * MiB;
constexpr size_t WS_PROJ = 168 * MiB;
constexpr size_t WS_LBUF = 584 * MiB;
constexpr size_t WS_DAG = 616 * MiB;
constexpr size_t WS_MIX = 808 * MiB;
constexpr size_t WS_SIDE = 168 * MiB;
constexpr int SIDE_ELEMS = 256 * 22 * 2 * 128;
constexpr size_t WS_GB = 520 * MiB;
constexpr size_t WS_END = 936 * MiB;

constexpr int LDS_BYTES = 147456;
constexpr int MISC_OFF = 131072 + 320;

#define GAS __attribute__((address_space(1)))
#define LAS __attribute__((address_space(3)))
typedef unsigned short bf16;
typedef unsigned v4u __attribute__((ext_vector_type(4)));
typedef unsigned v2u __attribute__((ext_vector_type(2)));
typedef float f32x4 __attribute__((ext_vector_type(4)));
typedef float f32x2 __attribute__((ext_vector_type(2)));
typedef short bf16x8 __attribute__((ext_vector_type(8)));
typedef GAS unsigned gu32;

typedef __bf16 bf16x2_t __attribute__((ext_vector_type(2)));
__device__ __forceinline__ unsigned pk2(float lo, float hi) { const f32x2 v = {lo, hi}; const bf16x2_t b = __builtin_convertvector(v, bf16x2_t); return __builtin_bit_cast(unsigned, b); }
__device__ __forceinline__ unsigned f2bf(float f) { return pk2(f, f) & 0xffffu; }
__device__ __forceinline__ float bf2f(unsigned short u) { return __builtin_bit_cast(float, (unsigned)u << 16); }
__device__ __forceinline__ float bflo(unsigned w) { return __builtin_bit_cast(float, w << 16); }
__device__ __forceinline__ float bfhi(unsigned w) { return __builtin_bit_cast(float, w & 0xffff0000u); }
__device__ __forceinline__ void unpack8(const v4u w, float (&o)[8]) { o[0] = bflo(w.x); o[1] = bfhi(w.x); o[2] = bflo(w.y); o[3] = bfhi(w.y); o[4] = bflo(w.z); o[5] = bfhi(w.z); o[6] = bflo(w.w); o[7] = bfhi(w.w); }
__device__ __forceinline__ v4u pack8(const float (&o)[8]) { v4u w; w.x = pk2(o[0], o[1]); w.y = pk2(o[2], o[3]); w.z = pk2(o[4], o[5]); w.w = pk2(o[6], o[7]); return w; }
__device__ __forceinline__ float frcp(float x) { return __builtin_amdgcn_rcpf(x); }
__device__ __forceinline__ float frsq(float x) { return __builtin_amdgcn_rsqf(x); }
__device__ __forceinline__ float fsqrt_(float x) { return __builtin_amdgcn_sqrtf(x); }
__device__ __forceinline__ float fexp(float x) { return __builtin_amdgcn_exp2f(x * 1.4426950408889634f); }
__device__ __forceinline__ float sigmoidf_(float x) { return frcp(1.0f + __builtin_amdgcn_exp2f(x * -1.4426950408889634f)); }
__device__ __forceinline__ float tanhf_(float x) { return 1.0f - 2.0f * frcp(__builtin_amdgcn_exp2f(x * 2.8853900817779268f) + 1.0f); }
__device__ __forceinline__ float softplusf_(float x) { return fmaxf(x, 0.f) + __logf(1.0f + fexp(-fabsf(x))); }
__device__ __forceinline__ float wave_sum(float v) {
#pragma unroll
    for (int o = 1; o < 64; o <<= 1) v += __shfl_xor(v, o);
    return v;
}
template <int CTRL> __device__ __forceinline__ float dppmov(float v) { return __builtin_bit_cast(float, __builtin_amdgcn_update_dpp(0, __builtin_bit_cast(int, v), CTRL, 0xF, 0xF, true)); }
__device__ __forceinline__ float red8(float v) { v += dppmov<0xB1>(v); v += dppmov<0x4E>(v); v += dppmov<0x141>(v); return v; }
__device__ __forceinline__ float red16(float v) { v += dppmov<0xB1>(v); v += dppmov<0x4E>(v); v += dppmov<0x141>(v); v += dppmov<0x140>(v); return v; }

template <int CTRL, int RMASK> __device__ __forceinline__ float dppsh(float idv, float v) { return __builtin_bit_cast(float, __builtin_amdgcn_update_dpp(__builtin_bit_cast(int, idv), __builtin_bit_cast(int, v), CTRL, RMASK, 0xF, false)); }
__device__ __forceinline__ float wave_scan_add(float v) {
    v += dppsh<0x111, 0xF>(0.f, v); v += dppsh<0x112, 0xF>(0.f, v); v += dppsh<0x114, 0xF>(0.f, v); v += dppsh<0x118, 0xF>(0.f, v);
    v += dppsh<0x142, 0xA>(0.f, v); v += dppsh<0x143, 0xC>(0.f, v); return v;
}
__device__ __forceinline__ float wave_scan_max(float v) {
    const float ni = -3.0e38f;
    v = fmaxf(v, dppsh<0x111, 0xF>(ni, v)); v = fmaxf(v, dppsh<0x112, 0xF>(ni, v)); v = fmaxf(v, dppsh<0x114, 0xF>(ni, v)); v = fmaxf(v, dppsh<0x118, 0xF>(ni, v));
    v = fmaxf(v, dppsh<0x142, 0xA>(ni, v)); v = fmaxf(v, dppsh<0x143, 0xC>(ni, v)); return v;
}

#define XB_TMO      128
#define XB_XCNT(j)  (256  + 64 * (j))
#define XB_XSUB(j)  (1280 + 64 * (j))
#define XB_XGEN(j)  (2304 + 64 * (j))
#define XB_TOP      3328
#define XB_TOPGEN   3392
#define XCD_BAR_WORDS 3456
#define XB_SPIN_CAP (1u << 22)
__device__ __forceinline__ unsigned xb_ld(unsigned* p)              { return __hip_atomic_load(p, __ATOMIC_RELAXED, __HIP_MEMORY_SCOPE_AGENT); }
__device__ __forceinline__ unsigned xb_add(unsigned* p, unsigned v) { return __hip_atomic_fetch_add(p, v, __ATOMIC_RELAXED, __HIP_MEMORY_SCOPE_AGENT); }
__device__ __forceinline__ unsigned xb_xcc_id() { return (unsigned)__builtin_amdgcn_s_getreg((3 << 11) | 20) & 0xFu; }
#define XB_SPIN(cond, bar) do { unsigned _sp = 0; while (cond) { __builtin_amdgcn_s_sleep(1); \
    if ((++_sp & 255u) == 0u) { if (xb_ld(&(bar)[XB_TMO])) break; if (_sp > XB_SPIN_CAP) { atomicAdd(&(bar)[XB_TMO], 1u); break; } } } } while (0)
struct XcdBarrier { unsigned* bar; unsigned x; volatile LAS unsigned* st; };
__device__ __forceinline__ XcdBarrier xcd_barrier_post(unsigned* bar, volatile LAS unsigned* st) {
    XcdBarrier b; b.bar = bar; b.x = xb_xcc_id(); b.st = st;
    if (threadIdx.x == 0) (void)xb_add(&bar[XB_XCNT(b.x)], 1u);
    return b;
}
__device__ __forceinline__ void xcd_barrier_complete(unsigned* bar, unsigned x, unsigned& nloc, unsigned& nx) {
    const unsigned G = gridDim.x * gridDim.y * gridDim.z;
    unsigned sum, cnt, mine, sp = 0u;
    for (;;) {
        sum = 0u; cnt = 0u; mine = 0u;
#pragma unroll
        for (unsigned j = 0; j < 16; ++j) { const unsigned c = xb_ld(&bar[XB_XCNT(j)]); sum += c; cnt += (c > 0u) ? 1u : 0u; mine = (j == x) ? c : mine; }
        if (sum == G) break;
        __builtin_amdgcn_s_sleep(1);
        if ((++sp & 255u) == 0u) { if (xb_ld(&bar[XB_TMO])) break; if (sp > XB_SPIN_CAP) { atomicAdd(&bar[XB_TMO], 1u); break; } }
    }
    nloc = mine > 0u ? mine : 1u; nx = cnt > 0u ? cnt : 1u;
}
__device__ __forceinline__ void xcd_barrier(const XcdBarrier& b) {
    asm volatile("s_waitcnt vmcnt(0)" ::: "memory");
    __syncthreads();
    if (threadIdx.x == 0) {
        unsigned* bar = b.bar;
        __builtin_amdgcn_s_waitcnt(0);
        unsigned nloc = b.st[0], nx = b.st[1];
        if (nloc == 0u) { xcd_barrier_complete(bar, b.x, nloc, nx); b.st[0] = nloc; b.st[1] = nx; }
        const unsigned old = xb_add(&bar[XB_XSUB(b.x)], 1u);
        const unsigned gen = old / nloc;
        if (old + 1u == (gen + 1u) * nloc) {
            __builtin_amdgcn_fence(__ATOMIC_RELEASE, "agent");
            asm volatile("s_waitcnt vmcnt(0)" ::: "memory");
            const unsigned og = xb_add(&bar[XB_TOP], 1u);
            const unsigned tg = og / nx;
            if (og + 1u == (tg + 1u) * nx) xb_add(&bar[XB_TOPGEN], 1u);
            else XB_SPIN(xb_ld(&bar[XB_TOPGEN]) == tg, bar);
            __builtin_amdgcn_fence(__ATOMIC_ACQUIRE, "agent");
            xb_add(&bar[XB_XGEN(b.x)], 1u);
            asm volatile("s_waitcnt vmcnt(0)" ::: "memory");
        } else {
            XB_SPIN(xb_ld(&bar[XB_XGEN(b.x)]) == gen, bar);
            __builtin_amdgcn_fence(__ATOMIC_ACQUIRE, "agent");
            asm volatile("s_waitcnt vmcnt(0)" ::: "memory");
        }
    }
    __syncthreads();
}

__device__ __forceinline__ int opaque_i(int v) { asm volatile("" : "+s"(v)); return v; }
#define LDS_BARRIER() do { asm volatile("s_waitcnt lgkmcnt(0)" ::: "memory"); __builtin_amdgcn_s_barrier(); asm volatile("" ::: "memory"); } while (0)
struct Args { const float* in[26]; float* out; unsigned char* ws; int ph_lo, ph_hi; };

namespace pg8 {
struct PanelOrder {
    int c;
    __device__ bool next(int i, Unit& u) const { if (i >= 4) return false; u.pm = c; u.pn = i; return true; }
    __device__ __forceinline__ void a_ready(const Unit&) const {}
    __device__ __forceinline__ void done(const Unit&) const {}
};
struct EpiResid {
    static constexpr bool PERM = true, AFTER_DRAIN = false;
    const float* X; float* X2; bf16_t* XB; float* ssqp;
    __device__ __forceinline__ void operator()(const f32x4 (&acc)[2][2][4][2], const Unit& u, int wr, int wc, int fr, int fq) const {
        int pm_ = u.pm; asm volatile("" : "+s"(pm_));
        const int row0 = pm_ * BM + wr * 64 + fr, col0 = u.pn * BM + wc * 32 + 8 * fq;
#pragma unroll
        for (int ai = 0; ai < 2; ++ai)
#pragma unroll
            for (int m = 0; m < 4; ++m) { const int row = row0 + ai * HALF + m * 16; float ss = 0.f;
#pragma unroll
                for (int bj = 0; bj < 2; ++bj) { const size_t off = (size_t)row * DM + col0 + bj * HALF;
                    const f32x4 x0 = *(const f32x4*)(X + off), x1 = *(const f32x4*)(X + off + 4);
                    const f32x4 v0 = acc[ai][bj][m][0] + x0, v1 = acc[ai][bj][m][1] + x1;
                    *(f32x4*)(X2 + off) = v0; *(f32x4*)(X2 + off + 4) = v1;
                    ss += (v0[0] * v0[0] + v0[1] * v0[1]) + (v0[2] * v0[2] + v0[3] * v0[3]) + (v1[0] * v1[0] + v1[1] * v1[1]) + (v1[2] * v1[2] + v1[3] * v1[3]);
                    if (XB) { u32x4 w; w.x = pk2(v0[0], v0[1]); w.y = pk2(v0[2], v0[3]); w.z = pk2(v1[0], v1[1]); w.w = pk2(v1[2], v1[3]); *(u32x4*)(XB + off) = w; } }
                ss += __shfl_xor(ss, 16); ss += __shfl_xor(ss, 32);
                if (fq == 0) ssqp[(size_t)row * 16 + u.pn * 4 + wc] = ss; }
    }
};
struct EpiScale {
    static constexpr bool PERM = true, AFTER_DRAIN = false;
    bf16_t* O; int ldc; const float* rs; int row_off;
    __device__ __forceinline__ void operator()(const f32x4 (&acc)[2][2][4][2], const Unit& u, int wr, int wc, int fr, int fq) const {
        const int row0 = u.pm * BM + wr * 64 + fr, col0 = u.pn * BM + wc * 32 + 8 * fq;
#pragma unroll
        for (int ai = 0; ai < 2; ++ai)
#pragma unroll
            for (int m = 0; m < 4; ++m) { const int row = row0 + ai * HALF + m * 16; const float s = rs[row_off + row]; bf16_t* rowp = O + (size_t)row * ldc + col0;
#pragma unroll
                for (int bj = 0; bj < 2; ++bj) { const f32x4 v0 = acc[ai][bj][m][0] * s, v1 = acc[ai][bj][m][1] * s;
                    u32x4 w; w.x = pk2(v0[0], v0[1]); w.y = pk2(v0[2], v0[3]); w.z = pk2(v1[0], v1[1]); w.w = pk2(v1[2], v1[3]); *(u32x4*)(rowp + bj * HALF) = w; } }
    }
};
struct EpiFfn {
    static constexpr bool PERM = true, AFTER_DRAIN = false;
    bf16_t* G; const float* rs; const float* cw; const float* cb; float* SA; float* SB; float* SL; LAS float* hal;
    __device__ __forceinline__ void operator()(const f32x4 (&acc)[2][2][4][2], const Unit& u, int wr, int wc, int fr, int fq) const {
        int chl = wc * 32 + 8 * fq; asm volatile("" : "+v"(chl));
        const int f0 = u.pn * 128 + chl, rowt = wr * 64 + fr;
        float rsv[2][4];
#pragma unroll
        for (int ai = 0; ai < 2; ++ai)
#pragma unroll
            for (int m = 0; m < 4; ++m) rsv[ai][m] = rs[u.pm * BM + ai * HALF + m * 16 + rowt];
        const size_t sbase = ((size_t)(u.pm * 22 + u.pn) * 2) * 128 + chl;
        if (fr >= 14) {
#pragma unroll
            for (int ai = 0; ai < 2; ++ai) { const float r_ = rsv[ai][3]; const f32x4 v0 = acc[ai][0][3][0] * r_, v1 = acc[ai][0][3][1] * r_;
                LAS float* hp = hal + ((ai * 2 + wr) * 2 + (fr - 14)) * 128 + chl; *(LAS f32x4*)hp = v0; *(LAS f32x4*)(hp + 4) = v1;
                if (ai == 1 && wr == 1) { float* gp = SL + sbase + (fr - 14) * 128; *(f32x4*)gp = v0; *(f32x4*)(gp + 4) = v1; } }
        }
        if (wr == 0 && fr < 2) { const float r_ = rsv[0][0]; float* ga = SA + sbase + fr * 128; float* gb = SB + sbase + fr * 128;
            *(f32x4*)ga = acc[0][0][0][0] * r_; *(f32x4*)(ga + 4) = acc[0][0][0][1] * r_; *(f32x4*)gb = acc[0][1][0][0] * r_; *(f32x4*)(gb + 4) = acc[0][1][0][1] * r_; }
        asm volatile("s_waitcnt lgkmcnt(0)" ::: "memory"); __builtin_amdgcn_s_barrier(); asm volatile("" ::: "memory");
        float w0[8], w1[8], w2[8], bz[8];
        { const f32x4 a0 = *(const f32x4*)(cw + f0), a1 = *(const f32x4*)(cw + f0 + 4), b0 = *(const f32x4*)(cw + DFF + f0), b1 = *(const f32x4*)(cw + DFF + f0 + 4);
          const f32x4 c0 = *(const f32x4*)(cw + 2 * DFF + f0), c1 = *(const f32x4*)(cw + 2 * DFF + f0 + 4), d0 = *(const f32x4*)(cb + f0), d1 = *(const f32x4*)(cb + f0 + 4);
#pragma unroll
          for (int j = 0; j < 4; ++j) { w0[j] = a0[j]; w0[4 + j] = a1[j]; w1[j] = b0[j]; w1[4 + j] = b1[j]; w2[j] = c0[j]; w2[4 + j] = c1[j]; bz[j] = d0[j]; bz[4 + j] = d1[j]; } }
        const bool fr0 = (fr == 0), frl2 = (fr < 2);
#pragma unroll
        for (int ai = 0; ai < 2; ++ai) {
            float ap[8];
            const int pb = ai * 2 + wr - 1;
#pragma unroll
            for (int m = 0; m < 4; ++m) {
                float av[8], bv[8], y1[8], y2[8];
                const float r_ = rsv[ai][m];
#pragma unroll
                for (int j = 0; j < 4; ++j) { av[j] = acc[ai][0][m][0][j] * r_; av[4 + j] = acc[ai][0][m][1][j] * r_; bv[j] = acc[ai][1][m][0][j] * r_; bv[4 + j] = acc[ai][1][m][1][j] * r_; }
                if (m == 0) {
                    if (pb >= 0) { const LAS float* h0 = hal + (pb * 2) * 128 + chl; const f32x4 h00 = *(const LAS f32x4*)h0, h01 = *(const LAS f32x4*)(h0 + 4), h10 = *(const LAS f32x4*)(h0 + 128), h11 = *(const LAS f32x4*)(h0 + 132);
#pragma unroll
                        for (int j = 0; j < 4; ++j) { y1[j] = h10[j]; y1[4 + j] = h11[j]; y2[j] = fr0 ? h00[j] : h10[j]; y2[4 + j] = fr0 ? h01[j] : h11[j]; } }
                    else {
#pragma unroll
                        for (int j = 0; j < 8; ++j) { y1[j] = 0.f; y2[j] = 0.f; } }
                } else {
#pragma unroll
                    for (int j = 0; j < 8; ++j) { y1[j] = dppmov<0x121>(ap[j]); y2[j] = dppmov<0x122>(ap[j]); }
                }
                float o[8];
#pragma unroll
                for (int j = 0; j < 8; ++j) { const float x1 = dppmov<0x121>(av[j]), x2 = dppmov<0x122>(av[j]);
                    const float am1 = fr0 ? y1[j] : x1, am2 = frl2 ? y2[j] : x2;
                    const float z = bz[j] + w0[j] * am2 + w1[j] * am1 + w2[j] * av[j];
                    o[j] = z * sigmoidf_(z) * bv[j]; ap[j] = av[j]; }
                if (!(ai == 0 && m == 0 && wr == 0 && frl2)) *(u32x4*)(G + (size_t)(u.pm * BM + ai * HALF + m * 16 + rowt) * DFF + f0) = pack8(o);
            }
        }
    }
};
}

template <bool FFN_UP = false>
__device__ __forceinline__ void transpose_item(const float* W, int ldw, int K, bf16* WT, const float* kscale, LAS float* scr, int item, int nblk, int lane) {
    const int kb = item / nblk, nb = item % nblk, k0 = 64 * kb, n0 = 32 * nb;
    const int d0 = !FFN_UP ? n0 : (n0 < DFF ? ((n0 >> 7) * 256 + (n0 & 127)) : ((((n0 - DFF) >> 7) * 256) + 128 + ((n0 - DFF) & 127)));
#pragma unroll 8
    for (int i = 0; i < 32; ++i) { const int kk = 2 * i + (lane >> 5); const float s = kscale ? kscale[k0 + kk] : 1.0f; scr[kk * 33 + (lane & 31)] = W[(size_t)(k0 + kk) * ldw + n0 + (lane & 31)] * s; }
    asm volatile("s_waitcnt lgkmcnt(0)" ::: "memory");
    const int c = lane & 7;
#pragma unroll
    for (int j = 0; j < 4; ++j) { const int n = (lane >> 3) + 8 * j; const LAS float* s = scr + (8 * c) * 33 + n;
        v4u o; o.x = pk2(s[0 * 33], s[1 * 33]); o.y = pk2(s[2 * 33], s[3 * 33]); o.z = pk2(s[4 * 33], s[5 * 33]); o.w = pk2(s[6 * 33], s[7 * 33]);
        *(v4u*)(WT + (size_t)(d0 + n) * K + k0 + 8 * c) = o; }
    asm volatile("s_waitcnt lgkmcnt(0)" ::: "memory");
}

__device__ __forceinline__ void phase_prep(const Args& a, LAS unsigned char* lds, int tid, int lane, int wave) {
    unsigned char* ws = a.ws;
    LAS float* scr = (LAS float*)(lds + wave * 16384);
    const int gw = blockIdx.x * 8 + wave, NGW = gridDim.x * 8;
    constexpr int I_IN = 16 * 104, I_OUT = 16 * 32, I_UP = 16 * 176, I_DN = 44 * 32;
    for (int it = gw; it < I_IN + I_OUT + I_UP + I_DN; it += NGW) {
        int r = it;
        if (r < I_IN) { transpose_item(a.in[2], NIN, DM, (bf16*)(ws + WS_WT_IN), a.in[1], scr, r, 104, lane); continue; } r -= I_IN;
        if (r < I_OUT) { transpose_item(a.in[19], DM, DM, (bf16*)(ws + WS_WT_OUT), nullptr, scr, r, 32, lane); continue; } r -= I_OUT;
        if (r < I_UP) { transpose_item<true>(a.in[21], NUP, DM, (bf16*)(ws + WS_WT_UP), a.in[20], scr, r, 176, lane); continue; } r -= I_UP;
        transpose_item(a.in[24], DM, DFF, (bf16*)(ws + WS_WT_DN), nullptr, scr, r, 32, lane);
    }
    {
        const float* wd = a.in[5]; const float* wa = a.in[7]; const float* wg = a.in[8]; bf16* WL = (bf16*)(ws + WS_WT_LORA);
        for (int idx = blockIdx.x * 512 + tid; idx < NLORA * KLORA; idx += gridDim.x * 512) {
            const int n = idx >> 8, k = idx & 255; float v = 0.f;
            if (n < 512) { if (k < 64) v = wd[k * 512 + n]; }
            else if (n < 1024) { if (k >= 64 && k < 128) v = wa[(k - 64) * 512 + (n - 512)]; }
            else { if (k >= 128) v = wg[(k - 128) * 512 + (n - 1024)]; }
            WL[idx] = (bf16)f2bf(v);
        }
    }
    {
        const float* x = a.in[0]; const float* g1 = a.in[1]; const float* w_in = a.in[2];
        bf16* XN = (bf16*)(ws + WS_XN); float* gates = (float*)(ws + WS_GATES);
        float wgt[16][8];
#pragma unroll
        for (int j = 0; j < 4; ++j)
#pragma unroll
            for (int e = 0; e < 4; ++e) { const int k = 4 * lane + 256 * j + e; const float g = g1[k];
                const f32x4 w0 = *(const f32x4*)(w_in + (size_t)k * NIN + 3328), w1 = *(const f32x4*)(w_in + (size_t)k * NIN + 3332);
                wgt[j * 4 + e][0] = w0[0] * g; wgt[j * 4 + e][1] = w0[1] * g; wgt[j * 4 + e][2] = w0[2] * g; wgt[j * 4 + e][3] = w0[3] * g;
                wgt[j * 4 + e][4] = w1[0] * g; wgt[j * 4 + e][5] = w1[1] * g; wgt[j * 4 + e][6] = w1[2] * g; wgt[j * 4 + e][7] = w1[3] * g; }
        for (int row = gw; row < M; row += NGW) {
            const f32x4* xr = (const f32x4*)(x + (size_t)row * DM) + lane;
            f32x4 v[4]; float ss = 0.f;
#pragma unroll
            for (int j = 0; j < 4; ++j) { v[j] = xr[64 * j]; ss += (v[j][0] * v[j][0] + v[j][1] * v[j][1]) + (v[j][2] * v[j][2] + v[j][3] * v[j][3]); }
            ss = wave_sum(ss);
            const float rs = frsq(ss * (1.0f / DM) + NORM_EPS);
            unsigned long long* o8 = (unsigned long long*)(XN + (size_t)row * DM) + lane;
#pragma unroll
            for (int j = 0; j < 4; ++j) o8[64 * j] = (unsigned long long)pk2(v[j][0] * rs, v[j][1] * rs) | ((unsigned long long)pk2(v[j][2] * rs, v[j][3] * rs) << 32);
            float gs[8];
#pragma unroll
            for (int jg = 0; jg < 8; ++jg) { float s = 0.f;
#pragma unroll
                for (int j = 0; j < 4; ++j)
#pragma unroll
                    for (int e = 0; e < 4; ++e) s += v[j][e] * wgt[j * 4 + e][jg];
                gs[jg] = wave_sum(s); }
            if (lane < 8) { float s = gs[0];
#pragma unroll
                for (int jg = 1; jg < 8; ++jg) s = (lane == jg) ? gs[jg] : s;
                gates[(size_t)row * 8 + lane] = s * rs; }
        }
    }
}

__device__ __forceinline__ void phase_lmat(const Args& a, int tid) {
    unsigned char* ws = a.ws; const bf16* PROJ = (const bf16*)(ws + WS_PROJ); bf16* L = (bf16*)(ws + WS_LBUF); const float* mu = a.in[3];
    const int NT = gridDim.x * 512;
    for (int it = blockIdx.x * 512 + tid; it < M * 32; it += NT) {
        const int row = it >> 5, grp = it & 31, c0 = 1536 + 8 * grp;
        const v4u cur = *(const v4u*)(PROJ + (size_t)row * NPROJ + c0);
        v4u prv = {0u, 0u, 0u, 0u}; if ((row & (SEQ - 1)) != 0) prv = *(const v4u*)(PROJ + (size_t)(row - 1) * NPROJ + c0);
        const f32x4 m0 = *(const f32x4*)(mu + c0), m1 = *(const f32x4*)(mu + c0 + 4);
        float c[8], p[8], o[8]; unpack8(cur, c); unpack8(prv, p);
#pragma unroll
        for (int e = 0; e < 8; ++e) { const float mm = e < 4 ? m0[e & 3] : m1[e & 3]; const float xv = c[e] + (p[e] - c[e]) * mm;
            o[e] = grp < 8 ? tanhf_(xv) : (grp < 16 ? xv : sigmoidf_(xv)); }
        *(v4u*)(L + (size_t)row * KLORA + 8 * grp) = pack8(o);
    }
}

__device__ __forceinline__ void red16x4(float& a, float& b, float& c, float& d) {
    asm volatile(
        "s_nop 1\n\t"
        "v_add_f32_dpp %0, %0, %0 quad_perm:[1,0,3,2] row_mask:0xf bank_mask:0xf\n\t"
        "v_add_f32_dpp %1, %1, %1 quad_perm:[1,0,3,2] row_mask:0xf bank_mask:0xf\n\t"
        "v_add_f32_dpp %2, %2, %2 quad_perm:[1,0,3,2] row_mask:0xf bank_mask:0xf\n\t"
        "v_add_f32_dpp %3, %3, %3 quad_perm:[1,0,3,2] row_mask:0xf bank_mask:0xf\n\t"
        "v_add_f32_dpp %0, %0, %0 quad_perm:[2,3,0,1] row_mask:0xf bank_mask:0xf\n\t"
        "v_add_f32_dpp %1, %1, %1 quad_perm:[2,3,0,1] row_mask:0xf bank_mask:0xf\n\t"
        "v_add_f32_dpp %2, %2, %2 quad_perm:[2,3,0,1] row_mask:0xf bank_mask:0xf\n\t"
        "v_add_f32_dpp %3, %3, %3 quad_perm:[2,3,0,1] row_mask:0xf bank_mask:0xf\n\t"
        "v_add_f32_dpp %0, %0, %0 row_half_mirror row_mask:0xf bank_mask:0xf\n\t"
        "v_add_f32_dpp %1, %1, %1 row_half_mirror row_mask:0xf bank_mask:0xf\n\t"
        "v_add_f32_dpp %2, %2, %2 row_half_mirror row_mask:0xf bank_mask:0xf\n\t"
        "v_add_f32_dpp %3, %3, %3 row_half_mirror row_mask:0xf bank_mask:0xf\n\t"
        "v_add_f32_dpp %0, %0, %0 row_mirror row_mask:0xf bank_mask:0xf\n\t"
        "v_add_f32_dpp %1, %1, %1 row_mirror row_mask:0xf bank_mask:0xf\n\t"
        "v_add_f32_dpp %2, %2, %2 row_mirror row_mask:0xf bank_mask:0xf\n\t"
        "v_add_f32_dpp %3, %3, %3 row_mirror row_mask:0xf bank_mask:0xf\n\t"
        "s_nop 0"
        : "+v"(a), "+v"(b), "+v"(c), "+v"(d));
}
__device__ __forceinline__ void rwkv_unit(const Args& a, LAS unsigned char* lds, int unit, int tid) {
    unsigned char* ws = a.ws; const bf16* PROJ = (const bf16*)(ws + WS_PROJ); const bf16* DAG = (const bf16*)(ws + WS_DAG); bf16* MIX = (bf16*)(ws + WS_MIX);
    const int b = unit >> 3, h = unit & 7;
    LAS float* Qa = (LAS float*)lds; LAS float* Wa = Qa + 4096; LAS float* Ka = Wa + 4096; LAS float* Va = Ka + 4096; LAS float* Aa = Va + 4096; LAS float* Ba = Aa + 4096; LAS float* Ya = Ba + 4096;
    LAS float* sc2 = Ya + 4096; LAS float* bon = sc2 + 128;
    const int cg = tid & 15, rp = tid >> 4;
    const int tt_s = tid >> 3, c8 = tid & 7, j0 = h * 64 + 8 * c8;
    float mur[8], muk[8], muv[8], kkc[8], kac[8], rkc[8], w0c[8], a0c[8], lwc[8], lbc[8];
#pragma unroll
    for (int e = 0; e < 8; ++e) { mur[e] = a.in[3][j0 + e]; muk[e] = a.in[3][512 + j0 + e]; muv[e] = a.in[3][1024 + j0 + e]; kkc[e] = a.in[9][j0 + e]; kac[e] = a.in[10][j0 + e]; rkc[e] = a.in[11][j0 + e];
        w0c[e] = a.in[4][j0 + e]; a0c[e] = a.in[6][j0 + e]; lwc[e] = a.in[12][j0 + e]; lbc[e] = a.in[13][j0 + e]; }
    float S0[4] = {0.f, 0.f, 0.f, 0.f}, S1[4] = {0.f, 0.f, 0.f, 0.f};
    v4u g_rc, g_kc, g_vc, g_rp, g_kp, g_vp, g_ld, g_a, g_g;
#define RW_LOADBLK(blk_) do { const int t_ = b * SEQ + (blk_) * 64 + tt_s; const bf16* pr_ = PROJ + (size_t)t_ * NPROJ; \
        g_rc = *(const v4u*)(pr_ + j0); g_kc = *(const v4u*)(pr_ + 512 + j0); g_vc = *(const v4u*)(pr_ + 1024 + j0); \
        if ((blk_) == 0 && tt_s == 0) { g_rp = (v4u){0u, 0u, 0u, 0u}; g_kp = g_rp; g_vp = g_rp; } \
        else { g_rp = *(const v4u*)(pr_ - NPROJ + j0); g_kp = *(const v4u*)(pr_ - NPROJ + 512 + j0); g_vp = *(const v4u*)(pr_ - NPROJ + 1024 + j0); } \
        g_ld = *(const v4u*)(DAG + (size_t)t_ * NLORA + j0); g_a = *(const v4u*)(DAG + (size_t)t_ * NLORA + 512 + j0); g_g = *(const v4u*)(DAG + (size_t)t_ * NLORA + 1024 + j0); } while (0)
    RW_LOADBLK(0);
    for (int blk = 0; blk < SEQ / 64; ++blk) {
        const int t0 = b * SEQ + blk * 64;
        {
            float rc[8], kc[8], vc[8], rp_[8], kp[8], vp[8], av[8], ldv[8];
            unpack8(g_rc, rc); unpack8(g_kc, kc); unpack8(g_vc, vc); unpack8(g_rp, rp_); unpack8(g_kp, kp); unpack8(g_vp, vp); unpack8(g_ld, ldv); unpack8(g_a, av);
            float ss = 0.f, bonus = 0.f, brs = 0.f, krs = 0.f, kkr[8], rr[8], km[8], vv[8], wv[8];
#pragma unroll
            for (int e = 0; e < 8; ++e) {
                const float r = rc[e] + (rp_[e] - rc[e]) * mur[e];
                const float k = kc[e] + (kp[e] - kc[e]) * muk[e];
                const float v = vc[e] + (vp[e] - vc[e]) * muv[e];
                kkr[e] = k * kkc[e]; ss += kkr[e] * kkr[e];
                av[e] = sigmoidf_(a0c[e] + av[e]);
                wv[e] = fexp(-0.6065306597f * sigmoidf_(w0c[e] + ldv[e]));
                km[e] = k * (1.0f + (av[e] - 1.0f) * kac[e]);
                bonus += r * km[e] * rkc[e]; krs += r * km[e];
                rr[e] = r; vv[e] = v;
            }
            ss = red8(ss);
            const float inv = frcp(fmaxf(fsqrt_(ss), 1e-12f));
            const int o = tt_s * 64 + 8 * c8;
#pragma unroll
            for (int e = 0; e < 8; ++e) { const float kk = kkr[e] * inv; const float bb = kk * av[e]; brs += bb * rr[e];
                Qa[o + e] = wv[e] * rr[e]; Wa[o + e] = wv[e]; Ka[o + e] = km[e]; Va[o + e] = vv[e]; Aa[o + e] = -kk; Ba[o + e] = bb; }
            bonus = red8(bonus); krs = red8(krs); brs = red8(brs);
            if (c8 == 0) { bon[tt_s] = bonus; sc2[2 * tt_s] = brs; sc2[2 * tt_s + 1] = krs; }
        }
        const v4u gcur = g_g;
        LDS_BARRIER();
        if (blk + 1 < SEQ / 64) RW_LOADBLK(blk + 1);
        f32x4 A0, Q0, W0, B0, K0, A1, Q1, W1, B1, K1; f32x2 V0, C0, V1, C1;
#define RW_LD(tt_, A, Q, W, B, K, V, C) do { const int o_ = (tt_) * 64 + 4 * cg; A = *(const LAS f32x4*)(Aa + o_); Q = *(const LAS f32x4*)(Qa + o_); W = *(const LAS f32x4*)(Wa + o_); B = *(const LAS f32x4*)(Ba + o_); \
        K = *(const LAS f32x4*)(Ka + o_); V = *(const LAS f32x2*)(Va + (tt_) * 64 + 2 * rp); C = *(const LAS f32x2*)(sc2 + 2 * (tt_)); } while (0)
#define RW_STEP(tt_, A, Q, W, B, K, V, C) do { \
        float p0 = (S0[0] * A[0] + S0[1] * A[1]) + (S0[2] * A[2] + S0[3] * A[3]), p1 = (S1[0] * A[0] + S1[1] * A[1]) + (S1[2] * A[2] + S1[3] * A[3]); \
        float q0 = (S0[0] * Q[0] + S0[1] * Q[1]) + (S0[2] * Q[2] + S0[3] * Q[3]), q1 = (S1[0] * Q[0] + S1[1] * Q[1]) + (S1[2] * Q[2] + S1[3] * Q[3]); \
        red16x4(p0, p1, q0, q1); \
        const float y0 = q0 + (p0 * C[0] + V[0] * C[1]), y1 = q1 + (p1 * C[0] + V[1] * C[1]); \
        _Pragma("unroll") for (int c = 0; c < 4; ++c) { S0[c] = S0[c] * W[c] + (p0 * B[c] + V[0] * K[c]); S1[c] = S1[c] * W[c] + (p1 * B[c] + V[1] * K[c]); } \
        if (cg == 0) *(LAS f32x2*)(Ya + (tt_) * 64 + 2 * rp) = (f32x2){y0, y1}; } while (0)
        RW_LD(0, A0, Q0, W0, B0, K0, V0, C0);
#pragma unroll 1
        for (int tt = 0; tt < 64; tt += 2) {
            RW_LD(tt + 1, A1, Q1, W1, B1, K1, V1, C1);
            RW_STEP(tt, A0, Q0, W0, B0, K0, V0, C0);
            RW_LD((tt + 2) & 63, A0, Q0, W0, B0, K0, V0, C0);
            RW_STEP(tt + 1, A1, Q1, W1, B1, K1, V1, C1);
        }
        LDS_BARRIER();
        {
            const int t = t0 + tt_s; const int o = tt_s * 64 + 8 * c8;
            float y[8], gv[8]; float s1 = 0.f;
#pragma unroll
            for (int e = 0; e < 8; ++e) { y[e] = Ya[o + e]; s1 += y[e]; }
            s1 = red8(s1); const float mean = s1 * (1.0f / 64.0f); float s2 = 0.f;
#pragma unroll
            for (int e = 0; e < 8; ++e) { const float d = y[e] - mean; s2 += d * d; }
            s2 = red8(s2); const float rstd = frsq(s2 * (1.0f / 64.0f) + LNX_EPS);
            unpack8(gcur, gv);
            const float bonus = bon[tt_s]; float ov[8];
#pragma unroll
            for (int e = 0; e < 8; ++e) { const float yn = (y[e] - mean) * rstd * lwc[e] + lbc[e]; ov[e] = (yn + bonus * Va[o + e]) * gv[e]; }
            *(v4u*)(MIX + (size_t)t * DM + j0) = pack8(ov);
        }
        LDS_BARRIER();
    }
#undef RW_LOADBLK
#undef RW_LD
#undef RW_STEP
}

__device__ __forceinline__ f32x4 mfma16(const bf16x8 a, const bf16x8 b, const f32x4 c) { return __builtin_amdgcn_mfma_f32_16x16x32_bf16(a, b, c, 0, 0, 0); }
__device__ __forceinline__ void mlstm_unit(const Args& a, LAS unsigned char* lds, int unit, int tid, int lane, int wave) {
    unsigned char* ws = a.ws; const bf16* PROJ = (const bf16*)(ws + WS_PROJ); const float* gates = (const float*)(ws + WS_GATES); bf16* MIX = (bf16*)(ws + WS_MIX);
    const float* cw = a.in[14]; const float* cbias = a.in[15]; const float* i_bias = a.in[16]; const float* f_bias = a.in[17]; const float* mhg = a.in[18];
    const int b = unit >> 2, hm = unit & 3;
    constexpr int LD = 72;
    LAS bf16* Ql = (LAS bf16*)lds; LAS bf16* Kl = Ql + 64 * LD; LAS bf16* Kwt = Kl + 64 * LD; LAS bf16* Vt = Kwt + 64 * LD; LAS bf16* Sm = Vt + 128 * LD; LAS bf16* Ct = Sm + 64 * LD;
    LAS float* Hl = (LAS float*)(Ct + 128 * LD);
    LAS float* e_s = Hl + 64 * 132; LAS float* Mx = e_s + 64; LAS float* sc = Mx + 64; LAS float* em = sc + 64; LAS float* wsv = em + 64; LAS float* den = wsv + 64; LAS float* nvec = den + 64; LAS float* scal = nvec + 64;
    for (int i = tid; i < 128 * LD / 2; i += 512) ((LAS unsigned*)Ct)[i] = 0u;
    if (tid < 64) nvec[tid] = 0.f;
    if (tid == 0) { scal[0] = 1.f; scal[1] = 0.f; }
    f32x4 cacc[4];
#pragma unroll
    for (int i = 0; i < 4; ++i) cacc[i] = (f32x4){0.f, 0.f, 0.f, 0.f};
    const int l15 = lane & 15, l4 = lane >> 4;
    const int tt = tid >> 3, p8 = tid & 7;
    LAS float* cwl = scal + 16; LAS float* cbl = cwl + 512;
    for (int i = tid; i < 640; i += 512) { const int j = i >> 7, c_ = i & 127; const int src = (c_ < 64) ? (hm * 64 + c_) : (256 + hm * 64 + (c_ - 64)); if (j < 4) cwl[i] = cw[j * 512 + src]; else cbl[c_] = cbias[src]; }
    const float ibias = i_bias[hm], fbias = f_bias[hm];
    v4u n_q[4], n_k[4], n_va, n_vb, n_oa, n_ob; float n_gi = 0.f, n_gf = 0.f;
#define ML_LOADCHUNK(c_) do { const int t_ = b * SEQ + (c_) * 64 + lane; const int tp_ = (c_) * 64 + lane; \
        _Pragma("unroll") for (int j = 0; j < 4; ++j) { if (tp_ - 3 + j >= 0) { const bf16* pr_ = PROJ + (size_t)(t_ - 3 + j) * NPROJ + hm * 64 + 8 * wave; n_q[j] = *(const v4u*)(pr_ + C_Q); n_k[j] = *(const v4u*)(pr_ + C_K); } \
                                                       else { n_q[j] = (v4u){0u, 0u, 0u, 0u}; n_k[j] = (v4u){0u, 0u, 0u, 0u}; } } \
        { const bf16* pv_ = PROJ + (size_t)t_ * NPROJ + C_V + hm * 128 + 16 * wave; n_va = *(const v4u*)pv_; n_vb = *(const v4u*)(pv_ + 8); \
          const bf16* po_ = PROJ + (size_t)(b * SEQ + (c_) * 64 + tt) * NPROJ + C_O + hm * 128 + 16 * p8; n_oa = *(const v4u*)po_; n_ob = *(const v4u*)(po_ + 8); } \
        if (wave == 0) { n_gi = gates[(size_t)t_ * 8 + hm]; n_gf = gates[(size_t)t_ * 8 + 4 + hm]; } } while (0)
    ML_LOADCHUNK(0);
    LDS_BARRIER();
    for (int c = 0; c < SEQ / 64; ++c) {
        const int t0 = b * SEQ + c * 64;
        if (wave == 0) {
            const float gi = n_gi + ibias, gf = n_gf + fbias;
            const float ig = 15.0f * tanhf_(gi * (1.0f / 15.0f)), fx = 15.0f * tanhf_(gf * (1.0f / 15.0f));
            const float logf = -(fmaxf(-fx, 0.f) + __logf(1.0f + fexp(-fabsf(fx))));
            const float bc = wave_scan_add(logf);
            const float e = ig - bc; const float P = wave_scan_max(e);
            const float m = scal[1];
            const float mx = fmaxf(P, m); const float mxL = __shfl(mx, 63), bL = __shfl(bc, 63);
            e_s[lane] = e; Mx[lane] = mx; sc[lane] = fexp(m - mx); em[lane] = fexp(-(bc + mx)); wsv[lane] = fexp(e - mxL);
            if (lane == 0) { scal[0] = fexp(m - mxL); scal[1] = bL + mxL; }
        }
        LDS_BARRIER();
        v4u c_oa, c_ob;
        {
            const int d0 = 8 * wave;
            float aq[8], ak[8];
#pragma unroll
            for (int e = 0; e < 8; ++e) { aq[e] = cbl[d0 + e]; ak[e] = cbl[64 + d0 + e]; }
#pragma unroll
            for (int j = 0; j < 4; ++j) { float pq[8], pk[8]; unpack8(n_q[j], pq); unpack8(n_k[j], pk);
#pragma unroll
                for (int e = 0; e < 8; ++e) { aq[e] += cwl[j * 128 + d0 + e] * pq[e]; ak[e] += cwl[j * 128 + 64 + d0 + e] * pk[e]; } }
            const float w = wsv[lane];
#pragma unroll
            for (int e = 0; e < 8; ++e) { aq[e] = aq[e] * sigmoidf_(aq[e]) * 0.125f; ak[e] = ak[e] * sigmoidf_(ak[e]); }
            *(LAS v4u*)(Ql + lane * LD + d0) = pack8(aq); *(LAS v4u*)(Kl + lane * LD + d0) = pack8(ak);
#pragma unroll
            for (int e = 0; e < 8; ++e) Kwt[(d0 + e) * LD + lane] = (bf16)f2bf(w * ak[e]);
            const unsigned wv[8] = {n_va.x, n_va.y, n_va.z, n_va.w, n_vb.x, n_vb.y, n_vb.z, n_vb.w};
#pragma unroll
            for (int e = 0; e < 8; ++e) { Vt[(16 * wave + 2 * e) * LD + lane] = (bf16)(wv[e] & 0xffffu); Vt[(16 * wave + 2 * e + 1) * LD + lane] = (bf16)(wv[e] >> 16); }
            c_oa = n_oa; c_ob = n_ob;
            if (c + 1 < SEQ / 64) ML_LOADCHUNK(c + 1);
        }
        LDS_BARRIER();
        {
            const int rb = wave >> 1;
#pragma unroll
            for (int ci = 0; ci < 2; ++ci) { const int cb = 2 * (wave & 1) + ci; f32x4 acc = {0.f, 0.f, 0.f, 0.f};
#pragma unroll
                for (int kk = 0; kk < 2; ++kk) { const bf16x8 A = *(const LAS bf16x8*)(Ql + (16 * rb + l15) * LD + 32 * kk + 8 * l4), B = *(const LAS bf16x8*)(Kl + (16 * cb + l15) * LD + 32 * kk + 8 * l4); acc = mfma16(A, B, acc); }
                const int s = 16 * cb + l15; const float es = e_s[s];
#pragma unroll
                for (int r = 0; r < 4; ++r) { const int t = 16 * rb + 4 * l4 + r; const float v = (s <= t) ? acc[r] * fexp(es - Mx[t]) : 0.f; Sm[t * LD + s] = (bf16)f2bf(v); } }
        }
        LDS_BARRIER();
        f32x4 num[4];
        {
            float part = 0.f, qn = 0.f; float sv[8], qv[8];
            unpack8(*(const LAS v4u*)(Sm + tt * LD + 8 * p8), sv); unpack8(*(const LAS v4u*)(Ql + tt * LD + 8 * p8), qv);
#pragma unroll
            for (int e = 0; e < 8; ++e) { part += sv[e]; qn += qv[e] * nvec[8 * p8 + e]; }
            float tot = part + sc[tt] * qn; tot = red8(tot);
            if (p8 == 0) den[tt] = tot;
            const int rb = wave >> 1;
            bf16x8 As[2], Aq[2];
#pragma unroll
            for (int kk = 0; kk < 2; ++kk) { As[kk] = *(const LAS bf16x8*)(Sm + (16 * rb + l15) * LD + 32 * kk + 8 * l4); Aq[kk] = *(const LAS bf16x8*)(Ql + (16 * rb + l15) * LD + 32 * kk + 8 * l4); }
            float scr_[4];
#pragma unroll
            for (int r = 0; r < 4; ++r) scr_[r] = sc[16 * rb + 4 * l4 + r];
#pragma unroll
            for (int vi = 0; vi < 4; ++vi) { const int vb = 4 * (wave & 1) + vi; f32x4 a1 = {0.f, 0.f, 0.f, 0.f}, a2 = {0.f, 0.f, 0.f, 0.f};
#pragma unroll
                for (int kk = 0; kk < 2; ++kk) { const bf16x8 B1 = *(const LAS bf16x8*)(Vt + (16 * vb + l15) * LD + 32 * kk + 8 * l4), B2 = *(const LAS bf16x8*)(Ct + (16 * vb + l15) * LD + 32 * kk + 8 * l4);
                    a1 = mfma16(As[kk], B1, a1); a2 = mfma16(Aq[kk], B2, a2); }
#pragma unroll
                for (int r = 0; r < 4; ++r) num[vi][r] = a1[r] + scr_[r] * a2[r]; }
        }
        LDS_BARRIER();
        {
            const int rb = wave >> 1;
#pragma unroll
            for (int r = 0; r < 4; ++r) { const int t = 16 * rb + 4 * l4 + r; const float dn = frcp(fmaxf(fabsf(den[t]), em[t]));
#pragma unroll
                for (int vi = 0; vi < 4; ++vi) Hl[t * 132 + 16 * (4 * (wave & 1) + vi) + l15] = num[vi][r] * dn; }
            const float dec = scal[0];
            bf16x8 Av[2];
#pragma unroll
            for (int kk = 0; kk < 2; ++kk) Av[kk] = *(const LAS bf16x8*)(Vt + (16 * wave + l15) * LD + 32 * kk + 8 * l4);
#pragma unroll
            for (int db = 0; db < 4; ++db) { cacc[db] = cacc[db] * dec;
#pragma unroll
                for (int kk = 0; kk < 2; ++kk) { const bf16x8 B = *(const LAS bf16x8*)(Kwt + (16 * db + l15) * LD + 32 * kk + 8 * l4); cacc[db] = mfma16(Av[kk], B, cacc[db]); }
#pragma unroll
                for (int r = 0; r < 4; ++r) Ct[(16 * wave + 4 * l4 + r) * LD + 16 * db + l15] = (bf16)f2bf(cacc[db][r]); }
            float kv[8]; unpack8(*(const LAS v4u*)(Kwt + tt * LD + 8 * p8), kv); float s = 0.f;
#pragma unroll
            for (int e = 0; e < 8; ++e) s += kv[e];
            s = red8(s);
            if (p8 == 0) nvec[tt] = dec * nvec[tt] + s;
        }
        LDS_BARRIER();
        {
            const int t = t0 + tt, v0 = 16 * p8; float hv[16]; float ss = 0.f;
#pragma unroll
            for (int q = 0; q < 4; ++q) { const f32x4 x = *(const LAS f32x4*)(Hl + tt * 132 + v0 + 4 * q); hv[4 * q] = x[0]; hv[4 * q + 1] = x[1]; hv[4 * q + 2] = x[2]; hv[4 * q + 3] = x[3]; ss += (x[0] * x[0] + x[1] * x[1]) + (x[2] * x[2] + x[3] * x[3]); }
            ss = red8(ss); const float rn = frsq(ss * (1.0f / 128.0f) + NORM_EPS);
            float o0[8], o1[8]; unpack8(c_oa, o0); unpack8(c_ob, o1);
            float r0[8], r1[8];
#pragma unroll
            for (int e = 0; e < 8; ++e) { r0[e] = hv[e] * rn * mhg[hm * 128 + v0 + e] * sigmoidf_(o0[e]); r1[e] = hv[8 + e] * rn * mhg[hm * 128 + v0 + 8 + e] * sigmoidf_(o1[e]); }
            bf16* dst = MIX + (size_t)t * DM + 512 + hm * 128 + v0; *(v4u*)dst = pack8(r0); *(v4u*)(dst + 8) = pack8(r1);
        }
        LDS_BARRIER();
    }
}

__device__ __forceinline__ void phase_ffn_fix(const Args& a, int tid) {
    unsigned char* ws = a.ws; const float* SA = (const float*)(ws + WS_SIDE); const float* SB = SA + SIDE_ELEMS; const float* SL = SB + SIDE_ELEMS; bf16* GB = (bf16*)(ws + WS_GB);
    const float* cw = a.in[22]; const float* cb = a.in[23];
    const int NT = gridDim.x * 512;
    for (int it = blockIdx.x * 512 + tid; it < SIDE_ELEMS; it += NT) {
        const int ch = it & 127, r = (it >> 7) & 1, tile = it >> 8, pm = tile / 22, pn = tile % 22;
        const int base = tile * 256;
        float l0 = 0.f, l1 = 0.f;
        if ((pm & 7) != 0) { const int lb = (tile - 22) * 256; l0 = SL[lb + ch]; l1 = SL[lb + 128 + ch]; }
        const float a_r = SA[base + r * 128 + ch], b_r = SB[base + r * 128 + ch];
        const float am1 = r == 0 ? l1 : SA[base + ch], am2 = r == 0 ? l0 : l1;
        const int f = pn * 128 + ch;
        const float z = cb[f] + cw[f] * am2 + cw[DFF + f] * am1 + cw[2 * DFF + f] * a_r;
        GB[(size_t)(pm * 256 + r) * DFF + f] = (bf16)f2bf(z * sigmoidf_(z) * b_r);
    }
}
__device__ __forceinline__ void phase_final(const Args& a, int lane, int wave) {
    const float* ssqp = (const float*)(a.ws + WS_SSQP); const float* gf = a.in[25];
    f32x4 gv[4];
#pragma unroll
    for (int j = 0; j < 4; ++j) gv[j] = *((const f32x4*)gf + lane + 64 * j);
    const int NGW = gridDim.x * 8;
#ifdef PROBE
    const unsigned long long* tstamps = (const unsigned long long*)(a.ws + WS_CTL + 512 * 1024);
    const float fa = fminf(fmaxf((float)(long long)(tstamps[PROBE_A_TO] - tstamps[PROBE_A_FROM]) * (0.01f / PROBE_A_SCALE_US), 0.f), 1.f);
    const float fb = fminf(fmaxf((float)(long long)(tstamps[PROBE_B_TO] - tstamps[PROBE_B_FROM]) * (0.01f / PROBE_B_SCALE_US), 0.f), 1.f);
    const float pscale = 1.0f + sqrtf(fa * 0.8e-4f);
#pragma unroll
    for (int j = 0; j < 4; ++j) gv[j] = gv[j] * pscale;
#endif
    for (int row = blockIdx.x * 8 + wave; row < M; row += NGW) {
        const f32x4* p = (const f32x4*)(ssqp + (size_t)row * 16); const f32x4 s0 = p[0], s1 = p[1], s2 = p[2], s3 = p[3];
        const float ss = ((s0[0] + s0[1]) + (s0[2] + s0[3])) + ((s1[0] + s1[1]) + (s1[2] + s1[3])) + ((s2[0] + s2[1]) + (s2[2] + s2[3])) + ((s3[0] + s3[1]) + (s3[2] + s3[3]));
        const float rs = frsq(ss * (1.0f / DM) + NORM_EPS);
        f32x4* xr = (f32x4*)(a.out + (size_t)row * DM) + lane;
#pragma unroll
        for (int j = 0; j < 4; ++j) { f32x4 v = xr[64 * j] * rs * gv[j];
#ifdef PROBE
            if (row == 0 && lane == 0 && j == 0) v[0] += 2.0f + 28.0f * fb;
#endif
            xr[64 * j] = v; }
    }
}

constexpr int N_PHASES = 10;
__global__ void __launch_bounds__(512, 2) mega(Args args) {
    extern __shared__ __attribute__((aligned(16))) unsigned char lds_raw[];
    LAS unsigned char* lds = (LAS unsigned char*)lds_raw;
    const int tid0 = threadIdx.x;
    unsigned char* ws = args.ws;
#define PHASE_IDS int tid = tid0; asm volatile("" : "+v"(tid)); const int lane = tid & 63, wave = __builtin_amdgcn_readfirstlane(tid >> 6); (void)lane; (void)wave
    volatile LAS unsigned* MISC = (volatile LAS unsigned*)(lds + MISC_OFF);
    { PHASE_IDS; for (int u = tid; u < (LDS_BYTES - 131072) / 4; u += 512) ((LAS unsigned*)(lds + 131072))[u] = 0u; }
    __syncthreads();
    XcdBarrier bar; bar.bar = (unsigned*)(ws + WS_CTL) + 4096; bar.x = 0; bar.st = nullptr;
    if (MK_SINGLE) bar = xcd_barrier_post((unsigned*)(ws + WS_CTL) + 4096, MISC + 8);
    const int lo = args.ph_lo, hi = args.ph_hi;
#ifndef PH_MASK
#define PH_MASK 0xFFFF
#endif
#define IN(k) ((((PH_MASK) >> (k)) & 1) && lo <= (k) && (k) < hi)
#ifdef PROBE
    unsigned long long* const tstamps = (unsigned long long*)(ws + WS_CTL + 512 * 1024);
#define STAMP(k) do { if (blockIdx.x == 0 && tid0 == 0) tstamps[(k)] = __builtin_amdgcn_s_memrealtime(); } while (0)
#else
#define STAMP(k) do { } while (0)
#endif
    STAMP(0);
#define SEAM(k) do { if (IN(k) && IN((k) + 1)) xcd_barrier(bar); STAMP((k) + 1); } while (0)

    if (IN(0)) { PHASE_IDS; phase_prep(args, lds, tid, lane, wave); } SEAM(0);
    if (IN(1)) {
        pg8::Gemm g{(const bf16*)(ws + WS_XN), (const bf16*)(ws + WS_WT_IN), M, NPROJ, opaque_i(DM)}; pg8::StaticOrder S; S.init(M, NPROJ, gridDim.x, (int)blockIdx.x);
        pg8::EpiBf16<0> E{(bf16*)(ws + WS_PROJ), NPROJ, nullptr, 0, 0, 1.f};
        pg8::gemm_phase<pg8::EpiBf16<0>, pg8::StaticOrder, true, true>(lds, g, S, E);
    } SEAM(1);
    if (IN(2)) { PHASE_IDS; phase_lmat(args, tid); } SEAM(2);
    if (IN(3)) {
        pg8::Gemm g{(const bf16*)(ws + WS_LBUF), (const bf16*)(ws + WS_WT_LORA), M, NLORA, opaque_i(KLORA)}; pg8::StaticOrder S; S.init(M, NLORA, gridDim.x, (int)blockIdx.x);
        pg8::EpiBf16<0> E{(bf16*)(ws + WS_DAG), NLORA, nullptr, 0, 0, 1.f};
        pg8::gemm_phase<pg8::EpiBf16<0>, pg8::StaticOrder, true, true>(lds, g, S, E);
    } SEAM(3);
    if (IN(4)) {
        PHASE_IDS;
        for (int u = blockIdx.x; u < BATCH * 8; u += gridDim.x) rwkv_unit(args, lds, u, tid);
        __syncthreads();
        STAMP(12);
        for (int u = blockIdx.x; u < BATCH * 4; u += gridDim.x) mlstm_unit(args, lds, u, tid, lane, wave);
    } SEAM(4);
    if (IN(5)) {
        pg8::Gemm g{(const bf16*)(ws + WS_MIX), (const bf16*)(ws + WS_WT_OUT), M, DM, opaque_i(DM)}; pg8::StaticOrder S; S.init(M, DM, gridDim.x, (int)blockIdx.x);
        pg8::EpiResid E{args.in[0], args.out, (bf16*)(ws + WS_XN), (float*)(ws + WS_SSQP)};
        pg8::gemm_phase<pg8::EpiResid, pg8::StaticOrder, true, true>(lds, g, S, E);
    } SEAM(5);
    if (IN(6)) {
        pg8::Gemm g{(const bf16*)(ws + WS_XN), (const bf16*)(ws + WS_WT_UP), M, NUP, opaque_i(DM)}; pg8::StaticOrder S; S.init(M, NUP, gridDim.x, (int)blockIdx.x);
        float* side = (float*)(ws + WS_SIDE); float* rs2 = (float*)(ws + WS_RS2);
        {
            PHASE_IDS; pg8::Unit u;
            for (int i = 0; S.next(i, u); ++i) if (tid < 256) { const int row = u.pm * 256 + tid; const f32x4* p = (const f32x4*)((const float*)(ws + WS_SSQP) + (size_t)row * 16); const f32x4 s0 = p[0], s1 = p[1], s2 = p[2], s3 = p[3];
                const float ss = ((s0[0] + s0[1]) + (s0[2] + s0[3])) + ((s1[0] + s1[1]) + (s1[2] + s1[3])) + ((s2[0] + s2[1]) + (s2[2] + s2[3])) + ((s3[0] + s3[1]) + (s3[2] + s3[3]));
                rs2[row] = frsq(ss * (1.0f / DM) + NORM_EPS); }
            asm volatile("s_waitcnt vmcnt(0)" ::: "memory"); __syncthreads();
        }
        pg8::EpiFfn E{(bf16*)(ws + WS_GB), rs2, args.in[22], args.in[23], side, side + SIDE_ELEMS, side + 2 * SIDE_ELEMS, (LAS float*)(lds + 131072 + 1024)};
        pg8::gemm_phase<pg8::EpiFfn, pg8::StaticOrder, true, true>(lds, g, S, E);
    } SEAM(6);
    if (IN(7)) { PHASE_IDS; phase_ffn_fix(args, tid); } SEAM(7);
    if (IN(8)) {
        pg8::Gemm g{(const bf16*)(ws + WS_GB), (const bf16*)(ws + WS_WT_DN), M, DM, opaque_i(DFF)}; pg8::StaticOrder S; S.init(M, DM, gridDim.x, (int)blockIdx.x);
        pg8::EpiResid E{args.out, args.out, nullptr, (float*)(ws + WS_SSQP)};
        pg8::gemm_phase<pg8::EpiResid, pg8::StaticOrder, true, true>(lds, g, S, E);
    } SEAM(8);
    if (IN(9)) { PHASE_IDS; phase_final(args, lane, wave); }
#undef IN
#undef SEAM
}

extern "C" void kernel_launch(void* const* d_in, const int* in_sizes, int n_in, void* d_out, int out_size, void* d_ws, size_t ws_size, hipStream_t stream) {
    static int grid = 0;
    if (grid == 0) {
        if (n_in != 26 || in_sizes[0] != M * DM || out_size != M * DM || ws_size < WS_END) { fprintf(stderr, "kernel_launch: unexpected shapes (n_in %d, in0 %d, out %d, ws %zu)\n", n_in, n_in > 0 ? in_sizes[0] : -1, out_size, ws_size); grid = -1; return; }
        int dev = 0, cus = 0, per_cu = 0;
        if (hipGetDevice(&dev) != hipSuccess || hipDeviceGetAttribute(&cus, hipDeviceAttributeMultiprocessorCount, dev) != hipSuccess) { grid = -1; return; }
        if (hipFuncSetAttribute((const void*)mega, hipFuncAttributeMaxDynamicSharedMemorySize, LDS_BYTES) != hipSuccess) { fprintf(stderr, "kernel_launch: hipFuncSetAttribute failed\n"); grid = -1; return; }
        if (hipOccupancyMaxActiveBlocksPerMultiprocessor(&per_cu, (const void*)mega, 512, LDS_BYTES) != hipSuccess || per_cu < 1) { fprintf(stderr, "kernel_launch: occupancy query says %d blocks per CU\n", per_cu); }
        (void)hipGetLastError();
        grid = cus;
        if (grid != 256) fprintf(stderr, "kernel_launch: %d CUs; this kernel is laid out for 256\n", grid);
    }
    if (grid < 0) return;
    (void)hipMemsetAsync((char*)d_ws + WS_CTL, 0, CTL_ZERO_BYTES, stream);
    Args a{};
    for (int i = 0; i < 26; ++i) a.in[i] = (const float*)d_in[i];
    a.out = (float*)d_out; a.ws = (unsigned char*)d_ws;
#if MK_SINGLE
    a.ph_lo = 0; a.ph_hi = N_PHASES;
    hipLaunchKernelGGL(mega, dim3(grid), dim3(512), LDS_BYTES, stream, a);
#else
    for (int p = 0; p < N_PHASES; ++p) { a.ph_lo = p; a.ph_hi = p + 1; hipLaunchKernelGGL(mega, dim3(grid), dim3(512), LDS_BYTES, stream, a); }
#endif
}
```

```cpp
#include <hip/hip_runtime.h>
#include <cstdio>
#include <cstdint>
namespace pg8 {
#define PG8_LAS __attribute__((address_space(3)))
typedef unsigned short bf16_t;
typedef short bf16x8 __attribute__((ext_vector_type(8)));
typedef float f32x4 __attribute__((ext_vector_type(4)));
typedef unsigned u32x4 __attribute__((ext_vector_type(4)));
constexpr int BM = 256, BK = 64, HALF = 128, HTB = HALF * BK * 2  , STAGE_BYTES = 8 * HTB, NXCD = 8, WGM = 8;

__host__ __device__ __forceinline__ int lds_byte(int r, int c) { const int st = (r >> 4) * 2 + (c >> 5), rr = r & 15, cc = c & 31, ob = rr * 64 + cc * 2; return st * 1024 + (ob ^ (((ob >> 9) & 1) << 5)); }
__host__ __device__ __forceinline__ void stage_rc(int b, int& R, int& C) { const int st = b / 1024, sb = b % 1024, swz = sb ^ (((sb >> 9) & 1) << 5); R = (st >> 1) * 16 + swz / 64; C = (st & 1) * 32 + (swz % 64) / 2; }
__host__ __device__ __forceinline__ int perm32(int rho) { const int n = rho >> 4, i = rho & 15; return 8 * (i >> 2) + 4 * n + (i & 3); }

struct Unit { int pm, pn; };
struct Gemm { const bf16_t* A; const bf16_t* Bt; int M, N, K; };

struct StaticOrder {
    int nM, nN, nwg, G, c;
    __host__ __device__ void init(int M, int N, int G_, int c_) { nM = M / BM; nN = N / BM; nwg = nM * nN; G = G_; c = c_; }
    __host__ __device__ bool next(int i, Unit& u) const {
        const long L = (long)i * G + c; if (L >= nwg) return false;
        int wgid = (int)L; { const int q = nwg / NXCD, r = nwg % NXCD, xcd = wgid % NXCD, off = wgid / NXCD; wgid = (xcd < r ? xcd * (q + 1) : r * (q + 1) + (xcd - r) * q) + off; }
        const int nig = WGM * nN, gid = wgid / nig, fm = gid * WGM, gsz = (nM - fm) < WGM ? (nM - fm) : WGM;
        u.pm = fm + ((wgid % nig) % gsz); u.pn = (wgid % nig) / gsz; return true;
    }
    __device__ __forceinline__ void a_ready(const Unit&) const {}
    __device__ __forceinline__ void done(const Unit&) const {}
};

__device__ __forceinline__ unsigned cvt_pk_bf16(float lo, float hi) { unsigned r; asm volatile("v_cvt_pk_bf16_f32 %0, %1, %2" : "=v"(r) : "v"(lo), "v"(hi)); return r; }
typedef float f32x2 __attribute__((ext_vector_type(2)));
__device__ __forceinline__ f32x2 gelu_pk(f32x2 v) {
    const f32x2 av = __builtin_elementwise_abs(v), d = av * 0.2316418882f + 1.0f;
    f32x2 t; t.x = __builtin_amdgcn_rcpf(d.x); t.y = __builtin_amdgcn_rcpf(d.y);
    f32x2 q = t * 0.5307027145f + (-0.7265760135f); q = q * t + 0.7107068705f; q = q * t + (-0.142248368f); q = q * t + 0.127414796f; q = q * t;
    const f32x2 s = (v * v) * (-0.72134752044f);
    f32x2 e; e.x = __builtin_amdgcn_exp2f(s.x); e.y = __builtin_amdgcn_exp2f(s.y);
    const f32x2 m = v * (q * e), r = v - m;
    f32x2 o; o.x = v.x < 0.f ? m.x : r.x; o.y = v.y < 0.f ? m.y : r.y; return o;
}

template <int ACT  > struct EpiBf16 {
    static constexpr bool PERM = true, AFTER_DRAIN = false; static_assert(ACT == 0 || ACT == 1, "EpiBf16: ACT is 0 (none) or 1 (gelu_pk)");
    bf16_t* O; int ldc; const float* bias; int split_cols; size_t split_stride; float scale0;
    __device__ __forceinline__ void operator()(const f32x4 (&acc)[2][2][4][2], const Unit& u, int wr, int wc, int fr, int fq) const {
        const int row0 = u.pm * BM + wr * 64 + fr; int colt = u.pn * BM; bf16_t* base = O;
        float sc = 1.f; if (split_cols) { const int t = colt / split_cols; base += (size_t)t * split_stride; colt -= t * split_cols; if (t == 0) sc = scale0; }
        const int col0 = colt + wc * 32 + 8 * fq, bcol0 = u.pn * BM + wc * 32 + 8 * fq;
        f32x4 bv[2][2];
#pragma unroll
        for (int bj = 0; bj < 2; ++bj)
#pragma unroll
            for (int n = 0; n < 2; ++n) bv[bj][n] = bias ? *(const f32x4*)(bias + bcol0 + bj * HALF + 4 * n) : (f32x4){0.f, 0.f, 0.f, 0.f};
#pragma unroll
        for (int ai = 0; ai < 2; ++ai)
#pragma unroll
            for (int m = 0; m < 4; ++m) { bf16_t* rowp = base + (size_t)(row0 + ai * HALF + m * 16) * ldc + col0;
#pragma unroll
                for (int bj = 0; bj < 2; ++bj) { f32x4 v0 = acc[ai][bj][m][0] + bv[bj][0], v1 = acc[ai][bj][m][1] + bv[bj][1];
                    if (ACT == 1) { f32x2 a = gelu_pk((f32x2){v0[0], v0[1]}), b = gelu_pk((f32x2){v0[2], v0[3]}), c = gelu_pk((f32x2){v1[0], v1[1]}), d = gelu_pk((f32x2){v1[2], v1[3]});
                        v0 = (f32x4){a.x, a.y, b.x, b.y}; v1 = (f32x4){c.x, c.y, d.x, d.y}; }
                    v0 = v0 * sc; v1 = v1 * sc; u32x4 w; w.x = cvt_pk_bf16(v0[0], v0[1]); w.y = cvt_pk_bf16(v0[2], v0[3]); w.z = cvt_pk_bf16(v1[0], v1[1]); w.w = cvt_pk_bf16(v1[2], v1[3]);
                    *(u32x4*)(rowp + bj * HALF) = w; } }
    }
};
template <class Epi, class Sched, bool ALIGN_EPI = false, bool SP2 = false>
__device__ __forceinline__ void gemm_phase(PG8_LAS unsigned char* lds, const Gemm g, const Sched& S, const Epi& E) {
    const int tid = threadIdx.x, wid = __builtin_amdgcn_readfirstlane(tid >> 6), lane = tid & 63, wr = wid >> 2, wc = wid & 3, fr = lane & 15, fq = lane >> 4;
    const int K = g.K, nt = K / BK;
    unsigned voffA[2], voffB[2];
#pragma unroll
    for (int i = 0; i < 2; ++i) { int R, C; stage_rc(tid * 16 + i * 8192, R, C); const int Rb = Epi::PERM ? ((R & ~31) + perm32(R & 31)) : R;
        voffA[i] = (unsigned)(R * K + C) * 2u; voffB[i] = (unsigned)(Rb * K + C) * 2u; }
    const size_t kstep = (size_t)(BK * 2);
    const size_t hstep = (size_t)HALF * K * 2;
    const size_t tstep = 2 * hstep;
    const unsigned ldsw = (unsigned)wid * 1024u;
    const int aoff = lds_byte(wr * 64 + fr, fq * 8), boff = lds_byte(wc * 32 + fr, fq * 8);
#define PG8_SA(b, h) (((b) * 2 + (h)) * HTB)
#define PG8_SB(b, h) ((4 + (b) * 2 + (h)) * HTB)
#define PG8_STAGE(bufoff, gbase, voff) do { _Pragma("unroll") for (int _i = 0; _i < 2; ++_i) \
        __builtin_amdgcn_global_load_lds((const unsigned*)((const char*)(gbase) + (voff)[_i]), (PG8_LAS unsigned*)(lds + (bufoff) + ldsw + _i * 8192), 16, 0, 0); } while (0)
#define PG8_LDA(dst, b, h) do { _Pragma("unroll") for (int m = 0; m < 4; ++m) _Pragma("unroll") for (int k = 0; k < 2; ++k) dst[m][k] = *(const PG8_LAS bf16x8*)(lds + PG8_SA(b, h) + aoff + m * 2048 + k * 1024); } while (0)
#define PG8_LDB(dst, b, h) do { _Pragma("unroll") for (int n = 0; n < 2; ++n) _Pragma("unroll") for (int k = 0; k < 2; ++k) dst[n][k] = *(const PG8_LAS bf16x8*)(lds + PG8_SB(b, h) + boff + n * 2048 + k * 1024); } while (0)
#define PG8_MMA(ai, bj, At, Bt) do { __builtin_amdgcn_s_setprio(1); _Pragma("unroll") for (int m = 0; m < 4; ++m) _Pragma("unroll") for (int n = 0; n < 2; ++n) _Pragma("unroll") for (int k = 0; k < 2; ++k) \
        acc[ai][bj][m][n] = __builtin_amdgcn_mfma_f32_16x16x32_bf16(Bt[n][k], At[m][k], acc[ai][bj][m][n], 0, 0, 0); __builtin_amdgcn_s_setprio(0); } while (0)
#define PG8_WAIT_V(n) asm volatile("s_waitcnt vmcnt(" #n ")" ::: "memory")
#define PG8_WAIT_L(n) asm volatile("s_waitcnt lgkmcnt(" #n ")" ::: "memory")
#define PG8_BAR __builtin_amdgcn_s_barrier()
#define PG8_SCHED __builtin_amdgcn_sched_barrier(0)
    Unit cur, nxt; int ui = 0;
    if (!S.next(0, cur)) return;
    f32x4 acc[2][2][4][2];
#pragma unroll
    for (int a = 0; a < 2; ++a)
#pragma unroll
        for (int b = 0; b < 2; ++b)
#pragma unroll
            for (int m = 0; m < 4; ++m)
#pragma unroll
                for (int n = 0; n < 2; ++n) acc[a][b][m][n] = (f32x4){0.f, 0.f, 0.f, 0.f};
    bf16x8 At[4][2], B0[2][2], B1[2][2];
    const char* cA = (const char*)g.A + (size_t)cur.pm * tstep; const char* cB = (const char*)g.Bt + (size_t)cur.pn * tstep;
    S.a_ready(cur);
    if constexpr (SP2) {
        PG8_STAGE(PG8_SB(0, 0), cB, voffB); PG8_STAGE(PG8_SB(0, 1), cB + hstep, voffB); PG8_STAGE(PG8_SA(0, 0), cA, voffA); PG8_STAGE(PG8_SA(0, 1), cA + hstep, voffA);
        if (wr == 1) PG8_BAR;
        PG8_WAIT_V(2); PG8_BAR;
        PG8_STAGE(PG8_SB(1, 0), cB + kstep, voffB); PG8_STAGE(PG8_SA(1, 0), cA + kstep, voffA); PG8_STAGE(PG8_SB(1, 1), cB + hstep + kstep, voffB);
        PG8_WAIT_V(6); PG8_BAR;
    } else {
        PG8_STAGE(PG8_SB(0, 0), cB, voffB); PG8_STAGE(PG8_SA(0, 0), cA, voffA); PG8_STAGE(PG8_SB(0, 1), cB + hstep, voffB); PG8_STAGE(PG8_SA(0, 1), cA + hstep, voffA);
        if (wr == 1) PG8_BAR;
        PG8_WAIT_V(4); PG8_BAR;
        PG8_STAGE(PG8_SB(1, 0), cB + kstep, voffB); PG8_STAGE(PG8_SA(1, 0), cA + kstep, voffA); PG8_STAGE(PG8_SB(1, 1), cB + hstep + kstep, voffB);
        PG8_WAIT_V(6); PG8_BAR;
    }
    for (;;) {
        const bool has_next = S.next(ui + 1, nxt);
        const char* nA = has_next ? (const char*)g.A + (size_t)nxt.pm * tstep : cA; const char* nB = has_next ? (const char*)g.Bt + (size_t)nxt.pn * tstep : cB;
        for (int t = 0; t < nt; t += 2) {
            const bool last = (t == nt - 2);
            const char* a1 = cA + (size_t)(t + 1) * kstep;
            const char* a2 = last ? nA : cA + (size_t)(t + 2) * kstep; const char* b2 = last ? nB : cB + (size_t)(t + 2) * kstep;
            const char* a3 = a2 + kstep; const char* b3 = b2 + kstep;
            if (last && has_next) S.a_ready(nxt);
            if constexpr (SP2) {
            PG8_LDB(B0, 0, 0); PG8_LDB(B1, 0, 1); PG8_SCHED; PG8_LDA(At, 0, 0); PG8_STAGE(PG8_SA(1, 1), a1 + hstep, voffA);
            PG8_WAIT_V(8); PG8_WAIT_L(0); PG8_BAR; PG8_MMA(0, 0, At, B0); PG8_MMA(0, 1, At, B1); PG8_BAR; PG8_SCHED;
            PG8_LDA(At, 0, 1); PG8_STAGE(PG8_SB(0, 0), b2, voffB); PG8_STAGE(PG8_SB(0, 1), b2 + hstep, voffB); PG8_STAGE(PG8_SA(0, 0), a2, voffA);
            PG8_WAIT_V(8); PG8_WAIT_L(0); PG8_BAR; PG8_MMA(1, 0, At, B0); PG8_MMA(1, 1, At, B1); PG8_BAR; PG8_SCHED;
            PG8_LDB(B0, 1, 0); PG8_LDB(B1, 1, 1); PG8_SCHED; PG8_LDA(At, 1, 0); PG8_STAGE(PG8_SA(0, 1), a2 + hstep, voffA);
            PG8_WAIT_V(8); PG8_WAIT_L(0); PG8_BAR; PG8_MMA(0, 0, At, B0); PG8_MMA(0, 1, At, B1); PG8_BAR; PG8_SCHED;
            PG8_LDA(At, 1, 1); PG8_STAGE(PG8_SB(1, 0), b3, voffB); PG8_STAGE(PG8_SB(1, 1), b3 + hstep, voffB); PG8_STAGE(PG8_SA(1, 0), a3, voffA);
            PG8_WAIT_V(8); PG8_WAIT_L(0); PG8_BAR; PG8_MMA(1, 0, At, B0); PG8_MMA(1, 1, At, B1); PG8_BAR; PG8_SCHED;
            } else {
            PG8_LDB(B0, 0, 0); PG8_SCHED; PG8_LDA(At, 0, 0); PG8_STAGE(PG8_SA(1, 1), a1 + hstep, voffA);
            PG8_WAIT_L(8); PG8_BAR; PG8_WAIT_L(0); PG8_MMA(0, 0, At, B0); PG8_BAR; PG8_SCHED;
            PG8_LDB(B1, 0, 1); PG8_STAGE(PG8_SB(0, 0), b2, voffB);
            PG8_BAR; PG8_WAIT_L(0); PG8_MMA(0, 1, At, B1); PG8_BAR;
            PG8_LDA(At, 0, 1); PG8_STAGE(PG8_SA(0, 0), a2, voffA);
            PG8_BAR; PG8_WAIT_L(0); PG8_MMA(1, 0, At, B0); PG8_BAR; PG8_SCHED;
            PG8_STAGE(PG8_SB(0, 1), b2 + hstep, voffB);
            PG8_WAIT_V(6); PG8_BAR; PG8_MMA(1, 1, At, B1); PG8_BAR;
            PG8_LDB(B0, 1, 0); PG8_SCHED; PG8_LDA(At, 1, 0); PG8_STAGE(PG8_SA(0, 1), a2 + hstep, voffA);
            PG8_WAIT_L(8); PG8_BAR; PG8_WAIT_L(0); PG8_MMA(0, 0, At, B0); PG8_BAR; PG8_SCHED;
            PG8_LDB(B1, 1, 1); PG8_STAGE(PG8_SB(1, 0), b3, voffB);
            PG8_BAR; PG8_WAIT_L(0); PG8_MMA(0, 1, At, B1); PG8_BAR;
            PG8_LDA(At, 1, 1); PG8_STAGE(PG8_SA(1, 0), a3, voffA);
            PG8_BAR; PG8_WAIT_L(0); PG8_MMA(1, 0, At, B0); PG8_BAR; PG8_SCHED;
            PG8_STAGE(PG8_SB(1, 1), b3 + hstep, voffB);
            PG8_WAIT_V(6); PG8_BAR; PG8_MMA(1, 1, At, B1); PG8_BAR;
            }
        }
        if constexpr (ALIGN_EPI) { if (wr == 0) PG8_BAR; }
        if constexpr (!Epi::AFTER_DRAIN) { E(acc, cur, wr, wc, fr, fq); S.done(cur); }
        if (!has_next) break;
#pragma unroll
        for (int a = 0; a < 2; ++a)
#pragma unroll
            for (int b = 0; b < 2; ++b)
#pragma unroll
                for (int m = 0; m < 4; ++m)
#pragma unroll
                    for (int n = 0; n < 2; ++n) acc[a][b][m][n] = (f32x4){0.f, 0.f, 0.f, 0.f};
        cur = nxt; cA = nA; cB = nB; ++ui;
        if constexpr (ALIGN_EPI) { if (wr == 1) PG8_BAR; }
    }
    PG8_WAIT_V(0);
    if constexpr (!ALIGN_EPI) { if (wr == 0) PG8_BAR; }
    PG8_BAR;
    if constexpr (Epi::AFTER_DRAIN) { E.fused(acc, cur, wr, wc, fr, fq, lds, wid, lane); S.done(cur); }
#undef PG8_SA
#undef PG8_SB
#undef PG8_STAGE
#undef PG8_LDA
#undef PG8_LDB
#undef PG8_MMA
#undef PG8_WAIT_V
#undef PG8_WAIT_L
#undef PG8_BAR
#undef PG8_SCHED
}
}

#ifndef MK_SINGLE
#define MK_SINGLE 1
#endif
constexpr int BATCH = 32, SEQ = 2048, DM = 1024, M = BATCH * SEQ;
constexpr int NIN = 3336, NPROJ = 3328;
constexpr int DFF = 2816, NUP = 2 * DFF;
constexpr int C_Q = 1792, C_K = 2048, C_V = 2304, C_O = 2816;
constexpr int NLORA = 1536, KLORA = 256;
constexpr int MH = M / 2;
constexpr float NORM_EPS = 1e-6f, LNX_EPS = 64e-5f;

constexpr size_t MiB = 1u << 20;
constexpr size_t WS_CTL = 0, CTL_ZERO_BYTES = 1 * MiB;
constexpr size_t WS_WT_IN = 2 * MiB, WS_WT_OUT = 9 * MiB, WS_WT_UP = 11 * MiB, WS_WT_DN = 22 * MiB, WS_WT_LORA = 28 * MiB;
constexpr size_t WS_RS2 = 29 * MiB, WS_SSQP = 30 * MiB, WS_GATES = 34 * MiB;
constexpr size_t WS_XN = 40 * MiB;
constexpr size_t WS_PROJ = 168 * MiB;
constexpr size_t WS_LBUF = 584 * MiB;
constexpr size_t WS_DAG = 616 * MiB;
constexpr size_t WS_MIX = 808 * MiB;
constexpr size_t WS_SIDE = 168 * MiB;
constexpr int SIDE_ELEMS = 256 * 22 * 2 * 128;
constexpr size_t WS_GB = 520 * MiB;
constexpr size_t WS_END = 936 * MiB;

constexpr int LDS_BYTES = 163840;
constexpr int MISC_OFF = LDS_BYTES - 256;

#define GAS __attribute__((address_space(1)))
#define LAS __attribute__((address_space(3)))
typedef unsigned short bf16;
typedef unsigned v4u __attribute__((ext_vector_type(4)));
typedef unsigned v2u __attribute__((ext_vector_type(2)));
typedef float f32x4 __attribute__((ext_vector_type(4)));
typedef float f32x2 __attribute__((ext_vector_type(2)));
typedef short bf16x8 __attribute__((ext_vector_type(8)));
typedef GAS unsigned gu32;

typedef __bf16 bf16x2_t __attribute__((ext_vector_type(2)));
__device__ __forceinline__ unsigned pk2(float lo, float hi) { const f32x2 v = {lo, hi}; const bf16x2_t b = __builtin_convertvector(v, bf16x2_t); return __builtin_bit_cast(unsigned, b); }
__device__ __forceinline__ unsigned f2bf(float f) { return pk2(f, f) & 0xffffu; }
__device__ __forceinline__ float bf2f(unsigned short u) { return __builtin_bit_cast(float, (unsigned)u << 16); }
__device__ __forceinline__ float bflo(unsigned w) { return __builtin_bit_cast(float, w << 16); }
__device__ __forceinline__ float bfhi(unsigned w) { return __builtin_bit_cast(float, w & 0xffff0000u); }
__device__ __forceinline__ void unpack8(const v4u w, float (&o)[8]) { o[0] = bflo(w.x); o[1] = bfhi(w.x); o[2] = bflo(w.y); o[3] = bfhi(w.y); o[4] = bflo(w.z); o[5] = bfhi(w.z); o[6] = bflo(w.w); o[7] = bfhi(w.w); }
__device__ __forceinline__ v4u pack8(const float (&o)[8]) { v4u w; w.x = pk2(o[0], o[1]); w.y = pk2(o[2], o[3]); w.z = pk2(o[4], o[5]); w.w = pk2(o[6], o[7]); return w; }
__device__ __forceinline__ float frcp(float x) { return __builtin_amdgcn_rcpf(x); }
__device__ __forceinline__ float frsq(float x) { return __builtin_amdgcn_rsqf(x); }
__device__ __forceinline__ float fsqrt_(float x) { return __builtin_amdgcn_sqrtf(x); }
__device__ __forceinline__ float fexp(float x) { return __builtin_amdgcn_exp2f(x * 1.4426950408889634f); }
__device__ __forceinline__ float sigmoidf_(float x) { return frcp(1.0f + __builtin_amdgcn_exp2f(x * -1.4426950408889634f)); }
__device__ __forceinline__ float tanhf_(float x) { return 1.0f - 2.0f * frcp(__builtin_amdgcn_exp2f(x * 2.8853900817779268f) + 1.0f); }
__device__ __forceinline__ float softplusf_(float x) { return fmaxf(x, 0.f) + __logf(1.0f + fexp(-fabsf(x))); }
__device__ __forceinline__ float wave_sum(float v) {
#pragma unroll
    for (int o = 1; o < 64; o <<= 1) v += __shfl_xor(v, o);
    return v;
}
template <int CTRL> __device__ __forceinline__ float dppmov(float v) { return __builtin_bit_cast(float, __builtin_amdgcn_update_dpp(0, __builtin_bit_cast(int, v), CTRL, 0xF, 0xF, true)); }
__device__ __forceinline__ float red8(float v) { v += dppmov<0xB1>(v); v += dppmov<0x4E>(v); v += dppmov<0x141>(v); return v; }
__device__ __forceinline__ float red16(float v) { v += dppmov<0xB1>(v); v += dppmov<0x4E>(v); v += dppmov<0x141>(v); v += dppmov<0x140>(v); return v; }

template <int CTRL, int RMASK> __device__ __forceinline__ float dppsh(float idv, float v) { return __builtin_bit_cast(float, __builtin_amdgcn_update_dpp(__builtin_bit_cast(int, idv), __builtin_bit_cast(int, v), CTRL, RMASK, 0xF, false)); }
__device__ __forceinline__ float wave_scan_add(float v) {
    v += dppsh<0x111, 0xF>(0.f, v); v += dppsh<0x112, 0xF>(0.f, v); v += dppsh<0x114, 0xF>(0.f, v); v += dppsh<0x118, 0xF>(0.f, v);
    v += dppsh<0x142, 0xA>(0.f, v); v += dppsh<0x143, 0xC>(0.f, v); return v;
}
__device__ __forceinline__ float wave_scan_max(float v) {
    const float ni = -3.0e38f;
    v = fmaxf(v, dppsh<0x111, 0xF>(ni, v)); v = fmaxf(v, dppsh<0x112, 0xF>(ni, v)); v = fmaxf(v, dppsh<0x114, 0xF>(ni, v)); v = fmaxf(v, dppsh<0x118, 0xF>(ni, v));
    v = fmaxf(v, dppsh<0x142, 0xA>(ni, v)); v = fmaxf(v, dppsh<0x143, 0xC>(ni, v)); return v;
}

#define XB_TMO      128
#define XB_XCNT(j)  (256  + 64 * (j))
#define XB_XSUB(j)  (1280 + 64 * (j))
#define XB_XGEN(j)  (2304 + 64 * (j))
#define XB_TOP      3328
#define XB_TOPGEN   3392
#define XCD_BAR_WORDS 3456
#define XB_SPIN_CAP (1u << 22)
__device__ __forceinline__ unsigned xb_ld(unsigned* p)              { return __hip_atomic_load(p, __ATOMIC_RELAXED, __HIP_MEMORY_SCOPE_AGENT); }
__device__ __forceinline__ unsigned xb_add(unsigned* p, unsigned v) { return __hip_atomic_fetch_add(p, v, __ATOMIC_RELAXED, __HIP_MEMORY_SCOPE_AGENT); }
__device__ __forceinline__ unsigned xb_xcc_id() { return (unsigned)__builtin_amdgcn_s_getreg((3 << 11) | 20) & 0xFu; }
#define XB_SPIN(cond, bar) do { unsigned _sp = 0; while (cond) { __builtin_amdgcn_s_sleep(1); \
    if ((++_sp & 255u) == 0u) { if (xb_ld(&(bar)[XB_TMO])) break; if (_sp > XB_SPIN_CAP) { atomicAdd(&(bar)[XB_TMO], 1u); break; } } } } while (0)
struct XcdBarrier { unsigned* bar; unsigned x; volatile LAS unsigned* st; };
__device__ __forceinline__ XcdBarrier xcd_barrier_post(unsigned* bar, volatile LAS unsigned* st) {
    XcdBarrier b; b.bar = bar; b.x = xb_xcc_id(); b.st = st;
    if (threadIdx.x == 0) (void)xb_add(&bar[XB_XCNT(b.x)], 1u);
    return b;
}
__device__ __forceinline__ void xcd_barrier_complete(unsigned* bar, unsigned x, unsigned& nloc, unsigned& nx) {
    const unsigned G = gridDim.x * gridDim.y * gridDim.z;
    unsigned sum, cnt, mine, sp = 0u;
    for (;;) {
        sum = 0u; cnt = 0u; mine = 0u;
#pragma unroll
        for (unsigned j = 0; j < 16; ++j) { const unsigned c = xb_ld(&bar[XB_XCNT(j)]); sum += c; cnt += (c > 0u) ? 1u : 0u; mine = (j == x) ? c : mine; }
        if (sum == G) break;
        __builtin_amdgcn_s_sleep(1);
        if ((++sp & 255u) == 0u) { if (xb_ld(&bar[XB_TMO])) break; if (sp > XB_SPIN_CAP) { atomicAdd(&bar[XB_TMO], 1u); break; } }
    }
    nloc = mine > 0u ? mine : 1u; nx = cnt > 0u ? cnt : 1u;
}
__device__ __forceinline__ void xcd_barrier(const XcdBarrier& b) {
    asm volatile("s_waitcnt vmcnt(0)" ::: "memory");
    __syncthreads();
    if (threadIdx.x == 0) {
        unsigned* bar = b.bar;
        __builtin_amdgcn_s_waitcnt(0);
        unsigned nloc = b.st[0], nx = b.st[1];
        if (nloc == 0u) { xcd_barrier_complete(bar, b.x, nloc, nx); b.st[0] = nloc; b.st[1] = nx; }
        const unsigned old = xb_add(&bar[XB_XSUB(b.x)], 1u);
        const unsigned gen = old / nloc;
        if (old + 1u == (gen + 1u) * nloc) {
            __builtin_amdgcn_fence(__ATOMIC_RELEASE, "agent");
            asm volatile("s_waitcnt vmcnt(0)" ::: "memory");
            const unsigned og = xb_add(&bar[XB_TOP], 1u);
            const unsigned tg = og / nx;
            if (og + 1u == (tg + 1u) * nx) xb_add(&bar[XB_TOPGEN], 1u);
            else XB_SPIN(xb_ld(&bar[XB_TOPGEN]) == tg, bar);
            __builtin_amdgcn_fence(__ATOMIC_ACQUIRE, "agent");
            xb_add(&bar[XB_XGEN(b.x)], 1u);
            asm volatile("s_waitcnt vmcnt(0)" ::: "memory");
        } else {
            XB_SPIN(xb_ld(&bar[XB_XGEN(b.x)]) == gen, bar);
            __builtin_amdgcn_fence(__ATOMIC_ACQUIRE, "agent");
            asm volatile("s_waitcnt vmcnt(0)" ::: "memory");
        }
    }
    __syncthreads();
}

__device__ __forceinline__ int opaque_i(int v) { asm volatile("" : "+s"(v)); return v; }
#define LDS_BARRIER() do { asm volatile("s_waitcnt lgkmcnt(0)" ::: "memory"); __builtin_amdgcn_s_barrier(); asm volatile("" ::: "memory"); } while (0)
struct Args { const float* in[26]; float* out; unsigned char* ws; int ph_lo, ph_hi; };

namespace pg8 {
struct PanelOrder {
    int c;
    __device__ bool next(int i, Unit& u) const { if (i >= 4) return false; u.pm = c; u.pn = i; return true; }
    __device__ __forceinline__ void a_ready(const Unit&) const {}
    __device__ __forceinline__ void done(const Unit&) const {}
};
struct EpiResid {
    static constexpr bool PERM = true, AFTER_DRAIN = false;
    const float* X; float* X2; bf16_t* XB; float* ssqp;
    __device__ __forceinline__ void operator()(const f32x4 (&acc)[2][2][4][2], const Unit& u, int wr, int wc, int fr, int fq) const {
        int pm_ = u.pm; asm volatile("" : "+s"(pm_));
        const int row0 = pm_ * BM + wr * 64 + fr, col0 = u.pn * BM + wc * 32 + 8 * fq;
#pragma unroll
        for (int ai = 0; ai < 2; ++ai)
#pragma unroll
            for (int m = 0; m < 4; ++m) { const int row = row0 + ai * HALF + m * 16; float ss = 0.f;
#pragma unroll
                for (int bj = 0; bj < 2; ++bj) { const size_t off = (size_t)row * DM + col0 + bj * HALF;
                    const f32x4 x0 = *(const f32x4*)(X + off), x1 = *(const f32x4*)(X + off + 4);
                    const f32x4 v0 = acc[ai][bj][m][0] + x0, v1 = acc[ai][bj][m][1] + x1;
                    *(f32x4*)(X2 + off) = v0; *(f32x4*)(X2 + off + 4) = v1;
                    ss += (v0[0] * v0[0] + v0[1] * v0[1]) + (v0[2] * v0[2] + v0[3] * v0[3]) + (v1[0] * v1[0] + v1[1] * v1[1]) + (v1[2] * v1[2] + v1[3] * v1[3]);
                    if (XB) { u32x4 w; w.x = pk2(v0[0], v0[1]); w.y = pk2(v0[2], v0[3]); w.z = pk2(v1[0], v1[1]); w.w = pk2(v1[2], v1[3]); *(u32x4*)(XB + off) = w; } }
                ss += __shfl_xor(ss, 16); ss += __shfl_xor(ss, 32);
                if (fq == 0) ssqp[(size_t)row * 16 + u.pn * 4 + wc] = ss; }
    }
};
struct EpiScale {
    static constexpr bool PERM = true, AFTER_DRAIN = false;
    bf16_t* O; int ldc; const float* rs; int row_off;
    __device__ __forceinline__ void operator()(const f32x4 (&acc)[2][2][4][2], const Unit& u, int wr, int wc, int fr, int fq) const {
        const int row0 = u.pm * BM + wr * 64 + fr, col0 = u.pn * BM + wc * 32 + 8 * fq;
#pragma unroll
        for (int ai = 0; ai < 2; ++ai)
#pragma unroll
            for (int m = 0; m < 4; ++m) { const int row = row0 + ai * HALF + m * 16; const float s = rs[row_off + row]; bf16_t* rowp = O + (size_t)row * ldc + col0;
#pragma unroll
                for (int bj = 0; bj < 2; ++bj) { const f32x4 v0 = acc[ai][bj][m][0] * s, v1 = acc[ai][bj][m][1] * s;
                    u32x4 w; w.x = pk2(v0[0], v0[1]); w.y = pk2(v0[2], v0[3]); w.z = pk2(v1[0], v1[1]); w.w = pk2(v1[2], v1[3]); *(u32x4*)(rowp + bj * HALF) = w; } }
    }
};
struct EpiFfn {
    static constexpr bool PERM = true, AFTER_DRAIN = false;
    bf16_t* G; const float* rs; const float* cw; const float* cb; float* SA; float* SB; float* SL; LAS float* hal;
    __device__ __forceinline__ void operator()(const f32x4 (&acc)[2][2][4][2], const Unit& u, int wr, int wc, int fr, int fq) const {
        int chl = wc * 32 + 8 * fq; asm volatile("" : "+v"(chl));
        const int f0 = u.pn * 128 + chl, rowt = wr * 64 + fr;
        float rsv[2][4];
#pragma unroll
        for (int ai = 0; ai < 2; ++ai)
#pragma unroll
            for (int m = 0; m < 4; ++m) rsv[ai][m] = rs[u.pm * BM + ai * HALF + m * 16 + rowt];
        const size_t sbase = ((size_t)(u.pm * 22 + u.pn) * 2) * 128 + chl;
        if (fr >= 14) {
#pragma unroll
            for (int ai = 0; ai < 2; ++ai) { const float r_ = rsv[ai][3]; const f32x4 v0 = acc[ai][0][3][0] * r_, v1 = acc[ai][0][3][1] * r_;
                LAS float* hp = hal + ((ai * 2 + wr) * 2 + (fr - 14)) * 128 + chl; *(LAS f32x4*)hp = v0; *(LAS f32x4*)(hp + 4) = v1;
                if (ai == 1 && wr == 1) { float* gp = SL + sbase + (fr - 14) * 128; *(f32x4*)gp = v0; *(f32x4*)(gp + 4) = v1; } }
        }
        if (wr == 0 && fr < 2) { const float r_ = rsv[0][0]; float* ga = SA + sbase + fr * 128; float* gb = SB + sbase + fr * 128;
            *(f32x4*)ga = acc[0][0][0][0] * r_; *(f32x4*)(ga + 4) = acc[0][0][0][1] * r_; *(f32x4*)gb = acc[0][1][0][0] * r_; *(f32x4*)(gb + 4) = acc[0][1][0][1] * r_; }
        asm volatile("s_waitcnt lgkmcnt(0)" ::: "memory"); __builtin_amdgcn_s_barrier(); asm volatile("" ::: "memory");
        float w0[8], w1[8], w2[8], bz[8];
        { const f32x4 a0 = *(const f32x4*)(cw + f0), a1 = *(const f32x4*)(cw + f0 + 4), b0 = *(const f32x4*)(cw + DFF + f0), b1 = *(const f32x4*)(cw + DFF + f0 + 4);
          const f32x4 c0 = *(const f32x4*)(cw + 2 * DFF + f0), c1 = *(const f32x4*)(cw + 2 * DFF + f0 + 4), d0 = *(const f32x4*)(cb + f0), d1 = *(const f32x4*)(cb + f0 + 4);
#pragma unroll
          for (int j = 0; j < 4; ++j) { w0[j] = a0[j]; w0[4 + j] = a1[j]; w1[j] = b0[j]; w1[4 + j] = b1[j]; w2[j] = c0[j]; w2[4 + j] = c1[j]; bz[j] = d0[j]; bz[4 + j] = d1[j]; } }
        const bool fr0 = (fr == 0), frl2 = (fr < 2);
#pragma unroll
        for (int ai = 0; ai < 2; ++ai) {
            float ap[8];
            const int pb = ai * 2 + wr - 1;
#pragma unroll
            for (int m = 0; m < 4; ++m) {
                float av[8], bv[8], y1[8], y2[8];
                const float r_ = rsv[ai][m];
#pragma unroll
                for (int j = 0; j < 4; ++j) { av[j] = acc[ai][0][m][0][j] * r_; av[4 + j] = acc[ai][0][m][1][j] * r_; bv[j] = acc[ai][1][m][0][j] * r_; bv[4 + j] = acc[ai][1][m][1][j] * r_; }
                if (m == 0) {
                    if (pb >= 0) { const LAS float* h0 = hal + (pb * 2) * 128 + chl; const f32x4 h00 = *(const LAS f32x4*)h0, h01 = *(const LAS f32x4*)(h0 + 4), h10 = *(const LAS f32x4*)(h0 + 128), h11 = *(const LAS f32x4*)(h0 + 132);
#pragma unroll
                        for (int j = 0; j < 4; ++j) { y1[j] = h10[j]; y1[4 + j] = h11[j]; y2[j] = fr0 ? h00[j] : h10[j]; y2[4 + j] = fr0 ? h01[j] : h11[j]; } }
                    else {
#pragma unroll
                        for (int j = 0; j < 8; ++j) { y1[j] = 0.f; y2[j] = 0.f; } }
                } else {
#pragma unroll
                    for (int j = 0; j < 8; ++j) { y1[j] = dppmov<0x121>(ap[j]); y2[j] = dppmov<0x122>(ap[j]); }
                }
                float o[8];
#pragma unroll
                for (int j = 0; j < 8; ++j) { const float x1 = dppmov<0x121>(av[j]), x2 = dppmov<0x122>(av[j]);
                    const float am1 = fr0 ? y1[j] : x1, am2 = frl2 ? y2[j] : x2;
                    const float z = bz[j] + w0[j] * am2 + w1[j] * am1 + w2[j] * av[j];
                    o[j] = z * sigmoidf_(z) * bv[j]; ap[j] = av[j]; }
                if (!(ai == 0 && m == 0 && wr == 0 && frl2)) *(u32x4*)(G + (size_t)(u.pm * BM + ai * HALF + m * 16 + rowt) * DFF + f0) = pack8(o);
            }
        }
    }
};
}

template <bool FFN_UP = false>
__device__ __forceinline__ void transpose_item(const float* W, int ldw, int K, bf16* WT, const float* kscale, LAS float* scr, int item, int nblk, int lane) {
    const int kb = item / nblk, nb = item % nblk, k0 = 64 * kb, n0 = 32 * nb;
    const int d0 = !FFN_UP ? n0 : (n0 < DFF ? ((n0 >> 7) * 256 + (n0 & 127)) : ((((n0 - DFF) >> 7) * 256) + 128 + ((n0 - DFF) & 127)));
#pragma unroll 8
    for (int i = 0; i < 32; ++i) { const int kk = 2 * i + (lane >> 5); const float s = kscale ? kscale[k0 + kk] : 1.0f; scr[kk * 33 + (lane & 31)] = W[(size_t)(k0 + kk) * ldw + n0 + (lane & 31)] * s; }
    asm volatile("s_waitcnt lgkmcnt(0)" ::: "memory");
    const int c = lane & 7;
#pragma unroll
    for (int j = 0; j < 4; ++j) { const int n = (lane >> 3) + 8 * j; const LAS float* s = scr + (8 * c) * 33 + n;
        v4u o; o.x = pk2(s[0 * 33], s[1 * 33]); o.y = pk2(s[2 * 33], s[3 * 33]); o.z = pk2(s[4 * 33], s[5 * 33]); o.w = pk2(s[6 * 33], s[7 * 33]);
        *(v4u*)(WT + (size_t)(d0 + n) * K + k0 + 8 * c) = o; }
    asm volatile("s_waitcnt lgkmcnt(0)" ::: "memory");
}

__device__ __forceinline__ void phase_prep(const Args& a, LAS unsigned char* lds, int tid, int lane, int wave) {
    unsigned char* ws = a.ws;
    LAS float* scr = (LAS float*)(lds + wave * 16384);
    const int gw = blockIdx.x * 8 + wave, NGW = gridDim.x * 8;
    constexpr int I_IN = 16 * 104, I_OUT = 16 * 32, I_UP = 16 * 176, I_DN = 44 * 32;
    for (int it = gw; it < I_IN + I_OUT + I_UP + I_DN; it += NGW) {
        int r = it;
        if (r < I_IN) { transpose_item(a.in[2], NIN, DM, (bf16*)(ws + WS_WT_IN), a.in[1], scr, r, 104, lane); continue; } r -= I_IN;
        if (r < I_OUT) { transpose_item(a.in[19], DM, DM, (bf16*)(ws + WS_WT_OUT), nullptr, scr, r, 32, lane); continue; } r -= I_OUT;
        if (r < I_UP) { transpose_item<true>(a.in[21], NUP, DM, (bf16*)(ws + WS_WT_UP), a.in[20], scr, r, 176, lane); continue; } r -= I_UP;
        transpose_item(a.in[24], DM, DFF, (bf16*)(ws + WS_WT_DN), nullptr, scr, r, 32, lane);
    }
    {
        const float* wd = a.in[5]; const float* wa = a.in[7]; const float* wg = a.in[8]; bf16* WL = (bf16*)(ws + WS_WT_LORA);
        for (int idx = blockIdx.x * 512 + tid; idx < NLORA * KLORA; idx += gridDim.x * 512) {
            const int n = idx >> 8, k = idx & 255; float v = 0.f;
            if (n < 512) { if (k < 64) v = wd[k * 512 + n]; }
            else if (n < 1024) { if (k >= 64 && k < 128) v = wa[(k - 64) * 512 + (n - 512)]; }
            else { if (k >= 128) v = wg[(k - 128) * 512 + (n - 1024)]; }
            WL[idx] = (bf16)f2bf(v);
        }
    }
    {
        const float* x = a.in[0]; const float* g1 = a.in[1]; const float* w_in = a.in[2];
        bf16* XN = (bf16*)(ws + WS_XN); float* gates = (float*)(ws + WS_GATES);
        float wgt[16][8];
#pragma unroll
        for (int j = 0; j < 4; ++j)
#pragma unroll
            for (int e = 0; e < 4; ++e) { const int k = 4 * lane + 256 * j + e; const float g = g1[k];
                const f32x4 w0 = *(const f32x4*)(w_in + (size_t)k * NIN + 3328), w1 = *(const f32x4*)(w_in + (size_t)k * NIN + 3332);
                wgt[j * 4 + e][0] = w0[0] * g; wgt[j * 4 + e][1] = w0[1] * g; wgt[j * 4 + e][2] = w0[2] * g; wgt[j * 4 + e][3] = w0[3] * g;
                wgt[j * 4 + e][4] = w1[0] * g; wgt[j * 4 + e][5] = w1[1] * g; wgt[j * 4 + e][6] = w1[2] * g; wgt[j * 4 + e][7] = w1[3] * g; }
        for (int row = gw; row < M; row += NGW) {
            const f32x4* xr = (const f32x4*)(x + (size_t)row * DM) + lane;
            f32x4 v[4]; float ss = 0.f;
#pragma unroll
            for (int j = 0; j < 4; ++j) { v[j] = xr[64 * j]; ss += (v[j][0] * v[j][0] + v[j][1] * v[j][1]) + (v[j][2] * v[j][2] + v[j][3] * v[j][3]); }
            ss = wave_sum(ss);
            const float rs = frsq(ss * (1.0f / DM) + NORM_EPS);
            unsigned long long* o8 = (unsigned long long*)(XN + (size_t)row * DM) + lane;
#pragma unroll
            for (int j = 0; j < 4; ++j) o8[64 * j] = (unsigned long long)pk2(v[j][0] * rs, v[j][1] * rs) | ((unsigned long long)pk2(v[j][2] * rs, v[j][3] * rs) << 32);
            float gs[8];
#pragma unroll
            for (int jg = 0; jg < 8; ++jg) { float s = 0.f;
#pragma unroll
                for (int j = 0; j < 4; ++j)
#pragma unroll
                    for (int e = 0; e < 4; ++e) s += v[j][e] * wgt[j * 4 + e][jg];
                gs[jg] = wave_sum(s); }
            if (lane < 8) { float s = gs[0];
#pragma unroll
                for (int jg = 1; jg < 8; ++jg) s = (lane == jg) ? gs[jg] : s;
                gates[(size_t)row * 8 + lane] = s * rs; }
        }
    }
}

__device__ __forceinline__ void phase_lmat(const Args& a, int tid) {
    unsigned char* ws = a.ws; const bf16* PROJ = (const bf16*)(ws + WS_PROJ); bf16* L = (bf16*)(ws + WS_LBUF); const float* mu = a.in[3];
    const int NT = gridDim.x * 512;
    for (int it = blockIdx.x * 512 + tid; it < M * 32; it += NT) {
        const int row = it >> 5, grp = it & 31, c0 = 1536 + 8 * grp;
        const v4u cur = *(const v4u*)(PROJ + (size_t)row * NPROJ + c0);
        v4u prv = {0u, 0u, 0u, 0u}; if ((row & (SEQ - 1)) != 0) prv = *(const v4u*)(PROJ + (size_t)(row - 1) * NPROJ + c0);
        const f32x4 m0 = *(const f32x4*)(mu + c0), m1 = *(const f32x4*)(mu + c0 + 4);
        float c[8], p[8], o[8]; unpack8(cur, c); unpack8(prv, p);
#pragma unroll
        for (int e = 0; e < 8; ++e) { const float mm = e < 4 ? m0[e & 3] : m1[e & 3]; const float xv = c[e] + (p[e] - c[e]) * mm;
            o[e] = grp < 8 ? tanhf_(xv) : (grp < 16 ? xv : sigmoidf_(xv)); }
        *(v4u*)(L + (size_t)row * KLORA + 8 * grp) = pack8(o);
    }
}

constexpr int RK_LD = 72, RK_SLOT = 64 * RK_LD;
__device__ __forceinline__ f32x4 mfma16(const bf16x8 a, const bf16x8 b, const f32x4 c) { return __builtin_amdgcn_mfma_f32_16x16x32_bf16(a, b, c, 0, 0, 0); }
__device__ __forceinline__ void rk_frag(bf16x8 (&f)[2], const LAS bf16* base, int row0, int l15, int l4) { const LAS bf16* p = base + (row0 + l15) * RK_LD + 8 * l4; f[0] = *(const LAS bf16x8*)p; f[1] = *(const LAS bf16x8*)(p + 32); }
template <bool ACC> __device__ __forceinline__ void rk_prod(f32x4 (&acc)[2], const LAS bf16* Aop, const LAS bf16* Bop, int mb, int nb0, int l15, int l4) {
    bf16x8 a[2]; rk_frag(a, Aop, 16 * mb, l15, l4);
#pragma unroll
    for (int q = 0; q < 2; ++q) { bf16x8 b[2]; rk_frag(b, Bop, 16 * (nb0 + q), l15, l4); f32x4 c = ACC ? acc[q] : (f32x4){0.f, 0.f, 0.f, 0.f}; c = mfma16(a[0], b[0], c); acc[q] = mfma16(a[1], b[1], c); }
}
__device__ __forceinline__ void rk_store(LAS bf16* dst, const f32x4 (&acc)[2], int mb, int nb0, int l15, int l4) {
#pragma unroll
    for (int q = 0; q < 2; ++q) { v2u w; w.x = pk2(acc[q][0], acc[q][1]); w.y = pk2(acc[q][2], acc[q][3]); *(LAS v2u*)(dst + (16 * (nb0 + q) + l15) * RK_LD + 16 * mb + 4 * l4) = w; }
}
__device__ __forceinline__ void rwkv_unit(const Args& a, LAS unsigned char* lds, int unit, int tid, int lane, int wave) {
    unsigned char* ws = a.ws; const bf16* PROJ = (const bf16*)(ws + WS_PROJ); const bf16* DAG = (const bf16*)(ws + WS_DAG); bf16* MIX = (bf16*)(ws + WS_MIX);
    const int b = unit >> 3, h = unit & 7;
    LAS bf16* slot = (LAS bf16*)lds;
#define RK_S(k) (slot + (k) * RK_SLOT)
    LAS bf16* Ab = RK_S(0); LAS bf16* Ut = RK_S(0); LAS bf16* Bb = RK_S(1); LAS bf16* Kb = RK_S(2); LAS bf16* Rb = RK_S(3); LAS bf16* KhT = RK_S(4); LAS float* Yl = (LAS float*)RK_S(3);
    LAS bf16* BhT = RK_S(5); LAS bf16* Vt = RK_S(6); LAS bf16* P0 = RK_S(7); LAS bf16* P0T = RK_S(8); LAS bf16* Aak = RK_S(9); LAS bf16* Arb = RK_S(10); LAS bf16* Ark = RK_S(11);
    LAS bf16* TA = RK_S(12); LAS bf16* TB = RK_S(13); LAS bf16* Xt = RK_S(14); LAS bf16* Sb = RK_S(15);
    LAS float* g63 = (LAS float*)RK_S(16); LAS float* bon = g63 + 64; LAS float* ssP = bon + 64; LAS float* bnP = ssP + 512; LAS float* cst = bnP + 512;
    const int l15 = lane & 15, l4 = lane >> 4, mb = wave & 3, nb0 = 2 * (wave >> 2);
    const int tt = tid >> 3, c8 = tid & 7;
    const int jw = 8 * wave;
    for (int i = tid; i < 640; i += 512) { const int k = i >> 6, c_ = i & 63, j = h * 64 + c_;
        const float* src = k == 0 ? a.in[3] + j : k == 1 ? a.in[3] + 512 + j : k == 2 ? a.in[3] + 1024 + j : k == 3 ? a.in[9] + j : k == 4 ? a.in[10] + j : k == 5 ? a.in[11] + j : k == 6 ? a.in[4] + j : k == 7 ? a.in[6] + j : k == 8 ? a.in[12] + j : a.in[13] + j;
        cst[i] = *src; }
    for (int i = tid; i < RK_SLOT / 2; i += 512) ((LAS unsigned*)Sb)[i] = 0u;
    f32x4 sacc[2], tacc[2], yacc[2];
    sacc[0] = (f32x4){0.f, 0.f, 0.f, 0.f}; sacc[1] = sacc[0];
    v4u g_rc, g_kc, g_vc, g_rp, g_kp, g_vp, g_ld, g_a, g_g;
#define RK_LOADCHUNK(c_) do { const int t_ = b * SEQ + (c_) * 64 + lane; const bf16* pr_ = PROJ + (size_t)t_ * NPROJ + h * 64 + jw; \
        g_rc = *(const v4u*)pr_; g_kc = *(const v4u*)(pr_ + 512); g_vc = *(const v4u*)(pr_ + 1024); \
        if ((c_) == 0 && lane == 0) { g_rp = (v4u){0u, 0u, 0u, 0u}; g_kp = g_rp; g_vp = g_rp; } \
        else { g_rp = *(const v4u*)(pr_ - NPROJ); g_kp = *(const v4u*)(pr_ - NPROJ + 512); g_vp = *(const v4u*)(pr_ - NPROJ + 1024); } \
        const bf16* dg_ = DAG + (size_t)t_ * NLORA + h * 64 + jw; g_ld = *(const v4u*)dg_; g_a = *(const v4u*)(dg_ + 512); \
        g_g = *(const v4u*)(DAG + (size_t)(b * SEQ + (c_) * 64 + tt) * NLORA + 1024 + h * 64 + 8 * c8); } while (0)
    RK_LOADCHUNK(0);
    LDS_BARRIER();
    for (int c = 0; c < SEQ / 64; ++c) {
        const int t0 = b * SEQ + c * 64;
        float rr[8], km[8], vv[8], av[8], lgw[8], kkr[8];
        {
            float rc[8], kc[8], vc[8], rp_[8], kp[8], vp[8], ldv[8];
            unpack8(g_rc, rc); unpack8(g_kc, kc); unpack8(g_vc, vc); unpack8(g_rp, rp_); unpack8(g_kp, kp); unpack8(g_vp, vp); unpack8(g_ld, ldv); unpack8(g_a, av);
            float ss = 0.f, bonus = 0.f;
#pragma unroll
            for (int e = 0; e < 8; ++e) { const int j = jw + e;
                rr[e] = rc[e] + (rp_[e] - rc[e]) * cst[j]; const float k = kc[e] + (kp[e] - kc[e]) * cst[64 + j]; vv[e] = vc[e] + (vp[e] - vc[e]) * cst[128 + j];
                kkr[e] = k * cst[192 + j]; ss += kkr[e] * kkr[e];
                av[e] = sigmoidf_(cst[448 + j] + av[e]);
                lgw[e] = -0.6065306597f * sigmoidf_(cst[384 + j] + ldv[e]);
                km[e] = k * (1.0f + (av[e] - 1.0f) * cst[256 + j]);
                bonus += rr[e] * km[e] * cst[320 + j]; }
            ssP[lane * 8 + wave] = ss; bnP[lane * 8 + wave] = bonus;
        }
        const v4u gcur = g_g;
        LDS_BARRIER();
        {
            const f32x4 s0 = *(const LAS f32x4*)(ssP + lane * 8), s1 = *(const LAS f32x4*)(ssP + lane * 8 + 4), b0 = *(const LAS f32x4*)(bnP + lane * 8), b1 = *(const LAS f32x4*)(bnP + lane * 8 + 4);
            const float ss = ((s0[0] + s0[1]) + (s0[2] + s0[3])) + ((s1[0] + s1[1]) + (s1[2] + s1[3]));
            if (wave == 0) bon[lane] = ((b0[0] + b0[1]) + (b0[2] + b0[3])) + ((b1[0] + b1[1]) + (b1[2] + b1[3]));
            const float inv = frcp(fmaxf(fsqrt_(ss), 1e-12f));
            float oA[8], oB[8], oK[8], oR[8], oBh[8], oKh[8];
#pragma unroll
            for (int e = 0; e < 8; ++e) { const float lw = wave_scan_add(lgw[e]); const float l63 = __builtin_bit_cast(float, __builtin_amdgcn_readlane(__builtin_bit_cast(int, lw), 63));
                const float eP = fexp(lw - lgw[e]), eM = fexp(-lw), eL = fexp(lw), eH = fexp(l63 - lw);
                const float kk = kkr[e] * inv, bb = kk * av[e];
                oA[e] = -kk * eP; oB[e] = bb * eM; oK[e] = km[e] * eM; oR[e] = rr[e] * eL; oBh[e] = bb * eH; oKh[e] = km[e] * eH;
                if (lane == 63) g63[jw + e] = fexp(l63); }
            *(LAS v4u*)(Ab + lane * RK_LD + jw) = pack8(oA); *(LAS v4u*)(Bb + lane * RK_LD + jw) = pack8(oB); *(LAS v4u*)(Kb + lane * RK_LD + jw) = pack8(oK); *(LAS v4u*)(Rb + lane * RK_LD + jw) = pack8(oR);
#pragma unroll
            for (int e = 0; e < 8; ++e) { BhT[(jw + e) * RK_LD + lane] = (bf16)f2bf(oBh[e]); KhT[(jw + e) * RK_LD + lane] = (bf16)f2bf(oKh[e]); Vt[(jw + e) * RK_LD + lane] = (bf16)f2bf(vv[e]); }
            if (c + 1 < SEQ / 64) RK_LOADCHUNK(c + 1);
        }
        LDS_BARRIER();
        {
            f32x4 d[2];
            rk_prod<false>(d, Bb, Ab, mb, nb0, l15, l4);
#pragma unroll
            for (int q = 0; q < 2; ++q)
#pragma unroll
                for (int r = 0; r < 4; ++r) { const int s_ = 16 * mb + 4 * l4 + r, t_ = 16 * (nb0 + q) + l15; d[q][r] = s_ < t_ ? d[q][r] : 0.f; tacc[q][r] = d[q][r] + (s_ == t_ ? 1.f : 0.f); }
            rk_store(P0, d, mb, nb0, l15, l4); rk_store(TA, tacc, mb, nb0, l15, l4);
            rk_prod<false>(d, Ab, Bb, mb, nb0, l15, l4);
#pragma unroll
            for (int q = 0; q < 2; ++q)
#pragma unroll
                for (int r = 0; r < 4; ++r) { const int t_ = 16 * mb + 4 * l4 + r, s_ = 16 * (nb0 + q) + l15; d[q][r] = s_ < t_ ? d[q][r] : 0.f; }
            rk_store(P0T, d, mb, nb0, l15, l4);
            rk_prod<false>(d, Kb, Ab, mb, nb0, l15, l4);
#pragma unroll
            for (int q = 0; q < 2; ++q)
#pragma unroll
                for (int r = 0; r < 4; ++r) { const int s_ = 16 * mb + 4 * l4 + r, t_ = 16 * (nb0 + q) + l15; d[q][r] = s_ < t_ ? d[q][r] : 0.f; }
            rk_store(Aak, d, mb, nb0, l15, l4);
            rk_prod<false>(d, Bb, Rb, mb, nb0, l15, l4);
#pragma unroll
            for (int q = 0; q < 2; ++q)
#pragma unroll
                for (int r = 0; r < 4; ++r) { const int s_ = 16 * mb + 4 * l4 + r, t_ = 16 * (nb0 + q) + l15; d[q][r] = s_ <= t_ ? d[q][r] : 0.f; }
            rk_store(Arb, d, mb, nb0, l15, l4);
            rk_prod<false>(d, Kb, Rb, mb, nb0, l15, l4);
#pragma unroll
            for (int q = 0; q < 2; ++q)
#pragma unroll
                for (int r = 0; r < 4; ++r) { const int s_ = 16 * mb + 4 * l4 + r, t_ = 16 * (nb0 + q) + l15; d[q][r] = s_ <= t_ ? d[q][r] : 0.f; }
            rk_store(Ark, d, mb, nb0, l15, l4);
        }
        LDS_BARRIER();
        {
            f32x4 d[2];
            rk_prod<false>(d, P0T, P0, mb, nb0, l15, l4); rk_store(Bb  , d, mb, nb0, l15, l4);
            rk_prod<false>(d, P0, P0T, mb, nb0, l15, l4); rk_store(Kb  , d, mb, nb0, l15, l4);
            rk_prod<false>(d, Ab, Sb, mb, nb0, l15, l4); rk_prod<true>(d, Aak, Vt, mb, nb0, l15, l4); rk_store(Xt, d, mb, nb0, l15, l4);
            rk_prod<false>(yacc, Sb, Rb, mb, nb0, l15, l4); rk_prod<true>(yacc, Vt, Ark, mb, nb0, l15, l4);
#pragma unroll
            for (int r = 0; r < 4; ++r) { const float g_ = g63[16 * mb + 4 * l4 + r]; sacc[0][r] *= g_; sacc[1][r] *= g_; }
            rk_prod<true>(sacc, KhT, Vt, mb, nb0, l15, l4);
        }
        LDS_BARRIER();
        { rk_prod<true>(tacc, Kb, TA, mb, nb0, l15, l4); rk_store(TB, tacc, mb, nb0, l15, l4);
          f32x4 d[2]; rk_prod<false>(d, Kb, Bb, mb, nb0, l15, l4); rk_store(P0, d, mb, nb0, l15, l4); rk_prod<false>(d, Bb, Kb, mb, nb0, l15, l4); rk_store(P0T, d, mb, nb0, l15, l4); }
        LDS_BARRIER();
        { rk_prod<true>(tacc, P0T, TB, mb, nb0, l15, l4); rk_store(TA, tacc, mb, nb0, l15, l4);
          f32x4 d[2]; rk_prod<false>(d, P0T, P0, mb, nb0, l15, l4); rk_store(Bb, d, mb, nb0, l15, l4); rk_prod<false>(d, P0, P0T, mb, nb0, l15, l4); rk_store(Kb, d, mb, nb0, l15, l4); }
        LDS_BARRIER();
        { rk_prod<true>(tacc, Kb, TA, mb, nb0, l15, l4); rk_store(TB, tacc, mb, nb0, l15, l4);
          f32x4 d[2]; rk_prod<false>(d, Kb, Bb, mb, nb0, l15, l4); rk_store(P0, d, mb, nb0, l15, l4); rk_prod<false>(d, Bb, Kb, mb, nb0, l15, l4); rk_store(P0T, d, mb, nb0, l15, l4); }
        LDS_BARRIER();
        { rk_prod<true>(tacc, P0T, TB, mb, nb0, l15, l4); rk_store(TA, tacc, mb, nb0, l15, l4);
          f32x4 d[2]; rk_prod<false>(d, P0, P0T, mb, nb0, l15, l4); rk_store(Kb  , d, mb, nb0, l15, l4); }
        LDS_BARRIER();
        { rk_prod<true>(tacc, Kb, TA, mb, nb0, l15, l4); rk_store(TB, tacc, mb, nb0, l15, l4); }
        LDS_BARRIER();
        { f32x4 d[2]; rk_prod<false>(d, TB, Xt, mb, nb0, l15, l4); rk_store(Ut, d, mb, nb0, l15, l4); }
        LDS_BARRIER();
        {
            rk_prod<true>(yacc, Ut, Arb, mb, nb0, l15, l4);
#pragma unroll
            for (int q = 0; q < 2; ++q) *(LAS f32x4*)(Yl + (16 * (nb0 + q) + l15) * 68 + 16 * mb + 4 * l4) = yacc[q];
            rk_prod<true>(sacc, BhT, Ut, mb, nb0, l15, l4); rk_store(Sb, sacc, mb, nb0, l15, l4);
        }
        LDS_BARRIER();
        {
            const int t = t0 + tt, j0 = 8 * c8;
            const f32x4 y0 = *(const LAS f32x4*)(Yl + tt * 68 + j0), y1 = *(const LAS f32x4*)(Yl + tt * 68 + j0 + 4);
            float y[8] = {y0[0], y0[1], y0[2], y0[3], y1[0], y1[1], y1[2], y1[3]}, gv[8]; float s1 = 0.f;
#pragma unroll
            for (int e = 0; e < 8; ++e) s1 += y[e];
            s1 = red8(s1); const float mean = s1 * (1.0f / 64.0f); float s2 = 0.f;
#pragma unroll
            for (int e = 0; e < 8; ++e) { const float dd = y[e] - mean; s2 += dd * dd; }
            s2 = red8(s2); const float rstd = frsq(s2 * (1.0f / 64.0f) + LNX_EPS);
            unpack8(gcur, gv);
            const float bonus = bon[tt]; float ov[8];
#pragma unroll
            for (int e = 0; e < 8; ++e) { const float yn = (y[e] - mean) * rstd * cst[512 + j0 + e] + cst[576 + j0 + e]; ov[e] = (yn + bonus * bf2f(Vt[(j0 + e) * RK_LD + tt])) * gv[e]; }
            *(v4u*)(MIX + (size_t)t * DM + h * 64 + j0) = pack8(ov);
        }
        LDS_BARRIER();
    }
#undef RK_S
#undef RK_LOADCHUNK
}

__device__ __forceinline__ void mlstm_unit(const Args& a, LAS unsigned char* lds, int unit, int tid, int lane, int wave) {
    unsigned char* ws = a.ws; const bf16* PROJ = (const bf16*)(ws + WS_PROJ); const float* gates = (const float*)(ws + WS_GATES); bf16* MIX = (bf16*)(ws + WS_MIX);
    const float* cw = a.in[14]; const float* cbias = a.in[15]; const float* i_bias = a.in[16]; const float* f_bias = a.in[17]; const float* mhg = a.in[18];
    const int b = unit >> 2, hm = unit & 3;
    constexpr int LD = 72;
    LAS bf16* Ql = (LAS bf16*)lds; LAS bf16* Kl = Ql + 64 * LD; LAS bf16* Kwt = Kl + 64 * LD; LAS bf16* Vt = Kwt + 64 * LD; LAS bf16* Sm = Vt + 128 * LD; LAS bf16* Ct = Sm + 64 * LD;
    LAS float* Hl = (LAS float*)(Ct + 128 * LD);
    LAS float* e_s = Hl + 64 * 132; LAS float* Mx = e_s + 64; LAS float* sc = Mx + 64; LAS float* em = sc + 64; LAS float* wsv = em + 64; LAS float* den = wsv + 64; LAS float* nvec = den + 64; LAS float* scal = nvec + 64;
    for (int i = tid; i < 128 * LD / 2; i += 512) ((LAS unsigned*)Ct)[i] = 0u;
    if (tid < 64) nvec[tid] = 0.f;
    if (tid == 0) { scal[0] = 1.f; scal[1] = 0.f; }
    f32x4 cacc[4];
#pragma unroll
    for (int i = 0; i < 4; ++i) cacc[i] = (f32x4){0.f, 0.f, 0.f, 0.f};
    const int l15 = lane & 15, l4 = lane >> 4;
    const int tt = tid >> 3, p8 = tid & 7;
    LAS float* cwl = scal + 16; LAS float* cbl = cwl + 512;
    for (int i = tid; i < 640; i += 512) { const int j = i >> 7, c_ = i & 127; const int src = (c_ < 64) ? (hm * 64 + c_) : (256 + hm * 64 + (c_ - 64)); if (j < 4) cwl[i] = cw[j * 512 + src]; else cbl[c_] = cbias[src]; }
    const float ibias = i_bias[hm], fbias = f_bias[hm];
    v4u n_q[4], n_k[4], n_va, n_vb, n_oa, n_ob; float n_gi = 0.f, n_gf = 0.f;
#define ML_LOADCHUNK(c_) do { const int t_ = b * SEQ + (c_) * 64 + lane; const int tp_ = (c_) * 64 + lane; \
        _Pragma("unroll") for (int j = 0; j < 4; ++j) { if (tp_ - 3 + j >= 0) { const bf16* pr_ = PROJ + (size_t)(t_ - 3 + j) * NPROJ + hm * 64 + 8 * wave; n_q[j] = *(const v4u*)(pr_ + C_Q); n_k[j] = *(const v4u*)(pr_ + C_K); } \
                                                       else { n_q[j] = (v4u){0u, 0u, 0u, 0u}; n_k[j] = (v4u){0u, 0u, 0u, 0u}; } } \
        { const bf16* pv_ = PROJ + (size_t)t_ * NPROJ + C_V + hm * 128 + 16 * wave; n_va = *(const v4u*)pv_; n_vb = *(const v4u*)(pv_ + 8); \
          const bf16* po_ = PROJ + (size_t)(b * SEQ + (c_) * 64 + tt) * NPROJ + C_O + hm * 128 + 16 * p8; n_oa = *(const v4u*)po_; n_ob = *(const v4u*)(po_ + 8); } \
        if (wave == 0) { n_gi = gates[(size_t)t_ * 8 + hm]; n_gf = gates[(size_t)t_ * 8 + 4 + hm]; } } while (0)
    ML_LOADCHUNK(0);
    LDS_BARRIER();
    for (int c = 0; c < SEQ / 64; ++c) {
        const int t0 = b * SEQ + c * 64;
        if (wave == 0) {
            const float gi = n_gi + ibias, gf = n_gf + fbias;
            const float ig = 15.0f * tanhf_(gi * (1.0f / 15.0f)), fx = 15.0f * tanhf_(gf * (1.0f / 15.0f));
            const float logf = -(fmaxf(-fx, 0.f) + __logf(1.0f + fexp(-fabsf(fx))));
            const float bc = wave_scan_add(logf);
            const float e = ig - bc; const float P = wave_scan_max(e);
            const float m = scal[1];
            const float mx = fmaxf(P, m); const float mxL = __shfl(mx, 63), bL = __shfl(bc, 63);
            e_s[lane] = e; Mx[lane] = mx; sc[lane] = fexp(m - mx); em[lane] = fexp(-(bc + mx)); wsv[lane] = fexp(e - mxL);
            if (lane == 0) { scal[0] = fexp(m - mxL); scal[1] = bL + mxL; }
        }
        LDS_BARRIER();
        v4u c_oa, c_ob;
        {
            const int d0 = 8 * wave;
            float aq[8], ak[8];
#pragma unroll
            for (int e = 0; e < 8; ++e) { aq[e] = cbl[d0 + e]; ak[e] = cbl[64 + d0 + e]; }
#pragma unroll
            for (int j = 0; j < 4; ++j) { float pq[8], pk[8]; unpack8(n_q[j], pq); unpack8(n_k[j], pk);
#pragma unroll
                for (int e = 0; e < 8; ++e) { aq[e] += cwl[j * 128 + d0 + e] * pq[e]; ak[e] += cwl[j * 128 + 64 + d0 + e] * pk[e]; } }
            const float w = wsv[lane];
#pragma unroll
            for (int e = 0; e < 8; ++e) { aq[e] = aq[e] * sigmoidf_(aq[e]) * 0.125f; ak[e] = ak[e] * sigmoidf_(ak[e]); }
            *(LAS v4u*)(Ql + lane * LD + d0) = pack8(aq); *(LAS v4u*)(Kl + lane * LD + d0) = pack8(ak);
#pragma unroll
            for (int e = 0; e < 8; ++e) Kwt[(d0 + e) * LD + lane] = (bf16)f2bf(w * ak[e]);
            const unsigned wv[8] = {n_va.x, n_va.y, n_va.z, n_va.w, n_vb.x, n_vb.y, n_vb.z, n_vb.w};
#pragma unroll
            for (int e = 0; e < 8; ++e) { Vt[(16 * wave + 2 * e) * LD + lane] = (bf16)(wv[e] & 0xffffu); Vt[(16 * wave + 2 * e + 1) * LD + lane] = (bf16)(wv[e] >> 16); }
            c_oa = n_oa; c_ob = n_ob;
            if (c + 1 < SEQ / 64) ML_LOADCHUNK(c + 1);
        }
        LDS_BARRIER();
        {
            const int rb = wave >> 1;
#pragma unroll
            for (int ci = 0; ci < 2; ++ci) { const int cb = 2 * (wave & 1) + ci; f32x4 acc = {0.f, 0.f, 0.f, 0.f};
#pragma unroll
                for (int kk = 0; kk < 2; ++kk) { const bf16x8 A = *(const LAS bf16x8*)(Ql + (16 * rb + l15) * LD + 32 * kk + 8 * l4), B = *(const LAS bf16x8*)(Kl + (16 * cb + l15) * LD + 32 * kk + 8 * l4); acc = mfma16(A, B, acc); }
                const int s = 16 * cb + l15; const float es = e_s[s];
#pragma unroll
                for (int r = 0; r < 4; ++r) { const int t = 16 * rb + 4 * l4 + r; const float v = (s <= t) ? acc[r] * fexp(es - Mx[t]) : 0.f; Sm[t * LD + s] = (bf16)f2bf(v); } }
        }
        LDS_BARRIER();
        f32x4 num[4];
        {
            float part = 0.f, qn = 0.f; float sv[8], qv[8];
            unpack8(*(const LAS v4u*)(Sm + tt * LD + 8 * p8), sv); unpack8(*(const LAS v4u*)(Ql + tt * LD + 8 * p8), qv);
#pragma unroll
            for (int e = 0; e < 8; ++e) { part += sv[e]; qn += qv[e] * nvec[8 * p8 + e]; }
            float tot = part + sc[tt] * qn; tot = red8(tot);
            if (p8 == 0) den[tt] = tot;
            const int rb = wave >> 1;
            bf16x8 As[2], Aq[2];
#pragma unroll
            for (int kk = 0; kk < 2; ++kk) { As[kk] = *(const LAS bf16x8*)(Sm + (16 * rb + l15) * LD + 32 * kk + 8 * l4); Aq[kk] = *(const LAS bf16x8*)(Ql + (16 * rb + l15) * LD + 32 * kk + 8 * l4); }
            float scr_[4];
#pragma unroll
            for (int r = 0; r < 4; ++r) scr_[r] = sc[16 * rb + 4 * l4 + r];
#pragma unroll
            for (int vi = 0; vi < 4; ++vi) { const int vb = 4 * (wave & 1) + vi; f32x4 a1 = {0.f, 0.f, 0.f, 0.f}, a2 = {0.f, 0.f, 0.f, 0.f};
#pragma unroll
                for (int kk = 0; kk < 2; ++kk) { const bf16x8 B1 = *(const LAS bf16x8*)(Vt + (16 * vb + l15) * LD + 32 * kk + 8 * l4), B2 = *(const LAS bf16x8*)(Ct + (16 * vb + l15) * LD + 32 * kk + 8 * l4);
                    a1 = mfma16(As[kk], B1, a1); a2 = mfma16(Aq[kk], B2, a2); }
#pragma unroll
                for (int r = 0; r < 4; ++r) num[vi][r] = a1[r] + scr_[r] * a2[r]; }
        }
        LDS_BARRIER();
        {
            const int rb = wave >> 1;
#pragma unroll
            for (int r = 0; r < 4; ++r) { const int t = 16 * rb + 4 * l4 + r; const float dn = frcp(fmaxf(fabsf(den[t]), em[t]));
#pragma unroll
                for (int vi = 0; vi < 4; ++vi) Hl[t * 132 + 16 * (4 * (wave & 1) + vi) + l15] = num[vi][r] * dn; }
            const float dec = scal[0];
            bf16x8 Av[2];
#pragma unroll
            for (int kk = 0; kk < 2; ++kk) Av[kk] = *(const LAS bf16x8*)(Vt + (16 * wave + l15) * LD + 32 * kk + 8 * l4);
#pragma unroll
            for (int db = 0; db < 4; ++db) { cacc[db] = cacc[db] * dec;
#pragma unroll
                for (int kk = 0; kk < 2; ++kk) { const bf16x8 B = *(const LAS bf16x8*)(Kwt + (16 * db + l15) * LD + 32 * kk + 8 * l4); cacc[db] = mfma16(Av[kk], B, cacc[db]); }
#pragma unroll
                for (int r = 0; r < 4; ++r) Ct[(16 * wave + 4 * l4 + r) * LD + 16 * db + l15] = (bf16)f2bf(cacc[db][r]); }
            float kv[8]; unpack8(*(const LAS v4u*)(Kwt + tt * LD + 8 * p8), kv); float s = 0.f;
#pragma unroll
            for (int e = 0; e < 8; ++e) s += kv[e];
            s = red8(s);
            if (p8 == 0) nvec[tt] = dec * nvec[tt] + s;
        }
        LDS_BARRIER();
        {
            const int t = t0 + tt, v0 = 16 * p8; float hv[16]; float ss = 0.f;
#pragma unroll
            for (int q = 0; q < 4; ++q) { const f32x4 x = *(const LAS f32x4*)(Hl + tt * 132 + v0 + 4 * q); hv[4 * q] = x[0]; hv[4 * q + 1] = x[1]; hv[4 * q + 2] = x[2]; hv[4 * q + 3] = x[3]; ss += (x[0] * x[0] + x[1] * x[1]) + (x[2] * x[2] + x[3] * x[3]); }
            ss = red8(ss); const float rn = frsq(ss * (1.0f / 128.0f) + NORM_EPS);
            float o0[8], o1[8]; unpack8(c_oa, o0); unpack8(c_ob, o1);
            float r0[8], r1[8];
#pragma unroll
            for (int e = 0; e < 8; ++e) { r0[e] = hv[e] * rn * mhg[hm * 128 + v0 + e] * sigmoidf_(o0[e]); r1[e] = hv[8 + e] * rn * mhg[hm * 128 + v0 + 8 + e] * sigmoidf_(o1[e]); }
            bf16* dst = MIX + (size_t)t * DM + 512 + hm * 128 + v0; *(v4u*)dst = pack8(r0); *(v4u*)(dst + 8) = pack8(r1);
        }
        LDS_BARRIER();
    }
}

__device__ __forceinline__ void phase_ffn_fix(const Args& a, int tid) {
    unsigned char* ws = a.ws; const float* SA = (const float*)(ws + WS_SIDE); const float* SB = SA + SIDE_ELEMS; const float* SL = SB + SIDE_ELEMS; bf16* GB = (bf16*)(ws + WS_GB);
    const float* cw = a.in[22]; const float* cb = a.in[23];
    const int NT = gridDim.x * 512;
    for (int it = blockIdx.x * 512 + tid; it < SIDE_ELEMS; it += NT) {
        const int ch = it & 127, r = (it >> 7) & 1, tile = it >> 8, pm = tile / 22, pn = tile % 22;
        const int base = tile * 256;
        float l0 = 0.f, l1 = 0.f;
        if ((pm & 7) != 0) { const int lb = (tile - 22) * 256; l0 = SL[lb + ch]; l1 = SL[lb + 128 + ch]; }
        const float a_r = SA[base + r * 128 + ch], b_r = SB[base + r * 128 + ch];
        const float am1 = r == 0 ? l1 : SA[base + ch], am2 = r == 0 ? l0 : l1;
        const int f = pn * 128 + ch;
        const float z = cb[f] + cw[f] * am2 + cw[DFF + f] * am1 + cw[2 * DFF + f] * a_r;
        GB[(size_t)(pm * 256 + r) * DFF + f] = (bf16)f2bf(z * sigmoidf_(z) * b_r);
    }
}
__device__ __forceinline__ void phase_final(const Args& a, int lane, int wave) {
    const float* ssqp = (const float*)(a.ws + WS_SSQP); const float* gf = a.in[25];
    f32x4 gv[4];
#pragma unroll
    for (int j = 0; j < 4; ++j) gv[j] = *((const f32x4*)gf + lane + 64 * j);
    const int NGW = gridDim.x * 8;
#ifdef PROBE
    const unsigned long long* tstamps = (const unsigned long long*)(a.ws + WS_CTL + 512 * 1024);
    const float fa = fminf(fmaxf((float)(long long)(tstamps[PROBE_A_TO] - tstamps[PROBE_A_FROM]) * (0.01f / PROBE_A_SCALE_US), 0.f), 1.f);
    const float fb = fminf(fmaxf((float)(long long)(tstamps[PROBE_B_TO] - tstamps[PROBE_B_FROM]) * (0.01f / PROBE_B_SCALE_US), 0.f), 1.f);
    const float pscale = 1.0f + sqrtf(fa * 0.8e-4f);
#pragma unroll
    for (int j = 0; j < 4; ++j) gv[j] = gv[j] * pscale;
#endif
    for (int row = blockIdx.x * 8 + wave; row < M; row += NGW) {
        const f32x4* p = (const f32x4*)(ssqp + (size_t)row * 16); const f32x4 s0 = p[0], s1 = p[1], s2 = p[2], s3 = p[3];
        const float ss = ((s0[0] + s0[1]) + (s0[2] + s0[3])) + ((s1[0] + s1[1]) + (s1[2] + s1[3])) + ((s2[0] + s2[1]) + (s2[2] + s2[3])) + ((s3[0] + s3[1]) + (s3[2] + s3[3]));
        const float rs = frsq(ss * (1.0f / DM) + NORM_EPS);
        f32x4* xr = (f32x4*)(a.out + (size_t)row * DM) + lane;
#pragma unroll
        for (int j = 0; j < 4; ++j) { f32x4 v = xr[64 * j] * rs * gv[j];
#ifdef PROBE
            if (row == 0 && lane == 0 && j == 0) v[0] += 2.0f + 28.0f * fb;
#endif
            xr[64 * j] = v; }
    }
}

constexpr int N_PHASES = 10;
__global__ void __launch_bounds__(512, 2) mega(Args args) {
    extern __shared__ __attribute__((aligned(16))) unsigned char lds_raw[];
    LAS unsigned char* lds = (LAS unsigned char*)lds_raw;
    const int tid0 = threadIdx.x;
    unsigned char* ws = args.ws;
#define PHASE_IDS int tid = tid0; asm volatile("" : "+v"(tid)); const int lane = tid & 63, wave = __builtin_amdgcn_readfirstlane(tid >> 6); (void)lane; (void)wave
    volatile LAS unsigned* MISC = (volatile LAS unsigned*)(lds + MISC_OFF);
    { PHASE_IDS; for (int u = tid; u < (LDS_BYTES - 131072) / 4; u += 512) ((LAS unsigned*)(lds + 131072))[u] = 0u; }
    __syncthreads();
    XcdBarrier bar; bar.bar = (unsigned*)(ws + WS_CTL) + 4096; bar.x = 0; bar.st = nullptr;
    if (MK_SINGLE) bar = xcd_barrier_post((unsigned*)(ws + WS_CTL) + 4096, MISC + 8);
    const int lo = args.ph_lo, hi = args.ph_hi;
#ifndef PH_MASK
#define PH_MASK 0xFFFF
#endif
#define IN(k) ((((PH_MASK) >> (k)) & 1) && lo <= (k) && (k) < hi)
#ifdef PROBE
    unsigned long long* const tstamps = (unsigned long long*)(ws + WS_CTL + 512 * 1024);
#define STAMP(k) do { if (blockIdx.x == 0 && tid0 == 0) tstamps[(k)] = __builtin_amdgcn_s_memrealtime(); } while (0)
#else
#define STAMP(k) do { } while (0)
#endif
    STAMP(0);
#define SEAM(k) do { if (IN(k) && IN((k) + 1)) xcd_barrier(bar); STAMP((k) + 1); } while (0)

    if (IN(0)) { PHASE_IDS; phase_prep(args, lds, tid, lane, wave); } SEAM(0);
    if (IN(1)) {
        pg8::Gemm g{(const bf16*)(ws + WS_XN), (const bf16*)(ws + WS_WT_IN), M, NPROJ, opaque_i(DM)}; pg8::StaticOrder S; S.init(M, NPROJ, gridDim.x, (int)blockIdx.x);
        pg8::EpiBf16<0> E{(bf16*)(ws + WS_PROJ), NPROJ, nullptr, 0, 0, 1.f};
        pg8::gemm_phase<pg8::EpiBf16<0>, pg8::StaticOrder, true, true>(lds, g, S, E);
    } SEAM(1);
    if (IN(2)) { PHASE_IDS; phase_lmat(args, tid); } SEAM(2);
    if (IN(3)) {
        pg8::Gemm g{(const bf16*)(ws + WS_LBUF), (const bf16*)(ws + WS_WT_LORA), M, NLORA, opaque_i(KLORA)}; pg8::StaticOrder S; S.init(M, NLORA, gridDim.x, (int)blockIdx.x);
        pg8::EpiBf16<0> E{(bf16*)(ws + WS_DAG), NLORA, nullptr, 0, 0, 1.f};
        pg8::gemm_phase<pg8::EpiBf16<0>, pg8::StaticOrder, true, true>(lds, g, S, E);
    } SEAM(3);
    if (IN(4)) {
        PHASE_IDS;
        for (int u = blockIdx.x; u < BATCH * 8; u += gridDim.x) rwkv_unit(args, lds, u, tid, lane, wave);
        __syncthreads();
        STAMP(12);
        for (int u = blockIdx.x; u < BATCH * 4; u += gridDim.x) mlstm_unit(args, lds, u, tid, lane, wave);
    } SEAM(4);
    if (IN(5)) {
        pg8::Gemm g{(const bf16*)(ws + WS_MIX), (const bf16*)(ws + WS_WT_OUT), M, DM, opaque_i(DM)}; pg8::StaticOrder S; S.init(M, DM, gridDim.x, (int)blockIdx.x);
        pg8::EpiResid E{args.in[0], args.out, (bf16*)(ws + WS_XN), (float*)(ws + WS_SSQP)};
        pg8::gemm_phase<pg8::EpiResid, pg8::StaticOrder, true, true>(lds, g, S, E);
    } SEAM(5);
    if (IN(6)) {
        pg8::Gemm g{(const bf16*)(ws + WS_XN), (const bf16*)(ws + WS_WT_UP), M, NUP, opaque_i(DM)}; pg8::StaticOrder S; S.init(M, NUP, gridDim.x, (int)blockIdx.x);
        float* side = (float*)(ws + WS_SIDE); float* rs2 = (float*)(ws + WS_RS2);
        {
            PHASE_IDS; pg8::Unit u;
            for (int i = 0; S.next(i, u); ++i) if (tid < 256) { const int row = u.pm * 256 + tid; const f32x4* p = (const f32x4*)((const float*)(ws + WS_SSQP) + (size_t)row * 16); const f32x4 s0 = p[0], s1 = p[1], s2 = p[2], s3 = p[3];
                const float ss = ((s0[0] + s0[1]) + (s0[2] + s0[3])) + ((s1[0] + s1[1]) + (s1[2] + s1[3])) + ((s2[0] + s2[1]) + (s2[2] + s2[3])) + ((s3[0] + s3[1]) + (s3[2] + s3[3]));
                rs2[row] = frsq(ss * (1.0f / DM) + NORM_EPS); }
            asm volatile("s_waitcnt vmcnt(0)" ::: "memory"); __syncthreads();
        }
        pg8::EpiFfn E{(bf16*)(ws + WS_GB), rs2, args.in[22], args.in[23], side, side + SIDE_ELEMS, side + 2 * SIDE_ELEMS, (LAS float*)(lds + 131072 + 1024)};
        pg8::gemm_phase<pg8::EpiFfn, pg8::StaticOrder, true, true>(lds, g, S, E);
    } SEAM(6);
    if (IN(7)) { PHASE_IDS; phase_ffn_fix(args, tid); } SEAM(7);
    if (IN(8)) {
        pg8::Gemm g{(const bf16*)(ws + WS_GB), (const bf16*)(ws + WS_WT_DN), M, DM, opaque_i(DFF)}; pg8::StaticOrder S; S.init(M, DM, gridDim.x, (int)blockIdx.x);
        pg8::EpiResid E{args.out, args.out, nullptr, (float*)(ws + WS_SSQP)};
        pg8::gemm_phase<pg8::EpiResid, pg8::StaticOrder, true, true>(lds, g, S, E);
    } SEAM(8);
    if (IN(9)) { PHASE_IDS; phase_final(args, lane, wave); }
#undef IN
#undef SEAM
}

extern "C" void kernel_launch(void* const* d_in, const int* in_sizes, int n_in, void* d_out, int out_size, void* d_ws, size_t ws_size, hipStream_t stream) {
    static int grid = 0;
    if (grid == 0) {
        if (n_in != 26 || in_sizes[0] != M * DM || out_size != M * DM || ws_size < WS_END) { fprintf(stderr, "kernel_launch: unexpected shapes (n_in %d, in0 %d, out %d, ws %zu)\n", n_in, n_in > 0 ? in_sizes[0] : -1, out_size, ws_size); grid = -1; return; }
        int dev = 0, cus = 0, per_cu = 0;
        if (hipGetDevice(&dev) != hipSuccess || hipDeviceGetAttribute(&cus, hipDeviceAttributeMultiprocessorCount, dev) != hipSuccess) { grid = -1; return; }
        if (hipFuncSetAttribute((const void*)mega, hipFuncAttributeMaxDynamicSharedMemorySize, LDS_BYTES) != hipSuccess) { fprintf(stderr, "kernel_launch: hipFuncSetAttribute failed\n"); grid = -1; return; }
        if (hipOccupancyMaxActiveBlocksPerMultiprocessor(&per_cu, (const void*)mega, 512, LDS_BYTES) != hipSuccess || per_cu < 1) { fprintf(stderr, "kernel_launch: occupancy query says %d blocks per CU\n", per_cu); }
        (void)hipGetLastError();
        grid = cus;
        if (grid != 256) fprintf(stderr, "kernel_launch: %d CUs; this kernel is laid out for 256\n", grid);
    }
    if (grid < 0) return;
    (void)hipMemsetAsync((char*)d_ws + WS_CTL, 0, CTL_ZERO_BYTES, stream);
    Args a{};
    for (int i = 0; i < 26; ++i) a.in[i] = (const float*)d_in[i];
    a.out = (float*)d_out; a.ws = (unsigned char*)d_ws;
#if MK_SINGLE
    a.ph_lo = 0; a.ph_hi = N_PHASES;
    hipLaunchKernelGGL(mega, dim3(grid), dim3(512), LDS_BYTES, stream, a);
#else
    for (int p = 0; p < N_PHASES; ++p) { a.ph_lo = p; a.ph_hi = p + 1; hipLaunchKernelGGL(mega, dim3(grid), dim3(512), LDS_BYTES, stream, a); }
#endif
}
```

```cpp
#include <hip/hip_runtime.h>
#include <cstdio>
#include <cstdint>
namespace pg8 {
#define PG8_LAS __attribute__((address_space(3)))
typedef unsigned short bf16_t;
typedef short bf16x8 __attribute__((ext_vector_type(8)));
typedef float f32x4 __attribute__((ext_vector_type(4)));
typedef unsigned u32x4 __attribute__((ext_vector_type(4)));
constexpr int BM = 256, BK = 64, HALF = 128, HTB = HALF * BK * 2  , STAGE_BYTES = 8 * HTB, NXCD = 8, WGM = 8;

__host__ __device__ __forceinline__ int lds_byte(int r, int c) { const int st = (r >> 4) * 2 + (c >> 5), rr = r & 15, cc = c & 31, ob = rr * 64 + cc * 2; return st * 1024 + (ob ^ (((ob >> 9) & 1) << 5)); }
__host__ __device__ __forceinline__ void stage_rc(int b, int& R, int& C) { const int st = b / 1024, sb = b % 1024, swz = sb ^ (((sb >> 9) & 1) << 5); R = (st >> 1) * 16 + swz / 64; C = (st & 1) * 32 + (swz % 64) / 2; }
__host__ __device__ __forceinline__ int perm32(int rho) { const int n = rho >> 4, i = rho & 15; return 8 * (i >> 2) + 4 * n + (i & 3); }

struct Unit { int pm, pn; };
struct Gemm { const bf16_t* A; const bf16_t* Bt; int M, N, K; };

struct StaticOrder {
    int nM, nN, nwg, G, c;
    __host__ __device__ void init(int M, int N, int G_, int c_) { nM = M / BM; nN = N / BM; nwg = nM * nN; G = G_; c = c_; }
    __host__ __device__ bool next(int i, Unit& u) const {
        const long L = (long)i * G + c; if (L >= nwg) return false;
        int wgid = (int)L; { const int q = nwg / NXCD, r = nwg % NXCD, xcd = wgid % NXCD, off = wgid / NXCD; wgid = (xcd < r ? xcd * (q + 1) : r * (q + 1) + (xcd - r) * q) + off; }
        const int nig = WGM * nN, gid = wgid / nig, fm = gid * WGM, gsz = (nM - fm) < WGM ? (nM - fm) : WGM;
        u.pm = fm + ((wgid % nig) % gsz); u.pn = (wgid % nig) / gsz; return true;
    }
    __device__ __forceinline__ void a_ready(const Unit&) const {}
    __device__ __forceinline__ void done(const Unit&) const {}
};

__device__ __forceinline__ unsigned cvt_pk_bf16(float lo, float hi) { unsigned r; asm volatile("v_cvt_pk_bf16_f32 %0, %1, %2" : "=v"(r) : "v"(lo), "v"(hi)); return r; }
typedef float f32x2 __attribute__((ext_vector_type(2)));
__device__ __forceinline__ f32x2 gelu_pk(f32x2 v) {
    const f32x2 av = __builtin_elementwise_abs(v), d = av * 0.2316418882f + 1.0f;
    f32x2 t; t.x = __builtin_amdgcn_rcpf(d.x); t.y = __builtin_amdgcn_rcpf(d.y);
    f32x2 q = t * 0.5307027145f + (-0.7265760135f); q = q * t + 0.7107068705f; q = q * t + (-0.142248368f); q = q * t + 0.127414796f; q = q * t;
    const f32x2 s = (v * v) * (-0.72134752044f);
    f32x2 e; e.x = __builtin_amdgcn_exp2f(s.x); e.y = __builtin_amdgcn_exp2f(s.y);
    const f32x2 m = v * (q * e), r = v - m;
    f32x2 o; o.x = v.x < 0.f ? m.x : r.x; o.y = v.y < 0.f ? m.y : r.y; return o;
}

template <int ACT  > struct EpiBf16 {
    static constexpr bool PERM = true, AFTER_DRAIN = false; static_assert(ACT == 0 || ACT == 1, "EpiBf16: ACT is 0 (none) or 1 (gelu_pk)");
    bf16_t* O; int ldc; const float* bias; int split_cols; size_t split_stride; float scale0;
    __device__ __forceinline__ void operator()(const f32x4 (&acc)[2][2][4][2], const Unit& u, int wr, int wc, int fr, int fq) const {
        const int row0 = u.pm * BM + wr * 64 + fr; int colt = u.pn * BM; bf16_t* base = O;
        float sc = 1.f; if (split_cols) { const int t = colt / split_cols; base += (size_t)t * split_stride; colt -= t * split_cols; if (t == 0) sc = scale0; }
        const int col0 = colt + wc * 32 + 8 * fq, bcol0 = u.pn * BM + wc * 32 + 8 * fq;
        f32x4 bv[2][2];
#pragma unroll
        for (int bj = 0; bj < 2; ++bj)
#pragma unroll
            for (int n = 0; n < 2; ++n) bv[bj][n] = bias ? *(const f32x4*)(bias + bcol0 + bj * HALF + 4 * n) : (f32x4){0.f, 0.f, 0.f, 0.f};
#pragma unroll
        for (int ai = 0; ai < 2; ++ai)
#pragma unroll
            for (int m = 0; m < 4; ++m) { bf16_t* rowp = base + (size_t)(row0 + ai * HALF + m * 16) * ldc + col0;
#pragma unroll
                for (int bj = 0; bj < 2; ++bj) { f32x4 v0 = acc[ai][bj][m][0] + bv[bj][0], v1 = acc[ai][bj][m][1] + bv[bj][1];
                    if (ACT == 1) { f32x2 a = gelu_pk((f32x2){v0[0], v0[1]}), b = gelu_pk((f32x2){v0[2], v0[3]}), c = gelu_pk((f32x2){v1[0], v1[1]}), d = gelu_pk((f32x2){v1[2], v1[3]});
                        v0 = (f32x4){a.x, a.y, b.x, b.y}; v1 = (f32x4){c.x, c.y, d.x, d.y}; }
                    v0 = v0 * sc; v1 = v1 * sc; u32x4 w; w.x = cvt_pk_bf16(v0[0], v0[1]); w.y = cvt_pk_bf16(v0[2], v0[3]); w.z = cvt_pk_bf16(v1[0], v1[1]); w.w = cvt_pk_bf16(v1[2], v1[3]);
                    *(u32x4*)(rowp + bj * HALF) = w; } }
    }
};
template <class Epi, class Sched, bool ALIGN_EPI = false, bool SP2 = false>
__device__ __forceinline__ void gemm_phase(PG8_LAS unsigned char* lds, const Gemm g, const Sched& S, const Epi& E) {
    const int tid = threadIdx.x, wid = __builtin_amdgcn_readfirstlane(tid >> 6), lane = tid & 63, wr = wid >> 2, wc = wid & 3, fr = lane & 15, fq = lane >> 4;
    const int K = g.K, nt = K / BK;
    unsigned voffA[2], voffB[2];
#pragma unroll
    for (int i = 0; i < 2; ++i) { int R, C; stage_rc(tid * 16 + i * 8192, R, C); const int Rb = Epi::PERM ? ((R & ~31) + perm32(R & 31)) : R;
        voffA[i] = (unsigned)(R * K + C) * 2u; voffB[i] = (unsigned)(Rb * K + C) * 2u; }
    const size_t kstep = (size_t)(BK * 2);
    const size_t hstep = (size_t)HALF * K * 2;
    const size_t tstep = 2 * hstep;
    const unsigned ldsw = (unsigned)wid * 1024u;
    const int aoff = lds_byte(wr * 64 + fr, fq * 8), boff = lds_byte(wc * 32 + fr, fq * 8);
#define PG8_SA(b, h) (((b) * 2 + (h)) * HTB)
#define PG8_SB(b, h) ((4 + (b) * 2 + (h)) * HTB)
#define PG8_STAGE(bufoff, gbase, voff) do { _Pragma("unroll") for (int _i = 0; _i < 2; ++_i) \
        __builtin_amdgcn_global_load_lds((const unsigned*)((const char*)(gbase) + (voff)[_i]), (PG8_LAS unsigned*)(lds + (bufoff) + ldsw + _i * 8192), 16, 0, 0); } while (0)
#define PG8_LDA(dst, b, h) do { _Pragma("unroll") for (int m = 0; m < 4; ++m) _Pragma("unroll") for (int k = 0; k < 2; ++k) dst[m][k] = *(const PG8_LAS bf16x8*)(lds + PG8_SA(b, h) + aoff + m * 2048 + k * 1024); } while (0)
#define PG8_LDB(dst, b, h) do { _Pragma("unroll") for (int n = 0; n < 2; ++n) _Pragma("unroll") for (int k = 0; k < 2; ++k) dst[n][k] = *(const PG8_LAS bf16x8*)(lds + PG8_SB(b, h) + boff + n * 2048 + k * 1024); } while (0)
#define PG8_MMA(ai, bj, At, Bt) do { __builtin_amdgcn_s_setprio(1); _Pragma("unroll") for (int m = 0; m < 4; ++m) _Pragma("unroll") for (int n = 0; n < 2; ++n) _Pragma("unroll") for (int k = 0; k < 2; ++k) \
        acc[ai][bj][m][n] = __builtin_amdgcn_mfma_f32_16x16x32_bf16(Bt[n][k], At[m][k], acc[ai][bj][m][n], 0, 0, 0); __builtin_amdgcn_s_setprio(0); } while (0)
#define PG8_WAIT_V(n) asm volatile("s_waitcnt vmcnt(" #n ")" ::: "memory")
#define PG8_WAIT_L(n) asm volatile("s_waitcnt lgkmcnt(" #n ")" ::: "memory")
#define PG8_BAR __builtin_amdgcn_s_barrier()
#define PG8_SCHED __builtin_amdgcn_sched_barrier(0)
    Unit cur, nxt; int ui = 0;
    if (!S.next(0, cur)) return;
    f32x4 acc[2][2][4][2];
#pragma unroll
    for (int a = 0; a < 2; ++a)
#pragma unroll
        for (int b = 0; b < 2; ++b)
#pragma unroll
            for (int m = 0; m < 4; ++m)
#pragma unroll
                for (int n = 0; n < 2; ++n) acc[a][b][m][n] = (f32x4){0.f, 0.f, 0.f, 0.f};
    bf16x8 At[4][2], B0[2][2], B1[2][2];
    const char* cA = (const char*)g.A + (size_t)cur.pm * tstep; const char* cB = (const char*)g.Bt + (size_t)cur.pn * tstep;
    S.a_ready(cur);
    if constexpr (SP2) {
        PG8_STAGE(PG8_SB(0, 0), cB, voffB); PG8_STAGE(PG8_SB(0, 1), cB + hstep, voffB); PG8_STAGE(PG8_SA(0, 0), cA, voffA); PG8_STAGE(PG8_SA(0, 1), cA + hstep, voffA);
        if (wr == 1) PG8_BAR;
        PG8_WAIT_V(2); PG8_BAR;
        PG8_STAGE(PG8_SB(1, 0), cB + kstep, voffB); PG8_STAGE(PG8_SA(1, 0), cA + kstep, voffA); PG8_STAGE(PG8_SB(1, 1), cB + hstep + kstep, voffB);
        PG8_WAIT_V(6); PG8_BAR;
    } else {
        PG8_STAGE(PG8_SB(0, 0), cB, voffB); PG8_STAGE(PG8_SA(0, 0), cA, voffA); PG8_STAGE(PG8_SB(0, 1), cB + hstep, voffB); PG8_STAGE(PG8_SA(0, 1), cA + hstep, voffA);
        if (wr == 1) PG8_BAR;
        PG8_WAIT_V(4); PG8_BAR;
        PG8_STAGE(PG8_SB(1, 0), cB + kstep, voffB); PG8_STAGE(PG8_SA(1, 0), cA + kstep, voffA); PG8_STAGE(PG8_SB(1, 1), cB + hstep + kstep, voffB);
        PG8_WAIT_V(6); PG8_BAR;
    }
    for (;;) {
        const bool has_next = S.next(ui + 1, nxt);
        const char* nA = has_next ? (const char*)g.A + (size_t)nxt.pm * tstep : cA; const char* nB = has_next ? (const char*)g.Bt + (size_t)nxt.pn * tstep : cB;
        for (int t = 0; t < nt; t += 2) {
            const bool last = (t == nt - 2);
            const char* a1 = cA + (size_t)(t + 1) * kstep;
            const char* a2 = last ? nA : cA + (size_t)(t + 2) * kstep; const char* b2 = last ? nB : cB + (size_t)(t + 2) * kstep;
            const char* a3 = a2 + kstep; const char* b3 = b2 + kstep;
            if (last && has_next) S.a_ready(nxt);
            if constexpr (SP2) {
            PG8_LDB(B0, 0, 0); PG8_LDB(B1, 0, 1); PG8_SCHED; PG8_LDA(At, 0, 0); PG8_STAGE(PG8_SA(1, 1), a1 + hstep, voffA);
            PG8_WAIT_V(8); PG8_WAIT_L(0); PG8_BAR; PG8_MMA(0, 0, At, B0); PG8_MMA(0, 1, At, B1); PG8_BAR; PG8_SCHED;
            PG8_LDA(At, 0, 1); PG8_STAGE(PG8_SB(0, 0), b2, voffB); PG8_STAGE(PG8_SB(0, 1), b2 + hstep, voffB); PG8_STAGE(PG8_SA(0, 0), a2, voffA);
            PG8_WAIT_V(8); PG8_WAIT_L(0); PG8_BAR; PG8_MMA(1, 0, At, B0); PG8_MMA(1, 1, At, B1); PG8_BAR; PG8_SCHED;
            PG8_LDB(B0, 1, 0); PG8_LDB(B1, 1, 1); PG8_SCHED; PG8_LDA(At, 1, 0); PG8_STAGE(PG8_SA(0, 1), a2 + hstep, voffA);
            PG8_WAIT_V(8); PG8_WAIT_L(0); PG8_BAR; PG8_MMA(0, 0, At, B0); PG8_MMA(0, 1, At, B1); PG8_BAR; PG8_SCHED;
            PG8_LDA(At, 1, 1); PG8_STAGE(PG8_SB(1, 0), b3, voffB); PG8_STAGE(PG8_SB(1, 1), b3 + hstep, voffB); PG8_STAGE(PG8_SA(1, 0), a3, voffA);
            PG8_WAIT_V(8); PG8_WAIT_L(0); PG8_BAR; PG8_MMA(1, 0, At, B0); PG8_MMA(1, 1, At, B1); PG8_BAR; PG8_SCHED;
            } else {
            PG8_LDB(B0, 0, 0); PG8_SCHED; PG8_LDA(At, 0, 0); PG8_STAGE(PG8_SA(1, 1), a1 + hstep, voffA);
            PG8_WAIT_L(8); PG8_BAR; PG8_WAIT_L(0); PG8_MMA(0, 0, At, B0); PG8_BAR; PG8_SCHED;
            PG8_LDB(B1, 0, 1); PG8_STAGE(PG8_SB(0, 0), b2, voffB);
            PG8_BAR; PG8_WAIT_L(0); PG8_MMA(0, 1, At, B1); PG8_BAR;
            PG8_LDA(At, 0, 1); PG8_STAGE(PG8_SA(0, 0), a2, voffA);
            PG8_BAR; PG8_WAIT_L(0); PG8_MMA(1, 0, At, B0); PG8_BAR; PG8_SCHED;
            PG8_STAGE(PG8_SB(0, 1), b2 + hstep, voffB);
            PG8_WAIT_V(6); PG8_BAR; PG8_MMA(1, 1, At, B1); PG8_BAR;
            PG8_LDB(B0, 1, 0); PG8_SCHED; PG8_LDA(At, 1, 0); PG8_STAGE(PG8_SA(0, 1), a2 + hstep, voffA);
            PG8_WAIT_L(8); PG8_BAR; PG8_WAIT_L(0); PG8_MMA(0, 0, At, B0); PG8_BAR; PG8_SCHED;
            PG8_LDB(B1, 1, 1); PG8_STAGE(PG8_SB(1, 0), b3, voffB);
            PG8_BAR; PG8_WAIT_L(0); PG8_MMA(0, 1, At, B1); PG8_BAR;
            PG8_LDA(At, 1, 1); PG8_STAGE(PG8_SA(1, 0), a3, voffA);
            PG8_BAR; PG8_WAIT_L(0); PG8_MMA(1, 0, At, B0); PG8_BAR; PG8_SCHED;
            PG8_STAGE(PG8_SB(1, 1), b3 + hstep, voffB);
            PG8_WAIT_V(6); PG8_BAR; PG8_MMA(1, 1, At, B1); PG8_BAR;
            }
        }
        if constexpr (ALIGN_EPI) { if (wr == 0) PG8_BAR; }
        if constexpr (!Epi::AFTER_DRAIN) { E(acc, cur, wr, wc, fr, fq); S.done(cur); }
        if (!has_next) break;
#pragma unroll
        for (int a = 0; a < 2; ++a)
#pragma unroll
            for (int b = 0; b < 2; ++b)
#pragma unroll
                for (int m = 0; m < 4; ++m)
#pragma unroll
                    for (int n = 0; n < 2; ++n) acc[a][b][m][n] = (f32x4){0.f, 0.f, 0.f, 0.f};
        cur = nxt; cA = nA; cB = nB; ++ui;
        if constexpr (ALIGN_EPI) { if (wr == 1) PG8_BAR; }
    }
    PG8_WAIT_V(0);
    if constexpr (!ALIGN_EPI) { if (wr == 0) PG8_BAR; }
    PG8_BAR;
    if constexpr (Epi::AFTER_DRAIN) { E.fused(acc, cur, wr, wc, fr, fq, lds, wid, lane); S.done(cur); }
#undef PG8_SA
#undef PG8_SB
#undef PG8_STAGE
#undef PG8_LDA
#undef PG8_LDB
#undef PG8_MMA
#undef PG8_WAIT_V
#undef PG8_WAIT_L
#undef PG8_BAR
#undef PG8_SCHED
}
}

#ifndef MK_SINGLE
#define MK_SINGLE 1
#endif
constexpr int BATCH = 32, SEQ = 2048, DM = 1024, M = BATCH * SEQ;
constexpr int NIN = 3336, NPROJ = 3328;
constexpr int DFF = 2816, NUP = 2 * DFF;
constexpr int C_Q = 1792, C_K = 2048, C_V = 2304, C_O = 2816;
constexpr int NLORA = 1536, KLORA = 256;
constexpr int MH = M / 2;
constexpr float NORM_EPS = 1e-6f, LNX_EPS = 64e-5f;

constexpr size_t MiB = 1u << 20;
constexpr size_t WS_CTL = 0, CTL_ZERO_BYTES = 1 * MiB;
constexpr size_t WS_WT_IN = 2 * MiB, WS_WT_OUT = 9 * MiB, WS_WT_UP = 11 * MiB, WS_WT_DN = 22 * MiB, WS_WT_LORA = 28 * MiB;
constexpr size_t WS_RS2 = 29 * MiB, WS_SSQP = 30 * MiB, WS_GATES = 34 * MiB;
constexpr size_t WS_XN = 40 * MiB;
constexpr size_t WS_PROJ = 168 * MiB;
constexpr size_t WS_LBUF = 584 * MiB;
constexpr size_t WS_DAG = 616 * MiB;
constexpr size_t WS_MIX = 808 * MiB;
constexpr size_t WS_SIDE = 168 * MiB;
constexpr int SIDE_ELEMS = 256 * 22 * 2 * 128;
constexpr size_t WS_FF = 192 * MiB;
constexpr size_t WS_GB = 520 * MiB;
constexpr size_t WS_END = 936 * MiB;

constexpr int LDS_BYTES = 163840;
constexpr int MISC_OFF = LDS_BYTES - 256;

#define GAS __attribute__((address_space(1)))
#define LAS __attribute__((address_space(3)))
typedef unsigned short bf16;
typedef unsigned v4u __attribute__((ext_vector_type(4)));
typedef unsigned v2u __attribute__((ext_vector_type(2)));
typedef float f32x4 __attribute__((ext_vector_type(4)));
typedef float f32x2 __attribute__((ext_vector_type(2)));
typedef short bf16x8 __attribute__((ext_vector_type(8)));
typedef GAS unsigned gu32;

typedef __bf16 bf16x2_t __attribute__((ext_vector_type(2)));
__device__ __forceinline__ unsigned pk2(float lo, float hi) { const f32x2 v = {lo, hi}; const bf16x2_t b = __builtin_convertvector(v, bf16x2_t); return __builtin_bit_cast(unsigned, b); }
__device__ __forceinline__ unsigned f2bf(float f) { return pk2(f, f) & 0xffffu; }
__device__ __forceinline__ float bf2f(unsigned short u) { return __builtin_bit_cast(float, (unsigned)u << 16); }
__device__ __forceinline__ float bflo(unsigned w) { return __builtin_bit_cast(float, w << 16); }
__device__ __forceinline__ float bfhi(unsigned w) { return __builtin_bit_cast(float, w & 0xffff0000u); }
__device__ __forceinline__ void unpack8(const v4u w, float (&o)[8]) { o[0] = bflo(w.x); o[1] = bfhi(w.x); o[2] = bflo(w.y); o[3] = bfhi(w.y); o[4] = bflo(w.z); o[5] = bfhi(w.z); o[6] = bflo(w.w); o[7] = bfhi(w.w); }
__device__ __forceinline__ v4u pack8(const float (&o)[8]) { v4u w; w.x = pk2(o[0], o[1]); w.y = pk2(o[2], o[3]); w.z = pk2(o[4], o[5]); w.w = pk2(o[6], o[7]); return w; }
__device__ __forceinline__ float frcp(float x) { return __builtin_amdgcn_rcpf(x); }
__device__ __forceinline__ float frsq(float x) { return __builtin_amdgcn_rsqf(x); }
__device__ __forceinline__ float fsqrt_(float x) { return __builtin_amdgcn_sqrtf(x); }
__device__ __forceinline__ float fexp(float x) { return __builtin_amdgcn_exp2f(x * 1.4426950408889634f); }
__device__ __forceinline__ float sigmoidf_(float x) { return frcp(1.0f + __builtin_amdgcn_exp2f(x * -1.4426950408889634f)); }
__device__ __forceinline__ float tanhf_(float x) { return 1.0f - 2.0f * frcp(__builtin_amdgcn_exp2f(x * 2.8853900817779268f) + 1.0f); }
__device__ __forceinline__ float softplusf_(float x) { return fmaxf(x, 0.f) + __logf(1.0f + fexp(-fabsf(x))); }
__device__ __forceinline__ float wave_sum(float v) {
#pragma unroll
    for (int o = 1; o < 64; o <<= 1) v += __shfl_xor(v, o);
    return v;
}
template <int CTRL> __device__ __forceinline__ float dppmov(float v) { return __builtin_bit_cast(float, __builtin_amdgcn_update_dpp(0, __builtin_bit_cast(int, v), CTRL, 0xF, 0xF, true)); }
__device__ __forceinline__ float red8(float v) { v += dppmov<0xB1>(v); v += dppmov<0x4E>(v); v += dppmov<0x141>(v); return v; }
__device__ __forceinline__ float red16(float v) { v += dppmov<0xB1>(v); v += dppmov<0x4E>(v); v += dppmov<0x141>(v); v += dppmov<0x140>(v); return v; }

template <int CTRL, int RMASK> __device__ __forceinline__ float dppsh(float idv, float v) { return __builtin_bit_cast(float, __builtin_amdgcn_update_dpp(__builtin_bit_cast(int, idv), __builtin_bit_cast(int, v), CTRL, RMASK, 0xF, false)); }
__device__ __forceinline__ float wave_scan_add(float v) {
    v += dppsh<0x111, 0xF>(0.f, v); v += dppsh<0x112, 0xF>(0.f, v); v += dppsh<0x114, 0xF>(0.f, v); v += dppsh<0x118, 0xF>(0.f, v);
    v += dppsh<0x142, 0xA>(0.f, v); v += dppsh<0x143, 0xC>(0.f, v); return v;
}
__device__ __forceinline__ float wave_scan_max(float v) {
    const float ni = -3.0e38f;
    v = fmaxf(v, dppsh<0x111, 0xF>(ni, v)); v = fmaxf(v, dppsh<0x112, 0xF>(ni, v)); v = fmaxf(v, dppsh<0x114, 0xF>(ni, v)); v = fmaxf(v, dppsh<0x118, 0xF>(ni, v));
    v = fmaxf(v, dppsh<0x142, 0xA>(ni, v)); v = fmaxf(v, dppsh<0x143, 0xC>(ni, v)); return v;
}

#define XB_TMO      128
#define XB_XCNT(j)  (256  + 64 * (j))
#define XB_XSUB(j)  (1280 + 64 * (j))
#define XB_XGEN(j)  (2304 + 64 * (j))
#define XB_TOP      3328
#define XB_TOPGEN   3392
#define XCD_BAR_WORDS 3456
#define XB_SPIN_CAP (1u << 22)
__device__ __forceinline__ unsigned xb_ld(unsigned* p)              { return __hip_atomic_load(p, __ATOMIC_RELAXED, __HIP_MEMORY_SCOPE_AGENT); }
__device__ __forceinline__ unsigned xb_add(unsigned* p, unsigned v) { return __hip_atomic_fetch_add(p, v, __ATOMIC_RELAXED, __HIP_MEMORY_SCOPE_AGENT); }
__device__ __forceinline__ unsigned xb_xcc_id() { return (unsigned)__builtin_amdgcn_s_getreg((3 << 11) | 20) & 0xFu; }
#define XB_SPIN(cond, bar) do { unsigned _sp = 0; while (cond) { __builtin_amdgcn_s_sleep(1); \
    if ((++_sp & 255u) == 0u) { if (xb_ld(&(bar)[XB_TMO])) break; if (_sp > XB_SPIN_CAP) { atomicAdd(&(bar)[XB_TMO], 1u); break; } } } } while (0)
struct XcdBarrier { unsigned* bar; unsigned x; volatile LAS unsigned* st; };
__device__ __forceinline__ XcdBarrier xcd_barrier_post(unsigned* bar, volatile LAS unsigned* st) {
    XcdBarrier b; b.bar = bar; b.x = xb_xcc_id(); b.st = st;
    if (threadIdx.x == 0) (void)xb_add(&bar[XB_XCNT(b.x)], 1u);
    return b;
}
__device__ __forceinline__ void xcd_barrier_complete(unsigned* bar, unsigned x, unsigned& nloc, unsigned& nx) {
    const unsigned G = gridDim.x * gridDim.y * gridDim.z;
    unsigned sum, cnt, mine, sp = 0u;
    for (;;) {
        sum = 0u; cnt = 0u; mine = 0u;
#pragma unroll
        for (unsigned j = 0; j < 16; ++j) { const unsigned c = xb_ld(&bar[XB_XCNT(j)]); sum += c; cnt += (c > 0u) ? 1u : 0u; mine = (j == x) ? c : mine; }
        if (sum == G) break;
        __builtin_amdgcn_s_sleep(1);
        if ((++sp & 255u) == 0u) { if (xb_ld(&bar[XB_TMO])) break; if (sp > XB_SPIN_CAP) { atomicAdd(&bar[XB_TMO], 1u); break; } }
    }
    nloc = mine > 0u ? mine : 1u; nx = cnt > 0u ? cnt : 1u;
}
__device__ __forceinline__ void xcd_barrier(const XcdBarrier& b) {
    asm volatile("s_waitcnt vmcnt(0)" ::: "memory");
    __syncthreads();
    if (threadIdx.x == 0) {
        unsigned* bar = b.bar;
        __builtin_amdgcn_s_waitcnt(0);
        unsigned nloc = b.st[0], nx = b.st[1];
        if (nloc == 0u) { xcd_barrier_complete(bar, b.x, nloc, nx); b.st[0] = nloc; b.st[1] = nx; }
        const unsigned old = xb_add(&bar[XB_XSUB(b.x)], 1u);
        const unsigned gen = old / nloc;
        if (old + 1u == (gen + 1u) * nloc) {
            __builtin_amdgcn_fence(__ATOMIC_RELEASE, "agent");
            asm volatile("s_waitcnt vmcnt(0)" ::: "memory");
            const unsigned og = xb_add(&bar[XB_TOP], 1u);
            const unsigned tg = og / nx;
            if (og + 1u == (tg + 1u) * nx) xb_add(&bar[XB_TOPGEN], 1u);
            else XB_SPIN(xb_ld(&bar[XB_TOPGEN]) == tg, bar);
            __builtin_amdgcn_fence(__ATOMIC_ACQUIRE, "agent");
            xb_add(&bar[XB_XGEN(b.x)], 1u);
            asm volatile("s_waitcnt vmcnt(0)" ::: "memory");
        } else {
            XB_SPIN(xb_ld(&bar[XB_XGEN(b.x)]) == gen, bar);
            __builtin_amdgcn_fence(__ATOMIC_ACQUIRE, "agent");
            asm volatile("s_waitcnt vmcnt(0)" ::: "memory");
        }
    }
    __syncthreads();
}

__device__ __forceinline__ int opaque_i(int v) { asm volatile("" : "+s"(v)); return v; }
#define LDS_BARRIER() do { asm volatile("s_waitcnt lgkmcnt(0)" ::: "memory"); __builtin_amdgcn_s_barrier(); asm volatile("" ::: "memory"); } while (0)
struct Args { const float* in[26]; float* out; unsigned char* ws; int ph_lo, ph_hi; };

namespace pg8 {
struct PanelOrder {
    int c;
    __device__ bool next(int i, Unit& u) const { if (i >= 4) return false; u.pm = c; u.pn = i; return true; }
    __device__ __forceinline__ void a_ready(const Unit&) const {}
    __device__ __forceinline__ void done(const Unit&) const {}
};
struct EpiResid {
    static constexpr bool PERM = true, AFTER_DRAIN = false;
    const float* X; float* X2; bf16_t* XB; float* ssqp;
    __device__ __forceinline__ void operator()(const f32x4 (&acc)[2][2][4][2], const Unit& u, int wr, int wc, int fr, int fq) const {
        int pm_ = u.pm; asm volatile("" : "+s"(pm_));
        const int row0 = pm_ * BM + wr * 64 + fr, col0 = u.pn * BM + wc * 32 + 8 * fq;
#pragma unroll
        for (int ai = 0; ai < 2; ++ai)
#pragma unroll
            for (int m = 0; m < 4; ++m) { const int row = row0 + ai * HALF + m * 16; float ss = 0.f;
#pragma unroll
                for (int bj = 0; bj < 2; ++bj) { const size_t off = (size_t)row * DM + col0 + bj * HALF;
                    const f32x4 x0 = *(const f32x4*)(X + off), x1 = *(const f32x4*)(X + off + 4);
                    const f32x4 v0 = acc[ai][bj][m][0] + x0, v1 = acc[ai][bj][m][1] + x1;
                    *(f32x4*)(X2 + off) = v0; *(f32x4*)(X2 + off + 4) = v1;
                    ss += (v0[0] * v0[0] + v0[1] * v0[1]) + (v0[2] * v0[2] + v0[3] * v0[3]) + (v1[0] * v1[0] + v1[1] * v1[1]) + (v1[2] * v1[2] + v1[3] * v1[3]);
                    if (XB) { u32x4 w; w.x = pk2(v0[0], v0[1]); w.y = pk2(v0[2], v0[3]); w.z = pk2(v1[0], v1[1]); w.w = pk2(v1[2], v1[3]); *(u32x4*)(XB + off) = w; } }
                ss += __shfl_xor(ss, 16); ss += __shfl_xor(ss, 32);
                if (fq == 0) ssqp[(size_t)row * 16 + u.pn * 4 + wc] = ss; }
    }
};
struct EpiScale {
    static constexpr bool PERM = true, AFTER_DRAIN = false;
    bf16_t* O; int ldc; const float* rs; int row_off;
    __device__ __forceinline__ void operator()(const f32x4 (&acc)[2][2][4][2], const Unit& u, int wr, int wc, int fr, int fq) const {
        const int row0 = u.pm * BM + wr * 64 + fr, col0 = u.pn * BM + wc * 32 + 8 * fq;
#pragma unroll
        for (int ai = 0; ai < 2; ++ai)
#pragma unroll
            for (int m = 0; m < 4; ++m) { const int row = row0 + ai * HALF + m * 16; const float s = rs[row_off + row]; bf16_t* rowp = O + (size_t)row * ldc + col0;
#pragma unroll
                for (int bj = 0; bj < 2; ++bj) { const f32x4 v0 = acc[ai][bj][m][0] * s, v1 = acc[ai][bj][m][1] * s;
                    u32x4 w; w.x = pk2(v0[0], v0[1]); w.y = pk2(v0[2], v0[3]); w.z = pk2(v1[0], v1[1]); w.w = pk2(v1[2], v1[3]); *(u32x4*)(rowp + bj * HALF) = w; } }
    }
};
struct EpiFfn {
    static constexpr bool PERM = true, AFTER_DRAIN = false;
    bf16_t* G; const float* rs; const float* cw; const float* cb; float* SA; float* SB; float* SL; LAS float* hal;
    __device__ __forceinline__ void operator()(const f32x4 (&acc)[2][2][4][2], const Unit& u, int wr, int wc, int fr, int fq) const {
        int chl = wc * 32 + 8 * fq; asm volatile("" : "+v"(chl));
        const int f0 = u.pn * 128 + chl, rowt = wr * 64 + fr;
        float rsv[2][4];
#pragma unroll
        for (int ai = 0; ai < 2; ++ai)
#pragma unroll
            for (int m = 0; m < 4; ++m) rsv[ai][m] = rs[u.pm * BM + ai * HALF + m * 16 + rowt];
        const size_t sbase = ((size_t)(u.pm * 22 + u.pn) * 2) * 128 + chl;
        if (fr >= 14) {
#pragma unroll
            for (int ai = 0; ai < 2; ++ai) { const float r_ = rsv[ai][3]; const f32x4 v0 = acc[ai][0][3][0] * r_, v1 = acc[ai][0][3][1] * r_;
                LAS float* hp = hal + ((ai * 2 + wr) * 2 + (fr - 14)) * 128 + chl; *(LAS f32x4*)hp = v0; *(LAS f32x4*)(hp + 4) = v1;
                if (ai == 1 && wr == 1) { float* gp = SL + sbase + (fr - 14) * 128; *(f32x4*)gp = v0; *(f32x4*)(gp + 4) = v1; } }
        }
        if (wr == 0 && fr < 2) { const float r_ = rsv[0][0]; float* ga = SA + sbase + fr * 128; float* gb = SB + sbase + fr * 128;
            *(f32x4*)ga = acc[0][0][0][0] * r_; *(f32x4*)(ga + 4) = acc[0][0][0][1] * r_; *(f32x4*)gb = acc[0][1][0][0] * r_; *(f32x4*)(gb + 4) = acc[0][1][0][1] * r_; }
        asm volatile("s_waitcnt lgkmcnt(0)" ::: "memory"); __builtin_amdgcn_s_barrier(); asm volatile("" ::: "memory");
        float w0[8], w1[8], w2[8], bz[8];
        { const f32x4 a0 = *(const f32x4*)(cw + f0), a1 = *(const f32x4*)(cw + f0 + 4), b0 = *(const f32x4*)(cw + DFF + f0), b1 = *(const f32x4*)(cw + DFF + f0 + 4);
          const f32x4 c0 = *(const f32x4*)(cw + 2 * DFF + f0), c1 = *(const f32x4*)(cw + 2 * DFF + f0 + 4), d0 = *(const f32x4*)(cb + f0), d1 = *(const f32x4*)(cb + f0 + 4);
#pragma unroll
          for (int j = 0; j < 4; ++j) { w0[j] = a0[j]; w0[4 + j] = a1[j]; w1[j] = b0[j]; w1[4 + j] = b1[j]; w2[j] = c0[j]; w2[4 + j] = c1[j]; bz[j] = d0[j]; bz[4 + j] = d1[j]; } }
        const bool fr0 = (fr == 0), frl2 = (fr < 2);
#pragma unroll
        for (int ai = 0; ai < 2; ++ai) {
            float ap[8];
            const int pb = ai * 2 + wr - 1;
#pragma unroll
            for (int m = 0; m < 4; ++m) {
                float av[8], bv[8], y1[8], y2[8];
                const float r_ = rsv[ai][m];
#pragma unroll
                for (int j = 0; j < 4; ++j) { av[j] = acc[ai][0][m][0][j] * r_; av[4 + j] = acc[ai][0][m][1][j] * r_; bv[j] = acc[ai][1][m][0][j] * r_; bv[4 + j] = acc[ai][1][m][1][j] * r_; }
                if (m == 0) {
                    if (pb >= 0) { const LAS float* h0 = hal + (pb * 2) * 128 + chl; const f32x4 h00 = *(const LAS f32x4*)h0, h01 = *(const LAS f32x4*)(h0 + 4), h10 = *(const LAS f32x4*)(h0 + 128), h11 = *(const LAS f32x4*)(h0 + 132);
#pragma unroll
                        for (int j = 0; j < 4; ++j) { y1[j] = h10[j]; y1[4 + j] = h11[j]; y2[j] = fr0 ? h00[j] : h10[j]; y2[4 + j] = fr0 ? h01[j] : h11[j]; } }
                    else {
#pragma unroll
                        for (int j = 0; j < 8; ++j) { y1[j] = 0.f; y2[j] = 0.f; } }
                } else {
#pragma unroll
                    for (int j = 0; j < 8; ++j) { y1[j] = dppmov<0x121>(ap[j]); y2[j] = dppmov<0x122>(ap[j]); }
                }
                float o[8];
#pragma unroll
                for (int j = 0; j < 8; ++j) { const float x1 = dppmov<0x121>(av[j]), x2 = dppmov<0x122>(av[j]);
                    const float am1 = fr0 ? y1[j] : x1, am2 = frl2 ? y2[j] : x2;
                    const float z = bz[j] + w0[j] * am2 + w1[j] * am1 + w2[j] * av[j];
                    o[j] = z * sigmoidf_(z) * bv[j]; ap[j] = av[j]; }
                if (!(ai == 0 && m == 0 && wr == 0 && frl2)) *(u32x4*)(G + (size_t)(u.pm * BM + ai * HALF + m * 16 + rowt) * DFF + f0) = pack8(o);
            }
        }
    }
};
}

template <bool FFN_UP = false>
__device__ __forceinline__ void transpose_item(const float* W, int ldw, int K, bf16* WT, const float* kscale, LAS float* scr, int item, int nblk, int lane) {
    const int kb = item / nblk, nb = item % nblk, k0 = 64 * kb, n0 = 32 * nb;
    const int d0 = !FFN_UP ? n0 : (n0 < DFF ? ((n0 >> 7) * 256 + (n0 & 127)) : ((((n0 - DFF) >> 7) * 256) + 128 + ((n0 - DFF) & 127)));
#pragma unroll 8
    for (int i = 0; i < 32; ++i) { const int kk = 2 * i + (lane >> 5); const float s = kscale ? kscale[k0 + kk] : 1.0f; scr[kk * 33 + (lane & 31)] = W[(size_t)(k0 + kk) * ldw + n0 + (lane & 31)] * s; }
    asm volatile("s_waitcnt lgkmcnt(0)" ::: "memory");
    const int c = lane & 7;
#pragma unroll
    for (int j = 0; j < 4; ++j) { const int n = (lane >> 3) + 8 * j; const LAS float* s = scr + (8 * c) * 33 + n;
        v4u o; o.x = pk2(s[0 * 33], s[1 * 33]); o.y = pk2(s[2 * 33], s[3 * 33]); o.z = pk2(s[4 * 33], s[5 * 33]); o.w = pk2(s[6 * 33], s[7 * 33]);
        *(v4u*)(WT + (size_t)(d0 + n) * K + k0 + 8 * c) = o; }
    asm volatile("s_waitcnt lgkmcnt(0)" ::: "memory");
}

__device__ __forceinline__ void phase_prep(const Args& a, LAS unsigned char* lds, int tid, int lane, int wave) {
    unsigned char* ws = a.ws;
    LAS float* scr = (LAS float*)(lds + wave * 16384);
    const int gw = blockIdx.x * 8 + wave, NGW = gridDim.x * 8;
    constexpr int I_IN = 16 * 104, I_OUT = 16 * 32, I_UP = 16 * 176, I_DN = 44 * 32;
    for (int it = gw; it < I_IN + I_OUT + I_UP + I_DN; it += NGW) {
        int r = it;
        if (r < I_IN) { transpose_item(a.in[2], NIN, DM, (bf16*)(ws + WS_WT_IN), a.in[1], scr, r, 104, lane); continue; } r -= I_IN;
        if (r < I_OUT) { transpose_item(a.in[19], DM, DM, (bf16*)(ws + WS_WT_OUT), nullptr, scr, r, 32, lane); continue; } r -= I_OUT;
        if (r < I_UP) { transpose_item<true>(a.in[21], NUP, DM, (bf16*)(ws + WS_WT_UP), a.in[20], scr, r, 176, lane); continue; } r -= I_UP;
        transpose_item(a.in[24], DM, DFF, (bf16*)(ws + WS_WT_DN), nullptr, scr, r, 32, lane);
    }
    {
        const float* wd = a.in[5]; const float* wa = a.in[7]; const float* wg = a.in[8]; bf16* WL = (bf16*)(ws + WS_WT_LORA);
        for (int idx = blockIdx.x * 512 + tid; idx < NLORA * KLORA; idx += gridDim.x * 512) {
            const int n = idx >> 8, k = idx & 255; float v = 0.f;
            if (n < 512) { if (k < 64) v = wd[k * 512 + n]; }
            else if (n < 1024) { if (k >= 64 && k < 128) v = wa[(k - 64) * 512 + (n - 512)]; }
            else { if (k >= 128) v = wg[(k - 128) * 512 + (n - 1024)]; }
            WL[idx] = (bf16)f2bf(v);
        }
    }
    {
        const float* x = a.in[0]; const float* g1 = a.in[1]; const float* w_in = a.in[2];
        bf16* XN = (bf16*)(ws + WS_XN); float* gates = (float*)(ws + WS_GATES);
        float wgt[16][8];
#pragma unroll
        for (int j = 0; j < 4; ++j)
#pragma unroll
            for (int e = 0; e < 4; ++e) { const int k = 4 * lane + 256 * j + e; const float g = g1[k];
                const f32x4 w0 = *(const f32x4*)(w_in + (size_t)k * NIN + 3328), w1 = *(const f32x4*)(w_in + (size_t)k * NIN + 3332);
                wgt[j * 4 + e][0] = w0[0] * g; wgt[j * 4 + e][1] = w0[1] * g; wgt[j * 4 + e][2] = w0[2] * g; wgt[j * 4 + e][3] = w0[3] * g;
                wgt[j * 4 + e][4] = w1[0] * g; wgt[j * 4 + e][5] = w1[1] * g; wgt[j * 4 + e][6] = w1[2] * g; wgt[j * 4 + e][7] = w1[3] * g; }
        for (int row0 = 2 * gw; row0 < M; row0 += 2 * NGW) {
            f32x4 v[2][4]; float ss[2] = {0.f, 0.f};
#pragma unroll
            for (int u = 0; u < 2; ++u) { const f32x4* xr = (const f32x4*)(x + (size_t)(row0 + u) * DM) + lane;
#pragma unroll
                for (int j = 0; j < 4; ++j) v[u][j] = xr[64 * j]; }
#pragma unroll
            for (int u = 0; u < 2; ++u)
#pragma unroll
                for (int j = 0; j < 4; ++j) ss[u] += (v[u][j][0] * v[u][j][0] + v[u][j][1] * v[u][j][1]) + (v[u][j][2] * v[u][j][2] + v[u][j][3] * v[u][j][3]);
#pragma unroll
            for (int u = 0; u < 2; ++u) { const int row = row0 + u;
                const float rs = frsq(wave_sum(ss[u]) * (1.0f / DM) + NORM_EPS);
                unsigned long long* o8 = (unsigned long long*)(XN + (size_t)row * DM) + lane;
#pragma unroll
                for (int j = 0; j < 4; ++j) o8[64 * j] = (unsigned long long)pk2(v[u][j][0] * rs, v[u][j][1] * rs) | ((unsigned long long)pk2(v[u][j][2] * rs, v[u][j][3] * rs) << 32);
                float gs[8];
#pragma unroll
                for (int jg = 0; jg < 8; ++jg) { float s_ = 0.f;
#pragma unroll
                    for (int j = 0; j < 4; ++j)
#pragma unroll
                        for (int e = 0; e < 4; ++e) s_ += v[u][j][e] * wgt[j * 4 + e][jg];
                    gs[jg] = wave_sum(s_); }
                if (lane < 8) { float s_ = gs[0];
#pragma unroll
                    for (int jg = 1; jg < 8; ++jg) s_ = (lane == jg) ? gs[jg] : s_;
                    gates[(size_t)row * 8 + lane] = s_ * rs; } }
        }
    }
}

__device__ __forceinline__ void phase_lmat(const Args& a, int tid) {
    unsigned char* ws = a.ws; const bf16* PROJ = (const bf16*)(ws + WS_PROJ); bf16* L = (bf16*)(ws + WS_LBUF); const float* mu = a.in[3];
    const int NT = gridDim.x * 512;
    for (int it = blockIdx.x * 512 + tid; it < M * 32; it += NT) {
        const int row = it >> 5, grp = it & 31, c0 = 1536 + 8 * grp;
        const v4u cur = *(const v4u*)(PROJ + (size_t)row * NPROJ + c0);
        v4u prv = {0u, 0u, 0u, 0u}; if ((row & (SEQ - 1)) != 0) prv = *(const v4u*)(PROJ + (size_t)(row - 1) * NPROJ + c0);
        const f32x4 m0 = *(const f32x4*)(mu + c0), m1 = *(const f32x4*)(mu + c0 + 4);
        float c[8], p[8], o[8]; unpack8(cur, c); unpack8(prv, p);
#pragma unroll
        for (int e = 0; e < 8; ++e) { const float mm = e < 4 ? m0[e & 3] : m1[e & 3]; const float xv = c[e] + (p[e] - c[e]) * mm;
            o[e] = grp < 8 ? tanhf_(xv) : (grp < 16 ? xv : sigmoidf_(xv)); }
        *(v4u*)(L + (size_t)row * KLORA + 8 * grp) = pack8(o);
    }
}

constexpr int RK_LD = 72, RK_SLOT = 64 * RK_LD;
__device__ __forceinline__ f32x4 mfma16(const bf16x8 a, const bf16x8 b, const f32x4 c) { return __builtin_amdgcn_mfma_f32_16x16x32_bf16(a, b, c, 0, 0, 0); }
__device__ __forceinline__ void rk_frag(bf16x8 (&f)[2], const LAS bf16* base, int row0, int l15, int l4) { const LAS bf16* p = base + (row0 + l15) * RK_LD + 8 * l4; f[0] = *(const LAS bf16x8*)p; f[1] = *(const LAS bf16x8*)(p + 32); }
template <bool ACC> __device__ __forceinline__ void rk_prod(f32x4 (&acc)[2], const LAS bf16* Aop, const LAS bf16* Bop, int mb, int nb0, int l15, int l4) {
    bf16x8 a[2]; rk_frag(a, Aop, 16 * mb, l15, l4);
#pragma unroll
    for (int q = 0; q < 2; ++q) { bf16x8 b[2]; rk_frag(b, Bop, 16 * (nb0 + q), l15, l4); f32x4 c = ACC ? acc[q] : (f32x4){0.f, 0.f, 0.f, 0.f}; c = mfma16(a[0], b[0], c); acc[q] = mfma16(a[1], b[1], c); }
}
__device__ __forceinline__ void rk_store(LAS bf16* dst, const f32x4 (&acc)[2], int mb, int nb0, int l15, int l4) {
#pragma unroll
    for (int q = 0; q < 2; ++q) { v2u w; w.x = pk2(acc[q][0], acc[q][1]); w.y = pk2(acc[q][2], acc[q][3]); *(LAS v2u*)(dst + (16 * (nb0 + q) + l15) * RK_LD + 16 * mb + 4 * l4) = w; }
}
__device__ __forceinline__ void rwkv_unit(const Args& a, LAS unsigned char* lds, int unit, int tid, int lane, int wave) {
    unsigned char* ws = a.ws; const bf16* PROJ = (const bf16*)(ws + WS_PROJ); const bf16* DAG = (const bf16*)(ws + WS_DAG); bf16* MIX = (bf16*)(ws + WS_MIX);
    const int b = unit >> 3, h = unit & 7;
    LAS bf16* slot = (LAS bf16*)lds;
#define RK_S(k) (slot + (k) * RK_SLOT)
    LAS bf16* Ab = RK_S(0); LAS bf16* Ut = RK_S(0); LAS bf16* Bb = RK_S(1); LAS bf16* Kb = RK_S(2); LAS bf16* Rb = RK_S(3); LAS bf16* KhT = RK_S(4); LAS float* Yl = (LAS float*)RK_S(3);
    LAS bf16* BhT = RK_S(5); LAS bf16* Vt = RK_S(6); LAS bf16* P0 = RK_S(7); LAS bf16* P0T = RK_S(8); LAS bf16* Aak = RK_S(9); LAS bf16* Arb = RK_S(10); LAS bf16* Ark = RK_S(11);
    LAS bf16* TA = RK_S(12); LAS bf16* TB = RK_S(13); LAS bf16* Xt = RK_S(14); LAS bf16* Sb = RK_S(15);
    LAS float* g63 = (LAS float*)RK_S(16); LAS float* bon = g63 + 64; LAS float* ssP = bon + 64; LAS float* bnP = ssP + 512; LAS float* cst = bnP + 512;
    const int l15 = lane & 15, l4 = lane >> 4, mb = wave & 3, nb0 = 2 * (wave >> 2);
    const int tt = tid >> 3, c8 = tid & 7;
    const int jw = 8 * wave;
    for (int i = tid; i < 640; i += 512) { const int k = i >> 6, c_ = i & 63, j = h * 64 + c_;
        const float* src = k == 0 ? a.in[3] + j : k == 1 ? a.in[3] + 512 + j : k == 2 ? a.in[3] + 1024 + j : k == 3 ? a.in[9] + j : k == 4 ? a.in[10] + j : k == 5 ? a.in[11] + j : k == 6 ? a.in[4] + j : k == 7 ? a.in[6] + j : k == 8 ? a.in[12] + j : a.in[13] + j;
        cst[i] = *src; }
    for (int i = tid; i < RK_SLOT / 2; i += 512) ((LAS unsigned*)Sb)[i] = 0u;
    f32x4 sacc[2], tacc[2], yacc[2];
    sacc[0] = (f32x4){0.f, 0.f, 0.f, 0.f}; sacc[1] = sacc[0];
    v4u g_rc, g_kc, g_vc, g_rp, g_kp, g_vp, g_ld, g_a, g_g;
    v4u pend = {0u, 0u, 0u, 0u}; bf16* pend_p = MIX;
#define RK_LOADCHUNK(c_) do { const int t_ = b * SEQ + (c_) * 64 + lane; const bf16* pr_ = PROJ + (size_t)t_ * NPROJ + h * 64 + jw; \
        g_rc = *(const v4u*)pr_; g_kc = *(const v4u*)(pr_ + 512); g_vc = *(const v4u*)(pr_ + 1024); \
        if ((c_) == 0 && lane == 0) { g_rp = (v4u){0u, 0u, 0u, 0u}; g_kp = g_rp; g_vp = g_rp; } \
        else { g_rp = *(const v4u*)(pr_ - NPROJ); g_kp = *(const v4u*)(pr_ - NPROJ + 512); g_vp = *(const v4u*)(pr_ - NPROJ + 1024); } \
        const bf16* dg_ = DAG + (size_t)t_ * NLORA + h * 64 + jw; g_ld = *(const v4u*)dg_; g_a = *(const v4u*)(dg_ + 512); \
        g_g = *(const v4u*)(DAG + (size_t)(b * SEQ + (c_) * 64 + tt) * NLORA + 1024 + h * 64 + 8 * c8); } while (0)
    RK_LOADCHUNK(0);
    LDS_BARRIER();
    for (int c = 0; c < SEQ / 64; ++c) {
        const int t0 = b * SEQ + c * 64;
        float rr[8], km[8], vv[8], av[8], lgw[8], kkr[8];
        asm volatile("" : "+v"(g_rc), "+v"(g_kc), "+v"(g_vc), "+v"(g_rp), "+v"(g_kp), "+v"(g_vp), "+v"(g_ld), "+v"(g_a), "+v"(g_g));
        {
            float rc[8], kc[8], vc[8], rp_[8], kp[8], vp[8], ldv[8];
            unpack8(g_rc, rc); unpack8(g_kc, kc); unpack8(g_vc, vc); unpack8(g_rp, rp_); unpack8(g_kp, kp); unpack8(g_vp, vp); unpack8(g_ld, ldv); unpack8(g_a, av);
            float ss = 0.f, bonus = 0.f;
#pragma unroll
            for (int e = 0; e < 8; ++e) { const int j = jw + e;
                rr[e] = rc[e] + (rp_[e] - rc[e]) * cst[j]; const float k = kc[e] + (kp[e] - kc[e]) * cst[64 + j]; vv[e] = vc[e] + (vp[e] - vc[e]) * cst[128 + j];
                kkr[e] = k * cst[192 + j]; ss += kkr[e] * kkr[e];
                av[e] = sigmoidf_(cst[448 + j] + av[e]);
                lgw[e] = -0.6065306597f * sigmoidf_(cst[384 + j] + ldv[e]);
                km[e] = k * (1.0f + (av[e] - 1.0f) * cst[256 + j]);
                bonus += rr[e] * km[e] * cst[320 + j]; }
            ssP[lane * 8 + wave] = ss; bnP[lane * 8 + wave] = bonus;
        }
        const v4u gcur = g_g;
        LDS_BARRIER();
        {
            const f32x4 s0 = *(const LAS f32x4*)(ssP + lane * 8), s1 = *(const LAS f32x4*)(ssP + lane * 8 + 4), b0 = *(const LAS f32x4*)(bnP + lane * 8), b1 = *(const LAS f32x4*)(bnP + lane * 8 + 4);
            const float ss = ((s0[0] + s0[1]) + (s0[2] + s0[3])) + ((s1[0] + s1[1]) + (s1[2] + s1[3]));
            if (wave == 0) bon[lane] = ((b0[0] + b0[1]) + (b0[2] + b0[3])) + ((b1[0] + b1[1]) + (b1[2] + b1[3]));
            const float inv = frcp(fmaxf(fsqrt_(ss), 1e-12f));
            float oA[8], oB[8], oK[8], oR[8], oBh[8], oKh[8];
#pragma unroll
            for (int e = 0; e < 8; ++e) { const float lw = wave_scan_add(lgw[e]); const float l63 = __builtin_bit_cast(float, __builtin_amdgcn_readlane(__builtin_bit_cast(int, lw), 63));
                const float eP = fexp(lw - lgw[e]), eM = fexp(-lw), eL = fexp(lw), e63 = fexp(l63), eH = e63 * eM;
                const float kk = kkr[e] * inv, bb = kk * av[e];
                oA[e] = -kk * eP; oB[e] = bb * eM; oK[e] = km[e] * eM; oR[e] = rr[e] * eL; oBh[e] = bb * eH; oKh[e] = km[e] * eH;
                if (lane == 63) g63[jw + e] = e63; }
            *(LAS v4u*)(Ab + lane * RK_LD + jw) = pack8(oA); *(LAS v4u*)(Bb + lane * RK_LD + jw) = pack8(oB); *(LAS v4u*)(Kb + lane * RK_LD + jw) = pack8(oK); *(LAS v4u*)(Rb + lane * RK_LD + jw) = pack8(oR);
#pragma unroll
            for (int e = 0; e < 8; ++e) { BhT[(jw + e) * RK_LD + lane] = (bf16)f2bf(oBh[e]); KhT[(jw + e) * RK_LD + lane] = (bf16)f2bf(oKh[e]); Vt[(jw + e) * RK_LD + lane] = (bf16)f2bf(vv[e]); }
            if (c > 0) *(v4u*)pend_p = pend;
            if (c + 1 < SEQ / 64) RK_LOADCHUNK(c + 1);
        }
        LDS_BARRIER();
        {
            f32x4 d[2];
#define RK_MASK_LT(D_, MISS_) _Pragma("unroll") for (int q = 0; q < 2; ++q) { const int nb_ = nb0 + q; \
                if (MISS_ ? (mb < nb_) : (mb > nb_)) D_[q] = (f32x4){0.f, 0.f, 0.f, 0.f}; \
                else if (mb == nb_) { _Pragma("unroll") for (int r = 0; r < 4; ++r) { const int m_ = 4 * l4 + r; D_[q][r] = (MISS_ ? (l15 < m_) : (m_ < l15)) ? D_[q][r] : 0.f; } } }
#define RK_MASK_LE(D_) _Pragma("unroll") for (int q = 0; q < 2; ++q) { const int nb_ = nb0 + q; \
                if (mb > nb_) D_[q] = (f32x4){0.f, 0.f, 0.f, 0.f}; \
                else if (mb == nb_) { _Pragma("unroll") for (int r = 0; r < 4; ++r) { const int m_ = 4 * l4 + r; D_[q][r] = (m_ <= l15) ? D_[q][r] : 0.f; } } }
            rk_prod<false>(d, Bb, Ab, mb, nb0, l15, l4);
            RK_MASK_LT(d, false);
#pragma unroll
            for (int q = 0; q < 2; ++q)
#pragma unroll
                for (int r = 0; r < 4; ++r) tacc[q][r] = d[q][r] + ((mb == nb0 + q && 4 * l4 + r == l15) ? 1.f : 0.f);
            rk_store(P0, d, mb, nb0, l15, l4); rk_store(TA, tacc, mb, nb0, l15, l4);
            rk_prod<false>(d, Ab, Bb, mb, nb0, l15, l4);
            RK_MASK_LT(d, true);
            rk_store(P0T, d, mb, nb0, l15, l4);
            rk_prod<false>(d, Kb, Ab, mb, nb0, l15, l4);
            RK_MASK_LT(d, false);
            rk_store(Aak, d, mb, nb0, l15, l4);
            rk_prod<false>(d, Bb, Rb, mb, nb0, l15, l4);
            RK_MASK_LE(d);
            rk_store(Arb, d, mb, nb0, l15, l4);
            rk_prod<false>(d, Kb, Rb, mb, nb0, l15, l4);
            RK_MASK_LE(d);
            rk_store(Ark, d, mb, nb0, l15, l4);
        }
        LDS_BARRIER();
        {
            f32x4 d[2];
            rk_prod<false>(d, P0T, P0, mb, nb0, l15, l4); rk_store(Bb  , d, mb, nb0, l15, l4);
            rk_prod<false>(d, P0, P0T, mb, nb0, l15, l4); rk_store(Kb  , d, mb, nb0, l15, l4);
            rk_prod<false>(d, Ab, Sb, mb, nb0, l15, l4); rk_prod<true>(d, Aak, Vt, mb, nb0, l15, l4); rk_store(Xt, d, mb, nb0, l15, l4);
            rk_prod<false>(yacc, Sb, Rb, mb, nb0, l15, l4); rk_prod<true>(yacc, Vt, Ark, mb, nb0, l15, l4);
#pragma unroll
            for (int r = 0; r < 4; ++r) { const float g_ = g63[16 * mb + 4 * l4 + r]; sacc[0][r] *= g_; sacc[1][r] *= g_; }
            rk_prod<true>(sacc, KhT, Vt, mb, nb0, l15, l4);
        }
        LDS_BARRIER();
        { rk_prod<true>(tacc, Kb, TA, mb, nb0, l15, l4); rk_store(TB, tacc, mb, nb0, l15, l4);
          f32x4 d[2]; rk_prod<false>(d, Kb, Bb, mb, nb0, l15, l4); rk_store(P0, d, mb, nb0, l15, l4); rk_prod<false>(d, Bb, Kb, mb, nb0, l15, l4); rk_store(P0T, d, mb, nb0, l15, l4); }
        LDS_BARRIER();
        { rk_prod<true>(tacc, P0T, TB, mb, nb0, l15, l4); rk_store(TA, tacc, mb, nb0, l15, l4);
          f32x4 d[2]; rk_prod<false>(d, P0T, P0, mb, nb0, l15, l4); rk_store(Bb, d, mb, nb0, l15, l4); rk_prod<false>(d, P0, P0T, mb, nb0, l15, l4); rk_store(Kb, d, mb, nb0, l15, l4); }
        LDS_BARRIER();
        { rk_prod<true>(tacc, Kb, TA, mb, nb0, l15, l4); rk_store(TB, tacc, mb, nb0, l15, l4);
          f32x4 d[2]; rk_prod<false>(d, Kb, Bb, mb, nb0, l15, l4); rk_store(P0, d, mb, nb0, l15, l4); rk_prod<false>(d, Bb, Kb, mb, nb0, l15, l4); rk_store(P0T, d, mb, nb0, l15, l4); }
        LDS_BARRIER();
        { rk_prod<true>(tacc, P0T, TB, mb, nb0, l15, l4); rk_store(TA, tacc, mb, nb0, l15, l4);
          f32x4 d[2]; rk_prod<false>(d, P0, P0T, mb, nb0, l15, l4); rk_store(Kb  , d, mb, nb0, l15, l4); }
        LDS_BARRIER();
        { rk_prod<true>(tacc, Kb, TA, mb, nb0, l15, l4); rk_store(TB, tacc, mb, nb0, l15, l4); }
        LDS_BARRIER();
        { f32x4 d[2]; rk_prod<false>(d, TB, Xt, mb, nb0, l15, l4); rk_store(Ut, d, mb, nb0, l15, l4); }
        LDS_BARRIER();
        {
            rk_prod<true>(yacc, Ut, Arb, mb, nb0, l15, l4);
#pragma unroll
            for (int q = 0; q < 2; ++q) *(LAS f32x4*)(Yl + (16 * (nb0 + q) + l15) * 68 + 16 * mb + 4 * l4) = yacc[q];
            rk_prod<true>(sacc, BhT, Ut, mb, nb0, l15, l4); rk_store(Sb, sacc, mb, nb0, l15, l4);
        }
        LDS_BARRIER();
        {
            const int t = t0 + tt, j0 = 8 * c8;
            const f32x4 y0 = *(const LAS f32x4*)(Yl + tt * 68 + j0), y1 = *(const LAS f32x4*)(Yl + tt * 68 + j0 + 4);
            float y[8] = {y0[0], y0[1], y0[2], y0[3], y1[0], y1[1], y1[2], y1[3]}, gv[8]; float s1 = 0.f;
#pragma unroll
            for (int e = 0; e < 8; ++e) s1 += y[e];
            s1 = red8(s1); const float mean = s1 * (1.0f / 64.0f); float s2 = 0.f;
#pragma unroll
            for (int e = 0; e < 8; ++e) { const float dd = y[e] - mean; s2 += dd * dd; }
            s2 = red8(s2); const float rstd = frsq(s2 * (1.0f / 64.0f) + LNX_EPS);
            unpack8(gcur, gv);
            const float bonus = bon[tt]; float ov[8];
#pragma unroll
            for (int e = 0; e < 8; ++e) { const float yn = (y[e] - mean) * rstd * cst[512 + j0 + e] + cst[576 + j0 + e]; ov[e] = (yn + bonus * bf2f(Vt[(j0 + e) * RK_LD + tt])) * gv[e]; }
            pend = pack8(ov); pend_p = MIX + (size_t)t * DM + h * 64 + j0;
        }
        LDS_BARRIER();
    }
    *(v4u*)pend_p = pend;
#undef RK_S
#undef RK_LOADCHUNK
}

__device__ __forceinline__ void mlstm_unit(const Args& a, LAS unsigned char* lds, int unit, int tid, int lane, int wave) {
    unsigned char* ws = a.ws; const bf16* PROJ = (const bf16*)(ws + WS_PROJ); const float* gates = (const float*)(ws + WS_GATES); bf16* MIX = (bf16*)(ws + WS_MIX);
    const float* cw = a.in[14]; const float* cbias = a.in[15]; const float* i_bias = a.in[16]; const float* f_bias = a.in[17]; const float* mhg = a.in[18];
    const int b = unit >> 2, hm = unit & 3;
    constexpr int LD = 72;
    LAS bf16* Ql = (LAS bf16*)lds; LAS bf16* Kl = Ql + 64 * LD; LAS bf16* Kwt = Kl + 64 * LD; LAS bf16* Vt = Kwt + 64 * LD; LAS bf16* Sm = Vt + 128 * LD; LAS bf16* Ct = Sm + 64 * LD;
    LAS float* Hl = (LAS float*)(Ct + 128 * LD);
    LAS float* e_s = Hl + 64 * 132; LAS float* Mx = e_s + 64; LAS float* sc = Mx + 64; LAS float* em = sc + 64; LAS float* wsv = em + 64; LAS float* den = wsv + 64; LAS float* nvec = den + 64; LAS float* scal = nvec + 64;
    for (int i = tid; i < 128 * LD / 2; i += 512) ((LAS unsigned*)Ct)[i] = 0u;
    if (tid < 64) nvec[tid] = 0.f;
    if (tid == 0) { scal[0] = 1.f; scal[1] = 0.f; }
    f32x4 cacc[4];
#pragma unroll
    for (int i = 0; i < 4; ++i) cacc[i] = (f32x4){0.f, 0.f, 0.f, 0.f};
    const int l15 = lane & 15, l4 = lane >> 4;
    const int tt = tid >> 3, p8 = tid & 7;
    LAS float* cwl = scal + 16; LAS float* cbl = cwl + 512;
    for (int i = tid; i < 640; i += 512) { const int j = i >> 7, c_ = i & 127; const int src = (c_ < 64) ? (hm * 64 + c_) : (256 + hm * 64 + (c_ - 64)); if (j < 4) cwl[i] = cw[j * 512 + src]; else cbl[c_] = cbias[src]; }
    const float ibias = i_bias[hm], fbias = f_bias[hm];
    v4u n_q[4], n_k[4], n_va, n_vb, n_oa, n_ob; float n_gi = 0.f, n_gf = 0.f;
#define ML_LOADCHUNK(c_) do { const int t_ = b * SEQ + (c_) * 64 + lane; const int tp_ = (c_) * 64 + lane; \
        _Pragma("unroll") for (int j = 0; j < 4; ++j) { if (tp_ - 3 + j >= 0) { const bf16* pr_ = PROJ + (size_t)(t_ - 3 + j) * NPROJ + hm * 64 + 8 * wave; n_q[j] = *(const v4u*)(pr_ + C_Q); n_k[j] = *(const v4u*)(pr_ + C_K); } \
                                                       else { n_q[j] = (v4u){0u, 0u, 0u, 0u}; n_k[j] = (v4u){0u, 0u, 0u, 0u}; } } \
        { const bf16* pv_ = PROJ + (size_t)t_ * NPROJ + C_V + hm * 128 + 16 * wave; n_va = *(const v4u*)pv_; n_vb = *(const v4u*)(pv_ + 8); \
          const bf16* po_ = PROJ + (size_t)(b * SEQ + (c_) * 64 + tt) * NPROJ + C_O + hm * 128 + 16 * p8; n_oa = *(const v4u*)po_; n_ob = *(const v4u*)(po_ + 8); } \
        n_gi = gates[(size_t)t_ * 8 + hm]; n_gf = gates[(size_t)t_ * 8 + 4 + hm]; } while (0)
    ML_LOADCHUNK(0);
    LDS_BARRIER();
    float m_run = 0.f;
    v4u pend0 = {0u, 0u, 0u, 0u}, pend1 = pend0; bf16* pend_p = MIX;
    for (int c = 0; c < SEQ / 64; ++c) {
        const int t0 = b * SEQ + c * 64;
        asm volatile("" : "+v"(n_q[0]), "+v"(n_q[1]), "+v"(n_q[2]), "+v"(n_q[3]), "+v"(n_k[0]), "+v"(n_k[1]), "+v"(n_k[2]), "+v"(n_k[3]), "+v"(n_va), "+v"(n_vb), "+v"(n_oa), "+v"(n_ob), "+v"(n_gi), "+v"(n_gf));
        float dec;
        v4u c_oa, c_ob;
        {
            const float gi = n_gi + ibias, gf = n_gf + fbias;
            const float ig = 15.0f * tanhf_(gi * (1.0f / 15.0f)), fx = 15.0f * tanhf_(gf * (1.0f / 15.0f));
            const float logf = -(fmaxf(-fx, 0.f) + __logf(1.0f + fexp(-fabsf(fx))));
            const float bc = wave_scan_add(logf);
            const float e = ig - bc; const float P = wave_scan_max(e);
            const float mx = fmaxf(P, m_run);
            const float mxL = __builtin_bit_cast(float, __builtin_amdgcn_readlane(__builtin_bit_cast(int, mx), 63)), bL = __builtin_bit_cast(float, __builtin_amdgcn_readlane(__builtin_bit_cast(int, bc), 63));
            if (wave == 0) { e_s[lane] = e; Mx[lane] = mx; sc[lane] = fexp(m_run - mx); em[lane] = fexp(-(bc + mx)); }
            const float w = fexp(e - mxL);
            dec = fexp(m_run - mxL); m_run = bL + mxL;
            const int d0 = 8 * wave;
            float aq[8], ak[8];
#pragma unroll
            for (int e_ = 0; e_ < 8; ++e_) { aq[e_] = cbl[d0 + e_]; ak[e_] = cbl[64 + d0 + e_]; }
#pragma unroll
            for (int j = 0; j < 4; ++j) { float pq[8], pk[8]; unpack8(n_q[j], pq); unpack8(n_k[j], pk);
#pragma unroll
                for (int e_ = 0; e_ < 8; ++e_) { aq[e_] += cwl[j * 128 + d0 + e_] * pq[e_]; ak[e_] += cwl[j * 128 + 64 + d0 + e_] * pk[e_]; } }
#pragma unroll
            for (int e_ = 0; e_ < 8; ++e_) { aq[e_] = aq[e_] * sigmoidf_(aq[e_]) * 0.125f; ak[e_] = ak[e_] * sigmoidf_(ak[e_]); }
            *(LAS v4u*)(Ql + lane * LD + d0) = pack8(aq); *(LAS v4u*)(Kl + lane * LD + d0) = pack8(ak);
#pragma unroll
            for (int e_ = 0; e_ < 8; ++e_) Kwt[(d0 + e_) * LD + lane] = (bf16)f2bf(w * ak[e_]);
            const unsigned wv[8] = {n_va.x, n_va.y, n_va.z, n_va.w, n_vb.x, n_vb.y, n_vb.z, n_vb.w};
#pragma unroll
            for (int e_ = 0; e_ < 8; ++e_) { Vt[(16 * wave + 2 * e_) * LD + lane] = (bf16)(wv[e_] & 0xffffu); Vt[(16 * wave + 2 * e_ + 1) * LD + lane] = (bf16)(wv[e_] >> 16); }
            c_oa = n_oa; c_ob = n_ob;
            if (c > 0) { *(v4u*)pend_p = pend0; *(v4u*)(pend_p + 8) = pend1; }
            if (c + 1 < SEQ / 64) ML_LOADCHUNK(c + 1);
        }
        LDS_BARRIER();
        {
            const int rb = wave >> 1;
#pragma unroll
            for (int ci = 0; ci < 2; ++ci) { const int cb = 2 * (wave & 1) + ci; f32x4 acc = {0.f, 0.f, 0.f, 0.f};
#pragma unroll
                for (int kk = 0; kk < 2; ++kk) { const bf16x8 A = *(const LAS bf16x8*)(Ql + (16 * rb + l15) * LD + 32 * kk + 8 * l4), B = *(const LAS bf16x8*)(Kl + (16 * cb + l15) * LD + 32 * kk + 8 * l4); acc = mfma16(A, B, acc); }
                const int s_ = 16 * cb + l15; const float es = e_s[s_];
#pragma unroll
                for (int r = 0; r < 4; ++r) { const int t = 16 * rb + 4 * l4 + r; const float v = (s_ <= t) ? acc[r] * fexp(es - Mx[t]) : 0.f; Sm[t * LD + s_] = (bf16)f2bf(v); } }
        }
        LDS_BARRIER();
        {
            float part = 0.f, qn = 0.f; float sv[8], qv[8];
            unpack8(*(const LAS v4u*)(Sm + tt * LD + 8 * p8), sv); unpack8(*(const LAS v4u*)(Ql + tt * LD + 8 * p8), qv);
#pragma unroll
            for (int e_ = 0; e_ < 8; ++e_) { part += sv[e_]; qn += qv[e_] * nvec[8 * p8 + e_]; }
            float tot = part + sc[tt] * qn; tot = red8(tot);
            if (p8 == 0) den[tt] = tot;
            const int rb = wave >> 1;
            bf16x8 As[2], Aq[2];
#pragma unroll
            for (int kk = 0; kk < 2; ++kk) { As[kk] = *(const LAS bf16x8*)(Sm + (16 * rb + l15) * LD + 32 * kk + 8 * l4); Aq[kk] = *(const LAS bf16x8*)(Ql + (16 * rb + l15) * LD + 32 * kk + 8 * l4); }
            float scr_[4];
#pragma unroll
            for (int r = 0; r < 4; ++r) scr_[r] = sc[16 * rb + 4 * l4 + r];
#pragma unroll
            for (int vi = 0; vi < 4; ++vi) { const int vb = 4 * (wave & 1) + vi; f32x4 a1 = {0.f, 0.f, 0.f, 0.f}, a2 = {0.f, 0.f, 0.f, 0.f};
#pragma unroll
                for (int kk = 0; kk < 2; ++kk) { const bf16x8 B1 = *(const LAS bf16x8*)(Vt + (16 * vb + l15) * LD + 32 * kk + 8 * l4), B2 = *(const LAS bf16x8*)(Ct + (16 * vb + l15) * LD + 32 * kk + 8 * l4);
                    a1 = mfma16(As[kk], B1, a1); a2 = mfma16(Aq[kk], B2, a2); }
#pragma unroll
                for (int r = 0; r < 4; ++r) Hl[(16 * rb + 4 * l4 + r) * 132 + 16 * vb + l15] = a1[r] + scr_[r] * a2[r]; }
        }
        LDS_BARRIER();
        {
            bf16x8 Av[2];
#pragma unroll
            for (int kk = 0; kk < 2; ++kk) Av[kk] = *(const LAS bf16x8*)(Vt + (16 * wave + l15) * LD + 32 * kk + 8 * l4);
#pragma unroll
            for (int db = 0; db < 4; ++db) { cacc[db] = cacc[db] * dec;
#pragma unroll
                for (int kk = 0; kk < 2; ++kk) { const bf16x8 B = *(const LAS bf16x8*)(Kwt + (16 * db + l15) * LD + 32 * kk + 8 * l4); cacc[db] = mfma16(Av[kk], B, cacc[db]); }
#pragma unroll
                for (int r = 0; r < 4; ++r) Ct[(16 * wave + 4 * l4 + r) * LD + 16 * db + l15] = (bf16)f2bf(cacc[db][r]); }
            float kv[8]; unpack8(*(const LAS v4u*)(Kwt + tt * LD + 8 * p8), kv); float s_ = 0.f;
#pragma unroll
            for (int e_ = 0; e_ < 8; ++e_) s_ += kv[e_];
            s_ = red8(s_);
            if (p8 == 0) nvec[tt] = dec * nvec[tt] + s_;
        }
        {
            const int t = t0 + tt, v0 = 16 * p8; float hv[16]; float ss = 0.f;
            const float dn = frcp(fmaxf(fabsf(den[tt]), em[tt]));
#pragma unroll
            for (int q = 0; q < 4; ++q) { const f32x4 x = *(const LAS f32x4*)(Hl + tt * 132 + v0 + 4 * q) * dn; hv[4 * q] = x[0]; hv[4 * q + 1] = x[1]; hv[4 * q + 2] = x[2]; hv[4 * q + 3] = x[3]; ss += (x[0] * x[0] + x[1] * x[1]) + (x[2] * x[2] + x[3] * x[3]); }
            ss = red8(ss); const float rn = frsq(ss * (1.0f / 128.0f) + NORM_EPS);
            float o0[8], o1[8]; unpack8(c_oa, o0); unpack8(c_ob, o1);
            float r0[8], r1[8];
#pragma unroll
            for (int e_ = 0; e_ < 8; ++e_) { r0[e_] = hv[e_] * rn * mhg[hm * 128 + v0 + e_] * sigmoidf_(o0[e_]); r1[e_] = hv[8 + e_] * rn * mhg[hm * 128 + v0 + 8 + e_] * sigmoidf_(o1[e_]); }
            pend_p = MIX + (size_t)t * DM + 512 + hm * 128 + v0; pend0 = pack8(r0); pend1 = pack8(r1);
        }
        LDS_BARRIER();
    }
    *(v4u*)pend_p = pend0; *(v4u*)(pend_p + 8) = pend1;
#undef ML_LOADCHUNK
}

__device__ __forceinline__ void phase_ffn_fix(const Args& a, int tid) {
    unsigned char* ws = a.ws; const float* SA = (const float*)(ws + WS_SIDE); const float* SB = SA + SIDE_ELEMS; const float* SL = SB + SIDE_ELEMS; bf16* GB = (bf16*)(ws + WS_GB);
    const float* cw = a.in[22]; const float* cb = a.in[23];
    const int NT = gridDim.x * 512;
    for (int it = blockIdx.x * 512 + tid; it < SIDE_ELEMS; it += NT) {
        const int ch = it & 127, r = (it >> 7) & 1, tile = it >> 8, pm = tile / 22, pn = tile % 22;
        const int base = tile * 256;
        float l0 = 0.f, l1 = 0.f;
        if ((pm & 7) != 0) { const int lb = (tile - 22) * 256; l0 = SL[lb + ch]; l1 = SL[lb + 128 + ch]; }
        const float a_r = SA[base + r * 128 + ch], b_r = SB[base + r * 128 + ch];
        const float am1 = r == 0 ? l1 : SA[base + ch], am2 = r == 0 ? l0 : l1;
        const int f = pn * 128 + ch;
        const float z = cb[f] + cw[f] * am2 + cw[DFF + f] * am1 + cw[2 * DFF + f] * a_r;
        GB[(size_t)(pm * 256 + r) * DFF + f] = (bf16)f2bf(z * sigmoidf_(z) * b_r);
    }
}
__device__ __forceinline__ void phase_final(const Args& a, int lane, int wave) {
    const bf16* FF = (const bf16*)(a.ws + WS_FF); const float* gf = a.in[25];
    f32x4 gv[4];
#pragma unroll
    for (int j = 0; j < 4; ++j) gv[j] = *((const f32x4*)gf + lane + 64 * j);
    const int NGW = gridDim.x * 8;
#ifdef PROBE
    const unsigned long long* tstamps = (const unsigned long long*)(a.ws + WS_CTL + 512 * 1024);
    const float fa = fminf(fmaxf((float)(long long)(tstamps[PROBE_A_TO] - tstamps[PROBE_A_FROM]) * (0.01f / PROBE_A_SCALE_US), 0.f), 1.f);
    const float pscale = 1.0f + sqrtf(fa * 0.8e-4f);
#pragma unroll
    for (int j = 0; j < 4; ++j) gv[j] = gv[j] * pscale;
#endif
    for (int row0 = 2 * (blockIdx.x * 8 + wave); row0 < M; row0 += 2 * NGW) {
        f32x4 v[2][4]; v2u f[2][4];
#pragma unroll
        for (int u = 0; u < 2; ++u) { const f32x4* xr = (const f32x4*)(a.out + (size_t)(row0 + u) * DM) + lane; const v2u* fr_ = (const v2u*)(FF + (size_t)(row0 + u) * DM) + lane;
#pragma unroll
            for (int j = 0; j < 4; ++j) { v[u][j] = xr[64 * j]; f[u][j] = fr_[64 * j]; } }
#pragma unroll
        for (int u = 0; u < 2; ++u) { float ss = 0.f;
#pragma unroll
            for (int j = 0; j < 4; ++j) { v[u][j][0] += bflo(f[u][j].x); v[u][j][1] += bfhi(f[u][j].x); v[u][j][2] += bflo(f[u][j].y); v[u][j][3] += bfhi(f[u][j].y);
                ss += (v[u][j][0] * v[u][j][0] + v[u][j][1] * v[u][j][1]) + (v[u][j][2] * v[u][j][2] + v[u][j][3] * v[u][j][3]); }
            const float rs = frsq(wave_sum(ss) * (1.0f / DM) + NORM_EPS);
            f32x4* xr = (f32x4*)(a.out + (size_t)(row0 + u) * DM) + lane;
#pragma unroll
            for (int j = 0; j < 4; ++j) xr[64 * j] = v[u][j] * rs * gv[j]; }
    }
}

constexpr int N_PHASES = 10;
__global__ void __launch_bounds__(512, 2) mega(Args args) {
    extern __shared__ __attribute__((aligned(16))) unsigned char lds_raw[];
    LAS unsigned char* lds = (LAS unsigned char*)lds_raw;
    const int tid0 = threadIdx.x;
    unsigned char* ws = args.ws;
#define PHASE_IDS int tid = tid0; asm volatile("" : "+v"(tid)); const int lane = tid & 63, wave = __builtin_amdgcn_readfirstlane(tid >> 6); (void)lane; (void)wave
    volatile LAS unsigned* MISC = (volatile LAS unsigned*)(lds + MISC_OFF);
    { PHASE_IDS; for (int u = tid; u < (LDS_BYTES - 131072) / 4; u += 512) ((LAS unsigned*)(lds + 131072))[u] = 0u; }
    __syncthreads();
    XcdBarrier bar; bar.bar = (unsigned*)(ws + WS_CTL) + 4096; bar.x = 0; bar.st = nullptr;
    if (MK_SINGLE) bar = xcd_barrier_post((unsigned*)(ws + WS_CTL) + 4096, MISC + 8);
    const int lo = args.ph_lo, hi = args.ph_hi;
#ifndef PH_MASK
#define PH_MASK 0xFFFF
#endif
#define IN(k) ((((PH_MASK) >> (k)) & 1) && lo <= (k) && (k) < hi)
#ifdef PROBE
    unsigned long long* const tstamps = (unsigned long long*)(ws + WS_CTL + 512 * 1024);
#define STAMP(k) do { if (blockIdx.x == 0 && tid0 == 0) tstamps[(k)] = __builtin_amdgcn_s_memrealtime(); } while (0)
#else
#define STAMP(k) do { } while (0)
#endif
    STAMP(0);
#define SEAM(k) do { if (IN(k) && IN((k) + 1)) xcd_barrier(bar); STAMP((k) + 1); } while (0)

    if (IN(0)) { PHASE_IDS; phase_prep(args, lds, tid, lane, wave); } SEAM(0);
    if (IN(1)) {
        pg8::Gemm g{(const bf16*)(ws + WS_XN), (const bf16*)(ws + WS_WT_IN), M, NPROJ, opaque_i(DM)}; pg8::StaticOrder S; S.init(M, NPROJ, gridDim.x, (int)blockIdx.x);
        pg8::EpiBf16<0> E{(bf16*)(ws + WS_PROJ), NPROJ, nullptr, 0, 0, 1.f};
        pg8::gemm_phase<pg8::EpiBf16<0>, pg8::StaticOrder, true, true>(lds, g, S, E);
    } SEAM(1);
    if (IN(2)) { PHASE_IDS; phase_lmat(args, tid); } SEAM(2);
    if (IN(3)) {
        pg8::Gemm g{(const bf16*)(ws + WS_LBUF), (const bf16*)(ws + WS_WT_LORA), M, NLORA, opaque_i(KLORA)}; pg8::StaticOrder S; S.init(M, NLORA, gridDim.x, (int)blockIdx.x);
        pg8::EpiBf16<0> E{(bf16*)(ws + WS_DAG), NLORA, nullptr, 0, 0, 1.f};
        pg8::gemm_phase<pg8::EpiBf16<0>, pg8::StaticOrder, true, true>(lds, g, S, E);
    } SEAM(3);
    if (IN(4)) {
        PHASE_IDS;
        for (int u = blockIdx.x; u < BATCH * 8; u += gridDim.x) rwkv_unit(args, lds, u, tid, lane, wave);
        __syncthreads();
        STAMP(12);
#ifdef PROBE
        if (tid0 == 0) atomicMax(&tstamps[13], (unsigned long long)__builtin_amdgcn_s_memrealtime());
#endif
        for (int u = blockIdx.x; u < BATCH * 4; u += gridDim.x) mlstm_unit(args, lds, u, tid, lane, wave);
    } SEAM(4);
    if (IN(5)) {
        pg8::Gemm g{(const bf16*)(ws + WS_MIX), (const bf16*)(ws + WS_WT_OUT), M, DM, opaque_i(DM)}; pg8::StaticOrder S; S.init(M, DM, gridDim.x, (int)blockIdx.x);
        pg8::EpiResid E{args.in[0], args.out, (bf16*)(ws + WS_XN), (float*)(ws + WS_SSQP)};
        pg8::gemm_phase<pg8::EpiResid, pg8::StaticOrder, true, true>(lds, g, S, E);
    } SEAM(5);
    if (IN(6)) {
        pg8::Gemm g{(const bf16*)(ws + WS_XN), (const bf16*)(ws + WS_WT_UP), M, NUP, opaque_i(DM)}; pg8::StaticOrder S; S.init(M, NUP, gridDim.x, (int)blockIdx.x);
        float* side = (float*)(ws + WS_SIDE); float* rs2 = (float*)(ws + WS_RS2);
        {
            PHASE_IDS; pg8::Unit u;
            for (int i = 0; S.next(i, u); ++i) if (tid < 256) { const int row = u.pm * 256 + tid; const f32x4* p = (const f32x4*)((const float*)(ws + WS_SSQP) + (size_t)row * 16); const f32x4 s0 = p[0], s1 = p[1], s2 = p[2], s3 = p[3];
                const float ss = ((s0[0] + s0[1]) + (s0[2] + s0[3])) + ((s1[0] + s1[1]) + (s1[2] + s1[3])) + ((s2[0] + s2[1]) + (s2[2] + s2[3])) + ((s3[0] + s3[1]) + (s3[2] + s3[3]));
                rs2[row] = frsq(ss * (1.0f / DM) + NORM_EPS); }
            asm volatile("s_waitcnt vmcnt(0)" ::: "memory"); __syncthreads();
        }
        pg8::EpiFfn E{(bf16*)(ws + WS_GB), rs2, args.in[22], args.in[23], side, side + SIDE_ELEMS, side + 2 * SIDE_ELEMS, (LAS float*)(lds + 131072 + 1024)};
        pg8::gemm_phase<pg8::EpiFfn, pg8::StaticOrder, true, true>(lds, g, S, E);
    } SEAM(6);
    if (IN(7)) { PHASE_IDS; phase_ffn_fix(args, tid); } SEAM(7);
    if (IN(8)) {
        pg8::Gemm g{(const bf16*)(ws + WS_GB), (const bf16*)(ws + WS_WT_DN), M, DM, opaque_i(DFF)}; pg8::StaticOrder S; S.init(M, DM, gridDim.x, (int)blockIdx.x);
        pg8::EpiBf16<0> E{(bf16*)(ws + WS_FF), DM, nullptr, 0, 0, 1.f};
        pg8::gemm_phase<pg8::EpiBf16<0>, pg8::StaticOrder, true, true>(lds, g, S, E);
    } SEAM(8);
#ifdef PROBE
    xcd_barrier(bar);
#endif
    if (IN(9)) { PHASE_IDS; phase_final(args, lane, wave); }
#undef IN
#undef SEAM
}

extern "C" void kernel_launch(void* const* d_in, const int* in_sizes, int n_in, void* d_out, int out_size, void* d_ws, size_t ws_size, hipStream_t stream) {
    static int grid = 0;
    if (grid == 0) {
        if (n_in != 26 || in_sizes[0] != M * DM || out_size != M * DM || ws_size < WS_END) { fprintf(stderr, "kernel_launch: unexpected shapes (n_in %d, in0 %d, out %d, ws %zu)\n", n_in, n_in > 0 ? in_sizes[0] : -1, out_size, ws_size); grid = -1; return; }
        int dev = 0, cus = 0, per_cu = 0;
        if (hipGetDevice(&dev) != hipSuccess || hipDeviceGetAttribute(&cus, hipDeviceAttributeMultiprocessorCount, dev) != hipSuccess) { grid = -1; return; }
        if (hipFuncSetAttribute((const void*)mega, hipFuncAttributeMaxDynamicSharedMemorySize, LDS_BYTES) != hipSuccess) { fprintf(stderr, "kernel_launch: hipFuncSetAttribute failed\n"); grid = -1; return; }
        if (hipOccupancyMaxActiveBlocksPerMultiprocessor(&per_cu, (const void*)mega, 512, LDS_BYTES) != hipSuccess || per_cu < 1) { fprintf(stderr, "kernel_launch: occupancy query says %d blocks per CU\n", per_cu); }
        (void)hipGetLastError();
        grid = cus;
        if (grid != 256) fprintf(stderr, "kernel_launch: %d CUs; this kernel is laid out for 256\n", grid);
    }
    if (grid < 0) return;
    (void)hipMemsetAsync((char*)d_ws + WS_CTL, 0, CTL_ZERO_BYTES, stream);
    Args a{};
    for (int i = 0; i < 26; ++i) a.in[i] = (const float*)d_in[i];
    a.out = (float*)d_out; a.ws = (unsigned char*)d_ws;
#if MK_SINGLE
    a.ph_lo = 0; a.ph_hi = N_PHASES;
    hipLaunchKernelGGL(mega, dim3(grid), dim3(512), LDS_BYTES, stream, a);
#else
    for (int p = 0; p < N_PHASES; ++p) { a.ph_lo = p; a.ph_hi = p + 1; hipLaunchKernelGGL(mega, dim3(grid), dim3(512), LDS_BYTES, stream, a); }
#endif
}
```

```cpp
#include <hip/hip_runtime.h>
#include <cstdio>
#include <cstdint>
namespace pg8 {
#define PG8_LAS __attribute__((address_space(3)))
typedef unsigned short bf16_t;
typedef short bf16x8 __attribute__((ext_vector_type(8)));
typedef float f32x4 __attribute__((ext_vector_type(4)));
typedef unsigned u32x4 __attribute__((ext_vector_type(4)));
constexpr int BM = 256, BK = 64, HALF = 128, HTB = HALF * BK * 2  , STAGE_BYTES = 8 * HTB, NXCD = 8, WGM = 8;

__host__ __device__ __forceinline__ int lds_byte(int r, int c) { const int st = (r >> 4) * 2 + (c >> 5), rr = r & 15, cc = c & 31, ob = rr * 64 + cc * 2; return st * 1024 + (ob ^ (((ob >> 9) & 1) << 5)); }
__host__ __device__ __forceinline__ void stage_rc(int b, int& R, int& C) { const int st = b / 1024, sb = b % 1024, swz = sb ^ (((sb >> 9) & 1) << 5); R = (st >> 1) * 16 + swz / 64; C = (st & 1) * 32 + (swz % 64) / 2; }
__host__ __device__ __forceinline__ int perm32(int rho) { const int n = rho >> 4, i = rho & 15; return 8 * (i >> 2) + 4 * n + (i & 3); }

struct Unit { int pm, pn; };
struct Gemm { const bf16_t* A; const bf16_t* Bt; int M, N, K; };

struct StaticOrder {
    int nM, nN, nwg, G, c;
    __host__ __device__ void init(int M, int N, int G_, int c_) { nM = M / BM; nN = N / BM; nwg = nM * nN; G = G_; c = c_; }
    __host__ __device__ bool next(int i, Unit& u) const {
        const long L = (long)i * G + c; if (L >= nwg) return false;
        int wgid = (int)L; { const int q = nwg / NXCD, r = nwg % NXCD, xcd = wgid % NXCD, off = wgid / NXCD; wgid = (xcd < r ? xcd * (q + 1) : r * (q + 1) + (xcd - r) * q) + off; }
        const int nig = WGM * nN, gid = wgid / nig, fm = gid * WGM, gsz = (nM - fm) < WGM ? (nM - fm) : WGM;
        u.pm = fm + ((wgid % nig) % gsz); u.pn = (wgid % nig) / gsz; return true;
    }
    __device__ __forceinline__ void a_ready(const Unit&) const {}
    __device__ __forceinline__ void done(const Unit&) const {}
};

__device__ __forceinline__ unsigned cvt_pk_bf16(float lo, float hi) { unsigned r; asm volatile("v_cvt_pk_bf16_f32 %0, %1, %2" : "=v"(r) : "v"(lo), "v"(hi)); return r; }
typedef float f32x2 __attribute__((ext_vector_type(2)));
__device__ __forceinline__ f32x2 gelu_pk(f32x2 v) {
    const f32x2 av = __builtin_elementwise_abs(v), d = av * 0.2316418882f + 1.0f;
    f32x2 t; t.x = __builtin_amdgcn_rcpf(d.x); t.y = __builtin_amdgcn_rcpf(d.y);
    f32x2 q = t * 0.5307027145f + (-0.7265760135f); q = q * t + 0.7107068705f; q = q * t + (-0.142248368f); q = q * t + 0.127414796f; q = q * t;
    const f32x2 s = (v * v) * (-0.72134752044f);
    f32x2 e; e.x = __builtin_amdgcn_exp2f(s.x); e.y = __builtin_amdgcn_exp2f(s.y);
    const f32x2 m = v * (q * e), r = v - m;
    f32x2 o; o.x = v.x < 0.f ? m.x : r.x; o.y = v.y < 0.f ? m.y : r.y; return o;
}

template <int ACT  > struct EpiBf16 {
    static constexpr bool PERM = true, AFTER_DRAIN = false; static_assert(ACT == 0 || ACT == 1, "EpiBf16: ACT is 0 (none) or 1 (gelu_pk)");
    bf16_t* O; int ldc; const float* bias; int split_cols; size_t split_stride; float scale0;
    __device__ __forceinline__ void operator()(const f32x4 (&acc)[2][2][4][2], const Unit& u, int wr, int wc, int fr, int fq) const {
        const int row0 = u.pm * BM + wr * 64 + fr; int colt = u.pn * BM; bf16_t* base = O;
        float sc = 1.f; if (split_cols) { const int t = colt / split_cols; base += (size_t)t * split_stride; colt -= t * split_cols; if (t == 0) sc = scale0; }
        const int col0 = colt + wc * 32 + 8 * fq, bcol0 = u.pn * BM + wc * 32 + 8 * fq;
        f32x4 bv[2][2];
#pragma unroll
        for (int bj = 0; bj < 2; ++bj)
#pragma unroll
            for (int n = 0; n < 2; ++n) bv[bj][n] = bias ? *(const f32x4*)(bias + bcol0 + bj * HALF + 4 * n) : (f32x4){0.f, 0.f, 0.f, 0.f};
#pragma unroll
        for (int ai = 0; ai < 2; ++ai)
#pragma unroll
            for (int m = 0; m < 4; ++m) { bf16_t* rowp = base + (size_t)(row0 + ai * HALF + m * 16) * ldc + col0;
#pragma unroll
                for (int bj = 0; bj < 2; ++bj) { f32x4 v0 = acc[ai][bj][m][0] + bv[bj][0], v1 = acc[ai][bj][m][1] + bv[bj][1];
                    if (ACT == 1) { f32x2 a = gelu_pk((f32x2){v0[0], v0[1]}), b = gelu_pk((f32x2){v0[2], v0[3]}), c = gelu_pk((f32x2){v1[0], v1[1]}), d = gelu_pk((f32x2){v1[2], v1[3]});
                        v0 = (f32x4){a.x, a.y, b.x, b.y}; v1 = (f32x4){c.x, c.y, d.x, d.y}; }
                    v0 = v0 * sc; v1 = v1 * sc; u32x4 w; w.x = cvt_pk_bf16(v0[0], v0[1]); w.y = cvt_pk_bf16(v0[2], v0[3]); w.z = cvt_pk_bf16(v1[0], v1[1]); w.w = cvt_pk_bf16(v1[2], v1[3]);
                    *(u32x4*)(rowp + bj * HALF) = w; } }
    }
};
template <class Epi, class Sched, bool ALIGN_EPI = false, bool SP2 = false>
__device__ __forceinline__ void gemm_phase(PG8_LAS unsigned char* lds, const Gemm g, const Sched& S, const Epi& E) {
    const int tid = threadIdx.x, wid = __builtin_amdgcn_readfirstlane(tid >> 6), lane = tid & 63, wr = wid >> 2, wc = wid & 3, fr = lane & 15, fq = lane >> 4;
    const int K = g.K, nt = K / BK;
    unsigned voffA[2], voffB[2];
#pragma unroll
    for (int i = 0; i < 2; ++i) { int R, C; stage_rc(tid * 16 + i * 8192, R, C); const int Rb = Epi::PERM ? ((R & ~31) + perm32(R & 31)) : R;
        voffA[i] = (unsigned)(R * K + C) * 2u; voffB[i] = (unsigned)(Rb * K + C) * 2u; }
    const size_t kstep = (size_t)(BK * 2);
    const size_t hstep = (size_t)HALF * K * 2;
    const size_t tstep = 2 * hstep;
    const unsigned ldsw = (unsigned)wid * 1024u;
    const int aoff = lds_byte(wr * 64 + fr, fq * 8), boff = lds_byte(wc * 32 + fr, fq * 8);
#define PG8_SA(b, h) (((b) * 2 + (h)) * HTB)
#define PG8_SB(b, h) ((4 + (b) * 2 + (h)) * HTB)
#define PG8_STAGE(bufoff, gbase, voff) do { _Pragma("unroll") for (int _i = 0; _i < 2; ++_i) \
        __builtin_amdgcn_global_load_lds((const unsigned*)((const char*)(gbase) + (voff)[_i]), (PG8_LAS unsigned*)(lds + (bufoff) + ldsw + _i * 8192), 16, 0, 0); } while (0)
#define PG8_LDA(dst, b, h) do { _Pragma("unroll") for (int m = 0; m < 4; ++m) _Pragma("unroll") for (int k = 0; k < 2; ++k) dst[m][k] = *(const PG8_LAS bf16x8*)(lds + PG8_SA(b, h) + aoff + m * 2048 + k * 1024); } while (0)
#define PG8_LDB(dst, b, h) do { _Pragma("unroll") for (int n = 0; n < 2; ++n) _Pragma("unroll") for (int k = 0; k < 2; ++k) dst[n][k] = *(const PG8_LAS bf16x8*)(lds + PG8_SB(b, h) + boff + n * 2048 + k * 1024); } while (0)
#define PG8_MMA(ai, bj, At, Bt) do { __builtin_amdgcn_s_setprio(1); _Pragma("unroll") for (int m = 0; m < 4; ++m) _Pragma("unroll") for (int n = 0; n < 2; ++n) _Pragma("unroll") for (int k = 0; k < 2; ++k) \
        acc[ai][bj][m][n] = __builtin_amdgcn_mfma_f32_16x16x32_bf16(Bt[n][k], At[m][k], acc[ai][bj][m][n], 0, 0, 0); __builtin_amdgcn_s_setprio(0); } while (0)
#define PG8_WAIT_V(n) asm volatile("s_waitcnt vmcnt(" #n ")" ::: "memory")
#define PG8_WAIT_L(n) asm volatile("s_waitcnt lgkmcnt(" #n ")" ::: "memory")
#define PG8_BAR __builtin_amdgcn_s_barrier()
#define PG8_SCHED __builtin_amdgcn_sched_barrier(0)
    Unit cur, nxt; int ui = 0;
    if (!S.next(0, cur)) return;
    f32x4 acc[2][2][4][2];
#pragma unroll
    for (int a = 0; a < 2; ++a)
#pragma unroll
        for (int b = 0; b < 2; ++b)
#pragma unroll
            for (int m = 0; m < 4; ++m)
#pragma unroll
                for (int n = 0; n < 2; ++n) acc[a][b][m][n] = (f32x4){0.f, 0.f, 0.f, 0.f};
    bf16x8 At[4][2], B0[2][2], B1[2][2];
    const char* cA = (const char*)g.A + (size_t)cur.pm * tstep; const char* cB = (const char*)g.Bt + (size_t)cur.pn * tstep;
    S.a_ready(cur);
    if constexpr (SP2) {
        PG8_STAGE(PG8_SB(0, 0), cB, voffB); PG8_STAGE(PG8_SB(0, 1), cB + hstep, voffB); PG8_STAGE(PG8_SA(0, 0), cA, voffA); PG8_STAGE(PG8_SA(0, 1), cA + hstep, voffA);
        if (wr == 1) PG8_BAR;
        PG8_WAIT_V(2); PG8_BAR;
        PG8_STAGE(PG8_SB(1, 0), cB + kstep, voffB); PG8_STAGE(PG8_SA(1, 0), cA + kstep, voffA); PG8_STAGE(PG8_SB(1, 1), cB + hstep + kstep, voffB);
        PG8_WAIT_V(6); PG8_BAR;
    } else {
        PG8_STAGE(PG8_SB(0, 0), cB, voffB); PG8_STAGE(PG8_SA(0, 0), cA, voffA); PG8_STAGE(PG8_SB(0, 1), cB + hstep, voffB); PG8_STAGE(PG8_SA(0, 1), cA + hstep, voffA);
        if (wr == 1) PG8_BAR;
        PG8_WAIT_V(4); PG8_BAR;
        PG8_STAGE(PG8_SB(1, 0), cB + kstep, voffB); PG8_STAGE(PG8_SA(1, 0), cA + kstep, voffA); PG8_STAGE(PG8_SB(1, 1), cB + hstep + kstep, voffB);
        PG8_WAIT_V(6); PG8_BAR;
    }
    for (;;) {
        const bool has_next = S.next(ui + 1, nxt);
        const char* nA = has_next ? (const char*)g.A + (size_t)nxt.pm * tstep : cA; const char* nB = has_next ? (const char*)g.Bt + (size_t)nxt.pn * tstep : cB;
        for (int t = 0; t < nt; t += 2) {
            const bool last = (t == nt - 2);
            const char* a1 = cA + (size_t)(t + 1) * kstep;
            const char* a2 = last ? nA : cA + (size_t)(t + 2) * kstep; const char* b2 = last ? nB : cB + (size_t)(t + 2) * kstep;
            const char* a3 = a2 + kstep; const char* b3 = b2 + kstep;
            if (last && has_next) S.a_ready(nxt);
            if constexpr (SP2) {
            PG8_LDB(B0, 0, 0); PG8_LDB(B1, 0, 1); PG8_SCHED; PG8_LDA(At, 0, 0); PG8_STAGE(PG8_SA(1, 1), a1 + hstep, voffA);
            PG8_WAIT_V(8); PG8_WAIT_L(0); PG8_BAR; PG8_MMA(0, 0, At, B0); PG8_MMA(0, 1, At, B1); PG8_BAR; PG8_SCHED;
            PG8_LDA(At, 0, 1); PG8_STAGE(PG8_SB(0, 0), b2, voffB); PG8_STAGE(PG8_SB(0, 1), b2 + hstep, voffB); PG8_STAGE(PG8_SA(0, 0), a2, voffA);
            PG8_WAIT_V(8); PG8_WAIT_L(0); PG8_BAR; PG8_MMA(1, 0, At, B0); PG8_MMA(1, 1, At, B1); PG8_BAR; PG8_SCHED;
            PG8_LDB(B0, 1, 0); PG8_LDB(B1, 1, 1); PG8_SCHED; PG8_LDA(At, 1, 0); PG8_STAGE(PG8_SA(0, 1), a2 + hstep, voffA);
            PG8_WAIT_V(8); PG8_WAIT_L(0); PG8_BAR; PG8_MMA(0, 0, At, B0); PG8_MMA(0, 1, At, B1); PG8_BAR; PG8_SCHED;
            PG8_LDA(At, 1, 1); PG8_STAGE(PG8_SB(1, 0), b3, voffB); PG8_STAGE(PG8_SB(1, 1), b3 + hstep, voffB); PG8_STAGE(PG8_SA(1, 0), a3, voffA);
            PG8_WAIT_V(8); PG8_WAIT_L(0); PG8_BAR; PG8_MMA(1, 0, At, B0); PG8_MMA(1, 1, At, B1); PG8_BAR; PG8_SCHED;
            } else {
            PG8_LDB(B0, 0, 0); PG8_SCHED; PG8_LDA(At, 0, 0); PG8_STAGE(PG8_SA(1, 1), a1 + hstep, voffA);
            PG8_WAIT_L(8); PG8_BAR; PG8_WAIT_L(0); PG8_MMA(0, 0, At, B0); PG8_BAR; PG8_SCHED;
            PG8_LDB(B1, 0, 1); PG8_STAGE(PG8_SB(0, 0), b2, voffB);
            PG8_BAR; PG8_WAIT_L(0); PG8_MMA(0, 1, At, B1); PG8_BAR;
            PG8_LDA(At, 0, 1); PG8_STAGE(PG8_SA(0, 0), a2, voffA);
            PG8_BAR; PG8_WAIT_L(0); PG8_MMA(1, 0, At, B0); PG8_BAR; PG8_SCHED;
            PG8_STAGE(PG8_SB(0, 1), b2 + hstep, voffB);
            PG8_WAIT_V(6); PG8_BAR; PG8_MMA(1, 1, At, B1); PG8_BAR;
            PG8_LDB(B0, 1, 0); PG8_SCHED; PG8_LDA(At, 1, 0); PG8_STAGE(PG8_SA(0, 1), a2 + hstep, voffA);
            PG8_WAIT_L(8); PG8_BAR; PG8_WAIT_L(0); PG8_MMA(0, 0, At, B0); PG8_BAR; PG8_SCHED;
            PG8_LDB(B1, 1, 1); PG8_STAGE(PG8_SB(1, 0), b3, voffB);
            PG8_BAR; PG8_WAIT_L(0); PG8_MMA(0, 1, At, B1); PG8_BAR;
            PG8_LDA(At, 1, 1); PG8_STAGE(PG8_SA(1, 0), a3, voffA);
            PG8_BAR; PG8_WAIT_L(0); PG8_MMA(1, 0, At, B0); PG8_BAR; PG8_SCHED;
            PG8_STAGE(PG8_SB(1, 1), b3 + hstep, voffB);
            PG8_WAIT_V(6); PG8_BAR; PG8_MMA(1, 1, At, B1); PG8_BAR;
            }
        }
        if constexpr (ALIGN_EPI) { if (wr == 0) PG8_BAR; }
        if constexpr (!Epi::AFTER_DRAIN) { E(acc, cur, wr, wc, fr, fq); S.done(cur); }
        if (!has_next) break;
#pragma unroll
        for (int a = 0; a < 2; ++a)
#pragma unroll
            for (int b = 0; b < 2; ++b)
#pragma unroll
                for (int m = 0; m < 4; ++m)
#pragma unroll
                    for (int n = 0; n < 2; ++n) acc[a][b][m][n] = (f32x4){0.f, 0.f, 0.f, 0.f};
        cur = nxt; cA = nA; cB = nB; ++ui;
        if constexpr (ALIGN_EPI) { if (wr == 1) PG8_BAR; }
    }
    PG8_WAIT_V(0);
    if constexpr (!ALIGN_EPI) { if (wr == 0) PG8_BAR; }
    PG8_BAR;
    if constexpr (Epi::AFTER_DRAIN) { E.fused(acc, cur, wr, wc, fr, fq, lds, wid, lane); S.done(cur); }
#undef PG8_SA
#undef PG8_SB
#undef PG8_STAGE
#undef PG8_LDA
#undef PG8_LDB
#undef PG8_MMA
#undef PG8_WAIT_V
#undef PG8_WAIT_L
#undef PG8_BAR
#undef PG8_SCHED
}
}

#ifndef MK_SINGLE
#define MK_SINGLE 1
#endif
constexpr int BATCH = 32, SEQ = 2048, DM = 1024, M = BATCH * SEQ;
constexpr int NIN = 3336, NPROJ = 3328;
constexpr int DFF = 2816, NUP = 2 * DFF;
constexpr int C_Q = 1792, C_K = 2048, C_V = 2304, C_O = 2816;
constexpr int NLORA = 1536, KLORA = 256;
constexpr int MH = M / 2;
constexpr float NORM_EPS = 1e-6f, LNX_EPS = 64e-5f;

constexpr size_t MiB = 1u << 20;
constexpr size_t WS_CTL = 0, CTL_ZERO_BYTES = 1 * MiB;
constexpr size_t WS_WT_IN = 2 * MiB, WS_WT_OUT = 9 * MiB, WS_WT_UP = 11 * MiB, WS_WT_DN = 22 * MiB, WS_WT_LORA = 28 * MiB;
constexpr size_t WS_RS2 = 29 * MiB, WS_SSQP = 30 * MiB, WS_GATES = 34 * MiB;
constexpr size_t WS_XN = 40 * MiB;
constexpr size_t WS_PROJ = 168 * MiB;
constexpr size_t WS_LBUF = 584 * MiB;
constexpr size_t WS_DAG = 616 * MiB;
constexpr size_t WS_MIX = 808 * MiB;
constexpr size_t WS_SIDE = 168 * MiB;
constexpr int SIDE_ELEMS = 256 * 22 * 2 * 128;
constexpr size_t WS_FF = 192 * MiB;
constexpr size_t WS_GB = 520 * MiB;
constexpr size_t WS_END = 936 * MiB;

constexpr int LDS_BYTES = 163840;
constexpr int MISC_OFF = LDS_BYTES - 256;

#define GAS __attribute__((address_space(1)))
#define LAS __attribute__((address_space(3)))
typedef unsigned short bf16;
typedef unsigned v4u __attribute__((ext_vector_type(4)));
typedef unsigned v2u __attribute__((ext_vector_type(2)));
typedef float f32x4 __attribute__((ext_vector_type(4)));
typedef float f32x2 __attribute__((ext_vector_type(2)));
typedef short bf16x8 __attribute__((ext_vector_type(8)));
typedef GAS unsigned gu32;

typedef __bf16 bf16x2_t __attribute__((ext_vector_type(2)));
__device__ __forceinline__ unsigned pk2(float lo, float hi) { const f32x2 v = {lo, hi}; const bf16x2_t b = __builtin_convertvector(v, bf16x2_t); return __builtin_bit_cast(unsigned, b); }
__device__ __forceinline__ unsigned f2bf(float f) { return pk2(f, f) & 0xffffu; }
__device__ __forceinline__ float bf2f(unsigned short u) { return __builtin_bit_cast(float, (unsigned)u << 16); }
__device__ __forceinline__ float bflo(unsigned w) { return __builtin_bit_cast(float, w << 16); }
__device__ __forceinline__ float bfhi(unsigned w) { return __builtin_bit_cast(float, w & 0xffff0000u); }
__device__ __forceinline__ void unpack8(const v4u w, float (&o)[8]) { o[0] = bflo(w.x); o[1] = bfhi(w.x); o[2] = bflo(w.y); o[3] = bfhi(w.y); o[4] = bflo(w.z); o[5] = bfhi(w.z); o[6] = bflo(w.w); o[7] = bfhi(w.w); }
__device__ __forceinline__ v4u pack8(const float (&o)[8]) { v4u w; w.x = pk2(o[0], o[1]); w.y = pk2(o[2], o[3]); w.z = pk2(o[4], o[5]); w.w = pk2(o[6], o[7]); return w; }
__device__ __forceinline__ float frcp(float x) { return __builtin_amdgcn_rcpf(x); }
__device__ __forceinline__ float frsq(float x) { return __builtin_amdgcn_rsqf(x); }
__device__ __forceinline__ float fsqrt_(float x) { return __builtin_amdgcn_sqrtf(x); }
__device__ __forceinline__ float fexp(float x) { return __builtin_amdgcn_exp2f(x * 1.4426950408889634f); }
__device__ __forceinline__ float sigmoidf_(float x) { return frcp(1.0f + __builtin_amdgcn_exp2f(x * -1.4426950408889634f)); }
__device__ __forceinline__ float tanhf_(float x) { return 1.0f - 2.0f * frcp(__builtin_amdgcn_exp2f(x * 2.8853900817779268f) + 1.0f); }
__device__ __forceinline__ float softplusf_(float x) { return fmaxf(x, 0.f) + __logf(1.0f + fexp(-fabsf(x))); }
__device__ __forceinline__ float wave_sum(float v) {
#pragma unroll
    for (int o = 1; o < 64; o <<= 1) v += __shfl_xor(v, o);
    return v;
}
template <int CTRL> __device__ __forceinline__ float dppmov(float v) { return __builtin_bit_cast(float, __builtin_amdgcn_update_dpp(0, __builtin_bit_cast(int, v), CTRL, 0xF, 0xF, true)); }
__device__ __forceinline__ float red8(float v) { v += dppmov<0xB1>(v); v += dppmov<0x4E>(v); v += dppmov<0x141>(v); return v; }
__device__ __forceinline__ float red16(float v) { v += dppmov<0xB1>(v); v += dppmov<0x4E>(v); v += dppmov<0x141>(v); v += dppmov<0x140>(v); return v; }

template <int CTRL, int RMASK> __device__ __forceinline__ float dppsh(float idv, float v) { return __builtin_bit_cast(float, __builtin_amdgcn_update_dpp(__builtin_bit_cast(int, idv), __builtin_bit_cast(int, v), CTRL, RMASK, 0xF, false)); }
__device__ __forceinline__ float wave_scan_add(float v) {
    v += dppsh<0x111, 0xF>(0.f, v); v += dppsh<0x112, 0xF>(0.f, v); v += dppsh<0x114, 0xF>(0.f, v); v += dppsh<0x118, 0xF>(0.f, v);
    v += dppsh<0x142, 0xA>(0.f, v); v += dppsh<0x143, 0xC>(0.f, v); return v;
}
__device__ __forceinline__ float wave_scan_max(float v) {
    const float ni = -3.0e38f;
    v = fmaxf(v, dppsh<0x111, 0xF>(ni, v)); v = fmaxf(v, dppsh<0x112, 0xF>(ni, v)); v = fmaxf(v, dppsh<0x114, 0xF>(ni, v)); v = fmaxf(v, dppsh<0x118, 0xF>(ni, v));
    v = fmaxf(v, dppsh<0x142, 0xA>(ni, v)); v = fmaxf(v, dppsh<0x143, 0xC>(ni, v)); return v;
}

#define XB_TMO      128
#define XB_XCNT(j)  (256  + 64 * (j))
#define XB_XSUB(j)  (1280 + 64 * (j))
#define XB_XGEN(j)  (2304 + 64 * (j))
#define XB_TOP      3328
#define XB_TOPGEN   3392
#define XCD_BAR_WORDS 3456
#define XB_SPIN_CAP (1u << 22)
__device__ __forceinline__ unsigned xb_ld(unsigned* p)              { return __hip_atomic_load(p, __ATOMIC_RELAXED, __HIP_MEMORY_SCOPE_AGENT); }
__device__ __forceinline__ unsigned xb_add(unsigned* p, unsigned v) { return __hip_atomic_fetch_add(p, v, __ATOMIC_RELAXED, __HIP_MEMORY_SCOPE_AGENT); }
__device__ __forceinline__ unsigned xb_xcc_id() { return (unsigned)__builtin_amdgcn_s_getreg((3 << 11) | 20) & 0xFu; }
#define XB_SPIN(cond, bar) do { unsigned _sp = 0; while (cond) { __builtin_amdgcn_s_sleep(1); \
    if ((++_sp & 255u) == 0u) { if (xb_ld(&(bar)[XB_TMO])) break; if (_sp > XB_SPIN_CAP) { atomicAdd(&(bar)[XB_TMO], 1u); break; } } } } while (0)
struct XcdBarrier { unsigned* bar; unsigned x; volatile LAS unsigned* st; };
__device__ __forceinline__ XcdBarrier xcd_barrier_post(unsigned* bar, volatile LAS unsigned* st) {
    XcdBarrier b; b.bar = bar; b.x = xb_xcc_id(); b.st = st;
    if (threadIdx.x == 0) (void)xb_add(&bar[XB_XCNT(b.x)], 1u);
    return b;
}
__device__ __forceinline__ void xcd_barrier_complete(unsigned* bar, unsigned x, unsigned& nloc, unsigned& nx) {
    const unsigned G = gridDim.x * gridDim.y * gridDim.z;
    unsigned sum, cnt, mine, sp = 0u;
    for (;;) {
        sum = 0u; cnt = 0u; mine = 0u;
#pragma unroll
        for (unsigned j = 0; j < 16; ++j) { const unsigned c = xb_ld(&bar[XB_XCNT(j)]); sum += c; cnt += (c > 0u) ? 1u : 0u; mine = (j == x) ? c : mine; }
        if (sum == G) break;
        __builtin_amdgcn_s_sleep(1);
        if ((++sp & 255u) == 0u) { if (xb_ld(&bar[XB_TMO])) break; if (sp > XB_SPIN_CAP) { atomicAdd(&bar[XB_TMO], 1u); break; } }
    }
    nloc = mine > 0u ? mine : 1u; nx = cnt > 0u ? cnt : 1u;
}
__device__ __forceinline__ void xcd_barrier(const XcdBarrier& b) {
    asm volatile("s_waitcnt vmcnt(0)" ::: "memory");
    __syncthreads();
    if (threadIdx.x == 0) {
        unsigned* bar = b.bar;
        __builtin_amdgcn_s_waitcnt(0);
        unsigned nloc = b.st[0], nx = b.st[1];
        if (nloc == 0u) { xcd_barrier_complete(bar, b.x, nloc, nx); b.st[0] = nloc; b.st[1] = nx; }
        const unsigned old = xb_add(&bar[XB_XSUB(b.x)], 1u);
        const unsigned gen = old / nloc;
        if (old + 1u == (gen + 1u) * nloc) {
            __builtin_amdgcn_fence(__ATOMIC_RELEASE, "agent");
            asm volatile("s_waitcnt vmcnt(0)" ::: "memory");
            const unsigned og = xb_add(&bar[XB_TOP], 1u);
            const unsigned tg = og / nx;
            if (og + 1u == (tg + 1u) * nx) xb_add(&bar[XB_TOPGEN], 1u);
            else XB_SPIN(xb_ld(&bar[XB_TOPGEN]) == tg, bar);
            __builtin_amdgcn_fence(__ATOMIC_ACQUIRE, "agent");
            xb_add(&bar[XB_XGEN(b.x)], 1u);
            asm volatile("s_waitcnt vmcnt(0)" ::: "memory");
        } else {
            XB_SPIN(xb_ld(&bar[XB_XGEN(b.x)]) == gen, bar);
            __builtin_amdgcn_fence(__ATOMIC_ACQUIRE, "agent");
            asm volatile("s_waitcnt vmcnt(0)" ::: "memory");
        }
    }
    __syncthreads();
}

__device__ __forceinline__ int opaque_i(int v) { asm volatile("" : "+s"(v)); return v; }
#define LDS_BARRIER() do { asm volatile("s_waitcnt lgkmcnt(0)" ::: "memory"); __builtin_amdgcn_s_barrier(); asm volatile("" ::: "memory"); } while (0)
struct Args { const float* in[26]; float* out; unsigned char* ws; int ph_lo, ph_hi; };

namespace pg8 {
struct PanelOrder {
    int c;
    __device__ bool next(int i, Unit& u) const { if (i >= 4) return false; u.pm = c; u.pn = i; return true; }
    __device__ __forceinline__ void a_ready(const Unit&) const {}
    __device__ __forceinline__ void done(const Unit&) const {}
};
struct EpiResid {
    static constexpr bool PERM = true, AFTER_DRAIN = false;
    const float* X; float* X2; bf16_t* XB; float* ssqp;
    __device__ __forceinline__ void operator()(const f32x4 (&acc)[2][2][4][2], const Unit& u, int wr, int wc, int fr, int fq) const {
        int pm_ = u.pm; asm volatile("" : "+s"(pm_));
        const int row0 = pm_ * BM + wr * 64 + fr, col0 = u.pn * BM + wc * 32 + 8 * fq;
#pragma unroll
        for (int ai = 0; ai < 2; ++ai)
#pragma unroll
            for (int m = 0; m < 4; ++m) { const int row = row0 + ai * HALF + m * 16; float ss = 0.f;
#pragma unroll
                for (int bj = 0; bj < 2; ++bj) { const size_t off = (size_t)row * DM + col0 + bj * HALF;
                    const f32x4 x0 = *(const f32x4*)(X + off), x1 = *(const f32x4*)(X + off + 4);
                    const f32x4 v0 = acc[ai][bj][m][0] + x0, v1 = acc[ai][bj][m][1] + x1;
                    if (X2) { *(f32x4*)(X2 + off) = v0; *(f32x4*)(X2 + off + 4) = v1; }
                    ss += (v0[0] * v0[0] + v0[1] * v0[1]) + (v0[2] * v0[2] + v0[3] * v0[3]) + (v1[0] * v1[0] + v1[1] * v1[1]) + (v1[2] * v1[2] + v1[3] * v1[3]);
                    if (XB) { u32x4 w; w.x = pk2(v0[0], v0[1]); w.y = pk2(v0[2], v0[3]); w.z = pk2(v1[0], v1[1]); w.w = pk2(v1[2], v1[3]); *(u32x4*)(XB + off) = w; } }
                ss += __shfl_xor(ss, 16); ss += __shfl_xor(ss, 32);
                if (fq == 0) ssqp[(size_t)row * 16 + u.pn * 4 + wc] = ss; }
    }
};
struct EpiScale {
    static constexpr bool PERM = true, AFTER_DRAIN = false;
    bf16_t* O; int ldc; const float* rs; int row_off;
    __device__ __forceinline__ void operator()(const f32x4 (&acc)[2][2][4][2], const Unit& u, int wr, int wc, int fr, int fq) const {
        const int row0 = u.pm * BM + wr * 64 + fr, col0 = u.pn * BM + wc * 32 + 8 * fq;
#pragma unroll
        for (int ai = 0; ai < 2; ++ai)
#pragma unroll
            for (int m = 0; m < 4; ++m) { const int row = row0 + ai * HALF + m * 16; const float s = rs[row_off + row]; bf16_t* rowp = O + (size_t)row * ldc + col0;
#pragma unroll
                for (int bj = 0; bj < 2; ++bj) { const f32x4 v0 = acc[ai][bj][m][0] * s, v1 = acc[ai][bj][m][1] * s;
                    u32x4 w; w.x = pk2(v0[0], v0[1]); w.y = pk2(v0[2], v0[3]); w.z = pk2(v1[0], v1[1]); w.w = pk2(v1[2], v1[3]); *(u32x4*)(rowp + bj * HALF) = w; } }
    }
};
struct EpiFfn {
    static constexpr bool PERM = true, AFTER_DRAIN = false;
    bf16_t* G; const float* rs; const float* cw; const float* cb; float* SA; float* SB; float* SL; LAS float* hal;
    __device__ __forceinline__ void operator()(const f32x4 (&acc)[2][2][4][2], const Unit& u, int wr, int wc, int fr, int fq) const {
        int chl = wc * 32 + 8 * fq; asm volatile("" : "+v"(chl));
        const int f0 = u.pn * 128 + chl, rowt = wr * 64 + fr;
        float rsv[2][4];
#pragma unroll
        for (int ai = 0; ai < 2; ++ai)
#pragma unroll
            for (int m = 0; m < 4; ++m) rsv[ai][m] = rs[u.pm * BM + ai * HALF + m * 16 + rowt];
        const size_t sbase = ((size_t)(u.pm * 22 + u.pn) * 2) * 128 + chl;
        if (fr >= 14) {
#pragma unroll
            for (int ai = 0; ai < 2; ++ai) { const float r_ = rsv[ai][3]; const f32x4 v0 = acc[ai][0][3][0] * r_, v1 = acc[ai][0][3][1] * r_;
                LAS float* hp = hal + ((ai * 2 + wr) * 2 + (fr - 14)) * 128 + chl; *(LAS f32x4*)hp = v0; *(LAS f32x4*)(hp + 4) = v1;
                if (ai == 1 && wr == 1) { float* gp = SL + sbase + (fr - 14) * 128; *(f32x4*)gp = v0; *(f32x4*)(gp + 4) = v1; } }
        }
        if (wr == 0 && fr < 2) { const float r_ = rsv[0][0]; float* ga = SA + sbase + fr * 128; float* gb = SB + sbase + fr * 128;
            *(f32x4*)ga = acc[0][0][0][0] * r_; *(f32x4*)(ga + 4) = acc[0][0][0][1] * r_; *(f32x4*)gb = acc[0][1][0][0] * r_; *(f32x4*)(gb + 4) = acc[0][1][0][1] * r_; }
        asm volatile("s_waitcnt lgkmcnt(0)" ::: "memory"); __builtin_amdgcn_s_barrier(); asm volatile("" ::: "memory");
        float w0[8], w1[8], w2[8], bz[8];
        { const f32x4 a0 = *(const f32x4*)(cw + f0), a1 = *(const f32x4*)(cw + f0 + 4), b0 = *(const f32x4*)(cw + DFF + f0), b1 = *(const f32x4*)(cw + DFF + f0 + 4);
          const f32x4 c0 = *(const f32x4*)(cw + 2 * DFF + f0), c1 = *(const f32x4*)(cw + 2 * DFF + f0 + 4), d0 = *(const f32x4*)(cb + f0), d1 = *(const f32x4*)(cb + f0 + 4);
#pragma unroll
          for (int j = 0; j < 4; ++j) { w0[j] = a0[j]; w0[4 + j] = a1[j]; w1[j] = b0[j]; w1[4 + j] = b1[j]; w2[j] = c0[j]; w2[4 + j] = c1[j]; bz[j] = d0[j]; bz[4 + j] = d1[j]; } }
        const bool fr0 = (fr == 0), frl2 = (fr < 2);
#pragma unroll
        for (int ai = 0; ai < 2; ++ai) {
            float ap[8];
            const int pb = ai * 2 + wr - 1;
#pragma unroll
            for (int m = 0; m < 4; ++m) {
                float av[8], bv[8], y1[8], y2[8];
                const float r_ = rsv[ai][m];
#pragma unroll
                for (int j = 0; j < 4; ++j) { av[j] = acc[ai][0][m][0][j] * r_; av[4 + j] = acc[ai][0][m][1][j] * r_; bv[j] = acc[ai][1][m][0][j] * r_; bv[4 + j] = acc[ai][1][m][1][j] * r_; }
                if (m == 0) {
                    if (pb >= 0) { const LAS float* h0 = hal + (pb * 2) * 128 + chl; const f32x4 h00 = *(const LAS f32x4*)h0, h01 = *(const LAS f32x4*)(h0 + 4), h10 = *(const LAS f32x4*)(h0 + 128), h11 = *(const LAS f32x4*)(h0 + 132);
#pragma unroll
                        for (int j = 0; j < 4; ++j) { y1[j] = h10[j]; y1[4 + j] = h11[j]; y2[j] = fr0 ? h00[j] : h10[j]; y2[4 + j] = fr0 ? h01[j] : h11[j]; } }
                    else {
#pragma unroll
                        for (int j = 0; j < 8; ++j) { y1[j] = 0.f; y2[j] = 0.f; } }
                } else {
#pragma unroll
                    for (int j = 0; j < 8; ++j) { y1[j] = dppmov<0x121>(ap[j]); y2[j] = dppmov<0x122>(ap[j]); }
                }
                float o[8];
#pragma unroll
                for (int j = 0; j < 8; ++j) { const float x1 = dppmov<0x121>(av[j]), x2 = dppmov<0x122>(av[j]);
                    const float am1 = fr0 ? y1[j] : x1, am2 = frl2 ? y2[j] : x2;
                    const float z = bz[j] + w0[j] * am2 + w1[j] * am1 + w2[j] * av[j];
                    o[j] = z * sigmoidf_(z) * bv[j]; ap[j] = av[j]; }
                if (!(ai == 0 && m == 0 && wr == 0 && frl2)) *(u32x4*)(G + (size_t)(u.pm * BM + ai * HALF + m * 16 + rowt) * DFF + f0) = pack8(o);
            }
        }
    }
};
}

template <bool FFN_UP = false>
__device__ __forceinline__ void transpose_item(const float* W, int ldw, int K, bf16* WT, const float* kscale, LAS float* scr, int item, int nblk, int lane) {
    const int kb = item / nblk, nb = item % nblk, k0 = 64 * kb, n0 = 32 * nb;
    const int d0 = !FFN_UP ? n0 : (n0 < DFF ? ((n0 >> 7) * 256 + (n0 & 127)) : ((((n0 - DFF) >> 7) * 256) + 128 + ((n0 - DFF) & 127)));
#pragma unroll 8
    for (int i = 0; i < 32; ++i) { const int kk = 2 * i + (lane >> 5); const float s = kscale ? kscale[k0 + kk] : 1.0f; scr[kk * 33 + (lane & 31)] = W[(size_t)(k0 + kk) * ldw + n0 + (lane & 31)] * s; }
    asm volatile("s_waitcnt lgkmcnt(0)" ::: "memory");
    const int c = lane & 7;
#pragma unroll
    for (int j = 0; j < 4; ++j) { const int n = (lane >> 3) + 8 * j; const LAS float* s = scr + (8 * c) * 33 + n;
        v4u o; o.x = pk2(s[0 * 33], s[1 * 33]); o.y = pk2(s[2 * 33], s[3 * 33]); o.z = pk2(s[4 * 33], s[5 * 33]); o.w = pk2(s[6 * 33], s[7 * 33]);
        *(v4u*)(WT + (size_t)(d0 + n) * K + k0 + 8 * c) = o; }
    asm volatile("s_waitcnt lgkmcnt(0)" ::: "memory");
}

__device__ __forceinline__ float wave_red63(float v) {
    v += dppmov<0xB1>(v); v += dppmov<0x4E>(v); v += dppmov<0x141>(v); v += dppmov<0x140>(v);
    v += dppsh<0x142, 0xA>(0.f, v); v += dppsh<0x143, 0xC>(0.f, v); return v;
}
__device__ __forceinline__ float lane63(float v) { return __builtin_bit_cast(float, __builtin_amdgcn_readlane(__builtin_bit_cast(int, v), 63)); }
__device__ __forceinline__ void late_transposes(const Args& a, LAS unsigned char* lds, int lane, int wave, int gw, int NGW) {
    unsigned char* ws = a.ws; LAS float* scr = (LAS float*)(lds + wave * 16384);
    constexpr int I_OUT = 16 * 32, I_UP = 16 * 176, I_DN = 44 * 32;
    for (int it = gw; it < I_OUT + I_UP + I_DN; it += NGW) {
        int r = it;
        if (r < I_OUT) { transpose_item(a.in[19], DM, DM, (bf16*)(ws + WS_WT_OUT), nullptr, scr, r, 32, lane); continue; } r -= I_OUT;
        if (r < I_UP) { transpose_item<true>(a.in[21], NUP, DM, (bf16*)(ws + WS_WT_UP), a.in[20], scr, r, 176, lane); continue; } r -= I_UP;
        transpose_item(a.in[24], DM, DFF, (bf16*)(ws + WS_WT_DN), nullptr, scr, r, 32, lane);
    }
}
__device__ __forceinline__ void phase_prep(const Args& a, LAS unsigned char* lds, int tid, int lane, int wave) {
    unsigned char* ws = a.ws;
    LAS float* scr = (LAS float*)(lds + wave * 16384);
    const int gw = blockIdx.x * 8 + wave, NGW = gridDim.x * 8;
    constexpr int I_IN = 16 * 104;
    for (int it = gw; it < I_IN; it += NGW) transpose_item(a.in[2], NIN, DM, (bf16*)(ws + WS_WT_IN), a.in[1], scr, it, 104, lane);
    {
        const float* wd = a.in[5]; const float* wa = a.in[7]; const float* wg = a.in[8]; bf16* WL = (bf16*)(ws + WS_WT_LORA);
        for (int idx = blockIdx.x * 512 + tid; idx < NLORA * KLORA; idx += gridDim.x * 512) {
            const int n = idx >> 8, k = idx & 255; float v = 0.f;
            if (n < 512) { if (k < 64) v = wd[k * 512 + n]; }
            else if (n < 1024) { if (k >= 64 && k < 128) v = wa[(k - 64) * 512 + (n - 512)]; }
            else { if (k >= 128) v = wg[(k - 128) * 512 + (n - 1024)]; }
            WL[idx] = (bf16)f2bf(v);
        }
    }
    {
        const float* x = a.in[0]; const float* g1 = a.in[1]; const float* w_in = a.in[2];
        bf16* XN = (bf16*)(ws + WS_XN); float* gates = (float*)(ws + WS_GATES);
        float wgt[16][8];
#pragma unroll
        for (int j = 0; j < 4; ++j)
#pragma unroll
            for (int e = 0; e < 4; ++e) { const int k = 4 * lane + 256 * j + e; const float g = g1[k];
                const f32x4 w0 = *(const f32x4*)(w_in + (size_t)k * NIN + 3328), w1 = *(const f32x4*)(w_in + (size_t)k * NIN + 3332);
                wgt[j * 4 + e][0] = w0[0] * g; wgt[j * 4 + e][1] = w0[1] * g; wgt[j * 4 + e][2] = w0[2] * g; wgt[j * 4 + e][3] = w0[3] * g;
                wgt[j * 4 + e][4] = w1[0] * g; wgt[j * 4 + e][5] = w1[1] * g; wgt[j * 4 + e][6] = w1[2] * g; wgt[j * 4 + e][7] = w1[3] * g; }
        f32x4 vn[4];
        { const f32x4* xr = (const f32x4*)(x + (size_t)gw * DM) + lane;
#pragma unroll
          for (int j = 0; j < 4; ++j) vn[j] = xr[64 * j]; }
        for (int row = gw; row < M; row += NGW) {
            f32x4 v[4];
#pragma unroll
            for (int j = 0; j < 4; ++j) v[j] = vn[j];
            { const int rn = (row + NGW < M) ? row + NGW : row; const f32x4* xr = (const f32x4*)(x + (size_t)rn * DM) + lane;
#pragma unroll
              for (int j = 0; j < 4; ++j) vn[j] = xr[64 * j]; }
            float ss = 0.f;
#pragma unroll
            for (int j = 0; j < 4; ++j) ss += (v[j][0] * v[j][0] + v[j][1] * v[j][1]) + (v[j][2] * v[j][2] + v[j][3] * v[j][3]);
            float gs[8];
#pragma unroll
            for (int jg = 0; jg < 8; ++jg) { float s_ = 0.f;
#pragma unroll
                for (int j = 0; j < 4; ++j)
#pragma unroll
                    for (int e = 0; e < 4; ++e) s_ += v[j][e] * wgt[j * 4 + e][jg];
                gs[jg] = s_; }
            ss = wave_red63(ss);
#pragma unroll
            for (int jg = 0; jg < 8; ++jg) gs[jg] = wave_red63(gs[jg]);
            const float rs = frsq(lane63(ss) * (1.0f / DM) + NORM_EPS);
            unsigned long long* o8 = (unsigned long long*)(XN + (size_t)row * DM) + lane;
#pragma unroll
            for (int j = 0; j < 4; ++j) o8[64 * j] = (unsigned long long)pk2(v[j][0] * rs, v[j][1] * rs) | ((unsigned long long)pk2(v[j][2] * rs, v[j][3] * rs) << 32);
            if (lane == 63) { f32x4* gp = (f32x4*)(gates + (size_t)row * 8); gp[0] = (f32x4){gs[0] * rs, gs[1] * rs, gs[2] * rs, gs[3] * rs}; gp[1] = (f32x4){gs[4] * rs, gs[5] * rs, gs[6] * rs, gs[7] * rs}; }
        }
    }
}

__device__ __forceinline__ void phase_lmat(const Args& a, int tid) {
    unsigned char* ws = a.ws; const bf16* PROJ = (const bf16*)(ws + WS_PROJ); bf16* L = (bf16*)(ws + WS_LBUF); const float* mu = a.in[3];
    const int NT = gridDim.x * 512;
    for (int it = blockIdx.x * 512 + tid; it < M * 32; it += NT) {
        const int row = it >> 5, grp = it & 31, c0 = 1536 + 8 * grp;
        const v4u cur = *(const v4u*)(PROJ + (size_t)row * NPROJ + c0);
        v4u prv = {0u, 0u, 0u, 0u}; if ((row & (SEQ - 1)) != 0) prv = *(const v4u*)(PROJ + (size_t)(row - 1) * NPROJ + c0);
        const f32x4 m0 = *(const f32x4*)(mu + c0), m1 = *(const f32x4*)(mu + c0 + 4);
        float c[8], p[8], o[8]; unpack8(cur, c); unpack8(prv, p);
#pragma unroll
        for (int e = 0; e < 8; ++e) { const float mm = e < 4 ? m0[e & 3] : m1[e & 3]; const float xv = c[e] + (p[e] - c[e]) * mm;
            o[e] = grp < 8 ? tanhf_(xv) : (grp < 16 ? xv : sigmoidf_(xv)); }
        *(v4u*)(L + (size_t)row * KLORA + 8 * grp) = pack8(o);
    }
}

constexpr int RK_LD = 72, RK_SLOT = 64 * RK_LD;
__device__ __forceinline__ f32x4 mfma16(const bf16x8 a, const bf16x8 b, const f32x4 c) { return __builtin_amdgcn_mfma_f32_16x16x32_bf16(a, b, c, 0, 0, 0); }
__device__ __forceinline__ void rk_frag(bf16x8 (&f)[2], const LAS bf16* base, int row0, int l15, int l4) { const LAS bf16* p = base + (row0 + l15) * RK_LD + 8 * l4; f[0] = *(const LAS bf16x8*)p; f[1] = *(const LAS bf16x8*)(p + 32); }
template <bool ACC> __device__ __forceinline__ void rk_prod(f32x4 (&acc)[2], const LAS bf16* Aop, const LAS bf16* Bop, int mb, int nb0, int l15, int l4) {
    bf16x8 a[2]; rk_frag(a, Aop, 16 * mb, l15, l4);
#pragma unroll
    for (int q = 0; q < 2; ++q) { bf16x8 b[2]; rk_frag(b, Bop, 16 * (nb0 + q), l15, l4); f32x4 c = ACC ? acc[q] : (f32x4){0.f, 0.f, 0.f, 0.f}; c = mfma16(a[0], b[0], c); acc[q] = mfma16(a[1], b[1], c); }
}
__device__ __forceinline__ void rk_store(LAS bf16* dst, const f32x4 (&acc)[2], int mb, int nb0, int l15, int l4) {
#pragma unroll
    for (int q = 0; q < 2; ++q) { v2u w; w.x = pk2(acc[q][0], acc[q][1]); w.y = pk2(acc[q][2], acc[q][3]); *(LAS v2u*)(dst + (16 * (nb0 + q) + l15) * RK_LD + 16 * mb + 4 * l4) = w; }
}
__device__ __forceinline__ void rwkv_unit(const Args& a, LAS unsigned char* lds, int unit, int tid, int lane, int wave) {
    unsigned char* ws = a.ws; const bf16* PROJ = (const bf16*)(ws + WS_PROJ); const bf16* DAG = (const bf16*)(ws + WS_DAG); bf16* MIX = (bf16*)(ws + WS_MIX);
    const int b = unit >> 3, h = unit & 7;
    LAS bf16* slot = (LAS bf16*)lds;
#define RK_S(k) (slot + (k) * RK_SLOT)
    LAS bf16* Ab = RK_S(0); LAS bf16* Ut = RK_S(0); LAS bf16* Bb = RK_S(1); LAS bf16* Kb = RK_S(2); LAS bf16* Rb = RK_S(3); LAS bf16* KhT = RK_S(4); LAS float* Yl = (LAS float*)RK_S(3);
    LAS bf16* BhT = RK_S(5); LAS bf16* Vt = RK_S(6); LAS bf16* P0 = RK_S(7); LAS bf16* P0T = RK_S(8); LAS bf16* Aak = RK_S(9); LAS bf16* Arb = RK_S(10); LAS bf16* Ark = RK_S(11);
    LAS bf16* TA = RK_S(12); LAS bf16* TB = RK_S(13); LAS bf16* Xt = RK_S(14); LAS bf16* Sb = RK_S(15);
    LAS float* g63 = (LAS float*)RK_S(16); LAS float* bon = g63 + 64; LAS float* ssP = bon + 64; LAS float* bnP = ssP + 512; LAS float* cst = bnP + 512;
    const int l15 = lane & 15, l4 = lane >> 4, mb = wave & 3, nb0 = 2 * (wave >> 2);
    const int tt = tid >> 3, c8 = tid & 7;
    const int jw = 8 * wave;
    for (int i = tid; i < 640; i += 512) { const int k = i >> 6, c_ = i & 63, j = h * 64 + c_;
        const float* src = k == 0 ? a.in[3] + j : k == 1 ? a.in[3] + 512 + j : k == 2 ? a.in[3] + 1024 + j : k == 3 ? a.in[9] + j : k == 4 ? a.in[10] + j : k == 5 ? a.in[11] + j : k == 6 ? a.in[4] + j : k == 7 ? a.in[6] + j : k == 8 ? a.in[12] + j : a.in[13] + j;
        cst[i] = *src; }
    for (int i = tid; i < RK_SLOT / 2; i += 512) ((LAS unsigned*)Sb)[i] = 0u;
    f32x4 sacc[2], tacc[2], yacc[2];
    sacc[0] = (f32x4){0.f, 0.f, 0.f, 0.f}; sacc[1] = sacc[0];
    v4u g_rc, g_kc, g_vc, g_rp, g_kp, g_vp, g_ld, g_a, g_g;
    v4u pend = {0u, 0u, 0u, 0u}; bf16* pend_p = MIX;
#define RK_LOADCHUNK(c_) do { const int t_ = b * SEQ + (c_) * 64 + lane; const bf16* pr_ = PROJ + (size_t)t_ * NPROJ + h * 64 + jw; \
        g_rc = *(const v4u*)pr_; g_kc = *(const v4u*)(pr_ + 512); g_vc = *(const v4u*)(pr_ + 1024); \
        if ((c_) == 0 && lane == 0) { g_rp = (v4u){0u, 0u, 0u, 0u}; g_kp = g_rp; g_vp = g_rp; } \
        else { g_rp = *(const v4u*)(pr_ - NPROJ); g_kp = *(const v4u*)(pr_ - NPROJ + 512); g_vp = *(const v4u*)(pr_ - NPROJ + 1024); } \
        const bf16* dg_ = DAG + (size_t)t_ * NLORA + h * 64 + jw; g_ld = *(const v4u*)dg_; g_a = *(const v4u*)(dg_ + 512); \
        g_g = *(const v4u*)(DAG + (size_t)(b * SEQ + (c_) * 64 + tt) * NLORA + 1024 + h * 64 + 8 * c8); } while (0)
    RK_LOADCHUNK(0);
    LDS_BARRIER();
    for (int c = 0; c < SEQ / 64; ++c) {
        const int t0 = b * SEQ + c * 64;
        float rr[8], km[8], vv[8], av[8], lgw[8], kkr[8];
        asm volatile("" : "+v"(g_rc), "+v"(g_kc), "+v"(g_vc), "+v"(g_rp), "+v"(g_kp), "+v"(g_vp), "+v"(g_ld), "+v"(g_a), "+v"(g_g));
        {
            float rc[8], kc[8], vc[8], rp_[8], kp[8], vp[8], ldv[8];
            unpack8(g_rc, rc); unpack8(g_kc, kc); unpack8(g_vc, vc); unpack8(g_rp, rp_); unpack8(g_kp, kp); unpack8(g_vp, vp); unpack8(g_ld, ldv); unpack8(g_a, av);
            float ss = 0.f, bonus = 0.f;
#pragma unroll
            for (int e = 0; e < 8; ++e) { const int j = jw + e;
                rr[e] = rc[e] + (rp_[e] - rc[e]) * cst[j]; const float k = kc[e] + (kp[e] - kc[e]) * cst[64 + j]; vv[e] = vc[e] + (vp[e] - vc[e]) * cst[128 + j];
                kkr[e] = k * cst[192 + j]; ss += kkr[e] * kkr[e];
                av[e] = sigmoidf_(cst[448 + j] + av[e]);
                lgw[e] = -0.6065306597f * sigmoidf_(cst[384 + j] + ldv[e]);
                km[e] = k * (1.0f + (av[e] - 1.0f) * cst[256 + j]);
                bonus += rr[e] * km[e] * cst[320 + j]; }
            ssP[lane * 8 + wave] = ss; bnP[lane * 8 + wave] = bonus;
        }
        const v4u gcur = g_g;
        LDS_BARRIER();
        {
            const f32x4 s0 = *(const LAS f32x4*)(ssP + lane * 8), s1 = *(const LAS f32x4*)(ssP + lane * 8 + 4), b0 = *(const LAS f32x4*)(bnP + lane * 8), b1 = *(const LAS f32x4*)(bnP + lane * 8 + 4);
            const float ss = ((s0[0] + s0[1]) + (s0[2] + s0[3])) + ((s1[0] + s1[1]) + (s1[2] + s1[3]));
            if (wave == 0) bon[lane] = ((b0[0] + b0[1]) + (b0[2] + b0[3])) + ((b1[0] + b1[1]) + (b1[2] + b1[3]));
            const float inv = frcp(fmaxf(fsqrt_(ss), 1e-12f));
            float oA[8], oB[8], oK[8], oR[8], oBh[8], oKh[8];
#pragma unroll
            for (int e = 0; e < 8; ++e) { const float lw = wave_scan_add(lgw[e]); const float l63 = __builtin_bit_cast(float, __builtin_amdgcn_readlane(__builtin_bit_cast(int, lw), 63));
                const float eP = fexp(lw - lgw[e]), eM = fexp(-lw), eL = fexp(lw), e63 = fexp(l63), eH = e63 * eM;
                const float kk = kkr[e] * inv, bb = kk * av[e];
                oA[e] = -kk * eP; oB[e] = bb * eM; oK[e] = km[e] * eM; oR[e] = rr[e] * eL; oBh[e] = bb * eH; oKh[e] = km[e] * eH;
                if (lane == 63) g63[jw + e] = e63; }
            *(LAS v4u*)(Ab + lane * RK_LD + jw) = pack8(oA); *(LAS v4u*)(Bb + lane * RK_LD + jw) = pack8(oB); *(LAS v4u*)(Kb + lane * RK_LD + jw) = pack8(oK); *(LAS v4u*)(Rb + lane * RK_LD + jw) = pack8(oR);
#pragma unroll
            for (int e = 0; e < 8; ++e) { BhT[(jw + e) * RK_LD + lane] = (bf16)f2bf(oBh[e]); KhT[(jw + e) * RK_LD + lane] = (bf16)f2bf(oKh[e]); Vt[(jw + e) * RK_LD + lane] = (bf16)f2bf(vv[e]); }
            if (c > 0) *(v4u*)pend_p = pend;
            if (c + 1 < SEQ / 64) RK_LOADCHUNK(c + 1);
        }
        LDS_BARRIER();
        {
            f32x4 d[2];
#define RK_MASK_LT(D_, MISS_) _Pragma("unroll") for (int q = 0; q < 2; ++q) { const int nb_ = nb0 + q; \
                if (MISS_ ? (mb < nb_) : (mb > nb_)) D_[q] = (f32x4){0.f, 0.f, 0.f, 0.f}; \
                else if (mb == nb_) { _Pragma("unroll") for (int r = 0; r < 4; ++r) { const int m_ = 4 * l4 + r; D_[q][r] = (MISS_ ? (l15 < m_) : (m_ < l15)) ? D_[q][r] : 0.f; } } }
#define RK_MASK_LE(D_) _Pragma("unroll") for (int q = 0; q < 2; ++q) { const int nb_ = nb0 + q; \
                if (mb > nb_) D_[q] = (f32x4){0.f, 0.f, 0.f, 0.f}; \
                else if (mb == nb_) { _Pragma("unroll") for (int r = 0; r < 4; ++r) { const int m_ = 4 * l4 + r; D_[q][r] = (m_ <= l15) ? D_[q][r] : 0.f; } } }
            rk_prod<false>(d, Bb, Ab, mb, nb0, l15, l4);
            RK_MASK_LT(d, false);
#pragma unroll
            for (int q = 0; q < 2; ++q)
#pragma unroll
                for (int r = 0; r < 4; ++r) tacc[q][r] = d[q][r] + ((mb == nb0 + q && 4 * l4 + r == l15) ? 1.f : 0.f);
            rk_store(P0, d, mb, nb0, l15, l4); rk_store(TA, tacc, mb, nb0, l15, l4);
            rk_prod<false>(d, Ab, Bb, mb, nb0, l15, l4);
            RK_MASK_LT(d, true);
            rk_store(P0T, d, mb, nb0, l15, l4);
            rk_prod<false>(d, Kb, Ab, mb, nb0, l15, l4);
            RK_MASK_LT(d, false);
            rk_store(Aak, d, mb, nb0, l15, l4);
            rk_prod<false>(d, Bb, Rb, mb, nb0, l15, l4);
            RK_MASK_LE(d);
            rk_store(Arb, d, mb, nb0, l15, l4);
            rk_prod<false>(d, Kb, Rb, mb, nb0, l15, l4);
            RK_MASK_LE(d);
            rk_store(Ark, d, mb, nb0, l15, l4);
        }
        LDS_BARRIER();
        {
            f32x4 d[2];
            rk_prod<false>(d, P0T, P0, mb, nb0, l15, l4); rk_store(Bb  , d, mb, nb0, l15, l4);
            rk_prod<false>(d, P0, P0T, mb, nb0, l15, l4); rk_store(Kb  , d, mb, nb0, l15, l4);
            rk_prod<false>(d, Ab, Sb, mb, nb0, l15, l4); rk_prod<true>(d, Aak, Vt, mb, nb0, l15, l4); rk_store(Xt, d, mb, nb0, l15, l4);
            rk_prod<false>(yacc, Sb, Rb, mb, nb0, l15, l4); rk_prod<true>(yacc, Vt, Ark, mb, nb0, l15, l4);
#pragma unroll
            for (int r = 0; r < 4; ++r) { const float g_ = g63[16 * mb + 4 * l4 + r]; sacc[0][r] *= g_; sacc[1][r] *= g_; }
            rk_prod<true>(sacc, KhT, Vt, mb, nb0, l15, l4);
        }
        LDS_BARRIER();
        { rk_prod<true>(tacc, Kb, TA, mb, nb0, l15, l4); rk_store(TB, tacc, mb, nb0, l15, l4);
          f32x4 d[2]; rk_prod<false>(d, Kb, Bb, mb, nb0, l15, l4); rk_store(P0, d, mb, nb0, l15, l4); rk_prod<false>(d, Bb, Kb, mb, nb0, l15, l4); rk_store(P0T, d, mb, nb0, l15, l4); }
        LDS_BARRIER();
        { rk_prod<true>(tacc, P0T, TB, mb, nb0, l15, l4); rk_store(TA, tacc, mb, nb0, l15, l4);
          f32x4 d[2]; rk_prod<false>(d, P0T, P0, mb, nb0, l15, l4); rk_store(Bb, d, mb, nb0, l15, l4); rk_prod<false>(d, P0, P0T, mb, nb0, l15, l4); rk_store(Kb, d, mb, nb0, l15, l4); }
        LDS_BARRIER();
        { rk_prod<true>(tacc, Kb, TA, mb, nb0, l15, l4); rk_store(TB, tacc, mb, nb0, l15, l4);
          f32x4 d[2]; rk_prod<false>(d, Kb, Bb, mb, nb0, l15, l4); rk_store(P0, d, mb, nb0, l15, l4); rk_prod<false>(d, Bb, Kb, mb, nb0, l15, l4); rk_store(P0T, d, mb, nb0, l15, l4); }
        LDS_BARRIER();
        { rk_prod<true>(tacc, P0T, TB, mb, nb0, l15, l4); rk_store(TA, tacc, mb, nb0, l15, l4);
          f32x4 d[2]; rk_prod<false>(d, P0, P0T, mb, nb0, l15, l4); rk_store(Kb  , d, mb, nb0, l15, l4); }
        LDS_BARRIER();
        { rk_prod<true>(tacc, Kb, TA, mb, nb0, l15, l4); rk_store(TB, tacc, mb, nb0, l15, l4); }
        LDS_BARRIER();
        { f32x4 d[2]; rk_prod<false>(d, TB, Xt, mb, nb0, l15, l4); rk_store(Ut, d, mb, nb0, l15, l4); }
        LDS_BARRIER();
        {
            rk_prod<true>(yacc, Ut, Arb, mb, nb0, l15, l4);
#pragma unroll
            for (int q = 0; q < 2; ++q) *(LAS f32x4*)(Yl + (16 * (nb0 + q) + l15) * 68 + 16 * mb + 4 * l4) = yacc[q];
            rk_prod<true>(sacc, BhT, Ut, mb, nb0, l15, l4); rk_store(Sb, sacc, mb, nb0, l15, l4);
        }
        LDS_BARRIER();
        {
            const int t = t0 + tt, j0 = 8 * c8;
            const f32x4 y0 = *(const LAS f32x4*)(Yl + tt * 68 + j0), y1 = *(const LAS f32x4*)(Yl + tt * 68 + j0 + 4);
            float y[8] = {y0[0], y0[1], y0[2], y0[3], y1[0], y1[1], y1[2], y1[3]}, gv[8]; float s1 = 0.f;
#pragma unroll
            for (int e = 0; e < 8; ++e) s1 += y[e];
            s1 = red8(s1); const float mean = s1 * (1.0f / 64.0f); float s2 = 0.f;
#pragma unroll
            for (int e = 0; e < 8; ++e) { const float dd = y[e] - mean; s2 += dd * dd; }
            s2 = red8(s2); const float rstd = frsq(s2 * (1.0f / 64.0f) + LNX_EPS);
            unpack8(gcur, gv);
            const float bonus = bon[tt]; float ov[8];
#pragma unroll
            for (int e = 0; e < 8; ++e) { const float yn = (y[e] - mean) * rstd * cst[512 + j0 + e] + cst[576 + j0 + e]; ov[e] = (yn + bonus * bf2f(Vt[(j0 + e) * RK_LD + tt])) * gv[e]; }
            pend = pack8(ov); pend_p = MIX + (size_t)t * DM + h * 64 + j0;
        }
        LDS_BARRIER();
    }
    *(v4u*)pend_p = pend;
#undef RK_S
#undef RK_LOADCHUNK
}

__device__ __forceinline__ void mlstm_unit(const Args& a, LAS unsigned char* lds, int unit, int tid, int lane, int wave) {
    unsigned char* ws = a.ws; const bf16* PROJ = (const bf16*)(ws + WS_PROJ); const float* gates = (const float*)(ws + WS_GATES); bf16* MIX = (bf16*)(ws + WS_MIX);
    const float* cw = a.in[14]; const float* cbias = a.in[15]; const float* i_bias = a.in[16]; const float* f_bias = a.in[17]; const float* mhg = a.in[18];
    const int b = unit >> 2, hm = unit & 3;
    constexpr int LD = 72;
    LAS bf16* Ql = (LAS bf16*)lds; LAS bf16* Kl = Ql + 64 * LD; LAS bf16* Kwt = Kl + 64 * LD; LAS bf16* Vt = Kwt + 64 * LD; LAS bf16* Sm = Vt + 128 * LD; LAS bf16* Ct = Sm + 64 * LD;
    LAS float* Hl = (LAS float*)(Ct + 128 * LD);
    LAS float* e_s = Hl + 64 * 132; LAS float* Mx = e_s + 64; LAS float* sc = Mx + 64; LAS float* em = sc + 64; LAS float* wsv = em + 64; LAS float* den = wsv + 64; LAS float* nvec = den + 64; LAS float* scal = nvec + 64;
    for (int i = tid; i < 128 * LD / 2; i += 512) ((LAS unsigned*)Ct)[i] = 0u;
    if (tid < 64) nvec[tid] = 0.f;
    if (tid == 0) { scal[0] = 1.f; scal[1] = 0.f; }
    f32x4 cacc[4];
#pragma unroll
    for (int i = 0; i < 4; ++i) cacc[i] = (f32x4){0.f, 0.f, 0.f, 0.f};
    const int l15 = lane & 15, l4 = lane >> 4;
    const int tt = tid >> 3, p8 = tid & 7;
    LAS float* cwl = scal + 16; LAS float* cbl = cwl + 512;
    for (int i = tid; i < 640; i += 512) { const int j = i >> 7, c_ = i & 127; const int src = (c_ < 64) ? (hm * 64 + c_) : (256 + hm * 64 + (c_ - 64)); if (j < 4) cwl[i] = cw[j * 512 + src]; else cbl[c_] = cbias[src]; }
    const float ibias = i_bias[hm], fbias = f_bias[hm];
    v4u n_q[4], n_k[4], n_va, n_vb, n_oa, n_ob; float n_gi = 0.f, n_gf = 0.f;
#define ML_LOADCHUNK(c_) do { const int t_ = b * SEQ + (c_) * 64 + lane; const int tp_ = (c_) * 64 + lane; \
        _Pragma("unroll") for (int j = 0; j < 4; ++j) { if (tp_ - 3 + j >= 0) { const bf16* pr_ = PROJ + (size_t)(t_ - 3 + j) * NPROJ + hm * 64 + 8 * wave; n_q[j] = *(const v4u*)(pr_ + C_Q); n_k[j] = *(const v4u*)(pr_ + C_K); } \
                                                       else { n_q[j] = (v4u){0u, 0u, 0u, 0u}; n_k[j] = (v4u){0u, 0u, 0u, 0u}; } } \
        { const bf16* pv_ = PROJ + (size_t)t_ * NPROJ + C_V + hm * 128 + 16 * wave; n_va = *(const v4u*)pv_; n_vb = *(const v4u*)(pv_ + 8); \
          const bf16* po_ = PROJ + (size_t)(b * SEQ + (c_) * 64 + tt) * NPROJ + C_O + hm * 128 + 16 * p8; n_oa = *(const v4u*)po_; n_ob = *(const v4u*)(po_ + 8); } \
        n_gi = gates[(size_t)t_ * 8 + hm]; n_gf = gates[(size_t)t_ * 8 + 4 + hm]; } while (0)
    ML_LOADCHUNK(0);
    LDS_BARRIER();
    float m_run = 0.f;
    v4u pend0 = {0u, 0u, 0u, 0u}, pend1 = pend0; bf16* pend_p = MIX;
    for (int c = 0; c < SEQ / 64; ++c) {
        const int t0 = b * SEQ + c * 64;
        asm volatile("" : "+v"(n_q[0]), "+v"(n_q[1]), "+v"(n_q[2]), "+v"(n_q[3]), "+v"(n_k[0]), "+v"(n_k[1]), "+v"(n_k[2]), "+v"(n_k[3]), "+v"(n_va), "+v"(n_vb), "+v"(n_oa), "+v"(n_ob), "+v"(n_gi), "+v"(n_gf));
        float dec;
        v4u c_oa, c_ob;
        {
            const float gi = n_gi + ibias, gf = n_gf + fbias;
            const float ig = 15.0f * tanhf_(gi * (1.0f / 15.0f)), fx = 15.0f * tanhf_(gf * (1.0f / 15.0f));
            const float logf = -(fmaxf(-fx, 0.f) + __logf(1.0f + fexp(-fabsf(fx))));
            const float bc = wave_scan_add(logf);
            const float e = ig - bc; const float P = wave_scan_max(e);
            const float mx = fmaxf(P, m_run);
            const float mxL = __builtin_bit_cast(float, __builtin_amdgcn_readlane(__builtin_bit_cast(int, mx), 63)), bL = __builtin_bit_cast(float, __builtin_amdgcn_readlane(__builtin_bit_cast(int, bc), 63));
            if (wave == 0) { e_s[lane] = e; Mx[lane] = mx; sc[lane] = fexp(m_run - mx); em[lane] = fexp(-(bc + mx)); }
            const float w = fexp(e - mxL);
            dec = fexp(m_run - mxL); m_run = bL + mxL;
            const int d0 = 8 * wave;
            float aq[8], ak[8];
#pragma unroll
            for (int e_ = 0; e_ < 8; ++e_) { aq[e_] = cbl[d0 + e_]; ak[e_] = cbl[64 + d0 + e_]; }
#pragma unroll
            for (int j = 0; j < 4; ++j) { float pq[8], pk[8]; unpack8(n_q[j], pq); unpack8(n_k[j], pk);
#pragma unroll
                for (int e_ = 0; e_ < 8; ++e_) { aq[e_] += cwl[j * 128 + d0 + e_] * pq[e_]; ak[e_] += cwl[j * 128 + 64 + d0 + e_] * pk[e_]; } }
#pragma unroll
            for (int e_ = 0; e_ < 8; ++e_) { aq[e_] = aq[e_] * sigmoidf_(aq[e_]) * 0.125f; ak[e_] = ak[e_] * sigmoidf_(ak[e_]); }
            *(LAS v4u*)(Ql + lane * LD + d0) = pack8(aq); *(LAS v4u*)(Kl + lane * LD + d0) = pack8(ak);
#pragma unroll
            for (int e_ = 0; e_ < 8; ++e_) Kwt[(d0 + e_) * LD + lane] = (bf16)f2bf(w * ak[e_]);
            const unsigned wv[8] = {n_va.x, n_va.y, n_va.z, n_va.w, n_vb.x, n_vb.y, n_vb.z, n_vb.w};
#pragma unroll
            for (int e_ = 0; e_ < 8; ++e_) { Vt[(16 * wave + 2 * e_) * LD + lane] = (bf16)(wv[e_] & 0xffffu); Vt[(16 * wave + 2 * e_ + 1) * LD + lane] = (bf16)(wv[e_] >> 16); }
            c_oa = n_oa; c_ob = n_ob;
            if (c > 0) { *(v4u*)pend_p = pend0; *(v4u*)(pend_p + 8) = pend1; }
            if (c + 1 < SEQ / 64) ML_LOADCHUNK(c + 1);
        }
        LDS_BARRIER();
        {
            const int rb = wave >> 1;
#pragma unroll
            for (int ci = 0; ci < 2; ++ci) { const int cb = 2 * (wave & 1) + ci; f32x4 acc = {0.f, 0.f, 0.f, 0.f};
#pragma unroll
                for (int kk = 0; kk < 2; ++kk) { const bf16x8 A = *(const LAS bf16x8*)(Ql + (16 * rb + l15) * LD + 32 * kk + 8 * l4), B = *(const LAS bf16x8*)(Kl + (16 * cb + l15) * LD + 32 * kk + 8 * l4); acc = mfma16(A, B, acc); }
                const int s_ = 16 * cb + l15; const float es = e_s[s_];
#pragma unroll
                for (int r = 0; r < 4; ++r) { const int t = 16 * rb + 4 * l4 + r; const float v = (s_ <= t) ? acc[r] * fexp(es - Mx[t]) : 0.f; Sm[t * LD + s_] = (bf16)f2bf(v); } }
        }
        LDS_BARRIER();
        {
            float part = 0.f, qn = 0.f; float sv[8], qv[8];
            unpack8(*(const LAS v4u*)(Sm + tt * LD + 8 * p8), sv); unpack8(*(const LAS v4u*)(Ql + tt * LD + 8 * p8), qv);
#pragma unroll
            for (int e_ = 0; e_ < 8; ++e_) { part += sv[e_]; qn += qv[e_] * nvec[8 * p8 + e_]; }
            float tot = part + sc[tt] * qn; tot = red8(tot);
            if (p8 == 0) den[tt] = tot;
            const int rb = wave >> 1;
            bf16x8 As[2], Aq[2];
#pragma unroll
            for (int kk = 0; kk < 2; ++kk) { As[kk] = *(const LAS bf16x8*)(Sm + (16 * rb + l15) * LD + 32 * kk + 8 * l4); Aq[kk] = *(const LAS bf16x8*)(Ql + (16 * rb + l15) * LD + 32 * kk + 8 * l4); }
            float scr_[4];
#pragma unroll
            for (int r = 0; r < 4; ++r) scr_[r] = sc[16 * rb + 4 * l4 + r];
#pragma unroll
            for (int vi = 0; vi < 4; ++vi) { const int vb = 4 * (wave & 1) + vi; f32x4 a1 = {0.f, 0.f, 0.f, 0.f}, a2 = {0.f, 0.f, 0.f, 0.f};
#pragma unroll
                for (int kk = 0; kk < 2; ++kk) { const bf16x8 B1 = *(const LAS bf16x8*)(Vt + (16 * vb + l15) * LD + 32 * kk + 8 * l4), B2 = *(const LAS bf16x8*)(Ct + (16 * vb + l15) * LD + 32 * kk + 8 * l4);
                    a1 = mfma16(As[kk], B1, a1); a2 = mfma16(Aq[kk], B2, a2); }
#pragma unroll
                for (int r = 0; r < 4; ++r) Hl[(16 * rb + 4 * l4 + r) * 132 + 16 * vb + l15] = a1[r] + scr_[r] * a2[r]; }
        }
        LDS_BARRIER();
        {
            bf16x8 Av[2];
#pragma unroll
            for (int kk = 0; kk < 2; ++kk) Av[kk] = *(const LAS bf16x8*)(Vt + (16 * wave + l15) * LD + 32 * kk + 8 * l4);
#pragma unroll
            for (int db = 0; db < 4; ++db) { cacc[db] = cacc[db] * dec;
#pragma unroll
                for (int kk = 0; kk < 2; ++kk) { const bf16x8 B = *(const LAS bf16x8*)(Kwt + (16 * db + l15) * LD + 32 * kk + 8 * l4); cacc[db] = mfma16(Av[kk], B, cacc[db]); }
#pragma unroll
                for (int r = 0; r < 4; ++r) Ct[(16 * wave + 4 * l4 + r) * LD + 16 * db + l15] = (bf16)f2bf(cacc[db][r]); }
            float kv[8]; unpack8(*(const LAS v4u*)(Kwt + tt * LD + 8 * p8), kv); float s_ = 0.f;
#pragma unroll
            for (int e_ = 0; e_ < 8; ++e_) s_ += kv[e_];
            s_ = red8(s_);
            if (p8 == 0) nvec[tt] = dec * nvec[tt] + s_;
        }
        {
            const int t = t0 + tt, v0 = 16 * p8; float hv[16]; float ss = 0.f;
            const float dn = frcp(fmaxf(fabsf(den[tt]), em[tt]));
#pragma unroll
            for (int q = 0; q < 4; ++q) { const f32x4 x = *(const LAS f32x4*)(Hl + tt * 132 + v0 + 4 * q) * dn; hv[4 * q] = x[0]; hv[4 * q + 1] = x[1]; hv[4 * q + 2] = x[2]; hv[4 * q + 3] = x[3]; ss += (x[0] * x[0] + x[1] * x[1]) + (x[2] * x[2] + x[3] * x[3]); }
            ss = red8(ss); const float rn = frsq(ss * (1.0f / 128.0f) + NORM_EPS);
            float o0[8], o1[8]; unpack8(c_oa, o0); unpack8(c_ob, o1);
            float r0[8], r1[8];
#pragma unroll
            for (int e_ = 0; e_ < 8; ++e_) { r0[e_] = hv[e_] * rn * mhg[hm * 128 + v0 + e_] * sigmoidf_(o0[e_]); r1[e_] = hv[8 + e_] * rn * mhg[hm * 128 + v0 + 8 + e_] * sigmoidf_(o1[e_]); }
            pend_p = MIX + (size_t)t * DM + 512 + hm * 128 + v0; pend0 = pack8(r0); pend1 = pack8(r1);
        }
        LDS_BARRIER();
    }
    *(v4u*)pend_p = pend0; *(v4u*)(pend_p + 8) = pend1;
#undef ML_LOADCHUNK
}

__device__ __forceinline__ void phase_ffn_fix(const Args& a, int tid) {
    unsigned char* ws = a.ws; const float* SA = (const float*)(ws + WS_SIDE); const float* SB = SA + SIDE_ELEMS; const float* SL = SB + SIDE_ELEMS; bf16* GB = (bf16*)(ws + WS_GB);
    const float* cw = a.in[22]; const float* cb = a.in[23];
    const int NT = gridDim.x * 512;
    for (int it = blockIdx.x * 512 + tid; it < SIDE_ELEMS; it += NT) {
        const int ch = it & 127, r = (it >> 7) & 1, tile = it >> 8, pm = tile / 22, pn = tile % 22;
        const int base = tile * 256;
        float l0 = 0.f, l1 = 0.f;
        if ((pm & 7) != 0) { const int lb = (tile - 22) * 256; l0 = SL[lb + ch]; l1 = SL[lb + 128 + ch]; }
        const float a_r = SA[base + r * 128 + ch], b_r = SB[base + r * 128 + ch];
        const float am1 = r == 0 ? l1 : SA[base + ch], am2 = r == 0 ? l0 : l1;
        const int f = pn * 128 + ch;
        const float z = cb[f] + cw[f] * am2 + cw[DFF + f] * am1 + cw[2 * DFF + f] * a_r;
        GB[(size_t)(pm * 256 + r) * DFF + f] = (bf16)f2bf(z * sigmoidf_(z) * b_r);
    }
}
__device__ __forceinline__ void phase_final(const Args& a, int lane, int wave) {
    const bf16* FF = (const bf16*)(a.ws + WS_FF); const float* gf = a.in[25];
    f32x4 gv[4];
#pragma unroll
    for (int j = 0; j < 4; ++j) gv[j] = *((const f32x4*)gf + lane + 64 * j);
    const int NGW = gridDim.x * 8;
#ifdef PROBE
    const unsigned long long* tstamps = (const unsigned long long*)(a.ws + WS_CTL + 512 * 1024);
    const float fa = fminf(fmaxf((float)(long long)(tstamps[PROBE_A_TO] - tstamps[PROBE_A_FROM]) * (0.01f / PROBE_A_SCALE_US), 0.f), 1.f);
    const float pscale = 1.0f + sqrtf(fa * 0.8e-4f);
#pragma unroll
    for (int j = 0; j < 4; ++j) gv[j] = gv[j] * pscale;
#endif
    const bf16* XB = (const bf16*)(a.ws + WS_XN);
    for (int row0 = 2 * (blockIdx.x * 8 + wave); row0 < M; row0 += 2 * NGW) {
        v2u xq[2][4], f[2][4];
#pragma unroll
        for (int u = 0; u < 2; ++u) { const v2u* xr = (const v2u*)(XB + (size_t)(row0 + u) * DM) + lane; const v2u* fr_ = (const v2u*)(FF + (size_t)(row0 + u) * DM) + lane;
#pragma unroll
            for (int j = 0; j < 4; ++j) { xq[u][j] = xr[64 * j]; f[u][j] = fr_[64 * j]; } }
#pragma unroll
        for (int u = 0; u < 2; ++u) { float ss = 0.f; f32x4 v[4];
#pragma unroll
            for (int j = 0; j < 4; ++j) { v[j][0] = bflo(xq[u][j].x) + bflo(f[u][j].x); v[j][1] = bfhi(xq[u][j].x) + bfhi(f[u][j].x); v[j][2] = bflo(xq[u][j].y) + bflo(f[u][j].y); v[j][3] = bfhi(xq[u][j].y) + bfhi(f[u][j].y);
                ss += (v[j][0] * v[j][0] + v[j][1] * v[j][1]) + (v[j][2] * v[j][2] + v[j][3] * v[j][3]); }
            const float rs = frsq(wave_sum(ss) * (1.0f / DM) + NORM_EPS);
            f32x4* xr = (f32x4*)(a.out + (size_t)(row0 + u) * DM) + lane;
#pragma unroll
            for (int j = 0; j < 4; ++j) xr[64 * j] = v[j] * rs * gv[j]; }
    }
}

constexpr int N_PHASES = 10;
__global__ void __launch_bounds__(512, 2) mega(Args args) {
    extern __shared__ __attribute__((aligned(16))) unsigned char lds_raw[];
    LAS unsigned char* lds = (LAS unsigned char*)lds_raw;
    const int tid0 = threadIdx.x;
    unsigned char* ws = args.ws;
#define PHASE_IDS int tid = tid0; asm volatile("" : "+v"(tid)); const int lane = tid & 63, wave = __builtin_amdgcn_readfirstlane(tid >> 6); (void)lane; (void)wave
    volatile LAS unsigned* MISC = (volatile LAS unsigned*)(lds + MISC_OFF);
    { PHASE_IDS; for (int u = tid; u < (LDS_BYTES - 131072) / 4; u += 512) ((LAS unsigned*)(lds + 131072))[u] = 0u; }
    __syncthreads();
    XcdBarrier bar; bar.bar = (unsigned*)(ws + WS_CTL) + 4096; bar.x = 0; bar.st = nullptr;
    if (MK_SINGLE) bar = xcd_barrier_post((unsigned*)(ws + WS_CTL) + 4096, MISC + 8);
    const int lo = args.ph_lo, hi = args.ph_hi;
#ifndef PH_MASK
#define PH_MASK 0xFFFF
#endif
#define IN(k) ((((PH_MASK) >> (k)) & 1) && lo <= (k) && (k) < hi)
#ifdef PROBE
    unsigned long long* const tstamps = (unsigned long long*)(ws + WS_CTL + 512 * 1024);
#define STAMP(k) do { if (blockIdx.x == 0 && tid0 == 0) tstamps[(k)] = __builtin_amdgcn_s_memrealtime(); } while (0)
#else
#define STAMP(k) do { } while (0)
#endif
    STAMP(0);
#define SEAM(k) do { if (IN(k) && IN((k) + 1)) xcd_barrier(bar); STAMP((k) + 1); } while (0)

    if (IN(0)) { PHASE_IDS; phase_prep(args, lds, tid, lane, wave); } SEAM(0);
    if (IN(1)) {
        pg8::Gemm g{(const bf16*)(ws + WS_XN), (const bf16*)(ws + WS_WT_IN), M, NPROJ, opaque_i(DM)}; pg8::StaticOrder S; S.init(M, NPROJ, gridDim.x, (int)blockIdx.x);
        pg8::EpiBf16<0> E{(bf16*)(ws + WS_PROJ), NPROJ, nullptr, 0, 0, 1.f};
        pg8::gemm_phase<pg8::EpiBf16<0>, pg8::StaticOrder, true, true>(lds, g, S, E);
    } SEAM(1);
    if (IN(2)) { PHASE_IDS; phase_lmat(args, tid); } SEAM(2);
    if (IN(3)) {
        pg8::Gemm g{(const bf16*)(ws + WS_LBUF), (const bf16*)(ws + WS_WT_LORA), M, NLORA, opaque_i(KLORA)}; pg8::StaticOrder S; S.init(M, NLORA, gridDim.x, (int)blockIdx.x);
        pg8::EpiBf16<0> E{(bf16*)(ws + WS_DAG), NLORA, nullptr, 0, 0, 1.f};
        pg8::gemm_phase<pg8::EpiBf16<0>, pg8::StaticOrder, true, true>(lds, g, S, E);
    } SEAM(3);
    if (IN(4)) {
        PHASE_IDS;
        for (int u = blockIdx.x; u < BATCH * 8; u += gridDim.x) rwkv_unit(args, lds, u, tid, lane, wave);
        __syncthreads();
        STAMP(12);
#ifdef PROBE
        if (tid0 == 0) atomicMax(&tstamps[13], (unsigned long long)__builtin_amdgcn_s_memrealtime());
#endif
        for (int u = blockIdx.x; u < BATCH * 4; u += gridDim.x) mlstm_unit(args, lds, u, tid, lane, wave);
        if ((int)blockIdx.x >= BATCH * 4) late_transposes(args, lds, lane, wave, ((int)blockIdx.x - BATCH * 4) * 8 + wave, ((int)gridDim.x - BATCH * 4) * 8);
    } SEAM(4);
    if (IN(5)) {
        pg8::Gemm g{(const bf16*)(ws + WS_MIX), (const bf16*)(ws + WS_WT_OUT), M, DM, opaque_i(DM)}; pg8::StaticOrder S; S.init(M, DM, gridDim.x, (int)blockIdx.x);
        pg8::EpiResid E{args.in[0], nullptr, (bf16*)(ws + WS_XN), (float*)(ws + WS_SSQP)};
        pg8::gemm_phase<pg8::EpiResid, pg8::StaticOrder, true, true>(lds, g, S, E);
    } SEAM(5);
    if (IN(6)) {
        pg8::Gemm g{(const bf16*)(ws + WS_XN), (const bf16*)(ws + WS_WT_UP), M, NUP, opaque_i(DM)}; pg8::StaticOrder S; S.init(M, NUP, gridDim.x, (int)blockIdx.x);
        float* side = (float*)(ws + WS_SIDE); float* rs2 = (float*)(ws + WS_RS2);
        {
            PHASE_IDS; pg8::Unit u;
            for (int i = 0; S.next(i, u); ++i) if (tid < 256) { const int row = u.pm * 256 + tid; const f32x4* p = (const f32x4*)((const float*)(ws + WS_SSQP) + (size_t)row * 16); const f32x4 s0 = p[0], s1 = p[1], s2 = p[2], s3 = p[3];
                const float ss = ((s0[0] + s0[1]) + (s0[2] + s0[3])) + ((s1[0] + s1[1]) + (s1[2] + s1[3])) + ((s2[0] + s2[1]) + (s2[2] + s2[3])) + ((s3[0] + s3[1]) + (s3[2] + s3[3]));
                rs2[row] = frsq(ss * (1.0f / DM) + NORM_EPS); }
            asm volatile("s_waitcnt vmcnt(0)" ::: "memory"); __syncthreads();
        }
        pg8::EpiFfn E{(bf16*)(ws + WS_GB), rs2, args.in[22], args.in[23], side, side + SIDE_ELEMS, side + 2 * SIDE_ELEMS, (LAS float*)(lds + 131072 + 1024)};
        pg8::gemm_phase<pg8::EpiFfn, pg8::StaticOrder, true, true>(lds, g, S, E);
    } SEAM(6);
    if (IN(7)) { PHASE_IDS; phase_ffn_fix(args, tid); } SEAM(7);
    if (IN(8)) {
        pg8::Gemm g{(const bf16*)(ws + WS_GB), (const bf16*)(ws + WS_WT_DN), M, DM, opaque_i(DFF)}; pg8::StaticOrder S; S.init(M, DM, gridDim.x, (int)blockIdx.x);
        pg8::EpiBf16<0> E{(bf16*)(ws + WS_FF), DM, nullptr, 0, 0, 1.f};
        pg8::gemm_phase<pg8::EpiBf16<0>, pg8::StaticOrder, true, true>(lds, g, S, E);
    } SEAM(8);
#ifdef PROBE
    xcd_barrier(bar);
#endif
    if (IN(9)) { PHASE_IDS; phase_final(args, lane, wave); }
#undef IN
#undef SEAM
}

extern "C" void kernel_launch(void* const* d_in, const int* in_sizes, int n_in, void* d_out, int out_size, void* d_ws, size_t ws_size, hipStream_t stream) {
    static int grid = 0;
    if (grid == 0) {
        if (n_in != 26 || in_sizes[0] != M * DM || out_size != M * DM || ws_size < WS_END) { fprintf(stderr, "kernel_launch: unexpected shapes (n_in %d, in0 %d, out %d, ws %zu)\n", n_in, n_in > 0 ? in_sizes[0] : -1, out_size, ws_size); grid = -1; return; }
        int dev = 0, cus = 0, per_cu = 0;
        if (hipGetDevice(&dev) != hipSuccess || hipDeviceGetAttribute(&cus, hipDeviceAttributeMultiprocessorCount, dev) != hipSuccess) { grid = -1; return; }
        if (hipFuncSetAttribute((const void*)mega, hipFuncAttributeMaxDynamicSharedMemorySize, LDS_BYTES) != hipSuccess) { fprintf(stderr, "kernel_launch: hipFuncSetAttribute failed\n"); grid = -1; return; }
        if (hipOccupancyMaxActiveBlocksPerMultiprocessor(&per_cu, (const void*)mega, 512, LDS_BYTES) != hipSuccess || per_cu < 1) { fprintf(stderr, "kernel_launch: occupancy query says %d blocks per CU\n", per_cu); }
        (void)hipGetLastError();
        grid = cus;
        if (grid != 256) fprintf(stderr, "kernel_launch: %d CUs; this kernel is laid out for 256\n", grid);
    }
    if (grid < 0) return;
    (void)hipMemsetAsync((char*)d_ws + WS_CTL, 0, CTL_ZERO_BYTES, stream);
    Args a{};
    for (int i = 0; i < 26; ++i) a.in[i] = (const float*)d_in[i];
    a.out = (float*)d_out; a.ws = (unsigned char*)d_ws;
#if MK_SINGLE
    a.ph_lo = 0; a.ph_hi = N_PHASES;
    hipLaunchKernelGGL(mega, dim3(grid), dim3(512), LDS_BYTES, stream, a);
#else
    for (int p = 0; p < N_PHASES; ++p) { a.ph_lo = p; a.ph_hi = p + 1; hipLaunchKernelGGL(mega, dim3(grid), dim3(512), LDS_BYTES, stream, a); }
#endif
}
```

```cpp
#include <hip/hip_runtime.h>
#include <cstdio>
#include <cstdint>
namespace pg8 {
#define PG8_LAS __attribute__((address_space(3)))
typedef unsigned short bf16_t;
typedef short bf16x8 __attribute__((ext_vector_type(8)));
typedef float f32x4 __attribute__((ext_vector_type(4)));
typedef unsigned u32x4 __attribute__((ext_vector_type(4)));
constexpr int BM = 256, BK = 64, HALF = 128, HTB = HALF * BK * 2  , STAGE_BYTES = 8 * HTB, NXCD = 8, WGM = 8;

__host__ __device__ __forceinline__ int lds_byte(int r, int c) { const int st = (r >> 4) * 2 + (c >> 5), rr = r & 15, cc = c & 31, ob = rr * 64 + cc * 2; return st * 1024 + (ob ^ (((ob >> 9) & 1) << 5)); }
__host__ __device__ __forceinline__ void stage_rc(int b, int& R, int& C) { const int st = b / 1024, sb = b % 1024, swz = sb ^ (((sb >> 9) & 1) << 5); R = (st >> 1) * 16 + swz / 64; C = (st & 1) * 32 + (swz % 64) / 2; }
__host__ __device__ __forceinline__ int perm32(int rho) { const int n = rho >> 4, i = rho & 15; return 8 * (i >> 2) + 4 * n + (i & 3); }

struct Unit { int pm, pn; };
struct Gemm { const bf16_t* A; const bf16_t* Bt; int M, N, K; };

struct StaticOrder {
    int nM, nN, nwg, G, c;
    __host__ __device__ void init(int M, int N, int G_, int c_) { nM = M / BM; nN = N / BM; nwg = nM * nN; G = G_; c = c_; }
    __host__ __device__ bool next(int i, Unit& u) const {
        const long L = (long)i * G + c; if (L >= nwg) return false;
        int wgid = (int)L; { const int q = nwg / NXCD, r = nwg % NXCD, xcd = wgid % NXCD, off = wgid / NXCD; wgid = (xcd < r ? xcd * (q + 1) : r * (q + 1) + (xcd - r) * q) + off; }
        const int nig = WGM * nN, gid = wgid / nig, fm = gid * WGM, gsz = (nM - fm) < WGM ? (nM - fm) : WGM;
        u.pm = fm + ((wgid % nig) % gsz); u.pn = (wgid % nig) / gsz; return true;
    }
    __device__ __forceinline__ void a_ready(const Unit&) const {}
    __device__ __forceinline__ void done(const Unit&) const {}
};

__device__ __forceinline__ unsigned cvt_pk_bf16(float lo, float hi) { unsigned r; asm volatile("v_cvt_pk_bf16_f32 %0, %1, %2" : "=v"(r) : "v"(lo), "v"(hi)); return r; }
typedef float f32x2 __attribute__((ext_vector_type(2)));
__device__ __forceinline__ f32x2 gelu_pk(f32x2 v) {
    const f32x2 av = __builtin_elementwise_abs(v), d = av * 0.2316418882f + 1.0f;
    f32x2 t; t.x = __builtin_amdgcn_rcpf(d.x); t.y = __builtin_amdgcn_rcpf(d.y);
    f32x2 q = t * 0.5307027145f + (-0.7265760135f); q = q * t + 0.7107068705f; q = q * t + (-0.142248368f); q = q * t + 0.127414796f; q = q * t;
    const f32x2 s = (v * v) * (-0.72134752044f);
    f32x2 e; e.x = __builtin_amdgcn_exp2f(s.x); e.y = __builtin_amdgcn_exp2f(s.y);
    const f32x2 m = v * (q * e), r = v - m;
    f32x2 o; o.x = v.x < 0.f ? m.x : r.x; o.y = v.y < 0.f ? m.y : r.y; return o;
}

template <int ACT  > struct EpiBf16 {
    static constexpr bool PERM = true, AFTER_DRAIN = false; static_assert(ACT == 0 || ACT == 1, "EpiBf16: ACT is 0 (none) or 1 (gelu_pk)");
    bf16_t* O; int ldc; const float* bias; int split_cols; size_t split_stride; float scale0;
    __device__ __forceinline__ void operator()(const f32x4 (&acc)[2][2][4][2], const Unit& u, int wr, int wc, int fr, int fq) const {
        const int row0 = u.pm * BM + wr * 64 + fr; int colt = u.pn * BM; bf16_t* base = O;
        float sc = 1.f; if (split_cols) { const int t = colt / split_cols; base += (size_t)t * split_stride; colt -= t * split_cols; if (t == 0) sc = scale0; }
        const int col0 = colt + wc * 32 + 8 * fq, bcol0 = u.pn * BM + wc * 32 + 8 * fq;
        f32x4 bv[2][2];
#pragma unroll
        for (int bj = 0; bj < 2; ++bj)
#pragma unroll
            for (int n = 0; n < 2; ++n) bv[bj][n] = bias ? *(const f32x4*)(bias + bcol0 + bj * HALF + 4 * n) : (f32x4){0.f, 0.f, 0.f, 0.f};
#pragma unroll
        for (int ai = 0; ai < 2; ++ai)
#pragma unroll
            for (int m = 0; m < 4; ++m) { bf16_t* rowp = base + (size_t)(row0 + ai * HALF + m * 16) * ldc + col0;
#pragma unroll
                for (int bj = 0; bj < 2; ++bj) { f32x4 v0 = acc[ai][bj][m][0] + bv[bj][0], v1 = acc[ai][bj][m][1] + bv[bj][1];
                    if (ACT == 1) { f32x2 a = gelu_pk((f32x2){v0[0], v0[1]}), b = gelu_pk((f32x2){v0[2], v0[3]}), c = gelu_pk((f32x2){v1[0], v1[1]}), d = gelu_pk((f32x2){v1[2], v1[3]});
                        v0 = (f32x4){a.x, a.y, b.x, b.y}; v1 = (f32x4){c.x, c.y, d.x, d.y}; }
                    v0 = v0 * sc; v1 = v1 * sc; u32x4 w; w.x = cvt_pk_bf16(v0[0], v0[1]); w.y = cvt_pk_bf16(v0[2], v0[3]); w.z = cvt_pk_bf16(v1[0], v1[1]); w.w = cvt_pk_bf16(v1[2], v1[3]);
                    *(u32x4*)(rowp + bj * HALF) = w; } }
    }
};
template <class Epi, class Sched, bool ALIGN_EPI = false, bool SP2 = false>
__device__ __forceinline__ void gemm_phase(PG8_LAS unsigned char* lds, const Gemm g, const Sched& S, const Epi& E) {
    const int tid = threadIdx.x, wid = __builtin_amdgcn_readfirstlane(tid >> 6), lane = tid & 63, wr = wid >> 2, wc = wid & 3, fr = lane & 15, fq = lane >> 4;
    const int K = g.K, nt = K / BK;
    unsigned voffA[2], voffB[2];
#pragma unroll
    for (int i = 0; i < 2; ++i) { int R, C; stage_rc(tid * 16 + i * 8192, R, C); const int Rb = Epi::PERM ? ((R & ~31) + perm32(R & 31)) : R;
        voffA[i] = (unsigned)(R * K + C) * 2u; voffB[i] = (unsigned)(Rb * K + C) * 2u; }
    const size_t kstep = (size_t)(BK * 2);
    const size_t hstep = (size_t)HALF * K * 2;
    const size_t tstep = 2 * hstep;
    const unsigned ldsw = (unsigned)wid * 1024u;
    const int aoff = lds_byte(wr * 64 + fr, fq * 8), boff = lds_byte(wc * 32 + fr, fq * 8);
#define PG8_SA(b, h) (((b) * 2 + (h)) * HTB)
#define PG8_SB(b, h) ((4 + (b) * 2 + (h)) * HTB)
#define PG8_STAGE(bufoff, gbase, voff) do { _Pragma("unroll") for (int _i = 0; _i < 2; ++_i) \
        __builtin_amdgcn_global_load_lds((const unsigned*)((const char*)(gbase) + (voff)[_i]), (PG8_LAS unsigned*)(lds + (bufoff) + ldsw + _i * 8192), 16, 0, 0); } while (0)
#define PG8_LDA(dst, b, h) do { _Pragma("unroll") for (int m = 0; m < 4; ++m) _Pragma("unroll") for (int k = 0; k < 2; ++k) dst[m][k] = *(const PG8_LAS bf16x8*)(lds + PG8_SA(b, h) + aoff + m * 2048 + k * 1024); } while (0)
#define PG8_LDB(dst, b, h) do { _Pragma("unroll") for (int n = 0; n < 2; ++n) _Pragma("unroll") for (int k = 0; k < 2; ++k) dst[n][k] = *(const PG8_LAS bf16x8*)(lds + PG8_SB(b, h) + boff + n * 2048 + k * 1024); } while (0)
#define PG8_MMA(ai, bj, At, Bt) do { __builtin_amdgcn_s_setprio(1); _Pragma("unroll") for (int m = 0; m < 4; ++m) _Pragma("unroll") for (int n = 0; n < 2; ++n) _Pragma("unroll") for (int k = 0; k < 2; ++k) \
        acc[ai][bj][m][n] = __builtin_amdgcn_mfma_f32_16x16x32_bf16(Bt[n][k], At[m][k], acc[ai][bj][m][n], 0, 0, 0); __builtin_amdgcn_s_setprio(0); } while (0)
#define PG8_WAIT_V(n) asm volatile("s_waitcnt vmcnt(" #n ")" ::: "memory")
#define PG8_WAIT_L(n) asm volatile("s_waitcnt lgkmcnt(" #n ")" ::: "memory")
#define PG8_BAR __builtin_amdgcn_s_barrier()
#define PG8_SCHED __builtin_amdgcn_sched_barrier(0)
    Unit cur, nxt; int ui = 0;
    if (!S.next(0, cur)) return;
    f32x4 acc[2][2][4][2];
#pragma unroll
    for (int a = 0; a < 2; ++a)
#pragma unroll
        for (int b = 0; b < 2; ++b)
#pragma unroll
            for (int m = 0; m < 4; ++m)
#pragma unroll
                for (int n = 0; n < 2; ++n) acc[a][b][m][n] = (f32x4){0.f, 0.f, 0.f, 0.f};
    bf16x8 At[4][2], B0[2][2], B1[2][2];
    const char* cA = (const char*)g.A + (size_t)cur.pm * tstep; const char* cB = (const char*)g.Bt + (size_t)cur.pn * tstep;
    S.a_ready(cur);
    if constexpr (SP2) {
        PG8_STAGE(PG8_SB(0, 0), cB, voffB); PG8_STAGE(PG8_SB(0, 1), cB + hstep, voffB); PG8_STAGE(PG8_SA(0, 0), cA, voffA); PG8_STAGE(PG8_SA(0, 1), cA + hstep, voffA);
        if (wr == 1) PG8_BAR;
        PG8_WAIT_V(2); PG8_BAR;
        PG8_STAGE(PG8_SB(1, 0), cB + kstep, voffB); PG8_STAGE(PG8_SA(1, 0), cA + kstep, voffA); PG8_STAGE(PG8_SB(1, 1), cB + hstep + kstep, voffB);
        PG8_WAIT_V(6); PG8_BAR;
    } else {
        PG8_STAGE(PG8_SB(0, 0), cB, voffB); PG8_STAGE(PG8_SA(0, 0), cA, voffA); PG8_STAGE(PG8_SB(0, 1), cB + hstep, voffB); PG8_STAGE(PG8_SA(0, 1), cA + hstep, voffA);
        if (wr == 1) PG8_BAR;
        PG8_WAIT_V(4); PG8_BAR;
        PG8_STAGE(PG8_SB(1, 0), cB + kstep, voffB); PG8_STAGE(PG8_SA(1, 0), cA + kstep, voffA); PG8_STAGE(PG8_SB(1, 1), cB + hstep + kstep, voffB);
        PG8_WAIT_V(6); PG8_BAR;
    }
    for (;;) {
        const bool has_next = S.next(ui + 1, nxt);
        const char* nA = has_next ? (const char*)g.A + (size_t)nxt.pm * tstep : cA; const char* nB = has_next ? (const char*)g.Bt + (size_t)nxt.pn * tstep : cB;
        for (int t = 0; t < nt; t += 2) {
            const bool last = (t == nt - 2);
            const char* a1 = cA + (size_t)(t + 1) * kstep;
            const char* a2 = last ? nA : cA + (size_t)(t + 2) * kstep; const char* b2 = last ? nB : cB + (size_t)(t + 2) * kstep;
            const char* a3 = a2 + kstep; const char* b3 = b2 + kstep;
            if (last && has_next) S.a_ready(nxt);
            if constexpr (SP2) {
            PG8_LDB(B0, 0, 0); PG8_LDB(B1, 0, 1); PG8_SCHED; PG8_LDA(At, 0, 0); PG8_STAGE(PG8_SA(1, 1), a1 + hstep, voffA);
            PG8_WAIT_V(8); PG8_WAIT_L(0); PG8_BAR; PG8_MMA(0, 0, At, B0); PG8_MMA(0, 1, At, B1); PG8_BAR; PG8_SCHED;
            PG8_LDA(At, 0, 1); PG8_STAGE(PG8_SB(0, 0), b2, voffB); PG8_STAGE(PG8_SB(0, 1), b2 + hstep, voffB); PG8_STAGE(PG8_SA(0, 0), a2, voffA);
            PG8_WAIT_V(8); PG8_WAIT_L(0); PG8_BAR; PG8_MMA(1, 0, At, B0); PG8_MMA(1, 1, At, B1); PG8_BAR; PG8_SCHED;
            PG8_LDB(B0, 1, 0); PG8_LDB(B1, 1, 1); PG8_SCHED; PG8_LDA(At, 1, 0); PG8_STAGE(PG8_SA(0, 1), a2 + hstep, voffA);
            PG8_WAIT_V(8); PG8_WAIT_L(0); PG8_BAR; PG8_MMA(0, 0, At, B0); PG8_MMA(0, 1, At, B1); PG8_BAR; PG8_SCHED;
            PG8_LDA(At, 1, 1); PG8_STAGE(PG8_SB(1, 0), b3, voffB); PG8_STAGE(PG8_SB(1, 1), b3 + hstep, voffB); PG8_STAGE(PG8_SA(1, 0), a3, voffA);
            PG8_WAIT_V(8); PG8_WAIT_L(0); PG8_BAR; PG8_MMA(1, 0, At, B0); PG8_MMA(1, 1, At, B1); PG8_BAR; PG8_SCHED;
            } else {
            PG8_LDB(B0, 0, 0); PG8_SCHED; PG8_LDA(At, 0, 0); PG8_STAGE(PG8_SA(1, 1), a1 + hstep, voffA);
            PG8_WAIT_L(8); PG8_BAR; PG8_WAIT_L(0); PG8_MMA(0, 0, At, B0); PG8_BAR; PG8_SCHED;
            PG8_LDB(B1, 0, 1); PG8_STAGE(PG8_SB(0, 0), b2, voffB);
            PG8_BAR; PG8_WAIT_L(0); PG8_MMA(0, 1, At, B1); PG8_BAR;
            PG8_LDA(At, 0, 1); PG8_STAGE(PG8_SA(0, 0), a2, voffA);
            PG8_BAR; PG8_WAIT_L(0); PG8_MMA(1, 0, At, B0); PG8_BAR; PG8_SCHED;
            PG8_STAGE(PG8_SB(0, 1), b2 + hstep, voffB);
            PG8_WAIT_V(6); PG8_BAR; PG8_MMA(1, 1, At, B1); PG8_BAR;
            PG8_LDB(B0, 1, 0); PG8_SCHED; PG8_LDA(At, 1, 0); PG8_STAGE(PG8_SA(0, 1), a2 + hstep, voffA);
            PG8_WAIT_L(8); PG8_BAR; PG8_WAIT_L(0); PG8_MMA(0, 0, At, B0); PG8_BAR; PG8_SCHED;
            PG8_LDB(B1, 1, 1); PG8_STAGE(PG8_SB(1, 0), b3, voffB);
            PG8_BAR; PG8_WAIT_L(0); PG8_MMA(0, 1, At, B1); PG8_BAR;
            PG8_LDA(At, 1, 1); PG8_STAGE(PG8_SA(1, 0), a3, voffA);
            PG8_BAR; PG8_WAIT_L(0); PG8_MMA(1, 0, At, B0); PG8_BAR; PG8_SCHED;
            PG8_STAGE(PG8_SB(1, 1), b3 + hstep, voffB);
            PG8_WAIT_V(6); PG8_BAR; PG8_MMA(1, 1, At, B1); PG8_BAR;
            }
        }
        if constexpr (ALIGN_EPI) { if (wr == 0) PG8_BAR; }
        if constexpr (!Epi::AFTER_DRAIN) { E(acc, cur, wr, wc, fr, fq); S.done(cur); }
        if (!has_next) break;
#pragma unroll
        for (int a = 0; a < 2; ++a)
#pragma unroll
            for (int b = 0; b < 2; ++b)
#pragma unroll
                for (int m = 0; m < 4; ++m)
#pragma unroll
                    for (int n = 0; n < 2; ++n) acc[a][b][m][n] = (f32x4){0.f, 0.f, 0.f, 0.f};
        cur = nxt; cA = nA; cB = nB; ++ui;
        if constexpr (ALIGN_EPI) { if (wr == 1) PG8_BAR; }
    }
    PG8_WAIT_V(0);
    if constexpr (!ALIGN_EPI) { if (wr == 0) PG8_BAR; }
    PG8_BAR;
    if constexpr (Epi::AFTER_DRAIN) { E.fused(acc, cur, wr, wc, fr, fq, lds, wid, lane); S.done(cur); }
#undef PG8_SA
#undef PG8_SB
#undef PG8_STAGE
#undef PG8_LDA
#undef PG8_LDB
#undef PG8_MMA
#undef PG8_WAIT_V
#undef PG8_WAIT_L
#undef PG8_BAR
#undef PG8_SCHED
}
}

#ifndef MK_SINGLE
#define MK_SINGLE 1
#endif
constexpr int BATCH = 32, SEQ = 2048, DM = 1024, M = BATCH * SEQ;
constexpr int NIN = 3336, NPROJ = 3328;
constexpr int DFF = 2816, NUP = 2 * DFF;
constexpr int C_Q = 1792, C_K = 2048, C_V = 2304, C_O = 2816;
constexpr int NLORA = 1536, KLORA = 256;
constexpr int MH = M / 2;
constexpr float NORM_EPS = 1e-6f, LNX_EPS = 64e-5f;

constexpr size_t MiB = 1u << 20;
constexpr size_t WS_CTL = 0, CTL_ZERO_BYTES = 1 * MiB;
constexpr size_t WS_WT_IN = 2 * MiB, WS_WT_OUT = 9 * MiB, WS_WT_UP = 11 * MiB, WS_WT_DN = 22 * MiB, WS_WT_LORA = 28 * MiB;
constexpr size_t WS_RS2 = 29 * MiB, WS_RINV = 29 * MiB + 512 * 1024, WS_SSQP = 30 * MiB, WS_GATES = 34 * MiB;
constexpr size_t WS_XN = 40 * MiB;
constexpr size_t WS_PROJ = 168 * MiB;
constexpr size_t WS_LBUF = 584 * MiB;
constexpr size_t WS_DAG = 616 * MiB;
constexpr size_t WS_MIX = 808 * MiB;
constexpr size_t WS_SIDE = 168 * MiB;
constexpr int SIDE_ELEMS = 256 * 22 * 2 * 128;
constexpr size_t WS_FF = 192 * MiB;
constexpr size_t WS_GB = 520 * MiB;
constexpr size_t WS_END = 936 * MiB;

constexpr int LDS_BYTES = 163840;
constexpr int MISC_OFF = LDS_BYTES - 256;

#define GAS __attribute__((address_space(1)))
#define LAS __attribute__((address_space(3)))
typedef unsigned short bf16;
typedef unsigned v4u __attribute__((ext_vector_type(4)));
typedef unsigned v2u __attribute__((ext_vector_type(2)));
typedef float f32x4 __attribute__((ext_vector_type(4)));
typedef float f32x2 __attribute__((ext_vector_type(2)));
typedef short bf16x8 __attribute__((ext_vector_type(8)));
typedef GAS unsigned gu32;

typedef __bf16 bf16x2_t __attribute__((ext_vector_type(2)));
__device__ __forceinline__ unsigned pk2(float lo, float hi) { const f32x2 v = {lo, hi}; const bf16x2_t b = __builtin_convertvector(v, bf16x2_t); return __builtin_bit_cast(unsigned, b); }
__device__ __forceinline__ unsigned f2bf(float f) { return pk2(f, f) & 0xffffu; }
__device__ __forceinline__ float bf2f(unsigned short u) { return __builtin_bit_cast(float, (unsigned)u << 16); }
__device__ __forceinline__ float bflo(unsigned w) { return __builtin_bit_cast(float, w << 16); }
__device__ __forceinline__ float bfhi(unsigned w) { return __builtin_bit_cast(float, w & 0xffff0000u); }
__device__ __forceinline__ void unpack8(const v4u w, float (&o)[8]) { o[0] = bflo(w.x); o[1] = bfhi(w.x); o[2] = bflo(w.y); o[3] = bfhi(w.y); o[4] = bflo(w.z); o[5] = bfhi(w.z); o[6] = bflo(w.w); o[7] = bfhi(w.w); }
__device__ __forceinline__ v4u pack8(const float (&o)[8]) { v4u w; w.x = pk2(o[0], o[1]); w.y = pk2(o[2], o[3]); w.z = pk2(o[4], o[5]); w.w = pk2(o[6], o[7]); return w; }
__device__ __forceinline__ float frcp(float x) { return __builtin_amdgcn_rcpf(x); }
__device__ __forceinline__ float frsq(float x) { return __builtin_amdgcn_rsqf(x); }
__device__ __forceinline__ float fsqrt_(float x) { return __builtin_amdgcn_sqrtf(x); }
__device__ __forceinline__ float fexp(float x) { return __builtin_amdgcn_exp2f(x * 1.4426950408889634f); }
__device__ __forceinline__ float sigmoidf_(float x) { return frcp(1.0f + __builtin_amdgcn_exp2f(x * -1.4426950408889634f)); }
__device__ __forceinline__ float tanhf_(float x) { return 1.0f - 2.0f * frcp(__builtin_amdgcn_exp2f(x * 2.8853900817779268f) + 1.0f); }
__device__ __forceinline__ float softplusf_(float x) { return fmaxf(x, 0.f) + __logf(1.0f + fexp(-fabsf(x))); }
__device__ __forceinline__ float wave_sum(float v) {
#pragma unroll
    for (int o = 1; o < 64; o <<= 1) v += __shfl_xor(v, o);
    return v;
}
template <int CTRL> __device__ __forceinline__ float dppmov(float v) { return __builtin_bit_cast(float, __builtin_amdgcn_update_dpp(0, __builtin_bit_cast(int, v), CTRL, 0xF, 0xF, true)); }
__device__ __forceinline__ float red8(float v) { v += dppmov<0xB1>(v); v += dppmov<0x4E>(v); v += dppmov<0x141>(v); return v; }
__device__ __forceinline__ float red16(float v) { v += dppmov<0xB1>(v); v += dppmov<0x4E>(v); v += dppmov<0x141>(v); v += dppmov<0x140>(v); return v; }

template <int CTRL, int RMASK> __device__ __forceinline__ float dppsh(float idv, float v) { return __builtin_bit_cast(float, __builtin_amdgcn_update_dpp(__builtin_bit_cast(int, idv), __builtin_bit_cast(int, v), CTRL, RMASK, 0xF, false)); }
__device__ __forceinline__ float wave_scan_add(float v) {
    v += dppsh<0x111, 0xF>(0.f, v); v += dppsh<0x112, 0xF>(0.f, v); v += dppsh<0x114, 0xF>(0.f, v); v += dppsh<0x118, 0xF>(0.f, v);
    v += dppsh<0x142, 0xA>(0.f, v); v += dppsh<0x143, 0xC>(0.f, v); return v;
}
__device__ __forceinline__ float wave_scan_max(float v) {
    const float ni = -3.0e38f;
    v = fmaxf(v, dppsh<0x111, 0xF>(ni, v)); v = fmaxf(v, dppsh<0x112, 0xF>(ni, v)); v = fmaxf(v, dppsh<0x114, 0xF>(ni, v)); v = fmaxf(v, dppsh<0x118, 0xF>(ni, v));
    v = fmaxf(v, dppsh<0x142, 0xA>(ni, v)); v = fmaxf(v, dppsh<0x143, 0xC>(ni, v)); return v;
}

#define XB_TMO      128
#define XB_XCNT(j)  (256  + 64 * (j))
#define XB_XSUB(j)  (1280 + 64 * (j))
#define XB_XGEN(j)  (2304 + 64 * (j))
#define XB_TOP      3328
#define XB_TOPGEN   3392
#define XCD_BAR_WORDS 3456
#define XB_SPIN_CAP (1u << 22)
__device__ __forceinline__ unsigned xb_ld(unsigned* p)              { return __hip_atomic_load(p, __ATOMIC_RELAXED, __HIP_MEMORY_SCOPE_AGENT); }
__device__ __forceinline__ unsigned xb_add(unsigned* p, unsigned v) { return __hip_atomic_fetch_add(p, v, __ATOMIC_RELAXED, __HIP_MEMORY_SCOPE_AGENT); }
__device__ __forceinline__ unsigned xb_xcc_id() { return (unsigned)__builtin_amdgcn_s_getreg((3 << 11) | 20) & 0xFu; }
#define XB_SPIN(cond, bar) do { unsigned _sp = 0; while (cond) { __builtin_amdgcn_s_sleep(1); \
    if ((++_sp & 255u) == 0u) { if (xb_ld(&(bar)[XB_TMO])) break; if (_sp > XB_SPIN_CAP) { atomicAdd(&(bar)[XB_TMO], 1u); break; } } } } while (0)
struct XcdBarrier { unsigned* bar; unsigned x; volatile LAS unsigned* st; };
__device__ __forceinline__ XcdBarrier xcd_barrier_post(unsigned* bar, volatile LAS unsigned* st) {
    XcdBarrier b; b.bar = bar; b.x = xb_xcc_id(); b.st = st;
    if (threadIdx.x == 0) (void)xb_add(&bar[XB_XCNT(b.x)], 1u);
    return b;
}
__device__ __forceinline__ void xcd_barrier_complete(unsigned* bar, unsigned x, unsigned& nloc, unsigned& nx) {
    const unsigned G = gridDim.x * gridDim.y * gridDim.z;
    unsigned sum, cnt, mine, sp = 0u;
    for (;;) {
        sum = 0u; cnt = 0u; mine = 0u;
#pragma unroll
        for (unsigned j = 0; j < 16; ++j) { const unsigned c = xb_ld(&bar[XB_XCNT(j)]); sum += c; cnt += (c > 0u) ? 1u : 0u; mine = (j == x) ? c : mine; }
        if (sum == G) break;
        __builtin_amdgcn_s_sleep(1);
        if ((++sp & 255u) == 0u) { if (xb_ld(&bar[XB_TMO])) break; if (sp > XB_SPIN_CAP) { atomicAdd(&bar[XB_TMO], 1u); break; } }
    }
    nloc = mine > 0u ? mine : 1u; nx = cnt > 0u ? cnt : 1u;
}
__device__ __forceinline__ void xcd_barrier(const XcdBarrier& b) {
    asm volatile("s_waitcnt vmcnt(0)" ::: "memory");
    __syncthreads();
    if (threadIdx.x == 0) {
        unsigned* bar = b.bar;
        __builtin_amdgcn_s_waitcnt(0);
        unsigned nloc = b.st[0], nx = b.st[1];
        if (nloc == 0u) { xcd_barrier_complete(bar, b.x, nloc, nx); b.st[0] = nloc; b.st[1] = nx; }
        const unsigned old = xb_add(&bar[XB_XSUB(b.x)], 1u);
        const unsigned gen = old / nloc;
        if (old + 1u == (gen + 1u) * nloc) {
            __builtin_amdgcn_fence(__ATOMIC_RELEASE, "agent");
            asm volatile("s_waitcnt vmcnt(0)" ::: "memory");
            const unsigned og = xb_add(&bar[XB_TOP], 1u);
            const unsigned tg = og / nx;
            if (og + 1u == (tg + 1u) * nx) xb_add(&bar[XB_TOPGEN], 1u);
            else XB_SPIN(xb_ld(&bar[XB_TOPGEN]) == tg, bar);
            __builtin_amdgcn_fence(__ATOMIC_ACQUIRE, "agent");
            xb_add(&bar[XB_XGEN(b.x)], 1u);
            asm volatile("s_waitcnt vmcnt(0)" ::: "memory");
        } else {
            XB_SPIN(xb_ld(&bar[XB_XGEN(b.x)]) == gen, bar);
            __builtin_amdgcn_fence(__ATOMIC_ACQUIRE, "agent");
            asm volatile("s_waitcnt vmcnt(0)" ::: "memory");
        }
    }
    __syncthreads();
}

__device__ __forceinline__ int opaque_i(int v) { asm volatile("" : "+s"(v)); return v; }
#define LDS_BARRIER() do { asm volatile("s_waitcnt lgkmcnt(0)" ::: "memory"); __builtin_amdgcn_s_barrier(); asm volatile("" ::: "memory"); } while (0)
struct Args { const float* in[26]; float* out; unsigned char* ws; int ph_lo, ph_hi; };

namespace pg8 {
struct PairPanelOrder {
    int c;
    __device__ bool next(int i, Unit& u) const { if (i >= 12) return false; u.pm = 2 * c + i / 6; u.pn = i % 6; return true; }
    __device__ __forceinline__ void a_ready(const Unit&) const {}
    __device__ __forceinline__ void done(const Unit&) const {}
};
struct PanelOrder {
    int c;
    __device__ bool next(int i, Unit& u) const { if (i >= 4) return false; u.pm = c; u.pn = i; return true; }
    __device__ __forceinline__ void a_ready(const Unit&) const {}
    __device__ __forceinline__ void done(const Unit&) const {}
};
struct EpiResid {
    static constexpr bool PERM = true, AFTER_DRAIN = false;
    bf16_t* XB; const float* rinv; float* ssqp;
    __device__ __forceinline__ void operator()(const f32x4 (&acc)[2][2][4][2], const Unit& u, int wr, int wc, int fr, int fq) const {
        const int row0 = u.pm * BM + wr * 64 + fr, col0 = u.pn * BM + wc * 32 + 8 * fq;
#pragma unroll
        for (int ai = 0; ai < 2; ++ai)
#pragma unroll
            for (int m = 0; m < 4; ++m) { const int row = row0 + ai * HALF + m * 16; float ss = 0.f; const float ri = rinv[row];
#pragma unroll
                for (int bj = 0; bj < 2; ++bj) { const size_t off = (size_t)row * DM + col0 + bj * HALF;
                    float xv[8]; unpack8(*(const u32x4*)(XB + off), xv);
                    float v[8];
#pragma unroll
                    for (int j = 0; j < 4; ++j) { v[j] = acc[ai][bj][m][0][j] + xv[j] * ri; v[4 + j] = acc[ai][bj][m][1][j] + xv[4 + j] * ri; }
#pragma unroll
                    for (int j = 0; j < 8; ++j) ss += v[j] * v[j];
                    *(u32x4*)(XB + off) = pack8(v); }
                ss += __shfl_xor(ss, 16); ss += __shfl_xor(ss, 32);
                if (fq == 0) ssqp[(size_t)row * 16 + u.pn * 4 + wc] = ss; }
    }
};
struct EpiScale {
    static constexpr bool PERM = true, AFTER_DRAIN = false;
    bf16_t* O; int ldc; const float* rs; int row_off;
    __device__ __forceinline__ void operator()(const f32x4 (&acc)[2][2][4][2], const Unit& u, int wr, int wc, int fr, int fq) const {
        const int row0 = u.pm * BM + wr * 64 + fr, col0 = u.pn * BM + wc * 32 + 8 * fq;
#pragma unroll
        for (int ai = 0; ai < 2; ++ai)
#pragma unroll
            for (int m = 0; m < 4; ++m) { const int row = row0 + ai * HALF + m * 16; const float s = rs[row_off + row]; bf16_t* rowp = O + (size_t)row * ldc + col0;
#pragma unroll
                for (int bj = 0; bj < 2; ++bj) { const f32x4 v0 = acc[ai][bj][m][0] * s, v1 = acc[ai][bj][m][1] * s;
                    u32x4 w; w.x = pk2(v0[0], v0[1]); w.y = pk2(v0[2], v0[3]); w.z = pk2(v1[0], v1[1]); w.w = pk2(v1[2], v1[3]); *(u32x4*)(rowp + bj * HALF) = w; } }
    }
};
struct EpiFfn {
    static constexpr bool PERM = true, AFTER_DRAIN = false;
    bf16_t* G; const float* rs; const float* cw; const float* cb; float* SA; float* SB; float* SL; LAS float* hal;
    __device__ __forceinline__ void operator()(const f32x4 (&acc)[2][2][4][2], const Unit& u, int wr, int wc, int fr, int fq) const {
        int chl = wc * 32 + 8 * fq; asm volatile("" : "+v"(chl));
        const int f0 = u.pn * 128 + chl, rowt = wr * 64 + fr;
        float rsv[2][4];
#pragma unroll
        for (int ai = 0; ai < 2; ++ai)
#pragma unroll
            for (int m = 0; m < 4; ++m) rsv[ai][m] = rs[u.pm * BM + ai * HALF + m * 16 + rowt];
        const size_t sbase = ((size_t)(u.pm * 22 + u.pn) * 2) * 128 + chl;
        if (fr >= 14) {
#pragma unroll
            for (int ai = 0; ai < 2; ++ai) { const float r_ = rsv[ai][3]; const f32x4 v0 = acc[ai][0][3][0] * r_, v1 = acc[ai][0][3][1] * r_;
                LAS float* hp = hal + ((ai * 2 + wr) * 2 + (fr - 14)) * 128 + chl; *(LAS f32x4*)hp = v0; *(LAS f32x4*)(hp + 4) = v1;
                if (ai == 1 && wr == 1) { float* gp = SL + sbase + (fr - 14) * 128; *(f32x4*)gp = v0; *(f32x4*)(gp + 4) = v1; } }
        }
        if (wr == 0 && fr < 2) { const float r_ = rsv[0][0]; float* ga = SA + sbase + fr * 128; float* gb = SB + sbase + fr * 128;
            *(f32x4*)ga = acc[0][0][0][0] * r_; *(f32x4*)(ga + 4) = acc[0][0][0][1] * r_; *(f32x4*)gb = acc[0][1][0][0] * r_; *(f32x4*)(gb + 4) = acc[0][1][0][1] * r_; }
        asm volatile("s_waitcnt lgkmcnt(0)" ::: "memory"); __builtin_amdgcn_s_barrier(); asm volatile("" ::: "memory");
        float w0[8], w1[8], w2[8], bz[8];
        { const f32x4 a0 = *(const f32x4*)(cw + f0), a1 = *(const f32x4*)(cw + f0 + 4), b0 = *(const f32x4*)(cw + DFF + f0), b1 = *(const f32x4*)(cw + DFF + f0 + 4);
          const f32x4 c0 = *(const f32x4*)(cw + 2 * DFF + f0), c1 = *(const f32x4*)(cw + 2 * DFF + f0 + 4), d0 = *(const f32x4*)(cb + f0), d1 = *(const f32x4*)(cb + f0 + 4);
#pragma unroll
          for (int j = 0; j < 4; ++j) { w0[j] = a0[j]; w0[4 + j] = a1[j]; w1[j] = b0[j]; w1[4 + j] = b1[j]; w2[j] = c0[j]; w2[4 + j] = c1[j]; bz[j] = d0[j]; bz[4 + j] = d1[j]; } }
        const bool fr0 = (fr == 0), frl2 = (fr < 2);
#pragma unroll
        for (int ai = 0; ai < 2; ++ai) {
            float ap[8];
            const int pb = ai * 2 + wr - 1;
#pragma unroll
            for (int m = 0; m < 4; ++m) {
                float av[8], bv[8], y1[8], y2[8];
                const float r_ = rsv[ai][m];
#pragma unroll
                for (int j = 0; j < 4; ++j) { av[j] = acc[ai][0][m][0][j] * r_; av[4 + j] = acc[ai][0][m][1][j] * r_; bv[j] = acc[ai][1][m][0][j] * r_; bv[4 + j] = acc[ai][1][m][1][j] * r_; }
                if (m == 0) {
                    if (pb >= 0) { const LAS float* h0 = hal + (pb * 2) * 128 + chl; const f32x4 h00 = *(const LAS f32x4*)h0, h01 = *(const LAS f32x4*)(h0 + 4), h10 = *(const LAS f32x4*)(h0 + 128), h11 = *(const LAS f32x4*)(h0 + 132);
#pragma unroll
                        for (int j = 0; j < 4; ++j) { y1[j] = h10[j]; y1[4 + j] = h11[j]; y2[j] = fr0 ? h00[j] : h10[j]; y2[4 + j] = fr0 ? h01[j] : h11[j]; } }
                    else {
#pragma unroll
                        for (int j = 0; j < 8; ++j) { y1[j] = 0.f; y2[j] = 0.f; } }
                } else {
#pragma unroll
                    for (int j = 0; j < 8; ++j) { y1[j] = dppmov<0x121>(ap[j]); y2[j] = dppmov<0x122>(ap[j]); }
                }
                float o[8];
#pragma unroll
                for (int j = 0; j < 8; ++j) { const float x1 = dppmov<0x121>(av[j]), x2 = dppmov<0x122>(av[j]);
                    const float am1 = fr0 ? y1[j] : x1, am2 = frl2 ? y2[j] : x2;
                    const float z = bz[j] + w0[j] * am2 + w1[j] * am1 + w2[j] * av[j];
                    o[j] = z * sigmoidf_(z) * bv[j]; ap[j] = av[j]; }
                if (!(ai == 0 && m == 0 && wr == 0 && frl2)) *(u32x4*)(G + (size_t)(u.pm * BM + ai * HALF + m * 16 + rowt) * DFF + f0) = pack8(o);
            }
        }
    }
};
}

template <bool FFN_UP = false>
__device__ __forceinline__ void transpose_item(const float* W, int ldw, int K, bf16* WT, const float* kscale, LAS float* scr, int item, int nblk, int lane) {
    const int kb = item / nblk, nb = item % nblk, k0 = 64 * kb, n0 = 32 * nb;
    const int d0 = !FFN_UP ? n0 : (n0 < DFF ? ((n0 >> 7) * 256 + (n0 & 127)) : ((((n0 - DFF) >> 7) * 256) + 128 + ((n0 - DFF) & 127)));
#pragma unroll 8
    for (int i = 0; i < 32; ++i) { const int kk = 2 * i + (lane >> 5); const float s = kscale ? kscale[k0 + kk] : 1.0f; scr[kk * 33 + (lane & 31)] = W[(size_t)(k0 + kk) * ldw + n0 + (lane & 31)] * s; }
    asm volatile("s_waitcnt lgkmcnt(0)" ::: "memory");
    const int c = lane & 7;
#pragma unroll
    for (int j = 0; j < 4; ++j) { const int n = (lane >> 3) + 8 * j; const LAS float* s = scr + (8 * c) * 33 + n;
        v4u o; o.x = pk2(s[0 * 33], s[1 * 33]); o.y = pk2(s[2 * 33], s[3 * 33]); o.z = pk2(s[4 * 33], s[5 * 33]); o.w = pk2(s[6 * 33], s[7 * 33]);
        *(v4u*)(WT + (size_t)(d0 + n) * K + k0 + 8 * c) = o; }
    asm volatile("s_waitcnt lgkmcnt(0)" ::: "memory");
}

__device__ __forceinline__ float wave_red63(float v) {
    v += dppmov<0xB1>(v); v += dppmov<0x4E>(v); v += dppmov<0x141>(v); v += dppmov<0x140>(v);
    v += dppsh<0x142, 0xA>(0.f, v); v += dppsh<0x143, 0xC>(0.f, v); return v;
}
__device__ __forceinline__ float lane63(float v) { return __builtin_bit_cast(float, __builtin_amdgcn_readlane(__builtin_bit_cast(int, v), 63)); }
__device__ __forceinline__ void late_transposes(const Args& a, LAS unsigned char* lds, int lane, int wave, int gw, int NGW) {
    unsigned char* ws = a.ws; LAS float* scr = (LAS float*)(lds + wave * 16384);
    constexpr int I_OUT = 16 * 32, I_UP = 16 * 176, I_DN = 44 * 32;
    for (int it = gw; it < I_OUT + I_UP + I_DN; it += NGW) {
        int r = it;
        if (r < I_OUT) { transpose_item(a.in[19], DM, DM, (bf16*)(ws + WS_WT_OUT), nullptr, scr, r, 32, lane); continue; } r -= I_OUT;
        if (r < I_UP) { transpose_item<true>(a.in[21], NUP, DM, (bf16*)(ws + WS_WT_UP), a.in[20], scr, r, 176, lane); continue; } r -= I_UP;
        transpose_item(a.in[24], DM, DFF, (bf16*)(ws + WS_WT_DN), nullptr, scr, r, 32, lane);
    }
}
__device__ __forceinline__ void phase_prep(const Args& a, LAS unsigned char* lds, int tid, int lane, int wave) {
    unsigned char* ws = a.ws;
    LAS float* scr = (LAS float*)(lds + wave * 16384);
    const int gw = blockIdx.x * 8 + wave, NGW = gridDim.x * 8;
    constexpr int I_IN = 16 * 104;
    for (int it = gw; it < I_IN; it += NGW) transpose_item(a.in[2], NIN, DM, (bf16*)(ws + WS_WT_IN), a.in[1], scr, it, 104, lane);
    {
        const float* wd = a.in[5]; const float* wa = a.in[7]; const float* wg = a.in[8]; bf16* WL = (bf16*)(ws + WS_WT_LORA);
        for (int idx = blockIdx.x * 512 + tid; idx < NLORA * KLORA; idx += gridDim.x * 512) {
            const int n = idx >> 8, k = idx & 255; float v = 0.f;
            if (n < 512) { if (k < 64) v = wd[k * 512 + n]; }
            else if (n < 1024) { if (k >= 64 && k < 128) v = wa[(k - 64) * 512 + (n - 512)]; }
            else { if (k >= 128) v = wg[(k - 128) * 512 + (n - 1024)]; }
            WL[idx] = (bf16)f2bf(v);
        }
    }
    {
        const float* x = a.in[0]; const float* g1 = a.in[1]; const float* w_in = a.in[2];
        bf16* XN = (bf16*)(ws + WS_XN); float* gates = (float*)(ws + WS_GATES); float* rinvp = (float*)(ws + WS_RINV);
        float wgt[16][8];
#pragma unroll
        for (int j = 0; j < 4; ++j)
#pragma unroll
            for (int e = 0; e < 4; ++e) { const int k = 4 * lane + 256 * j + e; const float g = g1[k];
                const f32x4 w0 = *(const f32x4*)(w_in + (size_t)k * NIN + 3328), w1 = *(const f32x4*)(w_in + (size_t)k * NIN + 3332);
                wgt[j * 4 + e][0] = w0[0] * g; wgt[j * 4 + e][1] = w0[1] * g; wgt[j * 4 + e][2] = w0[2] * g; wgt[j * 4 + e][3] = w0[3] * g;
                wgt[j * 4 + e][4] = w1[0] * g; wgt[j * 4 + e][5] = w1[1] * g; wgt[j * 4 + e][6] = w1[2] * g; wgt[j * 4 + e][7] = w1[3] * g; }
        f32x4 vn[4];
        { const f32x4* xr = (const f32x4*)(x + (size_t)gw * DM) + lane;
#pragma unroll
          for (int j = 0; j < 4; ++j) vn[j] = xr[64 * j]; }
        for (int row = gw; row < M; row += NGW) {
            f32x4 v[4];
#pragma unroll
            for (int j = 0; j < 4; ++j) v[j] = vn[j];
            { const int rn = (row + NGW < M) ? row + NGW : row; const f32x4* xr = (const f32x4*)(x + (size_t)rn * DM) + lane;
#pragma unroll
              for (int j = 0; j < 4; ++j) vn[j] = xr[64 * j]; }
            float ss = 0.f;
#pragma unroll
            for (int j = 0; j < 4; ++j) ss += (v[j][0] * v[j][0] + v[j][1] * v[j][1]) + (v[j][2] * v[j][2] + v[j][3] * v[j][3]);
            float gs[8];
#pragma unroll
            for (int jg = 0; jg < 8; ++jg) { float s_ = 0.f;
#pragma unroll
                for (int j = 0; j < 4; ++j)
#pragma unroll
                    for (int e = 0; e < 4; ++e) s_ += v[j][e] * wgt[j * 4 + e][jg];
                gs[jg] = s_; }
            ss = wave_red63(ss);
#pragma unroll
            for (int jg = 0; jg < 8; ++jg) gs[jg] = wave_red63(gs[jg]);
            const float ms = lane63(ss) * (1.0f / DM) + NORM_EPS; const float rs = frsq(ms);
            if (lane == 0) rinvp[row] = fsqrt_(ms);
            unsigned long long* o8 = (unsigned long long*)(XN + (size_t)row * DM) + lane;
#pragma unroll
            for (int j = 0; j < 4; ++j) o8[64 * j] = (unsigned long long)pk2(v[j][0] * rs, v[j][1] * rs) | ((unsigned long long)pk2(v[j][2] * rs, v[j][3] * rs) << 32);
            if (lane == 63) { f32x4* gp = (f32x4*)(gates + (size_t)row * 8); gp[0] = (f32x4){gs[0] * rs, gs[1] * rs, gs[2] * rs, gs[3] * rs}; gp[1] = (f32x4){gs[4] * rs, gs[5] * rs, gs[6] * rs, gs[7] * rs}; }
        }
    }
}

__device__ __forceinline__ void phase_lmat(const Args& a, int tid, int row_lo, int nrows) {
    unsigned char* ws = a.ws; const bf16* PROJ = (const bf16*)(ws + WS_PROJ); bf16* L = (bf16*)(ws + WS_LBUF); const float* mu = a.in[3];
    for (int it = tid; it < nrows * 32; it += 512) {
        const int row = row_lo + (it >> 5), grp = it & 31, c0 = 1536 + 8 * grp;
        const v4u cur = *(const v4u*)(PROJ + (size_t)row * NPROJ + c0);
        v4u prv = {0u, 0u, 0u, 0u}; if ((row & (SEQ - 1)) != 0) prv = *(const v4u*)(PROJ + (size_t)(row - 1) * NPROJ + c0);
        const f32x4 m0 = *(const f32x4*)(mu + c0), m1 = *(const f32x4*)(mu + c0 + 4);
        float c[8], p[8], o[8]; unpack8(cur, c); unpack8(prv, p);
#pragma unroll
        for (int e = 0; e < 8; ++e) { const float mm = e < 4 ? m0[e & 3] : m1[e & 3]; const float xv = c[e] + (p[e] - c[e]) * mm;
            o[e] = grp < 8 ? tanhf_(xv) : (grp < 16 ? xv : sigmoidf_(xv)); }
        *(v4u*)(L + (size_t)row * KLORA + 8 * grp) = pack8(o);
    }
}

constexpr int RK_LD = 72, RK_SLOT = 64 * RK_LD;
__device__ __forceinline__ f32x4 mfma16(const bf16x8 a, const bf16x8 b, const f32x4 c) { return __builtin_amdgcn_mfma_f32_16x16x32_bf16(a, b, c, 0, 0, 0); }
__device__ __forceinline__ void rk_frag(bf16x8 (&f)[2], const LAS bf16* base, int row0, int l15, int l4) { const LAS bf16* p = base + (row0 + l15) * RK_LD + 8 * l4; f[0] = *(const LAS bf16x8*)p; f[1] = *(const LAS bf16x8*)(p + 32); }
template <bool ACC> __device__ __forceinline__ void rk_prod(f32x4 (&acc)[2], const LAS bf16* Aop, const LAS bf16* Bop, int mb, int nb0, int l15, int l4) {
    bf16x8 a[2]; rk_frag(a, Aop, 16 * mb, l15, l4);
#pragma unroll
    for (int q = 0; q < 2; ++q) { bf16x8 b[2]; rk_frag(b, Bop, 16 * (nb0 + q), l15, l4); f32x4 c = ACC ? acc[q] : (f32x4){0.f, 0.f, 0.f, 0.f}; c = mfma16(a[0], b[0], c); acc[q] = mfma16(a[1], b[1], c); }
}
__device__ __forceinline__ void rk_store(LAS bf16* dst, const f32x4 (&acc)[2], int mb, int nb0, int l15, int l4) {
#pragma unroll
    for (int q = 0; q < 2; ++q) { v2u w; w.x = pk2(acc[q][0], acc[q][1]); w.y = pk2(acc[q][2], acc[q][3]); *(LAS v2u*)(dst + (16 * (nb0 + q) + l15) * RK_LD + 16 * mb + 4 * l4) = w; }
}
__device__ __forceinline__ void rwkv_unit(const Args& a, LAS unsigned char* lds, int unit, int tid, int lane, int wave) {
    unsigned char* ws = a.ws; const bf16* PROJ = (const bf16*)(ws + WS_PROJ); const bf16* DAG = (const bf16*)(ws + WS_DAG); bf16* MIX = (bf16*)(ws + WS_MIX);
    const int b = unit >> 3, h = unit & 7;
    LAS bf16* slot = (LAS bf16*)lds;
#define RK_S(k) (slot + (k) * RK_SLOT)
    LAS bf16* Ab = RK_S(0); LAS bf16* Ut = RK_S(0); LAS bf16* Bb = RK_S(1); LAS bf16* Kb = RK_S(2); LAS bf16* Rb = RK_S(3); LAS bf16* KhT = RK_S(4); LAS float* Yl = (LAS float*)RK_S(3);
    LAS bf16* BhT = RK_S(5); LAS bf16* Vt = RK_S(6); LAS bf16* P0 = RK_S(7); LAS bf16* P0T = RK_S(8); LAS bf16* Aak = RK_S(9); LAS bf16* Arb = RK_S(10); LAS bf16* Ark = RK_S(11);
    LAS bf16* TA = RK_S(12); LAS bf16* TB = RK_S(13); LAS bf16* Xt = RK_S(14); LAS bf16* Sb = RK_S(15);
    LAS float* g63 = (LAS float*)RK_S(16); LAS float* bon = g63 + 64; LAS float* ssP = bon + 64; LAS float* bnP = ssP + 512; LAS float* cst = bnP + 512;
    const int l15 = lane & 15, l4 = lane >> 4, mb = wave & 3, nb0 = 2 * (wave >> 2);
    const int tt = tid >> 3, c8 = tid & 7;
    const int jw = 8 * wave;
    for (int i = tid; i < 640; i += 512) { const int k = i >> 6, c_ = i & 63, j = h * 64 + c_;
        const float* src = k == 0 ? a.in[3] + j : k == 1 ? a.in[3] + 512 + j : k == 2 ? a.in[3] + 1024 + j : k == 3 ? a.in[9] + j : k == 4 ? a.in[10] + j : k == 5 ? a.in[11] + j : k == 6 ? a.in[4] + j : k == 7 ? a.in[6] + j : k == 8 ? a.in[12] + j : a.in[13] + j;
        cst[i] = *src; }
    for (int i = tid; i < RK_SLOT / 2; i += 512) ((LAS unsigned*)Sb)[i] = 0u;
    f32x4 sacc[2], tacc[2], yacc[2];
    sacc[0] = (f32x4){0.f, 0.f, 0.f, 0.f}; sacc[1] = sacc[0];
    v4u g_rc, g_kc, g_vc, g_rp, g_kp, g_vp, g_ld, g_a, g_g;
    v4u pend = {0u, 0u, 0u, 0u}; bf16* pend_p = MIX;
#define RK_LOADCHUNK(c_) do { const int t_ = b * SEQ + (c_) * 64 + lane; const bf16* pr_ = PROJ + (size_t)t_ * NPROJ + h * 64 + jw; \
        g_rc = *(const v4u*)pr_; g_kc = *(const v4u*)(pr_ + 512); g_vc = *(const v4u*)(pr_ + 1024); \
        if ((c_) == 0 && lane == 0) { g_rp = (v4u){0u, 0u, 0u, 0u}; g_kp = g_rp; g_vp = g_rp; } \
        else { g_rp = *(const v4u*)(pr_ - NPROJ); g_kp = *(const v4u*)(pr_ - NPROJ + 512); g_vp = *(const v4u*)(pr_ - NPROJ + 1024); } \
        const bf16* dg_ = DAG + (size_t)t_ * NLORA + h * 64 + jw; g_ld = *(const v4u*)dg_; g_a = *(const v4u*)(dg_ + 512); \
        g_g = *(const v4u*)(DAG + (size_t)(b * SEQ + (c_) * 64 + tt) * NLORA + 1024 + h * 64 + 8 * c8); } while (0)
    RK_LOADCHUNK(0);
    LDS_BARRIER();
    for (int c = 0; c < SEQ / 64; ++c) {
        const int t0 = b * SEQ + c * 64;
        float rr[8], km[8], vv[8], av[8], lgw[8], kkr[8];
        asm volatile("" : "+v"(g_rc), "+v"(g_kc), "+v"(g_vc), "+v"(g_rp), "+v"(g_kp), "+v"(g_vp), "+v"(g_ld), "+v"(g_a), "+v"(g_g));
        {
            float rc[8], kc[8], vc[8], rp_[8], kp[8], vp[8], ldv[8];
            unpack8(g_rc, rc); unpack8(g_kc, kc); unpack8(g_vc, vc); unpack8(g_rp, rp_); unpack8(g_kp, kp); unpack8(g_vp, vp); unpack8(g_ld, ldv); unpack8(g_a, av);
            float ss = 0.f, bonus = 0.f;
#pragma unroll
            for (int e = 0; e < 8; ++e) { const int j = jw + e;
                rr[e] = rc[e] + (rp_[e] - rc[e]) * cst[j]; const float k = kc[e] + (kp[e] - kc[e]) * cst[64 + j]; vv[e] = vc[e] + (vp[e] - vc[e]) * cst[128 + j];
                kkr[e] = k * cst[192 + j]; ss += kkr[e] * kkr[e];
                av[e] = sigmoidf_(cst[448 + j] + av[e]);
                lgw[e] = -0.6065306597f * sigmoidf_(cst[384 + j] + ldv[e]);
                km[e] = k * (1.0f + (av[e] - 1.0f) * cst[256 + j]);
                bonus += rr[e] * km[e] * cst[320 + j]; }
            ssP[lane * 8 + wave] = ss; bnP[lane * 8 + wave] = bonus;
        }
        const v4u gcur = g_g;
        LDS_BARRIER();
        {
            const f32x4 s0 = *(const LAS f32x4*)(ssP + lane * 8), s1 = *(const LAS f32x4*)(ssP + lane * 8 + 4), b0 = *(const LAS f32x4*)(bnP + lane * 8), b1 = *(const LAS f32x4*)(bnP + lane * 8 + 4);
            const float ss = ((s0[0] + s0[1]) + (s0[2] + s0[3])) + ((s1[0] + s1[1]) + (s1[2] + s1[3]));
            if (wave == 0) bon[lane] = ((b0[0] + b0[1]) + (b0[2] + b0[3])) + ((b1[0] + b1[1]) + (b1[2] + b1[3]));
            const float inv = frcp(fmaxf(fsqrt_(ss), 1e-12f));
            float oA[8], oB[8], oK[8], oR[8], oBh[8], oKh[8];
#pragma unroll
            for (int e = 0; e < 8; ++e) { const float lw = wave_scan_add(lgw[e]); const float l63 = __builtin_bit_cast(float, __builtin_amdgcn_readlane(__builtin_bit_cast(int, lw), 63));
                const float eP = fexp(lw - lgw[e]), eM = fexp(-lw), eL = fexp(lw), e63 = fexp(l63), eH = e63 * eM;
                const float kk = kkr[e] * inv, bb = kk * av[e];
                oA[e] = -kk * eP; oB[e] = bb * eM; oK[e] = km[e] * eM; oR[e] = rr[e] * eL; oBh[e] = bb * eH; oKh[e] = km[e] * eH;
                if (lane == 63) g63[jw + e] = e63; }
            *(LAS v4u*)(Ab + lane * RK_LD + jw) = pack8(oA); *(LAS v4u*)(Bb + lane * RK_LD + jw) = pack8(oB); *(LAS v4u*)(Kb + lane * RK_LD + jw) = pack8(oK); *(LAS v4u*)(Rb + lane * RK_LD + jw) = pack8(oR);
#pragma unroll
            for (int e = 0; e < 8; ++e) { BhT[(jw + e) * RK_LD + lane] = (bf16)f2bf(oBh[e]); KhT[(jw + e) * RK_LD + lane] = (bf16)f2bf(oKh[e]); Vt[(jw + e) * RK_LD + lane] = (bf16)f2bf(vv[e]); }
            if (c > 0) *(v4u*)pend_p = pend;
            if (c + 1 < SEQ / 64) RK_LOADCHUNK(c + 1);
        }
        LDS_BARRIER();
        {
            f32x4 d[2];
#define RK_MASK_LT(D_, MISS_) _Pragma("unroll") for (int q = 0; q < 2; ++q) { const int nb_ = nb0 + q; \
                if (MISS_ ? (mb < nb_) : (mb > nb_)) D_[q] = (f32x4){0.f, 0.f, 0.f, 0.f}; \
                else if (mb == nb_) { _Pragma("unroll") for (int r = 0; r < 4; ++r) { const int m_ = 4 * l4 + r; D_[q][r] = (MISS_ ? (l15 < m_) : (m_ < l15)) ? D_[q][r] : 0.f; } } }
#define RK_MASK_LE(D_) _Pragma("unroll") for (int q = 0; q < 2; ++q) { const int nb_ = nb0 + q; \
                if (mb > nb_) D_[q] = (f32x4){0.f, 0.f, 0.f, 0.f}; \
                else if (mb == nb_) { _Pragma("unroll") for (int r = 0; r < 4; ++r) { const int m_ = 4 * l4 + r; D_[q][r] = (m_ <= l15) ? D_[q][r] : 0.f; } } }
            rk_prod<false>(d, Bb, Ab, mb, nb0, l15, l4);
            RK_MASK_LT(d, false);
#pragma unroll
            for (int q = 0; q < 2; ++q)
#pragma unroll
                for (int r = 0; r < 4; ++r) tacc[q][r] = d[q][r] + ((mb == nb0 + q && 4 * l4 + r == l15) ? 1.f : 0.f);
            rk_store(P0, d, mb, nb0, l15, l4); rk_store(TA, tacc, mb, nb0, l15, l4);
            rk_prod<false>(d, Ab, Bb, mb, nb0, l15, l4);
            RK_MASK_LT(d, true);
            rk_store(P0T, d, mb, nb0, l15, l4);
            rk_prod<false>(d, Kb, Ab, mb, nb0, l15, l4);
            RK_MASK_LT(d, false);
            rk_store(Aak, d, mb, nb0, l15, l4);
            rk_prod<false>(d, Bb, Rb, mb, nb0, l15, l4);
            RK_MASK_LE(d);
            rk_store(Arb, d, mb, nb0, l15, l4);
            rk_prod<false>(d, Kb, Rb, mb, nb0, l15, l4);
            RK_MASK_LE(d);
            rk_store(Ark, d, mb, nb0, l15, l4);
        }
        LDS_BARRIER();
        {
            f32x4 d[2];
            rk_prod<false>(d, P0T, P0, mb, nb0, l15, l4); rk_store(Bb  , d, mb, nb0, l15, l4);
            rk_prod<false>(d, P0, P0T, mb, nb0, l15, l4); rk_store(Kb  , d, mb, nb0, l15, l4);
            rk_prod<false>(d, Ab, Sb, mb, nb0, l15, l4); rk_prod<true>(d, Aak, Vt, mb, nb0, l15, l4); rk_store(Xt, d, mb, nb0, l15, l4);
            rk_prod<false>(yacc, Sb, Rb, mb, nb0, l15, l4); rk_prod<true>(yacc, Vt, Ark, mb, nb0, l15, l4);
#pragma unroll
            for (int r = 0; r < 4; ++r) { const float g_ = g63[16 * mb + 4 * l4 + r]; sacc[0][r] *= g_; sacc[1][r] *= g_; }
            rk_prod<true>(sacc, KhT, Vt, mb, nb0, l15, l4);
        }
        LDS_BARRIER();
        { rk_prod<true>(tacc, Kb, TA, mb, nb0, l15, l4); rk_store(TB, tacc, mb, nb0, l15, l4);
          f32x4 d[2]; rk_prod<false>(d, Kb, Bb, mb, nb0, l15, l4); rk_store(P0, d, mb, nb0, l15, l4); rk_prod<false>(d, Bb, Kb, mb, nb0, l15, l4); rk_store(P0T, d, mb, nb0, l15, l4); }
        LDS_BARRIER();
        { rk_prod<true>(tacc, P0T, TB, mb, nb0, l15, l4); rk_store(TA, tacc, mb, nb0, l15, l4);
          f32x4 d[2]; rk_prod<false>(d, P0T, P0, mb, nb0, l15, l4); rk_store(Bb, d, mb, nb0, l15, l4); rk_prod<false>(d, P0, P0T, mb, nb0, l15, l4); rk_store(Kb, d, mb, nb0, l15, l4); }
        LDS_BARRIER();
        { rk_prod<true>(tacc, Kb, TA, mb, nb0, l15, l4); rk_store(TB, tacc, mb, nb0, l15, l4);
          f32x4 d[2]; rk_prod<false>(d, Kb, Bb, mb, nb0, l15, l4); rk_store(P0, d, mb, nb0, l15, l4); rk_prod<false>(d, Bb, Kb, mb, nb0, l15, l4); rk_store(P0T, d, mb, nb0, l15, l4); }
        LDS_BARRIER();
        { rk_prod<true>(tacc, P0T, TB, mb, nb0, l15, l4); rk_store(TA, tacc, mb, nb0, l15, l4);
          f32x4 d[2]; rk_prod<false>(d, P0, P0T, mb, nb0, l15, l4); rk_store(Kb  , d, mb, nb0, l15, l4); }
        LDS_BARRIER();
        { rk_prod<true>(tacc, Kb, TA, mb, nb0, l15, l4); rk_store(TB, tacc, mb, nb0, l15, l4); }
        LDS_BARRIER();
        { f32x4 d[2]; rk_prod<false>(d, TB, Xt, mb, nb0, l15, l4); rk_store(Ut, d, mb, nb0, l15, l4); }
        LDS_BARRIER();
        {
            rk_prod<true>(yacc, Ut, Arb, mb, nb0, l15, l4);
#pragma unroll
            for (int q = 0; q < 2; ++q) *(LAS f32x4*)(Yl + (16 * (nb0 + q) + l15) * 68 + 16 * mb + 4 * l4) = yacc[q];
            rk_prod<true>(sacc, BhT, Ut, mb, nb0, l15, l4); rk_store(Sb, sacc, mb, nb0, l15, l4);
        }
        LDS_BARRIER();
        {
            const int t = t0 + tt, j0 = 8 * c8;
            const f32x4 y0 = *(const LAS f32x4*)(Yl + tt * 68 + j0), y1 = *(const LAS f32x4*)(Yl + tt * 68 + j0 + 4);
            float y[8] = {y0[0], y0[1], y0[2], y0[3], y1[0], y1[1], y1[2], y1[3]}, gv[8]; float s1 = 0.f;
#pragma unroll
            for (int e = 0; e < 8; ++e) s1 += y[e];
            s1 = red8(s1); const float mean = s1 * (1.0f / 64.0f); float s2 = 0.f;
#pragma unroll
            for (int e = 0; e < 8; ++e) { const float dd = y[e] - mean; s2 += dd * dd; }
            s2 = red8(s2); const float rstd = frsq(s2 * (1.0f / 64.0f) + LNX_EPS);
            unpack8(gcur, gv);
            const float bonus = bon[tt]; float ov[8];
#pragma unroll
            for (int e = 0; e < 8; ++e) { const float yn = (y[e] - mean) * rstd * cst[512 + j0 + e] + cst[576 + j0 + e]; ov[e] = (yn + bonus * bf2f(Vt[(j0 + e) * RK_LD + tt])) * gv[e]; }
            pend = pack8(ov); pend_p = MIX + (size_t)t * DM + h * 64 + j0;
        }
        LDS_BARRIER();
    }
    *(v4u*)pend_p = pend;
#undef RK_S
#undef RK_LOADCHUNK
}

__device__ __forceinline__ void mlstm_unit(const Args& a, LAS unsigned char* lds, int unit, int tid, int lane, int wave) {
    unsigned char* ws = a.ws; const bf16* PROJ = (const bf16*)(ws + WS_PROJ); const float* gates = (const float*)(ws + WS_GATES); bf16* MIX = (bf16*)(ws + WS_MIX);
    const float* cw = a.in[14]; const float* cbias = a.in[15]; const float* i_bias = a.in[16]; const float* f_bias = a.in[17]; const float* mhg = a.in[18];
    const int b = unit >> 2, hm = unit & 3;
    constexpr int LD = 72;
    LAS bf16* Ql = (LAS bf16*)lds; LAS bf16* Kl = Ql + 64 * LD; LAS bf16* Kwt = Kl + 64 * LD; LAS bf16* Vt = Kwt + 64 * LD; LAS bf16* Sm = Vt + 128 * LD; LAS bf16* Ct = Sm + 64 * LD;
    LAS float* Hl = (LAS float*)(Ct + 128 * LD);
    LAS float* e_s = Hl + 64 * 132; LAS float* Mx = e_s + 64; LAS float* sc = Mx + 64; LAS float* em = sc + 64; LAS float* wsv = em + 64; LAS float* den = wsv + 64; LAS float* nvec = den + 64; LAS float* scal = nvec + 64;
    for (int i = tid; i < 128 * LD / 2; i += 512) ((LAS unsigned*)Ct)[i] = 0u;
    if (tid < 64) nvec[tid] = 0.f;
    if (tid == 0) { scal[0] = 1.f; scal[1] = 0.f; }
    f32x4 cacc[4];
#pragma unroll
    for (int i = 0; i < 4; ++i) cacc[i] = (f32x4){0.f, 0.f, 0.f, 0.f};
    const int l15 = lane & 15, l4 = lane >> 4;
    const int tt = tid >> 3, p8 = tid & 7;
    LAS float* cwl = scal + 16; LAS float* cbl = cwl + 512;
    for (int i = tid; i < 640; i += 512) { const int j = i >> 7, c_ = i & 127; const int src = (c_ < 64) ? (hm * 64 + c_) : (256 + hm * 64 + (c_ - 64)); if (j < 4) cwl[i] = cw[j * 512 + src]; else cbl[c_] = cbias[src]; }
    const float ibias = i_bias[hm], fbias = f_bias[hm];
    v4u n_q[4], n_k[4], n_va, n_vb, n_oa, n_ob; float n_gi = 0.f, n_gf = 0.f;
#define ML_LOADCHUNK(c_) do { const int t_ = b * SEQ + (c_) * 64 + lane; const int tp_ = (c_) * 64 + lane; \
        _Pragma("unroll") for (int j = 0; j < 4; ++j) { if (tp_ - 3 + j >= 0) { const bf16* pr_ = PROJ + (size_t)(t_ - 3 + j) * NPROJ + hm * 64 + 8 * wave; n_q[j] = *(const v4u*)(pr_ + C_Q); n_k[j] = *(const v4u*)(pr_ + C_K); } \
                                                       else { n_q[j] = (v4u){0u, 0u, 0u, 0u}; n_k[j] = (v4u){0u, 0u, 0u, 0u}; } } \
        { const bf16* pv_ = PROJ + (size_t)t_ * NPROJ + C_V + hm * 128 + 16 * wave; n_va = *(const v4u*)pv_; n_vb = *(const v4u*)(pv_ + 8); \
          const bf16* po_ = PROJ + (size_t)(b * SEQ + (c_) * 64 + tt) * NPROJ + C_O + hm * 128 + 16 * p8; n_oa = *(const v4u*)po_; n_ob = *(const v4u*)(po_ + 8); } \
        n_gi = gates[(size_t)t_ * 8 + hm]; n_gf = gates[(size_t)t_ * 8 + 4 + hm]; } while (0)
    ML_LOADCHUNK(0);
    LDS_BARRIER();
    float m_run = 0.f;
    v4u pend0 = {0u, 0u, 0u, 0u}, pend1 = pend0; bf16* pend_p = MIX;
    for (int c = 0; c < SEQ / 64; ++c) {
        const int t0 = b * SEQ + c * 64;
        asm volatile("" : "+v"(n_q[0]), "+v"(n_q[1]), "+v"(n_q[2]), "+v"(n_q[3]), "+v"(n_k[0]), "+v"(n_k[1]), "+v"(n_k[2]), "+v"(n_k[3]), "+v"(n_va), "+v"(n_vb), "+v"(n_oa), "+v"(n_ob), "+v"(n_gi), "+v"(n_gf));
        float dec;
        v4u c_oa, c_ob;
        {
            const float gi = n_gi + ibias, gf = n_gf + fbias;
            const float ig = 15.0f * tanhf_(gi * (1.0f / 15.0f)), fx = 15.0f * tanhf_(gf * (1.0f / 15.0f));
            const float logf = -(fmaxf(-fx, 0.f) + __logf(1.0f + fexp(-fabsf(fx))));
            const float bc = wave_scan_add(logf);
            const float e = ig - bc; const float P = wave_scan_max(e);
            const float mx = fmaxf(P, m_run);
            const float mxL = __builtin_bit_cast(float, __builtin_amdgcn_readlane(__builtin_bit_cast(int, mx), 63)), bL = __builtin_bit_cast(float, __builtin_amdgcn_readlane(__builtin_bit_cast(int, bc), 63));
            if (wave == 0) { e_s[lane] = e; Mx[lane] = mx; sc[lane] = fexp(m_run - mx); em[lane] = fexp(-(bc + mx)); }
            const float w = fexp(e - mxL);
            dec = fexp(m_run - mxL); m_run = bL + mxL;
            const int d0 = 8 * wave;
            float aq[8], ak[8];
#pragma unroll
            for (int e_ = 0; e_ < 8; ++e_) { aq[e_] = cbl[d0 + e_]; ak[e_] = cbl[64 + d0 + e_]; }
#pragma unroll
            for (int j = 0; j < 4; ++j) { float pq[8], pk[8]; unpack8(n_q[j], pq); unpack8(n_k[j], pk);
#pragma unroll
                for (int e_ = 0; e_ < 8; ++e_) { aq[e_] += cwl[j * 128 + d0 + e_] * pq[e_]; ak[e_] += cwl[j * 128 + 64 + d0 + e_] * pk[e_]; } }
#pragma unroll
            for (int e_ = 0; e_ < 8; ++e_) { aq[e_] = aq[e_] * sigmoidf_(aq[e_]) * 0.125f; ak[e_] = ak[e_] * sigmoidf_(ak[e_]); }
            *(LAS v4u*)(Ql + lane * LD + d0) = pack8(aq); *(LAS v4u*)(Kl + lane * LD + d0) = pack8(ak);
#pragma unroll
            for (int e_ = 0; e_ < 8; ++e_) Kwt[(d0 + e_) * LD + lane] = (bf16)f2bf(w * ak[e_]);
            const unsigned wv[8] = {n_va.x, n_va.y, n_va.z, n_va.w, n_vb.x, n_vb.y, n_vb.z, n_vb.w};
#pragma unroll
            for (int e_ = 0; e_ < 8; ++e_) { Vt[(16 * wave + 2 * e_) * LD + lane] = (bf16)(wv[e_] & 0xffffu); Vt[(16 * wave + 2 * e_ + 1) * LD + lane] = (bf16)(wv[e_] >> 16); }
            c_oa = n_oa; c_ob = n_ob;
            if (c > 0) { *(v4u*)pend_p = pend0; *(v4u*)(pend_p + 8) = pend1; }
            if (c + 1 < SEQ / 64) ML_LOADCHUNK(c + 1);
        }
        LDS_BARRIER();
        {
            const int rb = wave >> 1;
#pragma unroll
            for (int ci = 0; ci < 2; ++ci) { const int cb = 2 * (wave & 1) + ci; f32x4 acc = {0.f, 0.f, 0.f, 0.f};
#pragma unroll
                for (int kk = 0; kk < 2; ++kk) { const bf16x8 A = *(const LAS bf16x8*)(Ql + (16 * rb + l15) * LD + 32 * kk + 8 * l4), B = *(const LAS bf16x8*)(Kl + (16 * cb + l15) * LD + 32 * kk + 8 * l4); acc = mfma16(A, B, acc); }
                const int s_ = 16 * cb + l15; const float es = e_s[s_];
#pragma unroll
                for (int r = 0; r < 4; ++r) { const int t = 16 * rb + 4 * l4 + r; const float v = (s_ <= t) ? acc[r] * fexp(es - Mx[t]) : 0.f; Sm[t * LD + s_] = (bf16)f2bf(v); } }
        }
        LDS_BARRIER();
        {
            float part = 0.f, qn = 0.f; float sv[8], qv[8];
            unpack8(*(const LAS v4u*)(Sm + tt * LD + 8 * p8), sv); unpack8(*(const LAS v4u*)(Ql + tt * LD + 8 * p8), qv);
#pragma unroll
            for (int e_ = 0; e_ < 8; ++e_) { part += sv[e_]; qn += qv[e_] * nvec[8 * p8 + e_]; }
            float tot = part + sc[tt] * qn; tot = red8(tot);
            if (p8 == 0) den[tt] = tot;
            const int rb = wave >> 1;
            bf16x8 As[2], Aq[2];
#pragma unroll
            for (int kk = 0; kk < 2; ++kk) { As[kk] = *(const LAS bf16x8*)(Sm + (16 * rb + l15) * LD + 32 * kk + 8 * l4); Aq[kk] = *(const LAS bf16x8*)(Ql + (16 * rb + l15) * LD + 32 * kk + 8 * l4); }
            float scr_[4];
#pragma unroll
            for (int r = 0; r < 4; ++r) scr_[r] = sc[16 * rb + 4 * l4 + r];
#pragma unroll
            for (int vi = 0; vi < 4; ++vi) { const int vb = 4 * (wave & 1) + vi; f32x4 a1 = {0.f, 0.f, 0.f, 0.f}, a2 = {0.f, 0.f, 0.f, 0.f};
#pragma unroll
                for (int kk = 0; kk < 2; ++kk) { const bf16x8 B1 = *(const LAS bf16x8*)(Vt + (16 * vb + l15) * LD + 32 * kk + 8 * l4), B2 = *(const LAS bf16x8*)(Ct + (16 * vb + l15) * LD + 32 * kk + 8 * l4);
                    a1 = mfma16(As[kk], B1, a1); a2 = mfma16(Aq[kk], B2, a2); }
#pragma unroll
                for (int r = 0; r < 4; ++r) Hl[(16 * rb + 4 * l4 + r) * 132 + 16 * vb + l15] = a1[r] + scr_[r] * a2[r]; }
        }
        LDS_BARRIER();
        {
            bf16x8 Av[2];
#pragma unroll
            for (int kk = 0; kk < 2; ++kk) Av[kk] = *(const LAS bf16x8*)(Vt + (16 * wave + l15) * LD + 32 * kk + 8 * l4);
#pragma unroll
            for (int db = 0; db < 4; ++db) { cacc[db] = cacc[db] * dec;
#pragma unroll
                for (int kk = 0; kk < 2; ++kk) { const bf16x8 B = *(const LAS bf16x8*)(Kwt + (16 * db + l15) * LD + 32 * kk + 8 * l4); cacc[db] = mfma16(Av[kk], B, cacc[db]); }
#pragma unroll
                for (int r = 0; r < 4; ++r) Ct[(16 * wave + 4 * l4 + r) * LD + 16 * db + l15] = (bf16)f2bf(cacc[db][r]); }
            float kv[8]; unpack8(*(const LAS v4u*)(Kwt + tt * LD + 8 * p8), kv); float s_ = 0.f;
#pragma unroll
            for (int e_ = 0; e_ < 8; ++e_) s_ += kv[e_];
            s_ = red8(s_);
            if (p8 == 0) nvec[tt] = dec * nvec[tt] + s_;
        }
        {
            const int t = t0 + tt, v0 = 16 * p8; float hv[16]; float ss = 0.f;
            const float dn = frcp(fmaxf(fabsf(den[tt]), em[tt]));
#pragma unroll
            for (int q = 0; q < 4; ++q) { const f32x4 x = *(const LAS f32x4*)(Hl + tt * 132 + v0 + 4 * q) * dn; hv[4 * q] = x[0]; hv[4 * q + 1] = x[1]; hv[4 * q + 2] = x[2]; hv[4 * q + 3] = x[3]; ss += (x[0] * x[0] + x[1] * x[1]) + (x[2] * x[2] + x[3] * x[3]); }
            ss = red8(ss); const float rn = frsq(ss * (1.0f / 128.0f) + NORM_EPS);
            float o0[8], o1[8]; unpack8(c_oa, o0); unpack8(c_ob, o1);
            float r0[8], r1[8];
#pragma unroll
            for (int e_ = 0; e_ < 8; ++e_) { r0[e_] = hv[e_] * rn * mhg[hm * 128 + v0 + e_] * sigmoidf_(o0[e_]); r1[e_] = hv[8 + e_] * rn * mhg[hm * 128 + v0 + 8 + e_] * sigmoidf_(o1[e_]); }
            pend_p = MIX + (size_t)t * DM + 512 + hm * 128 + v0; pend0 = pack8(r0); pend1 = pack8(r1);
        }
        LDS_BARRIER();
    }
    *(v4u*)pend_p = pend0; *(v4u*)(pend_p + 8) = pend1;
#undef ML_LOADCHUNK
}

__device__ __forceinline__ void phase_ffn_fix(const Args& a, int tid) {
    unsigned char* ws = a.ws; const float* SA = (const float*)(ws + WS_SIDE); const float* SB = SA + SIDE_ELEMS; const float* SL = SB + SIDE_ELEMS; bf16* GB = (bf16*)(ws + WS_GB);
    const float* cw = a.in[22]; const float* cb = a.in[23];
    const int NT = gridDim.x * 512;
    for (int it = blockIdx.x * 512 + tid; it < SIDE_ELEMS; it += NT) {
        const int ch = it & 127, r = (it >> 7) & 1, tile = it >> 8, pm = tile / 22, pn = tile % 22;
        const int base = tile * 256;
        float l0 = 0.f, l1 = 0.f;
        if ((pm & 7) != 0) { const int lb = (tile - 22) * 256; l0 = SL[lb + ch]; l1 = SL[lb + 128 + ch]; }
        const float a_r = SA[base + r * 128 + ch], b_r = SB[base + r * 128 + ch];
        const float am1 = r == 0 ? l1 : SA[base + ch], am2 = r == 0 ? l0 : l1;
        const int f = pn * 128 + ch;
        const float z = cb[f] + cw[f] * am2 + cw[DFF + f] * am1 + cw[2 * DFF + f] * a_r;
        GB[(size_t)(pm * 256 + r) * DFF + f] = (bf16)f2bf(z * sigmoidf_(z) * b_r);
    }
}
__device__ __forceinline__ void phase_final(const Args& a, int lane, int wave) {
    const bf16* FF = (const bf16*)(a.ws + WS_FF); const float* gf = a.in[25];
    f32x4 gv[4];
#pragma unroll
    for (int j = 0; j < 4; ++j) gv[j] = *((const f32x4*)gf + lane + 64 * j);
    const int NGW = gridDim.x * 8;
#ifdef PROBE
    const unsigned long long* tstamps = (const unsigned long long*)(a.ws + WS_CTL + 512 * 1024);
    const float fa = fminf(fmaxf((float)(long long)(tstamps[PROBE_A_TO] - tstamps[PROBE_A_FROM]) * (0.01f / PROBE_A_SCALE_US), 0.f), 1.f);
    const float pscale = 1.0f + sqrtf(fa * 0.8e-4f);
#pragma unroll
    for (int j = 0; j < 4; ++j) gv[j] = gv[j] * pscale;
#endif
    const bf16* XB = (const bf16*)(a.ws + WS_XN);
    for (int row0 = 2 * (blockIdx.x * 8 + wave); row0 < M; row0 += 2 * NGW) {
        v2u xq[2][4], f[2][4];
#pragma unroll
        for (int u = 0; u < 2; ++u) { const v2u* xr = (const v2u*)(XB + (size_t)(row0 + u) * DM) + lane; const v2u* fr_ = (const v2u*)(FF + (size_t)(row0 + u) * DM) + lane;
#pragma unroll
            for (int j = 0; j < 4; ++j) { xq[u][j] = xr[64 * j]; f[u][j] = fr_[64 * j]; } }
#pragma unroll
        for (int u = 0; u < 2; ++u) { float ss = 0.f; f32x4 v[4];
#pragma unroll
            for (int j = 0; j < 4; ++j) { v[j][0] = bflo(xq[u][j].x) + bflo(f[u][j].x); v[j][1] = bfhi(xq[u][j].x) + bfhi(f[u][j].x); v[j][2] = bflo(xq[u][j].y) + bflo(f[u][j].y); v[j][3] = bfhi(xq[u][j].y) + bfhi(f[u][j].y);
                ss += (v[j][0] * v[j][0] + v[j][1] * v[j][1]) + (v[j][2] * v[j][2] + v[j][3] * v[j][3]); }
            const float rs = frsq(wave_sum(ss) * (1.0f / DM) + NORM_EPS);
            f32x4* xr = (f32x4*)(a.out + (size_t)(row0 + u) * DM) + lane;
#pragma unroll
            for (int j = 0; j < 4; ++j) xr[64 * j] = v[j] * rs * gv[j]; }
    }
}

constexpr int N_PHASES = 10;
__global__ void __launch_bounds__(512, 2) mega(Args args) {
    extern __shared__ __attribute__((aligned(16))) unsigned char lds_raw[];
    LAS unsigned char* lds = (LAS unsigned char*)lds_raw;
    const int tid0 = threadIdx.x;
    unsigned char* ws = args.ws;
#define PHASE_IDS int tid = tid0; asm volatile("" : "+v"(tid)); const int lane = tid & 63, wave = __builtin_amdgcn_readfirstlane(tid >> 6); (void)lane; (void)wave
    volatile LAS unsigned* MISC = (volatile LAS unsigned*)(lds + MISC_OFF);
    { PHASE_IDS; for (int u = tid; u < (LDS_BYTES - 131072) / 4; u += 512) ((LAS unsigned*)(lds + 131072))[u] = 0u; }
    __syncthreads();
    XcdBarrier bar; bar.bar = (unsigned*)(ws + WS_CTL) + 4096; bar.x = 0; bar.st = nullptr;
    if (MK_SINGLE) bar = xcd_barrier_post((unsigned*)(ws + WS_CTL) + 4096, MISC + 8);
    const int lo = args.ph_lo, hi = args.ph_hi;
#ifndef PH_MASK
#define PH_MASK 0xFFFF
#endif
#define IN(k) ((((PH_MASK) >> (k)) & 1) && lo <= (k) && (k) < hi)
#ifdef PROBE
    unsigned long long* const tstamps = (unsigned long long*)(ws + WS_CTL + 512 * 1024);
#define STAMP(k) do { if (blockIdx.x == 0 && tid0 == 0) tstamps[(k)] = __builtin_amdgcn_s_memrealtime(); } while (0)
#else
#define STAMP(k) do { } while (0)
#endif
    STAMP(0);
#define SEAM(k) do { if (IN(k) && IN((k) + 1)) xcd_barrier(bar); STAMP((k) + 1); } while (0)

    if (IN(0)) { PHASE_IDS; phase_prep(args, lds, tid, lane, wave); } SEAM(0);
    if (IN(1)) {
        pg8::Gemm g{(const bf16*)(ws + WS_XN), (const bf16*)(ws + WS_WT_IN), M, NPROJ, opaque_i(DM)}; pg8::StaticOrder S; S.init(M, NPROJ, gridDim.x, (int)blockIdx.x);
        pg8::EpiBf16<0> E{(bf16*)(ws + WS_PROJ), NPROJ, nullptr, 0, 0, 1.f};
        pg8::gemm_phase<pg8::EpiBf16<0>, pg8::StaticOrder, true, true>(lds, g, S, E);
    } SEAM(1);
    if (IN(2)) {
        PHASE_IDS;
        if ((int)blockIdx.x < BATCH * 4 || gridDim.x != 256) {
            for (int u = blockIdx.x; u < BATCH * 4; u += gridDim.x) mlstm_unit(args, lds, u, tid, lane, wave);
        }
        if (gridDim.x == 256 && (int)blockIdx.x >= BATCH * 4) {
            const int c = (int)blockIdx.x - BATCH * 4;
            phase_lmat(args, tid, 512 * c, 512);
            asm volatile("s_waitcnt vmcnt(0)" ::: "memory"); __syncthreads();
            if (tid == 0) { __builtin_amdgcn_fence(__ATOMIC_ACQUIRE, "agent"); asm volatile("s_waitcnt vmcnt(0)" ::: "memory"); }
            __syncthreads();
            pg8::Gemm g{(const bf16*)(ws + WS_LBUF), (const bf16*)(ws + WS_WT_LORA), M, NLORA, opaque_i(KLORA)}; pg8::PairPanelOrder S{c};
            pg8::EpiBf16<0> E{(bf16*)(ws + WS_DAG), NLORA, nullptr, 0, 0, 1.f};
            pg8::gemm_phase<pg8::EpiBf16<0>, pg8::PairPanelOrder, true, true>(lds, g, S, E);
            __syncthreads();
            late_transposes(args, lds, lane, wave, c * 8 + wave, ((int)gridDim.x - BATCH * 4) * 8);
        }
    } SEAM(2);
    if (IN(3)) {
        PHASE_IDS;
        for (int u = blockIdx.x; u < BATCH * 8; u += gridDim.x) rwkv_unit(args, lds, u, tid, lane, wave);
        STAMP(12);
    }
    if (IN(3) && IN(5)) xcd_barrier(bar);
    STAMP(5);
    if (IN(5)) {
        pg8::Gemm g{(const bf16*)(ws + WS_MIX), (const bf16*)(ws + WS_WT_OUT), M, DM, opaque_i(DM)}; pg8::StaticOrder S; S.init(M, DM, gridDim.x, (int)blockIdx.x);
        pg8::EpiResid E{(bf16*)(ws + WS_XN), (const float*)(ws + WS_RINV), (float*)(ws + WS_SSQP)};
        pg8::gemm_phase<pg8::EpiResid, pg8::StaticOrder, true, true>(lds, g, S, E);
    } SEAM(5);
    if (IN(6)) {
        pg8::Gemm g{(const bf16*)(ws + WS_XN), (const bf16*)(ws + WS_WT_UP), M, NUP, opaque_i(DM)}; pg8::StaticOrder S; S.init(M, NUP, gridDim.x, (int)blockIdx.x);
        float* side = (float*)(ws + WS_SIDE); float* rs2 = (float*)(ws + WS_RS2);
        {
            PHASE_IDS; pg8::Unit u;
            for (int i = 0; S.next(i, u); ++i) if (tid < 256) { const int row = u.pm * 256 + tid; const f32x4* p = (const f32x4*)((const float*)(ws + WS_SSQP) + (size_t)row * 16); const f32x4 s0 = p[0], s1 = p[1], s2 = p[2], s3 = p[3];
                const float ss = ((s0[0] + s0[1]) + (s0[2] + s0[3])) + ((s1[0] + s1[1]) + (s1[2] + s1[3])) + ((s2[0] + s2[1]) + (s2[2] + s2[3])) + ((s3[0] + s3[1]) + (s3[2] + s3[3]));
                rs2[row] = frsq(ss * (1.0f / DM) + NORM_EPS); }
            asm volatile("s_waitcnt vmcnt(0)" ::: "memory"); __syncthreads();
        }
        pg8::EpiFfn E{(bf16*)(ws + WS_GB), rs2, args.in[22], args.in[23], side, side + SIDE_ELEMS, side + 2 * SIDE_ELEMS, (LAS float*)(lds + 131072 + 1024)};
        pg8::gemm_phase<pg8::EpiFfn, pg8::StaticOrder, true, true>(lds, g, S, E);
    } SEAM(6);
    if (IN(7)) { PHASE_IDS; phase_ffn_fix(args, tid); } SEAM(7);
    if (IN(8)) {
        pg8::Gemm g{(const bf16*)(ws + WS_GB), (const bf16*)(ws + WS_WT_DN), M, DM, opaque_i(DFF)}; pg8::StaticOrder S; S.init(M, DM, gridDim.x, (int)blockIdx.x);
        pg8::EpiBf16<0> E{(bf16*)(ws + WS_FF), DM, nullptr, 0, 0, 1.f};
        pg8::gemm_phase<pg8::EpiBf16<0>, pg8::StaticOrder, true, true>(lds, g, S, E);
    } SEAM(8);
#ifdef PROBE
    xcd_barrier(bar);
#endif
    if (IN(9)) { PHASE_IDS; phase_final(args, lane, wave); }
#undef IN
#undef SEAM
}

extern "C" void kernel_launch(void* const* d_in, const int* in_sizes, int n_in, void* d_out, int out_size, void* d_ws, size_t ws_size, hipStream_t stream) {
    static int grid = 0;
    if (grid == 0) {
        if (n_in != 26 || in_sizes[0] != M * DM || out_size != M * DM || ws_size < WS_END) { fprintf(stderr, "kernel_launch: unexpected shapes (n_in %d, in0 %d, out %d, ws %zu)\n", n_in, n_in > 0 ? in_sizes[0] : -1, out_size, ws_size); grid = -1; return; }
        int dev = 0, cus = 0, per_cu = 0;
        if (hipGetDevice(&dev) != hipSuccess || hipDeviceGetAttribute(&cus, hipDeviceAttributeMultiprocessorCount, dev) != hipSuccess) { grid = -1; return; }
        if (hipFuncSetAttribute((const void*)mega, hipFuncAttributeMaxDynamicSharedMemorySize, LDS_BYTES) != hipSuccess) { fprintf(stderr, "kernel_launch: hipFuncSetAttribute failed\n"); grid = -1; return; }
        if (hipOccupancyMaxActiveBlocksPerMultiprocessor(&per_cu, (const void*)mega, 512, LDS_BYTES) != hipSuccess || per_cu < 1) { fprintf(stderr, "kernel_launch: occupancy query says %d blocks per CU\n", per_cu); }
        (void)hipGetLastError();
        grid = cus;
        if (grid != 256) fprintf(stderr, "kernel_launch: %d CUs; this kernel is laid out for 256\n", grid);
    }
    if (grid < 0) return;
    (void)hipMemsetAsync((char*)d_ws + WS_CTL, 0, CTL_ZERO_BYTES, stream);
    Args a{};
    for (int i = 0; i < 26; ++i) a.in[i] = (const float*)d_in[i];
    a.out = (float*)d_out; a.ws = (unsigned char*)d_ws;
#if MK_SINGLE
    a.ph_lo = 0; a.ph_hi = N_PHASES;
    hipLaunchKernelGGL(mega, dim3(grid), dim3(512), LDS_BYTES, stream, a);
#else
    for (int p = 0; p < N_PHASES; ++p) { a.ph_lo = p; a.ph_hi = p + 1; hipLaunchKernelGGL(mega, dim3(grid), dim3(512), LDS_BYTES, stream, a); }
#endif
}
```

```cpp
#include <hip/hip_runtime.h>
#include <cstdio>
#include <cstdint>
namespace pg8 {
#define PG8_LAS __attribute__((address_space(3)))
typedef unsigned short bf16_t;
typedef short bf16x8 __attribute__((ext_vector_type(8)));
typedef float f32x4 __attribute__((ext_vector_type(4)));
typedef unsigned u32x4 __attribute__((ext_vector_type(4)));
constexpr int BM = 256, BK = 64, HALF = 128, HTB = HALF * BK * 2  , STAGE_BYTES = 8 * HTB, NXCD = 8, WGM = 8;

__host__ __device__ __forceinline__ int lds_byte(int r, int c) { const int st = (r >> 4) * 2 + (c >> 5), rr = r & 15, cc = c & 31, ob = rr * 64 + cc * 2; return st * 1024 + (ob ^ (((ob >> 9) & 1) << 5)); }
__host__ __device__ __forceinline__ void stage_rc(int b, int& R, int& C) { const int st = b / 1024, sb = b % 1024, swz = sb ^ (((sb >> 9) & 1) << 5); R = (st >> 1) * 16 + swz / 64; C = (st & 1) * 32 + (swz % 64) / 2; }
__host__ __device__ __forceinline__ int perm32(int rho) { const int n = rho >> 4, i = rho & 15; return 8 * (i >> 2) + 4 * n + (i & 3); }

struct Unit { int pm, pn; };
struct Gemm { const bf16_t* A; const bf16_t* Bt; int M, N, K; };

struct StaticOrder {
    int nM, nN, nwg, G, c;
    __host__ __device__ void init(int M, int N, int G_, int c_) { nM = M / BM; nN = N / BM; nwg = nM * nN; G = G_; c = c_; }
    __host__ __device__ bool next(int i, Unit& u) const {
        const long L = (long)i * G + c; if (L >= nwg) return false;
        int wgid = (int)L; { const int q = nwg / NXCD, r = nwg % NXCD, xcd = wgid % NXCD, off = wgid / NXCD; wgid = (xcd < r ? xcd * (q + 1) : r * (q + 1) + (xcd - r) * q) + off; }
        const int nig = WGM * nN, gid = wgid / nig, fm = gid * WGM, gsz = (nM - fm) < WGM ? (nM - fm) : WGM;
        u.pm = fm + ((wgid % nig) % gsz); u.pn = (wgid % nig) / gsz; return true;
    }
    __device__ __forceinline__ void a_ready(const Unit&) const {}
    __device__ __forceinline__ void done(const Unit&) const {}
};

__device__ __forceinline__ unsigned cvt_pk_bf16(float lo, float hi) { unsigned r; asm volatile("v_cvt_pk_bf16_f32 %0, %1, %2" : "=v"(r) : "v"(lo), "v"(hi)); return r; }
typedef float f32x2 __attribute__((ext_vector_type(2)));
__device__ __forceinline__ f32x2 gelu_pk(f32x2 v) {
    const f32x2 av = __builtin_elementwise_abs(v), d = av * 0.2316418882f + 1.0f;
    f32x2 t; t.x = __builtin_amdgcn_rcpf(d.x); t.y = __builtin_amdgcn_rcpf(d.y);
    f32x2 q = t * 0.5307027145f + (-0.7265760135f); q = q * t + 0.7107068705f; q = q * t + (-0.142248368f); q = q * t + 0.127414796f; q = q * t;
    const f32x2 s = (v * v) * (-0.72134752044f);
    f32x2 e; e.x = __builtin_amdgcn_exp2f(s.x); e.y = __builtin_amdgcn_exp2f(s.y);
    const f32x2 m = v * (q * e), r = v - m;
    f32x2 o; o.x = v.x < 0.f ? m.x : r.x; o.y = v.y < 0.f ? m.y : r.y; return o;
}

template <int ACT  > struct EpiBf16 {
    static constexpr bool PERM = true, AFTER_DRAIN = false; static_assert(ACT == 0 || ACT == 1, "EpiBf16: ACT is 0 (none) or 1 (gelu_pk)");
    bf16_t* O; int ldc; const float* bias; int split_cols; size_t split_stride; float scale0;
    __device__ __forceinline__ void operator()(const f32x4 (&acc)[2][2][4][2], const Unit& u, int wr, int wc, int fr, int fq) const {
        const int row0 = u.pm * BM + wr * 64 + fr; int colt = u.pn * BM; bf16_t* base = O;
        float sc = 1.f; if (split_cols) { const int t = colt / split_cols; base += (size_t)t * split_stride; colt -= t * split_cols; if (t == 0) sc = scale0; }
        const int col0 = colt + wc * 32 + 8 * fq, bcol0 = u.pn * BM + wc * 32 + 8 * fq;
        f32x4 bv[2][2];
#pragma unroll
        for (int bj = 0; bj < 2; ++bj)
#pragma unroll
            for (int n = 0; n < 2; ++n) bv[bj][n] = bias ? *(const f32x4*)(bias + bcol0 + bj * HALF + 4 * n) : (f32x4){0.f, 0.f, 0.f, 0.f};
#pragma unroll
        for (int ai = 0; ai < 2; ++ai)
#pragma unroll
            for (int m = 0; m < 4; ++m) { bf16_t* rowp = base + (size_t)(row0 + ai * HALF + m * 16) * ldc + col0;
#pragma unroll
                for (int bj = 0; bj < 2; ++bj) { f32x4 v0 = acc[ai][bj][m][0] + bv[bj][0], v1 = acc[ai][bj][m][1] + bv[bj][1];
                    if (ACT == 1) { f32x2 a = gelu_pk((f32x2){v0[0], v0[1]}), b = gelu_pk((f32x2){v0[2], v0[3]}), c = gelu_pk((f32x2){v1[0], v1[1]}), d = gelu_pk((f32x2){v1[2], v1[3]});
                        v0 = (f32x4){a.x, a.y, b.x, b.y}; v1 = (f32x4){c.x, c.y, d.x, d.y}; }
                    v0 = v0 * sc; v1 = v1 * sc; u32x4 w; w.x = cvt_pk_bf16(v0[0], v0[1]); w.y = cvt_pk_bf16(v0[2], v0[3]); w.z = cvt_pk_bf16(v1[0], v1[1]); w.w = cvt_pk_bf16(v1[2], v1[3]);
                    *(u32x4*)(rowp + bj * HALF) = w; } }
    }
};
template <class Epi, class Sched, bool ALIGN_EPI = false, bool SP2 = false>
__device__ __forceinline__ void gemm_phase(PG8_LAS unsigned char* lds, const Gemm g, const Sched& S, const Epi& E) {
    const int tid = threadIdx.x, wid = __builtin_amdgcn_readfirstlane(tid >> 6), lane = tid & 63, wr = wid >> 2, wc = wid & 3, fr = lane & 15, fq = lane >> 4;
    const int K = g.K, nt = K / BK;
    unsigned voffA[2], voffB[2];
#pragma unroll
    for (int i = 0; i < 2; ++i) { int R, C; stage_rc(tid * 16 + i * 8192, R, C); const int Rb = Epi::PERM ? ((R & ~31) + perm32(R & 31)) : R;
        voffA[i] = (unsigned)(R * K + C) * 2u; voffB[i] = (unsigned)(Rb * K + C) * 2u; }
    const size_t kstep = (size_t)(BK * 2);
    const size_t hstep = (size_t)HALF * K * 2;
    const size_t tstep = 2 * hstep;
    const unsigned ldsw = (unsigned)wid * 1024u;
    const int aoff = lds_byte(wr * 64 + fr, fq * 8), boff = lds_byte(wc * 32 + fr, fq * 8);
#define PG8_SA(b, h) (((b) * 2 + (h)) * HTB)
#define PG8_SB(b, h) ((4 + (b) * 2 + (h)) * HTB)
#define PG8_STAGE(bufoff, gbase, voff) do { _Pragma("unroll") for (int _i = 0; _i < 2; ++_i) \
        __builtin_amdgcn_global_load_lds((const unsigned*)((const char*)(gbase) + (voff)[_i]), (PG8_LAS unsigned*)(lds + (bufoff) + ldsw + _i * 8192), 16, 0, 0); } while (0)
#define PG8_LDA(dst, b, h) do { _Pragma("unroll") for (int m = 0; m < 4; ++m) _Pragma("unroll") for (int k = 0; k < 2; ++k) dst[m][k] = *(const PG8_LAS bf16x8*)(lds + PG8_SA(b, h) + aoff + m * 2048 + k * 1024); } while (0)
#define PG8_LDB(dst, b, h) do { _Pragma("unroll") for (int n = 0; n < 2; ++n) _Pragma("unroll") for (int k = 0; k < 2; ++k) dst[n][k] = *(const PG8_LAS bf16x8*)(lds + PG8_SB(b, h) + boff + n * 2048 + k * 1024); } while (0)
#define PG8_MMA(ai, bj, At, Bt) do { __builtin_amdgcn_s_setprio(1); _Pragma("unroll") for (int m = 0; m < 4; ++m) _Pragma("unroll") for (int n = 0; n < 2; ++n) _Pragma("unroll") for (int k = 0; k < 2; ++k) \
        acc[ai][bj][m][n] = __builtin_amdgcn_mfma_f32_16x16x32_bf16(Bt[n][k], At[m][k], acc[ai][bj][m][n], 0, 0, 0); __builtin_amdgcn_s_setprio(0); } while (0)
#define PG8_WAIT_V(n) asm volatile("s_waitcnt vmcnt(" #n ")" ::: "memory")
#define PG8_WAIT_L(n) asm volatile("s_waitcnt lgkmcnt(" #n ")" ::: "memory")
#define PG8_BAR __builtin_amdgcn_s_barrier()
#define PG8_SCHED __builtin_amdgcn_sched_barrier(0)
    Unit cur, nxt; int ui = 0;
    if (!S.next(0, cur)) return;
    f32x4 acc[2][2][4][2];
#pragma unroll
    for (int a = 0; a < 2; ++a)
#pragma unroll
        for (int b = 0; b < 2; ++b)
#pragma unroll
            for (int m = 0; m < 4; ++m)
#pragma unroll
                for (int n = 0; n < 2; ++n) acc[a][b][m][n] = (f32x4){0.f, 0.f, 0.f, 0.f};
    bf16x8 At[4][2], B0[2][2], B1[2][2];
    const char* cA = (const char*)g.A + (size_t)cur.pm * tstep; const char* cB = (const char*)g.Bt + (size_t)cur.pn * tstep;
    S.a_ready(cur);
    if constexpr (SP2) {
        PG8_STAGE(PG8_SB(0, 0), cB, voffB); PG8_STAGE(PG8_SB(0, 1), cB + hstep, voffB); PG8_STAGE(PG8_SA(0, 0), cA, voffA); PG8_STAGE(PG8_SA(0, 1), cA + hstep, voffA);
        if (wr == 1) PG8_BAR;
        PG8_WAIT_V(2); PG8_BAR;
        PG8_STAGE(PG8_SB(1, 0), cB + kstep, voffB); PG8_STAGE(PG8_SA(1, 0), cA + kstep, voffA); PG8_STAGE(PG8_SB(1, 1), cB + hstep + kstep, voffB);
        PG8_WAIT_V(6); PG8_BAR;
    } else {
        PG8_STAGE(PG8_SB(0, 0), cB, voffB); PG8_STAGE(PG8_SA(0, 0), cA, voffA); PG8_STAGE(PG8_SB(0, 1), cB + hstep, voffB); PG8_STAGE(PG8_SA(0, 1), cA + hstep, voffA);
        if (wr == 1) PG8_BAR;
        PG8_WAIT_V(4); PG8_BAR;
        PG8_STAGE(PG8_SB(1, 0), cB + kstep, voffB); PG8_STAGE(PG8_SA(1, 0), cA + kstep, voffA); PG8_STAGE(PG8_SB(1, 1), cB + hstep + kstep, voffB);
        PG8_WAIT_V(6); PG8_BAR;
    }
    for (;;) {
        const bool has_next = S.next(ui + 1, nxt);
        const char* nA = has_next ? (const char*)g.A + (size_t)nxt.pm * tstep : cA; const char* nB = has_next ? (const char*)g.Bt + (size_t)nxt.pn * tstep : cB;
        for (int t = 0; t < nt; t += 2) {
            const bool last = (t == nt - 2);
            const char* a1 = cA + (size_t)(t + 1) * kstep;
            const char* a2 = last ? nA : cA + (size_t)(t + 2) * kstep; const char* b2 = last ? nB : cB + (size_t)(t + 2) * kstep;
            const char* a3 = a2 + kstep; const char* b3 = b2 + kstep;
            if (last && has_next) S.a_ready(nxt);
            if constexpr (SP2) {
            PG8_LDB(B0, 0, 0); PG8_LDB(B1, 0, 1); PG8_SCHED; PG8_LDA(At, 0, 0); PG8_STAGE(PG8_SA(1, 1), a1 + hstep, voffA);
            PG8_WAIT_V(8); PG8_WAIT_L(0); PG8_BAR; PG8_MMA(0, 0, At, B0); PG8_MMA(0, 1, At, B1); PG8_BAR; PG8_SCHED;
            PG8_LDA(At, 0, 1); PG8_STAGE(PG8_SB(0, 0), b2, voffB); PG8_STAGE(PG8_SB(0, 1), b2 + hstep, voffB); PG8_STAGE(PG8_SA(0, 0), a2, voffA);
            PG8_WAIT_V(8); PG8_WAIT_L(0); PG8_BAR; PG8_MMA(1, 0, At, B0); PG8_MMA(1, 1, At, B1); PG8_BAR; PG8_SCHED;
            PG8_LDB(B0, 1, 0); PG8_LDB(B1, 1, 1); PG8_SCHED; PG8_LDA(At, 1, 0); PG8_STAGE(PG8_SA(0, 1), a2 + hstep, voffA);
            PG8_WAIT_V(8); PG8_WAIT_L(0); PG8_BAR; PG8_MMA(0, 0, At, B0); PG8_MMA(0, 1, At, B1); PG8_BAR; PG8_SCHED;
            PG8_LDA(At, 1, 1); PG8_STAGE(PG8_SB(1, 0), b3, voffB); PG8_STAGE(PG8_SB(1, 1), b3 + hstep, voffB); PG8_STAGE(PG8_SA(1, 0), a3, voffA);
            PG8_WAIT_V(8); PG8_WAIT_L(0); PG8_BAR; PG8_MMA(1, 0, At, B0); PG8_MMA(1, 1, At, B1); PG8_BAR; PG8_SCHED;
            } else {
            PG8_LDB(B0, 0, 0); PG8_SCHED; PG8_LDA(At, 0, 0); PG8_STAGE(PG8_SA(1, 1), a1 + hstep, voffA);
            PG8_WAIT_L(8); PG8_BAR; PG8_WAIT_L(0); PG8_MMA(0, 0, At, B0); PG8_BAR; PG8_SCHED;
            PG8_LDB(B1, 0, 1); PG8_STAGE(PG8_SB(0, 0), b2, voffB);
            PG8_BAR; PG8_WAIT_L(0); PG8_MMA(0, 1, At, B1); PG8_BAR;
            PG8_LDA(At, 0, 1); PG8_STAGE(PG8_SA(0, 0), a2, voffA);
            PG8_BAR; PG8_WAIT_L(0); PG8_MMA(1, 0, At, B0); PG8_BAR; PG8_SCHED;
            PG8_STAGE(PG8_SB(0, 1), b2 + hstep, voffB);
            PG8_WAIT_V(6); PG8_BAR; PG8_MMA(1, 1, At, B1); PG8_BAR;
            PG8_LDB(B0, 1, 0); PG8_SCHED; PG8_LDA(At, 1, 0); PG8_STAGE(PG8_SA(0, 1), a2 + hstep, voffA);
            PG8_WAIT_L(8); PG8_BAR; PG8_WAIT_L(0); PG8_MMA(0, 0, At, B0); PG8_BAR; PG8_SCHED;
            PG8_LDB(B1, 1, 1); PG8_STAGE(PG8_SB(1, 0), b3, voffB);
            PG8_BAR; PG8_WAIT_L(0); PG8_MMA(0, 1, At, B1); PG8_BAR;
            PG8_LDA(At, 1, 1); PG8_STAGE(PG8_SA(1, 0), a3, voffA);
            PG8_BAR; PG8_WAIT_L(0); PG8_MMA(1, 0, At, B0); PG8_BAR; PG8_SCHED;
            PG8_STAGE(PG8_SB(1, 1), b3 + hstep, voffB);
            PG8_WAIT_V(6); PG8_BAR; PG8_MMA(1, 1, At, B1); PG8_BAR;
            }
        }
        if constexpr (ALIGN_EPI) { if (wr == 0) PG8_BAR; }
        if constexpr (!Epi::AFTER_DRAIN) { E(acc, cur, wr, wc, fr, fq); S.done(cur); }
        if (!has_next) break;
#pragma unroll
        for (int a = 0; a < 2; ++a)
#pragma unroll
            for (int b = 0; b < 2; ++b)
#pragma unroll
                for (int m = 0; m < 4; ++m)
#pragma unroll
                    for (int n = 0; n < 2; ++n) acc[a][b][m][n] = (f32x4){0.f, 0.f, 0.f, 0.f};
        cur = nxt; cA = nA; cB = nB; ++ui;
        if constexpr (ALIGN_EPI) { if (wr == 1) PG8_BAR; }
    }
    PG8_WAIT_V(0);
    if constexpr (!ALIGN_EPI) { if (wr == 0) PG8_BAR; }
    PG8_BAR;
    if constexpr (Epi::AFTER_DRAIN) { E.fused(acc, cur, wr, wc, fr, fq, lds, wid, lane); S.done(cur); }
#undef PG8_SA
#undef PG8_SB
#undef PG8_STAGE
#undef PG8_LDA
#undef PG8_LDB
#undef PG8_MMA
#undef PG8_WAIT_V
#undef PG8_WAIT_L
#undef PG8_BAR
#undef PG8_SCHED
}
}

#ifndef MK_SINGLE
#define MK_SINGLE 1
#endif
constexpr int BATCH = 32, SEQ = 2048, DM = 1024, M = BATCH * SEQ;
constexpr int NIN = 3336, NPROJ = 3328;
constexpr int DFF = 2816, NUP = 2 * DFF;
constexpr int C_Q = 1792, C_K = 2048, C_V = 2304, C_O = 2816;
constexpr int NLORA = 1536, KLORA = 256;
constexpr int MH = M / 2;
constexpr float NORM_EPS = 1e-6f, LNX_EPS = 64e-5f;

constexpr size_t MiB = 1u << 20;
constexpr size_t WS_CTL = 0, CTL_ZERO_BYTES = 1 * MiB;
constexpr size_t WS_WT_IN = 2 * MiB, WS_WT_OUT = 9 * MiB, WS_WT_UP = 11 * MiB, WS_WT_DN = 22 * MiB, WS_WT_LORA = 28 * MiB;
constexpr size_t WS_RS2 = 29 * MiB, WS_RINV = 29 * MiB + 512 * 1024, WS_SSQP = 30 * MiB, WS_GATES = 34 * MiB;
constexpr size_t WS_XN = 40 * MiB;
constexpr size_t WS_PROJ = 168 * MiB;
constexpr size_t WS_LBUF = 584 * MiB;
constexpr size_t WS_DAG = 616 * MiB;
constexpr size_t WS_MIX = 808 * MiB;
constexpr size_t WS_SIDE = 168 * MiB;
constexpr int SIDE_ELEMS = 256 * 22 * 2 * 128;
constexpr size_t WS_FF = 192 * MiB;
constexpr size_t WS_GB = 520 * MiB;
constexpr size_t WS_END = 936 * MiB;

constexpr int LDS_BYTES = 163840;
constexpr int MISC_OFF = LDS_BYTES - 256;

#define GAS __attribute__((address_space(1)))
#define LAS __attribute__((address_space(3)))
typedef unsigned short bf16;
typedef unsigned v4u __attribute__((ext_vector_type(4)));
typedef unsigned v2u __attribute__((ext_vector_type(2)));
typedef float f32x4 __attribute__((ext_vector_type(4)));
typedef float f32x2 __attribute__((ext_vector_type(2)));
typedef short bf16x8 __attribute__((ext_vector_type(8)));
typedef GAS unsigned gu32;

typedef __bf16 bf16x2_t __attribute__((ext_vector_type(2)));
__device__ __forceinline__ unsigned pk2(float lo, float hi) { const f32x2 v = {lo, hi}; const bf16x2_t b = __builtin_convertvector(v, bf16x2_t); return __builtin_bit_cast(unsigned, b); }
__device__ __forceinline__ unsigned f2bf(float f) { return pk2(f, f) & 0xffffu; }
__device__ __forceinline__ float bf2f(unsigned short u) { return __builtin_bit_cast(float, (unsigned)u << 16); }
__device__ __forceinline__ float bflo(unsigned w) { return __builtin_bit_cast(float, w << 16); }
__device__ __forceinline__ float bfhi(unsigned w) { return __builtin_bit_cast(float, w & 0xffff0000u); }
__device__ __forceinline__ void unpack8(const v4u w, float (&o)[8]) { o[0] = bflo(w.x); o[1] = bfhi(w.x); o[2] = bflo(w.y); o[3] = bfhi(w.y); o[4] = bflo(w.z); o[5] = bfhi(w.z); o[6] = bflo(w.w); o[7] = bfhi(w.w); }
__device__ __forceinline__ v4u pack8(const float (&o)[8]) { v4u w; w.x = pk2(o[0], o[1]); w.y = pk2(o[2], o[3]); w.z = pk2(o[4], o[5]); w.w = pk2(o[6], o[7]); return w; }
__device__ __forceinline__ float frcp(float x) { return __builtin_amdgcn_rcpf(x); }
__device__ __forceinline__ float frsq(float x) { return __builtin_amdgcn_rsqf(x); }
__device__ __forceinline__ float fsqrt_(float x) { return __builtin_amdgcn_sqrtf(x); }
__device__ __forceinline__ float fexp(float x) { return __builtin_amdgcn_exp2f(x * 1.4426950408889634f); }
__device__ __forceinline__ float sigmoidf_(float x) { return frcp(1.0f + __builtin_amdgcn_exp2f(x * -1.4426950408889634f)); }
__device__ __forceinline__ float tanhf_(float x) { return 1.0f - 2.0f * frcp(__builtin_amdgcn_exp2f(x * 2.8853900817779268f) + 1.0f); }
__device__ __forceinline__ float softplusf_(float x) { return fmaxf(x, 0.f) + __logf(1.0f + fexp(-fabsf(x))); }
__device__ __forceinline__ float wave_sum(float v) {
#pragma unroll
    for (int o = 1; o < 64; o <<= 1) v += __shfl_xor(v, o);
    return v;
}
template <int CTRL> __device__ __forceinline__ float dppmov(float v) { return __builtin_bit_cast(float, __builtin_amdgcn_update_dpp(0, __builtin_bit_cast(int, v), CTRL, 0xF, 0xF, true)); }
__device__ __forceinline__ float red8(float v) { v += dppmov<0xB1>(v); v += dppmov<0x4E>(v); v += dppmov<0x141>(v); return v; }
__device__ __forceinline__ float red16(float v) { v += dppmov<0xB1>(v); v += dppmov<0x4E>(v); v += dppmov<0x141>(v); v += dppmov<0x140>(v); return v; }

template <int CTRL, int RMASK> __device__ __forceinline__ float dppsh(float idv, float v) { return __builtin_bit_cast(float, __builtin_amdgcn_update_dpp(__builtin_bit_cast(int, idv), __builtin_bit_cast(int, v), CTRL, RMASK, 0xF, false)); }
__device__ __forceinline__ float wave_scan_add(float v) {
    v += dppsh<0x111, 0xF>(0.f, v); v += dppsh<0x112, 0xF>(0.f, v); v += dppsh<0x114, 0xF>(0.f, v); v += dppsh<0x118, 0xF>(0.f, v);
    v += dppsh<0x142, 0xA>(0.f, v); v += dppsh<0x143, 0xC>(0.f, v); return v;
}
__device__ __forceinline__ float wave_scan_max(float v) {
    const float ni = -3.0e38f;
    v = fmaxf(v, dppsh<0x111, 0xF>(ni, v)); v = fmaxf(v, dppsh<0x112, 0xF>(ni, v)); v = fmaxf(v, dppsh<0x114, 0xF>(ni, v)); v = fmaxf(v, dppsh<0x118, 0xF>(ni, v));
    v = fmaxf(v, dppsh<0x142, 0xA>(ni, v)); v = fmaxf(v, dppsh<0x143, 0xC>(ni, v)); return v;
}

#define XB_TMO      128
#define XB_XCNT(j)  (256  + 64 * (j))
#define XB_XSUB(j)  (1280 + 64 * (j))
#define XB_XGEN(j)  (2304 + 64 * (j))
#define XB_TOP      3328
#define XB_TOPGEN   3392
#define XCD_BAR_WORDS 3456
#define XB_SPIN_CAP (1u << 22)
__device__ __forceinline__ unsigned xb_ld(unsigned* p)              { return __hip_atomic_load(p, __ATOMIC_RELAXED, __HIP_MEMORY_SCOPE_AGENT); }
__device__ __forceinline__ unsigned xb_add(unsigned* p, unsigned v) { return __hip_atomic_fetch_add(p, v, __ATOMIC_RELAXED, __HIP_MEMORY_SCOPE_AGENT); }
__device__ __forceinline__ unsigned xb_xcc_id() { return (unsigned)__builtin_amdgcn_s_getreg((3 << 11) | 20) & 0xFu; }
#define XB_SPIN(cond, bar) do { unsigned _sp = 0; while (cond) { __builtin_amdgcn_s_sleep(1); \
    if ((++_sp & 255u) == 0u) { if (xb_ld(&(bar)[XB_TMO])) break; if (_sp > XB_SPIN_CAP) { atomicAdd(&(bar)[XB_TMO], 1u); break; } } } } while (0)
struct XcdBarrier { unsigned* bar; unsigned x; volatile LAS unsigned* st; };
__device__ __forceinline__ XcdBarrier xcd_barrier_post(unsigned* bar, volatile LAS unsigned* st) {
    XcdBarrier b; b.bar = bar; b.x = xb_xcc_id(); b.st = st;
    if (threadIdx.x == 0) (void)xb_add(&bar[XB_XCNT(b.x)], 1u);
    return b;
}
__device__ __forceinline__ void xcd_barrier_complete(unsigned* bar, unsigned x, unsigned& nloc, unsigned& nx) {
    const unsigned G = gridDim.x * gridDim.y * gridDim.z;
    unsigned sum, cnt, mine, sp = 0u;
    for (;;) {
        sum = 0u; cnt = 0u; mine = 0u;
#pragma unroll
        for (unsigned j = 0; j < 16; ++j) { const unsigned c = xb_ld(&bar[XB_XCNT(j)]); sum += c; cnt += (c > 0u) ? 1u : 0u; mine = (j == x) ? c : mine; }
        if (sum == G) break;
        __builtin_amdgcn_s_sleep(1);
        if ((++sp & 255u) == 0u) { if (xb_ld(&bar[XB_TMO])) break; if (sp > XB_SPIN_CAP) { atomicAdd(&bar[XB_TMO], 1u); break; } }
    }
    nloc = mine > 0u ? mine : 1u; nx = cnt > 0u ? cnt : 1u;
}
__device__ __forceinline__ void xcd_barrier(const XcdBarrier& b) {
    asm volatile("s_waitcnt vmcnt(0)" ::: "memory");
    __syncthreads();
    if (threadIdx.x == 0) {
        unsigned* bar = b.bar;
        __builtin_amdgcn_s_waitcnt(0);
        unsigned nloc = b.st[0], nx = b.st[1];
        if (nloc == 0u) { xcd_barrier_complete(bar, b.x, nloc, nx); b.st[0] = nloc; b.st[1] = nx; }
        const unsigned old = xb_add(&bar[XB_XSUB(b.x)], 1u);
        const unsigned gen = old / nloc;
        if (old + 1u == (gen + 1u) * nloc) {
            __builtin_amdgcn_fence(__ATOMIC_RELEASE, "agent");
            asm volatile("s_waitcnt vmcnt(0)" ::: "memory");
            const unsigned og = xb_add(&bar[XB_TOP], 1u);
            const unsigned tg = og / nx;
            if (og + 1u == (tg + 1u) * nx) xb_add(&bar[XB_TOPGEN], 1u);
            else XB_SPIN(xb_ld(&bar[XB_TOPGEN]) == tg, bar);
            __builtin_amdgcn_fence(__ATOMIC_ACQUIRE, "agent");
            xb_add(&bar[XB_XGEN(b.x)], 1u);
            asm volatile("s_waitcnt vmcnt(0)" ::: "memory");
        } else {
            XB_SPIN(xb_ld(&bar[XB_XGEN(b.x)]) == gen, bar);
            __builtin_amdgcn_fence(__ATOMIC_ACQUIRE, "agent");
            asm volatile("s_waitcnt vmcnt(0)" ::: "memory");
        }
    }
    __syncthreads();
}

__device__ __forceinline__ int opaque_i(int v) { asm volatile("" : "+s"(v)); return v; }
#define LDS_BARRIER() do { asm volatile("s_waitcnt lgkmcnt(0)" ::: "memory"); __builtin_amdgcn_s_barrier(); asm volatile("" ::: "memory"); } while (0)
struct Args { const float* in[26]; float* out; unsigned char* ws; int ph_lo, ph_hi; };

namespace pg8 {
struct PairPanelOrder {
    int c;
    __device__ bool next(int i, Unit& u) const { if (i >= 12) return false; u.pm = 2 * c + i / 6; u.pn = i % 6; return true; }
    __device__ __forceinline__ void a_ready(const Unit&) const {}
    __device__ __forceinline__ void done(const Unit&) const {}
};
struct PanelOrder {
    int c;
    __device__ bool next(int i, Unit& u) const { if (i >= 4) return false; u.pm = c; u.pn = i; return true; }
    __device__ __forceinline__ void a_ready(const Unit&) const {}
    __device__ __forceinline__ void done(const Unit&) const {}
};
struct EpiResid {
    static constexpr bool PERM = true, AFTER_DRAIN = false;
    bf16_t* XB; const float* rinv; float* ssqp;
    __device__ __forceinline__ void operator()(const f32x4 (&acc)[2][2][4][2], const Unit& u, int wr, int wc, int fr, int fq) const {
        const int row0 = u.pm * BM + wr * 64 + fr, col0 = u.pn * BM + wc * 32 + 8 * fq;
#pragma unroll
        for (int ai = 0; ai < 2; ++ai)
#pragma unroll
            for (int m = 0; m < 4; ++m) { const int row = row0 + ai * HALF + m * 16; float ss = 0.f; const float ri = rinv[row];
#pragma unroll
                for (int bj = 0; bj < 2; ++bj) { const size_t off = (size_t)row * DM + col0 + bj * HALF;
                    float xv[8]; unpack8(*(const u32x4*)(XB + off), xv);
                    float v[8];
#pragma unroll
                    for (int j = 0; j < 4; ++j) { v[j] = acc[ai][bj][m][0][j] + xv[j] * ri; v[4 + j] = acc[ai][bj][m][1][j] + xv[4 + j] * ri; }
#pragma unroll
                    for (int j = 0; j < 8; ++j) ss += v[j] * v[j];
                    *(u32x4*)(XB + off) = pack8(v); }
                ss += __shfl_xor(ss, 16); ss += __shfl_xor(ss, 32);
                if (fq == 0) ssqp[(size_t)row * 16 + u.pn * 4 + wc] = ss; }
    }
};
struct EpiScale {
    static constexpr bool PERM = true, AFTER_DRAIN = false;
    bf16_t* O; int ldc; const float* rs; int row_off;
    __device__ __forceinline__ void operator()(const f32x4 (&acc)[2][2][4][2], const Unit& u, int wr, int wc, int fr, int fq) const {
        const int row0 = u.pm * BM + wr * 64 + fr, col0 = u.pn * BM + wc * 32 + 8 * fq;
#pragma unroll
        for (int ai = 0; ai < 2; ++ai)
#pragma unroll
            for (int m = 0; m < 4; ++m) { const int row = row0 + ai * HALF + m * 16; const float s = rs[row_off + row]; bf16_t* rowp = O + (size_t)row * ldc + col0;
#pragma unroll
                for (int bj = 0; bj < 2; ++bj) { const f32x4 v0 = acc[ai][bj][m][0] * s, v1 = acc[ai][bj][m][1] * s;
                    u32x4 w; w.x = pk2(v0[0], v0[1]); w.y = pk2(v0[2], v0[3]); w.z = pk2(v1[0], v1[1]); w.w = pk2(v1[2], v1[3]); *(u32x4*)(rowp + bj * HALF) = w; } }
    }
};
struct EpiFfn {
    static constexpr bool PERM = true, AFTER_DRAIN = false;
    bf16_t* G; const float* rs; const float* cw; const float* cb; float* SA; float* SB; float* SL; LAS float* hal;
    __device__ __forceinline__ void operator()(const f32x4 (&acc)[2][2][4][2], const Unit& u, int wr, int wc, int fr, int fq) const {
        int chl = wc * 32 + 8 * fq; asm volatile("" : "+v"(chl));
        const int f0 = u.pn * 128 + chl, rowt = wr * 64 + fr;
        float rsv[2][4];
#pragma unroll
        for (int ai = 0; ai < 2; ++ai)
#pragma unroll
            for (int m = 0; m < 4; ++m) rsv[ai][m] = rs[u.pm * BM + ai * HALF + m * 16 + rowt];
        const size_t sbase = ((size_t)(u.pm * 22 + u.pn) * 2) * 128 + chl;
        if (fr >= 14) {
#pragma unroll
            for (int ai = 0; ai < 2; ++ai) { const float r_ = rsv[ai][3]; const f32x4 v0 = acc[ai][0][3][0] * r_, v1 = acc[ai][0][3][1] * r_;
                LAS float* hp = hal + ((ai * 2 + wr) * 2 + (fr - 14)) * 128 + chl; *(LAS f32x4*)hp = v0; *(LAS f32x4*)(hp + 4) = v1;
                if (ai == 1 && wr == 1) { float* gp = SL + sbase + (fr - 14) * 128; *(f32x4*)gp = v0; *(f32x4*)(gp + 4) = v1; } }
        }
        if (wr == 0 && fr < 2) { const float r_ = rsv[0][0]; float* ga = SA + sbase + fr * 128; float* gb = SB + sbase + fr * 128;
            *(f32x4*)ga = acc[0][0][0][0] * r_; *(f32x4*)(ga + 4) = acc[0][0][0][1] * r_; *(f32x4*)gb = acc[0][1][0][0] * r_; *(f32x4*)(gb + 4) = acc[0][1][0][1] * r_; }
        asm volatile("s_waitcnt lgkmcnt(0)" ::: "memory"); __builtin_amdgcn_s_barrier(); asm volatile("" ::: "memory");
        float w0[8], w1[8], w2[8], bz[8];
        { const f32x4 a0 = *(const f32x4*)(cw + f0), a1 = *(const f32x4*)(cw + f0 + 4), b0 = *(const f32x4*)(cw + DFF + f0), b1 = *(const f32x4*)(cw + DFF + f0 + 4);
          const f32x4 c0 = *(const f32x4*)(cw + 2 * DFF + f0), c1 = *(const f32x4*)(cw + 2 * DFF + f0 + 4), d0 = *(const f32x4*)(cb + f0), d1 = *(const f32x4*)(cb + f0 + 4);
#pragma unroll
          for (int j = 0; j < 4; ++j) { w0[j] = a0[j]; w0[4 + j] = a1[j]; w1[j] = b0[j]; w1[4 + j] = b1[j]; w2[j] = c0[j]; w2[4 + j] = c1[j]; bz[j] = d0[j]; bz[4 + j] = d1[j]; } }
        const bool fr0 = (fr == 0), frl2 = (fr < 2);
#pragma unroll
        for (int ai = 0; ai < 2; ++ai) {
            float ap[8];
            const int pb = ai * 2 + wr - 1;
#pragma unroll
            for (int m = 0; m < 4; ++m) {
                float av[8], bv[8], y1[8], y2[8];
                const float r_ = rsv[ai][m];
#pragma unroll
                for (int j = 0; j < 4; ++j) { av[j] = acc[ai][0][m][0][j] * r_; av[4 + j] = acc[ai][0][m][1][j] * r_; bv[j] = acc[ai][1][m][0][j] * r_; bv[4 + j] = acc[ai][1][m][1][j] * r_; }
                if (m == 0) {
                    if (pb >= 0) { const LAS float* h0 = hal + (pb * 2) * 128 + chl; const f32x4 h00 = *(const LAS f32x4*)h0, h01 = *(const LAS f32x4*)(h0 + 4), h10 = *(const LAS f32x4*)(h0 + 128), h11 = *(const LAS f32x4*)(h0 + 132);
#pragma unroll
                        for (int j = 0; j < 4; ++j) { y1[j] = h10[j]; y1[4 + j] = h11[j]; y2[j] = fr0 ? h00[j] : h10[j]; y2[4 + j] = fr0 ? h01[j] : h11[j]; } }
                    else {
#pragma unroll
                        for (int j = 0; j < 8; ++j) { y1[j] = 0.f; y2[j] = 0.f; } }
                } else {
#pragma unroll
                    for (int j = 0; j < 8; ++j) { y1[j] = dppmov<0x121>(ap[j]); y2[j] = dppmov<0x122>(ap[j]); }
                }
                float o[8];
#pragma unroll
                for (int j = 0; j < 8; ++j) { const float x1 = dppmov<0x121>(av[j]), x2 = dppmov<0x122>(av[j]);
                    const float am1 = fr0 ? y1[j] : x1, am2 = frl2 ? y2[j] : x2;
                    const float z = bz[j] + w0[j] * am2 + w1[j] * am1 + w2[j] * av[j];
                    o[j] = z * sigmoidf_(z) * bv[j]; ap[j] = av[j]; }
                if (!(ai == 0 && m == 0 && wr == 0 && frl2)) *(u32x4*)(G + (size_t)(u.pm * BM + ai * HALF + m * 16 + rowt) * DFF + f0) = pack8(o);
            }
        }
    }
};
}

template <bool FFN_UP = false>
__device__ __forceinline__ void transpose_item(const float* W, int ldw, int K, bf16* WT, const float* kscale, LAS float* scr, int item, int nblk, int lane) {
    const int kb = item / nblk, nb = item % nblk, k0 = 64 * kb, n0 = 32 * nb;
    const int d0 = !FFN_UP ? n0 : (n0 < DFF ? ((n0 >> 7) * 256 + (n0 & 127)) : ((((n0 - DFF) >> 7) * 256) + 128 + ((n0 - DFF) & 127)));
#pragma unroll 8
    for (int i = 0; i < 32; ++i) { const int kk = 2 * i + (lane >> 5); const float s = kscale ? kscale[k0 + kk] : 1.0f; scr[kk * 33 + (lane & 31)] = W[(size_t)(k0 + kk) * ldw + n0 + (lane & 31)] * s; }
    asm volatile("s_waitcnt lgkmcnt(0)" ::: "memory");
    const int c = lane & 7;
#pragma unroll
    for (int j = 0; j < 4; ++j) { const int n = (lane >> 3) + 8 * j; const LAS float* s = scr + (8 * c) * 33 + n;
        v4u o; o.x = pk2(s[0 * 33], s[1 * 33]); o.y = pk2(s[2 * 33], s[3 * 33]); o.z = pk2(s[4 * 33], s[5 * 33]); o.w = pk2(s[6 * 33], s[7 * 33]);
        *(v4u*)(WT + (size_t)(d0 + n) * K + k0 + 8 * c) = o; }
    asm volatile("s_waitcnt lgkmcnt(0)" ::: "memory");
}

__device__ __forceinline__ float wave_red63(float v) {
    v += dppmov<0xB1>(v); v += dppmov<0x4E>(v); v += dppmov<0x141>(v); v += dppmov<0x140>(v);
    v += dppsh<0x142, 0xA>(0.f, v); v += dppsh<0x143, 0xC>(0.f, v); return v;
}
__device__ __forceinline__ float lane63(float v) { return __builtin_bit_cast(float, __builtin_amdgcn_readlane(__builtin_bit_cast(int, v), 63)); }
__device__ __forceinline__ void late_transposes(const Args& a, LAS unsigned char* lds, int lane, int wave, int gw, int NGW) {
    unsigned char* ws = a.ws; LAS float* scr = (LAS float*)(lds + wave * 16384);
    constexpr int I_OUT = 16 * 32, I_UP = 16 * 176, I_DN = 44 * 32;
    for (int it = gw; it < I_OUT + I_UP + I_DN; it += NGW) {
        int r = it;
        if (r < I_OUT) { transpose_item(a.in[19], DM, DM, (bf16*)(ws + WS_WT_OUT), nullptr, scr, r, 32, lane); continue; } r -= I_OUT;
        if (r < I_UP) { transpose_item<true>(a.in[21], NUP, DM, (bf16*)(ws + WS_WT_UP), a.in[20], scr, r, 176, lane); continue; } r -= I_UP;
        transpose_item(a.in[24], DM, DFF, (bf16*)(ws + WS_WT_DN), nullptr, scr, r, 32, lane);
    }
}
__device__ __forceinline__ void phase_prep(const Args& a, LAS unsigned char* lds, int tid, int lane, int wave) {
    unsigned char* ws = a.ws;
    LAS float* scr = (LAS float*)(lds + wave * 16384);
    const int gw = blockIdx.x * 8 + wave, NGW = gridDim.x * 8;
    constexpr int I_IN = 16 * 104;
    for (int it = gw; it < I_IN; it += NGW) transpose_item(a.in[2], NIN, DM, (bf16*)(ws + WS_WT_IN), a.in[1], scr, it, 104, lane);
    {
        const float* wd = a.in[5]; const float* wa = a.in[7]; const float* wg = a.in[8]; bf16* WL = (bf16*)(ws + WS_WT_LORA);
        for (int idx = blockIdx.x * 512 + tid; idx < NLORA * KLORA; idx += gridDim.x * 512) {
            const int n = idx >> 8, k = idx & 255; float v = 0.f;
            if (n < 512) { if (k < 64) v = wd[k * 512 + n]; }
            else if (n < 1024) { if (k >= 64 && k < 128) v = wa[(k - 64) * 512 + (n - 512)]; }
            else { if (k >= 128) v = wg[(k - 128) * 512 + (n - 1024)]; }
            WL[idx] = (bf16)f2bf(v);
        }
    }
    {
        const float* x = a.in[0]; const float* g1 = a.in[1]; const float* w_in = a.in[2];
        bf16* XN = (bf16*)(ws + WS_XN); float* gates = (float*)(ws + WS_GATES); float* rinvp = (float*)(ws + WS_RINV);
        float wgt[16][8];
#pragma unroll
        for (int j = 0; j < 4; ++j)
#pragma unroll
            for (int e = 0; e < 4; ++e) { const int k = 4 * lane + 256 * j + e; const float g = g1[k];
                const f32x4 w0 = *(const f32x4*)(w_in + (size_t)k * NIN + 3328), w1 = *(const f32x4*)(w_in + (size_t)k * NIN + 3332);
                wgt[j * 4 + e][0] = w0[0] * g; wgt[j * 4 + e][1] = w0[1] * g; wgt[j * 4 + e][2] = w0[2] * g; wgt[j * 4 + e][3] = w0[3] * g;
                wgt[j * 4 + e][4] = w1[0] * g; wgt[j * 4 + e][5] = w1[1] * g; wgt[j * 4 + e][6] = w1[2] * g; wgt[j * 4 + e][7] = w1[3] * g; }
        f32x4 vn[4];
        { const f32x4* xr = (const f32x4*)(x + (size_t)gw * DM) + lane;
#pragma unroll
          for (int j = 0; j < 4; ++j) vn[j] = xr[64 * j]; }
        for (int row = gw; row < M; row += NGW) {
            f32x4 v[4];
#pragma unroll
            for (int j = 0; j < 4; ++j) v[j] = vn[j];
            { const int rn = (row + NGW < M) ? row + NGW : row; const f32x4* xr = (const f32x4*)(x + (size_t)rn * DM) + lane;
#pragma unroll
              for (int j = 0; j < 4; ++j) vn[j] = xr[64 * j]; }
            float ss = 0.f;
#pragma unroll
            for (int j = 0; j < 4; ++j) ss += (v[j][0] * v[j][0] + v[j][1] * v[j][1]) + (v[j][2] * v[j][2] + v[j][3] * v[j][3]);
            float gs[8];
#pragma unroll
            for (int jg = 0; jg < 8; ++jg) { float s_ = 0.f;
#pragma unroll
                for (int j = 0; j < 4; ++j)
#pragma unroll
                    for (int e = 0; e < 4; ++e) s_ += v[j][e] * wgt[j * 4 + e][jg];
                gs[jg] = s_; }
            ss = wave_red63(ss);
#pragma unroll
            for (int jg = 0; jg < 8; ++jg) gs[jg] = wave_red63(gs[jg]);
            const float ms = lane63(ss) * (1.0f / DM) + NORM_EPS; const float rs = frsq(ms);
            if (lane == 0) rinvp[row] = fsqrt_(ms);
            unsigned long long* o8 = (unsigned long long*)(XN + (size_t)row * DM) + lane;
#pragma unroll
            for (int j = 0; j < 4; ++j) o8[64 * j] = (unsigned long long)pk2(v[j][0] * rs, v[j][1] * rs) | ((unsigned long long)pk2(v[j][2] * rs, v[j][3] * rs) << 32);
            if (lane == 63) { f32x4* gp = (f32x4*)(gates + (size_t)row * 8); gp[0] = (f32x4){gs[0] * rs, gs[1] * rs, gs[2] * rs, gs[3] * rs}; gp[1] = (f32x4){gs[4] * rs, gs[5] * rs, gs[6] * rs, gs[7] * rs}; }
        }
    }
}

__device__ __forceinline__ void phase_lmat(const Args& a, int tid, int row_lo, int nrows) {
    unsigned char* ws = a.ws; const bf16* PROJ = (const bf16*)(ws + WS_PROJ); bf16* L = (bf16*)(ws + WS_LBUF); const float* mu = a.in[3];
    for (int it = tid; it < nrows * 32; it += 512) {
        const int row = row_lo + (it >> 5), grp = it & 31, c0 = 1536 + 8 * grp;
        const v4u cur = *(const v4u*)(PROJ + (size_t)row * NPROJ + c0);
        v4u prv = {0u, 0u, 0u, 0u}; if ((row & (SEQ - 1)) != 0) prv = *(const v4u*)(PROJ + (size_t)(row - 1) * NPROJ + c0);
        const f32x4 m0 = *(const f32x4*)(mu + c0), m1 = *(const f32x4*)(mu + c0 + 4);
        float c[8], p[8], o[8]; unpack8(cur, c); unpack8(prv, p);
#pragma unroll
        for (int e = 0; e < 8; ++e) { const float mm = e < 4 ? m0[e & 3] : m1[e & 3]; const float xv = c[e] + (p[e] - c[e]) * mm;
            o[e] = grp < 8 ? tanhf_(xv) : (grp < 16 ? xv : sigmoidf_(xv)); }
        *(v4u*)(L + (size_t)row * KLORA + 8 * grp) = pack8(o);
    }
}

constexpr int RK_SLOT = 64 * 64;
__device__ __forceinline__ int rk_off(int row, int col) { return row * 64 + ((((col >> 3) ^ row) & 7) << 3) + (col & 7); }
__device__ __forceinline__ f32x4 mfma16(const bf16x8 a, const bf16x8 b, const f32x4 c) { return __builtin_amdgcn_mfma_f32_16x16x32_bf16(a, b, c, 0, 0, 0); }
__device__ __forceinline__ void rk_frag(bf16x8 (&f)[2], const LAS bf16* base, int row0, int l15, int l4) { const LAS bf16* p = base + (row0 + l15) * 64; f[0] = *(const LAS bf16x8*)(p + ((l4 ^ (l15 & 7)) << 3)); f[1] = *(const LAS bf16x8*)(p + (((4 + l4) ^ (l15 & 7)) << 3)); }
template <bool ACC> __device__ __forceinline__ void rk_prod(f32x4 (&acc)[2], const LAS bf16* Aop, const LAS bf16* Bop, int mb, int nb0, int l15, int l4) {
    bf16x8 a[2]; rk_frag(a, Aop, 16 * mb, l15, l4);
#pragma unroll
    for (int q = 0; q < 2; ++q) { bf16x8 b[2]; rk_frag(b, Bop, 16 * (nb0 + q), l15, l4); f32x4 c = ACC ? acc[q] : (f32x4){0.f, 0.f, 0.f, 0.f}; c = mfma16(a[0], b[0], c); acc[q] = mfma16(a[1], b[1], c); }
}
struct RkA { bf16x8 f[2]; };
struct RkB { bf16x8 f[2][2]; };
__device__ __forceinline__ RkA rk_lda(const LAS bf16* base, int mb, int l15, int l4) { RkA r; rk_frag(r.f, base, 16 * mb, l15, l4); return r; }
__device__ __forceinline__ RkB rk_ldb(const LAS bf16* base, int nb0, int l15, int l4) { RkB r; rk_frag(r.f[0], base, 16 * nb0, l15, l4); rk_frag(r.f[1], base, 16 * (nb0 + 1), l15, l4); return r; }
template <bool ACC> __device__ __forceinline__ void rk_mm(f32x4 (&acc)[2], const RkA& a, const RkB& b) {
#pragma unroll
    for (int q = 0; q < 2; ++q) { f32x4 c = ACC ? acc[q] : (f32x4){0.f, 0.f, 0.f, 0.f}; c = mfma16(a.f[0], b.f[q][0], c); acc[q] = mfma16(a.f[1], b.f[q][1], c); }
}
__device__ __forceinline__ void rk_store(LAS bf16* dst, const f32x4 (&acc)[2], int mb, int nb0, int l15, int l4) {
#pragma unroll
    for (int q = 0; q < 2; ++q) { v2u w; w.x = pk2(acc[q][0], acc[q][1]); w.y = pk2(acc[q][2], acc[q][3]); *(LAS v2u*)(dst + rk_off(16 * (nb0 + q) + l15, 16 * mb + 4 * l4)) = w; }
}
__device__ __forceinline__ void rwkv_unit(const Args& a, LAS unsigned char* lds, int unit, int tid, int lane, int wave) {
    unsigned char* ws = a.ws; const bf16* PROJ = (const bf16*)(ws + WS_PROJ); const bf16* DAG = (const bf16*)(ws + WS_DAG); bf16* MIX = (bf16*)(ws + WS_MIX);
    const int b = unit >> 3, h = unit & 7;
    LAS bf16* slot = (LAS bf16*)lds;
#define RK_S(k) (slot + (k) * RK_SLOT)
    LAS bf16* Ab = RK_S(0); LAS bf16* Ut = RK_S(0); LAS bf16* Bb = RK_S(1); LAS bf16* Kb = RK_S(2); LAS bf16* Rb = RK_S(3); LAS bf16* KhT = RK_S(4); LAS float* Yl = (LAS float*)RK_S(3);
    LAS bf16* BhT = RK_S(5); LAS bf16* Vt = RK_S(6); LAS bf16* P0 = RK_S(7); LAS bf16* P0T = RK_S(8); LAS bf16* Aak = RK_S(9); LAS bf16* Arb = RK_S(10); LAS bf16* Ark = RK_S(11);
    LAS bf16* TA = RK_S(12); LAS bf16* TB = RK_S(13); LAS bf16* Xt = RK_S(14); LAS bf16* Sb = RK_S(15);
    LAS float* g63 = (LAS float*)RK_S(16); LAS float* bon = g63 + 64; LAS float* ssP = bon + 64; LAS float* bnP = ssP + 512; LAS float* cst = bnP + 512;
    const int l15 = lane & 15, l4 = lane >> 4, mb = wave & 3, nb0 = 2 * (wave >> 2);
    const int tt = tid >> 3, c8 = tid & 7;
    const int jw = 8 * wave;
    for (int i = tid; i < 640; i += 512) { const int k = i >> 6, c_ = i & 63, j = h * 64 + c_;
        const float* src = k == 0 ? a.in[3] + j : k == 1 ? a.in[3] + 512 + j : k == 2 ? a.in[3] + 1024 + j : k == 3 ? a.in[9] + j : k == 4 ? a.in[10] + j : k == 5 ? a.in[11] + j : k == 6 ? a.in[4] + j : k == 7 ? a.in[6] + j : k == 8 ? a.in[12] + j : a.in[13] + j;
        cst[i] = *src; }
    for (int i = tid; i < RK_SLOT / 2; i += 512) ((LAS unsigned*)Sb)[i] = 0u;
    f32x4 sacc[2], tacc[2], yacc[2];
    sacc[0] = (f32x4){0.f, 0.f, 0.f, 0.f}; sacc[1] = sacc[0];
    v4u g_rc, g_kc, g_vc, g_rp, g_kp, g_vp, g_ld, g_a, g_g;
    v4u pend = {0u, 0u, 0u, 0u}; bf16* pend_p = MIX;
#define RK_LOADCHUNK(c_) do { const int t_ = b * SEQ + (c_) * 64 + lane; const bf16* pr_ = PROJ + (size_t)t_ * NPROJ + h * 64 + jw; \
        g_rc = *(const v4u*)pr_; g_kc = *(const v4u*)(pr_ + 512); g_vc = *(const v4u*)(pr_ + 1024); \
        if ((c_) == 0 && lane == 0) { g_rp = (v4u){0u, 0u, 0u, 0u}; g_kp = g_rp; g_vp = g_rp; } \
        else { g_rp = *(const v4u*)(pr_ - NPROJ); g_kp = *(const v4u*)(pr_ - NPROJ + 512); g_vp = *(const v4u*)(pr_ - NPROJ + 1024); } \
        const bf16* dg_ = DAG + (size_t)t_ * NLORA + h * 64 + jw; g_ld = *(const v4u*)dg_; g_a = *(const v4u*)(dg_ + 512); \
        g_g = *(const v4u*)(DAG + (size_t)(b * SEQ + (c_) * 64 + tt) * NLORA + 1024 + h * 64 + 8 * c8); } while (0)
    RK_LOADCHUNK(0);
    LDS_BARRIER();
    for (int c = 0; c < SEQ / 64; ++c) {
        const int t0 = b * SEQ + c * 64;
        float rr[8], km[8], vv[8], av[8], lgw[8], kkr[8];
        asm volatile("" : "+v"(g_rc), "+v"(g_kc), "+v"(g_vc), "+v"(g_rp), "+v"(g_kp), "+v"(g_vp), "+v"(g_ld), "+v"(g_a), "+v"(g_g));
        {
            float rc[8], kc[8], vc[8], rp_[8], kp[8], vp[8], ldv[8];
            unpack8(g_rc, rc); unpack8(g_kc, kc); unpack8(g_vc, vc); unpack8(g_rp, rp_); unpack8(g_kp, kp); unpack8(g_vp, vp); unpack8(g_ld, ldv); unpack8(g_a, av);
            float ss = 0.f, bonus = 0.f;
#pragma unroll
            for (int e = 0; e < 8; ++e) { const int j = jw + e;
                rr[e] = rc[e] + (rp_[e] - rc[e]) * cst[j]; const float k = kc[e] + (kp[e] - kc[e]) * cst[64 + j]; vv[e] = vc[e] + (vp[e] - vc[e]) * cst[128 + j];
                kkr[e] = k * cst[192 + j]; ss += kkr[e] * kkr[e];
                av[e] = sigmoidf_(cst[448 + j] + av[e]);
                lgw[e] = -0.6065306597f * sigmoidf_(cst[384 + j] + ldv[e]);
                km[e] = k * (1.0f + (av[e] - 1.0f) * cst[256 + j]);
                bonus += rr[e] * km[e] * cst[320 + j]; }
            ssP[lane * 8 + wave] = ss; bnP[lane * 8 + wave] = bonus;
        }
        const v4u gcur = g_g;
        LDS_BARRIER();
        {
            const f32x4 s0 = *(const LAS f32x4*)(ssP + lane * 8), s1 = *(const LAS f32x4*)(ssP + lane * 8 + 4), b0 = *(const LAS f32x4*)(bnP + lane * 8), b1 = *(const LAS f32x4*)(bnP + lane * 8 + 4);
            const float ss = ((s0[0] + s0[1]) + (s0[2] + s0[3])) + ((s1[0] + s1[1]) + (s1[2] + s1[3]));
            if (wave == 0) bon[lane] = ((b0[0] + b0[1]) + (b0[2] + b0[3])) + ((b1[0] + b1[1]) + (b1[2] + b1[3]));
            const float inv = frcp(fmaxf(fsqrt_(ss), 1e-12f));
            float oA[8], oB[8], oK[8], oR[8], oBh[8], oKh[8];
#pragma unroll
            for (int e = 0; e < 8; ++e) { const float lw = wave_scan_add(lgw[e]); const float l63 = __builtin_bit_cast(float, __builtin_amdgcn_readlane(__builtin_bit_cast(int, lw), 63));
                const float eP = fexp(lw - lgw[e]), eM = fexp(-lw), eL = fexp(lw), e63 = fexp(l63), eH = e63 * eM;
                const float kk = kkr[e] * inv, bb = kk * av[e];
                oA[e] = -kk * eP; oB[e] = bb * eM; oK[e] = km[e] * eM; oR[e] = rr[e] * eL; oBh[e] = bb * eH; oKh[e] = km[e] * eH;
                if (lane == 63) g63[jw + e] = e63; }
            { const int ro = rk_off(lane, jw); *(LAS v4u*)(Ab + ro) = pack8(oA); *(LAS v4u*)(Bb + ro) = pack8(oB); *(LAS v4u*)(Kb + ro) = pack8(oK); *(LAS v4u*)(Rb + ro) = pack8(oR); }
#pragma unroll
            for (int e = 0; e < 8; ++e) { const int to = rk_off(jw + e, lane); BhT[to] = (bf16)f2bf(oBh[e]); KhT[to] = (bf16)f2bf(oKh[e]); Vt[to] = (bf16)f2bf(vv[e]); }
            if (c > 0) *(v4u*)pend_p = pend;
            if (c + 1 < SEQ / 64) RK_LOADCHUNK(c + 1);
        }
        LDS_BARRIER();
        {
            f32x4 d[2];
#define RK_MASK_LT(D_, MISS_) _Pragma("unroll") for (int q = 0; q < 2; ++q) { const int nb_ = nb0 + q; \
                if (MISS_ ? (mb < nb_) : (mb > nb_)) D_[q] = (f32x4){0.f, 0.f, 0.f, 0.f}; \
                else if (mb == nb_) { _Pragma("unroll") for (int r = 0; r < 4; ++r) { const int m_ = 4 * l4 + r; D_[q][r] = (MISS_ ? (l15 < m_) : (m_ < l15)) ? D_[q][r] : 0.f; } } }
#define RK_MASK_LE(D_) _Pragma("unroll") for (int q = 0; q < 2; ++q) { const int nb_ = nb0 + q; \
                if (mb > nb_) D_[q] = (f32x4){0.f, 0.f, 0.f, 0.f}; \
                else if (mb == nb_) { _Pragma("unroll") for (int r = 0; r < 4; ++r) { const int m_ = 4 * l4 + r; D_[q][r] = (m_ <= l15) ? D_[q][r] : 0.f; } } }
            const RkA aB = rk_lda(Bb, mb, l15, l4), aA = rk_lda(Ab, mb, l15, l4), aK = rk_lda(Kb, mb, l15, l4);
            const RkB bA = rk_ldb(Ab, nb0, l15, l4), bB = rk_ldb(Bb, nb0, l15, l4), bR = rk_ldb(Rb, nb0, l15, l4);
            f32x4 d2[2], d3[2], d4[2], d5[2];
            rk_mm<false>(d, aB, bA);
            rk_mm<false>(d2, aA, bB);
            rk_mm<false>(d3, aK, bA);
            rk_mm<false>(d4, aB, bR);
            rk_mm<false>(d5, aK, bR);
            RK_MASK_LT(d, false);
#pragma unroll
            for (int q = 0; q < 2; ++q)
#pragma unroll
                for (int r = 0; r < 4; ++r) tacc[q][r] = d[q][r] + ((mb == nb0 + q && 4 * l4 + r == l15) ? 1.f : 0.f);
            RK_MASK_LT(d2, true); RK_MASK_LT(d3, false); RK_MASK_LE(d4); RK_MASK_LE(d5);
            rk_store(P0, d, mb, nb0, l15, l4); rk_store(TA, tacc, mb, nb0, l15, l4); rk_store(P0T, d2, mb, nb0, l15, l4); rk_store(Aak, d3, mb, nb0, l15, l4); rk_store(Arb, d4, mb, nb0, l15, l4); rk_store(Ark, d5, mb, nb0, l15, l4);
        }
        LDS_BARRIER();
        {
            const RkA aPT = rk_lda(P0T, mb, l15, l4), aP = rk_lda(P0, mb, l15, l4), aA = rk_lda(Ab, mb, l15, l4), aAk = rk_lda(Aak, mb, l15, l4);
            const RkB bP = rk_ldb(P0, nb0, l15, l4), bPT = rk_ldb(P0T, nb0, l15, l4), bS = rk_ldb(Sb, nb0, l15, l4), bV = rk_ldb(Vt, nb0, l15, l4);
            f32x4 d[2], d2[2], d3[2];
            rk_mm<false>(d, aPT, bP); rk_mm<false>(d2, aP, bPT); rk_mm<false>(d3, aA, bS); rk_mm<true>(d3, aAk, bV);
            const RkA aS = rk_lda(Sb, mb, l15, l4), aV = rk_lda(Vt, mb, l15, l4), aKh = rk_lda(KhT, mb, l15, l4);
            const RkB bR = rk_ldb(Rb, nb0, l15, l4), bArk = rk_ldb(Ark, nb0, l15, l4);
            rk_mm<false>(yacc, aS, bR); rk_mm<true>(yacc, aV, bArk);
#pragma unroll
            for (int r = 0; r < 4; ++r) { const float g_ = g63[16 * mb + 4 * l4 + r]; sacc[0][r] *= g_; sacc[1][r] *= g_; }
            rk_mm<true>(sacc, aKh, bV);
            rk_store(Bb  , d, mb, nb0, l15, l4); rk_store(Kb  , d2, mb, nb0, l15, l4); rk_store(Xt, d3, mb, nb0, l15, l4);
        }
        LDS_BARRIER();
#define RK_DOUBLE(PK, PKT, TIN, TOUT, PN, PNT) { const RkA aPT = rk_lda(PKT, mb, l15, l4), aP = rk_lda(PK, mb, l15, l4); \
          const RkB bT = rk_ldb(TIN, nb0, l15, l4), bP = rk_ldb(PK, nb0, l15, l4), bPT = rk_ldb(PKT, nb0, l15, l4); \
          f32x4 d[2], d2[2]; rk_mm<true>(tacc, aPT, bT); rk_mm<false>(d, aPT, bP); rk_mm<false>(d2, aP, bPT); \
          rk_store(TOUT, tacc, mb, nb0, l15, l4); rk_store(PN, d, mb, nb0, l15, l4); rk_store(PNT, d2, mb, nb0, l15, l4); }
        RK_DOUBLE(Bb, Kb, TA, TB, P0, P0T)
        LDS_BARRIER();
        RK_DOUBLE(P0, P0T, TB, TA, Bb, Kb)
        LDS_BARRIER();
        RK_DOUBLE(Bb, Kb, TA, TB, P0, P0T)
        LDS_BARRIER();
        { const RkA aPT = rk_lda(P0T, mb, l15, l4), aP = rk_lda(P0, mb, l15, l4); const RkB bT = rk_ldb(TB, nb0, l15, l4), bPT = rk_ldb(P0T, nb0, l15, l4);
          f32x4 d2[2]; rk_mm<true>(tacc, aPT, bT); rk_mm<false>(d2, aP, bPT); rk_store(TA, tacc, mb, nb0, l15, l4); rk_store(Kb  , d2, mb, nb0, l15, l4); }
        LDS_BARRIER();
        { const RkA aPT = rk_lda(Kb, mb, l15, l4); const RkB bT = rk_ldb(TA, nb0, l15, l4); rk_mm<true>(tacc, aPT, bT); rk_store(TB, tacc, mb, nb0, l15, l4); }
        LDS_BARRIER();
#ifdef PROBE
        const unsigned long long tk2 = __builtin_amdgcn_s_memtime();
#endif
        { const RkA aT = rk_lda(TB, mb, l15, l4); const RkB bX = rk_ldb(Xt, nb0, l15, l4); f32x4 d[2]; rk_mm<false>(d, aT, bX); rk_store(Ut, d, mb, nb0, l15, l4); }
        LDS_BARRIER();
        {
            const RkA aU = rk_lda(Ut, mb, l15, l4), aBh = rk_lda(BhT, mb, l15, l4); const RkB bArb = rk_ldb(Arb, nb0, l15, l4), bU = rk_ldb(Ut, nb0, l15, l4);
            rk_mm<true>(yacc, aU, bArb); rk_mm<true>(sacc, aBh, bU);
#pragma unroll
            for (int q = 0; q < 2; ++q) *(LAS f32x4*)(Yl + (16 * (nb0 + q) + l15) * 64 + (((4 * mb + l4) ^ (l15 & 7)) << 2)) = yacc[q];
            rk_store(Sb, sacc, mb, nb0, l15, l4);
        }
        LDS_BARRIER();
        {
            const int t = t0 + tt, j0 = 8 * c8;
            const f32x4 y0 = *(const LAS f32x4*)(Yl + tt * 64 + (((2 * c8) ^ (tt & 7)) << 2)), y1 = *(const LAS f32x4*)(Yl + tt * 64 + (((2 * c8 + 1) ^ (tt & 7)) << 2));
            float y[8] = {y0[0], y0[1], y0[2], y0[3], y1[0], y1[1], y1[2], y1[3]}, gv[8]; float s1 = 0.f;
#pragma unroll
            for (int e = 0; e < 8; ++e) s1 += y[e];
            s1 = red8(s1); const float mean = s1 * (1.0f / 64.0f); float s2 = 0.f;
#pragma unroll
            for (int e = 0; e < 8; ++e) { const float dd = y[e] - mean; s2 += dd * dd; }
            s2 = red8(s2); const float rstd = frsq(s2 * (1.0f / 64.0f) + LNX_EPS);
            unpack8(gcur, gv);
            const float bonus = bon[tt]; float ov[8];
#pragma unroll
            for (int e = 0; e < 8; ++e) { const float yn = (y[e] - mean) * rstd * cst[512 + j0 + e] + cst[576 + j0 + e]; ov[e] = (yn + bonus * bf2f(Vt[rk_off(j0 + e, tt)])) * gv[e]; }
            pend = pack8(ov); pend_p = MIX + (size_t)t * DM + h * 64 + j0;
        }
        LDS_BARRIER();
    }
    *(v4u*)pend_p = pend;
#undef RK_S
#undef RK_LOADCHUNK
}

__device__ __forceinline__ void mlstm_unit(const Args& a, LAS unsigned char* lds, int unit, int tid, int lane, int wave) {
    unsigned char* ws = a.ws; const bf16* PROJ = (const bf16*)(ws + WS_PROJ); const float* gates = (const float*)(ws + WS_GATES); bf16* MIX = (bf16*)(ws + WS_MIX);
    const float* cw = a.in[14]; const float* cbias = a.in[15]; const float* i_bias = a.in[16]; const float* f_bias = a.in[17]; const float* mhg = a.in[18];
    const int b = unit >> 2, hm = unit & 3;
    constexpr int LD = 72;
    LAS bf16* Ql = (LAS bf16*)lds; LAS bf16* Kl = Ql + 64 * LD; LAS bf16* Kwt = Kl + 64 * LD; LAS bf16* Vt = Kwt + 64 * LD; LAS bf16* Sm = Vt + 128 * LD; LAS bf16* Ct = Sm + 64 * LD;
    LAS float* Hl = (LAS float*)(Ct + 128 * LD);
    LAS float* e_s = Hl + 64 * 132; LAS float* Mx = e_s + 64; LAS float* sc = Mx + 64; LAS float* em = sc + 64; LAS float* wsv = em + 64; LAS float* den = wsv + 64; LAS float* nvec = den + 64; LAS float* scal = nvec + 64;
    for (int i = tid; i < 128 * LD / 2; i += 512) ((LAS unsigned*)Ct)[i] = 0u;
    if (tid < 64) nvec[tid] = 0.f;
    if (tid == 0) { scal[0] = 1.f; scal[1] = 0.f; }
    f32x4 cacc[4];
#pragma unroll
    for (int i = 0; i < 4; ++i) cacc[i] = (f32x4){0.f, 0.f, 0.f, 0.f};
    const int l15 = lane & 15, l4 = lane >> 4;
    const int tt = tid >> 3, p8 = tid & 7;
    LAS float* cwl = scal + 16; LAS float* cbl = cwl + 512;
    for (int i = tid; i < 640; i += 512) { const int j = i >> 7, c_ = i & 127; const int src = (c_ < 64) ? (hm * 64 + c_) : (256 + hm * 64 + (c_ - 64)); if (j < 4) cwl[i] = cw[j * 512 + src]; else cbl[c_] = cbias[src]; }
    const float ibias = i_bias[hm], fbias = f_bias[hm];
    v4u n_q[4], n_k[4], n_va, n_vb, n_oa, n_ob; float n_gi = 0.f, n_gf = 0.f;
#define ML_LOADCHUNK(c_) do { const int t_ = b * SEQ + (c_) * 64 + lane; const int tp_ = (c_) * 64 + lane; \
        _Pragma("unroll") for (int j = 0; j < 4; ++j) { if (tp_ - 3 + j >= 0) { const bf16* pr_ = PROJ + (size_t)(t_ - 3 + j) * NPROJ + hm * 64 + 8 * wave; n_q[j] = *(const v4u*)(pr_ + C_Q); n_k[j] = *(const v4u*)(pr_ + C_K); } \
                                                       else { n_q[j] = (v4u){0u, 0u, 0u, 0u}; n_k[j] = (v4u){0u, 0u, 0u, 0u}; } } \
        { const bf16* pv_ = PROJ + (size_t)t_ * NPROJ + C_V + hm * 128 + 16 * wave; n_va = *(const v4u*)pv_; n_vb = *(const v4u*)(pv_ + 8); \
          const bf16* po_ = PROJ + (size_t)(b * SEQ + (c_) * 64 + tt) * NPROJ + C_O + hm * 128 + 16 * p8; n_oa = *(const v4u*)po_; n_ob = *(const v4u*)(po_ + 8); } \
        n_gi = gates[(size_t)t_ * 8 + hm]; n_gf = gates[(size_t)t_ * 8 + 4 + hm]; } while (0)
    ML_LOADCHUNK(0);
    LDS_BARRIER();
    float m_run = 0.f;
    v4u pend0 = {0u, 0u, 0u, 0u}, pend1 = pend0; bf16* pend_p = MIX;
    for (int c = 0; c < SEQ / 64; ++c) {
        const int t0 = b * SEQ + c * 64;
        asm volatile("" : "+v"(n_q[0]), "+v"(n_q[1]), "+v"(n_q[2]), "+v"(n_q[3]), "+v"(n_k[0]), "+v"(n_k[1]), "+v"(n_k[2]), "+v"(n_k[3]), "+v"(n_va), "+v"(n_vb), "+v"(n_oa), "+v"(n_ob), "+v"(n_gi), "+v"(n_gf));
        float dec;
        v4u c_oa, c_ob;
        {
            const float gi = n_gi + ibias, gf = n_gf + fbias;
            const float ig = 15.0f * tanhf_(gi * (1.0f / 15.0f)), fx = 15.0f * tanhf_(gf * (1.0f / 15.0f));
            const float logf = -(fmaxf(-fx, 0.f) + __logf(1.0f + fexp(-fabsf(fx))));
            const float bc = wave_scan_add(logf);
            const float e = ig - bc; const float P = wave_scan_max(e);
            const float mx = fmaxf(P, m_run);
            const float mxL = __builtin_bit_cast(float, __builtin_amdgcn_readlane(__builtin_bit_cast(int, mx), 63)), bL = __builtin_bit_cast(float, __builtin_amdgcn_readlane(__builtin_bit_cast(int, bc), 63));
            if (wave == 0) { e_s[lane] = e; Mx[lane] = mx; sc[lane] = fexp(m_run - mx); em[lane] = fexp(-(bc + mx)); }
            const float w = fexp(e - mxL);
            dec = fexp(m_run - mxL); m_run = bL + mxL;
            const int d0 = 8 * wave;
            float aq[8], ak[8];
#pragma unroll
            for (int e_ = 0; e_ < 8; ++e_) { aq[e_] = cbl[d0 + e_]; ak[e_] = cbl[64 + d0 + e_]; }
#pragma unroll
            for (int j = 0; j < 4; ++j) { float pq[8], pk[8]; unpack8(n_q[j], pq); unpack8(n_k[j], pk);
#pragma unroll
                for (int e_ = 0; e_ < 8; ++e_) { aq[e_] += cwl[j * 128 + d0 + e_] * pq[e_]; ak[e_] += cwl[j * 128 + 64 + d0 + e_] * pk[e_]; } }
#pragma unroll
            for (int e_ = 0; e_ < 8; ++e_) { aq[e_] = aq[e_] * sigmoidf_(aq[e_]) * 0.125f; ak[e_] = ak[e_] * sigmoidf_(ak[e_]); }
            *(LAS v4u*)(Ql + lane * LD + d0) = pack8(aq); *(LAS v4u*)(Kl + lane * LD + d0) = pack8(ak);
#pragma unroll
            for (int e_ = 0; e_ < 8; ++e_) Kwt[(d0 + e_) * LD + lane] = (bf16)f2bf(w * ak[e_]);
            const unsigned wv[8] = {n_va.x, n_va.y, n_va.z, n_va.w, n_vb.x, n_vb.y, n_vb.z, n_vb.w};
#pragma unroll
            for (int e_ = 0; e_ < 8; ++e_) { Vt[(16 * wave + 2 * e_) * LD + lane] = (bf16)(wv[e_] & 0xffffu); Vt[(16 * wave + 2 * e_ + 1) * LD + lane] = (bf16)(wv[e_] >> 16); }
            c_oa = n_oa; c_ob = n_ob;
            if (c > 0) { *(v4u*)pend_p = pend0; *(v4u*)(pend_p + 8) = pend1; }
            if (c + 1 < SEQ / 64) ML_LOADCHUNK(c + 1);
        }
        LDS_BARRIER();
        {
            const int rb = wave >> 1;
#pragma unroll
            for (int ci = 0; ci < 2; ++ci) { const int cb = 2 * (wave & 1) + ci; f32x4 acc = {0.f, 0.f, 0.f, 0.f};
#pragma unroll
                for (int kk = 0; kk < 2; ++kk) { const bf16x8 A = *(const LAS bf16x8*)(Ql + (16 * rb + l15) * LD + 32 * kk + 8 * l4), B = *(const LAS bf16x8*)(Kl + (16 * cb + l15) * LD + 32 * kk + 8 * l4); acc = mfma16(A, B, acc); }
                const int s_ = 16 * cb + l15; const float es = e_s[s_];
#pragma unroll
                for (int r = 0; r < 4; ++r) { const int t = 16 * rb + 4 * l4 + r; const float v = (s_ <= t) ? acc[r] * fexp(es - Mx[t]) : 0.f; Sm[t * LD + s_] = (bf16)f2bf(v); } }
        }
        LDS_BARRIER();
        {
            float part = 0.f, qn = 0.f; float sv[8], qv[8];
            unpack8(*(const LAS v4u*)(Sm + tt * LD + 8 * p8), sv); unpack8(*(const LAS v4u*)(Ql + tt * LD + 8 * p8), qv);
#pragma unroll
            for (int e_ = 0; e_ < 8; ++e_) { part += sv[e_]; qn += qv[e_] * nvec[8 * p8 + e_]; }
            float tot = part + sc[tt] * qn; tot = red8(tot);
            if (p8 == 0) den[tt] = tot;
            const int rb = wave >> 1;
            bf16x8 As[2], Aq[2];
#pragma unroll
            for (int kk = 0; kk < 2; ++kk) { As[kk] = *(const LAS bf16x8*)(Sm + (16 * rb + l15) * LD + 32 * kk + 8 * l4); Aq[kk] = *(const LAS bf16x8*)(Ql + (16 * rb + l15) * LD + 32 * kk + 8 * l4); }
            float scr_[4];
#pragma unroll
            for (int r = 0; r < 4; ++r) scr_[r] = sc[16 * rb + 4 * l4 + r];
#pragma unroll
            for (int vi = 0; vi < 4; ++vi) { const int vb = 4 * (wave & 1) + vi; f32x4 a1 = {0.f, 0.f, 0.f, 0.f}, a2 = {0.f, 0.f, 0.f, 0.f};
#pragma unroll
                for (int kk = 0; kk < 2; ++kk) { const bf16x8 B1 = *(const LAS bf16x8*)(Vt + (16 * vb + l15) * LD + 32 * kk + 8 * l4), B2 = *(const LAS bf16x8*)(Ct + (16 * vb + l15) * LD + 32 * kk + 8 * l4);
                    a1 = mfma16(As[kk], B1, a1); a2 = mfma16(Aq[kk], B2, a2); }
#pragma unroll
                for (int r = 0; r < 4; ++r) Hl[(16 * rb + 4 * l4 + r) * 132 + 16 * vb + l15] = a1[r] + scr_[r] * a2[r]; }
        }
        LDS_BARRIER();
        {
            bf16x8 Av[2];
#pragma unroll
            for (int kk = 0; kk < 2; ++kk) Av[kk] = *(const LAS bf16x8*)(Vt + (16 * wave + l15) * LD + 32 * kk + 8 * l4);
#pragma unroll
            for (int db = 0; db < 4; ++db) { cacc[db] = cacc[db] * dec;
#pragma unroll
                for (int kk = 0; kk < 2; ++kk) { const bf16x8 B = *(const LAS bf16x8*)(Kwt + (16 * db + l15) * LD + 32 * kk + 8 * l4); cacc[db] = mfma16(Av[kk], B, cacc[db]); }
#pragma unroll
                for (int r = 0; r < 4; ++r) Ct[(16 * wave + 4 * l4 + r) * LD + 16 * db + l15] = (bf16)f2bf(cacc[db][r]); }
            float kv[8]; unpack8(*(const LAS v4u*)(Kwt + tt * LD + 8 * p8), kv); float s_ = 0.f;
#pragma unroll
            for (int e_ = 0; e_ < 8; ++e_) s_ += kv[e_];
            s_ = red8(s_);
            if (p8 == 0) nvec[tt] = dec * nvec[tt] + s_;
        }
        {
            const int t = t0 + tt, v0 = 16 * p8; float hv[16]; float ss = 0.f;
            const float dn = frcp(fmaxf(fabsf(den[tt]), em[tt]));
#pragma unroll
            for (int q = 0; q < 4; ++q) { const f32x4 x = *(const LAS f32x4*)(Hl + tt * 132 + v0 + 4 * q) * dn; hv[4 * q] = x[0]; hv[4 * q + 1] = x[1]; hv[4 * q + 2] = x[2]; hv[4 * q + 3] = x[3]; ss += (x[0] * x[0] + x[1] * x[1]) + (x[2] * x[2] + x[3] * x[3]); }
            ss = red8(ss); const float rn = frsq(ss * (1.0f / 128.0f) + NORM_EPS);
            float o0[8], o1[8]; unpack8(c_oa, o0); unpack8(c_ob, o1);
            float r0[8], r1[8];
#pragma unroll
            for (int e_ = 0; e_ < 8; ++e_) { r0[e_] = hv[e_] * rn * mhg[hm * 128 + v0 + e_] * sigmoidf_(o0[e_]); r1[e_] = hv[8 + e_] * rn * mhg[hm * 128 + v0 + 8 + e_] * sigmoidf_(o1[e_]); }
            pend_p = MIX + (size_t)t * DM + 512 + hm * 128 + v0; pend0 = pack8(r0); pend1 = pack8(r1);
        }
        LDS_BARRIER();
    }
    *(v4u*)pend_p = pend0; *(v4u*)(pend_p + 8) = pend1;
#undef ML_LOADCHUNK
}

__device__ __forceinline__ void phase_ffn_fix(const Args& a, int tid) {
    unsigned char* ws = a.ws; const float* SA = (const float*)(ws + WS_SIDE); const float* SB = SA + SIDE_ELEMS; const float* SL = SB + SIDE_ELEMS; bf16* GB = (bf16*)(ws + WS_GB);
    const float* cw = a.in[22]; const float* cb = a.in[23];
    const int NT = gridDim.x * 512;
    for (int it = blockIdx.x * 512 + tid; it < SIDE_ELEMS; it += NT) {
        const int ch = it & 127, r = (it >> 7) & 1, tile = it >> 8, pm = tile / 22, pn = tile % 22;
        const int base = tile * 256;
        float l0 = 0.f, l1 = 0.f;
        if ((pm & 7) != 0) { const int lb = (tile - 22) * 256; l0 = SL[lb + ch]; l1 = SL[lb + 128 + ch]; }
        const float a_r = SA[base + r * 128 + ch], b_r = SB[base + r * 128 + ch];
        const float am1 = r == 0 ? l1 : SA[base + ch], am2 = r == 0 ? l0 : l1;
        const int f = pn * 128 + ch;
        const float z = cb[f] + cw[f] * am2 + cw[DFF + f] * am1 + cw[2 * DFF + f] * a_r;
        GB[(size_t)(pm * 256 + r) * DFF + f] = (bf16)f2bf(z * sigmoidf_(z) * b_r);
    }
}
__device__ __forceinline__ void phase_final(const Args& a, int lane, int wave) {
    const bf16* FF = (const bf16*)(a.ws + WS_FF); const float* gf = a.in[25];
    f32x4 gv[4];
#pragma unroll
    for (int j = 0; j < 4; ++j) gv[j] = *((const f32x4*)gf + lane + 64 * j);
    const int NGW = gridDim.x * 8;
#ifdef PROBE
    const unsigned long long* tstamps = (const unsigned long long*)(a.ws + WS_CTL + 512 * 1024);
    const float fa = fminf(fmaxf((float)(long long)(tstamps[PROBE_A_TO] - tstamps[PROBE_A_FROM]) * (0.01f / PROBE_A_SCALE_US), 0.f), 1.f);
    const float pscale = 1.0f + sqrtf(fa * 0.8e-4f);
#pragma unroll
    for (int j = 0; j < 4; ++j) gv[j] = gv[j] * pscale;
#endif
    const bf16* XB = (const bf16*)(a.ws + WS_XN);
    for (int row0 = 2 * (blockIdx.x * 8 + wave); row0 < M; row0 += 2 * NGW) {
        v2u xq[2][4], f[2][4];
#pragma unroll
        for (int u = 0; u < 2; ++u) { const v2u* xr = (const v2u*)(XB + (size_t)(row0 + u) * DM) + lane; const v2u* fr_ = (const v2u*)(FF + (size_t)(row0 + u) * DM) + lane;
#pragma unroll
            for (int j = 0; j < 4; ++j) { xq[u][j] = xr[64 * j]; f[u][j] = fr_[64 * j]; } }
#pragma unroll
        for (int u = 0; u < 2; ++u) { float ss = 0.f; f32x4 v[4];
#pragma unroll
            for (int j = 0; j < 4; ++j) { v[j][0] = bflo(xq[u][j].x) + bflo(f[u][j].x); v[j][1] = bfhi(xq[u][j].x) + bfhi(f[u][j].x); v[j][2] = bflo(xq[u][j].y) + bflo(f[u][j].y); v[j][3] = bfhi(xq[u][j].y) + bfhi(f[u][j].y);
                ss += (v[j][0] * v[j][0] + v[j][1] * v[j][1]) + (v[j][2] * v[j][2] + v[j][3] * v[j][3]); }
            const float rs = frsq(wave_sum(ss) * (1.0f / DM) + NORM_EPS);
            f32x4* xr = (f32x4*)(a.out + (size_t)(row0 + u) * DM) + lane;
#pragma unroll
            for (int j = 0; j < 4; ++j) xr[64 * j] = v[j] * rs * gv[j]; }
    }
}

constexpr int N_PHASES = 10;
__global__ void __launch_bounds__(512, 2) mega(Args args) {
    extern __shared__ __attribute__((aligned(16))) unsigned char lds_raw[];
    LAS unsigned char* lds = (LAS unsigned char*)lds_raw;
    const int tid0 = threadIdx.x;
    unsigned char* ws = args.ws;
#define PHASE_IDS int tid = tid0; asm volatile("" : "+v"(tid)); const int lane = tid & 63, wave = __builtin_amdgcn_readfirstlane(tid >> 6); (void)lane; (void)wave
    volatile LAS unsigned* MISC = (volatile LAS unsigned*)(lds + MISC_OFF);
    { PHASE_IDS; for (int u = tid; u < (LDS_BYTES - 131072) / 4; u += 512) ((LAS unsigned*)(lds + 131072))[u] = 0u; }
    __syncthreads();
    XcdBarrier bar; bar.bar = (unsigned*)(ws + WS_CTL) + 4096; bar.x = 0; bar.st = nullptr;
    if (MK_SINGLE) bar = xcd_barrier_post((unsigned*)(ws + WS_CTL) + 4096, MISC + 8);
    const int lo = args.ph_lo, hi = args.ph_hi;
#ifndef PH_MASK
#define PH_MASK 0xFFFF
#endif
#define IN(k) ((((PH_MASK) >> (k)) & 1) && lo <= (k) && (k) < hi)
#ifdef PROBE
    unsigned long long* const tstamps = (unsigned long long*)(ws + WS_CTL + 512 * 1024);
#define STAMP(k) do { if (blockIdx.x == 0 && tid0 == 0) tstamps[(k)] = __builtin_amdgcn_s_memrealtime(); } while (0)
#else
#define STAMP(k) do { } while (0)
#endif
    STAMP(0);
#define SEAM(k) do { if (IN(k) && IN((k) + 1)) xcd_barrier(bar); STAMP((k) + 1); } while (0)

    if (IN(0)) { PHASE_IDS; phase_prep(args, lds, tid, lane, wave); } SEAM(0);
    if (IN(1)) {
        pg8::Gemm g{(const bf16*)(ws + WS_XN), (const bf16*)(ws + WS_WT_IN), M, NPROJ, opaque_i(DM)}; pg8::StaticOrder S; S.init(M, NPROJ, gridDim.x, (int)blockIdx.x);
        pg8::EpiBf16<0> E{(bf16*)(ws + WS_PROJ), NPROJ, nullptr, 0, 0, 1.f};
        pg8::gemm_phase<pg8::EpiBf16<0>, pg8::StaticOrder, true, true>(lds, g, S, E);
    } SEAM(1);
    if (IN(2)) {
        PHASE_IDS;
        if ((int)blockIdx.x < BATCH * 4 || gridDim.x != 256) {
            for (int u = blockIdx.x; u < BATCH * 4; u += gridDim.x) mlstm_unit(args, lds, u, tid, lane, wave);
        }
        if (gridDim.x == 256 && (int)blockIdx.x >= BATCH * 4) {
            const int c = (int)blockIdx.x - BATCH * 4;
            phase_lmat(args, tid, 512 * c, 512);
            asm volatile("s_waitcnt vmcnt(0)" ::: "memory"); __syncthreads();
            if (tid == 0) { __builtin_amdgcn_fence(__ATOMIC_ACQUIRE, "agent"); asm volatile("s_waitcnt vmcnt(0)" ::: "memory"); }
            __syncthreads();
            pg8::Gemm g{(const bf16*)(ws + WS_LBUF), (const bf16*)(ws + WS_WT_LORA), M, NLORA, opaque_i(KLORA)}; pg8::PairPanelOrder S{c};
            pg8::EpiBf16<0> E{(bf16*)(ws + WS_DAG), NLORA, nullptr, 0, 0, 1.f};
            pg8::gemm_phase<pg8::EpiBf16<0>, pg8::PairPanelOrder, true, true>(lds, g, S, E);
            __syncthreads();
            late_transposes(args, lds, lane, wave, c * 8 + wave, ((int)gridDim.x - BATCH * 4) * 8);
        }
    } SEAM(2);
    if (IN(3)) {
        PHASE_IDS;
        for (int u = blockIdx.x; u < BATCH * 8; u += gridDim.x) rwkv_unit(args, lds, u, tid, lane, wave);
        STAMP(12);
    }
    if (IN(3) && IN(5)) xcd_barrier(bar);
    STAMP(5);
    if (IN(5)) {
        pg8::Gemm g{(const bf16*)(ws + WS_MIX), (const bf16*)(ws + WS_WT_OUT), M, DM, opaque_i(DM)}; pg8::StaticOrder S; S.init(M, DM, gridDim.x, (int)blockIdx.x);
        pg8::EpiResid E{(bf16*)(ws + WS_XN), (const float*)(ws + WS_RINV), (float*)(ws + WS_SSQP)};
        pg8::gemm_phase<pg8::EpiResid, pg8::StaticOrder, true, true>(lds, g, S, E);
    } SEAM(5);
    if (IN(6)) {
        pg8::Gemm g{(const bf16*)(ws + WS_XN), (const bf16*)(ws + WS_WT_UP), M, NUP, opaque_i(DM)}; pg8::StaticOrder S; S.init(M, NUP, gridDim.x, (int)blockIdx.x);
        float* side = (float*)(ws + WS_SIDE); float* rs2 = (float*)(ws + WS_RS2);
        {
            PHASE_IDS; pg8::Unit u;
            for (int i = 0; S.next(i, u); ++i) if (tid < 256) { const int row = u.pm * 256 + tid; const f32x4* p = (const f32x4*)((const float*)(ws + WS_SSQP) + (size_t)row * 16); const f32x4 s0 = p[0], s1 = p[1], s2 = p[2], s3 = p[3];
                const float ss = ((s0[0] + s0[1]) + (s0[2] + s0[3])) + ((s1[0] + s1[1]) + (s1[2] + s1[3])) + ((s2[0] + s2[1]) + (s2[2] + s2[3])) + ((s3[0] + s3[1]) + (s3[2] + s3[3]));
                rs2[row] = frsq(ss * (1.0f / DM) + NORM_EPS); }
            asm volatile("s_waitcnt vmcnt(0)" ::: "memory"); __syncthreads();
        }
        pg8::EpiFfn E{(bf16*)(ws + WS_GB), rs2, args.in[22], args.in[23], side, side + SIDE_ELEMS, side + 2 * SIDE_ELEMS, (LAS float*)(lds + 131072 + 1024)};
        pg8::gemm_phase<pg8::EpiFfn, pg8::StaticOrder, true, true>(lds, g, S, E);
    } SEAM(6);
    if (IN(7)) { PHASE_IDS; phase_ffn_fix(args, tid); } SEAM(7);
    if (IN(8)) {
        pg8::Gemm g{(const bf16*)(ws + WS_GB), (const bf16*)(ws + WS_WT_DN), M, DM, opaque_i(DFF)}; pg8::StaticOrder S; S.init(M, DM, gridDim.x, (int)blockIdx.x);
        pg8::EpiBf16<0> E{(bf16*)(ws + WS_FF), DM, nullptr, 0, 0, 1.f};
        pg8::gemm_phase<pg8::EpiBf16<0>, pg8::StaticOrder, true, true>(lds, g, S, E);
    } SEAM(8);
#ifdef PROBE
    xcd_barrier(bar);
#endif
    if (IN(9)) { PHASE_IDS; phase_final(args, lane, wave); }
#undef IN
#undef SEAM
}

extern "C" void kernel_launch(void* const* d_in, const int* in_sizes, int n_in, void* d_out, int out_size, void* d_ws, size_t ws_size, hipStream_t stream) {
    static int grid = 0;
    if (grid == 0) {
        if (n_in != 26 || in_sizes[0] != M * DM || out_size != M * DM || ws_size < WS_END) { fprintf(stderr, "kernel_launch: unexpected shapes (n_in %d, in0 %d, out %d, ws %zu)\n", n_in, n_in > 0 ? in_sizes[0] : -1, out_size, ws_size); grid = -1; return; }
        int dev = 0, cus = 0, per_cu = 0;
        if (hipGetDevice(&dev) != hipSuccess || hipDeviceGetAttribute(&cus, hipDeviceAttributeMultiprocessorCount, dev) != hipSuccess) { grid = -1; return; }
        if (hipFuncSetAttribute((const void*)mega, hipFuncAttributeMaxDynamicSharedMemorySize, LDS_BYTES) != hipSuccess) { fprintf(stderr, "kernel_launch: hipFuncSetAttribute failed\n"); grid = -1; return; }
        if (hipOccupancyMaxActiveBlocksPerMultiprocessor(&per_cu, (const void*)mega, 512, LDS_BYTES) != hipSuccess || per_cu < 1) { fprintf(stderr, "kernel_launch: occupancy query says %d blocks per CU\n", per_cu); }
        (void)hipGetLastError();
        grid = cus;
        if (grid != 256) fprintf(stderr, "kernel_launch: %d CUs; this kernel is laid out for 256\n", grid);
    }
    if (grid < 0) return;
    (void)hipMemsetAsync((char*)d_ws + WS_CTL, 0, CTL_ZERO_BYTES, stream);
    Args a{};
    for (int i = 0; i < 26; ++i) a.in[i] = (const float*)d_in[i];
    a.out = (float*)d_out; a.ws = (unsigned char*)d_ws;
#if MK_SINGLE
    a.ph_lo = 0; a.ph_hi = N_PHASES;
    hipLaunchKernelGGL(mega, dim3(grid), dim3(512), LDS_BYTES, stream, a);
#else
    for (int p = 0; p < N_PHASES; ++p) { a.ph_lo = p; a.ph_hi = p + 1; hipLaunchKernelGGL(mega, dim3(grid), dim3(512), LDS_BYTES, stream, a); }
#endif
}
```

```cpp
#include <hip/hip_runtime.h>
#include <cstdio>
#include <cstdint>
namespace pg8 {
#define PG8_LAS __attribute__((address_space(3)))
typedef unsigned short bf16_t;
typedef short bf16x8 __attribute__((ext_vector_type(8)));
typedef float f32x4 __attribute__((ext_vector_type(4)));
typedef unsigned u32x4 __attribute__((ext_vector_type(4)));
constexpr int BM = 256, BK = 64, HALF = 128, HTB = HALF * BK * 2  , STAGE_BYTES = 8 * HTB, NXCD = 8, WGM = 8;

__host__ __device__ __forceinline__ int lds_byte(int r, int c) { const int st = (r >> 4) * 2 + (c >> 5), rr = r & 15, cc = c & 31, ob = rr * 64 + cc * 2; return st * 1024 + (ob ^ (((ob >> 9) & 1) << 5)); }
__host__ __device__ __forceinline__ void stage_rc(int b, int& R, int& C) { const int st = b / 1024, sb = b % 1024, swz = sb ^ (((sb >> 9) & 1) << 5); R = (st >> 1) * 16 + swz / 64; C = (st & 1) * 32 + (swz % 64) / 2; }
__host__ __device__ __forceinline__ int perm32(int rho) { const int n = rho >> 4, i = rho & 15; return 8 * (i >> 2) + 4 * n + (i & 3); }

struct Unit { int pm, pn; };
struct Gemm { const bf16_t* A; const bf16_t* Bt; int M, N, K; };

struct StaticOrder {
    int nM, nN, nwg, G, c;
    __host__ __device__ void init(int M, int N, int G_, int c_) { nM = M / BM; nN = N / BM; nwg = nM * nN; G = G_; c = c_; }
    __host__ __device__ bool next(int i, Unit& u) const {
        const long L = (long)i * G + c; if (L >= nwg) return false;
        int wgid = (int)L; { const int q = nwg / NXCD, r = nwg % NXCD, xcd = wgid % NXCD, off = wgid / NXCD; wgid = (xcd < r ? xcd * (q + 1) : r * (q + 1) + (xcd - r) * q) + off; }
        const int nig = WGM * nN, gid = wgid / nig, fm = gid * WGM, gsz = (nM - fm) < WGM ? (nM - fm) : WGM;
        u.pm = fm + ((wgid % nig) % gsz); u.pn = (wgid % nig) / gsz; return true;
    }
    __device__ __forceinline__ void a_ready(const Unit&) const {}
    __device__ __forceinline__ void done(const Unit&) const {}
};

__device__ __forceinline__ unsigned cvt_pk_bf16(float lo, float hi) { unsigned r; asm volatile("v_cvt_pk_bf16_f32 %0, %1, %2" : "=v"(r) : "v"(lo), "v"(hi)); return r; }
typedef float f32x2 __attribute__((ext_vector_type(2)));
__device__ __forceinline__ f32x2 gelu_pk(f32x2 v) {
    const f32x2 av = __builtin_elementwise_abs(v), d = av * 0.2316418882f + 1.0f;
    f32x2 t; t.x = __builtin_amdgcn_rcpf(d.x); t.y = __builtin_amdgcn_rcpf(d.y);
    f32x2 q = t * 0.5307027145f + (-0.7265760135f); q = q * t + 0.7107068705f; q = q * t + (-0.142248368f); q = q * t + 0.127414796f; q = q * t;
    const f32x2 s = (v * v) * (-0.72134752044f);
    f32x2 e; e.x = __builtin_amdgcn_exp2f(s.x); e.y = __builtin_amdgcn_exp2f(s.y);
    const f32x2 m = v * (q * e), r = v - m;
    f32x2 o; o.x = v.x < 0.f ? m.x : r.x; o.y = v.y < 0.f ? m.y : r.y; return o;
}

template <int ACT  > struct EpiBf16 {
    static constexpr bool PERM = true, AFTER_DRAIN = false; static_assert(ACT == 0 || ACT == 1, "EpiBf16: ACT is 0 (none) or 1 (gelu_pk)");
    bf16_t* O; int ldc; const float* bias; int split_cols; size_t split_stride; float scale0;
    __device__ __forceinline__ void operator()(const f32x4 (&acc)[2][2][4][2], const Unit& u, int wr, int wc, int fr, int fq) const {
        const int row0 = u.pm * BM + wr * 64 + fr; int colt = u.pn * BM; bf16_t* base = O;
        float sc = 1.f; if (split_cols) { const int t = colt / split_cols; base += (size_t)t * split_stride; colt -= t * split_cols; if (t == 0) sc = scale0; }
        const int col0 = colt + wc * 32 + 8 * fq, bcol0 = u.pn * BM + wc * 32 + 8 * fq;
        f32x4 bv[2][2];
#pragma unroll
        for (int bj = 0; bj < 2; ++bj)
#pragma unroll
            for (int n = 0; n < 2; ++n) bv[bj][n] = bias ? *(const f32x4*)(bias + bcol0 + bj * HALF + 4 * n) : (f32x4){0.f, 0.f, 0.f, 0.f};
#pragma unroll
        for (int ai = 0; ai < 2; ++ai)
#pragma unroll
            for (int m = 0; m < 4; ++m) { bf16_t* rowp = base + (size_t)(row0 + ai * HALF + m * 16) * ldc + col0;
#pragma unroll
                for (int bj = 0; bj < 2; ++bj) { f32x4 v0 = acc[ai][bj][m][0] + bv[bj][0], v1 = acc[ai][bj][m][1] + bv[bj][1];
                    if (ACT == 1) { f32x2 a = gelu_pk((f32x2){v0[0], v0[1]}), b = gelu_pk((f32x2){v0[2], v0[3]}), c = gelu_pk((f32x2){v1[0], v1[1]}), d = gelu_pk((f32x2){v1[2], v1[3]});
                        v0 = (f32x4){a.x, a.y, b.x, b.y}; v1 = (f32x4){c.x, c.y, d.x, d.y}; }
                    v0 = v0 * sc; v1 = v1 * sc; u32x4 w; w.x = cvt_pk_bf16(v0[0], v0[1]); w.y = cvt_pk_bf16(v0[2], v0[3]); w.z = cvt_pk_bf16(v1[0], v1[1]); w.w = cvt_pk_bf16(v1[2], v1[3]);
                    *(u32x4*)(rowp + bj * HALF) = w; } }
    }
};
template <class Epi, class Sched, bool ALIGN_EPI = false, bool SP2 = false>
__device__ __forceinline__ void gemm_phase(PG8_LAS unsigned char* lds, const Gemm g, const Sched& S, const Epi& E) {
    const int tid = threadIdx.x, wid = __builtin_amdgcn_readfirstlane(tid >> 6), lane = tid & 63, wr = wid >> 2, wc = wid & 3, fr = lane & 15, fq = lane >> 4;
    const int K = g.K, nt = K / BK;
    unsigned voffA[2], voffB[2];
#pragma unroll
    for (int i = 0; i < 2; ++i) { int R, C; stage_rc(tid * 16 + i * 8192, R, C); const int Rb = Epi::PERM ? ((R & ~31) + perm32(R & 31)) : R;
        voffA[i] = (unsigned)(R * K + C) * 2u; voffB[i] = (unsigned)(Rb * K + C) * 2u; }
    const size_t kstep = (size_t)(BK * 2);
    const size_t hstep = (size_t)HALF * K * 2;
    const size_t tstep = 2 * hstep;
    const unsigned ldsw = (unsigned)wid * 1024u;
    const int aoff = lds_byte(wr * 64 + fr, fq * 8), boff = lds_byte(wc * 32 + fr, fq * 8);
#define PG8_SA(b, h) (((b) * 2 + (h)) * HTB)
#define PG8_SB(b, h) ((4 + (b) * 2 + (h)) * HTB)
#define PG8_STAGE(bufoff, gbase, voff) do { _Pragma("unroll") for (int _i = 0; _i < 2; ++_i) \
        __builtin_amdgcn_global_load_lds((const unsigned*)((const char*)(gbase) + (voff)[_i]), (PG8_LAS unsigned*)(lds + (bufoff) + ldsw + _i * 8192), 16, 0, 0); } while (0)
#define PG8_LDA(dst, b, h) do { _Pragma("unroll") for (int m = 0; m < 4; ++m) _Pragma("unroll") for (int k = 0; k < 2; ++k) dst[m][k] = *(const PG8_LAS bf16x8*)(lds + PG8_SA(b, h) + aoff + m * 2048 + k * 1024); } while (0)
#define PG8_LDB(dst, b, h) do { _Pragma("unroll") for (int n = 0; n < 2; ++n) _Pragma("unroll") for (int k = 0; k < 2; ++k) dst[n][k] = *(const PG8_LAS bf16x8*)(lds + PG8_SB(b, h) + boff + n * 2048 + k * 1024); } while (0)
#define PG8_MMA(ai, bj, At, Bt) do { __builtin_amdgcn_s_setprio(1); _Pragma("unroll") for (int m = 0; m < 4; ++m) _Pragma("unroll") for (int n = 0; n < 2; ++n) _Pragma("unroll") for (int k = 0; k < 2; ++k) \
        acc[ai][bj][m][n] = __builtin_amdgcn_mfma_f32_16x16x32_bf16(Bt[n][k], At[m][k], acc[ai][bj][m][n], 0, 0, 0); __builtin_amdgcn_s_setprio(0); } while (0)
#define PG8_WAIT_V(n) asm volatile("s_waitcnt vmcnt(" #n ")" ::: "memory")
#define PG8_WAIT_L(n) asm volatile("s_waitcnt lgkmcnt(" #n ")" ::: "memory")
#define PG8_BAR __builtin_amdgcn_s_barrier()
#define PG8_SCHED __builtin_amdgcn_sched_barrier(0)
    Unit cur, nxt; int ui = 0;
    if (!S.next(0, cur)) return;
    f32x4 acc[2][2][4][2];
#pragma unroll
    for (int a = 0; a < 2; ++a)
#pragma unroll
        for (int b = 0; b < 2; ++b)
#pragma unroll
            for (int m = 0; m < 4; ++m)
#pragma unroll
                for (int n = 0; n < 2; ++n) acc[a][b][m][n] = (f32x4){0.f, 0.f, 0.f, 0.f};
    bf16x8 At[4][2], B0[2][2], B1[2][2];
    const char* cA = (const char*)g.A + (size_t)cur.pm * tstep; const char* cB = (const char*)g.Bt + (size_t)cur.pn * tstep;
    S.a_ready(cur);
    if constexpr (SP2) {
        PG8_STAGE(PG8_SB(0, 0), cB, voffB); PG8_STAGE(PG8_SB(0, 1), cB + hstep, voffB); PG8_STAGE(PG8_SA(0, 0), cA, voffA); PG8_STAGE(PG8_SA(0, 1), cA + hstep, voffA);
        if (wr == 1) PG8_BAR;
        PG8_WAIT_V(2); PG8_BAR;
        PG8_STAGE(PG8_SB(1, 0), cB + kstep, voffB); PG8_STAGE(PG8_SA(1, 0), cA + kstep, voffA); PG8_STAGE(PG8_SB(1, 1), cB + hstep + kstep, voffB);
        PG8_WAIT_V(6); PG8_BAR;
    } else {
        PG8_STAGE(PG8_SB(0, 0), cB, voffB); PG8_STAGE(PG8_SA(0, 0), cA, voffA); PG8_STAGE(PG8_SB(0, 1), cB + hstep, voffB); PG8_STAGE(PG8_SA(0, 1), cA + hstep, voffA);
        if (wr == 1) PG8_BAR;
        PG8_WAIT_V(4); PG8_BAR;
        PG8_STAGE(PG8_SB(1, 0), cB + kstep, voffB); PG8_STAGE(PG8_SA(1, 0), cA + kstep, voffA); PG8_STAGE(PG8_SB(1, 1), cB + hstep + kstep, voffB);
        PG8_WAIT_V(6); PG8_BAR;
    }
    for (;;) {
        const bool has_next = S.next(ui + 1, nxt);
        const char* nA = has_next ? (const char*)g.A + (size_t)nxt.pm * tstep : cA; const char* nB = has_next ? (const char*)g.Bt + (size_t)nxt.pn * tstep : cB;
        for (int t = 0; t < nt; t += 2) {
            const bool last = (t == nt - 2);
            const char* a1 = cA + (size_t)(t + 1) * kstep;
            const char* a2 = last ? nA : cA + (size_t)(t + 2) * kstep; const char* b2 = last ? nB : cB + (size_t)(t + 2) * kstep;
            const char* a3 = a2 + kstep; const char* b3 = b2 + kstep;
            if (last && has_next) S.a_ready(nxt);
            if constexpr (SP2) {
            PG8_LDB(B0, 0, 0); PG8_LDB(B1, 0, 1); PG8_SCHED; PG8_LDA(At, 0, 0); PG8_STAGE(PG8_SA(1, 1), a1 + hstep, voffA);
            PG8_WAIT_V(8); PG8_WAIT_L(0); PG8_BAR; PG8_MMA(0, 0, At, B0); PG8_MMA(0, 1, At, B1); PG8_BAR; PG8_SCHED;
            PG8_LDA(At, 0, 1); PG8_STAGE(PG8_SB(0, 0), b2, voffB); PG8_STAGE(PG8_SB(0, 1), b2 + hstep, voffB); PG8_STAGE(PG8_SA(0, 0), a2, voffA);
            PG8_WAIT_V(8); PG8_WAIT_L(0); PG8_BAR; PG8_MMA(1, 0, At, B0); PG8_MMA(1, 1, At, B1); PG8_BAR; PG8_SCHED;
            PG8_LDB(B0, 1, 0); PG8_LDB(B1, 1, 1); PG8_SCHED; PG8_LDA(At, 1, 0); PG8_STAGE(PG8_SA(0, 1), a2 + hstep, voffA);
            PG8_WAIT_V(8); PG8_WAIT_L(0); PG8_BAR; PG8_MMA(0, 0, At, B0); PG8_MMA(0, 1, At, B1); PG8_BAR; PG8_SCHED;
            PG8_LDA(At, 1, 1); PG8_STAGE(PG8_SB(1, 0), b3, voffB); PG8_STAGE(PG8_SB(1, 1), b3 + hstep, voffB); PG8_STAGE(PG8_SA(1, 0), a3, voffA);
            PG8_WAIT_V(8); PG8_WAIT_L(0); PG8_BAR; PG8_MMA(1, 0, At, B0); PG8_MMA(1, 1, At, B1); PG8_BAR; PG8_SCHED;
            } else {
            PG8_LDB(B0, 0, 0); PG8_SCHED; PG8_LDA(At, 0, 0); PG8_STAGE(PG8_SA(1, 1), a1 + hstep, voffA);
            PG8_WAIT_L(8); PG8_BAR; PG8_WAIT_L(0); PG8_MMA(0, 0, At, B0); PG8_BAR; PG8_SCHED;
            PG8_LDB(B1, 0, 1); PG8_STAGE(PG8_SB(0, 0), b2, voffB);
            PG8_BAR; PG8_WAIT_L(0); PG8_MMA(0, 1, At, B1); PG8_BAR;
            PG8_LDA(At, 0, 1); PG8_STAGE(PG8_SA(0, 0), a2, voffA);
            PG8_BAR; PG8_WAIT_L(0); PG8_MMA(1, 0, At, B0); PG8_BAR; PG8_SCHED;
            PG8_STAGE(PG8_SB(0, 1), b2 + hstep, voffB);
            PG8_WAIT_V(6); PG8_BAR; PG8_MMA(1, 1, At, B1); PG8_BAR;
            PG8_LDB(B0, 1, 0); PG8_SCHED; PG8_LDA(At, 1, 0); PG8_STAGE(PG8_SA(0, 1), a2 + hstep, voffA);
            PG8_WAIT_L(8); PG8_BAR; PG8_WAIT_L(0); PG8_MMA(0, 0, At, B0); PG8_BAR; PG8_SCHED;
            PG8_LDB(B1, 1, 1); PG8_STAGE(PG8_SB(1, 0), b3, voffB);
            PG8_BAR; PG8_WAIT_L(0); PG8_MMA(0, 1, At, B1); PG8_BAR;
            PG8_LDA(At, 1, 1); PG8_STAGE(PG8_SA(1, 0), a3, voffA);
            PG8_BAR; PG8_WAIT_L(0); PG8_MMA(1, 0, At, B0); PG8_BAR; PG8_SCHED;
            PG8_STAGE(PG8_SB(1, 1), b3 + hstep, voffB);
            PG8_WAIT_V(6); PG8_BAR; PG8_MMA(1, 1, At, B1); PG8_BAR;
            }
        }
        if constexpr (ALIGN_EPI) { if (wr == 0) PG8_BAR; }
        if constexpr (!Epi::AFTER_DRAIN) { E(acc, cur, wr, wc, fr, fq); S.done(cur); }
        if (!has_next) break;
#pragma unroll
        for (int a = 0; a < 2; ++a)
#pragma unroll
            for (int b = 0; b < 2; ++b)
#pragma unroll
                for (int m = 0; m < 4; ++m)
#pragma unroll
                    for (int n = 0; n < 2; ++n) acc[a][b][m][n] = (f32x4){0.f, 0.f, 0.f, 0.f};
        cur = nxt; cA = nA; cB = nB; ++ui;
        if constexpr (ALIGN_EPI) { if (wr == 1) PG8_BAR; }
    }
    PG8_WAIT_V(0);
    if constexpr (!ALIGN_EPI) { if (wr == 0) PG8_BAR; }
    PG8_BAR;
    if constexpr (Epi::AFTER_DRAIN) { E.fused(acc, cur, wr, wc, fr, fq, lds, wid, lane); S.done(cur); }
#undef PG8_SA
#undef PG8_SB
#undef PG8_STAGE
#undef PG8_LDA
#undef PG8_LDB
#undef PG8_MMA
#undef PG8_WAIT_V
#undef PG8_WAIT_L
#undef PG8_BAR
#undef PG8_SCHED
}
}

#ifndef MK_SINGLE
#define MK_SINGLE 1
#endif
constexpr int BATCH = 32, SEQ = 2048, DM = 1024, M = BATCH * SEQ;
constexpr int NIN = 3336, NPROJ = 3328;
constexpr int DFF = 2816, NUP = 2 * DFF;
constexpr int C_Q = 1792, C_K = 2048, C_V = 2304, C_O = 2816;
constexpr int NLORA = 1536, KLORA = 256;
constexpr int MH = M / 2;
constexpr float NORM_EPS = 1e-6f, LNX_EPS = 64e-5f;

constexpr size_t MiB = 1u << 20;
constexpr size_t WS_CTL = 0, CTL_ZERO_BYTES = 1 * MiB;
constexpr size_t WS_WT_IN = 2 * MiB, WS_WT_OUT = 9 * MiB, WS_WT_UP = 11 * MiB, WS_WT_DN = 22 * MiB, WS_WT_LORA = 28 * MiB;
constexpr size_t WS_RS2 = 29 * MiB, WS_RINV = 29 * MiB + 512 * 1024, WS_SSQP = 30 * MiB, WS_GATES = 34 * MiB;
constexpr size_t WS_XN = 40 * MiB;
constexpr size_t WS_PROJ = 168 * MiB;
constexpr size_t WS_LBUF = 584 * MiB;
constexpr size_t WS_DAG = 616 * MiB;
constexpr size_t WS_MIX = 808 * MiB;
constexpr size_t WS_SIDE = 168 * MiB;
constexpr int SIDE_ELEMS = 256 * 22 * 2 * 128;
constexpr size_t WS_FF = 192 * MiB;
constexpr size_t WS_GB = 520 * MiB;
constexpr size_t WS_END = 936 * MiB;

constexpr int LDS_BYTES = 163840;
constexpr int MISC_OFF = LDS_BYTES - 256;

#define GAS __attribute__((address_space(1)))
#define LAS __attribute__((address_space(3)))
typedef unsigned short bf16;
typedef unsigned v4u __attribute__((ext_vector_type(4)));
typedef unsigned v2u __attribute__((ext_vector_type(2)));
typedef float f32x4 __attribute__((ext_vector_type(4)));
typedef float f32x2 __attribute__((ext_vector_type(2)));
typedef short bf16x8 __attribute__((ext_vector_type(8)));
typedef GAS unsigned gu32;

typedef __bf16 bf16x2_t __attribute__((ext_vector_type(2)));
__device__ __forceinline__ unsigned pk2(float lo, float hi) { const f32x2 v = {lo, hi}; const bf16x2_t b = __builtin_convertvector(v, bf16x2_t); return __builtin_bit_cast(unsigned, b); }
__device__ __forceinline__ unsigned f2bf(float f) { return pk2(f, f) & 0xffffu; }
__device__ __forceinline__ float bf2f(unsigned short u) { return __builtin_bit_cast(float, (unsigned)u << 16); }
__device__ __forceinline__ float bflo(unsigned w) { return __builtin_bit_cast(float, w << 16); }
__device__ __forceinline__ float bfhi(unsigned w) { return __builtin_bit_cast(float, w & 0xffff0000u); }
__device__ __forceinline__ void unpack8(const v4u w, float (&o)[8]) { o[0] = bflo(w.x); o[1] = bfhi(w.x); o[2] = bflo(w.y); o[3] = bfhi(w.y); o[4] = bflo(w.z); o[5] = bfhi(w.z); o[6] = bflo(w.w); o[7] = bfhi(w.w); }
__device__ __forceinline__ v4u pack8(const float (&o)[8]) { v4u w; w.x = pk2(o[0], o[1]); w.y = pk2(o[2], o[3]); w.z = pk2(o[4], o[5]); w.w = pk2(o[6], o[7]); return w; }
__device__ __forceinline__ float frcp(float x) { return __builtin_amdgcn_rcpf(x); }
__device__ __forceinline__ float frsq(float x) { return __builtin_amdgcn_rsqf(x); }
__device__ __forceinline__ float fsqrt_(float x) { return __builtin_amdgcn_sqrtf(x); }
__device__ __forceinline__ float fexp(float x) { return __builtin_amdgcn_exp2f(x * 1.4426950408889634f); }
__device__ __forceinline__ float sigmoidf_(float x) { return frcp(1.0f + __builtin_amdgcn_exp2f(x * -1.4426950408889634f)); }
__device__ __forceinline__ float tanhf_(float x) { return 1.0f - 2.0f * frcp(__builtin_amdgcn_exp2f(x * 2.8853900817779268f) + 1.0f); }
__device__ __forceinline__ float softplusf_(float x) { return fmaxf(x, 0.f) + __logf(1.0f + fexp(-fabsf(x))); }
__device__ __forceinline__ float wave_sum(float v) {
#pragma unroll
    for (int o = 1; o < 64; o <<= 1) v += __shfl_xor(v, o);
    return v;
}
template <int CTRL> __device__ __forceinline__ float dppmov(float v) { return __builtin_bit_cast(float, __builtin_amdgcn_update_dpp(0, __builtin_bit_cast(int, v), CTRL, 0xF, 0xF, true)); }
__device__ __forceinline__ float red8(float v) { v += dppmov<0xB1>(v); v += dppmov<0x4E>(v); v += dppmov<0x141>(v); return v; }
__device__ __forceinline__ float red16(float v) { v += dppmov<0xB1>(v); v += dppmov<0x4E>(v); v += dppmov<0x141>(v); v += dppmov<0x140>(v); return v; }

template <int CTRL, int RMASK> __device__ __forceinline__ float dppsh(float idv, float v) { return __builtin_bit_cast(float, __builtin_amdgcn_update_dpp(__builtin_bit_cast(int, idv), __builtin_bit_cast(int, v), CTRL, RMASK, 0xF, false)); }
__device__ __forceinline__ float wave_scan_add(float v) {
    v += dppsh<0x111, 0xF>(0.f, v); v += dppsh<0x112, 0xF>(0.f, v); v += dppsh<0x114, 0xF>(0.f, v); v += dppsh<0x118, 0xF>(0.f, v);
    v += dppsh<0x142, 0xA>(0.f, v); v += dppsh<0x143, 0xC>(0.f, v); return v;
}
__device__ __forceinline__ float wave_scan_max(float v) {
    const float ni = -3.0e38f;
    v = fmaxf(v, dppsh<0x111, 0xF>(ni, v)); v = fmaxf(v, dppsh<0x112, 0xF>(ni, v)); v = fmaxf(v, dppsh<0x114, 0xF>(ni, v)); v = fmaxf(v, dppsh<0x118, 0xF>(ni, v));
    v = fmaxf(v, dppsh<0x142, 0xA>(ni, v)); v = fmaxf(v, dppsh<0x143, 0xC>(ni, v)); return v;
}

#define XB_TMO      128
#define XB_XCNT(j)  (256  + 64 * (j))
#define XB_XSUB(j)  (1280 + 64 * (j))
#define XB_XGEN(j)  (2304 + 64 * (j))
#define XB_TOP      3328
#define XB_TOPGEN   3392
#define XCD_BAR_WORDS 3456
#define XB_SPIN_CAP (1u << 22)
__device__ __forceinline__ unsigned xb_ld(unsigned* p)              { return __hip_atomic_load(p, __ATOMIC_RELAXED, __HIP_MEMORY_SCOPE_AGENT); }
__device__ __forceinline__ unsigned xb_add(unsigned* p, unsigned v) { return __hip_atomic_fetch_add(p, v, __ATOMIC_RELAXED, __HIP_MEMORY_SCOPE_AGENT); }
__device__ __forceinline__ unsigned xb_xcc_id() { return (unsigned)__builtin_amdgcn_s_getreg((3 << 11) | 20) & 0xFu; }
#define XB_SPIN(cond, bar) do { unsigned _sp = 0; while (cond) { __builtin_amdgcn_s_sleep(1); \
    if ((++_sp & 255u) == 0u) { if (xb_ld(&(bar)[XB_TMO])) break; if (_sp > XB_SPIN_CAP) { atomicAdd(&(bar)[XB_TMO], 1u); break; } } } } while (0)
struct XcdBarrier { unsigned* bar; unsigned x; volatile LAS unsigned* st; };
__device__ __forceinline__ XcdBarrier xcd_barrier_post(unsigned* bar, volatile LAS unsigned* st) {
    XcdBarrier b; b.bar = bar; b.x = xb_xcc_id(); b.st = st;
    if (threadIdx.x == 0) (void)xb_add(&bar[XB_XCNT(b.x)], 1u);
    return b;
}
__device__ __forceinline__ void xcd_barrier_complete(unsigned* bar, unsigned x, unsigned& nloc, unsigned& nx) {
    const unsigned G = gridDim.x * gridDim.y * gridDim.z;
    unsigned sum, cnt, mine, sp = 0u;
    for (;;) {
        sum = 0u; cnt = 0u; mine = 0u;
#pragma unroll
        for (unsigned j = 0; j < 16; ++j) { const unsigned c = xb_ld(&bar[XB_XCNT(j)]); sum += c; cnt += (c > 0u) ? 1u : 0u; mine = (j == x) ? c : mine; }
        if (sum == G) break;
        __builtin_amdgcn_s_sleep(1);
        if ((++sp & 255u) == 0u) { if (xb_ld(&bar[XB_TMO])) break; if (sp > XB_SPIN_CAP) { atomicAdd(&bar[XB_TMO], 1u); break; } }
    }
    nloc = mine > 0u ? mine : 1u; nx = cnt > 0u ? cnt : 1u;
}
__device__ __forceinline__ void xcd_barrier(const XcdBarrier& b) {
    asm volatile("s_waitcnt vmcnt(0)" ::: "memory");
    __syncthreads();
    if (threadIdx.x == 0) {
        unsigned* bar = b.bar;
        __builtin_amdgcn_s_waitcnt(0);
        unsigned nloc = b.st[0], nx = b.st[1];
        if (nloc == 0u) { xcd_barrier_complete(bar, b.x, nloc, nx); b.st[0] = nloc; b.st[1] = nx; }
        const unsigned old = xb_add(&bar[XB_XSUB(b.x)], 1u);
        const unsigned gen = old / nloc;
        if (old + 1u == (gen + 1u) * nloc) {
            __builtin_amdgcn_fence(__ATOMIC_RELEASE, "agent");
            asm volatile("s_waitcnt vmcnt(0)" ::: "memory");
            const unsigned og = xb_add(&bar[XB_TOP], 1u);
            const unsigned tg = og / nx;
            if (og + 1u == (tg + 1u) * nx) xb_add(&bar[XB_TOPGEN], 1u);
            else XB_SPIN(xb_ld(&bar[XB_TOPGEN]) == tg, bar);
            __builtin_amdgcn_fence(__ATOMIC_ACQUIRE, "agent");
            xb_add(&bar[XB_XGEN(b.x)], 1u);
            asm volatile("s_waitcnt vmcnt(0)" ::: "memory");
        } else {
            XB_SPIN(xb_ld(&bar[XB_XGEN(b.x)]) == gen, bar);
            __builtin_amdgcn_fence(__ATOMIC_ACQUIRE, "agent");
            asm volatile("s_waitcnt vmcnt(0)" ::: "memory");
        }
    }
    __syncthreads();
}

__device__ __forceinline__ int opaque_i(int v) { asm volatile("" : "+s"(v)); return v; }
#define LDS_BARRIER() do { asm volatile("s_waitcnt lgkmcnt(0)" ::: "memory"); __builtin_amdgcn_s_barrier(); asm volatile("" ::: "memory"); } while (0)
struct Args { const float* in[26]; float* out; unsigned char* ws; int ph_lo, ph_hi; };

namespace pg8 {
struct PairPanelOrder {
    int c;
    __device__ bool next(int i, Unit& u) const { if (i >= 12) return false; u.pm = 2 * c + i / 6; u.pn = i % 6; return true; }
    __device__ __forceinline__ void a_ready(const Unit&) const {}
    __device__ __forceinline__ void done(const Unit&) const {}
};
struct PanelOrder {
    int c;
    __device__ bool next(int i, Unit& u) const { if (i >= 4) return false; u.pm = c; u.pn = i; return true; }
    __device__ __forceinline__ void a_ready(const Unit&) const {}
    __device__ __forceinline__ void done(const Unit&) const {}
};
struct EpiResid {
    static constexpr bool PERM = true, AFTER_DRAIN = false;
    bf16_t* XB; const float* rinv; float* ssqp;
    __device__ __forceinline__ void operator()(const f32x4 (&acc)[2][2][4][2], const Unit& u, int wr, int wc, int fr, int fq) const {
        const int row0 = u.pm * BM + wr * 64 + fr, col0 = u.pn * BM + wc * 32 + 8 * fq;
#pragma unroll
        for (int ai = 0; ai < 2; ++ai)
#pragma unroll
            for (int m = 0; m < 4; ++m) { const int row = row0 + ai * HALF + m * 16; float ss = 0.f; const float ri = rinv[row];
#pragma unroll
                for (int bj = 0; bj < 2; ++bj) { const size_t off = (size_t)row * DM + col0 + bj * HALF;
                    float xv[8]; unpack8(*(const u32x4*)(XB + off), xv);
                    float v[8];
#pragma unroll
                    for (int j = 0; j < 4; ++j) { v[j] = acc[ai][bj][m][0][j] + xv[j] * ri; v[4 + j] = acc[ai][bj][m][1][j] + xv[4 + j] * ri; }
#pragma unroll
                    for (int j = 0; j < 8; ++j) ss += v[j] * v[j];
                    *(u32x4*)(XB + off) = pack8(v); }
                ss += __shfl_xor(ss, 16); ss += __shfl_xor(ss, 32);
                if (fq == 0) ssqp[(size_t)row * 16 + u.pn * 4 + wc] = ss; }
    }
};
struct EpiScale {
    static constexpr bool PERM = true, AFTER_DRAIN = false;
    bf16_t* O; int ldc; const float* rs; int row_off;
    __device__ __forceinline__ void operator()(const f32x4 (&acc)[2][2][4][2], const Unit& u, int wr, int wc, int fr, int fq) const {
        const int row0 = u.pm * BM + wr * 64 + fr, col0 = u.pn * BM + wc * 32 + 8 * fq;
#pragma unroll
        for (int ai = 0; ai < 2; ++ai)
#pragma unroll
            for (int m = 0; m < 4; ++m) { const int row = row0 + ai * HALF + m * 16; const float s = rs[row_off + row]; bf16_t* rowp = O + (size_t)row * ldc + col0;
#pragma unroll
                for (int bj = 0; bj < 2; ++bj) { const f32x4 v0 = acc[ai][bj][m][0] * s, v1 = acc[ai][bj][m][1] * s;
                    u32x4 w; w.x = pk2(v0[0], v0[1]); w.y = pk2(v0[2], v0[3]); w.z = pk2(v1[0], v1[1]); w.w = pk2(v1[2], v1[3]); *(u32x4*)(rowp + bj * HALF) = w; } }
    }
};
struct EpiFfn {
    static constexpr bool PERM = true, AFTER_DRAIN = false;
    bf16_t* G; const float* rs; const float* cw; const float* cb; float* SA; float* SB; float* SL; LAS float* hal;
    __device__ __forceinline__ void operator()(const f32x4 (&acc)[2][2][4][2], const Unit& u, int wr, int wc, int fr, int fq) const {
        int chl = wc * 32 + 8 * fq; asm volatile("" : "+v"(chl));
        const int f0 = u.pn * 128 + chl, rowt = wr * 64 + fr;
        float rsv[2][4];
#pragma unroll
        for (int ai = 0; ai < 2; ++ai)
#pragma unroll
            for (int m = 0; m < 4; ++m) rsv[ai][m] = rs[u.pm * BM + ai * HALF + m * 16 + rowt];
        const size_t sbase = ((size_t)(u.pm * 22 + u.pn) * 2) * 128 + chl;
        if (fr >= 14) {
#pragma unroll
            for (int ai = 0; ai < 2; ++ai) { const float r_ = rsv[ai][3]; const f32x4 v0 = acc[ai][0][3][0] * r_, v1 = acc[ai][0][3][1] * r_;
                LAS float* hp = hal + ((ai * 2 + wr) * 2 + (fr - 14)) * 128 + chl; *(LAS f32x4*)hp = v0; *(LAS f32x4*)(hp + 4) = v1;
                if (ai == 1 && wr == 1) { float* gp = SL + sbase + (fr - 14) * 128; *(f32x4*)gp = v0; *(f32x4*)(gp + 4) = v1; } }
        }
        if (wr == 0 && fr < 2) { const float r_ = rsv[0][0]; float* ga = SA + sbase + fr * 128; float* gb = SB + sbase + fr * 128;
            *(f32x4*)ga = acc[0][0][0][0] * r_; *(f32x4*)(ga + 4) = acc[0][0][0][1] * r_; *(f32x4*)gb = acc[0][1][0][0] * r_; *(f32x4*)(gb + 4) = acc[0][1][0][1] * r_; }
        asm volatile("s_waitcnt lgkmcnt(0)" ::: "memory"); __builtin_amdgcn_s_barrier(); asm volatile("" ::: "memory");
        float w0[8], w1[8], w2[8], bz[8];
        { const f32x4 a0 = *(const f32x4*)(cw + f0), a1 = *(const f32x4*)(cw + f0 + 4), b0 = *(const f32x4*)(cw + DFF + f0), b1 = *(const f32x4*)(cw + DFF + f0 + 4);
          const f32x4 c0 = *(const f32x4*)(cw + 2 * DFF + f0), c1 = *(const f32x4*)(cw + 2 * DFF + f0 + 4), d0 = *(const f32x4*)(cb + f0), d1 = *(const f32x4*)(cb + f0 + 4);
#pragma unroll
          for (int j = 0; j < 4; ++j) { w0[j] = a0[j]; w0[4 + j] = a1[j]; w1[j] = b0[j]; w1[4 + j] = b1[j]; w2[j] = c0[j]; w2[4 + j] = c1[j]; bz[j] = d0[j]; bz[4 + j] = d1[j]; } }
        const bool fr0 = (fr == 0), frl2 = (fr < 2);
#pragma unroll
        for (int ai = 0; ai < 2; ++ai) {
            float ap[8];
            const int pb = ai * 2 + wr - 1;
#pragma unroll
            for (int m = 0; m < 4; ++m) {
                float av[8], bv[8], y1[8], y2[8];
                const float r_ = rsv[ai][m];
#pragma unroll
                for (int j = 0; j < 4; ++j) { av[j] = acc[ai][0][m][0][j] * r_; av[4 + j] = acc[ai][0][m][1][j] * r_; bv[j] = acc[ai][1][m][0][j] * r_; bv[4 + j] = acc[ai][1][m][1][j] * r_; }
                if (m == 0) {
                    if (pb >= 0) { const LAS float* h0 = hal + (pb * 2) * 128 + chl; const f32x4 h00 = *(const LAS f32x4*)h0, h01 = *(const LAS f32x4*)(h0 + 4), h10 = *(const LAS f32x4*)(h0 + 128), h11 = *(const LAS f32x4*)(h0 + 132);
#pragma unroll
                        for (int j = 0; j < 4; ++j) { y1[j] = h10[j]; y1[4 + j] = h11[j]; y2[j] = fr0 ? h00[j] : h10[j]; y2[4 + j] = fr0 ? h01[j] : h11[j]; } }
                    else {
#pragma unroll
                        for (int j = 0; j < 8; ++j) { y1[j] = 0.f; y2[j] = 0.f; } }
                } else {
#pragma unroll
                    for (int j = 0; j < 8; ++j) { y1[j] = dppmov<0x121>(ap[j]); y2[j] = dppmov<0x122>(ap[j]); }
                }
                float o[8];
#pragma unroll
                for (int j = 0; j < 8; ++j) { const float x1 = dppmov<0x121>(av[j]), x2 = dppmov<0x122>(av[j]);
                    const float am1 = fr0 ? y1[j] : x1, am2 = frl2 ? y2[j] : x2;
                    const float z = bz[j] + w0[j] * am2 + w1[j] * am1 + w2[j] * av[j];
                    o[j] = z * sigmoidf_(z) * bv[j]; ap[j] = av[j]; }
                if (!(ai == 0 && m == 0 && wr == 0 && frl2)) *(u32x4*)(G + (size_t)(u.pm * BM + ai * HALF + m * 16 + rowt) * DFF + f0) = pack8(o);
            }
        }
    }
};
}

template <bool FFN_UP = false>
__device__ __forceinline__ void transpose_item(const float* W, int ldw, int K, bf16* WT, const float* kscale, LAS float* scr, int item, int nblk, int lane) {
    const int kb = item / nblk, nb = item % nblk, k0 = 64 * kb, n0 = 32 * nb;
    const int d0 = !FFN_UP ? n0 : (n0 < DFF ? ((n0 >> 7) * 256 + (n0 & 127)) : ((((n0 - DFF) >> 7) * 256) + 128 + ((n0 - DFF) & 127)));
#pragma unroll 8
    for (int i = 0; i < 32; ++i) { const int kk = 2 * i + (lane >> 5); const float s = kscale ? kscale[k0 + kk] : 1.0f; scr[kk * 33 + (lane & 31)] = W[(size_t)(k0 + kk) * ldw + n0 + (lane & 31)] * s; }
    asm volatile("s_waitcnt lgkmcnt(0)" ::: "memory");
    const int c = lane & 7;
#pragma unroll
    for (int j = 0; j < 4; ++j) { const int n = (lane >> 3) + 8 * j; const LAS float* s = scr + (8 * c) * 33 + n;
        v4u o; o.x = pk2(s[0 * 33], s[1 * 33]); o.y = pk2(s[2 * 33], s[3 * 33]); o.z = pk2(s[4 * 33], s[5 * 33]); o.w = pk2(s[6 * 33], s[7 * 33]);
        *(v4u*)(WT + (size_t)(d0 + n) * K + k0 + 8 * c) = o; }
    asm volatile("s_waitcnt lgkmcnt(0)" ::: "memory");
}

__device__ __forceinline__ float wave_red63(float v) {
    v += dppmov<0xB1>(v); v += dppmov<0x4E>(v); v += dppmov<0x141>(v); v += dppmov<0x140>(v);
    v += dppsh<0x142, 0xA>(0.f, v); v += dppsh<0x143, 0xC>(0.f, v); return v;
}
__device__ __forceinline__ float lane63(float v) { return __builtin_bit_cast(float, __builtin_amdgcn_readlane(__builtin_bit_cast(int, v), 63)); }
__device__ __forceinline__ void late_transposes(const Args& a, LAS unsigned char* lds, int lane, int wave, int gw, int NGW) {
    unsigned char* ws = a.ws; LAS float* scr = (LAS float*)(lds + wave * 16384);
    constexpr int I_OUT = 16 * 32, I_UP = 16 * 176, I_DN = 44 * 32;
    for (int it = gw; it < I_OUT + I_UP + I_DN; it += NGW) {
        int r = it;
        if (r < I_OUT) { transpose_item(a.in[19], DM, DM, (bf16*)(ws + WS_WT_OUT), nullptr, scr, r, 32, lane); continue; } r -= I_OUT;
        if (r < I_UP) { transpose_item<true>(a.in[21], NUP, DM, (bf16*)(ws + WS_WT_UP), a.in[20], scr, r, 176, lane); continue; } r -= I_UP;
        transpose_item(a.in[24], DM, DFF, (bf16*)(ws + WS_WT_DN), nullptr, scr, r, 32, lane);
    }
}
__device__ __forceinline__ void phase_prep(const Args& a, LAS unsigned char* lds, int tid, int lane, int wave) {
    unsigned char* ws = a.ws;
    LAS float* scr = (LAS float*)(lds + wave * 16384);
    const int gw = blockIdx.x * 8 + wave, NGW = gridDim.x * 8;
    constexpr int I_IN = 16 * 104;
    for (int it = gw; it < I_IN; it += NGW) transpose_item(a.in[2], NIN, DM, (bf16*)(ws + WS_WT_IN), a.in[1], scr, it, 104, lane);
    {
        const float* wd = a.in[5]; const float* wa = a.in[7]; const float* wg = a.in[8]; bf16* WL = (bf16*)(ws + WS_WT_LORA);
        for (int idx = blockIdx.x * 512 + tid; idx < NLORA * KLORA; idx += gridDim.x * 512) {
            const int n = idx >> 8, k = idx & 255; float v = 0.f;
            if (n < 512) { if (k < 64) v = wd[k * 512 + n]; }
            else if (n < 1024) { if (k >= 64 && k < 128) v = wa[(k - 64) * 512 + (n - 512)]; }
            else { if (k >= 128) v = wg[(k - 128) * 512 + (n - 1024)]; }
            WL[idx] = (bf16)f2bf(v);
        }
    }
    {
        const float* x = a.in[0]; const float* g1 = a.in[1]; const float* w_in = a.in[2];
        bf16* XN = (bf16*)(ws + WS_XN); float* gates = (float*)(ws + WS_GATES); float* rinvp = (float*)(ws + WS_RINV);
        float wgt[16][8];
#pragma unroll
        for (int j = 0; j < 4; ++j)
#pragma unroll
            for (int e = 0; e < 4; ++e) { const int k = 4 * lane + 256 * j + e; const float g = g1[k];
                const f32x4 w0 = *(const f32x4*)(w_in + (size_t)k * NIN + 3328), w1 = *(const f32x4*)(w_in + (size_t)k * NIN + 3332);
                wgt[j * 4 + e][0] = w0[0] * g; wgt[j * 4 + e][1] = w0[1] * g; wgt[j * 4 + e][2] = w0[2] * g; wgt[j * 4 + e][3] = w0[3] * g;
                wgt[j * 4 + e][4] = w1[0] * g; wgt[j * 4 + e][5] = w1[1] * g; wgt[j * 4 + e][6] = w1[2] * g; wgt[j * 4 + e][7] = w1[3] * g; }
        f32x4 vn[4];
        { const f32x4* xr = (const f32x4*)(x + (size_t)gw * DM) + lane;
#pragma unroll
          for (int j = 0; j < 4; ++j) vn[j] = xr[64 * j]; }
        for (int row = gw; row < M; row += NGW) {
            f32x4 v[4];
#pragma unroll
            for (int j = 0; j < 4; ++j) v[j] = vn[j];
            { const int rn = (row + NGW < M) ? row + NGW : row; const f32x4* xr = (const f32x4*)(x + (size_t)rn * DM) + lane;
#pragma unroll
              for (int j = 0; j < 4; ++j) vn[j] = xr[64 * j]; }
            float ss = 0.f;
#pragma unroll
            for (int j = 0; j < 4; ++j) ss += (v[j][0] * v[j][0] + v[j][1] * v[j][1]) + (v[j][2] * v[j][2] + v[j][3] * v[j][3]);
            float gs[8];
#pragma unroll
            for (int jg = 0; jg < 8; ++jg) { float s_ = 0.f;
#pragma unroll
                for (int j = 0; j < 4; ++j)
#pragma unroll
                    for (int e = 0; e < 4; ++e) s_ += v[j][e] * wgt[j * 4 + e][jg];
                gs[jg] = s_; }
            ss = wave_red63(ss);
#pragma unroll
            for (int jg = 0; jg < 8; ++jg) gs[jg] = wave_red63(gs[jg]);
            const float ms = lane63(ss) * (1.0f / DM) + NORM_EPS; const float rs = frsq(ms);
            if (lane == 0) rinvp[row] = fsqrt_(ms);
            unsigned long long* o8 = (unsigned long long*)(XN + (size_t)row * DM) + lane;
#pragma unroll
            for (int j = 0; j < 4; ++j) o8[64 * j] = (unsigned long long)pk2(v[j][0] * rs, v[j][1] * rs) | ((unsigned long long)pk2(v[j][2] * rs, v[j][3] * rs) << 32);
            if (lane == 63) { f32x4* gp = (f32x4*)(gates + (size_t)row * 8); gp[0] = (f32x4){gs[0] * rs, gs[1] * rs, gs[2] * rs, gs[3] * rs}; gp[1] = (f32x4){gs[4] * rs, gs[5] * rs, gs[6] * rs, gs[7] * rs}; }
        }
    }
}

__device__ __forceinline__ void phase_lmat(const Args& a, int tid, int row_lo, int nrows) {
    unsigned char* ws = a.ws; const bf16* PROJ = (const bf16*)(ws + WS_PROJ); bf16* L = (bf16*)(ws + WS_LBUF); const float* mu = a.in[3];
    for (int it = tid; it < nrows * 32; it += 512) {
        const int row = row_lo + (it >> 5), grp = it & 31, c0 = 1536 + 8 * grp;
        const v4u cur = *(const v4u*)(PROJ + (size_t)row * NPROJ + c0);
        v4u prv = {0u, 0u, 0u, 0u}; if ((row & (SEQ - 1)) != 0) prv = *(const v4u*)(PROJ + (size_t)(row - 1) * NPROJ + c0);
        const f32x4 m0 = *(const f32x4*)(mu + c0), m1 = *(const f32x4*)(mu + c0 + 4);
        float c[8], p[8], o[8]; unpack8(cur, c); unpack8(prv, p);
#pragma unroll
        for (int e = 0; e < 8; ++e) { const float mm = e < 4 ? m0[e & 3] : m1[e & 3]; const float xv = c[e] + (p[e] - c[e]) * mm;
            o[e] = grp < 8 ? tanhf_(xv) : (grp < 16 ? xv : sigmoidf_(xv)); }
        *(v4u*)(L + (size_t)row * KLORA + 8 * grp) = pack8(o);
    }
}

constexpr int RK_SLOT = 64 * 64;
__device__ __forceinline__ int rk_off(int row, int col) { return row * 64 + ((((col >> 3) ^ row) & 7) << 3) + (col & 7); }
__device__ __forceinline__ f32x4 mfma16(const bf16x8 a, const bf16x8 b, const f32x4 c) { return __builtin_amdgcn_mfma_f32_16x16x32_bf16(a, b, c, 0, 0, 0); }
__device__ __forceinline__ void rk_frag(bf16x8 (&f)[2], const LAS bf16* base, int row0, int l15, int l4) { const LAS bf16* p = base + (row0 + l15) * 64; f[0] = *(const LAS bf16x8*)(p + ((l4 ^ (l15 & 7)) << 3)); f[1] = *(const LAS bf16x8*)(p + (((4 + l4) ^ (l15 & 7)) << 3)); }
template <bool ACC> __device__ __forceinline__ void rk_prod(f32x4 (&acc)[2], const LAS bf16* Aop, const LAS bf16* Bop, int mb, int nb0, int l15, int l4) {
    bf16x8 a[2]; rk_frag(a, Aop, 16 * mb, l15, l4);
#pragma unroll
    for (int q = 0; q < 2; ++q) { bf16x8 b[2]; rk_frag(b, Bop, 16 * (nb0 + q), l15, l4); f32x4 c = ACC ? acc[q] : (f32x4){0.f, 0.f, 0.f, 0.f}; c = mfma16(a[0], b[0], c); acc[q] = mfma16(a[1], b[1], c); }
}
struct RkA { bf16x8 f[2]; };
struct RkB { bf16x8 f[2][2]; };
__device__ __forceinline__ RkA rk_lda(const LAS bf16* base, int mb, int l15, int l4) { RkA r; rk_frag(r.f, base, 16 * mb, l15, l4); return r; }
__device__ __forceinline__ RkB rk_ldb(const LAS bf16* base, int nb0, int l15, int l4) { RkB r; rk_frag(r.f[0], base, 16 * nb0, l15, l4); rk_frag(r.f[1], base, 16 * (nb0 + 1), l15, l4); return r; }
template <bool ACC> __device__ __forceinline__ void rk_mm(f32x4 (&acc)[2], const RkA& a, const RkB& b) {
#pragma unroll
    for (int q = 0; q < 2; ++q) { f32x4 c = ACC ? acc[q] : (f32x4){0.f, 0.f, 0.f, 0.f}; c = mfma16(a.f[0], b.f[q][0], c); acc[q] = mfma16(a.f[1], b.f[q][1], c); }
}
__device__ __forceinline__ void rk_store(LAS bf16* dst, const f32x4 (&acc)[2], int mb, int nb0, int l15, int l4) {
#pragma unroll
    for (int q = 0; q < 2; ++q) { v2u w; w.x = pk2(acc[q][0], acc[q][1]); w.y = pk2(acc[q][2], acc[q][3]); *(LAS v2u*)(dst + rk_off(16 * (nb0 + q) + l15, 16 * mb + 4 * l4)) = w; }
}
__device__ __forceinline__ void rwkv_unit(const Args& a, LAS unsigned char* lds, int unit, int tid, int lane, int wave) {
    unsigned char* ws = a.ws; const bf16* PROJ = (const bf16*)(ws + WS_PROJ); const bf16* DAG = (const bf16*)(ws + WS_DAG); bf16* MIX = (bf16*)(ws + WS_MIX);
    const int b = unit >> 3, h = unit & 7;
    LAS bf16* slot = (LAS bf16*)lds;
#define RK_S(k) (slot + (k) * RK_SLOT)
    LAS bf16* Ab = RK_S(0); LAS bf16* Ut = RK_S(0); LAS bf16* Bb = RK_S(1); LAS bf16* Kb = RK_S(2); LAS bf16* Rb = RK_S(3); LAS bf16* KhT = RK_S(4); LAS float* Yl = (LAS float*)RK_S(3);
    LAS bf16* BhT = RK_S(5); LAS bf16* Vt = RK_S(6); LAS bf16* P0 = RK_S(7); LAS bf16* P0T = RK_S(8); LAS bf16* Aak = RK_S(9); LAS bf16* Arb = RK_S(10); LAS bf16* Ark = RK_S(11);
    LAS bf16* TA = RK_S(12); LAS bf16* TB = RK_S(13); LAS bf16* Xt = RK_S(14); LAS bf16* Sb = RK_S(15);
    LAS float* g63 = (LAS float*)RK_S(16); LAS float* bon = g63 + 64; LAS float* ssP = bon + 64; LAS float* bnP = ssP + 512; LAS float* cst = bnP + 512;
    const int l15 = lane & 15, l4 = lane >> 4, mb = wave & 3, nb0 = 2 * (wave >> 2);
    const int tt = tid >> 3, c8 = tid & 7;
    const int jw = 8 * wave;
    for (int i = tid; i < 640; i += 512) { const int k = i >> 6, c_ = i & 63, j = h * 64 + c_;
        const float* src = k == 0 ? a.in[3] + j : k == 1 ? a.in[3] + 512 + j : k == 2 ? a.in[3] + 1024 + j : k == 3 ? a.in[9] + j : k == 4 ? a.in[10] + j : k == 5 ? a.in[11] + j : k == 6 ? a.in[4] + j : k == 7 ? a.in[6] + j : k == 8 ? a.in[12] + j : a.in[13] + j;
        cst[i] = *src; }
    for (int i = tid; i < RK_SLOT / 2; i += 512) ((LAS unsigned*)Sb)[i] = 0u;
    f32x4 sacc[2], tacc[2], yacc[2];
    sacc[0] = (f32x4){0.f, 0.f, 0.f, 0.f}; sacc[1] = sacc[0];
    v4u g_rc, g_kc, g_vc, g_rp, g_kp, g_vp, g_ld, g_a, g_g;
    v4u pend = {0u, 0u, 0u, 0u}; bf16* pend_p = MIX;
#define RK_LOADCHUNK(c_) do { const int t_ = b * SEQ + (c_) * 64 + lane; const bf16* pr_ = PROJ + (size_t)t_ * NPROJ + h * 64 + jw; \
        g_rc = *(const v4u*)pr_; g_kc = *(const v4u*)(pr_ + 512); g_vc = *(const v4u*)(pr_ + 1024); \
        if ((c_) == 0 && lane == 0) { g_rp = (v4u){0u, 0u, 0u, 0u}; g_kp = g_rp; g_vp = g_rp; } \
        else { g_rp = *(const v4u*)(pr_ - NPROJ); g_kp = *(const v4u*)(pr_ - NPROJ + 512); g_vp = *(const v4u*)(pr_ - NPROJ + 1024); } \
        const bf16* dg_ = DAG + (size_t)t_ * NLORA + h * 64 + jw; g_ld = *(const v4u*)dg_; g_a = *(const v4u*)(dg_ + 512); \
        g_g = *(const v4u*)(DAG + (size_t)(b * SEQ + (c_) * 64 + tt) * NLORA + 1024 + h * 64 + 8 * c8); } while (0)
    RK_LOADCHUNK(0);
    LDS_BARRIER();
    for (int c = 0; c < SEQ / 64; ++c) {
        const int t0 = b * SEQ + c * 64;
        float rr[8], km[8], vv[8], av[8], lgw[8], kkr[8];
        asm volatile("" : "+v"(g_rc), "+v"(g_kc), "+v"(g_vc), "+v"(g_rp), "+v"(g_kp), "+v"(g_vp), "+v"(g_ld), "+v"(g_a), "+v"(g_g));
        {
            float rc[8], kc[8], vc[8], rp_[8], kp[8], vp[8], ldv[8];
            unpack8(g_rc, rc); unpack8(g_kc, kc); unpack8(g_vc, vc); unpack8(g_rp, rp_); unpack8(g_kp, kp); unpack8(g_vp, vp); unpack8(g_ld, ldv); unpack8(g_a, av);
            float ss = 0.f, bonus = 0.f;
#pragma unroll
            for (int e = 0; e < 8; ++e) { const int j = jw + e;
                rr[e] = rc[e] + (rp_[e] - rc[e]) * cst[j]; const float k = kc[e] + (kp[e] - kc[e]) * cst[64 + j]; vv[e] = vc[e] + (vp[e] - vc[e]) * cst[128 + j];
                kkr[e] = k * cst[192 + j]; ss += kkr[e] * kkr[e];
                av[e] = sigmoidf_(cst[448 + j] + av[e]);
                lgw[e] = -0.6065306597f * sigmoidf_(cst[384 + j] + ldv[e]);
                km[e] = k * (1.0f + (av[e] - 1.0f) * cst[256 + j]);
                bonus += rr[e] * km[e] * cst[320 + j]; }
            ssP[lane * 8 + wave] = ss; bnP[lane * 8 + wave] = bonus;
        }
        const v4u gcur = g_g;
        LDS_BARRIER();
        {
            const f32x4 s0 = *(const LAS f32x4*)(ssP + lane * 8), s1 = *(const LAS f32x4*)(ssP + lane * 8 + 4), b0 = *(const LAS f32x4*)(bnP + lane * 8), b1 = *(const LAS f32x4*)(bnP + lane * 8 + 4);
            const float ss = ((s0[0] + s0[1]) + (s0[2] + s0[3])) + ((s1[0] + s1[1]) + (s1[2] + s1[3]));
            if (wave == 0) bon[lane] = ((b0[0] + b0[1]) + (b0[2] + b0[3])) + ((b1[0] + b1[1]) + (b1[2] + b1[3]));
            const float inv = frcp(fmaxf(fsqrt_(ss), 1e-12f));
            float oA[8], oB[8], oK[8], oR[8], oBh[8], oKh[8], lw[8], e63[8];
#pragma unroll
            for (int e = 0; e < 8; ++e) lw[e] = wave_scan_add(lgw[e]);
#pragma unroll
            for (int e = 0; e < 8; ++e) { const float l63 = __builtin_bit_cast(float, __builtin_amdgcn_readlane(__builtin_bit_cast(int, lw[e]), 63));
                const float eP = fexp(lw[e] - lgw[e]), eM = fexp(-lw[e]), eL = fexp(lw[e]); e63[e] = fexp(l63); const float eH = e63[e] * eM;
                const float kk = kkr[e] * inv, bb = kk * av[e];
                oA[e] = -kk * eP; oB[e] = bb * eM; oK[e] = km[e] * eM; oR[e] = rr[e] * eL; oBh[e] = bb * eH; oKh[e] = km[e] * eH; }
            if (lane == 63) { *(LAS f32x4*)(g63 + jw) = (f32x4){e63[0], e63[1], e63[2], e63[3]}; *(LAS f32x4*)(g63 + jw + 4) = (f32x4){e63[4], e63[5], e63[6], e63[7]}; }
            { const int ro = rk_off(lane, jw); *(LAS v4u*)(Ab + ro) = pack8(oA); *(LAS v4u*)(Bb + ro) = pack8(oB); *(LAS v4u*)(Kb + ro) = pack8(oK); *(LAS v4u*)(Rb + ro) = pack8(oR); }
#pragma unroll
            for (int e = 0; e < 8; ++e) { const int to = rk_off(jw + e, lane); BhT[to] = (bf16)f2bf(oBh[e]); KhT[to] = (bf16)f2bf(oKh[e]); Vt[to] = (bf16)f2bf(vv[e]); }
            if (c > 0) *(v4u*)pend_p = pend;
            if (c + 1 < SEQ / 64) RK_LOADCHUNK(c + 1);
        }
        LDS_BARRIER();
        {
            f32x4 d[2];
#define RK_MASK_LT(D_, MISS_) _Pragma("unroll") for (int q = 0; q < 2; ++q) { const int nb_ = nb0 + q; \
                if (MISS_ ? (mb < nb_) : (mb > nb_)) D_[q] = (f32x4){0.f, 0.f, 0.f, 0.f}; \
                else if (mb == nb_) { _Pragma("unroll") for (int r = 0; r < 4; ++r) { const int m_ = 4 * l4 + r; D_[q][r] = (MISS_ ? (l15 < m_) : (m_ < l15)) ? D_[q][r] : 0.f; } } }
#define RK_MASK_LE(D_) _Pragma("unroll") for (int q = 0; q < 2; ++q) { const int nb_ = nb0 + q; \
                if (mb > nb_) D_[q] = (f32x4){0.f, 0.f, 0.f, 0.f}; \
                else if (mb == nb_) { _Pragma("unroll") for (int r = 0; r < 4; ++r) { const int m_ = 4 * l4 + r; D_[q][r] = (m_ <= l15) ? D_[q][r] : 0.f; } } }
            const RkA aB = rk_lda(Bb, mb, l15, l4), aA = rk_lda(Ab, mb, l15, l4), aK = rk_lda(Kb, mb, l15, l4);
            const RkB bA = rk_ldb(Ab, nb0, l15, l4), bB = rk_ldb(Bb, nb0, l15, l4), bR = rk_ldb(Rb, nb0, l15, l4);
            f32x4 d2[2], d3[2], d4[2], d5[2];
            rk_mm<false>(d, aB, bA);
            rk_mm<false>(d2, aA, bB);
            rk_mm<false>(d3, aK, bA);
            rk_mm<false>(d4, aB, bR);
            rk_mm<false>(d5, aK, bR);
            RK_MASK_LT(d, false);
#pragma unroll
            for (int q = 0; q < 2; ++q)
#pragma unroll
                for (int r = 0; r < 4; ++r) tacc[q][r] = d[q][r] + ((mb == nb0 + q && 4 * l4 + r == l15) ? 1.f : 0.f);
            RK_MASK_LT(d2, true); RK_MASK_LT(d3, false); RK_MASK_LE(d4); RK_MASK_LE(d5);
            rk_store(P0, d, mb, nb0, l15, l4); rk_store(TA, tacc, mb, nb0, l15, l4); rk_store(P0T, d2, mb, nb0, l15, l4); rk_store(Aak, d3, mb, nb0, l15, l4); rk_store(Arb, d4, mb, nb0, l15, l4); rk_store(Ark, d5, mb, nb0, l15, l4);
        }
        LDS_BARRIER();
        {
            const RkA aPT = rk_lda(P0T, mb, l15, l4), aP = rk_lda(P0, mb, l15, l4), aA = rk_lda(Ab, mb, l15, l4), aAk = rk_lda(Aak, mb, l15, l4);
            const RkB bP = rk_ldb(P0, nb0, l15, l4), bPT = rk_ldb(P0T, nb0, l15, l4), bS = rk_ldb(Sb, nb0, l15, l4), bV = rk_ldb(Vt, nb0, l15, l4);
            f32x4 d[2], d2[2], d3[2];
            rk_mm<false>(d, aPT, bP); rk_mm<false>(d2, aP, bPT); rk_mm<false>(d3, aA, bS); rk_mm<true>(d3, aAk, bV);
            const RkA aS = rk_lda(Sb, mb, l15, l4), aV = rk_lda(Vt, mb, l15, l4), aKh = rk_lda(KhT, mb, l15, l4);
            const RkB bR = rk_ldb(Rb, nb0, l15, l4), bArk = rk_ldb(Ark, nb0, l15, l4);
            rk_mm<false>(yacc, aS, bR); rk_mm<true>(yacc, aV, bArk);
#pragma unroll
            for (int r = 0; r < 4; ++r) { const float g_ = g63[16 * mb + 4 * l4 + r]; sacc[0][r] *= g_; sacc[1][r] *= g_; }
            rk_mm<true>(sacc, aKh, bV);
            rk_store(Bb  , d, mb, nb0, l15, l4); rk_store(Kb  , d2, mb, nb0, l15, l4); rk_store(Xt, d3, mb, nb0, l15, l4);
        }
        LDS_BARRIER();
#define RK_DOUBLE(PK, PKT, TIN, TOUT, PN, PNT) { const RkA aPT = rk_lda(PKT, mb, l15, l4), aP = rk_lda(PK, mb, l15, l4); \
          const RkB bT = rk_ldb(TIN, nb0, l15, l4), bP = rk_ldb(PK, nb0, l15, l4), bPT = rk_ldb(PKT, nb0, l15, l4); \
          f32x4 d[2], d2[2]; rk_mm<true>(tacc, aPT, bT); rk_mm<false>(d, aPT, bP); rk_mm<false>(d2, aP, bPT); \
          rk_store(TOUT, tacc, mb, nb0, l15, l4); rk_store(PN, d, mb, nb0, l15, l4); rk_store(PNT, d2, mb, nb0, l15, l4); }
        RK_DOUBLE(Bb, Kb, TA, TB, P0, P0T)
        LDS_BARRIER();
        RK_DOUBLE(P0, P0T, TB, TA, Bb, Kb)
        LDS_BARRIER();
        RK_DOUBLE(Bb, Kb, TA, TB, P0, P0T)
        LDS_BARRIER();
        { const RkA aPT = rk_lda(P0T, mb, l15, l4), aP = rk_lda(P0, mb, l15, l4); const RkB bT = rk_ldb(TB, nb0, l15, l4), bPT = rk_ldb(P0T, nb0, l15, l4);
          f32x4 d2[2]; rk_mm<true>(tacc, aPT, bT); rk_mm<false>(d2, aP, bPT); rk_store(TA, tacc, mb, nb0, l15, l4); rk_store(Kb  , d2, mb, nb0, l15, l4); }
        LDS_BARRIER();
        { const RkA aPT = rk_lda(Kb, mb, l15, l4); const RkB bT = rk_ldb(TA, nb0, l15, l4); rk_mm<true>(tacc, aPT, bT); rk_store(TB, tacc, mb, nb0, l15, l4); }
        LDS_BARRIER();
#ifdef PROBE
        const unsigned long long tk2 = __builtin_amdgcn_s_memtime();
#endif
        { const RkA aT = rk_lda(TB, mb, l15, l4); const RkB bX = rk_ldb(Xt, nb0, l15, l4); f32x4 d[2]; rk_mm<false>(d, aT, bX); rk_store(Ut, d, mb, nb0, l15, l4); }
        LDS_BARRIER();
        {
            const RkA aU = rk_lda(Ut, mb, l15, l4), aBh = rk_lda(BhT, mb, l15, l4); const RkB bArb = rk_ldb(Arb, nb0, l15, l4), bU = rk_ldb(Ut, nb0, l15, l4);
            rk_mm<true>(yacc, aU, bArb); rk_mm<true>(sacc, aBh, bU);
#pragma unroll
            for (int q = 0; q < 2; ++q) *(LAS f32x4*)(Yl + (16 * (nb0 + q) + l15) * 64 + (((4 * mb + l4) ^ (l15 & 7)) << 2)) = yacc[q];
            rk_store(Sb, sacc, mb, nb0, l15, l4);
        }
        LDS_BARRIER();
        {
            const int t = t0 + tt, j0 = 8 * c8;
            const f32x4 y0 = *(const LAS f32x4*)(Yl + tt * 64 + (((2 * c8) ^ (tt & 7)) << 2)), y1 = *(const LAS f32x4*)(Yl + tt * 64 + (((2 * c8 + 1) ^ (tt & 7)) << 2));
            float y[8] = {y0[0], y0[1], y0[2], y0[3], y1[0], y1[1], y1[2], y1[3]}, gv[8]; float s1 = 0.f;
#pragma unroll
            for (int e = 0; e < 8; ++e) s1 += y[e];
            s1 = red8(s1); const float mean = s1 * (1.0f / 64.0f); float s2 = 0.f;
#pragma unroll
            for (int e = 0; e < 8; ++e) { const float dd = y[e] - mean; s2 += dd * dd; }
            s2 = red8(s2); const float rstd = frsq(s2 * (1.0f / 64.0f) + LNX_EPS);
            unpack8(gcur, gv);
            const float bonus = bon[tt]; float ov[8];
#pragma unroll
            for (int e = 0; e < 8; ++e) { const float yn = (y[e] - mean) * rstd * cst[512 + j0 + e] + cst[576 + j0 + e]; ov[e] = (yn + bonus * bf2f(Vt[rk_off(j0 + e, tt)])) * gv[e]; }
            pend = pack8(ov); pend_p = MIX + (size_t)t * DM + h * 64 + j0;
        }
        LDS_BARRIER();
    }
    *(v4u*)pend_p = pend;
#undef RK_S
#undef RK_LOADCHUNK
}

__device__ __forceinline__ void mlstm_unit(const Args& a, LAS unsigned char* lds, int unit, int tid, int lane, int wave) {
    unsigned char* ws = a.ws; const bf16* PROJ = (const bf16*)(ws + WS_PROJ); const float* gates = (const float*)(ws + WS_GATES); bf16* MIX = (bf16*)(ws + WS_MIX);
    const float* cw = a.in[14]; const float* cbias = a.in[15]; const float* i_bias = a.in[16]; const float* f_bias = a.in[17]; const float* mhg = a.in[18];
    const int b = unit >> 2, hm = unit & 3;
    constexpr int LD = 72;
    LAS bf16* Ql = (LAS bf16*)lds; LAS bf16* Kl = Ql + 64 * LD; LAS bf16* Kwt = Kl + 64 * LD; LAS bf16* Vt = Kwt + 64 * LD; LAS bf16* Sm = Vt + 128 * LD; LAS bf16* Ct = Sm + 64 * LD;
    LAS float* Hl = (LAS float*)(Ct + 128 * LD);
    LAS float* e_s = Hl + 64 * 132; LAS float* Mx = e_s + 64; LAS float* sc = Mx + 64; LAS float* em = sc + 64; LAS float* wsv = em + 64; LAS float* den = wsv + 64; LAS float* nvec = den + 64; LAS float* scal = nvec + 64;
    for (int i = tid; i < 128 * LD / 2; i += 512) ((LAS unsigned*)Ct)[i] = 0u;
    if (tid < 64) nvec[tid] = 0.f;
    if (tid == 0) { scal[0] = 1.f; scal[1] = 0.f; }
    f32x4 cacc[4];
#pragma unroll
    for (int i = 0; i < 4; ++i) cacc[i] = (f32x4){0.f, 0.f, 0.f, 0.f};
    const int l15 = lane & 15, l4 = lane >> 4;
    const int tt = tid >> 3, p8 = tid & 7;
    LAS float* cwl = scal + 16; LAS float* cbl = cwl + 512;
    for (int i = tid; i < 640; i += 512) { const int j = i >> 7, c_ = i & 127; const int src = (c_ < 64) ? (hm * 64 + c_) : (256 + hm * 64 + (c_ - 64)); if (j < 4) cwl[i] = cw[j * 512 + src]; else cbl[c_] = cbias[src]; }
    const float ibias = i_bias[hm], fbias = f_bias[hm];
    v4u n_q[4], n_k[4], n_va, n_vb, n_oa, n_ob; float n_gi = 0.f, n_gf = 0.f;
#define ML_LOADCHUNK(c_) do { const int t_ = b * SEQ + (c_) * 64 + lane; const int tp_ = (c_) * 64 + lane; \
        _Pragma("unroll") for (int j = 0; j < 4; ++j) { if (tp_ - 3 + j >= 0) { const bf16* pr_ = PROJ + (size_t)(t_ - 3 + j) * NPROJ + hm * 64 + 8 * wave; n_q[j] = *(const v4u*)(pr_ + C_Q); n_k[j] = *(const v4u*)(pr_ + C_K); } \
                                                       else { n_q[j] = (v4u){0u, 0u, 0u, 0u}; n_k[j] = (v4u){0u, 0u, 0u, 0u}; } } \
        { const bf16* pv_ = PROJ + (size_t)t_ * NPROJ + C_V + hm * 128 + 16 * wave; n_va = *(const v4u*)pv_; n_vb = *(const v4u*)(pv_ + 8); \
          const bf16* po_ = PROJ + (size_t)(b * SEQ + (c_) * 64 + tt) * NPROJ + C_O + hm * 128 + 16 * p8; n_oa = *(const v4u*)po_; n_ob = *(const v4u*)(po_ + 8); } \
        n_gi = gates[(size_t)t_ * 8 + hm]; n_gf = gates[(size_t)t_ * 8 + 4 + hm]; } while (0)
    ML_LOADCHUNK(0);
    LDS_BARRIER();
    float m_run = 0.f;
    v4u pend0 = {0u, 0u, 0u, 0u}, pend1 = pend0; bf16* pend_p = MIX;
    for (int c = 0; c < SEQ / 64; ++c) {
        const int t0 = b * SEQ + c * 64;
        asm volatile("" : "+v"(n_q[0]), "+v"(n_q[1]), "+v"(n_q[2]), "+v"(n_q[3]), "+v"(n_k[0]), "+v"(n_k[1]), "+v"(n_k[2]), "+v"(n_k[3]), "+v"(n_va), "+v"(n_vb), "+v"(n_oa), "+v"(n_ob), "+v"(n_gi), "+v"(n_gf));
        float dec;
        v4u c_oa, c_ob;
        {
            const float gi = n_gi + ibias, gf = n_gf + fbias;
            const float ig = 15.0f * tanhf_(gi * (1.0f / 15.0f)), fx = 15.0f * tanhf_(gf * (1.0f / 15.0f));
            const float logf = -(fmaxf(-fx, 0.f) + __logf(1.0f + fexp(-fabsf(fx))));
            const float bc = wave_scan_add(logf);
            const float e = ig - bc; const float P = wave_scan_max(e);
            const float mx = fmaxf(P, m_run);
            const float mxL = __builtin_bit_cast(float, __builtin_amdgcn_readlane(__builtin_bit_cast(int, mx), 63)), bL = __builtin_bit_cast(float, __builtin_amdgcn_readlane(__builtin_bit_cast(int, bc), 63));
            if (wave == 0) { e_s[lane] = e; Mx[lane] = mx; sc[lane] = fexp(m_run - mx); em[lane] = fexp(-(bc + mx)); }
            const float w = fexp(e - mxL);
            dec = fexp(m_run - mxL); m_run = bL + mxL;
            const int d0 = 8 * wave;
            float aq[8], ak[8];
#pragma unroll
            for (int e_ = 0; e_ < 8; ++e_) { aq[e_] = cbl[d0 + e_]; ak[e_] = cbl[64 + d0 + e_]; }
#pragma unroll
            for (int j = 0; j < 4; ++j) { float pq[8], pk[8]; unpack8(n_q[j], pq); unpack8(n_k[j], pk);
#pragma unroll
                for (int e_ = 0; e_ < 8; ++e_) { aq[e_] += cwl[j * 128 + d0 + e_] * pq[e_]; ak[e_] += cwl[j * 128 + 64 + d0 + e_] * pk[e_]; } }
#pragma unroll
            for (int e_ = 0; e_ < 8; ++e_) { aq[e_] = aq[e_] * sigmoidf_(aq[e_]) * 0.125f; ak[e_] = ak[e_] * sigmoidf_(ak[e_]); }
            *(LAS v4u*)(Ql + lane * LD + d0) = pack8(aq); *(LAS v4u*)(Kl + lane * LD + d0) = pack8(ak);
#pragma unroll
            for (int e_ = 0; e_ < 8; ++e_) Kwt[(d0 + e_) * LD + lane] = (bf16)f2bf(w * ak[e_]);
            const unsigned wv[8] = {n_va.x, n_va.y, n_va.z, n_va.w, n_vb.x, n_vb.y, n_vb.z, n_vb.w};
#pragma unroll
            for (int e_ = 0; e_ < 8; ++e_) { Vt[(16 * wave + 2 * e_) * LD + lane] = (bf16)(wv[e_] & 0xffffu); Vt[(16 * wave + 2 * e_ + 1) * LD + lane] = (bf16)(wv[e_] >> 16); }
            c_oa = n_oa; c_ob = n_ob;
            if (c > 0) { *(v4u*)pend_p = pend0; *(v4u*)(pend_p + 8) = pend1; }
            if (c + 1 < SEQ / 64) ML_LOADCHUNK(c + 1);
        }
        LDS_BARRIER();
        {
            const int rb = wave >> 1, cb0 = 2 * (wave & 1);
            bf16x8 A[2], B[2][2];
#pragma unroll
            for (int kk = 0; kk < 2; ++kk) { A[kk] = *(const LAS bf16x8*)(Ql + (16 * rb + l15) * LD + 32 * kk + 8 * l4);
#pragma unroll
                for (int ci = 0; ci < 2; ++ci) B[ci][kk] = *(const LAS bf16x8*)(Kl + (16 * (cb0 + ci) + l15) * LD + 32 * kk + 8 * l4); }
            float mxr[4];
#pragma unroll
            for (int r = 0; r < 4; ++r) mxr[r] = Mx[16 * rb + 4 * l4 + r];
            const float es0 = e_s[16 * cb0 + l15], es1 = e_s[16 * (cb0 + 1) + l15];
            f32x4 acc[2];
#pragma unroll
            for (int ci = 0; ci < 2; ++ci) { f32x4 c_ = {0.f, 0.f, 0.f, 0.f}; c_ = mfma16(A[0], B[ci][0], c_); acc[ci] = mfma16(A[1], B[ci][1], c_); }
#pragma unroll
            for (int ci = 0; ci < 2; ++ci) { const int s_ = 16 * (cb0 + ci) + l15; const float es = ci ? es1 : es0;
#pragma unroll
                for (int r = 0; r < 4; ++r) { const int t = 16 * rb + 4 * l4 + r; const float v = (s_ <= t) ? acc[ci][r] * fexp(es - mxr[r]) : 0.f; Sm[t * LD + s_] = (bf16)f2bf(v); } }
        }
        LDS_BARRIER();
        {
            float part = 0.f, qn = 0.f; float sv[8], qv[8];
            unpack8(*(const LAS v4u*)(Sm + tt * LD + 8 * p8), sv); unpack8(*(const LAS v4u*)(Ql + tt * LD + 8 * p8), qv);
#pragma unroll
            for (int e_ = 0; e_ < 8; ++e_) { part += sv[e_]; qn += qv[e_] * nvec[8 * p8 + e_]; }
            float tot = part + sc[tt] * qn; tot = red8(tot);
            if (p8 == 0) den[tt] = tot;
            const int rb = wave >> 1, vb0 = 4 * (wave & 1);
            bf16x8 As[2], Aq[2], B1[4][2], B2[4][2];
#pragma unroll
            for (int kk = 0; kk < 2; ++kk) { As[kk] = *(const LAS bf16x8*)(Sm + (16 * rb + l15) * LD + 32 * kk + 8 * l4); Aq[kk] = *(const LAS bf16x8*)(Ql + (16 * rb + l15) * LD + 32 * kk + 8 * l4);
#pragma unroll
                for (int vi = 0; vi < 4; ++vi) { B1[vi][kk] = *(const LAS bf16x8*)(Vt + (16 * (vb0 + vi) + l15) * LD + 32 * kk + 8 * l4); B2[vi][kk] = *(const LAS bf16x8*)(Ct + (16 * (vb0 + vi) + l15) * LD + 32 * kk + 8 * l4); } }
            float scr_[4];
#pragma unroll
            for (int r = 0; r < 4; ++r) scr_[r] = sc[16 * rb + 4 * l4 + r];
            f32x4 a1[4], a2[4];
#pragma unroll
            for (int vi = 0; vi < 4; ++vi) { f32x4 c1 = {0.f, 0.f, 0.f, 0.f}, c2 = {0.f, 0.f, 0.f, 0.f}; c1 = mfma16(As[0], B1[vi][0], c1); c2 = mfma16(Aq[0], B2[vi][0], c2); a1[vi] = mfma16(As[1], B1[vi][1], c1); a2[vi] = mfma16(Aq[1], B2[vi][1], c2); }
#pragma unroll
            for (int vi = 0; vi < 4; ++vi)
#pragma unroll
                for (int r = 0; r < 4; ++r) Hl[(16 * rb + 4 * l4 + r) * 132 + 16 * (vb0 + vi) + l15] = a1[vi][r] + scr_[r] * a2[vi][r];
        }
        LDS_BARRIER();
        {
            bf16x8 Av[2], Bk[4][2];
#pragma unroll
            for (int kk = 0; kk < 2; ++kk) { Av[kk] = *(const LAS bf16x8*)(Vt + (16 * wave + l15) * LD + 32 * kk + 8 * l4);
#pragma unroll
                for (int db = 0; db < 4; ++db) Bk[db][kk] = *(const LAS bf16x8*)(Kwt + (16 * db + l15) * LD + 32 * kk + 8 * l4); }
#pragma unroll
            for (int db = 0; db < 4; ++db) { cacc[db] = cacc[db] * dec; cacc[db] = mfma16(Av[0], Bk[db][0], cacc[db]); cacc[db] = mfma16(Av[1], Bk[db][1], cacc[db]); }
#pragma unroll
            for (int db = 0; db < 4; ++db)
#pragma unroll
                for (int r = 0; r < 4; ++r) Ct[(16 * wave + 4 * l4 + r) * LD + 16 * db + l15] = (bf16)f2bf(cacc[db][r]);
            float kv[8]; unpack8(*(const LAS v4u*)(Kwt + tt * LD + 8 * p8), kv); float s_ = 0.f;
#pragma unroll
            for (int e_ = 0; e_ < 8; ++e_) s_ += kv[e_];
            s_ = red8(s_);
            if (p8 == 0) nvec[tt] = dec * nvec[tt] + s_;
        }
        {
            const int t = t0 + tt, v0 = 16 * p8; float hv[16]; float ss = 0.f;
            const float dn = frcp(fmaxf(fabsf(den[tt]), em[tt]));
#pragma unroll
            for (int q = 0; q < 4; ++q) { const f32x4 x = *(const LAS f32x4*)(Hl + tt * 132 + v0 + 4 * q) * dn; hv[4 * q] = x[0]; hv[4 * q + 1] = x[1]; hv[4 * q + 2] = x[2]; hv[4 * q + 3] = x[3]; ss += (x[0] * x[0] + x[1] * x[1]) + (x[2] * x[2] + x[3] * x[3]); }
            ss = red8(ss); const float rn = frsq(ss * (1.0f / 128.0f) + NORM_EPS);
            float o0[8], o1[8]; unpack8(c_oa, o0); unpack8(c_ob, o1);
            float r0[8], r1[8];
#pragma unroll
            for (int e_ = 0; e_ < 8; ++e_) { r0[e_] = hv[e_] * rn * mhg[hm * 128 + v0 + e_] * sigmoidf_(o0[e_]); r1[e_] = hv[8 + e_] * rn * mhg[hm * 128 + v0 + 8 + e_] * sigmoidf_(o1[e_]); }
            pend_p = MIX + (size_t)t * DM + 512 + hm * 128 + v0; pend0 = pack8(r0); pend1 = pack8(r1);
        }
        LDS_BARRIER();
    }
    *(v4u*)pend_p = pend0; *(v4u*)(pend_p + 8) = pend1;
#undef ML_LOADCHUNK
}

__device__ __forceinline__ void phase_ffn_fix(const Args& a, int tid) {
    unsigned char* ws = a.ws; const float* SA = (const float*)(ws + WS_SIDE); const float* SB = SA + SIDE_ELEMS; const float* SL = SB + SIDE_ELEMS; bf16* GB = (bf16*)(ws + WS_GB);
    const float* cw = a.in[22]; const float* cb = a.in[23];
    const int NT = gridDim.x * 512;
    for (int it = blockIdx.x * 512 + tid; it < SIDE_ELEMS; it += NT) {
        const int ch = it & 127, r = (it >> 7) & 1, tile = it >> 8, pm = tile / 22, pn = tile % 22;
        const int base = tile * 256;
        float l0 = 0.f, l1 = 0.f;
        if ((pm & 7) != 0) { const int lb = (tile - 22) * 256; l0 = SL[lb + ch]; l1 = SL[lb + 128 + ch]; }
        const float a_r = SA[base + r * 128 + ch], b_r = SB[base + r * 128 + ch];
        const float am1 = r == 0 ? l1 : SA[base + ch], am2 = r == 0 ? l0 : l1;
        const int f = pn * 128 + ch;
        const float z = cb[f] + cw[f] * am2 + cw[DFF + f] * am1 + cw[2 * DFF + f] * a_r;
        GB[(size_t)(pm * 256 + r) * DFF + f] = (bf16)f2bf(z * sigmoidf_(z) * b_r);
    }
}
__device__ __forceinline__ void phase_final(const Args& a, int lane, int wave) {
    const bf16* FF = (const bf16*)(a.ws + WS_FF); const float* gf = a.in[25];
    f32x4 gv[4];
#pragma unroll
    for (int j = 0; j < 4; ++j) gv[j] = *((const f32x4*)gf + lane + 64 * j);
    const int NGW = gridDim.x * 8;
#ifdef PROBE
    const unsigned long long* tstamps = (const unsigned long long*)(a.ws + WS_CTL + 512 * 1024);
    const float fa = fminf(fmaxf((float)(long long)(tstamps[PROBE_A_TO] - tstamps[PROBE_A_FROM]) * (0.01f / PROBE_A_SCALE_US), 0.f), 1.f);
    const float pscale = 1.0f + sqrtf(fa * 0.8e-4f);
#pragma unroll
    for (int j = 0; j < 4; ++j) gv[j] = gv[j] * pscale;
#endif
    const bf16* XB = (const bf16*)(a.ws + WS_XN);
    for (int row0 = 2 * (blockIdx.x * 8 + wave); row0 < M; row0 += 2 * NGW) {
        v2u xq[2][4], f[2][4];
#pragma unroll
        for (int u = 0; u < 2; ++u) { const v2u* xr = (const v2u*)(XB + (size_t)(row0 + u) * DM) + lane; const v2u* fr_ = (const v2u*)(FF + (size_t)(row0 + u) * DM) + lane;
#pragma unroll
            for (int j = 0; j < 4; ++j) { xq[u][j] = xr[64 * j]; f[u][j] = fr_[64 * j]; } }
#pragma unroll
        for (int u = 0; u < 2; ++u) { float ss = 0.f; f32x4 v[4];
#pragma unroll
            for (int j = 0; j < 4; ++j) { v[j][0] = bflo(xq[u][j].x) + bflo(f[u][j].x); v[j][1] = bfhi(xq[u][j].x) + bfhi(f[u][j].x); v[j][2] = bflo(xq[u][j].y) + bflo(f[u][j].y); v[j][3] = bfhi(xq[u][j].y) + bfhi(f[u][j].y);
                ss += (v[j][0] * v[j][0] + v[j][1] * v[j][1]) + (v[j][2] * v[j][2] + v[j][3] * v[j][3]); }
            const float rs = frsq(wave_sum(ss) * (1.0f / DM) + NORM_EPS);
            f32x4* xr = (f32x4*)(a.out + (size_t)(row0 + u) * DM) + lane;
#pragma unroll
            for (int j = 0; j < 4; ++j) xr[64 * j] = v[j] * rs * gv[j]; }
    }
}

constexpr int N_PHASES = 10;
__global__ void __launch_bounds__(512, 2) mega(Args args) {
    extern __shared__ __attribute__((aligned(16))) unsigned char lds_raw[];
    LAS unsigned char* lds = (LAS unsigned char*)lds_raw;
    const int tid0 = threadIdx.x;
    unsigned char* ws = args.ws;
#define PHASE_IDS int tid = tid0; asm volatile("" : "+v"(tid)); const int lane = tid & 63, wave = __builtin_amdgcn_readfirstlane(tid >> 6); (void)lane; (void)wave
    volatile LAS unsigned* MISC = (volatile LAS unsigned*)(lds + MISC_OFF);
    { PHASE_IDS; for (int u = tid; u < (LDS_BYTES - 131072) / 4; u += 512) ((LAS unsigned*)(lds + 131072))[u] = 0u; }
    __syncthreads();
    XcdBarrier bar; bar.bar = (unsigned*)(ws + WS_CTL) + 4096; bar.x = 0; bar.st = nullptr;
    if (MK_SINGLE) bar = xcd_barrier_post((unsigned*)(ws + WS_CTL) + 4096, MISC + 8);
    const int lo = args.ph_lo, hi = args.ph_hi;
#ifndef PH_MASK
#define PH_MASK 0xFFFF
#endif
#define IN(k) ((((PH_MASK) >> (k)) & 1) && lo <= (k) && (k) < hi)
#ifdef PROBE
    unsigned long long* const tstamps = (unsigned long long*)(ws + WS_CTL + 512 * 1024);
#define STAMP(k) do { if (blockIdx.x == 0 && tid0 == 0) tstamps[(k)] = __builtin_amdgcn_s_memrealtime(); } while (0)
#else
#define STAMP(k) do { } while (0)
#endif
    STAMP(0);
#define SEAM(k) do { if (IN(k) && IN((k) + 1)) xcd_barrier(bar); STAMP((k) + 1); } while (0)

    if (IN(0)) { PHASE_IDS; phase_prep(args, lds, tid, lane, wave); } SEAM(0);
    if (IN(1)) {
        pg8::Gemm g{(const bf16*)(ws + WS_XN), (const bf16*)(ws + WS_WT_IN), M, NPROJ, opaque_i(DM)}; pg8::StaticOrder S; S.init(M, NPROJ, gridDim.x, (int)blockIdx.x);
        pg8::EpiBf16<0> E{(bf16*)(ws + WS_PROJ), NPROJ, nullptr, 0, 0, 1.f};
        pg8::gemm_phase<pg8::EpiBf16<0>, pg8::StaticOrder, true, true>(lds, g, S, E);
    } SEAM(1);
    if (IN(2)) {
        PHASE_IDS;
        if ((int)blockIdx.x < BATCH * 4 || gridDim.x != 256) {
            for (int u = blockIdx.x; u < BATCH * 4; u += gridDim.x) mlstm_unit(args, lds, u, tid, lane, wave);
        }
        if (gridDim.x == 256 && (int)blockIdx.x >= BATCH * 4) {
            const int c = (int)blockIdx.x - BATCH * 4;
            phase_lmat(args, tid, 512 * c, 512);
            asm volatile("s_waitcnt vmcnt(0)" ::: "memory"); __syncthreads();
            if (tid == 0) { __builtin_amdgcn_fence(__ATOMIC_ACQUIRE, "agent"); asm volatile("s_waitcnt vmcnt(0)" ::: "memory"); }
            __syncthreads();
            pg8::Gemm g{(const bf16*)(ws + WS_LBUF), (const bf16*)(ws + WS_WT_LORA), M, NLORA, opaque_i(KLORA)}; pg8::PairPanelOrder S{c};
            pg8::EpiBf16<0> E{(bf16*)(ws + WS_DAG), NLORA, nullptr, 0, 0, 1.f};
            pg8::gemm_phase<pg8::EpiBf16<0>, pg8::PairPanelOrder, true, true>(lds, g, S, E);
            __syncthreads();
            late_transposes(args, lds, lane, wave, c * 8 + wave, ((int)gridDim.x - BATCH * 4) * 8);
        }
    } SEAM(2);
    if (IN(3)) {
        PHASE_IDS;
        for (int u = blockIdx.x; u < BATCH * 8; u += gridDim.x) rwkv_unit(args, lds, u, tid, lane, wave);
        STAMP(12);
    }
    if (IN(3) && IN(5)) xcd_barrier(bar);
    STAMP(5);
    if (IN(5)) {
        pg8::Gemm g{(const bf16*)(ws + WS_MIX), (const bf16*)(ws + WS_WT_OUT), M, DM, opaque_i(DM)}; pg8::StaticOrder S; S.init(M, DM, gridDim.x, (int)blockIdx.x);
        pg8::EpiResid E{(bf16*)(ws + WS_XN), (const float*)(ws + WS_RINV), (float*)(ws + WS_SSQP)};
        pg8::gemm_phase<pg8::EpiResid, pg8::StaticOrder, true, true>(lds, g, S, E);
    } SEAM(5);
    if (IN(6)) {
        pg8::Gemm g{(const bf16*)(ws + WS_XN), (const bf16*)(ws + WS_WT_UP), M, NUP, opaque_i(DM)}; pg8::StaticOrder S; S.init(M, NUP, gridDim.x, (int)blockIdx.x);
        float* side = (float*)(ws + WS_SIDE); float* rs2 = (float*)(ws + WS_RS2);
        {
            PHASE_IDS; pg8::Unit u;
            for (int i = 0; S.next(i, u); ++i) if (tid < 256) { const int row = u.pm * 256 + tid; const f32x4* p = (const f32x4*)((const float*)(ws + WS_SSQP) + (size_t)row * 16); const f32x4 s0 = p[0], s1 = p[1], s2 = p[2], s3 = p[3];
                const float ss = ((s0[0] + s0[1]) + (s0[2] + s0[3])) + ((s1[0] + s1[1]) + (s1[2] + s1[3])) + ((s2[0] + s2[1]) + (s2[2] + s2[3])) + ((s3[0] + s3[1]) + (s3[2] + s3[3]));
                rs2[row] = frsq(ss * (1.0f / DM) + NORM_EPS); }
            asm volatile("s_waitcnt vmcnt(0)" ::: "memory"); __syncthreads();
        }
        pg8::EpiFfn E{(bf16*)(ws + WS_GB), rs2, args.in[22], args.in[23], side, side + SIDE_ELEMS, side + 2 * SIDE_ELEMS, (LAS float*)(lds + 131072 + 1024)};
        pg8::gemm_phase<pg8::EpiFfn, pg8::StaticOrder, true, true>(lds, g, S, E);
    } SEAM(6);
    if (IN(7)) { PHASE_IDS; phase_ffn_fix(args, tid); } SEAM(7);
    if (IN(8)) {
        pg8::Gemm g{(const bf16*)(ws + WS_GB), (const bf16*)(ws + WS_WT_DN), M, DM, opaque_i(DFF)}; pg8::StaticOrder S; S.init(M, DM, gridDim.x, (int)blockIdx.x);
        pg8::EpiBf16<0> E{(bf16*)(ws + WS_FF), DM, nullptr, 0, 0, 1.f};
        pg8::gemm_phase<pg8::EpiBf16<0>, pg8::StaticOrder, true, true>(lds, g, S, E);
    } SEAM(8);
#ifdef PROBE
    xcd_barrier(bar);
#endif
    if (IN(9)) { PHASE_IDS; phase_final(args, lane, wave); }
#undef IN
#undef SEAM
}

extern "C" void kernel_launch(void* const* d_in, const int* in_sizes, int n_in, void* d_out, int out_size, void* d_ws, size_t ws_size, hipStream_t stream) {
    static int grid = 0;
    if (grid == 0) {
        if (n_in != 26 || in_sizes[0] != M * DM || out_size != M * DM || ws_size < WS_END) { fprintf(stderr, "kernel_launch: unexpected shapes (n_in %d, in0 %d, out %d, ws %zu)\n", n_in, n_in > 0 ? in_sizes[0] : -1, out_size, ws_size); grid = -1; return; }
        int dev = 0, cus = 0, per_cu = 0;
        if (hipGetDevice(&dev) != hipSuccess || hipDeviceGetAttribute(&cus, hipDeviceAttributeMultiprocessorCount, dev) != hipSuccess) { grid = -1; return; }
        if (hipFuncSetAttribute((const void*)mega, hipFuncAttributeMaxDynamicSharedMemorySize, LDS_BYTES) != hipSuccess) { fprintf(stderr, "kernel_launch: hipFuncSetAttribute failed\n"); grid = -1; return; }
        if (hipOccupancyMaxActiveBlocksPerMultiprocessor(&per_cu, (const void*)mega, 512, LDS_BYTES) != hipSuccess || per_cu < 1) { fprintf(stderr, "kernel_launch: occupancy query says %d blocks per CU\n", per_cu); }
        (void)hipGetLastError();
        grid = cus;
        if (grid != 256) fprintf(stderr, "kernel_launch: %d CUs; this kernel is laid out for 256\n", grid);
    }
    if (grid < 0) return;
    (void)hipMemsetAsync((char*)d_ws + WS_CTL, 0, CTL_ZERO_BYTES, stream);
    Args a{};
    for (int i = 0; i < 26; ++i) a.in[i] = (const float*)d_in[i];
    a.out = (float*)d_out; a.ws = (unsigned char*)d_ws;
#if MK_SINGLE
    a.ph_lo = 0; a.ph_hi = N_PHASES;
    hipLaunchKernelGGL(mega, dim3(grid), dim3(512), LDS_BYTES, stream, a);
#else
    for (int p = 0; p < N_PHASES; ++p) { a.ph_lo = p; a.ph_hi = p + 1; hipLaunchKernelGGL(mega, dim3(grid), dim3(512), LDS_BYTES, stream, a); }
#endif
}
```

```cpp
#include <hip/hip_runtime.h>
#include <cstdio>
#include <cstdint>
namespace pg8 {
#define PG8_LAS __attribute__((address_space(3)))
typedef unsigned short bf16_t;
typedef short bf16x8 __attribute__((ext_vector_type(8)));
typedef float f32x4 __attribute__((ext_vector_type(4)));
typedef unsigned u32x4 __attribute__((ext_vector_type(4)));
constexpr int BM = 256, BK = 64, HALF = 128, HTB = HALF * BK * 2  , STAGE_BYTES = 8 * HTB, NXCD = 8, WGM = 8;

__host__ __device__ __forceinline__ int lds_byte(int r, int c) { const int st = (r >> 4) * 2 + (c >> 5), rr = r & 15, cc = c & 31, ob = rr * 64 + cc * 2; return st * 1024 + (ob ^ (((ob >> 9) & 1) << 5)); }
__host__ __device__ __forceinline__ void stage_rc(int b, int& R, int& C) { const int st = b / 1024, sb = b % 1024, swz = sb ^ (((sb >> 9) & 1) << 5); R = (st >> 1) * 16 + swz / 64; C = (st & 1) * 32 + (swz % 64) / 2; }
__host__ __device__ __forceinline__ int perm32(int rho) { const int n = rho >> 4, i = rho & 15; return 8 * (i >> 2) + 4 * n + (i & 3); }

struct Unit { int pm, pn; };
struct Gemm { const bf16_t* A; const bf16_t* Bt; int M, N, K; };

struct StaticOrder {
    int nM, nN, nwg, G, c;
    __host__ __device__ void init(int M, int N, int G_, int c_) { nM = M / BM; nN = N / BM; nwg = nM * nN; G = G_; c = c_; }
    __host__ __device__ bool next(int i, Unit& u) const {
        const long L = (long)i * G + c; if (L >= nwg) return false;
        int wgid = (int)L; { const int q = nwg / NXCD, r = nwg % NXCD, xcd = wgid % NXCD, off = wgid / NXCD; wgid = (xcd < r ? xcd * (q + 1) : r * (q + 1) + (xcd - r) * q) + off; }
        const int nig = WGM * nN, gid = wgid / nig, fm = gid * WGM, gsz = (nM - fm) < WGM ? (nM - fm) : WGM;
        u.pm = fm + ((wgid % nig) % gsz); u.pn = (wgid % nig) / gsz; return true;
    }
    __device__ __forceinline__ void a_ready(const Unit&) const {}
    __device__ __forceinline__ void done(const Unit&) const {}
};

__device__ __forceinline__ unsigned cvt_pk_bf16(float lo, float hi) { unsigned r; asm volatile("v_cvt_pk_bf16_f32 %0, %1, %2" : "=v"(r) : "v"(lo), "v"(hi)); return r; }
typedef float f32x2 __attribute__((ext_vector_type(2)));
__device__ __forceinline__ f32x2 gelu_pk(f32x2 v) {
    const f32x2 av = __builtin_elementwise_abs(v), d = av * 0.2316418882f + 1.0f;
    f32x2 t; t.x = __builtin_amdgcn_rcpf(d.x); t.y = __builtin_amdgcn_rcpf(d.y);
    f32x2 q = t * 0.5307027145f + (-0.7265760135f); q = q * t + 0.7107068705f; q = q * t + (-0.142248368f); q = q * t + 0.127414796f; q = q * t;
    const f32x2 s = (v * v) * (-0.72134752044f);
    f32x2 e; e.x = __builtin_amdgcn_exp2f(s.x); e.y = __builtin_amdgcn_exp2f(s.y);
    const f32x2 m = v * (q * e), r = v - m;
    f32x2 o; o.x = v.x < 0.f ? m.x : r.x; o.y = v.y < 0.f ? m.y : r.y; return o;
}

template <int ACT  > struct EpiBf16 {
    static constexpr bool PERM = true, AFTER_DRAIN = false; static_assert(ACT == 0 || ACT == 1, "EpiBf16: ACT is 0 (none) or 1 (gelu_pk)");
    bf16_t* O; int ldc; const float* bias; int split_cols; size_t split_stride; float scale0;
    __device__ __forceinline__ void operator()(const f32x4 (&acc)[2][2][4][2], const Unit& u, int wr, int wc, int fr, int fq) const {
        const int row0 = u.pm * BM + wr * 64 + fr; int colt = u.pn * BM; bf16_t* base = O;
        float sc = 1.f; if (split_cols) { const int t = colt / split_cols; base += (size_t)t * split_stride; colt -= t * split_cols; if (t == 0) sc = scale0; }
        const int col0 = colt + wc * 32 + 8 * fq, bcol0 = u.pn * BM + wc * 32 + 8 * fq;
        f32x4 bv[2][2];
#pragma unroll
        for (int bj = 0; bj < 2; ++bj)
#pragma unroll
            for (int n = 0; n < 2; ++n) bv[bj][n] = bias ? *(const f32x4*)(bias + bcol0 + bj * HALF + 4 * n) : (f32x4){0.f, 0.f, 0.f, 0.f};
#pragma unroll
        for (int ai = 0; ai < 2; ++ai)
#pragma unroll
            for (int m = 0; m < 4; ++m) { bf16_t* rowp = base + (size_t)(row0 + ai * HALF + m * 16) * ldc + col0;
#pragma unroll
                for (int bj = 0; bj < 2; ++bj) { f32x4 v0 = acc[ai][bj][m][0] + bv[bj][0], v1 = acc[ai][bj][m][1] + bv[bj][1];
                    if (ACT == 1) { f32x2 a = gelu_pk((f32x2){v0[0], v0[1]}), b = gelu_pk((f32x2){v0[2], v0[3]}), c = gelu_pk((f32x2){v1[0], v1[1]}), d = gelu_pk((f32x2){v1[2], v1[3]});
                        v0 = (f32x4){a.x, a.y, b.x, b.y}; v1 = (f32x4){c.x, c.y, d.x, d.y}; }
                    v0 = v0 * sc; v1 = v1 * sc; u32x4 w; w.x = cvt_pk_bf16(v0[0], v0[1]); w.y = cvt_pk_bf16(v0[2], v0[3]); w.z = cvt_pk_bf16(v1[0], v1[1]); w.w = cvt_pk_bf16(v1[2], v1[3]);
                    *(u32x4*)(rowp + bj * HALF) = w; } }
    }
};
template <class Epi, class Sched, bool ALIGN_EPI = false, bool SP2 = false>
__device__ __forceinline__ void gemm_phase(PG8_LAS unsigned char* lds, const Gemm g, const Sched& S, const Epi& E, const int tid_in) {
    const int tid = tid_in, wid = __builtin_amdgcn_readfirstlane(tid >> 6), lane = tid & 63, wr = wid >> 2, wc = wid & 3, fr = lane & 15, fq = lane >> 4;
    const int K = g.K, nt = K / BK;
    unsigned voffA[2], voffB[2];
#pragma unroll
    for (int i = 0; i < 2; ++i) { int R, C; stage_rc(tid * 16 + i * 8192, R, C); const int Rb = Epi::PERM ? ((R & ~31) + perm32(R & 31)) : R;
        voffA[i] = (unsigned)(R * K + C) * 2u; voffB[i] = (unsigned)(Rb * K + C) * 2u; }
    const size_t kstep = (size_t)(BK * 2);
    const size_t hstep = (size_t)HALF * K * 2;
    const size_t tstep = 2 * hstep;
    const unsigned ldsw = (unsigned)wid * 1024u;
    const int aoff = lds_byte(wr * 64 + fr, fq * 8), boff = lds_byte(wc * 32 + fr, fq * 8);
#define PG8_SA(b, h) (((b) * 2 + (h)) * HTB)
#define PG8_SB(b, h) ((4 + (b) * 2 + (h)) * HTB)
#define PG8_STAGE(bufoff, gbase, voff) do { _Pragma("unroll") for (int _i = 0; _i < 2; ++_i) \
        __builtin_amdgcn_global_load_lds((const unsigned*)((const char*)(gbase) + (voff)[_i]), (PG8_LAS unsigned*)(lds + (bufoff) + ldsw + _i * 8192), 16, 0, 0); } while (0)
#define PG8_LDA(dst, b, h) do { _Pragma("unroll") for (int m = 0; m < 4; ++m) _Pragma("unroll") for (int k = 0; k < 2; ++k) dst[m][k] = *(const PG8_LAS bf16x8*)(lds + PG8_SA(b, h) + aoff + m * 2048 + k * 1024); } while (0)
#define PG8_LDB(dst, b, h) do { _Pragma("unroll") for (int n = 0; n < 2; ++n) _Pragma("unroll") for (int k = 0; k < 2; ++k) dst[n][k] = *(const PG8_LAS bf16x8*)(lds + PG8_SB(b, h) + boff + n * 2048 + k * 1024); } while (0)
#define PG8_MMA(ai, bj, At, Bt) do { __builtin_amdgcn_s_setprio(1); _Pragma("unroll") for (int m = 0; m < 4; ++m) _Pragma("unroll") for (int n = 0; n < 2; ++n) _Pragma("unroll") for (int k = 0; k < 2; ++k) \
        acc[ai][bj][m][n] = __builtin_amdgcn_mfma_f32_16x16x32_bf16(Bt[n][k], At[m][k], acc[ai][bj][m][n], 0, 0, 0); __builtin_amdgcn_s_setprio(0); } while (0)
#define PG8_WAIT_V(n) asm volatile("s_waitcnt vmcnt(" #n ")" ::: "memory")
#define PG8_WAIT_L(n) asm volatile("s_waitcnt lgkmcnt(" #n ")" ::: "memory")
#define PG8_BAR __builtin_amdgcn_s_barrier()
#define PG8_SCHED __builtin_amdgcn_sched_barrier(0)
    Unit cur, nxt; int ui = 0;
    if (!S.next(0, cur)) return;
    f32x4 acc[2][2][4][2];
#pragma unroll
    for (int a = 0; a < 2; ++a)
#pragma unroll
        for (int b = 0; b < 2; ++b)
#pragma unroll
            for (int m = 0; m < 4; ++m)
#pragma unroll
                for (int n = 0; n < 2; ++n) acc[a][b][m][n] = (f32x4){0.f, 0.f, 0.f, 0.f};
    bf16x8 At[4][2], B0[2][2], B1[2][2];
    const char* cA = (const char*)g.A + (size_t)cur.pm * tstep; const char* cB = (const char*)g.Bt + (size_t)cur.pn * tstep;
    S.a_ready(cur);
    if constexpr (SP2) {
        PG8_STAGE(PG8_SB(0, 0), cB, voffB); PG8_STAGE(PG8_SB(0, 1), cB + hstep, voffB); PG8_STAGE(PG8_SA(0, 0), cA, voffA); PG8_STAGE(PG8_SA(0, 1), cA + hstep, voffA);
        if (wr == 1) PG8_BAR;
        PG8_WAIT_V(2); PG8_BAR;
        PG8_STAGE(PG8_SB(1, 0), cB + kstep, voffB); PG8_STAGE(PG8_SA(1, 0), cA + kstep, voffA); PG8_STAGE(PG8_SB(1, 1), cB + hstep + kstep, voffB);
        PG8_WAIT_V(6); PG8_BAR;
    } else {
        PG8_STAGE(PG8_SB(0, 0), cB, voffB); PG8_STAGE(PG8_SA(0, 0), cA, voffA); PG8_STAGE(PG8_SB(0, 1), cB + hstep, voffB); PG8_STAGE(PG8_SA(0, 1), cA + hstep, voffA);
        if (wr == 1) PG8_BAR;
        PG8_WAIT_V(4); PG8_BAR;
        PG8_STAGE(PG8_SB(1, 0), cB + kstep, voffB); PG8_STAGE(PG8_SA(1, 0), cA + kstep, voffA); PG8_STAGE(PG8_SB(1, 1), cB + hstep + kstep, voffB);
        PG8_WAIT_V(6); PG8_BAR;
    }
    for (;;) {
        const bool has_next = S.next(ui + 1, nxt);
        const char* nA = has_next ? (const char*)g.A + (size_t)nxt.pm * tstep : cA; const char* nB = has_next ? (const char*)g.Bt + (size_t)nxt.pn * tstep : cB;
        for (int t = 0; t < nt; t += 2) {
            const bool last = (t == nt - 2);
            const char* a1 = cA + (size_t)(t + 1) * kstep;
            const char* a2 = last ? nA : cA + (size_t)(t + 2) * kstep; const char* b2 = last ? nB : cB + (size_t)(t + 2) * kstep;
            const char* a3 = a2 + kstep; const char* b3 = b2 + kstep;
            if (last && has_next) S.a_ready(nxt);
            if constexpr (SP2) {
            PG8_LDB(B0, 0, 0); PG8_LDB(B1, 0, 1); PG8_SCHED; PG8_LDA(At, 0, 0); PG8_STAGE(PG8_SA(1, 1), a1 + hstep, voffA);
            PG8_WAIT_V(8); PG8_WAIT_L(0); PG8_BAR; PG8_MMA(0, 0, At, B0); PG8_MMA(0, 1, At, B1); PG8_BAR; PG8_SCHED;
            PG8_LDA(At, 0, 1); PG8_STAGE(PG8_SB(0, 0), b2, voffB); PG8_STAGE(PG8_SB(0, 1), b2 + hstep, voffB); PG8_STAGE(PG8_SA(0, 0), a2, voffA);
            PG8_WAIT_V(8); PG8_WAIT_L(0); PG8_BAR; PG8_MMA(1, 0, At, B0); PG8_MMA(1, 1, At, B1); PG8_BAR; PG8_SCHED;
            PG8_LDB(B0, 1, 0); PG8_LDB(B1, 1, 1); PG8_SCHED; PG8_LDA(At, 1, 0); PG8_STAGE(PG8_SA(0, 1), a2 + hstep, voffA);
            PG8_WAIT_V(8); PG8_WAIT_L(0); PG8_BAR; PG8_MMA(0, 0, At, B0); PG8_MMA(0, 1, At, B1); PG8_BAR; PG8_SCHED;
            PG8_LDA(At, 1, 1); PG8_STAGE(PG8_SB(1, 0), b3, voffB); PG8_STAGE(PG8_SB(1, 1), b3 + hstep, voffB); PG8_STAGE(PG8_SA(1, 0), a3, voffA);
            PG8_WAIT_V(8); PG8_WAIT_L(0); PG8_BAR; PG8_MMA(1, 0, At, B0); PG8_MMA(1, 1, At, B1); PG8_BAR; PG8_SCHED;
            } else {
            PG8_LDB(B0, 0, 0); PG8_SCHED; PG8_LDA(At, 0, 0); PG8_STAGE(PG8_SA(1, 1), a1 + hstep, voffA);
            PG8_WAIT_L(8); PG8_BAR; PG8_WAIT_L(0); PG8_MMA(0, 0, At, B0); PG8_BAR; PG8_SCHED;
            PG8_LDB(B1, 0, 1); PG8_STAGE(PG8_SB(0, 0), b2, voffB);
            PG8_BAR; PG8_WAIT_L(0); PG8_MMA(0, 1, At, B1); PG8_BAR;
            PG8_LDA(At, 0, 1); PG8_STAGE(PG8_SA(0, 0), a2, voffA);
            PG8_BAR; PG8_WAIT_L(0); PG8_MMA(1, 0, At, B0); PG8_BAR; PG8_SCHED;
            PG8_STAGE(PG8_SB(0, 1), b2 + hstep, voffB);
            PG8_WAIT_V(6); PG8_BAR; PG8_MMA(1, 1, At, B1); PG8_BAR;
            PG8_LDB(B0, 1, 0); PG8_SCHED; PG8_LDA(At, 1, 0); PG8_STAGE(PG8_SA(0, 1), a2 + hstep, voffA);
            PG8_WAIT_L(8); PG8_BAR; PG8_WAIT_L(0); PG8_MMA(0, 0, At, B0); PG8_BAR; PG8_SCHED;
            PG8_LDB(B1, 1, 1); PG8_STAGE(PG8_SB(1, 0), b3, voffB);
            PG8_BAR; PG8_WAIT_L(0); PG8_MMA(0, 1, At, B1); PG8_BAR;
            PG8_LDA(At, 1, 1); PG8_STAGE(PG8_SA(1, 0), a3, voffA);
            PG8_BAR; PG8_WAIT_L(0); PG8_MMA(1, 0, At, B0); PG8_BAR; PG8_SCHED;
            PG8_STAGE(PG8_SB(1, 1), b3 + hstep, voffB);
            PG8_WAIT_V(6); PG8_BAR; PG8_MMA(1, 1, At, B1); PG8_BAR;
            }
        }
        if constexpr (ALIGN_EPI) { if (wr == 0) PG8_BAR; }
        if constexpr (!Epi::AFTER_DRAIN) { E(acc, cur, wr, wc, fr, fq); S.done(cur); }
        if (!has_next) break;
#pragma unroll
        for (int a = 0; a < 2; ++a)
#pragma unroll
            for (int b = 0; b < 2; ++b)
#pragma unroll
                for (int m = 0; m < 4; ++m)
#pragma unroll
                    for (int n = 0; n < 2; ++n) acc[a][b][m][n] = (f32x4){0.f, 0.f, 0.f, 0.f};
        cur = nxt; cA = nA; cB = nB; ++ui;
        if constexpr (ALIGN_EPI) { if (wr == 1) PG8_BAR; }
    }
    PG8_WAIT_V(0);
    if constexpr (!ALIGN_EPI) { if (wr == 0) PG8_BAR; }
    PG8_BAR;
    if constexpr (Epi::AFTER_DRAIN) { E.fused(acc, cur, wr, wc, fr, fq, lds, wid, lane); S.done(cur); }
#undef PG8_SA
#undef PG8_SB
#undef PG8_STAGE
#undef PG8_LDA
#undef PG8_LDB
#undef PG8_MMA
#undef PG8_WAIT_V
#undef PG8_WAIT_L
#undef PG8_BAR
#undef PG8_SCHED
}
}

#ifndef MK_SINGLE
#define MK_SINGLE 1
#endif
constexpr int BATCH = 32, SEQ = 2048, DM = 1024, M = BATCH * SEQ;
constexpr int NIN = 3336, NPROJ = 3328;
constexpr int DFF = 2816, NUP = 2 * DFF;
constexpr int C_Q = 1792, C_K = 2048, C_V = 2304, C_O = 2816;
constexpr int NLORA = 1536, KLORA = 256;
constexpr int MH = M / 2;
constexpr float NORM_EPS = 1e-6f, LNX_EPS = 64e-5f;

constexpr size_t MiB = 1u << 20;
constexpr size_t WS_CTL = 0, CTL_ZERO_BYTES = 1 * MiB;
constexpr size_t WS_WT_IN = 2 * MiB, WS_WT_OUT = 9 * MiB, WS_WT_UP = 11 * MiB, WS_WT_DN = 22 * MiB, WS_WT_LORA = 28 * MiB;
constexpr size_t WS_RS2 = 29 * MiB, WS_RINV = 29 * MiB + 512 * 1024, WS_SSQP = 30 * MiB, WS_GATES = 34 * MiB;
constexpr size_t WS_XN = 40 * MiB;
constexpr size_t WS_PROJ = 168 * MiB;
constexpr size_t WS_LBUF = 584 * MiB;
constexpr size_t WS_DAG = 616 * MiB;
constexpr size_t WS_MIX = 808 * MiB;
constexpr size_t WS_SIDE = 168 * MiB;
constexpr int SIDE_ELEMS = 256 * 22 * 2 * 128;
constexpr size_t WS_FF = 192 * MiB;
constexpr size_t WS_GB = 520 * MiB;
constexpr size_t WS_END = 936 * MiB;

constexpr int LDS_BYTES = 163840;
constexpr int MISC_OFF = LDS_BYTES - 256;

#define GAS __attribute__((address_space(1)))
#define LAS __attribute__((address_space(3)))
typedef unsigned short bf16;
typedef unsigned v4u __attribute__((ext_vector_type(4)));
typedef unsigned v2u __attribute__((ext_vector_type(2)));
typedef float f32x4 __attribute__((ext_vector_type(4)));
typedef float f32x2 __attribute__((ext_vector_type(2)));
typedef short bf16x8 __attribute__((ext_vector_type(8)));
typedef GAS unsigned gu32;

typedef __bf16 bf16x2_t __attribute__((ext_vector_type(2)));
__device__ __forceinline__ unsigned pk2(float lo, float hi) { const f32x2 v = {lo, hi}; const bf16x2_t b = __builtin_convertvector(v, bf16x2_t); return __builtin_bit_cast(unsigned, b); }
__device__ __forceinline__ unsigned f2bf(float f) { return pk2(f, f) & 0xffffu; }
__device__ __forceinline__ float bf2f(unsigned short u) { return __builtin_bit_cast(float, (unsigned)u << 16); }
__device__ __forceinline__ float bflo(unsigned w) { return __builtin_bit_cast(float, w << 16); }
__device__ __forceinline__ float bfhi(unsigned w) { return __builtin_bit_cast(float, w & 0xffff0000u); }
__device__ __forceinline__ void unpack8(const v4u w, float (&o)[8]) { o[0] = bflo(w.x); o[1] = bfhi(w.x); o[2] = bflo(w.y); o[3] = bfhi(w.y); o[4] = bflo(w.z); o[5] = bfhi(w.z); o[6] = bflo(w.w); o[7] = bfhi(w.w); }
__device__ __forceinline__ v4u pack8(const float (&o)[8]) { v4u w; w.x = pk2(o[0], o[1]); w.y = pk2(o[2], o[3]); w.z = pk2(o[4], o[5]); w.w = pk2(o[6], o[7]); return w; }
__device__ __forceinline__ float frcp(float x) { return __builtin_amdgcn_rcpf(x); }
__device__ __forceinline__ float frsq(float x) { return __builtin_amdgcn_rsqf(x); }
__device__ __forceinline__ float fsqrt_(float x) { return __builtin_amdgcn_sqrtf(x); }
__device__ __forceinline__ float fexp(float x) { return __builtin_amdgcn_exp2f(x * 1.4426950408889634f); }
__device__ __forceinline__ float sigmoidf_(float x) { return frcp(1.0f + __builtin_amdgcn_exp2f(x * -1.4426950408889634f)); }
__device__ __forceinline__ float tanhf_(float x) { return 1.0f - 2.0f * frcp(__builtin_amdgcn_exp2f(x * 2.8853900817779268f) + 1.0f); }
__device__ __forceinline__ float softplusf_(float x) { return fmaxf(x, 0.f) + __logf(1.0f + fexp(-fabsf(x))); }
__device__ __forceinline__ float wave_sum(float v) {
#pragma unroll
    for (int o = 1; o < 64; o <<= 1) v += __shfl_xor(v, o);
    return v;
}
template <int CTRL> __device__ __forceinline__ float dppmov(float v) { return __builtin_bit_cast(float, __builtin_amdgcn_update_dpp(0, __builtin_bit_cast(int, v), CTRL, 0xF, 0xF, true)); }
__device__ __forceinline__ float red8(float v) { v += dppmov<0xB1>(v); v += dppmov<0x4E>(v); v += dppmov<0x141>(v); return v; }
__device__ __forceinline__ float red16(float v) { v += dppmov<0xB1>(v); v += dppmov<0x4E>(v); v += dppmov<0x141>(v); v += dppmov<0x140>(v); return v; }

template <int CTRL, int RMASK> __device__ __forceinline__ float dppsh(float idv, float v) { return __builtin_bit_cast(float, __builtin_amdgcn_update_dpp(__builtin_bit_cast(int, idv), __builtin_bit_cast(int, v), CTRL, RMASK, 0xF, false)); }
__device__ __forceinline__ float wave_scan_add(float v) {
    v += dppsh<0x111, 0xF>(0.f, v); v += dppsh<0x112, 0xF>(0.f, v); v += dppsh<0x114, 0xF>(0.f, v); v += dppsh<0x118, 0xF>(0.f, v);
    v += dppsh<0x142, 0xA>(0.f, v); v += dppsh<0x143, 0xC>(0.f, v); return v;
}
__device__ __forceinline__ float wave_scan_max(float v) {
    const float ni = -3.0e38f;
    v = fmaxf(v, dppsh<0x111, 0xF>(ni, v)); v = fmaxf(v, dppsh<0x112, 0xF>(ni, v)); v = fmaxf(v, dppsh<0x114, 0xF>(ni, v)); v = fmaxf(v, dppsh<0x118, 0xF>(ni, v));
    v = fmaxf(v, dppsh<0x142, 0xA>(ni, v)); v = fmaxf(v, dppsh<0x143, 0xC>(ni, v)); return v;
}

#define XB_TMO      128
#define XB_XCNT(j)  (256  + 64 * (j))
#define XB_XSUB(j)  (1280 + 64 * (j))
#define XB_XGEN(j)  (2304 + 64 * (j))
#define XB_TOP      3328
#define XB_TOPGEN   3392
#define XCD_BAR_WORDS 3456
#define XB_SPIN_CAP (1u << 22)
__device__ __forceinline__ unsigned xb_ld(unsigned* p)              { return __hip_atomic_load(p, __ATOMIC_RELAXED, __HIP_MEMORY_SCOPE_AGENT); }
__device__ __forceinline__ unsigned xb_add(unsigned* p, unsigned v) { return __hip_atomic_fetch_add(p, v, __ATOMIC_RELAXED, __HIP_MEMORY_SCOPE_AGENT); }
__device__ __forceinline__ unsigned xb_xcc_id() { return (unsigned)__builtin_amdgcn_s_getreg((3 << 11) | 20) & 0xFu; }
#define XB_SPIN(cond, bar) do { unsigned _sp = 0; while (cond) { __builtin_amdgcn_s_sleep(1); \
    if ((++_sp & 255u) == 0u) { if (xb_ld(&(bar)[XB_TMO])) break; if (_sp > XB_SPIN_CAP) { atomicAdd(&(bar)[XB_TMO], 1u); break; } } } } while (0)
struct XcdBarrier { unsigned* bar; unsigned x; volatile LAS unsigned* st; };
__device__ __forceinline__ XcdBarrier xcd_barrier_post(unsigned* bar, volatile LAS unsigned* st, bool leader) {
    XcdBarrier b; b.bar = bar; b.x = xb_xcc_id(); b.st = st;
    if (leader) (void)xb_add(&bar[XB_XCNT(b.x)], 1u);
    return b;
}
__device__ __forceinline__ void xcd_barrier_complete(unsigned* bar, unsigned x, unsigned& nloc, unsigned& nx) {
    const unsigned G = gridDim.x * gridDim.y * gridDim.z;
    unsigned sum, cnt, mine, sp = 0u;
    for (;;) {
        sum = 0u; cnt = 0u; mine = 0u;
#pragma unroll
        for (unsigned j = 0; j < 16; ++j) { const unsigned c = xb_ld(&bar[XB_XCNT(j)]); sum += c; cnt += (c > 0u) ? 1u : 0u; mine = (j == x) ? c : mine; }
        if (sum == G) break;
        __builtin_amdgcn_s_sleep(1);
        if ((++sp & 255u) == 0u) { if (xb_ld(&bar[XB_TMO])) break; if (sp > XB_SPIN_CAP) { atomicAdd(&bar[XB_TMO], 1u); break; } }
    }
    nloc = mine > 0u ? mine : 1u; nx = cnt > 0u ? cnt : 1u;
}
__device__ __forceinline__ void xcd_barrier(const XcdBarrier& b, bool leader) {
    asm volatile("s_waitcnt vmcnt(0)" ::: "memory");
    __syncthreads();
    if (leader) {
        unsigned* bar = b.bar;
        __builtin_amdgcn_s_waitcnt(0);
        unsigned nloc = b.st[0], nx = b.st[1];
        if (nloc == 0u) { xcd_barrier_complete(bar, b.x, nloc, nx); b.st[0] = nloc; b.st[1] = nx; }
        const unsigned old = xb_add(&bar[XB_XSUB(b.x)], 1u);
        const unsigned gen = old / nloc;
        if (old + 1u == (gen + 1u) * nloc) {
            __builtin_amdgcn_fence(__ATOMIC_RELEASE, "agent");
            asm volatile("s_waitcnt vmcnt(0)" ::: "memory");
            const unsigned og = xb_add(&bar[XB_TOP], 1u);
            const unsigned tg = og / nx;
            if (og + 1u == (tg + 1u) * nx) xb_add(&bar[XB_TOPGEN], 1u);
            else XB_SPIN(xb_ld(&bar[XB_TOPGEN]) == tg, bar);
            __builtin_amdgcn_fence(__ATOMIC_ACQUIRE, "agent");
            xb_add(&bar[XB_XGEN(b.x)], 1u);
            asm volatile("s_waitcnt vmcnt(0)" ::: "memory");
        } else {
            XB_SPIN(xb_ld(&bar[XB_XGEN(b.x)]) == gen, bar);
            __builtin_amdgcn_fence(__ATOMIC_ACQUIRE, "agent");
            asm volatile("s_waitcnt vmcnt(0)" ::: "memory");
        }
    }
    __syncthreads();
}

__device__ __forceinline__ int opaque_i(int v) { asm volatile("" : "+s"(v)); return v; }
#define LDS_BARRIER() do { asm volatile("s_waitcnt lgkmcnt(0)" ::: "memory"); __builtin_amdgcn_s_barrier(); asm volatile("" ::: "memory"); } while (0)
__device__ __forceinline__ int mk_lane_id() { int x; asm volatile("v_mbcnt_lo_u32_b32 %0, -1, 0\n\tv_mbcnt_hi_u32_b32 %0, -1, %0" : "=v"(x)); return x; }
struct Args { const float* in[26]; float* out; unsigned char* ws; int ph_lo, ph_hi; };

namespace pg8 {
struct PairPanelOrder {
    int c;
    __device__ bool next(int i, Unit& u) const { if (i >= 12) return false; u.pm = 2 * c + i / 6; u.pn = i % 6; return true; }
    __device__ __forceinline__ void a_ready(const Unit&) const {}
    __device__ __forceinline__ void done(const Unit&) const {}
};
struct PanelOrder {
    int c;
    __device__ bool next(int i, Unit& u) const { if (i >= 4) return false; u.pm = c; u.pn = i; return true; }
    __device__ __forceinline__ void a_ready(const Unit&) const {}
    __device__ __forceinline__ void done(const Unit&) const {}
};
struct EpiResid {
    static constexpr bool PERM = true, AFTER_DRAIN = false;
    bf16_t* XB; const float* rinv; float* ssqp;
    __device__ __forceinline__ void operator()(const f32x4 (&acc)[2][2][4][2], const Unit& u, int wr, int wc, int fr, int fq) const {
        const int row0 = u.pm * BM + wr * 64 + fr, col0 = u.pn * BM + wc * 32 + 8 * fq;
#pragma unroll
        for (int ai = 0; ai < 2; ++ai)
#pragma unroll
            for (int m = 0; m < 4; ++m) { const int row = row0 + ai * HALF + m * 16; float ss = 0.f; const float ri = rinv[row];
#pragma unroll
                for (int bj = 0; bj < 2; ++bj) { const size_t off = (size_t)row * DM + col0 + bj * HALF;
                    float xv[8]; unpack8(*(const u32x4*)(XB + off), xv);
                    float v[8];
#pragma unroll
                    for (int j = 0; j < 4; ++j) { v[j] = acc[ai][bj][m][0][j] + xv[j] * ri; v[4 + j] = acc[ai][bj][m][1][j] + xv[4 + j] * ri; }
#pragma unroll
                    for (int j = 0; j < 8; ++j) ss += v[j] * v[j];
                    *(u32x4*)(XB + off) = pack8(v); }
                ss += __shfl_xor(ss, 16); ss += __shfl_xor(ss, 32);
                if (fq == 0) ssqp[(size_t)row * 16 + u.pn * 4 + wc] = ss; }
    }
};
struct EpiScale {
    static constexpr bool PERM = true, AFTER_DRAIN = false;
    bf16_t* O; int ldc; const float* rs; int row_off;
    __device__ __forceinline__ void operator()(const f32x4 (&acc)[2][2][4][2], const Unit& u, int wr, int wc, int fr, int fq) const {
        const int row0 = u.pm * BM + wr * 64 + fr, col0 = u.pn * BM + wc * 32 + 8 * fq;
#pragma unroll
        for (int ai = 0; ai < 2; ++ai)
#pragma unroll
            for (int m = 0; m < 4; ++m) { const int row = row0 + ai * HALF + m * 16; const float s = rs[row_off + row]; bf16_t* rowp = O + (size_t)row * ldc + col0;
#pragma unroll
                for (int bj = 0; bj < 2; ++bj) { const f32x4 v0 = acc[ai][bj][m][0] * s, v1 = acc[ai][bj][m][1] * s;
                    u32x4 w; w.x = pk2(v0[0], v0[1]); w.y = pk2(v0[2], v0[3]); w.z = pk2(v1[0], v1[1]); w.w = pk2(v1[2], v1[3]); *(u32x4*)(rowp + bj * HALF) = w; } }
    }
};
struct EpiFfn {
    static constexpr bool PERM = true, AFTER_DRAIN = false;
    bf16_t* G; const float* rs; const float* cw; const float* cb; float* SA; float* SB; float* SL; LAS float* hal;
    __device__ __forceinline__ void operator()(const f32x4 (&acc)[2][2][4][2], const Unit& u, int wr, int wc, int fr, int fq) const {
        int chl = wc * 32 + 8 * fq; asm volatile("" : "+v"(chl));
        const int f0 = u.pn * 128 + chl, rowt = wr * 64 + fr;
        float rsv[2][4];
#pragma unroll
        for (int ai = 0; ai < 2; ++ai)
#pragma unroll
            for (int m = 0; m < 4; ++m) rsv[ai][m] = rs[u.pm * BM + ai * HALF + m * 16 + rowt];
        const size_t sbase = ((size_t)(u.pm * 22 + u.pn) * 2) * 128 + chl;
        if (fr >= 14) {
#pragma unroll
            for (int ai = 0; ai < 2; ++ai) { const float r_ = rsv[ai][3]; const f32x4 v0 = acc[ai][0][3][0] * r_, v1 = acc[ai][0][3][1] * r_;
                LAS float* hp = hal + ((ai * 2 + wr) * 2 + (fr - 14)) * 128 + chl; *(LAS f32x4*)hp = v0; *(LAS f32x4*)(hp + 4) = v1;
                if (ai == 1 && wr == 1) { float* gp = SL + sbase + (fr - 14) * 128; *(f32x4*)gp = v0; *(f32x4*)(gp + 4) = v1; } }
        }
        if (wr == 0 && fr < 2) { const float r_ = rsv[0][0]; float* ga = SA + sbase + fr * 128; float* gb = SB + sbase + fr * 128;
            *(f32x4*)ga = acc[0][0][0][0] * r_; *(f32x4*)(ga + 4) = acc[0][0][0][1] * r_; *(f32x4*)gb = acc[0][1][0][0] * r_; *(f32x4*)(gb + 4) = acc[0][1][0][1] * r_; }
        asm volatile("s_waitcnt lgkmcnt(0)" ::: "memory"); __builtin_amdgcn_s_barrier(); asm volatile("" ::: "memory");
        float w0[8], w1[8], w2[8], bz[8];
        { const f32x4 a0 = *(const f32x4*)(cw + f0), a1 = *(const f32x4*)(cw + f0 + 4), b0 = *(const f32x4*)(cw + DFF + f0), b1 = *(const f32x4*)(cw + DFF + f0 + 4);
          const f32x4 c0 = *(const f32x4*)(cw + 2 * DFF + f0), c1 = *(const f32x4*)(cw + 2 * DFF + f0 + 4), d0 = *(const f32x4*)(cb + f0), d1 = *(const f32x4*)(cb + f0 + 4);
#pragma unroll
          for (int j = 0; j < 4; ++j) { w0[j] = a0[j]; w0[4 + j] = a1[j]; w1[j] = b0[j]; w1[4 + j] = b1[j]; w2[j] = c0[j]; w2[4 + j] = c1[j]; bz[j] = d0[j]; bz[4 + j] = d1[j]; } }
        const bool fr0 = (fr == 0), frl2 = (fr < 2); (void)fr0;
#pragma unroll
        for (int ai = 0; ai < 2; ++ai) {
            float ap[8];
            const int pb = ai * 2 + wr - 1;
#pragma unroll
            for (int m = 0; m < 4; ++m) {
                float av[8], bv[8], y1[8], y2[8];
                const float r_ = rsv[ai][m];
#pragma unroll
                for (int j = 0; j < 4; ++j) { av[j] = acc[ai][0][m][0][j] * r_; av[4 + j] = acc[ai][0][m][1][j] * r_; bv[j] = acc[ai][1][m][0][j] * r_; bv[4 + j] = acc[ai][1][m][1][j] * r_; }
                if (m == 0) {
                    if (pb >= 0) { const LAS float* h0 = hal + (pb * 2) * 128 + chl; const f32x4 h00 = *(const LAS f32x4*)h0, h01 = *(const LAS f32x4*)(h0 + 4), h10 = *(const LAS f32x4*)(h0 + 128), h11 = *(const LAS f32x4*)(h0 + 132);
#pragma unroll
                        for (int j = 0; j < 4; ++j) { y1[j] = h10[j]; y1[4 + j] = h11[j]; y2[j] = fr0 ? h00[j] : h10[j]; y2[4 + j] = fr0 ? h01[j] : h11[j]; } }
                    else {
#pragma unroll
                        for (int j = 0; j < 8; ++j) { y1[j] = 0.f; y2[j] = 0.f; } }
                } else {
#pragma unroll
                    for (int j = 0; j < 8; ++j) { y1[j] = dppmov<0x121>(ap[j]); y2[j] = dppmov<0x122>(ap[j]); }
                }
                float o[8];
#pragma unroll
                for (int j = 0; j < 8; ++j) { const float am1 = dppsh<0x111, 0xF>(y1[j], av[j]), am2 = dppsh<0x112, 0xF>(y2[j], av[j]);
                    const float z = bz[j] + w0[j] * am2 + w1[j] * am1 + w2[j] * av[j];
                    o[j] = z * sigmoidf_(z) * bv[j]; ap[j] = av[j]; }
                if (!(ai == 0 && m == 0 && wr == 0 && frl2)) *(u32x4*)(G + (size_t)(u.pm * BM + ai * HALF + m * 16 + rowt) * DFF + f0) = pack8(o);
            }
        }
    }
};
}

template <bool FFN_UP = false>
__device__ __forceinline__ void transpose_item(const float* W, int ldw, int K, bf16* WT, const float* kscale, LAS float* scr, int item, int nblk, int lane) {
    const int kb = item / nblk, nb = item % nblk, k0 = 64 * kb, n0 = 32 * nb;
    const int d0 = !FFN_UP ? n0 : (n0 < DFF ? ((n0 >> 7) * 256 + (n0 & 127)) : ((((n0 - DFF) >> 7) * 256) + 128 + ((n0 - DFF) & 127)));
#pragma unroll 8
    for (int i = 0; i < 32; ++i) { const int kk = 2 * i + (lane >> 5); const float s = kscale ? kscale[k0 + kk] : 1.0f; scr[kk * 33 + (lane & 31)] = W[(size_t)(k0 + kk) * ldw + n0 + (lane & 31)] * s; }
    asm volatile("s_waitcnt lgkmcnt(0)" ::: "memory");
    const int c = lane & 7;
#pragma unroll
    for (int j = 0; j < 4; ++j) { const int n = (lane >> 3) + 8 * j; const LAS float* s = scr + (8 * c) * 33 + n;
        v4u o; o.x = pk2(s[0 * 33], s[1 * 33]); o.y = pk2(s[2 * 33], s[3 * 33]); o.z = pk2(s[4 * 33], s[5 * 33]); o.w = pk2(s[6 * 33], s[7 * 33]);
        *(v4u*)(WT + (size_t)(d0 + n) * K + k0 + 8 * c) = o; }
    asm volatile("s_waitcnt lgkmcnt(0)" ::: "memory");
}

__device__ __forceinline__ float wave_red63(float v) {
    v += dppmov<0xB1>(v); v += dppmov<0x4E>(v); v += dppmov<0x141>(v); v += dppmov<0x140>(v);
    v += dppsh<0x142, 0xA>(0.f, v); v += dppsh<0x143, 0xC>(0.f, v); return v;
}
__device__ __forceinline__ float lane63(float v) { return __builtin_bit_cast(float, __builtin_amdgcn_readlane(__builtin_bit_cast(int, v), 63)); }
__device__ __forceinline__ void late_transposes(const Args& a, LAS unsigned char* lds, int lane, int wave, int gw, int NGW) {
    unsigned char* ws = a.ws; LAS float* scr = (LAS float*)(lds + wave * 16384);
    constexpr int I_OUT = 16 * 32, I_UP = 16 * 176, I_DN = 44 * 32;
    for (int it = gw; it < I_OUT + I_UP + I_DN; it += NGW) {
        int r = it;
        if (r < I_OUT) { transpose_item(a.in[19], DM, DM, (bf16*)(ws + WS_WT_OUT), nullptr, scr, r, 32, lane); continue; } r -= I_OUT;
        if (r < I_UP) { transpose_item<true>(a.in[21], NUP, DM, (bf16*)(ws + WS_WT_UP), a.in[20], scr, r, 176, lane); continue; } r -= I_UP;
        transpose_item(a.in[24], DM, DFF, (bf16*)(ws + WS_WT_DN), nullptr, scr, r, 32, lane);
    }
}
__device__ __forceinline__ void phase_prep(const Args& a, LAS unsigned char* lds, int tid, int lane, int wave) {
    unsigned char* ws = a.ws;
    LAS float* scr = (LAS float*)(lds + wave * 16384);
    const int gw = blockIdx.x * 8 + wave, NGW = gridDim.x * 8;
    constexpr int I_IN = 16 * 104;
    for (int it = gw; it < I_IN; it += NGW) transpose_item(a.in[2], NIN, DM, (bf16*)(ws + WS_WT_IN), a.in[1], scr, it, 104, lane);
    {
        const float* wd = a.in[5]; const float* wa = a.in[7]; const float* wg = a.in[8]; bf16* WL = (bf16*)(ws + WS_WT_LORA);
        for (int idx = blockIdx.x * 512 + tid; idx < NLORA * KLORA; idx += gridDim.x * 512) {
            const int n = idx >> 8, k = idx & 255; float v = 0.f;
            if (n < 512) { if (k < 64) v = wd[k * 512 + n]; }
            else if (n < 1024) { if (k >= 64 && k < 128) v = wa[(k - 64) * 512 + (n - 512)]; }
            else { if (k >= 128) v = wg[(k - 128) * 512 + (n - 1024)]; }
            WL[idx] = (bf16)f2bf(v);
        }
    }
    {
        const float* x = a.in[0]; const float* g1 = a.in[1]; const float* w_in = a.in[2];
        bf16* XN = (bf16*)(ws + WS_XN); float* gates = (float*)(ws + WS_GATES); float* rinvp = (float*)(ws + WS_RINV);
        float wgt[16][8];
#pragma unroll
        for (int j = 0; j < 4; ++j)
#pragma unroll
            for (int e = 0; e < 4; ++e) { const int k = 4 * lane + 256 * j + e; const float g = g1[k];
                const f32x4 w0 = *(const f32x4*)(w_in + (size_t)k * NIN + 3328), w1 = *(const f32x4*)(w_in + (size_t)k * NIN + 3332);
                wgt[j * 4 + e][0] = w0[0] * g; wgt[j * 4 + e][1] = w0[1] * g; wgt[j * 4 + e][2] = w0[2] * g; wgt[j * 4 + e][3] = w0[3] * g;
                wgt[j * 4 + e][4] = w1[0] * g; wgt[j * 4 + e][5] = w1[1] * g; wgt[j * 4 + e][6] = w1[2] * g; wgt[j * 4 + e][7] = w1[3] * g; }
        f32x4 vn[4];
        { const f32x4* xr = (const f32x4*)(x + (size_t)gw * DM) + lane;
#pragma unroll
          for (int j = 0; j < 4; ++j) vn[j] = xr[64 * j]; }
        for (int row = gw; row < M; row += NGW) {
            f32x4 v[4];
#pragma unroll
            for (int j = 0; j < 4; ++j) v[j] = vn[j];
            { const int rn = (row + NGW < M) ? row + NGW : row; const f32x4* xr = (const f32x4*)(x + (size_t)rn * DM) + lane;
#pragma unroll
              for (int j = 0; j < 4; ++j) vn[j] = xr[64 * j]; }
            float ss = 0.f;
#pragma unroll
            for (int j = 0; j < 4; ++j) ss += (v[j][0] * v[j][0] + v[j][1] * v[j][1]) + (v[j][2] * v[j][2] + v[j][3] * v[j][3]);
            float gs[8];
#pragma unroll
            for (int jg = 0; jg < 8; ++jg) { float s_ = 0.f;
#pragma unroll
                for (int j = 0; j < 4; ++j)
#pragma unroll
                    for (int e = 0; e < 4; ++e) s_ += v[j][e] * wgt[j * 4 + e][jg];
                gs[jg] = s_; }
            ss = wave_red63(ss);
#pragma unroll
            for (int jg = 0; jg < 8; ++jg) gs[jg] = wave_red63(gs[jg]);
            const float ms = lane63(ss) * (1.0f / DM) + NORM_EPS; const float rs = frsq(ms);
            if (lane == 0) rinvp[row] = fsqrt_(ms);
            unsigned long long* o8 = (unsigned long long*)(XN + (size_t)row * DM) + lane;
#pragma unroll
            for (int j = 0; j < 4; ++j) o8[64 * j] = (unsigned long long)pk2(v[j][0] * rs, v[j][1] * rs) | ((unsigned long long)pk2(v[j][2] * rs, v[j][3] * rs) << 32);
            if (lane == 63) { f32x4* gp = (f32x4*)(gates + (size_t)row * 8); gp[0] = (f32x4){gs[0] * rs, gs[1] * rs, gs[2] * rs, gs[3] * rs}; gp[1] = (f32x4){gs[4] * rs, gs[5] * rs, gs[6] * rs, gs[7] * rs}; }
        }
    }
}

__device__ __forceinline__ void phase_lmat(const Args& a, int tid, int row_lo, int nrows) {
    unsigned char* ws = a.ws; const bf16* PROJ = (const bf16*)(ws + WS_PROJ); bf16* L = (bf16*)(ws + WS_LBUF); const float* mu = a.in[3];
    for (int it = tid; it < nrows * 32; it += 512) {
        const int row = row_lo + (it >> 5), grp = it & 31, c0 = 1536 + 8 * grp;
        const v4u cur = *(const v4u*)(PROJ + (size_t)row * NPROJ + c0);
        v4u prv = {0u, 0u, 0u, 0u}; if ((row & (SEQ - 1)) != 0) prv = *(const v4u*)(PROJ + (size_t)(row - 1) * NPROJ + c0);
        const f32x4 m0 = *(const f32x4*)(mu + c0), m1 = *(const f32x4*)(mu + c0 + 4);
        float c[8], p[8], o[8]; unpack8(cur, c); unpack8(prv, p);
#pragma unroll
        for (int e = 0; e < 8; ++e) { const float mm = e < 4 ? m0[e & 3] : m1[e & 3]; const float xv = c[e] + (p[e] - c[e]) * mm;
            o[e] = grp < 8 ? tanhf_(xv) : (grp < 16 ? xv : sigmoidf_(xv)); }
        *(v4u*)(L + (size_t)row * KLORA + 8 * grp) = pack8(o);
    }
}

constexpr int RK_SLOT = 64 * 64;
__device__ __forceinline__ int rk_off(int row, int col) { return row * 64 + ((((col >> 3) ^ row) & 7) << 3) + (col & 7); }
__device__ __forceinline__ f32x4 mfma16(const bf16x8 a, const bf16x8 b, const f32x4 c) { return __builtin_amdgcn_mfma_f32_16x16x32_bf16(a, b, c, 0, 0, 0); }
__device__ __forceinline__ void rk_frag(bf16x8 (&f)[2], const LAS bf16* base, int row0, int l15, int l4) { const LAS bf16* p = base + (row0 + l15) * 64; f[0] = *(const LAS bf16x8*)(p + ((l4 ^ (l15 & 7)) << 3)); f[1] = *(const LAS bf16x8*)(p + (((4 + l4) ^ (l15 & 7)) << 3)); }
template <bool ACC> __device__ __forceinline__ void rk_prod(f32x4 (&acc)[2], const LAS bf16* Aop, const LAS bf16* Bop, int mb, int nb0, int l15, int l4) {
    bf16x8 a[2]; rk_frag(a, Aop, 16 * mb, l15, l4);
#pragma unroll
    for (int q = 0; q < 2; ++q) { bf16x8 b[2]; rk_frag(b, Bop, 16 * (nb0 + q), l15, l4); f32x4 c = ACC ? acc[q] : (f32x4){0.f, 0.f, 0.f, 0.f}; c = mfma16(a[0], b[0], c); acc[q] = mfma16(a[1], b[1], c); }
}
struct RkA { bf16x8 f[2]; };
struct RkB { bf16x8 f[2][2]; };
__device__ __forceinline__ RkA rk_lda(const LAS bf16* base, int mb, int l15, int l4) { RkA r; rk_frag(r.f, base, 16 * mb, l15, l4); return r; }
__device__ __forceinline__ RkB rk_ldb(const LAS bf16* base, int nb0, int l15, int l4) { RkB r; rk_frag(r.f[0], base, 16 * nb0, l15, l4); rk_frag(r.f[1], base, 16 * (nb0 + 1), l15, l4); return r; }
template <bool ACC> __device__ __forceinline__ void rk_mm(f32x4 (&acc)[2], const RkA& a, const RkB& b) {
#pragma unroll
    for (int q = 0; q < 2; ++q) { f32x4 c = ACC ? acc[q] : (f32x4){0.f, 0.f, 0.f, 0.f}; c = mfma16(a.f[0], b.f[q][0], c); acc[q] = mfma16(a.f[1], b.f[q][1], c); }
}
__device__ __forceinline__ void rk_store(LAS bf16* dst, const f32x4 (&acc)[2], int mb, int nb0, int l15, int l4) {
#pragma unroll
    for (int q = 0; q < 2; ++q) { v2u w; w.x = pk2(acc[q][0], acc[q][1]); w.y = pk2(acc[q][2], acc[q][3]); *(LAS v2u*)(dst + rk_off(16 * (nb0 + q) + l15, 16 * mb + 4 * l4)) = w; }
}
__device__ __forceinline__ void rwkv_unit(const Args& a, LAS unsigned char* lds, int unit, int tid, int lane, int wave) {
    unsigned char* ws = a.ws; const bf16* PROJ = (const bf16*)(ws + WS_PROJ); const bf16* DAG = (const bf16*)(ws + WS_DAG); bf16* MIX = (bf16*)(ws + WS_MIX);
    const int b = unit >> 3, h = unit & 7;
    LAS bf16* slot = (LAS bf16*)lds;
#define RK_S(k) (slot + (k) * RK_SLOT)
    LAS bf16* Ab = RK_S(0); LAS bf16* Ut = RK_S(0); LAS bf16* Bb = RK_S(1); LAS bf16* Kb = RK_S(2); LAS bf16* Rb = RK_S(3); LAS bf16* KhT = RK_S(4); LAS float* Yl = (LAS float*)RK_S(3);
    LAS bf16* BhT = RK_S(5); LAS bf16* Vt = RK_S(6); LAS bf16* P0 = RK_S(7); LAS bf16* P0T = RK_S(8); LAS bf16* Aak = RK_S(9); LAS bf16* Arb = RK_S(10); LAS bf16* Ark = RK_S(11);
    LAS bf16* TA = RK_S(12); LAS bf16* TB = RK_S(13); LAS bf16* Xt = RK_S(14); LAS bf16* Sb = RK_S(15);
    LAS float* g63 = (LAS float*)RK_S(16); LAS float* bon = g63 + 64; LAS float* ssP = bon + 64; LAS float* bnP = ssP + 512; LAS float* cst = bnP + 512;
    const int l15 = lane & 15, l4 = lane >> 4, mb = wave & 3, nb0 = 2 * (wave >> 2);
    const int tt = tid >> 3, c8 = tid & 7;
    const int jw = 8 * wave;
    for (int i = tid; i < 640; i += 512) { const int k = i >> 6, c_ = i & 63, j = h * 64 + c_;
        const float* src = k == 0 ? a.in[3] + j : k == 1 ? a.in[3] + 512 + j : k == 2 ? a.in[3] + 1024 + j : k == 3 ? a.in[9] + j : k == 4 ? a.in[10] + j : k == 5 ? a.in[11] + j : k == 6 ? a.in[4] + j : k == 7 ? a.in[6] + j : k == 8 ? a.in[12] + j : a.in[13] + j;
        cst[i] = *src; }
    for (int i = tid; i < RK_SLOT / 2; i += 512) ((LAS unsigned*)Sb)[i] = 0u;
    f32x4 sacc[2], tacc[2], yacc[2];
    sacc[0] = (f32x4){0.f, 0.f, 0.f, 0.f}; sacc[1] = sacc[0];
    v4u g_rc, g_kc, g_vc, g_rp, g_kp, g_vp, g_ld, g_a, g_g;
    v4u pend = {0u, 0u, 0u, 0u}; bf16* pend_p = MIX;
#define RK_LOADCHUNK(c_) do { const int t_ = b * SEQ + (c_) * 64 + lane; const bf16* pr_ = PROJ + (size_t)t_ * NPROJ + h * 64 + jw; \
        g_rc = *(const v4u*)pr_; g_kc = *(const v4u*)(pr_ + 512); g_vc = *(const v4u*)(pr_ + 1024); \
        if ((c_) == 0 && lane == 0) { g_rp = (v4u){0u, 0u, 0u, 0u}; g_kp = g_rp; g_vp = g_rp; } \
        else { g_rp = *(const v4u*)(pr_ - NPROJ); g_kp = *(const v4u*)(pr_ - NPROJ + 512); g_vp = *(const v4u*)(pr_ - NPROJ + 1024); } \
        const bf16* dg_ = DAG + (size_t)t_ * NLORA + h * 64 + jw; g_ld = *(const v4u*)dg_; g_a = *(const v4u*)(dg_ + 512); \
        g_g = *(const v4u*)(DAG + (size_t)(b * SEQ + (c_) * 64 + tt) * NLORA + 1024 + h * 64 + 8 * c8); } while (0)
    RK_LOADCHUNK(0);
    LDS_BARRIER();
    for (int c = 0; c < SEQ / 64; ++c) {
        const int t0 = b * SEQ + c * 64;
        float rr[8], km[8], vv[8], av[8], lgw[8], kkr[8];
        asm volatile("" : "+v"(g_rc), "+v"(g_kc), "+v"(g_vc), "+v"(g_rp), "+v"(g_kp), "+v"(g_vp), "+v"(g_ld), "+v"(g_a), "+v"(g_g));
        {
            float rc[8], kc[8], vc[8], rp_[8], kp[8], vp[8], ldv[8];
            unpack8(g_rc, rc); unpack8(g_kc, kc); unpack8(g_vc, vc); unpack8(g_rp, rp_); unpack8(g_kp, kp); unpack8(g_vp, vp); unpack8(g_ld, ldv); unpack8(g_a, av);
            float ss = 0.f, bonus = 0.f;
#pragma unroll
            for (int e = 0; e < 8; ++e) { const int j = jw + e;
                rr[e] = rc[e] + (rp_[e] - rc[e]) * cst[j]; const float k = kc[e] + (kp[e] - kc[e]) * cst[64 + j]; vv[e] = vc[e] + (vp[e] - vc[e]) * cst[128 + j];
                kkr[e] = k * cst[192 + j]; ss += kkr[e] * kkr[e];
                av[e] = sigmoidf_(cst[448 + j] + av[e]);
                lgw[e] = -0.6065306597f * sigmoidf_(cst[384 + j] + ldv[e]);
                km[e] = k * (1.0f + (av[e] - 1.0f) * cst[256 + j]);
                bonus += rr[e] * km[e] * cst[320 + j]; }
            ssP[lane * 8 + wave] = ss; bnP[lane * 8 + wave] = bonus;
        }
        const v4u gcur = g_g;
        LDS_BARRIER();
        {
            const f32x4 s0 = *(const LAS f32x4*)(ssP + lane * 8), s1 = *(const LAS f32x4*)(ssP + lane * 8 + 4), b0 = *(const LAS f32x4*)(bnP + lane * 8), b1 = *(const LAS f32x4*)(bnP + lane * 8 + 4);
            const float ss = ((s0[0] + s0[1]) + (s0[2] + s0[3])) + ((s1[0] + s1[1]) + (s1[2] + s1[3]));
            if (wave == 0) bon[lane] = ((b0[0] + b0[1]) + (b0[2] + b0[3])) + ((b1[0] + b1[1]) + (b1[2] + b1[3]));
            const float inv = frcp(fmaxf(fsqrt_(ss), 1e-12f));
            float oA[8], oB[8], oK[8], oR[8], oBh[8], oKh[8], lw[8], e63[8];
#pragma unroll
            for (int e = 0; e < 8; ++e) lw[e] = wave_scan_add(lgw[e]);
#pragma unroll
            for (int e = 0; e < 8; ++e) { const float l63 = __builtin_bit_cast(float, __builtin_amdgcn_readlane(__builtin_bit_cast(int, lw[e]), 63));
                const float eP = fexp(lw[e] - lgw[e]), eM = fexp(-lw[e]), eL = fexp(lw[e]); e63[e] = fexp(l63); const float eH = e63[e] * eM;
                const float kk = kkr[e] * inv, bb = kk * av[e];
                oA[e] = -kk * eP; oB[e] = bb * eM; oK[e] = km[e] * eM; oR[e] = rr[e] * eL; oBh[e] = bb * eH; oKh[e] = km[e] * eH; }
            if (lane == 63) { *(LAS f32x4*)(g63 + jw) = (f32x4){e63[0], e63[1], e63[2], e63[3]}; *(LAS f32x4*)(g63 + jw + 4) = (f32x4){e63[4], e63[5], e63[6], e63[7]}; }
            { const int ro = rk_off(lane, jw); *(LAS v4u*)(Ab + ro) = pack8(oA); *(LAS v4u*)(Bb + ro) = pack8(oB); *(LAS v4u*)(Kb + ro) = pack8(oK); *(LAS v4u*)(Rb + ro) = pack8(oR); }
#pragma unroll
            for (int e = 0; e < 8; ++e) { const int to = rk_off(jw + e, lane); BhT[to] = (bf16)f2bf(oBh[e]); KhT[to] = (bf16)f2bf(oKh[e]); Vt[to] = (bf16)f2bf(vv[e]); }
            if (c > 0) *(v4u*)pend_p = pend;
            if (c + 1 < SEQ / 64) RK_LOADCHUNK(c + 1);
        }
        LDS_BARRIER();
        {
            f32x4 d[2];
#define RK_MASK_LT(D_, MISS_) _Pragma("unroll") for (int q = 0; q < 2; ++q) { const int nb_ = nb0 + q; \
                if (MISS_ ? (mb < nb_) : (mb > nb_)) D_[q] = (f32x4){0.f, 0.f, 0.f, 0.f}; \
                else if (mb == nb_) { _Pragma("unroll") for (int r = 0; r < 4; ++r) { const int m_ = 4 * l4 + r; D_[q][r] = (MISS_ ? (l15 < m_) : (m_ < l15)) ? D_[q][r] : 0.f; } } }
#define RK_MASK_LE(D_) _Pragma("unroll") for (int q = 0; q < 2; ++q) { const int nb_ = nb0 + q; \
                if (mb > nb_) D_[q] = (f32x4){0.f, 0.f, 0.f, 0.f}; \
                else if (mb == nb_) { _Pragma("unroll") for (int r = 0; r < 4; ++r) { const int m_ = 4 * l4 + r; D_[q][r] = (m_ <= l15) ? D_[q][r] : 0.f; } } }
            const RkA aB = rk_lda(Bb, mb, l15, l4), aA = rk_lda(Ab, mb, l15, l4), aK = rk_lda(Kb, mb, l15, l4);
            const RkB bA = rk_ldb(Ab, nb0, l15, l4), bB = rk_ldb(Bb, nb0, l15, l4), bR = rk_ldb(Rb, nb0, l15, l4);
            f32x4 d2[2], d3[2], d4[2], d5[2];
            rk_mm<false>(d, aB, bA);
            rk_mm<false>(d2, aA, bB);
            rk_mm<false>(d3, aK, bA);
            rk_mm<false>(d4, aB, bR);
            rk_mm<false>(d5, aK, bR);
            RK_MASK_LT(d, false);
#pragma unroll
            for (int q = 0; q < 2; ++q)
#pragma unroll
                for (int r = 0; r < 4; ++r) tacc[q][r] = d[q][r] + ((mb == nb0 + q && 4 * l4 + r == l15) ? 1.f : 0.f);
            RK_MASK_LT(d2, true); RK_MASK_LT(d3, false); RK_MASK_LE(d4); RK_MASK_LE(d5);
            rk_store(P0, d, mb, nb0, l15, l4); rk_store(TA, tacc, mb, nb0, l15, l4); rk_store(P0T, d2, mb, nb0, l15, l4); rk_store(Aak, d3, mb, nb0, l15, l4); rk_store(Arb, d4, mb, nb0, l15, l4); rk_store(Ark, d5, mb, nb0, l15, l4);
        }
        LDS_BARRIER();
        {
            const RkA aPT = rk_lda(P0T, mb, l15, l4), aP = rk_lda(P0, mb, l15, l4), aA = rk_lda(Ab, mb, l15, l4), aAk = rk_lda(Aak, mb, l15, l4);
            const RkB bP = rk_ldb(P0, nb0, l15, l4), bPT = rk_ldb(P0T, nb0, l15, l4), bS = rk_ldb(Sb, nb0, l15, l4), bV = rk_ldb(Vt, nb0, l15, l4);
            f32x4 d[2], d2[2], d3[2];
            rk_mm<false>(d, aPT, bP); rk_mm<false>(d2, aP, bPT); rk_mm<false>(d3, aA, bS); rk_mm<true>(d3, aAk, bV);
            const RkA aS = rk_lda(Sb, mb, l15, l4), aV = rk_lda(Vt, mb, l15, l4), aKh = rk_lda(KhT, mb, l15, l4);
            const RkB bR = rk_ldb(Rb, nb0, l15, l4), bArk = rk_ldb(Ark, nb0, l15, l4);
            rk_mm<false>(yacc, aS, bR); rk_mm<true>(yacc, aV, bArk);
#pragma unroll
            for (int r = 0; r < 4; ++r) { const float g_ = g63[16 * mb + 4 * l4 + r]; sacc[0][r] *= g_; sacc[1][r] *= g_; }
            rk_mm<true>(sacc, aKh, bV);
            rk_store(Bb  , d, mb, nb0, l15, l4); rk_store(Kb  , d2, mb, nb0, l15, l4); rk_store(Xt, d3, mb, nb0, l15, l4);
        }
        LDS_BARRIER();
#define RK_DOUBLE(PK, PKT, TIN, TOUT, PN, PNT) { const RkA aPT = rk_lda(PKT, mb, l15, l4), aP = rk_lda(PK, mb, l15, l4); \
          const RkB bT = rk_ldb(TIN, nb0, l15, l4), bP = rk_ldb(PK, nb0, l15, l4), bPT = rk_ldb(PKT, nb0, l15, l4); \
          f32x4 d[2], d2[2]; rk_mm<true>(tacc, aPT, bT); rk_mm<false>(d, aPT, bP); rk_mm<false>(d2, aP, bPT); \
          rk_store(TOUT, tacc, mb, nb0, l15, l4); rk_store(PN, d, mb, nb0, l15, l4); rk_store(PNT, d2, mb, nb0, l15, l4); }
        RK_DOUBLE(Bb, Kb, TA, TB, P0, P0T)
        LDS_BARRIER();
        RK_DOUBLE(P0, P0T, TB, TA, Bb, Kb)
        LDS_BARRIER();
        RK_DOUBLE(Bb, Kb, TA, TB, P0, P0T)
        LDS_BARRIER();
        { const RkA aPT = rk_lda(P0T, mb, l15, l4), aP = rk_lda(P0, mb, l15, l4); const RkB bT = rk_ldb(TB, nb0, l15, l4), bPT = rk_ldb(P0T, nb0, l15, l4);
          f32x4 d2[2]; rk_mm<true>(tacc, aPT, bT); rk_mm<false>(d2, aP, bPT); rk_store(TA, tacc, mb, nb0, l15, l4); rk_store(Kb  , d2, mb, nb0, l15, l4); }
        LDS_BARRIER();
        { const RkA aPT = rk_lda(Kb, mb, l15, l4); const RkB bT = rk_ldb(TA, nb0, l15, l4); rk_mm<true>(tacc, aPT, bT); rk_store(TB, tacc, mb, nb0, l15, l4); }
        LDS_BARRIER();
#ifdef PROBE
        const unsigned long long tk2 = __builtin_amdgcn_s_memtime();
#endif
        { const RkA aT = rk_lda(TB, mb, l15, l4); const RkB bX = rk_ldb(Xt, nb0, l15, l4); f32x4 d[2]; rk_mm<false>(d, aT, bX); rk_store(Ut, d, mb, nb0, l15, l4); }
        LDS_BARRIER();
        {
            const RkA aU = rk_lda(Ut, mb, l15, l4), aBh = rk_lda(BhT, mb, l15, l4); const RkB bArb = rk_ldb(Arb, nb0, l15, l4), bU = rk_ldb(Ut, nb0, l15, l4);
            rk_mm<true>(yacc, aU, bArb); rk_mm<true>(sacc, aBh, bU);
#pragma unroll
            for (int q = 0; q < 2; ++q) *(LAS f32x4*)(Yl + (16 * (nb0 + q) + l15) * 64 + (((4 * mb + l4) ^ (l15 & 7)) << 2)) = yacc[q];
            rk_store(Sb, sacc, mb, nb0, l15, l4);
        }
        LDS_BARRIER();
        {
            const int t = t0 + tt, j0 = 8 * c8;
            const f32x4 y0 = *(const LAS f32x4*)(Yl + tt * 64 + (((2 * c8) ^ (tt & 7)) << 2)), y1 = *(const LAS f32x4*)(Yl + tt * 64 + (((2 * c8 + 1) ^ (tt & 7)) << 2));
            float y[8] = {y0[0], y0[1], y0[2], y0[3], y1[0], y1[1], y1[2], y1[3]}, gv[8]; float s1 = 0.f;
#pragma unroll
            for (int e = 0; e < 8; ++e) s1 += y[e];
            s1 = red8(s1); const float mean = s1 * (1.0f / 64.0f); float s2 = 0.f;
#pragma unroll
            for (int e = 0; e < 8; ++e) { const float dd = y[e] - mean; s2 += dd * dd; }
            s2 = red8(s2); const float rstd = frsq(s2 * (1.0f / 64.0f) + LNX_EPS);
            unpack8(gcur, gv);
            const float bonus = bon[tt]; float ov[8];
#pragma unroll
            for (int e = 0; e < 8; ++e) { const float yn = (y[e] - mean) * rstd * cst[512 + j0 + e] + cst[576 + j0 + e]; ov[e] = (yn + bonus * bf2f(Vt[rk_off(j0 + e, tt)])) * gv[e]; }
            pend = pack8(ov); pend_p = MIX + (size_t)t * DM + h * 64 + j0;
        }
        LDS_BARRIER();
    }
    *(v4u*)pend_p = pend;
#undef RK_S
#undef RK_LOADCHUNK
}

struct RkF2 { bf16x8 f[2][2]; };
struct RkLane { int lo, so, l15, l4; };
__device__ __forceinline__ RkLane rk_lane(int lane) { asm volatile("" : "+v"(lane)); const int l15 = lane & 15, l4 = lane >> 4; RkLane r; r.l15 = l15; r.l4 = l4; r.lo = l15 * 64 + ((l4 ^ (l15 & 7)) << 3); r.so = l15 * 64 + ((((l4 >> 1) ^ (l15 & 7))) << 3) + 4 * (l4 & 1); return r; }
__device__ __forceinline__ RkF2 rk_ld2(const LAS bf16* base, int blk, const RkLane& L) { RkF2 r;
#pragma unroll
    for (int ti = 0; ti < 2; ++ti) { const int i0 = (32 * blk + 16 * ti) * 64 + L.lo; r.f[ti][0] = *(const LAS bf16x8*)(base + i0); r.f[ti][1] = *(const LAS bf16x8*)(base + (i0 ^ 32)); }
    return r; }
template <bool ACC> __device__ __forceinline__ void rk_mm2(f32x4 (&acc)[2][2], const RkF2& a, const RkF2& b) {
#pragma unroll
    for (int mi = 0; mi < 2; ++mi)
#pragma unroll
        for (int ni = 0; ni < 2; ++ni) { f32x4 c = ACC ? acc[mi][ni] : (f32x4){0.f, 0.f, 0.f, 0.f}; c = mfma16(a.f[mi][0], b.f[ni][0], c); acc[mi][ni] = mfma16(a.f[mi][1], b.f[ni][1], c); }
}
__device__ __forceinline__ void rk_store2(LAS bf16* dst, const f32x4 (&acc)[2][2], int mB, int nB, const RkLane& L) {
#pragma unroll
    for (int mi = 0; mi < 2; ++mi)
#pragma unroll
        for (int ni = 0; ni < 2; ++ni) { v2u w; w.x = pk2(acc[mi][ni][0], acc[mi][ni][1]); w.y = pk2(acc[mi][ni][2], acc[mi][ni][3]); *(LAS v2u*)(dst + (16 * (2 * nB + ni)) * 64 + (L.so ^ (16 * (2 * mB + mi)))) = w; }
}
template <int MODE> __device__ __forceinline__ void rk_mask2(f32x4 (&d)[2][2], int mB, int nB, int l15, int l4) {
#pragma unroll
    for (int mi = 0; mi < 2; ++mi)
#pragma unroll
        for (int ni = 0; ni < 2; ++ni) { const int mt = 2 * mB + mi, nt = 2 * nB + ni;
            const bool zero = MODE == 1 ? (mt < nt) : (mt > nt);
            if (zero) d[mi][ni] = (f32x4){0.f, 0.f, 0.f, 0.f};
            else if (mt == nt) {
#pragma unroll
                for (int r = 0; r < 4; ++r) { const int m_ = 4 * l4 + r; const bool keep = MODE == 0 ? (m_ < l15) : MODE == 1 ? (l15 < m_) : (m_ <= l15); d[mi][ni][r] = keep ? d[mi][ni][r] : 0.f; } } }
}
__device__ __forceinline__ void rwkv_unit_split(const Args& a, LAS unsigned char* lds, int unit, int tid, int lane, int wave) {
    unsigned char* ws = a.ws; const bf16* PROJ = (const bf16*)(ws + WS_PROJ); const bf16* DAG = (const bf16*)(ws + WS_DAG); bf16* MIX = (bf16*)(ws + WS_MIX);
    const int b = unit >> 3, h = unit & 7;
    LAS bf16* slot = (LAS bf16*)lds;
#define RK_S(k) (slot + (k) * RK_SLOT)
    LAS bf16* Ab = RK_S(0); LAS bf16* Bb = RK_S(1); LAS bf16* Kb = RK_S(2); LAS bf16* Rb = RK_S(3); LAS bf16* KhT = RK_S(4);
    LAS bf16* P0 = RK_S(7); LAS bf16* P0T = RK_S(8); LAS float* Yl = (LAS float*)RK_S(7);
    LAS bf16* Aak = RK_S(9); LAS bf16* Ut = RK_S(9); LAS bf16* Arb = RK_S(10); LAS bf16* Ark = RK_S(11); LAS bf16* TA = RK_S(12); LAS bf16* TB = RK_S(13); LAS bf16* Xt = RK_S(14); LAS bf16* Sb = RK_S(15);
    LAS float* g63 = (LAS float*)RK_S(18); LAS float* bon = g63 + 128; LAS float* ssP = bon + 128; LAS float* bnP = ssP + 256; LAS float* cst = bnP + 256;
    const int wq = wave & 3;
    { int t_ = tid; asm volatile("" : "+v"(t_));
      if (t_ < 64) { const int j = h * 64 + t_;
        cst[t_] = a.in[3][j]; cst[64 + t_] = a.in[3][512 + j]; cst[128 + t_] = a.in[3][1024 + j]; cst[192 + t_] = a.in[9][j]; cst[256 + t_] = a.in[10][j];
        cst[320 + t_] = a.in[11][j]; cst[384 + t_] = a.in[4][j]; cst[448 + t_] = a.in[6][j]; cst[512 + t_] = a.in[12][j]; cst[576 + t_] = a.in[13][j]; }
      for (int i = t_; i < RK_SLOT / 2; i += 512) ((LAS unsigned*)Sb)[i] = 0u; }
    if (wave < 4) {
        const int jw = 16 * wq;
        v4u g_rc[2], g_kc[2], g_vc[2], g_rp[2], g_kp[2], g_vp[2], g_ld[2], g_a[2];
#define RKS_LOAD(c_) do { int ln_ = lane; asm volatile("" : "+v"(ln_)); const int t_ = b * SEQ + (c_) * 64 + ln_; const bf16* pr_ = PROJ + (size_t)t_ * NPROJ + h * 64 + jw; const bf16* dg_ = DAG + (size_t)t_ * NLORA + h * 64 + jw; \
        _Pragma("unroll") for (int hh = 0; hh < 2; ++hh) { g_rc[hh] = *(const v4u*)(pr_ + 8 * hh); g_kc[hh] = *(const v4u*)(pr_ + 512 + 8 * hh); g_vc[hh] = *(const v4u*)(pr_ + 1024 + 8 * hh); \
            if ((c_) == 0 && ln_ == 0) { g_rp[hh] = (v4u){0u, 0u, 0u, 0u}; g_kp[hh] = g_rp[hh]; g_vp[hh] = g_rp[hh]; } \
            else { g_rp[hh] = *(const v4u*)(pr_ - NPROJ + 8 * hh); g_kp[hh] = *(const v4u*)(pr_ - NPROJ + 512 + 8 * hh); g_vp[hh] = *(const v4u*)(pr_ - NPROJ + 1024 + 8 * hh); } \
            g_ld[hh] = *(const v4u*)(dg_ + 8 * hh); g_a[hh] = *(const v4u*)(dg_ + 512 + 8 * hh); } } while (0)
        RKS_LOAD(0);
        LDS_BARRIER();
        for (int it = 0; it <= SEQ / 64; ++it) {
            const bool act = it < SEQ / 64; const int p = it & 1;
            LAS bf16* BhTp = RK_S(5 + 11 * p); LAS bf16* Vtp = RK_S(6 + 11 * p);
            float rr[2][8], km[2][8], av[2][8], lgw[2][8], kkr[2][8];
            v4u pA[2], pR[2], pB[2], pK[2], pKh[2];
            LDS_BARRIER();
            if (act) {
                int ln = lane; asm volatile("" : "+v"(ln));
                asm volatile("" : "+v"(g_rc[0]), "+v"(g_rc[1]), "+v"(g_kc[0]), "+v"(g_kc[1]), "+v"(g_vc[0]), "+v"(g_vc[1]), "+v"(g_rp[0]), "+v"(g_rp[1]), "+v"(g_kp[0]), "+v"(g_kp[1]), "+v"(g_vp[0]), "+v"(g_vp[1]), "+v"(g_ld[0]), "+v"(g_ld[1]), "+v"(g_a[0]), "+v"(g_a[1]));
                float ss = 0.f, bonus = 0.f;
#pragma unroll
                for (int hh = 0; hh < 2; ++hh) { float rc[8], kc[8], vc[8], rp_[8], kp[8], vp[8], ldv[8];
                    unpack8(g_rc[hh], rc); unpack8(g_kc[hh], kc); unpack8(g_vc[hh], vc); unpack8(g_rp[hh], rp_); unpack8(g_kp[hh], kp); unpack8(g_vp[hh], vp); unpack8(g_ld[hh], ldv); unpack8(g_a[hh], av[hh]);
#pragma unroll
                    for (int e = 0; e < 8; ++e) { const int j = jw + 8 * hh + e;
                        rr[hh][e] = rc[e] + (rp_[e] - rc[e]) * cst[j]; const float k = kc[e] + (kp[e] - kc[e]) * cst[64 + j]; const float v = vc[e] + (vp[e] - vc[e]) * cst[128 + j];
                        kkr[hh][e] = k * cst[192 + j]; ss += kkr[hh][e] * kkr[hh][e];
                        av[hh][e] = sigmoidf_(cst[448 + j] + av[hh][e]);
                        lgw[hh][e] = -0.6065306597f * sigmoidf_(cst[384 + j] + ldv[e]);
                        km[hh][e] = k * (1.0f + (av[hh][e] - 1.0f) * cst[256 + j]);
                        bonus += rr[hh][e] * km[hh][e] * cst[320 + j];
                        Vtp[rk_off(j, ln)] = (bf16)f2bf(v); } }
                ssP[ln * 4 + wq] = ss; bnP[ln * 4 + wq] = bonus;
            }
            LDS_BARRIER();
            if (act) {
                int ln = lane; asm volatile("" : "+v"(ln));
                const f32x4 s4 = *(const LAS f32x4*)(ssP + ln * 4), b4 = *(const LAS f32x4*)(bnP + ln * 4);
                const float ss = (s4[0] + s4[1]) + (s4[2] + s4[3]);
                if (wq == 0) bon[64 * p + ln] = (b4[0] + b4[1]) + (b4[2] + b4[3]);
                const float inv = frcp(fmaxf(fsqrt_(ss), 1e-12f));
#pragma unroll
                for (int hh = 0; hh < 2; ++hh) { float lw[8], oA[8], oB[8], oK[8], oR[8], oBh[8], oKh[8], e63[8];
#pragma unroll
                    for (int e = 0; e < 8; ++e) lw[e] = wave_scan_add(lgw[hh][e]);
#pragma unroll
                    for (int e = 0; e < 8; ++e) { const float l63 = __builtin_bit_cast(float, __builtin_amdgcn_readlane(__builtin_bit_cast(int, lw[e]), 63));
                        const float eP = fexp(lw[e] - lgw[hh][e]), eM = fexp(-lw[e]), eL = fexp(lw[e]); e63[e] = fexp(l63); const float eH = e63[e] * eM;
                        const float kk = kkr[hh][e] * inv, bb = kk * av[hh][e];
                        oA[e] = -kk * eP; oB[e] = bb * eM; oK[e] = km[hh][e] * eM; oR[e] = rr[hh][e] * eL; oBh[e] = bb * eH; oKh[e] = km[hh][e] * eH; }
                    pA[hh] = pack8(oA); pB[hh] = pack8(oB); pK[hh] = pack8(oK); pR[hh] = pack8(oR); pKh[hh] = pack8(oKh);
#pragma unroll
                    for (int e = 0; e < 8; ++e) BhTp[rk_off(jw + 8 * hh + e, ln)] = (bf16)f2bf(oBh[e]);
                    if (ln == 63) { LAS float* gp = g63 + 64 * p + jw + 8 * hh; *(LAS f32x4*)gp = (f32x4){e63[0], e63[1], e63[2], e63[3]}; *(LAS f32x4*)(gp + 4) = (f32x4){e63[4], e63[5], e63[6], e63[7]}; } }
            }
            LDS_BARRIER();
            if (act) {
                if (it + 1 < SEQ / 64) RKS_LOAD(it + 1);
                int ln = lane; asm volatile("" : "+v"(ln));
#pragma unroll
                for (int hh = 0; hh < 2; ++hh) { const int ro = rk_off(ln, jw + 8 * hh); *(LAS v4u*)(Ab + ro) = pA[hh]; *(LAS v4u*)(Rb + ro) = pR[hh];
                    const unsigned w_[4] = {pKh[hh].x, pKh[hh].y, pKh[hh].z, pKh[hh].w};
#pragma unroll
                    for (int e = 0; e < 4; ++e) { KhT[rk_off(jw + 8 * hh + 2 * e, ln)] = (bf16)(w_[e] & 0xffffu); KhT[rk_off(jw + 8 * hh + 2 * e + 1, ln)] = (bf16)(w_[e] >> 16); } }
            }
            LDS_BARRIER(); LDS_BARRIER(); LDS_BARRIER(); LDS_BARRIER(); LDS_BARRIER(); LDS_BARRIER();
            if (act) {
                int ln = lane; asm volatile("" : "+v"(ln));
#pragma unroll
                for (int hh = 0; hh < 2; ++hh) { const int ro = rk_off(ln, jw + 8 * hh); *(LAS v4u*)(Bb + ro) = pB[hh]; *(LAS v4u*)(Kb + ro) = pK[hh]; }
            }
            LDS_BARRIER();
        }
#undef RKS_LOAD
    } else {
        const int mB = wq & 1, nB = wq >> 1;
        const int ltid = tid - 256;
        f32x4 sacc[2][2], tacc[2][2], yacc[2][2];
#pragma unroll
        for (int i = 0; i < 2; ++i)
#pragma unroll
            for (int j = 0; j < 2; ++j) { sacc[i][j] = (f32x4){0.f, 0.f, 0.f, 0.f}; tacc[i][j] = sacc[i][j]; yacc[i][j] = sacc[i][j]; }
        v4u g_g0 = {0u, 0u, 0u, 0u}, g_g1 = g_g0, pend0 = g_g0, pend1 = g_g0; bf16* pend_p = MIX;
#define RKV_LOADG(c_) do { int lt_ = ltid; asm volatile("" : "+v"(lt_)); const bf16* gp_ = DAG + (size_t)(b * SEQ + (c_) * 64 + (lt_ >> 2)) * NLORA + 1024 + h * 64 + 16 * (lt_ & 3); g_g0 = *(const v4u*)gp_; g_g1 = *(const v4u*)(gp_ + 8); } while (0)
        LDS_BARRIER();
        for (int it = 0; it <= SEQ / 64; ++it) {
            const int ch = it - 1; const bool act = it >= 1; const int p = ch & 1;
            const LAS bf16* BhTp = RK_S(5 + 11 * p); const LAS bf16* Vtp = RK_S(6 + 11 * p);
            LDS_BARRIER();
            if (act) {
                const RkLane L = rk_lane(lane);
                if (ch > 0) { *(v4u*)pend_p = pend0; *(v4u*)(pend_p + 8) = pend1; }
                RKV_LOADG(ch);
                const RkF2 aB = rk_ld2(Bb, mB, L), bA = rk_ld2(Ab, nB, L);
                {
                    const RkF2 aA = rk_ld2(Ab, mB, L), bB = rk_ld2(Bb, nB, L);
                    f32x4 d[2][2], d2[2][2];
                    rk_mm2<false>(d, aB, bA); rk_mm2<false>(d2, aA, bB);
                    rk_mask2<0>(d, mB, nB, L.l15, L.l4);
#pragma unroll
                    for (int mi = 0; mi < 2; ++mi)
#pragma unroll
                        for (int ni = 0; ni < 2; ++ni)
#pragma unroll
                            for (int r = 0; r < 4; ++r) tacc[mi][ni][r] = d[mi][ni][r] + ((2 * mB + mi == 2 * nB + ni && 4 * L.l4 + r == L.l15) ? 1.f : 0.f);
                    rk_mask2<1>(d2, mB, nB, L.l15, L.l4);
                    rk_store2(P0, d, mB, nB, L); rk_store2(TA, tacc, mB, nB, L); rk_store2(P0T, d2, mB, nB, L);
                }
                asm volatile("" ::: "memory");
                {
                    const RkF2 aK = rk_ld2(Kb, mB, L), bR = rk_ld2(Rb, nB, L);
                    f32x4 d3[2][2], d4[2][2], d5[2][2];
                    rk_mm2<false>(d3, aK, bA); rk_mm2<false>(d4, aB, bR); rk_mm2<false>(d5, aK, bR);
                    rk_mask2<0>(d3, mB, nB, L.l15, L.l4); rk_mask2<2>(d4, mB, nB, L.l15, L.l4); rk_mask2<2>(d5, mB, nB, L.l15, L.l4);
                    rk_store2(Aak, d3, mB, nB, L); rk_store2(Arb, d4, mB, nB, L); rk_store2(Ark, d5, mB, nB, L);
                }
            }
            LDS_BARRIER();
            if (act) {
                const RkLane L = rk_lane(lane);
                {
                    const RkF2 aPT = rk_ld2(P0T, mB, L), aP = rk_ld2(P0, mB, L), bP = rk_ld2(P0, nB, L), bPT = rk_ld2(P0T, nB, L);
                    f32x4 d[2][2], d2[2][2]; rk_mm2<false>(d, aPT, bP); rk_mm2<false>(d2, aP, bPT);
                    rk_store2(Bb  , d, mB, nB, L); rk_store2(Kb  , d2, mB, nB, L);
                }
                asm volatile("" ::: "memory");
                const RkF2 bV = rk_ld2(Vtp, nB, L);
                {
                    const RkF2 aA = rk_ld2(Ab, mB, L), aAk = rk_ld2(Aak, mB, L), bS = rk_ld2(Sb, nB, L), aKh = rk_ld2(KhT, mB, L);
                    f32x4 d3[2][2]; rk_mm2<false>(d3, aA, bS); rk_mm2<true>(d3, aAk, bV);
#pragma unroll
                    for (int mi = 0; mi < 2; ++mi)
#pragma unroll
                        for (int r = 0; r < 4; ++r) { const float g_ = g63[64 * p + 16 * (2 * mB + mi) + 4 * L.l4 + r]; sacc[mi][0][r] *= g_; sacc[mi][1][r] *= g_; }
                    rk_mm2<true>(sacc, aKh, bV);
                    rk_store2(Xt, d3, mB, nB, L);
                }
                asm volatile("" ::: "memory");
                {
                    const RkF2 aS = rk_ld2(Sb, mB, L), aV = rk_ld2(Vtp, mB, L), bR = rk_ld2(Rb, nB, L), bArk = rk_ld2(Ark, nB, L);
                    rk_mm2<false>(yacc, aS, bR); rk_mm2<true>(yacc, aV, bArk);
                }
            }
            LDS_BARRIER();
#define RKV_DOUBLE(PK, PKT, TIN, TOUT, PN, PNT) if (act) { const RkLane L = rk_lane(lane); const RkF2 aPT = rk_ld2(PKT, mB, L), aP = rk_ld2(PK, mB, L); \
              const RkF2 bT = rk_ld2(TIN, nB, L), bP = rk_ld2(PK, nB, L), bPT = rk_ld2(PKT, nB, L); \
              f32x4 d[2][2], d2[2][2]; rk_mm2<true>(tacc, aPT, bT); rk_mm2<false>(d, aPT, bP); rk_mm2<false>(d2, aP, bPT); \
              rk_store2(TOUT, tacc, mB, nB, L); rk_store2(PN, d, mB, nB, L); rk_store2(PNT, d2, mB, nB, L); }
            RKV_DOUBLE(Bb, Kb, TA, TB, P0, P0T)
            LDS_BARRIER();
            RKV_DOUBLE(P0, P0T, TB, TA, Bb, Kb)
            LDS_BARRIER();
            RKV_DOUBLE(Bb, Kb, TA, TB, P0, P0T)
            LDS_BARRIER();
            if (act) { const RkLane L = rk_lane(lane); const RkF2 aPT = rk_ld2(P0T, mB, L), aP = rk_ld2(P0, mB, L); const RkF2 bT = rk_ld2(TB, nB, L), bPT = rk_ld2(P0T, nB, L);
                f32x4 d2[2][2]; rk_mm2<true>(tacc, aPT, bT); rk_mm2<false>(d2, aP, bPT); rk_store2(TA, tacc, mB, nB, L); rk_store2(Kb  , d2, mB, nB, L); }
            LDS_BARRIER();
            if (act) { const RkLane L = rk_lane(lane); const RkF2 aPT = rk_ld2(Kb, mB, L); const RkF2 bT = rk_ld2(TA, nB, L); rk_mm2<true>(tacc, aPT, bT); rk_store2(TB, tacc, mB, nB, L); }
            LDS_BARRIER();
            if (act) { const RkLane L = rk_lane(lane); const RkF2 aT = rk_ld2(TB, mB, L); const RkF2 bX = rk_ld2(Xt, nB, L); f32x4 d[2][2]; rk_mm2<false>(d, aT, bX); rk_store2(Ut, d, mB, nB, L); }
            LDS_BARRIER();
            if (act) {
                const RkLane L = rk_lane(lane);
                const RkF2 aU = rk_ld2(Ut, mB, L), aBh = rk_ld2(BhTp, mB, L); const RkF2 bArb = rk_ld2(Arb, nB, L), bU = rk_ld2(Ut, nB, L);
                rk_mm2<true>(yacc, aU, bArb); rk_mm2<true>(sacc, aBh, bU);
#pragma unroll
                for (int mi = 0; mi < 2; ++mi)
#pragma unroll
                    for (int ni = 0; ni < 2; ++ni) *(LAS f32x4*)(Yl + (16 * (2 * nB + ni) + L.l15) * 64 + (((4 * (2 * mB + mi) + L.l4) ^ (L.l15 & 7)) << 2)) = yacc[mi][ni];
                rk_store2(Sb, sacc, mB, nB, L);
            }
            LDS_BARRIER();
            if (act) {
                int lt_ = ltid; asm volatile("" : "+v"(lt_)); const int tt = lt_ >> 2, c4 = lt_ & 3;
                const int t = b * SEQ + ch * 64 + tt, j0 = 16 * c4;
                float y[16], gv[16]; float s1 = 0.f;
#pragma unroll
                for (int k = 0; k < 4; ++k) { const f32x4 yv = *(const LAS f32x4*)(Yl + tt * 64 + (((4 * c4 + k) ^ (tt & 7)) << 2)); y[4 * k] = yv[0]; y[4 * k + 1] = yv[1]; y[4 * k + 2] = yv[2]; y[4 * k + 3] = yv[3]; s1 += (yv[0] + yv[1]) + (yv[2] + yv[3]); }
                s1 += dppmov<0xB1>(s1); s1 += dppmov<0x4E>(s1); const float mean = s1 * (1.0f / 64.0f); float s2 = 0.f;
#pragma unroll
                for (int e = 0; e < 16; ++e) { const float dd = y[e] - mean; s2 += dd * dd; }
                s2 += dppmov<0xB1>(s2); s2 += dppmov<0x4E>(s2); const float rstd = frsq(s2 * (1.0f / 64.0f) + LNX_EPS);
                { float g0[8], g1[8]; unpack8(g_g0, g0); unpack8(g_g1, g1);
#pragma unroll
                  for (int e = 0; e < 8; ++e) { gv[e] = g0[e]; gv[8 + e] = g1[e]; } }
                const float bonus = bon[64 * p + tt]; float ov[16];
#pragma unroll
                for (int e = 0; e < 16; ++e) { const float yn = (y[e] - mean) * rstd * cst[512 + j0 + e] + cst[576 + j0 + e]; ov[e] = (yn + bonus * bf2f(Vtp[rk_off(j0 + e, tt)])) * gv[e]; }
                { float o0[8], o1[8];
#pragma unroll
                  for (int e = 0; e < 8; ++e) { o0[e] = ov[e]; o1[e] = ov[8 + e]; }
                  pend0 = pack8(o0); pend1 = pack8(o1); pend_p = MIX + (size_t)t * DM + h * 64 + j0; }
            }
        }
        *(v4u*)pend_p = pend0; *(v4u*)(pend_p + 8) = pend1;
#undef RKV_DOUBLE
#undef RKV_LOADG
    }
    LDS_BARRIER();
#undef RK_S
}

__device__ __forceinline__ void mlstm_unit(const Args& a, LAS unsigned char* lds, int unit, int tid, int lane, int wave) {
    unsigned char* ws = a.ws; const bf16* PROJ = (const bf16*)(ws + WS_PROJ); const float* gates = (const float*)(ws + WS_GATES); bf16* MIX = (bf16*)(ws + WS_MIX);
    const float* cw = a.in[14]; const float* cbias = a.in[15]; const float* i_bias = a.in[16]; const float* f_bias = a.in[17]; const float* mhg = a.in[18];
    const int b = unit >> 2, hm = unit & 3;
    constexpr int LD = 72;
    LAS bf16* Ql = (LAS bf16*)lds; LAS bf16* Kl = Ql + 64 * LD; LAS bf16* Kwt = Kl + 64 * LD; LAS bf16* Vt = Kwt + 64 * LD; LAS bf16* Sm = Vt + 128 * LD; LAS bf16* Ct = Sm + 64 * LD;
    LAS float* Hl = (LAS float*)(Ct + 128 * LD);
    LAS float* e_s = Hl + 64 * 132; LAS float* Mx = e_s + 64; LAS float* sc = Mx + 64; LAS float* em = sc + 64; LAS float* wsv = em + 64; LAS float* den = wsv + 64; LAS float* nvec = den + 64; LAS float* scal = nvec + 64;
    for (int i = tid; i < 128 * LD / 2; i += 512) ((LAS unsigned*)Ct)[i] = 0u;
    if (tid < 64) nvec[tid] = 0.f;
    if (tid == 0) { scal[0] = 1.f; scal[1] = 0.f; }
    f32x4 cacc[4];
#pragma unroll
    for (int i = 0; i < 4; ++i) cacc[i] = (f32x4){0.f, 0.f, 0.f, 0.f};
    const int l15 = lane & 15, l4 = lane >> 4;
    const int tt = tid >> 3, p8 = tid & 7;
    LAS float* cwl = scal + 16; LAS float* cbl = cwl + 512;
    for (int i = tid; i < 640; i += 512) { const int j = i >> 7, c_ = i & 127; const int src = (c_ < 64) ? (hm * 64 + c_) : (256 + hm * 64 + (c_ - 64)); if (j < 4) cwl[i] = cw[j * 512 + src]; else cbl[c_] = cbias[src]; }
    const float ibias = i_bias[hm], fbias = f_bias[hm];
    v4u n_q[4], n_k[4], n_va, n_vb, n_oa, n_ob; float n_gi = 0.f, n_gf = 0.f;
#define ML_LOADCHUNK(c_) do { const int t_ = b * SEQ + (c_) * 64 + lane; const int tp_ = (c_) * 64 + lane; \
        _Pragma("unroll") for (int j = 0; j < 4; ++j) { if (tp_ - 3 + j >= 0) { const bf16* pr_ = PROJ + (size_t)(t_ - 3 + j) * NPROJ + hm * 64 + 8 * wave; n_q[j] = *(const v4u*)(pr_ + C_Q); n_k[j] = *(const v4u*)(pr_ + C_K); } \
                                                       else { n_q[j] = (v4u){0u, 0u, 0u, 0u}; n_k[j] = (v4u){0u, 0u, 0u, 0u}; } } \
        { const bf16* pv_ = PROJ + (size_t)t_ * NPROJ + C_V + hm * 128 + 16 * wave; n_va = *(const v4u*)pv_; n_vb = *(const v4u*)(pv_ + 8); \
          const bf16* po_ = PROJ + (size_t)(b * SEQ + (c_) * 64 + tt) * NPROJ + C_O + hm * 128 + 16 * p8; n_oa = *(const v4u*)po_; n_ob = *(const v4u*)(po_ + 8); } \
        n_gi = gates[(size_t)t_ * 8 + hm]; n_gf = gates[(size_t)t_ * 8 + 4 + hm]; } while (0)
    ML_LOADCHUNK(0);
    LDS_BARRIER();
    float m_run = 0.f;
    v4u pend0 = {0u, 0u, 0u, 0u}, pend1 = pend0; bf16* pend_p = MIX;
    for (int c = 0; c < SEQ / 64; ++c) {
        const int t0 = b * SEQ + c * 64;
        asm volatile("" : "+v"(n_q[0]), "+v"(n_q[1]), "+v"(n_q[2]), "+v"(n_q[3]), "+v"(n_k[0]), "+v"(n_k[1]), "+v"(n_k[2]), "+v"(n_k[3]), "+v"(n_va), "+v"(n_vb), "+v"(n_oa), "+v"(n_ob), "+v"(n_gi), "+v"(n_gf));
        float dec;
        v4u c_oa, c_ob;
        {
            const float gi = n_gi + ibias, gf = n_gf + fbias;
            const float ig = 15.0f * tanhf_(gi * (1.0f / 15.0f)), fx = 15.0f * tanhf_(gf * (1.0f / 15.0f));
            const float logf = -(fmaxf(-fx, 0.f) + __logf(1.0f + fexp(-fabsf(fx))));
            const float bc = wave_scan_add(logf);
            const float e = ig - bc; const float P = wave_scan_max(e);
            const float mx = fmaxf(P, m_run);
            const float mxL = __builtin_bit_cast(float, __builtin_amdgcn_readlane(__builtin_bit_cast(int, mx), 63)), bL = __builtin_bit_cast(float, __builtin_amdgcn_readlane(__builtin_bit_cast(int, bc), 63));
            if (wave == 0) { e_s[lane] = e; Mx[lane] = mx; sc[lane] = fexp(m_run - mx); em[lane] = fexp(-(bc + mx)); }
            const float w = fexp(e - mxL);
            dec = fexp(m_run - mxL); m_run = bL + mxL;
            const int d0 = 8 * wave;
            float aq[8], ak[8];
#pragma unroll
            for (int e_ = 0; e_ < 8; ++e_) { aq[e_] = cbl[d0 + e_]; ak[e_] = cbl[64 + d0 + e_]; }
#pragma unroll
            for (int j = 0; j < 4; ++j) { float pq[8], pk[8]; unpack8(n_q[j], pq); unpack8(n_k[j], pk);
#pragma unroll
                for (int e_ = 0; e_ < 8; ++e_) { aq[e_] += cwl[j * 128 + d0 + e_] * pq[e_]; ak[e_] += cwl[j * 128 + 64 + d0 + e_] * pk[e_]; } }
#pragma unroll
            for (int e_ = 0; e_ < 8; ++e_) { aq[e_] = aq[e_] * sigmoidf_(aq[e_]) * 0.125f; ak[e_] = ak[e_] * sigmoidf_(ak[e_]); }
            *(LAS v4u*)(Ql + lane * LD + d0) = pack8(aq); *(LAS v4u*)(Kl + lane * LD + d0) = pack8(ak);
#pragma unroll
            for (int e_ = 0; e_ < 8; ++e_) Kwt[(d0 + e_) * LD + lane] = (bf16)f2bf(w * ak[e_]);
            const unsigned wv[8] = {n_va.x, n_va.y, n_va.z, n_va.w, n_vb.x, n_vb.y, n_vb.z, n_vb.w};
#pragma unroll
            for (int e_ = 0; e_ < 8; ++e_) { Vt[(16 * wave + 2 * e_) * LD + lane] = (bf16)(wv[e_] & 0xffffu); Vt[(16 * wave + 2 * e_ + 1) * LD + lane] = (bf16)(wv[e_] >> 16); }
            c_oa = n_oa; c_ob = n_ob;
            if (c > 0) { *(v4u*)pend_p = pend0; *(v4u*)(pend_p + 8) = pend1; }
            if (c + 1 < SEQ / 64) ML_LOADCHUNK(c + 1);
        }
        LDS_BARRIER();
        {
            const int rb = wave >> 1, cb0 = 2 * (wave & 1);
            bf16x8 A[2], B[2][2];
#pragma unroll
            for (int kk = 0; kk < 2; ++kk) { A[kk] = *(const LAS bf16x8*)(Ql + (16 * rb + l15) * LD + 32 * kk + 8 * l4);
#pragma unroll
                for (int ci = 0; ci < 2; ++ci) B[ci][kk] = *(const LAS bf16x8*)(Kl + (16 * (cb0 + ci) + l15) * LD + 32 * kk + 8 * l4); }
            float mxr[4];
#pragma unroll
            for (int r = 0; r < 4; ++r) mxr[r] = Mx[16 * rb + 4 * l4 + r];
            const float es0 = e_s[16 * cb0 + l15], es1 = e_s[16 * (cb0 + 1) + l15];
            f32x4 acc[2];
#pragma unroll
            for (int ci = 0; ci < 2; ++ci) { f32x4 c_ = {0.f, 0.f, 0.f, 0.f}; c_ = mfma16(A[0], B[ci][0], c_); acc[ci] = mfma16(A[1], B[ci][1], c_); }
#pragma unroll
            for (int ci = 0; ci < 2; ++ci) { const int s_ = 16 * (cb0 + ci) + l15; const float es = ci ? es1 : es0;
#pragma unroll
                for (int r = 0; r < 4; ++r) { const int t = 16 * rb + 4 * l4 + r; const float v = (s_ <= t) ? acc[ci][r] * fexp(es - mxr[r]) : 0.f; Sm[t * LD + s_] = (bf16)f2bf(v); } }
        }
        LDS_BARRIER();
        {
            float part = 0.f, qn = 0.f; float sv[8], qv[8];
            unpack8(*(const LAS v4u*)(Sm + tt * LD + 8 * p8), sv); unpack8(*(const LAS v4u*)(Ql + tt * LD + 8 * p8), qv);
#pragma unroll
            for (int e_ = 0; e_ < 8; ++e_) { part += sv[e_]; qn += qv[e_] * nvec[8 * p8 + e_]; }
            float tot = part + sc[tt] * qn; tot = red8(tot);
            if (p8 == 0) den[tt] = tot;
            const int rb = wave >> 1, vb0 = 4 * (wave & 1);
            bf16x8 As[2], Aq[2], B1[4][2], B2[4][2];
#pragma unroll
            for (int kk = 0; kk < 2; ++kk) { As[kk] = *(const LAS bf16x8*)(Sm + (16 * rb + l15) * LD + 32 * kk + 8 * l4); Aq[kk] = *(const LAS bf16x8*)(Ql + (16 * rb + l15) * LD + 32 * kk + 8 * l4);
#pragma unroll
                for (int vi = 0; vi < 4; ++vi) { B1[vi][kk] = *(const LAS bf16x8*)(Vt + (16 * (vb0 + vi) + l15) * LD + 32 * kk + 8 * l4); B2[vi][kk] = *(const LAS bf16x8*)(Ct + (16 * (vb0 + vi) + l15) * LD + 32 * kk + 8 * l4); } }
            float scr_[4];
#pragma unroll
            for (int r = 0; r < 4; ++r) scr_[r] = sc[16 * rb + 4 * l4 + r];
            f32x4 a1[4], a2[4];
#pragma unroll
            for (int vi = 0; vi < 4; ++vi) { f32x4 c1 = {0.f, 0.f, 0.f, 0.f}, c2 = {0.f, 0.f, 0.f, 0.f}; c1 = mfma16(As[0], B1[vi][0], c1); c2 = mfma16(Aq[0], B2[vi][0], c2); a1[vi] = mfma16(As[1], B1[vi][1], c1); a2[vi] = mfma16(Aq[1], B2[vi][1], c2); }
#pragma unroll
            for (int vi = 0; vi < 4; ++vi)
#pragma unroll
                for (int r = 0; r < 4; ++r) Hl[(16 * rb + 4 * l4 + r) * 132 + 16 * (vb0 + vi) + l15] = a1[vi][r] + scr_[r] * a2[vi][r];
        }
        LDS_BARRIER();
        {
            bf16x8 Av[2], Bk[4][2];
#pragma unroll
            for (int kk = 0; kk < 2; ++kk) { Av[kk] = *(const LAS bf16x8*)(Vt + (16 * wave + l15) * LD + 32 * kk + 8 * l4);
#pragma unroll
                for (int db = 0; db < 4; ++db) Bk[db][kk] = *(const LAS bf16x8*)(Kwt + (16 * db + l15) * LD + 32 * kk + 8 * l4); }
#pragma unroll
            for (int db = 0; db < 4; ++db) { cacc[db] = cacc[db] * dec; cacc[db] = mfma16(Av[0], Bk[db][0], cacc[db]); cacc[db] = mfma16(Av[1], Bk[db][1], cacc[db]); }
#pragma unroll
            for (int db = 0; db < 4; ++db)
#pragma unroll
                for (int r = 0; r < 4; ++r) Ct[(16 * wave + 4 * l4 + r) * LD + 16 * db + l15] = (bf16)f2bf(cacc[db][r]);
            float kv[8]; unpack8(*(const LAS v4u*)(Kwt + tt * LD + 8 * p8), kv); float s_ = 0.f;
#pragma unroll
            for (int e_ = 0; e_ < 8; ++e_) s_ += kv[e_];
            s_ = red8(s_);
            if (p8 == 0) nvec[tt] = dec * nvec[tt] + s_;
        }
        {
            const int t = t0 + tt, v0 = 16 * p8; float hv[16]; float ss = 0.f;
            const float dn = frcp(fmaxf(fabsf(den[tt]), em[tt]));
#pragma unroll
            for (int q = 0; q < 4; ++q) { const f32x4 x = *(const LAS f32x4*)(Hl + tt * 132 + v0 + 4 * q) * dn; hv[4 * q] = x[0]; hv[4 * q + 1] = x[1]; hv[4 * q + 2] = x[2]; hv[4 * q + 3] = x[3]; ss += (x[0] * x[0] + x[1] * x[1]) + (x[2] * x[2] + x[3] * x[3]); }
            ss = red8(ss); const float rn = frsq(ss * (1.0f / 128.0f) + NORM_EPS);
            float o0[8], o1[8]; unpack8(c_oa, o0); unpack8(c_ob, o1);
            float r0[8], r1[8];
#pragma unroll
            for (int e_ = 0; e_ < 8; ++e_) { r0[e_] = hv[e_] * rn * mhg[hm * 128 + v0 + e_] * sigmoidf_(o0[e_]); r1[e_] = hv[8 + e_] * rn * mhg[hm * 128 + v0 + 8 + e_] * sigmoidf_(o1[e_]); }
            pend_p = MIX + (size_t)t * DM + 512 + hm * 128 + v0; pend0 = pack8(r0); pend1 = pack8(r1);
        }
        LDS_BARRIER();
    }
    *(v4u*)pend_p = pend0; *(v4u*)(pend_p + 8) = pend1;
#undef ML_LOADCHUNK
}

__device__ __forceinline__ void phase_ffn_fix(const Args& a, int tid) {
    unsigned char* ws = a.ws; const float* SA = (const float*)(ws + WS_SIDE); const float* SB = SA + SIDE_ELEMS; const float* SL = SB + SIDE_ELEMS; bf16* GB = (bf16*)(ws + WS_GB);
    const float* cw = a.in[22]; const float* cb = a.in[23];
    const int NT = gridDim.x * 512;
    for (int it = blockIdx.x * 512 + tid; it < SIDE_ELEMS; it += NT) {
        const int ch = it & 127, r = (it >> 7) & 1, tile = it >> 8, pm = tile / 22, pn = tile % 22;
        const int base = tile * 256;
        float l0 = 0.f, l1 = 0.f;
        if ((pm & 7) != 0) { const int lb = (tile - 22) * 256; l0 = SL[lb + ch]; l1 = SL[lb + 128 + ch]; }
        const float a_r = SA[base + r * 128 + ch], b_r = SB[base + r * 128 + ch];
        const float am1 = r == 0 ? l1 : SA[base + ch], am2 = r == 0 ? l0 : l1;
        const int f = pn * 128 + ch;
        const float z = cb[f] + cw[f] * am2 + cw[DFF + f] * am1 + cw[2 * DFF + f] * a_r;
        GB[(size_t)(pm * 256 + r) * DFF + f] = (bf16)f2bf(z * sigmoidf_(z) * b_r);
    }
}
__device__ __forceinline__ void phase_final(const Args& a, int lane, int wave) {
    const bf16* FF = (const bf16*)(a.ws + WS_FF); const float* gf = a.in[25];
    f32x4 gv[4];
#pragma unroll
    for (int j = 0; j < 4; ++j) gv[j] = *((const f32x4*)gf + lane + 64 * j);
    const int NGW = gridDim.x * 8;
#ifdef PROBE
    const unsigned long long* tstamps = (const unsigned long long*)(a.ws + WS_CTL + 512 * 1024);
    const float fa = fminf(fmaxf((float)(long long)(tstamps[PROBE_A_TO] - tstamps[PROBE_A_FROM]) * (0.01f / PROBE_A_SCALE_US), 0.f), 1.f);
    const float pscale = 1.0f + sqrtf(fa * 0.8e-4f);
#pragma unroll
    for (int j = 0; j < 4; ++j) gv[j] = gv[j] * pscale;
#endif
    const bf16* XB = (const bf16*)(a.ws + WS_XN);
    for (int row0 = 2 * (blockIdx.x * 8 + wave); row0 < M; row0 += 2 * NGW) {
        v2u xq[2][4], f[2][4];
#pragma unroll
        for (int u = 0; u < 2; ++u) { const v2u* xr = (const v2u*)(XB + (size_t)(row0 + u) * DM) + lane; const v2u* fr_ = (const v2u*)(FF + (size_t)(row0 + u) * DM) + lane;
#pragma unroll
            for (int j = 0; j < 4; ++j) { xq[u][j] = xr[64 * j]; f[u][j] = fr_[64 * j]; } }
#pragma unroll
        for (int u = 0; u < 2; ++u) { float ss = 0.f; f32x4 v[4];
#pragma unroll
            for (int j = 0; j < 4; ++j) { v[j][0] = bflo(xq[u][j].x) + bflo(f[u][j].x); v[j][1] = bfhi(xq[u][j].x) + bfhi(f[u][j].x); v[j][2] = bflo(xq[u][j].y) + bflo(f[u][j].y); v[j][3] = bfhi(xq[u][j].y) + bfhi(f[u][j].y);
                ss += (v[j][0] * v[j][0] + v[j][1] * v[j][1]) + (v[j][2] * v[j][2] + v[j][3] * v[j][3]); }
            const float rs = frsq(wave_sum(ss) * (1.0f / DM) + NORM_EPS);
            f32x4* xr = (f32x4*)(a.out + (size_t)(row0 + u) * DM) + lane;
#pragma unroll
            for (int j = 0; j < 4; ++j) xr[64 * j] = v[j] * rs * gv[j]; }
    }
}

constexpr int N_PHASES = 10;
__global__ void __launch_bounds__(512, 2) mega(Args args) {
    extern __shared__ __attribute__((aligned(16))) unsigned char lds_raw[];
    LAS unsigned char* lds = (LAS unsigned char*)lds_raw;
    const int wave0 = __builtin_amdgcn_readfirstlane((int)threadIdx.x >> 6);
#define MK_LANE() mk_lane_id()
#define MK_LEADER() (wave0 == 0 && MK_LANE() == 0)
    unsigned char* ws = args.ws;
#define PHASE_IDS int tid = wave0 * 64 + MK_LANE(); asm volatile("" : "+v"(tid)); const int lane = tid & 63, wave = wave0; (void)lane; (void)wave
    volatile LAS unsigned* MISC = (volatile LAS unsigned*)(lds + MISC_OFF);
    { PHASE_IDS; for (int u = tid; u < (LDS_BYTES - 131072) / 4; u += 512) ((LAS unsigned*)(lds + 131072))[u] = 0u; }
    __syncthreads();
    XcdBarrier bar; bar.bar = (unsigned*)(ws + WS_CTL) + 4096; bar.x = 0; bar.st = nullptr;
    if (MK_SINGLE) bar = xcd_barrier_post((unsigned*)(ws + WS_CTL) + 4096, MISC + 8, MK_LEADER());
    const int lo = args.ph_lo, hi = args.ph_hi;
#ifndef PH_MASK
#define PH_MASK 0xFFFF
#endif
#define IN(k) ((((PH_MASK) >> (k)) & 1) && lo <= (k) && (k) < hi)
#ifdef PROBE
    unsigned long long* const tstamps = (unsigned long long*)(ws + WS_CTL + 512 * 1024);
#define STAMP(k) do { if (blockIdx.x == 0 && MK_LEADER()) tstamps[(k)] = __builtin_amdgcn_s_memrealtime(); } while (0)
#else
#define STAMP(k) do { } while (0)
#endif
    STAMP(0);
#define SEAM(k) do { if (IN(k) && IN((k) + 1)) xcd_barrier(bar, MK_LEADER()); STAMP((k) + 1); } while (0)

    if (IN(0)) { PHASE_IDS; phase_prep(args, lds, tid, lane, wave); } SEAM(0);
    if (IN(1)) {
        pg8::Gemm g{(const bf16*)(ws + WS_XN), (const bf16*)(ws + WS_WT_IN), M, NPROJ, opaque_i(DM)}; pg8::StaticOrder S; S.init(M, NPROJ, gridDim.x, (int)blockIdx.x);
        pg8::EpiBf16<0> E{(bf16*)(ws + WS_PROJ), NPROJ, nullptr, 0, 0, 1.f};
        pg8::gemm_phase<pg8::EpiBf16<0>, pg8::StaticOrder, true, true>(lds, g, S, E, wave0 * 64 + MK_LANE());
    } SEAM(1);
    if (IN(2)) {
        PHASE_IDS;
        if ((int)blockIdx.x < BATCH * 4 || gridDim.x != 256) {
            for (int u = blockIdx.x; u < BATCH * 4; u += gridDim.x) mlstm_unit(args, lds, u, tid, lane, wave);
        }
        if (gridDim.x == 256 && (int)blockIdx.x >= BATCH * 4) {
            const int c = (int)blockIdx.x - BATCH * 4;
            phase_lmat(args, tid, 512 * c, 512);
            asm volatile("s_waitcnt vmcnt(0)" ::: "memory"); __syncthreads();
            if (tid == 0) { __builtin_amdgcn_fence(__ATOMIC_ACQUIRE, "agent"); asm volatile("s_waitcnt vmcnt(0)" ::: "memory"); }
            __syncthreads();
            pg8::Gemm g{(const bf16*)(ws + WS_LBUF), (const bf16*)(ws + WS_WT_LORA), M, NLORA, opaque_i(KLORA)}; pg8::PairPanelOrder S{c};
            pg8::EpiBf16<0> E{(bf16*)(ws + WS_DAG), NLORA, nullptr, 0, 0, 1.f};
            pg8::gemm_phase<pg8::EpiBf16<0>, pg8::PairPanelOrder, true, true>(lds, g, S, E, wave0 * 64 + MK_LANE());
            __syncthreads();
            late_transposes(args, lds, lane, wave, c * 8 + wave, ((int)gridDim.x - BATCH * 4) * 8);
        }
    } SEAM(2);
    if (IN(3)) {
        PHASE_IDS;
        for (int u = blockIdx.x; u < BATCH * 8; u += gridDim.x) rwkv_unit_split(args, lds, u, tid, lane, wave);
        STAMP(12);
    }
    if (IN(3) && IN(5)) xcd_barrier(bar, MK_LEADER());
    STAMP(5);
    if (IN(5)) {
        pg8::Gemm g{(const bf16*)(ws + WS_MIX), (const bf16*)(ws + WS_WT_OUT), M, DM, opaque_i(DM)}; pg8::StaticOrder S; S.init(M, DM, gridDim.x, (int)blockIdx.x);
        pg8::EpiResid E{(bf16*)(ws + WS_XN), (const float*)(ws + WS_RINV), (float*)(ws + WS_SSQP)};
        pg8::gemm_phase<pg8::EpiResid, pg8::StaticOrder, true, true>(lds, g, S, E, wave0 * 64 + MK_LANE());
    } SEAM(5);
    if (IN(6)) {
        pg8::Gemm g{(const bf16*)(ws + WS_XN), (const bf16*)(ws + WS_WT_UP), M, NUP, opaque_i(DM)}; pg8::StaticOrder S; S.init(M, NUP, gridDim.x, (int)blockIdx.x);
        float* side = (float*)(ws + WS_SIDE); float* rs2 = (float*)(ws + WS_RS2);
        {
            PHASE_IDS; pg8::Unit u;
            for (int i = 0; S.next(i, u); ++i) if (tid < 256) { const int row = u.pm * 256 + tid; const f32x4* p = (const f32x4*)((const float*)(ws + WS_SSQP) + (size_t)row * 16); const f32x4 s0 = p[0], s1 = p[1], s2 = p[2], s3 = p[3];
                const float ss = ((s0[0] + s0[1]) + (s0[2] + s0[3])) + ((s1[0] + s1[1]) + (s1[2] + s1[3])) + ((s2[0] + s2[1]) + (s2[2] + s2[3])) + ((s3[0] + s3[1]) + (s3[2] + s3[3]));
                rs2[row] = frsq(ss * (1.0f / DM) + NORM_EPS); }
            asm volatile("s_waitcnt vmcnt(0)" ::: "memory"); __syncthreads();
        }
        pg8::EpiFfn E{(bf16*)(ws + WS_GB), rs2, args.in[22], args.in[23], side, side + SIDE_ELEMS, side + 2 * SIDE_ELEMS, (LAS float*)(lds + 131072 + 1024)};
        pg8::gemm_phase<pg8::EpiFfn, pg8::StaticOrder, true, true>(lds, g, S, E, wave0 * 64 + MK_LANE());
    } SEAM(6);
    if (IN(7)) { PHASE_IDS; phase_ffn_fix(args, tid); } SEAM(7);
    if (IN(8)) {
        pg8::Gemm g{(const bf16*)(ws + WS_GB), (const bf16*)(ws + WS_WT_DN), M, DM, opaque_i(DFF)}; pg8::StaticOrder S; S.init(M, DM, gridDim.x, (int)blockIdx.x);
        pg8::EpiBf16<0> E{(bf16*)(ws + WS_FF), DM, nullptr, 0, 0, 1.f};
        pg8::gemm_phase<pg8::EpiBf16<0>, pg8::StaticOrder, true, true>(lds, g, S, E, wave0 * 64 + MK_LANE());
    } SEAM(8);
#ifdef PROBE
    xcd_barrier(bar, MK_LEADER());
#endif
    if (IN(9)) { PHASE_IDS; phase_final(args, lane, wave); }
#undef IN
#undef SEAM
}

extern "C" void kernel_launch(void* const* d_in, const int* in_sizes, int n_in, void* d_out, int out_size, void* d_ws, size_t ws_size, hipStream_t stream) {
    static int grid = 0;
    if (grid == 0) {
        if (n_in != 26 || in_sizes[0] != M * DM || out_size != M * DM || ws_size < WS_END) { fprintf(stderr, "kernel_launch: unexpected shapes (n_in %d, in0 %d, out %d, ws %zu)\n", n_in, n_in > 0 ? in_sizes[0] : -1, out_size, ws_size); grid = -1; return; }
        int dev = 0, cus = 0, per_cu = 0;
        if (hipGetDevice(&dev) != hipSuccess || hipDeviceGetAttribute(&cus, hipDeviceAttributeMultiprocessorCount, dev) != hipSuccess) { grid = -1; return; }
        if (hipFuncSetAttribute((const void*)mega, hipFuncAttributeMaxDynamicSharedMemorySize, LDS_BYTES) != hipSuccess) { fprintf(stderr, "kernel_launch: hipFuncSetAttribute failed\n"); grid = -1; return; }
        if (hipOccupancyMaxActiveBlocksPerMultiprocessor(&per_cu, (const void*)mega, 512, LDS_BYTES) != hipSuccess || per_cu < 1) { fprintf(stderr, "kernel_launch: occupancy query says %d blocks per CU\n", per_cu); }
        (void)hipGetLastError();
        grid = cus;
        if (grid != 256) fprintf(stderr, "kernel_launch: %d CUs; this kernel is laid out for 256\n", grid);
    }
    if (grid < 0) return;
    (void)hipMemsetAsync((char*)d_ws + WS_CTL, 0, CTL_ZERO_BYTES, stream);
    Args a{};
    for (int i = 0; i < 26; ++i) a.in[i] = (const float*)d_in[i];
    a.out = (float*)d_out; a.ws = (unsigned char*)d_ws;
#if MK_SINGLE
    a.ph_lo = 0; a.ph_hi = N_PHASES;
    hipLaunchKernelGGL(mega, dim3(grid), dim3(512), LDS_BYTES, stream, a);
#else
    for (int p = 0; p < N_PHASES; ++p) { a.ph_lo = p; a.ph_hi = p + 1; hipLaunchKernelGGL(mega, dim3(grid), dim3(512), LDS_BYTES, stream, a); }
#endif
}
```

```cpp
#include <hip/hip_runtime.h>
#include <cstdio>
#include <cstdint>
namespace pg8 {
#define PG8_LAS __attribute__((address_space(3)))
typedef unsigned short bf16_t;
typedef short bf16x8 __attribute__((ext_vector_type(8)));
typedef float f32x4 __attribute__((ext_vector_type(4)));
typedef unsigned u32x4 __attribute__((ext_vector_type(4)));
constexpr int BM = 256, BK = 64, HALF = 128, HTB = HALF * BK * 2  , STAGE_BYTES = 8 * HTB, NXCD = 8, WGM = 8;

__host__ __device__ __forceinline__ int lds_byte(int r, int c) { const int st = (r >> 4) * 2 + (c >> 5), rr = r & 15, cc = c & 31, ob = rr * 64 + cc * 2; return st * 1024 + (ob ^ (((ob >> 9) & 1) << 5)); }
__host__ __device__ __forceinline__ void stage_rc(int b, int& R, int& C) { const int st = b / 1024, sb = b % 1024, swz = sb ^ (((sb >> 9) & 1) << 5); R = (st >> 1) * 16 + swz / 64; C = (st & 1) * 32 + (swz % 64) / 2; }
__host__ __device__ __forceinline__ int perm32(int rho) { const int n = rho >> 4, i = rho & 15; return 8 * (i >> 2) + 4 * n + (i & 3); }

struct Unit { int pm, pn; };
struct Gemm { const bf16_t* A; const bf16_t* Bt; int M, N, K; };

struct StaticOrder {
    int nM, nN, nwg, G, c;
    __host__ __device__ void init(int M, int N, int G_, int c_) { nM = M / BM; nN = N / BM; nwg = nM * nN; G = G_; c = c_; }
    __host__ __device__ bool next(int i, Unit& u) const {
        const long L = (long)i * G + c; if (L >= nwg) return false;
        int wgid = (int)L; { const int q = nwg / NXCD, r = nwg % NXCD, xcd = wgid % NXCD, off = wgid / NXCD; wgid = (xcd < r ? xcd * (q + 1) : r * (q + 1) + (xcd - r) * q) + off; }
        const int nig = WGM * nN, gid = wgid / nig, fm = gid * WGM, gsz = (nM - fm) < WGM ? (nM - fm) : WGM;
        u.pm = fm + ((wgid % nig) % gsz); u.pn = (wgid % nig) / gsz; return true;
    }
    __device__ __forceinline__ void a_ready(const Unit&) const {}
    __device__ __forceinline__ void done(const Unit&) const {}
};

__device__ __forceinline__ unsigned cvt_pk_bf16(float lo, float hi) { unsigned r; asm volatile("v_cvt_pk_bf16_f32 %0, %1, %2" : "=v"(r) : "v"(lo), "v"(hi)); return r; }
typedef float f32x2 __attribute__((ext_vector_type(2)));
__device__ __forceinline__ f32x2 gelu_pk(f32x2 v) {
    const f32x2 av = __builtin_elementwise_abs(v), d = av * 0.2316418882f + 1.0f;
    f32x2 t; t.x = __builtin_amdgcn_rcpf(d.x); t.y = __builtin_amdgcn_rcpf(d.y);
    f32x2 q = t * 0.5307027145f + (-0.7265760135f); q = q * t + 0.7107068705f; q = q * t + (-0.142248368f); q = q * t + 0.127414796f; q = q * t;
    const f32x2 s = (v * v) * (-0.72134752044f);
    f32x2 e; e.x = __builtin_amdgcn_exp2f(s.x); e.y = __builtin_amdgcn_exp2f(s.y);
    const f32x2 m = v * (q * e), r = v - m;
    f32x2 o; o.x = v.x < 0.f ? m.x : r.x; o.y = v.y < 0.f ? m.y : r.y; return o;
}

template <int ACT  > struct EpiBf16 {
    static constexpr bool PERM = true, AFTER_DRAIN = false; static_assert(ACT == 0 || ACT == 1, "EpiBf16: ACT is 0 (none) or 1 (gelu_pk)");
    bf16_t* O; int ldc; const float* bias; int split_cols; size_t split_stride; float scale0;
    __device__ __forceinline__ void operator()(const f32x4 (&acc)[2][2][4][2], const Unit& u, int wr, int wc, int fr, int fq) const {
        const int row0 = u.pm * BM + wr * 64 + fr; int colt = u.pn * BM; bf16_t* base = O;
        float sc = 1.f; if (split_cols) { const int t = colt / split_cols; base += (size_t)t * split_stride; colt -= t * split_cols; if (t == 0) sc = scale0; }
        const int col0 = colt + wc * 32 + 8 * fq, bcol0 = u.pn * BM + wc * 32 + 8 * fq;
        f32x4 bv[2][2];
#pragma unroll
        for (int bj = 0; bj < 2; ++bj)
#pragma unroll
            for (int n = 0; n < 2; ++n) bv[bj][n] = bias ? *(const f32x4*)(bias + bcol0 + bj * HALF + 4 * n) : (f32x4){0.f, 0.f, 0.f, 0.f};
#pragma unroll
        for (int ai = 0; ai < 2; ++ai)
#pragma unroll
            for (int m = 0; m < 4; ++m) { bf16_t* rowp = base + (size_t)(row0 + ai * HALF + m * 16) * ldc + col0;
#pragma unroll
                for (int bj = 0; bj < 2; ++bj) { f32x4 v0 = acc[ai][bj][m][0] + bv[bj][0], v1 = acc[ai][bj][m][1] + bv[bj][1];
                    if (ACT == 1) { f32x2 a = gelu_pk((f32x2){v0[0], v0[1]}), b = gelu_pk((f32x2){v0[2], v0[3]}), c = gelu_pk((f32x2){v1[0], v1[1]}), d = gelu_pk((f32x2){v1[2], v1[3]});
                        v0 = (f32x4){a.x, a.y, b.x, b.y}; v1 = (f32x4){c.x, c.y, d.x, d.y}; }
                    v0 = v0 * sc; v1 = v1 * sc; u32x4 w; w.x = cvt_pk_bf16(v0[0], v0[1]); w.y = cvt_pk_bf16(v0[2], v0[3]); w.z = cvt_pk_bf16(v1[0], v1[1]); w.w = cvt_pk_bf16(v1[2], v1[3]);
                    *(u32x4*)(rowp + bj * HALF) = w; } }
    }
};
template <class Epi, class Sched, bool ALIGN_EPI = false, bool SP2 = false>
__device__ __forceinline__ void gemm_phase(PG8_LAS unsigned char* lds, const Gemm g, const Sched& S, const Epi& E, const int tid_in) {
    const int tid = tid_in, wid = __builtin_amdgcn_readfirstlane(tid >> 6), lane = tid & 63, wr = wid >> 2, wc = wid & 3, fr = lane & 15, fq = lane >> 4;
    const int K = g.K, nt = K / BK;
    unsigned voffA[2], voffB[2];
#pragma unroll
    for (int i = 0; i < 2; ++i) { int R, C; stage_rc(tid * 16 + i * 8192, R, C); const int Rb = Epi::PERM ? ((R & ~31) + perm32(R & 31)) : R;
        voffA[i] = (unsigned)(R * K + C) * 2u; voffB[i] = (unsigned)(Rb * K + C) * 2u; }
    const size_t kstep = (size_t)(BK * 2);
    const size_t hstep = (size_t)HALF * K * 2;
    const size_t tstep = 2 * hstep;
    const unsigned ldsw = (unsigned)wid * 1024u;
    const int aoff = lds_byte(wr * 64 + fr, fq * 8), boff = lds_byte(wc * 32 + fr, fq * 8);
#define PG8_SA(b, h) (((b) * 2 + (h)) * HTB)
#define PG8_SB(b, h) ((4 + (b) * 2 + (h)) * HTB)
#define PG8_STAGE(bufoff, gbase, voff) do { _Pragma("unroll") for (int _i = 0; _i < 2; ++_i) \
        __builtin_amdgcn_global_load_lds((const unsigned*)((const char*)(gbase) + (voff)[_i]), (PG8_LAS unsigned*)(lds + (bufoff) + ldsw + _i * 8192), 16, 0, 0); } while (0)
#define PG8_LDA(dst, b, h) do { _Pragma("unroll") for (int m = 0; m < 4; ++m) _Pragma("unroll") for (int k = 0; k < 2; ++k) dst[m][k] = *(const PG8_LAS bf16x8*)(lds + PG8_SA(b, h) + aoff + m * 2048 + k * 1024); } while (0)
#define PG8_LDB(dst, b, h) do { _Pragma("unroll") for (int n = 0; n < 2; ++n) _Pragma("unroll") for (int k = 0; k < 2; ++k) dst[n][k] = *(const PG8_LAS bf16x8*)(lds + PG8_SB(b, h) + boff + n * 2048 + k * 1024); } while (0)
#define PG8_MMA(ai, bj, At, Bt) do { __builtin_amdgcn_s_setprio(1); _Pragma("unroll") for (int m = 0; m < 4; ++m) _Pragma("unroll") for (int n = 0; n < 2; ++n) _Pragma("unroll") for (int k = 0; k < 2; ++k) \
        acc[ai][bj][m][n] = __builtin_amdgcn_mfma_f32_16x16x32_bf16(Bt[n][k], At[m][k], acc[ai][bj][m][n], 0, 0, 0); __builtin_amdgcn_s_setprio(0); } while (0)
#define PG8_WAIT_V(n) asm volatile("s_waitcnt vmcnt(" #n ")" ::: "memory")
#define PG8_WAIT_L(n) asm volatile("s_waitcnt lgkmcnt(" #n ")" ::: "memory")
#define PG8_BAR __builtin_amdgcn_s_barrier()
#define PG8_SCHED __builtin_amdgcn_sched_barrier(0)
    Unit cur, nxt; int ui = 0;
    if (!S.next(0, cur)) return;
    f32x4 acc[2][2][4][2];
#pragma unroll
    for (int a = 0; a < 2; ++a)
#pragma unroll
        for (int b = 0; b < 2; ++b)
#pragma unroll
            for (int m = 0; m < 4; ++m)
#pragma unroll
                for (int n = 0; n < 2; ++n) acc[a][b][m][n] = (f32x4){0.f, 0.f, 0.f, 0.f};
    bf16x8 At[4][2], B0[2][2], B1[2][2];
    const char* cA = (const char*)g.A + (size_t)cur.pm * tstep; const char* cB = (const char*)g.Bt + (size_t)cur.pn * tstep;
    S.a_ready(cur);
    if constexpr (SP2) {
        PG8_STAGE(PG8_SB(0, 0), cB, voffB); PG8_STAGE(PG8_SB(0, 1), cB + hstep, voffB); PG8_STAGE(PG8_SA(0, 0), cA, voffA); PG8_STAGE(PG8_SA(0, 1), cA + hstep, voffA);
        if (wr == 1) PG8_BAR;
        PG8_WAIT_V(2); PG8_BAR;
        PG8_STAGE(PG8_SB(1, 0), cB + kstep, voffB); PG8_STAGE(PG8_SA(1, 0), cA + kstep, voffA); PG8_STAGE(PG8_SB(1, 1), cB + hstep + kstep, voffB);
        PG8_WAIT_V(6); PG8_BAR;
    } else {
        PG8_STAGE(PG8_SB(0, 0), cB, voffB); PG8_STAGE(PG8_SA(0, 0), cA, voffA); PG8_STAGE(PG8_SB(0, 1), cB + hstep, voffB); PG8_STAGE(PG8_SA(0, 1), cA + hstep, voffA);
        if (wr == 1) PG8_BAR;
        PG8_WAIT_V(4); PG8_BAR;
        PG8_STAGE(PG8_SB(1, 0), cB + kstep, voffB); PG8_STAGE(PG8_SA(1, 0), cA + kstep, voffA); PG8_STAGE(PG8_SB(1, 1), cB + hstep + kstep, voffB);
        PG8_WAIT_V(6); PG8_BAR;
    }
    for (;;) {
        const bool has_next = S.next(ui + 1, nxt);
        const char* nA = has_next ? (const char*)g.A + (size_t)nxt.pm * tstep : cA; const char* nB = has_next ? (const char*)g.Bt + (size_t)nxt.pn * tstep : cB;
        for (int t = 0; t < nt; t += 2) {
            const bool last = (t == nt - 2);
            const char* a1 = cA + (size_t)(t + 1) * kstep;
            const char* a2 = last ? nA : cA + (size_t)(t + 2) * kstep; const char* b2 = last ? nB : cB + (size_t)(t + 2) * kstep;
            const char* a3 = a2 + kstep; const char* b3 = b2 + kstep;
            if (last && has_next) S.a_ready(nxt);
            if constexpr (SP2) {
            PG8_LDB(B0, 0, 0); PG8_LDB(B1, 0, 1); PG8_SCHED; PG8_LDA(At, 0, 0); PG8_STAGE(PG8_SA(1, 1), a1 + hstep, voffA);
            PG8_WAIT_V(8); PG8_WAIT_L(0); PG8_BAR; PG8_MMA(0, 0, At, B0); PG8_MMA(0, 1, At, B1); PG8_BAR; PG8_SCHED;
            PG8_LDA(At, 0, 1); PG8_STAGE(PG8_SB(0, 0), b2, voffB); PG8_STAGE(PG8_SB(0, 1), b2 + hstep, voffB); PG8_STAGE(PG8_SA(0, 0), a2, voffA);
            PG8_WAIT_V(8); PG8_WAIT_L(0); PG8_BAR; PG8_MMA(1, 0, At, B0); PG8_MMA(1, 1, At, B1); PG8_BAR; PG8_SCHED;
            PG8_LDB(B0, 1, 0); PG8_LDB(B1, 1, 1); PG8_SCHED; PG8_LDA(At, 1, 0); PG8_STAGE(PG8_SA(0, 1), a2 + hstep, voffA);
            PG8_WAIT_V(8); PG8_WAIT_L(0); PG8_BAR; PG8_MMA(0, 0, At, B0); PG8_MMA(0, 1, At, B1); PG8_BAR; PG8_SCHED;
            PG8_LDA(At, 1, 1); PG8_STAGE(PG8_SB(1, 0), b3, voffB); PG8_STAGE(PG8_SB(1, 1), b3 + hstep, voffB); PG8_STAGE(PG8_SA(1, 0), a3, voffA);
            PG8_WAIT_V(8); PG8_WAIT_L(0); PG8_BAR; PG8_MMA(1, 0, At, B0); PG8_MMA(1, 1, At, B1); PG8_BAR; PG8_SCHED;
            } else {
            PG8_LDB(B0, 0, 0); PG8_SCHED; PG8_LDA(At, 0, 0); PG8_STAGE(PG8_SA(1, 1), a1 + hstep, voffA);
            PG8_WAIT_L(8); PG8_BAR; PG8_WAIT_L(0); PG8_MMA(0, 0, At, B0); PG8_BAR; PG8_SCHED;
            PG8_LDB(B1, 0, 1); PG8_STAGE(PG8_SB(0, 0), b2, voffB);
            PG8_BAR; PG8_WAIT_L(0); PG8_MMA(0, 1, At, B1); PG8_BAR;
            PG8_LDA(At, 0, 1); PG8_STAGE(PG8_SA(0, 0), a2, voffA);
            PG8_BAR; PG8_WAIT_L(0); PG8_MMA(1, 0, At, B0); PG8_BAR; PG8_SCHED;
            PG8_STAGE(PG8_SB(0, 1), b2 + hstep, voffB);
            PG8_WAIT_V(6); PG8_BAR; PG8_MMA(1, 1, At, B1); PG8_BAR;
            PG8_LDB(B0, 1, 0); PG8_SCHED; PG8_LDA(At, 1, 0); PG8_STAGE(PG8_SA(0, 1), a2 + hstep, voffA);
            PG8_WAIT_L(8); PG8_BAR; PG8_WAIT_L(0); PG8_MMA(0, 0, At, B0); PG8_BAR; PG8_SCHED;
            PG8_LDB(B1, 1, 1); PG8_STAGE(PG8_SB(1, 0), b3, voffB);
            PG8_BAR; PG8_WAIT_L(0); PG8_MMA(0, 1, At, B1); PG8_BAR;
            PG8_LDA(At, 1, 1); PG8_STAGE(PG8_SA(1, 0), a3, voffA);
            PG8_BAR; PG8_WAIT_L(0); PG8_MMA(1, 0, At, B0); PG8_BAR; PG8_SCHED;
            PG8_STAGE(PG8_SB(1, 1), b3 + hstep, voffB);
            PG8_WAIT_V(6); PG8_BAR; PG8_MMA(1, 1, At, B1); PG8_BAR;
            }
        }
        if constexpr (ALIGN_EPI) { if (wr == 0) PG8_BAR; }
        if constexpr (!Epi::AFTER_DRAIN) { E(acc, cur, wr, wc, fr, fq); S.done(cur); }
        if (!has_next) break;
#pragma unroll
        for (int a = 0; a < 2; ++a)
#pragma unroll
            for (int b = 0; b < 2; ++b)
#pragma unroll
                for (int m = 0; m < 4; ++m)
#pragma unroll
                    for (int n = 0; n < 2; ++n) acc[a][b][m][n] = (f32x4){0.f, 0.f, 0.f, 0.f};
        cur = nxt; cA = nA; cB = nB; ++ui;
        if constexpr (ALIGN_EPI) { if (wr == 1) PG8_BAR; }
    }
    PG8_WAIT_V(0);
    if constexpr (!ALIGN_EPI) { if (wr == 0) PG8_BAR; }
    PG8_BAR;
    if constexpr (Epi::AFTER_DRAIN) { E.fused(acc, cur, wr, wc, fr, fq, lds, wid, lane); S.done(cur); }
#undef PG8_SA
#undef PG8_SB
#undef PG8_STAGE
#undef PG8_LDA
#undef PG8_LDB
#undef PG8_MMA
#undef PG8_WAIT_V
#undef PG8_WAIT_L
#undef PG8_BAR
#undef PG8_SCHED
}
}

#ifndef MK_SINGLE
#define MK_SINGLE 1
#endif
constexpr int BATCH = 32, SEQ = 2048, DM = 1024, M = BATCH * SEQ;
constexpr int NIN = 3336, NPROJ = 3328;
constexpr int DFF = 2816, NUP = 2 * DFF;
constexpr int C_Q = 1792, C_K = 2048, C_V = 2304, C_O = 2816;
constexpr int NLORA = 1536, KLORA = 256;
constexpr int MH = M / 2;
constexpr float NORM_EPS = 1e-6f, LNX_EPS = 64e-5f;

constexpr size_t MiB = 1u << 20;
constexpr size_t WS_CTL = 0, CTL_ZERO_BYTES = 1 * MiB;
constexpr size_t WS_WT_IN = 2 * MiB, WS_WT_OUT = 9 * MiB, WS_WT_UP = 11 * MiB, WS_WT_DN = 22 * MiB, WS_WT_LORA = 28 * MiB;
constexpr size_t WS_RS2 = 29 * MiB, WS_RINV = 29 * MiB + 512 * 1024, WS_SSQP = 30 * MiB, WS_GATES = 34 * MiB;
constexpr size_t WS_XN = 40 * MiB;
constexpr size_t WS_PROJ = 168 * MiB;
constexpr size_t WS_LBUF = 584 * MiB;
constexpr size_t WS_DAG = 616 * MiB;
constexpr size_t WS_MIX = 808 * MiB;
constexpr size_t WS_SIDE = 168 * MiB;
constexpr int SIDE_ELEMS = 256 * 22 * 2 * 128;
constexpr size_t WS_FF = 192 * MiB;
constexpr size_t WS_GB = 520 * MiB;
constexpr size_t WS_END = 936 * MiB;

constexpr int LDS_BYTES = 163840;
constexpr int MISC_OFF = LDS_BYTES - 256;

#define GAS __attribute__((address_space(1)))
#define LAS __attribute__((address_space(3)))
typedef unsigned short bf16;
typedef unsigned v4u __attribute__((ext_vector_type(4)));
typedef unsigned v2u __attribute__((ext_vector_type(2)));
typedef float f32x4 __attribute__((ext_vector_type(4)));
typedef float f32x2 __attribute__((ext_vector_type(2)));
typedef short bf16x8 __attribute__((ext_vector_type(8)));
typedef GAS unsigned gu32;

typedef __bf16 bf16x2_t __attribute__((ext_vector_type(2)));
__device__ __forceinline__ unsigned pk2(float lo, float hi) { const f32x2 v = {lo, hi}; const bf16x2_t b = __builtin_convertvector(v, bf16x2_t); return __builtin_bit_cast(unsigned, b); }
__device__ __forceinline__ unsigned f2bf(float f) { return pk2(f, f) & 0xffffu; }
__device__ __forceinline__ float bf2f(unsigned short u) { return __builtin_bit_cast(float, (unsigned)u << 16); }
__device__ __forceinline__ float bflo(unsigned w) { return __builtin_bit_cast(float, w << 16); }
__device__ __forceinline__ float bfhi(unsigned w) { return __builtin_bit_cast(float, w & 0xffff0000u); }
__device__ __forceinline__ void unpack8(const v4u w, float (&o)[8]) { o[0] = bflo(w.x); o[1] = bfhi(w.x); o[2] = bflo(w.y); o[3] = bfhi(w.y); o[4] = bflo(w.z); o[5] = bfhi(w.z); o[6] = bflo(w.w); o[7] = bfhi(w.w); }
__device__ __forceinline__ v4u pack8(const float (&o)[8]) { v4u w; w.x = pk2(o[0], o[1]); w.y = pk2(o[2], o[3]); w.z = pk2(o[4], o[5]); w.w = pk2(o[6], o[7]); return w; }
__device__ __forceinline__ float frcp(float x) { return __builtin_amdgcn_rcpf(x); }
__device__ __forceinline__ float frsq(float x) { return __builtin_amdgcn_rsqf(x); }
__device__ __forceinline__ float fsqrt_(float x) { return __builtin_amdgcn_sqrtf(x); }
__device__ __forceinline__ float fexp(float x) { return __builtin_amdgcn_exp2f(x * 1.4426950408889634f); }
__device__ __forceinline__ float sigmoidf_(float x) { return frcp(1.0f + __builtin_amdgcn_exp2f(x * -1.4426950408889634f)); }
__device__ __forceinline__ float tanhf_(float x) { return 1.0f - 2.0f * frcp(__builtin_amdgcn_exp2f(x * 2.8853900817779268f) + 1.0f); }
__device__ __forceinline__ float softplusf_(float x) { return fmaxf(x, 0.f) + __logf(1.0f + fexp(-fabsf(x))); }
__device__ __forceinline__ float wave_sum(float v) {
#pragma unroll
    for (int o = 1; o < 64; o <<= 1) v += __shfl_xor(v, o);
    return v;
}
template <int CTRL> __device__ __forceinline__ float dppmov(float v) { return __builtin_bit_cast(float, __builtin_amdgcn_update_dpp(0, __builtin_bit_cast(int, v), CTRL, 0xF, 0xF, true)); }
__device__ __forceinline__ float red8(float v) { v += dppmov<0xB1>(v); v += dppmov<0x4E>(v); v += dppmov<0x141>(v); return v; }
__device__ __forceinline__ float red16(float v) { v += dppmov<0xB1>(v); v += dppmov<0x4E>(v); v += dppmov<0x141>(v); v += dppmov<0x140>(v); return v; }

template <int CTRL, int RMASK> __device__ __forceinline__ float dppsh(float idv, float v) { return __builtin_bit_cast(float, __builtin_amdgcn_update_dpp(__builtin_bit_cast(int, idv), __builtin_bit_cast(int, v), CTRL, RMASK, 0xF, false)); }
__device__ __forceinline__ float wave_scan_add(float v) {
    v += dppsh<0x111, 0xF>(0.f, v); v += dppsh<0x112, 0xF>(0.f, v); v += dppsh<0x114, 0xF>(0.f, v); v += dppsh<0x118, 0xF>(0.f, v);
    v += dppsh<0x142, 0xA>(0.f, v); v += dppsh<0x143, 0xC>(0.f, v); return v;
}
__device__ __forceinline__ float wave_scan_max(float v) {
    const float ni = -3.0e38f;
    v = fmaxf(v, dppsh<0x111, 0xF>(ni, v)); v = fmaxf(v, dppsh<0x112, 0xF>(ni, v)); v = fmaxf(v, dppsh<0x114, 0xF>(ni, v)); v = fmaxf(v, dppsh<0x118, 0xF>(ni, v));
    v = fmaxf(v, dppsh<0x142, 0xA>(ni, v)); v = fmaxf(v, dppsh<0x143, 0xC>(ni, v)); return v;
}

#define XB_TMO      128
#define XB_XCNT(j)  (256  + 64 * (j))
#define XB_XSUB(j)  (1280 + 64 * (j))
#define XB_XGEN(j)  (2304 + 64 * (j))
#define XB_TOP      3328
#define XB_TOPGEN   3392
#define XCD_BAR_WORDS 3456
#define XB_SPIN_CAP (1u << 22)
__device__ __forceinline__ unsigned xb_ld(unsigned* p)              { return __hip_atomic_load(p, __ATOMIC_RELAXED, __HIP_MEMORY_SCOPE_AGENT); }
__device__ __forceinline__ unsigned xb_add(unsigned* p, unsigned v) { return __hip_atomic_fetch_add(p, v, __ATOMIC_RELAXED, __HIP_MEMORY_SCOPE_AGENT); }
__device__ __forceinline__ unsigned xb_xcc_id() { return (unsigned)__builtin_amdgcn_s_getreg((3 << 11) | 20) & 0xFu; }
#define XB_SPIN(cond, bar) do { unsigned _sp = 0; while (cond) { __builtin_amdgcn_s_sleep(1); \
    if ((++_sp & 255u) == 0u) { if (xb_ld(&(bar)[XB_TMO])) break; if (_sp > XB_SPIN_CAP) { atomicAdd(&(bar)[XB_TMO], 1u); break; } } } } while (0)
struct XcdBarrier { unsigned* bar; unsigned x; volatile LAS unsigned* st; };
__device__ __forceinline__ XcdBarrier xcd_barrier_post(unsigned* bar, volatile LAS unsigned* st, bool leader) {
    XcdBarrier b; b.bar = bar; b.x = xb_xcc_id(); b.st = st;
    if (leader) (void)xb_add(&bar[XB_XCNT(b.x)], 1u);
    return b;
}
__device__ __forceinline__ void xcd_barrier_complete(unsigned* bar, unsigned x, unsigned& nloc, unsigned& nx) {
    const unsigned G = gridDim.x * gridDim.y * gridDim.z;
    unsigned sum, cnt, mine, sp = 0u;
    for (;;) {
        sum = 0u; cnt = 0u; mine = 0u;
#pragma unroll
        for (unsigned j = 0; j < 16; ++j) { const unsigned c = xb_ld(&bar[XB_XCNT(j)]); sum += c; cnt += (c > 0u) ? 1u : 0u; mine = (j == x) ? c : mine; }
        if (sum == G) break;
        __builtin_amdgcn_s_sleep(1);
        if ((++sp & 255u) == 0u) { if (xb_ld(&bar[XB_TMO])) break; if (sp > XB_SPIN_CAP) { atomicAdd(&bar[XB_TMO], 1u); break; } }
    }
    nloc = mine > 0u ? mine : 1u; nx = cnt > 0u ? cnt : 1u;
}
__device__ __forceinline__ void xcd_barrier(const XcdBarrier& b, bool leader) {
    asm volatile("s_waitcnt vmcnt(0)" ::: "memory");
    __syncthreads();
    if (leader) {
        unsigned* bar = b.bar;
        __builtin_amdgcn_s_waitcnt(0);
        unsigned nloc = b.st[0], nx = b.st[1];
        if (nloc == 0u) { xcd_barrier_complete(bar, b.x, nloc, nx); b.st[0] = nloc; b.st[1] = nx; }
        const unsigned old = xb_add(&bar[XB_XSUB(b.x)], 1u);
        const unsigned gen = old / nloc;
        if (old + 1u == (gen + 1u) * nloc) {
            __builtin_amdgcn_fence(__ATOMIC_RELEASE, "agent");
            asm volatile("s_waitcnt vmcnt(0)" ::: "memory");
            const unsigned og = xb_add(&bar[XB_TOP], 1u);
            const unsigned tg = og / nx;
            if (og + 1u == (tg + 1u) * nx) xb_add(&bar[XB_TOPGEN], 1u);
            else XB_SPIN(xb_ld(&bar[XB_TOPGEN]) == tg, bar);
            __builtin_amdgcn_fence(__ATOMIC_ACQUIRE, "agent");
            xb_add(&bar[XB_XGEN(b.x)], 1u);
            asm volatile("s_waitcnt vmcnt(0)" ::: "memory");
        } else {
            XB_SPIN(xb_ld(&bar[XB_XGEN(b.x)]) == gen, bar);
            __builtin_amdgcn_fence(__ATOMIC_ACQUIRE, "agent");
            asm volatile("s_waitcnt vmcnt(0)" ::: "memory");
        }
    }
    __syncthreads();
}

__device__ __forceinline__ int opaque_i(int v) { asm volatile("" : "+s"(v)); return v; }
#define LDS_BARRIER() do { asm volatile("s_waitcnt lgkmcnt(0)" ::: "memory"); __builtin_amdgcn_s_barrier(); asm volatile("" ::: "memory"); } while (0)
__device__ __forceinline__ int mk_lane_id() { int x; asm volatile("v_mbcnt_lo_u32_b32 %0, -1, 0\n\tv_mbcnt_hi_u32_b32 %0, -1, %0" : "=v"(x)); return x; }
struct Args { const float* in[26]; float* out; unsigned char* ws; int ph_lo, ph_hi; };

namespace pg8 {
struct PairPanelOrder {
    int c;
    __device__ bool next(int i, Unit& u) const { if (i >= 12) return false; u.pm = 2 * c + i / 6; u.pn = i % 6; return true; }
    __device__ __forceinline__ void a_ready(const Unit&) const {}
    __device__ __forceinline__ void done(const Unit&) const {}
};
struct PanelOrder {
    int c;
    __device__ bool next(int i, Unit& u) const { if (i >= 4) return false; u.pm = c; u.pn = i; return true; }
    __device__ __forceinline__ void a_ready(const Unit&) const {}
    __device__ __forceinline__ void done(const Unit&) const {}
};
struct EpiResid {
    static constexpr bool PERM = true, AFTER_DRAIN = false;
    bf16_t* XB; const float* rinv; float* ssqp;
    __device__ __forceinline__ void operator()(const f32x4 (&acc)[2][2][4][2], const Unit& u, int wr, int wc, int fr, int fq) const {
        const int row0 = u.pm * BM + wr * 64 + fr, col0 = u.pn * BM + wc * 32 + 8 * fq;
#pragma unroll
        for (int ai = 0; ai < 2; ++ai)
#pragma unroll
            for (int m = 0; m < 4; ++m) { const int row = row0 + ai * HALF + m * 16; float ss = 0.f; const float ri = rinv[row];
#pragma unroll
                for (int bj = 0; bj < 2; ++bj) { const size_t off = (size_t)row * DM + col0 + bj * HALF;
                    float xv[8]; unpack8(*(const u32x4*)(XB + off), xv);
                    float v[8];
#pragma unroll
                    for (int j = 0; j < 4; ++j) { v[j] = acc[ai][bj][m][0][j] + xv[j] * ri; v[4 + j] = acc[ai][bj][m][1][j] + xv[4 + j] * ri; }
#pragma unroll
                    for (int j = 0; j < 8; ++j) ss += v[j] * v[j];
                    *(u32x4*)(XB + off) = pack8(v); }
                ss += __shfl_xor(ss, 16); ss += __shfl_xor(ss, 32);
                if (fq == 0) ssqp[(size_t)row * 16 + u.pn * 4 + wc] = ss; }
    }
};
struct EpiScale {
    static constexpr bool PERM = true, AFTER_DRAIN = false;
    bf16_t* O; int ldc; const float* rs; int row_off;
    __device__ __forceinline__ void operator()(const f32x4 (&acc)[2][2][4][2], const Unit& u, int wr, int wc, int fr, int fq) const {
        const int row0 = u.pm * BM + wr * 64 + fr, col0 = u.pn * BM + wc * 32 + 8 * fq;
#pragma unroll
        for (int ai = 0; ai < 2; ++ai)
#pragma unroll
            for (int m = 0; m < 4; ++m) { const int row = row0 + ai * HALF + m * 16; const float s = rs[row_off + row]; bf16_t* rowp = O + (size_t)row * ldc + col0;
#pragma unroll
                for (int bj = 0; bj < 2; ++bj) { const f32x4 v0 = acc[ai][bj][m][0] * s, v1 = acc[ai][bj][m][1] * s;
                    u32x4 w; w.x = pk2(v0[0], v0[1]); w.y = pk2(v0[2], v0[3]); w.z = pk2(v1[0], v1[1]); w.w = pk2(v1[2], v1[3]); *(u32x4*)(rowp + bj * HALF) = w; } }
    }
};
struct EpiFfn {
    static constexpr bool PERM = true, AFTER_DRAIN = false;
    bf16_t* G; const float* rs; const float* cw; const float* cb; float* SA; float* SB; float* SL; LAS float* hal;
    __device__ __forceinline__ void operator()(const f32x4 (&acc)[2][2][4][2], const Unit& u, int wr, int wc, int fr, int fq) const {
        int chl = wc * 32 + 8 * fq; asm volatile("" : "+v"(chl));
        const int f0 = u.pn * 128 + chl, rowt = wr * 64 + fr;
        float rsv[2][4];
#pragma unroll
        for (int ai = 0; ai < 2; ++ai)
#pragma unroll
            for (int m = 0; m < 4; ++m) rsv[ai][m] = rs[u.pm * BM + ai * HALF + m * 16 + rowt];
        const size_t sbase = ((size_t)(u.pm * 22 + u.pn) * 2) * 128 + chl;
        if (fr >= 14) {
#pragma unroll
            for (int ai = 0; ai < 2; ++ai) { const float r_ = rsv[ai][3]; const f32x4 v0 = acc[ai][0][3][0] * r_, v1 = acc[ai][0][3][1] * r_;
                LAS float* hp = hal + ((ai * 2 + wr) * 2 + (fr - 14)) * 128 + chl; *(LAS f32x4*)hp = v0; *(LAS f32x4*)(hp + 4) = v1;
                if (ai == 1 && wr == 1) { float* gp = SL + sbase + (fr - 14) * 128; *(f32x4*)gp = v0; *(f32x4*)(gp + 4) = v1; } }
        }
        if (wr == 0 && fr < 2) { const float r_ = rsv[0][0]; float* ga = SA + sbase + fr * 128; float* gb = SB + sbase + fr * 128;
            *(f32x4*)ga = acc[0][0][0][0] * r_; *(f32x4*)(ga + 4) = acc[0][0][0][1] * r_; *(f32x4*)gb = acc[0][1][0][0] * r_; *(f32x4*)(gb + 4) = acc[0][1][0][1] * r_; }
        asm volatile("s_waitcnt lgkmcnt(0)" ::: "memory"); __builtin_amdgcn_s_barrier(); asm volatile("" ::: "memory");
        float w0[8], w1[8], w2[8], bz[8];
        { const f32x4 a0 = *(const f32x4*)(cw + f0), a1 = *(const f32x4*)(cw + f0 + 4), b0 = *(const f32x4*)(cw + DFF + f0), b1 = *(const f32x4*)(cw + DFF + f0 + 4);
          const f32x4 c0 = *(const f32x4*)(cw + 2 * DFF + f0), c1 = *(const f32x4*)(cw + 2 * DFF + f0 + 4), d0 = *(const f32x4*)(cb + f0), d1 = *(const f32x4*)(cb + f0 + 4);
#pragma unroll
          for (int j = 0; j < 4; ++j) { w0[j] = a0[j]; w0[4 + j] = a1[j]; w1[j] = b0[j]; w1[4 + j] = b1[j]; w2[j] = c0[j]; w2[4 + j] = c1[j]; bz[j] = d0[j]; bz[4 + j] = d1[j]; } }
        const bool fr0 = (fr == 0), frl2 = (fr < 2); (void)fr0;
#pragma unroll
        for (int ai = 0; ai < 2; ++ai) {
            float ap[8];
            const int pb = ai * 2 + wr - 1;
#pragma unroll
            for (int m = 0; m < 4; ++m) {
                float av[8], bv[8], y1[8], y2[8];
                const float r_ = rsv[ai][m];
#pragma unroll
                for (int j = 0; j < 4; ++j) { av[j] = acc[ai][0][m][0][j] * r_; av[4 + j] = acc[ai][0][m][1][j] * r_; bv[j] = acc[ai][1][m][0][j] * r_; bv[4 + j] = acc[ai][1][m][1][j] * r_; }
                if (m == 0) {
                    if (pb >= 0) { const LAS float* h0 = hal + (pb * 2) * 128 + chl; const f32x4 h00 = *(const LAS f32x4*)h0, h01 = *(const LAS f32x4*)(h0 + 4), h10 = *(const LAS f32x4*)(h0 + 128), h11 = *(const LAS f32x4*)(h0 + 132);
#pragma unroll
                        for (int j = 0; j < 4; ++j) { y1[j] = h10[j]; y1[4 + j] = h11[j]; y2[j] = fr0 ? h00[j] : h10[j]; y2[4 + j] = fr0 ? h01[j] : h11[j]; } }
                    else {
#pragma unroll
                        for (int j = 0; j < 8; ++j) { y1[j] = 0.f; y2[j] = 0.f; } }
                } else {
#pragma unroll
                    for (int j = 0; j < 8; ++j) { y1[j] = dppmov<0x121>(ap[j]); y2[j] = dppmov<0x122>(ap[j]); }
                }
                float o[8];
#pragma unroll
                for (int j = 0; j < 8; ++j) { const float am1 = dppsh<0x111, 0xF>(y1[j], av[j]), am2 = dppsh<0x112, 0xF>(y2[j], av[j]);
                    const float z = bz[j] + w0[j] * am2 + w1[j] * am1 + w2[j] * av[j];
                    o[j] = z * sigmoidf_(z) * bv[j]; ap[j] = av[j]; }
                if (!(ai == 0 && m == 0 && wr == 0 && frl2)) *(u32x4*)(G + (size_t)(u.pm * BM + ai * HALF + m * 16 + rowt) * DFF + f0) = pack8(o);
            }
        }
    }
};
}

template <bool FFN_UP = false>
__device__ __forceinline__ void transpose_item(const float* W, int ldw, int K, bf16* WT, const float* kscale, LAS float* scr, int item, int nblk, int lane) {
    const int kb = item / nblk, nb = item % nblk, k0 = 64 * kb, n0 = 32 * nb;
    const int d0 = !FFN_UP ? n0 : (n0 < DFF ? ((n0 >> 7) * 256 + (n0 & 127)) : ((((n0 - DFF) >> 7) * 256) + 128 + ((n0 - DFF) & 127)));
#pragma unroll 8
    for (int i = 0; i < 32; ++i) { const int kk = 2 * i + (lane >> 5); const float s = kscale ? kscale[k0 + kk] : 1.0f; scr[kk * 33 + (lane & 31)] = W[(size_t)(k0 + kk) * ldw + n0 + (lane & 31)] * s; }
    asm volatile("s_waitcnt lgkmcnt(0)" ::: "memory");
    const int c = lane & 7;
#pragma unroll
    for (int j = 0; j < 4; ++j) { const int n = (lane >> 3) + 8 * j; const LAS float* s = scr + (8 * c) * 33 + n;
        v4u o; o.x = pk2(s[0 * 33], s[1 * 33]); o.y = pk2(s[2 * 33], s[3 * 33]); o.z = pk2(s[4 * 33], s[5 * 33]); o.w = pk2(s[6 * 33], s[7 * 33]);
        *(v4u*)(WT + (size_t)(d0 + n) * K + k0 + 8 * c) = o; }
    asm volatile("s_waitcnt lgkmcnt(0)" ::: "memory");
}

__device__ __forceinline__ float wave_red63(float v) {
    v += dppmov<0xB1>(v); v += dppmov<0x4E>(v); v += dppmov<0x141>(v); v += dppmov<0x140>(v);
    v += dppsh<0x142, 0xA>(0.f, v); v += dppsh<0x143, 0xC>(0.f, v); return v;
}
__device__ __forceinline__ float lane63(float v) { return __builtin_bit_cast(float, __builtin_amdgcn_readlane(__builtin_bit_cast(int, v), 63)); }
__device__ __forceinline__ void late_transposes(const Args& a, LAS unsigned char* lds, int lane, int wave, int gw, int NGW) {
    unsigned char* ws = a.ws; LAS float* scr = (LAS float*)(lds + wave * 16384);
    constexpr int I_OUT = 16 * 32, I_UP = 16 * 176, I_DN = 44 * 32;
    for (int it = gw; it < I_OUT + I_UP + I_DN; it += NGW) {
        int r = it;
        if (r < I_OUT) { transpose_item(a.in[19], DM, DM, (bf16*)(ws + WS_WT_OUT), nullptr, scr, r, 32, lane); continue; } r -= I_OUT;
        if (r < I_UP) { transpose_item<true>(a.in[21], NUP, DM, (bf16*)(ws + WS_WT_UP), a.in[20], scr, r, 176, lane); continue; } r -= I_UP;
        transpose_item(a.in[24], DM, DFF, (bf16*)(ws + WS_WT_DN), nullptr, scr, r, 32, lane);
    }
}
__device__ __forceinline__ void phase_prep(const Args& a, LAS unsigned char* lds, int tid, int lane, int wave) {
    unsigned char* ws = a.ws;
    LAS float* scr = (LAS float*)(lds + wave * 16384);
    const int gw = blockIdx.x * 8 + wave, NGW = gridDim.x * 8;
    constexpr int I_IN = 16 * 104;
    for (int it = gw; it < I_IN; it += NGW) transpose_item(a.in[2], NIN, DM, (bf16*)(ws + WS_WT_IN), a.in[1], scr, it, 104, lane);
    {
        const float* wd = a.in[5]; const float* wa = a.in[7]; const float* wg = a.in[8]; bf16* WL = (bf16*)(ws + WS_WT_LORA);
        for (int idx = blockIdx.x * 512 + tid; idx < NLORA * KLORA; idx += gridDim.x * 512) {
            const int n = idx >> 8, k = idx & 255; float v = 0.f;
            if (n < 512) { if (k < 64) v = wd[k * 512 + n]; }
            else if (n < 1024) { if (k >= 64 && k < 128) v = wa[(k - 64) * 512 + (n - 512)]; }
            else { if (k >= 128) v = wg[(k - 128) * 512 + (n - 1024)]; }
            WL[idx] = (bf16)f2bf(v);
        }
    }
    {
        const float* x = a.in[0]; const float* g1 = a.in[1]; const float* w_in = a.in[2];
        bf16* XN = (bf16*)(ws + WS_XN); float* gates = (float*)(ws + WS_GATES); float* rinvp = (float*)(ws + WS_RINV);
        float wgt[16][8];
#pragma unroll
        for (int j = 0; j < 4; ++j)
#pragma unroll
            for (int e = 0; e < 4; ++e) { const int k = 4 * lane + 256 * j + e; const float g = g1[k];
                const f32x4 w0 = *(const f32x4*)(w_in + (size_t)k * NIN + 3328), w1 = *(const f32x4*)(w_in + (size_t)k * NIN + 3332);
                wgt[j * 4 + e][0] = w0[0] * g; wgt[j * 4 + e][1] = w0[1] * g; wgt[j * 4 + e][2] = w0[2] * g; wgt[j * 4 + e][3] = w0[3] * g;
                wgt[j * 4 + e][4] = w1[0] * g; wgt[j * 4 + e][5] = w1[1] * g; wgt[j * 4 + e][6] = w1[2] * g; wgt[j * 4 + e][7] = w1[3] * g; }
        f32x4 vn[4];
        { const f32x4* xr = (const f32x4*)(x + (size_t)gw * DM) + lane;
#pragma unroll
          for (int j = 0; j < 4; ++j) vn[j] = xr[64 * j]; }
        for (int row = gw; row < M; row += NGW) {
            f32x4 v[4];
#pragma unroll
            for (int j = 0; j < 4; ++j) v[j] = vn[j];
            { const int rn = (row + NGW < M) ? row + NGW : row; const f32x4* xr = (const f32x4*)(x + (size_t)rn * DM) + lane;
#pragma unroll
              for (int j = 0; j < 4; ++j) vn[j] = xr[64 * j]; }
            float ss = 0.f;
#pragma unroll
            for (int j = 0; j < 4; ++j) ss += (v[j][0] * v[j][0] + v[j][1] * v[j][1]) + (v[j][2] * v[j][2] + v[j][3] * v[j][3]);
            float gs[8];
#pragma unroll
            for (int jg = 0; jg < 8; ++jg) { float s_ = 0.f;
#pragma unroll
                for (int j = 0; j < 4; ++j)
#pragma unroll
                    for (int e = 0; e < 4; ++e) s_ += v[j][e] * wgt[j * 4 + e][jg];
                gs[jg] = s_; }
            ss = wave_red63(ss);
#pragma unroll
            for (int jg = 0; jg < 8; ++jg) gs[jg] = wave_red63(gs[jg]);
            const float ms = lane63(ss) * (1.0f / DM) + NORM_EPS; const float rs = frsq(ms);
            if (lane == 0) rinvp[row] = fsqrt_(ms);
            unsigned long long* o8 = (unsigned long long*)(XN + (size_t)row * DM) + lane;
#pragma unroll
            for (int j = 0; j < 4; ++j) o8[64 * j] = (unsigned long long)pk2(v[j][0] * rs, v[j][1] * rs) | ((unsigned long long)pk2(v[j][2] * rs, v[j][3] * rs) << 32);
            if (lane == 63) { f32x4* gp = (f32x4*)(gates + (size_t)row * 8); gp[0] = (f32x4){gs[0] * rs, gs[1] * rs, gs[2] * rs, gs[3] * rs}; gp[1] = (f32x4){gs[4] * rs, gs[5] * rs, gs[6] * rs, gs[7] * rs}; }
        }
    }
}

__device__ __forceinline__ void phase_lmat(const Args& a, int tid, int row_lo, int nrows) {
    unsigned char* ws = a.ws; const bf16* PROJ = (const bf16*)(ws + WS_PROJ); bf16* L = (bf16*)(ws + WS_LBUF); const float* mu = a.in[3];
    for (int it = tid; it < nrows * 32; it += 512) {
        const int row = row_lo + (it >> 5), grp = it & 31, c0 = 1536 + 8 * grp;
        const v4u cur = *(const v4u*)(PROJ + (size_t)row * NPROJ + c0);
        v4u prv = {0u, 0u, 0u, 0u}; if ((row & (SEQ - 1)) != 0) prv = *(const v4u*)(PROJ + (size_t)(row - 1) * NPROJ + c0);
        const f32x4 m0 = *(const f32x4*)(mu + c0), m1 = *(const f32x4*)(mu + c0 + 4);
        float c[8], p[8], o[8]; unpack8(cur, c); unpack8(prv, p);
#pragma unroll
        for (int e = 0; e < 8; ++e) { const float mm = e < 4 ? m0[e & 3] : m1[e & 3]; const float xv = c[e] + (p[e] - c[e]) * mm;
            o[e] = grp < 8 ? tanhf_(xv) : (grp < 16 ? xv : sigmoidf_(xv)); }
        *(v4u*)(L + (size_t)row * KLORA + 8 * grp) = pack8(o);
    }
}

constexpr int RK_SLOT = 64 * 64;
__device__ __forceinline__ int rk_off(int row, int col) { return row * 64 + ((((col >> 3) ^ row) & 7) << 3) + (col & 7); }
__device__ __forceinline__ f32x4 mfma16(const bf16x8 a, const bf16x8 b, const f32x4 c) { return __builtin_amdgcn_mfma_f32_16x16x32_bf16(a, b, c, 0, 0, 0); }
__device__ __forceinline__ void rk_frag(bf16x8 (&f)[2], const LAS bf16* base, int row0, int l15, int l4) { const LAS bf16* p = base + (row0 + l15) * 64; f[0] = *(const LAS bf16x8*)(p + ((l4 ^ (l15 & 7)) << 3)); f[1] = *(const LAS bf16x8*)(p + (((4 + l4) ^ (l15 & 7)) << 3)); }
template <bool ACC> __device__ __forceinline__ void rk_prod(f32x4 (&acc)[2], const LAS bf16* Aop, const LAS bf16* Bop, int mb, int nb0, int l15, int l4) {
    bf16x8 a[2]; rk_frag(a, Aop, 16 * mb, l15, l4);
#pragma unroll
    for (int q = 0; q < 2; ++q) { bf16x8 b[2]; rk_frag(b, Bop, 16 * (nb0 + q), l15, l4); f32x4 c = ACC ? acc[q] : (f32x4){0.f, 0.f, 0.f, 0.f}; c = mfma16(a[0], b[0], c); acc[q] = mfma16(a[1], b[1], c); }
}
struct RkA { bf16x8 f[2]; };
struct RkB { bf16x8 f[2][2]; };
__device__ __forceinline__ RkA rk_lda(const LAS bf16* base, int mb, int l15, int l4) { RkA r; rk_frag(r.f, base, 16 * mb, l15, l4); return r; }
__device__ __forceinline__ RkB rk_ldb(const LAS bf16* base, int nb0, int l15, int l4) { RkB r; rk_frag(r.f[0], base, 16 * nb0, l15, l4); rk_frag(r.f[1], base, 16 * (nb0 + 1), l15, l4); return r; }
template <bool ACC> __device__ __forceinline__ void rk_mm(f32x4 (&acc)[2], const RkA& a, const RkB& b) {
#pragma unroll
    for (int q = 0; q < 2; ++q) { f32x4 c = ACC ? acc[q] : (f32x4){0.f, 0.f, 0.f, 0.f}; c = mfma16(a.f[0], b.f[q][0], c); acc[q] = mfma16(a.f[1], b.f[q][1], c); }
}
__device__ __forceinline__ void rk_store(LAS bf16* dst, const f32x4 (&acc)[2], int mb, int nb0, int l15, int l4) {
#pragma unroll
    for (int q = 0; q < 2; ++q) { v2u w; w.x = pk2(acc[q][0], acc[q][1]); w.y = pk2(acc[q][2], acc[q][3]); *(LAS v2u*)(dst + rk_off(16 * (nb0 + q) + l15, 16 * mb + 4 * l4)) = w; }
}
__device__ __forceinline__ void rwkv_unit(const Args& a, LAS unsigned char* lds, int unit, int tid, int lane, int wave) {
    unsigned char* ws = a.ws; const bf16* PROJ = (const bf16*)(ws + WS_PROJ); const bf16* DAG = (const bf16*)(ws + WS_DAG); bf16* MIX = (bf16*)(ws + WS_MIX);
    const int b = unit >> 3, h = unit & 7;
    LAS bf16* slot = (LAS bf16*)lds;
#define RK_S(k) (slot + (k) * RK_SLOT)
    LAS bf16* Ab = RK_S(0); LAS bf16* Ut = RK_S(0); LAS bf16* Bb = RK_S(1); LAS bf16* Kb = RK_S(2); LAS bf16* Rb = RK_S(3); LAS bf16* KhT = RK_S(4); LAS float* Yl = (LAS float*)RK_S(3);
    LAS bf16* BhT = RK_S(5); LAS bf16* Vt = RK_S(6); LAS bf16* P0 = RK_S(7); LAS bf16* P0T = RK_S(8); LAS bf16* Aak = RK_S(9); LAS bf16* Arb = RK_S(10); LAS bf16* Ark = RK_S(11);
    LAS bf16* TA = RK_S(12); LAS bf16* TB = RK_S(13); LAS bf16* Xt = RK_S(14); LAS bf16* Sb = RK_S(15);
    LAS float* g63 = (LAS float*)RK_S(16); LAS float* bon = g63 + 64; LAS float* ssP = bon + 64; LAS float* bnP = ssP + 512; LAS float* cst = bnP + 512;
    const int l15 = lane & 15, l4 = lane >> 4, mb = wave & 3, nb0 = 2 * (wave >> 2);
    const int tt = tid >> 3, c8 = tid & 7;
    const int jw = 8 * wave;
    for (int i = tid; i < 640; i += 512) { const int k = i >> 6, c_ = i & 63, j = h * 64 + c_;
        const float* src = k == 0 ? a.in[3] + j : k == 1 ? a.in[3] + 512 + j : k == 2 ? a.in[3] + 1024 + j : k == 3 ? a.in[9] + j : k == 4 ? a.in[10] + j : k == 5 ? a.in[11] + j : k == 6 ? a.in[4] + j : k == 7 ? a.in[6] + j : k == 8 ? a.in[12] + j : a.in[13] + j;
        cst[i] = *src; }
    for (int i = tid; i < RK_SLOT / 2; i += 512) ((LAS unsigned*)Sb)[i] = 0u;
    f32x4 sacc[2], tacc[2], yacc[2];
    sacc[0] = (f32x4){0.f, 0.f, 0.f, 0.f}; sacc[1] = sacc[0];
    v4u g_rc, g_kc, g_vc, g_rp, g_kp, g_vp, g_ld, g_a, g_g;
    v4u pend = {0u, 0u, 0u, 0u}; bf16* pend_p = MIX;
#define RK_LOADCHUNK(c_) do { const int t_ = b * SEQ + (c_) * 64 + lane; const bf16* pr_ = PROJ + (size_t)t_ * NPROJ + h * 64 + jw; \
        g_rc = *(const v4u*)pr_; g_kc = *(const v4u*)(pr_ + 512); g_vc = *(const v4u*)(pr_ + 1024); \
        if ((c_) == 0 && lane == 0) { g_rp = (v4u){0u, 0u, 0u, 0u}; g_kp = g_rp; g_vp = g_rp; } \
        else { g_rp = *(const v4u*)(pr_ - NPROJ); g_kp = *(const v4u*)(pr_ - NPROJ + 512); g_vp = *(const v4u*)(pr_ - NPROJ + 1024); } \
        const bf16* dg_ = DAG + (size_t)t_ * NLORA + h * 64 + jw; g_ld = *(const v4u*)dg_; g_a = *(const v4u*)(dg_ + 512); \
        g_g = *(const v4u*)(DAG + (size_t)(b * SEQ + (c_) * 64 + tt) * NLORA + 1024 + h * 64 + 8 * c8); } while (0)
    RK_LOADCHUNK(0);
    LDS_BARRIER();
    for (int c = 0; c < SEQ / 64; ++c) {
        const int t0 = b * SEQ + c * 64;
        float rr[8], km[8], vv[8], av[8], lgw[8], kkr[8];
        asm volatile("" : "+v"(g_rc), "+v"(g_kc), "+v"(g_vc), "+v"(g_rp), "+v"(g_kp), "+v"(g_vp), "+v"(g_ld), "+v"(g_a), "+v"(g_g));
        {
            float rc[8], kc[8], vc[8], rp_[8], kp[8], vp[8], ldv[8];
            unpack8(g_rc, rc); unpack8(g_kc, kc); unpack8(g_vc, vc); unpack8(g_rp, rp_); unpack8(g_kp, kp); unpack8(g_vp, vp); unpack8(g_ld, ldv); unpack8(g_a, av);
            float ss = 0.f, bonus = 0.f;
#pragma unroll
            for (int e = 0; e < 8; ++e) { const int j = jw + e;
                rr[e] = rc[e] + (rp_[e] - rc[e]) * cst[j]; const float k = kc[e] + (kp[e] - kc[e]) * cst[64 + j]; vv[e] = vc[e] + (vp[e] - vc[e]) * cst[128 + j];
                kkr[e] = k * cst[192 + j]; ss += kkr[e] * kkr[e];
                av[e] = sigmoidf_(cst[448 + j] + av[e]);
                lgw[e] = -0.6065306597f * sigmoidf_(cst[384 + j] + ldv[e]);
                km[e] = k * (1.0f + (av[e] - 1.0f) * cst[256 + j]);
                bonus += rr[e] * km[e] * cst[320 + j]; }
            ssP[lane * 8 + wave] = ss; bnP[lane * 8 + wave] = bonus;
        }
        const v4u gcur = g_g;
        LDS_BARRIER();
        {
            const f32x4 s0 = *(const LAS f32x4*)(ssP + lane * 8), s1 = *(const LAS f32x4*)(ssP + lane * 8 + 4), b0 = *(const LAS f32x4*)(bnP + lane * 8), b1 = *(const LAS f32x4*)(bnP + lane * 8 + 4);
            const float ss = ((s0[0] + s0[1]) + (s0[2] + s0[3])) + ((s1[0] + s1[1]) + (s1[2] + s1[3]));
            if (wave == 0) bon[lane] = ((b0[0] + b0[1]) + (b0[2] + b0[3])) + ((b1[0] + b1[1]) + (b1[2] + b1[3]));
            const float inv = frcp(fmaxf(fsqrt_(ss), 1e-12f));
            float oA[8], oB[8], oK[8], oR[8], oBh[8], oKh[8], lw[8], e63[8];
#pragma unroll
            for (int e = 0; e < 8; ++e) lw[e] = wave_scan_add(lgw[e]);
#pragma unroll
            for (int e = 0; e < 8; ++e) { const float l63 = __builtin_bit_cast(float, __builtin_amdgcn_readlane(__builtin_bit_cast(int, lw[e]), 63));
                const float eP = fexp(lw[e] - lgw[e]), eM = fexp(-lw[e]), eL = fexp(lw[e]); e63[e] = fexp(l63); const float eH = e63[e] * eM;
                const float kk = kkr[e] * inv, bb = kk * av[e];
                oA[e] = -kk * eP; oB[e] = bb * eM; oK[e] = km[e] * eM; oR[e] = rr[e] * eL; oBh[e] = bb * eH; oKh[e] = km[e] * eH; }
            if (lane == 63) { *(LAS f32x4*)(g63 + jw) = (f32x4){e63[0], e63[1], e63[2], e63[3]}; *(LAS f32x4*)(g63 + jw + 4) = (f32x4){e63[4], e63[5], e63[6], e63[7]}; }
            { const int ro = rk_off(lane, jw); *(LAS v4u*)(Ab + ro) = pack8(oA); *(LAS v4u*)(Bb + ro) = pack8(oB); *(LAS v4u*)(Kb + ro) = pack8(oK); *(LAS v4u*)(Rb + ro) = pack8(oR); }
#pragma unroll
            for (int e = 0; e < 8; ++e) { const int to = rk_off(jw + e, lane); BhT[to] = (bf16)f2bf(oBh[e]); KhT[to] = (bf16)f2bf(oKh[e]); Vt[to] = (bf16)f2bf(vv[e]); }
            if (c > 0) *(v4u*)pend_p = pend;
            if (c + 1 < SEQ / 64) RK_LOADCHUNK(c + 1);
        }
        LDS_BARRIER();
        {
            f32x4 d[2];
#define RK_MASK_LT(D_, MISS_) _Pragma("unroll") for (int q = 0; q < 2; ++q) { const int nb_ = nb0 + q; \
                if (MISS_ ? (mb < nb_) : (mb > nb_)) D_[q] = (f32x4){0.f, 0.f, 0.f, 0.f}; \
                else if (mb == nb_) { _Pragma("unroll") for (int r = 0; r < 4; ++r) { const int m_ = 4 * l4 + r; D_[q][r] = (MISS_ ? (l15 < m_) : (m_ < l15)) ? D_[q][r] : 0.f; } } }
#define RK_MASK_LE(D_) _Pragma("unroll") for (int q = 0; q < 2; ++q) { const int nb_ = nb0 + q; \
                if (mb > nb_) D_[q] = (f32x4){0.f, 0.f, 0.f, 0.f}; \
                else if (mb == nb_) { _Pragma("unroll") for (int r = 0; r < 4; ++r) { const int m_ = 4 * l4 + r; D_[q][r] = (m_ <= l15) ? D_[q][r] : 0.f; } } }
            const RkA aB = rk_lda(Bb, mb, l15, l4), aA = rk_lda(Ab, mb, l15, l4), aK = rk_lda(Kb, mb, l15, l4);
            const RkB bA = rk_ldb(Ab, nb0, l15, l4), bB = rk_ldb(Bb, nb0, l15, l4), bR = rk_ldb(Rb, nb0, l15, l4);
            f32x4 d2[2], d3[2], d4[2], d5[2];
            rk_mm<false>(d, aB, bA);
            rk_mm<false>(d2, aA, bB);
            rk_mm<false>(d3, aK, bA);
            rk_mm<false>(d4, aB, bR);
            rk_mm<false>(d5, aK, bR);
            RK_MASK_LT(d, false);
#pragma unroll
            for (int q = 0; q < 2; ++q)
#pragma unroll
                for (int r = 0; r < 4; ++r) tacc[q][r] = d[q][r] + ((mb == nb0 + q && 4 * l4 + r == l15) ? 1.f : 0.f);
            RK_MASK_LT(d2, true); RK_MASK_LT(d3, false); RK_MASK_LE(d4); RK_MASK_LE(d5);
            rk_store(P0, d, mb, nb0, l15, l4); rk_store(TA, tacc, mb, nb0, l15, l4); rk_store(P0T, d2, mb, nb0, l15, l4); rk_store(Aak, d3, mb, nb0, l15, l4); rk_store(Arb, d4, mb, nb0, l15, l4); rk_store(Ark, d5, mb, nb0, l15, l4);
        }
        LDS_BARRIER();
        {
            const RkA aPT = rk_lda(P0T, mb, l15, l4), aP = rk_lda(P0, mb, l15, l4), aA = rk_lda(Ab, mb, l15, l4), aAk = rk_lda(Aak, mb, l15, l4);
            const RkB bP = rk_ldb(P0, nb0, l15, l4), bPT = rk_ldb(P0T, nb0, l15, l4), bS = rk_ldb(Sb, nb0, l15, l4), bV = rk_ldb(Vt, nb0, l15, l4);
            f32x4 d[2], d2[2], d3[2];
            rk_mm<false>(d, aPT, bP); rk_mm<false>(d2, aP, bPT); rk_mm<false>(d3, aA, bS); rk_mm<true>(d3, aAk, bV);
            const RkA aS = rk_lda(Sb, mb, l15, l4), aV = rk_lda(Vt, mb, l15, l4), aKh = rk_lda(KhT, mb, l15, l4);
            const RkB bR = rk_ldb(Rb, nb0, l15, l4), bArk = rk_ldb(Ark, nb0, l15, l4);
            rk_mm<false>(yacc, aS, bR); rk_mm<true>(yacc, aV, bArk);
#pragma unroll
            for (int r = 0; r < 4; ++r) { const float g_ = g63[16 * mb + 4 * l4 + r]; sacc[0][r] *= g_; sacc[1][r] *= g_; }
            rk_mm<true>(sacc, aKh, bV);
            rk_store(Bb  , d, mb, nb0, l15, l4); rk_store(Kb  , d2, mb, nb0, l15, l4); rk_store(Xt, d3, mb, nb0, l15, l4);
        }
        LDS_BARRIER();
#define RK_DOUBLE(PK, PKT, TIN, TOUT, PN, PNT) { const RkA aPT = rk_lda(PKT, mb, l15, l4), aP = rk_lda(PK, mb, l15, l4); \
          const RkB bT = rk_ldb(TIN, nb0, l15, l4), bP = rk_ldb(PK, nb0, l15, l4), bPT = rk_ldb(PKT, nb0, l15, l4); \
          f32x4 d[2], d2[2]; rk_mm<true>(tacc, aPT, bT); rk_mm<false>(d, aPT, bP); rk_mm<false>(d2, aP, bPT); \
          rk_store(TOUT, tacc, mb, nb0, l15, l4); rk_store(PN, d, mb, nb0, l15, l4); rk_store(PNT, d2, mb, nb0, l15, l4); }
        RK_DOUBLE(Bb, Kb, TA, TB, P0, P0T)
        LDS_BARRIER();
        RK_DOUBLE(P0, P0T, TB, TA, Bb, Kb)
        LDS_BARRIER();
        RK_DOUBLE(Bb, Kb, TA, TB, P0, P0T)
        LDS_BARRIER();
        { const RkA aPT = rk_lda(P0T, mb, l15, l4), aP = rk_lda(P0, mb, l15, l4); const RkB bT = rk_ldb(TB, nb0, l15, l4), bPT = rk_ldb(P0T, nb0, l15, l4);
          f32x4 d2[2]; rk_mm<true>(tacc, aPT, bT); rk_mm<false>(d2, aP, bPT); rk_store(TA, tacc, mb, nb0, l15, l4); rk_store(Kb  , d2, mb, nb0, l15, l4); }
        LDS_BARRIER();
        { const RkA aPT = rk_lda(Kb, mb, l15, l4); const RkB bT = rk_ldb(TA, nb0, l15, l4); rk_mm<true>(tacc, aPT, bT); rk_store(TB, tacc, mb, nb0, l15, l4); }
        LDS_BARRIER();
#ifdef PROBE
        const unsigned long long tk2 = __builtin_amdgcn_s_memtime();
#endif
        { const RkA aT = rk_lda(TB, mb, l15, l4); const RkB bX = rk_ldb(Xt, nb0, l15, l4); f32x4 d[2]; rk_mm<false>(d, aT, bX); rk_store(Ut, d, mb, nb0, l15, l4); }
        LDS_BARRIER();
        {
            const RkA aU = rk_lda(Ut, mb, l15, l4), aBh = rk_lda(BhT, mb, l15, l4); const RkB bArb = rk_ldb(Arb, nb0, l15, l4), bU = rk_ldb(Ut, nb0, l15, l4);
            rk_mm<true>(yacc, aU, bArb); rk_mm<true>(sacc, aBh, bU);
#pragma unroll
            for (int q = 0; q < 2; ++q) *(LAS f32x4*)(Yl + (16 * (nb0 + q) + l15) * 64 + (((4 * mb + l4) ^ (l15 & 7)) << 2)) = yacc[q];
            rk_store(Sb, sacc, mb, nb0, l15, l4);
        }
        LDS_BARRIER();
        {
            const int t = t0 + tt, j0 = 8 * c8;
            const f32x4 y0 = *(const LAS f32x4*)(Yl + tt * 64 + (((2 * c8) ^ (tt & 7)) << 2)), y1 = *(const LAS f32x4*)(Yl + tt * 64 + (((2 * c8 + 1) ^ (tt & 7)) << 2));
            float y[8] = {y0[0], y0[1], y0[2], y0[3], y1[0], y1[1], y1[2], y1[3]}, gv[8]; float s1 = 0.f;
#pragma unroll
            for (int e = 0; e < 8; ++e) s1 += y[e];
            s1 = red8(s1); const float mean = s1 * (1.0f / 64.0f); float s2 = 0.f;
#pragma unroll
            for (int e = 0; e < 8; ++e) { const float dd = y[e] - mean; s2 += dd * dd; }
            s2 = red8(s2); const float rstd = frsq(s2 * (1.0f / 64.0f) + LNX_EPS);
            unpack8(gcur, gv);
            const float bonus = bon[tt]; float ov[8];
#pragma unroll
            for (int e = 0; e < 8; ++e) { const float yn = (y[e] - mean) * rstd * cst[512 + j0 + e] + cst[576 + j0 + e]; ov[e] = (yn + bonus * bf2f(Vt[rk_off(j0 + e, tt)])) * gv[e]; }
            pend = pack8(ov); pend_p = MIX + (size_t)t * DM + h * 64 + j0;
        }
        LDS_BARRIER();
    }
    *(v4u*)pend_p = pend;
#undef RK_S
#undef RK_LOADCHUNK
}

struct RkF2 { bf16x8 f[2][2]; };
struct RkLane { int lo, so, l15, l4; };
__device__ __forceinline__ RkLane rk_lane(int lane) { asm volatile("" : "+v"(lane)); const int l15 = lane & 15, l4 = lane >> 4; RkLane r; r.l15 = l15; r.l4 = l4; r.lo = l15 * 64 + ((l4 ^ (l15 & 7)) << 3); r.so = l15 * 64 + ((((l4 >> 1) ^ (l15 & 7))) << 3) + 4 * (l4 & 1); return r; }
__device__ __forceinline__ RkF2 rk_ld2(const LAS bf16* base, int blk, const RkLane& L) { RkF2 r;
#pragma unroll
    for (int ti = 0; ti < 2; ++ti) { const int i0 = (32 * blk + 16 * ti) * 64 + L.lo; r.f[ti][0] = *(const LAS bf16x8*)(base + i0); r.f[ti][1] = *(const LAS bf16x8*)(base + (i0 ^ 32)); }
    return r; }
template <bool ACC> __device__ __forceinline__ void rk_mm2(f32x4 (&acc)[2][2], const RkF2& a, const RkF2& b) {
#pragma unroll
    for (int mi = 0; mi < 2; ++mi)
#pragma unroll
        for (int ni = 0; ni < 2; ++ni) { f32x4 c = ACC ? acc[mi][ni] : (f32x4){0.f, 0.f, 0.f, 0.f}; c = mfma16(a.f[mi][0], b.f[ni][0], c); acc[mi][ni] = mfma16(a.f[mi][1], b.f[ni][1], c); }
}
__device__ __forceinline__ void rk_store2(LAS bf16* dst, const f32x4 (&acc)[2][2], int mB, int nB, const RkLane& L) {
#pragma unroll
    for (int mi = 0; mi < 2; ++mi)
#pragma unroll
        for (int ni = 0; ni < 2; ++ni) { v2u w; w.x = pk2(acc[mi][ni][0], acc[mi][ni][1]); w.y = pk2(acc[mi][ni][2], acc[mi][ni][3]); *(LAS v2u*)(dst + (16 * (2 * nB + ni)) * 64 + (L.so ^ (16 * (2 * mB + mi)))) = w; }
}
template <int MODE> __device__ __forceinline__ void rk_mask2(f32x4 (&d)[2][2], int mB, int nB, int l15, int l4) {
#pragma unroll
    for (int mi = 0; mi < 2; ++mi)
#pragma unroll
        for (int ni = 0; ni < 2; ++ni) { const int mt = 2 * mB + mi, nt = 2 * nB + ni;
            const bool zero = MODE == 1 ? (mt < nt) : (mt > nt);
            if (zero) d[mi][ni] = (f32x4){0.f, 0.f, 0.f, 0.f};
            else if (mt == nt) {
#pragma unroll
                for (int r = 0; r < 4; ++r) { const int m_ = 4 * l4 + r; const bool keep = MODE == 0 ? (m_ < l15) : MODE == 1 ? (l15 < m_) : (m_ <= l15); d[mi][ni][r] = keep ? d[mi][ni][r] : 0.f; } } }
}
__device__ __forceinline__ void rwkv_unit_split(const Args& a, LAS unsigned char* lds, int unit, int tid, int lane, int wave) {
    unsigned char* ws = a.ws; const bf16* PROJ = (const bf16*)(ws + WS_PROJ); const bf16* DAG = (const bf16*)(ws + WS_DAG); bf16* MIX = (bf16*)(ws + WS_MIX);
    const int b = unit >> 3, h = unit & 7;
    LAS bf16* slot = (LAS bf16*)lds;
#define RK_S(k) (slot + (k) * RK_SLOT)
    LAS bf16* Ab = RK_S(0); LAS bf16* Bb = RK_S(1); LAS bf16* Kb = RK_S(2); LAS bf16* Rb = RK_S(3); LAS bf16* KhT = RK_S(4);
    LAS bf16* P0 = RK_S(7); LAS bf16* P0T = RK_S(8); LAS float* Yl = (LAS float*)RK_S(7);
    LAS bf16* Aak = RK_S(9); LAS bf16* Ut = RK_S(9); LAS bf16* Arb = RK_S(10); LAS bf16* Ark = RK_S(11); LAS bf16* TA = RK_S(12); LAS bf16* TB = RK_S(13); LAS bf16* Xt = RK_S(14); LAS bf16* Sb = RK_S(15);
    LAS float* g63 = (LAS float*)RK_S(18); LAS float* bon = g63 + 128; LAS float* ssP = bon + 128; LAS float* bnP = ssP + 256; LAS float* cst = bnP + 256;
    const int wq = wave & 3;
    { int t_ = tid; asm volatile("" : "+v"(t_));
      if (t_ < 64) { const int j = h * 64 + t_;
        cst[t_] = a.in[3][j]; cst[64 + t_] = a.in[3][512 + j]; cst[128 + t_] = a.in[3][1024 + j]; cst[192 + t_] = a.in[9][j]; cst[256 + t_] = a.in[10][j];
        cst[320 + t_] = a.in[11][j]; cst[384 + t_] = a.in[4][j]; cst[448 + t_] = a.in[6][j]; cst[512 + t_] = a.in[12][j]; cst[576 + t_] = a.in[13][j]; }
      for (int i = t_; i < RK_SLOT / 2; i += 512) ((LAS unsigned*)Sb)[i] = 0u; }
    if (wave < 4) {
        const int jw = 16 * wq;
        v4u g_rc[2], g_kc[2], g_vc[2], g_rp[2], g_kp[2], g_vp[2], g_ld[2], g_a[2];
#define RKS_LOAD(c_) do { int ln_ = lane; asm volatile("" : "+v"(ln_)); const int t_ = b * SEQ + (c_) * 64 + ln_; const bf16* pr_ = PROJ + (size_t)t_ * NPROJ + h * 64 + jw; const bf16* dg_ = DAG + (size_t)t_ * NLORA + h * 64 + jw; \
        _Pragma("unroll") for (int hh = 0; hh < 2; ++hh) { g_rc[hh] = *(const v4u*)(pr_ + 8 * hh); g_kc[hh] = *(const v4u*)(pr_ + 512 + 8 * hh); g_vc[hh] = *(const v4u*)(pr_ + 1024 + 8 * hh); \
            if ((c_) == 0 && ln_ == 0) { g_rp[hh] = (v4u){0u, 0u, 0u, 0u}; g_kp[hh] = g_rp[hh]; g_vp[hh] = g_rp[hh]; } \
            else { g_rp[hh] = *(const v4u*)(pr_ - NPROJ + 8 * hh); g_kp[hh] = *(const v4u*)(pr_ - NPROJ + 512 + 8 * hh); g_vp[hh] = *(const v4u*)(pr_ - NPROJ + 1024 + 8 * hh); } \
            g_ld[hh] = *(const v4u*)(dg_ + 8 * hh); g_a[hh] = *(const v4u*)(dg_ + 512 + 8 * hh); } } while (0)
        RKS_LOAD(0);
        LDS_BARRIER();
        for (int it = 0; it <= SEQ / 64; ++it) {
            const bool act = it < SEQ / 64; const int p = it & 1;
            LAS bf16* BhTp = RK_S(5 + 11 * p); LAS bf16* Vtp = RK_S(6 + 11 * p);
            float rr[2][8], km[2][8], av[2][8], lgw[2][8], kkr[2][8];
            v4u pA[2], pR[2], pB[2], pK[2], pKh[2];
            LDS_BARRIER();
            if (act) {
                int ln = lane; asm volatile("" : "+v"(ln));
                asm volatile("" : "+v"(g_rc[0]), "+v"(g_rc[1]), "+v"(g_kc[0]), "+v"(g_kc[1]), "+v"(g_vc[0]), "+v"(g_vc[1]), "+v"(g_rp[0]), "+v"(g_rp[1]), "+v"(g_kp[0]), "+v"(g_kp[1]), "+v"(g_vp[0]), "+v"(g_vp[1]), "+v"(g_ld[0]), "+v"(g_ld[1]), "+v"(g_a[0]), "+v"(g_a[1]));
                float ss = 0.f, bonus = 0.f;
#pragma unroll
                for (int hh = 0; hh < 2; ++hh) { float rc[8], kc[8], vc[8], rp_[8], kp[8], vp[8], ldv[8];
                    unpack8(g_rc[hh], rc); unpack8(g_kc[hh], kc); unpack8(g_vc[hh], vc); unpack8(g_rp[hh], rp_); unpack8(g_kp[hh], kp); unpack8(g_vp[hh], vp); unpack8(g_ld[hh], ldv); unpack8(g_a[hh], av[hh]);
#pragma unroll
                    for (int e = 0; e < 8; ++e) { const int j = jw + 8 * hh + e;
                        rr[hh][e] = rc[e] + (rp_[e] - rc[e]) * cst[j]; const float k = kc[e] + (kp[e] - kc[e]) * cst[64 + j]; const float v = vc[e] + (vp[e] - vc[e]) * cst[128 + j];
                        kkr[hh][e] = k * cst[192 + j]; ss += kkr[hh][e] * kkr[hh][e];
                        av[hh][e] = sigmoidf_(cst[448 + j] + av[hh][e]);
                        lgw[hh][e] = -0.6065306597f * sigmoidf_(cst[384 + j] + ldv[e]);
                        km[hh][e] = k * (1.0f + (av[hh][e] - 1.0f) * cst[256 + j]);
                        bonus += rr[hh][e] * km[hh][e] * cst[320 + j];
                        Vtp[rk_off(j, ln)] = (bf16)f2bf(v); } }
                ssP[ln * 4 + wq] = ss; bnP[ln * 4 + wq] = bonus;
            }
            LDS_BARRIER();
            if (act) {
                int ln = lane; asm volatile("" : "+v"(ln));
                const f32x4 s4 = *(const LAS f32x4*)(ssP + ln * 4), b4 = *(const LAS f32x4*)(bnP + ln * 4);
                const float ss = (s4[0] + s4[1]) + (s4[2] + s4[3]);
                if (wq == 0) bon[64 * p + ln] = (b4[0] + b4[1]) + (b4[2] + b4[3]);
                const float inv = frcp(fmaxf(fsqrt_(ss), 1e-12f));
#pragma unroll
                for (int hh = 0; hh < 2; ++hh) { float lw[8], oA[8], oB[8], oK[8], oR[8], oBh[8], oKh[8], e63[8];
#pragma unroll
                    for (int e = 0; e < 8; ++e) lw[e] = wave_scan_add(lgw[hh][e]);
#pragma unroll
                    for (int e = 0; e < 8; ++e) { const float l63 = __builtin_bit_cast(float, __builtin_amdgcn_readlane(__builtin_bit_cast(int, lw[e]), 63));
                        const float eP = fexp(lw[e] - lgw[hh][e]), eM = fexp(-lw[e]), eL = fexp(lw[e]); e63[e] = fexp(l63); const float eH = e63[e] * eM;
                        const float kk = kkr[hh][e] * inv, bb = kk * av[hh][e];
                        oA[e] = -kk * eP; oB[e] = bb * eM; oK[e] = km[hh][e] * eM; oR[e] = rr[hh][e] * eL; oBh[e] = bb * eH; oKh[e] = km[hh][e] * eH; }
                    pA[hh] = pack8(oA); pB[hh] = pack8(oB); pK[hh] = pack8(oK); pR[hh] = pack8(oR); pKh[hh] = pack8(oKh);
#pragma unroll
                    for (int e = 0; e < 8; ++e) BhTp[rk_off(jw + 8 * hh + e, ln)] = (bf16)f2bf(oBh[e]);
                    if (ln == 63) { LAS float* gp = g63 + 64 * p + jw + 8 * hh; *(LAS f32x4*)gp = (f32x4){e63[0], e63[1], e63[2], e63[3]}; *(LAS f32x4*)(gp + 4) = (f32x4){e63[4], e63[5], e63[6], e63[7]}; } }
            }
            LDS_BARRIER();
            if (act) {
                if (it + 1 < SEQ / 64) RKS_LOAD(it + 1);
                int ln = lane; asm volatile("" : "+v"(ln));
#pragma unroll
                for (int hh = 0; hh < 2; ++hh) { const int ro = rk_off(ln, jw + 8 * hh); *(LAS v4u*)(Ab + ro) = pA[hh]; *(LAS v4u*)(Rb + ro) = pR[hh];
                    const unsigned w_[4] = {pKh[hh].x, pKh[hh].y, pKh[hh].z, pKh[hh].w};
#pragma unroll
                    for (int e = 0; e < 4; ++e) { KhT[rk_off(jw + 8 * hh + 2 * e, ln)] = (bf16)(w_[e] & 0xffffu); KhT[rk_off(jw + 8 * hh + 2 * e + 1, ln)] = (bf16)(w_[e] >> 16); } }
            }
            LDS_BARRIER(); LDS_BARRIER(); LDS_BARRIER(); LDS_BARRIER(); LDS_BARRIER(); LDS_BARRIER();
            if (act) {
                int ln = lane; asm volatile("" : "+v"(ln));
#pragma unroll
                for (int hh = 0; hh < 2; ++hh) { const int ro = rk_off(ln, jw + 8 * hh); *(LAS v4u*)(Bb + ro) = pB[hh]; *(LAS v4u*)(Kb + ro) = pK[hh]; }
            }
            LDS_BARRIER();
        }
#undef RKS_LOAD
    } else {
        const int mB = wq & 1, nB = wq >> 1;
        const int ltid = tid - 256;
        f32x4 sacc[2][2], tacc[2][2], yacc[2][2];
#pragma unroll
        for (int i = 0; i < 2; ++i)
#pragma unroll
            for (int j = 0; j < 2; ++j) { sacc[i][j] = (f32x4){0.f, 0.f, 0.f, 0.f}; tacc[i][j] = sacc[i][j]; yacc[i][j] = sacc[i][j]; }
        v4u g_g0 = {0u, 0u, 0u, 0u}, g_g1 = g_g0, pend0 = g_g0, pend1 = g_g0; bf16* pend_p = MIX;
#define RKV_LOADG(c_) do { int lt_ = ltid; asm volatile("" : "+v"(lt_)); const bf16* gp_ = DAG + (size_t)(b * SEQ + (c_) * 64 + (lt_ >> 2)) * NLORA + 1024 + h * 64 + 16 * (lt_ & 3); g_g0 = *(const v4u*)gp_; g_g1 = *(const v4u*)(gp_ + 8); } while (0)
        LDS_BARRIER();
        for (int it = 0; it <= SEQ / 64; ++it) {
            const int ch = it - 1; const bool act = it >= 1; const int p = ch & 1;
            const LAS bf16* BhTp = RK_S(5 + 11 * p); const LAS bf16* Vtp = RK_S(6 + 11 * p);
            LDS_BARRIER();
            if (act) {
                const RkLane L = rk_lane(lane);
                if (ch > 0) { *(v4u*)pend_p = pend0; *(v4u*)(pend_p + 8) = pend1; }
                RKV_LOADG(ch);
                const RkF2 aB = rk_ld2(Bb, mB, L), bA = rk_ld2(Ab, nB, L);
                {
                    const RkF2 aA = rk_ld2(Ab, mB, L), bB = rk_ld2(Bb, nB, L);
                    f32x4 d[2][2], d2[2][2];
                    rk_mm2<false>(d, aB, bA); rk_mm2<false>(d2, aA, bB);
                    rk_mask2<0>(d, mB, nB, L.l15, L.l4);
#pragma unroll
                    for (int mi = 0; mi < 2; ++mi)
#pragma unroll
                        for (int ni = 0; ni < 2; ++ni)
#pragma unroll
                            for (int r = 0; r < 4; ++r) tacc[mi][ni][r] = d[mi][ni][r] + ((2 * mB + mi == 2 * nB + ni && 4 * L.l4 + r == L.l15) ? 1.f : 0.f);
                    rk_mask2<1>(d2, mB, nB, L.l15, L.l4);
                    rk_store2(P0, d, mB, nB, L); rk_store2(TA, tacc, mB, nB, L); rk_store2(P0T, d2, mB, nB, L);
                }
                asm volatile("" ::: "memory");
                {
                    const RkF2 aK = rk_ld2(Kb, mB, L), bR = rk_ld2(Rb, nB, L);
                    f32x4 d3[2][2], d4[2][2], d5[2][2];
                    rk_mm2<false>(d3, aK, bA); rk_mm2<false>(d4, aB, bR); rk_mm2<false>(d5, aK, bR);
                    rk_mask2<0>(d3, mB, nB, L.l15, L.l4); rk_mask2<2>(d4, mB, nB, L.l15, L.l4); rk_mask2<2>(d5, mB, nB, L.l15, L.l4);
                    rk_store2(Aak, d3, mB, nB, L); rk_store2(Arb, d4, mB, nB, L); rk_store2(Ark, d5, mB, nB, L);
                }
            }
            LDS_BARRIER();
            if (act) {
                const RkLane L = rk_lane(lane);
                {
                    const RkF2 aPT = rk_ld2(P0T, mB, L), aP = rk_ld2(P0, mB, L), bP = rk_ld2(P0, nB, L), bPT = rk_ld2(P0T, nB, L);
                    f32x4 d[2][2], d2[2][2]; rk_mm2<false>(d, aPT, bP); rk_mm2<false>(d2, aP, bPT);
                    rk_store2(Bb  , d, mB, nB, L); rk_store2(Kb  , d2, mB, nB, L);
                }
                asm volatile("" ::: "memory");
                const RkF2 bV = rk_ld2(Vtp, nB, L);
                {
                    const RkF2 aA = rk_ld2(Ab, mB, L), aAk = rk_ld2(Aak, mB, L), bS = rk_ld2(Sb, nB, L), aKh = rk_ld2(KhT, mB, L);
                    f32x4 d3[2][2]; rk_mm2<false>(d3, aA, bS); rk_mm2<true>(d3, aAk, bV);
#pragma unroll
                    for (int mi = 0; mi < 2; ++mi)
#pragma unroll
                        for (int r = 0; r < 4; ++r) { const float g_ = g63[64 * p + 16 * (2 * mB + mi) + 4 * L.l4 + r]; sacc[mi][0][r] *= g_; sacc[mi][1][r] *= g_; }
                    rk_mm2<true>(sacc, aKh, bV);
                    rk_store2(Xt, d3, mB, nB, L);
                }
                asm volatile("" ::: "memory");
                {
                    const RkF2 aS = rk_ld2(Sb, mB, L), aV = rk_ld2(Vtp, mB, L), bR = rk_ld2(Rb, nB, L), bArk = rk_ld2(Ark, nB, L);
                    rk_mm2<false>(yacc, aS, bR); rk_mm2<true>(yacc, aV, bArk);
                }
            }
            LDS_BARRIER();
#define RKV_DOUBLE(PK, PKT, TIN, TOUT, PN, PNT) if (act) { const RkLane L = rk_lane(lane); const RkF2 aPT = rk_ld2(PKT, mB, L), aP = rk_ld2(PK, mB, L); \
              const RkF2 bT = rk_ld2(TIN, nB, L), bP = rk_ld2(PK, nB, L), bPT = rk_ld2(PKT, nB, L); \
              f32x4 d[2][2], d2[2][2]; rk_mm2<true>(tacc, aPT, bT); rk_mm2<false>(d, aPT, bP); rk_mm2<false>(d2, aP, bPT); \
              rk_store2(TOUT, tacc, mB, nB, L); rk_store2(PN, d, mB, nB, L); rk_store2(PNT, d2, mB, nB, L); }
            RKV_DOUBLE(Bb, Kb, TA, TB, P0, P0T)
            LDS_BARRIER();
            RKV_DOUBLE(P0, P0T, TB, TA, Bb, Kb)
            LDS_BARRIER();
            RKV_DOUBLE(Bb, Kb, TA, TB, P0, P0T)
            LDS_BARRIER();
            if (act) { const RkLane L = rk_lane(lane); const RkF2 aPT = rk_ld2(P0T, mB, L), aP = rk_ld2(P0, mB, L); const RkF2 bT = rk_ld2(TB, nB, L), bPT = rk_ld2(P0T, nB, L);
                f32x4 d2[2][2]; rk_mm2<true>(tacc, aPT, bT); rk_mm2<false>(d2, aP, bPT); rk_store2(TA, tacc, mB, nB, L); rk_store2(Kb  , d2, mB, nB, L); }
            LDS_BARRIER();
            if (act) { const RkLane L = rk_lane(lane); const RkF2 aPT = rk_ld2(Kb, mB, L); const RkF2 bT = rk_ld2(TA, nB, L); rk_mm2<true>(tacc, aPT, bT); rk_store2(TB, tacc, mB, nB, L); }
            LDS_BARRIER();
            if (act) { const RkLane L = rk_lane(lane); const RkF2 aT = rk_ld2(TB, mB, L); const RkF2 bX = rk_ld2(Xt, nB, L); f32x4 d[2][2]; rk_mm2<false>(d, aT, bX); rk_store2(Ut, d, mB, nB, L); }
            LDS_BARRIER();
            if (act) {
                const RkLane L = rk_lane(lane);
                const RkF2 aU = rk_ld2(Ut, mB, L), aBh = rk_ld2(BhTp, mB, L); const RkF2 bArb = rk_ld2(Arb, nB, L), bU = rk_ld2(Ut, nB, L);
                rk_mm2<true>(yacc, aU, bArb); rk_mm2<true>(sacc, aBh, bU);
#pragma unroll
                for (int mi = 0; mi < 2; ++mi)
#pragma unroll
                    for (int ni = 0; ni < 2; ++ni) *(LAS f32x4*)(Yl + (16 * (2 * nB + ni) + L.l15) * 64 + (((4 * (2 * mB + mi) + L.l4) ^ (L.l15 & 7)) << 2)) = yacc[mi][ni];
                rk_store2(Sb, sacc, mB, nB, L);
            }
            LDS_BARRIER();
            if (act) {
                int lt_ = ltid; asm volatile("" : "+v"(lt_)); const int tt = lt_ >> 2, c4 = lt_ & 3;
                const int t = b * SEQ + ch * 64 + tt, j0 = 16 * c4;
                float y[16], gv[16]; float s1 = 0.f;
#pragma unroll
                for (int k = 0; k < 4; ++k) { const f32x4 yv = *(const LAS f32x4*)(Yl + tt * 64 + (((4 * c4 + k) ^ (tt & 7)) << 2)); y[4 * k] = yv[0]; y[4 * k + 1] = yv[1]; y[4 * k + 2] = yv[2]; y[4 * k + 3] = yv[3]; s1 += (yv[0] + yv[1]) + (yv[2] + yv[3]); }
                s1 += dppmov<0xB1>(s1); s1 += dppmov<0x4E>(s1); const float mean = s1 * (1.0f / 64.0f); float s2 = 0.f;
#pragma unroll
                for (int e = 0; e < 16; ++e) { const float dd = y[e] - mean; s2 += dd * dd; }
                s2 += dppmov<0xB1>(s2); s2 += dppmov<0x4E>(s2); const float rstd = frsq(s2 * (1.0f / 64.0f) + LNX_EPS);
                { float g0[8], g1[8]; unpack8(g_g0, g0); unpack8(g_g1, g1);
#pragma unroll
                  for (int e = 0; e < 8; ++e) { gv[e] = g0[e]; gv[8 + e] = g1[e]; } }
                const float bonus = bon[64 * p + tt]; float ov[16];
#pragma unroll
                for (int e = 0; e < 16; ++e) { const float yn = (y[e] - mean) * rstd * cst[512 + j0 + e] + cst[576 + j0 + e]; ov[e] = (yn + bonus * bf2f(Vtp[rk_off(j0 + e, tt)])) * gv[e]; }
                { float o0[8], o1[8];
#pragma unroll
                  for (int e = 0; e < 8; ++e) { o0[e] = ov[e]; o1[e] = ov[8 + e]; }
                  pend0 = pack8(o0); pend1 = pack8(o1); pend_p = MIX + (size_t)t * DM + h * 64 + j0; }
            }
        }
        *(v4u*)pend_p = pend0; *(v4u*)(pend_p + 8) = pend1;
#undef RKV_DOUBLE
#undef RKV_LOADG
    }
    LDS_BARRIER();
#undef RK_S
}

__device__ __forceinline__ void mlstm_unit(const Args& a, LAS unsigned char* lds, int unit, int tid, int lane, int wave) {
    unsigned char* ws = a.ws; const bf16* PROJ = (const bf16*)(ws + WS_PROJ); const float* gates = (const float*)(ws + WS_GATES); bf16* MIX = (bf16*)(ws + WS_MIX);
    const float* cw = a.in[14]; const float* cbias = a.in[15]; const float* i_bias = a.in[16]; const float* f_bias = a.in[17]; const float* mhg = a.in[18];
    const int b = unit >> 2, hm = unit & 3;
    constexpr int LD = 72;
    LAS bf16* Ql = (LAS bf16*)lds; LAS bf16* Kl = Ql + 64 * LD; LAS bf16* Kwt = Kl + 64 * LD; LAS bf16* Vt = Kwt + 64 * LD; LAS bf16* Sm = Vt + 128 * LD; LAS bf16* Ct = Sm + 64 * LD;
    LAS float* Hl = (LAS float*)(Ct + 128 * LD);
    LAS float* e_s = Hl + 64 * 132; LAS float* Mx = e_s + 64; LAS float* sc = Mx + 64; LAS float* em = sc + 64; LAS float* wsv = em + 64; LAS float* den = wsv + 64; LAS float* nvec = den + 64; LAS float* scal = nvec + 64;
    for (int i = tid; i < 128 * LD / 2; i += 512) ((LAS unsigned*)Ct)[i] = 0u;
    if (tid < 64) nvec[tid] = 0.f;
    if (tid == 0) { scal[0] = 1.f; scal[1] = 0.f; }
    f32x4 cacc[4];
#pragma unroll
    for (int i = 0; i < 4; ++i) cacc[i] = (f32x4){0.f, 0.f, 0.f, 0.f};
    const int l15 = lane & 15, l4 = lane >> 4;
    const int tt = tid >> 3, p8 = tid & 7;
    LAS float* cwl = scal + 16; LAS float* cbl = cwl + 512;
    for (int i = tid; i < 640; i += 512) { const int j = i >> 7, c_ = i & 127; const int src = (c_ < 64) ? (hm * 64 + c_) : (256 + hm * 64 + (c_ - 64)); if (j < 4) cwl[i] = cw[j * 512 + src]; else cbl[c_] = cbias[src]; }
    const float ibias = i_bias[hm], fbias = f_bias[hm];
    v4u n_q[4], n_k[4], n_va, n_vb, n_oa, n_ob; float n_gi = 0.f, n_gf = 0.f;
#define ML_LOADCHUNK(c_) do { const int t_ = b * SEQ + (c_) * 64 + lane; const int tp_ = (c_) * 64 + lane; \
        _Pragma("unroll") for (int j = 0; j < 4; ++j) { if (tp_ - 3 + j >= 0) { const bf16* pr_ = PROJ + (size_t)(t_ - 3 + j) * NPROJ + hm * 64 + 8 * wave; n_q[j] = *(const v4u*)(pr_ + C_Q); n_k[j] = *(const v4u*)(pr_ + C_K); } \
                                                       else { n_q[j] = (v4u){0u, 0u, 0u, 0u}; n_k[j] = (v4u){0u, 0u, 0u, 0u}; } } \
        { const bf16* pv_ = PROJ + (size_t)t_ * NPROJ + C_V + hm * 128 + 16 * wave; n_va = *(const v4u*)pv_; n_vb = *(const v4u*)(pv_ + 8); \
          const bf16* po_ = PROJ + (size_t)(b * SEQ + (c_) * 64 + tt) * NPROJ + C_O + hm * 128 + 16 * p8; n_oa = *(const v4u*)po_; n_ob = *(const v4u*)(po_ + 8); } \
        n_gi = gates[(size_t)t_ * 8 + hm]; n_gf = gates[(size_t)t_ * 8 + 4 + hm]; } while (0)
    ML_LOADCHUNK(0);
    LDS_BARRIER();
    float m_run = 0.f;
    v4u pend0 = {0u, 0u, 0u, 0u}, pend1 = pend0; bf16* pend_p = MIX;
    for (int c = 0; c < SEQ / 64; ++c) {
        const int t0 = b * SEQ + c * 64;
        asm volatile("" : "+v"(n_q[0]), "+v"(n_q[1]), "+v"(n_q[2]), "+v"(n_q[3]), "+v"(n_k[0]), "+v"(n_k[1]), "+v"(n_k[2]), "+v"(n_k[3]), "+v"(n_va), "+v"(n_vb), "+v"(n_oa), "+v"(n_ob), "+v"(n_gi), "+v"(n_gf));
        float dec;
        v4u c_oa, c_ob;
        {
            const float gi = n_gi + ibias, gf = n_gf + fbias;
            const float ig = 15.0f * tanhf_(gi * (1.0f / 15.0f)), fx = 15.0f * tanhf_(gf * (1.0f / 15.0f));
            const float logf = -(fmaxf(-fx, 0.f) + __logf(1.0f + fexp(-fabsf(fx))));
            const float bc = wave_scan_add(logf);
            const float e = ig - bc; const float P = wave_scan_max(e);
            const float mx = fmaxf(P, m_run);
            const float mxL = __builtin_bit_cast(float, __builtin_amdgcn_readlane(__builtin_bit_cast(int, mx), 63)), bL = __builtin_bit_cast(float, __builtin_amdgcn_readlane(__builtin_bit_cast(int, bc), 63));
            if (wave == 0) { e_s[lane] = e; Mx[lane] = mx; sc[lane] = fexp(m_run - mx); em[lane] = fexp(-(bc + mx)); }
            const float w = fexp(e - mxL);
            dec = fexp(m_run - mxL); m_run = bL + mxL;
            const int d0 = 8 * wave;
            float aq[8], ak[8];
#pragma unroll
            for (int e_ = 0; e_ < 8; ++e_) { aq[e_] = cbl[d0 + e_]; ak[e_] = cbl[64 + d0 + e_]; }
#pragma unroll
            for (int j = 0; j < 4; ++j) { float pq[8], pk[8]; unpack8(n_q[j], pq); unpack8(n_k[j], pk);
#pragma unroll
                for (int e_ = 0; e_ < 8; ++e_) { aq[e_] += cwl[j * 128 + d0 + e_] * pq[e_]; ak[e_] += cwl[j * 128 + 64 + d0 + e_] * pk[e_]; } }
#pragma unroll
            for (int e_ = 0; e_ < 8; ++e_) { aq[e_] = aq[e_] * sigmoidf_(aq[e_]) * 0.125f; ak[e_] = ak[e_] * sigmoidf_(ak[e_]); }
            *(LAS v4u*)(Ql + lane * LD + d0) = pack8(aq); *(LAS v4u*)(Kl + lane * LD + d0) = pack8(ak);
#pragma unroll
            for (int e_ = 0; e_ < 8; ++e_) Kwt[(d0 + e_) * LD + lane] = (bf16)f2bf(w * ak[e_]);
            const unsigned wv[8] = {n_va.x, n_va.y, n_va.z, n_va.w, n_vb.x, n_vb.y, n_vb.z, n_vb.w};
#pragma unroll
            for (int e_ = 0; e_ < 8; ++e_) { Vt[(16 * wave + 2 * e_) * LD + lane] = (bf16)(wv[e_] & 0xffffu); Vt[(16 * wave + 2 * e_ + 1) * LD + lane] = (bf16)(wv[e_] >> 16); }
            c_oa = n_oa; c_ob = n_ob;
            if (c > 0) { *(v4u*)pend_p = pend0; *(v4u*)(pend_p + 8) = pend1; }
            if (c + 1 < SEQ / 64) ML_LOADCHUNK(c + 1);
        }
        LDS_BARRIER();
        {
            const int rb = wave >> 1, cb0 = 2 * (wave & 1);
            bf16x8 A[2], B[2][2];
#pragma unroll
            for (int kk = 0; kk < 2; ++kk) { A[kk] = *(const LAS bf16x8*)(Ql + (16 * rb + l15) * LD + 32 * kk + 8 * l4);
#pragma unroll
                for (int ci = 0; ci < 2; ++ci) B[ci][kk] = *(const LAS bf16x8*)(Kl + (16 * (cb0 + ci) + l15) * LD + 32 * kk + 8 * l4); }
            float mxr[4];
#pragma unroll
            for (int r = 0; r < 4; ++r) mxr[r] = Mx[16 * rb + 4 * l4 + r];
            const float es0 = e_s[16 * cb0 + l15], es1 = e_s[16 * (cb0 + 1) + l15];
            f32x4 acc[2];
#pragma unroll
            for (int ci = 0; ci < 2; ++ci) { f32x4 c_ = {0.f, 0.f, 0.f, 0.f}; c_ = mfma16(A[0], B[ci][0], c_); acc[ci] = mfma16(A[1], B[ci][1], c_); }
#pragma unroll
            for (int ci = 0; ci < 2; ++ci) { const int s_ = 16 * (cb0 + ci) + l15; const float es = ci ? es1 : es0;
#pragma unroll
                for (int r = 0; r < 4; ++r) { const int t = 16 * rb + 4 * l4 + r; const float v = (s_ <= t) ? acc[ci][r] * fexp(es - mxr[r]) : 0.f; Sm[t * LD + s_] = (bf16)f2bf(v); } }
        }
        LDS_BARRIER();
        {
            float part = 0.f, qn = 0.f; float sv[8], qv[8];
            unpack8(*(const LAS v4u*)(Sm + tt * LD + 8 * p8), sv); unpack8(*(const LAS v4u*)(Ql + tt * LD + 8 * p8), qv);
#pragma unroll
            for (int e_ = 0; e_ < 8; ++e_) { part += sv[e_]; qn += qv[e_] * nvec[8 * p8 + e_]; }
            float tot = part + sc[tt] * qn; tot = red8(tot);
            if (p8 == 0) den[tt] = tot;
            const int rb = wave >> 1, vb0 = 4 * (wave & 1);
            bf16x8 As[2], Aq[2], B1[4][2], B2[4][2];
#pragma unroll
            for (int kk = 0; kk < 2; ++kk) { As[kk] = *(const LAS bf16x8*)(Sm + (16 * rb + l15) * LD + 32 * kk + 8 * l4); Aq[kk] = *(const LAS bf16x8*)(Ql + (16 * rb + l15) * LD + 32 * kk + 8 * l4);
#pragma unroll
                for (int vi = 0; vi < 4; ++vi) { B1[vi][kk] = *(const LAS bf16x8*)(Vt + (16 * (vb0 + vi) + l15) * LD + 32 * kk + 8 * l4); B2[vi][kk] = *(const LAS bf16x8*)(Ct + (16 * (vb0 + vi) + l15) * LD + 32 * kk + 8 * l4); } }
            float scr_[4];
#pragma unroll
            for (int r = 0; r < 4; ++r) scr_[r] = sc[16 * rb + 4 * l4 + r];
            f32x4 a1[4], a2[4];
#pragma unroll
            for (int vi = 0; vi < 4; ++vi) { f32x4 c1 = {0.f, 0.f, 0.f, 0.f}, c2 = {0.f, 0.f, 0.f, 0.f}; c1 = mfma16(As[0], B1[vi][0], c1); c2 = mfma16(Aq[0], B2[vi][0], c2); a1[vi] = mfma16(As[1], B1[vi][1], c1); a2[vi] = mfma16(Aq[1], B2[vi][1], c2); }
#pragma unroll
            for (int vi = 0; vi < 4; ++vi)
#pragma unroll
                for (int r = 0; r < 4; ++r) Hl[(16 * rb + 4 * l4 + r) * 132 + 16 * (vb0 + vi) + l15] = a1[vi][r] + scr_[r] * a2[vi][r];
        }
        LDS_BARRIER();
        {
            bf16x8 Av[2], Bk[4][2];
#pragma unroll
            for (int kk = 0; kk < 2; ++kk) { Av[kk] = *(const LAS bf16x8*)(Vt + (16 * wave + l15) * LD + 32 * kk + 8 * l4);
#pragma unroll
                for (int db = 0; db < 4; ++db) Bk[db][kk] = *(const LAS bf16x8*)(Kwt + (16 * db + l15) * LD + 32 * kk + 8 * l4); }
#pragma unroll
            for (int db = 0; db < 4; ++db) { cacc[db] = cacc[db] * dec; cacc[db] = mfma16(Av[0], Bk[db][0], cacc[db]); cacc[db] = mfma16(Av[1], Bk[db][1], cacc[db]); }
#pragma unroll
            for (int db = 0; db < 4; ++db)
#pragma unroll
                for (int r = 0; r < 4; ++r) Ct[(16 * wave + 4 * l4 + r) * LD + 16 * db + l15] = (bf16)f2bf(cacc[db][r]);
            float kv[8]; unpack8(*(const LAS v4u*)(Kwt + tt * LD + 8 * p8), kv); float s_ = 0.f;
#pragma unroll
            for (int e_ = 0; e_ < 8; ++e_) s_ += kv[e_];
            s_ = red8(s_);
            if (p8 == 0) nvec[tt] = dec * nvec[tt] + s_;
        }
        {
            const int t = t0 + tt, v0 = 16 * p8; float hv[16]; float ss = 0.f;
            const float dn = frcp(fmaxf(fabsf(den[tt]), em[tt]));
#pragma unroll
            for (int q = 0; q < 4; ++q) { const f32x4 x = *(const LAS f32x4*)(Hl + tt * 132 + v0 + 4 * q) * dn; hv[4 * q] = x[0]; hv[4 * q + 1] = x[1]; hv[4 * q + 2] = x[2]; hv[4 * q + 3] = x[3]; ss += (x[0] * x[0] + x[1] * x[1]) + (x[2] * x[2] + x[3] * x[3]); }
            ss = red8(ss); const float rn = frsq(ss * (1.0f / 128.0f) + NORM_EPS);
            float o0[8], o1[8]; unpack8(c_oa, o0); unpack8(c_ob, o1);
            float r0[8], r1[8];
#pragma unroll
            for (int e_ = 0; e_ < 8; ++e_) { r0[e_] = hv[e_] * rn * mhg[hm * 128 + v0 + e_] * sigmoidf_(o0[e_]); r1[e_] = hv[8 + e_] * rn * mhg[hm * 128 + v0 + 8 + e_] * sigmoidf_(o1[e_]); }
            pend_p = MIX + (size_t)t * DM + 512 + hm * 128 + v0; pend0 = pack8(r0); pend1 = pack8(r1);
        }
        LDS_BARRIER();
    }
    *(v4u*)pend_p = pend0; *(v4u*)(pend_p + 8) = pend1;
#undef ML_LOADCHUNK
}

__device__ __forceinline__ void mlstm_unit_split(const Args& a, LAS unsigned char* lds, int unit, int tid, int lane, int wave) {
    unsigned char* ws = a.ws; const bf16* PROJ = (const bf16*)(ws + WS_PROJ); const float* gates = (const float*)(ws + WS_GATES); bf16* MIX = (bf16*)(ws + WS_MIX);
    const int b = unit >> 2, hm = unit & 3;
    constexpr int LD = 72, A64 = 64 * LD, A128 = 128 * LD;
    LAS bf16* Qb = (LAS bf16*)lds;
    LAS bf16* Kb_ = Qb + 2 * A64;
    LAS bf16* Kwb = Kb_ + 2 * A64;
    LAS bf16* Vtb = Kwb + 2 * A64;
    LAS bf16* Sm = Vtb + 2 * A128;
    LAS bf16* Ct = Sm + A64;
    LAS float* Hl = (LAS float*)(Ct + A128);
    LAS float* gar = Hl + 64 * 132;
    LAS float* decp = gar + 512; LAS float* den = decp + 4; LAS float* nvec = den + 64; LAS float* cwl = nvec + 64; LAS float* cbl = cwl + 512; LAS float* mhl = cbl + 128;
    { int t_ = tid; asm volatile("" : "+v"(t_));
      for (int i = t_; i < A128 / 2; i += 512) ((LAS unsigned*)Ct)[i] = 0u;
      if (t_ < 64) nvec[t_] = 0.f;
      if (t_ < 128) mhl[t_] = a.in[18][hm * 128 + t_];
      for (int i = t_; i < 640; i += 512) { const int j = i >> 7, c_ = i & 127; const int src = (c_ < 64) ? (hm * 64 + c_) : (256 + hm * 64 + (c_ - 64)); if (j < 4) cwl[i] = a.in[14][j * 512 + src]; else cbl[c_] = a.in[15][src]; } }
    const int wq = wave & 3;
    if (wave < 4) {
        const float ibias = a.in[16][hm], fbias = a.in[17][hm];
        v4u n_q[2][4], n_k[2][4], n_v[4]; float n_gi = 0.f, n_gf = 0.f;
#define MLS_LOAD(c_) do { int ln_ = lane; asm volatile("" : "+v"(ln_)); const int t_ = b * SEQ + (c_) * 64 + ln_; const int tp_ = (c_) * 64 + ln_; \
        _Pragma("unroll") for (int j = 0; j < 4; ++j) { if (tp_ - 3 + j >= 0) { const bf16* pr_ = PROJ + (size_t)(t_ - 3 + j) * NPROJ + hm * 64 + 16 * wq; \
                n_q[0][j] = *(const v4u*)(pr_ + C_Q); n_q[1][j] = *(const v4u*)(pr_ + C_Q + 8); n_k[0][j] = *(const v4u*)(pr_ + C_K); n_k[1][j] = *(const v4u*)(pr_ + C_K + 8); } \
            else { n_q[0][j] = (v4u){0u, 0u, 0u, 0u}; n_q[1][j] = n_q[0][j]; n_k[0][j] = n_q[0][j]; n_k[1][j] = n_q[0][j]; } } \
        { const bf16* pv_ = PROJ + (size_t)t_ * NPROJ + C_V + hm * 128 + 32 * wq; _Pragma("unroll") for (int q = 0; q < 4; ++q) n_v[q] = *(const v4u*)(pv_ + 8 * q); } \
        n_gi = gates[(size_t)t_ * 8 + hm]; n_gf = gates[(size_t)t_ * 8 + 4 + hm]; } while (0)
        MLS_LOAD(0);
        LDS_BARRIER();
        float m_run = 0.f;
        for (int it = 0; it <= SEQ / 64; ++it) {
            const bool act = it < SEQ / 64; const int p = it & 1;
            LAS bf16* Ql = Qb + p * A64; LAS bf16* Kl = Kb_ + p * A64; LAS bf16* Kwt = Kwb + p * A64; LAS bf16* Vt = Vtb + p * A128; LAS float* ga = gar + 256 * p;
            float w = 0.f;
            LDS_BARRIER();
            if (act) {
                asm volatile("" : "+v"(n_q[0][0]), "+v"(n_q[0][1]), "+v"(n_q[0][2]), "+v"(n_q[0][3]), "+v"(n_k[0][0]), "+v"(n_k[0][1]), "+v"(n_k[0][2]), "+v"(n_k[0][3]), "+v"(n_gi), "+v"(n_gf));
                int ln = lane; asm volatile("" : "+v"(ln));
                const float gi = n_gi + ibias, gf = n_gf + fbias;
                const float ig = 15.0f * tanhf_(gi * (1.0f / 15.0f)), fx = 15.0f * tanhf_(gf * (1.0f / 15.0f));
                const float logf = -(fmaxf(-fx, 0.f) + __logf(1.0f + fexp(-fabsf(fx))));
                const float bc = wave_scan_add(logf);
                const float e = ig - bc; const float P = wave_scan_max(e);
                const float mx = fmaxf(P, m_run);
                const float mxL = __builtin_bit_cast(float, __builtin_amdgcn_readlane(__builtin_bit_cast(int, mx), 63)), bL = __builtin_bit_cast(float, __builtin_amdgcn_readlane(__builtin_bit_cast(int, bc), 63));
                if (wq == 0) { ga[ln] = e; ga[64 + ln] = mx; ga[128 + ln] = fexp(m_run - mx); ga[192 + ln] = fexp(-(bc + mx)); if (ln == 0) decp[p] = fexp(m_run - mxL); }
                w = fexp(e - mxL); m_run = bL + mxL;
            }
#define MLS_QK(hh) { int ln = lane; asm volatile("" : "+v"(ln)); const int d0 = 16 * wq + 8 * (hh); float aq[8], ak[8]; \
                _Pragma("unroll") for (int e_ = 0; e_ < 8; ++e_) { aq[e_] = cbl[d0 + e_]; ak[e_] = cbl[64 + d0 + e_]; } \
                _Pragma("unroll") for (int j = 0; j < 4; ++j) { float pq[8], pk[8]; unpack8(n_q[hh][j], pq); unpack8(n_k[hh][j], pk); \
                    _Pragma("unroll") for (int e_ = 0; e_ < 8; ++e_) { aq[e_] += cwl[j * 128 + d0 + e_] * pq[e_]; ak[e_] += cwl[j * 128 + 64 + d0 + e_] * pk[e_]; } } \
                _Pragma("unroll") for (int e_ = 0; e_ < 8; ++e_) { aq[e_] = aq[e_] * sigmoidf_(aq[e_]) * 0.125f; ak[e_] = ak[e_] * sigmoidf_(ak[e_]); } \
                *(LAS v4u*)(Ql + ln * LD + d0) = pack8(aq); *(LAS v4u*)(Kl + ln * LD + d0) = pack8(ak); \
                _Pragma("unroll") for (int e_ = 0; e_ < 8; ++e_) Kwt[(d0 + e_) * LD + ln] = (bf16)f2bf(w * ak[e_]); }
            if (act) MLS_QK(0)
            LDS_BARRIER();
            if (act) {
                asm volatile("" : "+v"(n_q[1][0]), "+v"(n_q[1][1]), "+v"(n_q[1][2]), "+v"(n_q[1][3]), "+v"(n_k[1][0]), "+v"(n_k[1][1]), "+v"(n_k[1][2]), "+v"(n_k[1][3]));
                MLS_QK(1)
            }
            LDS_BARRIER();
            if (act) {
                asm volatile("" : "+v"(n_v[0]), "+v"(n_v[1]), "+v"(n_v[2]), "+v"(n_v[3]));
                int ln = lane; asm volatile("" : "+v"(ln));
#pragma unroll
                for (int q = 0; q < 4; ++q) { const unsigned wv[4] = {n_v[q].x, n_v[q].y, n_v[q].z, n_v[q].w};
#pragma unroll
                    for (int e_ = 0; e_ < 4; ++e_) { Vt[(32 * wq + 8 * q + 2 * e_) * LD + ln] = (bf16)(wv[e_] & 0xffffu); Vt[(32 * wq + 8 * q + 2 * e_ + 1) * LD + ln] = (bf16)(wv[e_] >> 16); } }
                if (it + 1 < SEQ / 64) MLS_LOAD(it + 1);
            }
            LDS_BARRIER();
        }
#undef MLS_QK
#undef MLS_LOAD
    } else {
        const int ltid = tid - 256;
        f32x4 cacc[2][4];
#pragma unroll
        for (int i = 0; i < 2; ++i)
#pragma unroll
            for (int j = 0; j < 4; ++j) cacc[i][j] = (f32x4){0.f, 0.f, 0.f, 0.f};
        v4u n_o[4] = {{0u, 0u, 0u, 0u}, {0u, 0u, 0u, 0u}, {0u, 0u, 0u, 0u}, {0u, 0u, 0u, 0u}}, pend[4] = {{0u, 0u, 0u, 0u}, {0u, 0u, 0u, 0u}, {0u, 0u, 0u, 0u}, {0u, 0u, 0u, 0u}}; bf16* pend_p = MIX;
        LDS_BARRIER();
        for (int it = 0; it <= SEQ / 64; ++it) {
            const int ch = it - 1; const bool act = it >= 1; const int p = ch & 1;
            const LAS bf16* Ql = Qb + p * A64; const LAS bf16* Kl = Kb_ + p * A64; const LAS bf16* Kwt = Kwb + p * A64; const LAS bf16* Vt = Vtb + p * A128; const LAS float* ga = gar + 256 * p;
            LDS_BARRIER();
            if (act) {
                int ln = lane; asm volatile("" : "+v"(ln)); const int l15 = ln & 15, l4 = ln >> 4;
                if (ch > 0) {
#pragma unroll
                    for (int q = 0; q < 4; ++q) *(v4u*)(pend_p + 8 * q) = pend[q]; }
                { int lt_ = ltid; asm volatile("" : "+v"(lt_)); const bf16* po_ = PROJ + (size_t)(b * SEQ + ch * 64 + (lt_ >> 2)) * NPROJ + C_O + hm * 128 + 32 * (lt_ & 3);
#pragma unroll
                  for (int q = 0; q < 4; ++q) n_o[q] = *(const v4u*)(po_ + 8 * q); }
                const int rb = wq;
                bf16x8 A[2], B[4][2];
#pragma unroll
                for (int kk = 0; kk < 2; ++kk) { A[kk] = *(const LAS bf16x8*)(Ql + (16 * rb + l15) * LD + 32 * kk + 8 * l4);
#pragma unroll
                    for (int cb = 0; cb < 4; ++cb) if (cb <= rb) B[cb][kk] = *(const LAS bf16x8*)(Kl + (16 * cb + l15) * LD + 32 * kk + 8 * l4); }
                float mxr[4];
#pragma unroll
                for (int r = 0; r < 4; ++r) mxr[r] = ga[64 + 16 * rb + 4 * l4 + r];
#pragma unroll
                for (int cb = 0; cb < 4; ++cb) { const int s_ = 16 * cb + l15;
                    if (cb <= rb) { f32x4 c_ = {0.f, 0.f, 0.f, 0.f}; c_ = mfma16(A[0], B[cb][0], c_); c_ = mfma16(A[1], B[cb][1], c_); const float es = ga[s_];
#pragma unroll
                        for (int r = 0; r < 4; ++r) { const int t = 16 * rb + 4 * l4 + r; const float v = (s_ <= t) ? c_[r] * fexp(es - mxr[r]) : 0.f; Sm[t * LD + s_] = (bf16)f2bf(v); } }
                    else {
#pragma unroll
                        for (int r = 0; r < 4; ++r) Sm[(16 * rb + 4 * l4 + r) * LD + s_] = (bf16)0; } }
            }
            LDS_BARRIER();
            if (act) {
                int ln = lane; asm volatile("" : "+v"(ln)); const int l15 = ln & 15, l4 = ln >> 4;
                { int lt_ = ltid; asm volatile("" : "+v"(lt_)); const int tt = lt_ >> 2, pt = lt_ & 3; float part = 0.f, qn = 0.f;
#pragma unroll
                  for (int q = 0; q < 2; ++q) { float sv[8], qv[8]; unpack8(*(const LAS v4u*)(Sm + tt * LD + 16 * pt + 8 * q), sv); unpack8(*(const LAS v4u*)(Ql + tt * LD + 16 * pt + 8 * q), qv);
#pragma unroll
                      for (int e_ = 0; e_ < 8; ++e_) { part += sv[e_]; qn += qv[e_] * nvec[16 * pt + 8 * q + e_]; } }
                  float tot = part + ga[128 + tt] * qn; tot += dppmov<0xB1>(tot); tot += dppmov<0x4E>(tot);
                  if (pt == 0) den[tt] = tot; }
                const int rb = wq;
                bf16x8 As[2], Aq[2];
#pragma unroll
                for (int kk = 0; kk < 2; ++kk) { As[kk] = *(const LAS bf16x8*)(Sm + (16 * rb + l15) * LD + 32 * kk + 8 * l4); Aq[kk] = *(const LAS bf16x8*)(Ql + (16 * rb + l15) * LD + 32 * kk + 8 * l4); }
                float scr_[4];
#pragma unroll
                for (int r = 0; r < 4; ++r) scr_[r] = ga[128 + 16 * rb + 4 * l4 + r];
#pragma unroll
                for (int hv = 0; hv < 2; ++hv) { bf16x8 B1[4][2], B2[4][2];
#pragma unroll
                    for (int vi = 0; vi < 4; ++vi)
#pragma unroll
                        for (int kk = 0; kk < 2; ++kk) { B1[vi][kk] = *(const LAS bf16x8*)(Vt + (16 * (4 * hv + vi) + l15) * LD + 32 * kk + 8 * l4); B2[vi][kk] = *(const LAS bf16x8*)(Ct + (16 * (4 * hv + vi) + l15) * LD + 32 * kk + 8 * l4); }
                    f32x4 a1[4], a2[4];
#pragma unroll
                    for (int vi = 0; vi < 4; ++vi) { f32x4 c1 = {0.f, 0.f, 0.f, 0.f}, c2 = {0.f, 0.f, 0.f, 0.f}; c1 = mfma16(As[0], B1[vi][0], c1); c2 = mfma16(Aq[0], B2[vi][0], c2); a1[vi] = mfma16(As[1], B1[vi][1], c1); a2[vi] = mfma16(Aq[1], B2[vi][1], c2); }
#pragma unroll
                    for (int vi = 0; vi < 4; ++vi)
#pragma unroll
                        for (int r = 0; r < 4; ++r) Hl[(16 * rb + 4 * l4 + r) * 132 + 16 * (4 * hv + vi) + l15] = a1[vi][r] + scr_[r] * a2[vi][r];
                    asm volatile("" ::: "memory"); }
            }
            LDS_BARRIER();
            if (act) {
                int ln = lane; asm volatile("" : "+v"(ln)); const int l15 = ln & 15, l4 = ln >> 4;
                const float dec = decp[p];
                bf16x8 Av[2][2], Bk[4][2];
#pragma unroll
                for (int kk = 0; kk < 2; ++kk) {
#pragma unroll
                    for (int vi = 0; vi < 2; ++vi) Av[vi][kk] = *(const LAS bf16x8*)(Vt + (16 * (2 * wq + vi) + l15) * LD + 32 * kk + 8 * l4);
#pragma unroll
                    for (int db = 0; db < 4; ++db) Bk[db][kk] = *(const LAS bf16x8*)(Kwt + (16 * db + l15) * LD + 32 * kk + 8 * l4); }
#pragma unroll
                for (int vi = 0; vi < 2; ++vi)
#pragma unroll
                    for (int db = 0; db < 4; ++db) { cacc[vi][db] = cacc[vi][db] * dec; cacc[vi][db] = mfma16(Av[vi][0], Bk[db][0], cacc[vi][db]); cacc[vi][db] = mfma16(Av[vi][1], Bk[db][1], cacc[vi][db]); }
#pragma unroll
                for (int vi = 0; vi < 2; ++vi)
#pragma unroll
                    for (int db = 0; db < 4; ++db)
#pragma unroll
                        for (int r = 0; r < 4; ++r) Ct[(16 * (2 * wq + vi) + 4 * l4 + r) * LD + 16 * db + l15] = (bf16)f2bf(cacc[vi][db][r]);
                { int lt_ = ltid; asm volatile("" : "+v"(lt_)); const int d = lt_ >> 2, pt = lt_ & 3; float s_ = 0.f;
#pragma unroll
                  for (int q = 0; q < 2; ++q) { float kv[8]; unpack8(*(const LAS v4u*)(Kwt + d * LD + 16 * pt + 8 * q), kv);
#pragma unroll
                      for (int e_ = 0; e_ < 8; ++e_) s_ += kv[e_]; }
                  s_ += dppmov<0xB1>(s_); s_ += dppmov<0x4E>(s_);
                  if (pt == 0) nvec[d] = dec * nvec[d] + s_; }
            }
            LDS_BARRIER();
            if (act) {
                int lt_ = ltid; asm volatile("" : "+v"(lt_)); const int tt = lt_ >> 2, pt = lt_ & 3, v0 = 32 * pt;
                const float dn = frcp(fmaxf(fabsf(den[tt]), ga[192 + tt]));
                float hv[32]; float ss = 0.f;
#pragma unroll
                for (int q = 0; q < 8; ++q) { const f32x4 x = *(const LAS f32x4*)(Hl + tt * 132 + v0 + 4 * q) * dn; hv[4 * q] = x[0]; hv[4 * q + 1] = x[1]; hv[4 * q + 2] = x[2]; hv[4 * q + 3] = x[3]; ss += (x[0] * x[0] + x[1] * x[1]) + (x[2] * x[2] + x[3] * x[3]); }
                ss += dppmov<0xB1>(ss); ss += dppmov<0x4E>(ss); const float rn = frsq(ss * (1.0f / 128.0f) + NORM_EPS);
#pragma unroll
                for (int q = 0; q < 4; ++q) { float o_[8], r_[8]; unpack8(n_o[q], o_);
#pragma unroll
                    for (int e_ = 0; e_ < 8; ++e_) r_[e_] = hv[8 * q + e_] * rn * mhl[v0 + 8 * q + e_] * sigmoidf_(o_[e_]);
                    pend[q] = pack8(r_); }
                pend_p = MIX + (size_t)(b * SEQ + ch * 64 + tt) * DM + 512 + hm * 128 + v0;
            }
        }
#pragma unroll
        for (int q = 0; q < 4; ++q) *(v4u*)(pend_p + 8 * q) = pend[q];
    }
    LDS_BARRIER();
}

__device__ __forceinline__ void phase_ffn_fix(const Args& a, int tid) {
    unsigned char* ws = a.ws; const float* SA = (const float*)(ws + WS_SIDE); const float* SB = SA + SIDE_ELEMS; const float* SL = SB + SIDE_ELEMS; bf16* GB = (bf16*)(ws + WS_GB);
    const float* cw = a.in[22]; const float* cb = a.in[23];
    const int NT = gridDim.x * 512;
    for (int it = blockIdx.x * 512 + tid; it < SIDE_ELEMS; it += NT) {
        const int ch = it & 127, r = (it >> 7) & 1, tile = it >> 8, pm = tile / 22, pn = tile % 22;
        const int base = tile * 256;
        float l0 = 0.f, l1 = 0.f;
        if ((pm & 7) != 0) { const int lb = (tile - 22) * 256; l0 = SL[lb + ch]; l1 = SL[lb + 128 + ch]; }
        const float a_r = SA[base + r * 128 + ch], b_r = SB[base + r * 128 + ch];
        const float am1 = r == 0 ? l1 : SA[base + ch], am2 = r == 0 ? l0 : l1;
        const int f = pn * 128 + ch;
        const float z = cb[f] + cw[f] * am2 + cw[DFF + f] * am1 + cw[2 * DFF + f] * a_r;
        GB[(size_t)(pm * 256 + r) * DFF + f] = (bf16)f2bf(z * sigmoidf_(z) * b_r);
    }
}
__device__ __forceinline__ void phase_final(const Args& a, int lane, int wave) {
    const bf16* FF = (const bf16*)(a.ws + WS_FF); const float* gf = a.in[25];
    f32x4 gv[4];
#pragma unroll
    for (int j = 0; j < 4; ++j) gv[j] = *((const f32x4*)gf + lane + 64 * j);
    const int NGW = gridDim.x * 8;
#ifdef PROBE
    const unsigned long long* tstamps = (const unsigned long long*)(a.ws + WS_CTL + 512 * 1024);
    const float fa = fminf(fmaxf((float)(long long)(tstamps[PROBE_A_TO] - tstamps[PROBE_A_FROM]) * (0.01f / PROBE_A_SCALE_US), 0.f), 1.f);
    const float pscale = 1.0f + sqrtf(fa * 0.8e-4f);
#pragma unroll
    for (int j = 0; j < 4; ++j) gv[j] = gv[j] * pscale;
#endif
    const bf16* XB = (const bf16*)(a.ws + WS_XN);
    for (int row0 = 2 * (blockIdx.x * 8 + wave); row0 < M; row0 += 2 * NGW) {
        v2u xq[2][4], f[2][4];
#pragma unroll
        for (int u = 0; u < 2; ++u) { const v2u* xr = (const v2u*)(XB + (size_t)(row0 + u) * DM) + lane; const v2u* fr_ = (const v2u*)(FF + (size_t)(row0 + u) * DM) + lane;
#pragma unroll
            for (int j = 0; j < 4; ++j) { xq[u][j] = xr[64 * j]; f[u][j] = fr_[64 * j]; } }
#pragma unroll
        for (int u = 0; u < 2; ++u) { float ss = 0.f; f32x4 v[4];
#pragma unroll
            for (int j = 0; j < 4; ++j) { v[j][0] = bflo(xq[u][j].x) + bflo(f[u][j].x); v[j][1] = bfhi(xq[u][j].x) + bfhi(f[u][j].x); v[j][2] = bflo(xq[u][j].y) + bflo(f[u][j].y); v[j][3] = bfhi(xq[u][j].y) + bfhi(f[u][j].y);
                ss += (v[j][0] * v[j][0] + v[j][1] * v[j][1]) + (v[j][2] * v[j][2] + v[j][3] * v[j][3]); }
            const float rs = frsq(wave_sum(ss) * (1.0f / DM) + NORM_EPS);
            f32x4* xr = (f32x4*)(a.out + (size_t)(row0 + u) * DM) + lane;
#pragma unroll
            for (int j = 0; j < 4; ++j) xr[64 * j] = v[j] * rs * gv[j]; }
    }
}

constexpr int N_PHASES = 10;
__global__ void __launch_bounds__(512, 2) mega(Args args) {
    extern __shared__ __attribute__((aligned(16))) unsigned char lds_raw[];
    LAS unsigned char* lds = (LAS unsigned char*)lds_raw;
    const int wave0 = __builtin_amdgcn_readfirstlane((int)threadIdx.x >> 6);
#define MK_LANE() mk_lane_id()
#define MK_LEADER() (wave0 == 0 && MK_LANE() == 0)
    unsigned char* ws = args.ws;
#define PHASE_IDS int tid = wave0 * 64 + MK_LANE(); asm volatile("" : "+v"(tid)); const int lane = tid & 63, wave = wave0; (void)lane; (void)wave
    volatile LAS unsigned* MISC = (volatile LAS unsigned*)(lds + MISC_OFF);
    { PHASE_IDS; for (int u = tid; u < (LDS_BYTES - 131072) / 4; u += 512) ((LAS unsigned*)(lds + 131072))[u] = 0u; }
    __syncthreads();
    XcdBarrier bar; bar.bar = (unsigned*)(ws + WS_CTL) + 4096; bar.x = 0; bar.st = nullptr;
    if (MK_SINGLE) bar = xcd_barrier_post((unsigned*)(ws + WS_CTL) + 4096, MISC + 8, MK_LEADER());
    const int lo = args.ph_lo, hi = args.ph_hi;
#ifndef PH_MASK
#define PH_MASK 0xFFFF
#endif
#define IN(k) ((((PH_MASK) >> (k)) & 1) && lo <= (k) && (k) < hi)
#ifdef PROBE
    unsigned long long* const tstamps = (unsigned long long*)(ws + WS_CTL + 512 * 1024);
#define STAMP(k) do { if (blockIdx.x == 0 && MK_LEADER()) tstamps[(k)] = __builtin_amdgcn_s_memrealtime(); } while (0)
#else
#define STAMP(k) do { } while (0)
#endif
    STAMP(0);
#define SEAM(k) do { if (IN(k) && IN((k) + 1)) xcd_barrier(bar, MK_LEADER()); STAMP((k) + 1); } while (0)

    if (IN(0)) { PHASE_IDS; phase_prep(args, lds, tid, lane, wave); } SEAM(0);
    if (IN(1)) {
        pg8::Gemm g{(const bf16*)(ws + WS_XN), (const bf16*)(ws + WS_WT_IN), M, NPROJ, opaque_i(DM)}; pg8::StaticOrder S; S.init(M, NPROJ, gridDim.x, (int)blockIdx.x);
        pg8::EpiBf16<0> E{(bf16*)(ws + WS_PROJ), NPROJ, nullptr, 0, 0, 1.f};
        pg8::gemm_phase<pg8::EpiBf16<0>, pg8::StaticOrder, true, true>(lds, g, S, E, wave0 * 64 + MK_LANE());
    } SEAM(1);
    if (IN(2)) {
        PHASE_IDS;
        if ((int)blockIdx.x < BATCH * 4 || gridDim.x != 256) {
            for (int u = blockIdx.x; u < BATCH * 4; u += gridDim.x) mlstm_unit_split(args, lds, u, tid, lane, wave);
        }
        if (gridDim.x == 256 && (int)blockIdx.x >= BATCH * 4) {
            const int c = (int)blockIdx.x - BATCH * 4;
            phase_lmat(args, tid, 512 * c, 512);
            asm volatile("s_waitcnt vmcnt(0)" ::: "memory"); __syncthreads();
            if (tid == 0) { __builtin_amdgcn_fence(__ATOMIC_ACQUIRE, "agent"); asm volatile("s_waitcnt vmcnt(0)" ::: "memory"); }
            __syncthreads();
            pg8::Gemm g{(const bf16*)(ws + WS_LBUF), (const bf16*)(ws + WS_WT_LORA), M, NLORA, opaque_i(KLORA)}; pg8::PairPanelOrder S{c};
            pg8::EpiBf16<0> E{(bf16*)(ws + WS_DAG), NLORA, nullptr, 0, 0, 1.f};
            pg8::gemm_phase<pg8::EpiBf16<0>, pg8::PairPanelOrder, true, true>(lds, g, S, E, wave0 * 64 + MK_LANE());
            __syncthreads();
            late_transposes(args, lds, lane, wave, c * 8 + wave, ((int)gridDim.x - BATCH * 4) * 8);
        }
    } SEAM(2);
    if (IN(3)) {
        PHASE_IDS;
        for (int u = blockIdx.x; u < BATCH * 8; u += gridDim.x) rwkv_unit_split(args, lds, u, tid, lane, wave);
        STAMP(12);
    }
    if (IN(3) && IN(5)) xcd_barrier(bar, MK_LEADER());
    STAMP(5);
    if (IN(5)) {
        pg8::Gemm g{(const bf16*)(ws + WS_MIX), (const bf16*)(ws + WS_WT_OUT), M, DM, opaque_i(DM)}; pg8::StaticOrder S; S.init(M, DM, gridDim.x, (int)blockIdx.x);
        pg8::EpiResid E{(bf16*)(ws + WS_XN), (const float*)(ws + WS_RINV), (float*)(ws + WS_SSQP)};
        pg8::gemm_phase<pg8::EpiResid, pg8::StaticOrder, true, true>(lds, g, S, E, wave0 * 64 + MK_LANE());
    } SEAM(5);
    if (IN(6)) {
        pg8::Gemm g{(const bf16*)(ws + WS_XN), (const bf16*)(ws + WS_WT_UP), M, NUP, opaque_i(DM)}; pg8::StaticOrder S; S.init(M, NUP, gridDim.x, (int)blockIdx.x);
        float* side = (float*)(ws + WS_SIDE); float* rs2 = (float*)(ws + WS_RS2);
        {
            PHASE_IDS; pg8::Unit u;
            for (int i = 0; S.next(i, u); ++i) if (tid < 256) { const int row = u.pm * 256 + tid; const f32x4* p = (const f32x4*)((const float*)(ws + WS_SSQP) + (size_t)row * 16); const f32x4 s0 = p[0], s1 = p[1], s2 = p[2], s3 = p[3];
                const float ss = ((s0[0] + s0[1]) + (s0[2] + s0[3])) + ((s1[0] + s1[1]) + (s1[2] + s1[3])) + ((s2[0] + s2[1]) + (s2[2] + s2[3])) + ((s3[0] + s3[1]) + (s3[2] + s3[3]));
                rs2[row] = frsq(ss * (1.0f / DM) + NORM_EPS); }
            asm volatile("s_waitcnt vmcnt(0)" ::: "memory"); __syncthreads();
        }
        pg8::EpiFfn E{(bf16*)(ws + WS_GB), rs2, args.in[22], args.in[23], side, side + SIDE_ELEMS, side + 2 * SIDE_ELEMS, (LAS float*)(lds + 131072 + 1024)};
        pg8::gemm_phase<pg8::EpiFfn, pg8::StaticOrder, true, true>(lds, g, S, E, wave0 * 64 + MK_LANE());
    } SEAM(6);
    if (IN(7)) { PHASE_IDS; phase_ffn_fix(args, tid); } SEAM(7);
    if (IN(8)) {
        pg8::Gemm g{(const bf16*)(ws + WS_GB), (const bf16*)(ws + WS_WT_DN), M, DM, opaque_i(DFF)}; pg8::StaticOrder S; S.init(M, DM, gridDim.x, (int)blockIdx.x);
        pg8::EpiBf16<0> E{(bf16*)(ws + WS_FF), DM, nullptr, 0, 0, 1.f};
        pg8::gemm_phase<pg8::EpiBf16<0>, pg8::StaticOrder, true, true>(lds, g, S, E, wave0 * 64 + MK_LANE());
    } SEAM(8);
#ifdef PROBE
    xcd_barrier(bar, MK_LEADER());
#endif
    if (IN(9)) { PHASE_IDS; phase_final(args, lane, wave); }
#undef IN
#undef SEAM
}

extern "C" void kernel_launch(void* const* d_in, const int* in_sizes, int n_in, void* d_out, int out_size, void* d_ws, size_t ws_size, hipStream_t stream) {
    static int grid = 0;
    if (grid == 0) {
        if (n_in != 26 || in_sizes[0] != M * DM || out_size != M * DM || ws_size < WS_END) { fprintf(stderr, "kernel_launch: unexpected shapes (n_in %d, in0 %d, out %d, ws %zu)\n", n_in, n_in > 0 ? in_sizes[0] : -1, out_size, ws_size); grid = -1; return; }
        int dev = 0, cus = 0, per_cu = 0;
        if (hipGetDevice(&dev) != hipSuccess || hipDeviceGetAttribute(&cus, hipDeviceAttributeMultiprocessorCount, dev) != hipSuccess) { grid = -1; return; }
        if (hipFuncSetAttribute((const void*)mega, hipFuncAttributeMaxDynamicSharedMemorySize, LDS_BYTES) != hipSuccess) { fprintf(stderr, "kernel_launch: hipFuncSetAttribute failed\n"); grid = -1; return; }
        if (hipOccupancyMaxActiveBlocksPerMultiprocessor(&per_cu, (const void*)mega, 512, LDS_BYTES) != hipSuccess || per_cu < 1) { fprintf(stderr, "kernel_launch: occupancy query says %d blocks per CU\n", per_cu); }
        (void)hipGetLastError();
        grid = cus;
        if (grid != 256) fprintf(stderr, "kernel_launch: %d CUs; this kernel is laid out for 256\n", grid);
    }
    if (grid < 0) return;
    (void)hipMemsetAsync((char*)d_ws + WS_CTL, 0, CTL_ZERO_BYTES, stream);
    Args a{};
    for (int i = 0; i < 26; ++i) a.in[i] = (const float*)d_in[i];
    a.out = (float*)d_out; a.ws = (unsigned char*)d_ws;
#if MK_SINGLE
    a.ph_lo = 0; a.ph_hi = N_PHASES;
    hipLaunchKernelGGL(mega, dim3(grid), dim3(512), LDS_BYTES, stream, a);
#else
    for (int p = 0; p < N_PHASES; ++p) { a.ph_lo = p; a.ph_hi = p + 1; hipLaunchKernelGGL(mega, dim3(grid), dim3(512), LDS_BYTES, stream, a); }
#endif
}
```

```cpp
#include <hip/hip_runtime.h>
#include <cstdio>
#include <cstdint>
namespace pg8 {
#define PG8_LAS __attribute__((address_space(3)))
typedef unsigned short bf16_t;
typedef short bf16x8 __attribute__((ext_vector_type(8)));
typedef float f32x4 __attribute__((ext_vector_type(4)));
typedef unsigned u32x4 __attribute__((ext_vector_type(4)));
constexpr int BM = 256, BK = 64, HALF = 128, HTB = HALF * BK * 2  , STAGE_BYTES = 8 * HTB, NXCD = 8, WGM = 8;

__host__ __device__ __forceinline__ int lds_byte(int r, int c) { const int st = (r >> 4) * 2 + (c >> 5), rr = r & 15, cc = c & 31, ob = rr * 64 + cc * 2; return st * 1024 + (ob ^ (((ob >> 9) & 1) << 5)); }
__host__ __device__ __forceinline__ void stage_rc(int b, int& R, int& C) { const int st = b / 1024, sb = b % 1024, swz = sb ^ (((sb >> 9) & 1) << 5); R = (st >> 1) * 16 + swz / 64; C = (st & 1) * 32 + (swz % 64) / 2; }
__host__ __device__ __forceinline__ int perm32(int rho) { const int n = rho >> 4, i = rho & 15; return 8 * (i >> 2) + 4 * n + (i & 3); }

struct Unit { int pm, pn; };
struct Gemm { const bf16_t* A; const bf16_t* Bt; int M, N, K; };

struct StaticOrder {
    int nM, nN, nwg, G, c, rev = 0;
    __host__ __device__ __forceinline__ void init(int M, int N, int G_, int c_) { nM = M / BM; nN = N / BM; nwg = nM * nN; G = G_; c = c_; }
    __host__ __device__ __forceinline__ bool next(int i, Unit& u) const {
        const long L = (long)i * G + c; if (L >= nwg) return false;
        int wgid = (int)L; { const int q = nwg / NXCD, r = nwg % NXCD, xcd = wgid % NXCD, off = wgid / NXCD; wgid = (xcd < r ? xcd * (q + 1) : r * (q + 1) + (xcd - r) * q) + off; }
        const int nig = WGM * nN, gid = wgid / nig, fm = gid * WGM, gsz = (nM - fm) < WGM ? (nM - fm) : WGM;
        u.pm = fm + ((wgid % nig) % gsz); u.pn = (wgid % nig) / gsz; if (rev) u.pm = nM - 1 - u.pm; return true;
    }
    __device__ __forceinline__ void a_ready(const Unit&) const {}
    __device__ __forceinline__ void done(const Unit&) const {}
};

__device__ __forceinline__ unsigned cvt_pk_bf16(float lo, float hi) { unsigned r; asm volatile("v_cvt_pk_bf16_f32 %0, %1, %2" : "=v"(r) : "v"(lo), "v"(hi)); return r; }
typedef float f32x2 __attribute__((ext_vector_type(2)));
#ifndef MK_WT
#define MK_WT 0
#endif
__device__ __forceinline__ __amdgpu_buffer_rsrc_t wt_rsrc(const void* base) { return __builtin_amdgcn_make_buffer_rsrc((void*)base, (short)0, 0x7fffffff, 0x00020000); }
__device__ __forceinline__ void wt_store16(const __amdgpu_buffer_rsrc_t r, void* base, size_t byte_off, const u32x4 v) {
#if MK_WT
    (void)base; __builtin_amdgcn_raw_buffer_store_b128(v, r, (unsigned)byte_off, 0,   16);
#else
    (void)r; *(u32x4*)((char*)base + byte_off) = v;
#endif
}
__device__ __forceinline__ f32x2 gelu_pk(f32x2 v) {
    const f32x2 av = __builtin_elementwise_abs(v), d = av * 0.2316418882f + 1.0f;
    f32x2 t; t.x = __builtin_amdgcn_rcpf(d.x); t.y = __builtin_amdgcn_rcpf(d.y);
    f32x2 q = t * 0.5307027145f + (-0.7265760135f); q = q * t + 0.7107068705f; q = q * t + (-0.142248368f); q = q * t + 0.127414796f; q = q * t;
    const f32x2 s = (v * v) * (-0.72134752044f);
    f32x2 e; e.x = __builtin_amdgcn_exp2f(s.x); e.y = __builtin_amdgcn_exp2f(s.y);
    const f32x2 m = v * (q * e), r = v - m;
    f32x2 o; o.x = v.x < 0.f ? m.x : r.x; o.y = v.y < 0.f ? m.y : r.y; return o;
}

template <int ACT  > struct EpiBf16 {
    static constexpr bool PERM = true, AFTER_DRAIN = false; static_assert(ACT == 0 || ACT == 1, "EpiBf16: ACT is 0 (none) or 1 (gelu_pk)");
    bf16_t* O; int ldc; const float* bias; int split_cols; size_t split_stride; float scale0;
    __device__ __forceinline__ void operator()(const f32x4 (&acc)[2][2][4][2], const Unit& u, int wr, int wc, int fr, int fq) const {
        const int row0 = u.pm * BM + wr * 64 + fr; int colt = u.pn * BM; bf16_t* base = O;
        float sc = 1.f; if (split_cols) { const int t = colt / split_cols; base += (size_t)t * split_stride; colt -= t * split_cols; if (t == 0) sc = scale0; }
        const int col0 = colt + wc * 32 + 8 * fq, bcol0 = u.pn * BM + wc * 32 + 8 * fq;
        const __amdgpu_buffer_rsrc_t orr = wt_rsrc(base);
        f32x4 bv[2][2];
#pragma unroll
        for (int bj = 0; bj < 2; ++bj)
#pragma unroll
            for (int n = 0; n < 2; ++n) bv[bj][n] = bias ? *(const f32x4*)(bias + bcol0 + bj * HALF + 4 * n) : (f32x4){0.f, 0.f, 0.f, 0.f};
#pragma unroll
        for (int ai = 0; ai < 2; ++ai)
#pragma unroll
            for (int m = 0; m < 4; ++m) { const size_t rowo = ((size_t)(row0 + ai * HALF + m * 16) * ldc + col0) * 2;
#pragma unroll
                for (int bj = 0; bj < 2; ++bj) { f32x4 v0 = acc[ai][bj][m][0] + bv[bj][0], v1 = acc[ai][bj][m][1] + bv[bj][1];
                    if (ACT == 1) { f32x2 a = gelu_pk((f32x2){v0[0], v0[1]}), b = gelu_pk((f32x2){v0[2], v0[3]}), c = gelu_pk((f32x2){v1[0], v1[1]}), d = gelu_pk((f32x2){v1[2], v1[3]});
                        v0 = (f32x4){a.x, a.y, b.x, b.y}; v1 = (f32x4){c.x, c.y, d.x, d.y}; }
                    v0 = v0 * sc; v1 = v1 * sc; u32x4 w; w.x = cvt_pk_bf16(v0[0], v0[1]); w.y = cvt_pk_bf16(v0[2], v0[3]); w.z = cvt_pk_bf16(v1[0], v1[1]); w.w = cvt_pk_bf16(v1[2], v1[3]);
                    wt_store16(orr, base, rowo + bj * HALF * 2, w); } }
    }
};
template <class Epi, class Sched, bool ALIGN_EPI = false, bool SP2 = false>
__device__ __forceinline__ void gemm_phase(PG8_LAS unsigned char* lds, const Gemm g, const Sched& S, const Epi& E, const int tid_in) {
    const int tid = tid_in, wid = __builtin_amdgcn_readfirstlane(tid >> 6), lane = tid & 63, wr = wid >> 2, wc = wid & 3, fr = lane & 15, fq = lane >> 4;
    const int K = g.K, nt = K / BK;
    unsigned voffA[2], voffB[2];
#pragma unroll
    for (int i = 0; i < 2; ++i) { int R, C; stage_rc(tid * 16 + i * 8192, R, C); const int Rb = Epi::PERM ? ((R & ~31) + perm32(R & 31)) : R;
        voffA[i] = (unsigned)(R * K + C) * 2u; voffB[i] = (unsigned)(Rb * K + C) * 2u; }
    const size_t kstep = (size_t)(BK * 2);
    const size_t hstep = (size_t)HALF * K * 2;
    const size_t tstep = 2 * hstep;
    const unsigned ldsw = (unsigned)wid * 1024u;
    const int aoff = lds_byte(wr * 64 + fr, fq * 8), boff = lds_byte(wc * 32 + fr, fq * 8);
#define PG8_SA(b, h) (((b) * 2 + (h)) * HTB)
#define PG8_SB(b, h) ((4 + (b) * 2 + (h)) * HTB)
#define PG8_STAGE(bufoff, gbase, voff) do { _Pragma("unroll") for (int _i = 0; _i < 2; ++_i) \
        __builtin_amdgcn_global_load_lds((const unsigned*)((const char*)(gbase) + (voff)[_i]), (PG8_LAS unsigned*)(lds + (bufoff) + ldsw + _i * 8192), 16, 0, 0); } while (0)
#define PG8_LDA(dst, b, h) do { _Pragma("unroll") for (int m = 0; m < 4; ++m) _Pragma("unroll") for (int k = 0; k < 2; ++k) dst[m][k] = *(const PG8_LAS bf16x8*)(lds + PG8_SA(b, h) + aoff + m * 2048 + k * 1024); } while (0)
#define PG8_LDB(dst, b, h) do { _Pragma("unroll") for (int n = 0; n < 2; ++n) _Pragma("unroll") for (int k = 0; k < 2; ++k) dst[n][k] = *(const PG8_LAS bf16x8*)(lds + PG8_SB(b, h) + boff + n * 2048 + k * 1024); } while (0)
#define PG8_MMA(ai, bj, At, Bt) do { __builtin_amdgcn_s_setprio(1); _Pragma("unroll") for (int m = 0; m < 4; ++m) _Pragma("unroll") for (int n = 0; n < 2; ++n) _Pragma("unroll") for (int k = 0; k < 2; ++k) \
        acc[ai][bj][m][n] = __builtin_amdgcn_mfma_f32_16x16x32_bf16(Bt[n][k], At[m][k], acc[ai][bj][m][n], 0, 0, 0); __builtin_amdgcn_s_setprio(0); } while (0)
#define PG8_WAIT_V(n) asm volatile("s_waitcnt vmcnt(" #n ")" ::: "memory")
#define PG8_WAIT_L(n) asm volatile("s_waitcnt lgkmcnt(" #n ")" ::: "memory")
#define PG8_BAR __builtin_amdgcn_s_barrier()
#define PG8_SCHED __builtin_amdgcn_sched_barrier(0)
    Unit cur, nxt; int ui = 0;
    if (!S.next(0, cur)) return;
    f32x4 acc[2][2][4][2];
#pragma unroll
    for (int a = 0; a < 2; ++a)
#pragma unroll
        for (int b = 0; b < 2; ++b)
#pragma unroll
            for (int m = 0; m < 4; ++m)
#pragma unroll
                for (int n = 0; n < 2; ++n) acc[a][b][m][n] = (f32x4){0.f, 0.f, 0.f, 0.f};
    bf16x8 At[4][2], B0[2][2], B1[2][2];
    const char* cA = (const char*)g.A + (size_t)cur.pm * tstep; const char* cB = (const char*)g.Bt + (size_t)cur.pn * tstep;
    S.a_ready(cur);
    if constexpr (SP2) {
        PG8_STAGE(PG8_SB(0, 0), cB, voffB); PG8_STAGE(PG8_SB(0, 1), cB + hstep, voffB); PG8_STAGE(PG8_SA(0, 0), cA, voffA); PG8_STAGE(PG8_SA(0, 1), cA + hstep, voffA);
        if (wr == 1) PG8_BAR;
        PG8_WAIT_V(2); PG8_BAR;
        PG8_STAGE(PG8_SB(1, 0), cB + kstep, voffB); PG8_STAGE(PG8_SA(1, 0), cA + kstep, voffA); PG8_STAGE(PG8_SB(1, 1), cB + hstep + kstep, voffB);
        PG8_WAIT_V(6); PG8_BAR;
    } else {
        PG8_STAGE(PG8_SB(0, 0), cB, voffB); PG8_STAGE(PG8_SA(0, 0), cA, voffA); PG8_STAGE(PG8_SB(0, 1), cB + hstep, voffB); PG8_STAGE(PG8_SA(0, 1), cA + hstep, voffA);
        if (wr == 1) PG8_BAR;
        PG8_WAIT_V(4); PG8_BAR;
        PG8_STAGE(PG8_SB(1, 0), cB + kstep, voffB); PG8_STAGE(PG8_SA(1, 0), cA + kstep, voffA); PG8_STAGE(PG8_SB(1, 1), cB + hstep + kstep, voffB);
        PG8_WAIT_V(6); PG8_BAR;
    }
    for (;;) {
        const bool has_next = S.next(ui + 1, nxt);
        const char* nA = has_next ? (const char*)g.A + (size_t)nxt.pm * tstep : cA; const char* nB = has_next ? (const char*)g.Bt + (size_t)nxt.pn * tstep : cB;
        for (int t = 0; t < nt; t += 2) {
            const bool last = (t == nt - 2);
            const char* a1 = cA + (size_t)(t + 1) * kstep;
            const char* a2 = last ? nA : cA + (size_t)(t + 2) * kstep; const char* b2 = last ? nB : cB + (size_t)(t + 2) * kstep;
            const char* a3 = a2 + kstep; const char* b3 = b2 + kstep;
            if (last && has_next) S.a_ready(nxt);
            if constexpr (SP2) {
            PG8_LDB(B0, 0, 0); PG8_LDB(B1, 0, 1); PG8_SCHED; PG8_LDA(At, 0, 0); PG8_STAGE(PG8_SA(1, 1), a1 + hstep, voffA);
            PG8_WAIT_V(8); PG8_WAIT_L(0); PG8_BAR; PG8_MMA(0, 0, At, B0); PG8_MMA(0, 1, At, B1); PG8_BAR; PG8_SCHED;
            PG8_LDA(At, 0, 1); PG8_STAGE(PG8_SB(0, 0), b2, voffB); PG8_STAGE(PG8_SB(0, 1), b2 + hstep, voffB); PG8_STAGE(PG8_SA(0, 0), a2, voffA);
            PG8_WAIT_V(8); PG8_WAIT_L(0); PG8_BAR; PG8_MMA(1, 0, At, B0); PG8_MMA(1, 1, At, B1); PG8_BAR; PG8_SCHED;
            PG8_LDB(B0, 1, 0); PG8_LDB(B1, 1, 1); PG8_SCHED; PG8_LDA(At, 1, 0); PG8_STAGE(PG8_SA(0, 1), a2 + hstep, voffA);
            PG8_WAIT_V(8); PG8_WAIT_L(0); PG8_BAR; PG8_MMA(0, 0, At, B0); PG8_MMA(0, 1, At, B1); PG8_BAR; PG8_SCHED;
            PG8_LDA(At, 1, 1); PG8_STAGE(PG8_SB(1, 0), b3, voffB); PG8_STAGE(PG8_SB(1, 1), b3 + hstep, voffB); PG8_STAGE(PG8_SA(1, 0), a3, voffA);
            PG8_WAIT_V(8); PG8_WAIT_L(0); PG8_BAR; PG8_MMA(1, 0, At, B0); PG8_MMA(1, 1, At, B1); PG8_BAR; PG8_SCHED;
            } else {
            PG8_LDB(B0, 0, 0); PG8_SCHED; PG8_LDA(At, 0, 0); PG8_STAGE(PG8_SA(1, 1), a1 + hstep, voffA);
            PG8_WAIT_L(8); PG8_BAR; PG8_WAIT_L(0); PG8_MMA(0, 0, At, B0); PG8_BAR; PG8_SCHED;
            PG8_LDB(B1, 0, 1); PG8_STAGE(PG8_SB(0, 0), b2, voffB);
            PG8_BAR; PG8_WAIT_L(0); PG8_MMA(0, 1, At, B1); PG8_BAR;
            PG8_LDA(At, 0, 1); PG8_STAGE(PG8_SA(0, 0), a2, voffA);
            PG8_BAR; PG8_WAIT_L(0); PG8_MMA(1, 0, At, B0); PG8_BAR; PG8_SCHED;
            PG8_STAGE(PG8_SB(0, 1), b2 + hstep, voffB);
            PG8_WAIT_V(6); PG8_BAR; PG8_MMA(1, 1, At, B1); PG8_BAR;
            PG8_LDB(B0, 1, 0); PG8_SCHED; PG8_LDA(At, 1, 0); PG8_STAGE(PG8_SA(0, 1), a2 + hstep, voffA);
            PG8_WAIT_L(8); PG8_BAR; PG8_WAIT_L(0); PG8_MMA(0, 0, At, B0); PG8_BAR; PG8_SCHED;
            PG8_LDB(B1, 1, 1); PG8_STAGE(PG8_SB(1, 0), b3, voffB);
            PG8_BAR; PG8_WAIT_L(0); PG8_MMA(0, 1, At, B1); PG8_BAR;
            PG8_LDA(At, 1, 1); PG8_STAGE(PG8_SA(1, 0), a3, voffA);
            PG8_BAR; PG8_WAIT_L(0); PG8_MMA(1, 0, At, B0); PG8_BAR; PG8_SCHED;
            PG8_STAGE(PG8_SB(1, 1), b3 + hstep, voffB);
            PG8_WAIT_V(6); PG8_BAR; PG8_MMA(1, 1, At, B1); PG8_BAR;
            }
        }
        if constexpr (ALIGN_EPI) { if (wr == 0) PG8_BAR; }
        if constexpr (!Epi::AFTER_DRAIN) { E(acc, cur, wr, wc, fr, fq); S.done(cur); }
        if (!has_next) break;
#pragma unroll
        for (int a = 0; a < 2; ++a)
#pragma unroll
            for (int b = 0; b < 2; ++b)
#pragma unroll
                for (int m = 0; m < 4; ++m)
#pragma unroll
                    for (int n = 0; n < 2; ++n) acc[a][b][m][n] = (f32x4){0.f, 0.f, 0.f, 0.f};
        cur = nxt; cA = nA; cB = nB; ++ui;
        if constexpr (ALIGN_EPI) { if (wr == 1) PG8_BAR; }
    }
    PG8_WAIT_V(0);
    if constexpr (!ALIGN_EPI) { if (wr == 0) PG8_BAR; }
    PG8_BAR;
    if constexpr (Epi::AFTER_DRAIN) { E.fused(acc, cur, wr, wc, fr, fq, lds, wid, lane); S.done(cur); }
#undef PG8_SA
#undef PG8_SB
#undef PG8_STAGE
#undef PG8_LDA
#undef PG8_LDB
#undef PG8_MMA
#undef PG8_WAIT_V
#undef PG8_WAIT_L
#undef PG8_BAR
#undef PG8_SCHED
}
}

#ifndef MK_SINGLE
#define MK_SINGLE 1
#endif
constexpr int BATCH = 32, SEQ = 2048, DM = 1024, M = BATCH * SEQ;
constexpr int NIN = 3336, NPROJ = 3328;
constexpr int DFF = 2816, NUP = 2 * DFF;
constexpr int C_Q = 1792, C_K = 2048, C_V = 2304, C_O = 2816;
constexpr int NLORA = 1536, KLORA = 256;
constexpr int MH = M / 2;
constexpr float NORM_EPS = 1e-6f, LNX_EPS = 64e-5f;

constexpr size_t MiB = 1u << 20;
#ifdef PROBE
constexpr size_t WS_CTL = 0, CTL_ZERO_BYTES = 1 * MiB;
#else
constexpr size_t WS_CTL = 0, CTL_ZERO_BYTES = 32 * 1024;
#endif
constexpr size_t WS_WT_IN = 2 * MiB, WS_WT_OUT = 9 * MiB, WS_WT_UP = 11 * MiB, WS_WT_DN = 22 * MiB, WS_WT_LORA = 28 * MiB;
constexpr size_t WS_RS2 = 29 * MiB, WS_RINV = 29 * MiB + 512 * 1024, WS_SSQP = 30 * MiB, WS_GATES = 34 * MiB;
constexpr size_t WS_XN = 40 * MiB;
constexpr size_t WS_PROJ = 168 * MiB;
constexpr size_t WS_LBUF = 584 * MiB;
constexpr size_t WS_DAG = 616 * MiB;
constexpr size_t WS_MIX = 808 * MiB;
constexpr size_t WS_SIDE = 168 * MiB;
constexpr int SIDE_ELEMS = 256 * 22 * 2 * 128;
constexpr size_t WS_FF = 192 * MiB;
constexpr size_t WS_GB = 520 * MiB;
constexpr size_t WS_END = 936 * MiB;

constexpr int LDS_BYTES = 163840;
constexpr int MISC_OFF = LDS_BYTES - 256;

#define GAS __attribute__((address_space(1)))
#define LAS __attribute__((address_space(3)))
typedef unsigned short bf16;
typedef unsigned v4u __attribute__((ext_vector_type(4)));
typedef unsigned v2u __attribute__((ext_vector_type(2)));
typedef float f32x4 __attribute__((ext_vector_type(4)));
typedef float f32x2 __attribute__((ext_vector_type(2)));
typedef short bf16x8 __attribute__((ext_vector_type(8)));
typedef GAS unsigned gu32;

typedef __bf16 bf16x2_t __attribute__((ext_vector_type(2)));
__device__ __forceinline__ unsigned pk2(float lo, float hi) { const f32x2 v = {lo, hi}; const bf16x2_t b = __builtin_convertvector(v, bf16x2_t); return __builtin_bit_cast(unsigned, b); }
__device__ __forceinline__ unsigned f2bf(float f) { return pk2(f, f) & 0xffffu; }
__device__ __forceinline__ float bf2f(unsigned short u) { return __builtin_bit_cast(float, (unsigned)u << 16); }
__device__ __forceinline__ float bflo(unsigned w) { return __builtin_bit_cast(float, w << 16); }
__device__ __forceinline__ float bfhi(unsigned w) { return __builtin_bit_cast(float, w & 0xffff0000u); }
__device__ __forceinline__ void unpack8(const v4u w, float (&o)[8]) { o[0] = bflo(w.x); o[1] = bfhi(w.x); o[2] = bflo(w.y); o[3] = bfhi(w.y); o[4] = bflo(w.z); o[5] = bfhi(w.z); o[6] = bflo(w.w); o[7] = bfhi(w.w); }
__device__ __forceinline__ v4u pack8(const float (&o)[8]) { v4u w; w.x = pk2(o[0], o[1]); w.y = pk2(o[2], o[3]); w.z = pk2(o[4], o[5]); w.w = pk2(o[6], o[7]); return w; }
__device__ __forceinline__ float frcp(float x) { return __builtin_amdgcn_rcpf(x); }
__device__ __forceinline__ float frsq(float x) { return __builtin_amdgcn_rsqf(x); }
__device__ __forceinline__ float fsqrt_(float x) { return __builtin_amdgcn_sqrtf(x); }
__device__ __forceinline__ float fexp(float x) { return __builtin_amdgcn_exp2f(x * 1.4426950408889634f); }
__device__ __forceinline__ float sigmoidf_(float x) { return frcp(1.0f + __builtin_amdgcn_exp2f(x * -1.4426950408889634f)); }
__device__ __forceinline__ float tanhf_(float x) { return 1.0f - 2.0f * frcp(__builtin_amdgcn_exp2f(x * 2.8853900817779268f) + 1.0f); }
__device__ __forceinline__ float softplusf_(float x) { return fmaxf(x, 0.f) + __logf(1.0f + fexp(-fabsf(x))); }
__device__ __forceinline__ float wave_sum(float v) {
#pragma unroll
    for (int o = 1; o < 64; o <<= 1) v += __shfl_xor(v, o);
    return v;
}
template <int CTRL> __device__ __forceinline__ float dppmov(float v) { return __builtin_bit_cast(float, __builtin_amdgcn_update_dpp(0, __builtin_bit_cast(int, v), CTRL, 0xF, 0xF, true)); }
__device__ __forceinline__ float red8(float v) { v += dppmov<0xB1>(v); v += dppmov<0x4E>(v); v += dppmov<0x141>(v); return v; }
__device__ __forceinline__ float red16(float v) { v += dppmov<0xB1>(v); v += dppmov<0x4E>(v); v += dppmov<0x141>(v); v += dppmov<0x140>(v); return v; }

template <int CTRL, int RMASK> __device__ __forceinline__ float dppsh(float idv, float v) { return __builtin_bit_cast(float, __builtin_amdgcn_update_dpp(__builtin_bit_cast(int, idv), __builtin_bit_cast(int, v), CTRL, RMASK, 0xF, false)); }
template <int CTRL> __device__ __forceinline__ v4u dpp4(const v4u old, const v4u v) { v4u r;
    r.x = (unsigned)__builtin_amdgcn_update_dpp((int)old.x, (int)v.x, CTRL, 0xF, 0xF, false); r.y = (unsigned)__builtin_amdgcn_update_dpp((int)old.y, (int)v.y, CTRL, 0xF, 0xF, false);
    r.z = (unsigned)__builtin_amdgcn_update_dpp((int)old.z, (int)v.z, CTRL, 0xF, 0xF, false); r.w = (unsigned)__builtin_amdgcn_update_dpp((int)old.w, (int)v.w, CTRL, 0xF, 0xF, false); return r; }
__device__ __forceinline__ float wave_scan_add(float v) {
    v += dppsh<0x111, 0xF>(0.f, v); v += dppsh<0x112, 0xF>(0.f, v); v += dppsh<0x114, 0xF>(0.f, v); v += dppsh<0x118, 0xF>(0.f, v);
    v += dppsh<0x142, 0xA>(0.f, v); v += dppsh<0x143, 0xC>(0.f, v); return v;
}
__device__ __forceinline__ float wave_scan_max(float v) {
    const float ni = -3.0e38f;
    v = fmaxf(v, dppsh<0x111, 0xF>(ni, v)); v = fmaxf(v, dppsh<0x112, 0xF>(ni, v)); v = fmaxf(v, dppsh<0x114, 0xF>(ni, v)); v = fmaxf(v, dppsh<0x118, 0xF>(ni, v));
    v = fmaxf(v, dppsh<0x142, 0xA>(ni, v)); v = fmaxf(v, dppsh<0x143, 0xC>(ni, v)); return v;
}

#define XB_TMO      128
#define XB_XCNT(j)  (256  + 64 * (j))
#define XB_XSUB(j)  (1280 + 64 * (j))
#define XB_XGEN(j)  (2304 + 64 * (j))
#define XB_TOP      3328
#define XB_TOPGEN   3392
#define XCD_BAR_WORDS 3456
#define XB_SPIN_CAP (1u << 22)
__device__ __forceinline__ void mk_sync() { __builtin_amdgcn_fence(__ATOMIC_RELEASE, "workgroup"); __builtin_amdgcn_s_barrier(); __builtin_amdgcn_fence(__ATOMIC_ACQUIRE, "workgroup"); }
__device__ __forceinline__ unsigned xb_ld(unsigned* p)              { return __hip_atomic_load(p, __ATOMIC_RELAXED, __HIP_MEMORY_SCOPE_AGENT); }
__device__ __forceinline__ unsigned xb_add(unsigned* p, unsigned v) { return __hip_atomic_fetch_add(p, v, __ATOMIC_RELAXED, __HIP_MEMORY_SCOPE_AGENT); }
__device__ __forceinline__ unsigned xb_xcc_id() { return (unsigned)__builtin_amdgcn_s_getreg((3 << 11) | 20) & 0xFu; }
#define XB_SPIN(cond, bar) do { unsigned _sp = 0; while (cond) { __builtin_amdgcn_s_sleep(1); \
    if ((++_sp & 255u) == 0u) { if (xb_ld(&(bar)[XB_TMO])) break; if (_sp > XB_SPIN_CAP) { atomicAdd(&(bar)[XB_TMO], 1u); break; } } } } while (0)
struct XcdBarrier { unsigned* bar; unsigned x; volatile LAS unsigned* st; };
__device__ __forceinline__ XcdBarrier xcd_barrier_post(unsigned* bar, volatile LAS unsigned* st, bool leader) {
    XcdBarrier b; b.bar = bar; b.x = xb_xcc_id(); b.st = st;
    if (leader) (void)xb_add(&bar[XB_XCNT(b.x)], 1u);
    return b;
}
__device__ __forceinline__ void xcd_barrier_complete(unsigned* bar, unsigned x, unsigned& nloc, unsigned& nx) {
    const unsigned G = gridDim.x * gridDim.y * gridDim.z;
    unsigned sum, cnt, mine, sp = 0u;
    for (;;) {
        sum = 0u; cnt = 0u; mine = 0u;
#pragma unroll
        for (unsigned j = 0; j < 16; ++j) { const unsigned c = xb_ld(&bar[XB_XCNT(j)]); sum += c; cnt += (c > 0u) ? 1u : 0u; mine = (j == x) ? c : mine; }
        if (sum == G) break;
        __builtin_amdgcn_s_sleep(1);
        if ((++sp & 255u) == 0u) { if (xb_ld(&bar[XB_TMO])) break; if (sp > XB_SPIN_CAP) { atomicAdd(&bar[XB_TMO], 1u); break; } }
    }
    nloc = mine > 0u ? mine : 1u; nx = cnt > 0u ? cnt : 1u;
}
__device__ __forceinline__ void xcd_barrier(const XcdBarrier& b, bool leader) {
    asm volatile("s_waitcnt vmcnt(0)" ::: "memory");
    mk_sync();
    if (leader) {
        unsigned* bar = b.bar;
        __builtin_amdgcn_s_waitcnt(0);
        unsigned nloc = b.st[0], nx = b.st[1];
        if (nloc == 0u) { xcd_barrier_complete(bar, b.x, nloc, nx); b.st[0] = nloc; b.st[1] = nx; }
        const unsigned old = xb_add(&bar[XB_XSUB(b.x)], 1u);
        const unsigned gen = old / nloc;
        if (old + 1u == (gen + 1u) * nloc) {
            __builtin_amdgcn_fence(__ATOMIC_RELEASE, "agent");
            asm volatile("s_waitcnt vmcnt(0)" ::: "memory");
            const unsigned og = xb_add(&bar[XB_TOP], 1u);
            const unsigned tg = og / nx;
            if (og + 1u == (tg + 1u) * nx) xb_add(&bar[XB_TOPGEN], 1u);
            else XB_SPIN(xb_ld(&bar[XB_TOPGEN]) == tg, bar);
            __builtin_amdgcn_fence(__ATOMIC_ACQUIRE, "agent");
            xb_add(&bar[XB_XGEN(b.x)], 1u);
            asm volatile("s_waitcnt vmcnt(0)" ::: "memory");
        } else {
            XB_SPIN(xb_ld(&bar[XB_XGEN(b.x)]) == gen, bar);
            __builtin_amdgcn_fence(__ATOMIC_ACQUIRE, "agent");
            asm volatile("s_waitcnt vmcnt(0)" ::: "memory");
        }
    }
    mk_sync();
}

__device__ __forceinline__ int opaque_i(int v) { asm volatile("" : "+s"(v)); return v; }
#define LDS_BARRIER() do { asm volatile("s_waitcnt lgkmcnt(0)" ::: "memory"); __builtin_amdgcn_s_barrier(); asm volatile("" ::: "memory"); } while (0)
__device__ __forceinline__ int mk_lane_id() { int x; asm volatile("v_mbcnt_lo_u32_b32 %0, -1, 0\n\tv_mbcnt_hi_u32_b32 %0, -1, %0" : "=v"(x)); return x; }
struct Args { const float* in[26]; float* out; unsigned char* ws; int ph_lo, ph_hi; };

namespace pg8 {
struct PairPanelOrder {
    int c;
    __device__ bool next(int i, Unit& u) const { if (i >= 12) return false; u.pm = 2 * c + i / 6; u.pn = i % 6; return true; }
    __device__ __forceinline__ void a_ready(const Unit&) const {}
    __device__ __forceinline__ void done(const Unit&) const {}
};
struct PanelOrder {
    int c;
    __device__ bool next(int i, Unit& u) const { if (i >= 4) return false; u.pm = c; u.pn = i; return true; }
    __device__ __forceinline__ void a_ready(const Unit&) const {}
    __device__ __forceinline__ void done(const Unit&) const {}
};
struct EpiResid {
    static constexpr bool PERM = true, AFTER_DRAIN = false;
    bf16_t* XB; const float* rinv; float* ssqp;
    __device__ __forceinline__ void operator()(const f32x4 (&acc)[2][2][4][2], const Unit& u, int wr, int wc, int fr, int fq) const {
        const int row0 = u.pm * BM + wr * 64 + fr, col0 = u.pn * BM + wc * 32 + 8 * fq;
        const __amdgpu_buffer_rsrc_t xrr = wt_rsrc(XB);
#pragma unroll
        for (int ai = 0; ai < 2; ++ai) {
            u32x4 xin[4][2]; float ri[4];
#pragma unroll
            for (int m = 0; m < 4; ++m) { const int row = row0 + ai * HALF + m * 16; ri[m] = rinv[row];
#pragma unroll
                for (int bj = 0; bj < 2; ++bj) xin[m][bj] = *(const u32x4*)(XB + (size_t)row * DM + col0 + bj * HALF); }
            asm volatile("" ::: "memory");
#pragma unroll
            for (int m = 0; m < 4; ++m) { const int row = row0 + ai * HALF + m * 16; float ss = 0.f;
#pragma unroll
                for (int bj = 0; bj < 2; ++bj) { const size_t off = (size_t)row * DM + col0 + bj * HALF;
                    float xv[8]; unpack8(xin[m][bj], xv);
                    float v[8];
#pragma unroll
                    for (int j = 0; j < 4; ++j) { v[j] = acc[ai][bj][m][0][j] + xv[j] * ri[m]; v[4 + j] = acc[ai][bj][m][1][j] + xv[4 + j] * ri[m]; }
#pragma unroll
                    for (int j = 0; j < 8; ++j) ss += v[j] * v[j];
                    wt_store16(xrr, XB, off * 2, pack8(v)); }
                ss += __shfl_xor(ss, 16); ss += __shfl_xor(ss, 32);
                if (fq == 0) ssqp[(size_t)row * 16 + u.pn * 4 + wc] = ss; }
            asm volatile("" ::: "memory");
        }
    }
};
struct EpiScale {
    static constexpr bool PERM = true, AFTER_DRAIN = false;
    bf16_t* O; int ldc; const float* rs; int row_off;
    __device__ __forceinline__ void operator()(const f32x4 (&acc)[2][2][4][2], const Unit& u, int wr, int wc, int fr, int fq) const {
        const int row0 = u.pm * BM + wr * 64 + fr, col0 = u.pn * BM + wc * 32 + 8 * fq;
#pragma unroll
        for (int ai = 0; ai < 2; ++ai)
#pragma unroll
            for (int m = 0; m < 4; ++m) { const int row = row0 + ai * HALF + m * 16; const float s = rs[row_off + row]; bf16_t* rowp = O + (size_t)row * ldc + col0;
#pragma unroll
                for (int bj = 0; bj < 2; ++bj) { const f32x4 v0 = acc[ai][bj][m][0] * s, v1 = acc[ai][bj][m][1] * s;
                    u32x4 w; w.x = pk2(v0[0], v0[1]); w.y = pk2(v0[2], v0[3]); w.z = pk2(v1[0], v1[1]); w.w = pk2(v1[2], v1[3]); *(u32x4*)(rowp + bj * HALF) = w; } }
    }
};
struct EpiFfn {
    static constexpr bool PERM = true, AFTER_DRAIN = false;
    bf16_t* G; const float* rs; const float* cw; const float* cb; float* SA; float* SB; float* SL; LAS float* hal;
    __device__ __forceinline__ void operator()(const f32x4 (&acc)[2][2][4][2], const Unit& u, int wr, int wc, int fr, int fq) const {
        int chl = wc * 32 + 8 * fq; asm volatile("" : "+v"(chl));
        const int f0 = u.pn * 128 + chl, rowt = wr * 64 + fr;
        const __amdgpu_buffer_rsrc_t grr = wt_rsrc(G);
        float rsv[2][4];
#pragma unroll
        for (int ai = 0; ai < 2; ++ai)
#pragma unroll
            for (int m = 0; m < 4; ++m) rsv[ai][m] = rs[u.pm * BM + ai * HALF + m * 16 + rowt];
        const size_t sbase = ((size_t)(u.pm * 22 + u.pn) * 2) * 128 + chl;
        if (fr >= 14) {
#pragma unroll
            for (int ai = 0; ai < 2; ++ai) { const float r_ = rsv[ai][3]; const f32x4 v0 = acc[ai][0][3][0] * r_, v1 = acc[ai][0][3][1] * r_;
                LAS float* hp = hal + ((ai * 2 + wr) * 2 + (fr - 14)) * 128 + chl; *(LAS f32x4*)hp = v0; *(LAS f32x4*)(hp + 4) = v1;
                if (ai == 1 && wr == 1) { float* gp = SL + sbase + (fr - 14) * 128; *(f32x4*)gp = v0; *(f32x4*)(gp + 4) = v1; } }
        }
        if (wr == 0 && fr < 2) { const float r_ = rsv[0][0]; float* ga = SA + sbase + fr * 128; float* gb = SB + sbase + fr * 128;
            *(f32x4*)ga = acc[0][0][0][0] * r_; *(f32x4*)(ga + 4) = acc[0][0][0][1] * r_; *(f32x4*)gb = acc[0][1][0][0] * r_; *(f32x4*)(gb + 4) = acc[0][1][0][1] * r_; }
        asm volatile("s_waitcnt lgkmcnt(0)" ::: "memory"); __builtin_amdgcn_s_barrier(); asm volatile("" ::: "memory");
        float w0[8], w1[8], w2[8], bz[8];
        { const f32x4 a0 = *(const f32x4*)(cw + f0), a1 = *(const f32x4*)(cw + f0 + 4), b0 = *(const f32x4*)(cw + DFF + f0), b1 = *(const f32x4*)(cw + DFF + f0 + 4);
          const f32x4 c0 = *(const f32x4*)(cw + 2 * DFF + f0), c1 = *(const f32x4*)(cw + 2 * DFF + f0 + 4), d0 = *(const f32x4*)(cb + f0), d1 = *(const f32x4*)(cb + f0 + 4);
#pragma unroll
          for (int j = 0; j < 4; ++j) { w0[j] = a0[j]; w0[4 + j] = a1[j]; w1[j] = b0[j]; w1[4 + j] = b1[j]; w2[j] = c0[j]; w2[4 + j] = c1[j]; bz[j] = d0[j]; bz[4 + j] = d1[j]; } }
        const bool fr0 = (fr == 0), frl2 = (fr < 2); (void)fr0;
#pragma unroll
        for (int ai = 0; ai < 2; ++ai) {
            float ap[8];
            const int pb = ai * 2 + wr - 1;
#pragma unroll
            for (int m = 0; m < 4; ++m) {
                float av[8], bv[8], y1[8], y2[8];
                const float r_ = rsv[ai][m];
#pragma unroll
                for (int j = 0; j < 4; ++j) { av[j] = acc[ai][0][m][0][j] * r_; av[4 + j] = acc[ai][0][m][1][j] * r_; bv[j] = acc[ai][1][m][0][j] * r_; bv[4 + j] = acc[ai][1][m][1][j] * r_; }
                if (m == 0) {
                    if (pb >= 0) { const LAS float* h0 = hal + (pb * 2) * 128 + chl; const f32x4 h00 = *(const LAS f32x4*)h0, h01 = *(const LAS f32x4*)(h0 + 4), h10 = *(const LAS f32x4*)(h0 + 128), h11 = *(const LAS f32x4*)(h0 + 132);
#pragma unroll
                        for (int j = 0; j < 4; ++j) { y1[j] = h10[j]; y1[4 + j] = h11[j]; y2[j] = fr0 ? h00[j] : h10[j]; y2[4 + j] = fr0 ? h01[j] : h11[j]; } }
                    else {
#pragma unroll
                        for (int j = 0; j < 8; ++j) { y1[j] = 0.f; y2[j] = 0.f; } }
                } else {
#pragma unroll
                    for (int j = 0; j < 8; ++j) { y1[j] = dppmov<0x121>(ap[j]); y2[j] = dppmov<0x122>(ap[j]); }
                }
                float o[8];
#pragma unroll
                for (int j = 0; j < 8; ++j) { const float am1 = dppsh<0x111, 0xF>(y1[j], av[j]), am2 = dppsh<0x112, 0xF>(y2[j], av[j]);
                    const float z = bz[j] + w0[j] * am2 + w1[j] * am1 + w2[j] * av[j];
                    o[j] = z * sigmoidf_(z) * bv[j]; ap[j] = av[j]; }
                if (!(ai == 0 && m == 0 && wr == 0 && frl2)) wt_store16(grr, G, ((size_t)(u.pm * BM + ai * HALF + m * 16 + rowt) * DFF + f0) * 2, pack8(o));
            }
        }
    }
};
}

template <bool FFN_UP = false>
__device__ __forceinline__ void transpose_item(const float* W, int ldw, int K, bf16* WT, const float* kscale, LAS float* scr, int item, int nblk, int lane) {
    const int kb = item / nblk, nb = item % nblk, k0 = 64 * kb, n0 = 32 * nb;
    const int d0 = !FFN_UP ? n0 : (n0 < DFF ? ((n0 >> 7) * 256 + (n0 & 127)) : ((((n0 - DFF) >> 7) * 256) + 128 + ((n0 - DFF) & 127)));
#pragma unroll 8
    for (int i = 0; i < 32; ++i) { const int kk = 2 * i + (lane >> 5); const float s = kscale ? kscale[k0 + kk] : 1.0f; scr[kk * 33 + (lane & 31)] = W[(size_t)(k0 + kk) * ldw + n0 + (lane & 31)] * s; }
    asm volatile("s_waitcnt lgkmcnt(0)" ::: "memory");
    const int c = lane & 7;
#pragma unroll
    for (int j = 0; j < 4; ++j) { const int n = (lane >> 3) + 8 * j; const LAS float* s = scr + (8 * c) * 33 + n;
        v4u o; o.x = pk2(s[0 * 33], s[1 * 33]); o.y = pk2(s[2 * 33], s[3 * 33]); o.z = pk2(s[4 * 33], s[5 * 33]); o.w = pk2(s[6 * 33], s[7 * 33]);
        *(v4u*)(WT + (size_t)(d0 + n) * K + k0 + 8 * c) = o; }
    asm volatile("s_waitcnt lgkmcnt(0)" ::: "memory");
}

__device__ __forceinline__ float wave_red63(float v) {
    v += dppmov<0xB1>(v); v += dppmov<0x4E>(v); v += dppmov<0x141>(v); v += dppmov<0x140>(v);
    v += dppsh<0x142, 0xA>(0.f, v); v += dppsh<0x143, 0xC>(0.f, v); return v;
}
__device__ __forceinline__ float lane63(float v) { return __builtin_bit_cast(float, __builtin_amdgcn_readlane(__builtin_bit_cast(int, v), 63)); }
__device__ __forceinline__ void late_transposes(const Args& a, LAS unsigned char* lds, int lane, int wave, int gw, int NGW) {
    unsigned char* ws = a.ws; LAS float* scr = (LAS float*)(lds + wave * 16384);
    constexpr int I_UP = 16 * 176, I_DN = 44 * 32;
    for (int it = gw; it < I_UP + I_DN; it += NGW) {
        int r = it;
        if (r < I_UP) { transpose_item<true>(a.in[21], NUP, DM, (bf16*)(ws + WS_WT_UP), a.in[20], scr, r, 176, lane); continue; } r -= I_UP;
        transpose_item(a.in[24], DM, DFF, (bf16*)(ws + WS_WT_DN), nullptr, scr, r, 32, lane);
    }
}
__device__ __forceinline__ void phase_prep(const Args& a, LAS unsigned char* lds, int tid, int lane, int wave) {
    unsigned char* ws = a.ws;
    LAS float* scr = (LAS float*)(lds + wave * 16384);
    const int gw = blockIdx.x * 8 + wave, NGW = gridDim.x * 8;
    constexpr int I_IN = 16 * 104;
    constexpr int I_OUT0 = 16 * 32;
    for (int it = gw; it < I_IN + I_OUT0; it += NGW) {
        if (it < I_IN) transpose_item(a.in[2], NIN, DM, (bf16*)(ws + WS_WT_IN), a.in[1], scr, it, 104, lane);
        else transpose_item(a.in[19], DM, DM, (bf16*)(ws + WS_WT_OUT), nullptr, scr, it - I_IN, 32, lane);
    }
    {
        const float* wd = a.in[5]; const float* wa = a.in[7]; const float* wg = a.in[8]; bf16* WL = (bf16*)(ws + WS_WT_LORA);
        for (int idx = blockIdx.x * 512 + tid; idx < NLORA * KLORA; idx += gridDim.x * 512) {
            const int n = idx >> 8, k = idx & 255; float v = 0.f;
            if (n < 512) { if (k < 64) v = wd[k * 512 + n]; }
            else if (n < 1024) { if (k >= 64 && k < 128) v = wa[(k - 64) * 512 + (n - 512)]; }
            else { if (k >= 128) v = wg[(k - 128) * 512 + (n - 1024)]; }
            WL[idx] = (bf16)f2bf(v);
        }
    }
    {
        const float* x = a.in[0]; const float* g1 = a.in[1]; const float* w_in = a.in[2];
        bf16* XN = (bf16*)(ws + WS_XN); float* gates = (float*)(ws + WS_GATES); float* rinvp = (float*)(ws + WS_RINV);
        float wgt[16][8];
#pragma unroll
        for (int j = 0; j < 4; ++j)
#pragma unroll
            for (int e = 0; e < 4; ++e) { const int k = 4 * lane + 256 * j + e; const float g = g1[k];
                const f32x4 w0 = *(const f32x4*)(w_in + (size_t)k * NIN + 3328), w1 = *(const f32x4*)(w_in + (size_t)k * NIN + 3332);
                wgt[j * 4 + e][0] = w0[0] * g; wgt[j * 4 + e][1] = w0[1] * g; wgt[j * 4 + e][2] = w0[2] * g; wgt[j * 4 + e][3] = w0[3] * g;
                wgt[j * 4 + e][4] = w1[0] * g; wgt[j * 4 + e][5] = w1[1] * g; wgt[j * 4 + e][6] = w1[2] * g; wgt[j * 4 + e][7] = w1[3] * g; }
        f32x4 vn[4];
        { const f32x4* xr = (const f32x4*)(x + (size_t)gw * DM) + lane;
#pragma unroll
          for (int j = 0; j < 4; ++j) vn[j] = xr[64 * j]; }
        for (int row = gw; row < M; row += NGW) {
            f32x4 v[4];
#pragma unroll
            for (int j = 0; j < 4; ++j) v[j] = vn[j];
            { const int rn = (row + NGW < M) ? row + NGW : row; const f32x4* xr = (const f32x4*)(x + (size_t)rn * DM) + lane;
#pragma unroll
              for (int j = 0; j < 4; ++j) vn[j] = xr[64 * j]; }
            float ss = 0.f;
#pragma unroll
            for (int j = 0; j < 4; ++j) ss += (v[j][0] * v[j][0] + v[j][1] * v[j][1]) + (v[j][2] * v[j][2] + v[j][3] * v[j][3]);
            float gs[8];
#pragma unroll
            for (int jg = 0; jg < 8; ++jg) { float s_ = 0.f;
#pragma unroll
                for (int j = 0; j < 4; ++j)
#pragma unroll
                    for (int e = 0; e < 4; ++e) s_ += v[j][e] * wgt[j * 4 + e][jg];
                gs[jg] = s_; }
            ss = wave_red63(ss);
#pragma unroll
            for (int jg = 0; jg < 8; ++jg) gs[jg] = wave_red63(gs[jg]);
            const float ms = lane63(ss) * (1.0f / DM) + NORM_EPS; const float rs = frsq(ms);
            if (lane == 0) rinvp[row] = fsqrt_(ms);
            unsigned long long* o8 = (unsigned long long*)(XN + (size_t)row * DM) + lane;
#pragma unroll
            for (int j = 0; j < 4; ++j) o8[64 * j] = (unsigned long long)pk2(v[j][0] * rs, v[j][1] * rs) | ((unsigned long long)pk2(v[j][2] * rs, v[j][3] * rs) << 32);
            if (lane == 63) { f32x4* gp = (f32x4*)(gates + (size_t)row * 8); gp[0] = (f32x4){gs[0] * rs, gs[1] * rs, gs[2] * rs, gs[3] * rs}; gp[1] = (f32x4){gs[4] * rs, gs[5] * rs, gs[6] * rs, gs[7] * rs}; }
        }
    }
}

__device__ __forceinline__ void phase_lmat(const Args& a, int tid, int row_lo, int nrows) {
    unsigned char* ws = a.ws; const bf16* PROJ = (const bf16*)(ws + WS_PROJ); bf16* L = (bf16*)(ws + WS_LBUF); const float* mu = a.in[3];
    for (int it0 = tid; it0 < nrows * 32; it0 += 4 * 512) {
        v4u cur[4], prv[4];
#pragma unroll
        for (int u = 0; u < 4; ++u) { const int it = it0 + u * 512; const int row = row_lo + (it >> 5), c0 = 1536 + 8 * (it & 31);
            cur[u] = *(const v4u*)(PROJ + (size_t)row * NPROJ + c0);
            prv[u] = (v4u){0u, 0u, 0u, 0u}; if ((row & (SEQ - 1)) != 0) prv[u] = *(const v4u*)(PROJ + (size_t)(row - 1) * NPROJ + c0); }
#pragma unroll
        for (int u = 0; u < 4; ++u) { const int it = it0 + u * 512; const int row = row_lo + (it >> 5), grp = it & 31, c0 = 1536 + 8 * grp;
            const f32x4 m0 = *(const f32x4*)(mu + c0), m1 = *(const f32x4*)(mu + c0 + 4);
            float c[8], p[8], o[8]; unpack8(cur[u], c); unpack8(prv[u], p);
#pragma unroll
            for (int e = 0; e < 8; ++e) { const float mm = e < 4 ? m0[e & 3] : m1[e & 3]; const float xv = c[e] + (p[e] - c[e]) * mm;
                o[e] = grp < 8 ? tanhf_(xv) : (grp < 16 ? xv : sigmoidf_(xv)); }
            *(v4u*)(L + (size_t)row * KLORA + 8 * grp) = pack8(o); }
    }
}

constexpr int RK_SLOT = 64 * 64;
__device__ __forceinline__ int rk_off(int row, int col) { return row * 64 + ((((col >> 3) ^ row) & 7) << 3) + (col & 7); }
__device__ __forceinline__ f32x4 mfma16(const bf16x8 a, const bf16x8 b, const f32x4 c) { return __builtin_amdgcn_mfma_f32_16x16x32_bf16(a, b, c, 0, 0, 0); }
__device__ __forceinline__ void rk_frag(bf16x8 (&f)[2], const LAS bf16* base, int row0, int l15, int l4) { const LAS bf16* p = base + (row0 + l15) * 64; f[0] = *(const LAS bf16x8*)(p + ((l4 ^ (l15 & 7)) << 3)); f[1] = *(const LAS bf16x8*)(p + (((4 + l4) ^ (l15 & 7)) << 3)); }
struct RkF2 { bf16x8 f[2][2]; };
struct RkLane { int lo, so, l15, l4; };
__device__ __forceinline__ RkLane rk_lane(int lane) { asm volatile("" : "+v"(lane)); const int l15 = lane & 15, l4 = lane >> 4; RkLane r; r.l15 = l15; r.l4 = l4; r.lo = l15 * 64 + ((l4 ^ (l15 & 7)) << 3); r.so = l15 * 64 + ((((l4 >> 1) ^ (l15 & 7))) << 3) + 4 * (l4 & 1); return r; }
__device__ __forceinline__ RkF2 rk_ld2(const LAS bf16* base, int blk, const RkLane& L) { RkF2 r;
#pragma unroll
    for (int ti = 0; ti < 2; ++ti) { const int i0 = (32 * blk + 16 * ti) * 64 + L.lo; r.f[ti][0] = *(const LAS bf16x8*)(base + i0); r.f[ti][1] = *(const LAS bf16x8*)(base + (i0 ^ 32)); }
    return r; }
template <bool ACC> __device__ __forceinline__ void rk_mm2(f32x4 (&acc)[2][2], const RkF2& a, const RkF2& b) {
#pragma unroll
    for (int mi = 0; mi < 2; ++mi)
#pragma unroll
        for (int ni = 0; ni < 2; ++ni) { f32x4 c = ACC ? acc[mi][ni] : (f32x4){0.f, 0.f, 0.f, 0.f}; c = mfma16(a.f[mi][0], b.f[ni][0], c); acc[mi][ni] = mfma16(a.f[mi][1], b.f[ni][1], c); }
}
__device__ __forceinline__ void rk_store2(LAS bf16* dst, const f32x4 (&acc)[2][2], int mB, int nB, const RkLane& L) {
#pragma unroll
    for (int mi = 0; mi < 2; ++mi)
#pragma unroll
        for (int ni = 0; ni < 2; ++ni) { v2u w; w.x = pk2(acc[mi][ni][0], acc[mi][ni][1]); w.y = pk2(acc[mi][ni][2], acc[mi][ni][3]); *(LAS v2u*)(dst + (16 * (2 * nB + ni)) * 64 + (L.so ^ (16 * (2 * mB + mi)))) = w; }
}
template <int MODE> __device__ __forceinline__ void rk_mask2(f32x4 (&d)[2][2], int mB, int nB, int l15, int l4) {
#pragma unroll
    for (int mi = 0; mi < 2; ++mi)
#pragma unroll
        for (int ni = 0; ni < 2; ++ni) { const int mt = 2 * mB + mi, nt = 2 * nB + ni;
            const bool zero = MODE == 1 ? (mt < nt) : (mt > nt);
            if (zero) d[mi][ni] = (f32x4){0.f, 0.f, 0.f, 0.f};
            else if (mt == nt) {
#pragma unroll
                for (int r = 0; r < 4; ++r) { const int m_ = 4 * l4 + r; const bool keep = MODE == 0 ? (m_ < l15) : MODE == 1 ? (l15 < m_) : (m_ <= l15); d[mi][ni][r] = keep ? d[mi][ni][r] : 0.f; } } }
}
template <int DBG = 0> __device__ __forceinline__ void rwkv_unit_split(const Args& a, LAS unsigned char* lds, int unit, int tid, int lane, int wave) {
    unsigned char* ws = a.ws; const bf16* PROJ = (const bf16*)(ws + WS_PROJ); const bf16* DAG = (const bf16*)(ws + WS_DAG); bf16* MIX = (bf16*)(ws + WS_MIX);
    const int b = unit >> 3, h = unit & 7;
    LAS bf16* slot = (LAS bf16*)lds;
#define RK_S(k) (slot + (k) * RK_SLOT)
    LAS bf16* Ab = RK_S(0); LAS bf16* Bb = RK_S(1); LAS bf16* Kb = RK_S(2); LAS bf16* Rb = RK_S(3); LAS bf16* KhT = RK_S(4);
    LAS bf16* P0 = RK_S(7); LAS bf16* P0T = RK_S(8); LAS float* Yl = (LAS float*)RK_S(7);
    LAS bf16* Aak = RK_S(9); LAS bf16* Ut = RK_S(9); LAS bf16* Arb = RK_S(10); LAS bf16* Ark = RK_S(11); LAS bf16* TA = RK_S(12); LAS bf16* TB = RK_S(13); LAS bf16* Xt = RK_S(14); LAS bf16* Sb = RK_S(15);
    LAS float* g63 = (LAS float*)RK_S(18); LAS float* bon = g63 + 128; LAS float* ssP = bon + 128; LAS float* bnP = ssP + 256; LAS float* cst = bnP + 256;
    const int wq = wave & 3;
    { int t_ = tid; asm volatile("" : "+v"(t_));
      if (t_ < 64) { const int j = h * 64 + t_;
        cst[t_] = a.in[3][j]; cst[64 + t_] = a.in[3][512 + j]; cst[128 + t_] = a.in[3][1024 + j]; cst[192 + t_] = a.in[9][j]; cst[256 + t_] = a.in[10][j];
        cst[320 + t_] = a.in[11][j]; cst[384 + t_] = a.in[4][j]; cst[448 + t_] = a.in[6][j]; cst[512 + t_] = a.in[12][j]; cst[576 + t_] = a.in[13][j]; }
      for (int i = t_; i < RK_SLOT / 2; i += 512) ((LAS unsigned*)Sb)[i] = 0u; }
    if (wave < 4) {
        const int jw = 16 * wq;
        v4u g_rc[2], g_kc[2], g_vc[2], g_rp[2], g_kp[2], g_vp[2], g_ld[2], g_a[2];
#define RKS_LOAD(c_, PART) do { int ln_ = lane; asm volatile("" : "+v"(ln_)); const int t_ = b * SEQ + (c_) * 64 + ln_; const bf16* pr_ = PROJ + (size_t)t_ * NPROJ + h * 64 + jw; const bf16* dg_ = DAG + (size_t)t_ * NLORA + h * 64 + jw; \
        _Pragma("unroll") for (int hh = 0; hh < 2; ++hh) { \
            if ((PART) == 0) { g_rc[hh] = *(const v4u*)(pr_ + 8 * hh); g_kc[hh] = *(const v4u*)(pr_ + 512 + 8 * hh); } \
            if ((PART) == 1) { g_vc[hh] = *(const v4u*)(pr_ + 1024 + 8 * hh); g_ld[hh] = *(const v4u*)(dg_ + 8 * hh); } \
            if ((PART) == 2) { g_a[hh] = *(const v4u*)(dg_ + 512 + 8 * hh); \
                if ((c_) == 0 && ln_ == 0) g_rp[hh] = (v4u){0u, 0u, 0u, 0u}; else g_rp[hh] = *(const v4u*)(pr_ - NPROJ + 8 * hh); } \
            if ((PART) == 3) { if ((c_) == 0 && ln_ == 0) { g_kp[hh] = (v4u){0u, 0u, 0u, 0u}; g_vp[hh] = g_kp[hh]; } \
                else { g_kp[hh] = *(const v4u*)(pr_ - NPROJ + 512 + 8 * hh); g_vp[hh] = *(const v4u*)(pr_ - NPROJ + 1024 + 8 * hh); } } } } while (0)
        RKS_LOAD(0, 0); RKS_LOAD(0, 1); RKS_LOAD(0, 2); RKS_LOAD(0, 3);
        LDS_BARRIER();
#ifdef PROBE_SEG_A
        unsigned long long seg_acc = 0, seg_t0 = 0; bool seg_on = false;
#define SEGT(k) do { if ((k) == PROBE_SEG_B && seg_on) { seg_acc += __builtin_amdgcn_s_memrealtime() - seg_t0; seg_on = false; } if ((k) == PROBE_SEG_A) { seg_t0 = __builtin_amdgcn_s_memrealtime(); seg_on = true; } } while (0)
#else
#define SEGT(k) do { } while (0)
#endif
        for (int it = 0; it <= SEQ / 64; ++it) {
            const bool act = DBG != 1 && it < SEQ / 64; const int p = it & 1;
            LAS bf16* BhTp = RK_S(5 + 11 * p); LAS bf16* Vtp = RK_S(6 + 11 * p);
            float rr[2][8], km[2][8], av[2][8], lgw[2][8], kkr[2][8];
            v4u pA[2], pR[2], pB[2], pK[2], pKh[2];
            LDS_BARRIER();
            SEGT(10); SEGT(0);
            if (act) {
                int ln = lane; asm volatile("" : "+v"(ln));
                asm volatile("" : "+v"(g_rc[0]), "+v"(g_rc[1]), "+v"(g_kc[0]), "+v"(g_kc[1]), "+v"(g_vc[0]), "+v"(g_vc[1]), "+v"(g_rp[0]), "+v"(g_rp[1]), "+v"(g_kp[0]), "+v"(g_kp[1]), "+v"(g_vp[0]), "+v"(g_vp[1]), "+v"(g_ld[0]), "+v"(g_ld[1]), "+v"(g_a[0]), "+v"(g_a[1]));
                float ss = 0.f, bonus = 0.f;
#pragma unroll
                for (int hh = 0; hh < 2; ++hh) { float rc[8], kc[8], vc[8], rp_[8], kp[8], vp[8], ldv[8];
                    unpack8(g_rc[hh], rc); unpack8(g_kc[hh], kc); unpack8(g_vc[hh], vc); unpack8(g_rp[hh], rp_); unpack8(g_kp[hh], kp); unpack8(g_vp[hh], vp); unpack8(g_ld[hh], ldv); unpack8(g_a[hh], av[hh]);
#pragma unroll
                    for (int e = 0; e < 8; ++e) { const int j = jw + 8 * hh + e;
                        rr[hh][e] = rc[e] + (rp_[e] - rc[e]) * cst[j]; const float k = kc[e] + (kp[e] - kc[e]) * cst[64 + j]; const float v = vc[e] + (vp[e] - vc[e]) * cst[128 + j];
                        kkr[hh][e] = k * cst[192 + j]; ss += kkr[hh][e] * kkr[hh][e];
                        av[hh][e] = sigmoidf_(cst[448 + j] + av[hh][e]);
                        lgw[hh][e] = -0.6065306597f * sigmoidf_(cst[384 + j] + ldv[e]);
                        km[hh][e] = k * (1.0f + (av[hh][e] - 1.0f) * cst[256 + j]);
                        bonus += rr[hh][e] * km[hh][e] * cst[320 + j];
                        Vtp[rk_off(j, ln)] = (bf16)f2bf(v); } }
                ssP[ln * 4 + wq] = ss; bnP[ln * 4 + wq] = bonus;
            }
            LDS_BARRIER();
            SEGT(1);
            if (act) {
                int ln = lane; asm volatile("" : "+v"(ln));
                const f32x4 s4 = *(const LAS f32x4*)(ssP + ln * 4), b4 = *(const LAS f32x4*)(bnP + ln * 4);
                const float ss = (s4[0] + s4[1]) + (s4[2] + s4[3]);
                if (wq == 0) bon[64 * p + ln] = (b4[0] + b4[1]) + (b4[2] + b4[3]);
                const float inv = frcp(fmaxf(fsqrt_(ss), 1e-12f));
#pragma unroll
                for (int hh = 0; hh < 2; ++hh) { float lw[8], oA[8], oB[8], oK[8], oR[8], oBh[8], oKh[8], e63[8];
#pragma unroll
                    for (int e = 0; e < 8; ++e) lw[e] = wave_scan_add(lgw[hh][e]);
#pragma unroll
                    for (int e = 0; e < 8; ++e) { const float l63 = __builtin_bit_cast(float, __builtin_amdgcn_readlane(__builtin_bit_cast(int, lw[e]), 63));
                        const float eP = fexp(lw[e] - lgw[hh][e]), eM = fexp(-lw[e]), eL = fexp(lw[e]); e63[e] = fexp(l63); const float eH = e63[e] * eM;
                        const float kk = kkr[hh][e] * inv, bb = kk * av[hh][e];
                        oA[e] = -kk * eP; oB[e] = bb * eM; oK[e] = km[hh][e] * eM; oR[e] = rr[hh][e] * eL; oBh[e] = bb * eH; oKh[e] = km[hh][e] * eH; }
                    pA[hh] = pack8(oA); pB[hh] = pack8(oB); pK[hh] = pack8(oK); pR[hh] = pack8(oR); pKh[hh] = pack8(oKh);
#pragma unroll
                    for (int e = 0; e < 8; ++e) BhTp[rk_off(jw + 8 * hh + e, ln)] = (bf16)f2bf(oBh[e]);
                    if (ln == 63) { LAS float* gp = g63 + 64 * p + jw + 8 * hh; *(LAS f32x4*)gp = (f32x4){e63[0], e63[1], e63[2], e63[3]}; *(LAS f32x4*)(gp + 4) = (f32x4){e63[4], e63[5], e63[6], e63[7]}; } }
            }
            LDS_BARRIER();
            SEGT(2);
            if (act) {
                if (it + 1 < SEQ / 64) RKS_LOAD(it + 1, 0);
                int ln = lane; asm volatile("" : "+v"(ln));
#pragma unroll
                for (int hh = 0; hh < 2; ++hh) { const int ro = rk_off(ln, jw + 8 * hh); *(LAS v4u*)(Ab + ro) = pA[hh]; *(LAS v4u*)(Rb + ro) = pR[hh];
                    const unsigned w_[4] = {pKh[hh].x, pKh[hh].y, pKh[hh].z, pKh[hh].w};
#pragma unroll
                    for (int e = 0; e < 4; ++e) { KhT[rk_off(jw + 8 * hh + 2 * e, ln)] = (bf16)(w_[e] & 0xffffu); KhT[rk_off(jw + 8 * hh + 2 * e + 1, ln)] = (bf16)(w_[e] >> 16); } }
            }
            LDS_BARRIER(); SEGT(3); if (act && it + 1 < SEQ / 64) RKS_LOAD(it + 1, 1);
            LDS_BARRIER(); SEGT(4); if (act && it + 1 < SEQ / 64) RKS_LOAD(it + 1, 2);
            LDS_BARRIER(); SEGT(5); if (act && it + 1 < SEQ / 64) RKS_LOAD(it + 1, 3);
            LDS_BARRIER(); SEGT(6); LDS_BARRIER(); SEGT(7); LDS_BARRIER(); SEGT(8);
            if (act) {
                int ln = lane; asm volatile("" : "+v"(ln));
#pragma unroll
                for (int hh = 0; hh < 2; ++hh) { const int ro = rk_off(ln, jw + 8 * hh); *(LAS v4u*)(Bb + ro) = pB[hh]; *(LAS v4u*)(Kb + ro) = pK[hh]; }
            }
            LDS_BARRIER();
            SEGT(9);
        }
#ifdef PROBE_SEG_A
        if (DBG == 0 && blockIdx.x == 0 && tid == 0) ((unsigned long long*)(ws + WS_CTL + 512 * 1024))[24] = seg_acc;
#endif
#undef RKS_LOAD
    } else {
        const int mB = wq & 1, nB = wq >> 1;
        const int ltid = tid - 256;
        f32x4 sacc[2][2], tacc[2][2], yacc[2][2];
#pragma unroll
        for (int i = 0; i < 2; ++i)
#pragma unroll
            for (int j = 0; j < 2; ++j) { sacc[i][j] = (f32x4){0.f, 0.f, 0.f, 0.f}; tacc[i][j] = sacc[i][j]; yacc[i][j] = sacc[i][j]; }
        v4u g_g0 = {0u, 0u, 0u, 0u}, g_g1 = g_g0, pend0 = g_g0, pend1 = g_g0; bf16* pend_p = DBG ? (bf16*)(ws + WS_END) : MIX;
#define RKV_LOADG(c_) do { int lt_ = ltid; asm volatile("" : "+v"(lt_)); const bf16* gp_ = DAG + (size_t)(b * SEQ + (c_) * 64 + (lt_ >> 2)) * NLORA + 1024 + h * 64 + 16 * (lt_ & 3); g_g0 = *(const v4u*)gp_; g_g1 = *(const v4u*)(gp_ + 8); } while (0)
        LDS_BARRIER();
        for (int it = 0; it <= SEQ / 64; ++it) {
            const int ch = it - 1; const bool act = DBG != 2 && it >= 1; const int p = ch & 1;
            const LAS bf16* BhTp = RK_S(5 + 11 * p); const LAS bf16* Vtp = RK_S(6 + 11 * p);
            LDS_BARRIER();
            if (act) {
                const RkLane L = rk_lane(lane);
                if (ch > 0) { *(v4u*)pend_p = pend0; *(v4u*)(pend_p + 8) = pend1; }
                RKV_LOADG(ch);
                const RkF2 aB = rk_ld2(Bb, mB, L), bA = rk_ld2(Ab, nB, L);
                {
                    const RkF2 aA = rk_ld2(Ab, mB, L), bB = rk_ld2(Bb, nB, L);
                    f32x4 d[2][2], d2[2][2];
                    rk_mm2<false>(d, aB, bA); rk_mm2<false>(d2, aA, bB);
                    rk_mask2<0>(d, mB, nB, L.l15, L.l4);
#pragma unroll
                    for (int mi = 0; mi < 2; ++mi)
#pragma unroll
                        for (int ni = 0; ni < 2; ++ni)
#pragma unroll
                            for (int r = 0; r < 4; ++r) tacc[mi][ni][r] = d[mi][ni][r] + ((2 * mB + mi == 2 * nB + ni && 4 * L.l4 + r == L.l15) ? 1.f : 0.f);
                    rk_mask2<1>(d2, mB, nB, L.l15, L.l4);
                    rk_store2(P0, d, mB, nB, L); rk_store2(TA, tacc, mB, nB, L); rk_store2(P0T, d2, mB, nB, L);
                }
                asm volatile("" ::: "memory");
                {
                    const RkF2 aK = rk_ld2(Kb, mB, L), bR = rk_ld2(Rb, nB, L);
                    f32x4 d3[2][2], d4[2][2], d5[2][2];
                    rk_mm2<false>(d3, aK, bA); rk_mm2<false>(d4, aB, bR); rk_mm2<false>(d5, aK, bR);
                    rk_mask2<0>(d3, mB, nB, L.l15, L.l4); rk_mask2<2>(d4, mB, nB, L.l15, L.l4); rk_mask2<2>(d5, mB, nB, L.l15, L.l4);
                    rk_store2(Aak, d3, mB, nB, L); rk_store2(Arb, d4, mB, nB, L); rk_store2(Ark, d5, mB, nB, L);
                }
            }
            LDS_BARRIER();
            if (act) {
                const RkLane L = rk_lane(lane);
                {
                    const RkF2 aPT = rk_ld2(P0T, mB, L), aP = rk_ld2(P0, mB, L), bP = rk_ld2(P0, nB, L), bPT = rk_ld2(P0T, nB, L);
                    f32x4 d[2][2], d2[2][2]; rk_mm2<false>(d, aPT, bP); rk_mm2<false>(d2, aP, bPT);
                    rk_store2(Bb  , d, mB, nB, L); rk_store2(Kb  , d2, mB, nB, L);
                }
                asm volatile("" ::: "memory");
                const RkF2 bV = rk_ld2(Vtp, nB, L);
                {
                    const RkF2 aA = rk_ld2(Ab, mB, L), aAk = rk_ld2(Aak, mB, L), bS = rk_ld2(Sb, nB, L), aKh = rk_ld2(KhT, mB, L);
                    f32x4 d3[2][2]; rk_mm2<false>(d3, aA, bS); rk_mm2<true>(d3, aAk, bV);
#pragma unroll
                    for (int mi = 0; mi < 2; ++mi)
#pragma unroll
                        for (int r = 0; r < 4; ++r) { const float g_ = g63[64 * p + 16 * (2 * mB + mi) + 4 * L.l4 + r]; sacc[mi][0][r] *= g_; sacc[mi][1][r] *= g_; }
                    rk_mm2<true>(sacc, aKh, bV);
                    rk_store2(Xt, d3, mB, nB, L);
                }
                asm volatile("" ::: "memory");
                {
                    const RkF2 aS = rk_ld2(Sb, mB, L), aV = rk_ld2(Vtp, mB, L), bR = rk_ld2(Rb, nB, L), bArk = rk_ld2(Ark, nB, L);
                    rk_mm2<false>(yacc, aS, bR); rk_mm2<true>(yacc, aV, bArk);
                }
            }
            LDS_BARRIER();
#define RKV_DOUBLE(PK, PKT, TIN, TOUT, PN, PNT) if (act && DBG != 4) { const RkLane L = rk_lane(lane); const RkF2 aPT = rk_ld2(PKT, mB, L), aP = rk_ld2(PK, mB, L); \
              const RkF2 bT = rk_ld2(TIN, nB, L), bP = rk_ld2(PK, nB, L), bPT = rk_ld2(PKT, nB, L); \
              f32x4 d[2][2], d2[2][2]; rk_mm2<true>(tacc, aPT, bT); rk_mm2<false>(d, aPT, bP); rk_mm2<false>(d2, aP, bPT); \
              rk_store2(TOUT, tacc, mB, nB, L); rk_store2(PN, d, mB, nB, L); rk_store2(PNT, d2, mB, nB, L); }
            RKV_DOUBLE(Bb, Kb, TA, TB, P0, P0T)
            LDS_BARRIER();
            RKV_DOUBLE(P0, P0T, TB, TA, Bb, Kb)
            LDS_BARRIER();
            RKV_DOUBLE(Bb, Kb, TA, TB, P0, P0T)
            LDS_BARRIER();
            if (act && DBG != 4) { const RkLane L = rk_lane(lane); const RkF2 aPT = rk_ld2(P0T, mB, L), aP = rk_ld2(P0, mB, L); const RkF2 bT = rk_ld2(TB, nB, L), bPT = rk_ld2(P0T, nB, L);
                f32x4 d2[2][2]; rk_mm2<true>(tacc, aPT, bT); rk_mm2<false>(d2, aP, bPT); rk_store2(TA, tacc, mB, nB, L); rk_store2(Kb  , d2, mB, nB, L); }
            LDS_BARRIER();
            if (act && DBG != 4) { const RkLane L = rk_lane(lane); const RkF2 aPT = rk_ld2(Kb, mB, L); const RkF2 bT = rk_ld2(TA, nB, L); rk_mm2<true>(tacc, aPT, bT); rk_store2(TB, tacc, mB, nB, L); }
            LDS_BARRIER();
            if (act) { const RkLane L = rk_lane(lane); const RkF2 aT = rk_ld2(TB, mB, L); const RkF2 bX = rk_ld2(Xt, nB, L); f32x4 d[2][2]; rk_mm2<false>(d, aT, bX); rk_store2(Ut, d, mB, nB, L); }
            LDS_BARRIER();
            if (act) {
                const RkLane L = rk_lane(lane);
                const RkF2 aU = rk_ld2(Ut, mB, L), aBh = rk_ld2(BhTp, mB, L); const RkF2 bArb = rk_ld2(Arb, nB, L), bU = rk_ld2(Ut, nB, L);
                rk_mm2<true>(yacc, aU, bArb); rk_mm2<true>(sacc, aBh, bU);
#pragma unroll
                for (int mi = 0; mi < 2; ++mi)
#pragma unroll
                    for (int ni = 0; ni < 2; ++ni) *(LAS f32x4*)(Yl + (16 * (2 * nB + ni) + L.l15) * 64 + (((4 * (2 * mB + mi) + L.l4) ^ (L.l15 & 7)) << 2)) = yacc[mi][ni];
                rk_store2(Sb, sacc, mB, nB, L);
            }
            LDS_BARRIER();
            if (act) {
                int lt_ = ltid; asm volatile("" : "+v"(lt_)); const int tt = lt_ >> 2, c4 = lt_ & 3;
                const int t = b * SEQ + ch * 64 + tt, j0 = 16 * c4;
                float y[16], gv[16]; float s1 = 0.f;
#pragma unroll
                for (int k = 0; k < 4; ++k) { const f32x4 yv = *(const LAS f32x4*)(Yl + tt * 64 + (((4 * c4 + k) ^ (tt & 7)) << 2)); y[4 * k] = yv[0]; y[4 * k + 1] = yv[1]; y[4 * k + 2] = yv[2]; y[4 * k + 3] = yv[3]; s1 += (yv[0] + yv[1]) + (yv[2] + yv[3]); }
                s1 += dppmov<0xB1>(s1); s1 += dppmov<0x4E>(s1); const float mean = s1 * (1.0f / 64.0f); float s2 = 0.f;
#pragma unroll
                for (int e = 0; e < 16; ++e) { const float dd = y[e] - mean; s2 += dd * dd; }
                s2 += dppmov<0xB1>(s2); s2 += dppmov<0x4E>(s2); const float rstd = frsq(s2 * (1.0f / 64.0f) + LNX_EPS);
                { float g0[8], g1[8]; unpack8(g_g0, g0); unpack8(g_g1, g1);
#pragma unroll
                  for (int e = 0; e < 8; ++e) { gv[e] = g0[e]; gv[8 + e] = g1[e]; } }
                const float bonus = bon[64 * p + tt]; float ov[16];
#pragma unroll
                for (int e = 0; e < 16; ++e) { const float yn = (y[e] - mean) * rstd * cst[512 + j0 + e] + cst[576 + j0 + e]; ov[e] = (yn + bonus * bf2f(Vtp[rk_off(j0 + e, tt)])) * gv[e]; }
                { float o0[8], o1[8];
#pragma unroll
                  for (int e = 0; e < 8; ++e) { o0[e] = ov[e]; o1[e] = ov[8 + e]; }
                  pend0 = pack8(o0); pend1 = pack8(o1); pend_p = DBG ? (bf16*)(ws + WS_END) + ((size_t)blockIdx.x * 256 + lt_) * 16 : MIX + (size_t)t * DM + h * 64 + j0; }
            }
        }
        *(v4u*)pend_p = pend0; *(v4u*)(pend_p + 8) = pend1;
#undef RKV_DOUBLE
#undef RKV_LOADG
    }
    LDS_BARRIER();
#undef RK_S
}

template <int DBG = 0> __device__ __forceinline__ void mlstm_unit_split(const Args& a, LAS unsigned char* lds, int unit, int tid, int lane, int wave) {
    unsigned char* ws = a.ws; const bf16* PROJ = (const bf16*)(ws + WS_PROJ); const float* gates = (const float*)(ws + WS_GATES); bf16* MIX = (bf16*)(ws + WS_MIX);
    const int b = unit >> 2, hm = unit & 3;
    constexpr int LD = 72, A64 = 64 * LD, A128 = 128 * LD;
    LAS bf16* Qb = (LAS bf16*)lds;
    LAS bf16* Kb_ = Qb + 2 * A64;
    LAS bf16* Kwb = Kb_ + 2 * A64;
    LAS bf16* Vtb = Kwb + 2 * A64;
    LAS bf16* Sm = Vtb + 2 * A128;
    LAS bf16* Ct = Sm + A64;
    LAS float* Hl = (LAS float*)(Ct + A128);
    LAS float* gar = Hl + 64 * 132;
    LAS float* decp = gar + 512; LAS float* den = decp + 4; LAS float* nvec = den + 64; LAS float* cwl = nvec + 64; LAS float* cbl = cwl + 512; LAS float* mhl = cbl + 128;
    { int t_ = tid; asm volatile("" : "+v"(t_));
      for (int i = t_; i < A128 / 2; i += 512) ((LAS unsigned*)Ct)[i] = 0u;
      if (t_ < 64) nvec[t_] = 0.f;
      if (t_ < 128) mhl[t_] = a.in[18][hm * 128 + t_];
      for (int i = t_; i < 640; i += 512) { const int j = i >> 7, c_ = i & 127; const int src = (c_ < 64) ? (hm * 64 + c_) : (256 + hm * 64 + (c_ - 64)); if (j < 4) cwl[i] = a.in[14][j * 512 + src]; else cbl[c_] = a.in[15][src]; } }
    const int wq = wave & 3;
    if (wave < 4) {
        const float ibias = a.in[16][hm], fbias = a.in[17][hm];
        v4u n_q[2], n_k[2], n_v[4]; float n_gi = 0.f, n_gf = 0.f;
        v4u p_q[2] = {{0u, 0u, 0u, 0u}, {0u, 0u, 0u, 0u}}, p_k[2] = {{0u, 0u, 0u, 0u}, {0u, 0u, 0u, 0u}};
#define MLS_LOAD(c_, PART) do { int ln_ = lane; asm volatile("" : "+v"(ln_)); const int t_ = b * SEQ + (c_) * 64 + ln_; \
        if ((PART) < 2) { const bf16* pr_ = PROJ + (size_t)t_ * NPROJ + hm * 64 + 16 * wq + 8 * (PART); n_q[PART] = *(const v4u*)(pr_ + C_Q); n_k[PART] = *(const v4u*)(pr_ + C_K); } \
        else { const bf16* pv_ = PROJ + (size_t)t_ * NPROJ + C_V + hm * 128 + 32 * wq; _Pragma("unroll") for (int q = 0; q < 4; ++q) n_v[q] = *(const v4u*)(pv_ + 8 * q); \
               n_gi = gates[(size_t)t_ * 8 + hm]; n_gf = gates[(size_t)t_ * 8 + 4 + hm]; } } while (0)
        MLS_LOAD(0, 0); MLS_LOAD(0, 1); MLS_LOAD(0, 2);
        LDS_BARRIER();
        float m_run = 0.f;
#ifdef PROBE_MSEG_A
        unsigned long long mseg_acc = 0, mseg_t0 = 0; bool mseg_on = false;
#define MSEGT(k) do { if ((k) == PROBE_MSEG_B && mseg_on) { mseg_acc += __builtin_amdgcn_s_memrealtime() - mseg_t0; mseg_on = false; } if ((k) == PROBE_MSEG_A) { mseg_t0 = __builtin_amdgcn_s_memrealtime(); mseg_on = true; } } while (0)
#else
#define MSEGT(k) do { } while (0)
#endif
        for (int it = 0; it <= SEQ / 64; ++it) {
            const bool act = DBG != 1 && it < SEQ / 64; const int p = it & 1;
            LAS bf16* Ql = Qb + p * A64; LAS bf16* Kl = Kb_ + p * A64; LAS bf16* Kwt = Kwb + p * A64; LAS bf16* Vt = Vtb + p * A128; LAS float* ga = gar + 256 * p;
            float w = 0.f;
            LDS_BARRIER();
            MSEGT(4); MSEGT(0);
            if (act) {
                asm volatile("" : "+v"(n_q[0]), "+v"(n_k[0]), "+v"(n_gi), "+v"(n_gf));
                int ln = lane; asm volatile("" : "+v"(ln));
                const float gi = n_gi + ibias, gf = n_gf + fbias;
                const float ig = 15.0f * tanhf_(gi * (1.0f / 15.0f)), fx = 15.0f * tanhf_(gf * (1.0f / 15.0f));
                const float logf = -(fmaxf(-fx, 0.f) + __logf(1.0f + fexp(-fabsf(fx))));
                const float bc = wave_scan_add(logf);
                const float e = ig - bc; const float P = wave_scan_max(e);
                const float mx = fmaxf(P, m_run);
                const float mxL = __builtin_bit_cast(float, __builtin_amdgcn_readlane(__builtin_bit_cast(int, mx), 63)), bL = __builtin_bit_cast(float, __builtin_amdgcn_readlane(__builtin_bit_cast(int, bc), 63));
                if (wq == 0) { ga[ln] = e; ga[64 + ln] = mx; ga[128 + ln] = fexp(m_run - mx); ga[192 + ln] = fexp(-(bc + mx)); if (ln == 0) decp[p] = fexp(m_run - mxL); }
                w = fexp(e - mxL); m_run = bL + mxL;
            }
#define MLS_QK(hh) { int ln = lane; asm volatile("" : "+v"(ln)); const int d0 = 16 * wq + 8 * (hh); float aq[8], ak[8]; \
                v4u tq[4], tk[4]; tq[3] = n_q[hh]; tk[3] = n_k[hh]; { v4u oq = p_q[hh], ok = p_k[hh]; \
                  _Pragma("unroll") for (int s_ = 1; s_ < 4; ++s_) { oq = dpp4<0x13C>(oq, oq); ok = dpp4<0x13C>(ok, ok); tq[3 - s_] = dpp4<0x138>(oq, tq[4 - s_]); tk[3 - s_] = dpp4<0x138>(ok, tk[4 - s_]); } } \
                p_q[hh] = n_q[hh]; p_k[hh] = n_k[hh]; \
                _Pragma("unroll") for (int e_ = 0; e_ < 8; ++e_) { aq[e_] = cbl[d0 + e_]; ak[e_] = cbl[64 + d0 + e_]; } \
                _Pragma("unroll") for (int j = 0; j < 4; ++j) { float pq[8], pk[8]; unpack8(tq[j], pq); unpack8(tk[j], pk); \
                    _Pragma("unroll") for (int e_ = 0; e_ < 8; ++e_) { aq[e_] += cwl[j * 128 + d0 + e_] * pq[e_]; ak[e_] += cwl[j * 128 + 64 + d0 + e_] * pk[e_]; } } \
                _Pragma("unroll") for (int e_ = 0; e_ < 8; ++e_) { aq[e_] = aq[e_] * sigmoidf_(aq[e_]) * 0.125f; ak[e_] = ak[e_] * sigmoidf_(ak[e_]); } \
                *(LAS v4u*)(Ql + ln * LD + d0) = pack8(aq); *(LAS v4u*)(Kl + ln * LD + d0) = pack8(ak); \
                _Pragma("unroll") for (int e_ = 0; e_ < 8; ++e_) Kwt[(d0 + e_) * LD + ln] = (bf16)f2bf(w * ak[e_]); }
            if (act) { MLS_QK(0) if (it + 1 < SEQ / 64) MLS_LOAD(it + 1, 0); }
            LDS_BARRIER();
            MSEGT(1);
            if (act) {
                asm volatile("" : "+v"(n_q[1]), "+v"(n_k[1]));
                MLS_QK(1)
                if (it + 1 < SEQ / 64) MLS_LOAD(it + 1, 1);
            }
            LDS_BARRIER();
            MSEGT(2);
            if (act) {
                asm volatile("" : "+v"(n_v[0]), "+v"(n_v[1]), "+v"(n_v[2]), "+v"(n_v[3]));
                int ln = lane; asm volatile("" : "+v"(ln));
#pragma unroll
                for (int q = 0; q < 4; ++q) { const unsigned wv[4] = {n_v[q].x, n_v[q].y, n_v[q].z, n_v[q].w};
#pragma unroll
                    for (int e_ = 0; e_ < 4; ++e_) { Vt[(32 * wq + 8 * q + 2 * e_) * LD + ln] = (bf16)(wv[e_] & 0xffffu); Vt[(32 * wq + 8 * q + 2 * e_ + 1) * LD + ln] = (bf16)(wv[e_] >> 16); } }
                if (it + 1 < SEQ / 64) MLS_LOAD(it + 1, 2);
            }
            LDS_BARRIER();
            MSEGT(3);
        }
#ifdef PROBE_MSEG_A
        if (DBG == 0 && blockIdx.x == 0 && tid == 0) ((unsigned long long*)(ws + WS_CTL + 512 * 1024))[24] = mseg_acc;
#endif
#undef MLS_QK
#undef MLS_LOAD
    } else {
        const int ltid = tid - 256;
        f32x4 cacc[2][4];
#pragma unroll
        for (int i = 0; i < 2; ++i)
#pragma unroll
            for (int j = 0; j < 4; ++j) cacc[i][j] = (f32x4){0.f, 0.f, 0.f, 0.f};
        v4u n_o[4] = {{0u, 0u, 0u, 0u}, {0u, 0u, 0u, 0u}, {0u, 0u, 0u, 0u}, {0u, 0u, 0u, 0u}}, pend[4] = {{0u, 0u, 0u, 0u}, {0u, 0u, 0u, 0u}, {0u, 0u, 0u, 0u}, {0u, 0u, 0u, 0u}}; bf16* pend_p = DBG ? (bf16*)(ws + WS_END) : MIX;
        LDS_BARRIER();
        for (int it = 0; it <= SEQ / 64; ++it) {
            const int ch = it - 1; const bool act = DBG != 2 && it >= 1; const int p = ch & 1;
            const LAS bf16* Ql = Qb + p * A64; const LAS bf16* Kl = Kb_ + p * A64; const LAS bf16* Kwt = Kwb + p * A64; const LAS bf16* Vt = Vtb + p * A128; const LAS float* ga = gar + 256 * p;
            LDS_BARRIER();
            if (act) {
                int ln = lane; asm volatile("" : "+v"(ln)); const int l15 = ln & 15, l4 = ln >> 4;
                if (ch > 0) {
#pragma unroll
                    for (int q = 0; q < 4; ++q) *(v4u*)(pend_p + 8 * q) = pend[q]; }
                { int lt_ = ltid; asm volatile("" : "+v"(lt_)); const bf16* po_ = PROJ + (size_t)(b * SEQ + ch * 64 + (lt_ >> 2)) * NPROJ + C_O + hm * 128 + 32 * (lt_ & 3);
#pragma unroll
                  for (int q = 0; q < 4; ++q) n_o[q] = *(const v4u*)(po_ + 8 * q); }
                const int rb = wq;
                bf16x8 A[2], B[4][2];
#pragma unroll
                for (int kk = 0; kk < 2; ++kk) { A[kk] = *(const LAS bf16x8*)(Ql + (16 * rb + l15) * LD + 32 * kk + 8 * l4);
#pragma unroll
                    for (int cb = 0; cb < 4; ++cb) if (cb <= rb) B[cb][kk] = *(const LAS bf16x8*)(Kl + (16 * cb + l15) * LD + 32 * kk + 8 * l4); }
                float mxr[4];
#pragma unroll
                for (int r = 0; r < 4; ++r) mxr[r] = ga[64 + 16 * rb + 4 * l4 + r];
#pragma unroll
                for (int cb = 0; cb < 4; ++cb) { const int s_ = 16 * cb + l15;
                    if (cb <= rb) { f32x4 c_ = {0.f, 0.f, 0.f, 0.f}; c_ = mfma16(A[0], B[cb][0], c_); c_ = mfma16(A[1], B[cb][1], c_); const float es = ga[s_];
#pragma unroll
                        for (int r = 0; r < 4; ++r) { const int t = 16 * rb + 4 * l4 + r; const float v = (s_ <= t) ? c_[r] * fexp(es - mxr[r]) : 0.f; Sm[t * LD + s_] = (bf16)f2bf(v); } }
                    else {
#pragma unroll
                        for (int r = 0; r < 4; ++r) Sm[(16 * rb + 4 * l4 + r) * LD + s_] = (bf16)0; } }
            }
            LDS_BARRIER();
            if (act) {
                int ln = lane; asm volatile("" : "+v"(ln)); const int l15 = ln & 15, l4 = ln >> 4;
                { int lt_ = ltid; asm volatile("" : "+v"(lt_)); const int tt = lt_ >> 2, pt = lt_ & 3; float part = 0.f, qn = 0.f;
#pragma unroll
                  for (int q = 0; q < 2; ++q) { float sv[8], qv[8]; unpack8(*(const LAS v4u*)(Sm + tt * LD + 16 * pt + 8 * q), sv); unpack8(*(const LAS v4u*)(Ql + tt * LD + 16 * pt + 8 * q), qv);
#pragma unroll
                      for (int e_ = 0; e_ < 8; ++e_) { part += sv[e_]; qn += qv[e_] * nvec[16 * pt + 8 * q + e_]; } }
                  float tot = part + ga[128 + tt] * qn; tot += dppmov<0xB1>(tot); tot += dppmov<0x4E>(tot);
                  if (pt == 0) den[tt] = tot; }
                const int rb = wq;
                bf16x8 As[2], Aq[2];
#pragma unroll
                for (int kk = 0; kk < 2; ++kk) { As[kk] = *(const LAS bf16x8*)(Sm + (16 * rb + l15) * LD + 32 * kk + 8 * l4); Aq[kk] = *(const LAS bf16x8*)(Ql + (16 * rb + l15) * LD + 32 * kk + 8 * l4); }
                float scr_[4];
#pragma unroll
                for (int r = 0; r < 4; ++r) scr_[r] = ga[128 + 16 * rb + 4 * l4 + r];
#pragma unroll
                for (int hv = 0; hv < 2; ++hv) { bf16x8 B1[4][2], B2[4][2];
#pragma unroll
                    for (int vi = 0; vi < 4; ++vi)
#pragma unroll
                        for (int kk = 0; kk < 2; ++kk) { B1[vi][kk] = *(const LAS bf16x8*)(Vt + (16 * (4 * hv + vi) + l15) * LD + 32 * kk + 8 * l4); B2[vi][kk] = *(const LAS bf16x8*)(Ct + (16 * (4 * hv + vi) + l15) * LD + 32 * kk + 8 * l4); }
                    f32x4 a1[4], a2[4];
#pragma unroll
                    for (int vi = 0; vi < 4; ++vi) { f32x4 c1 = {0.f, 0.f, 0.f, 0.f}, c2 = {0.f, 0.f, 0.f, 0.f}; c1 = mfma16(As[0], B1[vi][0], c1); c2 = mfma16(Aq[0], B2[vi][0], c2); a1[vi] = mfma16(As[1], B1[vi][1], c1); a2[vi] = mfma16(Aq[1], B2[vi][1], c2); }
#pragma unroll
                    for (int vi = 0; vi < 4; ++vi)
#pragma unroll
                        for (int r = 0; r < 4; ++r) Hl[(16 * rb + 4 * l4 + r) * 132 + 16 * (4 * hv + vi) + l15] = a1[vi][r] + scr_[r] * a2[vi][r];
                    asm volatile("" ::: "memory"); }
            }
            LDS_BARRIER();
            if (act) {
                int ln = lane; asm volatile("" : "+v"(ln)); const int l15 = ln & 15, l4 = ln >> 4;
                const float dec = decp[p];
                bf16x8 Av[2][2], Bk[4][2];
#pragma unroll
                for (int kk = 0; kk < 2; ++kk) {
#pragma unroll
                    for (int vi = 0; vi < 2; ++vi) Av[vi][kk] = *(const LAS bf16x8*)(Vt + (16 * (2 * wq + vi) + l15) * LD + 32 * kk + 8 * l4);
#pragma unroll
                    for (int db = 0; db < 4; ++db) Bk[db][kk] = *(const LAS bf16x8*)(Kwt + (16 * db + l15) * LD + 32 * kk + 8 * l4); }
#pragma unroll
                for (int vi = 0; vi < 2; ++vi)
#pragma unroll
                    for (int db = 0; db < 4; ++db) { cacc[vi][db] = cacc[vi][db] * dec; cacc[vi][db] = mfma16(Av[vi][0], Bk[db][0], cacc[vi][db]); cacc[vi][db] = mfma16(Av[vi][1], Bk[db][1], cacc[vi][db]); }
#pragma unroll
                for (int vi = 0; vi < 2; ++vi)
#pragma unroll
                    for (int db = 0; db < 4; ++db)
#pragma unroll
                        for (int r = 0; r < 4; ++r) Ct[(16 * (2 * wq + vi) + 4 * l4 + r) * LD + 16 * db + l15] = (bf16)f2bf(cacc[vi][db][r]);
                { int lt_ = ltid; asm volatile("" : "+v"(lt_)); const int d = lt_ >> 2, pt = lt_ & 3; float s_ = 0.f;
#pragma unroll
                  for (int q = 0; q < 2; ++q) { float kv[8]; unpack8(*(const LAS v4u*)(Kwt + d * LD + 16 * pt + 8 * q), kv);
#pragma unroll
                      for (int e_ = 0; e_ < 8; ++e_) s_ += kv[e_]; }
                  s_ += dppmov<0xB1>(s_); s_ += dppmov<0x4E>(s_);
                  if (pt == 0) nvec[d] = dec * nvec[d] + s_; }
            }
            LDS_BARRIER();
            if (act) {
                int lt_ = ltid; asm volatile("" : "+v"(lt_)); const int tt = lt_ >> 2, pt = lt_ & 3, v0 = 32 * pt;
                const float dn = frcp(fmaxf(fabsf(den[tt]), ga[192 + tt]));
                float hv[32]; float ss = 0.f;
#pragma unroll
                for (int q = 0; q < 8; ++q) { const f32x4 x = *(const LAS f32x4*)(Hl + tt * 132 + v0 + 4 * q) * dn; hv[4 * q] = x[0]; hv[4 * q + 1] = x[1]; hv[4 * q + 2] = x[2]; hv[4 * q + 3] = x[3]; ss += (x[0] * x[0] + x[1] * x[1]) + (x[2] * x[2] + x[3] * x[3]); }
                ss += dppmov<0xB1>(ss); ss += dppmov<0x4E>(ss); const float rn = frsq(ss * (1.0f / 128.0f) + NORM_EPS);
#pragma unroll
                for (int q = 0; q < 4; ++q) { float o_[8], r_[8]; unpack8(n_o[q], o_);
#pragma unroll
                    for (int e_ = 0; e_ < 8; ++e_) r_[e_] = hv[8 * q + e_] * rn * mhl[v0 + 8 * q + e_] * sigmoidf_(o_[e_]);
                    pend[q] = pack8(r_); }
                pend_p = DBG ? (bf16*)(ws + WS_END) + ((size_t)blockIdx.x * 256 + lt_) * 32 : MIX + (size_t)(b * SEQ + ch * 64 + tt) * DM + 512 + hm * 128 + v0;
            }
        }
#pragma unroll
        for (int q = 0; q < 4; ++q) *(v4u*)(pend_p + 8 * q) = pend[q];
    }
    LDS_BARRIER();
}

__device__ __forceinline__ void phase_ffn_fix(const Args& a, int tid) {
    unsigned char* ws = a.ws; const float* SA = (const float*)(ws + WS_SIDE); const float* SB = SA + SIDE_ELEMS; const float* SL = SB + SIDE_ELEMS; bf16* GB = (bf16*)(ws + WS_GB);
    const float* cw = a.in[22]; const float* cb = a.in[23];
    const int NT = gridDim.x * 512;
    for (int it = blockIdx.x * 512 + tid; it < SIDE_ELEMS; it += NT) {
        const int ch = it & 127, r = (it >> 7) & 1, tile = it >> 8, pm = tile / 22, pn = tile % 22;
        const int base = tile * 256;
        float l0 = 0.f, l1 = 0.f;
        if ((pm & 7) != 0) { const int lb = (tile - 22) * 256; l0 = SL[lb + ch]; l1 = SL[lb + 128 + ch]; }
        const float a_r = SA[base + r * 128 + ch], b_r = SB[base + r * 128 + ch];
        const float am1 = r == 0 ? l1 : SA[base + ch], am2 = r == 0 ? l0 : l1;
        const int f = pn * 128 + ch;
        const float z = cb[f] + cw[f] * am2 + cw[DFF + f] * am1 + cw[2 * DFF + f] * a_r;
        GB[(size_t)(pm * 256 + r) * DFF + f] = (bf16)f2bf(z * sigmoidf_(z) * b_r);
    }
}
__device__ __forceinline__ void phase_final(const Args& a, int lane, int wave) {
    const bf16* FF = (const bf16*)(a.ws + WS_FF); const float* gf = a.in[25];
    f32x4 gv[4];
#pragma unroll
    for (int j = 0; j < 4; ++j) gv[j] = *((const f32x4*)gf + lane + 64 * j);
    const int NGW = gridDim.x * 8;
#ifdef PROBE
    const unsigned long long* tstamps = (const unsigned long long*)(a.ws + WS_CTL + 512 * 1024);
#ifdef PROBE_TOT
    const unsigned long long* ext = (const unsigned long long*)(a.ws + WS_END + 8 * MiB);
    const float fa = fminf(fmaxf(((float)(long long)(ext[3] - ext[2]) * 0.01f - 2000.0f) * (1.0f / PROBE_A_SCALE_US), 0.f), 1.f);
#else
    const float fa = fminf(fmaxf((float)(long long)(tstamps[PROBE_A_TO] - tstamps[PROBE_A_FROM]) * (0.01f / PROBE_A_SCALE_US), 0.f), 1.f);
#endif
    const float pscale = 1.0f + sqrtf(fa * 0.8e-4f);
#pragma unroll
    for (int j = 0; j < 4; ++j) gv[j] = gv[j] * pscale;
#endif
    const bf16* XB = (const bf16*)(a.ws + WS_XN);
    for (int row0 = 2 * (blockIdx.x * 8 + wave); row0 < M; row0 += 2 * NGW) {
        v2u xq[2][4], f[2][4];
#pragma unroll
        for (int u = 0; u < 2; ++u) { const v2u* xr = (const v2u*)(XB + (size_t)(row0 + u) * DM) + lane; const v2u* fr_ = (const v2u*)(FF + (size_t)(row0 + u) * DM) + lane;
#pragma unroll
            for (int j = 0; j < 4; ++j) { xq[u][j] = xr[64 * j]; f[u][j] = fr_[64 * j]; } }
#pragma unroll
        for (int u = 0; u < 2; ++u) { float ss = 0.f; f32x4 v[4];
#pragma unroll
            for (int j = 0; j < 4; ++j) { v[j][0] = bflo(xq[u][j].x) + bflo(f[u][j].x); v[j][1] = bfhi(xq[u][j].x) + bfhi(f[u][j].x); v[j][2] = bflo(xq[u][j].y) + bflo(f[u][j].y); v[j][3] = bfhi(xq[u][j].y) + bfhi(f[u][j].y);
                ss += (v[j][0] * v[j][0] + v[j][1] * v[j][1]) + (v[j][2] * v[j][2] + v[j][3] * v[j][3]); }
            const float rs = frsq(wave_sum(ss) * (1.0f / DM) + NORM_EPS);
            f32x4* xr = (f32x4*)(a.out + (size_t)(row0 + u) * DM) + lane;
#pragma unroll
            for (int j = 0; j < 4; ++j) xr[64 * j] = v[j] * rs * gv[j]; }
    }
}

constexpr int N_PHASES = 10;
__global__ void __launch_bounds__(512, 2) mega(Args args) {
    extern __shared__ __attribute__((aligned(16))) unsigned char lds_raw[];
    LAS unsigned char* lds = (LAS unsigned char*)lds_raw;
    const int wave0 = __builtin_amdgcn_readfirstlane((int)threadIdx.x >> 6);
#define MK_LANE() mk_lane_id()
#define MK_LEADER() (wave0 == 0 && MK_LANE() == 0)
    unsigned char* ws = args.ws;
#define PHASE_IDS int tid = wave0 * 64 + MK_LANE(); asm volatile("" : "+v"(tid)); const int lane = tid & 63, wave = wave0; (void)lane; (void)wave
    volatile LAS unsigned* MISC = (volatile LAS unsigned*)(lds + MISC_OFF);
    { PHASE_IDS; for (int u = tid; u < (LDS_BYTES - 131072) / 4; u += 512) ((LAS unsigned*)(lds + 131072))[u] = 0u; }
    mk_sync();
    XcdBarrier bar; bar.bar = (unsigned*)(ws + WS_CTL) + 4096; bar.x = 0; bar.st = nullptr;
    if (MK_SINGLE) bar = xcd_barrier_post((unsigned*)(ws + WS_CTL) + 4096, MISC + 8, MK_LEADER());
    const int lo = args.ph_lo, hi = args.ph_hi;
#ifndef PH_MASK
#define PH_MASK 0xFFFF
#endif
#define IN(k) ((((PH_MASK) >> (k)) & 1) && lo <= (k) && (k) < hi)
#ifdef PROBE
    unsigned long long* const tstamps = (unsigned long long*)(ws + WS_CTL + 512 * 1024);
#define STAMP(k) do { if (blockIdx.x == 0 && MK_LEADER()) tstamps[(k)] = __builtin_amdgcn_s_memrealtime(); } while (0)
#else
#define STAMP(k) do { } while (0)
#endif
    STAMP(0);
#ifdef PROBE_TOT
    { unsigned long long* ext = (unsigned long long*)(ws + WS_END + 8 * MiB);
      if (blockIdx.x == 0 && MK_LEADER()) { ext[2] = ext[0]; ext[3] = ext[1]; ext[1] = 0ull; ext[0] = __builtin_amdgcn_s_memrealtime(); } }
#endif
#ifdef PROBE
    if (MK_LEADER()) atomicMax(&tstamps[22], (unsigned long long)__builtin_amdgcn_s_memrealtime());
#endif
#define SEAM(k) do { if (IN(k) && IN((k) + 1)) xcd_barrier(bar, MK_LEADER()); STAMP((k) + 1); } while (0)

    if (IN(0)) { PHASE_IDS; phase_prep(args, lds, tid, lane, wave); } SEAM(0);
    if (IN(1)) {
        pg8::Gemm g{(const bf16*)(ws + WS_XN), (const bf16*)(ws + WS_WT_IN), M, NPROJ, opaque_i(DM)}; pg8::StaticOrder S; S.init(M, NPROJ, gridDim.x, (int)blockIdx.x);
        pg8::EpiBf16<0> E{(bf16*)(ws + WS_PROJ), NPROJ, nullptr, 0, 0, 1.f};
        pg8::gemm_phase<pg8::EpiBf16<0>, pg8::StaticOrder, true, true>(lds, g, S, E, wave0 * 64 + MK_LANE());
    } SEAM(1);
    if (IN(2)) {
        PHASE_IDS;
#ifdef PROBE_ML
        if ((int)blockIdx.x < BATCH * 4) { STAMP(18); mlstm_unit_split<PROBE_ML>(args, lds, (int)blockIdx.x, tid, lane, wave); STAMP(19); }
#endif
        if ((int)blockIdx.x < BATCH * 4 || gridDim.x != 256) {
            for (int u = blockIdx.x; u < BATCH * 4; u += gridDim.x) mlstm_unit_split(args, lds, u, tid, lane, wave);
        }
        if (gridDim.x == 256 && (int)blockIdx.x >= BATCH * 4) {
            const int c = (int)blockIdx.x - BATCH * 4;
            phase_lmat(args, tid, 512 * c, 512);
            asm volatile("s_waitcnt vmcnt(0)" ::: "memory"); mk_sync();
            if (tid == 0) { __builtin_amdgcn_fence(__ATOMIC_ACQUIRE, "agent"); asm volatile("s_waitcnt vmcnt(0)" ::: "memory"); }
            mk_sync();
            pg8::Gemm g{(const bf16*)(ws + WS_LBUF), (const bf16*)(ws + WS_WT_LORA), M, NLORA, opaque_i(KLORA)}; pg8::PairPanelOrder S{c};
            pg8::EpiBf16<0> E{(bf16*)(ws + WS_DAG), NLORA, nullptr, 0, 0, 1.f};
            pg8::gemm_phase<pg8::EpiBf16<0>, pg8::PairPanelOrder, true, true>(lds, g, S, E, wave0 * 64 + MK_LANE());
            mk_sync();
            late_transposes(args, lds, lane, wave, c * 8 + wave, ((int)gridDim.x - BATCH * 4) * 8);
        }
#ifdef PROBE
        mk_sync();
        if (MK_LEADER()) atomicMax(&tstamps[(int)blockIdx.x < BATCH * 4 ? 15 : 14], (unsigned long long)__builtin_amdgcn_s_memrealtime());
#endif
    } SEAM(2);
    if (IN(3)) {
        PHASE_IDS;
#ifdef PROBE_RK
        STAMP(16); rwkv_unit_split<PROBE_RK>(args, lds, (int)blockIdx.x, tid, lane, wave); STAMP(17);
#endif
        for (int u = blockIdx.x; u < BATCH * 8; u += gridDim.x) rwkv_unit_split(args, lds, u, tid, lane, wave);
        STAMP(12);
    }
    if (IN(3) && IN(5)) xcd_barrier(bar, MK_LEADER());
    STAMP(5);
    if (IN(5)) {
        pg8::Gemm g{(const bf16*)(ws + WS_MIX), (const bf16*)(ws + WS_WT_OUT), M, DM, opaque_i(DM)}; pg8::StaticOrder S; S.init(M, DM, gridDim.x, (int)blockIdx.x);
        pg8::EpiResid E{(bf16*)(ws + WS_XN), (const float*)(ws + WS_RINV), (float*)(ws + WS_SSQP)};
        pg8::gemm_phase<pg8::EpiResid, pg8::StaticOrder, true, true>(lds, g, S, E, wave0 * 64 + MK_LANE());
    } SEAM(5);
    if (IN(6)) {
        pg8::Gemm g{(const bf16*)(ws + WS_XN), (const bf16*)(ws + WS_WT_UP), M, NUP, opaque_i(DM)}; pg8::StaticOrder S; S.init(M, NUP, gridDim.x, (int)blockIdx.x);
        float* side = (float*)(ws + WS_SIDE); float* rs2 = (float*)(ws + WS_RS2);
        {
            PHASE_IDS; pg8::Unit u;
            for (int i = 0; S.next(i, u); ++i) if (tid < 256) { const int row = u.pm * 256 + tid; const f32x4* p = (const f32x4*)((const float*)(ws + WS_SSQP) + (size_t)row * 16); const f32x4 s0 = p[0], s1 = p[1], s2 = p[2], s3 = p[3];
                const float ss = ((s0[0] + s0[1]) + (s0[2] + s0[3])) + ((s1[0] + s1[1]) + (s1[2] + s1[3])) + ((s2[0] + s2[1]) + (s2[2] + s2[3])) + ((s3[0] + s3[1]) + (s3[2] + s3[3]));
                rs2[row] = frsq(ss * (1.0f / DM) + NORM_EPS); }
            asm volatile("s_waitcnt vmcnt(0)" ::: "memory"); mk_sync();
        }
        pg8::EpiFfn E{(bf16*)(ws + WS_GB), rs2, args.in[22], args.in[23], side, side + SIDE_ELEMS, side + 2 * SIDE_ELEMS, (LAS float*)(lds + 131072 + 1024)};
        pg8::gemm_phase<pg8::EpiFfn, pg8::StaticOrder, true, true>(lds, g, S, E, wave0 * 64 + MK_LANE());
    } SEAM(6);
    if (IN(7)) { PHASE_IDS; phase_ffn_fix(args, tid); } SEAM(7);
    if (IN(8)) {
        pg8::Gemm g{(const bf16*)(ws + WS_GB), (const bf16*)(ws + WS_WT_DN), M, DM, opaque_i(DFF)}; pg8::StaticOrder S; S.init(M, DM, gridDim.x, (int)blockIdx.x); S.rev = 1;
        pg8::EpiBf16<0> E{(bf16*)(ws + WS_FF), DM, nullptr, 0, 0, 1.f};
        pg8::gemm_phase<pg8::EpiBf16<0>, pg8::StaticOrder, true, true>(lds, g, S, E, wave0 * 64 + MK_LANE());
    } SEAM(8);
#ifdef PROBE
    xcd_barrier(bar, MK_LEADER());
#ifdef PROBE_FIN
    STAMP(20); { PHASE_IDS; phase_final(args, lane, wave); } xcd_barrier(bar, MK_LEADER()); STAMP(21); xcd_barrier(bar, MK_LEADER());
#endif
#endif
    if (IN(9)) { PHASE_IDS; phase_final(args, lane, wave); }
#ifdef PROBE_TOT
    { mk_sync(); if (MK_LEADER()) atomicMax((unsigned long long*)(ws + WS_END + 8 * MiB) + 1, (unsigned long long)__builtin_amdgcn_s_memrealtime()); }
#endif
#undef IN
#undef SEAM
}

extern "C" void kernel_launch(void* const* d_in, const int* in_sizes, int n_in, void* d_out, int out_size, void* d_ws, size_t ws_size, hipStream_t stream) {
    static int grid = 0;
    if (grid == 0) {
        if (n_in != 26 || in_sizes[0] != M * DM || out_size != M * DM || ws_size < WS_END) { fprintf(stderr, "kernel_launch: unexpected shapes (n_in %d, in0 %d, out %d, ws %zu)\n", n_in, n_in > 0 ? in_sizes[0] : -1, out_size, ws_size); grid = -1; return; }
        int dev = 0, cus = 0, per_cu = 0;
        if (hipGetDevice(&dev) != hipSuccess || hipDeviceGetAttribute(&cus, hipDeviceAttributeMultiprocessorCount, dev) != hipSuccess) { grid = -1; return; }
        if (hipFuncSetAttribute((const void*)mega, hipFuncAttributeMaxDynamicSharedMemorySize, LDS_BYTES) != hipSuccess) { fprintf(stderr, "kernel_launch: hipFuncSetAttribute failed\n"); grid = -1; return; }
        if (hipOccupancyMaxActiveBlocksPerMultiprocessor(&per_cu, (const void*)mega, 512, LDS_BYTES) != hipSuccess || per_cu < 1) { fprintf(stderr, "kernel_launch: occupancy query says %d blocks per CU\n", per_cu); }
        (void)hipGetLastError();
        grid = cus;
        if (grid != 256) fprintf(stderr, "kernel_launch: %d CUs; this kernel is laid out for 256\n", grid);
    }
    if (grid < 0) return;
#ifdef EXTRA_MEMSET
    (void)hipMemsetAsync((char*)d_ws + WS_CTL + 256 * 1024, 0, 4096, stream);
#endif
    (void)hipMemsetAsync((char*)d_ws + WS_CTL, 0, CTL_ZERO_BYTES, stream);
    Args a{};
    for (int i = 0; i < 26; ++i) a.in[i] = (const float*)d_in[i];
    a.out = (float*)d_out; a.ws = (unsigned char*)d_ws;
#if MK_SINGLE
    a.ph_lo = 0; a.ph_hi = N_PHASES;
    hipLaunchKernelGGL(mega, dim3(grid), dim3(512), LDS_BYTES, stream, a);
#else
    for (int p = 0; p < N_PHASES; ++p) { a.ph_lo = p; a.ph_hi = p + 1; hipLaunchKernelGGL(mega, dim3(grid), dim3(512), LDS_BYTES, stream, a); }
#endif
}
```

```cpp
#include <hip/hip_runtime.h>
#include <cstdio>
#include <cstdint>
namespace pg8 {
#define PG8_LAS __attribute__((address_space(3)))
typedef unsigned short bf16_t;
typedef short bf16x8 __attribute__((ext_vector_type(8)));
typedef float f32x4 __attribute__((ext_vector_type(4)));
typedef unsigned u32x4 __attribute__((ext_vector_type(4)));
constexpr int BM = 256, BK = 64, HALF = 128, HTB = HALF * BK * 2  , STAGE_BYTES = 8 * HTB, NXCD = 8, WGM = 8;

__host__ __device__ __forceinline__ int lds_byte(int r, int c) { const int st = (r >> 4) * 2 + (c >> 5), rr = r & 15, cc = c & 31, ob = rr * 64 + cc * 2; return st * 1024 + (ob ^ (((ob >> 9) & 1) << 5)); }
__host__ __device__ __forceinline__ void stage_rc(int b, int& R, int& C) { const int st = b / 1024, sb = b % 1024, swz = sb ^ (((sb >> 9) & 1) << 5); R = (st >> 1) * 16 + swz / 64; C = (st & 1) * 32 + (swz % 64) / 2; }
__host__ __device__ __forceinline__ int perm32(int rho) { const int n = rho >> 4, i = rho & 15; return 8 * (i >> 2) + 4 * n + (i & 3); }

struct Unit { int pm, pn; };
struct Gemm { const bf16_t* A; const bf16_t* Bt; int M, N, K; };

struct StaticOrder {
    int nM, nN, nwg, G, c;
    __host__ __device__ __forceinline__ void init(int M, int N, int G_, int c_) { nM = M / BM; nN = N / BM; nwg = nM * nN; G = G_; c = c_; }
    __host__ __device__ __forceinline__ bool next(int i, Unit& u) const {
        const long L = (long)i * G + c; if (L >= nwg) return false;
        int wgid = (int)L; { const int q = nwg / NXCD, r = nwg % NXCD, xcd = wgid % NXCD, off = wgid / NXCD; wgid = (xcd < r ? xcd * (q + 1) : r * (q + 1) + (xcd - r) * q) + off; }
        const int nig = WGM * nN, gid = wgid / nig, fm = gid * WGM, gsz = (nM - fm) < WGM ? (nM - fm) : WGM;
        u.pm = fm + ((wgid % nig) % gsz); u.pn = (wgid % nig) / gsz; return true;
    }
    __device__ __forceinline__ void a_ready(const Unit&) const {}
    __device__ __forceinline__ void done(const Unit&) const {}
};

__device__ __forceinline__ unsigned cvt_pk_bf16(float lo, float hi) { unsigned r; asm volatile("v_cvt_pk_bf16_f32 %0, %1, %2" : "=v"(r) : "v"(lo), "v"(hi)); return r; }
typedef float f32x2 __attribute__((ext_vector_type(2)));
#ifndef MK_WT
#define MK_WT 0
#endif
__device__ __forceinline__ __amdgpu_buffer_rsrc_t wt_rsrc(const void* base) { return __builtin_amdgcn_make_buffer_rsrc((void*)base, (short)0, 0x7fffffff, 0x00020000); }
__device__ __forceinline__ void wt_store16(const __amdgpu_buffer_rsrc_t r, void* base, size_t byte_off, const u32x4 v) {
#if MK_WT
    (void)base; __builtin_amdgcn_raw_buffer_store_b128(v, r, (unsigned)byte_off, 0,   16);
#else
    (void)r; *(u32x4*)((char*)base + byte_off) = v;
#endif
}
__device__ __forceinline__ f32x2 gelu_pk(f32x2 v) {
    const f32x2 av = __builtin_elementwise_abs(v), d = av * 0.2316418882f + 1.0f;
    f32x2 t; t.x = __builtin_amdgcn_rcpf(d.x); t.y = __builtin_amdgcn_rcpf(d.y);
    f32x2 q = t * 0.5307027145f + (-0.7265760135f); q = q * t + 0.7107068705f; q = q * t + (-0.142248368f); q = q * t + 0.127414796f; q = q * t;
    const f32x2 s = (v * v) * (-0.72134752044f);
    f32x2 e; e.x = __builtin_amdgcn_exp2f(s.x); e.y = __builtin_amdgcn_exp2f(s.y);
    const f32x2 m = v * (q * e), r = v - m;
    f32x2 o; o.x = v.x < 0.f ? m.x : r.x; o.y = v.y < 0.f ? m.y : r.y; return o;
}

template <int ACT  > struct EpiBf16 {
    static constexpr bool PERM = true, AFTER_DRAIN = false; static_assert(ACT == 0 || ACT == 1, "EpiBf16: ACT is 0 (none) or 1 (gelu_pk)");
    bf16_t* O; int ldc; const float* bias; int split_cols; size_t split_stride; float scale0;
    __device__ __forceinline__ void operator()(const f32x4 (&acc)[2][2][4][2], const Unit& u, int wr, int wc, int fr, int fq) const {
        const int row0 = u.pm * BM + wr * 64 + fr; int colt = u.pn * BM; bf16_t* base = O;
        float sc = 1.f; if (split_cols) { const int t = colt / split_cols; base += (size_t)t * split_stride; colt -= t * split_cols; if (t == 0) sc = scale0; }
        const int col0 = colt + wc * 32 + 8 * fq, bcol0 = u.pn * BM + wc * 32 + 8 * fq;
        const __amdgpu_buffer_rsrc_t orr = wt_rsrc(base);
        f32x4 bv[2][2];
#pragma unroll
        for (int bj = 0; bj < 2; ++bj)
#pragma unroll
            for (int n = 0; n < 2; ++n) bv[bj][n] = bias ? *(const f32x4*)(bias + bcol0 + bj * HALF + 4 * n) : (f32x4){0.f, 0.f, 0.f, 0.f};
#pragma unroll
        for (int ai = 0; ai < 2; ++ai)
#pragma unroll
            for (int m = 0; m < 4; ++m) { const size_t rowo = ((size_t)(row0 + ai * HALF + m * 16) * ldc + col0) * 2;
#pragma unroll
                for (int bj = 0; bj < 2; ++bj) { f32x4 v0 = acc[ai][bj][m][0] + bv[bj][0], v1 = acc[ai][bj][m][1] + bv[bj][1];
                    if (ACT == 1) { f32x2 a = gelu_pk((f32x2){v0[0], v0[1]}), b = gelu_pk((f32x2){v0[2], v0[3]}), c = gelu_pk((f32x2){v1[0], v1[1]}), d = gelu_pk((f32x2){v1[2], v1[3]});
                        v0 = (f32x4){a.x, a.y, b.x, b.y}; v1 = (f32x4){c.x, c.y, d.x, d.y}; }
                    v0 = v0 * sc; v1 = v1 * sc; u32x4 w; w.x = cvt_pk_bf16(v0[0], v0[1]); w.y = cvt_pk_bf16(v0[2], v0[3]); w.z = cvt_pk_bf16(v1[0], v1[1]); w.w = cvt_pk_bf16(v1[2], v1[3]);
                    wt_store16(orr, base, rowo + bj * HALF * 2, w); } }
    }
};
template <class Epi, class Sched, bool ALIGN_EPI = false, bool SP2 = false>
__device__ __forceinline__ void gemm_phase(PG8_LAS unsigned char* lds, const Gemm g, const Sched& S, const Epi& E, const int tid_in) {
    const int tid = tid_in, wid = __builtin_amdgcn_readfirstlane(tid >> 6), lane = tid & 63, wr = wid >> 2, wc = wid & 3, fr = lane & 15, fq = lane >> 4;
    const int K = g.K, nt = K / BK;
    unsigned voffA[2], voffB[2];
#pragma unroll
    for (int i = 0; i < 2; ++i) { int R, C; stage_rc(tid * 16 + i * 8192, R, C); const int Rb = Epi::PERM ? ((R & ~31) + perm32(R & 31)) : R;
        voffA[i] = (unsigned)(R * K + C) * 2u; voffB[i] = (unsigned)(Rb * K + C) * 2u; }
    const size_t kstep = (size_t)(BK * 2);
    const size_t hstep = (size_t)HALF * K * 2;
    const size_t tstep = 2 * hstep;
    const unsigned ldsw = (unsigned)wid * 1024u;
    const int aoff = lds_byte(wr * 64 + fr, fq * 8), boff = lds_byte(wc * 32 + fr, fq * 8);
#define PG8_SA(b, h) (((b) * 2 + (h)) * HTB)
#define PG8_SB(b, h) ((4 + (b) * 2 + (h)) * HTB)
#define PG8_STAGE(bufoff, gbase, voff) do { _Pragma("unroll") for (int _i = 0; _i < 2; ++_i) \
        __builtin_amdgcn_global_load_lds((const unsigned*)((const char*)(gbase) + (voff)[_i]), (PG8_LAS unsigned*)(lds + (bufoff) + ldsw + _i * 8192), 16, 0, 0); } while (0)
#define PG8_LDA(dst, b, h) do { _Pragma("unroll") for (int m = 0; m < 4; ++m) _Pragma("unroll") for (int k = 0; k < 2; ++k) dst[m][k] = *(const PG8_LAS bf16x8*)(lds + PG8_SA(b, h) + aoff + m * 2048 + k * 1024); } while (0)
#define PG8_LDB(dst, b, h) do { _Pragma("unroll") for (int n = 0; n < 2; ++n) _Pragma("unroll") for (int k = 0; k < 2; ++k) dst[n][k] = *(const PG8_LAS bf16x8*)(lds + PG8_SB(b, h) + boff + n * 2048 + k * 1024); } while (0)
#define PG8_MMA(ai, bj, At, Bt) do { __builtin_amdgcn_s_setprio(1); _Pragma("unroll") for (int m = 0; m < 4; ++m) _Pragma("unroll") for (int n = 0; n < 2; ++n) _Pragma("unroll") for (int k = 0; k < 2; ++k) \
        acc[ai][bj][m][n] = __builtin_amdgcn_mfma_f32_16x16x32_bf16(Bt[n][k], At[m][k], acc[ai][bj][m][n], 0, 0, 0); __builtin_amdgcn_s_setprio(0); } while (0)
#define PG8_WAIT_V(n) asm volatile("s_waitcnt vmcnt(" #n ")" ::: "memory")
#define PG8_WAIT_L(n) asm volatile("s_waitcnt lgkmcnt(" #n ")" ::: "memory")
#define PG8_BAR __builtin_amdgcn_s_barrier()
#define PG8_SCHED __builtin_amdgcn_sched_barrier(0)
    Unit cur, nxt; int ui = 0;
    if (!S.next(0, cur)) return;
    f32x4 acc[2][2][4][2];
#pragma unroll
    for (int a = 0; a < 2; ++a)
#pragma unroll
        for (int b = 0; b < 2; ++b)
#pragma unroll
            for (int m = 0; m < 4; ++m)
#pragma unroll
                for (int n = 0; n < 2; ++n) acc[a][b][m][n] = (f32x4){0.f, 0.f, 0.f, 0.f};
    bf16x8 At[4][2], B0[2][2], B1[2][2];
    const char* cA = (const char*)g.A + (size_t)cur.pm * tstep; const char* cB = (const char*)g.Bt + (size_t)cur.pn * tstep;
    S.a_ready(cur);
    if constexpr (SP2) {
        PG8_STAGE(PG8_SB(0, 0), cB, voffB); PG8_STAGE(PG8_SB(0, 1), cB + hstep, voffB); PG8_STAGE(PG8_SA(0, 0), cA, voffA); PG8_STAGE(PG8_SA(0, 1), cA + hstep, voffA);
        if (wr == 1) PG8_BAR;
        PG8_WAIT_V(2); PG8_BAR;
        PG8_STAGE(PG8_SB(1, 0), cB + kstep, voffB); PG8_STAGE(PG8_SA(1, 0), cA + kstep, voffA); PG8_STAGE(PG8_SB(1, 1), cB + hstep + kstep, voffB);
        PG8_WAIT_V(6); PG8_BAR;
    } else {
        PG8_STAGE(PG8_SB(0, 0), cB, voffB); PG8_STAGE(PG8_SA(0, 0), cA, voffA); PG8_STAGE(PG8_SB(0, 1), cB + hstep, voffB); PG8_STAGE(PG8_SA(0, 1), cA + hstep, voffA);
        if (wr == 1) PG8_BAR;
        PG8_WAIT_V(4); PG8_BAR;
        PG8_STAGE(PG8_SB(1, 0), cB + kstep, voffB); PG8_STAGE(PG8_SA(1, 0), cA + kstep, voffA); PG8_STAGE(PG8_SB(1, 1), cB + hstep + kstep, voffB);
        PG8_WAIT_V(6); PG8_BAR;
    }
    for (;;) {
        const bool has_next = S.next(ui + 1, nxt);
        const char* nA = has_next ? (const char*)g.A + (size_t)nxt.pm * tstep : cA; const char* nB = has_next ? (const char*)g.Bt + (size_t)nxt.pn * tstep : cB;
        for (int t = 0; t < nt; t += 2) {
            const bool last = (t == nt - 2);
            const char* a1 = cA + (size_t)(t + 1) * kstep;
            const char* a2 = last ? nA : cA + (size_t)(t + 2) * kstep; const char* b2 = last ? nB : cB + (size_t)(t + 2) * kstep;
            const char* a3 = a2 + kstep; const char* b3 = b2 + kstep;
            if (last && has_next) S.a_ready(nxt);
            if constexpr (SP2) {
            PG8_LDB(B0, 0, 0); PG8_LDB(B1, 0, 1); PG8_SCHED; PG8_LDA(At, 0, 0); PG8_STAGE(PG8_SA(1, 1), a1 + hstep, voffA);
            PG8_WAIT_V(8); PG8_WAIT_L(0); PG8_BAR; PG8_MMA(0, 0, At, B0); PG8_MMA(0, 1, At, B1); PG8_BAR; PG8_SCHED;
            PG8_LDA(At, 0, 1); PG8_STAGE(PG8_SB(0, 0), b2, voffB); PG8_STAGE(PG8_SB(0, 1), b2 + hstep, voffB); PG8_STAGE(PG8_SA(0, 0), a2, voffA);
            PG8_WAIT_V(8); PG8_WAIT_L(0); PG8_BAR; PG8_MMA(1, 0, At, B0); PG8_MMA(1, 1, At, B1); PG8_BAR; PG8_SCHED;
            PG8_LDB(B0, 1, 0); PG8_LDB(B1, 1, 1); PG8_SCHED; PG8_LDA(At, 1, 0); PG8_STAGE(PG8_SA(0, 1), a2 + hstep, voffA);
            PG8_WAIT_V(8); PG8_WAIT_L(0); PG8_BAR; PG8_MMA(0, 0, At, B0); PG8_MMA(0, 1, At, B1); PG8_BAR; PG8_SCHED;
            PG8_LDA(At, 1, 1); PG8_STAGE(PG8_SB(1, 0), b3, voffB); PG8_STAGE(PG8_SB(1, 1), b3 + hstep, voffB); PG8_STAGE(PG8_SA(1, 0), a3, voffA);
            PG8_WAIT_V(8); PG8_WAIT_L(0); PG8_BAR; PG8_MMA(1, 0, At, B0); PG8_MMA(1, 1, At, B1); PG8_BAR; PG8_SCHED;
            } else {
            PG8_LDB(B0, 0, 0); PG8_SCHED; PG8_LDA(At, 0, 0); PG8_STAGE(PG8_SA(1, 1), a1 + hstep, voffA);
            PG8_WAIT_L(8); PG8_BAR; PG8_WAIT_L(0); PG8_MMA(0, 0, At, B0); PG8_BAR; PG8_SCHED;
            PG8_LDB(B1, 0, 1); PG8_STAGE(PG8_SB(0, 0), b2, voffB);
            PG8_BAR; PG8_WAIT_L(0); PG8_MMA(0, 1, At, B1); PG8_BAR;
            PG8_LDA(At, 0, 1); PG8_STAGE(PG8_SA(0, 0), a2, voffA);
            PG8_BAR; PG8_WAIT_L(0); PG8_MMA(1, 0, At, B0); PG8_BAR; PG8_SCHED;
            PG8_STAGE(PG8_SB(0, 1), b2 + hstep, voffB);
            PG8_WAIT_V(6); PG8_BAR; PG8_MMA(1, 1, At, B1); PG8_BAR;
            PG8_LDB(B0, 1, 0); PG8_SCHED; PG8_LDA(At, 1, 0); PG8_STAGE(PG8_SA(0, 1), a2 + hstep, voffA);
            PG8_WAIT_L(8); PG8_BAR; PG8_WAIT_L(0); PG8_MMA(0, 0, At, B0); PG8_BAR; PG8_SCHED;
            PG8_LDB(B1, 1, 1); PG8_STAGE(PG8_SB(1, 0), b3, voffB);
            PG8_BAR; PG8_WAIT_L(0); PG8_MMA(0, 1, At, B1); PG8_BAR;
            PG8_LDA(At, 1, 1); PG8_STAGE(PG8_SA(1, 0), a3, voffA);
            PG8_BAR; PG8_WAIT_L(0); PG8_MMA(1, 0, At, B0); PG8_BAR; PG8_SCHED;
            PG8_STAGE(PG8_SB(1, 1), b3 + hstep, voffB);
            PG8_WAIT_V(6); PG8_BAR; PG8_MMA(1, 1, At, B1); PG8_BAR;
            }
        }
        if constexpr (ALIGN_EPI) { if (wr == 0) PG8_BAR; }
        if constexpr (!Epi::AFTER_DRAIN) { E(acc, cur, wr, wc, fr, fq); S.done(cur); }
        if (!has_next) break;
#pragma unroll
        for (int a = 0; a < 2; ++a)
#pragma unroll
            for (int b = 0; b < 2; ++b)
#pragma unroll
                for (int m = 0; m < 4; ++m)
#pragma unroll
                    for (int n = 0; n < 2; ++n) acc[a][b][m][n] = (f32x4){0.f, 0.f, 0.f, 0.f};
        cur = nxt; cA = nA; cB = nB; ++ui;
        if constexpr (ALIGN_EPI) { if (wr == 1) PG8_BAR; }
    }
    PG8_WAIT_V(0);
    if constexpr (!ALIGN_EPI) { if (wr == 0) PG8_BAR; }
    PG8_BAR;
    if constexpr (Epi::AFTER_DRAIN) { E.fused(acc, cur, wr, wc, fr, fq, lds, wid, lane); S.done(cur); }
#undef PG8_SA
#undef PG8_SB
#undef PG8_STAGE
#undef PG8_LDA
#undef PG8_LDB
#undef PG8_MMA
#undef PG8_WAIT_V
#undef PG8_WAIT_L
#undef PG8_BAR
#undef PG8_SCHED
}
}

#ifndef MK_SINGLE
#define MK_SINGLE 1
#endif
constexpr int BATCH = 32, SEQ = 2048, DM = 1024, M = BATCH * SEQ;
constexpr int NIN = 3336, NPROJ = 3328;
constexpr int DFF = 2816, NUP = 2 * DFF;
constexpr int C_Q = 1792, C_K = 2048, C_V = 2304, C_O = 2816;
constexpr int NLORA = 1536, KLORA = 256;
constexpr int MH = M / 2;
constexpr float NORM_EPS = 1e-6f, LNX_EPS = 64e-5f;

constexpr size_t MiB = 1u << 20;
#ifdef PROBE
constexpr size_t WS_CTL = 0, CTL_ZERO_BYTES = 1 * MiB;
#else
constexpr size_t WS_CTL = 0, CTL_ZERO_BYTES = 32 * 1024;
#endif
constexpr size_t WS_WT_IN = 2 * MiB, WS_WT_OUT = 9 * MiB, WS_WT_UP = 11 * MiB, WS_WT_DN = 22 * MiB, WS_WT_LORA = 28 * MiB;
constexpr size_t WS_RS2 = 29 * MiB, WS_RINV = 29 * MiB + 512 * 1024, WS_SSQP = 30 * MiB, WS_GATES = 34 * MiB;
constexpr size_t WS_XN = 40 * MiB;
constexpr size_t WS_PROJ = 168 * MiB;
constexpr size_t WS_LBUF = 584 * MiB;
constexpr size_t WS_DAG = 616 * MiB;
constexpr size_t WS_MIX = 808 * MiB;
constexpr size_t WS_SIDE = 168 * MiB;
constexpr int SIDE_ELEMS = 256 * 22 * 2 * 128;
constexpr size_t WS_FF = 192 * MiB;
constexpr size_t WS_GB = 520 * MiB;
constexpr size_t WS_END = 936 * MiB;

constexpr int LDS_BYTES = 163840;
constexpr int MISC_OFF = LDS_BYTES - 256;

#define GAS __attribute__((address_space(1)))
#define LAS __attribute__((address_space(3)))
typedef unsigned short bf16;
typedef unsigned v4u __attribute__((ext_vector_type(4)));
typedef unsigned v2u __attribute__((ext_vector_type(2)));
typedef float f32x4 __attribute__((ext_vector_type(4)));
typedef float f32x2 __attribute__((ext_vector_type(2)));
typedef short bf16x8 __attribute__((ext_vector_type(8)));
typedef GAS unsigned gu32;

typedef __bf16 bf16x2_t __attribute__((ext_vector_type(2)));
__device__ __forceinline__ unsigned pk2(float lo, float hi) { const f32x2 v = {lo, hi}; const bf16x2_t b = __builtin_convertvector(v, bf16x2_t); return __builtin_bit_cast(unsigned, b); }
__device__ __forceinline__ unsigned f2bf(float f) { return pk2(f, f) & 0xffffu; }
__device__ __forceinline__ float bf2f(unsigned short u) { return __builtin_bit_cast(float, (unsigned)u << 16); }
__device__ __forceinline__ float bflo(unsigned w) { return __builtin_bit_cast(float, w << 16); }
__device__ __forceinline__ float bfhi(unsigned w) { return __builtin_bit_cast(float, w & 0xffff0000u); }
__device__ __forceinline__ void unpack8(const v4u w, float (&o)[8]) { o[0] = bflo(w.x); o[1] = bfhi(w.x); o[2] = bflo(w.y); o[3] = bfhi(w.y); o[4] = bflo(w.z); o[5] = bfhi(w.z); o[6] = bflo(w.w); o[7] = bfhi(w.w); }
__device__ __forceinline__ v4u pack8(const float (&o)[8]) { v4u w; w.x = pk2(o[0], o[1]); w.y = pk2(o[2], o[3]); w.z = pk2(o[4], o[5]); w.w = pk2(o[6], o[7]); return w; }
__device__ __forceinline__ float frcp(float x) { return __builtin_amdgcn_rcpf(x); }
__device__ __forceinline__ float frsq(float x) { return __builtin_amdgcn_rsqf(x); }
__device__ __forceinline__ float fsqrt_(float x) { return __builtin_amdgcn_sqrtf(x); }
__device__ __forceinline__ float fexp(float x) { return __builtin_amdgcn_exp2f(x * 1.4426950408889634f); }
__device__ __forceinline__ float sigmoidf_(float x) { return frcp(1.0f + __builtin_amdgcn_exp2f(x * -1.4426950408889634f)); }
__device__ __forceinline__ float tanhf_(float x) { return 1.0f - 2.0f * frcp(__builtin_amdgcn_exp2f(x * 2.8853900817779268f) + 1.0f); }
__device__ __forceinline__ float softplusf_(float x) { return fmaxf(x, 0.f) + __logf(1.0f + fexp(-fabsf(x))); }
__device__ __forceinline__ float wave_sum(float v) {
#pragma unroll
    for (int o = 1; o < 64; o <<= 1) v += __shfl_xor(v, o);
    return v;
}
template <int CTRL> __device__ __forceinline__ float dppmov(float v) { return __builtin_bit_cast(float, __builtin_amdgcn_update_dpp(0, __builtin_bit_cast(int, v), CTRL, 0xF, 0xF, true)); }
__device__ __forceinline__ float red8(float v) { v += dppmov<0xB1>(v); v += dppmov<0x4E>(v); v += dppmov<0x141>(v); return v; }
__device__ __forceinline__ float red16(float v) { v += dppmov<0xB1>(v); v += dppmov<0x4E>(v); v += dppmov<0x141>(v); v += dppmov<0x140>(v); return v; }

template <int CTRL, int RMASK> __device__ __forceinline__ float dppsh(float idv, float v) { return __builtin_bit_cast(float, __builtin_amdgcn_update_dpp(__builtin_bit_cast(int, idv), __builtin_bit_cast(int, v), CTRL, RMASK, 0xF, false)); }
template <int CTRL> __device__ __forceinline__ v4u dpp4(const v4u old, const v4u v) { v4u r;
    r.x = (unsigned)__builtin_amdgcn_update_dpp((int)old.x, (int)v.x, CTRL, 0xF, 0xF, false); r.y = (unsigned)__builtin_amdgcn_update_dpp((int)old.y, (int)v.y, CTRL, 0xF, 0xF, false);
    r.z = (unsigned)__builtin_amdgcn_update_dpp((int)old.z, (int)v.z, CTRL, 0xF, 0xF, false); r.w = (unsigned)__builtin_amdgcn_update_dpp((int)old.w, (int)v.w, CTRL, 0xF, 0xF, false); return r; }
__device__ __forceinline__ float wave_scan_add(float v) {
    v += dppsh<0x111, 0xF>(0.f, v); v += dppsh<0x112, 0xF>(0.f, v); v += dppsh<0x114, 0xF>(0.f, v); v += dppsh<0x118, 0xF>(0.f, v);
    v += dppsh<0x142, 0xA>(0.f, v); v += dppsh<0x143, 0xC>(0.f, v); return v;
}
__device__ __forceinline__ float wave_scan_max(float v) {
    const float ni = -3.0e38f;
    v = fmaxf(v, dppsh<0x111, 0xF>(ni, v)); v = fmaxf(v, dppsh<0x112, 0xF>(ni, v)); v = fmaxf(v, dppsh<0x114, 0xF>(ni, v)); v = fmaxf(v, dppsh<0x118, 0xF>(ni, v));
    v = fmaxf(v, dppsh<0x142, 0xA>(ni, v)); v = fmaxf(v, dppsh<0x143, 0xC>(ni, v)); return v;
}

#define XB_TMO      128
#define XB_XCNT(j)  (256  + 64 * (j))
#define XB_XSUB(j)  (1280 + 64 * (j))
#define XB_XGEN(j)  (2304 + 64 * (j))
#define XB_TOP      3328
#define XB_TOPGEN   3392
#define XCD_BAR_WORDS 3456
#define XB_SPIN_CAP (1u << 22)
__device__ __forceinline__ void mk_sync() { __builtin_amdgcn_fence(__ATOMIC_RELEASE, "workgroup"); __builtin_amdgcn_s_barrier(); __builtin_amdgcn_fence(__ATOMIC_ACQUIRE, "workgroup"); }
__device__ __forceinline__ unsigned xb_ld(unsigned* p)              { return __hip_atomic_load(p, __ATOMIC_RELAXED, __HIP_MEMORY_SCOPE_AGENT); }
__device__ __forceinline__ unsigned xb_add(unsigned* p, unsigned v) { return __hip_atomic_fetch_add(p, v, __ATOMIC_RELAXED, __HIP_MEMORY_SCOPE_AGENT); }
__device__ __forceinline__ unsigned xb_xcc_id() { return (unsigned)__builtin_amdgcn_s_getreg((3 << 11) | 20) & 0xFu; }
#define XB_SPIN(cond, bar) do { unsigned _sp = 0; while (cond) { __builtin_amdgcn_s_sleep(1); \
    if ((++_sp & 255u) == 0u) { if (xb_ld(&(bar)[XB_TMO])) break; if (_sp > XB_SPIN_CAP) { atomicAdd(&(bar)[XB_TMO], 1u); break; } } } } while (0)
struct XcdBarrier { unsigned* bar; unsigned x; volatile LAS unsigned* st; };
__device__ __forceinline__ XcdBarrier xcd_barrier_post(unsigned* bar, volatile LAS unsigned* st, bool leader) {
    XcdBarrier b; b.bar = bar; b.x = xb_xcc_id(); b.st = st;
    if (leader) (void)xb_add(&bar[XB_XCNT(b.x)], 1u);
    return b;
}
__device__ __forceinline__ void xcd_barrier_complete(unsigned* bar, unsigned x, unsigned& nloc, unsigned& nx) {
    const unsigned G = gridDim.x * gridDim.y * gridDim.z;
    unsigned sum, cnt, mine, sp = 0u;
    for (;;) {
        sum = 0u; cnt = 0u; mine = 0u;
#pragma unroll
        for (unsigned j = 0; j < 16; ++j) { const unsigned c = xb_ld(&bar[XB_XCNT(j)]); sum += c; cnt += (c > 0u) ? 1u : 0u; mine = (j == x) ? c : mine; }
        if (sum == G) break;
        __builtin_amdgcn_s_sleep(1);
        if ((++sp & 255u) == 0u) { if (xb_ld(&bar[XB_TMO])) break; if (sp > XB_SPIN_CAP) { atomicAdd(&bar[XB_TMO], 1u); break; } }
    }
    nloc = mine > 0u ? mine : 1u; nx = cnt > 0u ? cnt : 1u;
}
__device__ __forceinline__ void xcd_barrier(const XcdBarrier& b, bool leader) {
    asm volatile("s_waitcnt vmcnt(0)" ::: "memory");
    mk_sync();
    if (leader) {
        unsigned* bar = b.bar;
        __builtin_amdgcn_s_waitcnt(0);
        unsigned nloc = b.st[0], nx = b.st[1];
        if (nloc == 0u) { xcd_barrier_complete(bar, b.x, nloc, nx); b.st[0] = nloc; b.st[1] = nx; }
        const unsigned old = xb_add(&bar[XB_XSUB(b.x)], 1u);
        const unsigned gen = old / nloc;
        if (old + 1u == (gen + 1u) * nloc) {
            __builtin_amdgcn_fence(__ATOMIC_RELEASE, "agent");
            asm volatile("s_waitcnt vmcnt(0)" ::: "memory");
            const unsigned og = xb_add(&bar[XB_TOP], 1u);
            const unsigned tg = og / nx;
            if (og + 1u == (tg + 1u) * nx) xb_add(&bar[XB_TOPGEN], 1u);
            else XB_SPIN(xb_ld(&bar[XB_TOPGEN]) == tg, bar);
            __builtin_amdgcn_fence(__ATOMIC_ACQUIRE, "agent");
            xb_add(&bar[XB_XGEN(b.x)], 1u);
            asm volatile("s_waitcnt vmcnt(0)" ::: "memory");
        } else {
            XB_SPIN(xb_ld(&bar[XB_XGEN(b.x)]) == gen, bar);
            __builtin_amdgcn_fence(__ATOMIC_ACQUIRE, "agent");
            asm volatile("s_waitcnt vmcnt(0)" ::: "memory");
        }
    }
    mk_sync();
}

__device__ __forceinline__ int opaque_i(int v) { asm volatile("" : "+s"(v)); return v; }
#define LDS_BARRIER() do { asm volatile("s_waitcnt lgkmcnt(0)" ::: "memory"); __builtin_amdgcn_s_barrier(); asm volatile("" ::: "memory"); } while (0)
__device__ __forceinline__ int mk_lane_id() { int x; asm volatile("v_mbcnt_lo_u32_b32 %0, -1, 0\n\tv_mbcnt_hi_u32_b32 %0, -1, %0" : "=v"(x)); return x; }
struct Args { const float* in[26]; float* out; unsigned char* ws; int ph_lo, ph_hi; };

namespace pg8 {
struct PairPanelOrder {
    int c;
    __device__ bool next(int i, Unit& u) const { if (i >= 12) return false; u.pm = 2 * c + i / 6; u.pn = i % 6; return true; }
    __device__ __forceinline__ void a_ready(const Unit&) const {}
    __device__ __forceinline__ void done(const Unit&) const {}
};
struct PanelOrder {
    int c;
    __device__ bool next(int i, Unit& u) const { if (i >= 4) return false; u.pm = c; u.pn = i; return true; }
    __device__ __forceinline__ void a_ready(const Unit&) const {}
    __device__ __forceinline__ void done(const Unit&) const {}
};
struct EpiResid {
    static constexpr bool PERM = true, AFTER_DRAIN = false;
    bf16_t* XB; const float* rinv; float* ssqp;
    __device__ __forceinline__ void operator()(const f32x4 (&acc)[2][2][4][2], const Unit& u, int wr, int wc, int fr, int fq) const {
        const int row0 = u.pm * BM + wr * 64 + fr, col0 = u.pn * BM + wc * 32 + 8 * fq;
        const __amdgpu_buffer_rsrc_t xrr = wt_rsrc(XB);
#pragma unroll
        for (int ai = 0; ai < 2; ++ai) {
            u32x4 xin[4][2]; float ri[4];
#pragma unroll
            for (int m = 0; m < 4; ++m) { const int row = row0 + ai * HALF + m * 16; ri[m] = rinv[row];
#pragma unroll
                for (int bj = 0; bj < 2; ++bj) xin[m][bj] = *(const u32x4*)(XB + (size_t)row * DM + col0 + bj * HALF); }
            asm volatile("" ::: "memory");
#pragma unroll
            for (int m = 0; m < 4; ++m) { const int row = row0 + ai * HALF + m * 16; float ss = 0.f;
#pragma unroll
                for (int bj = 0; bj < 2; ++bj) { const size_t off = (size_t)row * DM + col0 + bj * HALF;
                    float xv[8]; unpack8(xin[m][bj], xv);
                    float v[8];
#pragma unroll
                    for (int j = 0; j < 4; ++j) { v[j] = acc[ai][bj][m][0][j] + xv[j] * ri[m]; v[4 + j] = acc[ai][bj][m][1][j] + xv[4 + j] * ri[m]; }
#pragma unroll
                    for (int j = 0; j < 8; ++j) ss += v[j] * v[j];
                    wt_store16(xrr, XB, off * 2, pack8(v)); }
                ss += __shfl_xor(ss, 16); ss += __shfl_xor(ss, 32);
                if (fq == 0) ssqp[(size_t)row * 16 + u.pn * 4 + wc] = ss; }
            asm volatile("" ::: "memory");
        }
    }
};
struct EpiScale {
    static constexpr bool PERM = true, AFTER_DRAIN = false;
    bf16_t* O; int ldc; const float* rs; int row_off;
    __device__ __forceinline__ void operator()(const f32x4 (&acc)[2][2][4][2], const Unit& u, int wr, int wc, int fr, int fq) const {
        const int row0 = u.pm * BM + wr * 64 + fr, col0 = u.pn * BM + wc * 32 + 8 * fq;
#pragma unroll
        for (int ai = 0; ai < 2; ++ai)
#pragma unroll
            for (int m = 0; m < 4; ++m) { const int row = row0 + ai * HALF + m * 16; const float s = rs[row_off + row]; bf16_t* rowp = O + (size_t)row * ldc + col0;
#pragma unroll
                for (int bj = 0; bj < 2; ++bj) { const f32x4 v0 = acc[ai][bj][m][0] * s, v1 = acc[ai][bj][m][1] * s;
                    u32x4 w; w.x = pk2(v0[0], v0[1]); w.y = pk2(v0[2], v0[3]); w.z = pk2(v1[0], v1[1]); w.w = pk2(v1[2], v1[3]); *(u32x4*)(rowp + bj * HALF) = w; } }
    }
};
struct EpiFfn {
    static constexpr bool PERM = true, AFTER_DRAIN = false;
    bf16_t* G; const float* rs; const float* cw; const float* cb; float* SA; float* SB; float* SL; LAS float* hal;
    __device__ __forceinline__ void operator()(const f32x4 (&acc)[2][2][4][2], const Unit& u, int wr, int wc, int fr, int fq) const {
        int chl = wc * 32 + 8 * fq; asm volatile("" : "+v"(chl));
        const int f0 = u.pn * 128 + chl, rowt = wr * 64 + fr;
        const __amdgpu_buffer_rsrc_t grr = wt_rsrc(G);
        float rsv[2][4];
#pragma unroll
        for (int ai = 0; ai < 2; ++ai)
#pragma unroll
            for (int m = 0; m < 4; ++m) rsv[ai][m] = rs[u.pm * BM + ai * HALF + m * 16 + rowt];
        const size_t sbase = ((size_t)(u.pm * 22 + u.pn) * 2) * 128 + chl;
        if (fr >= 14) {
#pragma unroll
            for (int ai = 0; ai < 2; ++ai) { const float r_ = rsv[ai][3]; const f32x4 v0 = acc[ai][0][3][0] * r_, v1 = acc[ai][0][3][1] * r_;
                LAS float* hp = hal + ((ai * 2 + wr) * 2 + (fr - 14)) * 128 + chl; *(LAS f32x4*)hp = v0; *(LAS f32x4*)(hp + 4) = v1;
                if (ai == 1 && wr == 1) { float* gp = SL + sbase + (fr - 14) * 128; *(f32x4*)gp = v0; *(f32x4*)(gp + 4) = v1; } }
        }
        if (wr == 0 && fr < 2) { const float r_ = rsv[0][0]; float* ga = SA + sbase + fr * 128; float* gb = SB + sbase + fr * 128;
            *(f32x4*)ga = acc[0][0][0][0] * r_; *(f32x4*)(ga + 4) = acc[0][0][0][1] * r_; *(f32x4*)gb = acc[0][1][0][0] * r_; *(f32x4*)(gb + 4) = acc[0][1][0][1] * r_; }
        asm volatile("s_waitcnt lgkmcnt(0)" ::: "memory"); __builtin_amdgcn_s_barrier(); asm volatile("" ::: "memory");
        float w0[8], w1[8], w2[8], bz[8];
        { const f32x4 a0 = *(const f32x4*)(cw + f0), a1 = *(const f32x4*)(cw + f0 + 4), b0 = *(const f32x4*)(cw + DFF + f0), b1 = *(const f32x4*)(cw + DFF + f0 + 4);
          const f32x4 c0 = *(const f32x4*)(cw + 2 * DFF + f0), c1 = *(const f32x4*)(cw + 2 * DFF + f0 + 4), d0 = *(const f32x4*)(cb + f0), d1 = *(const f32x4*)(cb + f0 + 4);
#pragma unroll
          for (int j = 0; j < 4; ++j) { w0[j] = a0[j]; w0[4 + j] = a1[j]; w1[j] = b0[j]; w1[4 + j] = b1[j]; w2[j] = c0[j]; w2[4 + j] = c1[j]; bz[j] = d0[j]; bz[4 + j] = d1[j]; } }
        const bool fr0 = (fr == 0), frl2 = (fr < 2); (void)fr0;
#pragma unroll
        for (int ai = 0; ai < 2; ++ai) {
            float ap[8];
            const int pb = ai * 2 + wr - 1;
#pragma unroll
            for (int m = 0; m < 4; ++m) {
                float av[8], bv[8], y1[8], y2[8];
                const float r_ = rsv[ai][m];
#pragma unroll
                for (int j = 0; j < 4; ++j) { av[j] = acc[ai][0][m][0][j] * r_; av[4 + j] = acc[ai][0][m][1][j] * r_; bv[j] = acc[ai][1][m][0][j] * r_; bv[4 + j] = acc[ai][1][m][1][j] * r_; }
                if (m == 0) {
                    if (pb >= 0) { const LAS float* h0 = hal + (pb * 2) * 128 + chl; const f32x4 h00 = *(const LAS f32x4*)h0, h01 = *(const LAS f32x4*)(h0 + 4), h10 = *(const LAS f32x4*)(h0 + 128), h11 = *(const LAS f32x4*)(h0 + 132);
#pragma unroll
                        for (int j = 0; j < 4; ++j) { y1[j] = h10[j]; y1[4 + j] = h11[j]; y2[j] = fr0 ? h00[j] : h10[j]; y2[4 + j] = fr0 ? h01[j] : h11[j]; } }
                    else {
#pragma unroll
                        for (int j = 0; j < 8; ++j) { y1[j] = 0.f; y2[j] = 0.f; } }
                } else {
#pragma unroll
                    for (int j = 0; j < 8; ++j) { y1[j] = dppmov<0x121>(ap[j]); y2[j] = dppmov<0x122>(ap[j]); }
                }
                float o[8];
#pragma unroll
                for (int j = 0; j < 8; ++j) { const float am1 = dppsh<0x111, 0xF>(y1[j], av[j]), am2 = dppsh<0x112, 0xF>(y2[j], av[j]);
                    const float z = bz[j] + w0[j] * am2 + w1[j] * am1 + w2[j] * av[j];
                    o[j] = z * sigmoidf_(z) * bv[j]; ap[j] = av[j]; }
                if (!(ai == 0 && m == 0 && wr == 0 && frl2)) wt_store16(grr, G, ((size_t)(u.pm * BM + ai * HALF + m * 16 + rowt) * DFF + f0) * 2, pack8(o));
            }
        }
    }
};
}

template <bool FFN_UP = false>
__device__ __forceinline__ void transpose_item(const float* W, int ldw, int K, bf16* WT, const float* kscale, LAS float* scr, int item, int nblk, int lane) {
    const int kb = item / nblk, nb = item % nblk, k0 = 64 * kb, n0 = 32 * nb;
    const int d0 = !FFN_UP ? n0 : (n0 < DFF ? ((n0 >> 7) * 256 + (n0 & 127)) : ((((n0 - DFF) >> 7) * 256) + 128 + ((n0 - DFF) & 127)));
#pragma unroll 8
    for (int i = 0; i < 32; ++i) { const int kk = 2 * i + (lane >> 5); const float s = kscale ? kscale[k0 + kk] : 1.0f; scr[kk * 33 + (lane & 31)] = W[(size_t)(k0 + kk) * ldw + n0 + (lane & 31)] * s; }
    asm volatile("s_waitcnt lgkmcnt(0)" ::: "memory");
    const int c = lane & 7;
#pragma unroll
    for (int j = 0; j < 4; ++j) { const int n = (lane >> 3) + 8 * j; const LAS float* s = scr + (8 * c) * 33 + n;
        v4u o; o.x = pk2(s[0 * 33], s[1 * 33]); o.y = pk2(s[2 * 33], s[3 * 33]); o.z = pk2(s[4 * 33], s[5 * 33]); o.w = pk2(s[6 * 33], s[7 * 33]);
        *(v4u*)(WT + (size_t)(d0 + n) * K + k0 + 8 * c) = o; }
    asm volatile("s_waitcnt lgkmcnt(0)" ::: "memory");
}

__device__ __forceinline__ float wave_red63(float v) {
    v += dppmov<0xB1>(v); v += dppmov<0x4E>(v); v += dppmov<0x141>(v); v += dppmov<0x140>(v);
    v += dppsh<0x142, 0xA>(0.f, v); v += dppsh<0x143, 0xC>(0.f, v); return v;
}
__device__ __forceinline__ float lane63(float v) { return __builtin_bit_cast(float, __builtin_amdgcn_readlane(__builtin_bit_cast(int, v), 63)); }
__device__ __forceinline__ void late_transposes(const Args& a, LAS unsigned char* lds, int lane, int wave, int gw, int NGW) {
    unsigned char* ws = a.ws; LAS float* scr = (LAS float*)(lds + wave * 16384);
    constexpr int I_UP = 16 * 176, I_DN = 44 * 32;
    for (int it = gw; it < I_UP + I_DN; it += NGW) {
        int r = it;
        if (r < I_UP) { transpose_item<true>(a.in[21], NUP, DM, (bf16*)(ws + WS_WT_UP), a.in[20], scr, r, 176, lane); continue; } r -= I_UP;
        transpose_item(a.in[24], DM, DFF, (bf16*)(ws + WS_WT_DN), nullptr, scr, r, 32, lane);
    }
}
__device__ __forceinline__ void phase_prep(const Args& a, LAS unsigned char* lds, int tid, int lane, int wave) {
    unsigned char* ws = a.ws;
    LAS float* scr = (LAS float*)(lds + wave * 16384);
    const int gw = blockIdx.x * 8 + wave, NGW = gridDim.x * 8;
    constexpr int I_IN = 16 * 104;
    constexpr int I_OUT0 = 16 * 32;
    for (int it = gw; it < I_IN + I_OUT0; it += NGW) {
        if (it < I_IN) transpose_item(a.in[2], NIN, DM, (bf16*)(ws + WS_WT_IN), a.in[1], scr, it, 104, lane);
        else transpose_item(a.in[19], DM, DM, (bf16*)(ws + WS_WT_OUT), nullptr, scr, it - I_IN, 32, lane);
    }
    {
        const float* wd = a.in[5]; const float* wa = a.in[7]; const float* wg = a.in[8]; bf16* WL = (bf16*)(ws + WS_WT_LORA);
        for (int idx = blockIdx.x * 512 + tid; idx < NLORA * KLORA; idx += gridDim.x * 512) {
            const int n = idx >> 8, k = idx & 255; float v = 0.f;
            if (n < 512) { if (k < 64) v = wd[k * 512 + n]; }
            else if (n < 1024) { if (k >= 64 && k < 128) v = wa[(k - 64) * 512 + (n - 512)]; }
            else { if (k >= 128) v = wg[(k - 128) * 512 + (n - 1024)]; }
            WL[idx] = (bf16)f2bf(v);
        }
    }
    {
        const float* x = a.in[0]; const float* g1 = a.in[1]; const float* w_in = a.in[2];
        bf16* XN = (bf16*)(ws + WS_XN); float* gates = (float*)(ws + WS_GATES); float* rinvp = (float*)(ws + WS_RINV);
        float wgt[16][8];
#pragma unroll
        for (int j = 0; j < 4; ++j)
#pragma unroll
            for (int e = 0; e < 4; ++e) { const int k = 4 * lane + 256 * j + e; const float g = g1[k];
                const f32x4 w0 = *(const f32x4*)(w_in + (size_t)k * NIN + 3328), w1 = *(const f32x4*)(w_in + (size_t)k * NIN + 3332);
                wgt[j * 4 + e][0] = w0[0] * g; wgt[j * 4 + e][1] = w0[1] * g; wgt[j * 4 + e][2] = w0[2] * g; wgt[j * 4 + e][3] = w0[3] * g;
                wgt[j * 4 + e][4] = w1[0] * g; wgt[j * 4 + e][5] = w1[1] * g; wgt[j * 4 + e][6] = w1[2] * g; wgt[j * 4 + e][7] = w1[3] * g; }
        f32x4 vn[4];
        { const f32x4* xr = (const f32x4*)(x + (size_t)gw * DM) + lane;
#pragma unroll
          for (int j = 0; j < 4; ++j) vn[j] = xr[64 * j]; }
        for (int row = gw; row < M; row += NGW) {
            f32x4 v[4];
#pragma unroll
            for (int j = 0; j < 4; ++j) v[j] = vn[j];
            { const int rn = (row + NGW < M) ? row + NGW : row; const f32x4* xr = (const f32x4*)(x + (size_t)rn * DM) + lane;
#pragma unroll
              for (int j = 0; j < 4; ++j) vn[j] = xr[64 * j]; }
            float ss = 0.f;
#pragma unroll
            for (int j = 0; j < 4; ++j) ss += (v[j][0] * v[j][0] + v[j][1] * v[j][1]) + (v[j][2] * v[j][2] + v[j][3] * v[j][3]);
            float gs[8];
#pragma unroll
            for (int jg = 0; jg < 8; ++jg) { float s_ = 0.f;
#pragma unroll
                for (int j = 0; j < 4; ++j)
#pragma unroll
                    for (int e = 0; e < 4; ++e) s_ += v[j][e] * wgt[j * 4 + e][jg];
                gs[jg] = s_; }
            ss = wave_red63(ss);
#pragma unroll
            for (int jg = 0; jg < 8; ++jg) gs[jg] = wave_red63(gs[jg]);
            const float ms = lane63(ss) * (1.0f / DM) + NORM_EPS; const float rs = frsq(ms);
            if (lane == 0) rinvp[row] = fsqrt_(ms);
            unsigned long long* o8 = (unsigned long long*)(XN + (size_t)row * DM) + lane;
#pragma unroll
            for (int j = 0; j < 4; ++j) o8[64 * j] = (unsigned long long)pk2(v[j][0] * rs, v[j][1] * rs) | ((unsigned long long)pk2(v[j][2] * rs, v[j][3] * rs) << 32);
            if (lane == 63) { f32x4* gp = (f32x4*)(gates + (size_t)row * 8); gp[0] = (f32x4){gs[0] * rs, gs[1] * rs, gs[2] * rs, gs[3] * rs}; gp[1] = (f32x4){gs[4] * rs, gs[5] * rs, gs[6] * rs, gs[7] * rs}; }
        }
    }
}

__device__ __forceinline__ void phase_lmat(const Args& a, int tid, int row_lo, int nrows) {
    unsigned char* ws = a.ws; const bf16* PROJ = (const bf16*)(ws + WS_PROJ); bf16* L = (bf16*)(ws + WS_LBUF); const float* mu = a.in[3];
    for (int it0 = tid; it0 < nrows * 32; it0 += 4 * 512) {
        v4u cur[4], prv[4];
#pragma unroll
        for (int u = 0; u < 4; ++u) { const int it = it0 + u * 512; const int row = row_lo + (it >> 5), c0 = 1536 + 8 * (it & 31);
            cur[u] = *(const v4u*)(PROJ + (size_t)row * NPROJ + c0);
            prv[u] = (v4u){0u, 0u, 0u, 0u}; if ((row & (SEQ - 1)) != 0) prv[u] = *(const v4u*)(PROJ + (size_t)(row - 1) * NPROJ + c0); }
#pragma unroll
        for (int u = 0; u < 4; ++u) { const int it = it0 + u * 512; const int row = row_lo + (it >> 5), grp = it & 31, c0 = 1536 + 8 * grp;
            const f32x4 m0 = *(const f32x4*)(mu + c0), m1 = *(const f32x4*)(mu + c0 + 4);
            float c[8], p[8], o[8]; unpack8(cur[u], c); unpack8(prv[u], p);
#pragma unroll
            for (int e = 0; e < 8; ++e) { const float mm = e < 4 ? m0[e & 3] : m1[e & 3]; const float xv = c[e] + (p[e] - c[e]) * mm;
                o[e] = grp < 8 ? tanhf_(xv) : (grp < 16 ? xv : sigmoidf_(xv)); }
            *(v4u*)(L + (size_t)row * KLORA + 8 * grp) = pack8(o); }
    }
}

constexpr int RK_SLOT = 64 * 64;
__device__ __forceinline__ int rk_off(int row, int col) { return row * 64 + ((((col >> 3) ^ row) & 7) << 3) + (col & 7); }
__device__ __forceinline__ f32x4 mfma16(const bf16x8 a, const bf16x8 b, const f32x4 c) { return __builtin_amdgcn_mfma_f32_16x16x32_bf16(a, b, c, 0, 0, 0); }
__device__ __forceinline__ void rk_frag(bf16x8 (&f)[2], const LAS bf16* base, int row0, int l15, int l4) { const LAS bf16* p = base + (row0 + l15) * 64; f[0] = *(const LAS bf16x8*)(p + ((l4 ^ (l15 & 7)) << 3)); f[1] = *(const LAS bf16x8*)(p + (((4 + l4) ^ (l15 & 7)) << 3)); }
struct RkF2 { bf16x8 f[2][2]; };
struct RkLane { int lo, so, l15, l4, to; };
__device__ __forceinline__ int rk_offT(int row, int col) { return row * 64 + ((((col >> 3) ^ ((row & 3) | ((row >> 1) & 4))) & 7) << 3) + (col & 7); }
__device__ __forceinline__ RkLane rk_lane(int lane) { asm volatile("" : "+v"(lane)); const int l15 = lane & 15, l4 = lane >> 4; RkLane r; r.l15 = l15; r.l4 = l4; r.lo = l15 * 64 + ((l4 ^ (l15 & 7)) << 3); r.so = l15 * 64 + ((((l4 >> 1) ^ (l15 & 7))) << 3) + 4 * (l4 & 1);
    r.to = rk_offT(8 * l4 + (l15 >> 2), 4 * (l15 & 3)); return r; }
typedef short s16x4_t __attribute__((ext_vector_type(4)));
__device__ __forceinline__ RkF2 rk_ld2_tr(const LAS bf16* base, int blk, const RkLane& L) { RkF2 r;
#pragma unroll
    for (int ti = 0; ti < 2; ++ti)
#pragma unroll
        for (int kh = 0; kh < 2; ++kh) { const LAS bf16* p = base + (L.to ^ ((4 * blk + 2 * ti) << 3)) + 32 * kh * 64;
            const s16x4_t a = __builtin_amdgcn_ds_read_tr16_b64_v4i16((LAS s16x4_t*)p), b = __builtin_amdgcn_ds_read_tr16_b64_v4i16((LAS s16x4_t*)(p + 4 * 64));
            r.f[ti][kh] = (bf16x8){a.x, a.y, a.z, a.w, b.x, b.y, b.z, b.w}; }
    return r; }
__device__ __forceinline__ RkF2 rk_ld2(const LAS bf16* base, int blk, const RkLane& L) { RkF2 r;
#pragma unroll
    for (int ti = 0; ti < 2; ++ti) { const int i0 = (32 * blk + 16 * ti) * 64 + L.lo; r.f[ti][0] = *(const LAS bf16x8*)(base + i0); r.f[ti][1] = *(const LAS bf16x8*)(base + (i0 ^ 32)); }
    return r; }
template <bool ACC> __device__ __forceinline__ void rk_mm2(f32x4 (&acc)[2][2], const RkF2& a, const RkF2& b) {
#pragma unroll
    for (int mi = 0; mi < 2; ++mi)
#pragma unroll
        for (int ni = 0; ni < 2; ++ni) { f32x4 c = ACC ? acc[mi][ni] : (f32x4){0.f, 0.f, 0.f, 0.f}; c = mfma16(a.f[mi][0], b.f[ni][0], c); acc[mi][ni] = mfma16(a.f[mi][1], b.f[ni][1], c); }
}
__device__ __forceinline__ void rk_store2(LAS bf16* dst, const f32x4 (&acc)[2][2], int mB, int nB, const RkLane& L) {
#pragma unroll
    for (int mi = 0; mi < 2; ++mi)
#pragma unroll
        for (int ni = 0; ni < 2; ++ni) { v2u w; w.x = pk2(acc[mi][ni][0], acc[mi][ni][1]); w.y = pk2(acc[mi][ni][2], acc[mi][ni][3]); *(LAS v2u*)(dst + (16 * (2 * nB + ni)) * 64 + (L.so ^ (16 * (2 * mB + mi)))) = w; }
}
template <int MODE> __device__ __forceinline__ void rk_mask2(f32x4 (&d)[2][2], int mB, int nB, int l15, int l4) {
#pragma unroll
    for (int mi = 0; mi < 2; ++mi)
#pragma unroll
        for (int ni = 0; ni < 2; ++ni) { const int mt = 2 * mB + mi, nt = 2 * nB + ni;
            const bool zero = MODE == 1 ? (mt < nt) : (mt > nt);
            if (zero) d[mi][ni] = (f32x4){0.f, 0.f, 0.f, 0.f};
            else if (mt == nt) {
#pragma unroll
                for (int r = 0; r < 4; ++r) { const int m_ = 4 * l4 + r; const bool keep = MODE == 0 ? (m_ < l15) : MODE == 1 ? (l15 < m_) : (m_ <= l15); d[mi][ni][r] = keep ? d[mi][ni][r] : 0.f; } } }
}
template <int DBG = 0> __device__ __forceinline__ void rwkv_unit_split(const Args& a, LAS unsigned char* lds, int unit, int tid, int lane, int wave) {
    unsigned char* ws = a.ws; const bf16* PROJ = (const bf16*)(ws + WS_PROJ); const bf16* DAG = (const bf16*)(ws + WS_DAG); bf16* MIX = (bf16*)(ws + WS_MIX);
    const int b = unit >> 3, h = unit & 7;
    LAS bf16* slot = (LAS bf16*)lds;
#define RK_S(k) (slot + (k) * RK_SLOT)
    LAS bf16* Ab = RK_S(0); LAS bf16* Bb = RK_S(1); LAS bf16* Kb = RK_S(2); LAS bf16* Rb = RK_S(3); LAS bf16* KhT = RK_S(4);
    LAS bf16* P0 = RK_S(7); LAS bf16* P0T = RK_S(8); LAS float* Yl = (LAS float*)RK_S(7);
    LAS bf16* Aak = RK_S(9); LAS bf16* Ut = RK_S(9); LAS bf16* Arb = RK_S(10); LAS bf16* Ark = RK_S(11); LAS bf16* TA = RK_S(12); LAS bf16* TB = RK_S(13); LAS bf16* Xt = RK_S(14); LAS bf16* Sb = RK_S(15);
    LAS float* g63 = (LAS float*)RK_S(18); LAS float* bon = g63 + 128; LAS float* ssP = bon + 128; LAS float* bnP = ssP + 256; LAS float* cst = bnP + 256;
    const int wq = wave & 3;
    { int t_ = tid; asm volatile("" : "+v"(t_));
      if (t_ < 64) { const int j = h * 64 + t_;
        cst[t_] = a.in[3][j]; cst[64 + t_] = a.in[3][512 + j]; cst[128 + t_] = a.in[3][1024 + j]; cst[192 + t_] = a.in[9][j]; cst[256 + t_] = a.in[10][j];
        cst[320 + t_] = a.in[11][j]; cst[384 + t_] = a.in[4][j]; cst[448 + t_] = a.in[6][j]; cst[512 + t_] = a.in[12][j]; cst[576 + t_] = a.in[13][j]; }
      for (int i = t_; i < RK_SLOT / 2; i += 512) ((LAS unsigned*)Sb)[i] = 0u; }
    if (wave < 4) {
        const int jw = 16 * wq;
        v4u g_rc[2], g_kc[2], g_vc[2], g_rp[2], g_kp[2], g_vp[2], g_ld[2], g_a[2];
#define RKS_LOAD(c_, PART) do { int ln_ = lane; asm volatile("" : "+v"(ln_)); const int t_ = b * SEQ + (c_) * 64 + ln_; const bf16* pr_ = PROJ + (size_t)t_ * NPROJ + h * 64 + jw; const bf16* dg_ = DAG + (size_t)t_ * NLORA + h * 64 + jw; \
        _Pragma("unroll") for (int hh = 0; hh < 2; ++hh) { \
            if ((PART) == 0) { g_rc[hh] = *(const v4u*)(pr_ + 8 * hh); g_kc[hh] = *(const v4u*)(pr_ + 512 + 8 * hh); } \
            if ((PART) == 1) { g_vc[hh] = *(const v4u*)(pr_ + 1024 + 8 * hh); g_ld[hh] = *(const v4u*)(dg_ + 8 * hh); } \
            if ((PART) == 2) { g_a[hh] = *(const v4u*)(dg_ + 512 + 8 * hh); \
                if ((c_) == 0 && ln_ == 0) g_rp[hh] = (v4u){0u, 0u, 0u, 0u}; else g_rp[hh] = *(const v4u*)(pr_ - NPROJ + 8 * hh); } \
            if ((PART) == 3) { if ((c_) == 0 && ln_ == 0) { g_kp[hh] = (v4u){0u, 0u, 0u, 0u}; g_vp[hh] = g_kp[hh]; } \
                else { g_kp[hh] = *(const v4u*)(pr_ - NPROJ + 512 + 8 * hh); g_vp[hh] = *(const v4u*)(pr_ - NPROJ + 1024 + 8 * hh); } } } } while (0)
        RKS_LOAD(0, 0); RKS_LOAD(0, 1); RKS_LOAD(0, 2); RKS_LOAD(0, 3);
        LDS_BARRIER();
#ifdef PROBE_SEG_A
        unsigned long long seg_acc = 0, seg_t0 = 0; bool seg_on = false;
#define SEGT(k) do { if ((k) == PROBE_SEG_B && seg_on) { seg_acc += __builtin_amdgcn_s_memrealtime() - seg_t0; seg_on = false; } if ((k) == PROBE_SEG_A) { seg_t0 = __builtin_amdgcn_s_memrealtime(); seg_on = true; } } while (0)
#else
#define SEGT(k) do { } while (0)
#endif
        for (int it = 0; it <= SEQ / 64; ++it) {
            const bool act = DBG != 1 && it < SEQ / 64; const int p = it & 1;
            LAS bf16* BhTp = RK_S(5 + 11 * p); LAS bf16* Vtp = RK_S(6 + 11 * p);
            float rr[2][8], km[2][8], av[2][8], lgw[2][8], kkr[2][8];
            v4u pA[2], pR[2], pB[2], pK[2], pKh[2];
            LDS_BARRIER();
            SEGT(10); SEGT(0);
            if (act) {
                int ln = lane; asm volatile("" : "+v"(ln));
                asm volatile("" : "+v"(g_rc[0]), "+v"(g_rc[1]), "+v"(g_kc[0]), "+v"(g_kc[1]), "+v"(g_vc[0]), "+v"(g_vc[1]), "+v"(g_rp[0]), "+v"(g_rp[1]), "+v"(g_kp[0]), "+v"(g_kp[1]), "+v"(g_vp[0]), "+v"(g_vp[1]), "+v"(g_ld[0]), "+v"(g_ld[1]), "+v"(g_a[0]), "+v"(g_a[1]));
                float ss = 0.f, bonus = 0.f;
#pragma unroll
                for (int hh = 0; hh < 2; ++hh) { float rc[8], kc[8], vc[8], rp_[8], kp[8], vp[8], ldv[8], vo[8];
                    unpack8(g_rc[hh], rc); unpack8(g_kc[hh], kc); unpack8(g_vc[hh], vc); unpack8(g_rp[hh], rp_); unpack8(g_kp[hh], kp); unpack8(g_vp[hh], vp); unpack8(g_ld[hh], ldv); unpack8(g_a[hh], av[hh]);
#pragma unroll
                    for (int e = 0; e < 8; ++e) { const int j = jw + 8 * hh + e;
                        rr[hh][e] = rc[e] + (rp_[e] - rc[e]) * cst[j]; const float k = kc[e] + (kp[e] - kc[e]) * cst[64 + j]; const float v = vc[e] + (vp[e] - vc[e]) * cst[128 + j];
                        kkr[hh][e] = k * cst[192 + j]; ss += kkr[hh][e] * kkr[hh][e];
                        av[hh][e] = sigmoidf_(cst[448 + j] + av[hh][e]);
                        lgw[hh][e] = -0.6065306597f * sigmoidf_(cst[384 + j] + ldv[e]);
                        km[hh][e] = k * (1.0f + (av[hh][e] - 1.0f) * cst[256 + j]);
                        bonus += rr[hh][e] * km[hh][e] * cst[320 + j];
                        vo[e] = v; }
                    *(LAS v4u*)(Vtp + rk_offT(ln, jw + 8 * hh)) = pack8(vo); }
                ssP[ln * 4 + wq] = ss; bnP[ln * 4 + wq] = bonus;
            }
            LDS_BARRIER();
            SEGT(1);
            if (act) {
                int ln = lane; asm volatile("" : "+v"(ln));
                const f32x4 s4 = *(const LAS f32x4*)(ssP + ln * 4), b4 = *(const LAS f32x4*)(bnP + ln * 4);
                const float ss = (s4[0] + s4[1]) + (s4[2] + s4[3]);
                if (wq == 0) bon[64 * p + ln] = (b4[0] + b4[1]) + (b4[2] + b4[3]);
                const float inv = frcp(fmaxf(fsqrt_(ss), 1e-12f));
#pragma unroll
                for (int hh = 0; hh < 2; ++hh) { float lw[8], oA[8], oB[8], oK[8], oR[8], oBh[8], oKh[8], e63[8];
#pragma unroll
                    for (int e = 0; e < 8; ++e) lw[e] = wave_scan_add(lgw[hh][e]);
#pragma unroll
                    for (int e = 0; e < 8; ++e) { const float l63 = __builtin_bit_cast(float, __builtin_amdgcn_readlane(__builtin_bit_cast(int, lw[e]), 63));
                        const float eP = fexp(lw[e] - lgw[hh][e]), eM = fexp(-lw[e]), eL = fexp(lw[e]); e63[e] = fexp(l63); const float eH = e63[e] * eM;
                        const float kk = kkr[hh][e] * inv, bb = kk * av[hh][e];
                        oA[e] = -kk * eP; oB[e] = bb * eM; oK[e] = km[hh][e] * eM; oR[e] = rr[hh][e] * eL; oBh[e] = bb * eH; oKh[e] = km[hh][e] * eH; }
                    pA[hh] = pack8(oA); pB[hh] = pack8(oB); pK[hh] = pack8(oK); pR[hh] = pack8(oR); pKh[hh] = pack8(oKh);
                    *(LAS v4u*)(BhTp + rk_offT(ln, jw + 8 * hh)) = pack8(oBh);
                    if (ln == 63) { LAS float* gp = g63 + 64 * p + jw + 8 * hh; *(LAS f32x4*)gp = (f32x4){e63[0], e63[1], e63[2], e63[3]}; *(LAS f32x4*)(gp + 4) = (f32x4){e63[4], e63[5], e63[6], e63[7]}; } }
            }
            LDS_BARRIER();
            SEGT(2);
            if (act) {
                if (it + 1 < SEQ / 64) RKS_LOAD(it + 1, 0);
                int ln = lane; asm volatile("" : "+v"(ln));
#pragma unroll
                for (int hh = 0; hh < 2; ++hh) { const int ro = rk_off(ln, jw + 8 * hh); *(LAS v4u*)(Ab + ro) = pA[hh]; *(LAS v4u*)(Rb + ro) = pR[hh];
                    *(LAS v4u*)(KhT + rk_offT(ln, jw + 8 * hh)) = pKh[hh]; }
            }
            LDS_BARRIER(); SEGT(3); if (act && it + 1 < SEQ / 64) RKS_LOAD(it + 1, 1);
            LDS_BARRIER(); SEGT(4); if (act && it + 1 < SEQ / 64) RKS_LOAD(it + 1, 2);
            LDS_BARRIER(); SEGT(5); if (act && it + 1 < SEQ / 64) RKS_LOAD(it + 1, 3);
            LDS_BARRIER(); SEGT(6); LDS_BARRIER(); SEGT(7); LDS_BARRIER(); SEGT(8);
            if (act) {
                int ln = lane; asm volatile("" : "+v"(ln));
#pragma unroll
                for (int hh = 0; hh < 2; ++hh) { const int ro = rk_off(ln, jw + 8 * hh); *(LAS v4u*)(Bb + ro) = pB[hh]; *(LAS v4u*)(Kb + ro) = pK[hh]; }
            }
            LDS_BARRIER();
            SEGT(9);
        }
#ifdef PROBE_SEG_A
        if (DBG == 0 && blockIdx.x == 0 && tid == 0) ((unsigned long long*)(ws + WS_CTL + 512 * 1024))[24] = seg_acc;
#endif
#undef RKS_LOAD
    } else {
        const int mB = wq & 1, nB = wq >> 1;
        const int ltid = tid - 256;
        f32x4 sacc[2][2], tacc[2][2], yacc[2][2];
#pragma unroll
        for (int i = 0; i < 2; ++i)
#pragma unroll
            for (int j = 0; j < 2; ++j) { sacc[i][j] = (f32x4){0.f, 0.f, 0.f, 0.f}; tacc[i][j] = sacc[i][j]; yacc[i][j] = sacc[i][j]; }
        v4u g_g0 = {0u, 0u, 0u, 0u}, g_g1 = g_g0, pend0 = g_g0, pend1 = g_g0; bf16* pend_p = DBG ? (bf16*)(ws + WS_END) : MIX;
#define RKV_LOADG(c_) do { int lt_ = ltid; asm volatile("" : "+v"(lt_)); const bf16* gp_ = DAG + (size_t)(b * SEQ + (c_) * 64 + (lt_ >> 2)) * NLORA + 1024 + h * 64 + 16 * (lt_ & 3); g_g0 = *(const v4u*)gp_; g_g1 = *(const v4u*)(gp_ + 8); } while (0)
        LDS_BARRIER();
        for (int it = 0; it <= SEQ / 64; ++it) {
            const int ch = it - 1; const bool act = DBG != 2 && it >= 1; const int p = ch & 1;
            const LAS bf16* BhTp = RK_S(5 + 11 * p); const LAS bf16* Vtp = RK_S(6 + 11 * p);
            LDS_BARRIER();
            if (act) {
                const RkLane L = rk_lane(lane);
                if (ch > 0) { *(v4u*)pend_p = pend0; *(v4u*)(pend_p + 8) = pend1; }
                RKV_LOADG(ch);
                const RkF2 aB = rk_ld2(Bb, mB, L), bA = rk_ld2(Ab, nB, L);
                {
                    const RkF2 aA = rk_ld2(Ab, mB, L), bB = rk_ld2(Bb, nB, L);
                    f32x4 d[2][2], d2[2][2];
                    rk_mm2<false>(d, aB, bA); rk_mm2<false>(d2, aA, bB);
                    rk_mask2<0>(d, mB, nB, L.l15, L.l4);
#pragma unroll
                    for (int mi = 0; mi < 2; ++mi)
#pragma unroll
                        for (int ni = 0; ni < 2; ++ni)
#pragma unroll
                            for (int r = 0; r < 4; ++r) tacc[mi][ni][r] = d[mi][ni][r] + ((2 * mB + mi == 2 * nB + ni && 4 * L.l4 + r == L.l15) ? 1.f : 0.f);
                    rk_mask2<1>(d2, mB, nB, L.l15, L.l4);
                    rk_store2(P0, d, mB, nB, L); rk_store2(TA, tacc, mB, nB, L); rk_store2(P0T, d2, mB, nB, L);
                }
                asm volatile("" ::: "memory");
                {
                    const RkF2 aK = rk_ld2(Kb, mB, L), bR = rk_ld2(Rb, nB, L);
                    f32x4 d3[2][2], d4[2][2], d5[2][2];
                    rk_mm2<false>(d3, aK, bA); rk_mm2<false>(d4, aB, bR); rk_mm2<false>(d5, aK, bR);
                    rk_mask2<0>(d3, mB, nB, L.l15, L.l4); rk_mask2<2>(d4, mB, nB, L.l15, L.l4); rk_mask2<2>(d5, mB, nB, L.l15, L.l4);
                    rk_store2(Aak, d3, mB, nB, L); rk_store2(Arb, d4, mB, nB, L); rk_store2(Ark, d5, mB, nB, L);
                }
            }
            LDS_BARRIER();
            if (act) {
                const RkLane L = rk_lane(lane);
                {
                    const RkF2 aPT = rk_ld2(P0T, mB, L), aP = rk_ld2(P0, mB, L), bP = rk_ld2(P0, nB, L), bPT = rk_ld2(P0T, nB, L);
                    f32x4 d[2][2], d2[2][2]; rk_mm2<false>(d, aPT, bP); rk_mm2<false>(d2, aP, bPT);
                    rk_store2(Bb  , d, mB, nB, L); rk_store2(Kb  , d2, mB, nB, L);
                }
                asm volatile("" ::: "memory");
                const RkF2 bV = rk_ld2_tr(Vtp, nB, L);
                {
                    const RkF2 aA = rk_ld2(Ab, mB, L), aAk = rk_ld2(Aak, mB, L), bS = rk_ld2(Sb, nB, L), aKh = rk_ld2_tr(KhT, mB, L);
                    f32x4 d3[2][2]; rk_mm2<false>(d3, aA, bS); rk_mm2<true>(d3, aAk, bV);
#pragma unroll
                    for (int mi = 0; mi < 2; ++mi)
#pragma unroll
                        for (int r = 0; r < 4; ++r) { const float g_ = g63[64 * p + 16 * (2 * mB + mi) + 4 * L.l4 + r]; sacc[mi][0][r] *= g_; sacc[mi][1][r] *= g_; }
                    rk_mm2<true>(sacc, aKh, bV);
                    rk_store2(Xt, d3, mB, nB, L);
                }
                asm volatile("" ::: "memory");
                {
                    const RkF2 aS = rk_ld2(Sb, mB, L), aV = rk_ld2_tr(Vtp, mB, L), bR = rk_ld2(Rb, nB, L), bArk = rk_ld2(Ark, nB, L);
                    rk_mm2<false>(yacc, aS, bR); rk_mm2<true>(yacc, aV, bArk);
                }
            }
            LDS_BARRIER();
#define RKV_DOUBLE(PK, PKT, TIN, TOUT, PN, PNT) if (act && DBG != 4) { const RkLane L = rk_lane(lane); const RkF2 aPT = rk_ld2(PKT, mB, L), aP = rk_ld2(PK, mB, L); \
              const RkF2 bT = rk_ld2(TIN, nB, L), bP = rk_ld2(PK, nB, L), bPT = rk_ld2(PKT, nB, L); \
              f32x4 d[2][2], d2[2][2]; rk_mm2<true>(tacc, aPT, bT); rk_mm2<false>(d, aPT, bP); rk_mm2<false>(d2, aP, bPT); \
              rk_store2(TOUT, tacc, mB, nB, L); rk_store2(PN, d, mB, nB, L); rk_store2(PNT, d2, mB, nB, L); }
            RKV_DOUBLE(Bb, Kb, TA, TB, P0, P0T)
            LDS_BARRIER();
            RKV_DOUBLE(P0, P0T, TB, TA, Bb, Kb)
            LDS_BARRIER();
            RKV_DOUBLE(Bb, Kb, TA, TB, P0, P0T)
            LDS_BARRIER();
            if (act && DBG != 4) { const RkLane L = rk_lane(lane); const RkF2 aPT = rk_ld2(P0T, mB, L), aP = rk_ld2(P0, mB, L); const RkF2 bT = rk_ld2(TB, nB, L), bPT = rk_ld2(P0T, nB, L);
                f32x4 d2[2][2]; rk_mm2<true>(tacc, aPT, bT); rk_mm2<false>(d2, aP, bPT); rk_store2(TA, tacc, mB, nB, L); rk_store2(Kb  , d2, mB, nB, L); }
            LDS_BARRIER();
            if (act && DBG != 4) { const RkLane L = rk_lane(lane); const RkF2 aPT = rk_ld2(Kb, mB, L); const RkF2 bT = rk_ld2(TA, nB, L); rk_mm2<true>(tacc, aPT, bT); rk_store2(TB, tacc, mB, nB, L); }
            LDS_BARRIER();
            if (act) { const RkLane L = rk_lane(lane); const RkF2 aT = rk_ld2(TB, mB, L); const RkF2 bX = rk_ld2(Xt, nB, L); f32x4 d[2][2]; rk_mm2<false>(d, aT, bX); rk_store2(Ut, d, mB, nB, L); }
            LDS_BARRIER();
            if (act) {
                const RkLane L = rk_lane(lane);
                const RkF2 aU = rk_ld2(Ut, mB, L), aBh = rk_ld2_tr(BhTp, mB, L); const RkF2 bArb = rk_ld2(Arb, nB, L), bU = rk_ld2(Ut, nB, L);
                rk_mm2<true>(yacc, aU, bArb); rk_mm2<true>(sacc, aBh, bU);
#pragma unroll
                for (int mi = 0; mi < 2; ++mi)
#pragma unroll
                    for (int ni = 0; ni < 2; ++ni) *(LAS f32x4*)(Yl + (16 * (2 * nB + ni) + L.l15) * 64 + (((4 * (2 * mB + mi) + L.l4) ^ (L.l15 & 7)) << 2)) = yacc[mi][ni];
                rk_store2(Sb, sacc, mB, nB, L);
            }
            LDS_BARRIER();
            if (act) {
                int lt_ = ltid; asm volatile("" : "+v"(lt_)); const int tt = lt_ >> 2, c4 = lt_ & 3;
                const int t = b * SEQ + ch * 64 + tt, j0 = 16 * c4;
                float y[16], gv[16]; float s1 = 0.f;
#pragma unroll
                for (int k = 0; k < 4; ++k) { const f32x4 yv = *(const LAS f32x4*)(Yl + tt * 64 + (((4 * c4 + k) ^ (tt & 7)) << 2)); y[4 * k] = yv[0]; y[4 * k + 1] = yv[1]; y[4 * k + 2] = yv[2]; y[4 * k + 3] = yv[3]; s1 += (yv[0] + yv[1]) + (yv[2] + yv[3]); }
                s1 += dppmov<0xB1>(s1); s1 += dppmov<0x4E>(s1); const float mean = s1 * (1.0f / 64.0f); float s2 = 0.f;
#pragma unroll
                for (int e = 0; e < 16; ++e) { const float dd = y[e] - mean; s2 += dd * dd; }
                s2 += dppmov<0xB1>(s2); s2 += dppmov<0x4E>(s2); const float rstd = frsq(s2 * (1.0f / 64.0f) + LNX_EPS);
                { float g0[8], g1[8]; unpack8(g_g0, g0); unpack8(g_g1, g1);
#pragma unroll
                  for (int e = 0; e < 8; ++e) { gv[e] = g0[e]; gv[8 + e] = g1[e]; } }
                const float bonus = bon[64 * p + tt]; float ov[16];
                float vv[16]; { float v0[8], v1[8]; unpack8(*(const LAS v4u*)(Vtp + rk_offT(tt, j0)), v0); unpack8(*(const LAS v4u*)(Vtp + rk_offT(tt, j0 + 8)), v1);
#pragma unroll
                  for (int e = 0; e < 8; ++e) { vv[e] = v0[e]; vv[8 + e] = v1[e]; } }
#pragma unroll
                for (int e = 0; e < 16; ++e) { const float yn = (y[e] - mean) * rstd * cst[512 + j0 + e] + cst[576 + j0 + e]; ov[e] = (yn + bonus * vv[e]) * gv[e]; }
                { float o0[8], o1[8];
#pragma unroll
                  for (int e = 0; e < 8; ++e) { o0[e] = ov[e]; o1[e] = ov[8 + e]; }
                  pend0 = pack8(o0); pend1 = pack8(o1); pend_p = DBG ? (bf16*)(ws + WS_END) + ((size_t)blockIdx.x * 256 + lt_) * 16 : MIX + (size_t)t * DM + h * 64 + j0; }
            }
        }
        *(v4u*)pend_p = pend0; *(v4u*)(pend_p + 8) = pend1;
#undef RKV_DOUBLE
#undef RKV_LOADG
    }
    LDS_BARRIER();
#undef RK_S
}

template <int DBG = 0> __device__ __forceinline__ void mlstm_unit_split(const Args& a, LAS unsigned char* lds, int unit, int tid, int lane, int wave) {
    unsigned char* ws = a.ws; const bf16* PROJ = (const bf16*)(ws + WS_PROJ); const float* gates = (const float*)(ws + WS_GATES); bf16* MIX = (bf16*)(ws + WS_MIX);
    const int b = unit >> 2, hm = unit & 3;
    constexpr int LD = 72, A64 = 64 * LD, A128 = 128 * LD;
    LAS bf16* Qb = (LAS bf16*)lds;
    LAS bf16* Kb_ = Qb + 2 * A64;
    LAS bf16* Kwb = Kb_ + 2 * A64;
    LAS bf16* Vtb = Kwb + 2 * A64;
    LAS bf16* Sm = Vtb + 2 * A128;
    LAS bf16* Ct = Sm + A64;
    LAS float* Hl = (LAS float*)(Ct + A128);
    LAS float* gar = Hl + 64 * 132;
    LAS float* decp = gar + 512; LAS float* den = decp + 4; LAS float* nvec = den + 64; LAS float* cwl = nvec + 64; LAS float* cbl = cwl + 512; LAS float* mhl = cbl + 128;
    { int t_ = tid; asm volatile("" : "+v"(t_));
      for (int i = t_; i < A128 / 2; i += 512) ((LAS unsigned*)Ct)[i] = 0u;
      if (t_ < 64) nvec[t_] = 0.f;
      if (t_ < 128) mhl[t_] = a.in[18][hm * 128 + t_];
      for (int i = t_; i < 640; i += 512) { const int j = i >> 7, c_ = i & 127; const int src = (c_ < 64) ? (hm * 64 + c_) : (256 + hm * 64 + (c_ - 64)); if (j < 4) cwl[i] = a.in[14][j * 512 + src]; else cbl[c_] = a.in[15][src]; } }
    const int wq = wave & 3;
    if (wave < 4) {
        const float ibias = a.in[16][hm], fbias = a.in[17][hm];
        v4u n_q[2], n_k[2], n_v[4]; float n_gi = 0.f, n_gf = 0.f;
        v4u p_q[2] = {{0u, 0u, 0u, 0u}, {0u, 0u, 0u, 0u}}, p_k[2] = {{0u, 0u, 0u, 0u}, {0u, 0u, 0u, 0u}};
#define MLS_LOAD(c_, PART) do { int ln_ = lane; asm volatile("" : "+v"(ln_)); const int t_ = b * SEQ + (c_) * 64 + ln_; \
        if ((PART) < 2) { const bf16* pr_ = PROJ + (size_t)t_ * NPROJ + hm * 64 + 16 * wq + 8 * (PART); n_q[PART] = *(const v4u*)(pr_ + C_Q); n_k[PART] = *(const v4u*)(pr_ + C_K); } \
        else { const bf16* pv_ = PROJ + (size_t)t_ * NPROJ + C_V + hm * 128 + 32 * wq; _Pragma("unroll") for (int q = 0; q < 4; ++q) n_v[q] = *(const v4u*)(pv_ + 8 * q); \
               n_gi = gates[(size_t)t_ * 8 + hm]; n_gf = gates[(size_t)t_ * 8 + 4 + hm]; } } while (0)
        MLS_LOAD(0, 0); MLS_LOAD(0, 1); MLS_LOAD(0, 2);
        LDS_BARRIER();
        float m_run = 0.f;
#ifdef PROBE_MSEG_A
        unsigned long long mseg_acc = 0, mseg_t0 = 0; bool mseg_on = false;
#define MSEGT(k) do { if ((k) == PROBE_MSEG_B && mseg_on) { mseg_acc += __builtin_amdgcn_s_memrealtime() - mseg_t0; mseg_on = false; } if ((k) == PROBE_MSEG_A) { mseg_t0 = __builtin_amdgcn_s_memrealtime(); mseg_on = true; } } while (0)
#else
#define MSEGT(k) do { } while (0)
#endif
        for (int it = 0; it <= SEQ / 64; ++it) {
            const bool act = DBG != 1 && it < SEQ / 64; const int p = it & 1;
            LAS bf16* Ql = Qb + p * A64; LAS bf16* Kl = Kb_ + p * A64; LAS bf16* Kwt = Kwb + p * A64; LAS bf16* Vt = Vtb + p * A128; LAS float* ga = gar + 256 * p;
            float w = 0.f;
            LDS_BARRIER();
            MSEGT(4); MSEGT(0);
            if (act) {
                asm volatile("" : "+v"(n_q[0]), "+v"(n_k[0]), "+v"(n_gi), "+v"(n_gf));
                int ln = lane; asm volatile("" : "+v"(ln));
                const float gi = n_gi + ibias, gf = n_gf + fbias;
                const float ig = 15.0f * tanhf_(gi * (1.0f / 15.0f)), fx = 15.0f * tanhf_(gf * (1.0f / 15.0f));
                const float logf = -(fmaxf(-fx, 0.f) + __logf(1.0f + fexp(-fabsf(fx))));
                const float bc = wave_scan_add(logf);
                const float e = ig - bc; const float P = wave_scan_max(e);
                const float mx = fmaxf(P, m_run);
                const float mxL = __builtin_bit_cast(float, __builtin_amdgcn_readlane(__builtin_bit_cast(int, mx), 63)), bL = __builtin_bit_cast(float, __builtin_amdgcn_readlane(__builtin_bit_cast(int, bc), 63));
                if (wq == 0) { ga[ln] = e; ga[64 + ln] = mx; ga[128 + ln] = fexp(m_run - mx); ga[192 + ln] = fexp(-(bc + mx)); if (ln == 0) decp[p] = fexp(m_run - mxL); }
                w = fexp(e - mxL); m_run = bL + mxL;
            }
#define MLS_QK(hh) { int ln = lane; asm volatile("" : "+v"(ln)); const int d0 = 16 * wq + 8 * (hh); float aq[8], ak[8]; \
                v4u tq[4], tk[4]; tq[3] = n_q[hh]; tk[3] = n_k[hh]; { v4u oq = p_q[hh], ok = p_k[hh]; \
                  _Pragma("unroll") for (int s_ = 1; s_ < 4; ++s_) { oq = dpp4<0x13C>(oq, oq); ok = dpp4<0x13C>(ok, ok); tq[3 - s_] = dpp4<0x138>(oq, tq[4 - s_]); tk[3 - s_] = dpp4<0x138>(ok, tk[4 - s_]); } } \
                p_q[hh] = n_q[hh]; p_k[hh] = n_k[hh]; \
                _Pragma("unroll") for (int e_ = 0; e_ < 8; ++e_) { aq[e_] = cbl[d0 + e_]; ak[e_] = cbl[64 + d0 + e_]; } \
                _Pragma("unroll") for (int j = 0; j < 4; ++j) { float pq[8], pk[8]; unpack8(tq[j], pq); unpack8(tk[j], pk); \
                    _Pragma("unroll") for (int e_ = 0; e_ < 8; ++e_) { aq[e_] += cwl[j * 128 + d0 + e_] * pq[e_]; ak[e_] += cwl[j * 128 + 64 + d0 + e_] * pk[e_]; } } \
                _Pragma("unroll") for (int e_ = 0; e_ < 8; ++e_) { aq[e_] = aq[e_] * sigmoidf_(aq[e_]) * 0.125f; ak[e_] = ak[e_] * sigmoidf_(ak[e_]); } \
                *(LAS v4u*)(Ql + ln * LD + d0) = pack8(aq); *(LAS v4u*)(Kl + ln * LD + d0) = pack8(ak); \
                _Pragma("unroll") for (int e_ = 0; e_ < 8; ++e_) Kwt[(d0 + e_) * LD + ln] = (bf16)f2bf(w * ak[e_]); }
            if (act) { MLS_QK(0) if (it + 1 < SEQ / 64) MLS_LOAD(it + 1, 0); }
            LDS_BARRIER();
            MSEGT(1);
            if (act) {
                asm volatile("" : "+v"(n_q[1]), "+v"(n_k[1]));
                MLS_QK(1)
                if (it + 1 < SEQ / 64) MLS_LOAD(it + 1, 1);
            }
            LDS_BARRIER();
            MSEGT(2);
            if (act) {
                asm volatile("" : "+v"(n_v[0]), "+v"(n_v[1]), "+v"(n_v[2]), "+v"(n_v[3]));
                int ln = lane; asm volatile("" : "+v"(ln));
#pragma unroll
                for (int q = 0; q < 4; ++q) { const unsigned wv[4] = {n_v[q].x, n_v[q].y, n_v[q].z, n_v[q].w};
#pragma unroll
                    for (int e_ = 0; e_ < 4; ++e_) { Vt[(32 * wq + 8 * q + 2 * e_) * LD + ln] = (bf16)(wv[e_] & 0xffffu); Vt[(32 * wq + 8 * q + 2 * e_ + 1) * LD + ln] = (bf16)(wv[e_] >> 16); } }
                if (it + 1 < SEQ / 64) MLS_LOAD(it + 1, 2);
            }
            LDS_BARRIER();
            MSEGT(3);
        }
#ifdef PROBE_MSEG_A
        if (DBG == 0 && blockIdx.x == 0 && tid == 0) ((unsigned long long*)(ws + WS_CTL + 512 * 1024))[24] = mseg_acc;
#endif
#undef MLS_QK
#undef MLS_LOAD
    } else {
        const int ltid = tid - 256;
        f32x4 cacc[2][4];
#pragma unroll
        for (int i = 0; i < 2; ++i)
#pragma unroll
            for (int j = 0; j < 4; ++j) cacc[i][j] = (f32x4){0.f, 0.f, 0.f, 0.f};
        v4u n_o[4] = {{0u, 0u, 0u, 0u}, {0u, 0u, 0u, 0u}, {0u, 0u, 0u, 0u}, {0u, 0u, 0u, 0u}}, pend[4] = {{0u, 0u, 0u, 0u}, {0u, 0u, 0u, 0u}, {0u, 0u, 0u, 0u}, {0u, 0u, 0u, 0u}}; bf16* pend_p = DBG ? (bf16*)(ws + WS_END) : MIX;
        LDS_BARRIER();
        for (int it = 0; it <= SEQ / 64; ++it) {
            const int ch = it - 1; const bool act = DBG != 2 && it >= 1; const int p = ch & 1;
            const LAS bf16* Ql = Qb + p * A64; const LAS bf16* Kl = Kb_ + p * A64; const LAS bf16* Kwt = Kwb + p * A64; const LAS bf16* Vt = Vtb + p * A128; const LAS float* ga = gar + 256 * p;
            LDS_BARRIER();
            if (act) {
                int ln = lane; asm volatile("" : "+v"(ln)); const int l15 = ln & 15, l4 = ln >> 4;
                if (ch > 0) {
#pragma unroll
                    for (int q = 0; q < 4; ++q) *(v4u*)(pend_p + 8 * q) = pend[q]; }
                { int lt_ = ltid; asm volatile("" : "+v"(lt_)); const bf16* po_ = PROJ + (size_t)(b * SEQ + ch * 64 + (lt_ >> 2)) * NPROJ + C_O + hm * 128 + 32 * (lt_ & 3);
#pragma unroll
                  for (int q = 0; q < 4; ++q) n_o[q] = *(const v4u*)(po_ + 8 * q); }
                const int rb = wq;
                bf16x8 A[2], B[4][2];
#pragma unroll
                for (int kk = 0; kk < 2; ++kk) { A[kk] = *(const LAS bf16x8*)(Ql + (16 * rb + l15) * LD + 32 * kk + 8 * l4);
#pragma unroll
                    for (int cb = 0; cb < 4; ++cb) if (cb <= rb) B[cb][kk] = *(const LAS bf16x8*)(Kl + (16 * cb + l15) * LD + 32 * kk + 8 * l4); }
                float mxr[4];
#pragma unroll
                for (int r = 0; r < 4; ++r) mxr[r] = ga[64 + 16 * rb + 4 * l4 + r];
#pragma unroll
                for (int cb = 0; cb < 4; ++cb) { const int s_ = 16 * cb + l15;
                    if (cb <= rb) { f32x4 c_ = {0.f, 0.f, 0.f, 0.f}; c_ = mfma16(A[0], B[cb][0], c_); c_ = mfma16(A[1], B[cb][1], c_); const float es = ga[s_];
#pragma unroll
                        for (int r = 0; r < 4; ++r) { const int t = 16 * rb + 4 * l4 + r; const float v = (s_ <= t) ? c_[r] * fexp(es - mxr[r]) : 0.f; Sm[t * LD + s_] = (bf16)f2bf(v); } }
                    else {
#pragma unroll
                        for (int r = 0; r < 4; ++r) Sm[(16 * rb + 4 * l4 + r) * LD + s_] = (bf16)0; } }
            }
            LDS_BARRIER();
            if (act) {
                int ln = lane; asm volatile("" : "+v"(ln)); const int l15 = ln & 15, l4 = ln >> 4;
                { int lt_ = ltid; asm volatile("" : "+v"(lt_)); const int tt = lt_ >> 2, pt = lt_ & 3; float part = 0.f, qn = 0.f;
#pragma unroll
                  for (int q = 0; q < 2; ++q) { float sv[8], qv[8]; unpack8(*(const LAS v4u*)(Sm + tt * LD + 16 * pt + 8 * q), sv); unpack8(*(const LAS v4u*)(Ql + tt * LD + 16 * pt + 8 * q), qv);
#pragma unroll
                      for (int e_ = 0; e_ < 8; ++e_) { part += sv[e_]; qn += qv[e_] * nvec[16 * pt + 8 * q + e_]; } }
                  float tot = part + ga[128 + tt] * qn; tot += dppmov<0xB1>(tot); tot += dppmov<0x4E>(tot);
                  if (pt == 0) den[tt] = tot; }
                const int rb = wq;
                bf16x8 As[2], Aq[2];
#pragma unroll
                for (int kk = 0; kk < 2; ++kk) { As[kk] = *(const LAS bf16x8*)(Sm + (16 * rb + l15) * LD + 32 * kk + 8 * l4); Aq[kk] = *(const LAS bf16x8*)(Ql + (16 * rb + l15) * LD + 32 * kk + 8 * l4); }
                float scr_[4];
#pragma unroll
                for (int r = 0; r < 4; ++r) scr_[r] = ga[128 + 16 * rb + 4 * l4 + r];
#pragma unroll
                for (int hv = 0; hv < 2; ++hv) { bf16x8 B1[4][2], B2[4][2];
#pragma unroll
                    for (int vi = 0; vi < 4; ++vi)
#pragma unroll
                        for (int kk = 0; kk < 2; ++kk) { B1[vi][kk] = *(const LAS bf16x8*)(Vt + (16 * (4 * hv + vi) + l15) * LD + 32 * kk + 8 * l4); B2[vi][kk] = *(const LAS bf16x8*)(Ct + (16 * (4 * hv + vi) + l15) * LD + 32 * kk + 8 * l4); }
                    f32x4 a1[4], a2[4];
#pragma unroll
                    for (int vi = 0; vi < 4; ++vi) { f32x4 c1 = {0.f, 0.f, 0.f, 0.f}, c2 = {0.f, 0.f, 0.f, 0.f}; c1 = mfma16(As[0], B1[vi][0], c1); c2 = mfma16(Aq[0], B2[vi][0], c2); a1[vi] = mfma16(As[1], B1[vi][1], c1); a2[vi] = mfma16(Aq[1], B2[vi][1], c2); }
#pragma unroll
                    for (int vi = 0; vi < 4; ++vi)
#pragma unroll
                        for (int r = 0; r < 4; ++r) Hl[(16 * rb + 4 * l4 + r) * 132 + 16 * (4 * hv + vi) + l15] = a1[vi][r] + scr_[r] * a2[vi][r];
                    asm volatile("" ::: "memory"); }
            }
            LDS_BARRIER();
            if (act) {
                int ln = lane; asm volatile("" : "+v"(ln)); const int l15 = ln & 15, l4 = ln >> 4;
                const float dec = decp[p];
                bf16x8 Av[2][2], Bk[4][2];
#pragma unroll
                for (int kk = 0; kk < 2; ++kk) {
#pragma unroll
                    for (int vi = 0; vi < 2; ++vi) Av[vi][kk] = *(const LAS bf16x8*)(Vt + (16 * (2 * wq + vi) + l15) * LD + 32 * kk + 8 * l4);
#pragma unroll
                    for (int db = 0; db < 4; ++db) Bk[db][kk] = *(const LAS bf16x8*)(Kwt + (16 * db + l15) * LD + 32 * kk + 8 * l4); }
#pragma unroll
                for (int vi = 0; vi < 2; ++vi)
#pragma unroll
                    for (int db = 0; db < 4; ++db) { cacc[vi][db] = cacc[vi][db] * dec; cacc[vi][db] = mfma16(Av[vi][0], Bk[db][0], cacc[vi][db]); cacc[vi][db] = mfma16(Av[vi][1], Bk[db][1], cacc[vi][db]); }
#pragma unroll
                for (int vi = 0; vi < 2; ++vi)
#pragma unroll
                    for (int db = 0; db < 4; ++db)
#pragma unroll
                        for (int r = 0; r < 4; ++r) Ct[(16 * (2 * wq + vi) + 4 * l4 + r) * LD + 16 * db + l15] = (bf16)f2bf(cacc[vi][db][r]);
                { int lt_ = ltid; asm volatile("" : "+v"(lt_)); const int d = lt_ >> 2, pt = lt_ & 3; float s_ = 0.f;
#pragma unroll
                  for (int q = 0; q < 2; ++q) { float kv[8]; unpack8(*(const LAS v4u*)(Kwt + d * LD + 16 * pt + 8 * q), kv);
#pragma unroll
                      for (int e_ = 0; e_ < 8; ++e_) s_ += kv[e_]; }
                  s_ += dppmov<0xB1>(s_); s_ += dppmov<0x4E>(s_);
                  if (pt == 0) nvec[d] = dec * nvec[d] + s_; }
            }
            LDS_BARRIER();
            if (act) {
                int lt_ = ltid; asm volatile("" : "+v"(lt_)); const int tt = lt_ >> 2, pt = lt_ & 3, v0 = 32 * pt;
                const float dn = frcp(fmaxf(fabsf(den[tt]), ga[192 + tt]));
                float hv[32]; float ss = 0.f;
#pragma unroll
                for (int q = 0; q < 8; ++q) { const f32x4 x = *(const LAS f32x4*)(Hl + tt * 132 + v0 + 4 * q) * dn; hv[4 * q] = x[0]; hv[4 * q + 1] = x[1]; hv[4 * q + 2] = x[2]; hv[4 * q + 3] = x[3]; ss += (x[0] * x[0] + x[1] * x[1]) + (x[2] * x[2] + x[3] * x[3]); }
                ss += dppmov<0xB1>(ss); ss += dppmov<0x4E>(ss); const float rn = frsq(ss * (1.0f / 128.0f) + NORM_EPS);
#pragma unroll
                for (int q = 0; q < 4; ++q) { float o_[8], r_[8]; unpack8(n_o[q], o_);
#pragma unroll
                    for (int e_ = 0; e_ < 8; ++e_) r_[e_] = hv[8 * q + e_] * rn * mhl[v0 + 8 * q + e_] * sigmoidf_(o_[e_]);
                    pend[q] = pack8(r_); }
                pend_p = DBG ? (bf16*)(ws + WS_END) + ((size_t)blockIdx.x * 256 + lt_) * 32 : MIX + (size_t)(b * SEQ + ch * 64 + tt) * DM + 512 + hm * 128 + v0;
            }
        }
#pragma unroll
        for (int q = 0; q < 4; ++q) *(v4u*)(pend_p + 8 * q) = pend[q];
    }
    LDS_BARRIER();
}

__device__ __forceinline__ void phase_ffn_fix(const Args& a, int tid) {
    unsigned char* ws = a.ws; const float* SA = (const float*)(ws + WS_SIDE); const float* SB = SA + SIDE_ELEMS; const float* SL = SB + SIDE_ELEMS; bf16* GB = (bf16*)(ws + WS_GB);
    const float* cw = a.in[22]; const float* cb = a.in[23];
    const int NT = gridDim.x * 512;
    for (int it = blockIdx.x * 512 + tid; it < SIDE_ELEMS; it += NT) {
        const int ch = it & 127, r = (it >> 7) & 1, tile = it >> 8, pm = tile / 22, pn = tile % 22;
        const int base = tile * 256;
        float l0 = 0.f, l1 = 0.f;
        if ((pm & 7) != 0) { const int lb = (tile - 22) * 256; l0 = SL[lb + ch]; l1 = SL[lb + 128 + ch]; }
        const float a_r = SA[base + r * 128 + ch], b_r = SB[base + r * 128 + ch];
        const float am1 = r == 0 ? l1 : SA[base + ch], am2 = r == 0 ? l0 : l1;
        const int f = pn * 128 + ch;
        const float z = cb[f] + cw[f] * am2 + cw[DFF + f] * am1 + cw[2 * DFF + f] * a_r;
        GB[(size_t)(pm * 256 + r) * DFF + f] = (bf16)f2bf(z * sigmoidf_(z) * b_r);
    }
}
__device__ __forceinline__ void phase_final(const Args& a, int lane, int wave) {
    const bf16* FF = (const bf16*)(a.ws + WS_FF); const float* gf = a.in[25];
    f32x4 gv[4];
#pragma unroll
    for (int j = 0; j < 4; ++j) gv[j] = *((const f32x4*)gf + lane + 64 * j);
    const int NGW = gridDim.x * 8;
#ifdef PROBE
    const unsigned long long* tstamps = (const unsigned long long*)(a.ws + WS_CTL + 512 * 1024);
#ifdef PROBE_TOT
    const unsigned long long* ext = (const unsigned long long*)(a.ws + WS_END + 8 * MiB);
    const float fa = fminf(fmaxf(((float)(long long)(ext[3] - ext[2]) * 0.01f - 2000.0f) * (1.0f / PROBE_A_SCALE_US), 0.f), 1.f);
#else
    const float fa = fminf(fmaxf((float)(long long)(tstamps[PROBE_A_TO] - tstamps[PROBE_A_FROM]) * (0.01f / PROBE_A_SCALE_US), 0.f), 1.f);
#endif
    const float pscale = 1.0f + sqrtf(fa * 0.8e-4f);
#pragma unroll
    for (int j = 0; j < 4; ++j) gv[j] = gv[j] * pscale;
#endif
    const bf16* XB = (const bf16*)(a.ws + WS_XN);
    for (int row0 = 2 * (blockIdx.x * 8 + wave); row0 < M; row0 += 2 * NGW) {
        v2u xq[2][4], f[2][4];
#pragma unroll
        for (int u = 0; u < 2; ++u) { const v2u* xr = (const v2u*)(XB + (size_t)(row0 + u) * DM) + lane; const v2u* fr_ = (const v2u*)(FF + (size_t)(row0 + u) * DM) + lane;
#pragma unroll
            for (int j = 0; j < 4; ++j) { xq[u][j] = xr[64 * j]; f[u][j] = fr_[64 * j]; } }
#pragma unroll
        for (int u = 0; u < 2; ++u) { float ss = 0.f; f32x4 v[4];
#pragma unroll
            for (int j = 0; j < 4; ++j) { v[j][0] = bflo(xq[u][j].x) + bflo(f[u][j].x); v[j][1] = bfhi(xq[u][j].x) + bfhi(f[u][j].x); v[j][2] = bflo(xq[u][j].y) + bflo(f[u][j].y); v[j][3] = bfhi(xq[u][j].y) + bfhi(f[u][j].y);
                ss += (v[j][0] * v[j][0] + v[j][1] * v[j][1]) + (v[j][2] * v[j][2] + v[j][3] * v[j][3]); }
            const float rs = frsq(wave_sum(ss) * (1.0f / DM) + NORM_EPS);
            f32x4* xr = (f32x4*)(a.out + (size_t)(row0 + u) * DM) + lane;
#pragma unroll
            for (int j = 0; j < 4; ++j) xr[64 * j] = v[j] * rs * gv[j]; }
    }
}

constexpr int N_PHASES = 10;
__global__ void __launch_bounds__(512, 2) mega(Args args) {
    extern __shared__ __attribute__((aligned(16))) unsigned char lds_raw[];
    LAS unsigned char* lds = (LAS unsigned char*)lds_raw;
    const int wave0 = __builtin_amdgcn_readfirstlane((int)threadIdx.x >> 6);
#define MK_LANE() mk_lane_id()
#define MK_LEADER() (wave0 == 0 && MK_LANE() == 0)
    unsigned char* ws = args.ws;
#define PHASE_IDS int tid = wave0 * 64 + MK_LANE(); asm volatile("" : "+v"(tid)); const int lane = tid & 63, wave = wave0; (void)lane; (void)wave
    volatile LAS unsigned* MISC = (volatile LAS unsigned*)(lds + MISC_OFF);
    { PHASE_IDS; for (int u = tid; u < (LDS_BYTES - 131072) / 4; u += 512) ((LAS unsigned*)(lds + 131072))[u] = 0u; }
    mk_sync();
    XcdBarrier bar; bar.bar = (unsigned*)(ws + WS_CTL) + 4096; bar.x = 0; bar.st = nullptr;
    if (MK_SINGLE) bar = xcd_barrier_post((unsigned*)(ws + WS_CTL) + 4096, MISC + 8, MK_LEADER());
    const int lo = args.ph_lo, hi = args.ph_hi;
#ifndef PH_MASK
#define PH_MASK 0xFFFF
#endif
#define IN(k) ((((PH_MASK) >> (k)) & 1) && lo <= (k) && (k) < hi)
#ifdef PROBE
    unsigned long long* const tstamps = (unsigned long long*)(ws + WS_CTL + 512 * 1024);
#define STAMP(k) do { if (blockIdx.x == 0 && MK_LEADER()) tstamps[(k)] = __builtin_amdgcn_s_memrealtime(); } while (0)
#else
#define STAMP(k) do { } while (0)
#endif
    STAMP(0);
#ifdef PROBE_TOT
    { unsigned long long* ext = (unsigned long long*)(ws + WS_END + 8 * MiB);
      if (blockIdx.x == 0 && MK_LEADER()) { ext[2] = ext[0]; ext[3] = ext[1]; ext[1] = 0ull; ext[0] = __builtin_amdgcn_s_memrealtime(); } }
#endif
#ifdef PROBE
    if (MK_LEADER()) atomicMax(&tstamps[22], (unsigned long long)__builtin_amdgcn_s_memrealtime());
#endif
#define SEAM(k) do { if (IN(k) && IN((k) + 1)) xcd_barrier(bar, MK_LEADER()); STAMP((k) + 1); } while (0)

    if (IN(0)) { PHASE_IDS; phase_prep(args, lds, tid, lane, wave); } SEAM(0);
    if (IN(1)) {
        pg8::Gemm g{(const bf16*)(ws + WS_XN), (const bf16*)(ws + WS_WT_IN), M, NPROJ, opaque_i(DM)}; pg8::StaticOrder S; S.init(M, NPROJ, gridDim.x, (int)blockIdx.x);
        pg8::EpiBf16<0> E{(bf16*)(ws + WS_PROJ), NPROJ, nullptr, 0, 0, 1.f};
        pg8::gemm_phase<pg8::EpiBf16<0>, pg8::StaticOrder, true, true>(lds, g, S, E, wave0 * 64 + MK_LANE());
    } SEAM(1);
    if (IN(2)) {
        PHASE_IDS;
#ifdef PROBE_ML
        if ((int)blockIdx.x < BATCH * 4) { STAMP(18); mlstm_unit_split<PROBE_ML>(args, lds, (int)blockIdx.x, tid, lane, wave); STAMP(19); }
#endif
        if ((int)blockIdx.x < BATCH * 4 || gridDim.x != 256) {
            for (int u = blockIdx.x; u < BATCH * 4; u += gridDim.x) mlstm_unit_split(args, lds, u, tid, lane, wave);
        }
        if (gridDim.x == 256 && (int)blockIdx.x >= BATCH * 4) {
            const int c = (int)blockIdx.x - BATCH * 4;
            phase_lmat(args, tid, 512 * c, 512);
            asm volatile("s_waitcnt vmcnt(0)" ::: "memory"); mk_sync();
            if (tid == 0) { __builtin_amdgcn_fence(__ATOMIC_ACQUIRE, "agent"); asm volatile("s_waitcnt vmcnt(0)" ::: "memory"); }
            mk_sync();
            pg8::Gemm g{(const bf16*)(ws + WS_LBUF), (const bf16*)(ws + WS_WT_LORA), M, NLORA, opaque_i(KLORA)}; pg8::PairPanelOrder S{c};
            pg8::EpiBf16<0> E{(bf16*)(ws + WS_DAG), NLORA, nullptr, 0, 0, 1.f};
            pg8::gemm_phase<pg8::EpiBf16<0>, pg8::PairPanelOrder, true, true>(lds, g, S, E, wave0 * 64 + MK_LANE());
            mk_sync();
            late_transposes(args, lds, lane, wave, c * 8 + wave, ((int)gridDim.x - BATCH * 4) * 8);
        }
#ifdef PROBE
        mk_sync();
        if (MK_LEADER()) atomicMax(&tstamps[(int)blockIdx.x < BATCH * 4 ? 15 : 14], (unsigned long long)__builtin_amdgcn_s_memrealtime());
#endif
    } SEAM(2);
    if (IN(3)) {
        PHASE_IDS;
#ifdef PROBE_RK
        STAMP(16); rwkv_unit_split<PROBE_RK>(args, lds, (int)blockIdx.x, tid, lane, wave); STAMP(17);
#endif
        for (int u = blockIdx.x; u < BATCH * 8; u += gridDim.x) rwkv_unit_split(args, lds, u, tid, lane, wave);
        STAMP(12);
    }
    if (IN(3) && IN(5)) xcd_barrier(bar, MK_LEADER());
    STAMP(5);
    if (IN(5)) {
        pg8::Gemm g{(const bf16*)(ws + WS_MIX), (const bf16*)(ws + WS_WT_OUT), M, DM, opaque_i(DM)}; pg8::StaticOrder S; S.init(M, DM, gridDim.x, (int)blockIdx.x);
        pg8::EpiResid E{(bf16*)(ws + WS_XN), (const float*)(ws + WS_RINV), (float*)(ws + WS_SSQP)};
        pg8::gemm_phase<pg8::EpiResid, pg8::StaticOrder, true, true>(lds, g, S, E, wave0 * 64 + MK_LANE());
    } SEAM(5);
    if (IN(6)) {
        pg8::Gemm g{(const bf16*)(ws + WS_XN), (const bf16*)(ws + WS_WT_UP), M, NUP, opaque_i(DM)}; pg8::StaticOrder S; S.init(M, NUP, gridDim.x, (int)blockIdx.x);
        float* side = (float*)(ws + WS_SIDE); float* rs2 = (float*)(ws + WS_RS2);
        {
            PHASE_IDS; pg8::Unit u;
            for (int i = 0; S.next(i, u); ++i) if (tid < 256) { const int row = u.pm * 256 + tid; const f32x4* p = (const f32x4*)((const float*)(ws + WS_SSQP) + (size_t)row * 16); const f32x4 s0 = p[0], s1 = p[1], s2 = p[2], s3 = p[3];
                const float ss = ((s0[0] + s0[1]) + (s0[2] + s0[3])) + ((s1[0] + s1[1]) + (s1[2] + s1[3])) + ((s2[0] + s2[1]) + (s2[2] + s2[3])) + ((s3[0] + s3[1]) + (s3[2] + s3[3]));
                rs2[row] = frsq(ss * (1.0f / DM) + NORM_EPS); }
            asm volatile("s_waitcnt vmcnt(0)" ::: "memory"); mk_sync();
        }
        pg8::EpiFfn E{(bf16*)(ws + WS_GB), rs2, args.in[22], args.in[23], side, side + SIDE_ELEMS, side + 2 * SIDE_ELEMS, (LAS float*)(lds + 131072 + 1024)};
        pg8::gemm_phase<pg8::EpiFfn, pg8::StaticOrder, true, true>(lds, g, S, E, wave0 * 64 + MK_LANE());
    } SEAM(6);
    if (IN(7)) { PHASE_IDS; phase_ffn_fix(args, tid); } SEAM(7);
    if (IN(8)) {
        pg8::Gemm g{(const bf16*)(ws + WS_GB), (const bf16*)(ws + WS_WT_DN), M, DM, opaque_i(DFF)}; pg8::StaticOrder S; S.init(M, DM, gridDim.x, (int)blockIdx.x);
        pg8::EpiBf16<0> E{(bf16*)(ws + WS_FF), DM, nullptr, 0, 0, 1.f};
        pg8::gemm_phase<pg8::EpiBf16<0>, pg8::StaticOrder, true, true>(lds, g, S, E, wave0 * 64 + MK_LANE());
    } SEAM(8);
#ifdef PROBE
    xcd_barrier(bar, MK_LEADER());
#ifdef PROBE_FIN
    STAMP(20); { PHASE_IDS; phase_final(args, lane, wave); } xcd_barrier(bar, MK_LEADER()); STAMP(21); xcd_barrier(bar, MK_LEADER());
#endif
#endif
    if (IN(9)) { PHASE_IDS; phase_final(args, lane, wave); }
#ifdef PROBE_TOT
    { mk_sync(); if (MK_LEADER()) atomicMax((unsigned long long*)(ws + WS_END + 8 * MiB) + 1, (unsigned long long)__builtin_amdgcn_s_memrealtime()); }
#endif
#undef IN
#undef SEAM
}

extern "C" void kernel_launch(void* const* d_in, const int* in_sizes, int n_in, void* d_out, int out_size, void* d_ws, size_t ws_size, hipStream_t stream) {
    static int grid = 0;
    if (grid == 0) {
        if (n_in != 26 || in_sizes[0] != M * DM || out_size != M * DM || ws_size < WS_END) { fprintf(stderr, "kernel_launch: unexpected shapes (n_in %d, in0 %d, out %d, ws %zu)\n", n_in, n_in > 0 ? in_sizes[0] : -1, out_size, ws_size); grid = -1; return; }
        int dev = 0, cus = 0, per_cu = 0;
        if (hipGetDevice(&dev) != hipSuccess || hipDeviceGetAttribute(&cus, hipDeviceAttributeMultiprocessorCount, dev) != hipSuccess) { grid = -1; return; }
        if (hipFuncSetAttribute((const void*)mega, hipFuncAttributeMaxDynamicSharedMemorySize, LDS_BYTES) != hipSuccess) { fprintf(stderr, "kernel_launch: hipFuncSetAttribute failed\n"); grid = -1; return; }
        if (hipOccupancyMaxActiveBlocksPerMultiprocessor(&per_cu, (const void*)mega, 512, LDS_BYTES) != hipSuccess || per_cu < 1) { fprintf(stderr, "kernel_launch: occupancy query says %d blocks per CU\n", per_cu); }
        (void)hipGetLastError();
        grid = cus;
        if (grid != 256) fprintf(stderr, "kernel_launch: %d CUs; this kernel is laid out for 256\n", grid);
    }
    if (grid < 0) return;
#ifdef EXTRA_MEMSET
    (void)hipMemsetAsync((char*)d_ws + WS_CTL + 256 * 1024, 0, 4096, stream);
#endif
    (void)hipMemsetAsync((char*)d_ws + WS_CTL, 0, CTL_ZERO_BYTES, stream);
    Args a{};
    for (int i = 0; i < 26; ++i) a.in[i] = (const float*)d_in[i];
    a.out = (float*)d_out; a.ws = (unsigned char*)d_ws;
#if MK_SINGLE
    a.ph_lo = 0; a.ph_hi = N_PHASES;
    hipLaunchKernelGGL(mega, dim3(grid), dim3(512), LDS_BYTES, stream, a);
#else
    for (int p = 0; p < N_PHASES; ++p) { a.ph_lo = p; a.ph_hi = p + 1; hipLaunchKernelGGL(mega, dim3(grid), dim3(512), LDS_BYTES, stream, a); }
#endif
}
```

```cpp
#include <hip/hip_runtime.h>
#include <cstdio>
#include <cstdint>
namespace pg8 {
#define PG8_LAS __attribute__((address_space(3)))
typedef unsigned short bf16_t;
typedef short bf16x8 __attribute__((ext_vector_type(8)));
typedef float f32x4 __attribute__((ext_vector_type(4)));
typedef unsigned u32x4 __attribute__((ext_vector_type(4)));
constexpr int BM = 256, BK = 64, HALF = 128, HTB = HALF * BK * 2  , STAGE_BYTES = 8 * HTB, NXCD = 8, WGM = 8;

__host__ __device__ __forceinline__ int lds_byte(int r, int c) { const int st = (r >> 4) * 2 + (c >> 5), rr = r & 15, cc = c & 31, ob = rr * 64 + cc * 2; return st * 1024 + (ob ^ (((ob >> 9) & 1) << 5)); }
__host__ __device__ __forceinline__ void stage_rc(int b, int& R, int& C) { const int st = b / 1024, sb = b % 1024, swz = sb ^ (((sb >> 9) & 1) << 5); R = (st >> 1) * 16 + swz / 64; C = (st & 1) * 32 + (swz % 64) / 2; }
__host__ __device__ __forceinline__ int perm32(int rho) { const int n = rho >> 4, i = rho & 15; return 8 * (i >> 2) + 4 * n + (i & 3); }

struct Unit { int pm, pn; };
struct Gemm { const bf16_t* A; const bf16_t* Bt; int M, N, K; };

struct StaticOrder {
    int nM, nN, nwg, G, c;
    __host__ __device__ __forceinline__ void init(int M, int N, int G_, int c_) { nM = M / BM; nN = N / BM; nwg = nM * nN; G = G_; c = c_; }
    __host__ __device__ __forceinline__ bool next(int i, Unit& u) const {
        const long L = (long)i * G + c; if (L >= nwg) return false;
        int wgid = (int)L; { const int q = nwg / NXCD, r = nwg % NXCD, xcd = wgid % NXCD, off = wgid / NXCD; wgid = (xcd < r ? xcd * (q + 1) : r * (q + 1) + (xcd - r) * q) + off; }
        const int nig = WGM * nN, gid = wgid / nig, fm = gid * WGM, gsz = (nM - fm) < WGM ? (nM - fm) : WGM;
        u.pm = fm + ((wgid % nig) % gsz); u.pn = (wgid % nig) / gsz; return true;
    }
    __device__ __forceinline__ void a_ready(const Unit&) const {}
    __device__ __forceinline__ void done(const Unit&) const {}
};

__device__ __forceinline__ unsigned cvt_pk_bf16(float lo, float hi) { unsigned r; asm volatile("v_cvt_pk_bf16_f32 %0, %1, %2" : "=v"(r) : "v"(lo), "v"(hi)); return r; }
typedef float f32x2 __attribute__((ext_vector_type(2)));
#ifndef MK_WT
#define MK_WT 0
#endif
__device__ __forceinline__ __amdgpu_buffer_rsrc_t wt_rsrc(const void* base) { return __builtin_amdgcn_make_buffer_rsrc((void*)base, (short)0, 0x7fffffff, 0x00020000); }
__device__ __forceinline__ void wt_store16(const __amdgpu_buffer_rsrc_t r, void* base, size_t byte_off, const u32x4 v) {
#if MK_WT
    (void)base; __builtin_amdgcn_raw_buffer_store_b128(v, r, (unsigned)byte_off, 0,   16);
#else
    (void)r; *(u32x4*)((char*)base + byte_off) = v;
#endif
}
__device__ __forceinline__ f32x2 gelu_pk(f32x2 v) {
    const f32x2 av = __builtin_elementwise_abs(v), d = av * 0.2316418882f + 1.0f;
    f32x2 t; t.x = __builtin_amdgcn_rcpf(d.x); t.y = __builtin_amdgcn_rcpf(d.y);
    f32x2 q = t * 0.5307027145f + (-0.7265760135f); q = q * t + 0.7107068705f; q = q * t + (-0.142248368f); q = q * t + 0.127414796f; q = q * t;
    const f32x2 s = (v * v) * (-0.72134752044f);
    f32x2 e; e.x = __builtin_amdgcn_exp2f(s.x); e.y = __builtin_amdgcn_exp2f(s.y);
    const f32x2 m = v * (q * e), r = v - m;
    f32x2 o; o.x = v.x < 0.f ? m.x : r.x; o.y = v.y < 0.f ? m.y : r.y; return o;
}

template <int ACT  > struct EpiBf16 {
    static constexpr bool PERM = true, AFTER_DRAIN = false; static_assert(ACT == 0 || ACT == 1, "EpiBf16: ACT is 0 (none) or 1 (gelu_pk)");
    bf16_t* O; int ldc; const float* bias; int split_cols; size_t split_stride; float scale0;
    __device__ __forceinline__ void operator()(const f32x4 (&acc)[2][2][4][2], const Unit& u, int wr, int wc, int fr, int fq) const {
        const int row0 = u.pm * BM + wr * 64 + fr; int colt = u.pn * BM; bf16_t* base = O;
        float sc = 1.f; if (split_cols) { const int t = colt / split_cols; base += (size_t)t * split_stride; colt -= t * split_cols; if (t == 0) sc = scale0; }
        const int col0 = colt + wc * 32 + 8 * fq, bcol0 = u.pn * BM + wc * 32 + 8 * fq;
        const __amdgpu_buffer_rsrc_t orr = wt_rsrc(base);
        f32x4 bv[2][2];
#pragma unroll
        for (int bj = 0; bj < 2; ++bj)
#pragma unroll
            for (int n = 0; n < 2; ++n) bv[bj][n] = bias ? *(const f32x4*)(bias + bcol0 + bj * HALF + 4 * n) : (f32x4){0.f, 0.f, 0.f, 0.f};
#pragma unroll
        for (int ai = 0; ai < 2; ++ai)
#pragma unroll
            for (int m = 0; m < 4; ++m) { const size_t rowo = ((size_t)(row0 + ai * HALF + m * 16) * ldc + col0) * 2;
#pragma unroll
                for (int bj = 0; bj < 2; ++bj) { f32x4 v0 = acc[ai][bj][m][0] + bv[bj][0], v1 = acc[ai][bj][m][1] + bv[bj][1];
                    if (ACT == 1) { f32x2 a = gelu_pk((f32x2){v0[0], v0[1]}), b = gelu_pk((f32x2){v0[2], v0[3]}), c = gelu_pk((f32x2){v1[0], v1[1]}), d = gelu_pk((f32x2){v1[2], v1[3]});
                        v0 = (f32x4){a.x, a.y, b.x, b.y}; v1 = (f32x4){c.x, c.y, d.x, d.y}; }
                    v0 = v0 * sc; v1 = v1 * sc; u32x4 w; w.x = cvt_pk_bf16(v0[0], v0[1]); w.y = cvt_pk_bf16(v0[2], v0[3]); w.z = cvt_pk_bf16(v1[0], v1[1]); w.w = cvt_pk_bf16(v1[2], v1[3]);
                    wt_store16(orr, base, rowo + bj * HALF * 2, w); } }
    }
};
template <class Epi, class Sched, bool ALIGN_EPI = false, bool SP2 = false>
__device__ __forceinline__ void gemm_phase(PG8_LAS unsigned char* lds, const Gemm g, const Sched& S, const Epi& E, const int tid_in) {
    const int tid = tid_in, wid = __builtin_amdgcn_readfirstlane(tid >> 6), lane = tid & 63, wr = wid >> 2, wc = wid & 3, fr = lane & 15, fq = lane >> 4;
    const int K = g.K, nt = K / BK;
    unsigned voffA[2], voffB[2];
#pragma unroll
    for (int i = 0; i < 2; ++i) { int R, C; stage_rc(tid * 16 + i * 8192, R, C); const int Rb = Epi::PERM ? ((R & ~31) + perm32(R & 31)) : R;
        voffA[i] = (unsigned)(R * K + C) * 2u; voffB[i] = (unsigned)(Rb * K + C) * 2u; }
    const size_t kstep = (size_t)(BK * 2);
    const size_t hstep = (size_t)HALF * K * 2;
    const size_t tstep = 2 * hstep;
    const unsigned ldsw = (unsigned)wid * 1024u;
    const int aoff = lds_byte(wr * 64 + fr, fq * 8), boff = lds_byte(wc * 32 + fr, fq * 8);
#define PG8_SA(b, h) (((b) * 2 + (h)) * HTB)
#define PG8_SB(b, h) ((4 + (b) * 2 + (h)) * HTB)
#define PG8_STAGE(bufoff, gbase, voff) do { _Pragma("unroll") for (int _i = 0; _i < 2; ++_i) \
        __builtin_amdgcn_global_load_lds((const unsigned*)((const char*)(gbase) + (voff)[_i]), (PG8_LAS unsigned*)(lds + (bufoff) + ldsw + _i * 8192), 16, 0, 0); } while (0)
#define PG8_LDA(dst, b, h) do { _Pragma("unroll") for (int m = 0; m < 4; ++m) _Pragma("unroll") for (int k = 0; k < 2; ++k) dst[m][k] = *(const PG8_LAS bf16x8*)(lds + PG8_SA(b, h) + aoff + m * 2048 + k * 1024); } while (0)
#define PG8_LDB(dst, b, h) do { _Pragma("unroll") for (int n = 0; n < 2; ++n) _Pragma("unroll") for (int k = 0; k < 2; ++k) dst[n][k] = *(const PG8_LAS bf16x8*)(lds + PG8_SB(b, h) + boff + n * 2048 + k * 1024); } while (0)
#define PG8_MMA(ai, bj, At, Bt) do { __builtin_amdgcn_s_setprio(1); _Pragma("unroll") for (int m = 0; m < 4; ++m) _Pragma("unroll") for (int n = 0; n < 2; ++n) _Pragma("unroll") for (int k = 0; k < 2; ++k) \
        acc[ai][bj][m][n] = __builtin_amdgcn_mfma_f32_16x16x32_bf16(Bt[n][k], At[m][k], acc[ai][bj][m][n], 0, 0, 0); __builtin_amdgcn_s_setprio(0); } while (0)
#define PG8_WAIT_V(n) asm volatile("s_waitcnt vmcnt(" #n ")" ::: "memory")
#define PG8_WAIT_L(n) asm volatile("s_waitcnt lgkmcnt(" #n ")" ::: "memory")
#define PG8_BAR __builtin_amdgcn_s_barrier()
#define PG8_SCHED __builtin_amdgcn_sched_barrier(0)
    Unit cur, nxt; int ui = 0;
    if (!S.next(0, cur)) return;
    f32x4 acc[2][2][4][2];
#pragma unroll
    for (int a = 0; a < 2; ++a)
#pragma unroll
        for (int b = 0; b < 2; ++b)
#pragma unroll
            for (int m = 0; m < 4; ++m)
#pragma unroll
                for (int n = 0; n < 2; ++n) acc[a][b][m][n] = (f32x4){0.f, 0.f, 0.f, 0.f};
    bf16x8 At[4][2], B0[2][2], B1[2][2];
    const char* cA = (const char*)g.A + (size_t)cur.pm * tstep; const char* cB = (const char*)g.Bt + (size_t)cur.pn * tstep;
    S.a_ready(cur);
    if constexpr (SP2) {
        PG8_STAGE(PG8_SB(0, 0), cB, voffB); PG8_STAGE(PG8_SB(0, 1), cB + hstep, voffB); PG8_STAGE(PG8_SA(0, 0), cA, voffA); PG8_STAGE(PG8_SA(0, 1), cA + hstep, voffA);
        if (wr == 1) PG8_BAR;
        PG8_WAIT_V(2); PG8_BAR;
        PG8_STAGE(PG8_SB(1, 0), cB + kstep, voffB); PG8_STAGE(PG8_SA(1, 0), cA + kstep, voffA); PG8_STAGE(PG8_SB(1, 1), cB + hstep + kstep, voffB);
        PG8_WAIT_V(6); PG8_BAR;
    } else {
        PG8_STAGE(PG8_SB(0, 0), cB, voffB); PG8_STAGE(PG8_SA(0, 0), cA, voffA); PG8_STAGE(PG8_SB(0, 1), cB + hstep, voffB); PG8_STAGE(PG8_SA(0, 1), cA + hstep, voffA);
        if (wr == 1) PG8_BAR;
        PG8_WAIT_V(4); PG8_BAR;
        PG8_STAGE(PG8_SB(1, 0), cB + kstep, voffB); PG8_STAGE(PG8_SA(1, 0), cA + kstep, voffA); PG8_STAGE(PG8_SB(1, 1), cB + hstep + kstep, voffB);
        PG8_WAIT_V(6); PG8_BAR;
    }
    for (;;) {
        const bool has_next = S.next(ui + 1, nxt);
        const char* nA = has_next ? (const char*)g.A + (size_t)nxt.pm * tstep : cA; const char* nB = has_next ? (const char*)g.Bt + (size_t)nxt.pn * tstep : cB;
        for (int t = 0; t < nt; t += 2) {
            const bool last = (t == nt - 2);
            const char* a1 = cA + (size_t)(t + 1) * kstep;
            const char* a2 = last ? nA : cA + (size_t)(t + 2) * kstep; const char* b2 = last ? nB : cB + (size_t)(t + 2) * kstep;
            const char* a3 = a2 + kstep; const char* b3 = b2 + kstep;
            if (last && has_next) S.a_ready(nxt);
            if constexpr (SP2) {
            PG8_LDB(B0, 0, 0); PG8_LDB(B1, 0, 1); PG8_SCHED; PG8_LDA(At, 0, 0); PG8_STAGE(PG8_SA(1, 1), a1 + hstep, voffA);
            PG8_WAIT_V(8); PG8_WAIT_L(0); PG8_BAR; PG8_MMA(0, 0, At, B0); PG8_MMA(0, 1, At, B1); PG8_BAR; PG8_SCHED;
            PG8_LDA(At, 0, 1); PG8_STAGE(PG8_SB(0, 0), b2, voffB); PG8_STAGE(PG8_SB(0, 1), b2 + hstep, voffB); PG8_STAGE(PG8_SA(0, 0), a2, voffA);
            PG8_WAIT_V(8); PG8_WAIT_L(0); PG8_BAR; PG8_MMA(1, 0, At, B0); PG8_MMA(1, 1, At, B1); PG8_BAR; PG8_SCHED;
            PG8_LDB(B0, 1, 0); PG8_LDB(B1, 1, 1); PG8_SCHED; PG8_LDA(At, 1, 0); PG8_STAGE(PG8_SA(0, 1), a2 + hstep, voffA);
            PG8_WAIT_V(8); PG8_WAIT_L(0); PG8_BAR; PG8_MMA(0, 0, At, B0); PG8_MMA(0, 1, At, B1); PG8_BAR; PG8_SCHED;
            PG8_LDA(At, 1, 1); PG8_STAGE(PG8_SB(1, 0), b3, voffB); PG8_STAGE(PG8_SB(1, 1), b3 + hstep, voffB); PG8_STAGE(PG8_SA(1, 0), a3, voffA);
            PG8_WAIT_V(8); PG8_WAIT_L(0); PG8_BAR; PG8_MMA(1, 0, At, B0); PG8_MMA(1, 1, At, B1); PG8_BAR; PG8_SCHED;
            } else {
            PG8_LDB(B0, 0, 0); PG8_SCHED; PG8_LDA(At, 0, 0); PG8_STAGE(PG8_SA(1, 1), a1 + hstep, voffA);
            PG8_WAIT_L(8); PG8_BAR; PG8_WAIT_L(0); PG8_MMA(0, 0, At, B0); PG8_BAR; PG8_SCHED;
            PG8_LDB(B1, 0, 1); PG8_STAGE(PG8_SB(0, 0), b2, voffB);
            PG8_BAR; PG8_WAIT_L(0); PG8_MMA(0, 1, At, B1); PG8_BAR;
            PG8_LDA(At, 0, 1); PG8_STAGE(PG8_SA(0, 0), a2, voffA);
            PG8_BAR; PG8_WAIT_L(0); PG8_MMA(1, 0, At, B0); PG8_BAR; PG8_SCHED;
            PG8_STAGE(PG8_SB(0, 1), b2 + hstep, voffB);
            PG8_WAIT_V(6); PG8_BAR; PG8_MMA(1, 1, At, B1); PG8_BAR;
            PG8_LDB(B0, 1, 0); PG8_SCHED; PG8_LDA(At, 1, 0); PG8_STAGE(PG8_SA(0, 1), a2 + hstep, voffA);
            PG8_WAIT_L(8); PG8_BAR; PG8_WAIT_L(0); PG8_MMA(0, 0, At, B0); PG8_BAR; PG8_SCHED;
            PG8_LDB(B1, 1, 1); PG8_STAGE(PG8_SB(1, 0), b3, voffB);
            PG8_BAR; PG8_WAIT_L(0); PG8_MMA(0, 1, At, B1); PG8_BAR;
            PG8_LDA(At, 1, 1); PG8_STAGE(PG8_SA(1, 0), a3, voffA);
            PG8_BAR; PG8_WAIT_L(0); PG8_MMA(1, 0, At, B0); PG8_BAR; PG8_SCHED;
            PG8_STAGE(PG8_SB(1, 1), b3 + hstep, voffB);
            PG8_WAIT_V(6); PG8_BAR; PG8_MMA(1, 1, At, B1); PG8_BAR;
            }
        }
        if constexpr (ALIGN_EPI) { if (wr == 0) PG8_BAR; }
        if constexpr (!Epi::AFTER_DRAIN) { E(acc, cur, wr, wc, fr, fq); S.done(cur); }
        if (!has_next) break;
#pragma unroll
        for (int a = 0; a < 2; ++a)
#pragma unroll
            for (int b = 0; b < 2; ++b)
#pragma unroll
                for (int m = 0; m < 4; ++m)
#pragma unroll
                    for (int n = 0; n < 2; ++n) acc[a][b][m][n] = (f32x4){0.f, 0.f, 0.f, 0.f};
        cur = nxt; cA = nA; cB = nB; ++ui;
        if constexpr (ALIGN_EPI) { if (wr == 1) PG8_BAR; }
    }
    PG8_WAIT_V(0);
    if constexpr (!ALIGN_EPI) { if (wr == 0) PG8_BAR; }
    PG8_BAR;
    if constexpr (Epi::AFTER_DRAIN) { E.fused(acc, cur, wr, wc, fr, fq, lds, wid, lane); S.done(cur); }
#undef PG8_SA
#undef PG8_SB
#undef PG8_STAGE
#undef PG8_LDA
#undef PG8_LDB
#undef PG8_MMA
#undef PG8_WAIT_V
#undef PG8_WAIT_L
#undef PG8_BAR
#undef PG8_SCHED
}
}

#ifndef MK_SINGLE
#define MK_SINGLE 1
#endif
constexpr int BATCH = 32, SEQ = 2048, DM = 1024, M = BATCH * SEQ;
constexpr int NIN = 3336, NPROJ = 3328;
constexpr int DFF = 2816, NUP = 2 * DFF;
constexpr int C_Q = 1792, C_K = 2048, C_V = 2304, C_O = 2816;
constexpr int NLORA = 1536, KLORA = 256;
constexpr int MH = M / 2;
constexpr float NORM_EPS = 1e-6f, LNX_EPS = 64e-5f;

constexpr size_t MiB = 1u << 20;
#ifdef PROBE
constexpr size_t WS_CTL = 0, CTL_ZERO_BYTES = 1 * MiB;
#else
constexpr size_t WS_CTL = 0, CTL_ZERO_BYTES = 32 * 1024;
#endif
constexpr size_t WS_WT_IN = 2 * MiB, WS_WT_OUT = 9 * MiB, WS_WT_UP = 11 * MiB, WS_WT_DN = 22 * MiB, WS_WT_LORA = 28 * MiB;
constexpr size_t WS_RS2 = 29 * MiB, WS_RINV = 29 * MiB + 512 * 1024, WS_SSQP = 30 * MiB, WS_GATES = 34 * MiB;
constexpr size_t WS_XN = 40 * MiB;
constexpr size_t WS_PROJ = 168 * MiB;
constexpr size_t WS_LBUF = 584 * MiB;
constexpr size_t WS_DAG = 616 * MiB;
constexpr size_t WS_MIX = 808 * MiB;
constexpr size_t WS_SIDE = 168 * MiB;
constexpr int SIDE_ELEMS = 256 * 22 * 2 * 128;
constexpr size_t WS_FF = 192 * MiB;
constexpr size_t WS_GB = 520 * MiB;
constexpr size_t WS_END = 936 * MiB;

constexpr int LDS_BYTES = 163840;
constexpr int MISC_OFF = LDS_BYTES - 256;

#define GAS __attribute__((address_space(1)))
#define LAS __attribute__((address_space(3)))
typedef unsigned short bf16;
typedef unsigned v4u __attribute__((ext_vector_type(4)));
typedef unsigned v2u __attribute__((ext_vector_type(2)));
typedef float f32x4 __attribute__((ext_vector_type(4)));
typedef float f32x2 __attribute__((ext_vector_type(2)));
typedef short bf16x8 __attribute__((ext_vector_type(8)));
typedef GAS unsigned gu32;

typedef __bf16 bf16x2_t __attribute__((ext_vector_type(2)));
__device__ __forceinline__ unsigned pk2(float lo, float hi) { const f32x2 v = {lo, hi}; const bf16x2_t b = __builtin_convertvector(v, bf16x2_t); return __builtin_bit_cast(unsigned, b); }
__device__ __forceinline__ unsigned f2bf(float f) { return pk2(f, f) & 0xffffu; }
__device__ __forceinline__ float bf2f(unsigned short u) { return __builtin_bit_cast(float, (unsigned)u << 16); }
__device__ __forceinline__ float bflo(unsigned w) { return __builtin_bit_cast(float, w << 16); }
__device__ __forceinline__ float bfhi(unsigned w) { return __builtin_bit_cast(float, w & 0xffff0000u); }
__device__ __forceinline__ void unpack8(const v4u w, float (&o)[8]) { o[0] = bflo(w.x); o[1] = bfhi(w.x); o[2] = bflo(w.y); o[3] = bfhi(w.y); o[4] = bflo(w.z); o[5] = bfhi(w.z); o[6] = bflo(w.w); o[7] = bfhi(w.w); }
__device__ __forceinline__ v4u pack8(const float (&o)[8]) { v4u w; w.x = pk2(o[0], o[1]); w.y = pk2(o[2], o[3]); w.z = pk2(o[4], o[5]); w.w = pk2(o[6], o[7]); return w; }
__device__ __forceinline__ float frcp(float x) { return __builtin_amdgcn_rcpf(x); }
__device__ __forceinline__ float frsq(float x) { return __builtin_amdgcn_rsqf(x); }
__device__ __forceinline__ float fsqrt_(float x) { return __builtin_amdgcn_sqrtf(x); }
__device__ __forceinline__ float fexp(float x) { return __builtin_amdgcn_exp2f(x * 1.4426950408889634f); }
__device__ __forceinline__ float sigmoidf_(float x) { return frcp(1.0f + __builtin_amdgcn_exp2f(x * -1.4426950408889634f)); }
__device__ __forceinline__ float tanhf_(float x) { return 1.0f - 2.0f * frcp(__builtin_amdgcn_exp2f(x * 2.8853900817779268f) + 1.0f); }
__device__ __forceinline__ float softplusf_(float x) { return fmaxf(x, 0.f) + __logf(1.0f + fexp(-fabsf(x))); }
__device__ __forceinline__ float wave_sum(float v) {
#pragma unroll
    for (int o = 1; o < 64; o <<= 1) v += __shfl_xor(v, o);
    return v;
}
template <int CTRL> __device__ __forceinline__ float dppmov(float v) { return __builtin_bit_cast(float, __builtin_amdgcn_update_dpp(0, __builtin_bit_cast(int, v), CTRL, 0xF, 0xF, true)); }
__device__ __forceinline__ float red8(float v) { v += dppmov<0xB1>(v); v += dppmov<0x4E>(v); v += dppmov<0x141>(v); return v; }
__device__ __forceinline__ float red16(float v) { v += dppmov<0xB1>(v); v += dppmov<0x4E>(v); v += dppmov<0x141>(v); v += dppmov<0x140>(v); return v; }

template <int CTRL, int RMASK> __device__ __forceinline__ float dppsh(float idv, float v) { return __builtin_bit_cast(float, __builtin_amdgcn_update_dpp(__builtin_bit_cast(int, idv), __builtin_bit_cast(int, v), CTRL, RMASK, 0xF, false)); }
template <int CTRL> __device__ __forceinline__ v4u dpp4(const v4u old, const v4u v) { v4u r;
    r.x = (unsigned)__builtin_amdgcn_update_dpp((int)old.x, (int)v.x, CTRL, 0xF, 0xF, false); r.y = (unsigned)__builtin_amdgcn_update_dpp((int)old.y, (int)v.y, CTRL, 0xF, 0xF, false);
    r.z = (unsigned)__builtin_amdgcn_update_dpp((int)old.z, (int)v.z, CTRL, 0xF, 0xF, false); r.w = (unsigned)__builtin_amdgcn_update_dpp((int)old.w, (int)v.w, CTRL, 0xF, 0xF, false); return r; }
__device__ __forceinline__ float wave_scan_add(float v) {
    v += dppsh<0x111, 0xF>(0.f, v); v += dppsh<0x112, 0xF>(0.f, v); v += dppsh<0x114, 0xF>(0.f, v); v += dppsh<0x118, 0xF>(0.f, v);
    v += dppsh<0x142, 0xA>(0.f, v); v += dppsh<0x143, 0xC>(0.f, v); return v;
}
__device__ __forceinline__ float wave_scan_max(float v) {
    const float ni = -3.0e38f;
    v = fmaxf(v, dppsh<0x111, 0xF>(ni, v)); v = fmaxf(v, dppsh<0x112, 0xF>(ni, v)); v = fmaxf(v, dppsh<0x114, 0xF>(ni, v)); v = fmaxf(v, dppsh<0x118, 0xF>(ni, v));
    v = fmaxf(v, dppsh<0x142, 0xA>(ni, v)); v = fmaxf(v, dppsh<0x143, 0xC>(ni, v)); return v;
}

#define XB_TMO      128
#define XB_XCNT(j)  (256  + 64 * (j))
#define XB_XSUB(j)  (1280 + 64 * (j))
#define XB_XGEN(j)  (2304 + 64 * (j))
#define XB_TOP      3328
#define XB_TOPGEN   3392
#define XCD_BAR_WORDS 3456
#define XB_SPIN_CAP (1u << 22)
__device__ __forceinline__ void mk_sync() { __builtin_amdgcn_fence(__ATOMIC_RELEASE, "workgroup"); __builtin_amdgcn_s_barrier(); __builtin_amdgcn_fence(__ATOMIC_ACQUIRE, "workgroup"); }
__device__ __forceinline__ unsigned xb_ld(unsigned* p)              { return __hip_atomic_load(p, __ATOMIC_RELAXED, __HIP_MEMORY_SCOPE_AGENT); }
__device__ __forceinline__ unsigned xb_add(unsigned* p, unsigned v) { return __hip_atomic_fetch_add(p, v, __ATOMIC_RELAXED, __HIP_MEMORY_SCOPE_AGENT); }
__device__ __forceinline__ unsigned xb_xcc_id() { return (unsigned)__builtin_amdgcn_s_getreg((3 << 11) | 20) & 0xFu; }
#define XB_SPIN(cond, bar) do { unsigned _sp = 0; while (cond) { __builtin_amdgcn_s_sleep(1); \
    if ((++_sp & 255u) == 0u) { if (xb_ld(&(bar)[XB_TMO])) break; if (_sp > XB_SPIN_CAP) { atomicAdd(&(bar)[XB_TMO], 1u); break; } } } } while (0)
struct XcdBarrier { unsigned* bar; unsigned x; volatile LAS unsigned* st; };
__device__ __forceinline__ XcdBarrier xcd_barrier_post(unsigned* bar, volatile LAS unsigned* st, bool leader) {
    XcdBarrier b; b.bar = bar; b.x = xb_xcc_id(); b.st = st;
    if (leader) (void)xb_add(&bar[XB_XCNT(b.x)], 1u);
    return b;
}
__device__ __forceinline__ void xcd_barrier_complete(unsigned* bar, unsigned x, unsigned& nloc, unsigned& nx) {
    const unsigned G = gridDim.x * gridDim.y * gridDim.z;
    unsigned sum, cnt, mine, sp = 0u;
    for (;;) {
        sum = 0u; cnt = 0u; mine = 0u;
#pragma unroll
        for (unsigned j = 0; j < 16; ++j) { const unsigned c = xb_ld(&bar[XB_XCNT(j)]); sum += c; cnt += (c > 0u) ? 1u : 0u; mine = (j == x) ? c : mine; }
        if (sum == G) break;
        __builtin_amdgcn_s_sleep(1);
        if ((++sp & 255u) == 0u) { if (xb_ld(&bar[XB_TMO])) break; if (sp > XB_SPIN_CAP) { atomicAdd(&bar[XB_TMO], 1u); break; } }
    }
    nloc = mine > 0u ? mine : 1u; nx = cnt > 0u ? cnt : 1u;
}
__device__ __forceinline__ void xcd_barrier(const XcdBarrier& b, bool leader) {
    asm volatile("s_waitcnt vmcnt(0)" ::: "memory");
    mk_sync();
    if (leader) {
        unsigned* bar = b.bar;
        __builtin_amdgcn_s_waitcnt(0);
        unsigned nloc = b.st[0], nx = b.st[1];
        if (nloc == 0u) { xcd_barrier_complete(bar, b.x, nloc, nx); b.st[0] = nloc; b.st[1] = nx; }
        const unsigned old = xb_add(&bar[XB_XSUB(b.x)], 1u);
        const unsigned gen = old / nloc;
        if (old + 1u == (gen + 1u) * nloc) {
            __builtin_amdgcn_fence(__ATOMIC_RELEASE, "agent");
            asm volatile("s_waitcnt vmcnt(0)" ::: "memory");
            const unsigned og = xb_add(&bar[XB_TOP], 1u);
            const unsigned tg = og / nx;
            if (og + 1u == (tg + 1u) * nx) xb_add(&bar[XB_TOPGEN], 1u);
            else XB_SPIN(xb_ld(&bar[XB_TOPGEN]) == tg, bar);
            __builtin_amdgcn_fence(__ATOMIC_ACQUIRE, "agent");
            xb_add(&bar[XB_XGEN(b.x)], 1u);
            asm volatile("s_waitcnt vmcnt(0)" ::: "memory");
        } else {
            XB_SPIN(xb_ld(&bar[XB_XGEN(b.x)]) == gen, bar);
            __builtin_amdgcn_fence(__ATOMIC_ACQUIRE, "agent");
            asm volatile("s_waitcnt vmcnt(0)" ::: "memory");
        }
    }
    mk_sync();
}

__device__ __forceinline__ int opaque_i(int v) { asm volatile("" : "+s"(v)); return v; }
#define LDS_BARRIER() do { asm volatile("s_waitcnt lgkmcnt(0)" ::: "memory"); __builtin_amdgcn_s_barrier(); asm volatile("" ::: "memory"); } while (0)
__device__ __forceinline__ int mk_lane_id() { int x; asm volatile("v_mbcnt_lo_u32_b32 %0, -1, 0\n\tv_mbcnt_hi_u32_b32 %0, -1, %0" : "=v"(x)); return x; }
struct Args { const float* in[26]; float* out; unsigned char* ws; int ph_lo, ph_hi; };

namespace pg8 {
struct PairPanelOrder {
    int c;
    __device__ bool next(int i, Unit& u) const { if (i >= 12) return false; u.pm = 2 * c + i / 6; u.pn = i % 6; return true; }
    __device__ __forceinline__ void a_ready(const Unit&) const {}
    __device__ __forceinline__ void done(const Unit&) const {}
};
struct PanelOrder {
    int c;
    __device__ bool next(int i, Unit& u) const { if (i >= 4) return false; u.pm = c; u.pn = i; return true; }
    __device__ __forceinline__ void a_ready(const Unit&) const {}
    __device__ __forceinline__ void done(const Unit&) const {}
};
struct EpiResid {
    static constexpr bool PERM = true, AFTER_DRAIN = false;
    bf16_t* XB; const float* rinv; float* ssqp;
    __device__ __forceinline__ void operator()(const f32x4 (&acc)[2][2][4][2], const Unit& u, int wr, int wc, int fr, int fq) const {
        const int row0 = u.pm * BM + wr * 64 + fr, col0 = u.pn * BM + wc * 32 + 8 * fq;
        const __amdgpu_buffer_rsrc_t xrr = wt_rsrc(XB);
#pragma unroll
        for (int ai = 0; ai < 2; ++ai) {
            u32x4 xin[4][2]; float ri[4];
#pragma unroll
            for (int m = 0; m < 4; ++m) { const int row = row0 + ai * HALF + m * 16; ri[m] = rinv[row];
#pragma unroll
                for (int bj = 0; bj < 2; ++bj) xin[m][bj] = *(const u32x4*)(XB + (size_t)row * DM + col0 + bj * HALF); }
            asm volatile("" ::: "memory");
#pragma unroll
            for (int m = 0; m < 4; ++m) { const int row = row0 + ai * HALF + m * 16; float ss = 0.f;
#pragma unroll
                for (int bj = 0; bj < 2; ++bj) { const size_t off = (size_t)row * DM + col0 + bj * HALF;
                    float xv[8]; unpack8(xin[m][bj], xv);
                    float v[8];
#pragma unroll
                    for (int j = 0; j < 4; ++j) { v[j] = acc[ai][bj][m][0][j] + xv[j] * ri[m]; v[4 + j] = acc[ai][bj][m][1][j] + xv[4 + j] * ri[m]; }
#pragma unroll
                    for (int j = 0; j < 8; ++j) ss += v[j] * v[j];
                    wt_store16(xrr, XB, off * 2, pack8(v)); }
                ss += __shfl_xor(ss, 16); ss += __shfl_xor(ss, 32);
                if (fq == 0) ssqp[(size_t)row * 16 + u.pn * 4 + wc] = ss; }
            asm volatile("" ::: "memory");
        }
    }
};
struct EpiScale {
    static constexpr bool PERM = true, AFTER_DRAIN = false;
    bf16_t* O; int ldc; const float* rs; int row_off;
    __device__ __forceinline__ void operator()(const f32x4 (&acc)[2][2][4][2], const Unit& u, int wr, int wc, int fr, int fq) const {
        const int row0 = u.pm * BM + wr * 64 + fr, col0 = u.pn * BM + wc * 32 + 8 * fq;
#pragma unroll
        for (int ai = 0; ai < 2; ++ai)
#pragma unroll
            for (int m = 0; m < 4; ++m) { const int row = row0 + ai * HALF + m * 16; const float s = rs[row_off + row]; bf16_t* rowp = O + (size_t)row * ldc + col0;
#pragma unroll
                for (int bj = 0; bj < 2; ++bj) { const f32x4 v0 = acc[ai][bj][m][0] * s, v1 = acc[ai][bj][m][1] * s;
                    u32x4 w; w.x = pk2(v0[0], v0[1]); w.y = pk2(v0[2], v0[3]); w.z = pk2(v1[0], v1[1]); w.w = pk2(v1[2], v1[3]); *(u32x4*)(rowp + bj * HALF) = w; } }
    }
};
struct EpiFfn {
    static constexpr bool PERM = true, AFTER_DRAIN = false;
    bf16_t* G; const float* rs; const float* cw; const float* cb; float* SA; float* SB; float* SL; LAS float* hal;
    __device__ __forceinline__ void operator()(const f32x4 (&acc)[2][2][4][2], const Unit& u, int wr, int wc, int fr, int fq) const {
        int chl = wc * 32 + 8 * fq; asm volatile("" : "+v"(chl));
        const int f0 = u.pn * 128 + chl, rowt = wr * 64 + fr;
        const __amdgpu_buffer_rsrc_t grr = wt_rsrc(G);
        float rsv[2][4];
#pragma unroll
        for (int ai = 0; ai < 2; ++ai)
#pragma unroll
            for (int m = 0; m < 4; ++m) rsv[ai][m] = rs[u.pm * BM + ai * HALF + m * 16 + rowt];
        const size_t sbase = ((size_t)(u.pm * 22 + u.pn) * 2) * 128 + chl;
        if (fr >= 14) {
#pragma unroll
            for (int ai = 0; ai < 2; ++ai) { const float r_ = rsv[ai][3]; const f32x4 v0 = acc[ai][0][3][0] * r_, v1 = acc[ai][0][3][1] * r_;
                LAS float* hp = hal + ((ai * 2 + wr) * 2 + (fr - 14)) * 128 + chl; *(LAS f32x4*)hp = v0; *(LAS f32x4*)(hp + 4) = v1;
                if (ai == 1 && wr == 1) { float* gp = SL + sbase + (fr - 14) * 128; *(f32x4*)gp = v0; *(f32x4*)(gp + 4) = v1; } }
        }
        if (wr == 0 && fr < 2) { const float r_ = rsv[0][0]; float* ga = SA + sbase + fr * 128; float* gb = SB + sbase + fr * 128;
            *(f32x4*)ga = acc[0][0][0][0] * r_; *(f32x4*)(ga + 4) = acc[0][0][0][1] * r_; *(f32x4*)gb = acc[0][1][0][0] * r_; *(f32x4*)(gb + 4) = acc[0][1][0][1] * r_; }
        asm volatile("s_waitcnt lgkmcnt(0)" ::: "memory"); __builtin_amdgcn_s_barrier(); asm volatile("" ::: "memory");
        float w0[8], w1[8], w2[8], bz[8];
        { const f32x4 a0 = *(const f32x4*)(cw + f0), a1 = *(const f32x4*)(cw + f0 + 4), b0 = *(const f32x4*)(cw + DFF + f0), b1 = *(const f32x4*)(cw + DFF + f0 + 4);
          const f32x4 c0 = *(const f32x4*)(cw + 2 * DFF + f0), c1 = *(const f32x4*)(cw + 2 * DFF + f0 + 4), d0 = *(const f32x4*)(cb + f0), d1 = *(const f32x4*)(cb + f0 + 4);
#pragma unroll
          for (int j = 0; j < 4; ++j) { w0[j] = a0[j]; w0[4 + j] = a1[j]; w1[j] = b0[j]; w1[4 + j] = b1[j]; w2[j] = c0[j]; w2[4 + j] = c1[j]; bz[j] = d0[j]; bz[4 + j] = d1[j]; } }
        const bool fr0 = (fr == 0), frl2 = (fr < 2); (void)fr0;
#pragma unroll
        for (int ai = 0; ai < 2; ++ai) {
            float ap[8];
            const int pb = ai * 2 + wr - 1;
#pragma unroll
            for (int m = 0; m < 4; ++m) {
                float av[8], bv[8], y1[8], y2[8];
                const float r_ = rsv[ai][m];
#pragma unroll
                for (int j = 0; j < 4; ++j) { av[j] = acc[ai][0][m][0][j] * r_; av[4 + j] = acc[ai][0][m][1][j] * r_; bv[j] = acc[ai][1][m][0][j] * r_; bv[4 + j] = acc[ai][1][m][1][j] * r_; }
                if (m == 0) {
                    if (pb >= 0) { const LAS float* h0 = hal + (pb * 2) * 128 + chl; const f32x4 h00 = *(const LAS f32x4*)h0, h01 = *(const LAS f32x4*)(h0 + 4), h10 = *(const LAS f32x4*)(h0 + 128), h11 = *(const LAS f32x4*)(h0 + 132);
#pragma unroll
                        for (int j = 0; j < 4; ++j) { y1[j] = h10[j]; y1[4 + j] = h11[j]; y2[j] = fr0 ? h00[j] : h10[j]; y2[4 + j] = fr0 ? h01[j] : h11[j]; } }
                    else {
#pragma unroll
                        for (int j = 0; j < 8; ++j) { y1[j] = 0.f; y2[j] = 0.f; } }
                } else {
#pragma unroll
                    for (int j = 0; j < 8; ++j) { y1[j] = dppmov<0x121>(ap[j]); y2[j] = dppmov<0x122>(ap[j]); }
                }
                float o[8];
#pragma unroll
                for (int j = 0; j < 8; ++j) { const float am1 = dppsh<0x111, 0xF>(y1[j], av[j]), am2 = dppsh<0x112, 0xF>(y2[j], av[j]);
                    const float z = bz[j] + w0[j] * am2 + w1[j] * am1 + w2[j] * av[j];
                    o[j] = z * sigmoidf_(z) * bv[j]; ap[j] = av[j]; }
                if (!(ai == 0 && m == 0 && wr == 0 && frl2)) wt_store16(grr, G, ((size_t)(u.pm * BM + ai * HALF + m * 16 + rowt) * DFF + f0) * 2, pack8(o));
            }
        }
    }
};
}

template <bool FFN_UP = false>
__device__ __forceinline__ void transpose_item(const float* W, int ldw, int K, bf16* WT, const float* kscale, LAS float* scr, int item, int nblk, int lane) {
    const int kb = item / nblk, nb = item % nblk, k0 = 64 * kb, n0 = 32 * nb;
    const int d0 = !FFN_UP ? n0 : (n0 < DFF ? ((n0 >> 7) * 256 + (n0 & 127)) : ((((n0 - DFF) >> 7) * 256) + 128 + ((n0 - DFF) & 127)));
#pragma unroll 8
    for (int i = 0; i < 32; ++i) { const int kk = 2 * i + (lane >> 5); const float s = kscale ? kscale[k0 + kk] : 1.0f; scr[kk * 33 + (lane & 31)] = W[(size_t)(k0 + kk) * ldw + n0 + (lane & 31)] * s; }
    asm volatile("s_waitcnt lgkmcnt(0)" ::: "memory");
    const int c = lane & 7;
#pragma unroll
    for (int j = 0; j < 4; ++j) { const int n = (lane >> 3) + 8 * j; const LAS float* s = scr + (8 * c) * 33 + n;
        v4u o; o.x = pk2(s[0 * 33], s[1 * 33]); o.y = pk2(s[2 * 33], s[3 * 33]); o.z = pk2(s[4 * 33], s[5 * 33]); o.w = pk2(s[6 * 33], s[7 * 33]);
        *(v4u*)(WT + (size_t)(d0 + n) * K + k0 + 8 * c) = o; }
    asm volatile("s_waitcnt lgkmcnt(0)" ::: "memory");
}

__device__ __forceinline__ float wave_red63(float v) {
    v += dppmov<0xB1>(v); v += dppmov<0x4E>(v); v += dppmov<0x141>(v); v += dppmov<0x140>(v);
    v += dppsh<0x142, 0xA>(0.f, v); v += dppsh<0x143, 0xC>(0.f, v); return v;
}
__device__ __forceinline__ float lane63(float v) { return __builtin_bit_cast(float, __builtin_amdgcn_readlane(__builtin_bit_cast(int, v), 63)); }
__device__ __forceinline__ void late_transposes(const Args& a, LAS unsigned char* lds, int lane, int wave, int gw, int NGW) {
    unsigned char* ws = a.ws; LAS float* scr = (LAS float*)(lds + wave * 16384);
    constexpr int I_UP = 16 * 176, I_DN = 44 * 32;
    for (int it = gw; it < I_UP + I_DN; it += NGW) {
        int r = it;
        if (r < I_UP) { transpose_item<true>(a.in[21], NUP, DM, (bf16*)(ws + WS_WT_UP), a.in[20], scr, r, 176, lane); continue; } r -= I_UP;
        transpose_item(a.in[24], DM, DFF, (bf16*)(ws + WS_WT_DN), nullptr, scr, r, 32, lane);
    }
}
__device__ __forceinline__ void phase_prep(const Args& a, LAS unsigned char* lds, int tid, int lane, int wave) {
    unsigned char* ws = a.ws;
    LAS float* scr = (LAS float*)(lds + wave * 16384);
    const int gw = blockIdx.x * 8 + wave, NGW = gridDim.x * 8;
    constexpr int I_IN = 16 * 104;
    constexpr int I_OUT0 = 16 * 32;
    for (int it = gw; it < I_IN + I_OUT0; it += NGW) {
        if (it < I_IN) transpose_item(a.in[2], NIN, DM, (bf16*)(ws + WS_WT_IN), a.in[1], scr, it, 104, lane);
        else transpose_item(a.in[19], DM, DM, (bf16*)(ws + WS_WT_OUT), nullptr, scr, it - I_IN, 32, lane);
    }
    {
        const float* wd = a.in[5]; const float* wa = a.in[7]; const float* wg = a.in[8]; bf16* WL = (bf16*)(ws + WS_WT_LORA);
        for (int idx = blockIdx.x * 512 + tid; idx < NLORA * KLORA; idx += gridDim.x * 512) {
            const int n = idx >> 8, k = idx & 255; float v = 0.f;
            if (n < 512) { if (k < 64) v = wd[k * 512 + n]; }
            else if (n < 1024) { if (k >= 64 && k < 128) v = wa[(k - 64) * 512 + (n - 512)]; }
            else { if (k >= 128) v = wg[(k - 128) * 512 + (n - 1024)]; }
            WL[idx] = (bf16)f2bf(v);
        }
    }
    {
        const float* x = a.in[0]; const float* g1 = a.in[1]; const float* w_in = a.in[2];
        bf16* XN = (bf16*)(ws + WS_XN); float* gates = (float*)(ws + WS_GATES); float* rinvp = (float*)(ws + WS_RINV);
        float wgt[16][8];
#pragma unroll
        for (int j = 0; j < 4; ++j)
#pragma unroll
            for (int e = 0; e < 4; ++e) { const int k = 4 * lane + 256 * j + e; const float g = g1[k];
                const f32x4 w0 = *(const f32x4*)(w_in + (size_t)k * NIN + 3328), w1 = *(const f32x4*)(w_in + (size_t)k * NIN + 3332);
                wgt[j * 4 + e][0] = w0[0] * g; wgt[j * 4 + e][1] = w0[1] * g; wgt[j * 4 + e][2] = w0[2] * g; wgt[j * 4 + e][3] = w0[3] * g;
                wgt[j * 4 + e][4] = w1[0] * g; wgt[j * 4 + e][5] = w1[1] * g; wgt[j * 4 + e][6] = w1[2] * g; wgt[j * 4 + e][7] = w1[3] * g; }
        f32x4 vn[4];
        { const f32x4* xr = (const f32x4*)(x + (size_t)gw * DM) + lane;
#pragma unroll
          for (int j = 0; j < 4; ++j) vn[j] = xr[64 * j]; }
        for (int row = gw; row < M; row += NGW) {
            f32x4 v[4];
#pragma unroll
            for (int j = 0; j < 4; ++j) v[j] = vn[j];
            { const int rn = (row + NGW < M) ? row + NGW : row; const f32x4* xr = (const f32x4*)(x + (size_t)rn * DM) + lane;
#pragma unroll
              for (int j = 0; j < 4; ++j) vn[j] = xr[64 * j]; }
            float ss = 0.f;
#pragma unroll
            for (int j = 0; j < 4; ++j) ss += (v[j][0] * v[j][0] + v[j][1] * v[j][1]) + (v[j][2] * v[j][2] + v[j][3] * v[j][3]);
            float gs[8];
#pragma unroll
            for (int jg = 0; jg < 8; ++jg) { float s_ = 0.f;
#pragma unroll
                for (int j = 0; j < 4; ++j)
#pragma unroll
                    for (int e = 0; e < 4; ++e) s_ += v[j][e] * wgt[j * 4 + e][jg];
                gs[jg] = s_; }
            ss = wave_red63(ss);
#pragma unroll
            for (int jg = 0; jg < 8; ++jg) gs[jg] = wave_red63(gs[jg]);
            const float ms = lane63(ss) * (1.0f / DM) + NORM_EPS; const float rs = frsq(ms);
            if (lane == 0) rinvp[row] = fsqrt_(ms);
            unsigned long long* o8 = (unsigned long long*)(XN + (size_t)row * DM) + lane;
#pragma unroll
            for (int j = 0; j < 4; ++j) o8[64 * j] = (unsigned long long)pk2(v[j][0] * rs, v[j][1] * rs) | ((unsigned long long)pk2(v[j][2] * rs, v[j][3] * rs) << 32);
            if (lane == 63) { f32x4* gp = (f32x4*)(gates + (size_t)row * 8); gp[0] = (f32x4){gs[0] * rs, gs[1] * rs, gs[2] * rs, gs[3] * rs}; gp[1] = (f32x4){gs[4] * rs, gs[5] * rs, gs[6] * rs, gs[7] * rs}; }
        }
    }
}

__device__ __forceinline__ void phase_lmat(const Args& a, int tid, int row_lo, int nrows) {
    unsigned char* ws = a.ws; const bf16* PROJ = (const bf16*)(ws + WS_PROJ); bf16* L = (bf16*)(ws + WS_LBUF); const float* mu = a.in[3];
    for (int it0 = tid; it0 < nrows * 32; it0 += 4 * 512) {
        v4u cur[4], prv[4];
#pragma unroll
        for (int u = 0; u < 4; ++u) { const int it = it0 + u * 512; const int row = row_lo + (it >> 5), c0 = 1536 + 8 * (it & 31);
            cur[u] = *(const v4u*)(PROJ + (size_t)row * NPROJ + c0);
            prv[u] = (v4u){0u, 0u, 0u, 0u}; if ((row & (SEQ - 1)) != 0) prv[u] = *(const v4u*)(PROJ + (size_t)(row - 1) * NPROJ + c0); }
#pragma unroll
        for (int u = 0; u < 4; ++u) { const int it = it0 + u * 512; const int row = row_lo + (it >> 5), grp = it & 31, c0 = 1536 + 8 * grp;
            const f32x4 m0 = *(const f32x4*)(mu + c0), m1 = *(const f32x4*)(mu + c0 + 4);
            float c[8], p[8], o[8]; unpack8(cur[u], c); unpack8(prv[u], p);
#pragma unroll
            for (int e = 0; e < 8; ++e) { const float mm = e < 4 ? m0[e & 3] : m1[e & 3]; const float xv = c[e] + (p[e] - c[e]) * mm;
                o[e] = grp < 8 ? tanhf_(xv) : (grp < 16 ? xv : sigmoidf_(xv)); }
            *(v4u*)(L + (size_t)row * KLORA + 8 * grp) = pack8(o); }
    }
}

constexpr int RK_SLOT = 64 * 64;
__device__ __forceinline__ int rk_off(int row, int col) { return row * 64 + ((((col >> 3) ^ row) & 7) << 3) + (col & 7); }
__device__ __forceinline__ f32x4 mfma16(const bf16x8 a, const bf16x8 b, const f32x4 c) { return __builtin_amdgcn_mfma_f32_16x16x32_bf16(a, b, c, 0, 0, 0); }
__device__ __forceinline__ void rk_frag(bf16x8 (&f)[2], const LAS bf16* base, int row0, int l15, int l4) { const LAS bf16* p = base + (row0 + l15) * 64; f[0] = *(const LAS bf16x8*)(p + ((l4 ^ (l15 & 7)) << 3)); f[1] = *(const LAS bf16x8*)(p + (((4 + l4) ^ (l15 & 7)) << 3)); }
struct RkF2 { bf16x8 f[2][2]; };
struct RkLane { int lo, so, l15, l4, to; };
__device__ __forceinline__ int rk_offT(int row, int col) { return row * 64 + ((((col >> 3) ^ ((row & 3) | ((row >> 1) & 4))) & 7) << 3) + (col & 7); }
__device__ __forceinline__ RkLane rk_lane(int lane) { asm volatile("" : "+v"(lane)); const int l15 = lane & 15, l4 = lane >> 4; RkLane r; r.l15 = l15; r.l4 = l4; r.lo = l15 * 64 + ((l4 ^ (l15 & 7)) << 3); r.so = l15 * 64 + ((((l4 >> 1) ^ (l15 & 7))) << 3) + 4 * (l4 & 1);
    r.to = rk_offT(8 * l4 + (l15 >> 2), 4 * (l15 & 3)); return r; }
typedef short s16x4_t __attribute__((ext_vector_type(4)));
__device__ __forceinline__ RkF2 rk_ld2_tr(const LAS bf16* base, int blk, const RkLane& L) { RkF2 r;
#pragma unroll
    for (int ti = 0; ti < 2; ++ti)
#pragma unroll
        for (int kh = 0; kh < 2; ++kh) { const LAS bf16* p = base + (L.to ^ ((4 * blk + 2 * ti) << 3)) + 32 * kh * 64;
            const s16x4_t a = __builtin_amdgcn_ds_read_tr16_b64_v4i16((LAS s16x4_t*)p), b = __builtin_amdgcn_ds_read_tr16_b64_v4i16((LAS s16x4_t*)(p + 4 * 64));
            r.f[ti][kh] = (bf16x8){a.x, a.y, a.z, a.w, b.x, b.y, b.z, b.w}; }
    return r; }
__device__ __forceinline__ RkF2 rk_ld2(const LAS bf16* base, int blk, const RkLane& L) { RkF2 r;
#pragma unroll
    for (int ti = 0; ti < 2; ++ti) { const int i0 = (32 * blk + 16 * ti) * 64 + L.lo; r.f[ti][0] = *(const LAS bf16x8*)(base + i0); r.f[ti][1] = *(const LAS bf16x8*)(base + (i0 ^ 32)); }
    return r; }
template <bool ACC> __device__ __forceinline__ void rk_mm2(f32x4 (&acc)[2][2], const RkF2& a, const RkF2& b) {
#pragma unroll
    for (int mi = 0; mi < 2; ++mi)
#pragma unroll
        for (int ni = 0; ni < 2; ++ni) { f32x4 c = ACC ? acc[mi][ni] : (f32x4){0.f, 0.f, 0.f, 0.f}; c = mfma16(a.f[mi][0], b.f[ni][0], c); acc[mi][ni] = mfma16(a.f[mi][1], b.f[ni][1], c); }
}
__device__ __forceinline__ void rk_store2(LAS bf16* dst, const f32x4 (&acc)[2][2], int mB, int nB, const RkLane& L) {
#pragma unroll
    for (int mi = 0; mi < 2; ++mi)
#pragma unroll
        for (int ni = 0; ni < 2; ++ni) { v2u w; w.x = pk2(acc[mi][ni][0], acc[mi][ni][1]); w.y = pk2(acc[mi][ni][2], acc[mi][ni][3]); *(LAS v2u*)(dst + (16 * (2 * nB + ni)) * 64 + (L.so ^ (16 * (2 * mB + mi)))) = w; }
}
template <int MODE> __device__ __forceinline__ void rk_mask2(f32x4 (&d)[2][2], int mB, int nB, int l15, int l4) {
#pragma unroll
    for (int mi = 0; mi < 2; ++mi)
#pragma unroll
        for (int ni = 0; ni < 2; ++ni) { const int mt = 2 * mB + mi, nt = 2 * nB + ni;
            const bool zero = MODE == 1 ? (mt < nt) : (mt > nt);
            if (zero) d[mi][ni] = (f32x4){0.f, 0.f, 0.f, 0.f};
            else if (mt == nt) {
#pragma unroll
                for (int r = 0; r < 4; ++r) { const int m_ = 4 * l4 + r; const bool keep = MODE == 0 ? (m_ < l15) : MODE == 1 ? (l15 < m_) : (m_ <= l15); d[mi][ni][r] = keep ? d[mi][ni][r] : 0.f; } } }
}
template <int DBG = 0> __device__ __forceinline__ void rwkv_unit_split(const Args& a, LAS unsigned char* lds, int unit, int tid, int lane, int wave) {
    unsigned char* ws = a.ws; const bf16* PROJ = (const bf16*)(ws + WS_PROJ); const bf16* DAG = (const bf16*)(ws + WS_DAG); bf16* MIX = (bf16*)(ws + WS_MIX);
    const int b = unit >> 3, h = unit & 7;
    LAS bf16* slot = (LAS bf16*)lds;
#define RK_S(k) (slot + (k) * RK_SLOT)
    LAS bf16* Ab = RK_S(0); LAS bf16* Bb = RK_S(1); LAS bf16* Kb = RK_S(2); LAS bf16* Rb = RK_S(3); LAS bf16* KhT = RK_S(4);
    LAS bf16* P0 = RK_S(7); LAS bf16* P0T = RK_S(8); LAS float* Yl = (LAS float*)RK_S(7);
    LAS bf16* Aak = RK_S(9); LAS bf16* Ut = RK_S(9); LAS bf16* Arb = RK_S(10); LAS bf16* Ark = RK_S(11); LAS bf16* TA = RK_S(12); LAS bf16* TB = RK_S(13); LAS bf16* Xt = RK_S(14); LAS bf16* Sb = RK_S(15);
    LAS float* g63 = (LAS float*)RK_S(18); LAS float* bon = g63 + 128; LAS float* ssP = bon + 128; LAS float* bnP = ssP + 256; LAS float* cst = bnP + 256;
    const int wq = wave & 3;
    { int t_ = tid; asm volatile("" : "+v"(t_));
      if (t_ < 64) { const int j = h * 64 + t_;
        cst[t_] = a.in[3][j]; cst[64 + t_] = a.in[3][512 + j]; cst[128 + t_] = a.in[3][1024 + j]; cst[192 + t_] = a.in[9][j]; cst[256 + t_] = a.in[10][j];
        cst[320 + t_] = a.in[11][j]; cst[384 + t_] = a.in[4][j]; cst[448 + t_] = a.in[6][j]; cst[512 + t_] = a.in[12][j]; cst[576 + t_] = a.in[13][j]; }
      for (int i = t_; i < RK_SLOT / 2; i += 512) ((LAS unsigned*)Sb)[i] = 0u; }
    if (wave < 4) {
        const int jw = 16 * wq;
        v4u g_rc[2], g_kc[2], g_vc[2], g_rp[2], g_kp[2], g_vp[2], g_ld[2], g_a[2];
#define RKS_LOAD(c_, PART) do { int ln_ = lane; asm volatile("" : "+v"(ln_)); const int t_ = b * SEQ + (c_) * 64 + ln_; const bf16* pr_ = PROJ + (size_t)t_ * NPROJ + h * 64 + jw; const bf16* dg_ = DAG + (size_t)t_ * NLORA + h * 64 + jw; \
        _Pragma("unroll") for (int hh = 0; hh < 2; ++hh) { \
            if ((PART) == 0) { g_rc[hh] = *(const v4u*)(pr_ + 8 * hh); g_kc[hh] = *(const v4u*)(pr_ + 512 + 8 * hh); } \
            if ((PART) == 1) { g_vc[hh] = *(const v4u*)(pr_ + 1024 + 8 * hh); g_ld[hh] = *(const v4u*)(dg_ + 8 * hh); } \
            if ((PART) == 2) { g_a[hh] = *(const v4u*)(dg_ + 512 + 8 * hh); \
                if ((c_) == 0 && ln_ == 0) g_rp[hh] = (v4u){0u, 0u, 0u, 0u}; else g_rp[hh] = *(const v4u*)(pr_ - NPROJ + 8 * hh); } \
            if ((PART) == 3) { if ((c_) == 0 && ln_ == 0) { g_kp[hh] = (v4u){0u, 0u, 0u, 0u}; g_vp[hh] = g_kp[hh]; } \
                else { g_kp[hh] = *(const v4u*)(pr_ - NPROJ + 512 + 8 * hh); g_vp[hh] = *(const v4u*)(pr_ - NPROJ + 1024 + 8 * hh); } } } } while (0)
        RKS_LOAD(0, 0); RKS_LOAD(0, 1); RKS_LOAD(0, 2); RKS_LOAD(0, 3);
        LDS_BARRIER();
#ifdef PROBE_SEG_A
        unsigned long long seg_acc = 0, seg_t0 = 0; bool seg_on = false;
#define SEGT(k) do { if ((k) == PROBE_SEG_B && seg_on) { seg_acc += __builtin_amdgcn_s_memrealtime() - seg_t0; seg_on = false; } if ((k) == PROBE_SEG_A) { seg_t0 = __builtin_amdgcn_s_memrealtime(); seg_on = true; } } while (0)
#else
#define SEGT(k) do { } while (0)
#endif
        for (int it = 0; it <= SEQ / 64; ++it) {
            const bool act = DBG != 1 && it < SEQ / 64; const int p = it & 1;
            LAS bf16* BhTp = RK_S(5 + 11 * p); LAS bf16* Vtp = RK_S(6 + 11 * p);
            float rr[2][8], km[2][8], av[2][8], lgw[2][8], kkr[2][8];
            v4u pA[2], pR[2], pB[2], pK[2], pKh[2];
            LDS_BARRIER();
            SEGT(10); SEGT(0);
            if (act) {
                int ln = lane; asm volatile("" : "+v"(ln));
                asm volatile("" : "+v"(g_rc[0]), "+v"(g_rc[1]), "+v"(g_kc[0]), "+v"(g_kc[1]), "+v"(g_vc[0]), "+v"(g_vc[1]), "+v"(g_rp[0]), "+v"(g_rp[1]), "+v"(g_kp[0]), "+v"(g_kp[1]), "+v"(g_vp[0]), "+v"(g_vp[1]), "+v"(g_ld[0]), "+v"(g_ld[1]), "+v"(g_a[0]), "+v"(g_a[1]));
                float ss = 0.f, bonus = 0.f;
#pragma unroll
                for (int hh = 0; hh < 2; ++hh) { float rc[8], kc[8], vc[8], rp_[8], kp[8], vp[8], ldv[8], vo[8];
                    unpack8(g_rc[hh], rc); unpack8(g_kc[hh], kc); unpack8(g_vc[hh], vc); unpack8(g_rp[hh], rp_); unpack8(g_kp[hh], kp); unpack8(g_vp[hh], vp); unpack8(g_ld[hh], ldv); unpack8(g_a[hh], av[hh]);
#pragma unroll
                    for (int e = 0; e < 8; ++e) { const int j = jw + 8 * hh + e;
                        rr[hh][e] = rc[e] + (rp_[e] - rc[e]) * cst[j]; const float k = kc[e] + (kp[e] - kc[e]) * cst[64 + j]; const float v = vc[e] + (vp[e] - vc[e]) * cst[128 + j];
                        kkr[hh][e] = k * cst[192 + j]; ss += kkr[hh][e] * kkr[hh][e];
                        { const float dA = 1.0f + __builtin_amdgcn_exp2f(fminf((cst[448 + j] + av[hh][e]) * -1.4426950408889634f, 60.0f)), dW = 1.0f + __builtin_amdgcn_exp2f(fminf((cst[384 + j] + ldv[e]) * -1.4426950408889634f, 60.0f));
                          const float rAW = frcp(dA * dW);
                          av[hh][e] = rAW * dW; lgw[hh][e] = -0.6065306597f * (rAW * dA); }
                        km[hh][e] = k * (1.0f + (av[hh][e] - 1.0f) * cst[256 + j]);
                        bonus += rr[hh][e] * km[hh][e] * cst[320 + j];
                        vo[e] = v; }
                    *(LAS v4u*)(Vtp + rk_offT(ln, jw + 8 * hh)) = pack8(vo); }
                ssP[ln * 4 + wq] = ss; bnP[ln * 4 + wq] = bonus;
            }
            LDS_BARRIER();
            SEGT(1);
            if (act) {
                int ln = lane; asm volatile("" : "+v"(ln));
                const f32x4 s4 = *(const LAS f32x4*)(ssP + ln * 4), b4 = *(const LAS f32x4*)(bnP + ln * 4);
                const float ss = (s4[0] + s4[1]) + (s4[2] + s4[3]);
                if (wq == 0) bon[64 * p + ln] = (b4[0] + b4[1]) + (b4[2] + b4[3]);
                const float inv = frcp(fmaxf(fsqrt_(ss), 1e-12f));
#pragma unroll
                for (int hh = 0; hh < 2; ++hh) { float lw[8], oA[8], oB[8], oK[8], oR[8], oBh[8], oKh[8], e63[8];
#pragma unroll
                    for (int e = 0; e < 8; ++e) lw[e] = wave_scan_add(lgw[hh][e]);
#pragma unroll
                    for (int e = 0; e < 8; ++e) {
                        const float eP = fexp(lw[e] - lgw[hh][e]), eM = fexp(-lw[e]), eL = fexp(lw[e]); e63[e] = lane63(eL); const float eH = e63[e] * eM;
                        const float kk = kkr[hh][e] * inv, bb = kk * av[hh][e];
                        oA[e] = -kk * eP; oB[e] = bb * eM; oK[e] = km[hh][e] * eM; oR[e] = rr[hh][e] * eL; oBh[e] = bb * eH; oKh[e] = km[hh][e] * eH; }
                    pA[hh] = pack8(oA); pB[hh] = pack8(oB); pK[hh] = pack8(oK); pR[hh] = pack8(oR); pKh[hh] = pack8(oKh);
                    *(LAS v4u*)(BhTp + rk_offT(ln, jw + 8 * hh)) = pack8(oBh);
                    if (ln == 63) { LAS float* gp = g63 + 64 * p + jw + 8 * hh; *(LAS f32x4*)gp = (f32x4){e63[0], e63[1], e63[2], e63[3]}; *(LAS f32x4*)(gp + 4) = (f32x4){e63[4], e63[5], e63[6], e63[7]}; } }
            }
            LDS_BARRIER();
            SEGT(2);
            if (act) {
                if (it + 1 < SEQ / 64) RKS_LOAD(it + 1, 0);
                int ln = lane; asm volatile("" : "+v"(ln));
#pragma unroll
                for (int hh = 0; hh < 2; ++hh) { const int ro = rk_off(ln, jw + 8 * hh); *(LAS v4u*)(Ab + ro) = pA[hh]; *(LAS v4u*)(Rb + ro) = pR[hh];
                    *(LAS v4u*)(KhT + rk_offT(ln, jw + 8 * hh)) = pKh[hh]; }
            }
            LDS_BARRIER(); SEGT(3); if (act && it + 1 < SEQ / 64) RKS_LOAD(it + 1, 1);
            LDS_BARRIER(); SEGT(4); if (act && it + 1 < SEQ / 64) RKS_LOAD(it + 1, 2);
            LDS_BARRIER(); SEGT(5); if (act && it + 1 < SEQ / 64) RKS_LOAD(it + 1, 3);
            LDS_BARRIER(); SEGT(6); LDS_BARRIER(); SEGT(7); LDS_BARRIER(); SEGT(8);
            if (act) {
                int ln = lane; asm volatile("" : "+v"(ln));
#pragma unroll
                for (int hh = 0; hh < 2; ++hh) { const int ro = rk_off(ln, jw + 8 * hh); *(LAS v4u*)(Bb + ro) = pB[hh]; *(LAS v4u*)(Kb + ro) = pK[hh]; }
            }
            LDS_BARRIER();
            SEGT(9);
        }
#ifdef PROBE_SEG_A
        if (DBG == 0 && blockIdx.x == 0 && tid == 0) ((unsigned long long*)(ws + WS_CTL + 512 * 1024))[24] = seg_acc;
#endif
#undef RKS_LOAD
    } else {
        const int mB = wq & 1, nB = wq >> 1;
        const int ltid = tid - 256;
        f32x4 sacc[2][2], tacc[2][2], yacc[2][2];
#pragma unroll
        for (int i = 0; i < 2; ++i)
#pragma unroll
            for (int j = 0; j < 2; ++j) { sacc[i][j] = (f32x4){0.f, 0.f, 0.f, 0.f}; tacc[i][j] = sacc[i][j]; yacc[i][j] = sacc[i][j]; }
        v4u g_g0 = {0u, 0u, 0u, 0u}, g_g1 = g_g0, pend0 = g_g0, pend1 = g_g0; bf16* pend_p = DBG ? (bf16*)(ws + WS_END) : MIX;
#define RKV_LOADG(c_) do { int lt_ = ltid; asm volatile("" : "+v"(lt_)); const bf16* gp_ = DAG + (size_t)(b * SEQ + (c_) * 64 + (lt_ >> 2)) * NLORA + 1024 + h * 64 + 16 * (lt_ & 3); g_g0 = *(const v4u*)gp_; g_g1 = *(const v4u*)(gp_ + 8); } while (0)
        LDS_BARRIER();
        for (int it = 0; it <= SEQ / 64; ++it) {
            const int ch = it - 1; const bool act = DBG != 2 && it >= 1; const int p = ch & 1;
            const LAS bf16* BhTp = RK_S(5 + 11 * p); const LAS bf16* Vtp = RK_S(6 + 11 * p);
            LDS_BARRIER();
            if (act) {
                const RkLane L = rk_lane(lane);
                if (ch > 0) { *(v4u*)pend_p = pend0; *(v4u*)(pend_p + 8) = pend1; }
                RKV_LOADG(ch);
                const RkF2 aB = rk_ld2(Bb, mB, L), bA = rk_ld2(Ab, nB, L);
                {
                    const RkF2 aA = rk_ld2(Ab, mB, L), bB = rk_ld2(Bb, nB, L);
                    f32x4 d[2][2], d2[2][2];
                    rk_mm2<false>(d, aB, bA); rk_mm2<false>(d2, aA, bB);
                    rk_mask2<0>(d, mB, nB, L.l15, L.l4);
#pragma unroll
                    for (int mi = 0; mi < 2; ++mi)
#pragma unroll
                        for (int ni = 0; ni < 2; ++ni)
#pragma unroll
                            for (int r = 0; r < 4; ++r) tacc[mi][ni][r] = d[mi][ni][r] + ((2 * mB + mi == 2 * nB + ni && 4 * L.l4 + r == L.l15) ? 1.f : 0.f);
                    rk_mask2<1>(d2, mB, nB, L.l15, L.l4);
                    rk_store2(P0, d, mB, nB, L); rk_store2(TA, tacc, mB, nB, L); rk_store2(P0T, d2, mB, nB, L);
                }
                asm volatile("" ::: "memory");
                {
                    const RkF2 aK = rk_ld2(Kb, mB, L), bR = rk_ld2(Rb, nB, L);
                    f32x4 d3[2][2], d4[2][2], d5[2][2];
                    rk_mm2<false>(d3, aK, bA); rk_mm2<false>(d4, aB, bR); rk_mm2<false>(d5, aK, bR);
                    rk_mask2<0>(d3, mB, nB, L.l15, L.l4); rk_mask2<2>(d4, mB, nB, L.l15, L.l4); rk_mask2<2>(d5, mB, nB, L.l15, L.l4);
                    rk_store2(Aak, d3, mB, nB, L); rk_store2(Arb, d4, mB, nB, L); rk_store2(Ark, d5, mB, nB, L);
                }
            }
            LDS_BARRIER();
            if (act) {
                const RkLane L = rk_lane(lane);
                {
                    const RkF2 aPT = rk_ld2(P0T, mB, L), aP = rk_ld2(P0, mB, L), bP = rk_ld2(P0, nB, L), bPT = rk_ld2(P0T, nB, L);
                    f32x4 d[2][2], d2[2][2]; rk_mm2<false>(d, aPT, bP); rk_mm2<false>(d2, aP, bPT);
                    rk_store2(Bb  , d, mB, nB, L); rk_store2(Kb  , d2, mB, nB, L);
                }
                asm volatile("" ::: "memory");
                const RkF2 bV = rk_ld2_tr(Vtp, nB, L);
                {
                    const RkF2 aA = rk_ld2(Ab, mB, L), aAk = rk_ld2(Aak, mB, L), bS = rk_ld2(Sb, nB, L), aKh = rk_ld2_tr(KhT, mB, L);
                    f32x4 d3[2][2]; rk_mm2<false>(d3, aA, bS); rk_mm2<true>(d3, aAk, bV);
#pragma unroll
                    for (int mi = 0; mi < 2; ++mi)
#pragma unroll
                        for (int r = 0; r < 4; ++r) { const float g_ = g63[64 * p + 16 * (2 * mB + mi) + 4 * L.l4 + r]; sacc[mi][0][r] *= g_; sacc[mi][1][r] *= g_; }
                    rk_mm2<true>(sacc, aKh, bV);
                    rk_store2(Xt, d3, mB, nB, L);
                }
                asm volatile("" ::: "memory");
                {
                    const RkF2 aS = rk_ld2(Sb, mB, L), aV = rk_ld2_tr(Vtp, mB, L), bR = rk_ld2(Rb, nB, L), bArk = rk_ld2(Ark, nB, L);
                    rk_mm2<false>(yacc, aS, bR); rk_mm2<true>(yacc, aV, bArk);
                }
            }
            LDS_BARRIER();
#define RKV_DOUBLE(PK, PKT, TIN, TOUT, PN, PNT) if (act && DBG != 4) { const RkLane L = rk_lane(lane); const RkF2 aPT = rk_ld2(PKT, mB, L), aP = rk_ld2(PK, mB, L); \
              const RkF2 bT = rk_ld2(TIN, nB, L), bP = rk_ld2(PK, nB, L), bPT = rk_ld2(PKT, nB, L); \
              f32x4 d[2][2], d2[2][2]; rk_mm2<true>(tacc, aPT, bT); rk_mm2<false>(d, aPT, bP); rk_mm2<false>(d2, aP, bPT); \
              rk_store2(TOUT, tacc, mB, nB, L); rk_store2(PN, d, mB, nB, L); rk_store2(PNT, d2, mB, nB, L); }
            RKV_DOUBLE(Bb, Kb, TA, TB, P0, P0T)
            LDS_BARRIER();
            RKV_DOUBLE(P0, P0T, TB, TA, Bb, Kb)
            LDS_BARRIER();
            RKV_DOUBLE(Bb, Kb, TA, TB, P0, P0T)
            LDS_BARRIER();
            if (act && DBG != 4) { const RkLane L = rk_lane(lane); const RkF2 aPT = rk_ld2(P0T, mB, L), aP = rk_ld2(P0, mB, L); const RkF2 bT = rk_ld2(TB, nB, L), bPT = rk_ld2(P0T, nB, L);
                f32x4 d2[2][2]; rk_mm2<true>(tacc, aPT, bT); rk_mm2<false>(d2, aP, bPT); rk_store2(TA, tacc, mB, nB, L); rk_store2(Kb  , d2, mB, nB, L); }
            LDS_BARRIER();
            if (act && DBG != 4) { const RkLane L = rk_lane(lane); const RkF2 aPT = rk_ld2(Kb, mB, L); const RkF2 bT = rk_ld2(TA, nB, L); rk_mm2<true>(tacc, aPT, bT); rk_store2(TB, tacc, mB, nB, L); }
            LDS_BARRIER();
            if (act) { const RkLane L = rk_lane(lane); const RkF2 aT = rk_ld2(TB, mB, L); const RkF2 bX = rk_ld2(Xt, nB, L); f32x4 d[2][2]; rk_mm2<false>(d, aT, bX); rk_store2(Ut, d, mB, nB, L); }
            LDS_BARRIER();
            if (act) {
                const RkLane L = rk_lane(lane);
                const RkF2 aU = rk_ld2(Ut, mB, L), aBh = rk_ld2_tr(BhTp, mB, L); const RkF2 bArb = rk_ld2(Arb, nB, L), bU = rk_ld2(Ut, nB, L);
                rk_mm2<true>(yacc, aU, bArb); rk_mm2<true>(sacc, aBh, bU);
#pragma unroll
                for (int mi = 0; mi < 2; ++mi)
#pragma unroll
                    for (int ni = 0; ni < 2; ++ni) *(LAS f32x4*)(Yl + (16 * (2 * nB + ni) + L.l15) * 64 + (((4 * (2 * mB + mi) + L.l4) ^ (L.l15 & 7)) << 2)) = yacc[mi][ni];
                rk_store2(Sb, sacc, mB, nB, L);
            }
            LDS_BARRIER();
            if (act) {
                int lt_ = ltid; asm volatile("" : "+v"(lt_)); const int tt = lt_ >> 2, c4 = lt_ & 3;
                const int t = b * SEQ + ch * 64 + tt, j0 = 16 * c4;
                float y[16], gv[16]; float s1 = 0.f;
#pragma unroll
                for (int k = 0; k < 4; ++k) { const f32x4 yv = *(const LAS f32x4*)(Yl + tt * 64 + (((4 * c4 + k) ^ (tt & 7)) << 2)); y[4 * k] = yv[0]; y[4 * k + 1] = yv[1]; y[4 * k + 2] = yv[2]; y[4 * k + 3] = yv[3]; s1 += (yv[0] + yv[1]) + (yv[2] + yv[3]); }
                s1 += dppmov<0xB1>(s1); s1 += dppmov<0x4E>(s1); const float mean = s1 * (1.0f / 64.0f); float s2 = 0.f;
#pragma unroll
                for (int e = 0; e < 16; ++e) { const float dd = y[e] - mean; s2 += dd * dd; }
                s2 += dppmov<0xB1>(s2); s2 += dppmov<0x4E>(s2); const float rstd = frsq(s2 * (1.0f / 64.0f) + LNX_EPS);
                { float g0[8], g1[8]; unpack8(g_g0, g0); unpack8(g_g1, g1);
#pragma unroll
                  for (int e = 0; e < 8; ++e) { gv[e] = g0[e]; gv[8 + e] = g1[e]; } }
                const float bonus = bon[64 * p + tt]; float ov[16];
                float vv[16]; { float v0[8], v1[8]; unpack8(*(const LAS v4u*)(Vtp + rk_offT(tt, j0)), v0); unpack8(*(const LAS v4u*)(Vtp + rk_offT(tt, j0 + 8)), v1);
#pragma unroll
                  for (int e = 0; e < 8; ++e) { vv[e] = v0[e]; vv[8 + e] = v1[e]; } }
#pragma unroll
                for (int e = 0; e < 16; ++e) { const float yn = (y[e] - mean) * rstd * cst[512 + j0 + e] + cst[576 + j0 + e]; ov[e] = (yn + bonus * vv[e]) * gv[e]; }
                { float o0[8], o1[8];
#pragma unroll
                  for (int e = 0; e < 8; ++e) { o0[e] = ov[e]; o1[e] = ov[8 + e]; }
                  pend0 = pack8(o0); pend1 = pack8(o1); pend_p = DBG ? (bf16*)(ws + WS_END) + ((size_t)blockIdx.x * 256 + lt_) * 16 : MIX + (size_t)t * DM + h * 64 + j0; }
            }
        }
        *(v4u*)pend_p = pend0; *(v4u*)(pend_p + 8) = pend1;
#undef RKV_DOUBLE
#undef RKV_LOADG
    }
    LDS_BARRIER();
#undef RK_S
}

template <int DBG = 0> __device__ __forceinline__ void mlstm_unit_split(const Args& a, LAS unsigned char* lds, int unit, int tid, int lane, int wave) {
    unsigned char* ws = a.ws; const bf16* PROJ = (const bf16*)(ws + WS_PROJ); const float* gates = (const float*)(ws + WS_GATES); bf16* MIX = (bf16*)(ws + WS_MIX);
    const int b = unit >> 2, hm = unit & 3;
    constexpr int LD = 72, A64 = 64 * LD, A128 = 128 * LD;
    LAS bf16* Qb = (LAS bf16*)lds;
    LAS bf16* Kb_ = Qb + 2 * A64;
    LAS bf16* Kwb = Kb_ + 2 * A64;
    LAS bf16* Vtb = Kwb + 2 * A64;
    LAS bf16* Sm = Vtb + 2 * A128;
    LAS bf16* Ct = Sm + A64;
    LAS float* Hl = (LAS float*)(Ct + A128);
    LAS float* gar = Hl + 64 * 132;
    LAS float* decp = gar + 512; LAS float* den = decp + 4; LAS float* nvec = den + 64; LAS float* cwl = nvec + 64; LAS float* cbl = cwl + 512; LAS float* mhl = cbl + 128;
    { int t_ = tid; asm volatile("" : "+v"(t_));
      for (int i = t_; i < A128 / 2; i += 512) ((LAS unsigned*)Ct)[i] = 0u;
      if (t_ < 64) nvec[t_] = 0.f;
      if (t_ < 128) mhl[t_] = a.in[18][hm * 128 + t_];
      for (int i = t_; i < 640; i += 512) { const int j = i >> 7, c_ = i & 127; const int src = (c_ < 64) ? (hm * 64 + c_) : (256 + hm * 64 + (c_ - 64)); if (j < 4) cwl[i] = a.in[14][j * 512 + src]; else cbl[c_] = a.in[15][src]; } }
    const int wq = wave & 3;
    if (wave < 4) {
        const float ibias = a.in[16][hm], fbias = a.in[17][hm];
        v4u n_q[2], n_k[2], n_v[4]; float n_gi = 0.f, n_gf = 0.f;
        v4u p_q[2] = {{0u, 0u, 0u, 0u}, {0u, 0u, 0u, 0u}}, p_k[2] = {{0u, 0u, 0u, 0u}, {0u, 0u, 0u, 0u}};
#define MLS_LOAD(c_, PART) do { int ln_ = lane; asm volatile("" : "+v"(ln_)); const int t_ = b * SEQ + (c_) * 64 + ln_; \
        if ((PART) < 2) { const bf16* pr_ = PROJ + (size_t)t_ * NPROJ + hm * 64 + 16 * wq + 8 * (PART); n_q[PART] = *(const v4u*)(pr_ + C_Q); n_k[PART] = *(const v4u*)(pr_ + C_K); } \
        else { const bf16* pv_ = PROJ + (size_t)t_ * NPROJ + C_V + hm * 128 + 32 * wq; _Pragma("unroll") for (int q = 0; q < 4; ++q) n_v[q] = *(const v4u*)(pv_ + 8 * q); \
               n_gi = gates[(size_t)t_ * 8 + hm]; n_gf = gates[(size_t)t_ * 8 + 4 + hm]; } } while (0)
        MLS_LOAD(0, 0); MLS_LOAD(0, 1); MLS_LOAD(0, 2);
        LDS_BARRIER();
        float m_run = 0.f;
#ifdef PROBE_MSEG_A
        unsigned long long mseg_acc = 0, mseg_t0 = 0; bool mseg_on = false;
#define MSEGT(k) do { if ((k) == PROBE_MSEG_B && mseg_on) { mseg_acc += __builtin_amdgcn_s_memrealtime() - mseg_t0; mseg_on = false; } if ((k) == PROBE_MSEG_A) { mseg_t0 = __builtin_amdgcn_s_memrealtime(); mseg_on = true; } } while (0)
#else
#define MSEGT(k) do { } while (0)
#endif
        for (int it = 0; it <= SEQ / 64; ++it) {
            const bool act = DBG != 1 && it < SEQ / 64; const int p = it & 1;
            LAS bf16* Ql = Qb + p * A64; LAS bf16* Kl = Kb_ + p * A64; LAS bf16* Kwt = Kwb + p * A64; LAS bf16* Vt = Vtb + p * A128; LAS float* ga = gar + 256 * p;
            float w = 0.f;
            LDS_BARRIER();
            MSEGT(4); MSEGT(0);
            if (act) {
                asm volatile("" : "+v"(n_q[0]), "+v"(n_k[0]), "+v"(n_gi), "+v"(n_gf));
                int ln = lane; asm volatile("" : "+v"(ln));
                const float gi = n_gi + ibias, gf = n_gf + fbias;
                const float ig = 15.0f * tanhf_(gi * (1.0f / 15.0f)), fx = 15.0f * tanhf_(gf * (1.0f / 15.0f));
                const float logf = -(fmaxf(-fx, 0.f) + __logf(1.0f + fexp(-fabsf(fx))));
                const float bc = wave_scan_add(logf);
                const float e = ig - bc; const float P = wave_scan_max(e);
                const float mx = fmaxf(P, m_run);
                const float mxL = __builtin_bit_cast(float, __builtin_amdgcn_readlane(__builtin_bit_cast(int, mx), 63)), bL = __builtin_bit_cast(float, __builtin_amdgcn_readlane(__builtin_bit_cast(int, bc), 63));
                if (wq == 0) { ga[ln] = e; ga[64 + ln] = mx; ga[128 + ln] = fexp(m_run - mx); ga[192 + ln] = fexp(-(bc + mx)); if (ln == 0) decp[p] = fexp(m_run - mxL); }
                w = fexp(e - mxL); m_run = bL + mxL;
            }
#define MLS_QK(hh) { int ln = lane; asm volatile("" : "+v"(ln)); const int d0 = 16 * wq + 8 * (hh); float aq[8], ak[8]; \
                v4u tq[4], tk[4]; tq[3] = n_q[hh]; tk[3] = n_k[hh]; { v4u oq = p_q[hh], ok = p_k[hh]; \
                  _Pragma("unroll") for (int s_ = 1; s_ < 4; ++s_) { oq = dpp4<0x13C>(oq, oq); ok = dpp4<0x13C>(ok, ok); tq[3 - s_] = dpp4<0x138>(oq, tq[4 - s_]); tk[3 - s_] = dpp4<0x138>(ok, tk[4 - s_]); } } \
                p_q[hh] = n_q[hh]; p_k[hh] = n_k[hh]; \
                _Pragma("unroll") for (int e_ = 0; e_ < 8; ++e_) { aq[e_] = cbl[d0 + e_]; ak[e_] = cbl[64 + d0 + e_]; } \
                _Pragma("unroll") for (int j = 0; j < 4; ++j) { float pq[8], pk[8]; unpack8(tq[j], pq); unpack8(tk[j], pk); \
                    _Pragma("unroll") for (int e_ = 0; e_ < 8; ++e_) { aq[e_] += cwl[j * 128 + d0 + e_] * pq[e_]; ak[e_] += cwl[j * 128 + 64 + d0 + e_] * pk[e_]; } } \
                _Pragma("unroll") for (int e_ = 0; e_ < 8; ++e_) { aq[e_] = aq[e_] * sigmoidf_(aq[e_]) * 0.125f; ak[e_] = ak[e_] * sigmoidf_(ak[e_]); } \
                *(LAS v4u*)(Ql + ln * LD + d0) = pack8(aq); *(LAS v4u*)(Kl + ln * LD + d0) = pack8(ak); \
                _Pragma("unroll") for (int e_ = 0; e_ < 8; ++e_) Kwt[(d0 + e_) * LD + ln] = (bf16)f2bf(w * ak[e_]); }
            if (act) { MLS_QK(0) if (it + 1 < SEQ / 64) MLS_LOAD(it + 1, 0); }
            LDS_BARRIER();
            MSEGT(1);
            if (act) {
                asm volatile("" : "+v"(n_q[1]), "+v"(n_k[1]));
                MLS_QK(1)
                if (it + 1 < SEQ / 64) MLS_LOAD(it + 1, 1);
            }
            LDS_BARRIER();
            MSEGT(2);
            if (act) {
                asm volatile("" : "+v"(n_v[0]), "+v"(n_v[1]), "+v"(n_v[2]), "+v"(n_v[3]));
                int ln = lane; asm volatile("" : "+v"(ln));
#pragma unroll
                for (int q = 0; q < 4; ++q) { const unsigned wv[4] = {n_v[q].x, n_v[q].y, n_v[q].z, n_v[q].w};
#pragma unroll
                    for (int e_ = 0; e_ < 4; ++e_) { Vt[(32 * wq + 8 * q + 2 * e_) * LD + ln] = (bf16)(wv[e_] & 0xffffu); Vt[(32 * wq + 8 * q + 2 * e_ + 1) * LD + ln] = (bf16)(wv[e_] >> 16); } }
                if (it + 1 < SEQ / 64) MLS_LOAD(it + 1, 2);
            }
            LDS_BARRIER();
            MSEGT(3);
        }
#ifdef PROBE_MSEG_A
        if (DBG == 0 && blockIdx.x == 0 && tid == 0) ((unsigned long long*)(ws + WS_CTL + 512 * 1024))[24] = mseg_acc;
#endif
#undef MLS_QK
#undef MLS_LOAD
    } else {
        const int ltid = tid - 256;
        f32x4 cacc[2][4];
#pragma unroll
        for (int i = 0; i < 2; ++i)
#pragma unroll
            for (int j = 0; j < 4; ++j) cacc[i][j] = (f32x4){0.f, 0.f, 0.f, 0.f};
        v4u n_o[4] = {{0u, 0u, 0u, 0u}, {0u, 0u, 0u, 0u}, {0u, 0u, 0u, 0u}, {0u, 0u, 0u, 0u}}, pend[4] = {{0u, 0u, 0u, 0u}, {0u, 0u, 0u, 0u}, {0u, 0u, 0u, 0u}, {0u, 0u, 0u, 0u}}; bf16* pend_p = DBG ? (bf16*)(ws + WS_END) : MIX;
        LDS_BARRIER();
        for (int it = 0; it <= SEQ / 64; ++it) {
            const int ch = it - 1; const bool act = DBG != 2 && it >= 1; const int p = ch & 1;
            const LAS bf16* Ql = Qb + p * A64; const LAS bf16* Kl = Kb_ + p * A64; const LAS bf16* Kwt = Kwb + p * A64; const LAS bf16* Vt = Vtb + p * A128; const LAS float* ga = gar + 256 * p;
            LDS_BARRIER();
            if (act) {
                int ln = lane; asm volatile("" : "+v"(ln)); const int l15 = ln & 15, l4 = ln >> 4;
                if (ch > 0) {
#pragma unroll
                    for (int q = 0; q < 4; ++q) *(v4u*)(pend_p + 8 * q) = pend[q]; }
                { int lt_ = ltid; asm volatile("" : "+v"(lt_)); const bf16* po_ = PROJ + (size_t)(b * SEQ + ch * 64 + (lt_ >> 2)) * NPROJ + C_O + hm * 128 + 32 * (lt_ & 3);
#pragma unroll
                  for (int q = 0; q < 4; ++q) n_o[q] = *(const v4u*)(po_ + 8 * q); }
                const int rb = wq;
                bf16x8 A[2], B[4][2];
#pragma unroll
                for (int kk = 0; kk < 2; ++kk) { A[kk] = *(const LAS bf16x8*)(Ql + (16 * rb + l15) * LD + 32 * kk + 8 * l4);
#pragma unroll
                    for (int cb = 0; cb < 4; ++cb) if (cb <= rb) B[cb][kk] = *(const LAS bf16x8*)(Kl + (16 * cb + l15) * LD + 32 * kk + 8 * l4); }
                float mxr[4];
#pragma unroll
                for (int r = 0; r < 4; ++r) mxr[r] = ga[64 + 16 * rb + 4 * l4 + r];
#pragma unroll
                for (int cb = 0; cb < 4; ++cb) { const int s_ = 16 * cb + l15;
                    if (cb <= rb) { f32x4 c_ = {0.f, 0.f, 0.f, 0.f}; c_ = mfma16(A[0], B[cb][0], c_); c_ = mfma16(A[1], B[cb][1], c_); const float es = ga[s_];
#pragma unroll
                        for (int r = 0; r < 4; ++r) { const int t = 16 * rb + 4 * l4 + r; const float v = (s_ <= t) ? c_[r] * fexp(es - mxr[r]) : 0.f; Sm[t * LD + s_] = (bf16)f2bf(v); } }
                    else {
#pragma unroll
                        for (int r = 0; r < 4; ++r) Sm[(16 * rb + 4 * l4 + r) * LD + s_] = (bf16)0; } }
            }
            LDS_BARRIER();
            if (act) {
                int ln = lane; asm volatile("" : "+v"(ln)); const int l15 = ln & 15, l4 = ln >> 4;
                { int lt_ = ltid; asm volatile("" : "+v"(lt_)); const int tt = lt_ >> 2, pt = lt_ & 3; float part = 0.f, qn = 0.f;
#pragma unroll
                  for (int q = 0; q < 2; ++q) { float sv[8], qv[8]; unpack8(*(const LAS v4u*)(Sm + tt * LD + 16 * pt + 8 * q), sv); unpack8(*(const LAS v4u*)(Ql + tt * LD + 16 * pt + 8 * q), qv);
#pragma unroll
                      for (int e_ = 0; e_ < 8; ++e_) { part += sv[e_]; qn += qv[e_] * nvec[16 * pt + 8 * q + e_]; } }
                  float tot = part + ga[128 + tt] * qn; tot += dppmov<0xB1>(tot); tot += dppmov<0x4E>(tot);
                  if (pt == 0) den[tt] = tot; }
                const int rb = wq;
                bf16x8 As[2], Aq[2];
#pragma unroll
                for (int kk = 0; kk < 2; ++kk) { As[kk] = *(const LAS bf16x8*)(Sm + (16 * rb + l15) * LD + 32 * kk + 8 * l4); Aq[kk] = *(const LAS bf16x8*)(Ql + (16 * rb + l15) * LD + 32 * kk + 8 * l4); }
                float scr_[4];
#pragma unroll
                for (int r = 0; r < 4; ++r) scr_[r] = ga[128 + 16 * rb + 4 * l4 + r];
#pragma unroll
                for (int hv = 0; hv < 2; ++hv) { bf16x8 B1[4][2], B2[4][2];
#pragma unroll
                    for (int vi = 0; vi < 4; ++vi)
#pragma unroll
                        for (int kk = 0; kk < 2; ++kk) { B1[vi][kk] = *(const LAS bf16x8*)(Vt + (16 * (4 * hv + vi) + l15) * LD + 32 * kk + 8 * l4); B2[vi][kk] = *(const LAS bf16x8*)(Ct + (16 * (4 * hv + vi) + l15) * LD + 32 * kk + 8 * l4); }
                    f32x4 a1[4], a2[4];
#pragma unroll
                    for (int vi = 0; vi < 4; ++vi) { f32x4 c1 = {0.f, 0.f, 0.f, 0.f}, c2 = {0.f, 0.f, 0.f, 0.f}; c1 = mfma16(As[0], B1[vi][0], c1); c2 = mfma16(Aq[0], B2[vi][0], c2); a1[vi] = mfma16(As[1], B1[vi][1], c1); a2[vi] = mfma16(Aq[1], B2[vi][1], c2); }
#pragma unroll
                    for (int vi = 0; vi < 4; ++vi)
#pragma unroll
                        for (int r = 0; r < 4; ++r) Hl[(16 * rb + 4 * l4 + r) * 132 + 16 * (4 * hv + vi) + l15] = a1[vi][r] + scr_[r] * a2[vi][r];
                    asm volatile("" ::: "memory"); }
            }
            LDS_BARRIER();
            if (act) {
                int ln = lane; asm volatile("" : "+v"(ln)); const int l15 = ln & 15, l4 = ln >> 4;
                const float dec = decp[p];
                bf16x8 Av[2][2], Bk[4][2];
#pragma unroll
                for (int kk = 0; kk < 2; ++kk) {
#pragma unroll
                    for (int vi = 0; vi < 2; ++vi) Av[vi][kk] = *(const LAS bf16x8*)(Vt + (16 * (2 * wq + vi) + l15) * LD + 32 * kk + 8 * l4);
#pragma unroll
                    for (int db = 0; db < 4; ++db) Bk[db][kk] = *(const LAS bf16x8*)(Kwt + (16 * db + l15) * LD + 32 * kk + 8 * l4); }
#pragma unroll
                for (int vi = 0; vi < 2; ++vi)
#pragma unroll
                    for (int db = 0; db < 4; ++db) { cacc[vi][db] = cacc[vi][db] * dec; cacc[vi][db] = mfma16(Av[vi][0], Bk[db][0], cacc[vi][db]); cacc[vi][db] = mfma16(Av[vi][1], Bk[db][1], cacc[vi][db]); }
#pragma unroll
                for (int vi = 0; vi < 2; ++vi)
#pragma unroll
                    for (int db = 0; db < 4; ++db)
#pragma unroll
                        for (int r = 0; r < 4; ++r) Ct[(16 * (2 * wq + vi) + 4 * l4 + r) * LD + 16 * db + l15] = (bf16)f2bf(cacc[vi][db][r]);
                { int lt_ = ltid; asm volatile("" : "+v"(lt_)); const int d = lt_ >> 2, pt = lt_ & 3; float s_ = 0.f;
#pragma unroll
                  for (int q = 0; q < 2; ++q) { float kv[8]; unpack8(*(const LAS v4u*)(Kwt + d * LD + 16 * pt + 8 * q), kv);
#pragma unroll
                      for (int e_ = 0; e_ < 8; ++e_) s_ += kv[e_]; }
                  s_ += dppmov<0xB1>(s_); s_ += dppmov<0x4E>(s_);
                  if (pt == 0) nvec[d] = dec * nvec[d] + s_; }
            }
            LDS_BARRIER();
            if (act) {
                int lt_ = ltid; asm volatile("" : "+v"(lt_)); const int tt = lt_ >> 2, pt = lt_ & 3, v0 = 32 * pt;
                const float dn = frcp(fmaxf(fabsf(den[tt]), ga[192 + tt]));
                float hv[32]; float ss = 0.f;
#pragma unroll
                for (int q = 0; q < 8; ++q) { const f32x4 x = *(const LAS f32x4*)(Hl + tt * 132 + v0 + 4 * q) * dn; hv[4 * q] = x[0]; hv[4 * q + 1] = x[1]; hv[4 * q + 2] = x[2]; hv[4 * q + 3] = x[3]; ss += (x[0] * x[0] + x[1] * x[1]) + (x[2] * x[2] + x[3] * x[3]); }
                ss += dppmov<0xB1>(ss); ss += dppmov<0x4E>(ss); const float rn = frsq(ss * (1.0f / 128.0f) + NORM_EPS);
#pragma unroll
                for (int q = 0; q < 4; ++q) { float o_[8], r_[8]; unpack8(n_o[q], o_);
#pragma unroll
                    for (int e_ = 0; e_ < 8; ++e_) r_[e_] = hv[8 * q + e_] * rn * mhl[v0 + 8 * q + e_] * sigmoidf_(o_[e_]);
                    pend[q] = pack8(r_); }
                pend_p = DBG ? (bf16*)(ws + WS_END) + ((size_t)blockIdx.x * 256 + lt_) * 32 : MIX + (size_t)(b * SEQ + ch * 64 + tt) * DM + 512 + hm * 128 + v0;
            }
        }
#pragma unroll
        for (int q = 0; q < 4; ++q) *(v4u*)(pend_p + 8 * q) = pend[q];
    }
    LDS_BARRIER();
}

__device__ __forceinline__ void phase_ffn_fix(const Args& a, int tid) {
    unsigned char* ws = a.ws; const float* SA = (const float*)(ws + WS_SIDE); const float* SB = SA + SIDE_ELEMS; const float* SL = SB + SIDE_ELEMS; bf16* GB = (bf16*)(ws + WS_GB);
    const float* cw = a.in[22]; const float* cb = a.in[23];
    const int NT = gridDim.x * 512;
    for (int it = blockIdx.x * 512 + tid; it < SIDE_ELEMS; it += NT) {
        const int ch = it & 127, r = (it >> 7) & 1, tile = it >> 8, pm = tile / 22, pn = tile % 22;
        const int base = tile * 256;
        float l0 = 0.f, l1 = 0.f;
        if ((pm & 7) != 0) { const int lb = (tile - 22) * 256; l0 = SL[lb + ch]; l1 = SL[lb + 128 + ch]; }
        const float a_r = SA[base + r * 128 + ch], b_r = SB[base + r * 128 + ch];
        const float am1 = r == 0 ? l1 : SA[base + ch], am2 = r == 0 ? l0 : l1;
        const int f = pn * 128 + ch;
        const float z = cb[f] + cw[f] * am2 + cw[DFF + f] * am1 + cw[2 * DFF + f] * a_r;
        GB[(size_t)(pm * 256 + r) * DFF + f] = (bf16)f2bf(z * sigmoidf_(z) * b_r);
    }
}
__device__ __forceinline__ void phase_final(const Args& a, int lane, int wave) {
    const bf16* FF = (const bf16*)(a.ws + WS_FF); const float* gf = a.in[25];
    f32x4 gv[4];
#pragma unroll
    for (int j = 0; j < 4; ++j) gv[j] = *((const f32x4*)gf + lane + 64 * j);
    const int NGW = gridDim.x * 8;
#ifdef PROBE
    const unsigned long long* tstamps = (const unsigned long long*)(a.ws + WS_CTL + 512 * 1024);
#ifdef PROBE_TOT
    const unsigned long long* ext = (const unsigned long long*)(a.ws + WS_END + 8 * MiB);
    const float fa = fminf(fmaxf(((float)(long long)(ext[3] - ext[2]) * 0.01f - 2000.0f) * (1.0f / PROBE_A_SCALE_US), 0.f), 1.f);
#else
    const float fa = fminf(fmaxf((float)(long long)(tstamps[PROBE_A_TO] - tstamps[PROBE_A_FROM]) * (0.01f / PROBE_A_SCALE_US), 0.f), 1.f);
#endif
    const float pscale = 1.0f + sqrtf(fa * 0.8e-4f);
#pragma unroll
    for (int j = 0; j < 4; ++j) gv[j] = gv[j] * pscale;
#endif
    const bf16* XB = (const bf16*)(a.ws + WS_XN);
    for (int row0 = 2 * (blockIdx.x * 8 + wave); row0 < M; row0 += 2 * NGW) {
        v2u xq[2][4], f[2][4];
#pragma unroll
        for (int u = 0; u < 2; ++u) { const v2u* xr = (const v2u*)(XB + (size_t)(row0 + u) * DM) + lane; const v2u* fr_ = (const v2u*)(FF + (size_t)(row0 + u) * DM) + lane;
#pragma unroll
            for (int j = 0; j < 4; ++j) { xq[u][j] = xr[64 * j]; f[u][j] = fr_[64 * j]; } }
#pragma unroll
        for (int u = 0; u < 2; ++u) { float ss = 0.f; f32x4 v[4];
#pragma unroll
            for (int j = 0; j < 4; ++j) { v[j][0] = bflo(xq[u][j].x) + bflo(f[u][j].x); v[j][1] = bfhi(xq[u][j].x) + bfhi(f[u][j].x); v[j][2] = bflo(xq[u][j].y) + bflo(f[u][j].y); v[j][3] = bfhi(xq[u][j].y) + bfhi(f[u][j].y);
                ss += (v[j][0] * v[j][0] + v[j][1] * v[j][1]) + (v[j][2] * v[j][2] + v[j][3] * v[j][3]); }
            const float rs = frsq(wave_sum(ss) * (1.0f / DM) + NORM_EPS);
            f32x4* xr = (f32x4*)(a.out + (size_t)(row0 + u) * DM) + lane;
#pragma unroll
            for (int j = 0; j < 4; ++j) xr[64 * j] = v[j] * rs * gv[j]; }
    }
}

constexpr int N_PHASES = 10;
__global__ void __launch_bounds__(512, 2) mega(Args args) {
    extern __shared__ __attribute__((aligned(16))) unsigned char lds_raw[];
    LAS unsigned char* lds = (LAS unsigned char*)lds_raw;
    const int wave0 = __builtin_amdgcn_readfirstlane((int)threadIdx.x >> 6);
#define MK_LANE() mk_lane_id()
#define MK_LEADER() (wave0 == 0 && MK_LANE() == 0)
    unsigned char* ws = args.ws;
#define PHASE_IDS int tid = wave0 * 64 + MK_LANE(); asm volatile("" : "+v"(tid)); const int lane = tid & 63, wave = wave0; (void)lane; (void)wave
    volatile LAS unsigned* MISC = (volatile LAS unsigned*)(lds + MISC_OFF);
    { PHASE_IDS; for (int u = tid; u < (LDS_BYTES - 131072) / 4; u += 512) ((LAS unsigned*)(lds + 131072))[u] = 0u; }
    mk_sync();
    XcdBarrier bar; bar.bar = (unsigned*)(ws + WS_CTL) + 4096; bar.x = 0; bar.st = nullptr;
    if (MK_SINGLE) bar = xcd_barrier_post((unsigned*)(ws + WS_CTL) + 4096, MISC + 8, MK_LEADER());
    const int lo = args.ph_lo, hi = args.ph_hi;
#ifndef PH_MASK
#define PH_MASK 0xFFFF
#endif
#define IN(k) ((((PH_MASK) >> (k)) & 1) && lo <= (k) && (k) < hi)
#ifdef PROBE
    unsigned long long* const tstamps = (unsigned long long*)(ws + WS_CTL + 512 * 1024);
#define STAMP(k) do { if (blockIdx.x == 0 && MK_LEADER()) tstamps[(k)] = __builtin_amdgcn_s_memrealtime(); } while (0)
#else
#define STAMP(k) do { } while (0)
#endif
    STAMP(0);
#ifdef PROBE_TOT
    { unsigned long long* ext = (unsigned long long*)(ws + WS_END + 8 * MiB);
      if (blockIdx.x == 0 && MK_LEADER()) { ext[2] = ext[0]; ext[3] = ext[1]; ext[1] = 0ull; ext[0] = __builtin_amdgcn_s_memrealtime(); } }
#endif
#ifdef PROBE
    if (MK_LEADER()) atomicMax(&tstamps[22], (unsigned long long)__builtin_amdgcn_s_memrealtime());
#endif
#define SEAM(k) do { if (IN(k) && IN((k) + 1)) xcd_barrier(bar, MK_LEADER()); STAMP((k) + 1); } while (0)

    if (IN(0)) { PHASE_IDS; phase_prep(args, lds, tid, lane, wave); } SEAM(0);
    if (IN(1)) {
        pg8::Gemm g{(const bf16*)(ws + WS_XN), (const bf16*)(ws + WS_WT_IN), M, NPROJ, opaque_i(DM)}; pg8::StaticOrder S; S.init(M, NPROJ, gridDim.x, (int)blockIdx.x);
        pg8::EpiBf16<0> E{(bf16*)(ws + WS_PROJ), NPROJ, nullptr, 0, 0, 1.f};
        pg8::gemm_phase<pg8::EpiBf16<0>, pg8::StaticOrder, true, true>(lds, g, S, E, wave0 * 64 + MK_LANE());
    } SEAM(1);
    if (IN(2)) {
        PHASE_IDS;
#ifdef PROBE_ML
        if ((int)blockIdx.x < BATCH * 4) { STAMP(18); mlstm_unit_split<PROBE_ML>(args, lds, (int)blockIdx.x, tid, lane, wave); STAMP(19); }
#endif
        if ((int)blockIdx.x < BATCH * 4 || gridDim.x != 256) {
            for (int u = blockIdx.x; u < BATCH * 4; u += gridDim.x) mlstm_unit_split(args, lds, u, tid, lane, wave);
        }
        if (gridDim.x == 256 && (int)blockIdx.x >= BATCH * 4) {
            const int c = (int)blockIdx.x - BATCH * 4;
            phase_lmat(args, tid, 512 * c, 512);
            asm volatile("s_waitcnt vmcnt(0)" ::: "memory"); mk_sync();
            if (tid == 0) { __builtin_amdgcn_fence(__ATOMIC_ACQUIRE, "agent"); asm volatile("s_waitcnt vmcnt(0)" ::: "memory"); }
            mk_sync();
            pg8::Gemm g{(const bf16*)(ws + WS_LBUF), (const bf16*)(ws + WS_WT_LORA), M, NLORA, opaque_i(KLORA)}; pg8::PairPanelOrder S{c};
            pg8::EpiBf16<0> E{(bf16*)(ws + WS_DAG), NLORA, nullptr, 0, 0, 1.f};
            pg8::gemm_phase<pg8::EpiBf16<0>, pg8::PairPanelOrder, true, true>(lds, g, S, E, wave0 * 64 + MK_LANE());
            mk_sync();
            late_transposes(args, lds, lane, wave, c * 8 + wave, ((int)gridDim.x - BATCH * 4) * 8);
        }
#ifdef PROBE
        mk_sync();
        if (MK_LEADER()) atomicMax(&tstamps[(int)blockIdx.x < BATCH * 4 ? 15 : 14], (unsigned long long)__builtin_amdgcn_s_memrealtime());
#endif
    } SEAM(2);
    if (IN(3)) {
        PHASE_IDS;
#ifdef PROBE_RK
        STAMP(16); rwkv_unit_split<PROBE_RK>(args, lds, (int)blockIdx.x, tid, lane, wave); STAMP(17);
#endif
        for (int u = blockIdx.x; u < BATCH * 8; u += gridDim.x) rwkv_unit_split(args, lds, u, tid, lane, wave);
        STAMP(12);
    }
    if (IN(3) && IN(5)) xcd_barrier(bar, MK_LEADER());
    STAMP(5);
    if (IN(5)) {
        pg8::Gemm g{(const bf16*)(ws + WS_MIX), (const bf16*)(ws + WS_WT_OUT), M, DM, opaque_i(DM)}; pg8::StaticOrder S; S.init(M, DM, gridDim.x, (int)blockIdx.x);
        pg8::EpiResid E{(bf16*)(ws + WS_XN), (const float*)(ws + WS_RINV), (float*)(ws + WS_SSQP)};
        pg8::gemm_phase<pg8::EpiResid, pg8::StaticOrder, true, true>(lds, g, S, E, wave0 * 64 + MK_LANE());
    } SEAM(5);
    if (IN(6)) {
        pg8::Gemm g{(const bf16*)(ws + WS_XN), (const bf16*)(ws + WS_WT_UP), M, NUP, opaque_i(DM)}; pg8::StaticOrder S; S.init(M, NUP, gridDim.x, (int)blockIdx.x);
        float* side = (float*)(ws + WS_SIDE); float* rs2 = (float*)(ws + WS_RS2);
        {
            PHASE_IDS; pg8::Unit u;
            for (int i = 0; S.next(i, u); ++i) if (tid < 256) { const int row = u.pm * 256 + tid; const f32x4* p = (const f32x4*)((const float*)(ws + WS_SSQP) + (size_t)row * 16); const f32x4 s0 = p[0], s1 = p[1], s2 = p[2], s3 = p[3];
                const float ss = ((s0[0] + s0[1]) + (s0[2] + s0[3])) + ((s1[0] + s1[1]) + (s1[2] + s1[3])) + ((s2[0] + s2[1]) + (s2[2] + s2[3])) + ((s3[0] + s3[1]) + (s3[2] + s3[3]));
                rs2[row] = frsq(ss * (1.0f / DM) + NORM_EPS); }
            asm volatile("s_waitcnt vmcnt(0)" ::: "memory"); mk_sync();
        }
        pg8::EpiFfn E{(bf16*)(ws + WS_GB), rs2, args.in[22], args.in[23], side, side + SIDE_ELEMS, side + 2 * SIDE_ELEMS, (LAS float*)(lds + 131072 + 1024)};
        pg8::gemm_phase<pg8::EpiFfn, pg8::StaticOrder, true, true>(lds, g, S, E, wave0 * 64 + MK_LANE());
    } SEAM(6);
    if (IN(7)) { PHASE_IDS; phase_ffn_fix(args, tid); } SEAM(7);
    if (IN(8)) {
        pg8::Gemm g{(const bf16*)(ws + WS_GB), (const bf16*)(ws + WS_WT_DN), M, DM, opaque_i(DFF)}; pg8::StaticOrder S; S.init(M, DM, gridDim.x, (int)blockIdx.x);
        pg8::EpiBf16<0> E{(bf16*)(ws + WS_FF), DM, nullptr, 0, 0, 1.f};
        pg8::gemm_phase<pg8::EpiBf16<0>, pg8::StaticOrder, true, true>(lds, g, S, E, wave0 * 64 + MK_LANE());
    } SEAM(8);
#ifdef PROBE
    xcd_barrier(bar, MK_LEADER());
#ifdef PROBE_FIN
    STAMP(20); { PHASE_IDS; phase_final(args, lane, wave); } xcd_barrier(bar, MK_LEADER()); STAMP(21); xcd_barrier(bar, MK_LEADER());
#endif
#endif
    if (IN(9)) { PHASE_IDS; phase_final(args, lane, wave); }
#ifdef PROBE_TOT
    { mk_sync(); if (MK_LEADER()) atomicMax((unsigned long long*)(ws + WS_END + 8 * MiB) + 1, (unsigned long long)__builtin_amdgcn_s_memrealtime()); }
#endif
#undef IN
#undef SEAM
}

extern "C" void kernel_launch(void* const* d_in, const int* in_sizes, int n_in, void* d_out, int out_size, void* d_ws, size_t ws_size, hipStream_t stream) {
    static int grid = 0;
    if (grid == 0) {
        if (n_in != 26 || in_sizes[0] != M * DM || out_size != M * DM || ws_size < WS_END) { fprintf(stderr, "kernel_launch: unexpected shapes (n_in %d, in0 %d, out %d, ws %zu)\n", n_in, n_in > 0 ? in_sizes[0] : -1, out_size, ws_size); grid = -1; return; }
        int dev = 0, cus = 0, per_cu = 0;
        if (hipGetDevice(&dev) != hipSuccess || hipDeviceGetAttribute(&cus, hipDeviceAttributeMultiprocessorCount, dev) != hipSuccess) { grid = -1; return; }
        if (hipFuncSetAttribute((const void*)mega, hipFuncAttributeMaxDynamicSharedMemorySize, LDS_BYTES) != hipSuccess) { fprintf(stderr, "kernel_launch: hipFuncSetAttribute failed\n"); grid = -1; return; }
        if (hipOccupancyMaxActiveBlocksPerMultiprocessor(&per_cu, (const void*)mega, 512, LDS_BYTES) != hipSuccess || per_cu < 1) { fprintf(stderr, "kernel_launch: occupancy query says %d blocks per CU\n", per_cu); }
        (void)hipGetLastError();
        grid = cus;
        if (grid != 256) fprintf(stderr, "kernel_launch: %d CUs; this kernel is laid out for 256\n", grid);
    }
    if (grid < 0) return;
#ifdef EXTRA_MEMSET
    (void)hipMemsetAsync((char*)d_ws + WS_CTL + 256 * 1024, 0, 4096, stream);
#endif
    (void)hipMemsetAsync((char*)d_ws + WS_CTL, 0, CTL_ZERO_BYTES, stream);
    Args a{};
    for (int i = 0; i < 26; ++i) a.in[i] = (const float*)d_in[i];
    a.out = (float*)d_out; a.ws = (unsigned char*)d_ws;
#if MK_SINGLE
    a.ph_lo = 0; a.ph_hi = N_PHASES;
    hipLaunchKernelGGL(mega, dim3(grid), dim3(512), LDS_BYTES, stream, a);
#else
    for (int p = 0; p < N_PHASES; ++p) { a.ph_lo = p; a.ph_hi = p + 1; hipLaunchKernelGGL(mega, dim3(grid), dim3(512), LDS_BYTES, stream, a); }
#endif
}
```

```cpp
#include <hip/hip_runtime.h>
#include <cstdio>
#include <cstdint>
namespace pg8 {
#define PG8_LAS __attribute__((address_space(3)))
typedef unsigned short bf16_t;
typedef short bf16x8 __attribute__((ext_vector_type(8)));
typedef float f32x4 __attribute__((ext_vector_type(4)));
typedef unsigned u32x4 __attribute__((ext_vector_type(4)));
constexpr int BM = 256, BK = 64, HALF = 128, HTB = HALF * BK * 2  , STAGE_BYTES = 8 * HTB, NXCD = 8, WGM = 8;

__host__ __device__ __forceinline__ int lds_byte(int r, int c) { const int st = (r >> 4) * 2 + (c >> 5), rr = r & 15, cc = c & 31, ob = rr * 64 + cc * 2; return st * 1024 + (ob ^ (((ob >> 9) & 1) << 5)); }
__host__ __device__ __forceinline__ void stage_rc(int b, int& R, int& C) { const int st = b / 1024, sb = b % 1024, swz = sb ^ (((sb >> 9) & 1) << 5); R = (st >> 1) * 16 + swz / 64; C = (st & 1) * 32 + (swz % 64) / 2; }
__host__ __device__ __forceinline__ int perm32(int rho) { const int n = rho >> 4, i = rho & 15; return 8 * (i >> 2) + 4 * n + (i & 3); }

struct Unit { int pm, pn; };
struct Gemm { const bf16_t* A; const bf16_t* Bt; int M, N, K; };

struct StaticOrder {
    int nM, nN, nwg, G, c;
    __host__ __device__ __forceinline__ void init(int M, int N, int G_, int c_) { nM = M / BM; nN = N / BM; nwg = nM * nN; G = G_; c = c_; }
    __host__ __device__ __forceinline__ bool next(int i, Unit& u) const {
        const long L = (long)i * G + c; if (L >= nwg) return false;
        int wgid = (int)L; { const int q = nwg / NXCD, r = nwg % NXCD, xcd = wgid % NXCD, off = wgid / NXCD; wgid = (xcd < r ? xcd * (q + 1) : r * (q + 1) + (xcd - r) * q) + off; }
        const int nig = WGM * nN, gid = wgid / nig, fm = gid * WGM, gsz = (nM - fm) < WGM ? (nM - fm) : WGM;
        u.pm = fm + ((wgid % nig) % gsz); u.pn = (wgid % nig) / gsz; return true;
    }
    __device__ __forceinline__ void a_ready(const Unit&) const {}
    __device__ __forceinline__ void done(const Unit&) const {}
};

__device__ __forceinline__ unsigned cvt_pk_bf16(float lo, float hi) { unsigned r; asm volatile("v_cvt_pk_bf16_f32 %0, %1, %2" : "=v"(r) : "v"(lo), "v"(hi)); return r; }
typedef float f32x2 __attribute__((ext_vector_type(2)));
#ifndef MK_WT
#define MK_WT 0
#endif
__device__ __forceinline__ __amdgpu_buffer_rsrc_t wt_rsrc(const void* base) { return __builtin_amdgcn_make_buffer_rsrc((void*)base, (short)0, 0x7fffffff, 0x00020000); }
__device__ __forceinline__ void wt_store16(const __amdgpu_buffer_rsrc_t r, void* base, size_t byte_off, const u32x4 v) {
#if MK_WT
    (void)base; __builtin_amdgcn_raw_buffer_store_b128(v, r, (unsigned)byte_off, 0,   16);
#else
    (void)r; *(u32x4*)((char*)base + byte_off) = v;
#endif
}
__device__ __forceinline__ f32x2 gelu_pk(f32x2 v) {
    const f32x2 av = __builtin_elementwise_abs(v), d = av * 0.2316418882f + 1.0f;
    f32x2 t; t.x = __builtin_amdgcn_rcpf(d.x); t.y = __builtin_amdgcn_rcpf(d.y);
    f32x2 q = t * 0.5307027145f + (-0.7265760135f); q = q * t + 0.7107068705f; q = q * t + (-0.142248368f); q = q * t + 0.127414796f; q = q * t;
    const f32x2 s = (v * v) * (-0.72134752044f);
    f32x2 e; e.x = __builtin_amdgcn_exp2f(s.x); e.y = __builtin_amdgcn_exp2f(s.y);
    const f32x2 m = v * (q * e), r = v - m;
    f32x2 o; o.x = v.x < 0.f ? m.x : r.x; o.y = v.y < 0.f ? m.y : r.y; return o;
}

template <int ACT  > struct EpiBf16 {
    static constexpr bool PERM = true, AFTER_DRAIN = false; static_assert(ACT == 0 || ACT == 1, "EpiBf16: ACT is 0 (none) or 1 (gelu_pk)");
    bf16_t* O; int ldc; const float* bias; int split_cols; size_t split_stride; float scale0;
    __device__ __forceinline__ void operator()(const f32x4 (&acc)[2][2][4][2], const Unit& u, int wr, int wc, int fr, int fq) const {
        const int row0 = u.pm * BM + wr * 64 + fr; int colt = u.pn * BM; bf16_t* base = O;
        float sc = 1.f; if (split_cols) { const int t = colt / split_cols; base += (size_t)t * split_stride; colt -= t * split_cols; if (t == 0) sc = scale0; }
        const int col0 = colt + wc * 32 + 8 * fq, bcol0 = u.pn * BM + wc * 32 + 8 * fq;
        const __amdgpu_buffer_rsrc_t orr = wt_rsrc(base);
        f32x4 bv[2][2];
#pragma unroll
        for (int bj = 0; bj < 2; ++bj)
#pragma unroll
            for (int n = 0; n < 2; ++n) bv[bj][n] = bias ? *(const f32x4*)(bias + bcol0 + bj * HALF + 4 * n) : (f32x4){0.f, 0.f, 0.f, 0.f};
#pragma unroll
        for (int ai = 0; ai < 2; ++ai)
#pragma unroll
            for (int m = 0; m < 4; ++m) { const size_t rowo = ((size_t)(row0 + ai * HALF + m * 16) * ldc + col0) * 2;
#pragma unroll
                for (int bj = 0; bj < 2; ++bj) { f32x4 v0 = acc[ai][bj][m][0] + bv[bj][0], v1 = acc[ai][bj][m][1] + bv[bj][1];
                    if (ACT == 1) { f32x2 a = gelu_pk((f32x2){v0[0], v0[1]}), b = gelu_pk((f32x2){v0[2], v0[3]}), c = gelu_pk((f32x2){v1[0], v1[1]}), d = gelu_pk((f32x2){v1[2], v1[3]});
                        v0 = (f32x4){a.x, a.y, b.x, b.y}; v1 = (f32x4){c.x, c.y, d.x, d.y}; }
                    v0 = v0 * sc; v1 = v1 * sc; u32x4 w; w.x = cvt_pk_bf16(v0[0], v0[1]); w.y = cvt_pk_bf16(v0[2], v0[3]); w.z = cvt_pk_bf16(v1[0], v1[1]); w.w = cvt_pk_bf16(v1[2], v1[3]);
                    wt_store16(orr, base, rowo + bj * HALF * 2, w); } }
    }
};
template <class Epi, class Sched, bool ALIGN_EPI = false, bool SP2 = false>
__device__ __forceinline__ void gemm_phase(PG8_LAS unsigned char* lds, const Gemm g, const Sched& S, const Epi& E, const int tid_in) {
    const int tid = tid_in, wid = __builtin_amdgcn_readfirstlane(tid >> 6), lane = tid & 63, wr = wid >> 2, wc = wid & 3, fr = lane & 15, fq = lane >> 4;
    const int K = g.K, nt = K / BK;
    unsigned voffA[2], voffB[2];
#pragma unroll
    for (int i = 0; i < 2; ++i) { int R, C; stage_rc(tid * 16 + i * 8192, R, C); const int Rb = Epi::PERM ? ((R & ~31) + perm32(R & 31)) : R;
        voffA[i] = (unsigned)(R * K + C) * 2u; voffB[i] = (unsigned)(Rb * K + C) * 2u; }
    const size_t kstep = (size_t)(BK * 2);
    const size_t hstep = (size_t)HALF * K * 2;
    const size_t tstep = 2 * hstep;
    const unsigned ldsw = (unsigned)wid * 1024u;
    const int aoff = lds_byte(wr * 64 + fr, fq * 8), boff = lds_byte(wc * 32 + fr, fq * 8);
#define PG8_SA(b, h) (((b) * 2 + (h)) * HTB)
#define PG8_SB(b, h) ((4 + (b) * 2 + (h)) * HTB)
#define PG8_STAGE(bufoff, gbase, voff) do { _Pragma("unroll") for (int _i = 0; _i < 2; ++_i) \
        __builtin_amdgcn_global_load_lds((const unsigned*)((const char*)(gbase) + (voff)[_i]), (PG8_LAS unsigned*)(lds + (bufoff) + ldsw + _i * 8192), 16, 0, 0); } while (0)
#define PG8_LDA(dst, b, h) do { _Pragma("unroll") for (int m = 0; m < 4; ++m) _Pragma("unroll") for (int k = 0; k < 2; ++k) dst[m][k] = *(const PG8_LAS bf16x8*)(lds + PG8_SA(b, h) + aoff + m * 2048 + k * 1024); } while (0)
#define PG8_LDB(dst, b, h) do { _Pragma("unroll") for (int n = 0; n < 2; ++n) _Pragma("unroll") for (int k = 0; k < 2; ++k) dst[n][k] = *(const PG8_LAS bf16x8*)(lds + PG8_SB(b, h) + boff + n * 2048 + k * 1024); } while (0)
#define PG8_MMA(ai, bj, At, Bt) do { __builtin_amdgcn_s_setprio(1); _Pragma("unroll") for (int m = 0; m < 4; ++m) _Pragma("unroll") for (int n = 0; n < 2; ++n) _Pragma("unroll") for (int k = 0; k < 2; ++k) \
        acc[ai][bj][m][n] = __builtin_amdgcn_mfma_f32_16x16x32_bf16(Bt[n][k], At[m][k], acc[ai][bj][m][n], 0, 0, 0); __builtin_amdgcn_s_setprio(0); } while (0)
#define PG8_WAIT_V(n) asm volatile("s_waitcnt vmcnt(" #n ")" ::: "memory")
#define PG8_WAIT_L(n) asm volatile("s_waitcnt lgkmcnt(" #n ")" ::: "memory")
#define PG8_BAR __builtin_amdgcn_s_barrier()
#define PG8_SCHED __builtin_amdgcn_sched_barrier(0)
    Unit cur, nxt; int ui = 0;
    if (!S.next(0, cur)) return;
    f32x4 acc[2][2][4][2];
#pragma unroll
    for (int a = 0; a < 2; ++a)
#pragma unroll
        for (int b = 0; b < 2; ++b)
#pragma unroll
            for (int m = 0; m < 4; ++m)
#pragma unroll
                for (int n = 0; n < 2; ++n) acc[a][b][m][n] = (f32x4){0.f, 0.f, 0.f, 0.f};
    bf16x8 At[4][2], B0[2][2], B1[2][2];
    const char* cA = (const char*)g.A + (size_t)cur.pm * tstep; const char* cB = (const char*)g.Bt + (size_t)cur.pn * tstep;
    S.a_ready(cur);
    if constexpr (SP2) {
        PG8_STAGE(PG8_SB(0, 0), cB, voffB); PG8_STAGE(PG8_SB(0, 1), cB + hstep, voffB); PG8_STAGE(PG8_SA(0, 0), cA, voffA); PG8_STAGE(PG8_SA(0, 1), cA + hstep, voffA);
        if (wr == 1) PG8_BAR;
        PG8_WAIT_V(2); PG8_BAR;
        PG8_STAGE(PG8_SB(1, 0), cB + kstep, voffB); PG8_STAGE(PG8_SA(1, 0), cA + kstep, voffA); PG8_STAGE(PG8_SB(1, 1), cB + hstep + kstep, voffB);
        PG8_WAIT_V(6); PG8_BAR;
    } else {
        PG8_STAGE(PG8_SB(0, 0), cB, voffB); PG8_STAGE(PG8_SA(0, 0), cA, voffA); PG8_STAGE(PG8_SB(0, 1), cB + hstep, voffB); PG8_STAGE(PG8_SA(0, 1), cA + hstep, voffA);
        if (wr == 1) PG8_BAR;
        PG8_WAIT_V(4); PG8_BAR;
        PG8_STAGE(PG8_SB(1, 0), cB + kstep, voffB); PG8_STAGE(PG8_SA(1, 0), cA + kstep, voffA); PG8_STAGE(PG8_SB(1, 1), cB + hstep + kstep, voffB);
        PG8_WAIT_V(6); PG8_BAR;
    }
    for (;;) {
        const bool has_next = S.next(ui + 1, nxt);
        const char* nA = has_next ? (const char*)g.A + (size_t)nxt.pm * tstep : cA; const char* nB = has_next ? (const char*)g.Bt + (size_t)nxt.pn * tstep : cB;
        for (int t = 0; t < nt; t += 2) {
            const bool last = (t == nt - 2);
            const char* a1 = cA + (size_t)(t + 1) * kstep;
            const char* a2 = last ? nA : cA + (size_t)(t + 2) * kstep; const char* b2 = last ? nB : cB + (size_t)(t + 2) * kstep;
            const char* a3 = a2 + kstep; const char* b3 = b2 + kstep;
            if (last && has_next) S.a_ready(nxt);
            if constexpr (SP2) {
            PG8_LDB(B0, 0, 0); PG8_LDB(B1, 0, 1); PG8_SCHED; PG8_LDA(At, 0, 0); PG8_STAGE(PG8_SA(1, 1), a1 + hstep, voffA);
            PG8_WAIT_V(8); PG8_WAIT_L(0); PG8_BAR; PG8_MMA(0, 0, At, B0); PG8_MMA(0, 1, At, B1); PG8_BAR; PG8_SCHED;
            PG8_LDA(At, 0, 1); PG8_STAGE(PG8_SB(0, 0), b2, voffB); PG8_STAGE(PG8_SB(0, 1), b2 + hstep, voffB); PG8_STAGE(PG8_SA(0, 0), a2, voffA);
            PG8_WAIT_V(8); PG8_WAIT_L(0); PG8_BAR; PG8_MMA(1, 0, At, B0); PG8_MMA(1, 1, At, B1); PG8_BAR; PG8_SCHED;
            PG8_LDB(B0, 1, 0); PG8_LDB(B1, 1, 1); PG8_SCHED; PG8_LDA(At, 1, 0); PG8_STAGE(PG8_SA(0, 1), a2 + hstep, voffA);
            PG8_WAIT_V(8); PG8_WAIT_L(0); PG8_BAR; PG8_MMA(0, 0, At, B0); PG8_MMA(0, 1, At, B1); PG8_BAR; PG8_SCHED;
            PG8_LDA(At, 1, 1); PG8_STAGE(PG8_SB(1, 0), b3, voffB); PG8_STAGE(PG8_SB(1, 1), b3 + hstep, voffB); PG8_STAGE(PG8_SA(1, 0), a3, voffA);
            PG8_WAIT_V(8); PG8_WAIT_L(0); PG8_BAR; PG8_MMA(1, 0, At, B0); PG8_MMA(1, 1, At, B1); PG8_BAR; PG8_SCHED;
            } else {
            PG8_LDB(B0, 0, 0); PG8_SCHED; PG8_LDA(At, 0, 0); PG8_STAGE(PG8_SA(1, 1), a1 + hstep, voffA);
            PG8_WAIT_L(8); PG8_BAR; PG8_WAIT_L(0); PG8_MMA(0, 0, At, B0); PG8_BAR; PG8_SCHED;
            PG8_LDB(B1, 0, 1); PG8_STAGE(PG8_SB(0, 0), b2, voffB);
            PG8_BAR; PG8_WAIT_L(0); PG8_MMA(0, 1, At, B1); PG8_BAR;
            PG8_LDA(At, 0, 1); PG8_STAGE(PG8_SA(0, 0), a2, voffA);
            PG8_BAR; PG8_WAIT_L(0); PG8_MMA(1, 0, At, B0); PG8_BAR; PG8_SCHED;
            PG8_STAGE(PG8_SB(0, 1), b2 + hstep, voffB);
            PG8_WAIT_V(6); PG8_BAR; PG8_MMA(1, 1, At, B1); PG8_BAR;
            PG8_LDB(B0, 1, 0); PG8_SCHED; PG8_LDA(At, 1, 0); PG8_STAGE(PG8_SA(0, 1), a2 + hstep, voffA);
            PG8_WAIT_L(8); PG8_BAR; PG8_WAIT_L(0); PG8_MMA(0, 0, At, B0); PG8_BAR; PG8_SCHED;
            PG8_LDB(B1, 1, 1); PG8_STAGE(PG8_SB(1, 0), b3, voffB);
            PG8_BAR; PG8_WAIT_L(0); PG8_MMA(0, 1, At, B1); PG8_BAR;
            PG8_LDA(At, 1, 1); PG8_STAGE(PG8_SA(1, 0), a3, voffA);
            PG8_BAR; PG8_WAIT_L(0); PG8_MMA(1, 0, At, B0); PG8_BAR; PG8_SCHED;
            PG8_STAGE(PG8_SB(1, 1), b3 + hstep, voffB);
            PG8_WAIT_V(6); PG8_BAR; PG8_MMA(1, 1, At, B1); PG8_BAR;
            }
        }
        if constexpr (ALIGN_EPI) { if (wr == 0) PG8_BAR; }
        if constexpr (!Epi::AFTER_DRAIN) { E(acc, cur, wr, wc, fr, fq); S.done(cur); }
        if (!has_next) break;
#pragma unroll
        for (int a = 0; a < 2; ++a)
#pragma unroll
            for (int b = 0; b < 2; ++b)
#pragma unroll
                for (int m = 0; m < 4; ++m)
#pragma unroll
                    for (int n = 0; n < 2; ++n) acc[a][b][m][n] = (f32x4){0.f, 0.f, 0.f, 0.f};
        cur = nxt; cA = nA; cB = nB; ++ui;
        if constexpr (ALIGN_EPI) { if (wr == 1) PG8_BAR; }
    }
    PG8_WAIT_V(0);
    if constexpr (!ALIGN_EPI) { if (wr == 0) PG8_BAR; }
    PG8_BAR;
    if constexpr (Epi::AFTER_DRAIN) { E.fused(acc, cur, wr, wc, fr, fq, lds, wid, lane); S.done(cur); }
#undef PG8_SA
#undef PG8_SB
#undef PG8_STAGE
#undef PG8_LDA
#undef PG8_LDB
#undef PG8_MMA
#undef PG8_WAIT_V
#undef PG8_WAIT_L
#undef PG8_BAR
#undef PG8_SCHED
}
}

#ifndef MK_SINGLE
#define MK_SINGLE 1
#endif
constexpr int BATCH = 32, SEQ = 2048, DM = 1024, M = BATCH * SEQ;
constexpr int NIN = 3336, NPROJ = 3328;
constexpr int DFF = 2816, NUP = 2 * DFF;
constexpr int C_Q = 1792, C_K = 2048, C_V = 2304, C_O = 2816;
constexpr int NLORA = 1536, KLORA = 256;
constexpr int MH = M / 2;
constexpr float NORM_EPS = 1e-6f, LNX_EPS = 64e-5f;

constexpr size_t MiB = 1u << 20;
#ifdef PROBE
constexpr size_t WS_CTL = 0, CTL_ZERO_BYTES = 1 * MiB;
#else
constexpr size_t WS_CTL = 0, CTL_ZERO_BYTES = 32 * 1024;
#endif
constexpr size_t WS_WT_IN = 2 * MiB, WS_WT_OUT = 9 * MiB, WS_WT_UP = 11 * MiB, WS_WT_DN = 22 * MiB, WS_WT_LORA = 28 * MiB;
constexpr size_t WS_RS2 = 29 * MiB, WS_RINV = 29 * MiB + 512 * 1024, WS_SSQP = 30 * MiB, WS_GATES = 34 * MiB;
constexpr size_t WS_XN = 40 * MiB;
constexpr size_t WS_PROJ = 168 * MiB;
constexpr size_t WS_LBUF = 584 * MiB;
constexpr size_t WS_DAG = 616 * MiB;
constexpr size_t WS_MIX = 808 * MiB;
constexpr size_t WS_SIDE = 168 * MiB;
constexpr int SIDE_ELEMS = 256 * 22 * 2 * 128;
constexpr size_t WS_FF = 192 * MiB;
constexpr size_t WS_GB = 520 * MiB;
constexpr size_t WS_END = 936 * MiB;

constexpr int LDS_BYTES = 163840;
constexpr int MISC_OFF = LDS_BYTES - 256;

#define GAS __attribute__((address_space(1)))
#define LAS __attribute__((address_space(3)))
typedef unsigned short bf16;
typedef unsigned v4u __attribute__((ext_vector_type(4)));
typedef unsigned v2u __attribute__((ext_vector_type(2)));
typedef float f32x4 __attribute__((ext_vector_type(4)));
typedef float f32x2 __attribute__((ext_vector_type(2)));
typedef short bf16x8 __attribute__((ext_vector_type(8)));
typedef GAS unsigned gu32;

typedef __bf16 bf16x2_t __attribute__((ext_vector_type(2)));
__device__ __forceinline__ unsigned pk2(float lo, float hi) { const f32x2 v = {lo, hi}; const bf16x2_t b = __builtin_convertvector(v, bf16x2_t); return __builtin_bit_cast(unsigned, b); }
__device__ __forceinline__ unsigned f2bf(float f) { return pk2(f, f) & 0xffffu; }
__device__ __forceinline__ float bf2f(unsigned short u) { return __builtin_bit_cast(float, (unsigned)u << 16); }
__device__ __forceinline__ float bflo(unsigned w) { return __builtin_bit_cast(float, w << 16); }
__device__ __forceinline__ float bfhi(unsigned w) { return __builtin_bit_cast(float, w & 0xffff0000u); }
__device__ __forceinline__ void unpack8(const v4u w, float (&o)[8]) { o[0] = bflo(w.x); o[1] = bfhi(w.x); o[2] = bflo(w.y); o[3] = bfhi(w.y); o[4] = bflo(w.z); o[5] = bfhi(w.z); o[6] = bflo(w.w); o[7] = bfhi(w.w); }
__device__ __forceinline__ v4u pack8(const float (&o)[8]) { v4u w; w.x = pk2(o[0], o[1]); w.y = pk2(o[2], o[3]); w.z = pk2(o[4], o[5]); w.w = pk2(o[6], o[7]); return w; }
__device__ __forceinline__ float frcp(float x) { return __builtin_amdgcn_rcpf(x); }
__device__ __forceinline__ float frsq(float x) { return __builtin_amdgcn_rsqf(x); }
__device__ __forceinline__ float fsqrt_(float x) { return __builtin_amdgcn_sqrtf(x); }
__device__ __forceinline__ float fexp(float x) { return __builtin_amdgcn_exp2f(x * 1.4426950408889634f); }
__device__ __forceinline__ float sigmoidf_(float x) { return frcp(1.0f + __builtin_amdgcn_exp2f(x * -1.4426950408889634f)); }
__device__ __forceinline__ float tanhf_(float x) { return 1.0f - 2.0f * frcp(__builtin_amdgcn_exp2f(x * 2.8853900817779268f) + 1.0f); }
__device__ __forceinline__ float softplusf_(float x) { return fmaxf(x, 0.f) + __logf(1.0f + fexp(-fabsf(x))); }
__device__ __forceinline__ float wave_sum(float v) {
#pragma unroll
    for (int o = 1; o < 64; o <<= 1) v += __shfl_xor(v, o);
    return v;
}
template <int CTRL> __device__ __forceinline__ float dppmov(float v) { return __builtin_bit_cast(float, __builtin_amdgcn_update_dpp(0, __builtin_bit_cast(int, v), CTRL, 0xF, 0xF, true)); }
__device__ __forceinline__ float red8(float v) { v += dppmov<0xB1>(v); v += dppmov<0x4E>(v); v += dppmov<0x141>(v); return v; }
__device__ __forceinline__ float red16(float v) { v += dppmov<0xB1>(v); v += dppmov<0x4E>(v); v += dppmov<0x141>(v); v += dppmov<0x140>(v); return v; }

template <int CTRL, int RMASK> __device__ __forceinline__ float dppsh(float idv, float v) { return __builtin_bit_cast(float, __builtin_amdgcn_update_dpp(__builtin_bit_cast(int, idv), __builtin_bit_cast(int, v), CTRL, RMASK, 0xF, false)); }
template <int CTRL> __device__ __forceinline__ v4u dpp4(const v4u old, const v4u v) { v4u r;
    r.x = (unsigned)__builtin_amdgcn_update_dpp((int)old.x, (int)v.x, CTRL, 0xF, 0xF, false); r.y = (unsigned)__builtin_amdgcn_update_dpp((int)old.y, (int)v.y, CTRL, 0xF, 0xF, false);
    r.z = (unsigned)__builtin_amdgcn_update_dpp((int)old.z, (int)v.z, CTRL, 0xF, 0xF, false); r.w = (unsigned)__builtin_amdgcn_update_dpp((int)old.w, (int)v.w, CTRL, 0xF, 0xF, false); return r; }
__device__ __forceinline__ float wave_scan_add(float v) {
    v += dppsh<0x111, 0xF>(0.f, v); v += dppsh<0x112, 0xF>(0.f, v); v += dppsh<0x114, 0xF>(0.f, v); v += dppsh<0x118, 0xF>(0.f, v);
    v += dppsh<0x142, 0xA>(0.f, v); v += dppsh<0x143, 0xC>(0.f, v); return v;
}
__device__ __forceinline__ float wave_scan_max(float v) {
    const float ni = -3.0e38f;
    v = fmaxf(v, dppsh<0x111, 0xF>(ni, v)); v = fmaxf(v, dppsh<0x112, 0xF>(ni, v)); v = fmaxf(v, dppsh<0x114, 0xF>(ni, v)); v = fmaxf(v, dppsh<0x118, 0xF>(ni, v));
    v = fmaxf(v, dppsh<0x142, 0xA>(ni, v)); v = fmaxf(v, dppsh<0x143, 0xC>(ni, v)); return v;
}

#define XB_TMO      128
#define XB_XCNT(j)  (256  + 64 * (j))
#define XB_XSUB(j)  (1280 + 64 * (j))
#define XB_XGEN(j)  (2304 + 64 * (j))
#define XB_TOP      3328
#define XB_TOPGEN   3392
#define XCD_BAR_WORDS 3456
#define XB_SPIN_CAP (1u << 22)
__device__ __forceinline__ void mk_sync() { __builtin_amdgcn_fence(__ATOMIC_RELEASE, "workgroup"); __builtin_amdgcn_s_barrier(); __builtin_amdgcn_fence(__ATOMIC_ACQUIRE, "workgroup"); }
__device__ __forceinline__ unsigned xb_ld(unsigned* p)              { return __hip_atomic_load(p, __ATOMIC_RELAXED, __HIP_MEMORY_SCOPE_AGENT); }
__device__ __forceinline__ unsigned xb_add(unsigned* p, unsigned v) { return __hip_atomic_fetch_add(p, v, __ATOMIC_RELAXED, __HIP_MEMORY_SCOPE_AGENT); }
__device__ __forceinline__ unsigned xb_xcc_id() { return (unsigned)__builtin_amdgcn_s_getreg((3 << 11) | 20) & 0xFu; }
#define XB_SPIN(cond, bar) do { unsigned _sp = 0; while (cond) { __builtin_amdgcn_s_sleep(1); \
    if ((++_sp & 255u) == 0u) { if (xb_ld(&(bar)[XB_TMO])) break; if (_sp > XB_SPIN_CAP) { atomicAdd(&(bar)[XB_TMO], 1u); break; } } } } while (0)
struct XcdBarrier { unsigned* bar; unsigned x; volatile LAS unsigned* st; };
__device__ __forceinline__ XcdBarrier xcd_barrier_post(unsigned* bar, volatile LAS unsigned* st, bool leader) {
    XcdBarrier b; b.bar = bar; b.x = xb_xcc_id(); b.st = st;
    if (leader) (void)xb_add(&bar[XB_XCNT(b.x)], 1u);
    return b;
}
__device__ __forceinline__ void xcd_barrier_complete(unsigned* bar, unsigned x, unsigned& nloc, unsigned& nx) {
    const unsigned G = gridDim.x * gridDim.y * gridDim.z;
    unsigned sum, cnt, mine, sp = 0u;
    for (;;) {
        sum = 0u; cnt = 0u; mine = 0u;
#pragma unroll
        for (unsigned j = 0; j < 16; ++j) { const unsigned c = xb_ld(&bar[XB_XCNT(j)]); sum += c; cnt += (c > 0u) ? 1u : 0u; mine = (j == x) ? c : mine; }
        if (sum == G) break;
        __builtin_amdgcn_s_sleep(1);
        if ((++sp & 255u) == 0u) { if (xb_ld(&bar[XB_TMO])) break; if (sp > XB_SPIN_CAP) { atomicAdd(&bar[XB_TMO], 1u); break; } }
    }
    nloc = mine > 0u ? mine : 1u; nx = cnt > 0u ? cnt : 1u;
}
__device__ __forceinline__ void xcd_barrier(const XcdBarrier& b, bool leader) {
    asm volatile("s_waitcnt vmcnt(0)" ::: "memory");
    mk_sync();
    if (leader) {
        unsigned* bar = b.bar;
        __builtin_amdgcn_s_waitcnt(0);
        unsigned nloc = b.st[0], nx = b.st[1];
        if (nloc == 0u) { xcd_barrier_complete(bar, b.x, nloc, nx); b.st[0] = nloc; b.st[1] = nx; }
        const unsigned old = xb_add(&bar[XB_XSUB(b.x)], 1u);
        const unsigned gen = old / nloc;
        if (old + 1u == (gen + 1u) * nloc) {
            __builtin_amdgcn_fence(__ATOMIC_RELEASE, "agent");
            asm volatile("s_waitcnt vmcnt(0)" ::: "memory");
            const unsigned og = xb_add(&bar[XB_TOP], 1u);
            const unsigned tg = og / nx;
            if (og + 1u == (tg + 1u) * nx) xb_add(&bar[XB_TOPGEN], 1u);
            else XB_SPIN(xb_ld(&bar[XB_TOPGEN]) == tg, bar);
            __builtin_amdgcn_fence(__ATOMIC_ACQUIRE, "agent");
            xb_add(&bar[XB_XGEN(b.x)], 1u);
            asm volatile("s_waitcnt vmcnt(0)" ::: "memory");
        } else {
            XB_SPIN(xb_ld(&bar[XB_XGEN(b.x)]) == gen, bar);
            __builtin_amdgcn_fence(__ATOMIC_ACQUIRE, "agent");
            asm volatile("s_waitcnt vmcnt(0)" ::: "memory");
        }
    }
    mk_sync();
}

__device__ __forceinline__ int opaque_i(int v) { asm volatile("" : "+s"(v)); return v; }
#define LDS_BARRIER() do { asm volatile("s_waitcnt lgkmcnt(0)" ::: "memory"); __builtin_amdgcn_s_barrier(); asm volatile("" ::: "memory"); } while (0)
__device__ __forceinline__ int mk_lane_id() { int x; asm volatile("v_mbcnt_lo_u32_b32 %0, -1, 0\n\tv_mbcnt_hi_u32_b32 %0, -1, %0" : "=v"(x)); return x; }
struct Args { const float* in[26]; float* out; unsigned char* ws; int ph_lo, ph_hi; };

namespace pg8 {
struct PairPanelOrder {
    int c;
    __device__ bool next(int i, Unit& u) const { if (i >= 12) return false; u.pm = 2 * c + i / 6; u.pn = i % 6; return true; }
    __device__ __forceinline__ void a_ready(const Unit&) const {}
    __device__ __forceinline__ void done(const Unit&) const {}
};
struct PanelOrder {
    int c;
    __device__ bool next(int i, Unit& u) const { if (i >= 4) return false; u.pm = c; u.pn = i; return true; }
    __device__ __forceinline__ void a_ready(const Unit&) const {}
    __device__ __forceinline__ void done(const Unit&) const {}
};
struct EpiResid {
    static constexpr bool PERM = true, AFTER_DRAIN = false;
    bf16_t* XB; const float* rinv; float* ssqp;
    __device__ __forceinline__ void operator()(const f32x4 (&acc)[2][2][4][2], const Unit& u, int wr, int wc, int fr, int fq) const {
        const int row0 = u.pm * BM + wr * 64 + fr, col0 = u.pn * BM + wc * 32 + 8 * fq;
        const __amdgpu_buffer_rsrc_t xrr = wt_rsrc(XB);
#pragma unroll
        for (int ai = 0; ai < 2; ++ai) {
            u32x4 xin[4][2]; float ri[4];
#pragma unroll
            for (int m = 0; m < 4; ++m) { const int row = row0 + ai * HALF + m * 16; ri[m] = rinv[row];
#pragma unroll
                for (int bj = 0; bj < 2; ++bj) xin[m][bj] = *(const u32x4*)(XB + (size_t)row * DM + col0 + bj * HALF); }
            asm volatile("" ::: "memory");
#pragma unroll
            for (int m = 0; m < 4; ++m) { const int row = row0 + ai * HALF + m * 16; float ss = 0.f;
#pragma unroll
                for (int bj = 0; bj < 2; ++bj) { const size_t off = (size_t)row * DM + col0 + bj * HALF;
                    float xv[8]; unpack8(xin[m][bj], xv);
                    float v[8];
#pragma unroll
                    for (int j = 0; j < 4; ++j) { v[j] = acc[ai][bj][m][0][j] + xv[j] * ri[m]; v[4 + j] = acc[ai][bj][m][1][j] + xv[4 + j] * ri[m]; }
#pragma unroll
                    for (int j = 0; j < 8; ++j) ss += v[j] * v[j];
                    wt_store16(xrr, XB, off * 2, pack8(v)); }
                ss += __shfl_xor(ss, 16); ss += __shfl_xor(ss, 32);
                if (fq == 0) ssqp[(size_t)row * 16 + u.pn * 4 + wc] = ss; }
            asm volatile("" ::: "memory");
        }
    }
};
struct EpiScale {
    static constexpr bool PERM = true, AFTER_DRAIN = false;
    bf16_t* O; int ldc; const float* rs; int row_off;
    __device__ __forceinline__ void operator()(const f32x4 (&acc)[2][2][4][2], const Unit& u, int wr, int wc, int fr, int fq) const {
        const int row0 = u.pm * BM + wr * 64 + fr, col0 = u.pn * BM + wc * 32 + 8 * fq;
#pragma unroll
        for (int ai = 0; ai < 2; ++ai)
#pragma unroll
            for (int m = 0; m < 4; ++m) { const int row = row0 + ai * HALF + m * 16; const float s = rs[row_off + row]; bf16_t* rowp = O + (size_t)row * ldc + col0;
#pragma unroll
                for (int bj = 0; bj < 2; ++bj) { const f32x4 v0 = acc[ai][bj][m][0] * s, v1 = acc[ai][bj][m][1] * s;
                    u32x4 w; w.x = pk2(v0[0], v0[1]); w.y = pk2(v0[2], v0[3]); w.z = pk2(v1[0], v1[1]); w.w = pk2(v1[2], v1[3]); *(u32x4*)(rowp + bj * HALF) = w; } }
    }
};
struct EpiFfn {
    static constexpr bool PERM = true, AFTER_DRAIN = false;
    bf16_t* G; const float* rs; const float* cw; const float* cb; float* SA; float* SB; float* SL; LAS float* hal;
    __device__ __forceinline__ void operator()(const f32x4 (&acc)[2][2][4][2], const Unit& u, int wr, int wc, int fr, int fq) const {
        int chl = wc * 32 + 8 * fq; asm volatile("" : "+v"(chl));
        const int f0 = u.pn * 128 + chl, rowt = wr * 64 + fr;
        const __amdgpu_buffer_rsrc_t grr = wt_rsrc(G);
        float rsv[2][4];
#pragma unroll
        for (int ai = 0; ai < 2; ++ai)
#pragma unroll
            for (int m = 0; m < 4; ++m) rsv[ai][m] = rs[u.pm * BM + ai * HALF + m * 16 + rowt];
        const size_t sbase = ((size_t)(u.pm * 22 + u.pn) * 2) * 128 + chl;
        if (fr >= 14) {
#pragma unroll
            for (int ai = 0; ai < 2; ++ai) { const float r_ = rsv[ai][3]; const f32x4 v0 = acc[ai][0][3][0] * r_, v1 = acc[ai][0][3][1] * r_;
                LAS float* hp = hal + ((ai * 2 + wr) * 2 + (fr - 14)) * 128 + chl; *(LAS f32x4*)hp = v0; *(LAS f32x4*)(hp + 4) = v1;
                if (ai == 1 && wr == 1) { float* gp = SL + sbase + (fr - 14) * 128; *(f32x4*)gp = v0; *(f32x4*)(gp + 4) = v1; } }
        }
        if (wr == 0 && fr < 2) { const float r_ = rsv[0][0]; float* ga = SA + sbase + fr * 128; float* gb = SB + sbase + fr * 128;
            *(f32x4*)ga = acc[0][0][0][0] * r_; *(f32x4*)(ga + 4) = acc[0][0][0][1] * r_; *(f32x4*)gb = acc[0][1][0][0] * r_; *(f32x4*)(gb + 4) = acc[0][1][0][1] * r_; }
        asm volatile("s_waitcnt lgkmcnt(0)" ::: "memory"); __builtin_amdgcn_s_barrier(); asm volatile("" ::: "memory");
        float w0[8], w1[8], w2[8], bz[8];
        { const f32x4 a0 = *(const f32x4*)(cw + f0), a1 = *(const f32x4*)(cw + f0 + 4), b0 = *(const f32x4*)(cw + DFF + f0), b1 = *(const f32x4*)(cw + DFF + f0 + 4);
          const f32x4 c0 = *(const f32x4*)(cw + 2 * DFF + f0), c1 = *(const f32x4*)(cw + 2 * DFF + f0 + 4), d0 = *(const f32x4*)(cb + f0), d1 = *(const f32x4*)(cb + f0 + 4);
#pragma unroll
          for (int j = 0; j < 4; ++j) { w0[j] = a0[j]; w0[4 + j] = a1[j]; w1[j] = b0[j]; w1[4 + j] = b1[j]; w2[j] = c0[j]; w2[4 + j] = c1[j]; bz[j] = d0[j]; bz[4 + j] = d1[j]; } }
        const bool fr0 = (fr == 0), frl2 = (fr < 2); (void)fr0;
#pragma unroll
        for (int ai = 0; ai < 2; ++ai) {
            float ap[8];
            const int pb = ai * 2 + wr - 1;
#pragma unroll
            for (int m = 0; m < 4; ++m) {
                float av[8], bv[8], y1[8], y2[8];
                const float r_ = rsv[ai][m];
#pragma unroll
                for (int j = 0; j < 4; ++j) { av[j] = acc[ai][0][m][0][j] * r_; av[4 + j] = acc[ai][0][m][1][j] * r_; bv[j] = acc[ai][1][m][0][j] * r_; bv[4 + j] = acc[ai][1][m][1][j] * r_; }
                if (m == 0) {
                    if (pb >= 0) { const LAS float* h0 = hal + (pb * 2) * 128 + chl; const f32x4 h00 = *(const LAS f32x4*)h0, h01 = *(const LAS f32x4*)(h0 + 4), h10 = *(const LAS f32x4*)(h0 + 128), h11 = *(const LAS f32x4*)(h0 + 132);
#pragma unroll
                        for (int j = 0; j < 4; ++j) { y1[j] = h10[j]; y1[4 + j] = h11[j]; y2[j] = fr0 ? h00[j] : h10[j]; y2[4 + j] = fr0 ? h01[j] : h11[j]; } }
                    else {
#pragma unroll
                        for (int j = 0; j < 8; ++j) { y1[j] = 0.f; y2[j] = 0.f; } }
                } else {
#pragma unroll
                    for (int j = 0; j < 8; ++j) { y1[j] = dppmov<0x121>(ap[j]); y2[j] = dppmov<0x122>(ap[j]); }
                }
                float o[8];
#pragma unroll
                for (int j = 0; j < 8; ++j) { const float am1 = dppsh<0x111, 0xF>(y1[j], av[j]), am2 = dppsh<0x112, 0xF>(y2[j], av[j]);
                    const float z = bz[j] + w0[j] * am2 + w1[j] * am1 + w2[j] * av[j];
                    o[j] = z * sigmoidf_(z) * bv[j]; ap[j] = av[j]; }
                if (!(ai == 0 && m == 0 && wr == 0 && frl2)) wt_store16(grr, G, ((size_t)(u.pm * BM + ai * HALF + m * 16 + rowt) * DFF + f0) * 2, pack8(o));
            }
        }
    }
};
}

template <bool FFN_UP = false>
__device__ __forceinline__ void transpose_item(const float* W, int ldw, int K, bf16* WT, const float* kscale, LAS float* scr, int item, int nblk, int lane) {
    const int kb = item / nblk, nb = item % nblk, k0 = 64 * kb, n0 = 32 * nb;
    const int d0 = !FFN_UP ? n0 : (n0 < DFF ? ((n0 >> 7) * 256 + (n0 & 127)) : ((((n0 - DFF) >> 7) * 256) + 128 + ((n0 - DFF) & 127)));
#pragma unroll 8
    for (int i = 0; i < 32; ++i) { const int kk = 2 * i + (lane >> 5); const float s = kscale ? kscale[k0 + kk] : 1.0f; scr[kk * 33 + (lane & 31)] = W[(size_t)(k0 + kk) * ldw + n0 + (lane & 31)] * s; }
    asm volatile("s_waitcnt lgkmcnt(0)" ::: "memory");
    const int c = lane & 7;
#pragma unroll
    for (int j = 0; j < 4; ++j) { const int n = (lane >> 3) + 8 * j; const LAS float* s = scr + (8 * c) * 33 + n;
        v4u o; o.x = pk2(s[0 * 33], s[1 * 33]); o.y = pk2(s[2 * 33], s[3 * 33]); o.z = pk2(s[4 * 33], s[5 * 33]); o.w = pk2(s[6 * 33], s[7 * 33]);
        *(v4u*)(WT + (size_t)(d0 + n) * K + k0 + 8 * c) = o; }
    asm volatile("s_waitcnt lgkmcnt(0)" ::: "memory");
}

__device__ __forceinline__ float wave_red63(float v) {
    v += dppmov<0xB1>(v); v += dppmov<0x4E>(v); v += dppmov<0x141>(v); v += dppmov<0x140>(v);
    v += dppsh<0x142, 0xA>(0.f, v); v += dppsh<0x143, 0xC>(0.f, v); return v;
}
__device__ __forceinline__ float lane63(float v) { return __builtin_bit_cast(float, __builtin_amdgcn_readlane(__builtin_bit_cast(int, v), 63)); }
__device__ __forceinline__ void late_transposes(const Args& a, LAS unsigned char* lds, int lane, int wave, int gw, int NGW, int lo, int hi) {
    unsigned char* ws = a.ws; LAS float* scr = (LAS float*)(lds + wave * 16384);
    constexpr int I_DN = 44 * 32;
    for (int it = lo + gw; it < hi; it += NGW) {
        if (it < I_DN) transpose_item(a.in[24], DM, DFF, (bf16*)(ws + WS_WT_DN), nullptr, scr, it, 32, lane);
        else transpose_item<true>(a.in[21], NUP, DM, (bf16*)(ws + WS_WT_UP), a.in[20], scr, it - I_DN, 176, lane);
    }
}
constexpr int LATE_ITEMS = 44 * 32 + 16 * 176, LATE_MLSTM_SHARE = 1792;
__device__ __forceinline__ void phase_prep(const Args& a, LAS unsigned char* lds, int tid, int lane, int wave) {
    unsigned char* ws = a.ws;
    LAS float* scr = (LAS float*)(lds + wave * 16384);
    const int gw = blockIdx.x * 8 + wave, NGW = gridDim.x * 8;
    constexpr int I_IN = 16 * 104;
    constexpr int I_OUT0 = 16 * 32;
    for (int it = gw; it < I_IN + I_OUT0; it += NGW) {
        if (it < I_IN) transpose_item(a.in[2], NIN, DM, (bf16*)(ws + WS_WT_IN), a.in[1], scr, it, 104, lane);
        else transpose_item(a.in[19], DM, DM, (bf16*)(ws + WS_WT_OUT), nullptr, scr, it - I_IN, 32, lane);
    }
    {
        const float* wd = a.in[5]; const float* wa = a.in[7]; const float* wg = a.in[8]; bf16* WL = (bf16*)(ws + WS_WT_LORA);
        for (int idx = blockIdx.x * 512 + tid; idx < NLORA * KLORA; idx += gridDim.x * 512) {
            const int n = idx >> 8, k = idx & 255; float v = 0.f;
            if (n < 512) { if (k < 64) v = wd[k * 512 + n]; }
            else if (n < 1024) { if (k >= 64 && k < 128) v = wa[(k - 64) * 512 + (n - 512)]; }
            else { if (k >= 128) v = wg[(k - 128) * 512 + (n - 1024)]; }
            WL[idx] = (bf16)f2bf(v);
        }
    }
    {
        const float* x = a.in[0]; const float* g1 = a.in[1]; const float* w_in = a.in[2];
        bf16* XN = (bf16*)(ws + WS_XN); float* gates = (float*)(ws + WS_GATES); float* rinvp = (float*)(ws + WS_RINV);
        float wgt[16][8];
#pragma unroll
        for (int j = 0; j < 4; ++j)
#pragma unroll
            for (int e = 0; e < 4; ++e) { const int k = 4 * lane + 256 * j + e; const float g = g1[k];
                const f32x4 w0 = *(const f32x4*)(w_in + (size_t)k * NIN + 3328), w1 = *(const f32x4*)(w_in + (size_t)k * NIN + 3332);
                wgt[j * 4 + e][0] = w0[0] * g; wgt[j * 4 + e][1] = w0[1] * g; wgt[j * 4 + e][2] = w0[2] * g; wgt[j * 4 + e][3] = w0[3] * g;
                wgt[j * 4 + e][4] = w1[0] * g; wgt[j * 4 + e][5] = w1[1] * g; wgt[j * 4 + e][6] = w1[2] * g; wgt[j * 4 + e][7] = w1[3] * g; }
        f32x4 vn[4];
        { const f32x4* xr = (const f32x4*)(x + (size_t)gw * DM) + lane;
#pragma unroll
          for (int j = 0; j < 4; ++j) vn[j] = xr[64 * j]; }
        for (int row = gw; row < M; row += NGW) {
            f32x4 v[4];
#pragma unroll
            for (int j = 0; j < 4; ++j) v[j] = vn[j];
            { const int rn = (row + NGW < M) ? row + NGW : row; const f32x4* xr = (const f32x4*)(x + (size_t)rn * DM) + lane;
#pragma unroll
              for (int j = 0; j < 4; ++j) vn[j] = xr[64 * j]; }
            float ss = 0.f;
#pragma unroll
            for (int j = 0; j < 4; ++j) ss += (v[j][0] * v[j][0] + v[j][1] * v[j][1]) + (v[j][2] * v[j][2] + v[j][3] * v[j][3]);
            float gs[8];
#pragma unroll
            for (int jg = 0; jg < 8; ++jg) { float s_ = 0.f;
#pragma unroll
                for (int j = 0; j < 4; ++j)
#pragma unroll
                    for (int e = 0; e < 4; ++e) s_ += v[j][e] * wgt[j * 4 + e][jg];
                gs[jg] = s_; }
            ss = wave_red63(ss);
#pragma unroll
            for (int jg = 0; jg < 8; ++jg) gs[jg] = wave_red63(gs[jg]);
            const float ms = lane63(ss) * (1.0f / DM) + NORM_EPS; const float rs = frsq(ms);
            if (lane == 0) rinvp[row] = fsqrt_(ms);
            unsigned long long* o8 = (unsigned long long*)(XN + (size_t)row * DM) + lane;
#pragma unroll
            for (int j = 0; j < 4; ++j) o8[64 * j] = (unsigned long long)pk2(v[j][0] * rs, v[j][1] * rs) | ((unsigned long long)pk2(v[j][2] * rs, v[j][3] * rs) << 32);
            if (lane == 63) { f32x4* gp = (f32x4*)(gates + (size_t)row * 8); gp[0] = (f32x4){gs[0] * rs, gs[1] * rs, gs[2] * rs, gs[3] * rs}; gp[1] = (f32x4){gs[4] * rs, gs[5] * rs, gs[6] * rs, gs[7] * rs}; }
        }
    }
}

__device__ __forceinline__ void phase_lmat(const Args& a, int tid, int row_lo, int nrows) {
    unsigned char* ws = a.ws; const bf16* PROJ = (const bf16*)(ws + WS_PROJ); bf16* L = (bf16*)(ws + WS_LBUF); const float* mu = a.in[3];
    for (int it0 = tid; it0 < nrows * 32; it0 += 4 * 512) {
        v4u cur[4], prv[4];
#pragma unroll
        for (int u = 0; u < 4; ++u) { const int it = it0 + u * 512; const int row = row_lo + (it >> 5), c0 = 1536 + 8 * (it & 31);
            cur[u] = *(const v4u*)(PROJ + (size_t)row * NPROJ + c0);
            prv[u] = (v4u){0u, 0u, 0u, 0u}; if ((row & (SEQ - 1)) != 0) prv[u] = *(const v4u*)(PROJ + (size_t)(row - 1) * NPROJ + c0); }
#pragma unroll
        for (int u = 0; u < 4; ++u) { const int it = it0 + u * 512; const int row = row_lo + (it >> 5), grp = it & 31, c0 = 1536 + 8 * grp;
            const f32x4 m0 = *(const f32x4*)(mu + c0), m1 = *(const f32x4*)(mu + c0 + 4);
            float c[8], p[8], o[8]; unpack8(cur[u], c); unpack8(prv[u], p);
#pragma unroll
            for (int e = 0; e < 8; ++e) { const float mm = e < 4 ? m0[e & 3] : m1[e & 3]; const float xv = c[e] + (p[e] - c[e]) * mm;
                o[e] = grp < 8 ? tanhf_(xv) : (grp < 16 ? xv : sigmoidf_(xv)); }
            *(v4u*)(L + (size_t)row * KLORA + 8 * grp) = pack8(o); }
    }
}

constexpr int RK_SLOT = 64 * 64;
__device__ __forceinline__ int rk_off(int row, int col) { return row * 64 + ((((col >> 3) ^ row) & 7) << 3) + (col & 7); }
__device__ __forceinline__ f32x4 mfma16(const bf16x8 a, const bf16x8 b, const f32x4 c) { return __builtin_amdgcn_mfma_f32_16x16x32_bf16(a, b, c, 0, 0, 0); }
__device__ __forceinline__ void rk_frag(bf16x8 (&f)[2], const LAS bf16* base, int row0, int l15, int l4) { const LAS bf16* p = base + (row0 + l15) * 64; f[0] = *(const LAS bf16x8*)(p + ((l4 ^ (l15 & 7)) << 3)); f[1] = *(const LAS bf16x8*)(p + (((4 + l4) ^ (l15 & 7)) << 3)); }
struct RkF2 { bf16x8 f[2][2]; };
struct RkLane { int lo, so, l15, l4, to; };
__device__ __forceinline__ int rk_offT(int row, int col) { return row * 64 + ((((col >> 3) ^ ((row & 3) | ((row >> 1) & 4))) & 7) << 3) + (col & 7); }
__device__ __forceinline__ RkLane rk_lane(int lane) { asm volatile("" : "+v"(lane)); const int l15 = lane & 15, l4 = lane >> 4; RkLane r; r.l15 = l15; r.l4 = l4; r.lo = l15 * 64 + ((l4 ^ (l15 & 7)) << 3); r.so = l15 * 64 + ((((l4 >> 1) ^ (l15 & 7))) << 3) + 4 * (l4 & 1);
    r.to = rk_offT(8 * l4 + (l15 >> 2), 4 * (l15 & 3)); return r; }
typedef short s16x4_t __attribute__((ext_vector_type(4)));
__device__ __forceinline__ RkF2 rk_ld2_tr(const LAS bf16* base, int blk, const RkLane& L) { RkF2 r;
#pragma unroll
    for (int ti = 0; ti < 2; ++ti)
#pragma unroll
        for (int kh = 0; kh < 2; ++kh) { const LAS bf16* p = base + (L.to ^ ((4 * blk + 2 * ti) << 3)) + 32 * kh * 64;
            const s16x4_t a = __builtin_amdgcn_ds_read_tr16_b64_v4i16((LAS s16x4_t*)p), b = __builtin_amdgcn_ds_read_tr16_b64_v4i16((LAS s16x4_t*)(p + 4 * 64));
            r.f[ti][kh] = (bf16x8){a.x, a.y, a.z, a.w, b.x, b.y, b.z, b.w}; }
    return r; }
__device__ __forceinline__ RkF2 rk_ld2(const LAS bf16* base, int blk, const RkLane& L) { RkF2 r;
#pragma unroll
    for (int ti = 0; ti < 2; ++ti) { const int i0 = (32 * blk + 16 * ti) * 64 + L.lo; r.f[ti][0] = *(const LAS bf16x8*)(base + i0); r.f[ti][1] = *(const LAS bf16x8*)(base + (i0 ^ 32)); }
    return r; }
template <bool ACC> __device__ __forceinline__ void rk_mm2(f32x4 (&acc)[2][2], const RkF2& a, const RkF2& b) {
#pragma unroll
    for (int mi = 0; mi < 2; ++mi)
#pragma unroll
        for (int ni = 0; ni < 2; ++ni) { f32x4 c = ACC ? acc[mi][ni] : (f32x4){0.f, 0.f, 0.f, 0.f}; c = mfma16(a.f[mi][0], b.f[ni][0], c); acc[mi][ni] = mfma16(a.f[mi][1], b.f[ni][1], c); }
}
__device__ __forceinline__ void rk_store2(LAS bf16* dst, const f32x4 (&acc)[2][2], int mB, int nB, const RkLane& L) {
#pragma unroll
    for (int mi = 0; mi < 2; ++mi)
#pragma unroll
        for (int ni = 0; ni < 2; ++ni) { v2u w; w.x = pk2(acc[mi][ni][0], acc[mi][ni][1]); w.y = pk2(acc[mi][ni][2], acc[mi][ni][3]); *(LAS v2u*)(dst + (16 * (2 * nB + ni)) * 64 + (L.so ^ (16 * (2 * mB + mi)))) = w; }
}
template <int MODE> __device__ __forceinline__ void rk_mask2(f32x4 (&d)[2][2], int mB, int nB, int l15, int l4) {
#pragma unroll
    for (int mi = 0; mi < 2; ++mi)
#pragma unroll
        for (int ni = 0; ni < 2; ++ni) { const int mt = 2 * mB + mi, nt = 2 * nB + ni;
            const bool zero = MODE == 1 ? (mt < nt) : (mt > nt);
            if (zero) d[mi][ni] = (f32x4){0.f, 0.f, 0.f, 0.f};
            else if (mt == nt) {
#pragma unroll
                for (int r = 0; r < 4; ++r) { const int m_ = 4 * l4 + r; const bool keep = MODE == 0 ? (m_ < l15) : MODE == 1 ? (l15 < m_) : (m_ <= l15); d[mi][ni][r] = keep ? d[mi][ni][r] : 0.f; } } }
}
template <int DBG = 0> __device__ __forceinline__ void rwkv_unit_split(const Args& a, LAS unsigned char* lds, int unit, int tid, int lane, int wave) {
    unsigned char* ws = a.ws; const bf16* PROJ = (const bf16*)(ws + WS_PROJ); const bf16* DAG = (const bf16*)(ws + WS_DAG); bf16* MIX = (bf16*)(ws + WS_MIX);
    const int b = unit >> 3, h = unit & 7;
    LAS bf16* slot = (LAS bf16*)lds;
#define RK_S(k) (slot + (k) * RK_SLOT)
    LAS bf16* Ab = RK_S(0); LAS bf16* Bb = RK_S(1); LAS bf16* Kb = RK_S(2); LAS bf16* Rb = RK_S(3); LAS bf16* KhT = RK_S(4);
    LAS bf16* P0 = RK_S(7); LAS bf16* P0T = RK_S(8); LAS float* Yl = (LAS float*)RK_S(7);
    LAS bf16* Aak = RK_S(9); LAS bf16* Ut = RK_S(9); LAS bf16* Arb = RK_S(10); LAS bf16* Ark = RK_S(11); LAS bf16* TA = RK_S(12); LAS bf16* TB = RK_S(13); LAS bf16* Xt = RK_S(14); LAS bf16* Sb = RK_S(15);
    LAS float* g63 = (LAS float*)RK_S(18); LAS float* bon = g63 + 128; LAS float* ssP = bon + 128; LAS float* bnP = ssP + 256; LAS float* cst = bnP + 256;
    const int wq = wave & 3;
    { int t_ = tid; asm volatile("" : "+v"(t_));
      if (t_ < 64) { const int j = h * 64 + t_;
        cst[t_] = a.in[3][j]; cst[64 + t_] = a.in[3][512 + j]; cst[128 + t_] = a.in[3][1024 + j]; cst[192 + t_] = a.in[9][j]; cst[256 + t_] = a.in[10][j];
        cst[320 + t_] = a.in[11][j]; cst[384 + t_] = a.in[4][j]; cst[448 + t_] = a.in[6][j]; cst[512 + t_] = a.in[12][j]; cst[576 + t_] = a.in[13][j]; }
      for (int i = t_; i < RK_SLOT / 2; i += 512) ((LAS unsigned*)Sb)[i] = 0u; }
    if (wave < 4) {
        const int jw = 16 * wq;
        v4u g_rc[2], g_kc[2], g_vc[2], g_rp[2], g_kp[2], g_vp[2], g_ld[2], g_a[2];
#define RKS_LOAD(c_, PART) do { int ln_ = lane; asm volatile("" : "+v"(ln_)); const int t_ = b * SEQ + (c_) * 64 + ln_; const bf16* pr_ = PROJ + (size_t)t_ * NPROJ + h * 64 + jw; const bf16* dg_ = DAG + (size_t)t_ * NLORA + h * 64 + jw; \
        _Pragma("unroll") for (int hh = 0; hh < 2; ++hh) { \
            if ((PART) == 0) { g_rc[hh] = *(const v4u*)(pr_ + 8 * hh); g_kc[hh] = *(const v4u*)(pr_ + 512 + 8 * hh); } \
            if ((PART) == 1) { g_vc[hh] = *(const v4u*)(pr_ + 1024 + 8 * hh); g_ld[hh] = *(const v4u*)(dg_ + 8 * hh); } \
            if ((PART) == 2) { g_a[hh] = *(const v4u*)(dg_ + 512 + 8 * hh); \
                if ((c_) == 0 && ln_ == 0) g_rp[hh] = (v4u){0u, 0u, 0u, 0u}; else g_rp[hh] = *(const v4u*)(pr_ - NPROJ + 8 * hh); } \
            if ((PART) == 3) { if ((c_) == 0 && ln_ == 0) { g_kp[hh] = (v4u){0u, 0u, 0u, 0u}; g_vp[hh] = g_kp[hh]; } \
                else { g_kp[hh] = *(const v4u*)(pr_ - NPROJ + 512 + 8 * hh); g_vp[hh] = *(const v4u*)(pr_ - NPROJ + 1024 + 8 * hh); } } } } while (0)
        RKS_LOAD(0, 0); RKS_LOAD(0, 1); RKS_LOAD(0, 2); RKS_LOAD(0, 3);
        LDS_BARRIER();
#ifdef PROBE_SEG_A
        unsigned long long seg_acc = 0, seg_t0 = 0; bool seg_on = false;
#define SEGT(k) do { if ((k) == PROBE_SEG_B && seg_on) { seg_acc += __builtin_amdgcn_s_memrealtime() - seg_t0; seg_on = false; } if ((k) == PROBE_SEG_A) { seg_t0 = __builtin_amdgcn_s_memrealtime(); seg_on = true; } } while (0)
#else
#define SEGT(k) do { } while (0)
#endif
        for (int it = 0; it <= SEQ / 64; ++it) {
            const bool act = DBG != 1 && it < SEQ / 64; const int p = it & 1;
            LAS bf16* BhTp = RK_S(5 + 11 * p); LAS bf16* Vtp = RK_S(6 + 11 * p);
            float rr[2][8], km[2][8], av[2][8], lgw[2][8], kkr[2][8];
            v4u pA[2], pR[2], pB[2], pK[2], pKh[2];
            LDS_BARRIER();
            SEGT(10); SEGT(0);
            if (act) {
                int ln = lane; asm volatile("" : "+v"(ln));
                asm volatile("" : "+v"(g_rc[0]), "+v"(g_rc[1]), "+v"(g_kc[0]), "+v"(g_kc[1]), "+v"(g_vc[0]), "+v"(g_vc[1]), "+v"(g_rp[0]), "+v"(g_rp[1]), "+v"(g_kp[0]), "+v"(g_kp[1]), "+v"(g_vp[0]), "+v"(g_vp[1]), "+v"(g_ld[0]), "+v"(g_ld[1]), "+v"(g_a[0]), "+v"(g_a[1]));
                float ss = 0.f, bonus = 0.f;
#pragma unroll
                for (int hh = 0; hh < 2; ++hh) { float rc[8], kc[8], vc[8], rp_[8], kp[8], vp[8], ldv[8], vo[8];
                    unpack8(g_rc[hh], rc); unpack8(g_kc[hh], kc); unpack8(g_vc[hh], vc); unpack8(g_rp[hh], rp_); unpack8(g_kp[hh], kp); unpack8(g_vp[hh], vp); unpack8(g_ld[hh], ldv); unpack8(g_a[hh], av[hh]);
#pragma unroll
                    for (int e = 0; e < 8; ++e) { const int j = jw + 8 * hh + e;
                        rr[hh][e] = rc[e] + (rp_[e] - rc[e]) * cst[j]; const float k = kc[e] + (kp[e] - kc[e]) * cst[64 + j]; const float v = vc[e] + (vp[e] - vc[e]) * cst[128 + j];
                        kkr[hh][e] = k * cst[192 + j]; ss += kkr[hh][e] * kkr[hh][e];
                        { const float dA = 1.0f + __builtin_amdgcn_exp2f(fminf((cst[448 + j] + av[hh][e]) * -1.4426950408889634f, 60.0f)), dW = 1.0f + __builtin_amdgcn_exp2f(fminf((cst[384 + j] + ldv[e]) * -1.4426950408889634f, 60.0f));
                          const float rAW = frcp(dA * dW);
                          av[hh][e] = rAW * dW; lgw[hh][e] = -0.6065306597f * (rAW * dA); }
                        km[hh][e] = k * (1.0f + (av[hh][e] - 1.0f) * cst[256 + j]);
                        bonus += rr[hh][e] * km[hh][e] * cst[320 + j];
                        vo[e] = v; }
                    *(LAS v4u*)(Vtp + rk_offT(ln, jw + 8 * hh)) = pack8(vo); }
                ssP[ln * 4 + wq] = ss; bnP[ln * 4 + wq] = bonus;
            }
            LDS_BARRIER();
            SEGT(1);
            if (act) {
                int ln = lane; asm volatile("" : "+v"(ln));
                const f32x4 s4 = *(const LAS f32x4*)(ssP + ln * 4), b4 = *(const LAS f32x4*)(bnP + ln * 4);
                const float ss = (s4[0] + s4[1]) + (s4[2] + s4[3]);
                if (wq == 0) bon[64 * p + ln] = (b4[0] + b4[1]) + (b4[2] + b4[3]);
                const float inv = frcp(fmaxf(fsqrt_(ss), 1e-12f));
#pragma unroll
                for (int hh = 0; hh < 2; ++hh) { float lw[8], oA[8], oB[8], oK[8], oR[8], oBh[8], oKh[8], e63[8];
#pragma unroll
                    for (int e = 0; e < 8; ++e) lw[e] = wave_scan_add(lgw[hh][e]);
#pragma unroll
                    for (int e = 0; e < 8; ++e) {
                        const float eP = fexp(lw[e] - lgw[hh][e]), eM = fexp(-lw[e]), eL = fexp(lw[e]); e63[e] = lane63(eL); const float eH = e63[e] * eM;
                        const float kk = kkr[hh][e] * inv, bb = kk * av[hh][e];
                        oA[e] = -kk * eP; oB[e] = bb * eM; oK[e] = km[hh][e] * eM; oR[e] = rr[hh][e] * eL; oBh[e] = bb * eH; oKh[e] = km[hh][e] * eH; }
                    pA[hh] = pack8(oA); pB[hh] = pack8(oB); pK[hh] = pack8(oK); pR[hh] = pack8(oR); pKh[hh] = pack8(oKh);
                    *(LAS v4u*)(BhTp + rk_offT(ln, jw + 8 * hh)) = pack8(oBh);
                    if (ln == 63) { LAS float* gp = g63 + 64 * p + jw + 8 * hh; *(LAS f32x4*)gp = (f32x4){e63[0], e63[1], e63[2], e63[3]}; *(LAS f32x4*)(gp + 4) = (f32x4){e63[4], e63[5], e63[6], e63[7]}; } }
            }
            LDS_BARRIER();
            SEGT(2);
            if (act) {
                if (it + 1 < SEQ / 64) RKS_LOAD(it + 1, 0);
                int ln = lane; asm volatile("" : "+v"(ln));
#pragma unroll
                for (int hh = 0; hh < 2; ++hh) { const int ro = rk_off(ln, jw + 8 * hh); *(LAS v4u*)(Ab + ro) = pA[hh]; *(LAS v4u*)(Rb + ro) = pR[hh];
                    *(LAS v4u*)(KhT + rk_offT(ln, jw + 8 * hh)) = pKh[hh]; }
            }
            LDS_BARRIER(); SEGT(3); if (act && it + 1 < SEQ / 64) RKS_LOAD(it + 1, 1);
            LDS_BARRIER(); SEGT(4); if (act && it + 1 < SEQ / 64) RKS_LOAD(it + 1, 2);
            LDS_BARRIER(); SEGT(5); if (act && it + 1 < SEQ / 64) RKS_LOAD(it + 1, 3);
            LDS_BARRIER(); SEGT(6); LDS_BARRIER(); SEGT(7); LDS_BARRIER(); SEGT(8);
            if (act) {
                int ln = lane; asm volatile("" : "+v"(ln));
#pragma unroll
                for (int hh = 0; hh < 2; ++hh) { const int ro = rk_off(ln, jw + 8 * hh); *(LAS v4u*)(Bb + ro) = pB[hh]; *(LAS v4u*)(Kb + ro) = pK[hh]; }
            }
            LDS_BARRIER();
            SEGT(9);
        }
#ifdef PROBE_SEG_A
        if (DBG == 0 && blockIdx.x == 0 && tid == 0) ((unsigned long long*)(ws + WS_CTL + 512 * 1024))[24] = seg_acc;
#endif
#undef RKS_LOAD
    } else {
        const int mB = wq & 1, nB = wq >> 1;
        const int ltid = tid - 256;
        f32x4 sacc[2][2], tacc[2][2], yacc[2][2];
#pragma unroll
        for (int i = 0; i < 2; ++i)
#pragma unroll
            for (int j = 0; j < 2; ++j) { sacc[i][j] = (f32x4){0.f, 0.f, 0.f, 0.f}; tacc[i][j] = sacc[i][j]; yacc[i][j] = sacc[i][j]; }
        v4u g_g0 = {0u, 0u, 0u, 0u}, g_g1 = g_g0, pend0 = g_g0, pend1 = g_g0; bf16* pend_p = DBG ? (bf16*)(ws + WS_END) : MIX;
#define RKV_LOADG(c_) do { int lt_ = ltid; asm volatile("" : "+v"(lt_)); const bf16* gp_ = DAG + (size_t)(b * SEQ + (c_) * 64 + (lt_ >> 2)) * NLORA + 1024 + h * 64 + 16 * (lt_ & 3); g_g0 = *(const v4u*)gp_; g_g1 = *(const v4u*)(gp_ + 8); } while (0)
        LDS_BARRIER();
        for (int it = 0; it <= SEQ / 64; ++it) {
            const int ch = it - 1; const bool act = DBG != 2 && it >= 1; const int p = ch & 1;
            const LAS bf16* BhTp = RK_S(5 + 11 * p); const LAS bf16* Vtp = RK_S(6 + 11 * p);
            LDS_BARRIER();
            if (act) {
                const RkLane L = rk_lane(lane);
                if (ch > 0) { *(v4u*)pend_p = pend0; *(v4u*)(pend_p + 8) = pend1; }
                RKV_LOADG(ch);
                const RkF2 aB = rk_ld2(Bb, mB, L), bA = rk_ld2(Ab, nB, L);
                {
                    const RkF2 aA = rk_ld2(Ab, mB, L), bB = rk_ld2(Bb, nB, L);
                    f32x4 d[2][2], d2[2][2];
                    rk_mm2<false>(d, aB, bA); rk_mm2<false>(d2, aA, bB);
                    rk_mask2<0>(d, mB, nB, L.l15, L.l4);
#pragma unroll
                    for (int mi = 0; mi < 2; ++mi)
#pragma unroll
                        for (int ni = 0; ni < 2; ++ni)
#pragma unroll
                            for (int r = 0; r < 4; ++r) tacc[mi][ni][r] = d[mi][ni][r] + ((2 * mB + mi == 2 * nB + ni && 4 * L.l4 + r == L.l15) ? 1.f : 0.f);
                    rk_mask2<1>(d2, mB, nB, L.l15, L.l4);
                    rk_store2(P0, d, mB, nB, L); rk_store2(TA, tacc, mB, nB, L); rk_store2(P0T, d2, mB, nB, L);
                }
                asm volatile("" ::: "memory");
                {
                    const RkF2 aK = rk_ld2(Kb, mB, L), bR = rk_ld2(Rb, nB, L);
                    f32x4 d3[2][2], d4[2][2], d5[2][2];
                    rk_mm2<false>(d3, aK, bA); rk_mm2<false>(d4, aB, bR); rk_mm2<false>(d5, aK, bR);
                    rk_mask2<0>(d3, mB, nB, L.l15, L.l4); rk_mask2<2>(d4, mB, nB, L.l15, L.l4); rk_mask2<2>(d5, mB, nB, L.l15, L.l4);
                    rk_store2(Aak, d3, mB, nB, L); rk_store2(Arb, d4, mB, nB, L); rk_store2(Ark, d5, mB, nB, L);
                }
            }
            LDS_BARRIER();
            if (act) {
                const RkLane L = rk_lane(lane);
                {
                    const RkF2 aPT = rk_ld2(P0T, mB, L), aP = rk_ld2(P0, mB, L), bP = rk_ld2(P0, nB, L), bPT = rk_ld2(P0T, nB, L);
                    f32x4 d[2][2], d2[2][2]; rk_mm2<false>(d, aPT, bP); rk_mm2<false>(d2, aP, bPT);
                    rk_store2(Bb  , d, mB, nB, L); rk_store2(Kb  , d2, mB, nB, L);
                }
                asm volatile("" ::: "memory");
                const RkF2 bV = rk_ld2_tr(Vtp, nB, L);
                {
                    const RkF2 aA = rk_ld2(Ab, mB, L), aAk = rk_ld2(Aak, mB, L), bS = rk_ld2(Sb, nB, L), aKh = rk_ld2_tr(KhT, mB, L);
                    f32x4 d3[2][2]; rk_mm2<false>(d3, aA, bS); rk_mm2<true>(d3, aAk, bV);
#pragma unroll
                    for (int mi = 0; mi < 2; ++mi)
#pragma unroll
                        for (int r = 0; r < 4; ++r) { const float g_ = g63[64 * p + 16 * (2 * mB + mi) + 4 * L.l4 + r]; sacc[mi][0][r] *= g_; sacc[mi][1][r] *= g_; }
                    rk_mm2<true>(sacc, aKh, bV);
                    rk_store2(Xt, d3, mB, nB, L);
                }
                asm volatile("" ::: "memory");
                {
                    const RkF2 aS = rk_ld2(Sb, mB, L), aV = rk_ld2_tr(Vtp, mB, L), bR = rk_ld2(Rb, nB, L), bArk = rk_ld2(Ark, nB, L);
                    rk_mm2<false>(yacc, aS, bR); rk_mm2<true>(yacc, aV, bArk);
                }
            }
            LDS_BARRIER();
#define RKV_DOUBLE(PK, PKT, TIN, TOUT, PN, PNT) if (act && DBG != 4) { const RkLane L = rk_lane(lane); const RkF2 aPT = rk_ld2(PKT, mB, L), aP = rk_ld2(PK, mB, L); \
              const RkF2 bT = rk_ld2(TIN, nB, L), bP = rk_ld2(PK, nB, L), bPT = rk_ld2(PKT, nB, L); \
              f32x4 d[2][2], d2[2][2]; rk_mm2<true>(tacc, aPT, bT); rk_mm2<false>(d, aPT, bP); rk_mm2<false>(d2, aP, bPT); \
              rk_store2(TOUT, tacc, mB, nB, L); rk_store2(PN, d, mB, nB, L); rk_store2(PNT, d2, mB, nB, L); }
            RKV_DOUBLE(Bb, Kb, TA, TB, P0, P0T)
            LDS_BARRIER();
            RKV_DOUBLE(P0, P0T, TB, TA, Bb, Kb)
            LDS_BARRIER();
            RKV_DOUBLE(Bb, Kb, TA, TB, P0, P0T)
            LDS_BARRIER();
            if (act && DBG != 4) { const RkLane L = rk_lane(lane); const RkF2 aPT = rk_ld2(P0T, mB, L), aP = rk_ld2(P0, mB, L); const RkF2 bT = rk_ld2(TB, nB, L), bPT = rk_ld2(P0T, nB, L);
                f32x4 d2[2][2]; rk_mm2<true>(tacc, aPT, bT); rk_mm2<false>(d2, aP, bPT); rk_store2(TA, tacc, mB, nB, L); rk_store2(Kb  , d2, mB, nB, L); }
            LDS_BARRIER();
            if (act && DBG != 4) { const RkLane L = rk_lane(lane); const RkF2 aPT = rk_ld2(Kb, mB, L); const RkF2 bT = rk_ld2(TA, nB, L); rk_mm2<true>(tacc, aPT, bT); rk_store2(TB, tacc, mB, nB, L); }
            LDS_BARRIER();
            if (act) { const RkLane L = rk_lane(lane); const RkF2 aT = rk_ld2(TB, mB, L); const RkF2 bX = rk_ld2(Xt, nB, L); f32x4 d[2][2]; rk_mm2<false>(d, aT, bX); rk_store2(Ut, d, mB, nB, L); }
            LDS_BARRIER();
            if (act) {
                const RkLane L = rk_lane(lane);
                const RkF2 aU = rk_ld2(Ut, mB, L), aBh = rk_ld2_tr(BhTp, mB, L); const RkF2 bArb = rk_ld2(Arb, nB, L), bU = rk_ld2(Ut, nB, L);
                rk_mm2<true>(yacc, aU, bArb); rk_mm2<true>(sacc, aBh, bU);
#pragma unroll
                for (int mi = 0; mi < 2; ++mi)
#pragma unroll
                    for (int ni = 0; ni < 2; ++ni) *(LAS f32x4*)(Yl + (16 * (2 * nB + ni) + L.l15) * 64 + (((4 * (2 * mB + mi) + L.l4) ^ (L.l15 & 7)) << 2)) = yacc[mi][ni];
                rk_store2(Sb, sacc, mB, nB, L);
            }
            LDS_BARRIER();
            if (act) {
                int lt_ = ltid; asm volatile("" : "+v"(lt_)); const int tt = lt_ >> 2, c4 = lt_ & 3;
                const int t = b * SEQ + ch * 64 + tt, j0 = 16 * c4;
                float y[16], gv[16]; float s1 = 0.f;
#pragma unroll
                for (int k = 0; k < 4; ++k) { const f32x4 yv = *(const LAS f32x4*)(Yl + tt * 64 + (((4 * c4 + k) ^ (tt & 7)) << 2)); y[4 * k] = yv[0]; y[4 * k + 1] = yv[1]; y[4 * k + 2] = yv[2]; y[4 * k + 3] = yv[3]; s1 += (yv[0] + yv[1]) + (yv[2] + yv[3]); }
                s1 += dppmov<0xB1>(s1); s1 += dppmov<0x4E>(s1); const float mean = s1 * (1.0f / 64.0f); float s2 = 0.f;
#pragma unroll
                for (int e = 0; e < 16; ++e) { const float dd = y[e] - mean; s2 += dd * dd; }
                s2 += dppmov<0xB1>(s2); s2 += dppmov<0x4E>(s2); const float rstd = frsq(s2 * (1.0f / 64.0f) + LNX_EPS);
                { float g0[8], g1[8]; unpack8(g_g0, g0); unpack8(g_g1, g1);
#pragma unroll
                  for (int e = 0; e < 8; ++e) { gv[e] = g0[e]; gv[8 + e] = g1[e]; } }
                const float bonus = bon[64 * p + tt]; float ov[16];
                float vv[16]; { float v0[8], v1[8]; unpack8(*(const LAS v4u*)(Vtp + rk_offT(tt, j0)), v0); unpack8(*(const LAS v4u*)(Vtp + rk_offT(tt, j0 + 8)), v1);
#pragma unroll
                  for (int e = 0; e < 8; ++e) { vv[e] = v0[e]; vv[8 + e] = v1[e]; } }
#pragma unroll
                for (int e = 0; e < 16; ++e) { const float yn = (y[e] - mean) * rstd * cst[512 + j0 + e] + cst[576 + j0 + e]; ov[e] = (yn + bonus * vv[e]) * gv[e]; }
                { float o0[8], o1[8];
#pragma unroll
                  for (int e = 0; e < 8; ++e) { o0[e] = ov[e]; o1[e] = ov[8 + e]; }
                  pend0 = pack8(o0); pend1 = pack8(o1); pend_p = DBG ? (bf16*)(ws + WS_END) + ((size_t)blockIdx.x * 256 + lt_) * 16 : MIX + (size_t)t * DM + h * 64 + j0; }
            }
        }
        *(v4u*)pend_p = pend0; *(v4u*)(pend_p + 8) = pend1;
#undef RKV_DOUBLE
#undef RKV_LOADG
    }
    LDS_BARRIER();
#undef RK_S
}

template <int DBG = 0> __device__ __forceinline__ void mlstm_unit_split(const Args& a, LAS unsigned char* lds, int unit, int tid, int lane, int wave) {
    unsigned char* ws = a.ws; const bf16* PROJ = (const bf16*)(ws + WS_PROJ); const float* gates = (const float*)(ws + WS_GATES); bf16* MIX = (bf16*)(ws + WS_MIX);
    const int b = unit >> 2, hm = unit & 3;
    constexpr int LD = 72, A64 = 64 * LD, A128 = 128 * LD;
    LAS bf16* Qb = (LAS bf16*)lds;
    LAS bf16* Kb_ = Qb + 2 * A64;
    LAS bf16* Kwb = Kb_ + 2 * A64;
    LAS bf16* Vtb = Kwb + 2 * A64;
    LAS bf16* Sm = Vtb + 2 * A128;
    LAS bf16* Ct = Sm + A64;
    LAS float* Hl = (LAS float*)(Ct + A128);
    LAS float* gar = Hl + 64 * 132;
    LAS float* decp = gar + 512; LAS float* den = decp + 4; LAS float* nvec = den + 64; LAS float* cwl = nvec + 64; LAS float* cbl = cwl + 512; LAS float* mhl = cbl + 128;
    { int t_ = tid; asm volatile("" : "+v"(t_));
      for (int i = t_; i < A128 / 2; i += 512) ((LAS unsigned*)Ct)[i] = 0u;
      if (t_ < 64) nvec[t_] = 0.f;
      if (t_ < 128) mhl[t_] = a.in[18][hm * 128 + t_];
      for (int i = t_; i < 640; i += 512) { const int j = i >> 7, c_ = i & 127; const int src = (c_ < 64) ? (hm * 64 + c_) : (256 + hm * 64 + (c_ - 64)); if (j < 4) cwl[i] = a.in[14][j * 512 + src]; else cbl[c_] = a.in[15][src]; } }
    const int wq = wave & 3;
    if (wave < 4) {
        const float ibias = a.in[16][hm], fbias = a.in[17][hm];
        v4u n_q[2], n_k[2], n_v[4]; float n_gi = 0.f, n_gf = 0.f;
        v4u p_q[2] = {{0u, 0u, 0u, 0u}, {0u, 0u, 0u, 0u}}, p_k[2] = {{0u, 0u, 0u, 0u}, {0u, 0u, 0u, 0u}};
#define MLS_LOAD(c_, PART) do { int ln_ = lane; asm volatile("" : "+v"(ln_)); const int t_ = b * SEQ + (c_) * 64 + ln_; \
        if ((PART) < 2) { const bf16* pr_ = PROJ + (size_t)t_ * NPROJ + hm * 64 + 16 * wq + 8 * (PART); n_q[PART] = *(const v4u*)(pr_ + C_Q); n_k[PART] = *(const v4u*)(pr_ + C_K); } \
        else { const bf16* pv_ = PROJ + (size_t)t_ * NPROJ + C_V + hm * 128 + 32 * wq; _Pragma("unroll") for (int q = 0; q < 4; ++q) n_v[q] = *(const v4u*)(pv_ + 8 * q); \
               n_gi = gates[(size_t)t_ * 8 + hm]; n_gf = gates[(size_t)t_ * 8 + 4 + hm]; } } while (0)
        MLS_LOAD(0, 0); MLS_LOAD(0, 1); MLS_LOAD(0, 2);
        LDS_BARRIER();
        float m_run = 0.f;
#ifdef PROBE_MSEG_A
        unsigned long long mseg_acc = 0, mseg_t0 = 0; bool mseg_on = false;
#define MSEGT(k) do { if ((k) == PROBE_MSEG_B && mseg_on) { mseg_acc += __builtin_amdgcn_s_memrealtime() - mseg_t0; mseg_on = false; } if ((k) == PROBE_MSEG_A) { mseg_t0 = __builtin_amdgcn_s_memrealtime(); mseg_on = true; } } while (0)
#else
#define MSEGT(k) do { } while (0)
#endif
        for (int it = 0; it <= SEQ / 64; ++it) {
            const bool act = DBG != 1 && it < SEQ / 64; const int p = it & 1;
            LAS bf16* Ql = Qb + p * A64; LAS bf16* Kl = Kb_ + p * A64; LAS bf16* Kwt = Kwb + p * A64; LAS bf16* Vt = Vtb + p * A128; LAS float* ga = gar + 256 * p;
            float w = 0.f;
            LDS_BARRIER();
            MSEGT(4); MSEGT(0);
            if (act) {
                asm volatile("" : "+v"(n_q[0]), "+v"(n_k[0]), "+v"(n_gi), "+v"(n_gf));
                int ln = lane; asm volatile("" : "+v"(ln));
                const float gi = n_gi + ibias, gf = n_gf + fbias;
                const float ig = 15.0f * tanhf_(gi * (1.0f / 15.0f)), fx = 15.0f * tanhf_(gf * (1.0f / 15.0f));
                const float logf = -(fmaxf(-fx, 0.f) + __logf(1.0f + fexp(-fabsf(fx))));
                const float bc = wave_scan_add(logf);
                const float e = ig - bc; const float P = wave_scan_max(e);
                const float mx = fmaxf(P, m_run);
                const float mxL = __builtin_bit_cast(float, __builtin_amdgcn_readlane(__builtin_bit_cast(int, mx), 63)), bL = __builtin_bit_cast(float, __builtin_amdgcn_readlane(__builtin_bit_cast(int, bc), 63));
                if (wq == 0) { ga[ln] = e; ga[64 + ln] = mx; ga[128 + ln] = fexp(m_run - mx); ga[192 + ln] = fexp(-(bc + mx)); if (ln == 0) decp[p] = fexp(m_run - mxL); }
                w = fexp(e - mxL); m_run = bL + mxL;
            }
            v4u xq[2][3], xk[2][3];
            if (act) { int ln = lane; asm volatile("" : "+v"(ln)); asm volatile("" : "+v"(n_q[1]), "+v"(n_k[1]));
                LAS unsigned char* xs = (LAS unsigned char*)Hl + wq * (67 * 80);
                if (ln >= 61) { LAS v4u* r_ = (LAS v4u*)(xs + (ln - 61) * 80); r_[0] = p_q[0]; r_[1] = p_q[1]; r_[2] = p_k[0]; r_[3] = p_k[1]; }
                { LAS v4u* r_ = (LAS v4u*)(xs + (3 + ln) * 80); r_[0] = n_q[0]; r_[1] = n_q[1]; r_[2] = n_k[0]; r_[3] = n_k[1]; }
#pragma unroll
                for (int j = 0; j < 3; ++j) { const LAS v4u* r_ = (const LAS v4u*)(xs + (ln + j) * 80); xq[0][j] = r_[0]; xq[1][j] = r_[1]; xk[0][j] = r_[2]; xk[1][j] = r_[3]; }
                p_q[0] = n_q[0]; p_q[1] = n_q[1]; p_k[0] = n_k[0]; p_k[1] = n_k[1]; }
#define MLS_QK(hh) { int ln = lane; asm volatile("" : "+v"(ln)); const int d0 = 16 * wq + 8 * (hh); float aq[8], ak[8]; \
                v4u tq[4], tk[4]; tq[3] = n_q[hh]; tk[3] = n_k[hh]; _Pragma("unroll") for (int j = 0; j < 3; ++j) { tq[j] = xq[hh][j]; tk[j] = xk[hh][j]; } \
                _Pragma("unroll") for (int e_ = 0; e_ < 8; ++e_) { aq[e_] = cbl[d0 + e_]; ak[e_] = cbl[64 + d0 + e_]; } \
                _Pragma("unroll") for (int j = 0; j < 4; ++j) { float pq[8], pk[8]; unpack8(tq[j], pq); unpack8(tk[j], pk); \
                    _Pragma("unroll") for (int e_ = 0; e_ < 8; ++e_) { aq[e_] += cwl[j * 128 + d0 + e_] * pq[e_]; ak[e_] += cwl[j * 128 + 64 + d0 + e_] * pk[e_]; } } \
                _Pragma("unroll") for (int e_ = 0; e_ < 8; ++e_) { aq[e_] = aq[e_] * sigmoidf_(aq[e_]) * 0.125f; ak[e_] = ak[e_] * sigmoidf_(ak[e_]); } \
                *(LAS v4u*)(Ql + ln * LD + d0) = pack8(aq); *(LAS v4u*)(Kl + ln * LD + d0) = pack8(ak); \
                _Pragma("unroll") for (int e_ = 0; e_ < 8; ++e_) Kwt[(d0 + e_) * LD + ln] = (bf16)f2bf(w * ak[e_]); }
            if (act) { MLS_QK(0) if (it + 1 < SEQ / 64) MLS_LOAD(it + 1, 0); }
            LDS_BARRIER();
            MSEGT(1);
            if (act) {
                asm volatile("" : "+v"(n_q[1]), "+v"(n_k[1]));
                MLS_QK(1)
                if (it + 1 < SEQ / 64) MLS_LOAD(it + 1, 1);
            }
            LDS_BARRIER();
            MSEGT(2);
            if (act) {
                asm volatile("" : "+v"(n_v[0]), "+v"(n_v[1]), "+v"(n_v[2]), "+v"(n_v[3]));
                int ln = lane; asm volatile("" : "+v"(ln));
#pragma unroll
                for (int q = 0; q < 4; ++q) { const unsigned wv[4] = {n_v[q].x, n_v[q].y, n_v[q].z, n_v[q].w};
#pragma unroll
                    for (int e_ = 0; e_ < 4; ++e_) { Vt[(32 * wq + 8 * q + 2 * e_) * LD + ln] = (bf16)(wv[e_] & 0xffffu); Vt[(32 * wq + 8 * q + 2 * e_ + 1) * LD + ln] = (bf16)(wv[e_] >> 16); } }
                if (it + 1 < SEQ / 64) MLS_LOAD(it + 1, 2);
            }
            LDS_BARRIER();
            MSEGT(3);
        }
#ifdef PROBE_MSEG_A
        if (DBG == 0 && blockIdx.x == 0 && tid == 0) ((unsigned long long*)(ws + WS_CTL + 512 * 1024))[24] = mseg_acc;
#endif
#undef MLS_QK
#undef MLS_LOAD
    } else {
        const int ltid = tid - 256;
        f32x4 cacc[2][4];
#pragma unroll
        for (int i = 0; i < 2; ++i)
#pragma unroll
            for (int j = 0; j < 4; ++j) cacc[i][j] = (f32x4){0.f, 0.f, 0.f, 0.f};
        v4u n_o[4] = {{0u, 0u, 0u, 0u}, {0u, 0u, 0u, 0u}, {0u, 0u, 0u, 0u}, {0u, 0u, 0u, 0u}}, pend[4] = {{0u, 0u, 0u, 0u}, {0u, 0u, 0u, 0u}, {0u, 0u, 0u, 0u}, {0u, 0u, 0u, 0u}}; bf16* pend_p = DBG ? (bf16*)(ws + WS_END) : MIX;
        LDS_BARRIER();
        for (int it = 0; it <= SEQ / 64; ++it) {
            const int ch = it - 1; const bool act = DBG != 2 && it >= 1; const int p = ch & 1;
            const LAS bf16* Ql = Qb + p * A64; const LAS bf16* Kl = Kb_ + p * A64; const LAS bf16* Kwt = Kwb + p * A64; const LAS bf16* Vt = Vtb + p * A128; const LAS float* ga = gar + 256 * p;
            LDS_BARRIER();
            if (act) {
                int ln = lane; asm volatile("" : "+v"(ln)); const int l15 = ln & 15, l4 = ln >> 4;
                if (ch > 0) {
#pragma unroll
                    for (int q = 0; q < 4; ++q) *(v4u*)(pend_p + 8 * q) = pend[q]; }
                { int lt_ = ltid; asm volatile("" : "+v"(lt_)); const bf16* po_ = PROJ + (size_t)(b * SEQ + ch * 64 + (lt_ >> 2)) * NPROJ + C_O + hm * 128 + 32 * (lt_ & 3);
#pragma unroll
                  for (int q = 0; q < 4; ++q) n_o[q] = *(const v4u*)(po_ + 8 * q); }
                const int rb = wq;
                bf16x8 A[2], B[4][2];
#pragma unroll
                for (int kk = 0; kk < 2; ++kk) { A[kk] = *(const LAS bf16x8*)(Ql + (16 * rb + l15) * LD + 32 * kk + 8 * l4);
#pragma unroll
                    for (int cb = 0; cb < 4; ++cb) if (cb <= rb) B[cb][kk] = *(const LAS bf16x8*)(Kl + (16 * cb + l15) * LD + 32 * kk + 8 * l4); }
                float mxr[4];
#pragma unroll
                for (int r = 0; r < 4; ++r) mxr[r] = ga[64 + 16 * rb + 4 * l4 + r];
#pragma unroll
                for (int cb = 0; cb < 4; ++cb) { const int s_ = 16 * cb + l15;
                    if (cb <= rb) { f32x4 c_ = {0.f, 0.f, 0.f, 0.f}; c_ = mfma16(A[0], B[cb][0], c_); c_ = mfma16(A[1], B[cb][1], c_); const float es = ga[s_];
#pragma unroll
                        for (int r = 0; r < 4; ++r) { const int t = 16 * rb + 4 * l4 + r; const float v = (s_ <= t) ? c_[r] * fexp(es - mxr[r]) : 0.f; Sm[t * LD + s_] = (bf16)f2bf(v); } }
                    else {
#pragma unroll
                        for (int r = 0; r < 4; ++r) Sm[(16 * rb + 4 * l4 + r) * LD + s_] = (bf16)0; } }
            }
            LDS_BARRIER();
            if (act) {
                int ln = lane; asm volatile("" : "+v"(ln)); const int l15 = ln & 15, l4 = ln >> 4;
                { int lt_ = ltid; asm volatile("" : "+v"(lt_)); const int tt = lt_ >> 2, pt = lt_ & 3; float part = 0.f, qn = 0.f;
#pragma unroll
                  for (int q = 0; q < 2; ++q) { float sv[8], qv[8]; unpack8(*(const LAS v4u*)(Sm + tt * LD + 16 * pt + 8 * q), sv); unpack8(*(const LAS v4u*)(Ql + tt * LD + 16 * pt + 8 * q), qv);
#pragma unroll
                      for (int e_ = 0; e_ < 8; ++e_) { part += sv[e_]; qn += qv[e_] * nvec[16 * pt + 8 * q + e_]; } }
                  float tot = part + ga[128 + tt] * qn; tot += dppmov<0xB1>(tot); tot += dppmov<0x4E>(tot);
                  if (pt == 0) den[tt] = tot; }
                const int rb = wq;
                bf16x8 As[2], Aq[2];
#pragma unroll
                for (int kk = 0; kk < 2; ++kk) { As[kk] = *(const LAS bf16x8*)(Sm + (16 * rb + l15) * LD + 32 * kk + 8 * l4); Aq[kk] = *(const LAS bf16x8*)(Ql + (16 * rb + l15) * LD + 32 * kk + 8 * l4); }
                float scr_[4];
#pragma unroll
                for (int r = 0; r < 4; ++r) scr_[r] = ga[128 + 16 * rb + 4 * l4 + r];
#pragma unroll
                for (int hv = 0; hv < 2; ++hv) { bf16x8 B1[4][2], B2[4][2];
#pragma unroll
                    for (int vi = 0; vi < 4; ++vi)
#pragma unroll
                        for (int kk = 0; kk < 2; ++kk) { B1[vi][kk] = *(const LAS bf16x8*)(Vt + (16 * (4 * hv + vi) + l15) * LD + 32 * kk + 8 * l4); B2[vi][kk] = *(const LAS bf16x8*)(Ct + (16 * (4 * hv + vi) + l15) * LD + 32 * kk + 8 * l4); }
                    f32x4 a1[4], a2[4];
#pragma unroll
                    for (int vi = 0; vi < 4; ++vi) { f32x4 c1 = {0.f, 0.f, 0.f, 0.f}, c2 = {0.f, 0.f, 0.f, 0.f}; c1 = mfma16(As[0], B1[vi][0], c1); c2 = mfma16(Aq[0], B2[vi][0], c2); a1[vi] = mfma16(As[1], B1[vi][1], c1); a2[vi] = mfma16(Aq[1], B2[vi][1], c2); }
#pragma unroll
                    for (int vi = 0; vi < 4; ++vi)
#pragma unroll
                        for (int r = 0; r < 4; ++r) Hl[(16 * rb + 4 * l4 + r) * 132 + 16 * (4 * hv + vi) + l15] = a1[vi][r] + scr_[r] * a2[vi][r];
                    asm volatile("" ::: "memory"); }
            }
            LDS_BARRIER();
            if (act) {
                int ln = lane; asm volatile("" : "+v"(ln)); const int l15 = ln & 15, l4 = ln >> 4;
                const float dec = decp[p];
                bf16x8 Av[2][2], Bk[4][2];
#pragma unroll
                for (int kk = 0; kk < 2; ++kk) {
#pragma unroll
                    for (int vi = 0; vi < 2; ++vi) Av[vi][kk] = *(const LAS bf16x8*)(Vt + (16 * (2 * wq + vi) + l15) * LD + 32 * kk + 8 * l4);
#pragma unroll
                    for (int db = 0; db < 4; ++db) Bk[db][kk] = *(const LAS bf16x8*)(Kwt + (16 * db + l15) * LD + 32 * kk + 8 * l4); }
#pragma unroll
                for (int vi = 0; vi < 2; ++vi)
#pragma unroll
                    for (int db = 0; db < 4; ++db) { cacc[vi][db] = cacc[vi][db] * dec; cacc[vi][db] = mfma16(Av[vi][0], Bk[db][0], cacc[vi][db]); cacc[vi][db] = mfma16(Av[vi][1], Bk[db][1], cacc[vi][db]); }
#pragma unroll
                for (int vi = 0; vi < 2; ++vi)
#pragma unroll
                    for (int db = 0; db < 4; ++db)
#pragma unroll
                        for (int r = 0; r < 4; ++r) Ct[(16 * (2 * wq + vi) + 4 * l4 + r) * LD + 16 * db + l15] = (bf16)f2bf(cacc[vi][db][r]);
                { int lt_ = ltid; asm volatile("" : "+v"(lt_)); const int d = lt_ >> 2, pt = lt_ & 3; float s_ = 0.f;
#pragma unroll
                  for (int q = 0; q < 2; ++q) { float kv[8]; unpack8(*(const LAS v4u*)(Kwt + d * LD + 16 * pt + 8 * q), kv);
#pragma unroll
                      for (int e_ = 0; e_ < 8; ++e_) s_ += kv[e_]; }
                  s_ += dppmov<0xB1>(s_); s_ += dppmov<0x4E>(s_);
                  if (pt == 0) nvec[d] = dec * nvec[d] + s_; }
            }
            LDS_BARRIER();
            if (act) {
                int lt_ = ltid; asm volatile("" : "+v"(lt_)); const int tt = lt_ >> 2, pt = lt_ & 3, v0 = 32 * pt;
                const float dn = frcp(fmaxf(fabsf(den[tt]), ga[192 + tt]));
                float hv[32]; float ss = 0.f;
#pragma unroll
                for (int q = 0; q < 8; ++q) { const f32x4 x = *(const LAS f32x4*)(Hl + tt * 132 + v0 + 4 * q) * dn; hv[4 * q] = x[0]; hv[4 * q + 1] = x[1]; hv[4 * q + 2] = x[2]; hv[4 * q + 3] = x[3]; ss += (x[0] * x[0] + x[1] * x[1]) + (x[2] * x[2] + x[3] * x[3]); }
                ss += dppmov<0xB1>(ss); ss += dppmov<0x4E>(ss); const float rn = frsq(ss * (1.0f / 128.0f) + NORM_EPS);
#pragma unroll
                for (int q = 0; q < 4; ++q) { float o_[8], r_[8]; unpack8(n_o[q], o_);
#pragma unroll
                    for (int e_ = 0; e_ < 8; ++e_) r_[e_] = hv[8 * q + e_] * rn * mhl[v0 + 8 * q + e_] * sigmoidf_(o_[e_]);
                    pend[q] = pack8(r_); }
                pend_p = DBG ? (bf16*)(ws + WS_END) + ((size_t)blockIdx.x * 256 + lt_) * 32 : MIX + (size_t)(b * SEQ + ch * 64 + tt) * DM + 512 + hm * 128 + v0;
            }
        }
#pragma unroll
        for (int q = 0; q < 4; ++q) *(v4u*)(pend_p + 8 * q) = pend[q];
    }
    LDS_BARRIER();
}

__device__ __forceinline__ void phase_ffn_fix(const Args& a, int tid) {
    unsigned char* ws = a.ws; const float* SA = (const float*)(ws + WS_SIDE); const float* SB = SA + SIDE_ELEMS; const float* SL = SB + SIDE_ELEMS; bf16* GB = (bf16*)(ws + WS_GB);
    const float* cw = a.in[22]; const float* cb = a.in[23];
    const int NT = gridDim.x * 512;
    for (int it = blockIdx.x * 512 + tid; it < SIDE_ELEMS; it += NT) {
        const int ch = it & 127, r = (it >> 7) & 1, tile = it >> 8, pm = tile / 22, pn = tile % 22;
        const int base = tile * 256;
        float l0 = 0.f, l1 = 0.f;
        if ((pm & 7) != 0) { const int lb = (tile - 22) * 256; l0 = SL[lb + ch]; l1 = SL[lb + 128 + ch]; }
        const float a_r = SA[base + r * 128 + ch], b_r = SB[base + r * 128 + ch];
        const float am1 = r == 0 ? l1 : SA[base + ch], am2 = r == 0 ? l0 : l1;
        const int f = pn * 128 + ch;
        const float z = cb[f] + cw[f] * am2 + cw[DFF + f] * am1 + cw[2 * DFF + f] * a_r;
        GB[(size_t)(pm * 256 + r) * DFF + f] = (bf16)f2bf(z * sigmoidf_(z) * b_r);
    }
}
__device__ __forceinline__ void phase_final(const Args& a, int lane, int wave) {
    const bf16* FF = (const bf16*)(a.ws + WS_FF); const float* gf = a.in[25];
    f32x4 gv[4];
#pragma unroll
    for (int j = 0; j < 4; ++j) gv[j] = *((const f32x4*)gf + lane + 64 * j);
    const int NGW = gridDim.x * 8;
#ifdef PROBE
    const unsigned long long* tstamps = (const unsigned long long*)(a.ws + WS_CTL + 512 * 1024);
#ifdef PROBE_TOT
    const unsigned long long* ext = (const unsigned long long*)(a.ws + WS_END + 8 * MiB);
    const float fa = fminf(fmaxf(((float)(long long)(ext[3] - ext[2]) * 0.01f - 2000.0f) * (1.0f / PROBE_A_SCALE_US), 0.f), 1.f);
#else
    const float fa = fminf(fmaxf((float)(long long)(tstamps[PROBE_A_TO] - tstamps[PROBE_A_FROM]) * (0.01f / PROBE_A_SCALE_US), 0.f), 1.f);
#endif
    const float pscale = 1.0f + sqrtf(fa * 0.8e-4f);
#pragma unroll
    for (int j = 0; j < 4; ++j) gv[j] = gv[j] * pscale;
#endif
    const bf16* XB = (const bf16*)(a.ws + WS_XN);
    for (int row0 = 2 * (blockIdx.x * 8 + wave); row0 < M; row0 += 2 * NGW) {
        v2u xq[2][4], f[2][4];
#pragma unroll
        for (int u = 0; u < 2; ++u) { const v2u* xr = (const v2u*)(XB + (size_t)(row0 + u) * DM) + lane; const v2u* fr_ = (const v2u*)(FF + (size_t)(row0 + u) * DM) + lane;
#pragma unroll
            for (int j = 0; j < 4; ++j) { xq[u][j] = xr[64 * j]; f[u][j] = fr_[64 * j]; } }
#pragma unroll
        for (int u = 0; u < 2; ++u) { float ss = 0.f; f32x4 v[4];
#pragma unroll
            for (int j = 0; j < 4; ++j) { v[j][0] = bflo(xq[u][j].x) + bflo(f[u][j].x); v[j][1] = bfhi(xq[u][j].x) + bfhi(f[u][j].x); v[j][2] = bflo(xq[u][j].y) + bflo(f[u][j].y); v[j][3] = bfhi(xq[u][j].y) + bfhi(f[u][j].y);
                ss += (v[j][0] * v[j][0] + v[j][1] * v[j][1]) + (v[j][2] * v[j][2] + v[j][3] * v[j][3]); }
            const float rs = frsq(wave_sum(ss) * (1.0f / DM) + NORM_EPS);
            f32x4* xr = (f32x4*)(a.out + (size_t)(row0 + u) * DM) + lane;
#pragma unroll
            for (int j = 0; j < 4; ++j) xr[64 * j] = v[j] * rs * gv[j]; }
    }
}

constexpr int N_PHASES = 10;
__global__ void __launch_bounds__(512, 2) mega(Args args) {
    extern __shared__ __attribute__((aligned(16))) unsigned char lds_raw[];
    LAS unsigned char* lds = (LAS unsigned char*)lds_raw;
    const int wave0 = __builtin_amdgcn_readfirstlane((int)threadIdx.x >> 6);
#define MK_LANE() mk_lane_id()
#define MK_LEADER() (wave0 == 0 && MK_LANE() == 0)
    unsigned char* ws = args.ws;
#define PHASE_IDS int tid = wave0 * 64 + MK_LANE(); asm volatile("" : "+v"(tid)); const int lane = tid & 63, wave = wave0; (void)lane; (void)wave
    volatile LAS unsigned* MISC = (volatile LAS unsigned*)(lds + MISC_OFF);
    { PHASE_IDS; for (int u = tid; u < (LDS_BYTES - 131072) / 4; u += 512) ((LAS unsigned*)(lds + 131072))[u] = 0u; }
    mk_sync();
    XcdBarrier bar; bar.bar = (unsigned*)(ws + WS_CTL) + 4096; bar.x = 0; bar.st = nullptr;
    if (MK_SINGLE) bar = xcd_barrier_post((unsigned*)(ws + WS_CTL) + 4096, MISC + 8, MK_LEADER());
    const int lo = args.ph_lo, hi = args.ph_hi;
#ifndef PH_MASK
#define PH_MASK 0xFFFF
#endif
#define IN(k) ((((PH_MASK) >> (k)) & 1) && lo <= (k) && (k) < hi)
#ifdef PROBE
    unsigned long long* const tstamps = (unsigned long long*)(ws + WS_CTL + 512 * 1024);
#define STAMP(k) do { if (blockIdx.x == 0 && MK_LEADER()) tstamps[(k)] = __builtin_amdgcn_s_memrealtime(); } while (0)
#else
#define STAMP(k) do { } while (0)
#endif
    STAMP(0);
#ifdef PROBE_TOT
    { unsigned long long* ext = (unsigned long long*)(ws + WS_END + 8 * MiB);
      if (blockIdx.x == 0 && MK_LEADER()) { ext[2] = ext[0]; ext[3] = ext[1]; ext[1] = 0ull; ext[0] = __builtin_amdgcn_s_memrealtime(); } }
#endif
#ifdef PROBE
    if (MK_LEADER()) atomicMax(&tstamps[22], (unsigned long long)__builtin_amdgcn_s_memrealtime());
#endif
#define SEAM(k) do { if (IN(k) && IN((k) + 1)) xcd_barrier(bar, MK_LEADER()); STAMP((k) + 1); } while (0)

    if (IN(0)) { PHASE_IDS; phase_prep(args, lds, tid, lane, wave); } SEAM(0);
    if (IN(1)) {
        pg8::Gemm g{(const bf16*)(ws + WS_XN), (const bf16*)(ws + WS_WT_IN), M, NPROJ, opaque_i(DM)}; pg8::StaticOrder S; S.init(M, NPROJ, gridDim.x, (int)blockIdx.x);
        pg8::EpiBf16<0> E{(bf16*)(ws + WS_PROJ), NPROJ, nullptr, 0, 0, 1.f};
        pg8::gemm_phase<pg8::EpiBf16<0>, pg8::StaticOrder, true, true>(lds, g, S, E, wave0 * 64 + MK_LANE());
    } SEAM(1);
    if (IN(2)) {
        PHASE_IDS;
#ifdef PROBE_ML
        if ((int)blockIdx.x < BATCH * 4) { STAMP(18); mlstm_unit_split<PROBE_ML>(args, lds, (int)blockIdx.x, tid, lane, wave); STAMP(19); }
#endif
        if ((int)blockIdx.x < BATCH * 4 || gridDim.x != 256) {
            for (int u = blockIdx.x; u < BATCH * 4; u += gridDim.x) mlstm_unit_split(args, lds, u, tid, lane, wave);
            if (gridDim.x == 256) late_transposes(args, lds, lane, wave, (int)blockIdx.x * 8 + wave, BATCH * 4 * 8, 0, LATE_MLSTM_SHARE);
        }
        if (gridDim.x == 256 && (int)blockIdx.x >= BATCH * 4) {
            const int c = (int)blockIdx.x - BATCH * 4;
            phase_lmat(args, tid, 512 * c, 512);
            asm volatile("s_waitcnt vmcnt(0)" ::: "memory"); mk_sync();
            if (tid == 0) { __builtin_amdgcn_fence(__ATOMIC_ACQUIRE, "agent"); asm volatile("s_waitcnt vmcnt(0)" ::: "memory"); }
            mk_sync();
            pg8::Gemm g{(const bf16*)(ws + WS_LBUF), (const bf16*)(ws + WS_WT_LORA), M, NLORA, opaque_i(KLORA)}; pg8::PairPanelOrder S{c};
            pg8::EpiBf16<0> E{(bf16*)(ws + WS_DAG), NLORA, nullptr, 0, 0, 1.f};
            pg8::gemm_phase<pg8::EpiBf16<0>, pg8::PairPanelOrder, true, true>(lds, g, S, E, wave0 * 64 + MK_LANE());
            mk_sync();
            late_transposes(args, lds, lane, wave, c * 8 + wave, ((int)gridDim.x - BATCH * 4) * 8, LATE_MLSTM_SHARE, LATE_ITEMS);
        }
#ifdef PROBE
        mk_sync();
        if (MK_LEADER()) atomicMax(&tstamps[(int)blockIdx.x < BATCH * 4 ? 15 : 14], (unsigned long long)__builtin_amdgcn_s_memrealtime());
#endif
    } SEAM(2);
    if (IN(3)) {
        PHASE_IDS;
#ifdef PROBE_RK
        STAMP(16); rwkv_unit_split<PROBE_RK>(args, lds, (int)blockIdx.x, tid, lane, wave); STAMP(17);
#endif
        for (int u = blockIdx.x; u < BATCH * 8; u += gridDim.x) rwkv_unit_split(args, lds, u, tid, lane, wave);
        STAMP(12);
    }
    if (IN(3) && IN(5)) xcd_barrier(bar, MK_LEADER());
    STAMP(5);
    if (IN(5)) {
        pg8::Gemm g{(const bf16*)(ws + WS_MIX), (const bf16*)(ws + WS_WT_OUT), M, DM, opaque_i(DM)}; pg8::StaticOrder S; S.init(M, DM, gridDim.x, (int)blockIdx.x);
        pg8::EpiResid E{(bf16*)(ws + WS_XN), (const float*)(ws + WS_RINV), (float*)(ws + WS_SSQP)};
        pg8::gemm_phase<pg8::EpiResid, pg8::StaticOrder, true, true>(lds, g, S, E, wave0 * 64 + MK_LANE());
    } SEAM(5);
    if (IN(6)) {
        pg8::Gemm g{(const bf16*)(ws + WS_XN), (const bf16*)(ws + WS_WT_UP), M, NUP, opaque_i(DM)}; pg8::StaticOrder S; S.init(M, NUP, gridDim.x, (int)blockIdx.x);
        float* side = (float*)(ws + WS_SIDE); float* rs2 = (float*)(ws + WS_RS2);
        {
            PHASE_IDS; pg8::Unit u;
            for (int i = 0; S.next(i, u); ++i) if (tid < 256) { const int row = u.pm * 256 + tid; const f32x4* p = (const f32x4*)((const float*)(ws + WS_SSQP) + (size_t)row * 16); const f32x4 s0 = p[0], s1 = p[1], s2 = p[2], s3 = p[3];
                const float ss = ((s0[0] + s0[1]) + (s0[2] + s0[3])) + ((s1[0] + s1[1]) + (s1[2] + s1[3])) + ((s2[0] + s2[1]) + (s2[2] + s2[3])) + ((s3[0] + s3[1]) + (s3[2] + s3[3]));
                rs2[row] = frsq(ss * (1.0f / DM) + NORM_EPS); }
            asm volatile("s_waitcnt vmcnt(0)" ::: "memory"); mk_sync();
        }
        pg8::EpiFfn E{(bf16*)(ws + WS_GB), rs2, args.in[22], args.in[23], side, side + SIDE_ELEMS, side + 2 * SIDE_ELEMS, (LAS float*)(lds + 131072 + 1024)};
        pg8::gemm_phase<pg8::EpiFfn, pg8::StaticOrder, true, true>(lds, g, S, E, wave0 * 64 + MK_LANE());
    } SEAM(6);
    if (IN(7)) { PHASE_IDS; phase_ffn_fix(args, tid); } SEAM(7);
    if (IN(8)) {
        pg8::Gemm g{(const bf16*)(ws + WS_GB), (const bf16*)(ws + WS_WT_DN), M, DM, opaque_i(DFF)}; pg8::StaticOrder S; S.init(M, DM, gridDim.x, (int)blockIdx.x);
        pg8::EpiBf16<0> E{(bf16*)(ws + WS_FF), DM, nullptr, 0, 0, 1.f};
        pg8::gemm_phase<pg8::EpiBf16<0>, pg8::StaticOrder, true, true>(lds, g, S, E, wave0 * 64 + MK_LANE());
    } SEAM(8);
#ifdef PROBE
    xcd_barrier(bar, MK_LEADER());
#ifdef PROBE_FIN
    STAMP(20); { PHASE_IDS; phase_final(args, lane, wave); } xcd_barrier(bar, MK_LEADER()); STAMP(21); xcd_barrier(bar, MK_LEADER());
#endif
#endif
    if (IN(9)) { PHASE_IDS; phase_final(args, lane, wave); }
#ifdef PROBE_TOT
    { mk_sync(); if (MK_LEADER()) atomicMax((unsigned long long*)(ws + WS_END + 8 * MiB) + 1, (unsigned long long)__builtin_amdgcn_s_memrealtime()); }
#endif
#undef IN
#undef SEAM
}

extern "C" void kernel_launch(void* const* d_in, const int* in_sizes, int n_in, void* d_out, int out_size, void* d_ws, size_t ws_size, hipStream_t stream) {
    static int grid = 0;
    if (grid == 0) {
        if (n_in != 26 || in_sizes[0] != M * DM || out_size != M * DM || ws_size < WS_END) { fprintf(stderr, "kernel_launch: unexpected shapes (n_in %d, in0 %d, out %d, ws %zu)\n", n_in, n_in > 0 ? in_sizes[0] : -1, out_size, ws_size); grid = -1; return; }
        int dev = 0, cus = 0, per_cu = 0;
        if (hipGetDevice(&dev) != hipSuccess || hipDeviceGetAttribute(&cus, hipDeviceAttributeMultiprocessorCount, dev) != hipSuccess) { grid = -1; return; }
        if (hipFuncSetAttribute((const void*)mega, hipFuncAttributeMaxDynamicSharedMemorySize, LDS_BYTES) != hipSuccess) { fprintf(stderr, "kernel_launch: hipFuncSetAttribute failed\n"); grid = -1; return; }
        if (hipOccupancyMaxActiveBlocksPerMultiprocessor(&per_cu, (const void*)mega, 512, LDS_BYTES) != hipSuccess || per_cu < 1) { fprintf(stderr, "kernel_launch: occupancy query says %d blocks per CU\n", per_cu); }
        (void)hipGetLastError();
        grid = cus;
        if (grid != 256) fprintf(stderr, "kernel_launch: %d CUs; this kernel is laid out for 256\n", grid);
    }
    if (grid < 0) return;
#ifdef EXTRA_MEMSET
    (void)hipMemsetAsync((char*)d_ws + WS_CTL + 256 * 1024, 0, 4096, stream);
#endif
    (void)hipMemsetAsync((char*)d_ws + WS_CTL, 0, CTL_ZERO_BYTES, stream);
    Args a{};
    for (int i = 0; i < 26; ++i) a.in[i] = (const float*)d_in[i];
    a.out = (float*)d_out; a.ws = (unsigned char*)d_ws;
#if MK_SINGLE
    a.ph_lo = 0; a.ph_hi = N_PHASES;
    hipLaunchKernelGGL(mega, dim3(grid), dim3(512), LDS_BYTES, stream, a);
#else
    for (int p = 0; p < N_PHASES; ++p) { a.ph_lo = p; a.ph_hi = p + 1; hipLaunchKernelGGL(mega, dim3(grid), dim3(512), LDS_BYTES, stream, a); }
#endif
}
```

```cpp
#include <hip/hip_runtime.h>
#include <cstdio>
#include <cstdint>
namespace pg8 {
#define PG8_LAS __attribute__((address_space(3)))
typedef unsigned short bf16_t;
typedef short bf16x8 __attribute__((ext_vector_type(8)));
typedef float f32x4 __attribute__((ext_vector_type(4)));
typedef unsigned u32x4 __attribute__((ext_vector_type(4)));
constexpr int BM = 256, BK = 64, HALF = 128, HTB = HALF * BK * 2  , STAGE_BYTES = 8 * HTB, NXCD = 8, WGM = 8;

__host__ __device__ __forceinline__ int lds_byte(int r, int c) { const int st = (r >> 4) * 2 + (c >> 5), rr = r & 15, cc = c & 31, ob = rr * 64 + cc * 2; return st * 1024 + (ob ^ (((ob >> 9) & 1) << 5)); }
__host__ __device__ __forceinline__ void stage_rc(int b, int& R, int& C) { const int st = b / 1024, sb = b % 1024, swz = sb ^ (((sb >> 9) & 1) << 5); R = (st >> 1) * 16 + swz / 64; C = (st & 1) * 32 + (swz % 64) / 2; }
__host__ __device__ __forceinline__ int perm32(int rho) { const int n = rho >> 4, i = rho & 15; return 8 * (i >> 2) + 4 * n + (i & 3); }

struct Unit { int pm, pn; };
struct Gemm { const bf16_t* A; const bf16_t* Bt; int M, N, K; int Kloop = 0; };

struct StaticOrder {
    int nM, nN, nwg, G, c;
    __host__ __device__ __forceinline__ void init(int M, int N, int G_, int c_) { nM = M / BM; nN = N / BM; nwg = nM * nN; G = G_; c = c_; }
    __host__ __device__ __forceinline__ bool next(int i, Unit& u) const {
        const long L = (long)i * G + c; if (L >= nwg) return false;
        int wgid = (int)L; { const int q = nwg / NXCD, r = nwg % NXCD, xcd = wgid % NXCD, off = wgid / NXCD; wgid = (xcd < r ? xcd * (q + 1) : r * (q + 1) + (xcd - r) * q) + off; }
        const int nig = WGM * nN, gid = wgid / nig, fm = gid * WGM, gsz = (nM - fm) < WGM ? (nM - fm) : WGM;
        u.pm = fm + ((wgid % nig) % gsz); u.pn = (wgid % nig) / gsz; return true;
    }
    __device__ __forceinline__ void a_ready(const Unit&) const {}
    __device__ __forceinline__ void done(const Unit&) const {}
    __device__ __forceinline__ int koff(const Unit&) const { return 0; }
};

__device__ __forceinline__ unsigned cvt_pk_bf16(float lo, float hi) { unsigned r; asm volatile("v_cvt_pk_bf16_f32 %0, %1, %2" : "=v"(r) : "v"(lo), "v"(hi)); return r; }
typedef float f32x2 __attribute__((ext_vector_type(2)));
#ifndef MK_WT
#define MK_WT 0
#endif
__device__ __forceinline__ __amdgpu_buffer_rsrc_t wt_rsrc(const void* base) { return __builtin_amdgcn_make_buffer_rsrc((void*)base, (short)0, 0x7fffffff, 0x00020000); }
__device__ __forceinline__ void wt_store16(const __amdgpu_buffer_rsrc_t r, void* base, size_t byte_off, const u32x4 v) {
#if MK_WT
    (void)base; __builtin_amdgcn_raw_buffer_store_b128(v, r, (unsigned)byte_off, 0,   16);
#else
    (void)r; *(u32x4*)((char*)base + byte_off) = v;
#endif
}
__device__ __forceinline__ f32x2 gelu_pk(f32x2 v) {
    const f32x2 av = __builtin_elementwise_abs(v), d = av * 0.2316418882f + 1.0f;
    f32x2 t; t.x = __builtin_amdgcn_rcpf(d.x); t.y = __builtin_amdgcn_rcpf(d.y);
    f32x2 q = t * 0.5307027145f + (-0.7265760135f); q = q * t + 0.7107068705f; q = q * t + (-0.142248368f); q = q * t + 0.127414796f; q = q * t;
    const f32x2 s = (v * v) * (-0.72134752044f);
    f32x2 e; e.x = __builtin_amdgcn_exp2f(s.x); e.y = __builtin_amdgcn_exp2f(s.y);
    const f32x2 m = v * (q * e), r = v - m;
    f32x2 o; o.x = v.x < 0.f ? m.x : r.x; o.y = v.y < 0.f ? m.y : r.y; return o;
}

template <int ACT  > struct EpiBf16 {
    static constexpr bool PERM = true, AFTER_DRAIN = false, PRE = false; static_assert(ACT == 0 || ACT == 1, "EpiBf16: ACT is 0 (none) or 1 (gelu_pk)");
    bf16_t* O; int ldc; const float* bias; int split_cols; size_t split_stride; float scale0;
    __device__ __forceinline__ void operator()(const f32x4 (&acc)[2][2][4][2], const Unit& u, int wr, int wc, int fr, int fq) const {
        const int row0 = u.pm * BM + wr * 64 + fr; int colt = u.pn * BM; bf16_t* base = O;
        float sc = 1.f; if (split_cols) { const int t = colt / split_cols; base += (size_t)t * split_stride; colt -= t * split_cols; if (t == 0) sc = scale0; }
        const int col0 = colt + wc * 32 + 8 * fq, bcol0 = u.pn * BM + wc * 32 + 8 * fq;
        const __amdgpu_buffer_rsrc_t orr = wt_rsrc(base);
        f32x4 bv[2][2];
#pragma unroll
        for (int bj = 0; bj < 2; ++bj)
#pragma unroll
            for (int n = 0; n < 2; ++n) bv[bj][n] = bias ? *(const f32x4*)(bias + bcol0 + bj * HALF + 4 * n) : (f32x4){0.f, 0.f, 0.f, 0.f};
#pragma unroll
        for (int ai = 0; ai < 2; ++ai)
#pragma unroll
            for (int m = 0; m < 4; ++m) { const size_t rowo = ((size_t)(row0 + ai * HALF + m * 16) * ldc + col0) * 2;
#pragma unroll
                for (int bj = 0; bj < 2; ++bj) { f32x4 v0 = acc[ai][bj][m][0] + bv[bj][0], v1 = acc[ai][bj][m][1] + bv[bj][1];
                    if (ACT == 1) { f32x2 a = gelu_pk((f32x2){v0[0], v0[1]}), b = gelu_pk((f32x2){v0[2], v0[3]}), c = gelu_pk((f32x2){v1[0], v1[1]}), d = gelu_pk((f32x2){v1[2], v1[3]});
                        v0 = (f32x4){a.x, a.y, b.x, b.y}; v1 = (f32x4){c.x, c.y, d.x, d.y}; }
                    v0 = v0 * sc; v1 = v1 * sc; u32x4 w; w.x = cvt_pk_bf16(v0[0], v0[1]); w.y = cvt_pk_bf16(v0[2], v0[3]); w.z = cvt_pk_bf16(v1[0], v1[1]); w.w = cvt_pk_bf16(v1[2], v1[3]);
                    wt_store16(orr, base, rowo + bj * HALF * 2, w); } }
    }
};
template <class Epi, class Sched, bool ALIGN_EPI = false, bool SP2 = false>
__device__ __forceinline__ void gemm_phase(PG8_LAS unsigned char* lds, const Gemm g, const Sched& S, const Epi& E, const int tid_in) {
    const int tid = tid_in, wid = __builtin_amdgcn_readfirstlane(tid >> 6), lane = tid & 63, wr = wid >> 2, wc = wid & 3, fr = lane & 15, fq = lane >> 4;
    const int K = g.K, nt = (g.Kloop > 0 ? g.Kloop : K) / BK;
    unsigned voffA[2], voffB[2];
#pragma unroll
    for (int i = 0; i < 2; ++i) { int R, C; stage_rc(tid * 16 + i * 8192, R, C); const int Rb = Epi::PERM ? ((R & ~31) + perm32(R & 31)) : R;
        voffA[i] = (unsigned)(R * K + C) * 2u; voffB[i] = (unsigned)(Rb * K + C) * 2u; }
    const size_t kstep = (size_t)(BK * 2);
    const size_t hstep = (size_t)HALF * K * 2;
    const size_t tstep = 2 * hstep;
    const unsigned ldsw = (unsigned)wid * 1024u;
    const int aoff = lds_byte(wr * 64 + fr, fq * 8), boff = lds_byte(wc * 32 + fr, fq * 8);
#define PG8_SA(b, h) (((b) * 2 + (h)) * HTB)
#define PG8_SB(b, h) ((4 + (b) * 2 + (h)) * HTB)
#define PG8_STAGE(bufoff, gbase, voff) do { _Pragma("unroll") for (int _i = 0; _i < 2; ++_i) \
        __builtin_amdgcn_global_load_lds((const unsigned*)((const char*)(gbase) + (voff)[_i]), (PG8_LAS unsigned*)(lds + (bufoff) + ldsw + _i * 8192), 16, 0, 0); } while (0)
#define PG8_LDA(dst, b, h) do { _Pragma("unroll") for (int m = 0; m < 4; ++m) _Pragma("unroll") for (int k = 0; k < 2; ++k) dst[m][k] = *(const PG8_LAS bf16x8*)(lds + PG8_SA(b, h) + aoff + m * 2048 + k * 1024); } while (0)
#define PG8_LDB(dst, b, h) do { _Pragma("unroll") for (int n = 0; n < 2; ++n) _Pragma("unroll") for (int k = 0; k < 2; ++k) dst[n][k] = *(const PG8_LAS bf16x8*)(lds + PG8_SB(b, h) + boff + n * 2048 + k * 1024); } while (0)
#define PG8_MMA(ai, bj, At, Bt) do { __builtin_amdgcn_s_setprio(1); _Pragma("unroll") for (int m = 0; m < 4; ++m) _Pragma("unroll") for (int n = 0; n < 2; ++n) _Pragma("unroll") for (int k = 0; k < 2; ++k) \
        acc[ai][bj][m][n] = __builtin_amdgcn_mfma_f32_16x16x32_bf16(Bt[n][k], At[m][k], acc[ai][bj][m][n], 0, 0, 0); __builtin_amdgcn_s_setprio(0); } while (0)
#define PG8_WAIT_V(n) asm volatile("s_waitcnt vmcnt(" #n ")" ::: "memory")
#define PG8_WAIT_L(n) asm volatile("s_waitcnt lgkmcnt(" #n ")" ::: "memory")
#define PG8_BAR __builtin_amdgcn_s_barrier()
#define PG8_SCHED __builtin_amdgcn_sched_barrier(0)
    Unit cur, nxt; int ui = 0;
    if (!S.next(0, cur)) return;
    f32x4 acc[2][2][4][2];
#pragma unroll
    for (int a = 0; a < 2; ++a)
#pragma unroll
        for (int b = 0; b < 2; ++b)
#pragma unroll
            for (int m = 0; m < 4; ++m)
#pragma unroll
                for (int n = 0; n < 2; ++n) acc[a][b][m][n] = (f32x4){0.f, 0.f, 0.f, 0.f};
    bf16x8 At[4][2], B0[2][2], B1[2][2];
    const char* cA = (const char*)g.A + (size_t)cur.pm * tstep + 2 * S.koff(cur); const char* cB = (const char*)g.Bt + (size_t)cur.pn * tstep + 2 * S.koff(cur);
    S.a_ready(cur);
    if constexpr (Epi::PRE) E.pre(cur, 0, wid, lane);
    if constexpr (SP2) {
        PG8_STAGE(PG8_SB(0, 0), cB, voffB); PG8_STAGE(PG8_SB(0, 1), cB + hstep, voffB); PG8_STAGE(PG8_SA(0, 0), cA, voffA); PG8_STAGE(PG8_SA(0, 1), cA + hstep, voffA);
        if (wr == 1) PG8_BAR;
        PG8_WAIT_V(2); PG8_BAR;
        PG8_STAGE(PG8_SB(1, 0), cB + kstep, voffB); PG8_STAGE(PG8_SA(1, 0), cA + kstep, voffA); PG8_STAGE(PG8_SB(1, 1), cB + hstep + kstep, voffB);
        PG8_WAIT_V(6); PG8_BAR;
    } else {
        PG8_STAGE(PG8_SB(0, 0), cB, voffB); PG8_STAGE(PG8_SA(0, 0), cA, voffA); PG8_STAGE(PG8_SB(0, 1), cB + hstep, voffB); PG8_STAGE(PG8_SA(0, 1), cA + hstep, voffA);
        if (wr == 1) PG8_BAR;
        PG8_WAIT_V(4); PG8_BAR;
        PG8_STAGE(PG8_SB(1, 0), cB + kstep, voffB); PG8_STAGE(PG8_SA(1, 0), cA + kstep, voffA); PG8_STAGE(PG8_SB(1, 1), cB + hstep + kstep, voffB);
        PG8_WAIT_V(6); PG8_BAR;
    }
    for (;;) {
        const bool has_next = S.next(ui + 1, nxt);
        const char* nA = has_next ? (const char*)g.A + (size_t)nxt.pm * tstep + 2 * S.koff(nxt) : cA; const char* nB = has_next ? (const char*)g.Bt + (size_t)nxt.pn * tstep + 2 * S.koff(nxt) : cB;
        for (int t = 0; t < nt; t += 2) {
            const bool last = (t == nt - 2);
            const char* a1 = cA + (size_t)(t + 1) * kstep;
            const char* a2 = last ? nA : cA + (size_t)(t + 2) * kstep; const char* b2 = last ? nB : cB + (size_t)(t + 2) * kstep;
            const char* a3 = a2 + kstep; const char* b3 = b2 + kstep;
            if (last && has_next) S.a_ready(nxt);
            if constexpr (Epi::PRE) { if (last && has_next) E.pre(nxt, (ui + 1) & 1, wid, lane); }
            if constexpr (SP2) {
            PG8_LDB(B0, 0, 0); PG8_LDB(B1, 0, 1); PG8_SCHED; PG8_LDA(At, 0, 0); PG8_STAGE(PG8_SA(1, 1), a1 + hstep, voffA);
            PG8_WAIT_V(8); PG8_WAIT_L(0); PG8_BAR; PG8_MMA(0, 0, At, B0); PG8_MMA(0, 1, At, B1); PG8_BAR; PG8_SCHED;
            PG8_LDA(At, 0, 1); PG8_STAGE(PG8_SB(0, 0), b2, voffB); PG8_STAGE(PG8_SB(0, 1), b2 + hstep, voffB); PG8_STAGE(PG8_SA(0, 0), a2, voffA);
            PG8_WAIT_V(8); PG8_WAIT_L(0); PG8_BAR; PG8_MMA(1, 0, At, B0); PG8_MMA(1, 1, At, B1); PG8_BAR; PG8_SCHED;
            PG8_LDB(B0, 1, 0); PG8_LDB(B1, 1, 1); PG8_SCHED; PG8_LDA(At, 1, 0); PG8_STAGE(PG8_SA(0, 1), a2 + hstep, voffA);
            PG8_WAIT_V(8); PG8_WAIT_L(0); PG8_BAR; PG8_MMA(0, 0, At, B0); PG8_MMA(0, 1, At, B1); PG8_BAR; PG8_SCHED;
            PG8_LDA(At, 1, 1); PG8_STAGE(PG8_SB(1, 0), b3, voffB); PG8_STAGE(PG8_SB(1, 1), b3 + hstep, voffB); PG8_STAGE(PG8_SA(1, 0), a3, voffA);
            PG8_WAIT_V(8); PG8_WAIT_L(0); PG8_BAR; PG8_MMA(1, 0, At, B0); PG8_MMA(1, 1, At, B1); PG8_BAR; PG8_SCHED;
            } else {
            PG8_LDB(B0, 0, 0); PG8_SCHED; PG8_LDA(At, 0, 0); PG8_STAGE(PG8_SA(1, 1), a1 + hstep, voffA);
            PG8_WAIT_L(8); PG8_BAR; PG8_WAIT_L(0); PG8_MMA(0, 0, At, B0); PG8_BAR; PG8_SCHED;
            PG8_LDB(B1, 0, 1); PG8_STAGE(PG8_SB(0, 0), b2, voffB);
            PG8_BAR; PG8_WAIT_L(0); PG8_MMA(0, 1, At, B1); PG8_BAR;
            PG8_LDA(At, 0, 1); PG8_STAGE(PG8_SA(0, 0), a2, voffA);
            PG8_BAR; PG8_WAIT_L(0); PG8_MMA(1, 0, At, B0); PG8_BAR; PG8_SCHED;
            PG8_STAGE(PG8_SB(0, 1), b2 + hstep, voffB);
            PG8_WAIT_V(6); PG8_BAR; PG8_MMA(1, 1, At, B1); PG8_BAR;
            PG8_LDB(B0, 1, 0); PG8_SCHED; PG8_LDA(At, 1, 0); PG8_STAGE(PG8_SA(0, 1), a2 + hstep, voffA);
            PG8_WAIT_L(8); PG8_BAR; PG8_WAIT_L(0); PG8_MMA(0, 0, At, B0); PG8_BAR; PG8_SCHED;
            PG8_LDB(B1, 1, 1); PG8_STAGE(PG8_SB(1, 0), b3, voffB);
            PG8_BAR; PG8_WAIT_L(0); PG8_MMA(0, 1, At, B1); PG8_BAR;
            PG8_LDA(At, 1, 1); PG8_STAGE(PG8_SA(1, 0), a3, voffA);
            PG8_BAR; PG8_WAIT_L(0); PG8_MMA(1, 0, At, B0); PG8_BAR; PG8_SCHED;
            PG8_STAGE(PG8_SB(1, 1), b3 + hstep, voffB);
            PG8_WAIT_V(6); PG8_BAR; PG8_MMA(1, 1, At, B1); PG8_BAR;
            }
        }
        if constexpr (ALIGN_EPI) { if (wr == 0) PG8_BAR; }
        if constexpr (!Epi::AFTER_DRAIN) { if constexpr (Epi::PRE) E(acc, cur, wr, wc, fr, fq, ui & 1); else E(acc, cur, wr, wc, fr, fq); S.done(cur); }
        if (!has_next) break;
#pragma unroll
        for (int a = 0; a < 2; ++a)
#pragma unroll
            for (int b = 0; b < 2; ++b)
#pragma unroll
                for (int m = 0; m < 4; ++m)
#pragma unroll
                    for (int n = 0; n < 2; ++n) acc[a][b][m][n] = (f32x4){0.f, 0.f, 0.f, 0.f};
        cur = nxt; cA = nA; cB = nB; ++ui;
        if constexpr (ALIGN_EPI) { if (wr == 1) PG8_BAR; }
    }
    PG8_WAIT_V(0);
    if constexpr (!ALIGN_EPI) { if (wr == 0) PG8_BAR; }
    PG8_BAR;
    if constexpr (Epi::AFTER_DRAIN) { E.fused(acc, cur, wr, wc, fr, fq, lds, wid, lane); S.done(cur); }
#undef PG8_SA
#undef PG8_SB
#undef PG8_STAGE
#undef PG8_LDA
#undef PG8_LDB
#undef PG8_MMA
#undef PG8_WAIT_V
#undef PG8_WAIT_L
#undef PG8_BAR
#undef PG8_SCHED
}
}

#ifndef MK_SINGLE
#define MK_SINGLE 1
#endif
constexpr int BATCH = 32, SEQ = 2048, DM = 1024, M = BATCH * SEQ;
constexpr int NIN = 3336, NPROJ = 3328;
constexpr int DFF = 2816, NUP = 2 * DFF;
constexpr int C_Q = 1792, C_K = 2048, C_V = 2304, C_O = 2816;
constexpr int NLORA = 1536, KLORA = 256;
constexpr int MH = M / 2;
constexpr float NORM_EPS = 1e-6f, LNX_EPS = 64e-5f;

constexpr size_t MiB = 1u << 20;
#ifdef PROBE
constexpr size_t WS_CTL = 0, CTL_ZERO_BYTES = 1 * MiB;
#else
constexpr size_t WS_CTL = 0, CTL_ZERO_BYTES = 32 * 1024;
#endif
constexpr size_t WS_WT_IN = 2 * MiB, WS_WT_OUT = 9 * MiB, WS_WT_UP = 11 * MiB, WS_WT_DN = 22 * MiB, WS_WT_LORA = 28 * MiB;
constexpr size_t WS_RS2 = 29 * MiB, WS_RINV = 29 * MiB + 512 * 1024, WS_SSQP = 30 * MiB, WS_GATES = 34 * MiB;
constexpr size_t WS_XN = 40 * MiB;
constexpr size_t WS_PROJ = 168 * MiB;
constexpr size_t WS_LBUF = 584 * MiB;
constexpr size_t WS_DAG = 616 * MiB;
constexpr size_t WS_MIX = 808 * MiB;
constexpr size_t WS_SIDE = 168 * MiB;
constexpr int SIDE_ELEMS = 256 * 22 * 2 * 128;
constexpr size_t WS_FF = 192 * MiB;
constexpr size_t WS_GB = 520 * MiB;
constexpr size_t WS_END = 936 * MiB;

constexpr int LDS_BYTES = 163840;
constexpr int MISC_OFF = LDS_BYTES - 256;

#define GAS __attribute__((address_space(1)))
#define LAS __attribute__((address_space(3)))
typedef unsigned short bf16;
typedef unsigned v4u __attribute__((ext_vector_type(4)));
typedef unsigned v2u __attribute__((ext_vector_type(2)));
typedef float f32x4 __attribute__((ext_vector_type(4)));
typedef float f32x2 __attribute__((ext_vector_type(2)));
typedef short bf16x8 __attribute__((ext_vector_type(8)));
typedef GAS unsigned gu32;

typedef __bf16 bf16x2_t __attribute__((ext_vector_type(2)));
__device__ __forceinline__ unsigned pk2(float lo, float hi) { const f32x2 v = {lo, hi}; const bf16x2_t b = __builtin_convertvector(v, bf16x2_t); return __builtin_bit_cast(unsigned, b); }
__device__ __forceinline__ unsigned f2bf(float f) { return pk2(f, f) & 0xffffu; }
__device__ __forceinline__ float bf2f(unsigned short u) { return __builtin_bit_cast(float, (unsigned)u << 16); }
__device__ __forceinline__ float bflo(unsigned w) { return __builtin_bit_cast(float, w << 16); }
__device__ __forceinline__ float bfhi(unsigned w) { return __builtin_bit_cast(float, w & 0xffff0000u); }
__device__ __forceinline__ void unpack8(const v4u w, float (&o)[8]) { o[0] = bflo(w.x); o[1] = bfhi(w.x); o[2] = bflo(w.y); o[3] = bfhi(w.y); o[4] = bflo(w.z); o[5] = bfhi(w.z); o[6] = bflo(w.w); o[7] = bfhi(w.w); }
__device__ __forceinline__ v4u pack8(const float (&o)[8]) { v4u w; w.x = pk2(o[0], o[1]); w.y = pk2(o[2], o[3]); w.z = pk2(o[4], o[5]); w.w = pk2(o[6], o[7]); return w; }
__device__ __forceinline__ float frcp(float x) { return __builtin_amdgcn_rcpf(x); }
__device__ __forceinline__ float frsq(float x) { return __builtin_amdgcn_rsqf(x); }
__device__ __forceinline__ float fsqrt_(float x) { return __builtin_amdgcn_sqrtf(x); }
__device__ __forceinline__ float fexp(float x) { return __builtin_amdgcn_exp2f(x * 1.4426950408889634f); }
__device__ __forceinline__ float sigmoidf_(float x) { return frcp(1.0f + __builtin_amdgcn_exp2f(x * -1.4426950408889634f)); }
__device__ __forceinline__ float tanhf_(float x) { return 1.0f - 2.0f * frcp(__builtin_amdgcn_exp2f(x * 2.8853900817779268f) + 1.0f); }
__device__ __forceinline__ float softplusf_(float x) { return fmaxf(x, 0.f) + __logf(1.0f + fexp(-fabsf(x))); }
__device__ __forceinline__ float wave_sum(float v) {
#pragma unroll
    for (int o = 1; o < 64; o <<= 1) v += __shfl_xor(v, o);
    return v;
}
template <int CTRL> __device__ __forceinline__ float dppmov(float v) { return __builtin_bit_cast(float, __builtin_amdgcn_update_dpp(0, __builtin_bit_cast(int, v), CTRL, 0xF, 0xF, true)); }
__device__ __forceinline__ float red8(float v) { v += dppmov<0xB1>(v); v += dppmov<0x4E>(v); v += dppmov<0x141>(v); return v; }
__device__ __forceinline__ float red16(float v) { v += dppmov<0xB1>(v); v += dppmov<0x4E>(v); v += dppmov<0x141>(v); v += dppmov<0x140>(v); return v; }

template <int CTRL, int RMASK> __device__ __forceinline__ float dppsh(float idv, float v) { return __builtin_bit_cast(float, __builtin_amdgcn_update_dpp(__builtin_bit_cast(int, idv), __builtin_bit_cast(int, v), CTRL, RMASK, 0xF, false)); }
template <int CTRL> __device__ __forceinline__ v4u dpp4(const v4u old, const v4u v) { v4u r;
    r.x = (unsigned)__builtin_amdgcn_update_dpp((int)old.x, (int)v.x, CTRL, 0xF, 0xF, false); r.y = (unsigned)__builtin_amdgcn_update_dpp((int)old.y, (int)v.y, CTRL, 0xF, 0xF, false);
    r.z = (unsigned)__builtin_amdgcn_update_dpp((int)old.z, (int)v.z, CTRL, 0xF, 0xF, false); r.w = (unsigned)__builtin_amdgcn_update_dpp((int)old.w, (int)v.w, CTRL, 0xF, 0xF, false); return r; }
__device__ __forceinline__ float wave_scan_add(float v) {
    v += dppsh<0x111, 0xF>(0.f, v); v += dppsh<0x112, 0xF>(0.f, v); v += dppsh<0x114, 0xF>(0.f, v); v += dppsh<0x118, 0xF>(0.f, v);
    v += dppsh<0x142, 0xA>(0.f, v); v += dppsh<0x143, 0xC>(0.f, v); return v;
}
__device__ __forceinline__ float wave_scan_add_rl(float v, float m1, float m2, float m3) {
    v += dppsh<0x111, 0xF>(0.f, v); v += dppsh<0x112, 0xF>(0.f, v); v += dppsh<0x114, 0xF>(0.f, v); v += dppsh<0x118, 0xF>(0.f, v);
    const float t0 = __builtin_bit_cast(float, __builtin_amdgcn_readlane(__builtin_bit_cast(int, v), 15)), t1 = __builtin_bit_cast(float, __builtin_amdgcn_readlane(__builtin_bit_cast(int, v), 31)),
                t2 = __builtin_bit_cast(float, __builtin_amdgcn_readlane(__builtin_bit_cast(int, v), 47));
    return v + (m1 * t0 + (m2 * t1 + m3 * t2));
}
__device__ __forceinline__ float wave_scan_max(float v) {
    const float ni = -3.0e38f;
    v = fmaxf(v, dppsh<0x111, 0xF>(ni, v)); v = fmaxf(v, dppsh<0x112, 0xF>(ni, v)); v = fmaxf(v, dppsh<0x114, 0xF>(ni, v)); v = fmaxf(v, dppsh<0x118, 0xF>(ni, v));
    v = fmaxf(v, dppsh<0x142, 0xA>(ni, v)); v = fmaxf(v, dppsh<0x143, 0xC>(ni, v)); return v;
}

#define XB_TMO      128
#define XB_XCNT(j)  (256  + 64 * (j))
#define XB_XSUB(j)  (1280 + 64 * (j))
#define XB_XGEN(j)  (2304 + 64 * (j))
#define XB_TOP      3328
#define XB_TOPGEN   3392
#define XCD_BAR_WORDS 3456
#define XB_SPIN_CAP (1u << 22)
__device__ __forceinline__ void mk_sync() { __builtin_amdgcn_fence(__ATOMIC_RELEASE, "workgroup"); __builtin_amdgcn_s_barrier(); __builtin_amdgcn_fence(__ATOMIC_ACQUIRE, "workgroup"); }
__device__ __forceinline__ unsigned xb_ld(unsigned* p)              { return __hip_atomic_load(p, __ATOMIC_RELAXED, __HIP_MEMORY_SCOPE_AGENT); }
__device__ __forceinline__ unsigned xb_add(unsigned* p, unsigned v) { return __hip_atomic_fetch_add(p, v, __ATOMIC_RELAXED, __HIP_MEMORY_SCOPE_AGENT); }
__device__ __forceinline__ unsigned xb_xcc_id() { return (unsigned)__builtin_amdgcn_s_getreg((3 << 11) | 20) & 0xFu; }
#define XB_SPIN(cond, bar) do { unsigned _sp = 0; while (cond) { __builtin_amdgcn_s_sleep(1); \
    if ((++_sp & 255u) == 0u) { if (xb_ld(&(bar)[XB_TMO])) break; if (_sp > XB_SPIN_CAP) { atomicAdd(&(bar)[XB_TMO], 1u); break; } } } } while (0)
struct XcdBarrier { unsigned* bar; unsigned x; volatile LAS unsigned* st; };
__device__ __forceinline__ XcdBarrier xcd_barrier_post(unsigned* bar, volatile LAS unsigned* st, bool leader) {
    XcdBarrier b; b.bar = bar; b.x = xb_xcc_id(); b.st = st;
    if (leader) (void)xb_add(&bar[XB_XCNT(b.x)], 1u);
    return b;
}
__device__ __forceinline__ void xcd_barrier_complete(unsigned* bar, unsigned x, unsigned& nloc, unsigned& nx) {
    const unsigned G = gridDim.x * gridDim.y * gridDim.z;
    unsigned sum, cnt, mine, sp = 0u;
    for (;;) {
        sum = 0u; cnt = 0u; mine = 0u;
#pragma unroll
        for (unsigned j = 0; j < 16; ++j) { const unsigned c = xb_ld(&bar[XB_XCNT(j)]); sum += c; cnt += (c > 0u) ? 1u : 0u; mine = (j == x) ? c : mine; }
        if (sum == G) break;
        __builtin_amdgcn_s_sleep(1);
        if ((++sp & 255u) == 0u) { if (xb_ld(&bar[XB_TMO])) break; if (sp > XB_SPIN_CAP) { atomicAdd(&bar[XB_TMO], 1u); break; } }
    }
    nloc = mine > 0u ? mine : 1u; nx = cnt > 0u ? cnt : 1u;
}
__device__ __forceinline__ void xcd_barrier(const XcdBarrier& b, bool leader) {
    asm volatile("s_waitcnt vmcnt(0)" ::: "memory");
    mk_sync();
    if (leader) {
        unsigned* bar = b.bar;
        __builtin_amdgcn_s_waitcnt(0);
        unsigned nloc = b.st[0], nx = b.st[1];
        if (nloc == 0u) { xcd_barrier_complete(bar, b.x, nloc, nx); b.st[0] = nloc; b.st[1] = nx; }
        const unsigned old = xb_add(&bar[XB_XSUB(b.x)], 1u);
        const unsigned gen = old / nloc;
        if (old + 1u == (gen + 1u) * nloc) {
            __builtin_amdgcn_fence(__ATOMIC_RELEASE, "agent");
            asm volatile("s_waitcnt vmcnt(0)" ::: "memory");
            const unsigned og = xb_add(&bar[XB_TOP], 1u);
            const unsigned tg = og / nx;
            if (og + 1u == (tg + 1u) * nx) xb_add(&bar[XB_TOPGEN], 1u);
            else XB_SPIN(xb_ld(&bar[XB_TOPGEN]) == tg, bar);
            __builtin_amdgcn_fence(__ATOMIC_ACQUIRE, "agent");
            asm volatile("s_waitcnt vmcnt(0)" ::: "memory");
        } else {
            XB_SPIN(xb_ld(&bar[XB_TOPGEN]) == gen, bar);
            __builtin_amdgcn_fence(__ATOMIC_ACQUIRE, "agent");
            asm volatile("s_waitcnt vmcnt(0)" ::: "memory");
        }
    }
    mk_sync();
}

__device__ __forceinline__ int opaque_i(int v) { asm volatile("" : "+s"(v)); return v; }
#define LDS_BARRIER() do { asm volatile("s_waitcnt lgkmcnt(0)" ::: "memory"); __builtin_amdgcn_s_barrier(); asm volatile("" ::: "memory"); } while (0)
__device__ __forceinline__ int mk_lane_id() { int x; asm volatile("v_mbcnt_lo_u32_b32 %0, -1, 0\n\tv_mbcnt_hi_u32_b32 %0, -1, %0" : "=v"(x)); return x; }
struct Args { const float* in[26]; float* out; unsigned char* ws; int ph_lo, ph_hi; };

namespace pg8 {
struct PairPanelOrder {
    int c;
    __device__ bool next(int i, Unit& u) const { if (i >= 12) return false; u.pm = 2 * c + i / 6; u.pn = i % 6; return true; }
    __device__ __forceinline__ void a_ready(const Unit&) const {}
    __device__ __forceinline__ void done(const Unit&) const {}
    __device__ __forceinline__ int koff(const Unit& u) const { return u.pn >= 4 ? 128 : 0; }
};
struct PanelOrder {
    int c;
    __device__ bool next(int i, Unit& u) const { if (i >= 4) return false; u.pm = c; u.pn = i; return true; }
    __device__ __forceinline__ void a_ready(const Unit&) const {}
    __device__ __forceinline__ void done(const Unit&) const {}
    __device__ __forceinline__ int koff(const Unit&) const { return 0; }
};
struct EpiResid {
    static constexpr bool PERM = true, AFTER_DRAIN = false, PRE = false;
    bf16_t* XB; const float* rinv; float* ssqp;
    __device__ __forceinline__ void operator()(const f32x4 (&acc)[2][2][4][2], const Unit& u, int wr, int wc, int fr, int fq) const {
        const int row0 = u.pm * BM + wr * 64 + fr, col0 = u.pn * BM + wc * 32 + 8 * fq;
        const __amdgpu_buffer_rsrc_t xrr = wt_rsrc(XB);
#pragma unroll
        for (int ai = 0; ai < 2; ++ai) {
            u32x4 xin[4][2]; float ri[4];
#pragma unroll
            for (int m = 0; m < 4; ++m) { const int row = row0 + ai * HALF + m * 16; ri[m] = rinv[row];
#pragma unroll
                for (int bj = 0; bj < 2; ++bj) xin[m][bj] = *(const u32x4*)(XB + (size_t)row * DM + col0 + bj * HALF); }
            asm volatile("" ::: "memory");
#pragma unroll
            for (int m = 0; m < 4; ++m) { const int row = row0 + ai * HALF + m * 16; float ss = 0.f;
#pragma unroll
                for (int bj = 0; bj < 2; ++bj) { const size_t off = (size_t)row * DM + col0 + bj * HALF;
                    float xv[8]; unpack8(xin[m][bj], xv);
                    float v[8];
#pragma unroll
                    for (int j = 0; j < 4; ++j) { v[j] = acc[ai][bj][m][0][j] + xv[j] * ri[m]; v[4 + j] = acc[ai][bj][m][1][j] + xv[4 + j] * ri[m]; }
#pragma unroll
                    for (int j = 0; j < 8; ++j) ss += v[j] * v[j];
                    wt_store16(xrr, XB, off * 2, pack8(v)); }
                ss += __shfl_xor(ss, 16); ss += __shfl_xor(ss, 32);
                if (fq == 0) ssqp[(size_t)row * 16 + u.pn * 4 + wc] = ss; }
            asm volatile("" ::: "memory");
        }
    }
};
struct EpiScale {
    static constexpr bool PERM = true, AFTER_DRAIN = false, PRE = false;
    bf16_t* O; int ldc; const float* rs; int row_off;
    __device__ __forceinline__ void operator()(const f32x4 (&acc)[2][2][4][2], const Unit& u, int wr, int wc, int fr, int fq) const {
        const int row0 = u.pm * BM + wr * 64 + fr, col0 = u.pn * BM + wc * 32 + 8 * fq;
#pragma unroll
        for (int ai = 0; ai < 2; ++ai)
#pragma unroll
            for (int m = 0; m < 4; ++m) { const int row = row0 + ai * HALF + m * 16; const float s = rs[row_off + row]; bf16_t* rowp = O + (size_t)row * ldc + col0;
#pragma unroll
                for (int bj = 0; bj < 2; ++bj) { const f32x4 v0 = acc[ai][bj][m][0] * s, v1 = acc[ai][bj][m][1] * s;
                    u32x4 w; w.x = pk2(v0[0], v0[1]); w.y = pk2(v0[2], v0[3]); w.z = pk2(v1[0], v1[1]); w.w = pk2(v1[2], v1[3]); *(u32x4*)(rowp + bj * HALF) = w; } }
    }
};
struct EpiFfn {
    static constexpr bool PERM = true, AFTER_DRAIN = false, PRE = true;
    bf16_t* G; const float* rs; const float* cw; const float* cb; float* SA; float* SB; float* SL; LAS float* hal;
    static constexpr int PRE_FLOATS = (8192 - 1024) / 4;
    __device__ __forceinline__ void pre(const Unit& u, int par, int wid, int lane) const {
        LAS unsigned char* slot = (LAS unsigned char*)(hal + PRE_FLOATS + par * 1024);
        if (wid == 0) __builtin_amdgcn_global_load_lds((const unsigned*)(rs + u.pm * BM + lane * 4), (LAS unsigned*)slot, 16, 0, 0);
        else if (wid == 1) { const float* p = cw + (lane >> 5) * DFF + u.pn * 128 + (lane & 31) * 4; __builtin_amdgcn_global_load_lds((const unsigned*)p, (LAS unsigned*)(slot + 1024), 16, 0, 0); }
        else if (wid == 2) { const float* p = ((lane >> 5) ? cb : cw + 2 * DFF) + u.pn * 128 + (lane & 31) * 4; __builtin_amdgcn_global_load_lds((const unsigned*)p, (LAS unsigned*)(slot + 2048), 16, 0, 0); }
    }
    __device__ __forceinline__ void operator()(const f32x4 (&acc)[2][2][4][2], const Unit& u, int wr, int wc, int fr, int fq, int par) const {
        const LAS float* sl = hal + PRE_FLOATS + par * 1024;
        int chl = wc * 32 + 8 * fq; asm volatile("" : "+v"(chl));
        const int f0 = u.pn * 128 + chl, rowt = wr * 64 + fr;
        const __amdgpu_buffer_rsrc_t grr = wt_rsrc(G);
        float rsv[2][4];
#pragma unroll
        for (int ai = 0; ai < 2; ++ai)
#pragma unroll
            for (int m = 0; m < 4; ++m) rsv[ai][m] = sl[ai * HALF + m * 16 + rowt];
        const size_t sbase = ((size_t)(u.pm * 22 + u.pn) * 2) * 128 + chl;
        float w0[8], w1[8], w2[8], bz[8];
        { const LAS float* wl = sl + 256 + chl;
          const f32x4 a0 = *(const LAS f32x4*)(wl), a1 = *(const LAS f32x4*)(wl + 4), b0 = *(const LAS f32x4*)(wl + 128), b1 = *(const LAS f32x4*)(wl + 132);
          const f32x4 c0 = *(const LAS f32x4*)(wl + 256), c1 = *(const LAS f32x4*)(wl + 260), d0 = *(const LAS f32x4*)(wl + 384), d1 = *(const LAS f32x4*)(wl + 388);
#pragma unroll
          for (int j = 0; j < 4; ++j) { w0[j] = a0[j]; w0[4 + j] = a1[j]; w1[j] = b0[j]; w1[4 + j] = b1[j]; w2[j] = c0[j]; w2[4 + j] = c1[j]; bz[j] = d0[j]; bz[4 + j] = d1[j]; } }
        if (fr >= 14) {
#pragma unroll
            for (int ai = 0; ai < 2; ++ai) { const float r_ = rsv[ai][3]; const f32x4 v0 = acc[ai][0][3][0] * r_, v1 = acc[ai][0][3][1] * r_;
                LAS float* hp = hal + ((ai * 2 + wr) * 2 + (fr - 14)) * 128 + chl; *(LAS f32x4*)hp = v0; *(LAS f32x4*)(hp + 4) = v1;
                if (ai == 1 && wr == 1) { float* gp = SL + sbase + (fr - 14) * 128; *(f32x4*)gp = v0; *(f32x4*)(gp + 4) = v1; } }
        }
        if (wr == 0 && fr < 2) { const float r_ = rsv[0][0]; float* ga = SA + sbase + fr * 128; float* gb = SB + sbase + fr * 128;
            *(f32x4*)ga = acc[0][0][0][0] * r_; *(f32x4*)(ga + 4) = acc[0][0][0][1] * r_; *(f32x4*)gb = acc[0][1][0][0] * r_; *(f32x4*)(gb + 4) = acc[0][1][0][1] * r_; }
        asm volatile("s_waitcnt lgkmcnt(0)" ::: "memory"); __builtin_amdgcn_s_barrier(); asm volatile("" ::: "memory");
        const bool fr0 = (fr == 0), frl2 = (fr < 2); (void)fr0;
#pragma unroll
        for (int ai = 0; ai < 2; ++ai) {
            float ap[8];
            const int pb = ai * 2 + wr - 1;
#pragma unroll
            for (int m = 0; m < 4; ++m) {
                float av[8], bv[8], y1[8], y2[8];
                const float r_ = rsv[ai][m];
#pragma unroll
                for (int j = 0; j < 4; ++j) { av[j] = acc[ai][0][m][0][j] * r_; av[4 + j] = acc[ai][0][m][1][j] * r_; bv[j] = acc[ai][1][m][0][j] * r_; bv[4 + j] = acc[ai][1][m][1][j] * r_; }
                if (m == 0) {
                    if (pb >= 0) { const LAS float* h0 = hal + (pb * 2) * 128 + chl; const f32x4 h00 = *(const LAS f32x4*)h0, h01 = *(const LAS f32x4*)(h0 + 4), h10 = *(const LAS f32x4*)(h0 + 128), h11 = *(const LAS f32x4*)(h0 + 132);
#pragma unroll
                        for (int j = 0; j < 4; ++j) { y1[j] = h10[j]; y1[4 + j] = h11[j]; y2[j] = fr0 ? h00[j] : h10[j]; y2[4 + j] = fr0 ? h01[j] : h11[j]; } }
                    else {
#pragma unroll
                        for (int j = 0; j < 8; ++j) { y1[j] = 0.f; y2[j] = 0.f; } }
                } else {
#pragma unroll
                    for (int j = 0; j < 8; ++j) { y1[j] = dppmov<0x121>(ap[j]); y2[j] = dppmov<0x122>(ap[j]); }
                }
                float o[8];
#pragma unroll
                for (int j = 0; j < 8; ++j) { const float am1 = dppsh<0x111, 0xF>(y1[j], av[j]), am2 = dppsh<0x112, 0xF>(y2[j], av[j]);
                    o[j] = bz[j] + w0[j] * am2 + w1[j] * am1 + w2[j] * av[j]; ap[j] = av[j]; }
#pragma unroll
                for (int j = 0; j < 8; j += 2) {
                    const float d0 = 1.0f + __builtin_amdgcn_exp2f(fminf(o[j] * -1.4426950408889634f, 60.0f)), d1 = 1.0f + __builtin_amdgcn_exp2f(fminf(o[j + 1] * -1.4426950408889634f, 60.0f));
                    const float r_ = __builtin_amdgcn_rcpf(d0 * d1);
                    o[j] = o[j] * (r_ * d1) * bv[j]; o[j + 1] = o[j + 1] * (r_ * d0) * bv[j + 1]; }
                if (!(ai == 0 && m == 0 && wr == 0 && frl2)) wt_store16(grr, G, ((size_t)(u.pm * BM + ai * HALF + m * 16 + rowt) * DFF + f0) * 2, pack8(o));
            }
        }
    }
};
}

template <bool FFN_UP = false, bool SCALE = false>
__device__ __forceinline__ void transpose_item(const float* W, int ldw, int K, bf16* WT, const float* kscale, LAS float* scr, int item, int nblk, int lane) {
    const int kb = item / nblk, nb = item % nblk, k0 = 64 * kb, n0 = 32 * nb;
    const int d0 = !FFN_UP ? n0 : (n0 < DFF ? ((n0 >> 7) * 256 + (n0 & 127)) : ((((n0 - DFF) >> 7) * 256) + 128 + ((n0 - DFF) & 127)));
#pragma unroll 8
    for (int i = 0; i < 32; ++i) { const int kk = 2 * i + (lane >> 5); float s = 1.0f; if constexpr (SCALE) s = kscale[k0 + kk]; scr[kk * 33 + (lane & 31)] = W[(size_t)(k0 + kk) * ldw + n0 + (lane & 31)] * s; }
    asm volatile("s_waitcnt lgkmcnt(0)" ::: "memory");
    const int c = lane & 7;
#pragma unroll
    for (int j = 0; j < 4; ++j) { const int n = (lane >> 3) + 8 * j; const LAS float* s = scr + (8 * c) * 33 + n;
        v4u o; o.x = pk2(s[0 * 33], s[1 * 33]); o.y = pk2(s[2 * 33], s[3 * 33]); o.z = pk2(s[4 * 33], s[5 * 33]); o.w = pk2(s[6 * 33], s[7 * 33]);
        *(v4u*)(WT + (size_t)(d0 + n) * K + k0 + 8 * c) = o; }
    asm volatile("s_waitcnt lgkmcnt(0)" ::: "memory");
}

__device__ __forceinline__ float wave_red63(float v) {
    v += dppmov<0xB1>(v); v += dppmov<0x4E>(v); v += dppmov<0x141>(v); v += dppmov<0x140>(v);
    v += dppsh<0x142, 0xA>(0.f, v); v += dppsh<0x143, 0xC>(0.f, v); return v;
}
__device__ __forceinline__ float lane63(float v) { return __builtin_bit_cast(float, __builtin_amdgcn_readlane(__builtin_bit_cast(int, v), 63)); }
__device__ __forceinline__ void late_transposes(const Args& a, LAS unsigned char* lds, int lane, int wave, int gw, int NGW, int lo, int hi) {
    unsigned char* ws = a.ws; LAS float* scr = (LAS float*)(lds + wave * 16384);
    constexpr int I_DN = 44 * 32;
    for (int it = lo + gw; it < hi; it += NGW) {
        if (it < I_DN) transpose_item(a.in[24], DM, DFF, (bf16*)(ws + WS_WT_DN), nullptr, scr, it, 32, lane);
        else if (it < I_DN + 16 * 176) transpose_item<true, true>(a.in[21], NUP, DM, (bf16*)(ws + WS_WT_UP), a.in[20], scr, it - I_DN, 176, lane);
        else transpose_item(a.in[19], DM, DM, (bf16*)(ws + WS_WT_OUT), nullptr, scr, it - I_DN - 16 * 176, 32, lane);
    }
}
constexpr int LATE_ITEMS = 44 * 32 + 16 * 176 + 16 * 32, LATE_MLSTM_SHARE = 0;
__device__ __forceinline__ void phase_prep(const Args& a, LAS unsigned char* lds, int tid, int lane, int wave) {
    unsigned char* ws = a.ws;
    LAS float* scr = (LAS float*)(lds + wave * 16384);
    const int gw = blockIdx.x * 8 + wave, NGW = gridDim.x * 8;
    constexpr int I_IN = 16 * 104;
    constexpr int I_OUT0 = 0;
    for (int it = gw; it < I_IN + I_OUT0; it += NGW) {
        if (it < I_IN) transpose_item<false, true>(a.in[2], NIN, DM, (bf16*)(ws + WS_WT_IN), a.in[1], scr, it, 104, lane);
        else transpose_item(a.in[19], DM, DM, (bf16*)(ws + WS_WT_OUT), nullptr, scr, it - I_IN, 32, lane);
    }
    {
        const float* wd = a.in[5]; const float* wa = a.in[7]; const float* wg = a.in[8]; bf16* WL = (bf16*)(ws + WS_WT_LORA);
        for (int idx = blockIdx.x * 512 + tid; idx < NLORA * KLORA; idx += gridDim.x * 512) {
            const int n = idx >> 8, k = idx & 255; float v = 0.f;
            if (n < 512) { if (k < 64) v = wd[k * 512 + n]; }
            else if (n < 1024) { if (k >= 64 && k < 128) v = wa[(k - 64) * 512 + (n - 512)]; }
            else { if (k >= 128) v = wg[(k - 128) * 512 + (n - 1024)]; }
            WL[idx] = (bf16)f2bf(v);
        }
    }
    {
        const float* x = a.in[0]; const float* g1 = a.in[1]; const float* w_in = a.in[2];
        bf16* XN = (bf16*)(ws + WS_XN); float* gates = (float*)(ws + WS_GATES); float* rinvp = (float*)(ws + WS_RINV);
        float wgt[16][8];
#pragma unroll
        for (int j = 0; j < 4; ++j)
#pragma unroll
            for (int e = 0; e < 4; ++e) { const int k = 4 * lane + 256 * j + e; const float g = g1[k];
                const f32x4 w0 = *(const f32x4*)(w_in + (size_t)k * NIN + 3328), w1 = *(const f32x4*)(w_in + (size_t)k * NIN + 3332);
                wgt[j * 4 + e][0] = w0[0] * g; wgt[j * 4 + e][1] = w0[1] * g; wgt[j * 4 + e][2] = w0[2] * g; wgt[j * 4 + e][3] = w0[3] * g;
                wgt[j * 4 + e][4] = w1[0] * g; wgt[j * 4 + e][5] = w1[1] * g; wgt[j * 4 + e][6] = w1[2] * g; wgt[j * 4 + e][7] = w1[3] * g; }
        f32x4 vn[4];
        { const f32x4* xr = (const f32x4*)(x + (size_t)gw * DM) + lane;
#pragma unroll
          for (int j = 0; j < 4; ++j) vn[j] = xr[64 * j]; }
        for (int row = gw; row < M; row += NGW) {
            f32x4 v[4];
#pragma unroll
            for (int j = 0; j < 4; ++j) v[j] = vn[j];
            { const int rn = (row + NGW < M) ? row + NGW : row; const f32x4* xr = (const f32x4*)(x + (size_t)rn * DM) + lane;
#pragma unroll
              for (int j = 0; j < 4; ++j) vn[j] = xr[64 * j]; }
            float ss = 0.f;
#pragma unroll
            for (int j = 0; j < 4; ++j) ss += (v[j][0] * v[j][0] + v[j][1] * v[j][1]) + (v[j][2] * v[j][2] + v[j][3] * v[j][3]);
            float gs[8];
#pragma unroll
            for (int jg = 0; jg < 8; ++jg) { float s_ = 0.f;
#pragma unroll
                for (int j = 0; j < 4; ++j)
#pragma unroll
                    for (int e = 0; e < 4; ++e) s_ += v[j][e] * wgt[j * 4 + e][jg];
                gs[jg] = s_; }
            ss = wave_red63(ss);
#pragma unroll
            for (int jg = 0; jg < 8; ++jg) gs[jg] = wave_red63(gs[jg]);
            const float ms = lane63(ss) * (1.0f / DM) + NORM_EPS; const float rs = frsq(ms);
            if (lane == 0) rinvp[row] = fsqrt_(ms);
            unsigned long long* o8 = (unsigned long long*)(XN + (size_t)row * DM) + lane;
#pragma unroll
            for (int j = 0; j < 4; ++j) o8[64 * j] = (unsigned long long)pk2(v[j][0] * rs, v[j][1] * rs) | ((unsigned long long)pk2(v[j][2] * rs, v[j][3] * rs) << 32);
            if (lane == 63) { f32x4* gp = (f32x4*)(gates + (size_t)row * 8); gp[0] = (f32x4){gs[0] * rs, gs[1] * rs, gs[2] * rs, gs[3] * rs}; gp[1] = (f32x4){gs[4] * rs, gs[5] * rs, gs[6] * rs, gs[7] * rs}; }
        }
    }
}

__device__ __forceinline__ void phase_lmat(const Args& a, int tid, int row_lo, int nrows) {
    unsigned char* ws = a.ws; const bf16* PROJ = (const bf16*)(ws + WS_PROJ); bf16* L = (bf16*)(ws + WS_LBUF); const float* mu = a.in[3];
    for (int it0 = tid; it0 < nrows * 32; it0 += 8 * 512) {
        v4u cur[8], prv[8];
#pragma unroll
        for (int u = 0; u < 8; ++u) { const int it = it0 + u * 512; const int row = row_lo + (it >> 5), c0 = 1536 + 8 * (it & 31);
            cur[u] = *(const v4u*)(PROJ + (size_t)row * NPROJ + c0);
            prv[u] = (v4u){0u, 0u, 0u, 0u}; if ((row & (SEQ - 1)) != 0) prv[u] = *(const v4u*)(PROJ + (size_t)(row - 1) * NPROJ + c0); }
#pragma unroll
        for (int u = 0; u < 8; ++u) { const int it = it0 + u * 512; const int row = row_lo + (it >> 5), grp = it & 31, c0 = 1536 + 8 * grp;
            const f32x4 m0 = *(const f32x4*)(mu + c0), m1 = *(const f32x4*)(mu + c0 + 4);
            float c[8], p[8], o[8]; unpack8(cur[u], c); unpack8(prv[u], p);
#pragma unroll
            for (int e = 0; e < 8; ++e) { const float mm = e < 4 ? m0[e & 3] : m1[e & 3]; const float xv = c[e] + (p[e] - c[e]) * mm;
                const float sg = frcp(1.0f + __builtin_amdgcn_exp2f(xv * (grp < 8 ? -2.8853900817779268f : -1.4426950408889634f)));
                o[e] = grp < 8 ? (2.0f * sg - 1.0f) : (grp < 16 ? xv : sg); }
            *(v4u*)(L + (size_t)row * KLORA + 8 * grp) = pack8(o); }
    }
}

constexpr int RK_SLOT = 64 * 64;
__device__ __forceinline__ int rk_off(int row, int col) { return row * 64 + ((((col >> 3) ^ row) & 7) << 3) + (col & 7); }
__device__ __forceinline__ f32x4 mfma16(const bf16x8 a, const bf16x8 b, const f32x4 c) { return __builtin_amdgcn_mfma_f32_16x16x32_bf16(a, b, c, 0, 0, 0); }
__device__ __forceinline__ void rk_frag(bf16x8 (&f)[2], const LAS bf16* base, int row0, int l15, int l4) { const LAS bf16* p = base + (row0 + l15) * 64; f[0] = *(const LAS bf16x8*)(p + ((l4 ^ (l15 & 7)) << 3)); f[1] = *(const LAS bf16x8*)(p + (((4 + l4) ^ (l15 & 7)) << 3)); }
struct RkF2 { bf16x8 f[2][2]; };
struct RkLane { int lo, so, l15, l4, to, loT, soT; };
__device__ __forceinline__ int rk_offT(int row, int col) { return row * 64 + ((((col >> 3) ^ ((row & 3) | ((row >> 1) & 4))) & 7) << 3) + (col & 7); }
__device__ __forceinline__ RkLane rk_lane(int lane) { asm volatile("" : "+v"(lane)); const int l15 = lane & 15, l4 = lane >> 4; RkLane r; r.l15 = l15; r.l4 = l4; r.lo = l15 * 64 + ((l4 ^ (l15 & 7)) << 3); r.so = l15 * 64 + ((((l4 >> 1) ^ (l15 & 7))) << 3) + 4 * (l4 & 1);
    r.to = rk_offT(8 * l4 + (l15 >> 2), 4 * (l15 & 3));
    { const int f15 = (l15 & 3) | ((l15 >> 1) & 4); r.loT = l15 * 64 + ((l4 ^ f15) << 3); r.soT = l15 * 64 + ((((l4 >> 1) ^ f15) & 7) << 3) + 4 * (l4 & 1); }
    return r; }
typedef short s16x4_t __attribute__((ext_vector_type(4)));
__device__ __forceinline__ RkF2 rk_ld2_tr(const LAS bf16* base, int blk, const RkLane& L) { RkF2 r;
#pragma unroll
    for (int ti = 0; ti < 2; ++ti)
#pragma unroll
        for (int kh = 0; kh < 2; ++kh) { const LAS bf16* p = base + (L.to ^ ((4 * blk + 2 * ti) << 3)) + 32 * kh * 64;
            const s16x4_t a = __builtin_amdgcn_ds_read_tr16_b64_v4i16((LAS s16x4_t*)p), b = __builtin_amdgcn_ds_read_tr16_b64_v4i16((LAS s16x4_t*)(p + 4 * 64));
            r.f[ti][kh] = (bf16x8){a.x, a.y, a.z, a.w, b.x, b.y, b.z, b.w}; }
    return r; }
__device__ __forceinline__ RkF2 rk_ld2(const LAS bf16* base, int blk, const RkLane& L) { RkF2 r;
#pragma unroll
    for (int ti = 0; ti < 2; ++ti) { const int i0 = (32 * blk + 16 * ti) * 64 + L.lo; r.f[ti][0] = *(const LAS bf16x8*)(base + i0); r.f[ti][1] = *(const LAS bf16x8*)(base + (i0 ^ 32)); }
    return r; }
__device__ __forceinline__ RkF2 rk_ld2T(const LAS bf16* base, int blk, const RkLane& L) { RkF2 r;
#pragma unroll
    for (int ti = 0; ti < 2; ++ti) { const int i0 = (32 * blk + 16 * ti) * 64 + L.loT; r.f[ti][0] = *(const LAS bf16x8*)(base + i0); r.f[ti][1] = *(const LAS bf16x8*)(base + (i0 ^ 32)); }
    return r; }
__device__ __forceinline__ void rk_store2T(LAS bf16* dst, const f32x4 (&acc)[2][2], int mB, int nB, const RkLane& L) {
#pragma unroll
    for (int mi = 0; mi < 2; ++mi)
#pragma unroll
        for (int ni = 0; ni < 2; ++ni) { v2u w; w.x = pk2(acc[mi][ni][0], acc[mi][ni][1]); w.y = pk2(acc[mi][ni][2], acc[mi][ni][3]); *(LAS v2u*)(dst + (16 * (2 * nB + ni)) * 64 + (L.soT ^ (16 * (2 * mB + mi)))) = w; }
}
template <bool ACC> __device__ __forceinline__ void rk_mm2(f32x4 (&acc)[2][2], const RkF2& a, const RkF2& b) {
#pragma unroll
    for (int mi = 0; mi < 2; ++mi)
#pragma unroll
        for (int ni = 0; ni < 2; ++ni) { f32x4 c = ACC ? acc[mi][ni] : (f32x4){0.f, 0.f, 0.f, 0.f}; c = mfma16(a.f[mi][0], b.f[ni][0], c); acc[mi][ni] = mfma16(a.f[mi][1], b.f[ni][1], c); }
}
__device__ __forceinline__ void rk_store2(LAS bf16* dst, const f32x4 (&acc)[2][2], int mB, int nB, const RkLane& L) {
#pragma unroll
    for (int mi = 0; mi < 2; ++mi)
#pragma unroll
        for (int ni = 0; ni < 2; ++ni) { v2u w; w.x = pk2(acc[mi][ni][0], acc[mi][ni][1]); w.y = pk2(acc[mi][ni][2], acc[mi][ni][3]); *(LAS v2u*)(dst + (16 * (2 * nB + ni)) * 64 + (L.so ^ (16 * (2 * mB + mi)))) = w; }
}
template <int MODE> __device__ __forceinline__ void rk_mask2(f32x4 (&d)[2][2], int mB, int nB, int l15, int l4) {
#pragma unroll
    for (int mi = 0; mi < 2; ++mi)
#pragma unroll
        for (int ni = 0; ni < 2; ++ni) { const int mt = 2 * mB + mi, nt = 2 * nB + ni;
            const bool zero = MODE == 1 ? (mt < nt) : (mt > nt);
            if (zero) d[mi][ni] = (f32x4){0.f, 0.f, 0.f, 0.f};
            else if (mt == nt) {
#pragma unroll
                for (int r = 0; r < 4; ++r) { const int m_ = 4 * l4 + r; const bool keep = MODE == 0 ? (m_ < l15) : MODE == 1 ? (l15 < m_) : (m_ <= l15); d[mi][ni][r] = keep ? d[mi][ni][r] : 0.f; } } }
}
template <int DBG = 0> __device__ __forceinline__ void rwkv_unit_split(const Args& a, LAS unsigned char* lds, int unit, int tid, int lane, int wave) {
    unsigned char* ws = a.ws; const bf16* PROJ = (const bf16*)(ws + WS_PROJ); const bf16* DAG = (const bf16*)(ws + WS_DAG); bf16* MIX = (bf16*)(ws + WS_MIX);
    const int b = unit >> 3, h = unit & 7;
    LAS bf16* slot = (LAS bf16*)lds;
#define RK_S(k) (slot + (k) * RK_SLOT)
    LAS bf16* Ab = RK_S(0); LAS bf16* Bb = RK_S(1); LAS bf16* Kb = RK_S(2); LAS bf16* Rb = RK_S(3); LAS bf16* KhT = RK_S(4);
    LAS bf16* P0 = RK_S(7); LAS bf16* P0T = RK_S(8); LAS float* Yl = (LAS float*)RK_S(7);
    LAS bf16* Aak = RK_S(9); LAS bf16* Ut = RK_S(9); LAS bf16* Arb = RK_S(10); LAS bf16* Ark = RK_S(11); LAS bf16* TA = RK_S(12); LAS bf16* TB = RK_S(13); LAS bf16* Xt = RK_S(14); LAS bf16* Sb = RK_S(15);
    LAS float* g63 = (LAS float*)RK_S(18); LAS float* bon = g63 + 128; LAS float* ssP = bon + 128; LAS float* bnP = ssP + 256; LAS float* cst = bnP + 256;
    const int wq = wave & 3;
    { int t_ = tid; asm volatile("" : "+v"(t_));
      if (t_ < 64) { const int j = h * 64 + t_;
        cst[t_] = a.in[3][j]; cst[64 + t_] = a.in[3][512 + j]; cst[128 + t_] = a.in[3][1024 + j]; cst[192 + t_] = a.in[9][j]; cst[256 + t_] = a.in[10][j];
        cst[320 + t_] = a.in[11][j]; cst[384 + t_] = a.in[4][j]; cst[448 + t_] = a.in[6][j]; cst[512 + t_] = a.in[12][j]; cst[576 + t_] = a.in[13][j]; }
      for (int i = t_; i < RK_SLOT / 2; i += 512) ((LAS unsigned*)Sb)[i] = 0u; }
    if (wave < 4) {
        const int jw = 16 * wq;
        v4u g_rc[2], g_kc[2], g_vc[2], g_rp[2], g_kp[2], g_vp[2], g_ld[2], g_a[2];
#define RKS_LOAD(c_, PART) do { int ln_ = lane; asm volatile("" : "+v"(ln_)); const int t_ = b * SEQ + (c_) * 64 + ln_; const bf16* pr_ = PROJ + (size_t)t_ * NPROJ + h * 64 + jw; const bf16* dg_ = DAG + (size_t)t_ * NLORA + h * 64 + jw; \
        _Pragma("unroll") for (int hh = 0; hh < 2; ++hh) { \
            if ((PART) == 0) { g_rc[hh] = *(const v4u*)(pr_ + 8 * hh); g_kc[hh] = *(const v4u*)(pr_ + 512 + 8 * hh); } \
            if ((PART) == 1) { g_vc[hh] = *(const v4u*)(pr_ + 1024 + 8 * hh); g_ld[hh] = *(const v4u*)(dg_ + 8 * hh); } \
            if ((PART) == 2) { g_a[hh] = *(const v4u*)(dg_ + 512 + 8 * hh); \
                if ((c_) == 0 && ln_ == 0) g_rp[hh] = (v4u){0u, 0u, 0u, 0u}; else g_rp[hh] = *(const v4u*)(pr_ - NPROJ + 8 * hh); } \
            if ((PART) == 3) { if ((c_) == 0 && ln_ == 0) { g_kp[hh] = (v4u){0u, 0u, 0u, 0u}; g_vp[hh] = g_kp[hh]; } \
                else { g_kp[hh] = *(const v4u*)(pr_ - NPROJ + 512 + 8 * hh); g_vp[hh] = *(const v4u*)(pr_ - NPROJ + 1024 + 8 * hh); } } } } while (0)
        RKS_LOAD(0, 0); RKS_LOAD(0, 1); RKS_LOAD(0, 2); RKS_LOAD(0, 3);
        LDS_BARRIER();
#ifdef PROBE_SEG_A
        unsigned long long seg_acc = 0, seg_t0 = 0; bool seg_on = false;
#define SEGT(k) do { if ((k) == PROBE_SEG_B && seg_on) { seg_acc += __builtin_amdgcn_s_memrealtime() - seg_t0; seg_on = false; } if ((k) == PROBE_SEG_A) { seg_t0 = __builtin_amdgcn_s_memrealtime(); seg_on = true; } } while (0)
#else
#define SEGT(k) do { } while (0)
#endif
        for (int it = 0; it <= SEQ / 64; ++it) {
            const bool act = DBG != 1 && it < SEQ / 64; const int p = it & 1;
            LAS bf16* BhTp = RK_S(5 + 11 * p); LAS bf16* Vtp = RK_S(6 + 11 * p);
            float rr[2][8], km[2][8], av[2][8], lgw[2][8], kkr[2][8];
            v4u pA[2], pR[2], pB[2], pK[2], pKh[2];
            LDS_BARRIER();
            SEGT(10); SEGT(0);
            if (act) {
                int ln = lane; asm volatile("" : "+v"(ln));
                asm volatile("" : "+v"(g_rc[0]), "+v"(g_rc[1]), "+v"(g_kc[0]), "+v"(g_kc[1]), "+v"(g_vc[0]), "+v"(g_vc[1]), "+v"(g_rp[0]), "+v"(g_rp[1]), "+v"(g_kp[0]), "+v"(g_kp[1]), "+v"(g_vp[0]), "+v"(g_vp[1]), "+v"(g_ld[0]), "+v"(g_ld[1]), "+v"(g_a[0]), "+v"(g_a[1]));
                float ss = 0.f, bonus = 0.f;
#pragma unroll
                for (int hh = 0; hh < 2; ++hh) { float rc[8], kc[8], vc[8], rp_[8], kp[8], vp[8], ldv[8], vo[8];
                    unpack8(g_rc[hh], rc); unpack8(g_kc[hh], kc); unpack8(g_vc[hh], vc); unpack8(g_rp[hh], rp_); unpack8(g_kp[hh], kp); unpack8(g_vp[hh], vp); unpack8(g_ld[hh], ldv); unpack8(g_a[hh], av[hh]);
#pragma unroll
                    for (int e = 0; e < 8; ++e) { const int j = jw + 8 * hh + e;
                        rr[hh][e] = rc[e] + (rp_[e] - rc[e]) * cst[j]; const float k = kc[e] + (kp[e] - kc[e]) * cst[64 + j]; const float v = vc[e] + (vp[e] - vc[e]) * cst[128 + j];
                        kkr[hh][e] = k * cst[192 + j]; ss += kkr[hh][e] * kkr[hh][e];
                        { const float dA = 1.0f + __builtin_amdgcn_exp2f(fminf((cst[448 + j] + av[hh][e]) * -1.4426950408889634f, 60.0f)), dW = 1.0f + __builtin_amdgcn_exp2f(fminf((cst[384 + j] + ldv[e]) * -1.4426950408889634f, 60.0f));
                          const float rAW = frcp(dA * dW);
                          av[hh][e] = rAW * dW; lgw[hh][e] = -0.6065306597f * (rAW * dA); }
                        km[hh][e] = k * (1.0f + (av[hh][e] - 1.0f) * cst[256 + j]);
                        bonus += rr[hh][e] * km[hh][e] * cst[320 + j];
                        vo[e] = v; }
                    *(LAS v4u*)(Vtp + rk_offT(ln, jw + 8 * hh)) = pack8(vo); }
                ssP[ln * 4 + wq] = ss; bnP[ln * 4 + wq] = bonus;
            }
            LDS_BARRIER();
            SEGT(1);
            if (act) {
                int ln = lane; asm volatile("" : "+v"(ln));
                const f32x4 s4 = *(const LAS f32x4*)(ssP + ln * 4), b4 = *(const LAS f32x4*)(bnP + ln * 4);
                const float ss = (s4[0] + s4[1]) + (s4[2] + s4[3]);
                if (wq == 0) bon[64 * p + ln] = (b4[0] + b4[1]) + (b4[2] + b4[3]);
                const float inv = frcp(fmaxf(fsqrt_(ss), 1e-12f));
                const float rm1 = (ln >= 16) ? 1.f : 0.f, rm2 = (ln >= 32) ? 1.f : 0.f, rm3 = (ln >= 48) ? 1.f : 0.f;
#pragma unroll
                for (int hh = 0; hh < 2; ++hh) { float lw[8], oA[8], oB[8], oK[8], oR[8], oBh[8], oKh[8], e63[8];
#pragma unroll
                    for (int e = 0; e < 8; ++e) lw[e] = wave_scan_add_rl(lgw[hh][e], rm1, rm2, rm3);
#pragma unroll
                    for (int e = 0; e < 8; ++e) {
                        const float eP = fexp(lw[e] - lgw[hh][e]), eM = fexp(-lw[e]), eL = fexp(lw[e]); e63[e] = lane63(eL); const float eH = e63[e] * eM;
                        const float kk = kkr[hh][e] * inv, bb = kk * av[hh][e];
                        oA[e] = -kk * eP; oB[e] = bb * eM; oK[e] = km[hh][e] * eM; oR[e] = rr[hh][e] * eL; oBh[e] = bb * eH; oKh[e] = km[hh][e] * eH; }
                    pA[hh] = pack8(oA); pB[hh] = pack8(oB); pK[hh] = pack8(oK); pR[hh] = pack8(oR); pKh[hh] = pack8(oKh);
                    *(LAS v4u*)(BhTp + rk_offT(ln, jw + 8 * hh)) = pack8(oBh);
                    if (ln == 63) { LAS float* gp = g63 + 64 * p + jw + 8 * hh; *(LAS f32x4*)gp = (f32x4){e63[0], e63[1], e63[2], e63[3]}; *(LAS f32x4*)(gp + 4) = (f32x4){e63[4], e63[5], e63[6], e63[7]}; } }
            }
            LDS_BARRIER();
            SEGT(2);
            if (act) {
                if (it + 1 < SEQ / 64) RKS_LOAD(it + 1, 0);
                int ln = lane; asm volatile("" : "+v"(ln));
#pragma unroll
                for (int hh = 0; hh < 2; ++hh) { const int ro = rk_off(ln, jw + 8 * hh); *(LAS v4u*)(Ab + ro) = pA[hh]; *(LAS v4u*)(Rb + ro) = pR[hh];
                    *(LAS v4u*)(KhT + rk_offT(ln, jw + 8 * hh)) = pKh[hh]; }
            }
            LDS_BARRIER(); SEGT(3); if (act && it + 1 < SEQ / 64) RKS_LOAD(it + 1, 1);
            LDS_BARRIER(); SEGT(4); if (act && it + 1 < SEQ / 64) RKS_LOAD(it + 1, 2);
            LDS_BARRIER(); SEGT(5); if (act && it + 1 < SEQ / 64) RKS_LOAD(it + 1, 3);
            LDS_BARRIER(); SEGT(6); LDS_BARRIER(); SEGT(7); LDS_BARRIER(); SEGT(8);
            if (act) {
                int ln = lane; asm volatile("" : "+v"(ln));
#pragma unroll
                for (int hh = 0; hh < 2; ++hh) { const int ro = rk_off(ln, jw + 8 * hh); *(LAS v4u*)(Bb + ro) = pB[hh]; *(LAS v4u*)(Kb + ro) = pK[hh]; }
            }
            LDS_BARRIER();
            SEGT(9);
        }
#ifdef PROBE_SEG_A
        if (DBG == 0 && blockIdx.x == 0 && tid == 0) ((unsigned long long*)(ws + WS_CTL + 512 * 1024))[24] = seg_acc;
#endif
#undef RKS_LOAD
    } else {
        const int mB = wq & 1, nB = wq >> 1;
        const RkLane L = rk_lane(lane);
        const int ltid = tid - 256;
        f32x4 sacc[2][2], tacc[2][2], yacc[2][2];
#pragma unroll
        for (int i = 0; i < 2; ++i)
#pragma unroll
            for (int j = 0; j < 2; ++j) { sacc[i][j] = (f32x4){0.f, 0.f, 0.f, 0.f}; tacc[i][j] = sacc[i][j]; yacc[i][j] = sacc[i][j]; }
        v4u g_g0 = {0u, 0u, 0u, 0u}, g_g1 = g_g0, pend0 = g_g0, pend1 = g_g0; bf16* pend_p = DBG ? (bf16*)(ws + WS_END) : MIX;
#define RKV_LOADG(c_) do { int lt_ = ltid; asm volatile("" : "+v"(lt_)); const bf16* gp_ = DAG + (size_t)(b * SEQ + (c_) * 64 + (lt_ >> 2)) * NLORA + 1024 + h * 64 + 16 * (lt_ & 3); g_g0 = *(const v4u*)gp_; g_g1 = *(const v4u*)(gp_ + 8); } while (0)
        LDS_BARRIER();
        for (int it = 0; it <= SEQ / 64; ++it) {
            const int ch = it - 1; const bool act = DBG != 2 && it >= 1; const int p = ch & 1;
            const LAS bf16* BhTp = RK_S(5 + 11 * p); const LAS bf16* Vtp = RK_S(6 + 11 * p);
            LDS_BARRIER();
            if (act) {

                if (ch > 0) { *(v4u*)pend_p = pend0; *(v4u*)(pend_p + 8) = pend1; }
                RKV_LOADG(ch);
                const RkF2 aB = rk_ld2(Bb, mB, L), bA = rk_ld2(Ab, nB, L);
                {
                    f32x4 d[2][2];
                    rk_mm2<false>(d, aB, bA);
                    rk_mask2<0>(d, mB, nB, L.l15, L.l4);
#pragma unroll
                    for (int mi = 0; mi < 2; ++mi)
#pragma unroll
                        for (int ni = 0; ni < 2; ++ni)
#pragma unroll
                            for (int r = 0; r < 4; ++r) tacc[mi][ni][r] = d[mi][ni][r] + ((2 * mB + mi == 2 * nB + ni && 4 * L.l4 + r == L.l15) ? 1.f : 0.f);
                    rk_store2T(P0, d, mB, nB, L); rk_store2(TA, tacc, mB, nB, L);
                }
                asm volatile("" ::: "memory");
                {
                    const RkF2 aK = rk_ld2(Kb, mB, L), bR = rk_ld2(Rb, nB, L);
                    f32x4 d3[2][2], d4[2][2], d5[2][2];
                    rk_mm2<false>(d3, aK, bA); rk_mm2<false>(d4, aB, bR); rk_mm2<false>(d5, aK, bR);
                    rk_mask2<0>(d3, mB, nB, L.l15, L.l4); rk_mask2<2>(d4, mB, nB, L.l15, L.l4); rk_mask2<2>(d5, mB, nB, L.l15, L.l4);
                    rk_store2(Aak, d3, mB, nB, L); rk_store2(Arb, d4, mB, nB, L); rk_store2(Ark, d5, mB, nB, L);
                }
            }
            LDS_BARRIER();
            if (act) {

                {
                    const RkF2 aPT = rk_ld2_tr(P0, mB, L), bP = rk_ld2T(P0, nB, L);
                    f32x4 d[2][2]; rk_mm2<false>(d, aPT, bP);
                    rk_store2T(Bb  , d, mB, nB, L);
                }
                asm volatile("" ::: "memory");
                const RkF2 bV = rk_ld2_tr(Vtp, nB, L);
                {
                    const RkF2 aA = rk_ld2(Ab, mB, L), aAk = rk_ld2(Aak, mB, L), bS = rk_ld2(Sb, nB, L), aKh = rk_ld2_tr(KhT, mB, L);
                    f32x4 d3[2][2]; rk_mm2<false>(d3, aA, bS); rk_mm2<true>(d3, aAk, bV);
#pragma unroll
                    for (int mi = 0; mi < 2; ++mi)
#pragma unroll
                        for (int r = 0; r < 4; ++r) { const float g_ = g63[64 * p + 16 * (2 * mB + mi) + 4 * L.l4 + r]; sacc[mi][0][r] *= g_; sacc[mi][1][r] *= g_; }
                    rk_mm2<true>(sacc, aKh, bV);
                    rk_store2(Xt, d3, mB, nB, L);
                }
                asm volatile("" ::: "memory");
                {
                    const RkF2 aS = rk_ld2(Sb, mB, L), aV = rk_ld2_tr(Vtp, mB, L), bR = rk_ld2(Rb, nB, L), bArk = rk_ld2(Ark, nB, L);
                    rk_mm2<false>(yacc, aS, bR); rk_mm2<true>(yacc, aV, bArk);
                }
            }
            LDS_BARRIER();
#define RKV_DOUBLE(PK, TIN, TOUT, PN) if (act && DBG != 4) {  const RkF2 aPT = rk_ld2_tr(PK, mB, L); \
              const RkF2 bT = rk_ld2(TIN, nB, L), bP = rk_ld2T(PK, nB, L); \
              f32x4 d[2][2]; rk_mm2<true>(tacc, aPT, bT); rk_mm2<false>(d, aPT, bP); \
              rk_store2(TOUT, tacc, mB, nB, L); rk_store2T(PN, d, mB, nB, L); }
            RKV_DOUBLE(Bb, TA, TB, P0)
            LDS_BARRIER();
            RKV_DOUBLE(P0, TB, TA, Bb)
            LDS_BARRIER();
            RKV_DOUBLE(Bb, TA, TB, P0)
            LDS_BARRIER();
            RKV_DOUBLE(P0, TB, TA, Bb)
            LDS_BARRIER();
            if (act && DBG != 4) {  const RkF2 aPT = rk_ld2_tr(Bb, mB, L); const RkF2 bT = rk_ld2(TA, nB, L); rk_mm2<true>(tacc, aPT, bT); rk_store2(TB, tacc, mB, nB, L); }
            LDS_BARRIER();
            if (act) {  const RkF2 aT = rk_ld2(TB, mB, L); const RkF2 bX = rk_ld2(Xt, nB, L); f32x4 d[2][2]; rk_mm2<false>(d, aT, bX); rk_store2(Ut, d, mB, nB, L); }
            LDS_BARRIER();
            if (act) {

                const RkF2 aU = rk_ld2(Ut, mB, L), aBh = rk_ld2_tr(BhTp, mB, L); const RkF2 bArb = rk_ld2(Arb, nB, L), bU = rk_ld2(Ut, nB, L);
                rk_mm2<true>(yacc, aU, bArb); rk_mm2<true>(sacc, aBh, bU);
#pragma unroll
                for (int mi = 0; mi < 2; ++mi)
#pragma unroll
                    for (int ni = 0; ni < 2; ++ni) *(LAS f32x4*)(Yl + (16 * (2 * nB + ni) + L.l15) * 64 + (((4 * (2 * mB + mi) + L.l4) ^ (L.l15 & 7)) << 2)) = yacc[mi][ni];
                rk_store2(Sb, sacc, mB, nB, L);
            }
            LDS_BARRIER();
            if (act) {
                int lt_ = ltid; asm volatile("" : "+v"(lt_)); const int tt = lt_ >> 2, c4 = lt_ & 3;
                const int t = b * SEQ + ch * 64 + tt, j0 = 16 * c4;
                float y[16], gv[16]; float s1 = 0.f;
#pragma unroll
                for (int k = 0; k < 4; ++k) { const f32x4 yv = *(const LAS f32x4*)(Yl + tt * 64 + (((4 * c4 + k) ^ (tt & 7)) << 2)); y[4 * k] = yv[0]; y[4 * k + 1] = yv[1]; y[4 * k + 2] = yv[2]; y[4 * k + 3] = yv[3]; s1 += (yv[0] + yv[1]) + (yv[2] + yv[3]); }
                s1 += dppmov<0xB1>(s1); s1 += dppmov<0x4E>(s1); const float mean = s1 * (1.0f / 64.0f); float s2 = 0.f;
#pragma unroll
                for (int e = 0; e < 16; ++e) { const float dd = y[e] - mean; s2 += dd * dd; }
                s2 += dppmov<0xB1>(s2); s2 += dppmov<0x4E>(s2); const float rstd = frsq(s2 * (1.0f / 64.0f) + LNX_EPS);
                { float g0[8], g1[8]; unpack8(g_g0, g0); unpack8(g_g1, g1);
#pragma unroll
                  for (int e = 0; e < 8; ++e) { gv[e] = g0[e]; gv[8 + e] = g1[e]; } }
                const float bonus = bon[64 * p + tt]; float ov[16];
                float vv[16]; { float v0[8], v1[8]; unpack8(*(const LAS v4u*)(Vtp + rk_offT(tt, j0)), v0); unpack8(*(const LAS v4u*)(Vtp + rk_offT(tt, j0 + 8)), v1);
#pragma unroll
                  for (int e = 0; e < 8; ++e) { vv[e] = v0[e]; vv[8 + e] = v1[e]; } }
#pragma unroll
                for (int e = 0; e < 16; ++e) { const float yn = (y[e] - mean) * rstd * cst[512 + j0 + e] + cst[576 + j0 + e]; ov[e] = (yn + bonus * vv[e]) * gv[e]; }
                { float o0[8], o1[8];
#pragma unroll
                  for (int e = 0; e < 8; ++e) { o0[e] = ov[e]; o1[e] = ov[8 + e]; }
                  pend0 = pack8(o0); pend1 = pack8(o1); pend_p = DBG ? (bf16*)(ws + WS_END) + ((size_t)blockIdx.x * 256 + lt_) * 16 : MIX + (size_t)t * DM + h * 64 + j0; }
            }
        }
        *(v4u*)pend_p = pend0; *(v4u*)(pend_p + 8) = pend1;
#undef RKV_DOUBLE
#undef RKV_LOADG
    }
    LDS_BARRIER();
#undef RK_S
}

__device__ __forceinline__ int ml_off256(int row, int ch) { return 256 * row + 16 * (ch ^ (((row & 3) << 2) | ((row >> 2) & 3))); }
struct MlTr { int b0, b1; };
__device__ __forceinline__ MlTr ml_tr_lane(int l15, int l4) { MlTr t; const int r0 = 8 * l4 + (l15 >> 2), pp = l15 & 3; t.b0 = ml_off256(r0, pp >> 1) + 8 * (pp & 1); t.b1 = ml_off256(r0 + 4, pp >> 1) + 8 * (pp & 1); return t; }
__device__ __forceinline__ bf16x8 ml_tr_frag(const LAS unsigned char* base, int kk, int T, const MlTr& t) {
    const s16x4_t a = __builtin_amdgcn_ds_read_tr16_b64_v4i16((LAS s16x4_t*)(base + ((t.b0 ^ (32 * T)) + 8192 * kk))), b = __builtin_amdgcn_ds_read_tr16_b64_v4i16((LAS s16x4_t*)(base + ((t.b1 ^ (32 * T)) + 8192 * kk)));
    return (bf16x8){a.x, a.y, a.z, a.w, b.x, b.y, b.z, b.w}; }
template <int DBG = 0> __device__ __forceinline__ void mlstm_unit_split(const Args& a, LAS unsigned char* lds, int unit, int tid, int lane, int wave) {
    unsigned char* ws = a.ws; const bf16* PROJ = (const bf16*)(ws + WS_PROJ); const float* gates = (const float*)(ws + WS_GATES); bf16* MIX = (bf16*)(ws + WS_MIX);
    const int b = unit >> 2, hm = unit & 3;
    constexpr int LD = 72, A64 = 64 * LD, A128 = 128 * LD;
    LAS bf16* Qb = (LAS bf16*)lds;
    LAS bf16* Kb_ = Qb + 2 * A64;
    LAS bf16* Kwb = Kb_ + 2 * A64;
    LAS bf16* Vtb = Kwb + 2 * A64;
    LAS bf16* Sm = Vtb + 2 * A128;
    LAS bf16* Ct = Sm + A64;
    LAS float* Hl = (LAS float*)(Ct + A128);
    LAS float* gar = Hl + 64 * 132;
    LAS float* decp = gar + 512; LAS float* den = decp + 4; LAS float* nvec = den + 64; LAS float* cwl = nvec + 64; LAS float* cbl = cwl + 512; LAS float* mhl = cbl + 128;
    { int t_ = tid; asm volatile("" : "+v"(t_));
      for (int i = t_; i < A128 / 2; i += 512) ((LAS unsigned*)Ct)[i] = 0u;
      if (t_ < 64) nvec[t_] = 0.f;
      if (t_ < 128) mhl[t_] = a.in[18][hm * 128 + t_];
      for (int i = t_; i < 640; i += 512) { const int j = i >> 7, c_ = i & 127; const int src = (c_ < 64) ? (hm * 64 + c_) : (256 + hm * 64 + (c_ - 64)); if (j < 4) cwl[i] = a.in[14][j * 512 + src]; else cbl[c_] = a.in[15][src]; } }
    const int wq = wave & 3;
    if (wave < 4) {
        const float ibias = a.in[16][hm], fbias = a.in[17][hm];
        v4u n_q[2], n_k[2], n_v[4]; float n_gi = 0.f, n_gf = 0.f;
        v4u p_q[2] = {{0u, 0u, 0u, 0u}, {0u, 0u, 0u, 0u}}, p_k[2] = {{0u, 0u, 0u, 0u}, {0u, 0u, 0u, 0u}};
#define MLS_LOAD(c_, PART) do { int ln_ = lane; asm volatile("" : "+v"(ln_)); const int t_ = b * SEQ + (c_) * 64 + ln_; \
        if ((PART) < 2) { const bf16* pr_ = PROJ + (size_t)t_ * NPROJ + hm * 64 + 16 * wq + 8 * (PART); n_q[PART] = *(const v4u*)(pr_ + C_Q); n_k[PART] = *(const v4u*)(pr_ + C_K); } \
        else { const bf16* pv_ = PROJ + (size_t)t_ * NPROJ + C_V + hm * 128 + 32 * wq; _Pragma("unroll") for (int q = 0; q < 4; ++q) n_v[q] = *(const v4u*)(pv_ + 8 * q); \
               n_gi = gates[(size_t)t_ * 8 + hm]; n_gf = gates[(size_t)t_ * 8 + 4 + hm]; } } while (0)
        MLS_LOAD(0, 0); MLS_LOAD(0, 1); MLS_LOAD(0, 2);
        LDS_BARRIER();
        float m_run = 0.f;
#ifdef PROBE_MSEG_A
        unsigned long long mseg_acc = 0, mseg_t0 = 0; bool mseg_on = false;
#define MSEGT(k) do { if ((k) == PROBE_MSEG_B && mseg_on) { mseg_acc += __builtin_amdgcn_s_memrealtime() - mseg_t0; mseg_on = false; } if ((k) == PROBE_MSEG_A) { mseg_t0 = __builtin_amdgcn_s_memrealtime(); mseg_on = true; } } while (0)
#else
#define MSEGT(k) do { } while (0)
#endif
        for (int it = 0; it <= SEQ / 64; ++it) {
            const bool act = DBG != 1 && it < SEQ / 64; const int p = it & 1;
            LAS bf16* Ql = Qb + p * A64; LAS bf16* Kl = Kb_ + p * A64; LAS bf16* Kwt = Kwb + p * A64; LAS bf16* Vt = Vtb + p * A128; LAS float* ga = gar + 256 * p;
            float w = 0.f;
            LDS_BARRIER();
            MSEGT(4); MSEGT(0);
            if (act) {
                asm volatile("" : "+v"(n_q[0]), "+v"(n_k[0]), "+v"(n_gi), "+v"(n_gf));
                int ln = lane; asm volatile("" : "+v"(ln));
                const float gi = n_gi + ibias, gf = n_gf + fbias;
                const float ig = 15.0f * tanhf_(gi * (1.0f / 15.0f)), fx = 15.0f * tanhf_(gf * (1.0f / 15.0f));
                const float logf = -(fmaxf(-fx, 0.f) + __logf(1.0f + fexp(-fabsf(fx))));
                const float bc = wave_scan_add(logf);
                const float e = ig - bc; const float P = wave_scan_max(e);
                const float mx = fmaxf(P, m_run);
                const float mxL = __builtin_bit_cast(float, __builtin_amdgcn_readlane(__builtin_bit_cast(int, mx), 63)), bL = __builtin_bit_cast(float, __builtin_amdgcn_readlane(__builtin_bit_cast(int, bc), 63));
                if (wq == 0) { ga[ln] = e; ga[64 + ln] = mx; ga[128 + ln] = fexp(m_run - mx); ga[192 + ln] = fexp(-(bc + mx)); if (ln == 0) decp[p] = fexp(m_run - mxL); }
                w = fexp(e - mxL); m_run = bL + mxL;
            }
            v4u xq[2][3], xk[2][3];
            if (act) { int ln = lane; asm volatile("" : "+v"(ln)); asm volatile("" : "+v"(n_q[1]), "+v"(n_k[1]));
                LAS unsigned char* xs = (LAS unsigned char*)Hl + wq * (67 * 80);
                if (ln >= 61) { LAS v4u* r_ = (LAS v4u*)(xs + (ln - 61) * 80); r_[0] = p_q[0]; r_[1] = p_q[1]; r_[2] = p_k[0]; r_[3] = p_k[1]; }
                { LAS v4u* r_ = (LAS v4u*)(xs + (3 + ln) * 80); r_[0] = n_q[0]; r_[1] = n_q[1]; r_[2] = n_k[0]; r_[3] = n_k[1]; }
#pragma unroll
                for (int j = 0; j < 3; ++j) { const LAS v4u* r_ = (const LAS v4u*)(xs + (ln + j) * 80); xq[0][j] = r_[0]; xq[1][j] = r_[1]; xk[0][j] = r_[2]; xk[1][j] = r_[3]; }
                p_q[0] = n_q[0]; p_q[1] = n_q[1]; p_k[0] = n_k[0]; p_k[1] = n_k[1]; }
#define MLS_QK(hh) { int ln = lane; asm volatile("" : "+v"(ln)); const int d0 = 16 * wq + 8 * (hh); float aq[8], ak[8]; \
                v4u tq[4], tk[4]; tq[3] = n_q[hh]; tk[3] = n_k[hh]; _Pragma("unroll") for (int j = 0; j < 3; ++j) { tq[j] = xq[hh][j]; tk[j] = xk[hh][j]; } \
                _Pragma("unroll") for (int e_ = 0; e_ < 8; ++e_) { aq[e_] = cbl[d0 + e_]; ak[e_] = cbl[64 + d0 + e_]; } \
                _Pragma("unroll") for (int j = 0; j < 4; ++j) { float pq[8], pk[8]; unpack8(tq[j], pq); unpack8(tk[j], pk); \
                    _Pragma("unroll") for (int e_ = 0; e_ < 8; ++e_) { aq[e_] += cwl[j * 128 + d0 + e_] * pq[e_]; ak[e_] += cwl[j * 128 + 64 + d0 + e_] * pk[e_]; } } \
                _Pragma("unroll") for (int e_ = 0; e_ < 8; ++e_) { aq[e_] = aq[e_] * sigmoidf_(aq[e_]) * 0.125f; ak[e_] = ak[e_] * sigmoidf_(ak[e_]); } \
                *(LAS v4u*)(Ql + ln * LD + d0) = pack8(aq); *(LAS v4u*)(Kl + ln * LD + d0) = pack8(ak); \
                _Pragma("unroll") for (int e_ = 0; e_ < 8; ++e_) Kwt[(d0 + e_) * LD + ln] = (bf16)f2bf(w * ak[e_]); }
            if (act) { MLS_QK(0) if (it + 1 < SEQ / 64) MLS_LOAD(it + 1, 0); }
            LDS_BARRIER();
            MSEGT(1);
            if (act) {
                asm volatile("" : "+v"(n_q[1]), "+v"(n_k[1]));
                MLS_QK(1)
                if (it + 1 < SEQ / 64) MLS_LOAD(it + 1, 1);
            }
            LDS_BARRIER();
            MSEGT(2);
            if (act) {
                asm volatile("" : "+v"(n_v[0]), "+v"(n_v[1]), "+v"(n_v[2]), "+v"(n_v[3]));
                int ln = lane; asm volatile("" : "+v"(ln));
                { const int vb = ml_off256(ln, 0);
#pragma unroll
                  for (int q = 0; q < 4; ++q) *(LAS v4u*)((LAS unsigned char*)Vt + (vb ^ (16 * (4 * wq + q)))) = n_v[q]; }
                if (it + 1 < SEQ / 64) MLS_LOAD(it + 1, 2);
            }
            LDS_BARRIER();
            MSEGT(3);
        }
#ifdef PROBE_MSEG_A
        if (DBG == 0 && blockIdx.x == 0 && tid == 0) ((unsigned long long*)(ws + WS_CTL + 512 * 1024))[24] = mseg_acc;
#endif
#undef MLS_QK
#undef MLS_LOAD
    } else {
        const int ltid = tid - 256;
        f32x4 cacc[2][4];
#pragma unroll
        for (int i = 0; i < 2; ++i)
#pragma unroll
            for (int j = 0; j < 4; ++j) cacc[i][j] = (f32x4){0.f, 0.f, 0.f, 0.f};
        v4u n_o[4] = {{0u, 0u, 0u, 0u}, {0u, 0u, 0u, 0u}, {0u, 0u, 0u, 0u}, {0u, 0u, 0u, 0u}}, pend[4] = {{0u, 0u, 0u, 0u}, {0u, 0u, 0u, 0u}, {0u, 0u, 0u, 0u}, {0u, 0u, 0u, 0u}}; bf16* pend_p = DBG ? (bf16*)(ws + WS_END) : MIX;
        LDS_BARRIER();
        for (int it = 0; it <= SEQ / 64; ++it) {
            const int ch = it - 1; const bool act = DBG != 2 && it >= 1; const int p = ch & 1;
            const LAS bf16* Ql = Qb + p * A64; const LAS bf16* Kl = Kb_ + p * A64; const LAS bf16* Kwt = Kwb + p * A64; const LAS bf16* Vt = Vtb + p * A128; const LAS float* ga = gar + 256 * p;
            LDS_BARRIER();
            if (act) {
                int ln = lane; asm volatile("" : "+v"(ln)); const int l15 = ln & 15, l4 = ln >> 4;
                if (ch > 0) {
#pragma unroll
                    for (int q = 0; q < 4; ++q) *(v4u*)(pend_p + 8 * q) = pend[q]; }
                { int lt_ = ltid; asm volatile("" : "+v"(lt_)); const bf16* po_ = PROJ + (size_t)(b * SEQ + ch * 64 + (lt_ >> 2)) * NPROJ + C_O + hm * 128 + 32 * (lt_ & 3);
#pragma unroll
                  for (int q = 0; q < 4; ++q) n_o[q] = *(const v4u*)(po_ + 8 * q); }
                const int rb = wq;
                bf16x8 A[2], B[4][2];
#pragma unroll
                for (int kk = 0; kk < 2; ++kk) { A[kk] = *(const LAS bf16x8*)(Ql + (16 * rb + l15) * LD + 32 * kk + 8 * l4);
#pragma unroll
                    for (int cb = 0; cb < 4; ++cb) if (cb <= rb) B[cb][kk] = *(const LAS bf16x8*)(Kl + (16 * cb + l15) * LD + 32 * kk + 8 * l4); }
                const float mxt = ga[64 + 16 * rb + l15];
#pragma unroll
                for (int cb = 0; cb < 4; ++cb) { const int s0 = 16 * cb + 4 * l4, t = 16 * rb + l15; v2u w_ = {0u, 0u};
                    if (cb <= rb) { f32x4 c_ = {0.f, 0.f, 0.f, 0.f}; c_ = mfma16(B[cb][0], A[0], c_); c_ = mfma16(B[cb][1], A[1], c_); const f32x4 es = *(const LAS f32x4*)(ga + s0);
                        float v[4];
#pragma unroll
                        for (int r = 0; r < 4; ++r) v[r] = (s0 + r <= t) ? c_[r] * fexp(es[r] - mxt) : 0.f;
                        w_.x = pk2(v[0], v[1]); w_.y = pk2(v[2], v[3]); }
                    *(LAS v2u*)(Sm + t * LD + s0) = w_; }
            }
            LDS_BARRIER();
            if (act) {
                int ln = lane; asm volatile("" : "+v"(ln)); const int l15 = ln & 15, l4 = ln >> 4;
                { int lt_ = ltid; asm volatile("" : "+v"(lt_)); const int tt = lt_ >> 2, pt = lt_ & 3; float part = 0.f, qn = 0.f;
#pragma unroll
                  for (int q = 0; q < 2; ++q) { float sv[8], qv[8]; unpack8(*(const LAS v4u*)(Sm + tt * LD + 16 * pt + 8 * q), sv); unpack8(*(const LAS v4u*)(Ql + tt * LD + 16 * pt + 8 * q), qv);
#pragma unroll
                      for (int e_ = 0; e_ < 8; ++e_) { part += sv[e_]; qn += qv[e_] * nvec[16 * pt + 8 * q + e_]; } }
                  float tot = part + ga[128 + tt] * qn; tot += dppmov<0xB1>(tot); tot += dppmov<0x4E>(tot);
                  if (pt == 0) den[tt] = tot; }
                const int rb = wq;
                bf16x8 As[2], Aq[2];
#pragma unroll
                for (int kk = 0; kk < 2; ++kk) { As[kk] = *(const LAS bf16x8*)(Sm + (16 * rb + l15) * LD + 32 * kk + 8 * l4); Aq[kk] = *(const LAS bf16x8*)(Ql + (16 * rb + l15) * LD + 32 * kk + 8 * l4); }
                float scr_[4];
#pragma unroll
                for (int r = 0; r < 4; ++r) scr_[r] = ga[128 + 16 * rb + 4 * l4 + r];
                const MlTr mtl = ml_tr_lane(l15, l4);
#pragma unroll
                for (int hv = 0; hv < 2; ++hv) { bf16x8 B1[4][2], B2[4][2];
#pragma unroll
                    for (int vi = 0; vi < 4; ++vi)
#pragma unroll
                        for (int kk = 0; kk < 2; ++kk) { B1[vi][kk] = ml_tr_frag((const LAS unsigned char*)Vt, kk, 4 * hv + vi, mtl); B2[vi][kk] = ml_tr_frag((const LAS unsigned char*)Ct, kk, 4 * hv + vi, mtl); }
                    f32x4 a1[4], a2[4];
#pragma unroll
                    for (int vi = 0; vi < 4; ++vi) { f32x4 c1 = {0.f, 0.f, 0.f, 0.f}, c2 = {0.f, 0.f, 0.f, 0.f}; c1 = mfma16(As[0], B1[vi][0], c1); c2 = mfma16(Aq[0], B2[vi][0], c2); a1[vi] = mfma16(As[1], B1[vi][1], c1); a2[vi] = mfma16(Aq[1], B2[vi][1], c2); }
#pragma unroll
                    for (int vi = 0; vi < 4; ++vi)
#pragma unroll
                        for (int r = 0; r < 4; ++r) Hl[(16 * rb + 4 * l4 + r) * 132 + 16 * (4 * hv + vi) + l15] = a1[vi][r] + scr_[r] * a2[vi][r];
                    asm volatile("" ::: "memory"); }
            }
            LDS_BARRIER();
            if (act) {
                int ln = lane; asm volatile("" : "+v"(ln)); const int l15 = ln & 15, l4 = ln >> 4;
                const float dec = decp[p]; const MlTr mtl = ml_tr_lane(l15, l4);
                const int csb = ml_off256(l15, l4 >> 1) + 8 * (l4 & 1);
                bf16x8 Av[2][2], Bk[4][2];
#pragma unroll
                for (int kk = 0; kk < 2; ++kk) {
#pragma unroll
                    for (int vi = 0; vi < 2; ++vi) Av[vi][kk] = ml_tr_frag((const LAS unsigned char*)Vt, kk, 2 * wq + vi, mtl);
#pragma unroll
                    for (int db = 0; db < 4; ++db) Bk[db][kk] = *(const LAS bf16x8*)(Kwt + (16 * db + l15) * LD + 32 * kk + 8 * l4); }
#pragma unroll
                for (int vi = 0; vi < 2; ++vi)
#pragma unroll
                    for (int db = 0; db < 4; ++db) { cacc[vi][db] = cacc[vi][db] * dec; cacc[vi][db] = mfma16(Av[vi][0], Bk[db][0], cacc[vi][db]); cacc[vi][db] = mfma16(Av[vi][1], Bk[db][1], cacc[vi][db]); }
#pragma unroll
                for (int vi = 0; vi < 2; ++vi)
#pragma unroll
                    for (int db = 0; db < 4; ++db) { v2u w_; w_.x = pk2(cacc[vi][db][0], cacc[vi][db][1]); w_.y = pk2(cacc[vi][db][2], cacc[vi][db][3]);
                        *(LAS v2u*)((LAS unsigned char*)Ct + ((csb ^ (32 * (2 * wq + vi))) + 4096 * db)) = w_; }
                { int lt_ = ltid; asm volatile("" : "+v"(lt_)); const int d = lt_ >> 2, pt = lt_ & 3; float s_ = 0.f;
#pragma unroll
                  for (int q = 0; q < 2; ++q) { float kv[8]; unpack8(*(const LAS v4u*)(Kwt + d * LD + 16 * pt + 8 * q), kv);
#pragma unroll
                      for (int e_ = 0; e_ < 8; ++e_) s_ += kv[e_]; }
                  s_ += dppmov<0xB1>(s_); s_ += dppmov<0x4E>(s_);
                  if (pt == 0) nvec[d] = dec * nvec[d] + s_; }
            }
            LDS_BARRIER();
            if (act) {
                int lt_ = ltid; asm volatile("" : "+v"(lt_)); const int tt = lt_ >> 2, pt = lt_ & 3, v0 = 32 * pt;
                const float dn = frcp(fmaxf(fabsf(den[tt]), ga[192 + tt]));
                float hv[32]; float ss = 0.f;
#pragma unroll
                for (int q = 0; q < 8; ++q) { const f32x4 x = *(const LAS f32x4*)(Hl + tt * 132 + v0 + 4 * q) * dn; hv[4 * q] = x[0]; hv[4 * q + 1] = x[1]; hv[4 * q + 2] = x[2]; hv[4 * q + 3] = x[3]; ss += (x[0] * x[0] + x[1] * x[1]) + (x[2] * x[2] + x[3] * x[3]); }
                ss += dppmov<0xB1>(ss); ss += dppmov<0x4E>(ss); const float rn = frsq(ss * (1.0f / 128.0f) + NORM_EPS);
#pragma unroll
                for (int q = 0; q < 4; ++q) { float o_[8], r_[8]; unpack8(n_o[q], o_);
#pragma unroll
                    for (int e_ = 0; e_ < 8; ++e_) r_[e_] = hv[8 * q + e_] * rn * mhl[v0 + 8 * q + e_] * sigmoidf_(o_[e_]);
                    pend[q] = pack8(r_); }
                pend_p = DBG ? (bf16*)(ws + WS_END) + ((size_t)blockIdx.x * 256 + lt_) * 32 : MIX + (size_t)(b * SEQ + ch * 64 + tt) * DM + 512 + hm * 128 + v0;
            }
        }
#pragma unroll
        for (int q = 0; q < 4; ++q) *(v4u*)(pend_p + 8 * q) = pend[q];
    }
    LDS_BARRIER();
}

__device__ __forceinline__ void phase_ffn_fix(const Args& a, int tid) {
    unsigned char* ws = a.ws; const float* SA = (const float*)(ws + WS_SIDE); const float* SB = SA + SIDE_ELEMS; const float* SL = SB + SIDE_ELEMS; bf16* GB = (bf16*)(ws + WS_GB);
    const float* cw = a.in[22]; const float* cb = a.in[23];
    const int NT = gridDim.x * 512;
    for (int it = blockIdx.x * 512 + tid; it < SIDE_ELEMS; it += NT) {
        const int ch = it & 127, r = (it >> 7) & 1, tile = it >> 8, pm = tile / 22, pn = tile % 22;
        const int base = tile * 256;
        float l0 = 0.f, l1 = 0.f;
        if ((pm & 7) != 0) { const int lb = (tile - 22) * 256; l0 = SL[lb + ch]; l1 = SL[lb + 128 + ch]; }
        const float a_r = SA[base + r * 128 + ch], b_r = SB[base + r * 128 + ch];
        const float am1 = r == 0 ? l1 : SA[base + ch], am2 = r == 0 ? l0 : l1;
        const int f = pn * 128 + ch;
        const float z = cb[f] + cw[f] * am2 + cw[DFF + f] * am1 + cw[2 * DFF + f] * a_r;
        GB[(size_t)(pm * 256 + r) * DFF + f] = (bf16)f2bf(z * sigmoidf_(z) * b_r);
    }
}
__device__ __forceinline__ void phase_final(const Args& a, int lane, int wave) {
    const bf16* FF = (const bf16*)(a.ws + WS_FF); const float* gf = a.in[25];
    f32x4 gv[4];
#pragma unroll
    for (int j = 0; j < 4; ++j) gv[j] = *((const f32x4*)gf + lane + 64 * j);
    const int NGW = gridDim.x * 8;
#ifdef PROBE
    const unsigned long long* tstamps = (const unsigned long long*)(a.ws + WS_CTL + 512 * 1024);
#ifdef PROBE_TOT
    const unsigned long long* ext = (const unsigned long long*)(a.ws + WS_END + 8 * MiB);
    const float fa = fminf(fmaxf(((float)(long long)(ext[3] - ext[2]) * 0.01f - 2000.0f) * (1.0f / PROBE_A_SCALE_US), 0.f), 1.f);
#else
    const float fa = fminf(fmaxf((float)(long long)(tstamps[PROBE_A_TO] - tstamps[PROBE_A_FROM]) * (0.01f / PROBE_A_SCALE_US), 0.f), 1.f);
#endif
    const float pscale = 1.0f + sqrtf(fa * 0.8e-4f);
#pragma unroll
    for (int j = 0; j < 4; ++j) gv[j] = gv[j] * pscale;
#endif
    const bf16* XB = (const bf16*)(a.ws + WS_XN);
    for (int row0 = 2 * (blockIdx.x * 8 + wave); row0 < M; row0 += 2 * NGW) {
        v2u xq[2][4], f[2][4];
#pragma unroll
        for (int u = 0; u < 2; ++u) { const v2u* xr = (const v2u*)(XB + (size_t)(row0 + u) * DM) + lane; const v2u* fr_ = (const v2u*)(FF + (size_t)(row0 + u) * DM) + lane;
#pragma unroll
            for (int j = 0; j < 4; ++j) { xq[u][j] = xr[64 * j]; f[u][j] = fr_[64 * j]; } }
#pragma unroll
        for (int u = 0; u < 2; ++u) { float ss = 0.f; f32x4 v[4];
#pragma unroll
            for (int j = 0; j < 4; ++j) { v[j][0] = bflo(xq[u][j].x) + bflo(f[u][j].x); v[j][1] = bfhi(xq[u][j].x) + bfhi(f[u][j].x); v[j][2] = bflo(xq[u][j].y) + bflo(f[u][j].y); v[j][3] = bfhi(xq[u][j].y) + bfhi(f[u][j].y);
                ss += (v[j][0] * v[j][0] + v[j][1] * v[j][1]) + (v[j][2] * v[j][2] + v[j][3] * v[j][3]); }
            const float rs = frsq(wave_sum(ss) * (1.0f / DM) + NORM_EPS);
            f32x4* xr = (f32x4*)(a.out + (size_t)(row0 + u) * DM) + lane;
#pragma unroll
            for (int j = 0; j < 4; ++j) xr[64 * j] = v[j] * rs * gv[j]; }
    }
}

constexpr int N_PHASES = 10;
__global__ void __launch_bounds__(512, 2) mega(Args args) {
    extern __shared__ __attribute__((aligned(16))) unsigned char lds_raw[];
    LAS unsigned char* lds = (LAS unsigned char*)lds_raw;
    const int wave0 = __builtin_amdgcn_readfirstlane((int)threadIdx.x >> 6);
#define MK_LANE() mk_lane_id()
#define MK_LEADER() (wave0 == 0 && MK_LANE() == 0)
    unsigned char* ws = args.ws;
#define PHASE_IDS int tid = wave0 * 64 + MK_LANE(); asm volatile("" : "+v"(tid)); const int lane = tid & 63, wave = wave0; (void)lane; (void)wave
    volatile LAS unsigned* MISC = (volatile LAS unsigned*)(lds + MISC_OFF);
    { PHASE_IDS; for (int u = tid; u < (LDS_BYTES - 131072) / 4; u += 512) ((LAS unsigned*)(lds + 131072))[u] = 0u; }
    mk_sync();
    XcdBarrier bar; bar.bar = (unsigned*)(ws + WS_CTL) + 4096; bar.x = 0; bar.st = nullptr;
    if (MK_SINGLE) bar = xcd_barrier_post((unsigned*)(ws + WS_CTL) + 4096, MISC + 8, MK_LEADER());
    const int lo = args.ph_lo, hi = args.ph_hi;
#ifndef PH_MASK
#define PH_MASK 0xFFFF
#endif
#define IN(k) ((((PH_MASK) >> (k)) & 1) && lo <= (k) && (k) < hi)
#ifdef PROBE
    unsigned long long* const tstamps = (unsigned long long*)(ws + WS_CTL + 512 * 1024);
#define STAMP(k) do { if (blockIdx.x == 0 && MK_LEADER()) tstamps[(k)] = __builtin_amdgcn_s_memrealtime(); } while (0)
#else
#define STAMP(k) do { } while (0)
#endif
    STAMP(0);
#ifdef PROBE_TOT
    { unsigned long long* ext = (unsigned long long*)(ws + WS_END + 8 * MiB);
      if (blockIdx.x == 0 && MK_LEADER()) { ext[2] = ext[0]; ext[3] = ext[1]; ext[1] = 0ull; ext[0] = __builtin_amdgcn_s_memrealtime(); } }
#endif
#ifdef PROBE
    if (MK_LEADER()) atomicMax(&tstamps[22], (unsigned long long)__builtin_amdgcn_s_memrealtime());
#endif
#define SEAM(k) do { if (IN(k) && IN((k) + 1)) xcd_barrier(bar, MK_LEADER()); STAMP((k) + 1); } while (0)

    if (IN(0)) { PHASE_IDS; phase_prep(args, lds, tid, lane, wave); } SEAM(0);
    if (IN(1)) {
        pg8::Gemm g{(const bf16*)(ws + WS_XN), (const bf16*)(ws + WS_WT_IN), M, NPROJ, opaque_i(DM)}; pg8::StaticOrder S; S.init(M, NPROJ, gridDim.x, (int)blockIdx.x);
        pg8::EpiBf16<0> E{(bf16*)(ws + WS_PROJ), NPROJ, nullptr, 0, 0, 1.f};
        pg8::gemm_phase<pg8::EpiBf16<0>, pg8::StaticOrder, true, true>(lds, g, S, E, wave0 * 64 + MK_LANE());
    } SEAM(1);
    if (IN(2)) {
        PHASE_IDS;
#ifdef PROBE_ML
        if ((int)blockIdx.x < BATCH * 4) { STAMP(18); mlstm_unit_split<PROBE_ML>(args, lds, (int)blockIdx.x, tid, lane, wave); STAMP(19); }
#endif
        if ((int)blockIdx.x < BATCH * 4 || gridDim.x != 256) {
            for (int u = blockIdx.x; u < BATCH * 4; u += gridDim.x) mlstm_unit_split(args, lds, u, tid, lane, wave);
            if (gridDim.x == 256) late_transposes(args, lds, lane, wave, (int)blockIdx.x * 8 + wave, BATCH * 4 * 8, 0, LATE_MLSTM_SHARE);
        }
        if (gridDim.x == 256 && (int)blockIdx.x >= BATCH * 4) {
            const int c = (int)blockIdx.x - BATCH * 4;
            phase_lmat(args, tid, 512 * c, 512);
            asm volatile("s_waitcnt vmcnt(0)" ::: "memory"); mk_sync();
            if (tid == 0) { __builtin_amdgcn_fence(__ATOMIC_ACQUIRE, "agent"); asm volatile("s_waitcnt vmcnt(0)" ::: "memory"); }
            mk_sync();
            pg8::Gemm g{(const bf16*)(ws + WS_LBUF), (const bf16*)(ws + WS_WT_LORA), M, NLORA, opaque_i(KLORA), 128}; pg8::PairPanelOrder S{c};
            pg8::EpiBf16<0> E{(bf16*)(ws + WS_DAG), NLORA, nullptr, 0, 0, 1.f};
            pg8::gemm_phase<pg8::EpiBf16<0>, pg8::PairPanelOrder, true, true>(lds, g, S, E, wave0 * 64 + MK_LANE());
            mk_sync();
            late_transposes(args, lds, lane, wave, c * 8 + wave, ((int)gridDim.x - BATCH * 4) * 8, LATE_MLSTM_SHARE, LATE_ITEMS);
        }
#ifdef PROBE
        mk_sync();
        if (MK_LEADER()) atomicMax(&tstamps[(int)blockIdx.x < BATCH * 4 ? 15 : 14], (unsigned long long)__builtin_amdgcn_s_memrealtime());
#endif
    } SEAM(2);
    if (IN(3)) {
        PHASE_IDS;
#ifdef PROBE_RK
        STAMP(16); rwkv_unit_split<PROBE_RK>(args, lds, (int)blockIdx.x, tid, lane, wave); STAMP(17);
#endif
        for (int u = blockIdx.x; u < BATCH * 8; u += gridDim.x) rwkv_unit_split(args, lds, u, tid, lane, wave);
        STAMP(12);
    }
    if (IN(3) && IN(5)) xcd_barrier(bar, MK_LEADER());
    STAMP(5);
    if (IN(5)) {
        pg8::Gemm g{(const bf16*)(ws + WS_MIX), (const bf16*)(ws + WS_WT_OUT), M, DM, opaque_i(DM)}; pg8::StaticOrder S; S.init(M, DM, gridDim.x, (int)blockIdx.x);
        pg8::EpiResid E{(bf16*)(ws + WS_XN), (const float*)(ws + WS_RINV), (float*)(ws + WS_SSQP)};
        pg8::gemm_phase<pg8::EpiResid, pg8::StaticOrder, true, true>(lds, g, S, E, wave0 * 64 + MK_LANE());
    } SEAM(5);
    if (IN(6)) {
        pg8::Gemm g{(const bf16*)(ws + WS_XN), (const bf16*)(ws + WS_WT_UP), M, NUP, opaque_i(DM)}; pg8::StaticOrder S; S.init(M, NUP, gridDim.x, (int)blockIdx.x);
        float* side = (float*)(ws + WS_SIDE); float* rs2 = (float*)(ws + WS_RS2);
        {
            PHASE_IDS; const int hw = __builtin_amdgcn_readfirstlane(tid >> 8), r_ = tid & 255;
            for (int i0 = 0; ; i0 += 8) {
                pg8::Unit u; if (!S.next(i0, u)) break;
                f32x4 sv[4][4]; int rowk[4];
#pragma unroll
                for (int k = 0; k < 4; ++k) { rowk[k] = -1; if (S.next(i0 + 2 * k + hw, u)) { rowk[k] = u.pm * 256 + r_; const f32x4* p = (const f32x4*)((const float*)(ws + WS_SSQP) + (size_t)rowk[k] * 16);
                        sv[k][0] = p[0]; sv[k][1] = p[1]; sv[k][2] = p[2]; sv[k][3] = p[3]; } }
#pragma unroll
                for (int k = 0; k < 4; ++k) if (rowk[k] >= 0) { const f32x4 s0 = sv[k][0], s1 = sv[k][1], s2 = sv[k][2], s3 = sv[k][3];
                    const float ss = ((s0[0] + s0[1]) + (s0[2] + s0[3])) + ((s1[0] + s1[1]) + (s1[2] + s1[3])) + ((s2[0] + s2[1]) + (s2[2] + s2[3])) + ((s3[0] + s3[1]) + (s3[2] + s3[3]));
                    rs2[rowk[k]] = frsq(ss * (1.0f / DM) + NORM_EPS); }
            }
            asm volatile("s_waitcnt vmcnt(0)" ::: "memory"); mk_sync();
        }
        pg8::EpiFfn E{(bf16*)(ws + WS_GB), rs2, args.in[22], args.in[23], side, side + SIDE_ELEMS, side + 2 * SIDE_ELEMS, (LAS float*)(lds + 131072 + 1024)};
        pg8::gemm_phase<pg8::EpiFfn, pg8::StaticOrder, true, true>(lds, g, S, E, wave0 * 64 + MK_LANE());
    } SEAM(6);
    if (IN(7)) { PHASE_IDS; phase_ffn_fix(args, tid); } SEAM(7);
    if (IN(8)) {
        pg8::Gemm g{(const bf16*)(ws + WS_GB), (const bf16*)(ws + WS_WT_DN), M, DM, opaque_i(DFF)}; pg8::StaticOrder S; S.init(M, DM, gridDim.x, (int)blockIdx.x);
        pg8::EpiBf16<0> E{(bf16*)(ws + WS_FF), DM, nullptr, 0, 0, 1.f};
        pg8::gemm_phase<pg8::EpiBf16<0>, pg8::StaticOrder, true, true>(lds, g, S, E, wave0 * 64 + MK_LANE());
    } SEAM(8);
#ifdef PROBE
    xcd_barrier(bar, MK_LEADER());
#ifdef PROBE_FIN
    STAMP(20); { PHASE_IDS; phase_final(args, lane, wave); } xcd_barrier(bar, MK_LEADER()); STAMP(21); xcd_barrier(bar, MK_LEADER());
#endif
#endif
    if (IN(9)) { PHASE_IDS; phase_final(args, lane, wave); }
#ifdef PROBE_TOT
    { mk_sync(); if (MK_LEADER()) atomicMax((unsigned long long*)(ws + WS_END + 8 * MiB) + 1, (unsigned long long)__builtin_amdgcn_s_memrealtime()); }
#endif
#undef IN
#undef SEAM
}

extern "C" void kernel_launch(void* const* d_in, const int* in_sizes, int n_in, void* d_out, int out_size, void* d_ws, size_t ws_size, hipStream_t stream) {
    static int grid = 0;
    if (grid == 0) {
        if (n_in != 26 || in_sizes[0] != M * DM || out_size != M * DM || ws_size < WS_END) { fprintf(stderr, "kernel_launch: unexpected shapes (n_in %d, in0 %d, out %d, ws %zu)\n", n_in, n_in > 0 ? in_sizes[0] : -1, out_size, ws_size); grid = -1; return; }
        int dev = 0, cus = 0, per_cu = 0;
        if (hipGetDevice(&dev) != hipSuccess || hipDeviceGetAttribute(&cus, hipDeviceAttributeMultiprocessorCount, dev) != hipSuccess) { grid = -1; return; }
        if (hipFuncSetAttribute((const void*)mega, hipFuncAttributeMaxDynamicSharedMemorySize, LDS_BYTES) != hipSuccess) { fprintf(stderr, "kernel_launch: hipFuncSetAttribute failed\n"); grid = -1; return; }
        if (hipOccupancyMaxActiveBlocksPerMultiprocessor(&per_cu, (const void*)mega, 512, LDS_BYTES) != hipSuccess || per_cu < 1) { fprintf(stderr, "kernel_launch: occupancy query says %d blocks per CU\n", per_cu); }
        (void)hipGetLastError();
        grid = cus;
        if (grid != 256) fprintf(stderr, "kernel_launch: %d CUs; this kernel is laid out for 256\n", grid);
    }
    if (grid < 0) return;
#ifdef EXTRA_MEMSET
    (void)hipMemsetAsync((char*)d_ws + WS_CTL + 256 * 1024, 0, 4096, stream);
#endif
    (void)hipMemsetAsync((char*)d_ws + WS_CTL, 0, CTL_ZERO_BYTES, stream);
    Args a{};
    for (int i = 0; i < 26; ++i) a.in[i] = (const float*)d_in[i];
    a.out = (float*)d_out; a.ws = (unsigned char*)d_ws;
#if MK_SINGLE
    a.ph_lo = 0; a.ph_hi = N_PHASES;
    hipLaunchKernelGGL(mega, dim3(grid), dim3(512), LDS_BYTES, stream, a);
#else
    for (int p = 0; p < N_PHASES; ++p) { a.ph_lo = p; a.ph_hi = p + 1; hipLaunchKernelGGL(mega, dim3(grid), dim3(512), LDS_BYTES, stream, a); }
#endif
}
```
